# Optimizing an MI355X kernel written in HIP

```python
import jax
import jax.numpy as jnp
from jax import lax
import numpy as np

D_MODEL = 2048
BATCH = 8
SEQ = 2048
DEPTH = 1

GRID_W = 64
N_META = 16
NA_HEADS = 16
NA_HEAD_DIM = 64
NA_WIN_H_MAX = 8
NA_WIN_W = 16
NA_QBLOCK_W = NA_WIN_W
NA_KBLOCK_W = 2 * NA_WIN_W
MLA_HEADS = 16
MLA_Q_RANK = 512
MLA_KV_RANK = 512
MLA_NOPE_DIM = 128
MLA_ROPE_DIM = 64
MLA_V_DIM = 128
MLA_QBLOCK = 128
ROPE_THETA = 10000.0
PEER_HEADS = 8
PEER_NKEYS = 128
PEER_EXPERTS = PEER_NKEYS * PEER_NKEYS
PEER_DK = 256
PEER_TOPK = 16
PEER_TOKEN_CHUNK = 16
NORM_EPS = 1e-6
NEG_INF = -1e30

NA_WIDTH = NA_HEADS * NA_HEAD_DIM
MLA_Q_WIDTH = MLA_HEADS * (MLA_NOPE_DIM + MLA_ROPE_DIM)
MLA_KV_WIDTH = MLA_HEADS * (MLA_NOPE_DIM + MLA_V_DIM)
MLA_OUT_WIDTH = MLA_HEADS * MLA_V_DIM
IN_SIZES = (NA_WIDTH, NA_WIDTH, NA_WIDTH, MLA_Q_RANK, MLA_KV_RANK, MLA_ROPE_DIM, D_MODEL, D_MODEL)
IN_WIDTH = sum(IN_SIZES)

kernel_name = 'hybrid_na_mla_peer_block'


def rmsnorm(x, g):
    xf = x.astype(jnp.float32)
    y = xf * lax.rsqrt(jnp.mean(xf * xf, axis=-1, keepdims=True) + NORM_EPS)
    return (y * g.astype(jnp.float32)).astype(x.dtype)


def rope(x, cos, sin):
    half = x.shape[-1] // 2
    x1 = x[..., :half].astype(jnp.float32)
    x2 = x[..., half:].astype(jnp.float32)
    return jnp.concatenate([x1 * cos - x2 * sin, x2 * cos + x1 * sin], axis=-1).astype(x.dtype)


def _na_static(rows):
    wh = min(NA_WIN_H_MAX, rows)
    r = np.arange(rows)
    row_start = np.clip(r - wh // 2, 0, rows - wh)
    row_off = row_start[:, None] + np.arange(wh)[None] - r[:, None] + (NA_WIN_H_MAX - 1)
    ncb = GRID_W // NA_QBLOCK_W
    qcol = np.arange(ncb)[:, None] * NA_QBLOCK_W + np.arange(NA_QBLOCK_W)[None]
    kcol0 = np.clip(np.arange(ncb) * NA_QBLOCK_W - NA_WIN_W // 2, 0, GRID_W - NA_KBLOCK_W)
    kcol = kcol0[:, None] + np.arange(NA_KBLOCK_W)[None]
    cstart = np.clip(qcol - NA_WIN_W // 2, 0, GRID_W - NA_WIN_W)
    kc = kcol[:, None, :]
    col_mask = (kc >= cstart[:, :, None]) & (kc < cstart[:, :, None] + NA_WIN_W)
    col_off = np.clip(kc - qcol[:, :, None], -(NA_WIN_W - 1), NA_WIN_W - 1) + NA_WIN_W - 1
    return wh, row_start.astype(np.int32), row_off, kcol, col_mask, col_off


def neighbourhood_attention(q, k, v, rel_bias, meta_bias):
    b, t, h, dh = q.shape
    n = t - N_META
    rows = n // GRID_W
    wh, row_start, row_off, kcol, col_mask, col_off = _na_static(rows)
    ncb = GRID_W // NA_QBLOCK_W
    scale = dh ** -0.5
    qm, km, vm = q[:, :N_META], k[:, :N_META], v[:, :N_META]
    qg = q[:, N_META:].reshape(b, rows, GRID_W, h, dh)
    kg = k[:, N_META:].reshape(b, rows, GRID_W, h, dh)
    vg = v[:, N_META:].reshape(b, rows, GRID_W, h, dh)
    mb = meta_bias.astype(jnp.float32)
    sm = jnp.einsum('bqhd,bkhd->bhqk', qm, km).astype(jnp.float32) * scale + mb[None, :, None, :]
    om = jnp.einsum('bhqk,bkhd->bqhd', jax.nn.softmax(sm, axis=-1).astype(v.dtype), vm)
    bias = rel_bias.astype(jnp.float32)[:, row_off[:, :, None, None, None], col_off[None, None]]
    bias = bias.transpose(1, 0, 3, 4, 2, 5)
    bias = jnp.where(jnp.asarray(col_mask)[None, None, :, :, None, :], bias, NEG_INF)
    q_rows = qg.reshape(b, rows, ncb, NA_QBLOCK_W, h, dh).transpose(1, 0, 2, 3, 4, 5)
    n_loc = wh * NA_KBLOCK_W

    def row_fn(args):
        q_r, rs, bias_r = args
        k_blk = lax.dynamic_slice_in_dim(kg, rs, wh, axis=1)[:, :, kcol]
        v_blk = lax.dynamic_slice_in_dim(vg, rs, wh, axis=1)[:, :, kcol]
        s_loc = jnp.einsum('bjqhd,bwjkhd->bhjqwk', q_r, k_blk).astype(jnp.float32) * scale + bias_r[None]
        s_meta = jnp.einsum('bjqhd,bmhd->bhjqm', q_r, km).astype(jnp.float32) * scale + mb[None, :, None, None, :]
        s = jnp.concatenate([s_loc.reshape(b, h, ncb, NA_QBLOCK_W, n_loc), s_meta], axis=-1)
        p = jax.nn.softmax(s, axis=-1).astype(v.dtype)
        p_loc = p[..., :n_loc].reshape(b, h, ncb, NA_QBLOCK_W, wh, NA_KBLOCK_W)
        return (jnp.einsum('bhjqwk,bwjkhd->bjqhd', p_loc, v_blk)
                + jnp.einsum('bhjqm,bmhd->bjqhd', p[..., n_loc:], vm))

    o_rows = lax.map(row_fn, (q_rows, jnp.asarray(row_start), bias))
    og = o_rows.transpose(1, 0, 2, 3, 4, 5).reshape(b, n, h, dh)
    return jnp.concatenate([om, og], axis=1)


def latent_attention(c_q, c_kv, k_rope_raw, q_norm_g, w_uq, kv_norm_g, w_ukv, cos, sin):
    b, t, _ = c_q.shape
    q = (rmsnorm(c_q, q_norm_g) @ w_uq).reshape(b, t, MLA_HEADS, MLA_NOPE_DIM + MLA_ROPE_DIM)
    q_nope = q[..., :MLA_NOPE_DIM]
    q_rope = rope(q[..., MLA_NOPE_DIM:], cos[:, None, :], sin[:, None, :])
    kv = (rmsnorm(c_kv, kv_norm_g) @ w_ukv).reshape(b, t, MLA_HEADS, MLA_NOPE_DIM + MLA_V_DIM)
    k_nope, val = kv[..., :MLA_NOPE_DIM], kv[..., MLA_NOPE_DIM:]
    k_rope = rope(k_rope_raw, cos, sin)
    scale = (MLA_NOPE_DIM + MLA_ROPE_DIM) ** -0.5

    def attend(qn, qr):
        s = (jnp.einsum('bqhd,bkhd->bhqk', qn, k_nope)
             + jnp.einsum('bqhr,bkr->bhqk', qr, k_rope)).astype(jnp.float32) * scale
        p = jax.nn.softmax(s, axis=-1).astype(val.dtype)
        return jnp.einsum('bhqk,bkhd->bqhd', p, val)

    o_meta = attend(q_nope[:, :N_META], q_rope[:, :N_META])
    n = t - N_META
    nb = n // MLA_QBLOCK

    def blocks(a):
        return a[:, N_META:].reshape((b, nb, MLA_QBLOCK) + a.shape[2:]).swapaxes(0, 1)

    o_real = lax.map(lambda a: attend(a[0], a[1]), (blocks(q_nope), blocks(q_rope)))
    o_real = o_real.swapaxes(0, 1).reshape(b, n, MLA_HEADS, MLA_V_DIM)
    return jnp.concatenate([o_meta, o_real], axis=1).reshape(b, t, MLA_OUT_WIDTH)


def peer(hn, w_q, sub_keys, u, v):
    b, t, d = hn.shape
    q = (hn @ w_q).reshape(b, t, PEER_HEADS, 2, PEER_DK // 2)
    s = jnp.einsum('bthsc,hsnc->bthsn', q, sub_keys).astype(jnp.float32)
    s_top, i_top = lax.top_k(s, PEER_TOPK)
    cand = s_top[..., 0, :, None] + s_top[..., 1, None, :]
    c_top, c_idx = lax.top_k(cand.reshape(b, t, PEER_HEADS, PEER_TOPK * PEER_TOPK), PEER_TOPK)
    i1 = jnp.take_along_axis(i_top[..., 0, :], c_idx // PEER_TOPK, axis=-1)
    i2 = jnp.take_along_axis(i_top[..., 1, :], c_idx % PEER_TOPK, axis=-1)
    expert = i1 * PEER_NKEYS + i2
    g = jax.nn.softmax(c_top, axis=-1).astype(hn.dtype)
    nc = (b * t) // PEER_TOKEN_CHUNK
    hf = hn.reshape(nc, PEER_TOKEN_CHUNK, d)
    ef = expert.reshape(nc, PEER_TOKEN_CHUNK, PEER_HEADS * PEER_TOPK)
    gf = g.reshape(nc, PEER_TOKEN_CHUNK, PEER_HEADS * PEER_TOPK)

    def chunk_fn(a):
        h_c, e_c, g_c = a
        act = jax.nn.gelu(jnp.einsum('nd,nkd->nk', h_c, u[e_c]))
        return jnp.einsum('nk,nkd->nd', g_c * act, v[e_c])

    return lax.map(chunk_fn, (hf, ef, gf)).reshape(b, t, d)


def setup_inputs(seed: int = 0) -> dict:
    key = jax.random.key(seed)
    ks = jax.random.split(key, 19)

    def nrm(k, shape, scale):
        return jax.random.normal(k, shape, jnp.float32) * scale

    def gain(k, shape):
        return 1.0 + 0.02 * jax.random.normal(k, shape, jnp.float32)

    return {
        'x': nrm(ks[0], (BATCH, SEQ, D_MODEL), 1.0),
        'meta_tokens': nrm(ks[1], (N_META, D_MODEL), 1.0),
        'norm1_g': gain(ks[2], (DEPTH, D_MODEL)),
        'w_in': nrm(ks[3], (DEPTH, D_MODEL, IN_WIDTH), D_MODEL ** -0.5),
        'na_rel_bias': nrm(ks[4], (DEPTH, NA_HEADS, 2 * NA_WIN_H_MAX - 1, 2 * NA_WIN_W - 1), 0.1),
        'na_meta_bias': nrm(ks[5], (DEPTH, NA_HEADS, N_META), 0.1),
        'mla_q_norm_g': gain(ks[6], (DEPTH, MLA_Q_RANK)),
        'mla_w_uq': nrm(ks[7], (DEPTH, MLA_Q_RANK, MLA_Q_WIDTH), MLA_Q_RANK ** -0.5),
        'mla_kv_norm_g': gain(ks[8], (DEPTH, MLA_KV_RANK)),
        'mla_w_ukv': nrm(ks[9], (DEPTH, MLA_KV_RANK, MLA_KV_WIDTH), MLA_KV_RANK ** -0.5),
        'w_na_branch': nrm(ks[10], (DEPTH, NA_WIDTH, D_MODEL), NA_WIDTH ** -0.5),
        'w_mla_branch': nrm(ks[11], (DEPTH, MLA_OUT_WIDTH, D_MODEL), MLA_OUT_WIDTH ** -0.5),
        'w_out': nrm(ks[12], (DEPTH, D_MODEL, D_MODEL), D_MODEL ** -0.5),
        'norm2_g': gain(ks[13], (DEPTH, D_MODEL)),
        'peer_w_q': nrm(ks[14], (DEPTH, D_MODEL, PEER_HEADS * PEER_DK), D_MODEL ** -0.5),
        'peer_sub_keys': nrm(ks[15], (DEPTH, PEER_HEADS, 2, PEER_NKEYS, PEER_DK // 2), (PEER_DK // 2) ** -0.5),
        'peer_u': nrm(ks[16], (DEPTH, PEER_EXPERTS, D_MODEL), D_MODEL ** -0.5),
        'peer_v': nrm(ks[17], (DEPTH, PEER_EXPERTS, D_MODEL), PEER_HEADS ** -0.5),
        'final_norm_g': gain(ks[18], (D_MODEL,)),
    }


def reference(x, meta_tokens, norm1_g, w_in, na_rel_bias, na_meta_bias, mla_q_norm_g, mla_w_uq,
              mla_kv_norm_g, mla_w_ukv, w_na_branch, w_mla_branch, w_out, norm2_g, peer_w_q,
              peer_sub_keys, peer_u, peer_v, final_norm_g):
    b, s, d = x.shape
    t = s + N_META
    h = jnp.concatenate([jnp.broadcast_to(meta_tokens.astype(x.dtype)[None], (b, N_META, d)), x], axis=1)
    pos = jnp.arange(t, dtype=jnp.float32)
    inv_freq = ROPE_THETA ** (-jnp.arange(0, MLA_ROPE_DIM, 2, dtype=jnp.float32) / MLA_ROPE_DIM)
    ang = pos[:, None] * inv_freq[None, :]
    cos, sin = jnp.cos(ang), jnp.sin(ang)
    offsets = [int(o) for o in np.cumsum(IN_SIZES)[:-1]]
    for l in range(DEPTH):
        hn = rmsnorm(h, norm1_g[l])
        na_q, na_k, na_v, c_q, c_kv, k_rope_raw, gate_a, gate_b = jnp.split(hn @ w_in[l], offsets, axis=-1)
        hd = (b, t, NA_HEADS, NA_HEAD_DIM)
        o_na = neighbourhood_attention(na_q.reshape(hd), na_k.reshape(hd), na_v.reshape(hd),
                                       na_rel_bias[l], na_meta_bias[l]).reshape(b, t, NA_WIDTH)
        o_mla = latent_attention(c_q, c_kv, k_rope_raw, mla_q_norm_g[l], mla_w_uq[l],
                                 mla_kv_norm_g[l], mla_w_ukv[l], cos, sin)
        merged = (jax.nn.sigmoid(gate_a) * (o_na @ w_na_branch[l])
                  + jax.nn.sigmoid(gate_b) * (o_mla @ w_mla_branch[l]))
        h = h + merged @ w_out[l]
        h = h + peer(rmsnorm(h, norm2_g[l]), peer_w_q[l], peer_sub_keys[l], peer_u[l], peer_v[l])
    return rmsnorm(h[:, N_META:], final_norm_g)
```

```cpp
#include <hip/hip_runtime.h>
#include <cstdio>
#include <cstdint>

#define LAS __attribute__((address_space(3)))
#define GAS __attribute__((address_space(1)))
typedef unsigned short bf16_t;
typedef short bf16x8 __attribute__((ext_vector_type(8)));
typedef short s16x4 __attribute__((ext_vector_type(4)));
typedef float f32x4 __attribute__((ext_vector_type(4)));
typedef float f32x2 __attribute__((ext_vector_type(2)));
typedef float f32x16 __attribute__((ext_vector_type(16)));
typedef unsigned u32x4 __attribute__((ext_vector_type(4)));
typedef unsigned u32x2 __attribute__((ext_vector_type(2)));

constexpr int DM = 2048, NBATCH = 8, SEQ = 2048, NMETA = 16;
constexpr int MREAL = NBATCH * SEQ;
constexpr int MPAD = MREAL + 256;
constexpr int NPOS = SEQ + NMETA;
constexpr float NORM_EPS = 1e-6f;
constexpr int C_NAQ = 0, C_NAK = 1024, C_CQ = 2048, C_CKV = 2560, C_GA = 3072, C_GB = 5120, C_KR = 7168, NMAIN = 7424;
constexpr int VT_PITCH = MPAD;

constexpr size_t MiB = 1u << 20;
constexpr size_t WS_CTL = 0, CTL_ZERO_BYTES = 1 * MiB;
constexpr size_t WS_SSQ_Q = 481 * MiB, WS_SSQ_KV = 482 * MiB, WS_SSQ_2 = 486 * MiB;
constexpr size_t WS_COS = 1 * MiB, WS_SIN = 1 * MiB + 512 * 1024;
constexpr size_t WS_WUQ = 2 * MiB, WS_WUKV = 5 * MiB, WS_WNA = 9 * MiB, WS_WMLA = 13 * MiB, WS_WOUT = 21 * MiB, WS_WSC = 29 * MiB;
constexpr size_t WS_GA = 37 * MiB, WS_GB = 101 * MiB;
constexpr size_t WS_KR = 165 * MiB;
constexpr size_t WS_WIN = 167 * MiB + 256 * 1024, WS_WVT = WS_WIN + 29 * MiB;
constexpr size_t WS_ONA = 190 * MiB;
constexpr size_t WS_NAQ = 222 * MiB, WS_NAK = 254 * MiB, WS_VT = WS_NAK + 32 * MiB + 512 * 1024;
constexpr size_t WS_HN1 = 319 * MiB;
constexpr size_t WS_CQ = 448 * MiB, WS_CKV = 464 * MiB;
constexpr size_t WS_QM = 222 * MiB, WS_KN = 318 * MiB, WS_VV = 383 * MiB;
constexpr size_t WS_OMLA = 448 * MiB;
constexpr size_t WS_MERGED = 222 * MiB, WS_T1 = 286 * MiB;
constexpr size_t WS_H2 = 37 * MiB, WS_H2B = 293 * MiB;
constexpr size_t WS_U = 357 * MiB, WS_V = 421 * MiB;
constexpr size_t WS_SC = 165 * MiB;
constexpr size_t WS_END = 512 * MiB;
static_assert(WS_CKV + (size_t)MPAD * 512 * 2 <= WS_SSQ_Q && WS_SSQ_Q + (size_t)8 * MPAD * 4 <= WS_SSQ_KV && WS_SSQ_KV + (size_t)8 * MPAD * 4 <= 483 * MiB && WS_V + 64 * MiB <= WS_SSQ_2 && WS_SSQ_2 + (size_t)32 * MREAL * 4 <= WS_END, "ssq slabs");
static_assert(WS_VT + (size_t)1024 * MPAD * 2 <= WS_HN1 && WS_HN1 + (size_t)MPAD * 2048 * 2 <= WS_CQ && WS_CKV + (size_t)MPAD * 512 * 2 <= WS_END, "map P1");
static_assert(WS_WVT + 4 * MiB <= WS_NAQ && WS_KR + (size_t)MPAD * 64 * 2 <= WS_WIN && WS_ONA + 32 * MiB <= WS_NAQ, "map P1b");
static_assert(WS_QM + 96 * MiB <= WS_KN && WS_KN + 65 * MiB <= WS_VV && WS_VV + 65 * MiB <= WS_OMLA && WS_OMLA + 64 * MiB <= WS_END, "map P3");
static_assert(WS_T1 + 128 * MiB <= WS_OMLA && WS_H2 + 128 * MiB <= WS_KR && WS_SC + 128 * MiB <= WS_H2B && WS_H2B + 64 * MiB <= WS_U && WS_V + 64 * MiB <= WS_END, "map P5+");

constexpr int CW_BAR = 4096;

constexpr int RING_BYTES = 131072;
constexpr int LDSCTL_OFF = RING_BYTES, MISC_OFF = LDSCTL_OFF + 320;
constexpr int LDS_BYTES = 147456;
constexpr int NWAVES = 8;

#define LDS_WAIT() asm volatile("s_waitcnt lgkmcnt(0)" ::: "memory")
#define VM_WAIT() asm volatile("s_waitcnt vmcnt(0)" ::: "memory")
#define SBAR() __builtin_amdgcn_sched_barrier(0)
typedef __bf16 bf16x2_t __attribute__((ext_vector_type(2)));
__device__ __forceinline__ unsigned cvt_pk_bf16(float lo, float hi) { const f32x2 v = {lo, hi}; const bf16x2_t b = __builtin_convertvector(v, bf16x2_t); return __builtin_bit_cast(unsigned, b); }
__device__ __forceinline__ float bf_lo(unsigned w) { return __uint_as_float(w << 16); }
__device__ __forceinline__ float bf_hi(unsigned w) { return __uint_as_float(w & 0xffff0000u); }
__device__ __forceinline__ u32x4 pack8(const f32x4 a, const f32x4 b) { u32x4 w; w.x = cvt_pk_bf16(a[0], a[1]); w.y = cvt_pk_bf16(a[2], a[3]); w.z = cvt_pk_bf16(b[0], b[1]); w.w = cvt_pk_bf16(b[2], b[3]); return w; }
__device__ __forceinline__ u32x2 pack4(const f32x4 a) { u32x2 w; w.x = cvt_pk_bf16(a[0], a[1]); w.y = cvt_pk_bf16(a[2], a[3]); return w; }
__device__ __forceinline__ float wave_sum(float v) {
#pragma unroll
    for (int o = 1; o < 64; o <<= 1) v += __shfl_xor(v, o);
    return v;
}
__device__ __forceinline__ float sigmoidf_(float x) { return __builtin_amdgcn_rcpf(1.0f + __builtin_amdgcn_exp2f(-1.4426950408889634f * x)); }
__device__ __forceinline__ int crow(int r, int hi) { return (r & 3) + 8 * (r >> 2) + 4 * hi; }
#ifndef PG8_AUX
#define PG8_AUX 16
#endif
namespace pg8 {
constexpr int BM = 256, BK = 64, HALF = 128, HTB = HALF * BK * 2  , STAGE_BYTES = 8 * HTB, NXCD = 8, WGM = 8;
__host__ __device__ __forceinline__ int lds_byte(int r, int c) { const int st = (r >> 4) * 2 + (c >> 5), rr = r & 15, cc = c & 31, ob = rr * 64 + cc * 2; return st * 1024 + (ob ^ (((ob >> 9) & 1) << 5)); }
__host__ __device__ __forceinline__ void stage_rc(int b, int& R, int& C) { const int st = b / 1024, sb = b % 1024, swz = sb ^ (((sb >> 9) & 1) << 5); R = (st >> 1) * 16 + swz / 64; C = (st & 1) * 32 + (swz % 64) / 2; }
__host__ __device__ __forceinline__ int perm32(int rho) { const int n = rho >> 4, i = rho & 15; return 8 * (i >> 2) + 4 * n + (i & 3); }

struct Unit { int pm, pn, kind; };

__device__ __forceinline__ void grid_order(int L, int nM, int nN, int& pm, int& pn) {
    const int nwg = nM * nN; int wgid = L;
    { const int q = nwg / NXCD, r = nwg % NXCD, xcd = wgid % NXCD, off = wgid / NXCD; wgid = (xcd < r ? xcd * (q + 1) : r * (q + 1) + (xcd - r) * q) + off; }
    const int nig = WGM * nN, gid = wgid / nig, fm = gid * WGM, gsz = (nM - fm) < WGM ? (nM - fm) : WGM;
    pm = fm + ((wgid % nig) % gsz); pn = (wgid % nig) / gsz;
}

template <class Epi, class Sched>
__device__ __forceinline__ void gemm_phase(LAS unsigned char* lds, const int K, const Sched& S, const Epi& E) {
    const int tid = threadIdx.x, wid = __builtin_amdgcn_readfirstlane(tid >> 6), lane = tid & 63, wr = wid >> 2, wc = wid & 3, fr = lane & 15, fq = lane >> 4;
    const int nt = K / BK;
    unsigned voffA[2], voffB[2];
#pragma unroll
    for (int i = 0; i < 2; ++i) { int R, C; stage_rc(tid * 16 + i * 8192, R, C); const int Rb = Epi::PERM ? ((R & ~31) + perm32(R & 31)) : R;
        voffA[i] = (unsigned)(R * K + C) * 2u; voffB[i] = (unsigned)(Rb * K + C) * 2u; }
    const size_t kstep = (size_t)(BK * 2);
    const size_t hstep = (size_t)HALF * K * 2;
    const unsigned ldsw = (unsigned)wid * 1024u;
    const int aoff = lds_byte(wr * 64 + fr, fq * 8), boff = lds_byte(wc * 32 + fr, fq * 8);
#define PG8_SA(b, h) (((b) * 2 + (h)) * HTB)
#define PG8_SB(b, h) ((4 + (b) * 2 + (h)) * HTB)
#define PG8_STAGE(bufoff, gbase, voff) do { _Pragma("unroll") for (int _i = 0; _i < 2; ++_i) \
        __builtin_amdgcn_global_load_lds((const unsigned*)((const char*)(gbase) + (voff)[_i]), (LAS unsigned*)(lds + (bufoff) + ldsw + _i * 8192), 16, 0, PG8_AUX); } while (0)
#define PG8_LDA(dst, b, h) do { _Pragma("unroll") for (int m = 0; m < 4; ++m) _Pragma("unroll") for (int k = 0; k < 2; ++k) dst[m][k] = *(const LAS bf16x8*)(lds + PG8_SA(b, h) + aoff + m * 2048 + k * 1024); } while (0)
#define PG8_LDB(dst, b, h) do { _Pragma("unroll") for (int n = 0; n < 2; ++n) _Pragma("unroll") for (int k = 0; k < 2; ++k) dst[n][k] = *(const LAS bf16x8*)(lds + PG8_SB(b, h) + boff + n * 2048 + k * 1024); } while (0)
#define PG8_MMA(ai, bj, At, Bt) do { __builtin_amdgcn_s_setprio(1); _Pragma("unroll") for (int m = 0; m < 4; ++m) _Pragma("unroll") for (int n = 0; n < 2; ++n) _Pragma("unroll") for (int k = 0; k < 2; ++k) \
        acc[ai][bj][m][n] = __builtin_amdgcn_mfma_f32_16x16x32_bf16(Bt[n][k], At[m][k], acc[ai][bj][m][n], 0, 0, 0); __builtin_amdgcn_s_setprio(0); } while (0)
#define PG8_WAIT_V(n) asm volatile("s_waitcnt vmcnt(" #n ")" ::: "memory")
#define PG8_WAIT_L(n) asm volatile("s_waitcnt lgkmcnt(" #n ")" ::: "memory")
#define PG8_BAR __builtin_amdgcn_s_barrier()
#define PG8_SCHED __builtin_amdgcn_sched_barrier(0)
    Unit cur, nxt; int ui = 0;
    if (!S.next(0, cur)) return;
    f32x4 acc[2][2][4][2];
#pragma unroll
    for (int a = 0; a < 2; ++a)
#pragma unroll
        for (int b = 0; b < 2; ++b)
#pragma unroll
            for (int m = 0; m < 4; ++m)
#pragma unroll
                for (int n = 0; n < 2; ++n) acc[a][b][m][n] = (f32x4){0.f, 0.f, 0.f, 0.f};
    bf16x8 At[4][2], B0[2][2], B1[2][2];
    const char* cA = S.pa(cur); const char* cB = S.pb(cur);
    PG8_STAGE(PG8_SB(0, 0), cB, voffB); PG8_STAGE(PG8_SB(0, 1), cB + hstep, voffB); PG8_STAGE(PG8_SA(0, 0), cA, voffA); PG8_STAGE(PG8_SA(0, 1), cA + hstep, voffA);
    if (wr == 1) PG8_BAR;
    PG8_WAIT_V(2); PG8_BAR;
    PG8_STAGE(PG8_SB(1, 0), cB + kstep, voffB); PG8_STAGE(PG8_SA(1, 0), cA + kstep, voffA); PG8_STAGE(PG8_SB(1, 1), cB + hstep + kstep, voffB);
    PG8_WAIT_V(6); PG8_BAR;
    for (;;) {
        const bool has_next = S.next(ui + 1, nxt);
        const char* nA = has_next ? S.pa(nxt) : cA; const char* nB = has_next ? S.pb(nxt) : cB;
        for (int t = 0; t < nt; t += 2) {
            const bool last = (t == nt - 2);
            const char* a1 = cA + (size_t)(t + 1) * kstep;
            const char* a2 = last ? nA : cA + (size_t)(t + 2) * kstep; const char* b2 = last ? nB : cB + (size_t)(t + 2) * kstep;
            const char* a3 = a2 + kstep; const char* b3 = b2 + kstep;
            PG8_LDB(B0, 0, 0); PG8_LDB(B1, 0, 1); PG8_SCHED; PG8_LDA(At, 0, 0); PG8_STAGE(PG8_SA(1, 1), a1 + hstep, voffA);
            PG8_WAIT_V(8); PG8_WAIT_L(0); PG8_BAR; PG8_MMA(0, 0, At, B0); PG8_MMA(0, 1, At, B1); PG8_BAR; PG8_SCHED;
            PG8_LDA(At, 0, 1); PG8_STAGE(PG8_SB(0, 0), b2, voffB); PG8_STAGE(PG8_SB(0, 1), b2 + hstep, voffB); PG8_STAGE(PG8_SA(0, 0), a2, voffA);
            PG8_WAIT_V(8); PG8_WAIT_L(0); PG8_BAR; PG8_MMA(1, 0, At, B0); PG8_MMA(1, 1, At, B1); PG8_BAR; PG8_SCHED;
            PG8_LDB(B0, 1, 0); PG8_LDB(B1, 1, 1); PG8_SCHED; PG8_LDA(At, 1, 0); PG8_STAGE(PG8_SA(0, 1), a2 + hstep, voffA);
            PG8_WAIT_V(8); PG8_WAIT_L(0); PG8_BAR; PG8_MMA(0, 0, At, B0); PG8_MMA(0, 1, At, B1); PG8_BAR; PG8_SCHED;
            PG8_LDA(At, 1, 1); PG8_STAGE(PG8_SB(1, 0), b3, voffB); PG8_STAGE(PG8_SB(1, 1), b3 + hstep, voffB); PG8_STAGE(PG8_SA(1, 0), a3, voffA);
            PG8_WAIT_V(8); PG8_WAIT_L(0); PG8_BAR; PG8_MMA(1, 0, At, B0); PG8_MMA(1, 1, At, B1); PG8_BAR; PG8_SCHED;
        }
        if (wr == 0) PG8_BAR;
        E(acc, cur, wr, wc, fr, fq);
        if (!has_next) break;
#pragma unroll
        for (int a = 0; a < 2; ++a)
#pragma unroll
            for (int b = 0; b < 2; ++b)
#pragma unroll
                for (int m = 0; m < 4; ++m)
#pragma unroll
                    for (int n = 0; n < 2; ++n) acc[a][b][m][n] = (f32x4){0.f, 0.f, 0.f, 0.f};
        cur = nxt; cA = nA; cB = nB; ++ui;
        if (wr == 1) PG8_BAR;
    }
    PG8_WAIT_V(0);
    PG8_BAR;
#undef PG8_SA
#undef PG8_SB
#undef PG8_STAGE
#undef PG8_LDA
#undef PG8_LDB
#undef PG8_MMA
#undef PG8_WAIT_V
#undef PG8_WAIT_L
#undef PG8_BAR
#undef PG8_SCHED
}
}
typedef GAS unsigned gu32;
#define RLX_AGENT __ATOMIC_RELAXED, __HIP_MEMORY_SCOPE_AGENT
#define XB_TMO      128
#define XB_XCNT(j)  (256  + 64 * (j))
#define XB_XSUB(j)  (1280 + 64 * (j))
#define XB_XGEN(j)  (2304 + 64 * (j))
#define XB_TOP      3328
#define XB_TOPGEN   3392
#define XCD_BAR_WORDS 3456
#define XB_SPIN_CAP (1u << 18)
__device__ __forceinline__ unsigned xb_ld(unsigned* p)              { return __hip_atomic_load(p, __ATOMIC_RELAXED, __HIP_MEMORY_SCOPE_AGENT); }
__device__ __forceinline__ unsigned xb_add(unsigned* p, unsigned v) { return __hip_atomic_fetch_add(p, v, __ATOMIC_RELAXED, __HIP_MEMORY_SCOPE_AGENT); }
__device__ __forceinline__ unsigned xb_xcc_id() { return (unsigned)__builtin_amdgcn_s_getreg((3 << 11) | 20) & 0xFu; }
#define XB_SPIN(cond, bar) do { unsigned _sp = 0; while (cond) { __builtin_amdgcn_s_sleep(1); \
    if ((++_sp & 255u) == 0u) { if (xb_ld(&(bar)[XB_TMO])) break; if (_sp > XB_SPIN_CAP) { atomicAdd(&(bar)[XB_TMO], 1u); break; } } } } while (0)
struct XcdBarrier { unsigned* bar; unsigned x; volatile LAS unsigned* st; };
__device__ __forceinline__ XcdBarrier xcd_barrier_post(unsigned* bar, volatile LAS unsigned* st) {
    XcdBarrier b; b.bar = bar; b.x = xb_xcc_id(); b.st = st;
    if (threadIdx.x == 0) (void)xb_add(&bar[XB_XCNT(b.x)], 1u);
    return b;
}
__device__ __forceinline__ void xcd_barrier_complete(unsigned* bar, unsigned x, unsigned& nloc, unsigned& nx) {
    const unsigned G = gridDim.x * gridDim.y * gridDim.z;
    unsigned sum, cnt, mine, sp = 0u;
    for (;;) {
        sum = 0u; cnt = 0u; mine = 0u;
#pragma unroll
        for (unsigned j = 0; j < 16; ++j) { const unsigned c = xb_ld(&bar[XB_XCNT(j)]); sum += c; cnt += (c > 0u) ? 1u : 0u; mine = (j == x) ? c : mine; }
        if (sum == G) break;
        __builtin_amdgcn_s_sleep(1);
        if ((++sp & 255u) == 0u) { if (xb_ld(&bar[XB_TMO])) break; if (sp > XB_SPIN_CAP) { atomicAdd(&bar[XB_TMO], 1u); break; } }
    }
    nloc = mine > 0u ? mine : 1u; nx = cnt > 0u ? cnt : 1u;
}
__device__ __forceinline__ void xcd_barrier(const XcdBarrier& b) {
    asm volatile("s_waitcnt vmcnt(0)" ::: "memory");
    __syncthreads();
    if (threadIdx.x == 0) {
        unsigned* bar = b.bar;
        __builtin_amdgcn_s_waitcnt(0);
        unsigned nloc = b.st[0], nx = b.st[1];
        if (nloc == 0u) { xcd_barrier_complete(bar, b.x, nloc, nx); b.st[0] = nloc; b.st[1] = nx; }
        const unsigned old = xb_add(&bar[XB_XSUB(b.x)], 1u);
        const unsigned gen = old / nloc;
        if (old + 1u == (gen + 1u) * nloc) {
            __builtin_amdgcn_fence(__ATOMIC_RELEASE, "agent");
            asm volatile("s_waitcnt vmcnt(0)" ::: "memory");
            const unsigned og = xb_add(&bar[XB_TOP], 1u);
            const unsigned tg = og / nx;
            if (og + 1u == (tg + 1u) * nx) xb_add(&bar[XB_TOPGEN], 1u);
            else XB_SPIN(xb_ld(&bar[XB_TOPGEN]) == tg, bar);
            __builtin_amdgcn_fence(__ATOMIC_ACQUIRE, "agent");
            xb_add(&bar[XB_XGEN(b.x)], 1u);
            asm volatile("s_waitcnt vmcnt(0)" ::: "memory");
        } else {
            XB_SPIN(xb_ld(&bar[XB_XGEN(b.x)]) == gen, bar);
            __builtin_amdgcn_fence(__ATOMIC_ACQUIRE, "agent");
            asm volatile("s_waitcnt vmcnt(0)" ::: "memory");
        }
    }
    __syncthreads();
}
struct Frame {
    LAS unsigned char* lds;
    volatile LAS unsigned* MISC;
    unsigned char* ws;
    int tid, lane, wave;
    int vcu, G;
    const float* in[19];
    float* out;
};
#define WSP(T, off) ((T*)(F.ws + (off)))

__device__ __forceinline__ void p0_transpose_item(const float* W, int K, int N, int k0, int n0, bf16_t* WT, int drow, bool rope, const float* gain, LAS float* scr, int lane) {
#pragma unroll 8
    for (int i = 0; i < 32; ++i) { const int kk = 2 * i + (lane >> 5); float w = W[(size_t)(k0 + kk) * N + n0 + (lane & 31)]; if (gain) w *= gain[k0 + kk]; scr[kk * 33 + (lane & 31)] = w; }
    LDS_WAIT(); asm volatile("" ::: "memory");
    const int c = lane & 7;
#pragma unroll
    for (int j = 0; j < 4; ++j) { const int n = (lane >> 3) + 8 * j; const LAS float* s = scr + (8 * c) * 33 + n;
        u32x4 o; o.x = cvt_pk_bf16(s[0 * 33], s[1 * 33]); o.y = cvt_pk_bf16(s[2 * 33], s[3 * 33]); o.z = cvt_pk_bf16(s[4 * 33], s[5 * 33]); o.w = cvt_pk_bf16(s[6 * 33], s[7 * 33]);
        const int dr = drow + (rope ? (8 * (n >> 2) + (n & 3)) : n);
        *(GAS u32x4*)(WT + (size_t)dr * K + k0 + 8 * c) = o; }
    LDS_WAIT(); asm volatile("" ::: "memory");
}
__device__ __forceinline__ void rms_row_to_bf16(const float* xrow, const float* g, bf16_t* orow, int lane) {
    const GAS f32x4* xr = (const GAS f32x4*)xrow + lane; const GAS f32x4* gr = (const GAS f32x4*)g + lane;
    f32x4 v[8]; float s = 0.f;
#pragma unroll
    for (int j = 0; j < 8; ++j) { v[j] = xr[64 * j]; s += (v[j].x * v[j].x + v[j].y * v[j].y) + (v[j].z * v[j].z + v[j].w * v[j].w); }
    const float rstd = 1.0f / sqrtf(wave_sum(s) * (1.f / DM) + NORM_EPS);
    GAS u32x2* o8 = (GAS u32x2*)orow + lane;
#pragma unroll
    for (int j = 0; j < 8; ++j) { const f32x4 gg = gr[64 * j]; o8[64 * j] = pack4((v[j] * rstd) * gg); }
}
__device__ __forceinline__ void p0_prologue(Frame& F) {
    LAS float* scr = (LAS float*)(F.lds + F.wave * 16384);
    const int gw = F.vcu * NWAVES + F.wave, NGW = F.G * NWAVES, lane = F.lane;
    bf16_t* WIN = WSP(bf16_t, WS_WIN); bf16_t* WVT = WSP(bf16_t, WS_WVT);
    constexpr int I_IN = 32 * 258, I_UQ = 8 * 96, I_UKV = 8 * 128, I_NA = 16 * 64, I_MLA = 32 * 64, I_OUT = 32 * 64;
    constexpr int NITEMS = I_IN + I_UQ + I_UKV + I_NA + I_MLA + I_OUT;
    for (int it = gw; it < NITEMS; it += NGW) {
        int r = it;
        if (r < I_IN) { const int kb = r / 258, sb = r % 258, n0 = 32 * sb, k0 = 64 * kb; const float* W = F.in[3];
            bf16_t* dst = WIN; int drow; bool rope = false;
            if (n0 < 1024) drow = C_NAQ + n0;
            else if (n0 < 2048) drow = C_NAK + (n0 - 1024);
            else if (n0 < 3072) { dst = WVT; drow = n0 - 2048; }
            else if (n0 < 3584) drow = C_CQ + (n0 - 3072);
            else if (n0 < 4096) drow = C_CKV + (n0 - 3584);
            else if (n0 < 4160) { drow = C_KR + ((n0 - 4096) ? 4 : 0); rope = true; }
            else if (n0 < 6208) drow = C_GA + (n0 - 4160);
            else drow = C_GB + (n0 - 6208);
            p0_transpose_item(W, 2048, 8256, k0, n0, dst, drow, rope, nullptr, scr, lane); continue; } r -= I_IN;
        if (r < I_UQ) { const int kb = r / 96, sb = r % 96, n0 = 32 * sb, k0 = 64 * kb; const int hd = n0 / 192, w = n0 % 192;
            int drow = n0; bool rope = false; if (w >= 128) { rope = true; drow = hd * 192 + 128 + ((w - 128) ? 4 : 0); }
            p0_transpose_item(F.in[7], 512, 3072, k0, n0, WSP(bf16_t, WS_WUQ), drow, rope, F.in[6], scr, lane); continue; } r -= I_UQ;
        if (r < I_UKV) { const int kb = r / 128, sb = r % 128; p0_transpose_item(F.in[9], 512, 4096, 64 * kb, 32 * sb, WSP(bf16_t, WS_WUKV), 32 * sb, false, F.in[8], scr, lane); continue; } r -= I_UKV;
        if (r < I_NA) { const int kb = r / 64, sb = r % 64; p0_transpose_item(F.in[10], 1024, 2048, 64 * kb, 32 * sb, WSP(bf16_t, WS_WNA), 32 * sb, false, nullptr, scr, lane); continue; } r -= I_NA;
        if (r < I_MLA) { const int kb = r / 64, sb = r % 64; p0_transpose_item(F.in[11], 2048, 2048, 64 * kb, 32 * sb, WSP(bf16_t, WS_WMLA), 32 * sb, false, nullptr, scr, lane); continue; } r -= I_MLA;
        { const int kb = r / 64, sb = r % 64; p0_transpose_item(F.in[12], 2048, 2048, 64 * kb, 32 * sb, WSP(bf16_t, WS_WOUT), 32 * sb, false, nullptr, scr, lane); }
    }
    { GAS u32x4* z = (GAS u32x4*)(WIN + (size_t)(C_KR + 64) * 2048); const int n16 = (NMAIN - C_KR - 64) * 2048 * 2 / 16;
      for (int i = F.vcu * 512 + F.tid; i < n16; i += F.G * 512) z[i] = (u32x4){0u, 0u, 0u, 0u}; }
    { bf16_t* HN1 = WSP(bf16_t, WS_HN1);
      for (int m = gw; m < MREAL + NMETA; m += NGW) {
          const float* src = (m < MREAL) ? F.in[0] + (size_t)m * DM : F.in[1] + (size_t)(m - MREAL) * DM;
          rms_row_to_bf16(src, F.in[2], HN1 + (size_t)m * DM, lane); }
      GAS u32x4* z = (GAS u32x4*)(HN1 + (size_t)(MREAL + NMETA) * DM); const int n16 = (MPAD - MREAL - NMETA) * DM * 2 / 16;
      for (int i = F.vcu * 512 + F.tid; i < n16; i += F.G * 512) z[i] = (u32x4){0u, 0u, 0u, 0u}; }
    { float* ct = WSP(float, WS_COS); float* st = WSP(float, WS_SIN);
      for (int i = F.vcu * 512 + F.tid; i < NPOS * 32; i += F.G * 512) { const int p = i >> 5, j = i & 31;
          const float inv = __builtin_powf(10000.0f, -(float)(2 * j) / 64.0f); const float ang = (float)p * inv;
          double r = (double)ang * 0.15915494309189535; r -= __builtin_rint(r); const float rf = (float)r;
          ct[i] = __builtin_amdgcn_cosf(rf); st[i] = __builtin_amdgcn_sinf(rf); } }
    { const float* SK = F.in[15]; const float* WQ = F.in[14]; const float* g2 = F.in[13]; bf16_t* WSCp = WSP(bf16_t, WS_WSC);
      const int l15 = lane & 15, l4 = lane >> 4;
      for (int task = gw; task < 2048; task += NGW) { const int g = task >> 7, nt = (task >> 4) & 7, kc = task & 15, n0 = nt * 16;
          bf16x8 bfr[4];
#pragma unroll
          for (int kk = 0; kk < 4; ++kk) { const float* p = SK + ((size_t)g * 128 + n0 + l15) * 128 + 32 * kk + 8 * l4; const f32x4 a = *(const GAS f32x4*)p, b = *(const GAS f32x4*)(p + 4);
              const u32x4 w = pack8(a, b); bfr[kk] = __builtin_bit_cast(bf16x8, w); }
          for (int kt = 0; kt < 8; ++kt) { const int k0 = (kc * 8 + kt) * 16; f32x4 acc = (f32x4){0.f, 0.f, 0.f, 0.f};
#pragma unroll
              for (int kk = 0; kk < 4; ++kk) { const float* p = WQ + (size_t)(k0 + l15) * 2048 + g * 128 + 32 * kk + 8 * l4; const f32x4 a = *(const GAS f32x4*)p, b = *(const GAS f32x4*)(p + 4);
                  const u32x4 w = pack8(a, b); acc = __builtin_amdgcn_mfma_f32_16x16x32_bf16(__builtin_bit_cast(bf16x8, w), bfr[kk], acc, 0, 0, 0); }
              const f32x4 gg = *(const GAS f32x4*)(g2 + k0 + 4 * l4);
              *(GAS u32x2*)(WSCp + (size_t)(g * 128 + n0 + l15) * 2048 + k0 + 4 * l4) = pack4(acc * gg); } } }
}
using pg8::Unit;
struct SchedGrid {
    int G, c, nM, nN; const char* A; const char* B; size_t tstep;
    __device__ __forceinline__ bool next(int i, Unit& u) const { const int L = i * G + c; if (L >= nM * nN) return false; pg8::grid_order(L, nM, nN, u.pm, u.pn); u.kind = 0; return true; }
    __device__ __forceinline__ const char* pa(const Unit& u) const { return A + (size_t)u.pm * tstep; }
    __device__ __forceinline__ const char* pb(const Unit& u) const { return B + (size_t)u.pn * tstep; }
};
constexpr int P1_MAIN = 64 * 29, P1_VT = 4 * 65, P1_META = 7, P1_UNITS = P1_MAIN + P1_VT + P1_META;
struct SchedP1 {
    int G, c; const char* hn1; const char* win; const char* wvt; size_t tstep;
    __device__ __forceinline__ bool next(int i, Unit& u) const {
        const int L = i * G + c; if (L >= P1_UNITS) return false;
        if (L < P1_MAIN) { pg8::grid_order(L, 64, 29, u.pm, u.pn); u.kind = 0; }
        else if (L < P1_MAIN + P1_VT) { const int idx = L - P1_MAIN; u.pm = idx & 3; u.pn = idx >> 2; u.kind = 1; }
        else { const int idx = L - P1_MAIN - P1_VT; u.pm = 64; u.pn = idx < 4 ? 4 + idx : (idx < 6 ? 10 + (idx - 4) : 28); u.kind = 0; }
        return true; }
    __device__ __forceinline__ const char* pa(const Unit& u) const { return (u.kind == 1 ? wvt : hn1) + (size_t)u.pm * tstep; }
    __device__ __forceinline__ const char* pb(const Unit& u) const { return (u.kind == 1 ? hn1 : win) + (size_t)u.pn * tstep; }
};
__device__ __forceinline__ void rope4(const f32x4 x1, const f32x4 x2, const float* cosT, const float* sinT, int pos, int j0, f32x4& lo, f32x4& hi) {
    const f32x4 c = *(const GAS f32x4*)(cosT + pos * 32 + j0), s = *(const GAS f32x4*)(sinT + pos * 32 + j0);
    lo = x1 * c - x2 * s; hi = x2 * c + x1 * s;
}
struct EpiP1 {
    static constexpr bool PERM = true;
    bf16_t *naq, *nak, *vt, *cq, *ckv, *kr, *ga, *gb; float *ssq_q, *ssq_kv; const float *cosT, *sinT;
    __device__ __forceinline__ void operator()(const f32x4 (&acc)[2][2][4][2], const Unit& u, int wr, int wc, int fr, int fq) const {
        const int row0 = u.pm * 256 + wr * 64 + fr, colu = wc * 32 + 8 * fq;
        if (u.kind == 1) {
#pragma unroll
            for (int ai = 0; ai < 2; ++ai)
#pragma unroll
                for (int m = 0; m < 4; ++m) { bf16_t* rp = vt + (size_t)(row0 + ai * 128 + m * 16) * VT_PITCH + u.pn * 256 + colu;
#pragma unroll
                    for (int bj = 0; bj < 2; ++bj) *(GAS u32x4*)(rp + bj * 128) = pack8(acc[ai][bj][m][0], acc[ai][bj][m][1]); }
            return; }
        const int pn = u.pn;
        if (pn == 28) {
            if (wc < 2) { const int j0 = 4 * (4 * wc + fq);
#pragma unroll
                for (int ai = 0; ai < 2; ++ai)
#pragma unroll
                    for (int m = 0; m < 4; ++m) { const int row = row0 + ai * 128 + m * 16; const int pos = row < MREAL ? NMETA + (row & (SEQ - 1)) : row - MREAL;
                        f32x4 lo, hi; rope4(acc[ai][0][m][0], acc[ai][0][m][1], cosT, sinT, pos, j0, lo, hi);
                        *(GAS u32x2*)(kr + (size_t)row * 64 + j0) = pack4(lo); *(GAS u32x2*)(kr + (size_t)row * 64 + 32 + j0) = pack4(hi); } }
            return; }
        if (pn >= 12) {
            bf16_t* base = pn < 20 ? ga : gb; const int colt = (pn < 20 ? pn - 12 : pn - 20) * 256 + colu;
#pragma unroll
            for (int ai = 0; ai < 2; ++ai)
#pragma unroll
                for (int m = 0; m < 4; ++m) { bf16_t* rp = base + (size_t)(row0 + ai * 128 + m * 16) * 2048 + colt;
#pragma unroll
                    for (int bj = 0; bj < 2; ++bj) { f32x4 a = acc[ai][bj][m][0], b = acc[ai][bj][m][1];
#pragma unroll
                        for (int i = 0; i < 4; ++i) { a[i] = sigmoidf_(a[i]); b[i] = sigmoidf_(b[i]); }
                        *(GAS u32x4*)(rp + bj * 128) = pack8(a, b); } }
            return; }
        if (pn >= 8) {
            const bool isq = pn < 10; bf16_t* base = isq ? cq : ckv; float* ssq = isq ? ssq_q : ssq_kv; const int colt = (isq ? pn - 8 : pn - 10) * 256 + colu;
#pragma unroll
            for (int ai = 0; ai < 2; ++ai)
#pragma unroll
                for (int m = 0; m < 4; ++m) { const int row = row0 + ai * 128 + m * 16; bf16_t* rp = base + (size_t)row * 512 + colt; float s = 0.f;
#pragma unroll
                    for (int bj = 0; bj < 2; ++bj) { const f32x4 a = acc[ai][bj][m][0], b = acc[ai][bj][m][1];
                        s += (a[0] * a[0] + a[1] * a[1]) + (a[2] * a[2] + a[3] * a[3]) + (b[0] * b[0] + b[1] * b[1]) + (b[2] * b[2] + b[3] * b[3]);
                        *(GAS u32x4*)(rp + bj * 128) = pack8(a, b); }
                    s += __shfl_xor(s, 16); s += __shfl_xor(s, 32);
                    if (fq == 0) ssq[(size_t)((pn & 1) * 4 + wc) * MPAD + row] = s; }
            return; }
        {
            bf16_t* base = pn < 4 ? naq : nak; const int colt = (pn & 3) * 256 + colu;
#pragma unroll
            for (int ai = 0; ai < 2; ++ai)
#pragma unroll
                for (int m = 0; m < 4; ++m) { bf16_t* rp = base + (size_t)(row0 + ai * 128 + m * 16) * 1024 + colt;
#pragma unroll
                    for (int bj = 0; bj < 2; ++bj) *(GAS u32x4*)(rp + bj * 128) = pack8(acc[ai][bj][m][0], acc[ai][bj][m][1]); }
        }
    }
};
constexpr int P3_Q = 64 * 12, P3_KV = 65 * 16, P3_UNITS = P3_Q + P3_KV;
struct SchedP3 {
    int G, c; const char* cq; const char* ckv; const char* wuq; const char* wukv; size_t tstep;
    __device__ __forceinline__ bool next(int i, Unit& u) const {
        const int L = i * G + c; if (L >= P3_UNITS) return false;
        if (L < P3_Q) { pg8::grid_order(L, 64, 12, u.pm, u.pn); u.kind = 0; } else { pg8::grid_order(L - P3_Q, 65, 16, u.pm, u.pn); u.kind = 1; }
        return true; }
    __device__ __forceinline__ const char* pa(const Unit& u) const { return (u.kind ? ckv : cq) + (size_t)u.pm * tstep; }
    __device__ __forceinline__ const char* pb(const Unit& u) const { return (u.kind ? wukv : wuq) + (size_t)u.pn * tstep; }
};
template <int NS, int LD> __device__ __forceinline__ float rstd_slabs(const float* part, int row, float invn) {
    float s = 0.f;
#pragma unroll
    for (int i = 0; i < NS; ++i) s += part[(size_t)i * LD + row];
    return 1.0f / sqrtf(s * invn + NORM_EPS);
}
struct EpiP3 {
    static constexpr bool PERM = true;
    bf16_t *qm, *kn, *vv; const float *ssq_q, *ssq_kv; const float *cosT, *sinT;
    __device__ __forceinline__ void operator()(const f32x4 (&acc)[2][2][4][2], const Unit& u, int wr, int wc, int fr, int fq) const {
        const int row0 = u.pm * 256 + wr * 64 + fr, colu = wc * 32 + 8 * fq;
        if (u.kind == 1) {
#pragma unroll
            for (int ai = 0; ai < 2; ++ai)
#pragma unroll
                for (int m = 0; m < 4; ++m) { const int row = row0 + ai * 128 + m * 16; const float rs = rstd_slabs<8, MPAD>(ssq_kv, row, 1.f / 512.f);
                    const size_t off = (size_t)row * 2048 + u.pn * 128 + colu;
                    *(GAS u32x4*)(kn + off) = pack8(acc[ai][0][m][0] * rs, acc[ai][0][m][1] * rs);
                    *(GAS u32x4*)(vv + off) = pack8(acc[ai][1][m][0] * rs, acc[ai][1][m][1] * rs); }
            return; }
#pragma unroll
        for (int bj = 0; bj < 2; ++bj) { const int c8 = u.pn * 256 + bj * 128 + colu; const int hd = c8 / 192, w = c8 - hd * 192;
            if (w < 128) {
#pragma unroll
                for (int ai = 0; ai < 2; ++ai)
#pragma unroll
                    for (int m = 0; m < 4; ++m) { const int row = row0 + ai * 128 + m * 16; const float rs = rstd_slabs<8, MPAD>(ssq_q, row, 1.f / 512.f);
                        *(GAS u32x4*)(qm + (size_t)row * 3072 + c8) = pack8(acc[ai][bj][m][0] * rs, acc[ai][bj][m][1] * rs); }
            } else { const int j0 = (w - 128) >> 1;
#pragma unroll
                for (int ai = 0; ai < 2; ++ai)
#pragma unroll
                    for (int m = 0; m < 4; ++m) { const int row = row0 + ai * 128 + m * 16; const float rs = rstd_slabs<8, MPAD>(ssq_q, row, 1.f / 512.f);
                        const int pos = NMETA + (row & (SEQ - 1)); f32x4 lo, hi; rope4(acc[ai][bj][m][0] * rs, acc[ai][bj][m][1] * rs, cosT, sinT, pos, j0, lo, hi);
                        bf16_t* qp = qm + (size_t)row * 3072 + hd * 192 + 128 + j0; *(GAS u32x2*)qp = pack4(lo); *(GAS u32x2*)(qp + 32) = pack4(hi); }
            } }
    }
};
__device__ __forceinline__ void unpack8(const u32x4 w, f32x4& a, f32x4& b) { a = (f32x4){bf_lo(w.x), bf_hi(w.x), bf_lo(w.y), bf_hi(w.y)}; b = (f32x4){bf_lo(w.z), bf_hi(w.z), bf_lo(w.w), bf_hi(w.w)}; }
struct EpiP5a {
    static constexpr bool PERM = true;
    const bf16_t* ga; float* t1;
    __device__ __forceinline__ void operator()(const f32x4 (&acc)[2][2][4][2], const Unit& u, int wr, int wc, int fr, int fq) const {
        const int row0 = u.pm * 256 + wr * 64 + fr, col0 = u.pn * 256 + wc * 32 + 8 * fq;
#pragma unroll
        for (int ai = 0; ai < 2; ++ai)
#pragma unroll
            for (int m = 0; m < 4; ++m) { const size_t off = (size_t)(row0 + ai * 128 + m * 16) * 2048 + col0;
#pragma unroll
                for (int bj = 0; bj < 2; ++bj) { f32x4 g0, g1; unpack8(*(const GAS u32x4*)(ga + off + bj * 128), g0, g1);
                    *(GAS f32x4*)(t1 + off + bj * 128) = acc[ai][bj][m][0] * g0; *(GAS f32x4*)(t1 + off + bj * 128 + 4) = acc[ai][bj][m][1] * g1; } }
    }
};
struct EpiP5b {
    static constexpr bool PERM = true;
    const bf16_t* gb; const float* t1; bf16_t* merged;
    __device__ __forceinline__ void operator()(const f32x4 (&acc)[2][2][4][2], const Unit& u, int wr, int wc, int fr, int fq) const {
        const int row0 = u.pm * 256 + wr * 64 + fr, col0 = u.pn * 256 + wc * 32 + 8 * fq;
#pragma unroll
        for (int ai = 0; ai < 2; ++ai)
#pragma unroll
            for (int m = 0; m < 4; ++m) { const size_t off = (size_t)(row0 + ai * 128 + m * 16) * 2048 + col0;
#pragma unroll
                for (int bj = 0; bj < 2; ++bj) { f32x4 g0, g1; unpack8(*(const GAS u32x4*)(gb + off + bj * 128), g0, g1);
                    const f32x4 a = *(const GAS f32x4*)(t1 + off + bj * 128), b = *(const GAS f32x4*)(t1 + off + bj * 128 + 4);
                    *(GAS u32x4*)(merged + off + bj * 128) = pack8(a + acc[ai][bj][m][0] * g0, b + acc[ai][bj][m][1] * g1); } }
    }
};
struct EpiP6 {
    static constexpr bool PERM = true;
    const float* x; float* h2; bf16_t* h2b; float* ssq2;
    __device__ __forceinline__ void operator()(const f32x4 (&acc)[2][2][4][2], const Unit& u, int wr, int wc, int fr, int fq) const {
        const int row0 = u.pm * 256 + wr * 64 + fr, col0 = u.pn * 256 + wc * 32 + 8 * fq;
#pragma unroll
        for (int ai = 0; ai < 2; ++ai)
#pragma unroll
            for (int m = 0; m < 4; ++m) { const int row = row0 + ai * 128 + m * 16; const size_t off = (size_t)row * 2048 + col0; float s = 0.f;
#pragma unroll
                for (int bj = 0; bj < 2; ++bj) { const f32x4 a = *(const GAS f32x4*)(x + off + bj * 128) + acc[ai][bj][m][0], b = *(const GAS f32x4*)(x + off + bj * 128 + 4) + acc[ai][bj][m][1];
                    s += (a[0] * a[0] + a[1] * a[1]) + (a[2] * a[2] + a[3] * a[3]) + (b[0] * b[0] + b[1] * b[1]) + (b[2] * b[2] + b[3] * b[3]);
                    *(GAS f32x4*)(h2 + off + bj * 128) = a; *(GAS f32x4*)(h2 + off + bj * 128 + 4) = b; *(GAS u32x4*)(h2b + off + bj * 128) = pack8(a, b); }
                s += __shfl_xor(s, 16); s += __shfl_xor(s, 32);
                if (fq == 0) ssq2[(size_t)(u.pn * 4 + wc) * MREAL + row] = s; }
    }
};
struct EpiP7 {
    static constexpr bool PERM = false;
    const float* ssq2; float* sc;
    __device__ __forceinline__ void operator()(const f32x4 (&acc)[2][2][4][2], const Unit& u, int wr, int wc, int fr, int fq) const {
        const int row0 = u.pm * 256 + wr * 64 + fr, col0 = u.pn * 256 + wc * 32 + 4 * fq;
#pragma unroll
        for (int ai = 0; ai < 2; ++ai)
#pragma unroll
            for (int m = 0; m < 4; ++m) { const int row = row0 + ai * 128 + m * 16; const float rs = rstd_slabs<32, MREAL>(ssq2, row, 1.f / 2048.f); const size_t off = (size_t)row * 2048 + col0;
#pragma unroll
                for (int bj = 0; bj < 2; ++bj)
#pragma unroll
                    for (int n = 0; n < 2; ++n) *(GAS f32x4*)(sc + off + bj * 128 + n * 16) = acc[ai][bj][m][n] * rs; }
    }
};
namespace att {
#define KSWZ(row, colB) ((row) * 256 + ((colB) ^ (((row) & 7) << 4)))
#define KRSWZ(row, colB) ((row) * 128 + ((colB) ^ ((((row) >> 1) & 7) << 4)))
constexpr float L2E = 1.4426950408889634f;
template <int DUMMY = 0>
__device__ __forceinline__ void partialSM(f32x16& p0, f32x16& p1, float& m_reg, float& mn, float& alpha, const float C, const float THRS) {
  float pmax = p0[0];
#pragma unroll
  for (int r = 1; r < 16; ++r) pmax = fmaxf(pmax, p0[r]);
#pragma unroll
  for (int r = 0; r < 16; ++r) pmax = fmaxf(pmax, p1[r]);
  { auto rr = __builtin_amdgcn_permlane32_swap(__float_as_uint(pmax), __float_as_uint(pmax), false, false);
    pmax = fmaxf(__uint_as_float(rr[0]), __uint_as_float(rr[1])); }
  if (__builtin_expect(__all(pmax - m_reg <= THRS), 1)) { mn = m_reg; alpha = 1.f; }
  else { mn = fmaxf(m_reg, pmax); alpha = __builtin_amdgcn_exp2f((m_reg - mn) * C); m_reg = mn; }
  const float mnC = -mn * C;
#pragma unroll
  for (int r = 0; r < 16; ++r) p0[r] = fmaf(p0[r], C, mnC);
#pragma unroll
  for (int r = 0; r < 16; ++r) p1[r] = fmaf(p1[r], C, mnC);
#pragma unroll
  for (int r = 0; r < 16; ++r) p0[r] = __builtin_amdgcn_exp2f(p0[r]);
}
__device__ __forceinline__ void finishSM(f32x16& p0, f32x16& p1, float alpha, float& l_reg, bf16x8& pa0, bf16x8& pa1, bf16x8& pa2, bf16x8& pa3) {
#pragma unroll
  for (int r = 0; r < 16; ++r) p1[r] = __builtin_amdgcn_exp2f(p1[r]);
  float ps = 0;
#pragma unroll
  for (int r = 0; r < 16; ++r) ps += p0[r];
#pragma unroll
  for (int r = 0; r < 16; ++r) ps += p1[r];
  { auto rr = __builtin_amdgcn_permlane32_swap(__float_as_uint(ps), __float_as_uint(ps), false, false);
    ps = __uint_as_float(rr[0]) + __uint_as_float(rr[1]); }
  l_reg = l_reg * alpha + ps;
#define PK4(P, BASE, OUT) do { unsigned a0 = cvt_pk_bf16(P[BASE + 0], P[BASE + 1]), a1 = cvt_pk_bf16(P[BASE + 2], P[BASE + 3]);   \
    unsigned b0 = cvt_pk_bf16(P[BASE + 4], P[BASE + 5]), b1 = cvt_pk_bf16(P[BASE + 6], P[BASE + 7]);                              \
    auto r0 = __builtin_amdgcn_permlane32_swap(a0, b0, false, false); auto r1 = __builtin_amdgcn_permlane32_swap(a1, b1, false, false); \
    u32x4 w = {r0[0], r1[0], r0[1], r1[1]}; OUT = __builtin_bit_cast(bf16x8, w); } while (0)
  PK4(p0, 0, pa0); PK4(p0, 8, pa1); PK4(p1, 0, pa2); PK4(p1, 8, pa3);
#undef PK4
}
constexpr int NW = 8, QBLK = 32, KVBLK = 64;
constexpr float MLA_SCALE = 0.07216878364870322f;
constexpr float MLA_THR = 8.f;
constexpr int SHM_V = KVBLK * 128 * 2, SHM_KN = KVBLK * 128 * 2, SHM_KR = KVBLK * 64 * 2;
constexpr int OFF_V = 0, OFF_KN = 2 * SHM_V, OFF_KR = OFF_KN + 2 * SHM_KN, OFF_WS = OFF_KR + 2 * SHM_KR, OFF_QR = OFF_WS + NW * 64 * 4, MLA_LDS = OFF_QR + NW * 4096;
__device__ __forceinline__ void qkt(f32x16& p0, f32x16& p1, const LAS char* Kn, const LAS char* Kr, const bf16x8* qr, const LAS char* qrp, const int* kb, const int* krb) {
  p0 = f32x16{}; p1 = f32x16{};
#pragma unroll
  for (int d0 = 0; d0 < 8; ++d0) {
    const bf16x8 b0 = *(const LAS bf16x8*)(Kn + kb[d0 & 3] + (d0 >> 2) * 128);
    const bf16x8 b1 = *(const LAS bf16x8*)(Kn + kb[d0 & 3] + (d0 >> 2) * 128 + 8192);
    p0 = __builtin_amdgcn_mfma_f32_32x32x16_bf16(b0, qr[d0], p0, 0, 0, 0);
    p1 = __builtin_amdgcn_mfma_f32_32x32x16_bf16(b1, qr[d0], p1, 0, 0, 0); }
#pragma unroll
  for (int d0 = 0; d0 < 4; ++d0) {
    const bf16x8 b0 = *(const LAS bf16x8*)(Kr + krb[d0]);
    const bf16x8 b1 = *(const LAS bf16x8*)(Kr + krb[d0] + 4096);
    const bf16x8 qf = *(const LAS bf16x8*)(qrp + d0 * 1024);
    p0 = __builtin_amdgcn_mfma_f32_32x32x16_bf16(b0, qf, p0, 0, 0, 0);
    p1 = __builtin_amdgcn_mfma_f32_32x32x16_bf16(b1, qf, p1, 0, 0, 0); }
}
__device__ __forceinline__ int v_st(int k, int c) { const int kk = (k & ~0xC) | ((k & 4) << 1) | ((k & 8) >> 1); return ((kk >> 3) * 4 + (c >> 5)) * 512 + ((kk & 7) * 32 + (c & 31)) * 2; }
__device__ __forceinline__ int v_rd_base(int lane) { return ((lane & 3) << 3) | (((lane >> 2) & 3) << 6) | (((lane >> 4) & 1) << 5) | (((lane >> 5) & 1) << 8); }
constexpr int v_rd_off(int d0, int ks, int half) { return d0 * 512 + ks * 4096 + half * 2048; }
template <int OFF> __device__ __forceinline__ s16x4 tr_read(int vb) {
  s16x4 r; asm volatile("ds_read_b64_tr_b16 %0, %1 offset:%2" : "=&v"(r) : "v"(vb), "i"(OFF) : "memory"); return r;
}
template <int D0> __device__ __forceinline__ void pv_one(f32x16& od, int vb, bf16x8 pa0, bf16x8 pa1, bf16x8 pa2, bf16x8 pa3) {
  const s16x4 l0 = tr_read<v_rd_off(D0, 0, 0)>(vb), h0 = tr_read<v_rd_off(D0, 0, 1)>(vb), l1 = tr_read<v_rd_off(D0, 1, 0)>(vb), h1 = tr_read<v_rd_off(D0, 1, 1)>(vb);
  const s16x4 l2 = tr_read<v_rd_off(D0, 2, 0)>(vb), h2 = tr_read<v_rd_off(D0, 2, 1)>(vb), l3 = tr_read<v_rd_off(D0, 3, 0)>(vb), h3 = tr_read<v_rd_off(D0, 3, 1)>(vb);
  asm volatile("s_waitcnt lgkmcnt(0)" ::: "memory"); SBAR();
#define PK(L, H) (bf16x8){L[0], L[1], L[2], L[3], H[0], H[1], H[2], H[3]}
  od = __builtin_amdgcn_mfma_f32_32x32x16_bf16(pa0, PK(l0, h0), od, 0, 0, 0);
  od = __builtin_amdgcn_mfma_f32_32x32x16_bf16(pa1, PK(l1, h1), od, 0, 0, 0);
  od = __builtin_amdgcn_mfma_f32_32x32x16_bf16(pa2, PK(l2, h2), od, 0, 0, 0);
  od = __builtin_amdgcn_mfma_f32_32x32x16_bf16(pa3, PK(l3, h3), od, 0, 0, 0);
#undef PK
}
__device__ __forceinline__ void pv_d0(f32x16* o, int vb, bf16x8 pa0, bf16x8 pa1, bf16x8 pa2, bf16x8 pa3) {
  pv_one<0>(o[0], vb, pa0, pa1, pa2, pa3); pv_one<1>(o[1], vb, pa0, pa1, pa2, pa3); pv_one<2>(o[2], vb, pa0, pa1, pa2, pa3); pv_one<3>(o[3], vb, pa0, pa1, pa2, pa3);
}
__device__ __forceinline__ void mla_unit(int b, int h, int qb, const bf16_t* __restrict__ QM, const bf16_t* __restrict__ KN, const bf16_t* __restrict__ KR, const bf16_t* __restrict__ VV, bf16_t* __restrict__ OM, LAS char* lds) {
  const int tid = threadIdx.x, wid = tid >> 6, lane = tid & 63, r32 = lane & 31, hi = lane >> 5;
  constexpr float C = MLA_SCALE * L2E, THRS = MLA_THR / MLA_SCALE;
  constexpr int NT = 33;
  LAS char* V_lds = lds + OFF_V; LAS char* Kn_lds = lds + OFF_KN; LAS char* Kr_lds = lds + OFF_KR;
  LAS float* ws = (LAS float*)(lds + OFF_WS) + wid * 64; LAS float* li_l = ws; LAS float* al_l = ws + 32;
  float m_reg = -1e30f, l_reg = 0; f32x16 o[4] = {}; bf16x8 qr[8];
  LAS char* qrp = lds + OFF_QR + wid * 4096 + lane * 16;
  const int qrow = b * SEQ + qb * 256 + wid * QBLK + r32;
  const bf16_t* Qw = QM + (size_t)qrow * 3072 + h * 192 + hi * 8;
#pragma unroll
  for (int d0 = 0; d0 < 8; ++d0) qr[d0] = *(const GAS bf16x8*)(Qw + d0 * 16);
  __syncthreads();
#pragma unroll
  for (int d0 = 0; d0 < 4; ++d0) *(LAS bf16x8*)(qrp + d0 * 1024) = *(const GAS bf16x8*)(Qw + (8 + d0) * 16);
  const int sr = tid >> 4, sc = (tid & 15) * 8, vst0 = v_st(sr, sc), vst1 = v_st(32 + sr, sc);
  const int krr = tid >> 3, krc = (tid & 7) * 8;
  const int vb0 = (int)(uintptr_t)V_lds + v_rd_base(lane);
  bf16x8 s_v0, s_v1, s_k0, s_k1, s_kr;
  const int realbase = b * SEQ - KVBLK;
  const unsigned voff = (unsigned)(sr * 2048 + sc) * 2u, kroff = (unsigned)(krr * 64 + krc) * 2u;
  int kb[4], krb[4];
#pragma unroll
  for (int bq = 0; bq < 4; ++bq) { kb[bq] = KSWZ(r32, bq * 32 + hi * 16); krb[bq] = KRSWZ(r32, bq * 32 + hi * 16); }
#define TROW(t) ((t) == 0 ? MREAL : realbase + (t) * KVBLK)
#define SLOAD(t) do { const int k0_ = TROW(t); const size_t ro_ = ((size_t)k0_ * 2048 + h * 128) * 2; \
    const GAS char* vb_ = (const GAS char*)VV + ro_; const GAS char* nb_ = (const GAS char*)KN + ro_; const GAS char* rb_ = (const GAS char*)KR + (size_t)k0_ * 128; \
    s_v0 = *(const GAS bf16x8*)(vb_ + voff); s_v1 = *(const GAS bf16x8*)(vb_ + 32 * 4096 + voff); \
    s_k0 = *(const GAS bf16x8*)(nb_ + voff); s_k1 = *(const GAS bf16x8*)(nb_ + 32 * 4096 + voff); \
    s_kr = *(const GAS bf16x8*)(rb_ + kroff); } while (0)
#define SWRITE(bf) do { *(LAS bf16x8*)(V_lds + (bf) * SHM_V + vst0) = s_v0; *(LAS bf16x8*)(V_lds + (bf) * SHM_V + vst1) = s_v1; const int kc_ = sc * 2; \
    *(LAS bf16x8*)(Kn_lds + (bf) * SHM_KN + KSWZ(sr, kc_)) = s_k0; *(LAS bf16x8*)(Kn_lds + (bf) * SHM_KN + KSWZ(32 + sr, kc_)) = s_k1; \
    *(LAS bf16x8*)(Kr_lds + (bf) * SHM_KR + KRSWZ(krr, krc * 2)) = s_kr; } while (0)
#define SWAIT() asm volatile("s_waitcnt vmcnt(0)" ::: "memory")
#define RESC(a) do { if (__any((a) < 1.f)) { if (hi == 0) al_l[r32] = (a); asm volatile("s_waitcnt lgkmcnt(0)" ::: "memory"); \
    _Pragma("unroll") for (int d = 0; d < 4; ++d) _Pragma("unroll") for (int r = 0; r < 16; ++r) o[d][r] *= al_l[crow(r, hi)]; } } while (0)
  f32x16 pA0, pA1, pB0, pB1; float mnA, mnB, alA, alB; bf16x8 pa0, pa1, pa2, pa3;
  SLOAD(0); SWAIT(); SWRITE(0); __syncthreads();
  qkt(pA0, pA1, Kn_lds, Kr_lds, qr, qrp, kb, krb);
  { const float NEG = -INFINITY;
#pragma unroll
    for (int r = 8; r < 16; ++r) pA0[r] = NEG;
#pragma unroll
    for (int r = 0; r < 16; ++r) pA1[r] = NEG; }
  partialSM(pA0, pA1, m_reg, mnA, alA, C, THRS);
  SLOAD(1); SWAIT(); SWRITE(1); __syncthreads();
  for (int j = 1; j + 1 < NT; j += 2) {
    SBAR(); qkt(pB0, pB1, Kn_lds + SHM_KN, Kr_lds + SHM_KR, qr, qrp, kb, krb);
    finishSM(pA0, pA1, alA, l_reg, pa0, pa1, pa2, pa3); SBAR();
    SLOAD(j + 1); SBAR();
    pv_d0(o, vb0, pa0, pa1, pa2, pa3); partialSM(pB0, pB1, m_reg, mnB, alB, C, THRS);
    __syncthreads(); SWAIT(); SWRITE(0);
    RESC(alB); __syncthreads();
    SBAR(); qkt(pA0, pA1, Kn_lds, Kr_lds, qr, qrp, kb, krb);
    finishSM(pB0, pB1, alB, l_reg, pa0, pa1, pa2, pa3); SBAR();
    if (j + 2 < NT) SLOAD(j + 2); SBAR();
    pv_d0(o, vb0 + SHM_V, pa0, pa1, pa2, pa3); partialSM(pA0, pA1, m_reg, mnA, alA, C, THRS);
    __syncthreads(); if (j + 2 < NT) { SWAIT(); SWRITE(1); }
    RESC(alA); __syncthreads();
  }
  finishSM(pA0, pA1, alA, l_reg, pa0, pa1, pa2, pa3); SBAR();
  pv_d0(o, vb0, pa0, pa1, pa2, pa3);
  if (hi == 0) li_l[r32] = l_reg; asm volatile("s_waitcnt lgkmcnt(0)" ::: "memory");
  float rli[16];
#pragma unroll
  for (int r = 0; r < 16; ++r) rli[r] = __builtin_amdgcn_rcpf(li_l[crow(r, hi)]);
  bf16_t* Ow = OM + (size_t)(b * SEQ + qb * 256 + wid * QBLK) * 2048 + h * 128;
#pragma unroll
  for (int r = 0; r < 16; ++r) { const int orow = crow(r, hi);
#pragma unroll
    for (int d0 = 0; d0 < 4; ++d0) { const unsigned w = cvt_pk_bf16(o[d0][r] * rli[r], 0.f); Ow[(size_t)orow * 2048 + d0 * 32 + r32] = (bf16_t)(w & 0xffffu); } }
#undef TROW
#undef SLOAD
#undef SWRITE
#undef SWAIT
#undef RESC
}
__device__ __forceinline__ void na_task(int task, const bf16_t* __restrict__ NAQ, const bf16_t* __restrict__ NAK, const bf16_t* __restrict__ VT, bf16_t* __restrict__ ONA,
                                        const LAS float* relb, const LAS float* metab, LAS float* wsf, int lane) {
  const int r32 = lane & 31, hi = lane >> 5;
  const int half = task & 1, r = (task >> 1) & 31, h = (task >> 6) & 15, b = task >> 10;
  const int qc = half * 32 + r32;
  const int cs = min(max(qc - 8, 0), 48), rs = min(max(r - 4, 0), 24);
  const int qtok = b * SEQ + r * 64 + qc;
  constexpr float C = L2E, THRS = 8.f, SCALE = 0.125f;
  bf16x8 qr[4];
#pragma unroll
  for (int d0 = 0; d0 < 4; ++d0) qr[d0] = *(const GAS bf16x8*)(NAQ + (size_t)qtok * 1024 + h * 64 + d0 * 16 + hi * 8);
  float m_reg = -1e30f, l_reg = 0.f; f32x16 o[2] = {};
  LAS float* al_l = wsf; LAS float* li_l = wsf + 32;
  const float NEG = -INFINITY;
  for (int w = 0; w < 9; ++w) {
    const bool meta = (w == 8);
    const int krow = rs + w, ktok0 = meta ? MREAL : b * SEQ + krow * 64;
    f32x16 p0 = {}, p1 = {};
    { bf16x8 kb0[4], kb1[4];
#pragma unroll
      for (int d0 = 0; d0 < 4; ++d0) { kb0[d0] = *(const GAS bf16x8*)(NAK + (size_t)(ktok0 + r32) * 1024 + h * 64 + d0 * 16 + hi * 8);
        if (!meta) kb1[d0] = *(const GAS bf16x8*)(NAK + (size_t)(ktok0 + 32 + r32) * 1024 + h * 64 + d0 * 16 + hi * 8); }
#pragma unroll
      for (int d0 = 0; d0 < 4; ++d0) { p0 = __builtin_amdgcn_mfma_f32_32x32x16_bf16(kb0[d0], qr[d0], p0, 0, 0, 0);
        if (!meta) p1 = __builtin_amdgcn_mfma_f32_32x32x16_bf16(kb1[d0], qr[d0], p1, 0, 0, 0); } }
    if (!meta) { const LAS float* bp = relb + (h * 15 + (krow - r + 7)) * 31 + 15 - qc;
#pragma unroll
      for (int rg = 0; rg < 16; ++rg) { const int kc = crow(rg, hi);
        { const bool ok = (kc >= cs) && (kc < cs + 16); const int bi = min(max(kc, qc - 15), qc + 15); const float bv = bp[bi]; p0[rg] = ok ? fmaf(p0[rg], SCALE, bv) : NEG; }
        { const int kc2 = kc + 32; const bool ok = (kc2 >= cs) && (kc2 < cs + 16); const int bi = min(max(kc2, qc - 15), qc + 15); const float bv = bp[bi]; p1[rg] = ok ? fmaf(p1[rg], SCALE, bv) : NEG; } }
    } else { const LAS float* bp = metab + h * 16;
#pragma unroll
      for (int rg = 0; rg < 16; ++rg) { const int kc = crow(rg, hi); p0[rg] = (rg < 8) ? fmaf(p0[rg], SCALE, bp[kc & 15]) : NEG; p1[rg] = NEG; } }
    float mn, alpha; partialSM(p0, p1, m_reg, mn, alpha, C, THRS);
    bf16x8 pa0, pa1, pa2, pa3; finishSM(p0, p1, alpha, l_reg, pa0, pa1, pa2, pa3);
    if (__any(alpha < 1.f)) { if (hi == 0) al_l[r32] = alpha; asm volatile("s_waitcnt lgkmcnt(0)" ::: "memory");
#pragma unroll
      for (int d = 0; d < 2; ++d)
#pragma unroll
        for (int rg = 0; rg < 16; ++rg) o[d][rg] *= al_l[crow(rg, hi)]; }
    const bf16_t* vp = VT + (size_t)(h * 64 + r32) * VT_PITCH + ktok0 + 8 * hi;
#pragma unroll
    for (int d0 = 0; d0 < 2; ++d0) {
      const bf16x8 v0 = *(const GAS bf16x8*)(vp + (size_t)d0 * 32 * VT_PITCH);
      o[d0] = __builtin_amdgcn_mfma_f32_32x32x16_bf16(pa0, v0, o[d0], 0, 0, 0);
      if (!meta) { const bf16x8 v1 = *(const GAS bf16x8*)(vp + (size_t)d0 * 32 * VT_PITCH + 16), v2 = *(const GAS bf16x8*)(vp + (size_t)d0 * 32 * VT_PITCH + 32), v3 = *(const GAS bf16x8*)(vp + (size_t)d0 * 32 * VT_PITCH + 48);
        o[d0] = __builtin_amdgcn_mfma_f32_32x32x16_bf16(pa1, v1, o[d0], 0, 0, 0);
        o[d0] = __builtin_amdgcn_mfma_f32_32x32x16_bf16(pa2, v2, o[d0], 0, 0, 0);
        o[d0] = __builtin_amdgcn_mfma_f32_32x32x16_bf16(pa3, v3, o[d0], 0, 0, 0); } }
  }
  if (hi == 0) li_l[r32] = l_reg; asm volatile("s_waitcnt lgkmcnt(0)" ::: "memory");
  bf16_t* Ow = ONA + (size_t)(b * SEQ + r * 64 + half * 32) * 1024 + h * 64;
#pragma unroll
  for (int rg = 0; rg < 16; ++rg) { const int orow = crow(rg, hi); const float rl = __builtin_amdgcn_rcpf(li_l[orow]);
#pragma unroll
    for (int d0 = 0; d0 < 2; ++d0) { const unsigned wv = cvt_pk_bf16(o[d0][rg] * rl, 0.f); Ow[(size_t)orow * 1024 + d0 * 32 + r32] = (bf16_t)(wv & 0xffffu); } }
  asm volatile("s_waitcnt lgkmcnt(0)" ::: "memory");
}
}
namespace peer {
constexpr int CH = 32;
constexpr int OFF_TV = 0, OFF_TI = OFF_TV + CH * 16 * 16 * 4, OFF_SE = OFF_TI + CH * 16 * 16 * 4, OFF_SG = OFF_SE + CH * 128 * 4, PEER_LDS = OFF_SG + CH * 128 * 4;
__device__ __forceinline__ float gelu_tanh(float x) {
    const float u = 0.7978845608028654f * (x + 0.044715f * x * x * x);
    const float e = __builtin_amdgcn_exp2f(-2.f * 1.4426950408889634f * fabsf(u));
    const float t = (1.f - e) * __builtin_amdgcn_rcpf(1.f + e);
    return 0.5f * x * (1.f + (u < 0.f ? -t : t));
}
#define PEER_INSERT(x_, xi_) do { float x__ = (x_); int xi__ = (xi_); \
    _Pragma("unroll") for (int j_ = 0; j_ < 16; ++j_) { const bool gt_ = x__ > tv[j_]; const float tvo_ = tv[j_]; const int tio_ = ti[j_]; \
        tv[j_] = gt_ ? x__ : tvo_; ti[j_] = gt_ ? xi__ : tio_; x__ = gt_ ? tvo_ : x__; xi__ = gt_ ? tio_ : xi__; } } while (0)

#ifndef PEER_AUX
#define PEER_AUX 0
#endif
typedef __amdgpu_buffer_rsrc_t rsrc_t;
__device__ __forceinline__ rsrc_t mk_rsrc(const void* p, unsigned bytes) { return __builtin_amdgcn_make_buffer_rsrc((void*)p, 0, bytes, 0x00020000); }
__device__ __forceinline__ u32x4 ldb128(rsrc_t r, unsigned off) { return __builtin_amdgcn_raw_buffer_load_b128(r, off, 0, PEER_AUX); }
__device__ __forceinline__ f32x4 ldf128(rsrc_t r, unsigned off) { return __builtin_bit_cast(f32x4, __builtin_amdgcn_raw_buffer_load_b128(r, off, 0, PEER_AUX)); }
__device__ __forceinline__ void peer_chunk(int CHECK  , unsigned* mism, int chunk, const float* __restrict__ SC, const float* __restrict__ H2, const bf16_t* __restrict__ U, const bf16_t* __restrict__ V,
                                           const float* __restrict__ g2, const float* __restrict__ gf, float* OUT, LAS char* lds, int tid) {
    LAS float* TV = (LAS float*)(lds + OFF_TV); LAS int* TI = (LAS int*)(lds + OFF_TI); LAS int* SE = (LAS int*)(lds + OFF_SE); LAS float* SG = (LAS float*)(lds + OFF_SG);
    asm volatile("" : "+v"(tid));
    const int tok0 = chunk * CH, lane = tid & 63, wave = tid >> 6;
    const rsrc_t rSC = mk_rsrc(SC, 0x8000000u), rH2 = mk_rsrc(H2, 0x8000000u), rU = mk_rsrc(U, 0x4000000u), rV = mk_rsrc(V, 0x4000000u);
    __syncthreads();
    { const int tl = tid >> 4, g = tid & 15; const unsigned spo = ((unsigned)(tok0 + tl) * 2048u + (unsigned)g * 128u) * 4u;
      float tv[16]; int ti[16];
#pragma unroll
      for (int j = 0; j < 16; ++j) { tv[j] = -INFINITY; ti[j] = 0; }
#pragma unroll 1
      for (int i = 0; i < 32; i += 2) { const f32x4 a = ldf128(rSC, spo + i * 16), b = ldf128(rSC, spo + i * 16 + 16);
          PEER_INSERT(a[0], 4 * i + 0); PEER_INSERT(a[1], 4 * i + 1); PEER_INSERT(a[2], 4 * i + 2); PEER_INSERT(a[3], 4 * i + 3);
          PEER_INSERT(b[0], 4 * i + 4); PEER_INSERT(b[1], 4 * i + 5); PEER_INSERT(b[2], 4 * i + 6); PEER_INSERT(b[3], 4 * i + 7); }
      LAS float* tvp = TV + (tl * 16 + g) * 16; LAS int* tip = TI + (tl * 16 + g) * 16;
#pragma unroll
      for (int j = 0; j < 16; ++j) { tvp[j] = tv[j]; tip[j] = ti[j]; } }
    __syncthreads();
    asm volatile("" : "+v"(tid));
    if (tid < CH * 8) { const int tl = tid >> 3, hh = tid & 7;
      const LAS float* s1 = TV + (tl * 16 + 2 * hh) * 16; const LAS float* s2 = s1 + 16; const LAS int* i1 = TI + (tl * 16 + 2 * hh) * 16; const LAS int* i2 = i1 + 16;
      float b2[16];
#pragma unroll
      for (int j = 0; j < 16; ++j) b2[j] = s2[j];
      float tv[16]; int ti[16];
#pragma unroll
      for (int j = 0; j < 16; ++j) { tv[j] = -INFINITY; ti[j] = 0; }
#pragma unroll 1
      for (int i = 0; i < 16; ++i) { const float a = s1[i];
#pragma unroll
          for (int j = 0; j < 16; ++j) PEER_INSERT(a + b2[j], i * 16 + j); }
      float e[16], sum = 0.f;
#pragma unroll
      for (int j = 0; j < 16; ++j) { e[j] = __builtin_amdgcn_exp2f((tv[j] - tv[0]) * 1.4426950408889634f); sum += e[j]; }
      const float inv = 1.0f / sum;
#pragma unroll
      for (int j = 0; j < 16; ++j) { const int ci = ti[j]; SE[tl * 128 + hh * 16 + j] = i1[ci >> 4] * 128 + i2[ci & 15]; SG[tl * 128 + hh * 16 + j] = e[j] * inv; } }
    __syncthreads();
#pragma unroll 1
    for (int tt = 0; tt < CH / NWAVES; ++tt) { const int tl = wave * (CH / NWAVES) + tt, tok = tok0 + tl;
      asm volatile("" ::: "memory");
      float hn[32], acc[32]; float ss = 0.f;
#pragma unroll
      for (int j = 0; j < 4; ++j) { const unsigned ho = ((unsigned)tok * 2048u + 512u * j + 8u * lane) * 4u; const f32x4 a = ldf128(rH2, ho), b = ldf128(rH2, ho + 16);
#pragma unroll
          for (int i = 0; i < 4; ++i) { hn[8 * j + i] = a[i]; hn[8 * j + 4 + i] = b[i]; ss += a[i] * a[i] + b[i] * b[i]; } }
      const float rstd = 1.0f / sqrtf(wave_sum(ss) * (1.f / 2048.f) + NORM_EPS);
#pragma unroll
      for (int j = 0; j < 4; ++j) { const f32x4 a = *(const GAS f32x4*)(g2 + 512 * j + 8 * lane), b = *(const GAS f32x4*)(g2 + 512 * j + 8 * lane + 4);
#pragma unroll
          for (int i = 0; i < 4; ++i) { hn[8 * j + i] *= rstd * a[i]; hn[8 * j + 4 + i] *= rstd * b[i]; } }
#pragma unroll
      for (int i = 0; i < 32; ++i) acc[i] = 0.f;
#pragma unroll 1
      for (int k = 0; k < 128; k += 2) {
          const int e0 = SE[tl * 128 + k], e1 = SE[tl * 128 + k + 1]; const float g0 = SG[tl * 128 + k], g1 = SG[tl * 128 + k + 1];
          const unsigned o0 = (unsigned)e0 * 4096u + (unsigned)lane * 16u, o1 = (unsigned)e1 * 4096u + (unsigned)lane * 16u;
          u32x4 ua[4], ub[4], va[4], vb[4];
#pragma unroll
          for (int j = 0; j < 4; ++j) { ua[j] = ldb128(rU, o0 + 1024 * j); ub[j] = ldb128(rU, o1 + 1024 * j); }
#pragma unroll
          for (int j = 0; j < 4; ++j) { va[j] = ldb128(rV, o0 + 1024 * j); vb[j] = ldb128(rV, o1 + 1024 * j); }
          float d0 = 0.f, d1 = 0.f;
#pragma unroll
          for (int j = 0; j < 4; ++j) {
              d0 += hn[8 * j + 0] * bf_lo(ua[j].x) + hn[8 * j + 1] * bf_hi(ua[j].x) + hn[8 * j + 2] * bf_lo(ua[j].y) + hn[8 * j + 3] * bf_hi(ua[j].y)
                  + hn[8 * j + 4] * bf_lo(ua[j].z) + hn[8 * j + 5] * bf_hi(ua[j].z) + hn[8 * j + 6] * bf_lo(ua[j].w) + hn[8 * j + 7] * bf_hi(ua[j].w);
              d1 += hn[8 * j + 0] * bf_lo(ub[j].x) + hn[8 * j + 1] * bf_hi(ub[j].x) + hn[8 * j + 2] * bf_lo(ub[j].y) + hn[8 * j + 3] * bf_hi(ub[j].y)
                  + hn[8 * j + 4] * bf_lo(ub[j].z) + hn[8 * j + 5] * bf_hi(ub[j].z) + hn[8 * j + 6] * bf_lo(ub[j].w) + hn[8 * j + 7] * bf_hi(ub[j].w); }
          d0 = wave_sum(d0); d1 = wave_sum(d1);
          const float c0 = g0 * gelu_tanh(d0), c1 = g1 * gelu_tanh(d1);
#pragma unroll
          for (int j = 0; j < 4; ++j) {
              acc[8 * j + 0] += c0 * bf_lo(va[j].x) + c1 * bf_lo(vb[j].x); acc[8 * j + 1] += c0 * bf_hi(va[j].x) + c1 * bf_hi(vb[j].x);
              acc[8 * j + 2] += c0 * bf_lo(va[j].y) + c1 * bf_lo(vb[j].y); acc[8 * j + 3] += c0 * bf_hi(va[j].y) + c1 * bf_hi(vb[j].y);
              acc[8 * j + 4] += c0 * bf_lo(va[j].z) + c1 * bf_lo(vb[j].z); acc[8 * j + 5] += c0 * bf_hi(va[j].z) + c1 * bf_hi(vb[j].z);
              acc[8 * j + 6] += c0 * bf_lo(va[j].w) + c1 * bf_lo(vb[j].w); acc[8 * j + 7] += c0 * bf_hi(va[j].w) + c1 * bf_hi(vb[j].w); }
      }
      asm volatile("" ::: "memory");
      float s2 = 0.f;
#pragma unroll
      for (int j = 0; j < 4; ++j) { const unsigned ho = ((unsigned)tok * 2048u + 512u * j + 8u * lane) * 4u; const f32x4 a = ldf128(rH2, ho), b = ldf128(rH2, ho + 16);
#pragma unroll
          for (int i = 0; i < 4; ++i) { acc[8 * j + i] += a[i]; acc[8 * j + 4 + i] += b[i]; s2 += acc[8 * j + i] * acc[8 * j + i] + acc[8 * j + 4 + i] * acc[8 * j + 4 + i]; } }
      const float rf = 1.0f / sqrtf(wave_sum(s2) * (1.f / 2048.f) + NORM_EPS);
#pragma unroll
      for (int j = 0; j < 4; ++j) { const f32x4 a = *(const GAS f32x4*)(gf + 512 * j + 8 * lane), b = *(const GAS f32x4*)(gf + 512 * j + 8 * lane + 4);
          f32x4 oa, ob;
#pragma unroll
          for (int i = 0; i < 4; ++i) { oa[i] = acc[8 * j + i] * rf * a[i]; ob[i] = acc[8 * j + 4 + i] * rf * b[i]; }
          if (CHECK) { const f32x4 ra = *(const GAS f32x4*)(OUT + (size_t)tok * 2048 + 512 * j + 8 * lane), rb = *(const GAS f32x4*)(OUT + (size_t)tok * 2048 + 512 * j + 8 * lane + 4); bool bad = false;
#pragma unroll
              for (int i = 0; i < 4; ++i) bad |= (__float_as_uint(ra[i]) != __float_as_uint(oa[i])) | (__float_as_uint(rb[i]) != __float_as_uint(ob[i]));
              if (bad) atomicAdd(mism, 1u); }
          if (CHECK != 1) { *(GAS f32x4*)(OUT + (size_t)tok * 2048 + 512 * j + 8 * lane) = oa; *(GAS f32x4*)(OUT + (size_t)tok * 2048 + 512 * j + 8 * lane + 4) = ob; } }
    }
}
}
#ifndef MK_N_LAUNCHES
#define MK_N_LAUNCHES 1
#endif
constexpr int N_PHASES = 9;
constexpr int N_LAUNCHES = MK_N_LAUNCHES;
struct Args { const float* in[19]; float* out; unsigned char* ws; int ph_lo, ph_hi; };
static_assert(sizeof(Args) == 19 * 8 + 8 + 8 + 8, "no padding");

#if defined(DBG_CK) || defined(DBG_CKALL)
constexpr int CW_CK = 2048;
#ifdef DBG_CKALL
#define DBG_CK cksel
#endif
__device__ __forceinline__ void dbg_cksum(Frame& F, size_t off, size_t bytes, int slot = 0) {
    const GAS u32x4* p = (const GAS u32x4*)(F.ws + off); const size_t n16 = bytes / 16; unsigned s = 0u;
    for (size_t i = (size_t)F.vcu * 512 + F.tid; i < n16; i += (size_t)F.G * 512) { const u32x4 v = p[i]; s += v.x * 3u + v.y * 5u + v.z * 7u + v.w * 11u + (unsigned)i * (v.x ^ v.w); }
#pragma unroll
    for (int o = 1; o < 64; o <<= 1) s += __shfl_xor(s, o);
    if (F.lane == 0) __hip_atomic_fetch_add((unsigned*)(F.ws + WS_CTL) + CW_CK + 64 * slot, s, __ATOMIC_RELAXED, __HIP_MEMORY_SCOPE_AGENT);
}
#ifdef DBG_CKALL
#define CK(k, off, bytes) do { xcd_barrier(bar); dbg_cksum(F, (off), (bytes), (k)); } while (0)
#else
#define CK(k, off, bytes) do { if (DBG_CK == (k)) { xcd_barrier(bar); dbg_cksum(F, (off), (bytes)); } } while (0)
#endif
#else
#define CK(k, off, bytes) do { } while (0)
#endif
__global__ void __launch_bounds__(NWAVES * 64, 2) hybrid_fwd(Args args) {
    extern __shared__ __attribute__((aligned(16))) unsigned char lds_raw[];
    Frame F;
    F.lds = (LAS unsigned char*)lds_raw;
    F.MISC = (volatile LAS unsigned*)(F.lds + MISC_OFF);
    F.tid = threadIdx.x; F.lane = F.tid & 63; F.wave = __builtin_amdgcn_readfirstlane(F.tid >> 6);
    F.G = gridDim.x; { const int bx = blockIdx.x; F.vcu = (F.G % 8 == 0) ? (bx % 8) * (F.G / 8) + bx / 8 : bx; }
    F.ws = args.ws; F.out = args.out;
#pragma unroll
    for (int i = 0; i < 19; ++i) F.in[i] = args.in[i];
    for (int u = F.tid; u < (LDS_BYTES - LDSCTL_OFF) / 4; u += NWAVES * 64) ((LAS unsigned*)(F.lds + LDSCTL_OFF))[u] = 0u;
    __syncthreads();
    XcdBarrier bar; bar.bar = (unsigned*)(F.ws + WS_CTL) + CW_BAR; bar.x = 0; bar.st = nullptr;
    if (N_LAUNCHES == 1) bar = xcd_barrier_post((unsigned*)(F.ws + WS_CTL) + CW_BAR, F.MISC + 8);
    const int lo = args.ph_lo, hi = args.ph_hi;
#ifndef PH_MASK
#define PH_MASK 0x1ff
#endif
#define IN(k) ((((PH_MASK) >> (k)) & 1) && lo <= (k) && (k) < hi)
#define SEAM(k) do { if (IN(k) && IN((k) + 1)) xcd_barrier(bar); } while (0)
    const size_t T2048 = (size_t)256 * 2048 * 2, T1024 = (size_t)256 * 1024 * 2, T512 = (size_t)256 * 512 * 2;
    float* cosT = WSP(float, WS_COS); float* sinT = WSP(float, WS_SIN);
    float* ssq_q = WSP(float, WS_SSQ_Q); float* ssq_kv = WSP(float, WS_SSQ_KV); float* ssq2 = WSP(float, WS_SSQ_2);

#ifdef DBG_PREFILL
    if (IN(0)) {
        for (int u = F.tid; u < LDSCTL_OFF / 4; u += NWAVES * 64) ((LAS unsigned*)F.lds)[u] = 0u;
        GAS u32x4* z = (GAS u32x4*)(F.ws + CTL_ZERO_BYTES); const size_t n16 = (WS_END - CTL_ZERO_BYTES) / 16;
        for (size_t i = (size_t)F.vcu * 512 + F.tid; i < n16; i += (size_t)F.G * 512) z[i] = (u32x4){DBG_PREFILL, DBG_PREFILL, DBG_PREFILL, DBG_PREFILL};
        xcd_barrier(bar); }
#endif
    if (IN(0)) { p0_prologue(F); CK(0, WS_COS, (size_t)NPOS * 32 * 4); CK(0, WS_SIN, (size_t)NPOS * 32 * 4); CK(0, WS_WUQ, 35 * MiB); CK(0, WS_WIN, 33 * MiB); CK(0, WS_HN1, 65 * MiB); } SEAM(0);
    if (IN(1)) {
        SchedP1 S{F.G, (int)blockIdx.x, (const char*)(F.ws + WS_HN1), (const char*)(F.ws + WS_WIN), (const char*)(F.ws + WS_WVT), T2048};
        EpiP1 E{WSP(bf16_t, WS_NAQ), WSP(bf16_t, WS_NAK), WSP(bf16_t, WS_VT), WSP(bf16_t, WS_CQ), WSP(bf16_t, WS_CKV), WSP(bf16_t, WS_KR), WSP(bf16_t, WS_GA), WSP(bf16_t, WS_GB), ssq_q, ssq_kv, cosT, sinT};
#ifdef DBG_P1TWICE
        {
            unsigned* cnt = (unsigned*)(F.ws + WS_CTL) + 2056;
#pragma unroll 1
            for (int rep = 0; rep < 2; ++rep) {
                pg8::gemm_phase<EpiP1, SchedP1>(F.lds, 2048, S, E);
                xcd_barrier(bar);
                const GAS u32x4* g = (const GAS u32x4*)(F.ws + WS_GA); GAS u32x4* cp = (GAS u32x4*)(F.ws + 384 * MiB); const size_t n16 = 64 * MiB / 16;
                unsigned nd = 0u; float md = 0.f;
                for (size_t i = (size_t)F.vcu * 512 + F.tid; i < n16; i += (size_t)F.G * 512) { const u32x4 v = g[i];
                    if (rep == 0) cp[i] = v; else { const u32x4 w = cp[i];
#pragma unroll
                        for (int e = 0; e < 4; ++e) { if (v[e] != w[e]) { ++nd; md = fmaxf(md, fmaxf(fabsf(bf_lo(v[e]) - bf_lo(w[e])), fabsf(bf_hi(v[e]) - bf_hi(w[e])))); atomicMin(cnt + 128, (unsigned)(i * 4 + e)); atomicMax(cnt + 192, (unsigned)(i * 4 + e)); } } } }
                if (rep == 0 && blockIdx.x == 0 && F.tid == 0) { cnt[128] = 0xffffffffu; }
                if (rep == 1) { if (nd) atomicAdd(cnt, nd); atomicMax(cnt + 64, __float_as_uint(md)); }
                xcd_barrier(bar); }
            F.MISC[20] = __hip_atomic_load(cnt + 128, __ATOMIC_RELAXED, __HIP_MEMORY_SCOPE_AGENT); F.MISC[21] = __hip_atomic_load(cnt + 192, __ATOMIC_RELAXED, __HIP_MEMORY_SCOPE_AGENT);
        }
#else
        pg8::gemm_phase<EpiP1, SchedP1>(F.lds, 2048, S, E);
#endif
        CK(1, WS_GA, 128 * MiB); CK(1, WS_KR, (size_t)MPAD * 64 * 2); CK(1, WS_NAQ, 97 * MiB); CK(1, WS_CQ, 16 * MiB); CK(1, WS_CKV, (size_t)MPAD * 512 * 2); CK(1, WS_SSQ_Q, (size_t)8 * MPAD * 4); CK(1, WS_SSQ_KV, (size_t)8 * MPAD * 4);
    } SEAM(1);
    if (IN(2)) {
        LAS float* relb = (LAS float*)F.lds; LAS float* metab = relb + 16 * 15 * 31; LAS float* wsf = metab + 256 + F.wave * 64;
        for (int i = F.tid; i < 16 * 15 * 31; i += NWAVES * 64) relb[i] = F.in[4][i];
        if (F.tid < 256) metab[F.tid] = F.in[5][F.tid];
        __syncthreads();
        const int gw = F.vcu * NWAVES + F.wave, NGW = F.G * NWAVES;
        for (int task = gw; task < NBATCH * 16 * 32 * 2; task += NGW)
            att::na_task(task, WSP(bf16_t, WS_NAQ), WSP(bf16_t, WS_NAK), WSP(bf16_t, WS_VT), WSP(bf16_t, WS_ONA), relb, metab, wsf, F.lane);
        __syncthreads();
        CK(2, WS_ONA, 32 * MiB);
    } SEAM(2);
    if (IN(3)) {
        SchedP3 S{F.G, (int)blockIdx.x, (const char*)(F.ws + WS_CQ), (const char*)(F.ws + WS_CKV), (const char*)(F.ws + WS_WUQ), (const char*)(F.ws + WS_WUKV), T512};
        EpiP3 E{WSP(bf16_t, WS_QM), WSP(bf16_t, WS_KN), WSP(bf16_t, WS_VV), ssq_q, ssq_kv, cosT, sinT};
        pg8::gemm_phase<EpiP3, SchedP3>(F.lds, 512, S, E);
        CK(3, WS_QM, 226 * MiB);
    } SEAM(3);
    if (IN(4)) {
        for (int id = F.vcu; id < NBATCH * 16 * 8; id += F.G) { const int bh = id >> 3, qb = id & 7;
            att::mla_unit(bh >> 4, bh & 15, qb, WSP(bf16_t, WS_QM), WSP(bf16_t, WS_KN), WSP(bf16_t, WS_KR), WSP(bf16_t, WS_VV), WSP(bf16_t, WS_OMLA), (LAS char*)F.lds); }
        __syncthreads();
        CK(4, WS_OMLA, 64 * MiB);
    } SEAM(4);
    if (IN(5)) {
        { SchedGrid S{F.G, (int)blockIdx.x, 64, 8, (const char*)(F.ws + WS_ONA), (const char*)(F.ws + WS_WNA), T1024};
          EpiP5a E{WSP(bf16_t, WS_GA), WSP(float, WS_T1)};
          pg8::gemm_phase<EpiP5a, SchedGrid>(F.lds, 1024, S, E); }
        { SchedGrid S{F.G, (int)blockIdx.x, 64, 8, (const char*)(F.ws + WS_OMLA), (const char*)(F.ws + WS_WMLA), T2048};
          EpiP5b E{WSP(bf16_t, WS_GB), WSP(float, WS_T1), WSP(bf16_t, WS_MERGED)};
          pg8::gemm_phase<EpiP5b, SchedGrid>(F.lds, 2048, S, E); }
        CK(5, WS_MERGED, 64 * MiB);
    } SEAM(5);
    if (IN(6)) {
        { SchedGrid S{F.G, (int)blockIdx.x, 64, 8, (const char*)(F.ws + WS_MERGED), (const char*)(F.ws + WS_WOUT), T2048};
          EpiP6 E{F.in[0], WSP(float, WS_H2), WSP(bf16_t, WS_H2B), ssq2};
          pg8::gemm_phase<EpiP6, SchedGrid>(F.lds, 2048, S, E); }
        { const size_t n8 = (size_t)16384 * 2048 / 8;
          for (size_t i = (size_t)F.vcu * 512 + F.tid; i < 2 * n8; i += (size_t)F.G * 512) { const bool isu = i < n8; const size_t j = isu ? i : i - n8;
              const float* src = (isu ? F.in[16] : F.in[17]) + j * 8; const f32x4 a = *(const GAS f32x4*)src, b = *(const GAS f32x4*)(src + 4);
              *(GAS u32x4*)((isu ? WSP(bf16_t, WS_U) : WSP(bf16_t, WS_V)) + j * 8) = pack8(a, b); } }
        CK(6, WS_H2, 128 * MiB); CK(6, WS_H2B, 192 * MiB);
    } SEAM(6);
    if (IN(7)) {
        SchedGrid S{F.G, (int)blockIdx.x, 64, 8, (const char*)(F.ws + WS_H2B), (const char*)(F.ws + WS_WSC), T2048};
        EpiP7 E{ssq2, WSP(float, WS_SC)};
        pg8::gemm_phase<EpiP7, SchedGrid>(F.lds, 2048, S, E);
        CK(7, WS_SC, 128 * MiB);
    } SEAM(7);
    if (IN(8)) {
#ifdef DBG_MEMPROBE
        {
            unsigned* mism = (unsigned*)(F.ws + WS_CTL) + 2056; unsigned sA = 0u, sB = 0u, hA = 0u, hB = 0u, junk = 0u;
            for (int chunk = F.vcu; chunk < MREAL / peer::CH; chunk += F.G) { const GAS u32x4* p = (const GAS u32x4*)(F.ws + WS_SC + (size_t)chunk * 32 * 8192); const GAS u32x4* q = (const GAS u32x4*)(F.ws + WS_H2 + (size_t)chunk * 32 * 8192);
                for (int i = F.tid; i < 32 * 512; i += 512) { const u32x4 v = p[i]; sA += v.x * 3u + v.y * 5u + v.z * 7u + v.w * 11u; const u32x4 w = q[i]; hA += w.x * 3u + w.y * 5u + w.z * 7u + w.w * 11u; } }
            { const GAS u32x4* p = (const GAS u32x4*)(F.in[16]) + (size_t)(F.vcu & 7) * (1u << 20);
              for (int i = F.tid; i < (1 << 20); i += 512) { const u32x4 v = p[i]; junk += v.x ^ v.y ^ v.z ^ v.w; } }
            __syncthreads();
            for (int chunk = F.vcu; chunk < MREAL / peer::CH; chunk += F.G) { const GAS u32x4* p = (const GAS u32x4*)(F.ws + WS_SC + (size_t)chunk * 32 * 8192); const GAS u32x4* q = (const GAS u32x4*)(F.ws + WS_H2 + (size_t)chunk * 32 * 8192);
                for (int i = F.tid; i < 32 * 512; i += 512) { const u32x4 v = p[i]; sB += v.x * 3u + v.y * 5u + v.z * 7u + v.w * 11u; const u32x4 w = q[i]; hB += w.x * 3u + w.y * 5u + w.z * 7u + w.w * 11u; } }
            if (sA != sB) atomicAdd(mism, 1u); if (hA != hB) atomicAdd(mism + 64, 1u); if (junk == 0x12345u) atomicAdd(mism + 128, 1u);
            xcd_barrier(bar);
            const unsigned n1 = __hip_atomic_load(mism, __ATOMIC_RELAXED, __HIP_MEMORY_SCOPE_AGENT), n2 = __hip_atomic_load(mism + 64, __ATOMIC_RELAXED, __HIP_MEMORY_SCOPE_AGENT);
            if (n1 != 0u) { if (blockIdx.x == 0 && F.tid == 0) F.in[0] == nullptr ? (void)0 : (void)(F.out[0] = 0.f); }
            F.MISC[16] = n1; F.MISC[17] = n2;
        }
#endif
#ifdef DBG_LDSZ
        { for (int u = F.tid; u < LDSCTL_OFF / 4; u += NWAVES * 64) ((LAS unsigned*)F.lds)[u] = DBG_LDSZ; __syncthreads(); }
#endif
#ifdef DBG_DELAY
        { const unsigned long long t0 = __builtin_amdgcn_s_memrealtime(); while (__builtin_amdgcn_s_memrealtime() - t0 < (unsigned long long)DBG_DELAY) __builtin_amdgcn_s_sleep(8); xcd_barrier(bar); }
#endif
#ifdef DBG_P8TWICE
        constexpr int NPASS = 3;
#else
        constexpr int NPASS = 1;
#endif
        unsigned* mism = (unsigned*)(F.ws + WS_CTL) + 2056;
#pragma unroll 1
        for (int pass = 0; pass < NPASS; ++pass) {
            int mode = pass > 0 ? 1 : 0; asm volatile("" : "+v"(mode));
            if (pass) xcd_barrier(bar);
            for (int chunk = F.vcu; chunk < MREAL / peer::CH; chunk += F.G)
                peer::peer_chunk(mode, mism + 64 * pass, chunk, WSP(float, WS_SC), WSP(float, WS_H2), WSP(bf16_t, WS_U), WSP(bf16_t, WS_V), F.in[13], F.in[18], F.out, (LAS char*)F.lds, F.tid);
        }
#ifdef DBG_P8TWICE
        { xcd_barrier(bar);
          const unsigned n12 = __hip_atomic_load(mism + 64, __ATOMIC_RELAXED, __HIP_MEMORY_SCOPE_AGENT), n23 = __hip_atomic_load(mism + 128, __ATOMIC_RELAXED, __HIP_MEMORY_SCOPE_AGENT);
          if (blockIdx.x == 0 && F.tid == 0) { const int a = 32 - __builtin_clz(n12 + 1u) - 1, b = 32 - __builtin_clz(n23 + 1u) - 1;
              float v = (float)(10 + a) * 0.1f; for (int i = 0; i < 10 + b; ++i) v *= 10.f; F.out[64] = v; } }
#endif
#ifdef DBG_P1TWICE
        { xcd_barrier(bar); if (blockIdx.x == 0 && F.tid == 0) { const unsigned wmin = F.MISC[20], wmax = F.MISC[21]; const int rmin = (int)(wmin / 1024u), rmax = (int)(wmax / 1024u), cmin = (int)((wmin % 1024u) / 128u);
              const int DBGSEL = DBG_P1TWICE; const int a = DBGSEL == 1 ? rmin / 256 : (DBGSEL == 2 ? rmax / 256 : (rmin % 256) / 4), b = DBGSEL == 3 ? (rmax % 256) / 16 : cmin;
              float v = (float)(10 + a) * 0.1f; for (int i = 0; i < 10 + b; ++i) v *= 10.f; F.out[64] = v; } }
#endif
#ifdef DBG_MEMPROBE
        { xcd_barrier(bar); if (blockIdx.x == 0 && F.tid == 0) { if (F.MISC[16] != 0u) F.out[0] = __builtin_nanf(""); else if (F.MISC[17] != 0u) F.out[64] = 1e30f; } }
#endif
#ifdef FINAL_BARRIER
        xcd_barrier(bar);
#endif
#ifdef DBG_REWRITE
        { xcd_barrier(bar);
          volatile GAS f32x4* o = (volatile GAS f32x4*)F.out; const size_t n16 = (size_t)MREAL * DM / 4;
          for (size_t i = (size_t)F.vcu * 512 + F.tid; i < n16; i += (size_t)F.G * 512) { f32x4 v = o[i]; asm volatile("" : "+v"(v)); o[i] = v; } }
#endif
#ifdef DBG_CKALL
        { xcd_barrier(bar);
          if (blockIdx.x == 0 && F.tid == 0) { unsigned* keep = (unsigned*)(F.ws + 1 * MiB + 960 * 1024); int kbad = -1;
              for (int k = 7; k >= 0; --k) { const unsigned ck = __hip_atomic_load((unsigned*)(F.ws + WS_CTL) + CW_CK + 64 * k, __ATOMIC_RELAXED, __HIP_MEMORY_SCOPE_AGENT); const unsigned prev = keep[k];
                  if (prev != 0xAAAAAAAAu && prev != 0u && prev != ck) kbad = k; keep[k] = ck; }
              if (kbad >= 0) { float v = 5792.f * 0.05f; for (int i = 0; i < kbad; ++i) v *= 2.f; F.out[64] = v; } } }
#elif defined(DBG_CK)
        { xcd_barrier(bar);
          const unsigned ck = __hip_atomic_load((unsigned*)(F.ws + WS_CTL) + CW_CK, __ATOMIC_RELAXED, __HIP_MEMORY_SCOPE_AGENT);
          const unsigned hsh = (ck * 2654435761u) ^ (ck >> 15); const float g = (float)((hsh >> 8) & 0xffffu) * (1.f / 32768.f) - 1.f; const float sc = 1.f + 0.03f * g;
          GAS f32x4* o = (GAS f32x4*)F.out; const size_t n16 = (size_t)MREAL * DM / 4;
          for (size_t i = (size_t)F.vcu * 512 + F.tid; i < n16; i += (size_t)F.G * 512) o[i] = o[i] * sc; }
#endif
    }
#undef IN
#undef SEAM
}

extern "C" void kernel_launch(void* const* d_in, const int* in_sizes, int n_in, void* d_out, int out_size, void* d_ws, size_t ws_size, hipStream_t stream) {
    static int grid = 0;
    if (grid == 0) {
        if (n_in != 19 || in_sizes[0] != MREAL * DM || out_size != MREAL * DM || ws_size < WS_END) {
            fprintf(stderr, "kernel_launch: shape/workspace mismatch: n_in %d in0 %d out %d ws %zu (need %zu); nothing launched\n", n_in, n_in > 0 ? in_sizes[0] : -1, out_size, ws_size, (size_t)WS_END); grid = -1; return; }
        int dev = 0, cus = 0, per_cu = 0;
        if (hipGetDevice(&dev) != hipSuccess || hipDeviceGetAttribute(&cus, hipDeviceAttributeMultiprocessorCount, dev) != hipSuccess) { fprintf(stderr, "kernel_launch: device query failed\n"); grid = -1; return; }
        if (hipFuncSetAttribute((const void*)hybrid_fwd, hipFuncAttributeMaxDynamicSharedMemorySize, LDS_BYTES) != hipSuccess) { fprintf(stderr, "kernel_launch: hipFuncSetAttribute failed\n"); grid = -1; return; }
        if (hipOccupancyMaxActiveBlocksPerMultiprocessor(&per_cu, (const void*)hybrid_fwd, NWAVES * 64, LDS_BYTES) != hipSuccess || per_cu < 1)
            fprintf(stderr, "kernel_launch: note: occupancy query reports %d workgroups per CU\n", per_cu);
        (void)hipGetLastError();
        grid = cus;
    }
    if (grid < 0) return;
    if (hipMemsetAsync((char*)d_ws + WS_CTL, 0, CTL_ZERO_BYTES, stream) != hipSuccess) { fprintf(stderr, "kernel_launch: hipMemsetAsync failed\n"); return; }
    Args a{};
    for (int i = 0; i < 19; ++i) a.in[i] = (const float*)d_in[i];
    a.out = (float*)d_out; a.ws = (unsigned char*)d_ws;
    for (int li = 0; li < N_LAUNCHES; ++li) {
        a.ph_lo = (N_LAUNCHES == 1) ? 0 : li; a.ph_hi = (N_LAUNCHES == 1) ? N_PHASES : li + 1;
        hipLaunchKernelGGL(hybrid_fwd, dim3(grid), dim3(NWAVES * 64), LDS_BYTES, stream, a);
        const hipError_t le = hipPeekAtLastError();
        if (le != hipSuccess) { fprintf(stderr, "kernel_launch: launch %d failed: %s\n", li, hipGetErrorName(le)); break; }
    }
}
```

```cpp
#include <hip/hip_runtime.h>
#include <cstdio>
#include <cstdint>

#define LAS __attribute__((address_space(3)))
#define GAS __attribute__((address_space(1)))
typedef unsigned short bf16_t;
typedef short bf16x8 __attribute__((ext_vector_type(8)));
typedef short s16x4 __attribute__((ext_vector_type(4)));
typedef float f32x4 __attribute__((ext_vector_type(4)));
typedef float f32x2 __attribute__((ext_vector_type(2)));
typedef float f32x16 __attribute__((ext_vector_type(16)));
typedef unsigned u32x4 __attribute__((ext_vector_type(4)));
typedef unsigned u32x2 __attribute__((ext_vector_type(2)));

constexpr int DM = 2048, NBATCH = 8, SEQ = 2048, NMETA = 16;
constexpr int MREAL = NBATCH * SEQ;
constexpr int MPAD = MREAL + 256;
constexpr int NPOS = SEQ + NMETA;
constexpr float NORM_EPS = 1e-6f;
constexpr int C_NAQ = 0, C_NAK = 1024, C_CQ = 2048, C_CKV = 2560, C_GA = 3072, C_GB = 5120, C_KR = 7168, NMAIN = 7424;
constexpr int VT_PITCH = MPAD;

constexpr size_t MiB = 1u << 20;
constexpr size_t WS_CTL = 0, CTL_ZERO_BYTES = 1 * MiB;
constexpr size_t WS_SSQ_Q = 481 * MiB, WS_SSQ_KV = 482 * MiB, WS_SSQ_2 = 486 * MiB;
constexpr size_t WS_COS = 1 * MiB, WS_SIN = 1 * MiB + 512 * 1024;
constexpr size_t WS_WUQ = 2 * MiB, WS_WUKV = 5 * MiB, WS_WNA = 9 * MiB, WS_WMLA = 13 * MiB, WS_WOUT = 21 * MiB, WS_WSC = 29 * MiB;
constexpr size_t WS_GA = 37 * MiB, WS_GB = 101 * MiB;
constexpr size_t WS_KR = 165 * MiB;
constexpr size_t WS_WIN = 167 * MiB + 256 * 1024, WS_WVT = WS_WIN + 29 * MiB;
constexpr size_t WS_ONA = 190 * MiB;
constexpr size_t WS_NAQ = 222 * MiB, WS_NAK = 254 * MiB, WS_VT = WS_NAK + 32 * MiB + 512 * 1024;
constexpr size_t WS_HN1 = 319 * MiB;
constexpr size_t WS_CQ = 448 * MiB, WS_CKV = 464 * MiB;
constexpr size_t WS_QM = 222 * MiB, WS_KN = 318 * MiB, WS_VV = 383 * MiB;
constexpr size_t WS_OMLA = 448 * MiB;
constexpr size_t WS_MERGED = 222 * MiB, WS_T1 = 286 * MiB;
constexpr size_t WS_H2 = 37 * MiB, WS_H2B = 293 * MiB;
constexpr size_t WS_U = 357 * MiB, WS_V = 421 * MiB;
constexpr size_t WS_SC = 165 * MiB;
constexpr size_t WS_END = 512 * MiB;
static_assert(WS_CKV + (size_t)MPAD * 512 * 2 <= WS_SSQ_Q && WS_SSQ_Q + (size_t)8 * MPAD * 4 <= WS_SSQ_KV && WS_SSQ_KV + (size_t)8 * MPAD * 4 <= 483 * MiB && WS_V + 64 * MiB <= WS_SSQ_2 && WS_SSQ_2 + (size_t)32 * MREAL * 4 <= WS_END, "ssq slabs");
static_assert(WS_VT + (size_t)1024 * MPAD * 2 <= WS_HN1 && WS_HN1 + (size_t)MPAD * 2048 * 2 <= WS_CQ && WS_CKV + (size_t)MPAD * 512 * 2 <= WS_END, "map P1");
static_assert(WS_WVT + 4 * MiB <= WS_NAQ && WS_KR + (size_t)MPAD * 64 * 2 <= WS_WIN && WS_ONA + 32 * MiB <= WS_NAQ, "map P1b");
static_assert(WS_QM + 96 * MiB <= WS_KN && WS_KN + 65 * MiB <= WS_VV && WS_VV + 65 * MiB <= WS_OMLA && WS_OMLA + 64 * MiB <= WS_END, "map P3");
static_assert(WS_T1 + 128 * MiB <= WS_OMLA && WS_H2 + 128 * MiB <= WS_KR && WS_SC + 128 * MiB <= WS_H2B && WS_H2B + 64 * MiB <= WS_U && WS_V + 64 * MiB <= WS_END, "map P5+");

constexpr int CW_BAR = 4096;

constexpr int RING_BYTES = 131072;
constexpr int LDSCTL_OFF = RING_BYTES, MISC_OFF = LDSCTL_OFF + 320;
constexpr int LDS_BYTES = 147456;
constexpr int NWAVES = 8;

#define LDS_WAIT() asm volatile("s_waitcnt lgkmcnt(0)" ::: "memory")
#define VM_WAIT() asm volatile("s_waitcnt vmcnt(0)" ::: "memory")
#define SBAR() __builtin_amdgcn_sched_barrier(0)
typedef __bf16 bf16x2_t __attribute__((ext_vector_type(2)));
__device__ __forceinline__ unsigned cvt_pk_bf16(float lo, float hi) { const f32x2 v = {lo, hi}; const bf16x2_t b = __builtin_convertvector(v, bf16x2_t); return __builtin_bit_cast(unsigned, b); }
__device__ __forceinline__ float bf_lo(unsigned w) { return __uint_as_float(w << 16); }
__device__ __forceinline__ float bf_hi(unsigned w) { return __uint_as_float(w & 0xffff0000u); }
__device__ __forceinline__ u32x4 pack8(const f32x4 a, const f32x4 b) { u32x4 w; w.x = cvt_pk_bf16(a[0], a[1]); w.y = cvt_pk_bf16(a[2], a[3]); w.z = cvt_pk_bf16(b[0], b[1]); w.w = cvt_pk_bf16(b[2], b[3]); return w; }
__device__ __forceinline__ u32x2 pack4(const f32x4 a) { u32x2 w; w.x = cvt_pk_bf16(a[0], a[1]); w.y = cvt_pk_bf16(a[2], a[3]); return w; }
__device__ __forceinline__ float wave_sum(float v) {
#pragma unroll
    for (int o = 1; o < 64; o <<= 1) v += __shfl_xor(v, o);
    return v;
}
__device__ __forceinline__ float sigmoidf_(float x) { return __builtin_amdgcn_rcpf(1.0f + __builtin_amdgcn_exp2f(-1.4426950408889634f * x)); }
__device__ __forceinline__ int crow(int r, int hi) { return (r & 3) + 8 * (r >> 2) + 4 * hi; }
#define PG8_AUX 0
namespace pg8 {
constexpr int BM = 256, BK = 64, HALF = 128, HTB = HALF * BK * 2  , STAGE_BYTES = 8 * HTB, NXCD = 8, WGM = 8;
__host__ __device__ __forceinline__ int lds_byte(int r, int c) { const int st = (r >> 4) * 2 + (c >> 5), rr = r & 15, cc = c & 31, ob = rr * 64 + cc * 2; return st * 1024 + (ob ^ (((ob >> 9) & 1) << 5)); }
__host__ __device__ __forceinline__ void stage_rc(int b, int& R, int& C) { const int st = b / 1024, sb = b % 1024, swz = sb ^ (((sb >> 9) & 1) << 5); R = (st >> 1) * 16 + swz / 64; C = (st & 1) * 32 + (swz % 64) / 2; }
__host__ __device__ __forceinline__ int perm32(int rho) { const int n = rho >> 4, i = rho & 15; return 8 * (i >> 2) + 4 * n + (i & 3); }

struct Unit { int pm, pn, kind; };

__device__ __forceinline__ void grid_order(int L, int nM, int nN, int& pm, int& pn) {
    const int nwg = nM * nN; int wgid = L;
    { const int q = nwg / NXCD, r = nwg % NXCD, xcd = wgid % NXCD, off = wgid / NXCD; wgid = (xcd < r ? xcd * (q + 1) : r * (q + 1) + (xcd - r) * q) + off; }
    const int nig = WGM * nN, gid = wgid / nig, fm = gid * WGM, gsz = (nM - fm) < WGM ? (nM - fm) : WGM;
    pm = fm + ((wgid % nig) % gsz); pn = (wgid % nig) / gsz;
}

template <class Epi, class Sched>
__device__ __forceinline__ void gemm_phase(LAS unsigned char* lds, const int K, const Sched& S, const Epi& E) {
    const int tid = threadIdx.x, wid = __builtin_amdgcn_readfirstlane(tid >> 6), lane = tid & 63, wr = wid >> 2, wc = wid & 3, fr = lane & 15, fq = lane >> 4;
    const int nt = K / BK;
    unsigned voffA[2], voffB[2];
#pragma unroll
    for (int i = 0; i < 2; ++i) { int R, C; stage_rc(tid * 16 + i * 8192, R, C); const int Rb = Epi::PERM ? ((R & ~31) + perm32(R & 31)) : R;
        voffA[i] = (unsigned)(R * K + C) * 2u; voffB[i] = (unsigned)(Rb * K + C) * 2u; }
    const size_t kstep = (size_t)(BK * 2);
    const size_t hstep = (size_t)HALF * K * 2;
    const unsigned ldsw = (unsigned)wid * 1024u;
    const int aoff = lds_byte(wr * 64 + fr, fq * 8), boff = lds_byte(wc * 32 + fr, fq * 8);
#define PG8_SA(b, h) (((b) * 2 + (h)) * HTB)
#define PG8_SB(b, h) ((4 + (b) * 2 + (h)) * HTB)
#define PG8_STAGE(bufoff, gbase, voff) do { _Pragma("unroll") for (int _i = 0; _i < 2; ++_i) \
        __builtin_amdgcn_global_load_lds((const unsigned*)((const char*)(gbase) + (voff)[_i]), (LAS unsigned*)(lds + (bufoff) + ldsw + _i * 8192), 16, 0, PG8_AUX); } while (0)
#define PG8_LDA(dst, b, h) do { _Pragma("unroll") for (int m = 0; m < 4; ++m) _Pragma("unroll") for (int k = 0; k < 2; ++k) dst[m][k] = *(const LAS bf16x8*)(lds + PG8_SA(b, h) + aoff + m * 2048 + k * 1024); } while (0)
#define PG8_LDB(dst, b, h) do { _Pragma("unroll") for (int n = 0; n < 2; ++n) _Pragma("unroll") for (int k = 0; k < 2; ++k) dst[n][k] = *(const LAS bf16x8*)(lds + PG8_SB(b, h) + boff + n * 2048 + k * 1024); } while (0)
#define PG8_MMA(ai, bj, At, Bt) do { __builtin_amdgcn_s_setprio(1); _Pragma("unroll") for (int m = 0; m < 4; ++m) _Pragma("unroll") for (int n = 0; n < 2; ++n) _Pragma("unroll") for (int k = 0; k < 2; ++k) \
        acc[ai][bj][m][n] = __builtin_amdgcn_mfma_f32_16x16x32_bf16(Bt[n][k], At[m][k], acc[ai][bj][m][n], 0, 0, 0); __builtin_amdgcn_s_setprio(0); } while (0)
#define PG8_WAIT_V(n) asm volatile("s_waitcnt vmcnt(" #n ")" ::: "memory")
#define PG8_WAIT_L(n) asm volatile("s_waitcnt lgkmcnt(" #n ")" ::: "memory")
#define PG8_BAR __builtin_amdgcn_s_barrier()
#define PG8_SCHED __builtin_amdgcn_sched_barrier(0)
    Unit cur, nxt; int ui = 0;
    if (!S.next(0, cur)) return;
    f32x4 acc[2][2][4][2];
#pragma unroll
    for (int a = 0; a < 2; ++a)
#pragma unroll
        for (int b = 0; b < 2; ++b)
#pragma unroll
            for (int m = 0; m < 4; ++m)
#pragma unroll
                for (int n = 0; n < 2; ++n) acc[a][b][m][n] = (f32x4){0.f, 0.f, 0.f, 0.f};
    bf16x8 At[4][2], B0[2][2], B1[2][2];
    const char* cA = S.pa(cur); const char* cB = S.pb(cur);
    PG8_STAGE(PG8_SB(0, 0), cB, voffB); PG8_STAGE(PG8_SB(0, 1), cB + hstep, voffB); PG8_STAGE(PG8_SA(0, 0), cA, voffA); PG8_STAGE(PG8_SA(0, 1), cA + hstep, voffA);
    if (wr == 1) PG8_BAR;
    PG8_WAIT_V(2); PG8_BAR;
    PG8_STAGE(PG8_SB(1, 0), cB + kstep, voffB); PG8_STAGE(PG8_SA(1, 0), cA + kstep, voffA); PG8_STAGE(PG8_SB(1, 1), cB + hstep + kstep, voffB);
    PG8_WAIT_V(6); PG8_BAR;
    for (;;) {
        const bool has_next = S.next(ui + 1, nxt);
        const char* nA = has_next ? S.pa(nxt) : cA; const char* nB = has_next ? S.pb(nxt) : cB;
        for (int t = 0; t < nt; t += 2) {
            const bool last = (t == nt - 2);
            const char* a1 = cA + (size_t)(t + 1) * kstep;
            const char* a2 = last ? nA : cA + (size_t)(t + 2) * kstep; const char* b2 = last ? nB : cB + (size_t)(t + 2) * kstep;
            const char* a3 = a2 + kstep; const char* b3 = b2 + kstep;
            PG8_LDB(B0, 0, 0); PG8_LDB(B1, 0, 1); PG8_SCHED; PG8_LDA(At, 0, 0); PG8_STAGE(PG8_SA(1, 1), a1 + hstep, voffA);
            PG8_WAIT_V(8); PG8_WAIT_L(0); PG8_BAR; PG8_MMA(0, 0, At, B0); PG8_MMA(0, 1, At, B1); PG8_BAR; PG8_SCHED;
            PG8_LDA(At, 0, 1); PG8_STAGE(PG8_SB(0, 0), b2, voffB); PG8_STAGE(PG8_SB(0, 1), b2 + hstep, voffB); PG8_STAGE(PG8_SA(0, 0), a2, voffA);
            PG8_WAIT_V(8); PG8_WAIT_L(0); PG8_BAR; PG8_MMA(1, 0, At, B0); PG8_MMA(1, 1, At, B1); PG8_BAR; PG8_SCHED;
            PG8_LDB(B0, 1, 0); PG8_LDB(B1, 1, 1); PG8_SCHED; PG8_LDA(At, 1, 0); PG8_STAGE(PG8_SA(0, 1), a2 + hstep, voffA);
            PG8_WAIT_V(8); PG8_WAIT_L(0); PG8_BAR; PG8_MMA(0, 0, At, B0); PG8_MMA(0, 1, At, B1); PG8_BAR; PG8_SCHED;
            PG8_LDA(At, 1, 1); PG8_STAGE(PG8_SB(1, 0), b3, voffB); PG8_STAGE(PG8_SB(1, 1), b3 + hstep, voffB); PG8_STAGE(PG8_SA(1, 0), a3, voffA);
            PG8_WAIT_V(8); PG8_WAIT_L(0); PG8_BAR; PG8_MMA(1, 0, At, B0); PG8_MMA(1, 1, At, B1); PG8_BAR; PG8_SCHED;
        }
        if (wr == 0) PG8_BAR;
        if constexpr (Epi::HAS_PRE) {
            E.pre(cur, (LAS float*)(lds + STAGE_BYTES + 1024), tid); PG8_WAIT_L(0); PG8_BAR; }
        E(acc, cur, wr, wc, fr, fq, (const LAS float*)(lds + STAGE_BYTES + 1024));
        if (!has_next) break;
#pragma unroll
        for (int a = 0; a < 2; ++a)
#pragma unroll
            for (int b = 0; b < 2; ++b)
#pragma unroll
                for (int m = 0; m < 4; ++m)
#pragma unroll
                    for (int n = 0; n < 2; ++n) acc[a][b][m][n] = (f32x4){0.f, 0.f, 0.f, 0.f};
        cur = nxt; cA = nA; cB = nB; ++ui;
        if (wr == 1) PG8_BAR;
    }
    PG8_WAIT_V(0);
    PG8_BAR;
#undef PG8_SA
#undef PG8_SB
#undef PG8_STAGE
#undef PG8_LDA
#undef PG8_LDB
#undef PG8_MMA
#undef PG8_WAIT_V
#undef PG8_WAIT_L
#undef PG8_BAR
#undef PG8_SCHED
}
}
typedef GAS unsigned gu32;
#define RLX_AGENT __ATOMIC_RELAXED, __HIP_MEMORY_SCOPE_AGENT
#define XB_TMO      128
#define XB_XCNT(j)  (256  + 64 * (j))
#define XB_XSUB(j)  (1280 + 64 * (j))
#define XB_XGEN(j)  (2304 + 64 * (j))
#define XB_TOP      3328
#define XB_TOPGEN   3392
#define XCD_BAR_WORDS 3456
#define XB_SPIN_CAP (1u << 18)
__device__ __forceinline__ unsigned xb_ld(unsigned* p)              { return __hip_atomic_load(p, __ATOMIC_RELAXED, __HIP_MEMORY_SCOPE_AGENT); }
__device__ __forceinline__ unsigned xb_add(unsigned* p, unsigned v) { return __hip_atomic_fetch_add(p, v, __ATOMIC_RELAXED, __HIP_MEMORY_SCOPE_AGENT); }
__device__ __forceinline__ unsigned xb_xcc_id() { return (unsigned)__builtin_amdgcn_s_getreg((3 << 11) | 20) & 0xFu; }
#define XB_SPIN(cond, bar) do { unsigned _sp = 0; while (cond) { __builtin_amdgcn_s_sleep(1); \
    if ((++_sp & 255u) == 0u) { if (xb_ld(&(bar)[XB_TMO])) break; if (_sp > XB_SPIN_CAP) { atomicAdd(&(bar)[XB_TMO], 1u); break; } } } } while (0)
struct XcdBarrier { unsigned* bar; unsigned x; volatile LAS unsigned* st; };
__device__ __forceinline__ XcdBarrier xcd_barrier_post(unsigned* bar, volatile LAS unsigned* st) {
    XcdBarrier b; b.bar = bar; b.x = xb_xcc_id(); b.st = st;
    if (threadIdx.x == 0) (void)xb_add(&bar[XB_XCNT(b.x)], 1u);
    return b;
}
__device__ __forceinline__ void xcd_barrier_complete(unsigned* bar, unsigned x, unsigned& nloc, unsigned& nx) {
    const unsigned G = gridDim.x * gridDim.y * gridDim.z;
    unsigned sum, cnt, mine, sp = 0u;
    for (;;) {
        sum = 0u; cnt = 0u; mine = 0u;
#pragma unroll
        for (unsigned j = 0; j < 16; ++j) { const unsigned c = xb_ld(&bar[XB_XCNT(j)]); sum += c; cnt += (c > 0u) ? 1u : 0u; mine = (j == x) ? c : mine; }
        if (sum == G) break;
        __builtin_amdgcn_s_sleep(1);
        if ((++sp & 255u) == 0u) { if (xb_ld(&bar[XB_TMO])) break; if (sp > XB_SPIN_CAP) { atomicAdd(&bar[XB_TMO], 1u); break; } }
    }
    nloc = mine > 0u ? mine : 1u; nx = cnt > 0u ? cnt : 1u;
}
__device__ __forceinline__ void xcd_barrier(const XcdBarrier& b) {
    asm volatile("s_waitcnt vmcnt(0)" ::: "memory");
    __syncthreads();
    if (threadIdx.x == 0) {
        unsigned* bar = b.bar;
        __builtin_amdgcn_s_waitcnt(0);
        unsigned nloc = b.st[0], nx = b.st[1];
        if (nloc == 0u) { xcd_barrier_complete(bar, b.x, nloc, nx); b.st[0] = nloc; b.st[1] = nx; }
        const unsigned old = xb_add(&bar[XB_XSUB(b.x)], 1u);
        const unsigned gen = old / nloc;
        if (old + 1u == (gen + 1u) * nloc) {
            __builtin_amdgcn_fence(__ATOMIC_RELEASE, "agent");
            asm volatile("s_waitcnt vmcnt(0)" ::: "memory");
            const unsigned og = xb_add(&bar[XB_TOP], 1u);
            const unsigned tg = og / nx;
            if (og + 1u == (tg + 1u) * nx) xb_add(&bar[XB_TOPGEN], 1u);
            else XB_SPIN(xb_ld(&bar[XB_TOPGEN]) == tg, bar);
            __builtin_amdgcn_fence(__ATOMIC_ACQUIRE, "agent");
            xb_add(&bar[XB_XGEN(b.x)], 1u);
            asm volatile("s_waitcnt vmcnt(0)" ::: "memory");
        } else {
            XB_SPIN(xb_ld(&bar[XB_XGEN(b.x)]) == gen, bar);
            __builtin_amdgcn_fence(__ATOMIC_ACQUIRE, "agent");
            asm volatile("s_waitcnt vmcnt(0)" ::: "memory");
        }
    }
    __syncthreads();
}
struct Frame {
    LAS unsigned char* lds;
    volatile LAS unsigned* MISC;
    unsigned char* ws;
    int tid, lane, wave;
    int vcu, G;
    const float* in[19];
    float* out;
};
#define WSP(T, off) ((T*)(F.ws + (off)))

__device__ __forceinline__ void p0_transpose_item(const float* W, int K, int N, int k0, int n0, bf16_t* WT, int drow, bool rope, const float* gain, LAS float* scr, int lane) {
#pragma unroll 8
    for (int i = 0; i < 32; ++i) { const int kk = 2 * i + (lane >> 5); float w = W[(size_t)(k0 + kk) * N + n0 + (lane & 31)]; if (gain) w *= gain[k0 + kk]; scr[kk * 33 + (lane & 31)] = w; }
    LDS_WAIT(); asm volatile("" ::: "memory");
    const int c = lane & 7;
#pragma unroll
    for (int j = 0; j < 4; ++j) { const int n = (lane >> 3) + 8 * j; const LAS float* s = scr + (8 * c) * 33 + n;
        u32x4 o; o.x = cvt_pk_bf16(s[0 * 33], s[1 * 33]); o.y = cvt_pk_bf16(s[2 * 33], s[3 * 33]); o.z = cvt_pk_bf16(s[4 * 33], s[5 * 33]); o.w = cvt_pk_bf16(s[6 * 33], s[7 * 33]);
        const int dr = drow + (rope ? (8 * (n >> 2) + (n & 3)) : n);
        *(GAS u32x4*)(WT + (size_t)dr * K + k0 + 8 * c) = o; }
    LDS_WAIT(); asm volatile("" ::: "memory");
}
__device__ __forceinline__ void rms_row_to_bf16(const float* xrow, const float* g, bf16_t* orow, int lane) {
    const GAS f32x4* xr = (const GAS f32x4*)xrow + lane; const GAS f32x4* gr = (const GAS f32x4*)g + lane;
    f32x4 v[8]; float s = 0.f;
#pragma unroll
    for (int j = 0; j < 8; ++j) { v[j] = xr[64 * j]; s += (v[j].x * v[j].x + v[j].y * v[j].y) + (v[j].z * v[j].z + v[j].w * v[j].w); }
    const float rstd = 1.0f / sqrtf(wave_sum(s) * (1.f / DM) + NORM_EPS);
    GAS u32x2* o8 = (GAS u32x2*)orow + lane;
#pragma unroll
    for (int j = 0; j < 8; ++j) { const f32x4 gg = gr[64 * j]; o8[64 * j] = pack4((v[j] * rstd) * gg); }
}
__device__ __forceinline__ void p0_prologue(Frame& F) {
    LAS float* scr = (LAS float*)(F.lds + F.wave * 16384);
    const int gw = F.vcu * NWAVES + F.wave, NGW = F.G * NWAVES, lane = F.lane;
    bf16_t* WIN = WSP(bf16_t, WS_WIN); bf16_t* WVT = WSP(bf16_t, WS_WVT);
    constexpr int I_IN = 32 * 258, I_UQ = 8 * 96, I_UKV = 8 * 128, I_NA = 16 * 64, I_MLA = 32 * 64, I_OUT = 32 * 64;
    constexpr int NITEMS = I_IN + I_UQ + I_UKV + I_NA + I_MLA + I_OUT;
    for (int it = gw; it < NITEMS; it += NGW) {
        int r = it;
        if (r < I_IN) { const int kb = r / 258, sb = r % 258, n0 = 32 * sb, k0 = 64 * kb; const float* W = F.in[3];
            bf16_t* dst = WIN; int drow; bool rope = false;
            if (n0 < 1024) drow = C_NAQ + n0;
            else if (n0 < 2048) drow = C_NAK + (n0 - 1024);
            else if (n0 < 3072) { dst = WVT; drow = n0 - 2048; }
            else if (n0 < 3584) drow = C_CQ + (n0 - 3072);
            else if (n0 < 4096) drow = C_CKV + (n0 - 3584);
            else if (n0 < 4160) { drow = C_KR + ((n0 - 4096) ? 4 : 0); rope = true; }
            else if (n0 < 6208) drow = C_GA + (n0 - 4160);
            else drow = C_GB + (n0 - 6208);
            p0_transpose_item(W, 2048, 8256, k0, n0, dst, drow, rope, nullptr, scr, lane); continue; } r -= I_IN;
        if (r < I_UQ) { const int kb = r / 96, sb = r % 96, n0 = 32 * sb, k0 = 64 * kb; const int hd = n0 / 192, w = n0 % 192;
            int drow = n0; bool rope = false; if (w >= 128) { rope = true; drow = hd * 192 + 128 + ((w - 128) ? 4 : 0); }
            p0_transpose_item(F.in[7], 512, 3072, k0, n0, WSP(bf16_t, WS_WUQ), drow, rope, F.in[6], scr, lane); continue; } r -= I_UQ;
        if (r < I_UKV) { const int kb = r / 128, sb = r % 128; p0_transpose_item(F.in[9], 512, 4096, 64 * kb, 32 * sb, WSP(bf16_t, WS_WUKV), 32 * sb, false, F.in[8], scr, lane); continue; } r -= I_UKV;
        if (r < I_NA) { const int kb = r / 64, sb = r % 64; p0_transpose_item(F.in[10], 1024, 2048, 64 * kb, 32 * sb, WSP(bf16_t, WS_WNA), 32 * sb, false, nullptr, scr, lane); continue; } r -= I_NA;
        if (r < I_MLA) { const int kb = r / 64, sb = r % 64; p0_transpose_item(F.in[11], 2048, 2048, 64 * kb, 32 * sb, WSP(bf16_t, WS_WMLA), 32 * sb, false, nullptr, scr, lane); continue; } r -= I_MLA;
        { const int kb = r / 64, sb = r % 64; p0_transpose_item(F.in[12], 2048, 2048, 64 * kb, 32 * sb, WSP(bf16_t, WS_WOUT), 32 * sb, false, nullptr, scr, lane); }
    }
    { GAS u32x4* z = (GAS u32x4*)(WIN + (size_t)(C_KR + 64) * 2048); const int n16 = (NMAIN - C_KR - 64) * 2048 * 2 / 16;
      for (int i = F.vcu * 512 + F.tid; i < n16; i += F.G * 512) z[i] = (u32x4){0u, 0u, 0u, 0u}; }
    { bf16_t* HN1 = WSP(bf16_t, WS_HN1);
      for (int m = gw; m < MREAL + NMETA; m += NGW) {
          const float* src = (m < MREAL) ? F.in[0] + (size_t)m * DM : F.in[1] + (size_t)(m - MREAL) * DM;
          rms_row_to_bf16(src, F.in[2], HN1 + (size_t)m * DM, lane); }
      GAS u32x4* z = (GAS u32x4*)(HN1 + (size_t)(MREAL + NMETA) * DM); const int n16 = (MPAD - MREAL - NMETA) * DM * 2 / 16;
      for (int i = F.vcu * 512 + F.tid; i < n16; i += F.G * 512) z[i] = (u32x4){0u, 0u, 0u, 0u}; }
    { float* ct = WSP(float, WS_COS); float* st = WSP(float, WS_SIN);
      for (int i = F.vcu * 512 + F.tid; i < NPOS * 32; i += F.G * 512) { const int p = i >> 5, j = i & 31;
          const float inv = __builtin_powf(10000.0f, -(float)(2 * j) / 64.0f); const float ang = (float)p * inv;
          double r = (double)ang * 0.15915494309189535; r -= __builtin_rint(r); const float rf = (float)r;
          ct[i] = __builtin_amdgcn_cosf(rf); st[i] = __builtin_amdgcn_sinf(rf); } }
    { const float* SK = F.in[15]; const float* WQ = F.in[14]; const float* g2 = F.in[13]; bf16_t* WSCp = WSP(bf16_t, WS_WSC);
      const int l15 = lane & 15, l4 = lane >> 4;
      for (int task = gw; task < 2048; task += NGW) { const int g = task >> 7, nt = (task >> 4) & 7, kc = task & 15, n0 = nt * 16;
          bf16x8 bfr[4];
#pragma unroll
          for (int kk = 0; kk < 4; ++kk) { const float* p = SK + ((size_t)g * 128 + n0 + l15) * 128 + 32 * kk + 8 * l4; const f32x4 a = *(const GAS f32x4*)p, b = *(const GAS f32x4*)(p + 4);
              const u32x4 w = pack8(a, b); bfr[kk] = __builtin_bit_cast(bf16x8, w); }
          for (int kt = 0; kt < 8; ++kt) { const int k0 = (kc * 8 + kt) * 16; f32x4 acc = (f32x4){0.f, 0.f, 0.f, 0.f};
#pragma unroll
              for (int kk = 0; kk < 4; ++kk) { const float* p = WQ + (size_t)(k0 + l15) * 2048 + g * 128 + 32 * kk + 8 * l4; const f32x4 a = *(const GAS f32x4*)p, b = *(const GAS f32x4*)(p + 4);
                  const u32x4 w = pack8(a, b); acc = __builtin_amdgcn_mfma_f32_16x16x32_bf16(__builtin_bit_cast(bf16x8, w), bfr[kk], acc, 0, 0, 0); }
              const f32x4 gg = *(const GAS f32x4*)(g2 + k0 + 4 * l4);
              *(GAS u32x2*)(WSCp + (size_t)(g * 128 + n0 + l15) * 2048 + k0 + 4 * l4) = pack4(acc * gg); } } }
}
using pg8::Unit;
struct SchedGrid {
    int G, c, nM, nN; const char* A; const char* B; size_t tstep;
    __device__ __forceinline__ bool next(int i, Unit& u) const { const int L = i * G + c; if (L >= nM * nN) return false; pg8::grid_order(L, nM, nN, u.pm, u.pn); u.kind = 0; return true; }
    __device__ __forceinline__ const char* pa(const Unit& u) const { return A + (size_t)u.pm * tstep; }
    __device__ __forceinline__ const char* pb(const Unit& u) const { return B + (size_t)u.pn * tstep; }
};
constexpr int P1_MAIN = 64 * 29, P1_VT = 4 * 65, P1_META = 7, P1_UNITS = P1_MAIN + P1_VT + P1_META;
struct SchedP1 {
    int G, c; const char* hn1; const char* win; const char* wvt; size_t tstep;
    __device__ __forceinline__ bool next(int i, Unit& u) const {
        const int L = i * G + c; if (L >= P1_UNITS) return false;
        if (L < P1_MAIN) { pg8::grid_order(L, 64, 29, u.pm, u.pn); u.kind = 0; }
        else if (L < P1_MAIN + P1_VT) { const int idx = L - P1_MAIN; u.pm = idx & 3; u.pn = idx >> 2; u.kind = 1; }
        else { const int idx = L - P1_MAIN - P1_VT; u.pm = 64; u.pn = idx < 4 ? 4 + idx : (idx < 6 ? 10 + (idx - 4) : 28); u.kind = 0; }
        return true; }
    __device__ __forceinline__ const char* pa(const Unit& u) const { return (u.kind == 1 ? wvt : hn1) + (size_t)u.pm * tstep; }
    __device__ __forceinline__ const char* pb(const Unit& u) const { return (u.kind == 1 ? hn1 : win) + (size_t)u.pn * tstep; }
};
__device__ __forceinline__ void rope4(const f32x4 x1, const f32x4 x2, const float* cosT, const float* sinT, int pos, int j0, f32x4& lo, f32x4& hi) {
    const f32x4 c = *(const GAS f32x4*)(cosT + pos * 32 + j0), s = *(const GAS f32x4*)(sinT + pos * 32 + j0);
    lo = x1 * c - x2 * s; hi = x2 * c + x1 * s;
}
struct EpiP1 {
    static constexpr bool PERM = true, HAS_PRE = false;
    bf16_t *naq, *nak, *vt, *cq, *ckv, *kr, *ga, *gb; float *ssq_q, *ssq_kv; const float *cosT, *sinT;
    __device__ __forceinline__ void operator()(const f32x4 (&acc)[2][2][4][2], const Unit& u, int wr, int wc, int fr, int fq, const LAS float* rowsc) const {
        const int row0 = u.pm * 256 + wr * 64 + fr, colu = wc * 32 + 8 * fq;
        if (u.kind == 1) {
#pragma unroll
            for (int ai = 0; ai < 2; ++ai)
#pragma unroll
                for (int m = 0; m < 4; ++m) { bf16_t* rp = vt + (size_t)(row0 + ai * 128 + m * 16) * VT_PITCH + u.pn * 256 + colu;
#pragma unroll
                    for (int bj = 0; bj < 2; ++bj) *(GAS u32x4*)(rp + bj * 128) = pack8(acc[ai][bj][m][0], acc[ai][bj][m][1]); }
            return; }
        const int pn = u.pn;
        if (pn == 28) {
            if (wc < 2) { const int j0 = 4 * (4 * wc + fq);
#pragma unroll
                for (int ai = 0; ai < 2; ++ai)
#pragma unroll
                    for (int m = 0; m < 4; ++m) { const int row = row0 + ai * 128 + m * 16; const int pos = row < MREAL ? NMETA + (row & (SEQ - 1)) : row - MREAL;
                        f32x4 lo, hi; rope4(acc[ai][0][m][0], acc[ai][0][m][1], cosT, sinT, pos, j0, lo, hi);
                        *(GAS u32x2*)(kr + (size_t)row * 64 + j0) = pack4(lo); *(GAS u32x2*)(kr + (size_t)row * 64 + 32 + j0) = pack4(hi); } }
            return; }
        if (pn >= 12) {
            bf16_t* base = pn < 20 ? ga : gb; const int colt = (pn < 20 ? pn - 12 : pn - 20) * 256 + colu;
#pragma unroll
            for (int ai = 0; ai < 2; ++ai)
#pragma unroll
                for (int m = 0; m < 4; ++m) { bf16_t* rp = base + (size_t)(row0 + ai * 128 + m * 16) * 2048 + colt;
#pragma unroll
                    for (int bj = 0; bj < 2; ++bj) { f32x4 a = acc[ai][bj][m][0], b = acc[ai][bj][m][1];
#pragma unroll
                        for (int i = 0; i < 4; ++i) { a[i] = sigmoidf_(a[i]); b[i] = sigmoidf_(b[i]); }
                        *(GAS u32x4*)(rp + bj * 128) = pack8(a, b); } }
            return; }
        if (pn >= 8) {
            const bool isq = pn < 10; bf16_t* base = isq ? cq : ckv; float* ssq = isq ? ssq_q : ssq_kv; const int colt = (isq ? pn - 8 : pn - 10) * 256 + colu;
#pragma unroll
            for (int ai = 0; ai < 2; ++ai)
#pragma unroll
                for (int m = 0; m < 4; ++m) { const int row = row0 + ai * 128 + m * 16; bf16_t* rp = base + (size_t)row * 512 + colt; float s = 0.f;
#pragma unroll
                    for (int bj = 0; bj < 2; ++bj) { const f32x4 a = acc[ai][bj][m][0], b = acc[ai][bj][m][1];
                        s += (a[0] * a[0] + a[1] * a[1]) + (a[2] * a[2] + a[3] * a[3]) + (b[0] * b[0] + b[1] * b[1]) + (b[2] * b[2] + b[3] * b[3]);
                        *(GAS u32x4*)(rp + bj * 128) = pack8(a, b); }
                    s += __shfl_xor(s, 16); s += __shfl_xor(s, 32);
                    if (fq == 0) ssq[(size_t)((pn & 1) * 4 + wc) * MPAD + row] = s; }
            return; }
        {
            bf16_t* base = pn < 4 ? naq : nak; const int colt = (pn & 3) * 256 + colu;
#pragma unroll
            for (int ai = 0; ai < 2; ++ai)
#pragma unroll
                for (int m = 0; m < 4; ++m) { bf16_t* rp = base + (size_t)(row0 + ai * 128 + m * 16) * 1024 + colt;
#pragma unroll
                    for (int bj = 0; bj < 2; ++bj) *(GAS u32x4*)(rp + bj * 128) = pack8(acc[ai][bj][m][0], acc[ai][bj][m][1]); }
        }
    }
};
constexpr int P3_Q = 64 * 12, P3_KV = 65 * 16, P3_UNITS = P3_Q + P3_KV;
struct SchedP3 {
    int G, c; const char* cq; const char* ckv; const char* wuq; const char* wukv; size_t tstep;
    __device__ __forceinline__ bool next(int i, Unit& u) const {
        const int L = i * G + c; if (L >= P3_UNITS) return false;
        if (L < P3_Q) { pg8::grid_order(L, 64, 12, u.pm, u.pn); u.kind = 0; } else { pg8::grid_order(L - P3_Q, 65, 16, u.pm, u.pn); u.kind = 1; }
        return true; }
    __device__ __forceinline__ const char* pa(const Unit& u) const { return (u.kind ? ckv : cq) + (size_t)u.pm * tstep; }
    __device__ __forceinline__ const char* pb(const Unit& u) const { return (u.kind ? wukv : wuq) + (size_t)u.pn * tstep; }
};
template <int NS, int LD> __device__ __forceinline__ float rstd_slabs(const float* part, int row, float invn) {
    float s = 0.f;
#pragma unroll
    for (int i = 0; i < NS; ++i) s += part[(size_t)i * LD + row];
    return 1.0f / sqrtf(s * invn + NORM_EPS);
}
struct EpiP3 {
    static constexpr bool PERM = true, HAS_PRE = true;
    bf16_t *qm, *kn, *vv; const float *ssq_q, *ssq_kv; const float *cosT, *sinT;
    __device__ __forceinline__ void pre(const Unit& u, LAS float* sc, int tid) const { if (tid < 256) { const int row = u.pm * 256 + tid; sc[tid] = u.kind ? rstd_slabs<8, MPAD>(ssq_kv, row, 1.f / 512.f) : rstd_slabs<8, MPAD>(ssq_q, row, 1.f / 512.f); } }
    __device__ __forceinline__ void operator()(const f32x4 (&acc)[2][2][4][2], const Unit& u, int wr, int wc, int fr, int fq, const LAS float* rowsc) const {
        const int row0 = u.pm * 256 + wr * 64 + fr, colu = wc * 32 + 8 * fq;
        if (u.kind == 1) {
#pragma unroll
            for (int ai = 0; ai < 2; ++ai)
#pragma unroll
                for (int m = 0; m < 4; ++m) { const int row = row0 + ai * 128 + m * 16; const float rs = rowsc[ai * 128 + wr * 64 + m * 16 + fr];
                    const size_t off = (size_t)row * 2048 + u.pn * 128 + colu;
                    *(GAS u32x4*)(kn + off) = pack8(acc[ai][0][m][0] * rs, acc[ai][0][m][1] * rs);
                    *(GAS u32x4*)(vv + off) = pack8(acc[ai][1][m][0] * rs, acc[ai][1][m][1] * rs); }
            return; }
#pragma unroll
        for (int bj = 0; bj < 2; ++bj) { const int c8 = u.pn * 256 + bj * 128 + colu; const int hd = c8 / 192, w = c8 - hd * 192;
            if (w < 128) {
#pragma unroll
                for (int ai = 0; ai < 2; ++ai)
#pragma unroll
                    for (int m = 0; m < 4; ++m) { const int row = row0 + ai * 128 + m * 16; const float rs = rowsc[ai * 128 + wr * 64 + m * 16 + fr];
                        *(GAS u32x4*)(qm + (size_t)row * 3072 + c8) = pack8(acc[ai][bj][m][0] * rs, acc[ai][bj][m][1] * rs); }
            } else { const int j0 = (w - 128) >> 1;
#pragma unroll
                for (int ai = 0; ai < 2; ++ai)
#pragma unroll
                    for (int m = 0; m < 4; ++m) { const int row = row0 + ai * 128 + m * 16; const float rs = rowsc[ai * 128 + wr * 64 + m * 16 + fr];
                        const int pos = NMETA + (row & (SEQ - 1)); f32x4 lo, hi; rope4(acc[ai][bj][m][0] * rs, acc[ai][bj][m][1] * rs, cosT, sinT, pos, j0, lo, hi);
                        bf16_t* qp = qm + (size_t)row * 3072 + hd * 192 + 128 + j0; *(GAS u32x2*)qp = pack4(lo); *(GAS u32x2*)(qp + 32) = pack4(hi); }
            } }
    }
};
__device__ __forceinline__ void unpack8(const u32x4 w, f32x4& a, f32x4& b) { a = (f32x4){bf_lo(w.x), bf_hi(w.x), bf_lo(w.y), bf_hi(w.y)}; b = (f32x4){bf_lo(w.z), bf_hi(w.z), bf_lo(w.w), bf_hi(w.w)}; }
struct EpiP5a {
    static constexpr bool PERM = true, HAS_PRE = false;
    const bf16_t* ga; bf16_t* t1;
    __device__ __forceinline__ void operator()(const f32x4 (&acc)[2][2][4][2], const Unit& u, int wr, int wc, int fr, int fq, const LAS float* rowsc) const {
        const int row0 = u.pm * 256 + wr * 64 + fr, col0 = u.pn * 256 + wc * 32 + 8 * fq;
#pragma unroll
        for (int ai = 0; ai < 2; ++ai)
#pragma unroll
            for (int m = 0; m < 4; ++m) { const size_t off = (size_t)(row0 + ai * 128 + m * 16) * 2048 + col0;
#pragma unroll
                for (int bj = 0; bj < 2; ++bj) { f32x4 g0, g1; unpack8(*(const GAS u32x4*)(ga + off + bj * 128), g0, g1);
                    *(GAS u32x4*)(t1 + off + bj * 128) = pack8(acc[ai][bj][m][0] * g0, acc[ai][bj][m][1] * g1); } }
    }
};
struct EpiP5b {
    static constexpr bool PERM = true, HAS_PRE = false;
    const bf16_t* gb; const bf16_t* t1; bf16_t* merged;
    __device__ __forceinline__ void operator()(const f32x4 (&acc)[2][2][4][2], const Unit& u, int wr, int wc, int fr, int fq, const LAS float* rowsc) const {
        const int row0 = u.pm * 256 + wr * 64 + fr, col0 = u.pn * 256 + wc * 32 + 8 * fq;
#pragma unroll
        for (int ai = 0; ai < 2; ++ai)
#pragma unroll
            for (int m = 0; m < 4; ++m) { const size_t off = (size_t)(row0 + ai * 128 + m * 16) * 2048 + col0;
#pragma unroll
                for (int bj = 0; bj < 2; ++bj) { f32x4 g0, g1; unpack8(*(const GAS u32x4*)(gb + off + bj * 128), g0, g1);
                    f32x4 a, b; unpack8(*(const GAS u32x4*)(t1 + off + bj * 128), a, b);
                    *(GAS u32x4*)(merged + off + bj * 128) = pack8(a + acc[ai][bj][m][0] * g0, b + acc[ai][bj][m][1] * g1); } }
    }
};
struct EpiP6 {
    static constexpr bool PERM = true, HAS_PRE = false;
    const float* x; float* h2; bf16_t* h2b; float* ssq2;
    __device__ __forceinline__ void operator()(const f32x4 (&acc)[2][2][4][2], const Unit& u, int wr, int wc, int fr, int fq, const LAS float* rowsc) const {
        const int row0 = u.pm * 256 + wr * 64 + fr, col0 = u.pn * 256 + wc * 32 + 8 * fq;
#pragma unroll
        for (int ai = 0; ai < 2; ++ai)
#pragma unroll
            for (int m = 0; m < 4; ++m) { const int row = row0 + ai * 128 + m * 16; const size_t off = (size_t)row * 2048 + col0; float s = 0.f;
#pragma unroll
                for (int bj = 0; bj < 2; ++bj) { const f32x4 a = *(const GAS f32x4*)(x + off + bj * 128) + acc[ai][bj][m][0], b = *(const GAS f32x4*)(x + off + bj * 128 + 4) + acc[ai][bj][m][1];
                    s += (a[0] * a[0] + a[1] * a[1]) + (a[2] * a[2] + a[3] * a[3]) + (b[0] * b[0] + b[1] * b[1]) + (b[2] * b[2] + b[3] * b[3]);
                    *(GAS f32x4*)(h2 + off + bj * 128) = a; *(GAS f32x4*)(h2 + off + bj * 128 + 4) = b; *(GAS u32x4*)(h2b + off + bj * 128) = pack8(a, b); }
                s += __shfl_xor(s, 16); s += __shfl_xor(s, 32);
                if (fq == 0) ssq2[(size_t)(u.pn * 4 + wc) * MREAL + row] = s; }
    }
};
struct EpiP7 {
    static constexpr bool PERM = false, HAS_PRE = true;
    const float* ssq2; float* sc;
    __device__ __forceinline__ void pre(const Unit& u, LAS float* sc, int tid) const { if (tid < 256) sc[tid] = rstd_slabs<32, MREAL>(ssq2, u.pm * 256 + tid, 1.f / 2048.f); }
    __device__ __forceinline__ void operator()(const f32x4 (&acc)[2][2][4][2], const Unit& u, int wr, int wc, int fr, int fq, const LAS float* rowsc) const {
        const int row0 = u.pm * 256 + wr * 64 + fr, col0 = u.pn * 256 + wc * 32 + 4 * fq;
#pragma unroll
        for (int ai = 0; ai < 2; ++ai)
#pragma unroll
            for (int m = 0; m < 4; ++m) { const int row = row0 + ai * 128 + m * 16; const float rs = rowsc[ai * 128 + wr * 64 + m * 16 + fr]; const size_t off = (size_t)row * 2048 + col0;
#pragma unroll
                for (int bj = 0; bj < 2; ++bj)
#pragma unroll
                    for (int n = 0; n < 2; ++n) *(GAS f32x4*)(sc + off + bj * 128 + n * 16) = acc[ai][bj][m][n] * rs; }
    }
};
namespace att {
#define KSWZ(row, colB) ((row) * 256 + ((colB) ^ (((row) & 7) << 4)))
#define KRSWZ(row, colB) ((row) * 128 + ((colB) ^ ((((row) >> 1) & 7) << 4)))
constexpr float L2E = 1.4426950408889634f;
template <int DUMMY = 0>
__device__ __forceinline__ void partialSM(f32x16& p0, f32x16& p1, float& m_reg, float& mn, float& alpha, const float C, const float THRS) {
  float pmax = p0[0];
#pragma unroll
  for (int r = 1; r < 16; ++r) pmax = fmaxf(pmax, p0[r]);
#pragma unroll
  for (int r = 0; r < 16; ++r) pmax = fmaxf(pmax, p1[r]);
  { auto rr = __builtin_amdgcn_permlane32_swap(__float_as_uint(pmax), __float_as_uint(pmax), false, false);
    pmax = fmaxf(__uint_as_float(rr[0]), __uint_as_float(rr[1])); }
  if (__builtin_expect(__all(pmax - m_reg <= THRS), 1)) { mn = m_reg; alpha = 1.f; }
  else { mn = fmaxf(m_reg, pmax); alpha = __builtin_amdgcn_exp2f((m_reg - mn) * C); m_reg = mn; }
  const float mnC = -mn * C;
#pragma unroll
  for (int r = 0; r < 16; ++r) p0[r] = fmaf(p0[r], C, mnC);
#pragma unroll
  for (int r = 0; r < 16; ++r) p1[r] = fmaf(p1[r], C, mnC);
#pragma unroll
  for (int r = 0; r < 16; ++r) p0[r] = __builtin_amdgcn_exp2f(p0[r]);
}
__device__ __forceinline__ void finishSM(f32x16& p0, f32x16& p1, float alpha, float& l_reg, bf16x8& pa0, bf16x8& pa1, bf16x8& pa2, bf16x8& pa3) {
#pragma unroll
  for (int r = 0; r < 16; ++r) p1[r] = __builtin_amdgcn_exp2f(p1[r]);
  float ps = 0;
#pragma unroll
  for (int r = 0; r < 16; ++r) ps += p0[r];
#pragma unroll
  for (int r = 0; r < 16; ++r) ps += p1[r];
  { auto rr = __builtin_amdgcn_permlane32_swap(__float_as_uint(ps), __float_as_uint(ps), false, false);
    ps = __uint_as_float(rr[0]) + __uint_as_float(rr[1]); }
  l_reg = l_reg * alpha + ps;
#define PK4(P, BASE, OUT) do { unsigned a0 = cvt_pk_bf16(P[BASE + 0], P[BASE + 1]), a1 = cvt_pk_bf16(P[BASE + 2], P[BASE + 3]);   \
    unsigned b0 = cvt_pk_bf16(P[BASE + 4], P[BASE + 5]), b1 = cvt_pk_bf16(P[BASE + 6], P[BASE + 7]);                              \
    auto r0 = __builtin_amdgcn_permlane32_swap(a0, b0, false, false); auto r1 = __builtin_amdgcn_permlane32_swap(a1, b1, false, false); \
    u32x4 w = {r0[0], r1[0], r0[1], r1[1]}; OUT = __builtin_bit_cast(bf16x8, w); } while (0)
  PK4(p0, 0, pa0); PK4(p0, 8, pa1); PK4(p1, 0, pa2); PK4(p1, 8, pa3);
#undef PK4
}
constexpr int NW = 8, QBLK = 32, KVBLK = 64;
constexpr float MLA_SCALE = 0.07216878364870322f;
constexpr float MLA_THR = 8.f;
constexpr int SHM_V = KVBLK * 128 * 2, SHM_KN = KVBLK * 128 * 2, SHM_KR = KVBLK * 64 * 2;
constexpr int OFF_V = 0, OFF_KN = 2 * SHM_V, OFF_KR = OFF_KN + 2 * SHM_KN, OFF_WS = OFF_KR + 2 * SHM_KR, OFF_QR = OFF_WS + NW * 64 * 4, MLA_LDS = OFF_QR + NW * 4096;
__device__ __forceinline__ void qkt(f32x16& p0, f32x16& p1, const LAS char* Kn, const LAS char* Kr, const bf16x8* qr, const LAS char* qrp, const int* kb, const int* krb) {
  p0 = f32x16{}; p1 = f32x16{};
#pragma unroll
  for (int d0 = 0; d0 < 8; ++d0) {
    const bf16x8 b0 = *(const LAS bf16x8*)(Kn + kb[d0 & 3] + (d0 >> 2) * 128);
    const bf16x8 b1 = *(const LAS bf16x8*)(Kn + kb[d0 & 3] + (d0 >> 2) * 128 + 8192);
    p0 = __builtin_amdgcn_mfma_f32_32x32x16_bf16(b0, qr[d0], p0, 0, 0, 0);
    p1 = __builtin_amdgcn_mfma_f32_32x32x16_bf16(b1, qr[d0], p1, 0, 0, 0); }
#pragma unroll
  for (int d0 = 0; d0 < 4; ++d0) {
    const bf16x8 b0 = *(const LAS bf16x8*)(Kr + krb[d0]);
    const bf16x8 b1 = *(const LAS bf16x8*)(Kr + krb[d0] + 4096);
    const bf16x8 qf = *(const LAS bf16x8*)(qrp + d0 * 1024);
    p0 = __builtin_amdgcn_mfma_f32_32x32x16_bf16(b0, qf, p0, 0, 0, 0);
    p1 = __builtin_amdgcn_mfma_f32_32x32x16_bf16(b1, qf, p1, 0, 0, 0); }
}
__device__ __forceinline__ int v_st(int k, int c) { const int kk = (k & ~0xC) | ((k & 4) << 1) | ((k & 8) >> 1); return ((kk >> 3) * 4 + (c >> 5)) * 512 + ((kk & 7) * 32 + (c & 31)) * 2; }
__device__ __forceinline__ int v_rd_base(int lane) { return ((lane & 3) << 3) | (((lane >> 2) & 3) << 6) | (((lane >> 4) & 1) << 5) | (((lane >> 5) & 1) << 8); }
constexpr int v_rd_off(int d0, int ks, int half) { return d0 * 512 + ks * 4096 + half * 2048; }
template <int OFF> __device__ __forceinline__ s16x4 tr_read(int vb) {
  s16x4 r; asm volatile("ds_read_b64_tr_b16 %0, %1 offset:%2" : "=&v"(r) : "v"(vb), "i"(OFF) : "memory"); return r;
}
template <int D0> __device__ __forceinline__ void pv_one(f32x16& od, int vb, bf16x8 pa0, bf16x8 pa1, bf16x8 pa2, bf16x8 pa3) {
  const s16x4 l0 = tr_read<v_rd_off(D0, 0, 0)>(vb), h0 = tr_read<v_rd_off(D0, 0, 1)>(vb), l1 = tr_read<v_rd_off(D0, 1, 0)>(vb), h1 = tr_read<v_rd_off(D0, 1, 1)>(vb);
  const s16x4 l2 = tr_read<v_rd_off(D0, 2, 0)>(vb), h2 = tr_read<v_rd_off(D0, 2, 1)>(vb), l3 = tr_read<v_rd_off(D0, 3, 0)>(vb), h3 = tr_read<v_rd_off(D0, 3, 1)>(vb);
  asm volatile("s_waitcnt lgkmcnt(0)" ::: "memory"); SBAR();
#define PK(L, H) (bf16x8){L[0], L[1], L[2], L[3], H[0], H[1], H[2], H[3]}
  od = __builtin_amdgcn_mfma_f32_32x32x16_bf16(pa0, PK(l0, h0), od, 0, 0, 0);
  od = __builtin_amdgcn_mfma_f32_32x32x16_bf16(pa1, PK(l1, h1), od, 0, 0, 0);
  od = __builtin_amdgcn_mfma_f32_32x32x16_bf16(pa2, PK(l2, h2), od, 0, 0, 0);
  od = __builtin_amdgcn_mfma_f32_32x32x16_bf16(pa3, PK(l3, h3), od, 0, 0, 0);
#undef PK
}
__device__ __forceinline__ void pv_d0(f32x16* o, int vb, bf16x8 pa0, bf16x8 pa1, bf16x8 pa2, bf16x8 pa3) {
  pv_one<0>(o[0], vb, pa0, pa1, pa2, pa3); pv_one<1>(o[1], vb, pa0, pa1, pa2, pa3); pv_one<2>(o[2], vb, pa0, pa1, pa2, pa3); pv_one<3>(o[3], vb, pa0, pa1, pa2, pa3);
}
__device__ __forceinline__ void mla_unit(int b, int h, int qb, const bf16_t* __restrict__ QM, const bf16_t* __restrict__ KN, const bf16_t* __restrict__ KR, const bf16_t* __restrict__ VV, bf16_t* __restrict__ OM, LAS char* lds) {
  const int tid = threadIdx.x, wid = tid >> 6, lane = tid & 63, r32 = lane & 31, hi = lane >> 5;
  constexpr float C = MLA_SCALE * L2E, THRS = MLA_THR / MLA_SCALE;
  constexpr int NT = 33;
  LAS char* V_lds = lds + OFF_V; LAS char* Kn_lds = lds + OFF_KN; LAS char* Kr_lds = lds + OFF_KR;
  LAS float* ws = (LAS float*)(lds + OFF_WS) + wid * 64; LAS float* li_l = ws; LAS float* al_l = ws + 32;
  float m_reg = -1e30f, l_reg = 0; f32x16 o[4] = {}; bf16x8 qr[8];
  LAS char* qrp = lds + OFF_QR + wid * 4096 + lane * 16;
  const int qrow = b * SEQ + qb * 256 + wid * QBLK + r32;
  const bf16_t* Qw = QM + (size_t)qrow * 3072 + h * 192 + hi * 8;
#pragma unroll
  for (int d0 = 0; d0 < 8; ++d0) qr[d0] = *(const GAS bf16x8*)(Qw + d0 * 16);
  __syncthreads();
#pragma unroll
  for (int d0 = 0; d0 < 4; ++d0) *(LAS bf16x8*)(qrp + d0 * 1024) = *(const GAS bf16x8*)(Qw + (8 + d0) * 16);
  const int sr = tid >> 4, sc = (tid & 15) * 8, vst0 = v_st(sr, sc), vst1 = v_st(32 + sr, sc);
  const int krr = tid >> 3, krc = (tid & 7) * 8;
  const int vb0 = (int)(uintptr_t)V_lds + v_rd_base(lane);
  bf16x8 s_v0, s_v1, s_k0, s_k1, s_kr;
  const int realbase = b * SEQ - KVBLK;
  const unsigned voff = (unsigned)(sr * 2048 + sc) * 2u, kroff = (unsigned)(krr * 64 + krc) * 2u;
  int kb[4], krb[4];
#pragma unroll
  for (int bq = 0; bq < 4; ++bq) { kb[bq] = KSWZ(r32, bq * 32 + hi * 16); krb[bq] = KRSWZ(r32, bq * 32 + hi * 16); }
#define TROW(t) ((t) == 0 ? MREAL : realbase + (t) * KVBLK)
#define SLOAD(t) do { const int k0_ = TROW(t); const size_t ro_ = ((size_t)k0_ * 2048 + h * 128) * 2; \
    const GAS char* vb_ = (const GAS char*)VV + ro_; const GAS char* nb_ = (const GAS char*)KN + ro_; const GAS char* rb_ = (const GAS char*)KR + (size_t)k0_ * 128; \
    s_v0 = *(const GAS bf16x8*)(vb_ + voff); s_v1 = *(const GAS bf16x8*)(vb_ + 32 * 4096 + voff); \
    s_k0 = *(const GAS bf16x8*)(nb_ + voff); s_k1 = *(const GAS bf16x8*)(nb_ + 32 * 4096 + voff); \
    s_kr = *(const GAS bf16x8*)(rb_ + kroff); } while (0)
#define SWRITE(bf) do { *(LAS bf16x8*)(V_lds + (bf) * SHM_V + vst0) = s_v0; *(LAS bf16x8*)(V_lds + (bf) * SHM_V + vst1) = s_v1; const int kc_ = sc * 2; \
    *(LAS bf16x8*)(Kn_lds + (bf) * SHM_KN + KSWZ(sr, kc_)) = s_k0; *(LAS bf16x8*)(Kn_lds + (bf) * SHM_KN + KSWZ(32 + sr, kc_)) = s_k1; \
    *(LAS bf16x8*)(Kr_lds + (bf) * SHM_KR + KRSWZ(krr, krc * 2)) = s_kr; } while (0)
#define SWAIT() asm volatile("s_waitcnt vmcnt(0)" ::: "memory")
#define RESC(a) do { if (__any((a) < 1.f)) { if (hi == 0) al_l[r32] = (a); asm volatile("s_waitcnt lgkmcnt(0)" ::: "memory"); \
    _Pragma("unroll") for (int d = 0; d < 4; ++d) _Pragma("unroll") for (int r = 0; r < 16; ++r) o[d][r] *= al_l[crow(r, hi)]; } } while (0)
  f32x16 pA0, pA1, pB0, pB1; float mnA, mnB, alA, alB; bf16x8 pa0, pa1, pa2, pa3;
  SLOAD(0); SWAIT(); SWRITE(0); __syncthreads();
  qkt(pA0, pA1, Kn_lds, Kr_lds, qr, qrp, kb, krb);
  { const float NEG = -INFINITY;
#pragma unroll
    for (int r = 8; r < 16; ++r) pA0[r] = NEG;
#pragma unroll
    for (int r = 0; r < 16; ++r) pA1[r] = NEG; }
  partialSM(pA0, pA1, m_reg, mnA, alA, C, THRS);
  SLOAD(1); SWAIT(); SWRITE(1); __syncthreads();
  for (int j = 1; j + 1 < NT; j += 2) {
    SBAR(); qkt(pB0, pB1, Kn_lds + SHM_KN, Kr_lds + SHM_KR, qr, qrp, kb, krb);
    finishSM(pA0, pA1, alA, l_reg, pa0, pa1, pa2, pa3); SBAR();
    SLOAD(j + 1); SBAR();
    pv_d0(o, vb0, pa0, pa1, pa2, pa3); partialSM(pB0, pB1, m_reg, mnB, alB, C, THRS);
    __syncthreads(); SWAIT(); SWRITE(0);
    RESC(alB); __syncthreads();
    SBAR(); qkt(pA0, pA1, Kn_lds, Kr_lds, qr, qrp, kb, krb);
    finishSM(pB0, pB1, alB, l_reg, pa0, pa1, pa2, pa3); SBAR();
    if (j + 2 < NT) SLOAD(j + 2); SBAR();
    pv_d0(o, vb0 + SHM_V, pa0, pa1, pa2, pa3); partialSM(pA0, pA1, m_reg, mnA, alA, C, THRS);
    __syncthreads(); if (j + 2 < NT) { SWAIT(); SWRITE(1); }
    RESC(alA); __syncthreads();
  }
  finishSM(pA0, pA1, alA, l_reg, pa0, pa1, pa2, pa3); SBAR();
  pv_d0(o, vb0, pa0, pa1, pa2, pa3);
  if (hi == 0) li_l[r32] = l_reg; asm volatile("s_waitcnt lgkmcnt(0)" ::: "memory");
  float rli[16];
#pragma unroll
  for (int r = 0; r < 16; ++r) rli[r] = __builtin_amdgcn_rcpf(li_l[crow(r, hi)]);
  bf16_t* Ow = OM + (size_t)(b * SEQ + qb * 256 + wid * QBLK) * 2048 + h * 128;
#pragma unroll
  for (int r = 0; r < 16; ++r) { const int orow = crow(r, hi);
#pragma unroll
    for (int d0 = 0; d0 < 4; ++d0) { const unsigned w = cvt_pk_bf16(o[d0][r] * rli[r], 0.f); Ow[(size_t)orow * 2048 + d0 * 32 + r32] = (bf16_t)(w & 0xffffu); } }
#undef TROW
#undef SLOAD
#undef SWRITE
#undef SWAIT
#undef RESC
}
__device__ __forceinline__ void na_task(int task, const bf16_t* __restrict__ NAQ, const bf16_t* __restrict__ NAK, const bf16_t* __restrict__ VT, bf16_t* __restrict__ ONA,
                                        const LAS float* relb, const LAS float* metab, LAS float* wsf, int lane) {
  const int r32 = lane & 31, hi = lane >> 5;
  const int half = task & 1, r = (task >> 1) & 31, h = (task >> 6) & 15, b = task >> 10;
  const int qc = half * 32 + r32;
  const int cs = min(max(qc - 8, 0), 48), rs = min(max(r - 4, 0), 24);
  const int qtok = b * SEQ + r * 64 + qc;
  constexpr float C = L2E, THRS = 8.f, SCALE = 0.125f;
  bf16x8 qr[4];
#pragma unroll
  for (int d0 = 0; d0 < 4; ++d0) qr[d0] = *(const GAS bf16x8*)(NAQ + (size_t)qtok * 1024 + h * 64 + d0 * 16 + hi * 8);
  float m_reg = -1e30f, l_reg = 0.f; f32x16 o[2] = {};
  LAS float* al_l = wsf; LAS float* li_l = wsf + 32;
  const float NEG = -INFINITY;
  const unsigned long long wm = 0xFFFFull << cs;
  const unsigned mh0 = (unsigned)wm >> (4 * hi), mh1 = (unsigned)(wm >> 32) >> (4 * hi);
  const bf16_t* kq = NAK + (size_t)r32 * 1024 + h * 64 + hi * 8;
  const bf16_t* vq = VT + (size_t)(h * 64 + r32) * VT_PITCH + 8 * hi;
#define NA_KTOK(w) ((w) == 8 ? MREAL : b * SEQ + (rs + (w)) * 64)
#define NA_LOADK(KF, w) do { const bf16_t* kp_ = kq + (size_t)NA_KTOK(w) * 1024; _Pragma("unroll") for (int d0 = 0; d0 < 4; ++d0) { KF[d0] = *(const GAS bf16x8*)(kp_ + d0 * 16); KF[4 + d0] = *(const GAS bf16x8*)(kp_ + 32 * 1024 + d0 * 16); } } while (0)
#define NA_TILE(KF, w) do { \
    bf16x8 vf[8]; { const bf16_t* vp_ = vq + NA_KTOK(w); _Pragma("unroll") for (int ks = 0; ks < 4; ++ks) { vf[ks] = *(const GAS bf16x8*)(vp_ + 16 * ks); vf[4 + ks] = *(const GAS bf16x8*)(vp_ + (size_t)32 * VT_PITCH + 16 * ks); } } \
    f32x16 p0 = {}, p1 = {}; \
    _Pragma("unroll") for (int d0 = 0; d0 < 4; ++d0) { p0 = __builtin_amdgcn_mfma_f32_32x32x16_bf16(KF[d0], qr[d0], p0, 0, 0, 0); p1 = __builtin_amdgcn_mfma_f32_32x32x16_bf16(KF[4 + d0], qr[d0], p1, 0, 0, 0); } \
    if ((w) + 1 < 9) NA_LOADK(KF, (w) + 1);            \
    if ((w) < 8) { const LAS float* bp_ = relb + ((h * 15 + (rs + (w) - r + 7)) * 31 + 15 - qc + 4 * hi);     \
      _Pragma("unroll") for (int rg = 0; rg < 16; ++rg) { const int c_ = (rg & 3) + 8 * (rg >> 2); \
        { const bool ok = (mh0 >> c_) & 1u; const float bv = bp_[c_]; p0[rg] = ok ? fmaf(p0[rg], SCALE, bv) : NEG; } \
        { const bool ok = (mh1 >> c_) & 1u; const float bv = bp_[c_ + 32]; p1[rg] = ok ? fmaf(p1[rg], SCALE, bv) : NEG; } } \
    } else { const LAS float* bp = metab + h * 16; \
      _Pragma("unroll") for (int rg = 0; rg < 16; ++rg) { const int kc = crow(rg, hi); p0[rg] = (rg < 8) ? fmaf(p0[rg], SCALE, bp[kc & 15]) : NEG; p1[rg] = NEG; } } \
    float mn, alpha; partialSM(p0, p1, m_reg, mn, alpha, C, THRS); \
    bf16x8 pa0, pa1, pa2, pa3; finishSM(p0, p1, alpha, l_reg, pa0, pa1, pa2, pa3); \
    if (__any(alpha < 1.f)) { if (hi == 0) al_l[r32] = alpha; asm volatile("s_waitcnt lgkmcnt(0)" ::: "memory"); \
      _Pragma("unroll") for (int d = 0; d < 2; ++d) _Pragma("unroll") for (int rg = 0; rg < 16; ++rg) o[d][rg] *= al_l[crow(rg, hi)]; } \
    _Pragma("unroll") for (int d0 = 0; d0 < 2; ++d0) { \
      o[d0] = __builtin_amdgcn_mfma_f32_32x32x16_bf16(pa0, vf[4 * d0 + 0], o[d0], 0, 0, 0); o[d0] = __builtin_amdgcn_mfma_f32_32x32x16_bf16(pa1, vf[4 * d0 + 1], o[d0], 0, 0, 0); \
      o[d0] = __builtin_amdgcn_mfma_f32_32x32x16_bf16(pa2, vf[4 * d0 + 2], o[d0], 0, 0, 0); o[d0] = __builtin_amdgcn_mfma_f32_32x32x16_bf16(pa3, vf[4 * d0 + 3], o[d0], 0, 0, 0); } } while (0)
  { bf16x8 kA[8];
    NA_LOADK(kA, 0);
#pragma unroll 1
    for (int w = 0; w < 8; ++w) { NA_TILE(kA, w); }
    NA_TILE(kA, 8); }
#undef NA_KTOK
#undef NA_LOADK
#undef NA_TILE
  if (hi == 0) li_l[r32] = l_reg; asm volatile("s_waitcnt lgkmcnt(0)" ::: "memory");
  bf16_t* Ow = ONA + (size_t)(b * SEQ + r * 64 + half * 32) * 1024 + h * 64;
#pragma unroll
  for (int rg = 0; rg < 16; ++rg) { const int orow = crow(rg, hi); const float rl = __builtin_amdgcn_rcpf(li_l[orow]);
#pragma unroll
    for (int d0 = 0; d0 < 2; ++d0) { const unsigned wv = cvt_pk_bf16(o[d0][rg] * rl, 0.f); Ow[(size_t)orow * 1024 + d0 * 32 + r32] = (bf16_t)(wv & 0xffffu); } }
  asm volatile("s_waitcnt lgkmcnt(0)" ::: "memory");
}
}
namespace peer {
constexpr int CH = 32;
constexpr int OFF_TV = 0, OFF_TI = OFF_TV + CH * 16 * 16 * 4, OFF_SE = OFF_TI + CH * 16 * 16 * 4, OFF_SG = OFF_SE + CH * 128 * 4, PEER_LDS = OFF_SG + CH * 128 * 4;
__device__ __forceinline__ float gelu_tanh(float x) {
    const float u = 0.7978845608028654f * (x + 0.044715f * x * x * x);
    const float e = __builtin_amdgcn_exp2f(-2.f * 1.4426950408889634f * fabsf(u));
    const float t = (1.f - e) * __builtin_amdgcn_rcpf(1.f + e);
    return 0.5f * x * (1.f + (u < 0.f ? -t : t));
}
__device__ __forceinline__ void fmac1(float& acc, float a, float b) { asm("v_fmac_f32_e32 %0, %1, %2" : "+v"(acc) : "v"(a), "v"(b)); }
#define PEER_INSERT(x_, xi_) do { float x__ = (x_); int xi__ = (xi_); \
    _Pragma("unroll") for (int j_ = 0; j_ < 16; ++j_) { const bool gt_ = x__ > tv[j_]; const float tvo_ = tv[j_]; const int tio_ = ti[j_]; \
        tv[j_] = gt_ ? x__ : tvo_; ti[j_] = gt_ ? xi__ : tio_; x__ = gt_ ? tvo_ : x__; xi__ = gt_ ? tio_ : xi__; } } while (0)

#define PEER_AUX 0
typedef __amdgpu_buffer_rsrc_t rsrc_t;
__device__ __forceinline__ rsrc_t mk_rsrc(const void* p, unsigned bytes) { return __builtin_amdgcn_make_buffer_rsrc((void*)p, 0, bytes, 0x00020000); }
__device__ __forceinline__ u32x4 ldb128(rsrc_t r, unsigned off) { return __builtin_amdgcn_raw_buffer_load_b128(r, off, 0, PEER_AUX); }
typedef unsigned v6u_t __attribute__((ext_vector_type(6)));
typedef float v32f_t __attribute__((ext_vector_type(32)));
typedef float v16f_t __attribute__((ext_vector_type(16)));
__device__ __forceinline__ u32x2 ldb64(rsrc_t r, unsigned off) { return __builtin_amdgcn_raw_buffer_load_b64(r, off, 0, PEER_AUX); }
__device__ __forceinline__ f32x4 ldf128(rsrc_t r, unsigned off) { return __builtin_bit_cast(f32x4, __builtin_amdgcn_raw_buffer_load_b128(r, off, 0, PEER_AUX)); }
__device__ __forceinline__ f32x4 ldf128_nt(rsrc_t r, unsigned off) { return __builtin_bit_cast(f32x4, __builtin_amdgcn_raw_buffer_load_b128(r, off, 0, 2)); }
__device__ __forceinline__ void peer_chunk(int chunk, const float* __restrict__ SC, const float* __restrict__ H2, const unsigned char* __restrict__ U, const unsigned char* __restrict__ V,
                                           const float* __restrict__ g2, const float* __restrict__ gf, float* OUT, LAS char* lds, int tid) {
    LAS float* TV = (LAS float*)(lds + OFF_TV); LAS int* TI = (LAS int*)(lds + OFF_TI); LAS int* SE = (LAS int*)(lds + OFF_SE); LAS float* SG = (LAS float*)(lds + OFF_SG);
    asm volatile("" : "+v"(tid));
    const int tok0 = chunk * CH, lane = tid & 63, wave = tid >> 6;
    const rsrc_t rSC = mk_rsrc(SC, 0x8000000u), rH2 = mk_rsrc(H2, 0x8000000u), rU = mk_rsrc(U, 0x3000000u), rG2 = mk_rsrc(g2, 8192u), rGF = mk_rsrc(gf, 8192u);
    __syncthreads();
    { const int tl = tid >> 4, g = tid & 15; const unsigned spo = ((unsigned)(tok0 + tl) * 2048u + (unsigned)g * 128u) * 4u;
      int tk[16];
#pragma unroll
      for (int j = 0; j < 16; ++j) tk[j] = (int)0x80000000;
#define PEER_KEY(x_, lowbits_, mask_) ({ const int f_ = __float_as_int(x_); ((f_ ^ ((f_ >> 31) & 0x7fffffff)) & ~(mask_)) | (lowbits_); })
#define PEER_INS(key_) do { int x__ = (key_); _Pragma("unroll") for (int j_ = 0; j_ < 16; ++j_) { const int hi_ = max(x__, tk[j_]); x__ = min(x__, tk[j_]); tk[j_] = hi_; } } while (0)
#pragma unroll 1
      for (int i = 0; i < 32; i += 2) { const f32x4 a = ldf128_nt(rSC, spo + i * 16), b = ldf128_nt(rSC, spo + i * 16 + 16);
#pragma unroll
          for (int e = 0; e < 4; ++e) { PEER_INS(PEER_KEY(a[e], 127 - (4 * i + e), 127)); }
#pragma unroll
          for (int e = 0; e < 4; ++e) { PEER_INS(PEER_KEY(b[e], 127 - (4 * i + 4 + e), 127)); } }
      LAS float* tvp = TV + (tl * 16 + g) * 16; LAS int* tip = TI + (tl * 16 + g) * 16;
#pragma unroll
      for (int j = 0; j < 16; ++j) { const int k_ = tk[j] & ~127; tvp[j] = __int_as_float(k_ ^ ((k_ >> 31) & 0x7fffffff)); tip[j] = 127 - (tk[j] & 127); } }
    __syncthreads();
    asm volatile("" : "+v"(tid));
    { const int tl = tid >> 4, hh = (tid >> 1) & 7, half = tid & 1;
      const LAS float* s1 = TV + (tl * 16 + 2 * hh) * 16; const LAS float* s2 = s1 + 16; const LAS int* i1 = TI + (tl * 16 + 2 * hh) * 16; const LAS int* i2 = i1 + 16;
      float b2[16];
#pragma unroll
      for (int j = 0; j < 16; ++j) b2[j] = s2[j];
      int tk[16];
#pragma unroll
      for (int j = 0; j < 16; ++j) tk[j] = (int)0x80000000;
#pragma unroll 1
      for (int ii = 0; ii < 8; ++ii) { const int i = half * 8 + ii; const float a = s1[i];
#pragma unroll
          for (int j = 0; j < 16; ++j) PEER_INS(PEER_KEY(a + b2[j], 255 - (i * 16 + j), 255)); }
      { int pk[16];
#pragma unroll
        for (int j = 0; j < 16; ++j) pk[j] = __shfl_xor(tk[j], 1);
#pragma unroll
        for (int j = 0; j < 16; ++j) PEER_INS(pk[j]); }
      if (half == 0) { float e[16], sum = 0.f; const int k0_ = tk[0] & ~255; const float v0 = __int_as_float(k0_ ^ ((k0_ >> 31) & 0x7fffffff));
#pragma unroll
        for (int j = 0; j < 16; ++j) { const int k_ = tk[j] & ~255; const float vj = __int_as_float(k_ ^ ((k_ >> 31) & 0x7fffffff)); e[j] = __builtin_amdgcn_exp2f((vj - v0) * 1.4426950408889634f); sum += e[j]; }
        const float inv = 1.0f / sum;
#pragma unroll
        for (int j = 0; j < 16; ++j) { const int ci = 255 - (tk[j] & 255); SE[tl * 128 + hh * 16 + j] = i1[ci >> 4] * 128 + i2[ci & 15]; SG[tl * 128 + hh * 16 + j] = e[j] * inv; } } }
#undef PEER_KEY
#undef PEER_INS
    __syncthreads();
#pragma unroll 1
    for (int tt = 0; tt < CH / NWAVES; ++tt) { const int tl = wave * (CH / NWAVES) + tt, tok = tok0 + tl;
      asm volatile("" ::: "memory");
      float hn[32], acc[32]; float ss = 0.f;
#pragma unroll
      for (int j = 0; j < 2; ++j)
#pragma unroll
          for (int q = 0; q < 4; ++q) { const f32x4 a = ldf128_nt(rH2, ((unsigned)tok * 2048u + 1024u * j + 16u * lane + 4u * q) * 4u);
#pragma unroll
              for (int i = 0; i < 4; ++i) { hn[16 * j + 4 * q + i] = a[i]; ss += a[i] * a[i]; } }
      const float rstd = 1.0f / sqrtf(wave_sum(ss) * (1.f / 2048.f) + NORM_EPS);
#pragma unroll
      for (int j = 0; j < 2; ++j)
#pragma unroll
          for (int q = 0; q < 4; ++q) { const f32x4 a = ldf128(rG2, (1024u * j + 16u * lane + 4u * q) * 4u);
#pragma unroll
              for (int i = 0; i < 4; ++i) hn[16 * j + 4 * q + i] *= rstd * a[i]; }
#pragma unroll
      for (int i = 0; i < 32; ++i) acc[i] = 0.f;
#define NX 4
#define PEER_LOAD(S, kb) do { _Pragma("unroll") for (int x = 0; x < NX; ++x) { const unsigned o = (unsigned)SE[tl * 128 + (kb) + x] * 3072u; \
          S##ua[x] = ldb128(rU, o + (unsigned)lane * 16u); S##ub[x] = ldb64(rU, o + 1024u + (unsigned)lane * 8u); S##va[x] = ldb128(rU, o + 1536u + (unsigned)lane * 16u); S##vb[x] = ldb64(rU, o + 2560u + (unsigned)lane * 8u); } } while (0)
#define PEER_DEC(A, B) __builtin_amdgcn_cvt_scalef32_pk32_f32_fp6((v6u_t){A.x, A.y, A.z, A.w, B.x, B.y}, 1.0f)
#define PEER_COMPUTE(S, kb) do { float d[NX]; \
          _Pragma("unroll") for (int x = 0; x < NX; ++x) { const v32f_t r = PEER_DEC(S##ua[x], S##ub[x]); float dd = 0.f; \
              _Pragma("unroll") for (int i = 0; i < 32; ++i) fmac1(dd, hn[i], r[i]); \
              d[x] = dd; } \
          _Pragma("unroll") for (int o = 1; o < 64; o <<= 1) { _Pragma("unroll") for (int x = 0; x < NX; ++x) d[x] += __shfl_xor(d[x], o); } \
          float c[NX]; \
          _Pragma("unroll") for (int x = 0; x < NX; ++x) c[x] = SG[tl * 128 + (kb) + x] * gelu_tanh(d[x] * (1.f / 64.f)) * 0.25f; \
          _Pragma("unroll") for (int x = 0; x < NX; ++x) { const v32f_t r = PEER_DEC(S##va[x], S##vb[x]); \
              _Pragma("unroll") for (int i = 0; i < 32; ++i) fmac1(acc[i], c[x], r[i]); } } while (0)
      { u32x4 Aua[NX], Ava[NX], Bua[NX], Bva[NX]; u32x2 Aub[NX], Avb[NX], Bub[NX], Bvb[NX];
        PEER_LOAD(A, 0);
#pragma unroll 1
        for (int k = 0; k < 128; k += 2 * NX) {
            PEER_LOAD(B, k + NX); PEER_COMPUTE(A, k);
            { const int kn = min(k + 2 * NX, 128 - NX); PEER_LOAD(A, kn); }
            PEER_COMPUTE(B, k + NX);
        } }
#undef PEER_DEC
#undef NX
#undef PEER_LOAD
#undef PEER_COMPUTE
      asm volatile("" ::: "memory");
      int tok2 = tok, lane2 = lane; asm volatile("" : "+v"(tok2), "+v"(lane2));
      float s2 = 0.f;
#pragma unroll
      for (int j = 0; j < 2; ++j)
#pragma unroll
          for (int q = 0; q < 4; ++q) { const f32x4 a = ldf128_nt(rH2, ((unsigned)tok2 * 2048u + 1024u * j + 16u * lane2 + 4u * q) * 4u);
#pragma unroll
              for (int i = 0; i < 4; ++i) { acc[16 * j + 4 * q + i] += a[i]; s2 += acc[16 * j + 4 * q + i] * acc[16 * j + 4 * q + i]; } }
      const float rf = 1.0f / sqrtf(wave_sum(s2) * (1.f / 2048.f) + NORM_EPS);
#pragma unroll
      for (int j = 0; j < 2; ++j)
#pragma unroll
          for (int q = 0; q < 4; ++q) { const f32x4 a = ldf128(rGF, (1024u * j + 16u * lane2 + 4u * q) * 4u); f32x4 oa;
#pragma unroll
              for (int i = 0; i < 4; ++i) oa[i] = acc[16 * j + 4 * q + i] * rf * a[i];
              float* op = OUT + (size_t)tok2 * 2048 + 1024 * j + 16 * lane2 + 4 * q;
              __builtin_nontemporal_store(oa, (GAS f32x4*)op); }
    }
}
}
#ifndef MK_N_LAUNCHES
#define MK_N_LAUNCHES 1
#endif
constexpr int N_PHASES = 9;
constexpr int N_LAUNCHES = MK_N_LAUNCHES;
struct Args { const float* in[19]; float* out; unsigned char* ws; int ph_lo, ph_hi; };
static_assert(sizeof(Args) == 19 * 8 + 8 + 8 + 8, "no padding");

__global__ void __launch_bounds__(NWAVES * 64, 2) hybrid_fwd(Args args) {
    extern __shared__ __attribute__((aligned(16))) unsigned char lds_raw[];
    Frame F;
    F.lds = (LAS unsigned char*)lds_raw;
    F.MISC = (volatile LAS unsigned*)(F.lds + MISC_OFF);
    F.tid = threadIdx.x; F.lane = F.tid & 63; F.wave = __builtin_amdgcn_readfirstlane(F.tid >> 6);
    F.G = gridDim.x; { const int bx = blockIdx.x; F.vcu = (F.G % 8 == 0) ? (bx % 8) * (F.G / 8) + bx / 8 : bx; }
    F.ws = args.ws; F.out = args.out;
#pragma unroll
    for (int i = 0; i < 19; ++i) F.in[i] = args.in[i];
    for (int u = F.tid; u < (LDS_BYTES - LDSCTL_OFF) / 4; u += NWAVES * 64) ((LAS unsigned*)(F.lds + LDSCTL_OFF))[u] = 0u;
    __syncthreads();
    XcdBarrier bar; bar.bar = (unsigned*)(F.ws + WS_CTL) + CW_BAR; bar.x = 0; bar.st = nullptr;
    if (N_LAUNCHES == 1) bar = xcd_barrier_post((unsigned*)(F.ws + WS_CTL) + CW_BAR, F.MISC + 8);
    const int lo = args.ph_lo, hi = args.ph_hi;
#define IN(k) (lo <= (k) && (k) < hi)
#define SEAM(k) do { if (IN(k) && IN((k) + 1)) xcd_barrier(bar); } while (0)
    const size_t T2048 = (size_t)256 * 2048 * 2, T1024 = (size_t)256 * 1024 * 2, T512 = (size_t)256 * 512 * 2;
    float* cosT = WSP(float, WS_COS); float* sinT = WSP(float, WS_SIN);
    float* ssq_q = WSP(float, WS_SSQ_Q); float* ssq_kv = WSP(float, WS_SSQ_KV); float* ssq2 = WSP(float, WS_SSQ_2);

    if (IN(0)) { p0_prologue(F); } SEAM(0);
    if (IN(1)) {
        SchedP1 S{F.G, (int)blockIdx.x, (const char*)(F.ws + WS_HN1), (const char*)(F.ws + WS_WIN), (const char*)(F.ws + WS_WVT), T2048};
        EpiP1 E{WSP(bf16_t, WS_NAQ), WSP(bf16_t, WS_NAK), WSP(bf16_t, WS_VT), WSP(bf16_t, WS_CQ), WSP(bf16_t, WS_CKV), WSP(bf16_t, WS_KR), WSP(bf16_t, WS_GA), WSP(bf16_t, WS_GB), ssq_q, ssq_kv, cosT, sinT};
        pg8::gemm_phase<EpiP1, SchedP1>(F.lds, 2048, S, E);
    } SEAM(1);
    if (IN(2)) {
        LAS float* relb = (LAS float*)F.lds + 64; LAS float* metab = relb + 16 * 15 * 31 + 128; LAS float* wsf = metab + 256 + F.wave * 64;
        for (int i = F.tid; i < 16 * 15 * 31; i += NWAVES * 64) relb[i] = F.in[4][i];
        if (F.tid < 256) metab[F.tid] = F.in[5][F.tid];
        __syncthreads();
        const int gw = F.vcu * NWAVES + F.wave, NGW = F.G * NWAVES;
        for (int task = gw; task < NBATCH * 16 * 32 * 2; task += NGW)
            att::na_task(task, WSP(bf16_t, WS_NAQ), WSP(bf16_t, WS_NAK), WSP(bf16_t, WS_VT), WSP(bf16_t, WS_ONA), relb, metab, wsf, F.lane);
        __syncthreads();
    } SEAM(2);
    if (IN(3)) {
        SchedP3 S{F.G, (int)blockIdx.x, (const char*)(F.ws + WS_CQ), (const char*)(F.ws + WS_CKV), (const char*)(F.ws + WS_WUQ), (const char*)(F.ws + WS_WUKV), T512};
        EpiP3 E{WSP(bf16_t, WS_QM), WSP(bf16_t, WS_KN), WSP(bf16_t, WS_VV), ssq_q, ssq_kv, cosT, sinT};
        pg8::gemm_phase<EpiP3, SchedP3>(F.lds, 512, S, E);
    } SEAM(3);
    if (IN(4)) {
        for (int id = F.vcu; id < NBATCH * 16 * 8; id += F.G) { const int bh = id >> 3, qb = id & 7;
            att::mla_unit(bh >> 4, bh & 15, qb, WSP(bf16_t, WS_QM), WSP(bf16_t, WS_KN), WSP(bf16_t, WS_KR), WSP(bf16_t, WS_VV), WSP(bf16_t, WS_OMLA), (LAS char*)F.lds); }
        __syncthreads();
    } SEAM(4);
    if (IN(5)) {
        { SchedGrid S{F.G, (int)blockIdx.x, 64, 8, (const char*)(F.ws + WS_ONA), (const char*)(F.ws + WS_WNA), T1024};
          EpiP5a E{WSP(bf16_t, WS_GA), WSP(bf16_t, WS_T1)};
          pg8::gemm_phase<EpiP5a, SchedGrid>(F.lds, 1024, S, E); }
        { SchedGrid S{F.G, (int)blockIdx.x, 64, 8, (const char*)(F.ws + WS_OMLA), (const char*)(F.ws + WS_WMLA), T2048};
          EpiP5b E{WSP(bf16_t, WS_GB), WSP(bf16_t, WS_T1), WSP(bf16_t, WS_MERGED)};
          pg8::gemm_phase<EpiP5b, SchedGrid>(F.lds, 2048, S, E); }
    } SEAM(5);
    if (IN(6)) {
        { SchedGrid S{F.G, (int)blockIdx.x, 64, 8, (const char*)(F.ws + WS_MERGED), (const char*)(F.ws + WS_WOUT), T2048};
          EpiP6 E{F.in[0], WSP(float, WS_H2), WSP(bf16_t, WS_H2B), ssq2};
          pg8::gemm_phase<EpiP6, SchedGrid>(F.lds, 2048, S, E); }
        {
          for (unsigned i = (unsigned)F.vcu * 512u + F.tid; i < 2u * 16384u * 64u; i += (unsigned)F.G * 512u) { const unsigned isv = i >> 20, row = (i >> 6) & 16383u, l = i & 63u; const float sc = isv ? 4.f : 64.f;
              const float* src = (isv ? F.in[17] : F.in[16]) + (size_t)row * 2048 + 16 * l; peer::v16f_t a, b;
#pragma unroll
              for (int q = 0; q < 4; ++q) { const f32x4 x0 = *(const GAS f32x4*)(src + 4 * q) * sc, x1 = *(const GAS f32x4*)(src + 1024 + 4 * q) * sc;
#pragma unroll
                  for (int e = 0; e < 4; ++e) { const int k0_ = 4 * q + e, k1_ = 16 + 4 * q + e;
                      if (k0_ & 1) b[k0_ >> 1] = x0[e]; else a[k0_ >> 1] = x0[e];
                      if (k1_ & 1) b[k1_ >> 1] = x1[e]; else a[k1_ >> 1] = x1[e]; } }
              const peer::v6u_t w = __builtin_amdgcn_cvt_scalef32_2xpk16_fp6_f32(a, b, 1.0f);
              unsigned char* rec = WSP(unsigned char, WS_U) + (size_t)row * 3072 + (isv ? 1536 : 0);
              *(GAS u32x4*)(rec + l * 16) = (u32x4){w[0], w[1], w[2], w[3]}; *(GAS u32x2*)(rec + 1024 + l * 8) = (u32x2){w[4], w[5]}; } }
    } SEAM(6);
    if (IN(7)) {
        SchedGrid S{F.G, (int)blockIdx.x, 64, 8, (const char*)(F.ws + WS_H2B), (const char*)(F.ws + WS_WSC), T2048};
        EpiP7 E{ssq2, WSP(float, WS_SC)};
        pg8::gemm_phase<EpiP7, SchedGrid>(F.lds, 2048, S, E);
    } SEAM(7);
    if (IN(8)) {
        for (int chunk = F.vcu; chunk < MREAL / peer::CH; chunk += F.G)
            peer::peer_chunk(chunk, WSP(float, WS_SC), WSP(float, WS_H2), WSP(unsigned char, WS_U), WSP(unsigned char, WS_V), F.in[13], F.in[18], F.out, (LAS char*)F.lds, F.tid);
    }
#undef IN
#undef SEAM
}

extern "C" void kernel_launch(void* const* d_in, const int* in_sizes, int n_in, void* d_out, int out_size, void* d_ws, size_t ws_size, hipStream_t stream) {
    static int grid = 0;
    if (grid == 0) {
        if (n_in != 19 || in_sizes[0] != MREAL * DM || out_size != MREAL * DM || ws_size < WS_END) {
            fprintf(stderr, "kernel_launch: shape/workspace mismatch: n_in %d in0 %d out %d ws %zu (need %zu); nothing launched\n", n_in, n_in > 0 ? in_sizes[0] : -1, out_size, ws_size, (size_t)WS_END); grid = -1; return; }
        int dev = 0, cus = 0, per_cu = 0;
        if (hipGetDevice(&dev) != hipSuccess || hipDeviceGetAttribute(&cus, hipDeviceAttributeMultiprocessorCount, dev) != hipSuccess) { fprintf(stderr, "kernel_launch: device query failed\n"); grid = -1; return; }
        if (hipFuncSetAttribute((const void*)hybrid_fwd, hipFuncAttributeMaxDynamicSharedMemorySize, LDS_BYTES) != hipSuccess) { fprintf(stderr, "kernel_launch: hipFuncSetAttribute failed\n"); grid = -1; return; }
        if (hipOccupancyMaxActiveBlocksPerMultiprocessor(&per_cu, (const void*)hybrid_fwd, NWAVES * 64, LDS_BYTES) != hipSuccess || per_cu < 1)
            fprintf(stderr, "kernel_launch: note: occupancy query reports %d workgroups per CU\n", per_cu);
        (void)hipGetLastError();
        grid = cus;
    }
    if (grid < 0) return;
    if (hipMemsetAsync((char*)d_ws + WS_CTL, 0, CTL_ZERO_BYTES, stream) != hipSuccess) { fprintf(stderr, "kernel_launch: hipMemsetAsync failed\n"); return; }
    Args a{};
    for (int i = 0; i < 19; ++i) a.in[i] = (const float*)d_in[i];
    a.out = (float*)d_out; a.ws = (unsigned char*)d_ws;
    for (int li = 0; li < N_LAUNCHES; ++li) {
        a.ph_lo = (N_LAUNCHES == 1) ? 0 : li; a.ph_hi = (N_LAUNCHES == 1) ? N_PHASES : li + 1;
        hipLaunchKernelGGL(hybrid_fwd, dim3(grid), dim3(NWAVES * 64), LDS_BYTES, stream, a);
        const hipError_t le = hipPeekAtLastError();
        if (le != hipSuccess) { fprintf(stderr, "kernel_launch: launch %d failed: %s\n", li, hipGetErrorName(le)); break; }
    }
}
```

```cpp
#include <hip/hip_runtime.h>
#include <cstdio>
#include <cstdint>

#define LAS __attribute__((address_space(3)))
#define GAS __attribute__((address_space(1)))
typedef unsigned short bf16_t;
typedef short bf16x8 __attribute__((ext_vector_type(8)));
typedef short s16x4 __attribute__((ext_vector_type(4)));
typedef float f32x4 __attribute__((ext_vector_type(4)));
typedef float f32x2 __attribute__((ext_vector_type(2)));
typedef float f32x16 __attribute__((ext_vector_type(16)));
typedef unsigned u32x4 __attribute__((ext_vector_type(4)));
typedef unsigned u32x2 __attribute__((ext_vector_type(2)));

constexpr int DM = 2048, NBATCH = 8, SEQ = 2048, NMETA = 16;
constexpr int MREAL = NBATCH * SEQ;
constexpr int MPAD = MREAL + 256;
constexpr int NPOS = SEQ + NMETA;
constexpr float NORM_EPS = 1e-6f;
constexpr int C_NAQ = 0, C_NAK = 1024, C_CQ = 2048, C_CKV = 2560, C_GA = 3072, C_GB = 5120, C_KR = 7168, NMAIN = 7424;
constexpr int VT_PITCH = MPAD;

constexpr size_t MiB = 1u << 20;
constexpr size_t WS_CTL = 0, CTL_ZERO_BYTES = 1 * MiB;
constexpr size_t WS_SSQ_Q = 481 * MiB, WS_SSQ_KV = 482 * MiB, WS_SSQ_2 = 486 * MiB;
constexpr size_t WS_COS = 1 * MiB, WS_SIN = 1 * MiB + 512 * 1024;
constexpr size_t WS_WUQ = 2 * MiB, WS_WUKV = 5 * MiB, WS_WNA = 9 * MiB, WS_WMLA = 13 * MiB, WS_WOUT = 21 * MiB, WS_WSC = 29 * MiB;
constexpr size_t WS_GA = 37 * MiB, WS_GB = 101 * MiB;
constexpr size_t WS_KR = 165 * MiB;
constexpr size_t WS_WIN = 167 * MiB + 256 * 1024, WS_WVT = WS_WIN + 29 * MiB;
constexpr size_t WS_ONA = 190 * MiB;
constexpr size_t WS_NAQ = 222 * MiB, WS_NAK = 254 * MiB, WS_VT = WS_NAK + 32 * MiB + 512 * 1024;
constexpr size_t WS_HN1 = 319 * MiB;
constexpr size_t WS_CQ = 448 * MiB, WS_CKV = 464 * MiB;
constexpr size_t WS_QM = 222 * MiB, WS_KN = 318 * MiB, WS_VV = 383 * MiB;
constexpr size_t WS_OMLA = 448 * MiB;
constexpr size_t WS_MERGED = 222 * MiB, WS_T1 = 286 * MiB;
constexpr size_t WS_H2 = 37 * MiB, WS_H2B = 293 * MiB;
constexpr size_t WS_U = 357 * MiB, WS_V = 421 * MiB;
constexpr size_t WS_SC = 165 * MiB;
constexpr size_t WS_END = 512 * MiB;
static_assert(WS_CKV + (size_t)MPAD * 512 * 2 <= WS_SSQ_Q && WS_SSQ_Q + (size_t)8 * MPAD * 4 <= WS_SSQ_KV && WS_SSQ_KV + (size_t)8 * MPAD * 4 <= 483 * MiB && WS_V + 64 * MiB <= WS_SSQ_2 && WS_SSQ_2 + (size_t)32 * MREAL * 4 <= WS_END, "ssq slabs");
static_assert(WS_VT + (size_t)1024 * MPAD * 2 <= WS_HN1 && WS_HN1 + (size_t)MPAD * 2048 * 2 <= WS_CQ && WS_CKV + (size_t)MPAD * 512 * 2 <= WS_END, "map P1");
static_assert(WS_WVT + 4 * MiB <= WS_NAQ && WS_KR + (size_t)MPAD * 64 * 2 <= WS_WIN && WS_ONA + 32 * MiB <= WS_NAQ, "map P1b");
static_assert(WS_QM + 96 * MiB <= WS_KN && WS_KN + 65 * MiB <= WS_VV && WS_VV + 65 * MiB <= WS_OMLA && WS_OMLA + 64 * MiB <= WS_END, "map P3");
static_assert(WS_T1 + 128 * MiB <= WS_OMLA && WS_H2 + 128 * MiB <= WS_KR && WS_SC + 128 * MiB <= WS_H2B && WS_H2B + 64 * MiB <= WS_U && WS_V + 64 * MiB <= WS_END, "map P5+");

constexpr int CW_BAR = 4096;

constexpr int RING_BYTES = 131072;
constexpr int LDSCTL_OFF = RING_BYTES, MISC_OFF = LDSCTL_OFF + 320;
constexpr int LDS_BYTES = 147456;
constexpr int NWAVES = 8;

#define LDS_WAIT() asm volatile("s_waitcnt lgkmcnt(0)" ::: "memory")
#define VM_WAIT() asm volatile("s_waitcnt vmcnt(0)" ::: "memory")
#define SBAR() __builtin_amdgcn_sched_barrier(0)
typedef __bf16 bf16x2_t __attribute__((ext_vector_type(2)));
__device__ __forceinline__ unsigned cvt_pk_bf16(float lo, float hi) { const f32x2 v = {lo, hi}; const bf16x2_t b = __builtin_convertvector(v, bf16x2_t); return __builtin_bit_cast(unsigned, b); }
__device__ __forceinline__ float bf_lo(unsigned w) { return __uint_as_float(w << 16); }
__device__ __forceinline__ float bf_hi(unsigned w) { return __uint_as_float(w & 0xffff0000u); }
__device__ __forceinline__ u32x4 pack8(const f32x4 a, const f32x4 b) { u32x4 w; w.x = cvt_pk_bf16(a[0], a[1]); w.y = cvt_pk_bf16(a[2], a[3]); w.z = cvt_pk_bf16(b[0], b[1]); w.w = cvt_pk_bf16(b[2], b[3]); return w; }
__device__ __forceinline__ u32x2 pack4(const f32x4 a) { u32x2 w; w.x = cvt_pk_bf16(a[0], a[1]); w.y = cvt_pk_bf16(a[2], a[3]); return w; }
__device__ __forceinline__ float wave_sum(float v) {
#pragma unroll
    for (int o = 1; o < 64; o <<= 1) v += __shfl_xor(v, o);
    return v;
}
__device__ __forceinline__ float sigmoidf_(float x) { return __builtin_amdgcn_rcpf(1.0f + __builtin_amdgcn_exp2f(-1.4426950408889634f * x)); }
__device__ __forceinline__ int crow(int r, int hi) { return (r & 3) + 8 * (r >> 2) + 4 * hi; }
#define PG8_AUX 0
namespace pg8 {
constexpr int BM = 256, BK = 64, HALF = 128, HTB = HALF * BK * 2  , STAGE_BYTES = 8 * HTB, NXCD = 8, WGM = 8;
__host__ __device__ __forceinline__ int lds_byte(int r, int c) { const int st = (r >> 4) * 2 + (c >> 5), rr = r & 15, cc = c & 31, ob = rr * 64 + cc * 2; return st * 1024 + (ob ^ (((ob >> 9) & 1) << 5)); }
__host__ __device__ __forceinline__ void stage_rc(int b, int& R, int& C) { const int st = b / 1024, sb = b % 1024, swz = sb ^ (((sb >> 9) & 1) << 5); R = (st >> 1) * 16 + swz / 64; C = (st & 1) * 32 + (swz % 64) / 2; }
__host__ __device__ __forceinline__ int perm32(int rho) { const int n = rho >> 4, i = rho & 15; return 8 * (i >> 2) + 4 * n + (i & 3); }

struct Unit { int pm, pn, kind; };

__device__ __forceinline__ void grid_order(int L, int nM, int nN, int& pm, int& pn) {
    const int nwg = nM * nN; int wgid = L;
    { const int q = nwg / NXCD, r = nwg % NXCD, xcd = wgid % NXCD, off = wgid / NXCD; wgid = (xcd < r ? xcd * (q + 1) : r * (q + 1) + (xcd - r) * q) + off; }
    const int nig = WGM * nN, gid = wgid / nig, fm = gid * WGM, gsz = (nM - fm) < WGM ? (nM - fm) : WGM;
    pm = fm + ((wgid % nig) % gsz); pn = (wgid % nig) / gsz;
}

template <class Epi, class Sched>
__device__ __forceinline__ void gemm_phase(LAS unsigned char* lds, const int K, const Sched& S, const Epi& E) {
    const int tid = threadIdx.x, wid = __builtin_amdgcn_readfirstlane(tid >> 6), lane = tid & 63, wr = wid >> 2, wc = wid & 3, fr = lane & 15, fq = lane >> 4;
    const int nt = K / BK;
    unsigned voffA[2], voffB[2];
#pragma unroll
    for (int i = 0; i < 2; ++i) { int R, C; stage_rc(tid * 16 + i * 8192, R, C); const int Rb = Epi::PERM ? ((R & ~31) + perm32(R & 31)) : R;
        voffA[i] = (unsigned)(R * K + C) * 2u; voffB[i] = (unsigned)(Rb * K + C) * 2u; }
    const size_t kstep = (size_t)(BK * 2);
    const size_t hstep = (size_t)HALF * K * 2;
    const unsigned ldsw = (unsigned)wid * 1024u;
    const int aoff = lds_byte(wr * 64 + fr, fq * 8), boff = lds_byte(wc * 32 + fr, fq * 8);
#define PG8_SA(b, h) (((b) * 2 + (h)) * HTB)
#define PG8_SB(b, h) ((4 + (b) * 2 + (h)) * HTB)
#define PG8_STAGE(bufoff, gbase, voff) do { _Pragma("unroll") for (int _i = 0; _i < 2; ++_i) \
        __builtin_amdgcn_global_load_lds((const unsigned*)((const char*)(gbase) + (voff)[_i]), (LAS unsigned*)(lds + (bufoff) + ldsw + _i * 8192), 16, 0, PG8_AUX); } while (0)
#define PG8_LDA(dst, b, h) do { _Pragma("unroll") for (int m = 0; m < 4; ++m) _Pragma("unroll") for (int k = 0; k < 2; ++k) dst[m][k] = *(const LAS bf16x8*)(lds + PG8_SA(b, h) + aoff + m * 2048 + k * 1024); } while (0)
#define PG8_LDB(dst, b, h) do { _Pragma("unroll") for (int n = 0; n < 2; ++n) _Pragma("unroll") for (int k = 0; k < 2; ++k) dst[n][k] = *(const LAS bf16x8*)(lds + PG8_SB(b, h) + boff + n * 2048 + k * 1024); } while (0)
#define PG8_MMA(ai, bj, At, Bt) do { __builtin_amdgcn_s_setprio(1); _Pragma("unroll") for (int m = 0; m < 4; ++m) _Pragma("unroll") for (int n = 0; n < 2; ++n) _Pragma("unroll") for (int k = 0; k < 2; ++k) \
        acc[ai][bj][m][n] = __builtin_amdgcn_mfma_f32_16x16x32_bf16(Bt[n][k], At[m][k], acc[ai][bj][m][n], 0, 0, 0); __builtin_amdgcn_s_setprio(0); } while (0)
#define PG8_WAIT_V(n) asm volatile("s_waitcnt vmcnt(" #n ")" ::: "memory")
#define PG8_WAIT_L(n) asm volatile("s_waitcnt lgkmcnt(" #n ")" ::: "memory")
#define PG8_BAR __builtin_amdgcn_s_barrier()
#define PG8_SCHED __builtin_amdgcn_sched_barrier(0)
    Unit cur, nxt; int ui = 0;
    if (!S.next(0, cur)) return;
    f32x4 acc[2][2][4][2];
#pragma unroll
    for (int a = 0; a < 2; ++a)
#pragma unroll
        for (int b = 0; b < 2; ++b)
#pragma unroll
            for (int m = 0; m < 4; ++m)
#pragma unroll
                for (int n = 0; n < 2; ++n) acc[a][b][m][n] = (f32x4){0.f, 0.f, 0.f, 0.f};
    bf16x8 At[4][2], B0[2][2], B1[2][2];
    const char* cA = S.pa(cur); const char* cB = S.pb(cur);
    PG8_STAGE(PG8_SB(0, 0), cB, voffB); PG8_STAGE(PG8_SB(0, 1), cB + hstep, voffB); PG8_STAGE(PG8_SA(0, 0), cA, voffA); PG8_STAGE(PG8_SA(0, 1), cA + hstep, voffA);
    if (wr == 1) PG8_BAR;
    PG8_WAIT_V(2); PG8_BAR;
    PG8_STAGE(PG8_SB(1, 0), cB + kstep, voffB); PG8_STAGE(PG8_SA(1, 0), cA + kstep, voffA); PG8_STAGE(PG8_SB(1, 1), cB + hstep + kstep, voffB);
    PG8_WAIT_V(6); PG8_BAR;
    for (;;) {
        const bool has_next = S.next(ui + 1, nxt);
        const char* nA = has_next ? S.pa(nxt) : cA; const char* nB = has_next ? S.pb(nxt) : cB;
        for (int t = 0; t < nt; t += 2) {
            const bool last = (t == nt - 2);
            const char* a1 = cA + (size_t)(t + 1) * kstep;
            const char* a2 = last ? nA : cA + (size_t)(t + 2) * kstep; const char* b2 = last ? nB : cB + (size_t)(t + 2) * kstep;
            const char* a3 = a2 + kstep; const char* b3 = b2 + kstep;
            PG8_LDB(B0, 0, 0); PG8_LDB(B1, 0, 1); PG8_SCHED; PG8_LDA(At, 0, 0); PG8_STAGE(PG8_SA(1, 1), a1 + hstep, voffA);
            PG8_WAIT_V(8); PG8_WAIT_L(0); PG8_BAR; PG8_MMA(0, 0, At, B0); PG8_MMA(0, 1, At, B1); PG8_BAR; PG8_SCHED;
            PG8_LDA(At, 0, 1); PG8_STAGE(PG8_SB(0, 0), b2, voffB); PG8_STAGE(PG8_SB(0, 1), b2 + hstep, voffB); PG8_STAGE(PG8_SA(0, 0), a2, voffA);
            PG8_WAIT_V(8); PG8_WAIT_L(0); PG8_BAR; PG8_MMA(1, 0, At, B0); PG8_MMA(1, 1, At, B1); PG8_BAR; PG8_SCHED;
            PG8_LDB(B0, 1, 0); PG8_LDB(B1, 1, 1); PG8_SCHED; PG8_LDA(At, 1, 0); PG8_STAGE(PG8_SA(0, 1), a2 + hstep, voffA);
            PG8_WAIT_V(8); PG8_WAIT_L(0); PG8_BAR; PG8_MMA(0, 0, At, B0); PG8_MMA(0, 1, At, B1); PG8_BAR; PG8_SCHED;
            PG8_LDA(At, 1, 1); PG8_STAGE(PG8_SB(1, 0), b3, voffB); PG8_STAGE(PG8_SB(1, 1), b3 + hstep, voffB); PG8_STAGE(PG8_SA(1, 0), a3, voffA);
            PG8_WAIT_V(8); PG8_WAIT_L(0); PG8_BAR; PG8_MMA(1, 0, At, B0); PG8_MMA(1, 1, At, B1); PG8_BAR; PG8_SCHED;
        }
        if (wr == 0) PG8_BAR;
        if constexpr (Epi::HAS_PRE) {
            E.pre(cur, (LAS float*)(lds + STAGE_BYTES + 1024), tid); PG8_WAIT_L(0); PG8_BAR; }
        E(acc, cur, wr, wc, fr, fq, (const LAS float*)(lds + STAGE_BYTES + 1024));
        if (!has_next) break;
#pragma unroll
        for (int a = 0; a < 2; ++a)
#pragma unroll
            for (int b = 0; b < 2; ++b)
#pragma unroll
                for (int m = 0; m < 4; ++m)
#pragma unroll
                    for (int n = 0; n < 2; ++n) acc[a][b][m][n] = (f32x4){0.f, 0.f, 0.f, 0.f};
        cur = nxt; cA = nA; cB = nB; ++ui;
        if (wr == 1) PG8_BAR;
    }
    PG8_WAIT_V(0);
    PG8_BAR;
#undef PG8_SA
#undef PG8_SB
#undef PG8_STAGE
#undef PG8_LDA
#undef PG8_LDB
#undef PG8_MMA
#undef PG8_WAIT_V
#undef PG8_WAIT_L
#undef PG8_BAR
#undef PG8_SCHED
}
}
typedef GAS unsigned gu32;
#define RLX_AGENT __ATOMIC_RELAXED, __HIP_MEMORY_SCOPE_AGENT
#define XB_TMO      128
#define XB_XCNT(j)  (256  + 64 * (j))
#define XB_XSUB(j)  (1280 + 64 * (j))
#define XB_XGEN(j)  (2304 + 64 * (j))
#define XB_TOP      3328
#define XB_TOPGEN   3392
#define XCD_BAR_WORDS 3456
#define XB_SPIN_CAP (1u << 18)
__device__ __forceinline__ unsigned xb_ld(unsigned* p)              { return __hip_atomic_load(p, __ATOMIC_RELAXED, __HIP_MEMORY_SCOPE_AGENT); }
__device__ __forceinline__ unsigned xb_add(unsigned* p, unsigned v) { return __hip_atomic_fetch_add(p, v, __ATOMIC_RELAXED, __HIP_MEMORY_SCOPE_AGENT); }
__device__ __forceinline__ unsigned xb_xcc_id() { return (unsigned)__builtin_amdgcn_s_getreg((3 << 11) | 20) & 0xFu; }
#define XB_SPIN(cond, bar) do { unsigned _sp = 0; while (cond) { __builtin_amdgcn_s_sleep(1); \
    if ((++_sp & 255u) == 0u) { if (xb_ld(&(bar)[XB_TMO])) break; if (_sp > XB_SPIN_CAP) { atomicAdd(&(bar)[XB_TMO], 1u); break; } } } } while (0)
struct XcdBarrier { unsigned* bar; unsigned x; volatile LAS unsigned* st; };
__device__ __forceinline__ XcdBarrier xcd_barrier_post(unsigned* bar, volatile LAS unsigned* st) {
    XcdBarrier b; b.bar = bar; b.x = xb_xcc_id(); b.st = st;
    if (threadIdx.x == 0) (void)xb_add(&bar[XB_XCNT(b.x)], 1u);
    return b;
}
__device__ __forceinline__ void xcd_barrier_complete(unsigned* bar, unsigned x, unsigned& nloc, unsigned& nx) {
    const unsigned G = gridDim.x * gridDim.y * gridDim.z;
    unsigned sum, cnt, mine, sp = 0u;
    for (;;) {
        sum = 0u; cnt = 0u; mine = 0u;
#pragma unroll
        for (unsigned j = 0; j < 16; ++j) { const unsigned c = xb_ld(&bar[XB_XCNT(j)]); sum += c; cnt += (c > 0u) ? 1u : 0u; mine = (j == x) ? c : mine; }
        if (sum == G) break;
        __builtin_amdgcn_s_sleep(1);
        if ((++sp & 255u) == 0u) { if (xb_ld(&bar[XB_TMO])) break; if (sp > XB_SPIN_CAP) { atomicAdd(&bar[XB_TMO], 1u); break; } }
    }
    nloc = mine > 0u ? mine : 1u; nx = cnt > 0u ? cnt : 1u;
}
__device__ __forceinline__ void xcd_barrier(const XcdBarrier& b) {
    asm volatile("s_waitcnt vmcnt(0)" ::: "memory");
    __syncthreads();
    if (threadIdx.x == 0) {
        unsigned* bar = b.bar;
        __builtin_amdgcn_s_waitcnt(0);
        unsigned nloc = b.st[0], nx = b.st[1];
        if (nloc == 0u) { xcd_barrier_complete(bar, b.x, nloc, nx); b.st[0] = nloc; b.st[1] = nx; }
        const unsigned old = xb_add(&bar[XB_XSUB(b.x)], 1u);
        const unsigned gen = old / nloc;
        if (old + 1u == (gen + 1u) * nloc) {
            __builtin_amdgcn_fence(__ATOMIC_RELEASE, "agent");
            asm volatile("s_waitcnt vmcnt(0)" ::: "memory");
            const unsigned og = xb_add(&bar[XB_TOP], 1u);
            const unsigned tg = og / nx;
            if (og + 1u == (tg + 1u) * nx) xb_add(&bar[XB_TOPGEN], 1u);
            else XB_SPIN(xb_ld(&bar[XB_TOPGEN]) == tg, bar);
            __builtin_amdgcn_fence(__ATOMIC_ACQUIRE, "agent");
            xb_add(&bar[XB_XGEN(b.x)], 1u);
            asm volatile("s_waitcnt vmcnt(0)" ::: "memory");
        } else {
            XB_SPIN(xb_ld(&bar[XB_XGEN(b.x)]) == gen, bar);
            __builtin_amdgcn_fence(__ATOMIC_ACQUIRE, "agent");
            asm volatile("s_waitcnt vmcnt(0)" ::: "memory");
        }
    }
    __syncthreads();
}
struct Frame {
    LAS unsigned char* lds;
    volatile LAS unsigned* MISC;
    unsigned char* ws;
    int tid, lane, wave;
    int vcu, G;
    const float* in[19];
    float* out;
};
#define WSP(T, off) ((T*)(F.ws + (off)))

__device__ __forceinline__ void p0_transpose_item(const float* W, int K, int N, int k0, int n0, bf16_t* WT, int drow, bool rope, const float* gain, LAS float* scr, int lane) {
#pragma unroll 8
    for (int i = 0; i < 32; ++i) { const int kk = 2 * i + (lane >> 5); float w = W[(size_t)(k0 + kk) * N + n0 + (lane & 31)]; if (gain) w *= gain[k0 + kk]; scr[kk * 33 + (lane & 31)] = w; }
    LDS_WAIT(); asm volatile("" ::: "memory");
    const int c = lane & 7;
#pragma unroll
    for (int j = 0; j < 4; ++j) { const int n = (lane >> 3) + 8 * j; const LAS float* s = scr + (8 * c) * 33 + n;
        u32x4 o; o.x = cvt_pk_bf16(s[0 * 33], s[1 * 33]); o.y = cvt_pk_bf16(s[2 * 33], s[3 * 33]); o.z = cvt_pk_bf16(s[4 * 33], s[5 * 33]); o.w = cvt_pk_bf16(s[6 * 33], s[7 * 33]);
        const int dr = drow + (rope ? (8 * (n >> 2) + (n & 3)) : n);
        *(GAS u32x4*)(WT + (size_t)dr * K + k0 + 8 * c) = o; }
    LDS_WAIT(); asm volatile("" ::: "memory");
}
__device__ __forceinline__ void rms_row_to_bf16(const float* xrow, const float* g, bf16_t* orow, int lane) {
    const GAS f32x4* xr = (const GAS f32x4*)xrow + lane; const GAS f32x4* gr = (const GAS f32x4*)g + lane;
    f32x4 v[8]; float s = 0.f;
#pragma unroll
    for (int j = 0; j < 8; ++j) { v[j] = xr[64 * j]; s += (v[j].x * v[j].x + v[j].y * v[j].y) + (v[j].z * v[j].z + v[j].w * v[j].w); }
    const float rstd = 1.0f / sqrtf(wave_sum(s) * (1.f / DM) + NORM_EPS);
    GAS u32x2* o8 = (GAS u32x2*)orow + lane;
#pragma unroll
    for (int j = 0; j < 8; ++j) { const f32x4 gg = gr[64 * j]; o8[64 * j] = pack4((v[j] * rstd) * gg); }
}
template <int PART>
__device__ __forceinline__ void p0_prologue(Frame& F, int rank, int nrank) {
    LAS float* scr = (LAS float*)(F.lds + F.wave * 16384);
    const int gw = rank * NWAVES + F.wave, NGW = nrank * NWAVES, lane = F.lane; const int gt = rank * 512 + F.tid, NGT = nrank * 512;
    bf16_t* WIN = WSP(bf16_t, WS_WIN); bf16_t* WVT = WSP(bf16_t, WS_WVT);
    constexpr int I_IN = 32 * 258, I_UQ = 8 * 96, I_UKV = 8 * 128, I_NA = 16 * 64, I_MLA = 32 * 64, I_OUT = 32 * 64;
    constexpr int NEARLY = I_IN + I_UQ + I_UKV, NITEMS = NEARLY + I_NA + I_MLA + I_OUT;
    for (int it = (PART == 0 ? 0 : NEARLY) + gw; it < (PART == 0 ? NEARLY : NITEMS); it += NGW) {
        int r = it;
        if (r < I_IN) { const int kb = r / 258, sb = r % 258, n0 = 32 * sb, k0 = 64 * kb; const float* W = F.in[3];
            bf16_t* dst = WIN; int drow; bool rope = false;
            if (n0 < 1024) drow = C_NAQ + n0;
            else if (n0 < 2048) drow = C_NAK + (n0 - 1024);
            else if (n0 < 3072) { dst = WVT; drow = n0 - 2048; }
            else if (n0 < 3584) drow = C_CQ + (n0 - 3072);
            else if (n0 < 4096) drow = C_CKV + (n0 - 3584);
            else if (n0 < 4160) { drow = C_KR + ((n0 - 4096) ? 4 : 0); rope = true; }
            else if (n0 < 6208) drow = C_GA + (n0 - 4160);
            else drow = C_GB + (n0 - 6208);
            p0_transpose_item(W, 2048, 8256, k0, n0, dst, drow, rope, nullptr, scr, lane); continue; } r -= I_IN;
        if (r < I_UQ) { const int kb = r / 96, sb = r % 96, n0 = 32 * sb, k0 = 64 * kb; const int hd = n0 / 192, w = n0 % 192;
            int drow = n0; bool rope = false; if (w >= 128) { rope = true; drow = hd * 192 + 128 + ((w - 128) ? 4 : 0); }
            p0_transpose_item(F.in[7], 512, 3072, k0, n0, WSP(bf16_t, WS_WUQ), drow, rope, F.in[6], scr, lane); continue; } r -= I_UQ;
        if (r < I_UKV) { const int kb = r / 128, sb = r % 128; p0_transpose_item(F.in[9], 512, 4096, 64 * kb, 32 * sb, WSP(bf16_t, WS_WUKV), 32 * sb, false, F.in[8], scr, lane); continue; } r -= I_UKV;
        if (r < I_NA) { const int kb = r / 64, sb = r % 64; p0_transpose_item(F.in[10], 1024, 2048, 64 * kb, 32 * sb, WSP(bf16_t, WS_WNA), 32 * sb, false, nullptr, scr, lane); continue; } r -= I_NA;
        if (r < I_MLA) { const int kb = r / 64, sb = r % 64; p0_transpose_item(F.in[11], 2048, 2048, 64 * kb, 32 * sb, WSP(bf16_t, WS_WMLA), 32 * sb, false, nullptr, scr, lane); continue; } r -= I_MLA;
        { const int kb = r / 64, sb = r % 64; p0_transpose_item(F.in[12], 2048, 2048, 64 * kb, 32 * sb, WSP(bf16_t, WS_WOUT), 32 * sb, false, nullptr, scr, lane); }
    }
    if (PART == 0) { GAS u32x4* z = (GAS u32x4*)(WIN + (size_t)(C_KR + 64) * 2048); const int n16 = (NMAIN - C_KR - 64) * 2048 * 2 / 16;
      for (int i = gt; i < n16; i += NGT) z[i] = (u32x4){0u, 0u, 0u, 0u}; }
    if (PART == 0) { bf16_t* HN1 = WSP(bf16_t, WS_HN1);
      for (int m = gw; m < MREAL + NMETA; m += NGW) {
          const float* src = (m < MREAL) ? F.in[0] + (size_t)m * DM : F.in[1] + (size_t)(m - MREAL) * DM;
          rms_row_to_bf16(src, F.in[2], HN1 + (size_t)m * DM, lane); }
      GAS u32x4* z = (GAS u32x4*)(HN1 + (size_t)(MREAL + NMETA) * DM); const int n16 = (MPAD - MREAL - NMETA) * DM * 2 / 16;
      for (int i = gt; i < n16; i += NGT) z[i] = (u32x4){0u, 0u, 0u, 0u}; }
    if (PART == 0) { float* ct = WSP(float, WS_COS); float* st = WSP(float, WS_SIN);
      for (int i = gt; i < NPOS * 32; i += NGT) { const int p = i >> 5, j = i & 31;
          const float inv = __builtin_powf(10000.0f, -(float)(2 * j) / 64.0f); const float ang = (float)p * inv;
          double r = (double)ang * 0.15915494309189535; r -= __builtin_rint(r); const float rf = (float)r;
          ct[i] = __builtin_amdgcn_cosf(rf); st[i] = __builtin_amdgcn_sinf(rf); } }
    if (PART == 1) { const float* SK = F.in[15]; const float* WQ = F.in[14]; const float* g2 = F.in[13]; bf16_t* WSCp = WSP(bf16_t, WS_WSC);
      const int l15 = lane & 15, l4 = lane >> 4;
      for (int task = gw; task < 2048; task += NGW) { const int g = task >> 7, nt = (task >> 4) & 7, kc = task & 15, n0 = nt * 16;
          bf16x8 bfr[4];
#pragma unroll
          for (int kk = 0; kk < 4; ++kk) { const float* p = SK + ((size_t)g * 128 + n0 + l15) * 128 + 32 * kk + 8 * l4; const f32x4 a = *(const GAS f32x4*)p, b = *(const GAS f32x4*)(p + 4);
              const u32x4 w = pack8(a, b); bfr[kk] = __builtin_bit_cast(bf16x8, w); }
          for (int kt = 0; kt < 8; ++kt) { const int k0 = (kc * 8 + kt) * 16; f32x4 acc = (f32x4){0.f, 0.f, 0.f, 0.f};
#pragma unroll
              for (int kk = 0; kk < 4; ++kk) { const float* p = WQ + (size_t)(k0 + l15) * 2048 + g * 128 + 32 * kk + 8 * l4; const f32x4 a = *(const GAS f32x4*)p, b = *(const GAS f32x4*)(p + 4);
                  const u32x4 w = pack8(a, b); acc = __builtin_amdgcn_mfma_f32_16x16x32_bf16(__builtin_bit_cast(bf16x8, w), bfr[kk], acc, 0, 0, 0); }
              const f32x4 gg = *(const GAS f32x4*)(g2 + k0 + 4 * l4);
              *(GAS u32x2*)(WSCp + (size_t)(g * 128 + n0 + l15) * 2048 + k0 + 4 * l4) = pack4(acc * gg); } } }
}
using pg8::Unit;
struct SchedGrid {
    int G, c, nM, nN; const char* A; const char* B; size_t tstep;
    __device__ __forceinline__ bool next(int i, Unit& u) const { const int L = i * G + c; if (L >= nM * nN) return false; pg8::grid_order(L, nM, nN, u.pm, u.pn); u.kind = 0; return true; }
    __device__ __forceinline__ const char* pa(const Unit& u) const { return A + (size_t)u.pm * tstep; }
    __device__ __forceinline__ const char* pb(const Unit& u) const { return B + (size_t)u.pn * tstep; }
};
constexpr int P1_MAIN = 64 * 29, P1_VT = 4 * 65, P1_META = 7, P1_UNITS = P1_MAIN + P1_VT + P1_META;
struct SchedP1 {
    int G, c; const char* hn1; const char* win; const char* wvt; size_t tstep;
    __device__ __forceinline__ bool next(int i, Unit& u) const {
        const int L = i * G + c; if (L >= P1_UNITS) return false;
        if (L < P1_MAIN) { pg8::grid_order(L, 64, 29, u.pm, u.pn); u.kind = 0; }
        else if (L < P1_MAIN + P1_VT) { const int idx = L - P1_MAIN; u.pm = idx & 3; u.pn = idx >> 2; u.kind = 1; }
        else { const int idx = L - P1_MAIN - P1_VT; u.pm = 64; u.pn = idx < 4 ? 4 + idx : (idx < 6 ? 10 + (idx - 4) : 28); u.kind = 0; }
        return true; }
    __device__ __forceinline__ const char* pa(const Unit& u) const { return (u.kind == 1 ? wvt : hn1) + (size_t)u.pm * tstep; }
    __device__ __forceinline__ const char* pb(const Unit& u) const { return (u.kind == 1 ? hn1 : win) + (size_t)u.pn * tstep; }
};
__device__ __forceinline__ void rope4(const f32x4 x1, const f32x4 x2, const float* cosT, const float* sinT, int pos, int j0, f32x4& lo, f32x4& hi) {
    const f32x4 c = *(const GAS f32x4*)(cosT + pos * 32 + j0), s = *(const GAS f32x4*)(sinT + pos * 32 + j0);
    lo = x1 * c - x2 * s; hi = x2 * c + x1 * s;
}
struct EpiP1 {
    static constexpr bool PERM = true, HAS_PRE = false;
    bf16_t *naq, *nak, *vt, *cq, *ckv, *kr, *ga, *gb; float *ssq_q, *ssq_kv; const float *cosT, *sinT;
    __device__ __forceinline__ void operator()(const f32x4 (&acc)[2][2][4][2], const Unit& u, int wr, int wc, int fr, int fq, const LAS float* rowsc) const {
        const int row0 = u.pm * 256 + wr * 64 + fr, colu = wc * 32 + 8 * fq;
        if (u.kind == 1) {
#pragma unroll
            for (int ai = 0; ai < 2; ++ai)
#pragma unroll
                for (int m = 0; m < 4; ++m) { bf16_t* rp = vt + (size_t)(row0 + ai * 128 + m * 16) * VT_PITCH + u.pn * 256 + colu;
#pragma unroll
                    for (int bj = 0; bj < 2; ++bj) *(GAS u32x4*)(rp + bj * 128) = pack8(acc[ai][bj][m][0], acc[ai][bj][m][1]); }
            return; }
        const int pn = u.pn;
        if (pn == 28) {
            if (wc < 2) { const int j0 = 4 * (4 * wc + fq);
#pragma unroll
                for (int ai = 0; ai < 2; ++ai)
#pragma unroll
                    for (int m = 0; m < 4; ++m) { const int row = row0 + ai * 128 + m * 16; const int pos = row < MREAL ? NMETA + (row & (SEQ - 1)) : row - MREAL;
                        f32x4 lo, hi; rope4(acc[ai][0][m][0], acc[ai][0][m][1], cosT, sinT, pos, j0, lo, hi);
                        *(GAS u32x2*)(kr + (size_t)row * 64 + j0) = pack4(lo); *(GAS u32x2*)(kr + (size_t)row * 64 + 32 + j0) = pack4(hi); } }
            return; }
        if (pn >= 12) {
            bf16_t* base = pn < 20 ? ga : gb; const int colt = (pn < 20 ? pn - 12 : pn - 20) * 256 + colu;
#pragma unroll
            for (int ai = 0; ai < 2; ++ai)
#pragma unroll
                for (int m = 0; m < 4; ++m) { bf16_t* rp = base + (size_t)(row0 + ai * 128 + m * 16) * 2048 + colt;
#pragma unroll
                    for (int bj = 0; bj < 2; ++bj) { f32x4 a = acc[ai][bj][m][0], b = acc[ai][bj][m][1];
#pragma unroll
                        for (int i = 0; i < 4; ++i) { a[i] = sigmoidf_(a[i]); b[i] = sigmoidf_(b[i]); }
                        *(GAS u32x4*)(rp + bj * 128) = pack8(a, b); } }
            return; }
        if (pn >= 8) {
            const bool isq = pn < 10; bf16_t* base = isq ? cq : ckv; float* ssq = isq ? ssq_q : ssq_kv; const int colt = (isq ? pn - 8 : pn - 10) * 256 + colu;
#pragma unroll
            for (int ai = 0; ai < 2; ++ai)
#pragma unroll
                for (int m = 0; m < 4; ++m) { const int row = row0 + ai * 128 + m * 16; bf16_t* rp = base + (size_t)row * 512 + colt; float s = 0.f;
#pragma unroll
                    for (int bj = 0; bj < 2; ++bj) { const f32x4 a = acc[ai][bj][m][0], b = acc[ai][bj][m][1];
                        s += (a[0] * a[0] + a[1] * a[1]) + (a[2] * a[2] + a[3] * a[3]) + (b[0] * b[0] + b[1] * b[1]) + (b[2] * b[2] + b[3] * b[3]);
                        *(GAS u32x4*)(rp + bj * 128) = pack8(a, b); }
                    s += __shfl_xor(s, 16); s += __shfl_xor(s, 32);
                    if (fq == 0) ssq[(size_t)((pn & 1) * 4 + wc) * MPAD + row] = s; }
            return; }
        {
            bf16_t* base = pn < 4 ? naq : nak; const int colt = (pn & 3) * 256 + colu;
#pragma unroll
            for (int ai = 0; ai < 2; ++ai)
#pragma unroll
                for (int m = 0; m < 4; ++m) { bf16_t* rp = base + (size_t)(row0 + ai * 128 + m * 16) * 1024 + colt;
#pragma unroll
                    for (int bj = 0; bj < 2; ++bj) *(GAS u32x4*)(rp + bj * 128) = pack8(acc[ai][bj][m][0], acc[ai][bj][m][1]); }
        }
    }
};
constexpr int P3_Q = 64 * 12, P3_KV = 65 * 16, P3_UNITS = P3_Q + P3_KV;
struct SchedP3 {
    int G, c; const char* cq; const char* ckv; const char* wuq; const char* wukv; size_t tstep;
    __device__ __forceinline__ bool next(int i, Unit& u) const {
        const int L = i * G + c; if (L >= P3_UNITS) return false;
        if (L < P3_Q) { pg8::grid_order(L, 64, 12, u.pm, u.pn); u.kind = 0; } else { pg8::grid_order(L - P3_Q, 65, 16, u.pm, u.pn); u.kind = 1; }
        return true; }
    __device__ __forceinline__ const char* pa(const Unit& u) const { return (u.kind ? ckv : cq) + (size_t)u.pm * tstep; }
    __device__ __forceinline__ const char* pb(const Unit& u) const { return (u.kind ? wukv : wuq) + (size_t)u.pn * tstep; }
};
template <int NS, int LD> __device__ __forceinline__ float rstd_slabs(const float* part, int row, float invn) {
    float s = 0.f;
#pragma unroll
    for (int i = 0; i < NS; ++i) s += part[(size_t)i * LD + row];
    return 1.0f / sqrtf(s * invn + NORM_EPS);
}
struct EpiP3 {
    static constexpr bool PERM = true, HAS_PRE = true;
    bf16_t *qm, *kn, *vv; const float *ssq_q, *ssq_kv; const float *cosT, *sinT;
    __device__ __forceinline__ void pre(const Unit& u, LAS float* sc, int tid) const { if (tid < 256) { const int row = u.pm * 256 + tid; sc[tid] = u.kind ? rstd_slabs<8, MPAD>(ssq_kv, row, 1.f / 512.f) : rstd_slabs<8, MPAD>(ssq_q, row, 1.f / 512.f); } }
    __device__ __forceinline__ void operator()(const f32x4 (&acc)[2][2][4][2], const Unit& u, int wr, int wc, int fr, int fq, const LAS float* rowsc) const {
        const int row0 = u.pm * 256 + wr * 64 + fr, colu = wc * 32 + 8 * fq;
        if (u.kind == 1) {
#pragma unroll
            for (int ai = 0; ai < 2; ++ai)
#pragma unroll
                for (int m = 0; m < 4; ++m) { const int row = row0 + ai * 128 + m * 16; const float rs = rowsc[ai * 128 + wr * 64 + m * 16 + fr];
                    const size_t off = (size_t)row * 2048 + u.pn * 128 + colu;
                    *(GAS u32x4*)(kn + off) = pack8(acc[ai][0][m][0] * rs, acc[ai][0][m][1] * rs);
                    *(GAS u32x4*)(vv + off) = pack8(acc[ai][1][m][0] * rs, acc[ai][1][m][1] * rs); }
            return; }
#pragma unroll
        for (int bj = 0; bj < 2; ++bj) { const int c8 = u.pn * 256 + bj * 128 + colu; const int hd = c8 / 192, w = c8 - hd * 192;
            if (w < 128) {
#pragma unroll
                for (int ai = 0; ai < 2; ++ai)
#pragma unroll
                    for (int m = 0; m < 4; ++m) { const int row = row0 + ai * 128 + m * 16; const float rs = rowsc[ai * 128 + wr * 64 + m * 16 + fr];
                        *(GAS u32x4*)(qm + (size_t)row * 3072 + c8) = pack8(acc[ai][bj][m][0] * rs, acc[ai][bj][m][1] * rs); }
            } else { const int j0 = (w - 128) >> 1;
#pragma unroll
                for (int ai = 0; ai < 2; ++ai)
#pragma unroll
                    for (int m = 0; m < 4; ++m) { const int row = row0 + ai * 128 + m * 16; const float rs = rowsc[ai * 128 + wr * 64 + m * 16 + fr];
                        const int pos = NMETA + (row & (SEQ - 1)); f32x4 lo, hi; rope4(acc[ai][bj][m][0] * rs, acc[ai][bj][m][1] * rs, cosT, sinT, pos, j0, lo, hi);
                        bf16_t* qp = qm + (size_t)row * 3072 + hd * 192 + 128 + j0; *(GAS u32x2*)qp = pack4(lo); *(GAS u32x2*)(qp + 32) = pack4(hi); }
            } }
    }
};
__device__ __forceinline__ void unpack8(const u32x4 w, f32x4& a, f32x4& b) { a = (f32x4){bf_lo(w.x), bf_hi(w.x), bf_lo(w.y), bf_hi(w.y)}; b = (f32x4){bf_lo(w.z), bf_hi(w.z), bf_lo(w.w), bf_hi(w.w)}; }
struct EpiP5a {
    static constexpr bool PERM = true, HAS_PRE = false;
    const bf16_t* ga; bf16_t* t1;
    __device__ __forceinline__ void operator()(const f32x4 (&acc)[2][2][4][2], const Unit& u, int wr, int wc, int fr, int fq, const LAS float* rowsc) const {
        const int row0 = u.pm * 256 + wr * 64 + fr, col0 = u.pn * 256 + wc * 32 + 8 * fq;
#pragma unroll
        for (int ai = 0; ai < 2; ++ai)
#pragma unroll
            for (int m = 0; m < 4; ++m) { const size_t off = (size_t)(row0 + ai * 128 + m * 16) * 2048 + col0;
#pragma unroll
                for (int bj = 0; bj < 2; ++bj) { f32x4 g0, g1; unpack8(*(const GAS u32x4*)(ga + off + bj * 128), g0, g1);
                    *(GAS u32x4*)(t1 + off + bj * 128) = pack8(acc[ai][bj][m][0] * g0, acc[ai][bj][m][1] * g1); } }
    }
};
struct EpiP5b {
    static constexpr bool PERM = true, HAS_PRE = false;
    const bf16_t* gb; const bf16_t* t1; bf16_t* merged;
    __device__ __forceinline__ void operator()(const f32x4 (&acc)[2][2][4][2], const Unit& u, int wr, int wc, int fr, int fq, const LAS float* rowsc) const {
        const int row0 = u.pm * 256 + wr * 64 + fr, col0 = u.pn * 256 + wc * 32 + 8 * fq;
#pragma unroll
        for (int ai = 0; ai < 2; ++ai)
#pragma unroll
            for (int m = 0; m < 4; ++m) { const size_t off = (size_t)(row0 + ai * 128 + m * 16) * 2048 + col0;
#pragma unroll
                for (int bj = 0; bj < 2; ++bj) { f32x4 g0, g1; unpack8(*(const GAS u32x4*)(gb + off + bj * 128), g0, g1);
                    f32x4 a, b; unpack8(*(const GAS u32x4*)(t1 + off + bj * 128), a, b);
                    *(GAS u32x4*)(merged + off + bj * 128) = pack8(a + acc[ai][bj][m][0] * g0, b + acc[ai][bj][m][1] * g1); } }
    }
};
struct EpiP6 {
    static constexpr bool PERM = true, HAS_PRE = false;
    const float* x; float* h2; bf16_t* h2b; float* ssq2;
    __device__ __forceinline__ void operator()(const f32x4 (&acc)[2][2][4][2], const Unit& u, int wr, int wc, int fr, int fq, const LAS float* rowsc) const {
        const int row0 = u.pm * 256 + wr * 64 + fr, col0 = u.pn * 256 + wc * 32 + 8 * fq;
#pragma unroll
        for (int ai = 0; ai < 2; ++ai)
#pragma unroll
            for (int m = 0; m < 4; ++m) { const int row = row0 + ai * 128 + m * 16; const size_t off = (size_t)row * 2048 + col0; float s = 0.f;
#pragma unroll
                for (int bj = 0; bj < 2; ++bj) { const f32x4 a = *(const GAS f32x4*)(x + off + bj * 128) + acc[ai][bj][m][0], b = *(const GAS f32x4*)(x + off + bj * 128 + 4) + acc[ai][bj][m][1];
                    s += (a[0] * a[0] + a[1] * a[1]) + (a[2] * a[2] + a[3] * a[3]) + (b[0] * b[0] + b[1] * b[1]) + (b[2] * b[2] + b[3] * b[3]);
                    *(GAS f32x4*)(h2 + off + bj * 128) = a; *(GAS f32x4*)(h2 + off + bj * 128 + 4) = b; *(GAS u32x4*)(h2b + off + bj * 128) = pack8(a, b); }
                s += __shfl_xor(s, 16); s += __shfl_xor(s, 32);
                if (fq == 0) ssq2[(size_t)(u.pn * 4 + wc) * MREAL + row] = s; }
    }
};
struct EpiP7 {
    static constexpr bool PERM = false, HAS_PRE = true;
    const float* ssq2; float* sc;
    __device__ __forceinline__ void pre(const Unit& u, LAS float* sc, int tid) const { if (tid < 256) sc[tid] = rstd_slabs<32, MREAL>(ssq2, u.pm * 256 + tid, 1.f / 2048.f); }
    __device__ __forceinline__ void operator()(const f32x4 (&acc)[2][2][4][2], const Unit& u, int wr, int wc, int fr, int fq, const LAS float* rowsc) const {
        const int row0 = u.pm * 256 + wr * 64 + fr, col0 = u.pn * 256 + wc * 32 + 4 * fq;
#pragma unroll
        for (int ai = 0; ai < 2; ++ai)
#pragma unroll
            for (int m = 0; m < 4; ++m) { const int row = row0 + ai * 128 + m * 16; const float rs = rowsc[ai * 128 + wr * 64 + m * 16 + fr]; const size_t off = (size_t)row * 2048 + col0;
#pragma unroll
                for (int bj = 0; bj < 2; ++bj)
#pragma unroll
                    for (int n = 0; n < 2; ++n) *(GAS f32x4*)(sc + off + bj * 128 + n * 16) = acc[ai][bj][m][n] * rs; }
    }
};
namespace att {
#define KSWZ(row, colB) ((row) * 256 + ((colB) ^ (((row) & 7) << 4)))
#define KRSWZ(row, colB) ((row) * 128 + ((colB) ^ ((((row) >> 1) & 7) << 4)))
constexpr float L2E = 1.4426950408889634f;
template <int DUMMY = 0>
__device__ __forceinline__ void partialSM(f32x16& p0, f32x16& p1, float& m_reg, float& mn, float& alpha, const float C, const float THRS) {
  float pmax = p0[0];
#pragma unroll
  for (int r = 1; r < 16; ++r) pmax = fmaxf(pmax, p0[r]);
#pragma unroll
  for (int r = 0; r < 16; ++r) pmax = fmaxf(pmax, p1[r]);
  { auto rr = __builtin_amdgcn_permlane32_swap(__float_as_uint(pmax), __float_as_uint(pmax), false, false);
    pmax = fmaxf(__uint_as_float(rr[0]), __uint_as_float(rr[1])); }
  if (__builtin_expect(__all(pmax - m_reg <= THRS), 1)) { mn = m_reg; alpha = 1.f; }
  else { mn = fmaxf(m_reg, pmax); alpha = __builtin_amdgcn_exp2f((m_reg - mn) * C); m_reg = mn; }
  const float mnC = -mn * C;
#pragma unroll
  for (int r = 0; r < 16; ++r) p0[r] = fmaf(p0[r], C, mnC);
#pragma unroll
  for (int r = 0; r < 16; ++r) p1[r] = fmaf(p1[r], C, mnC);
#pragma unroll
  for (int r = 0; r < 16; ++r) p0[r] = __builtin_amdgcn_exp2f(p0[r]);
}
__device__ __forceinline__ void finishSM(f32x16& p0, f32x16& p1, float alpha, float& l_reg, bf16x8& pa0, bf16x8& pa1, bf16x8& pa2, bf16x8& pa3) {
#pragma unroll
  for (int r = 0; r < 16; ++r) p1[r] = __builtin_amdgcn_exp2f(p1[r]);
  float ps = 0;
#pragma unroll
  for (int r = 0; r < 16; ++r) ps += p0[r];
#pragma unroll
  for (int r = 0; r < 16; ++r) ps += p1[r];
  { auto rr = __builtin_amdgcn_permlane32_swap(__float_as_uint(ps), __float_as_uint(ps), false, false);
    ps = __uint_as_float(rr[0]) + __uint_as_float(rr[1]); }
  l_reg = l_reg * alpha + ps;
#define PK4(P, BASE, OUT) do { unsigned a0 = cvt_pk_bf16(P[BASE + 0], P[BASE + 1]), a1 = cvt_pk_bf16(P[BASE + 2], P[BASE + 3]);   \
    unsigned b0 = cvt_pk_bf16(P[BASE + 4], P[BASE + 5]), b1 = cvt_pk_bf16(P[BASE + 6], P[BASE + 7]);                              \
    auto r0 = __builtin_amdgcn_permlane32_swap(a0, b0, false, false); auto r1 = __builtin_amdgcn_permlane32_swap(a1, b1, false, false); \
    u32x4 w = {r0[0], r1[0], r0[1], r1[1]}; OUT = __builtin_bit_cast(bf16x8, w); } while (0)
  PK4(p0, 0, pa0); PK4(p0, 8, pa1); PK4(p1, 0, pa2); PK4(p1, 8, pa3);
#undef PK4
}
constexpr int NW = 8, QBLK = 32, KVBLK = 64;
constexpr float MLA_SCALE = 0.07216878364870322f;
constexpr float MLA_THR = 8.f;
constexpr int SHM_V = KVBLK * 128 * 2, SHM_KN = KVBLK * 128 * 2, SHM_KR = KVBLK * 64 * 2;
constexpr int OFF_V = 0, OFF_KN = 2 * SHM_V, OFF_KR = OFF_KN + 2 * SHM_KN, OFF_WS = OFF_KR + 2 * SHM_KR, OFF_QR = OFF_WS + NW * 64 * 4, MLA_LDS = OFF_QR + NW * 4096;
__device__ __forceinline__ void qkt(f32x16& p0, f32x16& p1, const LAS char* Kn, const LAS char* Kr, const bf16x8* qr, const LAS char* qrp, const int* kb, const int* krb) {
  p0 = f32x16{}; p1 = f32x16{};
#pragma unroll
  for (int d0 = 0; d0 < 8; ++d0) {
    const bf16x8 b0 = *(const LAS bf16x8*)(Kn + kb[d0 & 3] + (d0 >> 2) * 128);
    const bf16x8 b1 = *(const LAS bf16x8*)(Kn + kb[d0 & 3] + (d0 >> 2) * 128 + 8192);
    p0 = __builtin_amdgcn_mfma_f32_32x32x16_bf16(b0, qr[d0], p0, 0, 0, 0);
    p1 = __builtin_amdgcn_mfma_f32_32x32x16_bf16(b1, qr[d0], p1, 0, 0, 0); }
#pragma unroll
  for (int d0 = 0; d0 < 4; ++d0) {
    const bf16x8 b0 = *(const LAS bf16x8*)(Kr + krb[d0]);
    const bf16x8 b1 = *(const LAS bf16x8*)(Kr + krb[d0] + 4096);
    const bf16x8 qf = *(const LAS bf16x8*)(qrp + d0 * 1024);
    p0 = __builtin_amdgcn_mfma_f32_32x32x16_bf16(b0, qf, p0, 0, 0, 0);
    p1 = __builtin_amdgcn_mfma_f32_32x32x16_bf16(b1, qf, p1, 0, 0, 0); }
}
__device__ __forceinline__ int v_st(int k, int c) { const int kk = (k & ~0xC) | ((k & 4) << 1) | ((k & 8) >> 1); return ((kk >> 3) * 4 + (c >> 5)) * 512 + ((kk & 7) * 32 + (c & 31)) * 2; }
__device__ __forceinline__ int v_rd_base(int lane) { return ((lane & 3) << 3) | (((lane >> 2) & 3) << 6) | (((lane >> 4) & 1) << 5) | (((lane >> 5) & 1) << 8); }
constexpr int v_rd_off(int d0, int ks, int half) { return d0 * 512 + ks * 4096 + half * 2048; }
template <int OFF> __device__ __forceinline__ s16x4 tr_read(int vb) {
  s16x4 r; asm volatile("ds_read_b64_tr_b16 %0, %1 offset:%2" : "=&v"(r) : "v"(vb), "i"(OFF) : "memory"); return r;
}
template <int D0> __device__ __forceinline__ void pv_one(f32x16& od, int vb, bf16x8 pa0, bf16x8 pa1, bf16x8 pa2, bf16x8 pa3) {
  const s16x4 l0 = tr_read<v_rd_off(D0, 0, 0)>(vb), h0 = tr_read<v_rd_off(D0, 0, 1)>(vb), l1 = tr_read<v_rd_off(D0, 1, 0)>(vb), h1 = tr_read<v_rd_off(D0, 1, 1)>(vb);
  const s16x4 l2 = tr_read<v_rd_off(D0, 2, 0)>(vb), h2 = tr_read<v_rd_off(D0, 2, 1)>(vb), l3 = tr_read<v_rd_off(D0, 3, 0)>(vb), h3 = tr_read<v_rd_off(D0, 3, 1)>(vb);
  asm volatile("s_waitcnt lgkmcnt(0)" ::: "memory"); SBAR();
#define PK(L, H) (bf16x8){L[0], L[1], L[2], L[3], H[0], H[1], H[2], H[3]}
  od = __builtin_amdgcn_mfma_f32_32x32x16_bf16(pa0, PK(l0, h0), od, 0, 0, 0);
  od = __builtin_amdgcn_mfma_f32_32x32x16_bf16(pa1, PK(l1, h1), od, 0, 0, 0);
  od = __builtin_amdgcn_mfma_f32_32x32x16_bf16(pa2, PK(l2, h2), od, 0, 0, 0);
  od = __builtin_amdgcn_mfma_f32_32x32x16_bf16(pa3, PK(l3, h3), od, 0, 0, 0);
#undef PK
}
__device__ __forceinline__ void pv_d0(f32x16* o, int vb, bf16x8 pa0, bf16x8 pa1, bf16x8 pa2, bf16x8 pa3) {
  pv_one<0>(o[0], vb, pa0, pa1, pa2, pa3); pv_one<1>(o[1], vb, pa0, pa1, pa2, pa3); pv_one<2>(o[2], vb, pa0, pa1, pa2, pa3); pv_one<3>(o[3], vb, pa0, pa1, pa2, pa3);
}
__device__ __forceinline__ void mla_unit(int b, int h, int qb, const bf16_t* __restrict__ QM, const bf16_t* __restrict__ KN, const bf16_t* __restrict__ KR, const bf16_t* __restrict__ VV, bf16_t* __restrict__ OM, LAS char* lds) {
  const int tid = threadIdx.x, wid = tid >> 6, lane = tid & 63, r32 = lane & 31, hi = lane >> 5;
  constexpr float C = MLA_SCALE * L2E, THRS = MLA_THR / MLA_SCALE;
  constexpr int NT = 33;
  LAS char* V_lds = lds + OFF_V; LAS char* Kn_lds = lds + OFF_KN; LAS char* Kr_lds = lds + OFF_KR;
  LAS float* ws = (LAS float*)(lds + OFF_WS) + wid * 64; LAS float* li_l = ws; LAS float* al_l = ws + 32;
  float m_reg = -1e30f, l_reg = 0; f32x16 o[4] = {}; bf16x8 qr[8];
  LAS char* qrp = lds + OFF_QR + wid * 4096 + lane * 16;
  const int qrow = b * SEQ + qb * 256 + wid * QBLK + r32;
  const bf16_t* Qw = QM + (size_t)qrow * 3072 + h * 192 + hi * 8;
#pragma unroll
  for (int d0 = 0; d0 < 8; ++d0) qr[d0] = *(const GAS bf16x8*)(Qw + d0 * 16);
  __syncthreads();
#pragma unroll
  for (int d0 = 0; d0 < 4; ++d0) *(LAS bf16x8*)(qrp + d0 * 1024) = *(const GAS bf16x8*)(Qw + (8 + d0) * 16);
  const int sr = tid >> 4, sc = (tid & 15) * 8, vst0 = v_st(sr, sc), vst1 = v_st(32 + sr, sc);
  const int krr = tid >> 3, krc = (tid & 7) * 8;
  const int vb0 = (int)(uintptr_t)V_lds + v_rd_base(lane);
  bf16x8 s_v0, s_v1, s_k0, s_k1, s_kr;
  const int realbase = b * SEQ - KVBLK;
  const unsigned voff = (unsigned)(sr * 2048 + sc) * 2u, kroff = (unsigned)(krr * 64 + krc) * 2u;
  int kb[4], krb[4];
#pragma unroll
  for (int bq = 0; bq < 4; ++bq) { kb[bq] = KSWZ(r32, bq * 32 + hi * 16); krb[bq] = KRSWZ(r32, bq * 32 + hi * 16); }
#define TROW(t) ((t) == 0 ? MREAL : realbase + (t) * KVBLK)
#define SLOAD(t) do { const int k0_ = TROW(t); const size_t ro_ = ((size_t)k0_ * 2048 + h * 128) * 2; \
    const GAS char* vb_ = (const GAS char*)VV + ro_; const GAS char* nb_ = (const GAS char*)KN + ro_; const GAS char* rb_ = (const GAS char*)KR + (size_t)k0_ * 128; \
    s_v0 = *(const GAS bf16x8*)(vb_ + voff); s_v1 = *(const GAS bf16x8*)(vb_ + 32 * 4096 + voff); \
    s_k0 = *(const GAS bf16x8*)(nb_ + voff); s_k1 = *(const GAS bf16x8*)(nb_ + 32 * 4096 + voff); \
    s_kr = *(const GAS bf16x8*)(rb_ + kroff); } while (0)
#define SWRITE(bf) do { *(LAS bf16x8*)(V_lds + (bf) * SHM_V + vst0) = s_v0; *(LAS bf16x8*)(V_lds + (bf) * SHM_V + vst1) = s_v1; const int kc_ = sc * 2; \
    *(LAS bf16x8*)(Kn_lds + (bf) * SHM_KN + KSWZ(sr, kc_)) = s_k0; *(LAS bf16x8*)(Kn_lds + (bf) * SHM_KN + KSWZ(32 + sr, kc_)) = s_k1; \
    *(LAS bf16x8*)(Kr_lds + (bf) * SHM_KR + KRSWZ(krr, krc * 2)) = s_kr; } while (0)
#define SWAIT() asm volatile("s_waitcnt vmcnt(0)" ::: "memory")
#define RESC(a) do { if (__any((a) < 1.f)) { if (hi == 0) al_l[r32] = (a); asm volatile("s_waitcnt lgkmcnt(0)" ::: "memory"); \
    _Pragma("unroll") for (int d = 0; d < 4; ++d) _Pragma("unroll") for (int r = 0; r < 16; ++r) o[d][r] *= al_l[crow(r, hi)]; } } while (0)
  f32x16 pA0, pA1, pB0, pB1; float mnA, mnB, alA, alB; bf16x8 pa0, pa1, pa2, pa3;
  SLOAD(0); SWAIT(); SWRITE(0); __syncthreads();
  qkt(pA0, pA1, Kn_lds, Kr_lds, qr, qrp, kb, krb);
  { const float NEG = -INFINITY;
#pragma unroll
    for (int r = 8; r < 16; ++r) pA0[r] = NEG;
#pragma unroll
    for (int r = 0; r < 16; ++r) pA1[r] = NEG; }
  partialSM(pA0, pA1, m_reg, mnA, alA, C, THRS);
  SLOAD(1); SWAIT(); SWRITE(1); __syncthreads();
  for (int j = 1; j + 1 < NT; j += 2) {
    SBAR(); qkt(pB0, pB1, Kn_lds + SHM_KN, Kr_lds + SHM_KR, qr, qrp, kb, krb);
    finishSM(pA0, pA1, alA, l_reg, pa0, pa1, pa2, pa3); SBAR();
    SLOAD(j + 1); SBAR();
    pv_d0(o, vb0, pa0, pa1, pa2, pa3); partialSM(pB0, pB1, m_reg, mnB, alB, C, THRS);
    __syncthreads(); SWAIT(); SWRITE(0);
    RESC(alB); __syncthreads();
    SBAR(); qkt(pA0, pA1, Kn_lds, Kr_lds, qr, qrp, kb, krb);
    finishSM(pB0, pB1, alB, l_reg, pa0, pa1, pa2, pa3); SBAR();
    if (j + 2 < NT) SLOAD(j + 2); SBAR();
    pv_d0(o, vb0 + SHM_V, pa0, pa1, pa2, pa3); partialSM(pA0, pA1, m_reg, mnA, alA, C, THRS);
    __syncthreads(); if (j + 2 < NT) { SWAIT(); SWRITE(1); }
    RESC(alA); __syncthreads();
  }
  finishSM(pA0, pA1, alA, l_reg, pa0, pa1, pa2, pa3); SBAR();
  pv_d0(o, vb0, pa0, pa1, pa2, pa3);
  if (hi == 0) li_l[r32] = l_reg; asm volatile("s_waitcnt lgkmcnt(0)" ::: "memory");
  float rli[16];
#pragma unroll
  for (int r = 0; r < 16; ++r) rli[r] = __builtin_amdgcn_rcpf(li_l[crow(r, hi)]);
  bf16_t* Ow = OM + (size_t)(b * SEQ + qb * 256 + wid * QBLK) * 2048 + h * 128;
#pragma unroll
  for (int r = 0; r < 16; ++r) { const int orow = crow(r, hi);
#pragma unroll
    for (int d0 = 0; d0 < 4; ++d0) { const unsigned w = cvt_pk_bf16(o[d0][r] * rli[r], 0.f); Ow[(size_t)orow * 2048 + d0 * 32 + r32] = (bf16_t)(w & 0xffffu); } }
#undef TROW
#undef SLOAD
#undef SWRITE
#undef SWAIT
#undef RESC
}
__device__ __forceinline__ void na_task(int task, const bf16_t* __restrict__ NAQ, const bf16_t* __restrict__ NAK, const bf16_t* __restrict__ VT, bf16_t* __restrict__ ONA,
                                        const LAS float* relb, const LAS float* metab, LAS float* wsf, int lane) {
  const int r32 = lane & 31, hi = lane >> 5;
  const int half = task & 1, r = (task >> 1) & 31, h = (task >> 6) & 15, b = task >> 10;
  const int qc = half * 32 + r32;
  const int cs = min(max(qc - 8, 0), 48), rs = min(max(r - 4, 0), 24);
  const int qtok = b * SEQ + r * 64 + qc;
  constexpr float C = L2E, THRS = 8.f, SCALE = 0.125f;
  bf16x8 qr[4];
#pragma unroll
  for (int d0 = 0; d0 < 4; ++d0) qr[d0] = *(const GAS bf16x8*)(NAQ + (size_t)qtok * 1024 + h * 64 + d0 * 16 + hi * 8);
  float m_reg = -1e30f, l_reg = 0.f; f32x16 o[2] = {};
  LAS float* al_l = wsf; LAS float* li_l = wsf + 32;
  const float NEG = -INFINITY;
  const unsigned long long wm = 0xFFFFull << cs;
  const unsigned mh0 = (unsigned)wm >> (4 * hi), mh1 = (unsigned)(wm >> 32) >> (4 * hi);
  const bf16_t* kq = NAK + (size_t)r32 * 1024 + h * 64 + hi * 8;
  const bf16_t* vq = VT + (size_t)(h * 64 + r32) * VT_PITCH + 8 * hi;
#define NA_KTOK(w) ((w) == 8 ? MREAL : b * SEQ + (rs + (w)) * 64)
#define NA_LOADK(KF, w) do { const bf16_t* kp_ = kq + (size_t)NA_KTOK(w) * 1024; _Pragma("unroll") for (int d0 = 0; d0 < 4; ++d0) { KF[d0] = *(const GAS bf16x8*)(kp_ + d0 * 16); KF[4 + d0] = *(const GAS bf16x8*)(kp_ + 32 * 1024 + d0 * 16); } } while (0)
#define NA_TILE(KF, w) do { \
    bf16x8 vf[8]; { const bf16_t* vp_ = vq + NA_KTOK(w); _Pragma("unroll") for (int ks = 0; ks < 4; ++ks) { vf[ks] = *(const GAS bf16x8*)(vp_ + 16 * ks); vf[4 + ks] = *(const GAS bf16x8*)(vp_ + (size_t)32 * VT_PITCH + 16 * ks); } } \
    f32x16 p0 = {}, p1 = {}; \
    _Pragma("unroll") for (int d0 = 0; d0 < 4; ++d0) { p0 = __builtin_amdgcn_mfma_f32_32x32x16_bf16(KF[d0], qr[d0], p0, 0, 0, 0); p1 = __builtin_amdgcn_mfma_f32_32x32x16_bf16(KF[4 + d0], qr[d0], p1, 0, 0, 0); } \
    if ((w) + 1 < 9) NA_LOADK(KF, (w) + 1);            \
    if ((w) < 8) { const LAS float* bp_ = relb + ((h * 15 + (rs + (w) - r + 7)) * 31 + 15 - qc + 4 * hi);     \
      _Pragma("unroll") for (int rg = 0; rg < 16; ++rg) { const int c_ = (rg & 3) + 8 * (rg >> 2); \
        { const bool ok = (mh0 >> c_) & 1u; const float bv = bp_[c_]; p0[rg] = ok ? fmaf(p0[rg], SCALE, bv) : NEG; } \
        { const bool ok = (mh1 >> c_) & 1u; const float bv = bp_[c_ + 32]; p1[rg] = ok ? fmaf(p1[rg], SCALE, bv) : NEG; } } \
    } else { const LAS float* bp = metab + h * 16; \
      _Pragma("unroll") for (int rg = 0; rg < 16; ++rg) { const int kc = crow(rg, hi); p0[rg] = (rg < 8) ? fmaf(p0[rg], SCALE, bp[kc & 15]) : NEG; p1[rg] = NEG; } } \
    float mn, alpha; partialSM(p0, p1, m_reg, mn, alpha, C, THRS); \
    bf16x8 pa0, pa1, pa2, pa3; finishSM(p0, p1, alpha, l_reg, pa0, pa1, pa2, pa3); \
    if (__any(alpha < 1.f)) { if (hi == 0) al_l[r32] = alpha; asm volatile("s_waitcnt lgkmcnt(0)" ::: "memory"); \
      _Pragma("unroll") for (int d = 0; d < 2; ++d) _Pragma("unroll") for (int rg = 0; rg < 16; ++rg) o[d][rg] *= al_l[crow(rg, hi)]; } \
    _Pragma("unroll") for (int d0 = 0; d0 < 2; ++d0) { \
      o[d0] = __builtin_amdgcn_mfma_f32_32x32x16_bf16(pa0, vf[4 * d0 + 0], o[d0], 0, 0, 0); o[d0] = __builtin_amdgcn_mfma_f32_32x32x16_bf16(pa1, vf[4 * d0 + 1], o[d0], 0, 0, 0); \
      o[d0] = __builtin_amdgcn_mfma_f32_32x32x16_bf16(pa2, vf[4 * d0 + 2], o[d0], 0, 0, 0); o[d0] = __builtin_amdgcn_mfma_f32_32x32x16_bf16(pa3, vf[4 * d0 + 3], o[d0], 0, 0, 0); } } while (0)
  { bf16x8 kA[8];
    NA_LOADK(kA, 0);
#pragma unroll 1
    for (int w = 0; w < 8; ++w) { NA_TILE(kA, w); }
    NA_TILE(kA, 8); }
#undef NA_KTOK
#undef NA_LOADK
#undef NA_TILE
  if (hi == 0) li_l[r32] = l_reg; asm volatile("s_waitcnt lgkmcnt(0)" ::: "memory");
  bf16_t* Ow = ONA + (size_t)(b * SEQ + r * 64 + half * 32) * 1024 + h * 64;
#pragma unroll
  for (int rg = 0; rg < 16; ++rg) { const int orow = crow(rg, hi); const float rl = __builtin_amdgcn_rcpf(li_l[orow]);
#pragma unroll
    for (int d0 = 0; d0 < 2; ++d0) { const unsigned wv = cvt_pk_bf16(o[d0][rg] * rl, 0.f); Ow[(size_t)orow * 1024 + d0 * 32 + r32] = (bf16_t)(wv & 0xffffu); } }
  asm volatile("s_waitcnt lgkmcnt(0)" ::: "memory");
}
}
namespace peer {
constexpr int CH = 32;
constexpr int OFF_TV = 0, OFF_TI = OFF_TV + CH * 16 * 16 * 4, OFF_SE = OFF_TI + CH * 16 * 16 * 4, OFF_SG = OFF_SE + CH * 128 * 4, PEER_LDS = OFF_SG + CH * 128 * 4;
__device__ __forceinline__ float gelu_tanh(float x) {
    const float u = 0.7978845608028654f * (x + 0.044715f * x * x * x);
    const float e = __builtin_amdgcn_exp2f(-2.f * 1.4426950408889634f * fabsf(u));
    const float t = (1.f - e) * __builtin_amdgcn_rcpf(1.f + e);
    return 0.5f * x * (1.f + (u < 0.f ? -t : t));
}
__device__ __forceinline__ void fmac1(float& acc, float a, float b) { asm("v_fmac_f32_e32 %0, %1, %2" : "+v"(acc) : "v"(a), "v"(b)); }
#define PEER_INSERT(x_, xi_) do { float x__ = (x_); int xi__ = (xi_); \
    _Pragma("unroll") for (int j_ = 0; j_ < 16; ++j_) { const bool gt_ = x__ > tv[j_]; const float tvo_ = tv[j_]; const int tio_ = ti[j_]; \
        tv[j_] = gt_ ? x__ : tvo_; ti[j_] = gt_ ? xi__ : tio_; x__ = gt_ ? tvo_ : x__; xi__ = gt_ ? tio_ : xi__; } } while (0)

#define PEER_AUX 0
typedef __amdgpu_buffer_rsrc_t rsrc_t;
__device__ __forceinline__ rsrc_t mk_rsrc(const void* p, unsigned bytes) { return __builtin_amdgcn_make_buffer_rsrc((void*)p, 0, bytes, 0x00020000); }
__device__ __forceinline__ u32x4 ldb128(rsrc_t r, unsigned off) { return __builtin_amdgcn_raw_buffer_load_b128(r, off, 0, PEER_AUX); }
typedef unsigned v6u_t __attribute__((ext_vector_type(6)));
typedef float v32f_t __attribute__((ext_vector_type(32)));
typedef float v16f_t __attribute__((ext_vector_type(16)));
__device__ __forceinline__ u32x2 ldb64(rsrc_t r, unsigned off) { return __builtin_amdgcn_raw_buffer_load_b64(r, off, 0, PEER_AUX); }
__device__ __forceinline__ f32x4 ldf128(rsrc_t r, unsigned off) { return __builtin_bit_cast(f32x4, __builtin_amdgcn_raw_buffer_load_b128(r, off, 0, PEER_AUX)); }
__device__ __forceinline__ f32x4 ldf128_nt(rsrc_t r, unsigned off) { return __builtin_bit_cast(f32x4, __builtin_amdgcn_raw_buffer_load_b128(r, off, 0, 2)); }
__device__ __forceinline__ void peer_chunk(int chunk, const float* __restrict__ SC, const float* __restrict__ H2, const unsigned char* __restrict__ U, const unsigned char* __restrict__ V,
                                           const float* __restrict__ g2, const float* __restrict__ gf, float* OUT, LAS char* lds, int tid) {
    LAS float* TV = (LAS float*)(lds + OFF_TV); LAS int* TI = (LAS int*)(lds + OFF_TI); LAS int* SE = (LAS int*)(lds + OFF_SE); LAS float* SG = (LAS float*)(lds + OFF_SG);
    asm volatile("" : "+v"(tid));
    const int tok0 = chunk * CH, lane = tid & 63, wave = tid >> 6;
    const rsrc_t rSC = mk_rsrc(SC, 0x8000000u), rH2 = mk_rsrc(H2, 0x8000000u), rU = mk_rsrc(U, 0x3000000u), rG2 = mk_rsrc(g2, 8192u), rGF = mk_rsrc(gf, 8192u);
    __syncthreads();
    { const int tl = tid >> 4, g = tid & 15; const unsigned spo = ((unsigned)(tok0 + tl) * 2048u + (unsigned)g * 128u) * 4u;
      int tk[16];
#pragma unroll
      for (int j = 0; j < 16; ++j) tk[j] = (int)0x80000000;
#define PEER_KEY(x_, lowbits_, mask_) ({ const int f_ = __float_as_int(x_); ((f_ ^ ((f_ >> 31) & 0x7fffffff)) & ~(mask_)) | (lowbits_); })
#define PEER_INS(key_) do { int x__ = (key_); _Pragma("unroll") for (int j_ = 0; j_ < 16; ++j_) { const int hi_ = max(x__, tk[j_]); x__ = min(x__, tk[j_]); tk[j_] = hi_; } } while (0)
#pragma unroll 1
      for (int i = 0; i < 32; i += 2) { const f32x4 a = ldf128_nt(rSC, spo + i * 16), b = ldf128_nt(rSC, spo + i * 16 + 16);
#pragma unroll
          for (int e = 0; e < 4; ++e) { PEER_INS(PEER_KEY(a[e], 127 - (4 * i + e), 127)); }
#pragma unroll
          for (int e = 0; e < 4; ++e) { PEER_INS(PEER_KEY(b[e], 127 - (4 * i + 4 + e), 127)); } }
      LAS float* tvp = TV + (tl * 16 + g) * 16; LAS int* tip = TI + (tl * 16 + g) * 16;
#pragma unroll
      for (int j = 0; j < 16; ++j) { const int k_ = tk[j] & ~127; tvp[j] = __int_as_float(k_ ^ ((k_ >> 31) & 0x7fffffff)); tip[j] = 127 - (tk[j] & 127); } }
    __syncthreads();
    asm volatile("" : "+v"(tid));
    { const int tl = tid >> 4, hh = (tid >> 1) & 7, half = tid & 1;
      const LAS float* s1 = TV + (tl * 16 + 2 * hh) * 16; const LAS float* s2 = s1 + 16; const LAS int* i1 = TI + (tl * 16 + 2 * hh) * 16; const LAS int* i2 = i1 + 16;
      float b2[16];
#pragma unroll
      for (int j = 0; j < 16; ++j) b2[j] = s2[j];
      int tk[16];
#pragma unroll
      for (int j = 0; j < 16; ++j) tk[j] = (int)0x80000000;
#pragma unroll
      for (int ii = 0; ii < 8; ++ii) { const int i = 2 * ii + half; const float a = s1[i];
#pragma unroll
          for (int j = 0; j < 16; ++j) if ((2 * ii + 1) * (j + 1) <= 16) { if (half == 0 || (2 * ii + 2) * (j + 1) <= 16) PEER_INS(PEER_KEY(a + b2[j], 255 - (i * 16 + j), 255)); } }
      { int pk[16];
#pragma unroll
        for (int j = 0; j < 16; ++j) pk[j] = __shfl_xor(tk[j], 1);
#pragma unroll
        for (int j = 0; j < 16; ++j) PEER_INS(pk[j]); }
      if (half == 0) { float e[16], sum = 0.f; const int k0_ = tk[0] & ~255; const float v0 = __int_as_float(k0_ ^ ((k0_ >> 31) & 0x7fffffff));
#pragma unroll
        for (int j = 0; j < 16; ++j) { const int k_ = tk[j] & ~255; const float vj = __int_as_float(k_ ^ ((k_ >> 31) & 0x7fffffff)); e[j] = __builtin_amdgcn_exp2f((vj - v0) * 1.4426950408889634f); sum += e[j]; }
        const float inv = 1.0f / sum;
#pragma unroll
        for (int j = 0; j < 16; ++j) { const int ci = 255 - (tk[j] & 255); SE[tl * 128 + hh * 16 + j] = i1[ci >> 4] * 128 + i2[ci & 15]; SG[tl * 128 + hh * 16 + j] = e[j] * inv; } } }
#undef PEER_KEY
#undef PEER_INS
    __syncthreads();
#pragma unroll 1
    for (int tt = 0; tt < CH / NWAVES; ++tt) { const int tl = wave * (CH / NWAVES) + tt, tok = tok0 + tl;
      asm volatile("" ::: "memory");
      float hn[32], acc[32]; float ss = 0.f;
#pragma unroll
      for (int j = 0; j < 2; ++j)
#pragma unroll
          for (int q = 0; q < 4; ++q) { const f32x4 a = ldf128_nt(rH2, ((unsigned)tok * 2048u + 1024u * j + 16u * lane + 4u * q) * 4u);
#pragma unroll
              for (int i = 0; i < 4; ++i) { hn[16 * j + 4 * q + i] = a[i]; ss += a[i] * a[i]; } }
      const float rstd = 1.0f / sqrtf(wave_sum(ss) * (1.f / 2048.f) + NORM_EPS);
#pragma unroll
      for (int j = 0; j < 2; ++j)
#pragma unroll
          for (int q = 0; q < 4; ++q) { const f32x4 a = ldf128(rG2, (1024u * j + 16u * lane + 4u * q) * 4u);
#pragma unroll
              for (int i = 0; i < 4; ++i) hn[16 * j + 4 * q + i] *= rstd * a[i]; }
#pragma unroll
      for (int i = 0; i < 32; ++i) acc[i] = 0.f;
#define NX 4
#define PEER_LOAD(S, kb) do { _Pragma("unroll") for (int x = 0; x < NX; ++x) { const unsigned o = (unsigned)SE[tl * 128 + (kb) + x] * 3072u; \
          S##ua[x] = ldb128(rU, o + (unsigned)lane * 16u); S##ub[x] = ldb64(rU, o + 1024u + (unsigned)lane * 8u); S##va[x] = ldb128(rU, o + 1536u + (unsigned)lane * 16u); S##vb[x] = ldb64(rU, o + 2560u + (unsigned)lane * 8u); } } while (0)
#define PEER_DEC(A, B) ({ v32f_t r_ = __builtin_amdgcn_cvt_scalef32_pk32_f32_fp6((v6u_t){A.x, A.y, A.z, A.w, B.x, B.y}, 1.0f); asm volatile("s_nop 1" : "+v"(r_)); r_; })
#define PEER_COMPUTE(S, kb) do { float d[NX]; \
          _Pragma("unroll") for (int x = 0; x < NX; ++x) { const v32f_t r = PEER_DEC(S##ua[x], S##ub[x]); float dd = 0.f; \
              _Pragma("unroll") for (int i = 0; i < 32; ++i) fmac1(dd, hn[i], r[i]); \
              d[x] = dd; } \
          _Pragma("unroll") for (int o = 1; o < 64; o <<= 1) { _Pragma("unroll") for (int x = 0; x < NX; ++x) d[x] += __shfl_xor(d[x], o); } \
          float c[NX]; \
          _Pragma("unroll") for (int x = 0; x < NX; ++x) c[x] = SG[tl * 128 + (kb) + x] * gelu_tanh(d[x] * (1.f / 64.f)) * 0.25f; \
          _Pragma("unroll") for (int x = 0; x < NX; ++x) { const v32f_t r = PEER_DEC(S##va[x], S##vb[x]); \
              _Pragma("unroll") for (int i = 0; i < 32; ++i) fmac1(acc[i], c[x], r[i]); } } while (0)
      { u32x4 Aua[NX], Ava[NX], Bua[NX], Bva[NX]; u32x2 Aub[NX], Avb[NX], Bub[NX], Bvb[NX];
        PEER_LOAD(A, 0);
#pragma unroll 1
        for (int k = 0; k < 128; k += 2 * NX) {
            PEER_LOAD(B, k + NX); PEER_COMPUTE(A, k);
            { const int kn = min(k + 2 * NX, 128 - NX); PEER_LOAD(A, kn); }
            PEER_COMPUTE(B, k + NX);
        } }
#undef PEER_DEC
#undef NX
#undef PEER_LOAD
#undef PEER_COMPUTE
      asm volatile("" ::: "memory");
      int tok2 = tok, lane2 = lane; asm volatile("" : "+v"(tok2), "+v"(lane2));
      float s2 = 0.f;
#pragma unroll
      for (int j = 0; j < 2; ++j)
#pragma unroll
          for (int q = 0; q < 4; ++q) { const f32x4 a = ldf128_nt(rH2, ((unsigned)tok2 * 2048u + 1024u * j + 16u * lane2 + 4u * q) * 4u);
#pragma unroll
              for (int i = 0; i < 4; ++i) { acc[16 * j + 4 * q + i] += a[i]; s2 += acc[16 * j + 4 * q + i] * acc[16 * j + 4 * q + i]; } }
      const float rf = 1.0f / sqrtf(wave_sum(s2) * (1.f / 2048.f) + NORM_EPS);
#pragma unroll
      for (int j = 0; j < 2; ++j)
#pragma unroll
          for (int q = 0; q < 4; ++q) { const f32x4 a = ldf128(rGF, (1024u * j + 16u * lane2 + 4u * q) * 4u); f32x4 oa;
#pragma unroll
              for (int i = 0; i < 4; ++i) oa[i] = acc[16 * j + 4 * q + i] * rf * a[i];
              float* op = OUT + (size_t)tok2 * 2048 + 1024 * j + 16 * lane2 + 4 * q;
              __builtin_nontemporal_store(oa, (GAS f32x4*)op); }
    }
}
}
#ifndef MK_N_LAUNCHES
#define MK_N_LAUNCHES 1
#endif
constexpr int N_PHASES = 9;
constexpr int N_LAUNCHES = MK_N_LAUNCHES;
struct Args { const float* in[19]; float* out; unsigned char* ws; int ph_lo, ph_hi; };
static_assert(sizeof(Args) == 19 * 8 + 8 + 8 + 8, "no padding");

__global__ void __launch_bounds__(NWAVES * 64, 2) hybrid_fwd(Args args) {
    extern __shared__ __attribute__((aligned(16))) unsigned char lds_raw[];
    Frame F;
    F.lds = (LAS unsigned char*)lds_raw;
    F.MISC = (volatile LAS unsigned*)(F.lds + MISC_OFF);
    F.tid = threadIdx.x; F.lane = F.tid & 63; F.wave = __builtin_amdgcn_readfirstlane(F.tid >> 6);
    F.G = gridDim.x; { const int bx = blockIdx.x; F.vcu = (F.G % 8 == 0) ? (bx % 8) * (F.G / 8) + bx / 8 : bx; }
    F.ws = args.ws; F.out = args.out;
#pragma unroll
    for (int i = 0; i < 19; ++i) F.in[i] = args.in[i];
    for (int u = F.tid; u < (LDS_BYTES - LDSCTL_OFF) / 4; u += NWAVES * 64) ((LAS unsigned*)(F.lds + LDSCTL_OFF))[u] = 0u;
    __syncthreads();
    XcdBarrier bar; bar.bar = (unsigned*)(F.ws + WS_CTL) + CW_BAR; bar.x = 0; bar.st = nullptr;
    if (N_LAUNCHES == 1) bar = xcd_barrier_post((unsigned*)(F.ws + WS_CTL) + CW_BAR, F.MISC + 8);
    const int lo = args.ph_lo, hi = args.ph_hi;
#define IN(k) (lo <= (k) && (k) < hi)
#define SEAM(k) do { if (IN(k) && IN((k) + 1)) xcd_barrier(bar); } while (0)
    const size_t T2048 = (size_t)256 * 2048 * 2, T1024 = (size_t)256 * 1024 * 2, T512 = (size_t)256 * 512 * 2;
    float* cosT = WSP(float, WS_COS); float* sinT = WSP(float, WS_SIN);
    float* ssq_q = WSP(float, WS_SSQ_Q); float* ssq_kv = WSP(float, WS_SSQ_KV); float* ssq2 = WSP(float, WS_SSQ_2);

    if (IN(0)) { p0_prologue<0>(F, F.vcu, F.G); } SEAM(0);
    if (IN(1)) {
        SchedP1 S{F.G, (int)blockIdx.x, (const char*)(F.ws + WS_HN1), (const char*)(F.ws + WS_WIN), (const char*)(F.ws + WS_WVT), T2048};
        EpiP1 E{WSP(bf16_t, WS_NAQ), WSP(bf16_t, WS_NAK), WSP(bf16_t, WS_VT), WSP(bf16_t, WS_CQ), WSP(bf16_t, WS_CKV), WSP(bf16_t, WS_KR), WSP(bf16_t, WS_GA), WSP(bf16_t, WS_GB), ssq_q, ssq_kv, cosT, sinT};
        pg8::gemm_phase<EpiP1, SchedP1>(F.lds, 2048, S, E);
        { const int extra = P1_UNITS % F.G, bx = (int)blockIdx.x; if (extra != 0 && bx >= extra) p0_prologue<1>(F, bx - extra, F.G - extra); else if (extra == 0) p0_prologue<1>(F, bx, F.G); }
    } SEAM(1);
    if (IN(2)) {
        LAS float* relb = (LAS float*)F.lds + 64; LAS float* metab = relb + 16 * 15 * 31 + 128; LAS float* wsf = metab + 256 + F.wave * 64;
        for (int i = F.tid; i < 16 * 15 * 31; i += NWAVES * 64) relb[i] = F.in[4][i];
        if (F.tid < 256) metab[F.tid] = F.in[5][F.tid];
        __syncthreads();
        const int gw = F.vcu * NWAVES + F.wave, NGW = F.G * NWAVES;
        for (int task = gw; task < NBATCH * 16 * 32 * 2; task += NGW)
            att::na_task(task, WSP(bf16_t, WS_NAQ), WSP(bf16_t, WS_NAK), WSP(bf16_t, WS_VT), WSP(bf16_t, WS_ONA), relb, metab, wsf, F.lane);
        __syncthreads();
    } SEAM(2);
    if (IN(3)) {
        SchedP3 S{F.G, (int)blockIdx.x, (const char*)(F.ws + WS_CQ), (const char*)(F.ws + WS_CKV), (const char*)(F.ws + WS_WUQ), (const char*)(F.ws + WS_WUKV), T512};
        EpiP3 E{WSP(bf16_t, WS_QM), WSP(bf16_t, WS_KN), WSP(bf16_t, WS_VV), ssq_q, ssq_kv, cosT, sinT};
        pg8::gemm_phase<EpiP3, SchedP3>(F.lds, 512, S, E);
    } SEAM(3);
    if (IN(4)) {
        for (int id = F.vcu; id < NBATCH * 16 * 8; id += F.G) { const int bh = id >> 3, qb = id & 7;
            att::mla_unit(bh >> 4, bh & 15, qb, WSP(bf16_t, WS_QM), WSP(bf16_t, WS_KN), WSP(bf16_t, WS_KR), WSP(bf16_t, WS_VV), WSP(bf16_t, WS_OMLA), (LAS char*)F.lds); }
        __syncthreads();
    } SEAM(4);
    if (IN(5)) {
        { SchedGrid S{F.G, (int)blockIdx.x, 64, 8, (const char*)(F.ws + WS_ONA), (const char*)(F.ws + WS_WNA), T1024};
          EpiP5a E{WSP(bf16_t, WS_GA), WSP(bf16_t, WS_T1)};
          pg8::gemm_phase<EpiP5a, SchedGrid>(F.lds, 1024, S, E); }
        { SchedGrid S{F.G, (int)blockIdx.x, 64, 8, (const char*)(F.ws + WS_OMLA), (const char*)(F.ws + WS_WMLA), T2048};
          EpiP5b E{WSP(bf16_t, WS_GB), WSP(bf16_t, WS_T1), WSP(bf16_t, WS_MERGED)};
          pg8::gemm_phase<EpiP5b, SchedGrid>(F.lds, 2048, S, E); }
    } SEAM(5);
    if (IN(6)) {
        { SchedGrid S{F.G, (int)blockIdx.x, 64, 8, (const char*)(F.ws + WS_MERGED), (const char*)(F.ws + WS_WOUT), T2048};
          EpiP6 E{F.in[0], WSP(float, WS_H2), WSP(bf16_t, WS_H2B), ssq2};
          pg8::gemm_phase<EpiP6, SchedGrid>(F.lds, 2048, S, E); }
        {
          for (unsigned i = (unsigned)F.vcu * 512u + F.tid; i < 2u * 16384u * 64u; i += (unsigned)F.G * 512u) { const unsigned isv = i >> 20, row = (i >> 6) & 16383u, l = i & 63u; const float sc = isv ? 4.f : 64.f;
              const float* src = (isv ? F.in[17] : F.in[16]) + (size_t)row * 2048 + 16 * l; peer::v16f_t a, b;
#pragma unroll
              for (int q = 0; q < 4; ++q) { const f32x4 x0 = *(const GAS f32x4*)(src + 4 * q) * sc, x1 = *(const GAS f32x4*)(src + 1024 + 4 * q) * sc;
#pragma unroll
                  for (int e = 0; e < 4; ++e) { const int k0_ = 4 * q + e, k1_ = 16 + 4 * q + e;
                      if (k0_ & 1) b[k0_ >> 1] = x0[e]; else a[k0_ >> 1] = x0[e];
                      if (k1_ & 1) b[k1_ >> 1] = x1[e]; else a[k1_ >> 1] = x1[e]; } }
              const peer::v6u_t w = __builtin_amdgcn_cvt_scalef32_2xpk16_fp6_f32(a, b, 1.0f);
              unsigned char* rec = WSP(unsigned char, WS_U) + (size_t)row * 3072 + (isv ? 1536 : 0);
              *(GAS u32x4*)(rec + l * 16) = (u32x4){w[0], w[1], w[2], w[3]}; *(GAS u32x2*)(rec + 1024 + l * 8) = (u32x2){w[4], w[5]}; } }
    } SEAM(6);
    if (IN(7)) {
        SchedGrid S{F.G, (int)blockIdx.x, 64, 8, (const char*)(F.ws + WS_H2B), (const char*)(F.ws + WS_WSC), T2048};
        EpiP7 E{ssq2, WSP(float, WS_SC)};
        pg8::gemm_phase<EpiP7, SchedGrid>(F.lds, 2048, S, E);
    } SEAM(7);
    if (IN(8)) {
        for (int chunk = F.vcu; chunk < MREAL / peer::CH; chunk += F.G)
            peer::peer_chunk(chunk, WSP(float, WS_SC), WSP(float, WS_H2), WSP(unsigned char, WS_U), WSP(unsigned char, WS_V), F.in[13], F.in[18], F.out, (LAS char*)F.lds, F.tid);
    }
#undef IN
#undef SEAM
}

extern "C" void kernel_launch(void* const* d_in, const int* in_sizes, int n_in, void* d_out, int out_size, void* d_ws, size_t ws_size, hipStream_t stream) {
    static int grid = 0;
    if (grid == 0) {
        if (n_in != 19 || in_sizes[0] != MREAL * DM || out_size != MREAL * DM || ws_size < WS_END) {
            fprintf(stderr, "kernel_launch: shape/workspace mismatch: n_in %d in0 %d out %d ws %zu (need %zu); nothing launched\n", n_in, n_in > 0 ? in_sizes[0] : -1, out_size, ws_size, (size_t)WS_END); grid = -1; return; }
        int dev = 0, cus = 0, per_cu = 0;
        if (hipGetDevice(&dev) != hipSuccess || hipDeviceGetAttribute(&cus, hipDeviceAttributeMultiprocessorCount, dev) != hipSuccess) { fprintf(stderr, "kernel_launch: device query failed\n"); grid = -1; return; }
        if (hipFuncSetAttribute((const void*)hybrid_fwd, hipFuncAttributeMaxDynamicSharedMemorySize, LDS_BYTES) != hipSuccess) { fprintf(stderr, "kernel_launch: hipFuncSetAttribute failed\n"); grid = -1; return; }
        if (hipOccupancyMaxActiveBlocksPerMultiprocessor(&per_cu, (const void*)hybrid_fwd, NWAVES * 64, LDS_BYTES) != hipSuccess || per_cu < 1)
            fprintf(stderr, "kernel_launch: note: occupancy query reports %d workgroups per CU\n", per_cu);
        (void)hipGetLastError();
        grid = cus;
    }
    if (grid < 0) return;
    if (hipMemsetAsync((char*)d_ws + WS_CTL, 0, CTL_ZERO_BYTES, stream) != hipSuccess) { fprintf(stderr, "kernel_launch: hipMemsetAsync failed\n"); return; }
    Args a{};
    for (int i = 0; i < 19; ++i) a.in[i] = (const float*)d_in[i];
    a.out = (float*)d_out; a.ws = (unsigned char*)d_ws;
    for (int li = 0; li < N_LAUNCHES; ++li) {
        a.ph_lo = (N_LAUNCHES == 1) ? 0 : li; a.ph_hi = (N_LAUNCHES == 1) ? N_PHASES : li + 1;
        hipLaunchKernelGGL(hybrid_fwd, dim3(grid), dim3(NWAVES * 64), LDS_BYTES, stream, a);
        const hipError_t le = hipPeekAtLastError();
        if (le != hipSuccess) { fprintf(stderr, "kernel_launch: launch %d failed: %s\n", li, hipGetErrorName(le)); break; }
    }
}
```

```cpp
#include <hip/hip_runtime.h>
#include <cstdio>
#include <cstdint>

#define LAS __attribute__((address_space(3)))
#define GAS __attribute__((address_space(1)))
typedef unsigned short bf16_t;
typedef short bf16x8 __attribute__((ext_vector_type(8)));
typedef short s16x4 __attribute__((ext_vector_type(4)));
typedef float f32x4 __attribute__((ext_vector_type(4)));
typedef float f32x2 __attribute__((ext_vector_type(2)));
typedef float f32x16 __attribute__((ext_vector_type(16)));
typedef unsigned u32x4 __attribute__((ext_vector_type(4)));
typedef unsigned u32x2 __attribute__((ext_vector_type(2)));

constexpr int DM = 2048, NBATCH = 8, SEQ = 2048, NMETA = 16;
constexpr int MREAL = NBATCH * SEQ;
constexpr int MPAD = MREAL + 256;
constexpr int NPOS = SEQ + NMETA;
constexpr float NORM_EPS = 1e-6f;
constexpr int C_NAQ = 0, C_NAK = 1024, C_CQ = 2048, C_CKV = 2560, C_GA = 3072, C_GB = 5120, C_KR = 7168, NMAIN = 7424;
constexpr int VT_PITCH = MPAD;

constexpr size_t MiB = 1u << 20;
constexpr size_t WS_CTL = 0, CTL_ZERO_BYTES = 1 * MiB;
constexpr size_t WS_SSQ_Q = 481 * MiB, WS_SSQ_KV = 482 * MiB, WS_SSQ_2 = 486 * MiB;
constexpr size_t WS_COS = 1 * MiB, WS_SIN = 1 * MiB + 512 * 1024;
constexpr size_t WS_WUQ = 2 * MiB, WS_WUKV = 5 * MiB, WS_WNA = 9 * MiB, WS_WMLA = 13 * MiB, WS_WOUT = 21 * MiB, WS_WSC = 29 * MiB;
constexpr size_t WS_GA = 37 * MiB, WS_GB = 101 * MiB;
constexpr size_t WS_KR = 165 * MiB;
constexpr size_t WS_WIN = 167 * MiB + 256 * 1024, WS_WVT = WS_WIN + 29 * MiB;
constexpr size_t WS_ONA = 190 * MiB;
constexpr size_t WS_NAQ = 222 * MiB, WS_NAK = 254 * MiB, WS_VT = WS_NAK + 32 * MiB + 512 * 1024;
constexpr size_t WS_HN1 = 319 * MiB;
constexpr size_t WS_CQ = 448 * MiB, WS_CKV = 464 * MiB;
constexpr size_t WS_QM = 222 * MiB, WS_KN = 318 * MiB, WS_VV = 383 * MiB;
constexpr size_t WS_OMLA = 448 * MiB;
constexpr size_t WS_MERGED = 222 * MiB, WS_T1 = 286 * MiB;
constexpr size_t WS_H2 = 37 * MiB, WS_H2B = 293 * MiB;
constexpr size_t WS_U = 357 * MiB, WS_V = 421 * MiB;
constexpr size_t WS_SC = 165 * MiB;
constexpr size_t WS_END = 512 * MiB;
static_assert(WS_CKV + (size_t)MPAD * 512 * 2 <= WS_SSQ_Q && WS_SSQ_Q + (size_t)8 * MPAD * 4 <= WS_SSQ_KV && WS_SSQ_KV + (size_t)8 * MPAD * 4 <= 483 * MiB && WS_V + 64 * MiB <= WS_SSQ_2 && WS_SSQ_2 + (size_t)32 * MREAL * 4 <= WS_END, "ssq slabs");
static_assert(WS_VT + (size_t)1024 * MPAD * 2 <= WS_HN1 && WS_HN1 + (size_t)MPAD * 2048 * 2 <= WS_CQ && WS_CKV + (size_t)MPAD * 512 * 2 <= WS_END, "map P1");
static_assert(WS_WVT + 4 * MiB <= WS_NAQ && WS_KR + (size_t)MPAD * 64 * 2 <= WS_WIN && WS_ONA + 32 * MiB <= WS_NAQ, "map P1b");
static_assert(WS_QM + 96 * MiB <= WS_KN && WS_KN + 65 * MiB <= WS_VV && WS_VV + 65 * MiB <= WS_OMLA && WS_OMLA + 64 * MiB <= WS_END, "map P3");
static_assert(WS_T1 + 128 * MiB <= WS_OMLA && WS_H2 + 128 * MiB <= WS_KR && WS_SC + 128 * MiB <= WS_H2B && WS_H2B + 64 * MiB <= WS_U && WS_V + 64 * MiB <= WS_END, "map P5+");

constexpr int CW_BAR = 4096;

constexpr int RING_BYTES = 131072;
constexpr int LDSCTL_OFF = RING_BYTES, MISC_OFF = LDSCTL_OFF + 320;
constexpr int LDS_BYTES = 147456;
constexpr int NWAVES = 8;

#define LDS_WAIT() asm volatile("s_waitcnt lgkmcnt(0)" ::: "memory")
#define VM_WAIT() asm volatile("s_waitcnt vmcnt(0)" ::: "memory")
#define SBAR() __builtin_amdgcn_sched_barrier(0)
typedef __bf16 bf16x2_t __attribute__((ext_vector_type(2)));
__device__ __forceinline__ unsigned cvt_pk_bf16(float lo, float hi) { const f32x2 v = {lo, hi}; const bf16x2_t b = __builtin_convertvector(v, bf16x2_t); return __builtin_bit_cast(unsigned, b); }
__device__ __forceinline__ float bf_lo(unsigned w) { return __uint_as_float(w << 16); }
__device__ __forceinline__ float bf_hi(unsigned w) { return __uint_as_float(w & 0xffff0000u); }
__device__ __forceinline__ u32x4 pack8(const f32x4 a, const f32x4 b) { u32x4 w; w.x = cvt_pk_bf16(a[0], a[1]); w.y = cvt_pk_bf16(a[2], a[3]); w.z = cvt_pk_bf16(b[0], b[1]); w.w = cvt_pk_bf16(b[2], b[3]); return w; }
__device__ __forceinline__ u32x2 pack4(const f32x4 a) { u32x2 w; w.x = cvt_pk_bf16(a[0], a[1]); w.y = cvt_pk_bf16(a[2], a[3]); return w; }
__device__ __forceinline__ float wave_sum(float v) {
#pragma unroll
    for (int o = 1; o < 64; o <<= 1) v += __shfl_xor(v, o);
    return v;
}
__device__ __forceinline__ float sigmoidf_(float x) { return __builtin_amdgcn_rcpf(1.0f + __builtin_amdgcn_exp2f(-1.4426950408889634f * x)); }
__device__ __forceinline__ int crow(int r, int hi) { return (r & 3) + 8 * (r >> 2) + 4 * hi; }
#define PG8_AUX 0
namespace pg8 {
constexpr int BM = 256, BK = 64, HALF = 128, HTB = HALF * BK * 2  , STAGE_BYTES = 8 * HTB, NXCD = 8, WGM = 8;
__host__ __device__ __forceinline__ int lds_byte(int r, int c) { const int st = (r >> 4) * 2 + (c >> 5), rr = r & 15, cc = c & 31, ob = rr * 64 + cc * 2; return st * 1024 + (ob ^ (((ob >> 9) & 1) << 5)); }
__host__ __device__ __forceinline__ void stage_rc(int b, int& R, int& C) { const int st = b / 1024, sb = b % 1024, swz = sb ^ (((sb >> 9) & 1) << 5); R = (st >> 1) * 16 + swz / 64; C = (st & 1) * 32 + (swz % 64) / 2; }
__host__ __device__ __forceinline__ int perm32(int rho) { const int n = rho >> 4, i = rho & 15; return 8 * (i >> 2) + 4 * n + (i & 3); }

struct Unit { int pm, pn, kind; };

__device__ __forceinline__ void grid_order(int L, int nM, int nN, int& pm, int& pn) {
    const int nwg = nM * nN; int wgid = L;
    { const int q = nwg / NXCD, r = nwg % NXCD, xcd = wgid % NXCD, off = wgid / NXCD; wgid = (xcd < r ? xcd * (q + 1) : r * (q + 1) + (xcd - r) * q) + off; }
    const int nig = WGM * nN, gid = wgid / nig, fm = gid * WGM, gsz = (nM - fm) < WGM ? (nM - fm) : WGM;
    pm = fm + ((wgid % nig) % gsz); pn = (wgid % nig) / gsz;
}

typedef int v8i_t __attribute__((ext_vector_type(8)));
template <class Epi, class Sched, bool F8 = false, int F8_SCALE_EXP = 0>
__device__ __forceinline__ void gemm_phase(LAS unsigned char* lds, const int K, const Sched& S, const Epi& E) {
    const int tid = threadIdx.x, wid = __builtin_amdgcn_readfirstlane(tid >> 6), lane = tid & 63, wr = wid >> 2, wc = wid & 3, fr = lane & 15, fq = lane >> 4;
    int f8sa = 0x01010101 * (127 + F8_SCALE_EXP), f8sb = 0x7f7f7f7f; asm volatile("" : "+v"(f8sa), "+v"(f8sb));
    const int Kb = F8 ? K : 2 * K;
    const int nt = Kb / 128;
    unsigned voffA[2], voffB[2];
#pragma unroll
    for (int i = 0; i < 2; ++i) { int R, C; stage_rc(tid * 16 + i * 8192, R, C); const int Rb = Epi::PERM ? ((R & ~31) + perm32(R & 31)) : R;
        voffA[i] = (unsigned)(R * Kb + C * 2); voffB[i] = (unsigned)(Rb * Kb + C * 2); }
    const size_t kstep = (size_t)128;
    const size_t hstep = (size_t)HALF * Kb;
    const unsigned ldsw = (unsigned)wid * 1024u;
    const int aoff = lds_byte(wr * 64 + fr, F8 ? fq * 16 : fq * 8), boff = lds_byte(wc * 32 + fr, F8 ? fq * 16 : fq * 8);
#define PG8_SA(b, h) (((b) * 2 + (h)) * HTB)
#define PG8_SB(b, h) ((4 + (b) * 2 + (h)) * HTB)
#define PG8_STAGE(bufoff, gbase, voff) do { _Pragma("unroll") for (int _i = 0; _i < 2; ++_i) \
        __builtin_amdgcn_global_load_lds((const unsigned*)((const char*)(gbase) + (voff)[_i]), (LAS unsigned*)(lds + (bufoff) + ldsw + _i * 8192), 16, 0, PG8_AUX); } while (0)
#define PG8_LDA(dst, b, h) do { _Pragma("unroll") for (int m = 0; m < 4; ++m) _Pragma("unroll") for (int k = 0; k < 2; ++k) dst[m][k] = *(const LAS bf16x8*)(lds + PG8_SA(b, h) + aoff + m * 2048 + (F8 ? k * 16 : k * 1024)); } while (0)
#define PG8_LDB(dst, b, h) do { _Pragma("unroll") for (int n = 0; n < 2; ++n) _Pragma("unroll") for (int k = 0; k < 2; ++k) dst[n][k] = *(const LAS bf16x8*)(lds + PG8_SB(b, h) + boff + n * 2048 + (F8 ? k * 16 : k * 1024)); } while (0)
#define PG8_F8OP(X) __builtin_bit_cast(v8i_t, __builtin_shufflevector(X[0], X[1], 0, 1, 2, 3, 4, 5, 6, 7, 8, 9, 10, 11, 12, 13, 14, 15))
#define PG8_MMA(ai, bj, At, Bt) do { __builtin_amdgcn_s_setprio(1); \
        if constexpr (F8) { _Pragma("unroll") for (int m = 0; m < 4; ++m) _Pragma("unroll") for (int n = 0; n < 2; ++n) \
            asm volatile("v_mfma_scale_f32_16x16x128_f8f6f4 %0, %1, %2, %0, %3, %4 op_sel_hi:[0,0,0]" : "+v"(acc[ai][bj][m][n]) : "v"(PG8_F8OP(Bt[n])), "v"(PG8_F8OP(At[m])), "v"(f8sa), "v"(f8sb)); } \
        else { _Pragma("unroll") for (int m = 0; m < 4; ++m) _Pragma("unroll") for (int n = 0; n < 2; ++n) _Pragma("unroll") for (int k = 0; k < 2; ++k) \
            acc[ai][bj][m][n] = __builtin_amdgcn_mfma_f32_16x16x32_bf16(Bt[n][k], At[m][k], acc[ai][bj][m][n], 0, 0, 0); } \
        __builtin_amdgcn_s_setprio(0); } while (0)
#define PG8_WAIT_V(n) asm volatile("s_waitcnt vmcnt(" #n ")" ::: "memory")
#define PG8_WAIT_L(n) asm volatile("s_waitcnt lgkmcnt(" #n ")" ::: "memory")
#define PG8_BAR __builtin_amdgcn_s_barrier()
#define PG8_SCHED __builtin_amdgcn_sched_barrier(0)
    Unit cur, nxt; int ui = 0;
    if (!S.next(0, cur)) return;
    f32x4 acc[2][2][4][2];
#pragma unroll
    for (int a = 0; a < 2; ++a)
#pragma unroll
        for (int b = 0; b < 2; ++b)
#pragma unroll
            for (int m = 0; m < 4; ++m)
#pragma unroll
                for (int n = 0; n < 2; ++n) acc[a][b][m][n] = (f32x4){0.f, 0.f, 0.f, 0.f};
    bf16x8 At[4][2], B0[2][2], B1[2][2];
    const char* cA = S.pa(cur); const char* cB = S.pb(cur);
    PG8_STAGE(PG8_SB(0, 0), cB, voffB); PG8_STAGE(PG8_SB(0, 1), cB + hstep, voffB); PG8_STAGE(PG8_SA(0, 0), cA, voffA); PG8_STAGE(PG8_SA(0, 1), cA + hstep, voffA);
    if (wr == 1) PG8_BAR;
    PG8_WAIT_V(2); PG8_BAR;
    PG8_STAGE(PG8_SB(1, 0), cB + kstep, voffB); PG8_STAGE(PG8_SA(1, 0), cA + kstep, voffA); PG8_STAGE(PG8_SB(1, 1), cB + hstep + kstep, voffB);
    PG8_WAIT_V(6); PG8_BAR;
    for (;;) {
        const bool has_next = S.next(ui + 1, nxt);
        const char* nA = has_next ? S.pa(nxt) : cA; const char* nB = has_next ? S.pb(nxt) : cB;
        for (int t = 0; t < nt; t += 2) {
            const bool last = (t == nt - 2);
            const char* a1 = cA + (size_t)(t + 1) * kstep;
            const char* a2 = last ? nA : cA + (size_t)(t + 2) * kstep; const char* b2 = last ? nB : cB + (size_t)(t + 2) * kstep;
            const char* a3 = a2 + kstep; const char* b3 = b2 + kstep;
            PG8_LDB(B0, 0, 0); PG8_LDB(B1, 0, 1); PG8_SCHED; PG8_LDA(At, 0, 0); PG8_STAGE(PG8_SA(1, 1), a1 + hstep, voffA);
            PG8_WAIT_V(8); PG8_WAIT_L(0); PG8_BAR; PG8_MMA(0, 0, At, B0); PG8_MMA(0, 1, At, B1); PG8_BAR; PG8_SCHED;
            PG8_LDA(At, 0, 1); PG8_STAGE(PG8_SB(0, 0), b2, voffB); PG8_STAGE(PG8_SB(0, 1), b2 + hstep, voffB); PG8_STAGE(PG8_SA(0, 0), a2, voffA);
            PG8_WAIT_V(8); PG8_WAIT_L(0); PG8_BAR; PG8_MMA(1, 0, At, B0); PG8_MMA(1, 1, At, B1); PG8_BAR; PG8_SCHED;
            PG8_LDB(B0, 1, 0); PG8_LDB(B1, 1, 1); PG8_SCHED; PG8_LDA(At, 1, 0); PG8_STAGE(PG8_SA(0, 1), a2 + hstep, voffA);
            PG8_WAIT_V(8); PG8_WAIT_L(0); PG8_BAR; PG8_MMA(0, 0, At, B0); PG8_MMA(0, 1, At, B1); PG8_BAR; PG8_SCHED;
            PG8_LDA(At, 1, 1); PG8_STAGE(PG8_SB(1, 0), b3, voffB); PG8_STAGE(PG8_SB(1, 1), b3 + hstep, voffB); PG8_STAGE(PG8_SA(1, 0), a3, voffA);
            PG8_WAIT_V(8); PG8_WAIT_L(0); PG8_BAR; PG8_MMA(1, 0, At, B0); PG8_MMA(1, 1, At, B1); PG8_BAR; PG8_SCHED;
        }
        if (wr == 0) PG8_BAR;
        if constexpr (F8) asm volatile("s_nop 15\n\ts_nop 7" ::: "memory");
        if constexpr (Epi::HAS_PRE) {
            E.pre(cur, (LAS float*)(lds + STAGE_BYTES + 1024), tid); PG8_WAIT_L(0); PG8_BAR; }
        E(acc, cur, wr, wc, fr, fq, (const LAS float*)(lds + STAGE_BYTES + 1024));
        if (!has_next) break;
#pragma unroll
        for (int a = 0; a < 2; ++a)
#pragma unroll
            for (int b = 0; b < 2; ++b)
#pragma unroll
                for (int m = 0; m < 4; ++m)
#pragma unroll
                    for (int n = 0; n < 2; ++n) acc[a][b][m][n] = (f32x4){0.f, 0.f, 0.f, 0.f};
        cur = nxt; cA = nA; cB = nB; ++ui;
        if (wr == 1) PG8_BAR;
    }
    PG8_WAIT_V(0);
    PG8_BAR;
#undef PG8_SA
#undef PG8_SB
#undef PG8_STAGE
#undef PG8_LDA
#undef PG8_LDB
#undef PG8_MMA
#undef PG8_F8OP
#undef PG8_WAIT_V
#undef PG8_WAIT_L
#undef PG8_BAR
#undef PG8_SCHED
}
}
typedef GAS unsigned gu32;
#define RLX_AGENT __ATOMIC_RELAXED, __HIP_MEMORY_SCOPE_AGENT
#define XB_TMO      128
#define XB_XCNT(j)  (256  + 64 * (j))
#define XB_XSUB(j)  (1280 + 64 * (j))
#define XB_XGEN(j)  (2304 + 64 * (j))
#define XB_TOP      3328
#define XB_TOPGEN   3392
#define XCD_BAR_WORDS 3456
#define XB_SPIN_CAP (1u << 18)
__device__ __forceinline__ unsigned xb_ld(unsigned* p)              { return __hip_atomic_load(p, __ATOMIC_RELAXED, __HIP_MEMORY_SCOPE_AGENT); }
__device__ __forceinline__ unsigned xb_add(unsigned* p, unsigned v) { return __hip_atomic_fetch_add(p, v, __ATOMIC_RELAXED, __HIP_MEMORY_SCOPE_AGENT); }
__device__ __forceinline__ unsigned xb_xcc_id() { return (unsigned)__builtin_amdgcn_s_getreg((3 << 11) | 20) & 0xFu; }
#define XB_SPIN(cond, bar) do { unsigned _sp = 0; while (cond) { __builtin_amdgcn_s_sleep(1); \
    if ((++_sp & 255u) == 0u) { if (xb_ld(&(bar)[XB_TMO])) break; if (_sp > XB_SPIN_CAP) { atomicAdd(&(bar)[XB_TMO], 1u); break; } } } } while (0)
struct XcdBarrier { unsigned* bar; unsigned x; volatile LAS unsigned* st; };
__device__ __forceinline__ XcdBarrier xcd_barrier_post(unsigned* bar, volatile LAS unsigned* st) {
    XcdBarrier b; b.bar = bar; b.x = xb_xcc_id(); b.st = st;
    if (threadIdx.x == 0) (void)xb_add(&bar[XB_XCNT(b.x)], 1u);
    return b;
}
__device__ __forceinline__ void xcd_barrier_complete(unsigned* bar, unsigned x, unsigned& nloc, unsigned& nx) {
    const unsigned G = gridDim.x * gridDim.y * gridDim.z;
    unsigned sum, cnt, mine, sp = 0u;
    for (;;) {
        sum = 0u; cnt = 0u; mine = 0u;
#pragma unroll
        for (unsigned j = 0; j < 16; ++j) { const unsigned c = xb_ld(&bar[XB_XCNT(j)]); sum += c; cnt += (c > 0u) ? 1u : 0u; mine = (j == x) ? c : mine; }
        if (sum == G) break;
        __builtin_amdgcn_s_sleep(1);
        if ((++sp & 255u) == 0u) { if (xb_ld(&bar[XB_TMO])) break; if (sp > XB_SPIN_CAP) { atomicAdd(&bar[XB_TMO], 1u); break; } }
    }
    nloc = mine > 0u ? mine : 1u; nx = cnt > 0u ? cnt : 1u;
}
__device__ __forceinline__ void xcd_barrier(const XcdBarrier& b) {
    asm volatile("s_waitcnt vmcnt(0)" ::: "memory");
    __syncthreads();
    if (threadIdx.x == 0) {
        unsigned* bar = b.bar;
        __builtin_amdgcn_s_waitcnt(0);
        unsigned nloc = b.st[0], nx = b.st[1];
        if (nloc == 0u) { xcd_barrier_complete(bar, b.x, nloc, nx); b.st[0] = nloc; b.st[1] = nx; }
        const unsigned old = xb_add(&bar[XB_XSUB(b.x)], 1u);
        const unsigned gen = old / nloc;
        if (old + 1u == (gen + 1u) * nloc) {
            __builtin_amdgcn_fence(__ATOMIC_RELEASE, "agent");
            asm volatile("s_waitcnt vmcnt(0)" ::: "memory");
            const unsigned og = xb_add(&bar[XB_TOP], 1u);
            const unsigned tg = og / nx;
            if (og + 1u == (tg + 1u) * nx) xb_add(&bar[XB_TOPGEN], 1u);
            else XB_SPIN(xb_ld(&bar[XB_TOPGEN]) == tg, bar);
            __builtin_amdgcn_fence(__ATOMIC_ACQUIRE, "agent");
            xb_add(&bar[XB_XGEN(b.x)], 1u);
            asm volatile("s_waitcnt vmcnt(0)" ::: "memory");
        } else {
            XB_SPIN(xb_ld(&bar[XB_XGEN(b.x)]) == gen, bar);
            __builtin_amdgcn_fence(__ATOMIC_ACQUIRE, "agent");
            asm volatile("s_waitcnt vmcnt(0)" ::: "memory");
        }
    }
    __syncthreads();
}
struct Frame {
    LAS unsigned char* lds;
    volatile LAS unsigned* MISC;
    unsigned char* ws;
    int tid, lane, wave;
    int vcu, G;
    const float* in[19];
    float* out;
};
#define WSP(T, off) ((T*)(F.ws + (off)))

__device__ __forceinline__ void p0_transpose_item(const float* W, int K, int N, int k0, int n0, bf16_t* WT, int drow, bool rope, const float* gain, LAS float* scr, int lane) {
#pragma unroll 8
    for (int i = 0; i < 32; ++i) { const int kk = 2 * i + (lane >> 5); float w = W[(size_t)(k0 + kk) * N + n0 + (lane & 31)]; if (gain) w *= gain[k0 + kk]; scr[kk * 33 + (lane & 31)] = w; }
    LDS_WAIT(); asm volatile("" ::: "memory");
    const int c = lane & 7;
#pragma unroll
    for (int j = 0; j < 4; ++j) { const int n = (lane >> 3) + 8 * j; const LAS float* s = scr + (8 * c) * 33 + n;
        u32x4 o; o.x = cvt_pk_bf16(s[0 * 33], s[1 * 33]); o.y = cvt_pk_bf16(s[2 * 33], s[3 * 33]); o.z = cvt_pk_bf16(s[4 * 33], s[5 * 33]); o.w = cvt_pk_bf16(s[6 * 33], s[7 * 33]);
        const int dr = drow + (rope ? (8 * (n >> 2) + (n & 3)) : n);
        *(GAS u32x4*)(WT + (size_t)dr * K + k0 + 8 * c) = o; }
    LDS_WAIT(); asm volatile("" ::: "memory");
}
__device__ __forceinline__ void p0_transpose_item8(const float* W, int K, int N, int k0, int n0, unsigned char* WT, int drow, bool rope, float scale, LAS float* scr, int lane) {
#pragma unroll 8
    for (int i = 0; i < 32; ++i) { const int kk = 2 * i + (lane >> 5); scr[kk * 33 + (lane & 31)] = W[(size_t)(k0 + kk) * N + n0 + (lane & 31)] * scale; }
    LDS_WAIT(); asm volatile("" ::: "memory");
#pragma unroll
    for (int j = 0; j < 2; ++j) { const int q = lane + 64 * j, n = q >> 2, c = q & 3; const LAS float* s = scr + (16 * c) * 33 + n; u32x4 o;
#pragma unroll
        for (int d = 0; d < 4; ++d) { int w = 0; w = __builtin_amdgcn_cvt_pk_fp8_f32(s[(4 * d) * 33], s[(4 * d + 1) * 33], w, false); w = __builtin_amdgcn_cvt_pk_fp8_f32(s[(4 * d + 2) * 33], s[(4 * d + 3) * 33], w, true); o[d] = (unsigned)w; }
        const int dr = drow + (rope ? (8 * (n >> 2) + (n & 3)) : n);
        *(GAS u32x4*)(WT + (size_t)dr * K + k0 + 16 * c) = o; }
    LDS_WAIT(); asm volatile("" ::: "memory");
}
__device__ __forceinline__ void rms_row_to_fp8(const float* xrow, const float* g, unsigned char* orow, int lane) {
    const GAS f32x4* xr = (const GAS f32x4*)xrow + lane; const GAS f32x4* gr = (const GAS f32x4*)g + lane;
    f32x4 v[8]; float s = 0.f;
#pragma unroll
    for (int j = 0; j < 8; ++j) { v[j] = xr[64 * j]; s += (v[j].x * v[j].x + v[j].y * v[j].y) + (v[j].z * v[j].z + v[j].w * v[j].w); }
    const float rstd = 1.0f / sqrtf(wave_sum(s) * (1.f / DM) + NORM_EPS);
    GAS unsigned* o4 = (GAS unsigned*)orow + lane;
#pragma unroll
    for (int j = 0; j < 8; ++j) { const f32x4 y = (v[j] * rstd) * gr[64 * j]; int w = 0; w = __builtin_amdgcn_cvt_pk_fp8_f32(y[0], y[1], w, false); w = __builtin_amdgcn_cvt_pk_fp8_f32(y[2], y[3], w, true); o4[64 * j] = (unsigned)w; }
}
__device__ __forceinline__ void rms_row_to_bf16(const float* xrow, const float* g, bf16_t* orow, int lane) {
    const GAS f32x4* xr = (const GAS f32x4*)xrow + lane; const GAS f32x4* gr = (const GAS f32x4*)g + lane;
    f32x4 v[8]; float s = 0.f;
#pragma unroll
    for (int j = 0; j < 8; ++j) { v[j] = xr[64 * j]; s += (v[j].x * v[j].x + v[j].y * v[j].y) + (v[j].z * v[j].z + v[j].w * v[j].w); }
    const float rstd = 1.0f / sqrtf(wave_sum(s) * (1.f / DM) + NORM_EPS);
    GAS u32x2* o8 = (GAS u32x2*)orow + lane;
#pragma unroll
    for (int j = 0; j < 8; ++j) { const f32x4 gg = gr[64 * j]; o8[64 * j] = pack4((v[j] * rstd) * gg); }
}
template <int PART>
__device__ __forceinline__ void p0_prologue(Frame& F, int rank, int nrank) {
    LAS float* scr = (LAS float*)(F.lds + F.wave * 16384);
    const int gw = rank * NWAVES + F.wave, NGW = nrank * NWAVES, lane = F.lane; const int gt = rank * 512 + F.tid, NGT = nrank * 512;
    unsigned char* WIN = WSP(unsigned char, WS_WIN); unsigned char* WVT = WSP(unsigned char, WS_WVT);
    constexpr int I_IN = 32 * 258, I_UQ = 8 * 96, I_UKV = 8 * 128, I_NA = 16 * 64, I_MLA = 32 * 64, I_OUT = 32 * 64;
    constexpr int NEARLY = I_IN + I_UQ + I_UKV, NITEMS = NEARLY + I_NA + I_MLA + I_OUT;
    for (int it = (PART == 0 ? 0 : NEARLY) + gw; it < (PART == 0 ? NEARLY : NITEMS); it += NGW) {
        int r = it;
        if (r < I_IN) { const int kb = r / 258, sb = r % 258, n0 = 32 * sb, k0 = 64 * kb; const float* W = F.in[3];
            unsigned char* dst = WIN; int drow; bool rope = false;
            if (n0 < 1024) drow = C_NAQ + n0;
            else if (n0 < 2048) drow = C_NAK + (n0 - 1024);
            else if (n0 < 3072) { dst = WVT; drow = n0 - 2048; }
            else if (n0 < 3584) drow = C_CQ + (n0 - 3072);
            else if (n0 < 4096) drow = C_CKV + (n0 - 3584);
            else if (n0 < 4160) { drow = C_KR + ((n0 - 4096) ? 4 : 0); rope = true; }
            else if (n0 < 6208) drow = C_GA + (n0 - 4160);
            else drow = C_GB + (n0 - 6208);
            p0_transpose_item8(W, 2048, 8256, k0, n0, dst, drow, rope, 64.f, scr, lane); continue; } r -= I_IN;
        if (r < I_UQ) { const int kb = r / 96, sb = r % 96, n0 = 32 * sb, k0 = 64 * kb; const int hd = n0 / 192, w = n0 % 192;
            int drow = n0; bool rope = false; if (w >= 128) { rope = true; drow = hd * 192 + 128 + ((w - 128) ? 4 : 0); }
            p0_transpose_item(F.in[7], 512, 3072, k0, n0, WSP(bf16_t, WS_WUQ), drow, rope, F.in[6], scr, lane); continue; } r -= I_UQ;
        if (r < I_UKV) { const int kb = r / 128, sb = r % 128; p0_transpose_item(F.in[9], 512, 4096, 64 * kb, 32 * sb, WSP(bf16_t, WS_WUKV), 32 * sb, false, F.in[8], scr, lane); continue; } r -= I_UKV;
        if (r < I_NA) { const int kb = r / 64, sb = r % 64; p0_transpose_item(F.in[10], 1024, 2048, 64 * kb, 32 * sb, WSP(bf16_t, WS_WNA), 32 * sb, false, nullptr, scr, lane); continue; } r -= I_NA;
        if (r < I_MLA) { const int kb = r / 64, sb = r % 64; p0_transpose_item(F.in[11], 2048, 2048, 64 * kb, 32 * sb, WSP(bf16_t, WS_WMLA), 32 * sb, false, nullptr, scr, lane); continue; } r -= I_MLA;
        { const int kb = r / 64, sb = r % 64; p0_transpose_item(F.in[12], 2048, 2048, 64 * kb, 32 * sb, WSP(bf16_t, WS_WOUT), 32 * sb, false, nullptr, scr, lane); }
    }
    if (PART == 0) { GAS u32x4* z = (GAS u32x4*)(WIN + (size_t)(C_KR + 64) * 2048); const int n16 = (NMAIN - C_KR - 64) * 2048 / 16;
      for (int i = gt; i < n16; i += NGT) z[i] = (u32x4){0u, 0u, 0u, 0u}; }
    if (PART == 0) { unsigned char* HN1 = WSP(unsigned char, WS_HN1);
      for (int m = gw; m < MREAL + NMETA; m += NGW) {
          const float* src = (m < MREAL) ? F.in[0] + (size_t)m * DM : F.in[1] + (size_t)(m - MREAL) * DM;
          rms_row_to_fp8(src, F.in[2], HN1 + (size_t)m * DM, lane); }
      GAS u32x4* z = (GAS u32x4*)(HN1 + (size_t)(MREAL + NMETA) * DM); const int n16 = (MPAD - MREAL - NMETA) * DM / 16;
      for (int i = gt; i < n16; i += NGT) z[i] = (u32x4){0u, 0u, 0u, 0u}; }
    if (PART == 0) { float* ct = WSP(float, WS_COS); float* st = WSP(float, WS_SIN);
      for (int i = gt; i < NPOS * 32; i += NGT) { const int p = i >> 5, j = i & 31;
          const float inv = __builtin_powf(10000.0f, -(float)(2 * j) / 64.0f); const float ang = (float)p * inv;
          double r = (double)ang * 0.15915494309189535; r -= __builtin_rint(r); const float rf = (float)r;
          ct[i] = __builtin_amdgcn_cosf(rf); st[i] = __builtin_amdgcn_sinf(rf); } }
    if (PART == 1) { const float* SK = F.in[15]; const float* WQ = F.in[14]; const float* g2 = F.in[13]; bf16_t* WSCp = WSP(bf16_t, WS_WSC);
      const int l15 = lane & 15, l4 = lane >> 4;
      for (int task = gw; task < 2048; task += NGW) { const int g = task >> 7, nt = (task >> 4) & 7, kc = task & 15, n0 = nt * 16;
          bf16x8 bfr[4];
#pragma unroll
          for (int kk = 0; kk < 4; ++kk) { const float* p = SK + ((size_t)g * 128 + n0 + l15) * 128 + 32 * kk + 8 * l4; const f32x4 a = *(const GAS f32x4*)p, b = *(const GAS f32x4*)(p + 4);
              const u32x4 w = pack8(a, b); bfr[kk] = __builtin_bit_cast(bf16x8, w); }
          for (int kt = 0; kt < 8; ++kt) { const int k0 = (kc * 8 + kt) * 16; f32x4 acc = (f32x4){0.f, 0.f, 0.f, 0.f};
#pragma unroll
              for (int kk = 0; kk < 4; ++kk) { const float* p = WQ + (size_t)(k0 + l15) * 2048 + g * 128 + 32 * kk + 8 * l4; const f32x4 a = *(const GAS f32x4*)p, b = *(const GAS f32x4*)(p + 4);
                  const u32x4 w = pack8(a, b); acc = __builtin_amdgcn_mfma_f32_16x16x32_bf16(__builtin_bit_cast(bf16x8, w), bfr[kk], acc, 0, 0, 0); }
              const f32x4 gg = *(const GAS f32x4*)(g2 + k0 + 4 * l4);
              *(GAS u32x2*)(WSCp + (size_t)(g * 128 + n0 + l15) * 2048 + k0 + 4 * l4) = pack4(acc * gg); } } }
}
using pg8::Unit;
struct SchedGrid {
    int G, c, nM, nN; const char* A; const char* B; size_t tstep;
    __device__ __forceinline__ bool next(int i, Unit& u) const { const int L = i * G + c; if (L >= nM * nN) return false; pg8::grid_order(L, nM, nN, u.pm, u.pn); u.kind = 0; return true; }
    __device__ __forceinline__ const char* pa(const Unit& u) const { return A + (size_t)u.pm * tstep; }
    __device__ __forceinline__ const char* pb(const Unit& u) const { return B + (size_t)u.pn * tstep; }
};
constexpr int P1_MAIN = 64 * 29, P1_VT = 4 * 65, P1_META = 7, P1_UNITS = P1_MAIN + P1_VT + P1_META;
struct SchedP1 {
    int G, c; const char* hn1; const char* win; const char* wvt; size_t tstep;
    __device__ __forceinline__ bool next(int i, Unit& u) const {
        const int L = i * G + c; if (L >= P1_UNITS) return false;
        if (L < P1_MAIN) { pg8::grid_order(L, 64, 29, u.pm, u.pn); u.kind = 0; }
        else if (L < P1_MAIN + P1_VT) { const int idx = L - P1_MAIN; u.pm = idx & 3; u.pn = idx >> 2; u.kind = 1; }
        else { const int idx = L - P1_MAIN - P1_VT; u.pm = 64; u.pn = idx < 4 ? 4 + idx : (idx < 6 ? 10 + (idx - 4) : 28); u.kind = 0; }
        return true; }
    __device__ __forceinline__ const char* pa(const Unit& u) const { return (u.kind == 1 ? wvt : hn1) + (size_t)u.pm * tstep; }
    __device__ __forceinline__ const char* pb(const Unit& u) const { return (u.kind == 1 ? hn1 : win) + (size_t)u.pn * tstep; }
};
__device__ __forceinline__ void rope4(const f32x4 x1, const f32x4 x2, const float* cosT, const float* sinT, int pos, int j0, f32x4& lo, f32x4& hi) {
    const f32x4 c = *(const GAS f32x4*)(cosT + pos * 32 + j0), s = *(const GAS f32x4*)(sinT + pos * 32 + j0);
    lo = x1 * c - x2 * s; hi = x2 * c + x1 * s;
}
struct EpiP1 {
    static constexpr bool PERM = true, HAS_PRE = false;
    bf16_t *naq, *nak, *vt, *cq, *ckv, *kr, *ga, *gb; float *ssq_q, *ssq_kv; const float *cosT, *sinT;
    __device__ __forceinline__ void operator()(const f32x4 (&acc)[2][2][4][2], const Unit& u, int wr, int wc, int fr, int fq, const LAS float* rowsc) const {
        const int row0 = u.pm * 256 + wr * 64 + fr, colu = wc * 32 + 8 * fq;
        if (u.kind == 1) {
#pragma unroll
            for (int ai = 0; ai < 2; ++ai)
#pragma unroll
                for (int m = 0; m < 4; ++m) { bf16_t* rp = vt + (size_t)(row0 + ai * 128 + m * 16) * VT_PITCH + u.pn * 256 + colu;
#pragma unroll
                    for (int bj = 0; bj < 2; ++bj) *(GAS u32x4*)(rp + bj * 128) = pack8(acc[ai][bj][m][0], acc[ai][bj][m][1]); }
            return; }
        const int pn = u.pn;
        if (pn == 28) {
            if (wc < 2) { const int j0 = 4 * (4 * wc + fq);
#pragma unroll
                for (int ai = 0; ai < 2; ++ai)
#pragma unroll
                    for (int m = 0; m < 4; ++m) { const int row = row0 + ai * 128 + m * 16; const int pos = row < MREAL ? NMETA + (row & (SEQ - 1)) : row - MREAL;
                        f32x4 lo, hi; rope4(acc[ai][0][m][0], acc[ai][0][m][1], cosT, sinT, pos, j0, lo, hi);
                        *(GAS u32x2*)(kr + (size_t)row * 64 + j0) = pack4(lo); *(GAS u32x2*)(kr + (size_t)row * 64 + 32 + j0) = pack4(hi); } }
            return; }
        if (pn >= 12) {
            bf16_t* base = pn < 20 ? ga : gb; const int colt = (pn < 20 ? pn - 12 : pn - 20) * 256 + colu;
#pragma unroll
            for (int ai = 0; ai < 2; ++ai)
#pragma unroll
                for (int m = 0; m < 4; ++m) { bf16_t* rp = base + (size_t)(row0 + ai * 128 + m * 16) * 2048 + colt;
#pragma unroll
                    for (int bj = 0; bj < 2; ++bj) { f32x4 a = acc[ai][bj][m][0], b = acc[ai][bj][m][1];
#pragma unroll
                        for (int i = 0; i < 4; ++i) { a[i] = sigmoidf_(a[i]); b[i] = sigmoidf_(b[i]); }
                        *(GAS u32x4*)(rp + bj * 128) = pack8(a, b); } }
            return; }
        if (pn >= 8) {
            const bool isq = pn < 10; bf16_t* base = isq ? cq : ckv; float* ssq = isq ? ssq_q : ssq_kv; const int colt = (isq ? pn - 8 : pn - 10) * 256 + colu;
#pragma unroll
            for (int ai = 0; ai < 2; ++ai)
#pragma unroll
                for (int m = 0; m < 4; ++m) { const int row = row0 + ai * 128 + m * 16; bf16_t* rp = base + (size_t)row * 512 + colt; float s = 0.f;
#pragma unroll
                    for (int bj = 0; bj < 2; ++bj) { const f32x4 a = acc[ai][bj][m][0], b = acc[ai][bj][m][1];
                        s += (a[0] * a[0] + a[1] * a[1]) + (a[2] * a[2] + a[3] * a[3]) + (b[0] * b[0] + b[1] * b[1]) + (b[2] * b[2] + b[3] * b[3]);
                        *(GAS u32x4*)(rp + bj * 128) = pack8(a, b); }
                    s += __shfl_xor(s, 16); s += __shfl_xor(s, 32);
                    if (fq == 0) ssq[(size_t)((pn & 1) * 4 + wc) * MPAD + row] = s; }
            return; }
        {
            bf16_t* base = pn < 4 ? naq : nak; const int colt = (pn & 3) * 256 + colu;
#pragma unroll
            for (int ai = 0; ai < 2; ++ai)
#pragma unroll
                for (int m = 0; m < 4; ++m) { bf16_t* rp = base + (size_t)(row0 + ai * 128 + m * 16) * 1024 + colt;
#pragma unroll
                    for (int bj = 0; bj < 2; ++bj) *(GAS u32x4*)(rp + bj * 128) = pack8(acc[ai][bj][m][0], acc[ai][bj][m][1]); }
        }
    }
};
constexpr int P3_Q = 64 * 12, P3_KV = 65 * 16, P3_UNITS = P3_Q + P3_KV;
struct SchedP3 {
    int G, c; const char* cq; const char* ckv; const char* wuq; const char* wukv; size_t tstep;
    __device__ __forceinline__ bool next(int i, Unit& u) const {
        const int L = i * G + c; if (L >= P3_UNITS) return false;
        if (L < P3_Q) { pg8::grid_order(L, 64, 12, u.pm, u.pn); u.kind = 0; } else { pg8::grid_order(L - P3_Q, 65, 16, u.pm, u.pn); u.kind = 1; }
        return true; }
    __device__ __forceinline__ const char* pa(const Unit& u) const { return (u.kind ? ckv : cq) + (size_t)u.pm * tstep; }
    __device__ __forceinline__ const char* pb(const Unit& u) const { return (u.kind ? wukv : wuq) + (size_t)u.pn * tstep; }
};
template <int NS, int LD> __device__ __forceinline__ float rstd_slabs(const float* part, int row, float invn) {
    float s = 0.f;
#pragma unroll
    for (int i = 0; i < NS; ++i) s += part[(size_t)i * LD + row];
    return 1.0f / sqrtf(s * invn + NORM_EPS);
}
struct EpiP3 {
    static constexpr bool PERM = true, HAS_PRE = true;
    bf16_t *qm, *kn, *vv; const float *ssq_q, *ssq_kv; const float *cosT, *sinT;
    __device__ __forceinline__ void pre(const Unit& u, LAS float* sc, int tid) const { if (tid < 256) { const int row = u.pm * 256 + tid; sc[tid] = u.kind ? rstd_slabs<8, MPAD>(ssq_kv, row, 1.f / 512.f) : rstd_slabs<8, MPAD>(ssq_q, row, 1.f / 512.f); } }
    __device__ __forceinline__ void operator()(const f32x4 (&acc)[2][2][4][2], const Unit& u, int wr, int wc, int fr, int fq, const LAS float* rowsc) const {
        const int row0 = u.pm * 256 + wr * 64 + fr, colu = wc * 32 + 8 * fq;
        if (u.kind == 1) {
#pragma unroll
            for (int ai = 0; ai < 2; ++ai)
#pragma unroll
                for (int m = 0; m < 4; ++m) { const int row = row0 + ai * 128 + m * 16; const float rs = rowsc[ai * 128 + wr * 64 + m * 16 + fr];
                    const size_t off = (size_t)row * 2048 + u.pn * 128 + colu;
                    *(GAS u32x4*)(kn + off) = pack8(acc[ai][0][m][0] * rs, acc[ai][0][m][1] * rs);
                    *(GAS u32x4*)(vv + off) = pack8(acc[ai][1][m][0] * rs, acc[ai][1][m][1] * rs); }
            return; }
#pragma unroll
        for (int bj = 0; bj < 2; ++bj) { const int c8 = u.pn * 256 + bj * 128 + colu; const int hd = c8 / 192, w = c8 - hd * 192;
            if (w < 128) {
#pragma unroll
                for (int ai = 0; ai < 2; ++ai)
#pragma unroll
                    for (int m = 0; m < 4; ++m) { const int row = row0 + ai * 128 + m * 16; const float rs = rowsc[ai * 128 + wr * 64 + m * 16 + fr];
                        *(GAS u32x4*)(qm + (size_t)row * 3072 + c8) = pack8(acc[ai][bj][m][0] * rs, acc[ai][bj][m][1] * rs); }
            } else { const int j0 = (w - 128) >> 1;
#pragma unroll
                for (int ai = 0; ai < 2; ++ai)
#pragma unroll
                    for (int m = 0; m < 4; ++m) { const int row = row0 + ai * 128 + m * 16; const float rs = rowsc[ai * 128 + wr * 64 + m * 16 + fr];
                        const int pos = NMETA + (row & (SEQ - 1)); f32x4 lo, hi; rope4(acc[ai][bj][m][0] * rs, acc[ai][bj][m][1] * rs, cosT, sinT, pos, j0, lo, hi);
                        bf16_t* qp = qm + (size_t)row * 3072 + hd * 192 + 128 + j0; *(GAS u32x2*)qp = pack4(lo); *(GAS u32x2*)(qp + 32) = pack4(hi); }
            } }
    }
};
__device__ __forceinline__ void unpack8(const u32x4 w, f32x4& a, f32x4& b) { a = (f32x4){bf_lo(w.x), bf_hi(w.x), bf_lo(w.y), bf_hi(w.y)}; b = (f32x4){bf_lo(w.z), bf_hi(w.z), bf_lo(w.w), bf_hi(w.w)}; }
struct EpiP5a {
    static constexpr bool PERM = true, HAS_PRE = false;
    const bf16_t* ga; bf16_t* t1;
    __device__ __forceinline__ void operator()(const f32x4 (&acc)[2][2][4][2], const Unit& u, int wr, int wc, int fr, int fq, const LAS float* rowsc) const {
        const int row0 = u.pm * 256 + wr * 64 + fr, col0 = u.pn * 256 + wc * 32 + 8 * fq;
#pragma unroll
        for (int ai = 0; ai < 2; ++ai)
#pragma unroll
            for (int m = 0; m < 4; ++m) { const size_t off = (size_t)(row0 + ai * 128 + m * 16) * 2048 + col0;
#pragma unroll
                for (int bj = 0; bj < 2; ++bj) { f32x4 g0, g1; unpack8(*(const GAS u32x4*)(ga + off + bj * 128), g0, g1);
                    *(GAS u32x4*)(t1 + off + bj * 128) = pack8(acc[ai][bj][m][0] * g0, acc[ai][bj][m][1] * g1); } }
    }
};
struct EpiP5b {
    static constexpr bool PERM = true, HAS_PRE = false;
    const bf16_t* gb; const bf16_t* t1; bf16_t* merged;
    __device__ __forceinline__ void operator()(const f32x4 (&acc)[2][2][4][2], const Unit& u, int wr, int wc, int fr, int fq, const LAS float* rowsc) const {
        const int row0 = u.pm * 256 + wr * 64 + fr, col0 = u.pn * 256 + wc * 32 + 8 * fq;
#pragma unroll
        for (int ai = 0; ai < 2; ++ai)
#pragma unroll
            for (int m = 0; m < 4; ++m) { const size_t off = (size_t)(row0 + ai * 128 + m * 16) * 2048 + col0;
#pragma unroll
                for (int bj = 0; bj < 2; ++bj) { f32x4 g0, g1; unpack8(*(const GAS u32x4*)(gb + off + bj * 128), g0, g1);
                    f32x4 a, b; unpack8(*(const GAS u32x4*)(t1 + off + bj * 128), a, b);
                    *(GAS u32x4*)(merged + off + bj * 128) = pack8(a + acc[ai][bj][m][0] * g0, b + acc[ai][bj][m][1] * g1); } }
    }
};
struct EpiP6 {
    static constexpr bool PERM = true, HAS_PRE = false;
    const float* x; float* h2; bf16_t* h2b; float* ssq2;
    __device__ __forceinline__ void operator()(const f32x4 (&acc)[2][2][4][2], const Unit& u, int wr, int wc, int fr, int fq, const LAS float* rowsc) const {
        const int row0 = u.pm * 256 + wr * 64 + fr, col0 = u.pn * 256 + wc * 32 + 8 * fq;
#pragma unroll
        for (int ai = 0; ai < 2; ++ai)
#pragma unroll
            for (int m = 0; m < 4; ++m) { const int row = row0 + ai * 128 + m * 16; const size_t off = (size_t)row * 2048 + col0; float s = 0.f;
#pragma unroll
                for (int bj = 0; bj < 2; ++bj) { const f32x4 a = *(const GAS f32x4*)(x + off + bj * 128) + acc[ai][bj][m][0], b = *(const GAS f32x4*)(x + off + bj * 128 + 4) + acc[ai][bj][m][1];
                    s += (a[0] * a[0] + a[1] * a[1]) + (a[2] * a[2] + a[3] * a[3]) + (b[0] * b[0] + b[1] * b[1]) + (b[2] * b[2] + b[3] * b[3]);
                    *(GAS f32x4*)(h2 + off + bj * 128) = a; *(GAS f32x4*)(h2 + off + bj * 128 + 4) = b; *(GAS u32x4*)(h2b + off + bj * 128) = pack8(a, b); }
                s += __shfl_xor(s, 16); s += __shfl_xor(s, 32);
                if (fq == 0) ssq2[(size_t)(u.pn * 4 + wc) * MREAL + row] = s; }
    }
};
struct EpiP7 {
    static constexpr bool PERM = false, HAS_PRE = true;
    const float* ssq2; float* sc;
    __device__ __forceinline__ void pre(const Unit& u, LAS float* sc, int tid) const { if (tid < 256) sc[tid] = rstd_slabs<32, MREAL>(ssq2, u.pm * 256 + tid, 1.f / 2048.f); }
    __device__ __forceinline__ void operator()(const f32x4 (&acc)[2][2][4][2], const Unit& u, int wr, int wc, int fr, int fq, const LAS float* rowsc) const {
        const int row0 = u.pm * 256 + wr * 64 + fr, col0 = u.pn * 256 + wc * 32 + 4 * fq;
#pragma unroll
        for (int ai = 0; ai < 2; ++ai)
#pragma unroll
            for (int m = 0; m < 4; ++m) { const int row = row0 + ai * 128 + m * 16; const float rs = rowsc[ai * 128 + wr * 64 + m * 16 + fr]; const size_t off = (size_t)row * 2048 + col0;
#pragma unroll
                for (int bj = 0; bj < 2; ++bj)
#pragma unroll
                    for (int n = 0; n < 2; ++n) *(GAS f32x4*)(sc + off + bj * 128 + n * 16) = acc[ai][bj][m][n] * rs; }
    }
};
namespace att {
#define KSWZ(row, colB) ((row) * 256 + ((colB) ^ (((row) & 7) << 4)))
#define KRSWZ(row, colB) ((row) * 128 + ((colB) ^ ((((row) >> 1) & 7) << 4)))
constexpr float L2E = 1.4426950408889634f;
template <int DUMMY = 0>
__device__ __forceinline__ void partialSM(f32x16& p0, f32x16& p1, float& m_reg, float& mn, float& alpha, const float C, const float THRS) {
  float pmax = p0[0];
#pragma unroll
  for (int r = 1; r < 16; ++r) pmax = fmaxf(pmax, p0[r]);
#pragma unroll
  for (int r = 0; r < 16; ++r) pmax = fmaxf(pmax, p1[r]);
  { auto rr = __builtin_amdgcn_permlane32_swap(__float_as_uint(pmax), __float_as_uint(pmax), false, false);
    pmax = fmaxf(__uint_as_float(rr[0]), __uint_as_float(rr[1])); }
  if (__builtin_expect(__all(pmax - m_reg <= THRS), 1)) { mn = m_reg; alpha = 1.f; }
  else { mn = fmaxf(m_reg, pmax); alpha = __builtin_amdgcn_exp2f((m_reg - mn) * C); m_reg = mn; }
  const float mnC = -mn * C;
#pragma unroll
  for (int r = 0; r < 16; ++r) p0[r] = fmaf(p0[r], C, mnC);
#pragma unroll
  for (int r = 0; r < 16; ++r) p1[r] = fmaf(p1[r], C, mnC);
#pragma unroll
  for (int r = 0; r < 16; ++r) p0[r] = __builtin_amdgcn_exp2f(p0[r]);
}
__device__ __forceinline__ void finishSM(f32x16& p0, f32x16& p1, float alpha, float& l_reg, bf16x8& pa0, bf16x8& pa1, bf16x8& pa2, bf16x8& pa3) {
#pragma unroll
  for (int r = 0; r < 16; ++r) p1[r] = __builtin_amdgcn_exp2f(p1[r]);
  float ps = 0;
#pragma unroll
  for (int r = 0; r < 16; ++r) ps += p0[r];
#pragma unroll
  for (int r = 0; r < 16; ++r) ps += p1[r];
  { auto rr = __builtin_amdgcn_permlane32_swap(__float_as_uint(ps), __float_as_uint(ps), false, false);
    ps = __uint_as_float(rr[0]) + __uint_as_float(rr[1]); }
  l_reg = l_reg * alpha + ps;
#define PK4(P, BASE, OUT) do { unsigned a0 = cvt_pk_bf16(P[BASE + 0], P[BASE + 1]), a1 = cvt_pk_bf16(P[BASE + 2], P[BASE + 3]);   \
    unsigned b0 = cvt_pk_bf16(P[BASE + 4], P[BASE + 5]), b1 = cvt_pk_bf16(P[BASE + 6], P[BASE + 7]);                              \
    auto r0 = __builtin_amdgcn_permlane32_swap(a0, b0, false, false); auto r1 = __builtin_amdgcn_permlane32_swap(a1, b1, false, false); \
    u32x4 w = {r0[0], r1[0], r0[1], r1[1]}; OUT = __builtin_bit_cast(bf16x8, w); } while (0)
  PK4(p0, 0, pa0); PK4(p0, 8, pa1); PK4(p1, 0, pa2); PK4(p1, 8, pa3);
#undef PK4
}
constexpr int NW = 8, QBLK = 32, KVBLK = 64;
constexpr float MLA_SCALE = 0.07216878364870322f;
constexpr float MLA_THR = 8.f;
constexpr int SHM_V = KVBLK * 128 * 2, SHM_KN = KVBLK * 128 * 2, SHM_KR = KVBLK * 64 * 2;
constexpr int OFF_V = 0, OFF_KN = 2 * SHM_V, OFF_KR = OFF_KN + 2 * SHM_KN, OFF_WS = OFF_KR + 2 * SHM_KR, OFF_QR = OFF_WS + NW * 64 * 4, MLA_LDS = OFF_QR + NW * 4096;
__device__ __forceinline__ void qkt(f32x16& p0, f32x16& p1, const LAS char* Kn, const LAS char* Kr, const bf16x8* qr, const LAS char* qrp, const int* kb, const int* krb) {
  p0 = f32x16{}; p1 = f32x16{};
#pragma unroll
  for (int d0 = 0; d0 < 8; ++d0) {
    const bf16x8 b0 = *(const LAS bf16x8*)(Kn + kb[d0 & 3] + (d0 >> 2) * 128);
    const bf16x8 b1 = *(const LAS bf16x8*)(Kn + kb[d0 & 3] + (d0 >> 2) * 128 + 8192);
    p0 = __builtin_amdgcn_mfma_f32_32x32x16_bf16(b0, qr[d0], p0, 0, 0, 0);
    p1 = __builtin_amdgcn_mfma_f32_32x32x16_bf16(b1, qr[d0], p1, 0, 0, 0); }
#pragma unroll
  for (int d0 = 0; d0 < 4; ++d0) {
    const bf16x8 b0 = *(const LAS bf16x8*)(Kr + krb[d0]);
    const bf16x8 b1 = *(const LAS bf16x8*)(Kr + krb[d0] + 4096);
    const bf16x8 qf = *(const LAS bf16x8*)(qrp + d0 * 1024);
    p0 = __builtin_amdgcn_mfma_f32_32x32x16_bf16(b0, qf, p0, 0, 0, 0);
    p1 = __builtin_amdgcn_mfma_f32_32x32x16_bf16(b1, qf, p1, 0, 0, 0); }
}
__device__ __forceinline__ int v_st(int k, int c) { const int kk = (k & ~0xC) | ((k & 4) << 1) | ((k & 8) >> 1); return ((kk >> 3) * 4 + (c >> 5)) * 512 + ((kk & 7) * 32 + (c & 31)) * 2; }
__device__ __forceinline__ int v_rd_base(int lane) { return ((lane & 3) << 3) | (((lane >> 2) & 3) << 6) | (((lane >> 4) & 1) << 5) | (((lane >> 5) & 1) << 8); }
constexpr int v_rd_off(int d0, int ks, int half) { return d0 * 512 + ks * 4096 + half * 2048; }
template <int OFF> __device__ __forceinline__ s16x4 tr_read(int vb) {
  s16x4 r; asm volatile("ds_read_b64_tr_b16 %0, %1 offset:%2" : "=&v"(r) : "v"(vb), "i"(OFF) : "memory"); return r;
}
template <int D0> __device__ __forceinline__ void pv_one(f32x16& od, int vb, bf16x8 pa0, bf16x8 pa1, bf16x8 pa2, bf16x8 pa3) {
  const s16x4 l0 = tr_read<v_rd_off(D0, 0, 0)>(vb), h0 = tr_read<v_rd_off(D0, 0, 1)>(vb), l1 = tr_read<v_rd_off(D0, 1, 0)>(vb), h1 = tr_read<v_rd_off(D0, 1, 1)>(vb);
  const s16x4 l2 = tr_read<v_rd_off(D0, 2, 0)>(vb), h2 = tr_read<v_rd_off(D0, 2, 1)>(vb), l3 = tr_read<v_rd_off(D0, 3, 0)>(vb), h3 = tr_read<v_rd_off(D0, 3, 1)>(vb);
  asm volatile("s_waitcnt lgkmcnt(0)" ::: "memory"); SBAR();
#define PK(L, H) (bf16x8){L[0], L[1], L[2], L[3], H[0], H[1], H[2], H[3]}
  od = __builtin_amdgcn_mfma_f32_32x32x16_bf16(pa0, PK(l0, h0), od, 0, 0, 0);
  od = __builtin_amdgcn_mfma_f32_32x32x16_bf16(pa1, PK(l1, h1), od, 0, 0, 0);
  od = __builtin_amdgcn_mfma_f32_32x32x16_bf16(pa2, PK(l2, h2), od, 0, 0, 0);
  od = __builtin_amdgcn_mfma_f32_32x32x16_bf16(pa3, PK(l3, h3), od, 0, 0, 0);
#undef PK
}
__device__ __forceinline__ void pv_d0(f32x16* o, int vb, bf16x8 pa0, bf16x8 pa1, bf16x8 pa2, bf16x8 pa3) {
  pv_one<0>(o[0], vb, pa0, pa1, pa2, pa3); pv_one<1>(o[1], vb, pa0, pa1, pa2, pa3); pv_one<2>(o[2], vb, pa0, pa1, pa2, pa3); pv_one<3>(o[3], vb, pa0, pa1, pa2, pa3);
}
__device__ __forceinline__ void mla_unit(int b, int h, int qb, const bf16_t* __restrict__ QM, const bf16_t* __restrict__ KN, const bf16_t* __restrict__ KR, const bf16_t* __restrict__ VV, bf16_t* __restrict__ OM, LAS char* lds) {
  const int tid = threadIdx.x, wid = tid >> 6, lane = tid & 63, r32 = lane & 31, hi = lane >> 5;
  constexpr float C = MLA_SCALE * L2E, THRS = MLA_THR / MLA_SCALE;
  constexpr int NT = 33;
  LAS char* V_lds = lds + OFF_V; LAS char* Kn_lds = lds + OFF_KN; LAS char* Kr_lds = lds + OFF_KR;
  LAS float* ws = (LAS float*)(lds + OFF_WS) + wid * 64; LAS float* li_l = ws; LAS float* al_l = ws + 32;
  float m_reg = -1e30f, l_reg = 0; f32x16 o[4] = {}; bf16x8 qr[8];
  LAS char* qrp = lds + OFF_QR + wid * 4096 + lane * 16;
  const int qrow = b * SEQ + qb * 256 + wid * QBLK + r32;
  const bf16_t* Qw = QM + (size_t)qrow * 3072 + h * 192 + hi * 8;
#pragma unroll
  for (int d0 = 0; d0 < 8; ++d0) qr[d0] = *(const GAS bf16x8*)(Qw + d0 * 16);
  __syncthreads();
#pragma unroll
  for (int d0 = 0; d0 < 4; ++d0) *(LAS bf16x8*)(qrp + d0 * 1024) = *(const GAS bf16x8*)(Qw + (8 + d0) * 16);
  const int sr = tid >> 4, sc = (tid & 15) * 8, vst0 = v_st(sr, sc), vst1 = v_st(32 + sr, sc);
  const int krr = tid >> 3, krc = (tid & 7) * 8;
  const int vb0 = (int)(uintptr_t)V_lds + v_rd_base(lane);
  bf16x8 s_v0, s_v1, s_k0, s_k1, s_kr;
  const int realbase = b * SEQ - KVBLK;
  const unsigned voff = (unsigned)(sr * 2048 + sc) * 2u, kroff = (unsigned)(krr * 64 + krc) * 2u;
  int kb[4], krb[4];
#pragma unroll
  for (int bq = 0; bq < 4; ++bq) { kb[bq] = KSWZ(r32, bq * 32 + hi * 16); krb[bq] = KRSWZ(r32, bq * 32 + hi * 16); }
#define TROW(t) ((t) == 0 ? MREAL : realbase + (t) * KVBLK)
#define SLOAD(t) do { const int k0_ = TROW(t); const size_t ro_ = ((size_t)k0_ * 2048 + h * 128) * 2; \
    const GAS char* vb_ = (const GAS char*)VV + ro_; const GAS char* nb_ = (const GAS char*)KN + ro_; const GAS char* rb_ = (const GAS char*)KR + (size_t)k0_ * 128; \
    s_v0 = *(const GAS bf16x8*)(vb_ + voff); s_v1 = *(const GAS bf16x8*)(vb_ + 32 * 4096 + voff); \
    s_k0 = *(const GAS bf16x8*)(nb_ + voff); s_k1 = *(const GAS bf16x8*)(nb_ + 32 * 4096 + voff); \
    s_kr = *(const GAS bf16x8*)(rb_ + kroff); } while (0)
#define SWRITE(bf) do { *(LAS bf16x8*)(V_lds + (bf) * SHM_V + vst0) = s_v0; *(LAS bf16x8*)(V_lds + (bf) * SHM_V + vst1) = s_v1; const int kc_ = sc * 2; \
    *(LAS bf16x8*)(Kn_lds + (bf) * SHM_KN + KSWZ(sr, kc_)) = s_k0; *(LAS bf16x8*)(Kn_lds + (bf) * SHM_KN + KSWZ(32 + sr, kc_)) = s_k1; \
    *(LAS bf16x8*)(Kr_lds + (bf) * SHM_KR + KRSWZ(krr, krc * 2)) = s_kr; } while (0)
#define SWAIT() asm volatile("s_waitcnt vmcnt(0)" ::: "memory")
#define RESC(a) do { if (__any((a) < 1.f)) { if (hi == 0) al_l[r32] = (a); asm volatile("s_waitcnt lgkmcnt(0)" ::: "memory"); \
    _Pragma("unroll") for (int d = 0; d < 4; ++d) _Pragma("unroll") for (int r = 0; r < 16; ++r) o[d][r] *= al_l[crow(r, hi)]; } } while (0)
  f32x16 pA0, pA1, pB0, pB1; float mnA, mnB, alA, alB; bf16x8 pa0, pa1, pa2, pa3;
  SLOAD(0); SWAIT(); SWRITE(0); __syncthreads();
  qkt(pA0, pA1, Kn_lds, Kr_lds, qr, qrp, kb, krb);
  { const float NEG = -INFINITY;
#pragma unroll
    for (int r = 8; r < 16; ++r) pA0[r] = NEG;
#pragma unroll
    for (int r = 0; r < 16; ++r) pA1[r] = NEG; }
  partialSM(pA0, pA1, m_reg, mnA, alA, C, THRS);
  SLOAD(1); SWAIT(); SWRITE(1); __syncthreads();
  for (int j = 1; j + 1 < NT; j += 2) {
    SBAR(); qkt(pB0, pB1, Kn_lds + SHM_KN, Kr_lds + SHM_KR, qr, qrp, kb, krb);
    finishSM(pA0, pA1, alA, l_reg, pa0, pa1, pa2, pa3); SBAR();
    SLOAD(j + 1); SBAR();
    pv_d0(o, vb0, pa0, pa1, pa2, pa3); partialSM(pB0, pB1, m_reg, mnB, alB, C, THRS);
    __syncthreads(); SWAIT(); SWRITE(0);
    RESC(alB); __syncthreads();
    SBAR(); qkt(pA0, pA1, Kn_lds, Kr_lds, qr, qrp, kb, krb);
    finishSM(pB0, pB1, alB, l_reg, pa0, pa1, pa2, pa3); SBAR();
    if (j + 2 < NT) SLOAD(j + 2); SBAR();
    pv_d0(o, vb0 + SHM_V, pa0, pa1, pa2, pa3); partialSM(pA0, pA1, m_reg, mnA, alA, C, THRS);
    __syncthreads(); if (j + 2 < NT) { SWAIT(); SWRITE(1); }
    RESC(alA); __syncthreads();
  }
  finishSM(pA0, pA1, alA, l_reg, pa0, pa1, pa2, pa3); SBAR();
  pv_d0(o, vb0, pa0, pa1, pa2, pa3);
  if (hi == 0) li_l[r32] = l_reg; asm volatile("s_waitcnt lgkmcnt(0)" ::: "memory");
  float rli[16];
#pragma unroll
  for (int r = 0; r < 16; ++r) rli[r] = __builtin_amdgcn_rcpf(li_l[crow(r, hi)]);
  bf16_t* Ow = OM + (size_t)(b * SEQ + qb * 256 + wid * QBLK) * 2048 + h * 128;
#pragma unroll
  for (int r = 0; r < 16; ++r) { const int orow = crow(r, hi);
#pragma unroll
    for (int d0 = 0; d0 < 4; ++d0) { const unsigned w = cvt_pk_bf16(o[d0][r] * rli[r], 0.f); Ow[(size_t)orow * 2048 + d0 * 32 + r32] = (bf16_t)(w & 0xffffu); } }
#undef TROW
#undef SLOAD
#undef SWRITE
#undef SWAIT
#undef RESC
}
__device__ __forceinline__ void na_task(int task, const bf16_t* __restrict__ NAQ, const bf16_t* __restrict__ NAK, const bf16_t* __restrict__ VT, bf16_t* __restrict__ ONA,
                                        const LAS float* relb, const LAS float* metab, LAS float* wsf, int lane) {
  const int r32 = lane & 31, hi = lane >> 5;
  const int half = task & 1, r = (task >> 1) & 31, h = (task >> 6) & 15, b = task >> 10;
  const int qc = half * 32 + r32;
  const int cs = min(max(qc - 8, 0), 48), rs = min(max(r - 4, 0), 24);
  const int qtok = b * SEQ + r * 64 + qc;
  constexpr float C = L2E, THRS = 8.f, SCALE = 0.125f;
  bf16x8 qr[4];
#pragma unroll
  for (int d0 = 0; d0 < 4; ++d0) qr[d0] = *(const GAS bf16x8*)(NAQ + (size_t)qtok * 1024 + h * 64 + d0 * 16 + hi * 8);
  float m_reg = -1e30f, l_reg = 0.f; f32x16 o[2] = {};
  LAS float* al_l = wsf; LAS float* li_l = wsf + 32;
  const float NEG = -INFINITY;
  const unsigned long long wm = 0xFFFFull << cs;
  const unsigned mh0 = (unsigned)wm >> (4 * hi), mh1 = (unsigned)(wm >> 32) >> (4 * hi);
  const bf16_t* kq = NAK + (size_t)r32 * 1024 + h * 64 + hi * 8;
  const bf16_t* vq = VT + (size_t)(h * 64 + r32) * VT_PITCH + 8 * hi;
#define NA_KTOK(w) ((w) == 8 ? MREAL : b * SEQ + (rs + (w)) * 64)
#define NA_LOADK(KF, w) do { const bf16_t* kp_ = kq + (size_t)NA_KTOK(w) * 1024; _Pragma("unroll") for (int d0 = 0; d0 < 4; ++d0) { KF[d0] = *(const GAS bf16x8*)(kp_ + d0 * 16); KF[4 + d0] = *(const GAS bf16x8*)(kp_ + 32 * 1024 + d0 * 16); } } while (0)
#define NA_TILE(KF, w) do { \
    bf16x8 vf[8]; { const bf16_t* vp_ = vq + NA_KTOK(w); _Pragma("unroll") for (int ks = 0; ks < 4; ++ks) { vf[ks] = *(const GAS bf16x8*)(vp_ + 16 * ks); vf[4 + ks] = *(const GAS bf16x8*)(vp_ + (size_t)32 * VT_PITCH + 16 * ks); } } \
    f32x16 p0 = {}, p1 = {}; \
    _Pragma("unroll") for (int d0 = 0; d0 < 4; ++d0) { p0 = __builtin_amdgcn_mfma_f32_32x32x16_bf16(KF[d0], qr[d0], p0, 0, 0, 0); p1 = __builtin_amdgcn_mfma_f32_32x32x16_bf16(KF[4 + d0], qr[d0], p1, 0, 0, 0); } \
    if ((w) + 1 < 9) NA_LOADK(KF, (w) + 1);            \
    if ((w) < 8) { const LAS float* bp_ = relb + ((h * 15 + (rs + (w) - r + 7)) * 31 + 15 - qc + 4 * hi);     \
      _Pragma("unroll") for (int rg = 0; rg < 16; ++rg) { const int c_ = (rg & 3) + 8 * (rg >> 2); \
        { const bool ok = (mh0 >> c_) & 1u; const float bv = bp_[c_]; p0[rg] = ok ? fmaf(p0[rg], SCALE, bv) : NEG; } \
        { const bool ok = (mh1 >> c_) & 1u; const float bv = bp_[c_ + 32]; p1[rg] = ok ? fmaf(p1[rg], SCALE, bv) : NEG; } } \
    } else { const LAS float* bp = metab + h * 16; \
      _Pragma("unroll") for (int rg = 0; rg < 16; ++rg) { const int kc = crow(rg, hi); p0[rg] = (rg < 8) ? fmaf(p0[rg], SCALE, bp[kc & 15]) : NEG; p1[rg] = NEG; } } \
    float mn, alpha; partialSM(p0, p1, m_reg, mn, alpha, C, THRS); \
    bf16x8 pa0, pa1, pa2, pa3; finishSM(p0, p1, alpha, l_reg, pa0, pa1, pa2, pa3); \
    if (__any(alpha < 1.f)) { if (hi == 0) al_l[r32] = alpha; asm volatile("s_waitcnt lgkmcnt(0)" ::: "memory"); \
      _Pragma("unroll") for (int d = 0; d < 2; ++d) _Pragma("unroll") for (int rg = 0; rg < 16; ++rg) o[d][rg] *= al_l[crow(rg, hi)]; } \
    _Pragma("unroll") for (int d0 = 0; d0 < 2; ++d0) { \
      o[d0] = __builtin_amdgcn_mfma_f32_32x32x16_bf16(pa0, vf[4 * d0 + 0], o[d0], 0, 0, 0); o[d0] = __builtin_amdgcn_mfma_f32_32x32x16_bf16(pa1, vf[4 * d0 + 1], o[d0], 0, 0, 0); \
      o[d0] = __builtin_amdgcn_mfma_f32_32x32x16_bf16(pa2, vf[4 * d0 + 2], o[d0], 0, 0, 0); o[d0] = __builtin_amdgcn_mfma_f32_32x32x16_bf16(pa3, vf[4 * d0 + 3], o[d0], 0, 0, 0); } } while (0)
  { bf16x8 kA[8];
    NA_LOADK(kA, 0);
#pragma unroll 1
    for (int w = 0; w < 8; ++w) { NA_TILE(kA, w); }
    NA_TILE(kA, 8); }
#undef NA_KTOK
#undef NA_LOADK
#undef NA_TILE
  if (hi == 0) li_l[r32] = l_reg; asm volatile("s_waitcnt lgkmcnt(0)" ::: "memory");
  bf16_t* Ow = ONA + (size_t)(b * SEQ + r * 64 + half * 32) * 1024 + h * 64;
#pragma unroll
  for (int rg = 0; rg < 16; ++rg) { const int orow = crow(rg, hi); const float rl = __builtin_amdgcn_rcpf(li_l[orow]);
#pragma unroll
    for (int d0 = 0; d0 < 2; ++d0) { const unsigned wv = cvt_pk_bf16(o[d0][rg] * rl, 0.f); Ow[(size_t)orow * 1024 + d0 * 32 + r32] = (bf16_t)(wv & 0xffffu); } }
  asm volatile("s_waitcnt lgkmcnt(0)" ::: "memory");
}
}
namespace peer {
constexpr int CH = 32;
constexpr int OFF_TV = 0, OFF_TI = OFF_TV + CH * 16 * 16 * 4, OFF_SE = OFF_TI + CH * 16 * 16 * 4, OFF_SG = OFF_SE + CH * 128 * 4, PEER_LDS = OFF_SG + CH * 128 * 4;
__device__ __forceinline__ float gelu_tanh(float x) {
    const float u = 0.7978845608028654f * (x + 0.044715f * x * x * x);
    const float e = __builtin_amdgcn_exp2f(-2.f * 1.4426950408889634f * fabsf(u));
    const float t = (1.f - e) * __builtin_amdgcn_rcpf(1.f + e);
    return 0.5f * x * (1.f + (u < 0.f ? -t : t));
}
__device__ __forceinline__ void fmac1(float& acc, float a, float b) { asm("v_fmac_f32_e32 %0, %1, %2" : "+v"(acc) : "v"(a), "v"(b)); }
#define PEER_INSERT(x_, xi_) do { float x__ = (x_); int xi__ = (xi_); \
    _Pragma("unroll") for (int j_ = 0; j_ < 16; ++j_) { const bool gt_ = x__ > tv[j_]; const float tvo_ = tv[j_]; const int tio_ = ti[j_]; \
        tv[j_] = gt_ ? x__ : tvo_; ti[j_] = gt_ ? xi__ : tio_; x__ = gt_ ? tvo_ : x__; xi__ = gt_ ? tio_ : xi__; } } while (0)

#define PEER_AUX 0
typedef __amdgpu_buffer_rsrc_t rsrc_t;
__device__ __forceinline__ rsrc_t mk_rsrc(const void* p, unsigned bytes) { return __builtin_amdgcn_make_buffer_rsrc((void*)p, 0, bytes, 0x00020000); }
__device__ __forceinline__ u32x4 ldb128(rsrc_t r, unsigned off) { return __builtin_amdgcn_raw_buffer_load_b128(r, off, 0, PEER_AUX); }
typedef unsigned v6u_t __attribute__((ext_vector_type(6)));
typedef float v32f_t __attribute__((ext_vector_type(32)));
typedef float v16f_t __attribute__((ext_vector_type(16)));
__device__ __forceinline__ u32x2 ldb64(rsrc_t r, unsigned off) { return __builtin_amdgcn_raw_buffer_load_b64(r, off, 0, PEER_AUX); }
__device__ __forceinline__ f32x4 ldf128(rsrc_t r, unsigned off) { return __builtin_bit_cast(f32x4, __builtin_amdgcn_raw_buffer_load_b128(r, off, 0, PEER_AUX)); }
__device__ __forceinline__ f32x4 ldf128_nt(rsrc_t r, unsigned off) { return __builtin_bit_cast(f32x4, __builtin_amdgcn_raw_buffer_load_b128(r, off, 0, 2)); }
__device__ __forceinline__ void peer_chunk(int chunk, const float* __restrict__ SC, const float* __restrict__ H2, const unsigned char* __restrict__ U, const unsigned char* __restrict__ V,
                                           const float* __restrict__ g2, const float* __restrict__ gf, float* OUT, LAS char* lds, int tid) {
    LAS float* TV = (LAS float*)(lds + OFF_TV); LAS int* TI = (LAS int*)(lds + OFF_TI); LAS int* SE = (LAS int*)(lds + OFF_SE); LAS float* SG = (LAS float*)(lds + OFF_SG);
    asm volatile("" : "+v"(tid));
    const int tok0 = chunk * CH, lane = tid & 63, wave = tid >> 6;
    const rsrc_t rSC = mk_rsrc(SC, 0x8000000u), rH2 = mk_rsrc(H2, 0x8000000u), rU = mk_rsrc(U, 0x3000000u), rG2 = mk_rsrc(g2, 8192u), rGF = mk_rsrc(gf, 8192u);
    __syncthreads();
    { const int tl = tid >> 4, g = tid & 15; const unsigned spo = ((unsigned)(tok0 + tl) * 2048u + (unsigned)g * 128u) * 4u;
      int tk[16];
#pragma unroll
      for (int j = 0; j < 16; ++j) tk[j] = (int)0x80000000;
#define PEER_KEY(x_, lowbits_, mask_) ({ const int f_ = __float_as_int(x_); ((f_ ^ ((f_ >> 31) & 0x7fffffff)) & ~(mask_)) | (lowbits_); })
#define PEER_INS(key_) do { int x__ = (key_); _Pragma("unroll") for (int j_ = 0; j_ < 16; ++j_) { const int hi_ = max(x__, tk[j_]); x__ = min(x__, tk[j_]); tk[j_] = hi_; } } while (0)
#pragma unroll 1
      for (int i = 0; i < 32; i += 2) { const f32x4 a = ldf128_nt(rSC, spo + i * 16), b = ldf128_nt(rSC, spo + i * 16 + 16);
#pragma unroll
          for (int e = 0; e < 4; ++e) { PEER_INS(PEER_KEY(a[e], 127 - (4 * i + e), 127)); }
#pragma unroll
          for (int e = 0; e < 4; ++e) { PEER_INS(PEER_KEY(b[e], 127 - (4 * i + 4 + e), 127)); } }
      LAS float* tvp = TV + (tl * 16 + g) * 16; LAS int* tip = TI + (tl * 16 + g) * 16;
#pragma unroll
      for (int j = 0; j < 16; ++j) { const int k_ = tk[j] & ~127; tvp[j] = __int_as_float(k_ ^ ((k_ >> 31) & 0x7fffffff)); tip[j] = 127 - (tk[j] & 127); } }
    __syncthreads();
    asm volatile("" : "+v"(tid));
    { const int tl = tid >> 4, hh = (tid >> 1) & 7, half = tid & 1;
      const LAS float* s1 = TV + (tl * 16 + 2 * hh) * 16; const LAS float* s2 = s1 + 16; const LAS int* i1 = TI + (tl * 16 + 2 * hh) * 16; const LAS int* i2 = i1 + 16;
      float b2[16];
#pragma unroll
      for (int j = 0; j < 16; ++j) b2[j] = s2[j];
      int tk[16];
#pragma unroll
      for (int j = 0; j < 16; ++j) tk[j] = (int)0x80000000;
#pragma unroll
      for (int ii = 0; ii < 8; ++ii) { const int i = 2 * ii + half; const float a = s1[i];
#pragma unroll
          for (int j = 0; j < 16; ++j) if ((2 * ii + 1) * (j + 1) <= 16) { if (half == 0 || (2 * ii + 2) * (j + 1) <= 16) PEER_INS(PEER_KEY(a + b2[j], 255 - (i * 16 + j), 255)); } }
      { int pk[16];
#pragma unroll
        for (int j = 0; j < 16; ++j) pk[j] = __shfl_xor(tk[j], 1);
#pragma unroll
        for (int j = 0; j < 16; ++j) PEER_INS(pk[j]); }
      if (half == 0) { float e[16], sum = 0.f; const int k0_ = tk[0] & ~255; const float v0 = __int_as_float(k0_ ^ ((k0_ >> 31) & 0x7fffffff));
#pragma unroll
        for (int j = 0; j < 16; ++j) { const int k_ = tk[j] & ~255; const float vj = __int_as_float(k_ ^ ((k_ >> 31) & 0x7fffffff)); e[j] = __builtin_amdgcn_exp2f((vj - v0) * 1.4426950408889634f); sum += e[j]; }
        const float inv = 1.0f / sum;
#pragma unroll
        for (int j = 0; j < 16; ++j) { const int ci = 255 - (tk[j] & 255); SE[tl * 128 + hh * 16 + j] = i1[ci >> 4] * 128 + i2[ci & 15]; SG[tl * 128 + hh * 16 + j] = e[j] * inv; } } }
#undef PEER_KEY
#undef PEER_INS
    __syncthreads();
#pragma unroll 1
    for (int tt = 0; tt < CH / NWAVES; ++tt) { const int tl = wave * (CH / NWAVES) + tt, tok = tok0 + tl;
      asm volatile("" ::: "memory");
      float hn[32], acc[32]; float ss = 0.f;
#pragma unroll
      for (int j = 0; j < 2; ++j)
#pragma unroll
          for (int q = 0; q < 4; ++q) { const f32x4 a = ldf128_nt(rH2, ((unsigned)tok * 2048u + 1024u * j + 16u * lane + 4u * q) * 4u);
#pragma unroll
              for (int i = 0; i < 4; ++i) { hn[16 * j + 4 * q + i] = a[i]; ss += a[i] * a[i]; } }
      const float rstd = 1.0f / sqrtf(wave_sum(ss) * (1.f / 2048.f) + NORM_EPS);
#pragma unroll
      for (int j = 0; j < 2; ++j)
#pragma unroll
          for (int q = 0; q < 4; ++q) { const f32x4 a = ldf128(rG2, (1024u * j + 16u * lane + 4u * q) * 4u);
#pragma unroll
              for (int i = 0; i < 4; ++i) hn[16 * j + 4 * q + i] *= rstd * a[i]; }
#pragma unroll
      for (int i = 0; i < 32; ++i) acc[i] = 0.f;
#define NX 4
#define PEER_LOAD(S, kb) do { _Pragma("unroll") for (int x = 0; x < NX; ++x) { const unsigned o = (unsigned)SE[tl * 128 + (kb) + x] * 3072u; \
          S##ua[x] = ldb128(rU, o + (unsigned)lane * 16u); S##ub[x] = ldb64(rU, o + 1024u + (unsigned)lane * 8u); S##va[x] = ldb128(rU, o + 1536u + (unsigned)lane * 16u); S##vb[x] = ldb64(rU, o + 2560u + (unsigned)lane * 8u); } } while (0)
#define PEER_DEC(A, B) ({ v32f_t r_ = __builtin_amdgcn_cvt_scalef32_pk32_f32_fp6((v6u_t){A.x, A.y, A.z, A.w, B.x, B.y}, 1.0f); asm volatile("s_nop 1" : "+v"(r_)); r_; })
#define PEER_COMPUTE(S, kb) do { float d[NX]; \
          _Pragma("unroll") for (int x = 0; x < NX; ++x) { const v32f_t r = PEER_DEC(S##ua[x], S##ub[x]); float dd = 0.f; \
              _Pragma("unroll") for (int i = 0; i < 32; ++i) fmac1(dd, hn[i], r[i]); \
              d[x] = dd; } \
          _Pragma("unroll") for (int o = 1; o < 64; o <<= 1) { _Pragma("unroll") for (int x = 0; x < NX; ++x) d[x] += __shfl_xor(d[x], o); } \
          float c[NX]; \
          _Pragma("unroll") for (int x = 0; x < NX; ++x) c[x] = SG[tl * 128 + (kb) + x] * gelu_tanh(d[x] * (1.f / 64.f)) * 0.25f; \
          _Pragma("unroll") for (int x = 0; x < NX; ++x) { const v32f_t r = PEER_DEC(S##va[x], S##vb[x]); \
              _Pragma("unroll") for (int i = 0; i < 32; ++i) fmac1(acc[i], c[x], r[i]); } } while (0)
      { u32x4 Aua[NX], Ava[NX], Bua[NX], Bva[NX]; u32x2 Aub[NX], Avb[NX], Bub[NX], Bvb[NX];
        PEER_LOAD(A, 0);
#pragma unroll 1
        for (int k = 0; k < 128; k += 2 * NX) {
            PEER_LOAD(B, k + NX); PEER_COMPUTE(A, k);
            { const int kn = min(k + 2 * NX, 128 - NX); PEER_LOAD(A, kn); }
            PEER_COMPUTE(B, k + NX);
        } }
#undef PEER_DEC
#undef NX
#undef PEER_LOAD
#undef PEER_COMPUTE
      asm volatile("" ::: "memory");
      int tok2 = tok, lane2 = lane; asm volatile("" : "+v"(tok2), "+v"(lane2));
      float s2 = 0.f;
#pragma unroll
      for (int j = 0; j < 2; ++j)
#pragma unroll
          for (int q = 0; q < 4; ++q) { const f32x4 a = ldf128_nt(rH2, ((unsigned)tok2 * 2048u + 1024u * j + 16u * lane2 + 4u * q) * 4u);
#pragma unroll
              for (int i = 0; i < 4; ++i) { acc[16 * j + 4 * q + i] += a[i]; s2 += acc[16 * j + 4 * q + i] * acc[16 * j + 4 * q + i]; } }
      const float rf = 1.0f / sqrtf(wave_sum(s2) * (1.f / 2048.f) + NORM_EPS);
#pragma unroll
      for (int j = 0; j < 2; ++j)
#pragma unroll
          for (int q = 0; q < 4; ++q) { const f32x4 a = ldf128(rGF, (1024u * j + 16u * lane2 + 4u * q) * 4u); f32x4 oa;
#pragma unroll
              for (int i = 0; i < 4; ++i) oa[i] = acc[16 * j + 4 * q + i] * rf * a[i];
              float* op = OUT + (size_t)tok2 * 2048 + 1024 * j + 16 * lane2 + 4 * q;
              __builtin_nontemporal_store(oa, (GAS f32x4*)op); }
    }
}
}
#ifndef MK_N_LAUNCHES
#define MK_N_LAUNCHES 1
#endif
constexpr int N_PHASES = 9;
constexpr int N_LAUNCHES = MK_N_LAUNCHES;
struct Args { const float* in[19]; float* out; unsigned char* ws; int ph_lo, ph_hi; };
static_assert(sizeof(Args) == 19 * 8 + 8 + 8 + 8, "no padding");

__global__ void __launch_bounds__(NWAVES * 64, 2) hybrid_fwd(Args args) {
    extern __shared__ __attribute__((aligned(16))) unsigned char lds_raw[];
    Frame F;
    F.lds = (LAS unsigned char*)lds_raw;
    F.MISC = (volatile LAS unsigned*)(F.lds + MISC_OFF);
    F.tid = threadIdx.x; F.lane = F.tid & 63; F.wave = __builtin_amdgcn_readfirstlane(F.tid >> 6);
    F.G = gridDim.x; { const int bx = blockIdx.x; F.vcu = (F.G % 8 == 0) ? (bx % 8) * (F.G / 8) + bx / 8 : bx; }
    F.ws = args.ws; F.out = args.out;
#pragma unroll
    for (int i = 0; i < 19; ++i) F.in[i] = args.in[i];
    for (int u = F.tid; u < (LDS_BYTES - LDSCTL_OFF) / 4; u += NWAVES * 64) ((LAS unsigned*)(F.lds + LDSCTL_OFF))[u] = 0u;
    __syncthreads();
    XcdBarrier bar; bar.bar = (unsigned*)(F.ws + WS_CTL) + CW_BAR; bar.x = 0; bar.st = nullptr;
    if (N_LAUNCHES == 1) bar = xcd_barrier_post((unsigned*)(F.ws + WS_CTL) + CW_BAR, F.MISC + 8);
    const int lo = args.ph_lo, hi = args.ph_hi;
#define IN(k) (lo <= (k) && (k) < hi)
#define SEAM(k) do { if (IN(k) && IN((k) + 1)) xcd_barrier(bar); } while (0)
    const size_t T2048 = (size_t)256 * 2048 * 2, T1024 = (size_t)256 * 1024 * 2, T512 = (size_t)256 * 512 * 2;
    float* cosT = WSP(float, WS_COS); float* sinT = WSP(float, WS_SIN);
    float* ssq_q = WSP(float, WS_SSQ_Q); float* ssq_kv = WSP(float, WS_SSQ_KV); float* ssq2 = WSP(float, WS_SSQ_2);

    if (IN(0)) { p0_prologue<0>(F, F.vcu, F.G); } SEAM(0);
    if (IN(1)) {
        SchedP1 S{F.G, (int)blockIdx.x, (const char*)(F.ws + WS_HN1), (const char*)(F.ws + WS_WIN), (const char*)(F.ws + WS_WVT), T1024};
        EpiP1 E{WSP(bf16_t, WS_NAQ), WSP(bf16_t, WS_NAK), WSP(bf16_t, WS_VT), WSP(bf16_t, WS_CQ), WSP(bf16_t, WS_CKV), WSP(bf16_t, WS_KR), WSP(bf16_t, WS_GA), WSP(bf16_t, WS_GB), ssq_q, ssq_kv, cosT, sinT};
        pg8::gemm_phase<EpiP1, SchedP1, true, -6>(F.lds, 2048, S, E);
        { const int extra = P1_UNITS % F.G, bx = (int)blockIdx.x; if (extra != 0 && bx >= extra) p0_prologue<1>(F, bx - extra, F.G - extra); else if (extra == 0) p0_prologue<1>(F, bx, F.G); }
    } SEAM(1);
    if (IN(2)) {
        LAS float* relb = (LAS float*)F.lds + 64; LAS float* metab = relb + 16 * 15 * 31 + 128; LAS float* wsf = metab + 256 + F.wave * 64;
        for (int i = F.tid; i < 16 * 15 * 31; i += NWAVES * 64) relb[i] = F.in[4][i];
        if (F.tid < 256) metab[F.tid] = F.in[5][F.tid];
        __syncthreads();
        const int gw = F.vcu * NWAVES + F.wave, NGW = F.G * NWAVES;
        for (int task = gw; task < NBATCH * 16 * 32 * 2; task += NGW)
            att::na_task(task, WSP(bf16_t, WS_NAQ), WSP(bf16_t, WS_NAK), WSP(bf16_t, WS_VT), WSP(bf16_t, WS_ONA), relb, metab, wsf, F.lane);
        __syncthreads();
    } SEAM(2);
    if (IN(3)) {
        SchedP3 S{F.G, (int)blockIdx.x, (const char*)(F.ws + WS_CQ), (const char*)(F.ws + WS_CKV), (const char*)(F.ws + WS_WUQ), (const char*)(F.ws + WS_WUKV), T512};
        EpiP3 E{WSP(bf16_t, WS_QM), WSP(bf16_t, WS_KN), WSP(bf16_t, WS_VV), ssq_q, ssq_kv, cosT, sinT};
        pg8::gemm_phase<EpiP3, SchedP3>(F.lds, 512, S, E);
    } SEAM(3);
    if (IN(4)) {
        for (int id = F.vcu; id < NBATCH * 16 * 8; id += F.G) { const int bh = id >> 3, qb = id & 7;
            att::mla_unit(bh >> 4, bh & 15, qb, WSP(bf16_t, WS_QM), WSP(bf16_t, WS_KN), WSP(bf16_t, WS_KR), WSP(bf16_t, WS_VV), WSP(bf16_t, WS_OMLA), (LAS char*)F.lds); }
        __syncthreads();
    } SEAM(4);
    if (IN(5)) {
        { SchedGrid S{F.G, (int)blockIdx.x, 64, 8, (const char*)(F.ws + WS_ONA), (const char*)(F.ws + WS_WNA), T1024};
          EpiP5a E{WSP(bf16_t, WS_GA), WSP(bf16_t, WS_T1)};
          pg8::gemm_phase<EpiP5a, SchedGrid>(F.lds, 1024, S, E); }
        { SchedGrid S{F.G, (int)blockIdx.x, 64, 8, (const char*)(F.ws + WS_OMLA), (const char*)(F.ws + WS_WMLA), T2048};
          EpiP5b E{WSP(bf16_t, WS_GB), WSP(bf16_t, WS_T1), WSP(bf16_t, WS_MERGED)};
          pg8::gemm_phase<EpiP5b, SchedGrid>(F.lds, 2048, S, E); }
    } SEAM(5);
    if (IN(6)) {
        { SchedGrid S{F.G, (int)blockIdx.x, 64, 8, (const char*)(F.ws + WS_MERGED), (const char*)(F.ws + WS_WOUT), T2048};
          EpiP6 E{F.in[0], WSP(float, WS_H2), WSP(bf16_t, WS_H2B), ssq2};
          pg8::gemm_phase<EpiP6, SchedGrid>(F.lds, 2048, S, E); }
        {
          for (unsigned i = (unsigned)F.vcu * 512u + F.tid; i < 2u * 16384u * 64u; i += (unsigned)F.G * 512u) { const unsigned isv = i >> 20, row = (i >> 6) & 16383u, l = i & 63u; const float sc = isv ? 4.f : 64.f;
              const float* src = (isv ? F.in[17] : F.in[16]) + (size_t)row * 2048 + 16 * l; peer::v16f_t a, b;
#pragma unroll
              for (int q = 0; q < 4; ++q) { const f32x4 x0 = *(const GAS f32x4*)(src + 4 * q) * sc, x1 = *(const GAS f32x4*)(src + 1024 + 4 * q) * sc;
#pragma unroll
                  for (int e = 0; e < 4; ++e) { const int k0_ = 4 * q + e, k1_ = 16 + 4 * q + e;
                      if (k0_ & 1) b[k0_ >> 1] = x0[e]; else a[k0_ >> 1] = x0[e];
                      if (k1_ & 1) b[k1_ >> 1] = x1[e]; else a[k1_ >> 1] = x1[e]; } }
              const peer::v6u_t w = __builtin_amdgcn_cvt_scalef32_2xpk16_fp6_f32(a, b, 1.0f);
              unsigned char* rec = WSP(unsigned char, WS_U) + (size_t)row * 3072 + (isv ? 1536 : 0);
              *(GAS u32x4*)(rec + l * 16) = (u32x4){w[0], w[1], w[2], w[3]}; *(GAS u32x2*)(rec + 1024 + l * 8) = (u32x2){w[4], w[5]}; } }
    } SEAM(6);
    if (IN(7)) {
        SchedGrid S{F.G, (int)blockIdx.x, 64, 8, (const char*)(F.ws + WS_H2B), (const char*)(F.ws + WS_WSC), T2048};
        EpiP7 E{ssq2, WSP(float, WS_SC)};
        pg8::gemm_phase<EpiP7, SchedGrid>(F.lds, 2048, S, E);
    } SEAM(7);
    if (IN(8)) {
        for (int chunk = F.vcu; chunk < MREAL / peer::CH; chunk += F.G)
            peer::peer_chunk(chunk, WSP(float, WS_SC), WSP(float, WS_H2), WSP(unsigned char, WS_U), WSP(unsigned char, WS_V), F.in[13], F.in[18], F.out, (LAS char*)F.lds, F.tid);
    }
#undef IN
#undef SEAM
}

extern "C" void kernel_launch(void* const* d_in, const int* in_sizes, int n_in, void* d_out, int out_size, void* d_ws, size_t ws_size, hipStream_t stream) {
    static int grid = 0;
    if (grid == 0) {
        if (n_in != 19 || in_sizes[0] != MREAL * DM || out_size != MREAL * DM || ws_size < WS_END) {
            fprintf(stderr, "kernel_launch: shape/workspace mismatch: n_in %d in0 %d out %d ws %zu (need %zu); nothing launched\n", n_in, n_in > 0 ? in_sizes[0] : -1, out_size, ws_size, (size_t)WS_END); grid = -1; return; }
        int dev = 0, cus = 0, per_cu = 0;
        if (hipGetDevice(&dev) != hipSuccess || hipDeviceGetAttribute(&cus, hipDeviceAttributeMultiprocessorCount, dev) != hipSuccess) { fprintf(stderr, "kernel_launch: device query failed\n"); grid = -1; return; }
        if (hipFuncSetAttribute((const void*)hybrid_fwd, hipFuncAttributeMaxDynamicSharedMemorySize, LDS_BYTES) != hipSuccess) { fprintf(stderr, "kernel_launch: hipFuncSetAttribute failed\n"); grid = -1; return; }
        if (hipOccupancyMaxActiveBlocksPerMultiprocessor(&per_cu, (const void*)hybrid_fwd, NWAVES * 64, LDS_BYTES) != hipSuccess || per_cu < 1)
            fprintf(stderr, "kernel_launch: note: occupancy query reports %d workgroups per CU\n", per_cu);
        (void)hipGetLastError();
        grid = cus;
    }
    if (grid < 0) return;
    if (hipMemsetAsync((char*)d_ws + WS_CTL, 0, CTL_ZERO_BYTES, stream) != hipSuccess) { fprintf(stderr, "kernel_launch: hipMemsetAsync failed\n"); return; }
    Args a{};
    for (int i = 0; i < 19; ++i) a.in[i] = (const float*)d_in[i];
    a.out = (float*)d_out; a.ws = (unsigned char*)d_ws;
    for (int li = 0; li < N_LAUNCHES; ++li) {
        a.ph_lo = (N_LAUNCHES == 1) ? 0 : li; a.ph_hi = (N_LAUNCHES == 1) ? N_PHASES : li + 1;
        hipLaunchKernelGGL(hybrid_fwd, dim3(grid), dim3(NWAVES * 64), LDS_BYTES, stream, a);
        const hipError_t le = hipPeekAtLastError();
        if (le != hipSuccess) { fprintf(stderr, "kernel_launch: launch %d failed: %s\n", li, hipGetErrorName(le)); break; }
    }
}
```

```cpp
#include <hip/hip_runtime.h>
#include <cstdio>
#include <cstdint>

#define LAS __attribute__((address_space(3)))
#define GAS __attribute__((address_space(1)))
typedef unsigned short bf16_t;
typedef short bf16x8 __attribute__((ext_vector_type(8)));
typedef short s16x4 __attribute__((ext_vector_type(4)));
typedef float f32x4 __attribute__((ext_vector_type(4)));
typedef float f32x2 __attribute__((ext_vector_type(2)));
typedef float f32x16 __attribute__((ext_vector_type(16)));
typedef unsigned u32x4 __attribute__((ext_vector_type(4)));
typedef unsigned u32x2 __attribute__((ext_vector_type(2)));

constexpr int DM = 2048, NBATCH = 8, SEQ = 2048, NMETA = 16;
constexpr int MREAL = NBATCH * SEQ;
constexpr int MPAD = MREAL + 256;
constexpr int NPOS = SEQ + NMETA;
constexpr float NORM_EPS = 1e-6f;
constexpr int C_NAQ = 0, C_NAK = 1024, C_CQ = 2048, C_CKV = 2560, C_GA = 3072, C_GB = 5120, C_KR = 7168, NMAIN = 7424;
constexpr int VT_PITCH = MPAD;

constexpr size_t MiB = 1u << 20;
constexpr size_t WS_CTL = 0, CTL_ZERO_BYTES = 1 * MiB;
constexpr size_t WS_SSQ_Q = 481 * MiB, WS_SSQ_KV = 482 * MiB, WS_SSQ_2 = 486 * MiB;
constexpr size_t WS_COS = 1 * MiB, WS_SIN = 1 * MiB + 512 * 1024;
constexpr size_t WS_WUQ = 2 * MiB, WS_WUKV = 5 * MiB, WS_WNA = 9 * MiB, WS_WMLA = 13 * MiB, WS_WOUT = 21 * MiB, WS_WSC = 29 * MiB;
constexpr size_t WS_GA = 37 * MiB, WS_GB = 101 * MiB;
constexpr size_t WS_KR = 165 * MiB;
constexpr size_t WS_WIN = 167 * MiB + 256 * 1024, WS_WVT = WS_WIN + 29 * MiB;
constexpr size_t WS_ONA = 190 * MiB;
constexpr size_t WS_NAQ = 222 * MiB, WS_NAK = 254 * MiB, WS_VT = WS_NAK + 32 * MiB + 512 * 1024;
constexpr size_t WS_HN1 = 319 * MiB;
constexpr size_t WS_CQ = 448 * MiB, WS_CKV = 464 * MiB;
constexpr size_t WS_QM = 222 * MiB, WS_KN = 318 * MiB, WS_VV = 383 * MiB;
constexpr size_t WS_OMLA = 448 * MiB;
constexpr size_t WS_MERGED = 222 * MiB, WS_T1 = 286 * MiB;
constexpr size_t WS_H2 = 37 * MiB, WS_H2B = 293 * MiB;
constexpr size_t WS_U = 357 * MiB, WS_V = 421 * MiB;
constexpr size_t WS_SC = 165 * MiB;
constexpr size_t WS_END = 512 * MiB;
static_assert(WS_CKV + (size_t)MPAD * 512 * 2 <= WS_SSQ_Q && WS_SSQ_Q + (size_t)8 * MPAD * 4 <= WS_SSQ_KV && WS_SSQ_KV + (size_t)8 * MPAD * 4 <= 483 * MiB && WS_V + 64 * MiB <= WS_SSQ_2 && WS_SSQ_2 + (size_t)32 * MREAL * 4 <= WS_END, "ssq slabs");
static_assert(WS_VT + (size_t)1024 * MPAD * 2 <= WS_HN1 && WS_HN1 + (size_t)MPAD * 2048 * 2 <= WS_CQ && WS_CKV + (size_t)MPAD * 512 * 2 <= WS_END, "map P1");
static_assert(WS_WVT + 4 * MiB <= WS_NAQ && WS_KR + (size_t)MPAD * 64 * 2 <= WS_WIN && WS_ONA + 32 * MiB <= WS_NAQ, "map P1b");
static_assert(WS_QM + 96 * MiB <= WS_KN && WS_KN + 65 * MiB <= WS_VV && WS_VV + 65 * MiB <= WS_OMLA && WS_OMLA + 64 * MiB <= WS_END, "map P3");
static_assert(WS_T1 + 128 * MiB <= WS_OMLA && WS_H2 + 128 * MiB <= WS_KR && WS_SC + 128 * MiB <= WS_H2B && WS_H2B + 64 * MiB <= WS_U && WS_V + 64 * MiB <= WS_END, "map P5+");

constexpr int CW_BAR = 4096;

constexpr int RING_BYTES = 131072;
constexpr int LDSCTL_OFF = RING_BYTES, MISC_OFF = LDSCTL_OFF + 320;
constexpr int LDS_BYTES = 147456;
constexpr int NWAVES = 8;

#define LDS_WAIT() asm volatile("s_waitcnt lgkmcnt(0)" ::: "memory")
#define VM_WAIT() asm volatile("s_waitcnt vmcnt(0)" ::: "memory")
#define SBAR() __builtin_amdgcn_sched_barrier(0)
typedef __bf16 bf16x2_t __attribute__((ext_vector_type(2)));
__device__ __forceinline__ unsigned cvt_pk_bf16(float lo, float hi) { const f32x2 v = {lo, hi}; const bf16x2_t b = __builtin_convertvector(v, bf16x2_t); return __builtin_bit_cast(unsigned, b); }
__device__ __forceinline__ float bf_lo(unsigned w) { return __uint_as_float(w << 16); }
__device__ __forceinline__ float bf_hi(unsigned w) { return __uint_as_float(w & 0xffff0000u); }
__device__ __forceinline__ u32x4 pack8(const f32x4 a, const f32x4 b) { u32x4 w; w.x = cvt_pk_bf16(a[0], a[1]); w.y = cvt_pk_bf16(a[2], a[3]); w.z = cvt_pk_bf16(b[0], b[1]); w.w = cvt_pk_bf16(b[2], b[3]); return w; }
__device__ __forceinline__ u32x2 pack8_fp8(f32x4 a, f32x4 b) {
#pragma unroll
    for (int i = 0; i < 4; ++i) { a[i] = __builtin_fminf(__builtin_fmaxf(a[i], -448.f), 448.f); b[i] = __builtin_fminf(__builtin_fmaxf(b[i], -448.f), 448.f); }
    int w0 = 0, w1 = 0; w0 = __builtin_amdgcn_cvt_pk_fp8_f32(a[0], a[1], w0, false); w0 = __builtin_amdgcn_cvt_pk_fp8_f32(a[2], a[3], w0, true);
    w1 = __builtin_amdgcn_cvt_pk_fp8_f32(b[0], b[1], w1, false); w1 = __builtin_amdgcn_cvt_pk_fp8_f32(b[2], b[3], w1, true); return (u32x2){(unsigned)w0, (unsigned)w1}; }
__device__ __forceinline__ unsigned char f32_to_fp8(float x) { x = __builtin_fminf(__builtin_fmaxf(x, -448.f), 448.f); return (unsigned char)(__builtin_amdgcn_cvt_pk_fp8_f32(x, 0.f, 0, false) & 0xff); }
__device__ __forceinline__ u32x2 pack4(const f32x4 a) { u32x2 w; w.x = cvt_pk_bf16(a[0], a[1]); w.y = cvt_pk_bf16(a[2], a[3]); return w; }
__device__ __forceinline__ float wave_sum(float v) {
#pragma unroll
    for (int o = 1; o < 64; o <<= 1) v += __shfl_xor(v, o);
    return v;
}
__device__ __forceinline__ float sigmoidf_(float x) { return __builtin_amdgcn_rcpf(1.0f + __builtin_amdgcn_exp2f(-1.4426950408889634f * x)); }
__device__ __forceinline__ int crow(int r, int hi) { return (r & 3) + 8 * (r >> 2) + 4 * hi; }
#define PG8_AUX 0
namespace pg8 {
constexpr int BM = 256, BK = 64, HALF = 128, HTB = HALF * BK * 2  , STAGE_BYTES = 8 * HTB, NXCD = 8, WGM = 8;
__host__ __device__ __forceinline__ int lds_byte(int r, int c) { const int st = (r >> 4) * 2 + (c >> 5), rr = r & 15, cc = c & 31, ob = rr * 64 + cc * 2; return st * 1024 + (ob ^ (((ob >> 9) & 1) << 5)); }
__host__ __device__ __forceinline__ void stage_rc(int b, int& R, int& C) { const int st = b / 1024, sb = b % 1024, swz = sb ^ (((sb >> 9) & 1) << 5); R = (st >> 1) * 16 + swz / 64; C = (st & 1) * 32 + (swz % 64) / 2; }
__host__ __device__ __forceinline__ int perm32(int rho) { const int n = rho >> 4, i = rho & 15; return 8 * (i >> 2) + 4 * n + (i & 3); }

struct Unit { int pm, pn, kind; };

__device__ __forceinline__ void grid_order(int L, int nM, int nN, int& pm, int& pn) {
    const int nwg = nM * nN; int wgid = L;
    { const int q = nwg / NXCD, r = nwg % NXCD, xcd = wgid % NXCD, off = wgid / NXCD; wgid = (xcd < r ? xcd * (q + 1) : r * (q + 1) + (xcd - r) * q) + off; }
    const int nig = WGM * nN, gid = wgid / nig, fm = gid * WGM, gsz = (nM - fm) < WGM ? (nM - fm) : WGM;
    pm = fm + ((wgid % nig) % gsz); pn = (wgid % nig) / gsz;
}

typedef int v8i_t __attribute__((ext_vector_type(8)));
template <class Epi, class Sched, bool F8 = false, int F8_SCALE_EXP = 0>
__device__ __forceinline__ void gemm_phase(LAS unsigned char* lds, const int K, const Sched& S, const Epi& E) {
    const int tid = threadIdx.x, wid = __builtin_amdgcn_readfirstlane(tid >> 6), lane = tid & 63, wr = wid >> 2, wc = wid & 3, fr = lane & 15, fq = lane >> 4;
    int f8sa = 0x01010101 * (127 + F8_SCALE_EXP), f8sb = 0x7f7f7f7f; asm volatile("" : "+v"(f8sa), "+v"(f8sb));
    const int Kb = F8 ? K : 2 * K;
    const int nt = Kb / 128;
    unsigned voffA[2], voffB[2];
#pragma unroll
    for (int i = 0; i < 2; ++i) { int R, C; stage_rc(tid * 16 + i * 8192, R, C); const int Rb = Epi::PERM ? ((R & ~31) + perm32(R & 31)) : R;
        voffA[i] = (unsigned)(R * Kb + C * 2); voffB[i] = (unsigned)(Rb * Kb + C * 2); }
    const size_t kstep = (size_t)128;
    const size_t hstep = (size_t)HALF * Kb;
    const unsigned ldsw = (unsigned)wid * 1024u;
    const int aoff = lds_byte(wr * 64 + fr, F8 ? fq * 16 : fq * 8), boff = lds_byte(wc * 32 + fr, F8 ? fq * 16 : fq * 8);
#define PG8_SA(b, h) (((b) * 2 + (h)) * HTB)
#define PG8_SB(b, h) ((4 + (b) * 2 + (h)) * HTB)
#define PG8_STAGE(bufoff, gbase, voff) do { _Pragma("unroll") for (int _i = 0; _i < 2; ++_i) \
        __builtin_amdgcn_global_load_lds((const unsigned*)((const char*)(gbase) + (voff)[_i]), (LAS unsigned*)(lds + (bufoff) + ldsw + _i * 8192), 16, 0, PG8_AUX); } while (0)
#define PG8_LDA(dst, b, h) do { _Pragma("unroll") for (int m = 0; m < 4; ++m) _Pragma("unroll") for (int k = 0; k < 2; ++k) dst[m][k] = *(const LAS bf16x8*)(lds + PG8_SA(b, h) + aoff + m * 2048 + (F8 ? k * 16 : k * 1024)); } while (0)
#define PG8_LDB(dst, b, h) do { _Pragma("unroll") for (int n = 0; n < 2; ++n) _Pragma("unroll") for (int k = 0; k < 2; ++k) dst[n][k] = *(const LAS bf16x8*)(lds + PG8_SB(b, h) + boff + n * 2048 + (F8 ? k * 16 : k * 1024)); } while (0)
#define PG8_F8OP(X) __builtin_bit_cast(v8i_t, __builtin_shufflevector(X[0], X[1], 0, 1, 2, 3, 4, 5, 6, 7, 8, 9, 10, 11, 12, 13, 14, 15))
#define PG8_MMA(ai, bj, At, Bt) do { __builtin_amdgcn_s_setprio(1); \
        if constexpr (F8) { _Pragma("unroll") for (int m = 0; m < 4; ++m) _Pragma("unroll") for (int n = 0; n < 2; ++n) \
            asm volatile("v_mfma_scale_f32_16x16x128_f8f6f4 %0, %1, %2, %0, %3, %4 op_sel_hi:[0,0,0]" : "+v"(acc[ai][bj][m][n]) : "v"(PG8_F8OP(Bt[n])), "v"(PG8_F8OP(At[m])), "v"(f8sa), "v"(f8sb)); } \
        else { _Pragma("unroll") for (int m = 0; m < 4; ++m) _Pragma("unroll") for (int n = 0; n < 2; ++n) _Pragma("unroll") for (int k = 0; k < 2; ++k) \
            acc[ai][bj][m][n] = __builtin_amdgcn_mfma_f32_16x16x32_bf16(Bt[n][k], At[m][k], acc[ai][bj][m][n], 0, 0, 0); } \
        __builtin_amdgcn_s_setprio(0); } while (0)
#define PG8_WAIT_V(n) asm volatile("s_waitcnt vmcnt(" #n ")" ::: "memory")
#define PG8_WAIT_L(n) asm volatile("s_waitcnt lgkmcnt(" #n ")" ::: "memory")
#define PG8_BAR __builtin_amdgcn_s_barrier()
#define PG8_SCHED __builtin_amdgcn_sched_barrier(0)
    Unit cur, nxt; int ui = 0;
    if (!S.next(0, cur)) return;
    f32x4 acc[2][2][4][2];
#pragma unroll
    for (int a = 0; a < 2; ++a)
#pragma unroll
        for (int b = 0; b < 2; ++b)
#pragma unroll
            for (int m = 0; m < 4; ++m)
#pragma unroll
                for (int n = 0; n < 2; ++n) acc[a][b][m][n] = (f32x4){0.f, 0.f, 0.f, 0.f};
    bf16x8 At[4][2], B0[2][2], B1[2][2];
    const char* cA = S.pa(cur); const char* cB = S.pb(cur);
    PG8_STAGE(PG8_SB(0, 0), cB, voffB); PG8_STAGE(PG8_SB(0, 1), cB + hstep, voffB); PG8_STAGE(PG8_SA(0, 0), cA, voffA); PG8_STAGE(PG8_SA(0, 1), cA + hstep, voffA);
    if (wr == 1) PG8_BAR;
    PG8_WAIT_V(2); PG8_BAR;
    PG8_STAGE(PG8_SB(1, 0), cB + kstep, voffB); PG8_STAGE(PG8_SA(1, 0), cA + kstep, voffA); PG8_STAGE(PG8_SB(1, 1), cB + hstep + kstep, voffB);
    PG8_WAIT_V(6); PG8_BAR;
    for (;;) {
        const bool has_next = S.next(ui + 1, nxt);
        const char* nA = has_next ? S.pa(nxt) : cA; const char* nB = has_next ? S.pb(nxt) : cB;
        for (int t = 0; t < nt; t += 2) {
            const bool last = (t == nt - 2);
            const char* a1 = cA + (size_t)(t + 1) * kstep;
            const char* a2 = last ? nA : cA + (size_t)(t + 2) * kstep; const char* b2 = last ? nB : cB + (size_t)(t + 2) * kstep;
            const char* a3 = a2 + kstep; const char* b3 = b2 + kstep;
            PG8_LDB(B0, 0, 0); PG8_LDB(B1, 0, 1); PG8_SCHED; PG8_LDA(At, 0, 0); PG8_STAGE(PG8_SA(1, 1), a1 + hstep, voffA);
            PG8_WAIT_V(8); PG8_WAIT_L(0); PG8_BAR; PG8_MMA(0, 0, At, B0); PG8_MMA(0, 1, At, B1); PG8_BAR; PG8_SCHED;
            PG8_LDA(At, 0, 1); PG8_STAGE(PG8_SB(0, 0), b2, voffB); PG8_STAGE(PG8_SB(0, 1), b2 + hstep, voffB); PG8_STAGE(PG8_SA(0, 0), a2, voffA);
            PG8_WAIT_V(8); PG8_WAIT_L(0); PG8_BAR; PG8_MMA(1, 0, At, B0); PG8_MMA(1, 1, At, B1); PG8_BAR; PG8_SCHED;
            PG8_LDB(B0, 1, 0); PG8_LDB(B1, 1, 1); PG8_SCHED; PG8_LDA(At, 1, 0); PG8_STAGE(PG8_SA(0, 1), a2 + hstep, voffA);
            PG8_WAIT_V(8); PG8_WAIT_L(0); PG8_BAR; PG8_MMA(0, 0, At, B0); PG8_MMA(0, 1, At, B1); PG8_BAR; PG8_SCHED;
            PG8_LDA(At, 1, 1); PG8_STAGE(PG8_SB(1, 0), b3, voffB); PG8_STAGE(PG8_SB(1, 1), b3 + hstep, voffB); PG8_STAGE(PG8_SA(1, 0), a3, voffA);
            PG8_WAIT_V(8); PG8_WAIT_L(0); PG8_BAR; PG8_MMA(1, 0, At, B0); PG8_MMA(1, 1, At, B1); PG8_BAR; PG8_SCHED;
        }
        if (wr == 0) PG8_BAR;
        if constexpr (F8) asm volatile("s_nop 15\n\ts_nop 7" ::: "memory");
        if constexpr (Epi::HAS_PRE) {
            E.pre(cur, (LAS float*)(lds + STAGE_BYTES + 1024), tid); PG8_WAIT_L(0); PG8_BAR; }
        E(acc, cur, wr, wc, fr, fq, (const LAS float*)(lds + STAGE_BYTES + 1024));
        if (!has_next) break;
#pragma unroll
        for (int a = 0; a < 2; ++a)
#pragma unroll
            for (int b = 0; b < 2; ++b)
#pragma unroll
                for (int m = 0; m < 4; ++m)
#pragma unroll
                    for (int n = 0; n < 2; ++n) acc[a][b][m][n] = (f32x4){0.f, 0.f, 0.f, 0.f};
        cur = nxt; cA = nA; cB = nB; ++ui;
        if (wr == 1) PG8_BAR;
    }
    PG8_WAIT_V(0);
    PG8_BAR;
#undef PG8_SA
#undef PG8_SB
#undef PG8_STAGE
#undef PG8_LDA
#undef PG8_LDB
#undef PG8_MMA
#undef PG8_F8OP
#undef PG8_WAIT_V
#undef PG8_WAIT_L
#undef PG8_BAR
#undef PG8_SCHED
}
}
typedef GAS unsigned gu32;
#define RLX_AGENT __ATOMIC_RELAXED, __HIP_MEMORY_SCOPE_AGENT
#define XB_TMO      128
#define XB_XCNT(j)  (256  + 64 * (j))
#define XB_XSUB(j)  (1280 + 64 * (j))
#define XB_XGEN(j)  (2304 + 64 * (j))
#define XB_TOP      3328
#define XB_TOPGEN   3392
#define XCD_BAR_WORDS 3456
#define XB_SPIN_CAP (1u << 18)
__device__ __forceinline__ unsigned xb_ld(unsigned* p)              { return __hip_atomic_load(p, __ATOMIC_RELAXED, __HIP_MEMORY_SCOPE_AGENT); }
__device__ __forceinline__ unsigned xb_add(unsigned* p, unsigned v) { return __hip_atomic_fetch_add(p, v, __ATOMIC_RELAXED, __HIP_MEMORY_SCOPE_AGENT); }
__device__ __forceinline__ unsigned xb_xcc_id() { return (unsigned)__builtin_amdgcn_s_getreg((3 << 11) | 20) & 0xFu; }
#define XB_SPIN(cond, bar) do { unsigned _sp = 0; while (cond) { __builtin_amdgcn_s_sleep(1); \
    if ((++_sp & 255u) == 0u) { if (xb_ld(&(bar)[XB_TMO])) break; if (_sp > XB_SPIN_CAP) { atomicAdd(&(bar)[XB_TMO], 1u); break; } } } } while (0)
struct XcdBarrier { unsigned* bar; unsigned x; volatile LAS unsigned* st; };
__device__ __forceinline__ XcdBarrier xcd_barrier_post(unsigned* bar, volatile LAS unsigned* st) {
    XcdBarrier b; b.bar = bar; b.x = xb_xcc_id(); b.st = st;
    if (threadIdx.x == 0) (void)xb_add(&bar[XB_XCNT(b.x)], 1u);
    return b;
}
__device__ __forceinline__ void xcd_barrier_complete(unsigned* bar, unsigned x, unsigned& nloc, unsigned& nx) {
    const unsigned G = gridDim.x * gridDim.y * gridDim.z;
    unsigned sum, cnt, mine, sp = 0u;
    for (;;) {
        sum = 0u; cnt = 0u; mine = 0u;
#pragma unroll
        for (unsigned j = 0; j < 16; ++j) { const unsigned c = xb_ld(&bar[XB_XCNT(j)]); sum += c; cnt += (c > 0u) ? 1u : 0u; mine = (j == x) ? c : mine; }
        if (sum == G) break;
        __builtin_amdgcn_s_sleep(1);
        if ((++sp & 255u) == 0u) { if (xb_ld(&bar[XB_TMO])) break; if (sp > XB_SPIN_CAP) { atomicAdd(&bar[XB_TMO], 1u); break; } }
    }
    nloc = mine > 0u ? mine : 1u; nx = cnt > 0u ? cnt : 1u;
}
__device__ __forceinline__ void xcd_barrier(const XcdBarrier& b) {
    asm volatile("s_waitcnt vmcnt(0)" ::: "memory");
    __syncthreads();
    if (threadIdx.x == 0) {
        unsigned* bar = b.bar;
        __builtin_amdgcn_s_waitcnt(0);
        unsigned nloc = b.st[0], nx = b.st[1];
        if (nloc == 0u) { xcd_barrier_complete(bar, b.x, nloc, nx); b.st[0] = nloc; b.st[1] = nx; }
        const unsigned old = xb_add(&bar[XB_XSUB(b.x)], 1u);
        const unsigned gen = old / nloc;
        if (old + 1u == (gen + 1u) * nloc) {
            __builtin_amdgcn_fence(__ATOMIC_RELEASE, "agent");
            asm volatile("s_waitcnt vmcnt(0)" ::: "memory");
            const unsigned og = xb_add(&bar[XB_TOP], 1u);
            const unsigned tg = og / nx;
            if (og + 1u == (tg + 1u) * nx) xb_add(&bar[XB_TOPGEN], 1u);
            else XB_SPIN(xb_ld(&bar[XB_TOPGEN]) == tg, bar);
            __builtin_amdgcn_fence(__ATOMIC_ACQUIRE, "agent");
            xb_add(&bar[XB_XGEN(b.x)], 1u);
            asm volatile("s_waitcnt vmcnt(0)" ::: "memory");
        } else {
            XB_SPIN(xb_ld(&bar[XB_XGEN(b.x)]) == gen, bar);
            __builtin_amdgcn_fence(__ATOMIC_ACQUIRE, "agent");
            asm volatile("s_waitcnt vmcnt(0)" ::: "memory");
        }
    }
    __syncthreads();
}
struct Frame {
    LAS unsigned char* lds;
    volatile LAS unsigned* MISC;
    unsigned char* ws;
    int tid, lane, wave;
    int vcu, G;
    const float* in[19];
    float* out;
};
#define WSP(T, off) ((T*)(F.ws + (off)))

__device__ __forceinline__ void p0_transpose_item(const float* W, int K, int N, int k0, int n0, bf16_t* WT, int drow, bool rope, const float* gain, LAS float* scr, int lane) {
#pragma unroll 8
    for (int i = 0; i < 32; ++i) { const int kk = 2 * i + (lane >> 5); float w = W[(size_t)(k0 + kk) * N + n0 + (lane & 31)]; if (gain) w *= gain[k0 + kk]; scr[kk * 33 + (lane & 31)] = w; }
    LDS_WAIT(); asm volatile("" ::: "memory");
    const int c = lane & 7;
#pragma unroll
    for (int j = 0; j < 4; ++j) { const int n = (lane >> 3) + 8 * j; const LAS float* s = scr + (8 * c) * 33 + n;
        u32x4 o; o.x = cvt_pk_bf16(s[0 * 33], s[1 * 33]); o.y = cvt_pk_bf16(s[2 * 33], s[3 * 33]); o.z = cvt_pk_bf16(s[4 * 33], s[5 * 33]); o.w = cvt_pk_bf16(s[6 * 33], s[7 * 33]);
        const int dr = drow + (rope ? (8 * (n >> 2) + (n & 3)) : n);
        *(GAS u32x4*)(WT + (size_t)dr * K + k0 + 8 * c) = o; }
    LDS_WAIT(); asm volatile("" ::: "memory");
}
__device__ __forceinline__ void p0_transpose_item8(const float* W, int K, int N, int k0, int n0, unsigned char* WT, int drow, bool rope, float scale, LAS float* scr, int lane) {
#pragma unroll 8
    for (int i = 0; i < 32; ++i) { const int kk = 2 * i + (lane >> 5); scr[kk * 33 + (lane & 31)] = W[(size_t)(k0 + kk) * N + n0 + (lane & 31)] * scale; }
    LDS_WAIT(); asm volatile("" ::: "memory");
#pragma unroll
    for (int j = 0; j < 2; ++j) { const int q = lane + 64 * j, n = q >> 2, c = q & 3; const LAS float* s = scr + (16 * c) * 33 + n; u32x4 o;
#pragma unroll
        for (int d = 0; d < 4; ++d) { int w = 0; w = __builtin_amdgcn_cvt_pk_fp8_f32(s[(4 * d) * 33], s[(4 * d + 1) * 33], w, false); w = __builtin_amdgcn_cvt_pk_fp8_f32(s[(4 * d + 2) * 33], s[(4 * d + 3) * 33], w, true); o[d] = (unsigned)w; }
        const int dr = drow + (rope ? (8 * (n >> 2) + (n & 3)) : n);
        *(GAS u32x4*)(WT + (size_t)dr * K + k0 + 16 * c) = o; }
    LDS_WAIT(); asm volatile("" ::: "memory");
}
__device__ __forceinline__ void rms_row_to_fp8(const float* xrow, const float* g, unsigned char* orow, int lane) {
    const GAS f32x4* xr = (const GAS f32x4*)xrow + lane; const GAS f32x4* gr = (const GAS f32x4*)g + lane;
    f32x4 v[8]; float s = 0.f;
#pragma unroll
    for (int j = 0; j < 8; ++j) { v[j] = xr[64 * j]; s += (v[j].x * v[j].x + v[j].y * v[j].y) + (v[j].z * v[j].z + v[j].w * v[j].w); }
    const float rstd = 1.0f / sqrtf(wave_sum(s) * (1.f / DM) + NORM_EPS);
    GAS unsigned* o4 = (GAS unsigned*)orow + lane;
#pragma unroll
    for (int j = 0; j < 8; ++j) { const f32x4 y = (v[j] * rstd) * gr[64 * j]; int w = 0; w = __builtin_amdgcn_cvt_pk_fp8_f32(y[0], y[1], w, false); w = __builtin_amdgcn_cvt_pk_fp8_f32(y[2], y[3], w, true); o4[64 * j] = (unsigned)w; }
}
__device__ __forceinline__ void rms_row_to_bf16(const float* xrow, const float* g, bf16_t* orow, int lane) {
    const GAS f32x4* xr = (const GAS f32x4*)xrow + lane; const GAS f32x4* gr = (const GAS f32x4*)g + lane;
    f32x4 v[8]; float s = 0.f;
#pragma unroll
    for (int j = 0; j < 8; ++j) { v[j] = xr[64 * j]; s += (v[j].x * v[j].x + v[j].y * v[j].y) + (v[j].z * v[j].z + v[j].w * v[j].w); }
    const float rstd = 1.0f / sqrtf(wave_sum(s) * (1.f / DM) + NORM_EPS);
    GAS u32x2* o8 = (GAS u32x2*)orow + lane;
#pragma unroll
    for (int j = 0; j < 8; ++j) { const f32x4 gg = gr[64 * j]; o8[64 * j] = pack4((v[j] * rstd) * gg); }
}
template <int PART>
__device__ __forceinline__ void p0_prologue(Frame& F, int rank, int nrank) {
    LAS float* scr = (LAS float*)(F.lds + F.wave * 16384);
    const int gw = rank * NWAVES + F.wave, NGW = nrank * NWAVES, lane = F.lane; const int gt = rank * 512 + F.tid, NGT = nrank * 512;
    unsigned char* WIN = WSP(unsigned char, WS_WIN); unsigned char* WVT = WSP(unsigned char, WS_WVT);
    constexpr int I_IN = 32 * 258, I_UQ = 8 * 96, I_UKV = 8 * 128, I_NA = 16 * 64, I_MLA = 32 * 64, I_OUT = 32 * 64;
    constexpr int NEARLY = I_IN + I_UQ + I_UKV, NITEMS = NEARLY + I_NA + I_MLA + I_OUT;
    for (int it = (PART == 0 ? 0 : NEARLY) + gw; it < (PART == 0 ? NEARLY : NITEMS); it += NGW) {
        int r = it;
        if (r < I_IN) { const int kb = r / 258, sb = r % 258, n0 = 32 * sb, k0 = 64 * kb; const float* W = F.in[3];
            unsigned char* dst = WIN; int drow; bool rope = false;
            if (n0 < 1024) drow = C_NAQ + n0;
            else if (n0 < 2048) drow = C_NAK + (n0 - 1024);
            else if (n0 < 3072) { dst = WVT; drow = n0 - 2048; }
            else if (n0 < 3584) drow = C_CQ + (n0 - 3072);
            else if (n0 < 4096) drow = C_CKV + (n0 - 3584);
            else if (n0 < 4160) { drow = C_KR + ((n0 - 4096) ? 4 : 0); rope = true; }
            else if (n0 < 6208) drow = C_GA + (n0 - 4160);
            else drow = C_GB + (n0 - 6208);
            p0_transpose_item8(W, 2048, 8256, k0, n0, dst, drow, rope, 64.f, scr, lane); continue; } r -= I_IN;
        if (r < I_UQ) { const int kb = r / 96, sb = r % 96, n0 = 32 * sb, k0 = 64 * kb; const int hd = n0 / 192, w = n0 % 192;
            int drow = n0; bool rope = false; if (w >= 128) { rope = true; drow = hd * 192 + 128 + ((w - 128) ? 4 : 0); }
            p0_transpose_item(F.in[7], 512, 3072, k0, n0, WSP(bf16_t, WS_WUQ), drow, rope, F.in[6], scr, lane); continue; } r -= I_UQ;
        if (r < I_UKV) { const int kb = r / 128, sb = r % 128; p0_transpose_item(F.in[9], 512, 4096, 64 * kb, 32 * sb, WSP(bf16_t, WS_WUKV), 32 * sb, false, F.in[8], scr, lane); continue; } r -= I_UKV;
        if (r < I_NA) { const int kb = r / 64, sb = r % 64; p0_transpose_item8(F.in[10], 1024, 2048, 64 * kb, 32 * sb, WSP(unsigned char, WS_WNA), 32 * sb, false, 32.f, scr, lane); continue; } r -= I_NA;
        if (r < I_MLA) { const int kb = r / 64, sb = r % 64; p0_transpose_item8(F.in[11], 2048, 2048, 64 * kb, 32 * sb, WSP(unsigned char, WS_WMLA), 32 * sb, false, 64.f, scr, lane); continue; } r -= I_MLA;
        { const int kb = r / 64, sb = r % 64; p0_transpose_item8(F.in[12], 2048, 2048, 64 * kb, 32 * sb, WSP(unsigned char, WS_WOUT), 32 * sb, false, 64.f, scr, lane); }
    }
    if (PART == 0) { GAS u32x4* z = (GAS u32x4*)(WIN + (size_t)(C_KR + 64) * 2048); const int n16 = (NMAIN - C_KR - 64) * 2048 / 16;
      for (int i = gt; i < n16; i += NGT) z[i] = (u32x4){0u, 0u, 0u, 0u}; }
    if (PART == 0) { unsigned char* HN1 = WSP(unsigned char, WS_HN1);
      for (int m = gw; m < MREAL + NMETA; m += NGW) {
          const float* src = (m < MREAL) ? F.in[0] + (size_t)m * DM : F.in[1] + (size_t)(m - MREAL) * DM;
          rms_row_to_fp8(src, F.in[2], HN1 + (size_t)m * DM, lane); }
      GAS u32x4* z = (GAS u32x4*)(HN1 + (size_t)(MREAL + NMETA) * DM); const int n16 = (MPAD - MREAL - NMETA) * DM / 16;
      for (int i = gt; i < n16; i += NGT) z[i] = (u32x4){0u, 0u, 0u, 0u}; }
    if (PART == 0) { float* ct = WSP(float, WS_COS); float* st = WSP(float, WS_SIN);
      for (int i = gt; i < NPOS * 32; i += NGT) { const int p = i >> 5, j = i & 31;
          const float inv = __builtin_powf(10000.0f, -(float)(2 * j) / 64.0f); const float ang = (float)p * inv;
          double r = (double)ang * 0.15915494309189535; r -= __builtin_rint(r); const float rf = (float)r;
          ct[i] = __builtin_amdgcn_cosf(rf); st[i] = __builtin_amdgcn_sinf(rf); } }
    if (PART == 1) { const float* SK = F.in[15]; const float* WQ = F.in[14]; const float* g2 = F.in[13]; bf16_t* WSCp = WSP(bf16_t, WS_WSC);
      const int l15 = lane & 15, l4 = lane >> 4;
      for (int task = gw; task < 2048; task += NGW) { const int g = task >> 7, nt = (task >> 4) & 7, kc = task & 15, n0 = nt * 16;
          bf16x8 bfr[4];
#pragma unroll
          for (int kk = 0; kk < 4; ++kk) { const float* p = SK + ((size_t)g * 128 + n0 + l15) * 128 + 32 * kk + 8 * l4; const f32x4 a = *(const GAS f32x4*)p, b = *(const GAS f32x4*)(p + 4);
              const u32x4 w = pack8(a, b); bfr[kk] = __builtin_bit_cast(bf16x8, w); }
          for (int kt = 0; kt < 8; ++kt) { const int k0 = (kc * 8 + kt) * 16; f32x4 acc = (f32x4){0.f, 0.f, 0.f, 0.f};
#pragma unroll
              for (int kk = 0; kk < 4; ++kk) { const float* p = WQ + (size_t)(k0 + l15) * 2048 + g * 128 + 32 * kk + 8 * l4; const f32x4 a = *(const GAS f32x4*)p, b = *(const GAS f32x4*)(p + 4);
                  const u32x4 w = pack8(a, b); acc = __builtin_amdgcn_mfma_f32_16x16x32_bf16(__builtin_bit_cast(bf16x8, w), bfr[kk], acc, 0, 0, 0); }
              const f32x4 gg = *(const GAS f32x4*)(g2 + k0 + 4 * l4);
              *(GAS u32x2*)(WSCp + (size_t)(g * 128 + n0 + l15) * 2048 + k0 + 4 * l4) = pack4(acc * gg); } } }
}
using pg8::Unit;
struct SchedGrid {
    int G, c, nM, nN; const char* A; const char* B; size_t tstep;
    __device__ __forceinline__ bool next(int i, Unit& u) const { const int L = i * G + c; if (L >= nM * nN) return false; pg8::grid_order(L, nM, nN, u.pm, u.pn); u.kind = 0; return true; }
    __device__ __forceinline__ const char* pa(const Unit& u) const { return A + (size_t)u.pm * tstep; }
    __device__ __forceinline__ const char* pb(const Unit& u) const { return B + (size_t)u.pn * tstep; }
};
constexpr int P1_MAIN = 64 * 29, P1_VT = 4 * 65, P1_META = 7, P1_UNITS = P1_MAIN + P1_VT + P1_META;
struct SchedP1 {
    int G, c; const char* hn1; const char* win; const char* wvt; size_t tstep;
    __device__ __forceinline__ bool next(int i, Unit& u) const {
        const int L = i * G + c; if (L >= P1_UNITS) return false;
        if (L < P1_MAIN) { pg8::grid_order(L, 64, 29, u.pm, u.pn); u.kind = 0; }
        else if (L < P1_MAIN + P1_VT) { const int idx = L - P1_MAIN; u.pm = idx & 3; u.pn = idx >> 2; u.kind = 1; }
        else { const int idx = L - P1_MAIN - P1_VT; u.pm = 64; u.pn = idx < 4 ? 4 + idx : (idx < 6 ? 10 + (idx - 4) : 28); u.kind = 0; }
        return true; }
    __device__ __forceinline__ const char* pa(const Unit& u) const { return (u.kind == 1 ? wvt : hn1) + (size_t)u.pm * tstep; }
    __device__ __forceinline__ const char* pb(const Unit& u) const { return (u.kind == 1 ? hn1 : win) + (size_t)u.pn * tstep; }
};
__device__ __forceinline__ void rope4(const f32x4 x1, const f32x4 x2, const float* cosT, const float* sinT, int pos, int j0, f32x4& lo, f32x4& hi) {
    const f32x4 c = *(const GAS f32x4*)(cosT + pos * 32 + j0), s = *(const GAS f32x4*)(sinT + pos * 32 + j0);
    lo = x1 * c - x2 * s; hi = x2 * c + x1 * s;
}
struct EpiP1 {
    static constexpr bool PERM = true, HAS_PRE = false;
    bf16_t *naq, *nak, *vt, *cq, *ckv, *kr, *ga, *gb; float *ssq_q, *ssq_kv; const float *cosT, *sinT;
    __device__ __forceinline__ void operator()(const f32x4 (&acc)[2][2][4][2], const Unit& u, int wr, int wc, int fr, int fq, const LAS float* rowsc) const {
        const int row0 = u.pm * 256 + wr * 64 + fr, colu = wc * 32 + 8 * fq;
        if (u.kind == 1) {
#pragma unroll
            for (int ai = 0; ai < 2; ++ai)
#pragma unroll
                for (int m = 0; m < 4; ++m) { bf16_t* rp = vt + (size_t)(row0 + ai * 128 + m * 16) * VT_PITCH + u.pn * 256 + colu;
#pragma unroll
                    for (int bj = 0; bj < 2; ++bj) *(GAS u32x4*)(rp + bj * 128) = pack8(acc[ai][bj][m][0], acc[ai][bj][m][1]); }
            return; }
        const int pn = u.pn;
        if (pn == 28) {
            if (wc < 2) { const int j0 = 4 * (4 * wc + fq);
#pragma unroll
                for (int ai = 0; ai < 2; ++ai)
#pragma unroll
                    for (int m = 0; m < 4; ++m) { const int row = row0 + ai * 128 + m * 16; const int pos = row < MREAL ? NMETA + (row & (SEQ - 1)) : row - MREAL;
                        f32x4 lo, hi; rope4(acc[ai][0][m][0], acc[ai][0][m][1], cosT, sinT, pos, j0, lo, hi);
                        *(GAS u32x2*)(kr + (size_t)row * 64 + j0) = pack4(lo); *(GAS u32x2*)(kr + (size_t)row * 64 + 32 + j0) = pack4(hi); } }
            return; }
        if (pn >= 12) {
            bf16_t* base = pn < 20 ? ga : gb; const int colt = (pn < 20 ? pn - 12 : pn - 20) * 256 + colu;
#pragma unroll
            for (int ai = 0; ai < 2; ++ai)
#pragma unroll
                for (int m = 0; m < 4; ++m) { bf16_t* rp = base + (size_t)(row0 + ai * 128 + m * 16) * 2048 + colt;
#pragma unroll
                    for (int bj = 0; bj < 2; ++bj) { f32x4 a = acc[ai][bj][m][0], b = acc[ai][bj][m][1];
#pragma unroll
                        for (int i = 0; i < 4; ++i) { a[i] = sigmoidf_(a[i]); b[i] = sigmoidf_(b[i]); }
                        *(GAS u32x4*)(rp + bj * 128) = pack8(a, b); } }
            return; }
        if (pn >= 8) {
            const bool isq = pn < 10; bf16_t* base = isq ? cq : ckv; float* ssq = isq ? ssq_q : ssq_kv; const int colt = (isq ? pn - 8 : pn - 10) * 256 + colu;
#pragma unroll
            for (int ai = 0; ai < 2; ++ai)
#pragma unroll
                for (int m = 0; m < 4; ++m) { const int row = row0 + ai * 128 + m * 16; bf16_t* rp = base + (size_t)row * 512 + colt; float s = 0.f;
#pragma unroll
                    for (int bj = 0; bj < 2; ++bj) { const f32x4 a = acc[ai][bj][m][0], b = acc[ai][bj][m][1];
                        s += (a[0] * a[0] + a[1] * a[1]) + (a[2] * a[2] + a[3] * a[3]) + (b[0] * b[0] + b[1] * b[1]) + (b[2] * b[2] + b[3] * b[3]);
                        *(GAS u32x4*)(rp + bj * 128) = pack8(a, b); }
                    s += __shfl_xor(s, 16); s += __shfl_xor(s, 32);
                    if (fq == 0) ssq[(size_t)((pn & 1) * 4 + wc) * MPAD + row] = s; }
            return; }
        {
            bf16_t* base = pn < 4 ? naq : nak; const int colt = (pn & 3) * 256 + colu;
#pragma unroll
            for (int ai = 0; ai < 2; ++ai)
#pragma unroll
                for (int m = 0; m < 4; ++m) { bf16_t* rp = base + (size_t)(row0 + ai * 128 + m * 16) * 1024 + colt;
#pragma unroll
                    for (int bj = 0; bj < 2; ++bj) *(GAS u32x4*)(rp + bj * 128) = pack8(acc[ai][bj][m][0], acc[ai][bj][m][1]); }
        }
    }
};
constexpr int P3_Q = 64 * 12, P3_KV = 65 * 16, P3_UNITS = P3_Q + P3_KV;
struct SchedP3 {
    int G, c; const char* cq; const char* ckv; const char* wuq; const char* wukv; size_t tstep;
    __device__ __forceinline__ bool next(int i, Unit& u) const {
        const int L = i * G + c; if (L >= P3_UNITS) return false;
        if (L < P3_Q) { pg8::grid_order(L, 64, 12, u.pm, u.pn); u.kind = 0; } else { pg8::grid_order(L - P3_Q, 65, 16, u.pm, u.pn); u.kind = 1; }
        return true; }
    __device__ __forceinline__ const char* pa(const Unit& u) const { return (u.kind ? ckv : cq) + (size_t)u.pm * tstep; }
    __device__ __forceinline__ const char* pb(const Unit& u) const { return (u.kind ? wukv : wuq) + (size_t)u.pn * tstep; }
};
template <int NS, int LD> __device__ __forceinline__ float rstd_slabs(const float* part, int row, float invn) {
    float s = 0.f;
#pragma unroll
    for (int i = 0; i < NS; ++i) s += part[(size_t)i * LD + row];
    return 1.0f / sqrtf(s * invn + NORM_EPS);
}
struct EpiP3 {
    static constexpr bool PERM = true, HAS_PRE = true;
    bf16_t *qm, *kn, *vv; const float *ssq_q, *ssq_kv; const float *cosT, *sinT;
    __device__ __forceinline__ void pre(const Unit& u, LAS float* sc, int tid) const { if (tid < 256) { const int row = u.pm * 256 + tid; sc[tid] = u.kind ? rstd_slabs<8, MPAD>(ssq_kv, row, 1.f / 512.f) : rstd_slabs<8, MPAD>(ssq_q, row, 1.f / 512.f); } }
    __device__ __forceinline__ void operator()(const f32x4 (&acc)[2][2][4][2], const Unit& u, int wr, int wc, int fr, int fq, const LAS float* rowsc) const {
        const int row0 = u.pm * 256 + wr * 64 + fr, colu = wc * 32 + 8 * fq;
        if (u.kind == 1) {
#pragma unroll
            for (int ai = 0; ai < 2; ++ai)
#pragma unroll
                for (int m = 0; m < 4; ++m) { const int row = row0 + ai * 128 + m * 16; const float rs = rowsc[ai * 128 + wr * 64 + m * 16 + fr];
                    const size_t off = (size_t)row * 2048 + u.pn * 128 + colu;
                    *(GAS u32x4*)(kn + off) = pack8(acc[ai][0][m][0] * rs, acc[ai][0][m][1] * rs);
                    *(GAS u32x4*)(vv + off) = pack8(acc[ai][1][m][0] * rs, acc[ai][1][m][1] * rs); }
            return; }
#pragma unroll
        for (int bj = 0; bj < 2; ++bj) { const int c8 = u.pn * 256 + bj * 128 + colu; const int hd = c8 / 192, w = c8 - hd * 192;
            if (w < 128) {
#pragma unroll
                for (int ai = 0; ai < 2; ++ai)
#pragma unroll
                    for (int m = 0; m < 4; ++m) { const int row = row0 + ai * 128 + m * 16; const float rs = rowsc[ai * 128 + wr * 64 + m * 16 + fr];
                        *(GAS u32x4*)(qm + (size_t)row * 3072 + c8) = pack8(acc[ai][bj][m][0] * rs, acc[ai][bj][m][1] * rs); }
            } else { const int j0 = (w - 128) >> 1;
#pragma unroll
                for (int ai = 0; ai < 2; ++ai)
#pragma unroll
                    for (int m = 0; m < 4; ++m) { const int row = row0 + ai * 128 + m * 16; const float rs = rowsc[ai * 128 + wr * 64 + m * 16 + fr];
                        const int pos = NMETA + (row & (SEQ - 1)); f32x4 lo, hi; rope4(acc[ai][bj][m][0] * rs, acc[ai][bj][m][1] * rs, cosT, sinT, pos, j0, lo, hi);
                        bf16_t* qp = qm + (size_t)row * 3072 + hd * 192 + 128 + j0; *(GAS u32x2*)qp = pack4(lo); *(GAS u32x2*)(qp + 32) = pack4(hi); }
            } }
    }
};
__device__ __forceinline__ void unpack8(const u32x4 w, f32x4& a, f32x4& b) { a = (f32x4){bf_lo(w.x), bf_hi(w.x), bf_lo(w.y), bf_hi(w.y)}; b = (f32x4){bf_lo(w.z), bf_hi(w.z), bf_lo(w.w), bf_hi(w.w)}; }
struct EpiP5a {
    static constexpr bool PERM = true, HAS_PRE = false;
    const bf16_t* ga; bf16_t* t1;
    __device__ __forceinline__ void operator()(const f32x4 (&acc)[2][2][4][2], const Unit& u, int wr, int wc, int fr, int fq, const LAS float* rowsc) const {
        const int row0 = u.pm * 256 + wr * 64 + fr, col0 = u.pn * 256 + wc * 32 + 8 * fq;
#pragma unroll
        for (int ai = 0; ai < 2; ++ai)
#pragma unroll
            for (int m = 0; m < 4; ++m) { const size_t off = (size_t)(row0 + ai * 128 + m * 16) * 2048 + col0;
#pragma unroll
                for (int bj = 0; bj < 2; ++bj) { f32x4 g0, g1; unpack8(*(const GAS u32x4*)(ga + off + bj * 128), g0, g1);
                    *(GAS u32x4*)(t1 + off + bj * 128) = pack8(acc[ai][bj][m][0] * g0, acc[ai][bj][m][1] * g1); } }
    }
};
struct EpiP5b {
    static constexpr bool PERM = true, HAS_PRE = false;
    const bf16_t* gb; const bf16_t* t1; unsigned char* merged;
    __device__ __forceinline__ void operator()(const f32x4 (&acc)[2][2][4][2], const Unit& u, int wr, int wc, int fr, int fq, const LAS float* rowsc) const {
        const int row0 = u.pm * 256 + wr * 64 + fr, col0 = u.pn * 256 + wc * 32 + 8 * fq;
#pragma unroll
        for (int ai = 0; ai < 2; ++ai)
#pragma unroll
            for (int m = 0; m < 4; ++m) { const size_t off = (size_t)(row0 + ai * 128 + m * 16) * 2048 + col0;
#pragma unroll
                for (int bj = 0; bj < 2; ++bj) { f32x4 g0, g1; unpack8(*(const GAS u32x4*)(gb + off + bj * 128), g0, g1);
                    f32x4 a, b; unpack8(*(const GAS u32x4*)(t1 + off + bj * 128), a, b);
                    *(GAS u32x2*)(merged + off + bj * 128) = pack8_fp8((a + acc[ai][bj][m][0] * g0) * 32.f, (b + acc[ai][bj][m][1] * g1) * 32.f); } }
    }
};
struct EpiP6 {
    static constexpr bool PERM = true, HAS_PRE = false;
    const float* x; float* h2; bf16_t* h2b; float* ssq2;
    __device__ __forceinline__ void operator()(const f32x4 (&acc)[2][2][4][2], const Unit& u, int wr, int wc, int fr, int fq, const LAS float* rowsc) const {
        const int row0 = u.pm * 256 + wr * 64 + fr, col0 = u.pn * 256 + wc * 32 + 8 * fq;
#pragma unroll
        for (int ai = 0; ai < 2; ++ai)
#pragma unroll
            for (int m = 0; m < 4; ++m) { const int row = row0 + ai * 128 + m * 16; const size_t off = (size_t)row * 2048 + col0; float s = 0.f;
#pragma unroll
                for (int bj = 0; bj < 2; ++bj) { const f32x4 a = *(const GAS f32x4*)(x + off + bj * 128) + acc[ai][bj][m][0], b = *(const GAS f32x4*)(x + off + bj * 128 + 4) + acc[ai][bj][m][1];
                    s += (a[0] * a[0] + a[1] * a[1]) + (a[2] * a[2] + a[3] * a[3]) + (b[0] * b[0] + b[1] * b[1]) + (b[2] * b[2] + b[3] * b[3]);
                    *(GAS f32x4*)(h2 + off + bj * 128) = a; *(GAS f32x4*)(h2 + off + bj * 128 + 4) = b; *(GAS u32x4*)(h2b + off + bj * 128) = pack8(a, b); }
                s += __shfl_xor(s, 16); s += __shfl_xor(s, 32);
                if (fq == 0) ssq2[(size_t)(u.pn * 4 + wc) * MREAL + row] = s; }
    }
};
struct EpiP7 {
    static constexpr bool PERM = false, HAS_PRE = true;
    const float* ssq2; float* sc;
    __device__ __forceinline__ void pre(const Unit& u, LAS float* sc, int tid) const { if (tid < 256) sc[tid] = rstd_slabs<32, MREAL>(ssq2, u.pm * 256 + tid, 1.f / 2048.f); }
    __device__ __forceinline__ void operator()(const f32x4 (&acc)[2][2][4][2], const Unit& u, int wr, int wc, int fr, int fq, const LAS float* rowsc) const {
        const int row0 = u.pm * 256 + wr * 64 + fr, col0 = u.pn * 256 + wc * 32 + 4 * fq;
#pragma unroll
        for (int ai = 0; ai < 2; ++ai)
#pragma unroll
            for (int m = 0; m < 4; ++m) { const int row = row0 + ai * 128 + m * 16; const float rs = rowsc[ai * 128 + wr * 64 + m * 16 + fr]; const size_t off = (size_t)row * 2048 + col0;
#pragma unroll
                for (int bj = 0; bj < 2; ++bj)
#pragma unroll
                    for (int n = 0; n < 2; ++n) *(GAS f32x4*)(sc + off + bj * 128 + n * 16) = acc[ai][bj][m][n] * rs; }
    }
};
namespace att {
#define KSWZ(row, colB) ((row) * 256 + ((colB) ^ (((row) & 7) << 4)))
#define KRSWZ(row, colB) ((row) * 128 + ((colB) ^ ((((row) >> 1) & 7) << 4)))
constexpr float L2E = 1.4426950408889634f;
template <int DUMMY = 0>
__device__ __forceinline__ void partialSM(f32x16& p0, f32x16& p1, float& m_reg, float& mn, float& alpha, const float C, const float THRS) {
  float pmax = p0[0];
#pragma unroll
  for (int r = 1; r < 16; ++r) pmax = fmaxf(pmax, p0[r]);
#pragma unroll
  for (int r = 0; r < 16; ++r) pmax = fmaxf(pmax, p1[r]);
  { auto rr = __builtin_amdgcn_permlane32_swap(__float_as_uint(pmax), __float_as_uint(pmax), false, false);
    pmax = fmaxf(__uint_as_float(rr[0]), __uint_as_float(rr[1])); }
  if (__builtin_expect(__all(pmax - m_reg <= THRS), 1)) { mn = m_reg; alpha = 1.f; }
  else { mn = fmaxf(m_reg, pmax); alpha = __builtin_amdgcn_exp2f((m_reg - mn) * C); m_reg = mn; }
  const float mnC = -mn * C;
#pragma unroll
  for (int r = 0; r < 16; ++r) p0[r] = fmaf(p0[r], C, mnC);
#pragma unroll
  for (int r = 0; r < 16; ++r) p1[r] = fmaf(p1[r], C, mnC);
#pragma unroll
  for (int r = 0; r < 16; ++r) p0[r] = __builtin_amdgcn_exp2f(p0[r]);
}
__device__ __forceinline__ void finishSM(f32x16& p0, f32x16& p1, float alpha, float& l_reg, bf16x8& pa0, bf16x8& pa1, bf16x8& pa2, bf16x8& pa3) {
#pragma unroll
  for (int r = 0; r < 16; ++r) p1[r] = __builtin_amdgcn_exp2f(p1[r]);
  float ps = 0;
#pragma unroll
  for (int r = 0; r < 16; ++r) ps += p0[r];
#pragma unroll
  for (int r = 0; r < 16; ++r) ps += p1[r];
  { auto rr = __builtin_amdgcn_permlane32_swap(__float_as_uint(ps), __float_as_uint(ps), false, false);
    ps = __uint_as_float(rr[0]) + __uint_as_float(rr[1]); }
  l_reg = l_reg * alpha + ps;
#define PK4(P, BASE, OUT) do { unsigned a0 = cvt_pk_bf16(P[BASE + 0], P[BASE + 1]), a1 = cvt_pk_bf16(P[BASE + 2], P[BASE + 3]);   \
    unsigned b0 = cvt_pk_bf16(P[BASE + 4], P[BASE + 5]), b1 = cvt_pk_bf16(P[BASE + 6], P[BASE + 7]);                              \
    auto r0 = __builtin_amdgcn_permlane32_swap(a0, b0, false, false); auto r1 = __builtin_amdgcn_permlane32_swap(a1, b1, false, false); \
    u32x4 w = {r0[0], r1[0], r0[1], r1[1]}; OUT = __builtin_bit_cast(bf16x8, w); } while (0)
  PK4(p0, 0, pa0); PK4(p0, 8, pa1); PK4(p1, 0, pa2); PK4(p1, 8, pa3);
#undef PK4
}
constexpr int NW = 8, QBLK = 32, KVBLK = 64;
constexpr float MLA_SCALE = 0.07216878364870322f;
constexpr float MLA_THR = 8.f;
constexpr int SHM_V = KVBLK * 128 * 2, SHM_KN = KVBLK * 128 * 2, SHM_KR = KVBLK * 64 * 2;
constexpr int OFF_V = 0, OFF_KN = 2 * SHM_V, OFF_KR = OFF_KN + 2 * SHM_KN, OFF_WS = OFF_KR + 2 * SHM_KR, OFF_QR = OFF_WS + NW * 64 * 4, MLA_LDS = OFF_QR + NW * 4096;
__device__ __forceinline__ void qkt(f32x16& p0, f32x16& p1, const LAS char* Kn, const LAS char* Kr, const bf16x8* qr, const LAS char* qrp, const int* kb, const int* krb) {
  p0 = f32x16{}; p1 = f32x16{};
#pragma unroll
  for (int d0 = 0; d0 < 8; ++d0) {
    const bf16x8 b0 = *(const LAS bf16x8*)(Kn + kb[d0 & 3] + (d0 >> 2) * 128);
    const bf16x8 b1 = *(const LAS bf16x8*)(Kn + kb[d0 & 3] + (d0 >> 2) * 128 + 8192);
    p0 = __builtin_amdgcn_mfma_f32_32x32x16_bf16(b0, qr[d0], p0, 0, 0, 0);
    p1 = __builtin_amdgcn_mfma_f32_32x32x16_bf16(b1, qr[d0], p1, 0, 0, 0); }
#pragma unroll
  for (int d0 = 0; d0 < 4; ++d0) {
    const bf16x8 b0 = *(const LAS bf16x8*)(Kr + krb[d0]);
    const bf16x8 b1 = *(const LAS bf16x8*)(Kr + krb[d0] + 4096);
    const bf16x8 qf = *(const LAS bf16x8*)(qrp + d0 * 1024);
    p0 = __builtin_amdgcn_mfma_f32_32x32x16_bf16(b0, qf, p0, 0, 0, 0);
    p1 = __builtin_amdgcn_mfma_f32_32x32x16_bf16(b1, qf, p1, 0, 0, 0); }
}
__device__ __forceinline__ int v_st(int k, int c) { const int kk = (k & ~0xC) | ((k & 4) << 1) | ((k & 8) >> 1); return ((kk >> 3) * 4 + (c >> 5)) * 512 + ((kk & 7) * 32 + (c & 31)) * 2; }
__device__ __forceinline__ int v_rd_base(int lane) { return ((lane & 3) << 3) | (((lane >> 2) & 3) << 6) | (((lane >> 4) & 1) << 5) | (((lane >> 5) & 1) << 8); }
constexpr int v_rd_off(int d0, int ks, int half) { return d0 * 512 + ks * 4096 + half * 2048; }
template <int OFF> __device__ __forceinline__ s16x4 tr_read(int vb) {
  s16x4 r; asm volatile("ds_read_b64_tr_b16 %0, %1 offset:%2" : "=&v"(r) : "v"(vb), "i"(OFF) : "memory"); return r;
}
template <int D0> __device__ __forceinline__ void pv_one(f32x16& od, int vb, bf16x8 pa0, bf16x8 pa1, bf16x8 pa2, bf16x8 pa3) {
  const s16x4 l0 = tr_read<v_rd_off(D0, 0, 0)>(vb), h0 = tr_read<v_rd_off(D0, 0, 1)>(vb), l1 = tr_read<v_rd_off(D0, 1, 0)>(vb), h1 = tr_read<v_rd_off(D0, 1, 1)>(vb);
  const s16x4 l2 = tr_read<v_rd_off(D0, 2, 0)>(vb), h2 = tr_read<v_rd_off(D0, 2, 1)>(vb), l3 = tr_read<v_rd_off(D0, 3, 0)>(vb), h3 = tr_read<v_rd_off(D0, 3, 1)>(vb);
  asm volatile("s_waitcnt lgkmcnt(0)" ::: "memory"); SBAR();
#define PK(L, H) (bf16x8){L[0], L[1], L[2], L[3], H[0], H[1], H[2], H[3]}
  od = __builtin_amdgcn_mfma_f32_32x32x16_bf16(pa0, PK(l0, h0), od, 0, 0, 0);
  od = __builtin_amdgcn_mfma_f32_32x32x16_bf16(pa1, PK(l1, h1), od, 0, 0, 0);
  od = __builtin_amdgcn_mfma_f32_32x32x16_bf16(pa2, PK(l2, h2), od, 0, 0, 0);
  od = __builtin_amdgcn_mfma_f32_32x32x16_bf16(pa3, PK(l3, h3), od, 0, 0, 0);
#undef PK
}
__device__ __forceinline__ void pv_d0(f32x16* o, int vb, bf16x8 pa0, bf16x8 pa1, bf16x8 pa2, bf16x8 pa3) {
  pv_one<0>(o[0], vb, pa0, pa1, pa2, pa3); pv_one<1>(o[1], vb, pa0, pa1, pa2, pa3); pv_one<2>(o[2], vb, pa0, pa1, pa2, pa3); pv_one<3>(o[3], vb, pa0, pa1, pa2, pa3);
}
__device__ __forceinline__ void mla_unit(int b, int h, int qb, const bf16_t* __restrict__ QM, const bf16_t* __restrict__ KN, const bf16_t* __restrict__ KR, const bf16_t* __restrict__ VV, unsigned char* __restrict__ OM, LAS char* lds) {
  const int tid = threadIdx.x, wid = tid >> 6, lane = tid & 63, r32 = lane & 31, hi = lane >> 5;
  constexpr float C = MLA_SCALE * L2E, THRS = MLA_THR / MLA_SCALE;
  constexpr int NT = 33;
  LAS char* V_lds = lds + OFF_V; LAS char* Kn_lds = lds + OFF_KN; LAS char* Kr_lds = lds + OFF_KR;
  LAS float* ws = (LAS float*)(lds + OFF_WS) + wid * 64; LAS float* li_l = ws; LAS float* al_l = ws + 32;
  float m_reg = -1e30f, l_reg = 0; f32x16 o[4] = {}; bf16x8 qr[8];
  LAS char* qrp = lds + OFF_QR + wid * 4096 + lane * 16;
  const int qrow = b * SEQ + qb * 256 + wid * QBLK + r32;
  const bf16_t* Qw = QM + (size_t)qrow * 3072 + h * 192 + hi * 8;
#pragma unroll
  for (int d0 = 0; d0 < 8; ++d0) qr[d0] = *(const GAS bf16x8*)(Qw + d0 * 16);
  __syncthreads();
#pragma unroll
  for (int d0 = 0; d0 < 4; ++d0) *(LAS bf16x8*)(qrp + d0 * 1024) = *(const GAS bf16x8*)(Qw + (8 + d0) * 16);
  const int sr = tid >> 4, sc = (tid & 15) * 8, vst0 = v_st(sr, sc), vst1 = v_st(32 + sr, sc);
  const int krr = tid >> 3, krc = (tid & 7) * 8;
  const int vb0 = (int)(uintptr_t)V_lds + v_rd_base(lane);
  bf16x8 s_v0, s_v1, s_k0, s_k1, s_kr;
  const int realbase = b * SEQ - KVBLK;
  const unsigned voff = (unsigned)(sr * 2048 + sc) * 2u, kroff = (unsigned)(krr * 64 + krc) * 2u;
  int kb[4], krb[4];
#pragma unroll
  for (int bq = 0; bq < 4; ++bq) { kb[bq] = KSWZ(r32, bq * 32 + hi * 16); krb[bq] = KRSWZ(r32, bq * 32 + hi * 16); }
#define TROW(t) ((t) == 0 ? MREAL : realbase + (t) * KVBLK)
#define SLOAD(t) do { const int k0_ = TROW(t); const size_t ro_ = ((size_t)k0_ * 2048 + h * 128) * 2; \
    const GAS char* vb_ = (const GAS char*)VV + ro_; const GAS char* nb_ = (const GAS char*)KN + ro_; const GAS char* rb_ = (const GAS char*)KR + (size_t)k0_ * 128; \
    s_v0 = *(const GAS bf16x8*)(vb_ + voff); s_v1 = *(const GAS bf16x8*)(vb_ + 32 * 4096 + voff); \
    s_k0 = *(const GAS bf16x8*)(nb_ + voff); s_k1 = *(const GAS bf16x8*)(nb_ + 32 * 4096 + voff); \
    s_kr = *(const GAS bf16x8*)(rb_ + kroff); } while (0)
#define SWRITE(bf) do { *(LAS bf16x8*)(V_lds + (bf) * SHM_V + vst0) = s_v0; *(LAS bf16x8*)(V_lds + (bf) * SHM_V + vst1) = s_v1; const int kc_ = sc * 2; \
    *(LAS bf16x8*)(Kn_lds + (bf) * SHM_KN + KSWZ(sr, kc_)) = s_k0; *(LAS bf16x8*)(Kn_lds + (bf) * SHM_KN + KSWZ(32 + sr, kc_)) = s_k1; \
    *(LAS bf16x8*)(Kr_lds + (bf) * SHM_KR + KRSWZ(krr, krc * 2)) = s_kr; } while (0)
#define SWAIT() asm volatile("s_waitcnt vmcnt(0)" ::: "memory")
#define RESC(a) do { if (__any((a) < 1.f)) { if (hi == 0) al_l[r32] = (a); asm volatile("s_waitcnt lgkmcnt(0)" ::: "memory"); \
    _Pragma("unroll") for (int d = 0; d < 4; ++d) _Pragma("unroll") for (int r = 0; r < 16; ++r) o[d][r] *= al_l[crow(r, hi)]; } } while (0)
  f32x16 pA0, pA1, pB0, pB1; float mnA, mnB, alA, alB; bf16x8 pa0, pa1, pa2, pa3;
  SLOAD(0); SWAIT(); SWRITE(0); __syncthreads();
  qkt(pA0, pA1, Kn_lds, Kr_lds, qr, qrp, kb, krb);
  { const float NEG = -INFINITY;
#pragma unroll
    for (int r = 8; r < 16; ++r) pA0[r] = NEG;
#pragma unroll
    for (int r = 0; r < 16; ++r) pA1[r] = NEG; }
  partialSM(pA0, pA1, m_reg, mnA, alA, C, THRS);
  SLOAD(1); SWAIT(); SWRITE(1); __syncthreads();
  for (int j = 1; j + 1 < NT; j += 2) {
    SBAR(); qkt(pB0, pB1, Kn_lds + SHM_KN, Kr_lds + SHM_KR, qr, qrp, kb, krb);
    finishSM(pA0, pA1, alA, l_reg, pa0, pa1, pa2, pa3); SBAR();
    SLOAD(j + 1); SBAR();
    pv_d0(o, vb0, pa0, pa1, pa2, pa3); partialSM(pB0, pB1, m_reg, mnB, alB, C, THRS);
    __syncthreads(); SWAIT(); SWRITE(0);
    RESC(alB); __syncthreads();
    SBAR(); qkt(pA0, pA1, Kn_lds, Kr_lds, qr, qrp, kb, krb);
    finishSM(pB0, pB1, alB, l_reg, pa0, pa1, pa2, pa3); SBAR();
    if (j + 2 < NT) SLOAD(j + 2); SBAR();
    pv_d0(o, vb0 + SHM_V, pa0, pa1, pa2, pa3); partialSM(pA0, pA1, m_reg, mnA, alA, C, THRS);
    __syncthreads(); if (j + 2 < NT) { SWAIT(); SWRITE(1); }
    RESC(alA); __syncthreads();
  }
  finishSM(pA0, pA1, alA, l_reg, pa0, pa1, pa2, pa3); SBAR();
  pv_d0(o, vb0, pa0, pa1, pa2, pa3);
  if (hi == 0) li_l[r32] = l_reg; asm volatile("s_waitcnt lgkmcnt(0)" ::: "memory");
  float rli[16];
#pragma unroll
  for (int r = 0; r < 16; ++r) rli[r] = __builtin_amdgcn_rcpf(li_l[crow(r, hi)]);
  unsigned char* Ow = OM + (size_t)(b * SEQ + qb * 256 + wid * QBLK) * 2048 + h * 128;
#pragma unroll
  for (int r = 0; r < 16; ++r) { const int orow = crow(r, hi);
#pragma unroll
    for (int d0 = 0; d0 < 4; ++d0) Ow[(size_t)orow * 2048 + d0 * 32 + r32] = f32_to_fp8(o[d0][r] * rli[r] * 32.f); }
#undef TROW
#undef SLOAD
#undef SWRITE
#undef SWAIT
#undef RESC
}
__device__ __forceinline__ void na_task(int task, const bf16_t* __restrict__ NAQ, const bf16_t* __restrict__ NAK, const bf16_t* __restrict__ VT, unsigned char* __restrict__ ONA,
                                        const LAS float* relb, const LAS float* metab, LAS float* wsf, int lane) {
  const int r32 = lane & 31, hi = lane >> 5;
  const int half = task & 1, r = (task >> 1) & 31, h = (task >> 6) & 15, b = task >> 10;
  const int qc = half * 32 + r32;
  const int cs = min(max(qc - 8, 0), 48), rs = min(max(r - 4, 0), 24);
  const int qtok = b * SEQ + r * 64 + qc;
  constexpr float C = L2E, THRS = 8.f, SCALE = 0.125f;
  bf16x8 qr[4];
#pragma unroll
  for (int d0 = 0; d0 < 4; ++d0) qr[d0] = *(const GAS bf16x8*)(NAQ + (size_t)qtok * 1024 + h * 64 + d0 * 16 + hi * 8);
  float m_reg = -1e30f, l_reg = 0.f; f32x16 o[2] = {};
  LAS float* al_l = wsf; LAS float* li_l = wsf + 32;
  const float NEG = -INFINITY;
  const unsigned long long wm = 0xFFFFull << cs;
  const unsigned mh0 = (unsigned)wm >> (4 * hi), mh1 = (unsigned)(wm >> 32) >> (4 * hi);
  const bf16_t* kq = NAK + (size_t)r32 * 1024 + h * 64 + hi * 8;
  const bf16_t* vq = VT + (size_t)(h * 64 + r32) * VT_PITCH + 8 * hi;
#define NA_KTOK(w) ((w) == 8 ? MREAL : b * SEQ + (rs + (w)) * 64)
#define NA_LOADK(KF, w) do { const bf16_t* kp_ = kq + (size_t)NA_KTOK(w) * 1024; _Pragma("unroll") for (int d0 = 0; d0 < 4; ++d0) { KF[d0] = *(const GAS bf16x8*)(kp_ + d0 * 16); KF[4 + d0] = *(const GAS bf16x8*)(kp_ + 32 * 1024 + d0 * 16); } } while (0)
#define NA_TILE(KF, w) do { \
    bf16x8 vf[8]; { const bf16_t* vp_ = vq + NA_KTOK(w); _Pragma("unroll") for (int ks = 0; ks < 4; ++ks) { vf[ks] = *(const GAS bf16x8*)(vp_ + 16 * ks); vf[4 + ks] = *(const GAS bf16x8*)(vp_ + (size_t)32 * VT_PITCH + 16 * ks); } } \
    f32x16 p0 = {}, p1 = {}; \
    _Pragma("unroll") for (int d0 = 0; d0 < 4; ++d0) { p0 = __builtin_amdgcn_mfma_f32_32x32x16_bf16(KF[d0], qr[d0], p0, 0, 0, 0); p1 = __builtin_amdgcn_mfma_f32_32x32x16_bf16(KF[4 + d0], qr[d0], p1, 0, 0, 0); } \
    if ((w) + 1 < 9) NA_LOADK(KF, (w) + 1);            \
    if ((w) < 8) { const LAS float* bp_ = relb + ((h * 15 + (rs + (w) - r + 7)) * 31 + 15 - qc + 4 * hi);     \
      _Pragma("unroll") for (int rg = 0; rg < 16; ++rg) { const int c_ = (rg & 3) + 8 * (rg >> 2); \
        { const bool ok = (mh0 >> c_) & 1u; const float bv = bp_[c_]; p0[rg] = ok ? fmaf(p0[rg], SCALE, bv) : NEG; } \
        { const bool ok = (mh1 >> c_) & 1u; const float bv = bp_[c_ + 32]; p1[rg] = ok ? fmaf(p1[rg], SCALE, bv) : NEG; } } \
    } else { const LAS float* bp = metab + h * 16; \
      _Pragma("unroll") for (int rg = 0; rg < 16; ++rg) { const int kc = crow(rg, hi); p0[rg] = (rg < 8) ? fmaf(p0[rg], SCALE, bp[kc & 15]) : NEG; p1[rg] = NEG; } } \
    float mn, alpha; partialSM(p0, p1, m_reg, mn, alpha, C, THRS); \
    bf16x8 pa0, pa1, pa2, pa3; finishSM(p0, p1, alpha, l_reg, pa0, pa1, pa2, pa3); \
    if (__any(alpha < 1.f)) { if (hi == 0) al_l[r32] = alpha; asm volatile("s_waitcnt lgkmcnt(0)" ::: "memory"); \
      _Pragma("unroll") for (int d = 0; d < 2; ++d) _Pragma("unroll") for (int rg = 0; rg < 16; ++rg) o[d][rg] *= al_l[crow(rg, hi)]; } \
    _Pragma("unroll") for (int d0 = 0; d0 < 2; ++d0) { \
      o[d0] = __builtin_amdgcn_mfma_f32_32x32x16_bf16(pa0, vf[4 * d0 + 0], o[d0], 0, 0, 0); o[d0] = __builtin_amdgcn_mfma_f32_32x32x16_bf16(pa1, vf[4 * d0 + 1], o[d0], 0, 0, 0); \
      o[d0] = __builtin_amdgcn_mfma_f32_32x32x16_bf16(pa2, vf[4 * d0 + 2], o[d0], 0, 0, 0); o[d0] = __builtin_amdgcn_mfma_f32_32x32x16_bf16(pa3, vf[4 * d0 + 3], o[d0], 0, 0, 0); } } while (0)
  { bf16x8 kA[8];
    NA_LOADK(kA, 0);
#pragma unroll 1
    for (int w = 0; w < 8; ++w) { NA_TILE(kA, w); }
    NA_TILE(kA, 8); }
#undef NA_KTOK
#undef NA_LOADK
#undef NA_TILE
  if (hi == 0) li_l[r32] = l_reg; asm volatile("s_waitcnt lgkmcnt(0)" ::: "memory");
  unsigned char* Ow = ONA + (size_t)(b * SEQ + r * 64 + half * 32) * 1024 + h * 64;
#pragma unroll
  for (int rg = 0; rg < 16; ++rg) { const int orow = crow(rg, hi); const float rl = __builtin_amdgcn_rcpf(li_l[orow]);
#pragma unroll
    for (int d0 = 0; d0 < 2; ++d0) Ow[(size_t)orow * 1024 + d0 * 32 + r32] = f32_to_fp8(o[d0][rg] * rl * 16.f); }
  asm volatile("s_waitcnt lgkmcnt(0)" ::: "memory");
}
}
namespace peer {
constexpr int CH = 32;
constexpr int OFF_TV = 0, OFF_TI = OFF_TV + CH * 16 * 16 * 4, OFF_SE = OFF_TI + CH * 16 * 16 * 4, OFF_SG = OFF_SE + CH * 128 * 4, PEER_LDS = OFF_SG + CH * 128 * 4;
__device__ __forceinline__ float gelu_tanh(float x) {
    const float u = 0.7978845608028654f * (x + 0.044715f * x * x * x);
    const float e = __builtin_amdgcn_exp2f(-2.f * 1.4426950408889634f * fabsf(u));
    const float t = (1.f - e) * __builtin_amdgcn_rcpf(1.f + e);
    return 0.5f * x * (1.f + (u < 0.f ? -t : t));
}
__device__ __forceinline__ void fmac1(float& acc, float a, float b) { asm("v_fmac_f32_e32 %0, %1, %2" : "+v"(acc) : "v"(a), "v"(b)); }
#define PEER_INSERT(x_, xi_) do { float x__ = (x_); int xi__ = (xi_); \
    _Pragma("unroll") for (int j_ = 0; j_ < 16; ++j_) { const bool gt_ = x__ > tv[j_]; const float tvo_ = tv[j_]; const int tio_ = ti[j_]; \
        tv[j_] = gt_ ? x__ : tvo_; ti[j_] = gt_ ? xi__ : tio_; x__ = gt_ ? tvo_ : x__; xi__ = gt_ ? tio_ : xi__; } } while (0)

#define PEER_AUX 0
typedef __amdgpu_buffer_rsrc_t rsrc_t;
__device__ __forceinline__ rsrc_t mk_rsrc(const void* p, unsigned bytes) { return __builtin_amdgcn_make_buffer_rsrc((void*)p, 0, bytes, 0x00020000); }
__device__ __forceinline__ u32x4 ldb128(rsrc_t r, unsigned off) { return __builtin_amdgcn_raw_buffer_load_b128(r, off, 0, PEER_AUX); }
typedef unsigned v6u_t __attribute__((ext_vector_type(6)));
typedef float v32f_t __attribute__((ext_vector_type(32)));
typedef float v16f_t __attribute__((ext_vector_type(16)));
__device__ __forceinline__ u32x2 ldb64(rsrc_t r, unsigned off) { return __builtin_amdgcn_raw_buffer_load_b64(r, off, 0, PEER_AUX); }
__device__ __forceinline__ f32x4 ldf128(rsrc_t r, unsigned off) { return __builtin_bit_cast(f32x4, __builtin_amdgcn_raw_buffer_load_b128(r, off, 0, PEER_AUX)); }
__device__ __forceinline__ f32x4 ldf128_nt(rsrc_t r, unsigned off) { return __builtin_bit_cast(f32x4, __builtin_amdgcn_raw_buffer_load_b128(r, off, 0, 2)); }
__device__ __forceinline__ void peer_chunk(int chunk, const float* __restrict__ SC, const float* __restrict__ H2, const unsigned char* __restrict__ U, const unsigned char* __restrict__ V,
                                           const float* __restrict__ g2, const float* __restrict__ gf, float* OUT, LAS char* lds, int tid) {
    LAS float* TV = (LAS float*)(lds + OFF_TV); LAS int* TI = (LAS int*)(lds + OFF_TI); LAS int* SE = (LAS int*)(lds + OFF_SE); LAS float* SG = (LAS float*)(lds + OFF_SG);
    asm volatile("" : "+v"(tid));
    const int tok0 = chunk * CH, lane = tid & 63, wave = tid >> 6;
    const rsrc_t rSC = mk_rsrc(SC, 0x8000000u), rH2 = mk_rsrc(H2, 0x8000000u), rU = mk_rsrc(U, 0x3000000u), rG2 = mk_rsrc(g2, 8192u), rGF = mk_rsrc(gf, 8192u);
    __syncthreads();
    { const int tl = tid >> 4, g = tid & 15; const unsigned spo = ((unsigned)(tok0 + tl) * 2048u + (unsigned)g * 128u) * 4u;
      int tk[16];
#pragma unroll
      for (int j = 0; j < 16; ++j) tk[j] = (int)0x80000000;
#define PEER_KEY(x_, lowbits_, mask_) ({ const int f_ = __float_as_int(x_); ((f_ ^ ((f_ >> 31) & 0x7fffffff)) & ~(mask_)) | (lowbits_); })
#define PEER_INS(key_) do { int x__ = (key_); _Pragma("unroll") for (int j_ = 0; j_ < 16; ++j_) { const int hi_ = max(x__, tk[j_]); x__ = min(x__, tk[j_]); tk[j_] = hi_; } } while (0)
#pragma unroll 1
      for (int i = 0; i < 32; i += 2) { const f32x4 a = ldf128_nt(rSC, spo + i * 16), b = ldf128_nt(rSC, spo + i * 16 + 16);
#pragma unroll
          for (int e = 0; e < 4; ++e) { PEER_INS(PEER_KEY(a[e], 127 - (4 * i + e), 127)); }
#pragma unroll
          for (int e = 0; e < 4; ++e) { PEER_INS(PEER_KEY(b[e], 127 - (4 * i + 4 + e), 127)); } }
      LAS float* tvp = TV + (tl * 16 + g) * 16; LAS int* tip = TI + (tl * 16 + g) * 16;
#pragma unroll
      for (int j = 0; j < 16; ++j) { const int k_ = tk[j] & ~127; tvp[j] = __int_as_float(k_ ^ ((k_ >> 31) & 0x7fffffff)); tip[j] = 127 - (tk[j] & 127); } }
    __syncthreads();
    asm volatile("" : "+v"(tid));
    { const int tl = tid >> 4, hh = (tid >> 1) & 7, half = tid & 1;
      const LAS float* s1 = TV + (tl * 16 + 2 * hh) * 16; const LAS float* s2 = s1 + 16; const LAS int* i1 = TI + (tl * 16 + 2 * hh) * 16; const LAS int* i2 = i1 + 16;
      float b2[16];
#pragma unroll
      for (int j = 0; j < 16; ++j) b2[j] = s2[j];
      int tk[16];
#pragma unroll
      for (int j = 0; j < 16; ++j) tk[j] = (int)0x80000000;
#pragma unroll
      for (int ii = 0; ii < 8; ++ii) { const int i = 2 * ii + half; const float a = s1[i];
#pragma unroll
          for (int j = 0; j < 16; ++j) if ((2 * ii + 1) * (j + 1) <= 16) { if (half == 0 || (2 * ii + 2) * (j + 1) <= 16) PEER_INS(PEER_KEY(a + b2[j], 255 - (i * 16 + j), 255)); } }
      { int pk[16];
#pragma unroll
        for (int j = 0; j < 16; ++j) pk[j] = __shfl_xor(tk[j], 1);
#pragma unroll
        for (int j = 0; j < 16; ++j) PEER_INS(pk[j]); }
      if (half == 0) { float e[16], sum = 0.f; const int k0_ = tk[0] & ~255; const float v0 = __int_as_float(k0_ ^ ((k0_ >> 31) & 0x7fffffff));
#pragma unroll
        for (int j = 0; j < 16; ++j) { const int k_ = tk[j] & ~255; const float vj = __int_as_float(k_ ^ ((k_ >> 31) & 0x7fffffff)); e[j] = __builtin_amdgcn_exp2f((vj - v0) * 1.4426950408889634f); sum += e[j]; }
        const float inv = 1.0f / sum;
#pragma unroll
        for (int j = 0; j < 16; ++j) { const int ci = 255 - (tk[j] & 255); SE[tl * 128 + hh * 16 + j] = i1[ci >> 4] * 128 + i2[ci & 15]; SG[tl * 128 + hh * 16 + j] = e[j] * inv; } } }
#undef PEER_KEY
#undef PEER_INS
    __syncthreads();
#pragma unroll 1
    for (int tt = 0; tt < CH / NWAVES; ++tt) { const int tl = wave * (CH / NWAVES) + tt, tok = tok0 + tl;
      asm volatile("" ::: "memory");
      float hn[32], acc[32]; float ss = 0.f;
#pragma unroll
      for (int j = 0; j < 2; ++j)
#pragma unroll
          for (int q = 0; q < 4; ++q) { const f32x4 a = ldf128_nt(rH2, ((unsigned)tok * 2048u + 1024u * j + 16u * lane + 4u * q) * 4u);
#pragma unroll
              for (int i = 0; i < 4; ++i) { hn[16 * j + 4 * q + i] = a[i]; ss += a[i] * a[i]; } }
      const float rstd = 1.0f / sqrtf(wave_sum(ss) * (1.f / 2048.f) + NORM_EPS);
#pragma unroll
      for (int j = 0; j < 2; ++j)
#pragma unroll
          for (int q = 0; q < 4; ++q) { const f32x4 a = ldf128(rG2, (1024u * j + 16u * lane + 4u * q) * 4u);
#pragma unroll
              for (int i = 0; i < 4; ++i) hn[16 * j + 4 * q + i] *= rstd * a[i]; }
#pragma unroll
      for (int i = 0; i < 32; ++i) acc[i] = 0.f;
#define NX 4
#define PEER_LOAD(S, kb) do { _Pragma("unroll") for (int x = 0; x < NX; ++x) { const unsigned o = (unsigned)SE[tl * 128 + (kb) + x] * 3072u; \
          S##ua[x] = ldb128(rU, o + (unsigned)lane * 16u); S##ub[x] = ldb64(rU, o + 1024u + (unsigned)lane * 8u); S##va[x] = ldb128(rU, o + 1536u + (unsigned)lane * 16u); S##vb[x] = ldb64(rU, o + 2560u + (unsigned)lane * 8u); } } while (0)
#define PEER_DEC(A, B) ({ v32f_t r_ = __builtin_amdgcn_cvt_scalef32_pk32_f32_fp6((v6u_t){A.x, A.y, A.z, A.w, B.x, B.y}, 1.0f); asm volatile("s_nop 1" : "+v"(r_)); r_; })
#define PEER_COMPUTE(S, kb) do { float d[NX]; \
          _Pragma("unroll") for (int x = 0; x < NX; ++x) { const v32f_t r = PEER_DEC(S##ua[x], S##ub[x]); float dd = 0.f; \
              _Pragma("unroll") for (int i = 0; i < 32; ++i) fmac1(dd, hn[i], r[i]); \
              d[x] = dd; } \
          _Pragma("unroll") for (int o = 1; o < 64; o <<= 1) { _Pragma("unroll") for (int x = 0; x < NX; ++x) d[x] += __shfl_xor(d[x], o); } \
          float c[NX]; \
          _Pragma("unroll") for (int x = 0; x < NX; ++x) c[x] = SG[tl * 128 + (kb) + x] * gelu_tanh(d[x] * (1.f / 64.f)) * 0.25f; \
          _Pragma("unroll") for (int x = 0; x < NX; ++x) { const v32f_t r = PEER_DEC(S##va[x], S##vb[x]); \
              _Pragma("unroll") for (int i = 0; i < 32; ++i) fmac1(acc[i], c[x], r[i]); } } while (0)
      { u32x4 Aua[NX], Ava[NX], Bua[NX], Bva[NX]; u32x2 Aub[NX], Avb[NX], Bub[NX], Bvb[NX];
        PEER_LOAD(A, 0);
#pragma unroll 1
        for (int k = 0; k < 128; k += 2 * NX) {
            PEER_LOAD(B, k + NX); PEER_COMPUTE(A, k);
            { const int kn = min(k + 2 * NX, 128 - NX); PEER_LOAD(A, kn); }
            PEER_COMPUTE(B, k + NX);
        } }
#undef PEER_DEC
#undef NX
#undef PEER_LOAD
#undef PEER_COMPUTE
      asm volatile("" ::: "memory");
      int tok2 = tok, lane2 = lane; asm volatile("" : "+v"(tok2), "+v"(lane2));
      float s2 = 0.f;
#pragma unroll
      for (int j = 0; j < 2; ++j)
#pragma unroll
          for (int q = 0; q < 4; ++q) { const f32x4 a = ldf128_nt(rH2, ((unsigned)tok2 * 2048u + 1024u * j + 16u * lane2 + 4u * q) * 4u);
#pragma unroll
              for (int i = 0; i < 4; ++i) { acc[16 * j + 4 * q + i] += a[i]; s2 += acc[16 * j + 4 * q + i] * acc[16 * j + 4 * q + i]; } }
      const float rf = 1.0f / sqrtf(wave_sum(s2) * (1.f / 2048.f) + NORM_EPS);
#pragma unroll
      for (int j = 0; j < 2; ++j)
#pragma unroll
          for (int q = 0; q < 4; ++q) { const f32x4 a = ldf128(rGF, (1024u * j + 16u * lane2 + 4u * q) * 4u); f32x4 oa;
#pragma unroll
              for (int i = 0; i < 4; ++i) oa[i] = acc[16 * j + 4 * q + i] * rf * a[i];
              float* op = OUT + (size_t)tok2 * 2048 + 1024 * j + 16 * lane2 + 4 * q;
              __builtin_nontemporal_store(oa, (GAS f32x4*)op); }
    }
}
}
#ifndef MK_N_LAUNCHES
#define MK_N_LAUNCHES 1
#endif
constexpr int N_PHASES = 9;
constexpr int N_LAUNCHES = MK_N_LAUNCHES;
struct Args { const float* in[19]; float* out; unsigned char* ws; int ph_lo, ph_hi; };
static_assert(sizeof(Args) == 19 * 8 + 8 + 8 + 8, "no padding");

__global__ void __launch_bounds__(NWAVES * 64, 2) hybrid_fwd(Args args) {
    extern __shared__ __attribute__((aligned(16))) unsigned char lds_raw[];
    Frame F;
    F.lds = (LAS unsigned char*)lds_raw;
    F.MISC = (volatile LAS unsigned*)(F.lds + MISC_OFF);
    F.tid = threadIdx.x; F.lane = F.tid & 63; F.wave = __builtin_amdgcn_readfirstlane(F.tid >> 6);
    F.G = gridDim.x; { const int bx = blockIdx.x; F.vcu = (F.G % 8 == 0) ? (bx % 8) * (F.G / 8) + bx / 8 : bx; }
    F.ws = args.ws; F.out = args.out;
#pragma unroll
    for (int i = 0; i < 19; ++i) F.in[i] = args.in[i];
    for (int u = F.tid; u < (LDS_BYTES - LDSCTL_OFF) / 4; u += NWAVES * 64) ((LAS unsigned*)(F.lds + LDSCTL_OFF))[u] = 0u;
    __syncthreads();
    XcdBarrier bar; bar.bar = (unsigned*)(F.ws + WS_CTL) + CW_BAR; bar.x = 0; bar.st = nullptr;
    if (N_LAUNCHES == 1) bar = xcd_barrier_post((unsigned*)(F.ws + WS_CTL) + CW_BAR, F.MISC + 8);
    const int lo = args.ph_lo, hi = args.ph_hi;
#define IN(k) (lo <= (k) && (k) < hi)
#define SEAM(k) do { if (IN(k) && IN((k) + 1)) xcd_barrier(bar); } while (0)
    const size_t T2048 = (size_t)256 * 2048 * 2, T1024 = (size_t)256 * 1024 * 2, T512 = (size_t)256 * 512 * 2;
    float* cosT = WSP(float, WS_COS); float* sinT = WSP(float, WS_SIN);
    float* ssq_q = WSP(float, WS_SSQ_Q); float* ssq_kv = WSP(float, WS_SSQ_KV); float* ssq2 = WSP(float, WS_SSQ_2);

    if (IN(0)) { p0_prologue<0>(F, F.vcu, F.G); } SEAM(0);
    if (IN(1)) {
        SchedP1 S{F.G, (int)blockIdx.x, (const char*)(F.ws + WS_HN1), (const char*)(F.ws + WS_WIN), (const char*)(F.ws + WS_WVT), T1024};
        EpiP1 E{WSP(bf16_t, WS_NAQ), WSP(bf16_t, WS_NAK), WSP(bf16_t, WS_VT), WSP(bf16_t, WS_CQ), WSP(bf16_t, WS_CKV), WSP(bf16_t, WS_KR), WSP(bf16_t, WS_GA), WSP(bf16_t, WS_GB), ssq_q, ssq_kv, cosT, sinT};
        pg8::gemm_phase<EpiP1, SchedP1, true, -6>(F.lds, 2048, S, E);
        { const int extra = P1_UNITS % F.G, bx = (int)blockIdx.x; if (extra != 0 && bx >= extra) p0_prologue<1>(F, bx - extra, F.G - extra); else if (extra == 0) p0_prologue<1>(F, bx, F.G); }
    } SEAM(1);
    if (IN(2)) {
        LAS float* relb = (LAS float*)F.lds + 64; LAS float* metab = relb + 16 * 15 * 31 + 128; LAS float* wsf = metab + 256 + F.wave * 64;
        for (int i = F.tid; i < 16 * 15 * 31; i += NWAVES * 64) relb[i] = F.in[4][i];
        if (F.tid < 256) metab[F.tid] = F.in[5][F.tid];
        __syncthreads();
        const int gw = F.vcu * NWAVES + F.wave, NGW = F.G * NWAVES;
        for (int task = gw; task < NBATCH * 16 * 32 * 2; task += NGW)
            att::na_task(task, WSP(bf16_t, WS_NAQ), WSP(bf16_t, WS_NAK), WSP(bf16_t, WS_VT), WSP(unsigned char, WS_ONA), relb, metab, wsf, F.lane);
        __syncthreads();
    } SEAM(2);
    if (IN(3)) {
        SchedP3 S{F.G, (int)blockIdx.x, (const char*)(F.ws + WS_CQ), (const char*)(F.ws + WS_CKV), (const char*)(F.ws + WS_WUQ), (const char*)(F.ws + WS_WUKV), T512};
        EpiP3 E{WSP(bf16_t, WS_QM), WSP(bf16_t, WS_KN), WSP(bf16_t, WS_VV), ssq_q, ssq_kv, cosT, sinT};
        pg8::gemm_phase<EpiP3, SchedP3>(F.lds, 512, S, E);
    } SEAM(3);
    if (IN(4)) {
        for (int id = F.vcu; id < NBATCH * 16 * 8; id += F.G) { const int bh = id >> 3, qb = id & 7;
            att::mla_unit(bh >> 4, bh & 15, qb, WSP(bf16_t, WS_QM), WSP(bf16_t, WS_KN), WSP(bf16_t, WS_KR), WSP(bf16_t, WS_VV), WSP(unsigned char, WS_OMLA), (LAS char*)F.lds); }
        __syncthreads();
    } SEAM(4);
    if (IN(5)) {
        { SchedGrid S{F.G, (int)blockIdx.x, 64, 8, (const char*)(F.ws + WS_ONA), (const char*)(F.ws + WS_WNA), T512};
          EpiP5a E{WSP(bf16_t, WS_GA), WSP(bf16_t, WS_T1)};
          pg8::gemm_phase<EpiP5a, SchedGrid, true, -9>(F.lds, 1024, S, E); }
        { SchedGrid S{F.G, (int)blockIdx.x, 64, 8, (const char*)(F.ws + WS_OMLA), (const char*)(F.ws + WS_WMLA), T1024};
          EpiP5b E{WSP(bf16_t, WS_GB), WSP(bf16_t, WS_T1), WSP(unsigned char, WS_MERGED)};
          pg8::gemm_phase<EpiP5b, SchedGrid, true, -11>(F.lds, 2048, S, E); }
    } SEAM(5);
    if (IN(6)) {
        { SchedGrid S{F.G, (int)blockIdx.x, 64, 8, (const char*)(F.ws + WS_MERGED), (const char*)(F.ws + WS_WOUT), T1024};
          EpiP6 E{F.in[0], WSP(float, WS_H2), WSP(bf16_t, WS_H2B), ssq2};
          pg8::gemm_phase<EpiP6, SchedGrid, true, -11>(F.lds, 2048, S, E); }
        {
          for (unsigned i = (unsigned)F.vcu * 512u + F.tid; i < 2u * 16384u * 64u; i += (unsigned)F.G * 512u) { const unsigned isv = i >> 20, row = (i >> 6) & 16383u, l = i & 63u; const float sc = isv ? 4.f : 64.f;
              const float* src = (isv ? F.in[17] : F.in[16]) + (size_t)row * 2048 + 16 * l; peer::v16f_t a, b;
#pragma unroll
              for (int q = 0; q < 4; ++q) { const f32x4 x0 = *(const GAS f32x4*)(src + 4 * q) * sc, x1 = *(const GAS f32x4*)(src + 1024 + 4 * q) * sc;
#pragma unroll
                  for (int e = 0; e < 4; ++e) { const int k0_ = 4 * q + e, k1_ = 16 + 4 * q + e;
                      if (k0_ & 1) b[k0_ >> 1] = x0[e]; else a[k0_ >> 1] = x0[e];
                      if (k1_ & 1) b[k1_ >> 1] = x1[e]; else a[k1_ >> 1] = x1[e]; } }
              const peer::v6u_t w = __builtin_amdgcn_cvt_scalef32_2xpk16_fp6_f32(a, b, 1.0f);
              unsigned char* rec = WSP(unsigned char, WS_U) + (size_t)row * 3072 + (isv ? 1536 : 0);
              *(GAS u32x4*)(rec + l * 16) = (u32x4){w[0], w[1], w[2], w[3]}; *(GAS u32x2*)(rec + 1024 + l * 8) = (u32x2){w[4], w[5]}; } }
    } SEAM(6);
    if (IN(7)) {
        SchedGrid S{F.G, (int)blockIdx.x, 64, 8, (const char*)(F.ws + WS_H2B), (const char*)(F.ws + WS_WSC), T2048};
        EpiP7 E{ssq2, WSP(float, WS_SC)};
        pg8::gemm_phase<EpiP7, SchedGrid>(F.lds, 2048, S, E);
    } SEAM(7);
    if (IN(8)) {
        for (int chunk = F.vcu; chunk < MREAL / peer::CH; chunk += F.G)
            peer::peer_chunk(chunk, WSP(float, WS_SC), WSP(float, WS_H2), WSP(unsigned char, WS_U), WSP(unsigned char, WS_V), F.in[13], F.in[18], F.out, (LAS char*)F.lds, F.tid);
    }
#undef IN
#undef SEAM
}

extern "C" void kernel_launch(void* const* d_in, const int* in_sizes, int n_in, void* d_out, int out_size, void* d_ws, size_t ws_size, hipStream_t stream) {
    static int grid = 0;
    if (grid == 0) {
        if (n_in != 19 || in_sizes[0] != MREAL * DM || out_size != MREAL * DM || ws_size < WS_END) {
            fprintf(stderr, "kernel_launch: shape/workspace mismatch: n_in %d in0 %d out %d ws %zu (need %zu); nothing launched\n", n_in, n_in > 0 ? in_sizes[0] : -1, out_size, ws_size, (size_t)WS_END); grid = -1; return; }
        int dev = 0, cus = 0, per_cu = 0;
        if (hipGetDevice(&dev) != hipSuccess || hipDeviceGetAttribute(&cus, hipDeviceAttributeMultiprocessorCount, dev) != hipSuccess) { fprintf(stderr, "kernel_launch: device query failed\n"); grid = -1; return; }
        if (hipFuncSetAttribute((const void*)hybrid_fwd, hipFuncAttributeMaxDynamicSharedMemorySize, LDS_BYTES) != hipSuccess) { fprintf(stderr, "kernel_launch: hipFuncSetAttribute failed\n"); grid = -1; return; }
        if (hipOccupancyMaxActiveBlocksPerMultiprocessor(&per_cu, (const void*)hybrid_fwd, NWAVES * 64, LDS_BYTES) != hipSuccess || per_cu < 1)
            fprintf(stderr, "kernel_launch: note: occupancy query reports %d workgroups per CU\n", per_cu);
        (void)hipGetLastError();
        grid = cus;
    }
    if (grid < 0) return;
    if (hipMemsetAsync((char*)d_ws + WS_CTL, 0, CTL_ZERO_BYTES, stream) != hipSuccess) { fprintf(stderr, "kernel_launch: hipMemsetAsync failed\n"); return; }
    Args a{};
    for (int i = 0; i < 19; ++i) a.in[i] = (const float*)d_in[i];
    a.out = (float*)d_out; a.ws = (unsigned char*)d_ws;
    for (int li = 0; li < N_LAUNCHES; ++li) {
        a.ph_lo = (N_LAUNCHES == 1) ? 0 : li; a.ph_hi = (N_LAUNCHES == 1) ? N_PHASES : li + 1;
        hipLaunchKernelGGL(hybrid_fwd, dim3(grid), dim3(NWAVES * 64), LDS_BYTES, stream, a);
        const hipError_t le = hipPeekAtLastError();
        if (le != hipSuccess) { fprintf(stderr, "kernel_launch: launch %d failed: %s\n", li, hipGetErrorName(le)); break; }
    }
}
```

```cpp
#include <hip/hip_runtime.h>
#include <cstdio>
#include <cstdint>

#define LAS __attribute__((address_space(3)))
#define GAS __attribute__((address_space(1)))
typedef unsigned short bf16_t;
typedef short bf16x8 __attribute__((ext_vector_type(8)));
typedef short s16x4 __attribute__((ext_vector_type(4)));
typedef float f32x4 __attribute__((ext_vector_type(4)));
typedef float f32x2 __attribute__((ext_vector_type(2)));
typedef float f32x16 __attribute__((ext_vector_type(16)));
typedef unsigned u32x4 __attribute__((ext_vector_type(4)));
typedef unsigned u32x2 __attribute__((ext_vector_type(2)));

constexpr int DM = 2048, NBATCH = 8, SEQ = 2048, NMETA = 16;
constexpr int MREAL = NBATCH * SEQ;
constexpr int MPAD = MREAL + 256;
constexpr int NPOS = SEQ + NMETA;
constexpr float NORM_EPS = 1e-6f;
constexpr int C_NAQ = 0, C_NAK = 1024, C_CQ = 2048, C_CKV = 2560, C_GA = 3072, C_GB = 5120, C_KR = 7168, NMAIN = 7424;
constexpr int VT_PITCH = MPAD;

constexpr size_t MiB = 1u << 20;
constexpr size_t WS_CTL = 0, CTL_ZERO_BYTES = 1 * MiB;
constexpr size_t WS_SSQ_Q = 481 * MiB, WS_SSQ_KV = 482 * MiB, WS_SSQ_2 = 486 * MiB;
constexpr size_t WS_COS = 1 * MiB, WS_SIN = 1 * MiB + 512 * 1024;
constexpr size_t WS_WUQ = 2 * MiB, WS_WUKV = 5 * MiB, WS_WNA = 9 * MiB, WS_WMLA = 13 * MiB, WS_WOUT = 21 * MiB, WS_WSC = 29 * MiB;
constexpr size_t WS_GA = 37 * MiB, WS_GB = 101 * MiB;
constexpr size_t WS_KR = 165 * MiB;
constexpr size_t WS_WIN = 167 * MiB + 256 * 1024, WS_WVT = WS_WIN + 29 * MiB;
constexpr size_t WS_ONA = 190 * MiB;
constexpr size_t WS_NAQ = 222 * MiB, WS_NAK = 254 * MiB, WS_VT = WS_NAK + 32 * MiB + 512 * 1024;
constexpr size_t WS_HN1 = 319 * MiB;
constexpr size_t WS_CQ = 448 * MiB, WS_CKV = 464 * MiB;
constexpr size_t WS_QM = 222 * MiB, WS_KN = 318 * MiB, WS_VV = 383 * MiB;
constexpr size_t WS_OMLA = 448 * MiB;
constexpr size_t WS_MERGED = 222 * MiB, WS_T1 = 286 * MiB;
constexpr size_t WS_H2 = 37 * MiB, WS_H2B = 293 * MiB;
constexpr size_t WS_U = 357 * MiB, WS_V = 421 * MiB;
constexpr size_t WS_SC = 165 * MiB;
constexpr size_t WS_END = 512 * MiB;
static_assert(WS_CKV + (size_t)MPAD * 512 * 2 <= WS_SSQ_Q && WS_SSQ_Q + (size_t)8 * MPAD * 4 <= WS_SSQ_KV && WS_SSQ_KV + (size_t)8 * MPAD * 4 <= 483 * MiB && WS_V + 64 * MiB <= WS_SSQ_2 && WS_SSQ_2 + (size_t)32 * MREAL * 4 <= WS_END, "ssq slabs");
static_assert(WS_VT + (size_t)1024 * MPAD * 2 <= WS_HN1 && WS_HN1 + (size_t)MPAD * 2048 * 2 <= WS_CQ && WS_CKV + (size_t)MPAD * 512 * 2 <= WS_END, "map P1");
static_assert(WS_WVT + 4 * MiB <= WS_NAQ && WS_KR + (size_t)MPAD * 64 * 2 <= WS_WIN && WS_ONA + 32 * MiB <= WS_NAQ, "map P1b");
static_assert(WS_QM + 96 * MiB <= WS_KN && WS_KN + 65 * MiB <= WS_VV && WS_VV + 65 * MiB <= WS_OMLA && WS_OMLA + 64 * MiB <= WS_END, "map P3");
static_assert(WS_T1 + 128 * MiB <= WS_OMLA && WS_H2 + 128 * MiB <= WS_KR && WS_SC + 128 * MiB <= WS_H2B && WS_H2B + 64 * MiB <= WS_U && WS_V + 64 * MiB <= WS_END, "map P5+");

constexpr int CW_BAR = 4096, CW_FLAG = 0, CW_DONE = 64;
constexpr unsigned CTL_MAGIC = 0x5EED600Du;

constexpr int RING_BYTES = 131072;
constexpr int LDSCTL_OFF = RING_BYTES, MISC_OFF = LDSCTL_OFF + 320;
constexpr int LDS_BYTES = 147456;
constexpr int NWAVES = 8;

#define LDS_WAIT() asm volatile("s_waitcnt lgkmcnt(0)" ::: "memory")
#define VM_WAIT() asm volatile("s_waitcnt vmcnt(0)" ::: "memory")
#define SBAR() __builtin_amdgcn_sched_barrier(0)
typedef __bf16 bf16x2_t __attribute__((ext_vector_type(2)));
__device__ __forceinline__ unsigned cvt_pk_bf16(float lo, float hi) { const f32x2 v = {lo, hi}; const bf16x2_t b = __builtin_convertvector(v, bf16x2_t); return __builtin_bit_cast(unsigned, b); }
__device__ __forceinline__ float bf_lo(unsigned w) { return __uint_as_float(w << 16); }
__device__ __forceinline__ float bf_hi(unsigned w) { return __uint_as_float(w & 0xffff0000u); }
__device__ __forceinline__ u32x4 pack8(const f32x4 a, const f32x4 b) { u32x4 w; w.x = cvt_pk_bf16(a[0], a[1]); w.y = cvt_pk_bf16(a[2], a[3]); w.z = cvt_pk_bf16(b[0], b[1]); w.w = cvt_pk_bf16(b[2], b[3]); return w; }
__device__ __forceinline__ u32x2 pack8_fp8(f32x4 a, f32x4 b) {
#pragma unroll
    for (int i = 0; i < 4; ++i) { a[i] = __builtin_fminf(__builtin_fmaxf(a[i], -448.f), 448.f); b[i] = __builtin_fminf(__builtin_fmaxf(b[i], -448.f), 448.f); }
    int w0 = 0, w1 = 0; w0 = __builtin_amdgcn_cvt_pk_fp8_f32(a[0], a[1], w0, false); w0 = __builtin_amdgcn_cvt_pk_fp8_f32(a[2], a[3], w0, true);
    w1 = __builtin_amdgcn_cvt_pk_fp8_f32(b[0], b[1], w1, false); w1 = __builtin_amdgcn_cvt_pk_fp8_f32(b[2], b[3], w1, true); return (u32x2){(unsigned)w0, (unsigned)w1}; }
__device__ __forceinline__ unsigned char f32_to_fp8(float x) { x = __builtin_fminf(__builtin_fmaxf(x, -448.f), 448.f); return (unsigned char)(__builtin_amdgcn_cvt_pk_fp8_f32(x, 0.f, 0, false) & 0xff); }
__device__ __forceinline__ u32x2 pack4(const f32x4 a) { u32x2 w; w.x = cvt_pk_bf16(a[0], a[1]); w.y = cvt_pk_bf16(a[2], a[3]); return w; }
__device__ __forceinline__ float wave_sum(float v) {
#pragma unroll
    for (int o = 1; o < 64; o <<= 1) v += __shfl_xor(v, o);
    return v;
}
__device__ __forceinline__ float sigmoidf_(float x) { return __builtin_amdgcn_rcpf(1.0f + __builtin_amdgcn_exp2f(-1.4426950408889634f * x)); }
__device__ __forceinline__ int crow(int r, int hi) { return (r & 3) + 8 * (r >> 2) + 4 * hi; }
#define PG8_AUX 0
namespace pg8 {
constexpr int BM = 256, BK = 64, HALF = 128, HTB = HALF * BK * 2  , STAGE_BYTES = 8 * HTB, NXCD = 8, WGM = 8;
__host__ __device__ __forceinline__ int lds_byte(int r, int c) { const int st = (r >> 4) * 2 + (c >> 5), rr = r & 15, cc = c & 31, ob = rr * 64 + cc * 2; return st * 1024 + (ob ^ (((ob >> 9) & 1) << 5)); }
__host__ __device__ __forceinline__ void stage_rc(int b, int& R, int& C) { const int st = b / 1024, sb = b % 1024, swz = sb ^ (((sb >> 9) & 1) << 5); R = (st >> 1) * 16 + swz / 64; C = (st & 1) * 32 + (swz % 64) / 2; }
__host__ __device__ __forceinline__ int perm32(int rho) { const int n = rho >> 4, i = rho & 15; return 8 * (i >> 2) + 4 * n + (i & 3); }

struct Unit { int pm, pn, kind; };

__device__ __forceinline__ void grid_order(int L, int nM, int nN, int& pm, int& pn) {
    const int nwg = nM * nN; int wgid = L;
    { const int q = nwg / NXCD, r = nwg % NXCD, xcd = wgid % NXCD, off = wgid / NXCD; wgid = (xcd < r ? xcd * (q + 1) : r * (q + 1) + (xcd - r) * q) + off; }
    const int nig = WGM * nN, gid = wgid / nig, fm = gid * WGM, gsz = (nM - fm) < WGM ? (nM - fm) : WGM;
    pm = fm + ((wgid % nig) % gsz); pn = (wgid % nig) / gsz;
}

typedef int v8i_t __attribute__((ext_vector_type(8)));
template <class Epi, class Sched, bool F8 = false, int F8_SCALE_EXP = 0>
__device__ __forceinline__ void gemm_phase(LAS unsigned char* lds, const int K, const Sched& S, const Epi& E) {
    const int tid = threadIdx.x, wid = __builtin_amdgcn_readfirstlane(tid >> 6), lane = tid & 63, wr = wid >> 2, wc = wid & 3, fr = lane & 15, fq = lane >> 4;
    int f8sa = 0x01010101 * (127 + F8_SCALE_EXP), f8sb = 0x7f7f7f7f; asm volatile("" : "+v"(f8sa), "+v"(f8sb));
    const int Kb = F8 ? K : 2 * K;
    const int nt = Kb / 128;
    unsigned voffA[2], voffB[2];
#pragma unroll
    for (int i = 0; i < 2; ++i) { int R, C; stage_rc(tid * 16 + i * 8192, R, C); const int Rb = Epi::PERM ? ((R & ~31) + perm32(R & 31)) : R;
        voffA[i] = (unsigned)(R * Kb + C * 2); voffB[i] = (unsigned)(Rb * Kb + C * 2); }
    const size_t kstep = (size_t)128;
    const size_t hstep = (size_t)HALF * Kb;
    const unsigned ldsw = (unsigned)wid * 1024u;
    const int aoff = lds_byte(wr * 64 + fr, F8 ? fq * 16 : fq * 8), boff = lds_byte(wc * 32 + fr, F8 ? fq * 16 : fq * 8);
#define PG8_SA(b, h) (((b) * 2 + (h)) * HTB)
#define PG8_SB(b, h) ((4 + (b) * 2 + (h)) * HTB)
#define PG8_STAGE(bufoff, gbase, voff) do { _Pragma("unroll") for (int _i = 0; _i < 2; ++_i) \
        __builtin_amdgcn_global_load_lds((const unsigned*)((const char*)(gbase) + (voff)[_i]), (LAS unsigned*)(lds + (bufoff) + ldsw + _i * 8192), 16, 0, PG8_AUX); } while (0)
#define PG8_LDA(dst, b, h) do { _Pragma("unroll") for (int m = 0; m < 4; ++m) _Pragma("unroll") for (int k = 0; k < 2; ++k) dst[m][k] = *(const LAS bf16x8*)(lds + PG8_SA(b, h) + aoff + m * 2048 + (F8 ? k * 16 : k * 1024)); } while (0)
#define PG8_LDB(dst, b, h) do { _Pragma("unroll") for (int n = 0; n < 2; ++n) _Pragma("unroll") for (int k = 0; k < 2; ++k) dst[n][k] = *(const LAS bf16x8*)(lds + PG8_SB(b, h) + boff + n * 2048 + (F8 ? k * 16 : k * 1024)); } while (0)
#define PG8_F8OP(X) __builtin_bit_cast(v8i_t, __builtin_shufflevector(X[0], X[1], 0, 1, 2, 3, 4, 5, 6, 7, 8, 9, 10, 11, 12, 13, 14, 15))
#define PG8_MMA(ai, bj, At, Bt) do { __builtin_amdgcn_s_setprio(1); \
        if constexpr (F8) { _Pragma("unroll") for (int m = 0; m < 4; ++m) _Pragma("unroll") for (int n = 0; n < 2; ++n) \
            asm volatile("v_mfma_scale_f32_16x16x128_f8f6f4 %0, %1, %2, %0, %3, %4 op_sel_hi:[0,0,0]" : "+v"(acc[ai][bj][m][n]) : "v"(PG8_F8OP(Bt[n])), "v"(PG8_F8OP(At[m])), "v"(f8sa), "v"(f8sb)); } \
        else { _Pragma("unroll") for (int m = 0; m < 4; ++m) _Pragma("unroll") for (int n = 0; n < 2; ++n) _Pragma("unroll") for (int k = 0; k < 2; ++k) \
            acc[ai][bj][m][n] = __builtin_amdgcn_mfma_f32_16x16x32_bf16(Bt[n][k], At[m][k], acc[ai][bj][m][n], 0, 0, 0); } \
        __builtin_amdgcn_s_setprio(0); } while (0)
#define PG8_WAIT_V(n) asm volatile("s_waitcnt vmcnt(" #n ")" ::: "memory")
#define PG8_WAIT_L(n) asm volatile("s_waitcnt lgkmcnt(" #n ")" ::: "memory")
#define PG8_BAR __builtin_amdgcn_s_barrier()
#define PG8_SCHED __builtin_amdgcn_sched_barrier(0)
    Unit cur, nxt; int ui = 0;
    if (!S.next(0, cur)) return;
    f32x4 acc[2][2][4][2];
#pragma unroll
    for (int a = 0; a < 2; ++a)
#pragma unroll
        for (int b = 0; b < 2; ++b)
#pragma unroll
            for (int m = 0; m < 4; ++m)
#pragma unroll
                for (int n = 0; n < 2; ++n) acc[a][b][m][n] = (f32x4){0.f, 0.f, 0.f, 0.f};
    bf16x8 At[4][2], B0[2][2], B1[2][2];
    const char* cA = S.pa(cur); const char* cB = S.pb(cur);
    PG8_STAGE(PG8_SB(0, 0), cB, voffB); PG8_STAGE(PG8_SB(0, 1), cB + hstep, voffB); PG8_STAGE(PG8_SA(0, 0), cA, voffA); PG8_STAGE(PG8_SA(0, 1), cA + hstep, voffA);
    if (wr == 1) PG8_BAR;
    PG8_WAIT_V(2); PG8_BAR;
    PG8_STAGE(PG8_SB(1, 0), cB + kstep, voffB); PG8_STAGE(PG8_SA(1, 0), cA + kstep, voffA); PG8_STAGE(PG8_SB(1, 1), cB + hstep + kstep, voffB);
    PG8_WAIT_V(6); PG8_BAR;
    for (;;) {
        const bool has_next = S.next(ui + 1, nxt);
        const char* nA = has_next ? S.pa(nxt) : cA; const char* nB = has_next ? S.pb(nxt) : cB;
        for (int t = 0; t < nt; t += 2) {
            const bool last = (t == nt - 2);
            const char* a1 = cA + (size_t)(t + 1) * kstep;
            const char* a2 = last ? nA : cA + (size_t)(t + 2) * kstep; const char* b2 = last ? nB : cB + (size_t)(t + 2) * kstep;
            const char* a3 = a2 + kstep; const char* b3 = b2 + kstep;
            PG8_LDB(B0, 0, 0); PG8_LDB(B1, 0, 1); PG8_SCHED; PG8_LDA(At, 0, 0); PG8_STAGE(PG8_SA(1, 1), a1 + hstep, voffA);
            PG8_WAIT_V(8); PG8_WAIT_L(0); PG8_BAR; PG8_MMA(0, 0, At, B0); PG8_MMA(0, 1, At, B1); PG8_BAR; PG8_SCHED;
            PG8_LDA(At, 0, 1); PG8_STAGE(PG8_SB(0, 0), b2, voffB); PG8_STAGE(PG8_SB(0, 1), b2 + hstep, voffB); PG8_STAGE(PG8_SA(0, 0), a2, voffA);
            PG8_WAIT_V(8); PG8_WAIT_L(0); PG8_BAR; PG8_MMA(1, 0, At, B0); PG8_MMA(1, 1, At, B1); PG8_BAR; PG8_SCHED;
            PG8_LDB(B0, 1, 0); PG8_LDB(B1, 1, 1); PG8_SCHED; PG8_LDA(At, 1, 0); PG8_STAGE(PG8_SA(0, 1), a2 + hstep, voffA);
            PG8_WAIT_V(8); PG8_WAIT_L(0); PG8_BAR; PG8_MMA(0, 0, At, B0); PG8_MMA(0, 1, At, B1); PG8_BAR; PG8_SCHED;
            PG8_LDA(At, 1, 1); PG8_STAGE(PG8_SB(1, 0), b3, voffB); PG8_STAGE(PG8_SB(1, 1), b3 + hstep, voffB); PG8_STAGE(PG8_SA(1, 0), a3, voffA);
            PG8_WAIT_V(8); PG8_WAIT_L(0); PG8_BAR; PG8_MMA(1, 0, At, B0); PG8_MMA(1, 1, At, B1); PG8_BAR; PG8_SCHED;
        }
        if (wr == 0) PG8_BAR;
        if constexpr (F8) asm volatile("s_nop 15\n\ts_nop 7" ::: "memory");
        if constexpr (Epi::HAS_PRE) {
            E.pre(cur, (LAS float*)(lds + STAGE_BYTES + 1024), tid); PG8_WAIT_L(0); PG8_BAR; }
        E(acc, cur, wr, wc, fr, fq, (const LAS float*)(lds + STAGE_BYTES + 1024));
        if (!has_next) break;
#pragma unroll
        for (int a = 0; a < 2; ++a)
#pragma unroll
            for (int b = 0; b < 2; ++b)
#pragma unroll
                for (int m = 0; m < 4; ++m)
#pragma unroll
                    for (int n = 0; n < 2; ++n) acc[a][b][m][n] = (f32x4){0.f, 0.f, 0.f, 0.f};
        cur = nxt; cA = nA; cB = nB; ++ui;
        if (wr == 1) PG8_BAR;
    }
    PG8_WAIT_V(0);
    PG8_BAR;
#undef PG8_SA
#undef PG8_SB
#undef PG8_STAGE
#undef PG8_LDA
#undef PG8_LDB
#undef PG8_MMA
#undef PG8_F8OP
#undef PG8_WAIT_V
#undef PG8_WAIT_L
#undef PG8_BAR
#undef PG8_SCHED
}
}
typedef GAS unsigned gu32;
#define RLX_AGENT __ATOMIC_RELAXED, __HIP_MEMORY_SCOPE_AGENT
#define XB_TMO      128
#define XB_XCNT(j)  (256  + 64 * (j))
#define XB_XSUB(j)  (1280 + 64 * (j))
#define XB_XGEN(j)  (2304 + 64 * (j))
#define XB_TOP      3328
#define XB_TOPGEN   3392
#define XCD_BAR_WORDS 3456
#define XB_SPIN_CAP (1u << 18)
__device__ __forceinline__ unsigned xb_ld(unsigned* p)              { return __hip_atomic_load(p, __ATOMIC_RELAXED, __HIP_MEMORY_SCOPE_AGENT); }
__device__ __forceinline__ unsigned xb_add(unsigned* p, unsigned v) { return __hip_atomic_fetch_add(p, v, __ATOMIC_RELAXED, __HIP_MEMORY_SCOPE_AGENT); }
__device__ __forceinline__ unsigned xb_xcc_id() { return (unsigned)__builtin_amdgcn_s_getreg((3 << 11) | 20) & 0xFu; }
#define XB_SPIN(cond, bar) do { unsigned _sp = 0; while (cond) { __builtin_amdgcn_s_sleep(1); \
    if ((++_sp & 255u) == 0u) { if (xb_ld(&(bar)[XB_TMO])) break; if (_sp > XB_SPIN_CAP) { atomicAdd(&(bar)[XB_TMO], 1u); break; } } } } while (0)
struct XcdBarrier { unsigned* bar; unsigned x; volatile LAS unsigned* st; };
__device__ __forceinline__ XcdBarrier xcd_barrier_post(unsigned* bar, volatile LAS unsigned* st) {
    XcdBarrier b; b.bar = bar; b.x = xb_xcc_id(); b.st = st;
    if (threadIdx.x == 0) (void)xb_add(&bar[XB_XCNT(b.x)], 1u);
    return b;
}
__device__ __forceinline__ void xcd_barrier_complete(unsigned* bar, unsigned x, unsigned& nloc, unsigned& nx) {
    const unsigned G = gridDim.x * gridDim.y * gridDim.z;
    unsigned sum, cnt, mine, sp = 0u;
    for (;;) {
        sum = 0u; cnt = 0u; mine = 0u;
#pragma unroll
        for (unsigned j = 0; j < 16; ++j) { const unsigned c = xb_ld(&bar[XB_XCNT(j)]); sum += c; cnt += (c > 0u) ? 1u : 0u; mine = (j == x) ? c : mine; }
        if (sum == G) break;
        __builtin_amdgcn_s_sleep(1);
        if ((++sp & 255u) == 0u) { if (xb_ld(&bar[XB_TMO])) break; if (sp > XB_SPIN_CAP) { atomicAdd(&bar[XB_TMO], 1u); break; } }
    }
    nloc = mine > 0u ? mine : 1u; nx = cnt > 0u ? cnt : 1u;
}
__device__ __forceinline__ void xcd_barrier(const XcdBarrier& b) {
    asm volatile("s_waitcnt vmcnt(0)" ::: "memory");
    __syncthreads();
    if (threadIdx.x == 0) {
        unsigned* bar = b.bar;
        __builtin_amdgcn_s_waitcnt(0);
        unsigned nloc = b.st[0], nx = b.st[1];
        if (nloc == 0u) { xcd_barrier_complete(bar, b.x, nloc, nx); b.st[0] = nloc; b.st[1] = nx; }
        const unsigned old = xb_add(&bar[XB_XSUB(b.x)], 1u);
        const unsigned gen = old / nloc;
        if (old + 1u == (gen + 1u) * nloc) {
            __builtin_amdgcn_fence(__ATOMIC_RELEASE, "agent");
            asm volatile("s_waitcnt vmcnt(0)" ::: "memory");
            const unsigned og = xb_add(&bar[XB_TOP], 1u);
            const unsigned tg = og / nx;
            if (og + 1u == (tg + 1u) * nx) xb_add(&bar[XB_TOPGEN], 1u);
            else XB_SPIN(xb_ld(&bar[XB_TOPGEN]) == tg, bar);
            __builtin_amdgcn_fence(__ATOMIC_ACQUIRE, "agent");
            xb_add(&bar[XB_XGEN(b.x)], 1u);
            asm volatile("s_waitcnt vmcnt(0)" ::: "memory");
        } else {
            XB_SPIN(xb_ld(&bar[XB_XGEN(b.x)]) == gen, bar);
            __builtin_amdgcn_fence(__ATOMIC_ACQUIRE, "agent");
            asm volatile("s_waitcnt vmcnt(0)" ::: "memory");
        }
    }
    __syncthreads();
}
struct Frame {
    LAS unsigned char* lds;
    volatile LAS unsigned* MISC;
    unsigned char* ws;
    int tid, lane, wave;
    int vcu, G;
    const float* in[19];
    float* out;
};
#define WSP(T, off) ((T*)(F.ws + (off)))

__device__ __forceinline__ void p0_transpose_item(const float* W, int K, int N, int k0, int n0, bf16_t* WT, int drow, bool rope, const float* gain, LAS float* scr, int lane) {
    { f32x4 v[8]; float gk[8];
#pragma unroll
      for (int i = 0; i < 8; ++i) { const int kk = 8 * i + (lane >> 3); v[i] = *(const GAS f32x4*)(W + (size_t)(k0 + kk) * N + n0 + 4 * (lane & 7)); gk[i] = gain ? gain[k0 + kk] : 1.f; }
#pragma unroll
      for (int i = 0; i < 8; ++i) { const int kk = 8 * i + (lane >> 3); LAS float* d = scr + kk * 33 + 4 * (lane & 7);
#pragma unroll
          for (int e = 0; e < 4; ++e) d[e] = v[i][e] * gk[i]; } }
    LDS_WAIT(); asm volatile("" ::: "memory");
    const int c = lane & 7;
#pragma unroll
    for (int j = 0; j < 4; ++j) { const int n = (lane >> 3) + 8 * j; const LAS float* s = scr + (8 * c) * 33 + n;
        u32x4 o; o.x = cvt_pk_bf16(s[0 * 33], s[1 * 33]); o.y = cvt_pk_bf16(s[2 * 33], s[3 * 33]); o.z = cvt_pk_bf16(s[4 * 33], s[5 * 33]); o.w = cvt_pk_bf16(s[6 * 33], s[7 * 33]);
        const int dr = drow + (rope ? (8 * (n >> 2) + (n & 3)) : n);
        *(GAS u32x4*)(WT + (size_t)dr * K + k0 + 8 * c) = o; }
    LDS_WAIT(); asm volatile("" ::: "memory");
}
__device__ __forceinline__ void p0_transpose_item8(const float* W, int K, int N, int k0, int n0, unsigned char* WT, int drow, bool rope, float scale, LAS float* scr, int lane, const float* gain = nullptr) {
    { f32x4 v[8]; float gk[8];
#pragma unroll
      for (int i = 0; i < 8; ++i) { const int kk = 8 * i + (lane >> 3); v[i] = *(const GAS f32x4*)(W + (size_t)(k0 + kk) * N + n0 + 4 * (lane & 7)); gk[i] = gain ? gain[k0 + kk] * scale : scale; }
#pragma unroll
      for (int i = 0; i < 8; ++i) { const int kk = 8 * i + (lane >> 3); LAS float* d = scr + kk * 33 + 4 * (lane & 7);
#pragma unroll
          for (int e = 0; e < 4; ++e) d[e] = v[i][e] * gk[i]; } }
    LDS_WAIT(); asm volatile("" ::: "memory");
#pragma unroll
    for (int j = 0; j < 2; ++j) { const int q = lane + 64 * j, n = q >> 2, c = q & 3; const LAS float* s = scr + (16 * c) * 33 + n; u32x4 o;
#pragma unroll
        for (int d = 0; d < 4; ++d) { int w = 0; w = __builtin_amdgcn_cvt_pk_fp8_f32(s[(4 * d) * 33], s[(4 * d + 1) * 33], w, false); w = __builtin_amdgcn_cvt_pk_fp8_f32(s[(4 * d + 2) * 33], s[(4 * d + 3) * 33], w, true); o[d] = (unsigned)w; }
        const int dr = drow + (rope ? (8 * (n >> 2) + (n & 3)) : n);
        *(GAS u32x4*)(WT + (size_t)dr * K + k0 + 16 * c) = o; }
    LDS_WAIT(); asm volatile("" ::: "memory");
}
__device__ __forceinline__ void rms_row_to_fp8(const float* xrow, const float* g, unsigned char* orow, int lane) {
    const GAS f32x4* xr = (const GAS f32x4*)xrow + lane; const GAS f32x4* gr = (const GAS f32x4*)g + lane;
    f32x4 v[8]; float s = 0.f;
#pragma unroll
    for (int j = 0; j < 8; ++j) { v[j] = xr[64 * j]; s += (v[j].x * v[j].x + v[j].y * v[j].y) + (v[j].z * v[j].z + v[j].w * v[j].w); }
    const float rstd = 1.0f / sqrtf(wave_sum(s) * (1.f / DM) + NORM_EPS);
    GAS unsigned* o4 = (GAS unsigned*)orow + lane;
#pragma unroll
    for (int j = 0; j < 8; ++j) { const f32x4 y = (v[j] * rstd) * gr[64 * j]; int w = 0; w = __builtin_amdgcn_cvt_pk_fp8_f32(y[0], y[1], w, false); w = __builtin_amdgcn_cvt_pk_fp8_f32(y[2], y[3], w, true); o4[64 * j] = (unsigned)w; }
}
__device__ __forceinline__ void rms_row_to_bf16(const float* xrow, const float* g, bf16_t* orow, int lane) {
    const GAS f32x4* xr = (const GAS f32x4*)xrow + lane; const GAS f32x4* gr = (const GAS f32x4*)g + lane;
    f32x4 v[8]; float s = 0.f;
#pragma unroll
    for (int j = 0; j < 8; ++j) { v[j] = xr[64 * j]; s += (v[j].x * v[j].x + v[j].y * v[j].y) + (v[j].z * v[j].z + v[j].w * v[j].w); }
    const float rstd = 1.0f / sqrtf(wave_sum(s) * (1.f / DM) + NORM_EPS);
    GAS u32x2* o8 = (GAS u32x2*)orow + lane;
#pragma unroll
    for (int j = 0; j < 8; ++j) { const f32x4 gg = gr[64 * j]; o8[64 * j] = pack4((v[j] * rstd) * gg); }
}
template <int PART>
__device__ __forceinline__ void p0_prologue(Frame& F, int rank, int nrank) {
    LAS float* scr = (LAS float*)(F.lds + F.wave * 16384);
    const int gw = rank * NWAVES + F.wave, NGW = nrank * NWAVES, lane = F.lane; const int gt = rank * 512 + F.tid, NGT = nrank * 512;
    unsigned char* WIN = WSP(unsigned char, WS_WIN); unsigned char* WVT = WSP(unsigned char, WS_WVT);
    constexpr int I_IN = 32 * 258, I_UQ = 8 * 96, I_UKV = 8 * 128, I_NA = 16 * 64, I_MLA = 32 * 64, I_OUT = 32 * 64;
    constexpr int NEARLY = I_IN + I_UQ + I_UKV, NITEMS = NEARLY + I_NA + I_MLA + I_OUT;
    for (int it = (PART == 0 ? 0 : NEARLY) + gw; it < (PART == 0 ? NEARLY : NITEMS); it += NGW) {
        int r = it;
        if (r < I_IN) { const int kb = r / 258, sb = r % 258, n0 = 32 * sb, k0 = 64 * kb; const float* W = F.in[3];
            unsigned char* dst = WIN; int drow; bool rope = false;
            if (n0 < 1024) drow = C_NAQ + n0;
            else if (n0 < 2048) drow = C_NAK + (n0 - 1024);
            else if (n0 < 3072) { dst = WVT; drow = n0 - 2048; }
            else if (n0 < 3584) drow = C_CQ + (n0 - 3072);
            else if (n0 < 4096) drow = C_CKV + (n0 - 3584);
            else if (n0 < 4160) { drow = C_KR + ((n0 - 4096) ? 4 : 0); rope = true; }
            else if (n0 < 6208) drow = C_GA + (n0 - 4160);
            else drow = C_GB + (n0 - 6208);
            p0_transpose_item8(W, 2048, 8256, k0, n0, dst, drow, rope, 64.f, scr, lane); continue; } r -= I_IN;
        if (r < I_UQ) { const int kb = r / 96, sb = r % 96, n0 = 32 * sb, k0 = 64 * kb; const int hd = n0 / 192, w = n0 % 192;
            int drow = n0; bool rope = false; if (w >= 128) { rope = true; drow = hd * 192 + 128 + ((w - 128) ? 4 : 0); }
            p0_transpose_item8(F.in[7], 512, 3072, k0, n0, WSP(unsigned char, WS_WUQ), drow, rope, 16.f, scr, lane, F.in[6]); continue; } r -= I_UQ;
        if (r < I_UKV) { const int kb = r / 128, sb = r % 128; p0_transpose_item8(F.in[9], 512, 4096, 64 * kb, 32 * sb, WSP(unsigned char, WS_WUKV), 32 * sb, false, 16.f, scr, lane, F.in[8]); continue; } r -= I_UKV;
        if (r < I_NA) { const int kb = r / 64, sb = r % 64; p0_transpose_item8(F.in[10], 1024, 2048, 64 * kb, 32 * sb, WSP(unsigned char, WS_WNA), 32 * sb, false, 32.f, scr, lane); continue; } r -= I_NA;
        if (r < I_MLA) { const int kb = r / 64, sb = r % 64; p0_transpose_item8(F.in[11], 2048, 2048, 64 * kb, 32 * sb, WSP(unsigned char, WS_WMLA), 32 * sb, false, 64.f, scr, lane); continue; } r -= I_MLA;
        { const int kb = r / 64, sb = r % 64; p0_transpose_item8(F.in[12], 2048, 2048, 64 * kb, 32 * sb, WSP(unsigned char, WS_WOUT), 32 * sb, false, 64.f, scr, lane); }
    }
    if (PART == 0) { GAS u32x4* z = (GAS u32x4*)(WIN + (size_t)(C_KR + 64) * 2048); const int n16 = (NMAIN - C_KR - 64) * 2048 / 16;
      for (int i = gt; i < n16; i += NGT) z[i] = (u32x4){0u, 0u, 0u, 0u}; }
    if (PART == 0) { unsigned char* HN1 = WSP(unsigned char, WS_HN1);
#define P0_ROWSRC(m_) (((m_) < MREAL) ? F.in[0] + (size_t)(m_) * DM : F.in[1] + (size_t)((m_) - MREAL) * DM)
      { f32x4 v[8]; int m = gw;
        if (m < MREAL + NMETA) { const GAS f32x4* xr = (const GAS f32x4*)P0_ROWSRC(m) + lane;
#pragma unroll
            for (int j = 0; j < 8; ++j) v[j] = xr[64 * j]; }
        const GAS f32x4* gr = (const GAS f32x4*)F.in[2] + lane;
        while (m < MREAL + NMETA) { const int mn = m + NGW; f32x4 vn[8];
            { const int ml = mn < MREAL + NMETA ? mn : m; const GAS f32x4* xr = (const GAS f32x4*)P0_ROWSRC(ml) + lane;
#pragma unroll
              for (int j = 0; j < 8; ++j) vn[j] = xr[64 * j]; }
            float sq = 0.f;
#pragma unroll
            for (int j = 0; j < 8; ++j) sq += (v[j].x * v[j].x + v[j].y * v[j].y) + (v[j].z * v[j].z + v[j].w * v[j].w);
            const float rstd = 1.0f / sqrtf(wave_sum(sq) * (1.f / DM) + NORM_EPS);
            GAS unsigned* o4 = (GAS unsigned*)(HN1 + (size_t)m * DM) + lane;
#pragma unroll
            for (int j = 0; j < 8; ++j) { const f32x4 y = (v[j] * rstd) * gr[64 * j]; int w = 0; w = __builtin_amdgcn_cvt_pk_fp8_f32(y[0], y[1], w, false); w = __builtin_amdgcn_cvt_pk_fp8_f32(y[2], y[3], w, true); o4[64 * j] = (unsigned)w; }
#pragma unroll
            for (int j = 0; j < 8; ++j) v[j] = vn[j];
            m = mn; } }
#undef P0_ROWSRC
      GAS u32x4* z = (GAS u32x4*)(HN1 + (size_t)(MREAL + NMETA) * DM); const int n16 = (MPAD - MREAL - NMETA) * DM / 16;
      for (int i = gt; i < n16; i += NGT) z[i] = (u32x4){0u, 0u, 0u, 0u}; }
    if (PART == 0) { float* ct = WSP(float, WS_COS); float* st = WSP(float, WS_SIN);
      for (int i = gt; i < NPOS * 32; i += NGT) { const int p = i >> 5, j = i & 31;
          const float inv = __builtin_powf(10000.0f, -(float)(2 * j) / 64.0f); const float ang = (float)p * inv;
          double r = (double)ang * 0.15915494309189535; r -= __builtin_rint(r); const float rf = (float)r;
          ct[i] = __builtin_amdgcn_cosf(rf); st[i] = __builtin_amdgcn_sinf(rf); } }
    if (PART == 1) { const float* SK = F.in[15]; const float* WQ = F.in[14]; const float* g2 = F.in[13]; bf16_t* WSCp = WSP(bf16_t, WS_WSC);
      const int l15 = lane & 15, l4 = lane >> 4;
      for (int task = gw; task < 2048; task += NGW) { const int g = task >> 7, nt = (task >> 4) & 7, kc = task & 15, n0 = nt * 16;
          bf16x8 bfr[4];
#pragma unroll
          for (int kk = 0; kk < 4; ++kk) { const float* p = SK + ((size_t)g * 128 + n0 + l15) * 128 + 32 * kk + 8 * l4; const f32x4 a = *(const GAS f32x4*)p, b = *(const GAS f32x4*)(p + 4);
              const u32x4 w = pack8(a, b); bfr[kk] = __builtin_bit_cast(bf16x8, w); }
          for (int kt = 0; kt < 8; ++kt) { const int k0 = (kc * 8 + kt) * 16; f32x4 acc = (f32x4){0.f, 0.f, 0.f, 0.f};
#pragma unroll
              for (int kk = 0; kk < 4; ++kk) { const float* p = WQ + (size_t)(k0 + l15) * 2048 + g * 128 + 32 * kk + 8 * l4; const f32x4 a = *(const GAS f32x4*)p, b = *(const GAS f32x4*)(p + 4);
                  const u32x4 w = pack8(a, b); acc = __builtin_amdgcn_mfma_f32_16x16x32_bf16(__builtin_bit_cast(bf16x8, w), bfr[kk], acc, 0, 0, 0); }
              const f32x4 gg = *(const GAS f32x4*)(g2 + k0 + 4 * l4);
              *(GAS u32x2*)(WSCp + (size_t)(g * 128 + n0 + l15) * 2048 + k0 + 4 * l4) = pack4(acc * gg); } } }
}
using pg8::Unit;
struct SchedGrid {
    int G, c, nM, nN; const char* A; const char* B; size_t tstep;
    __device__ __forceinline__ bool next(int i, Unit& u) const { const int L = i * G + c; if (L >= nM * nN) return false; pg8::grid_order(L, nM, nN, u.pm, u.pn); u.kind = 0; return true; }
    __device__ __forceinline__ const char* pa(const Unit& u) const { return A + (size_t)u.pm * tstep; }
    __device__ __forceinline__ const char* pb(const Unit& u) const { return B + (size_t)u.pn * tstep; }
};
constexpr int P1_MAIN = 64 * 29, P1_VT = 4 * 65, P1_META = 7, P1_UNITS = P1_MAIN + P1_VT + P1_META;
struct SchedP1 {
    int G, c; const char* hn1; const char* win; const char* wvt; size_t tstep;
    __device__ __forceinline__ bool next(int i, Unit& u) const {
        const int L = i * G + c; if (L >= P1_UNITS) return false;
        if (L < P1_MAIN) { pg8::grid_order(L, 64, 29, u.pm, u.pn); u.kind = 0; }
        else if (L < P1_MAIN + P1_VT) { const int idx = L - P1_MAIN; u.pm = idx & 3; u.pn = idx >> 2; u.kind = 1; }
        else { const int idx = L - P1_MAIN - P1_VT; u.pm = 64; u.pn = idx < 4 ? 4 + idx : (idx < 6 ? 10 + (idx - 4) : 28); u.kind = 0; }
        return true; }
    __device__ __forceinline__ const char* pa(const Unit& u) const { return (u.kind == 1 ? wvt : hn1) + (size_t)u.pm * tstep; }
    __device__ __forceinline__ const char* pb(const Unit& u) const { return (u.kind == 1 ? hn1 : win) + (size_t)u.pn * tstep; }
};
__device__ __forceinline__ void rope4(const f32x4 x1, const f32x4 x2, const float* cosT, const float* sinT, int pos, int j0, f32x4& lo, f32x4& hi) {
    const f32x4 c = *(const GAS f32x4*)(cosT + pos * 32 + j0), s = *(const GAS f32x4*)(sinT + pos * 32 + j0);
    lo = x1 * c - x2 * s; hi = x2 * c + x1 * s;
}
struct EpiP1 {
    static constexpr bool PERM = true, HAS_PRE = false;
    bf16_t *naq, *nak, *vt; unsigned char *cq, *ckv; bf16_t *kr, *ga, *gb; float *ssq_q, *ssq_kv; const float *cosT, *sinT;
    __device__ __forceinline__ void operator()(const f32x4 (&acc)[2][2][4][2], const Unit& u, int wr, int wc, int fr, int fq, const LAS float* rowsc) const {
        const int row0 = u.pm * 256 + wr * 64 + fr, colu = wc * 32 + 8 * fq;
        if (u.kind == 1) {
#pragma unroll
            for (int ai = 0; ai < 2; ++ai)
#pragma unroll
                for (int m = 0; m < 4; ++m) { bf16_t* rp = vt + (size_t)(row0 + ai * 128 + m * 16) * VT_PITCH + u.pn * 256 + colu;
#pragma unroll
                    for (int bj = 0; bj < 2; ++bj) *(GAS u32x4*)(rp + bj * 128) = pack8(acc[ai][bj][m][0], acc[ai][bj][m][1]); }
            return; }
        const int pn = u.pn;
        if (pn == 28) {
            if (wc < 2) { const int j0 = 4 * (4 * wc + fq);
#pragma unroll
                for (int ai = 0; ai < 2; ++ai)
#pragma unroll
                    for (int m = 0; m < 4; ++m) { const int row = row0 + ai * 128 + m * 16; const int pos = row < MREAL ? NMETA + (row & (SEQ - 1)) : row - MREAL;
                        f32x4 lo, hi; rope4(acc[ai][0][m][0], acc[ai][0][m][1], cosT, sinT, pos, j0, lo, hi);
                        *(GAS u32x2*)(kr + (size_t)row * 64 + j0) = pack4(lo); *(GAS u32x2*)(kr + (size_t)row * 64 + 32 + j0) = pack4(hi); } }
            return; }
        if (pn >= 12) {
            bf16_t* base = pn < 20 ? ga : gb; const int colt = (pn < 20 ? pn - 12 : pn - 20) * 256 + colu;
#pragma unroll
            for (int ai = 0; ai < 2; ++ai)
#pragma unroll
                for (int m = 0; m < 4; ++m) { bf16_t* rp = base + (size_t)(row0 + ai * 128 + m * 16) * 2048 + colt;
#pragma unroll
                    for (int bj = 0; bj < 2; ++bj) { f32x4 a = acc[ai][bj][m][0], b = acc[ai][bj][m][1];
#pragma unroll
                        for (int i = 0; i < 4; ++i) { a[i] = sigmoidf_(a[i]); b[i] = sigmoidf_(b[i]); }
                        *(GAS u32x4*)(rp + bj * 128) = pack8(a, b); } }
            return; }
        if (pn >= 8) {
            const bool isq = pn < 10; unsigned char* base = isq ? cq : ckv; float* ssq = isq ? ssq_q : ssq_kv; const int colt = (isq ? pn - 8 : pn - 10) * 256 + colu;
#pragma unroll
            for (int ai = 0; ai < 2; ++ai)
#pragma unroll
                for (int m = 0; m < 4; ++m) { const int row = row0 + ai * 128 + m * 16; unsigned char* rp = base + (size_t)row * 512 + colt; float s = 0.f;
#pragma unroll
                    for (int bj = 0; bj < 2; ++bj) { const f32x4 a = acc[ai][bj][m][0], b = acc[ai][bj][m][1];
                        s += (a[0] * a[0] + a[1] * a[1]) + (a[2] * a[2] + a[3] * a[3]) + (b[0] * b[0] + b[1] * b[1]) + (b[2] * b[2] + b[3] * b[3]);
                        *(GAS u32x2*)(rp + bj * 128) = pack8_fp8(a, b); }
                    s += __shfl_xor(s, 16); s += __shfl_xor(s, 32);
                    if (fq == 0) ssq[(size_t)((pn & 1) * 4 + wc) * MPAD + row] = s; }
            return; }
        {
            bf16_t* base = pn < 4 ? naq : nak; const int colt = (pn & 3) * 256 + colu;
#pragma unroll
            for (int ai = 0; ai < 2; ++ai)
#pragma unroll
                for (int m = 0; m < 4; ++m) { bf16_t* rp = base + (size_t)(row0 + ai * 128 + m * 16) * 1024 + colt;
#pragma unroll
                    for (int bj = 0; bj < 2; ++bj) *(GAS u32x4*)(rp + bj * 128) = pack8(acc[ai][bj][m][0], acc[ai][bj][m][1]); }
        }
    }
};
constexpr int P3_Q = 64 * 12, P3_KV = 65 * 16, P3_UNITS = P3_Q + P3_KV;
struct SchedP3 {
    int G, c; const char* cq; const char* ckv; const char* wuq; const char* wukv; size_t tstep;
    __device__ __forceinline__ bool next(int i, Unit& u) const {
        const int L = i * G + c; if (L >= P3_UNITS) return false;
        if (L < P3_Q) { pg8::grid_order(L, 64, 12, u.pm, u.pn); u.kind = 0; } else { pg8::grid_order(L - P3_Q, 65, 16, u.pm, u.pn); u.kind = 1; }
        return true; }
    __device__ __forceinline__ const char* pa(const Unit& u) const { return (u.kind ? ckv : cq) + (size_t)u.pm * tstep; }
    __device__ __forceinline__ const char* pb(const Unit& u) const { return (u.kind ? wukv : wuq) + (size_t)u.pn * tstep; }
};
template <int NS, int LD> __device__ __forceinline__ float rstd_slabs(const float* part, int row, float invn) {
    float s = 0.f;
#pragma unroll
    for (int i = 0; i < NS; ++i) s += part[(size_t)i * LD + row];
    return 1.0f / sqrtf(s * invn + NORM_EPS);
}
struct EpiP3 {
    static constexpr bool PERM = true, HAS_PRE = true;
    bf16_t *qm, *kn, *vv; const float *ssq_q, *ssq_kv; const float *cosT, *sinT;
    __device__ __forceinline__ void pre(const Unit& u, LAS float* sc, int tid) const { if (tid < 256) { const int row = u.pm * 256 + tid; sc[tid] = u.kind ? rstd_slabs<8, MPAD>(ssq_kv, row, 1.f / 512.f) : rstd_slabs<8, MPAD>(ssq_q, row, 1.f / 512.f); } }
    __device__ __forceinline__ void operator()(const f32x4 (&acc)[2][2][4][2], const Unit& u, int wr, int wc, int fr, int fq, const LAS float* rowsc) const {
        const int row0 = u.pm * 256 + wr * 64 + fr, colu = wc * 32 + 8 * fq;
        if (u.kind == 1) {
#pragma unroll
            for (int ai = 0; ai < 2; ++ai)
#pragma unroll
                for (int m = 0; m < 4; ++m) { const int row = row0 + ai * 128 + m * 16; const float rs = rowsc[ai * 128 + wr * 64 + m * 16 + fr];
                    const size_t off = (size_t)row * 2048 + u.pn * 128 + colu;
                    *(GAS u32x4*)(kn + off) = pack8(acc[ai][0][m][0] * rs, acc[ai][0][m][1] * rs);
                    *(GAS u32x4*)(vv + off) = pack8(acc[ai][1][m][0] * rs, acc[ai][1][m][1] * rs); }
            return; }
#pragma unroll
        for (int bj = 0; bj < 2; ++bj) { const int c8 = u.pn * 256 + bj * 128 + colu; const int hd = c8 / 192, w = c8 - hd * 192;
            if (w < 128) {
#pragma unroll
                for (int ai = 0; ai < 2; ++ai)
#pragma unroll
                    for (int m = 0; m < 4; ++m) { const int row = row0 + ai * 128 + m * 16; const float rs = rowsc[ai * 128 + wr * 64 + m * 16 + fr];
                        *(GAS u32x4*)(qm + (size_t)row * 3072 + c8) = pack8(acc[ai][bj][m][0] * rs, acc[ai][bj][m][1] * rs); }
            } else { const int j0 = (w - 128) >> 1;
#pragma unroll
                for (int ai = 0; ai < 2; ++ai)
#pragma unroll
                    for (int m = 0; m < 4; ++m) { const int row = row0 + ai * 128 + m * 16; const float rs = rowsc[ai * 128 + wr * 64 + m * 16 + fr];
                        const int pos = NMETA + (row & (SEQ - 1)); f32x4 lo, hi; rope4(acc[ai][bj][m][0] * rs, acc[ai][bj][m][1] * rs, cosT, sinT, pos, j0, lo, hi);
                        bf16_t* qp = qm + (size_t)row * 3072 + hd * 192 + 128 + j0; *(GAS u32x2*)qp = pack4(lo); *(GAS u32x2*)(qp + 32) = pack4(hi); }
            } }
    }
};
__device__ __forceinline__ void unpack8(const u32x4 w, f32x4& a, f32x4& b) { a = (f32x4){bf_lo(w.x), bf_hi(w.x), bf_lo(w.y), bf_hi(w.y)}; b = (f32x4){bf_lo(w.z), bf_hi(w.z), bf_lo(w.w), bf_hi(w.w)}; }
struct EpiP5a {
    static constexpr bool PERM = true, HAS_PRE = false;
    const bf16_t* ga; bf16_t* t1;
    __device__ __forceinline__ void operator()(const f32x4 (&acc)[2][2][4][2], const Unit& u, int wr, int wc, int fr, int fq, const LAS float* rowsc) const {
        const int row0 = u.pm * 256 + wr * 64 + fr, col0 = u.pn * 256 + wc * 32 + 8 * fq;
#pragma unroll
        for (int ai = 0; ai < 2; ++ai)
#pragma unroll
            for (int m = 0; m < 4; ++m) { const size_t off = (size_t)(row0 + ai * 128 + m * 16) * 2048 + col0;
#pragma unroll
                for (int bj = 0; bj < 2; ++bj) { f32x4 g0, g1; unpack8(*(const GAS u32x4*)(ga + off + bj * 128), g0, g1);
                    *(GAS u32x4*)(t1 + off + bj * 128) = pack8(acc[ai][bj][m][0] * g0, acc[ai][bj][m][1] * g1); } }
    }
};
struct EpiP5b {
    static constexpr bool PERM = true, HAS_PRE = false;
    const bf16_t* gb; const bf16_t* t1; unsigned char* merged;
    __device__ __forceinline__ void operator()(const f32x4 (&acc)[2][2][4][2], const Unit& u, int wr, int wc, int fr, int fq, const LAS float* rowsc) const {
        const int row0 = u.pm * 256 + wr * 64 + fr, col0 = u.pn * 256 + wc * 32 + 8 * fq;
#pragma unroll
        for (int ai = 0; ai < 2; ++ai)
#pragma unroll
            for (int m = 0; m < 4; ++m) { const size_t off = (size_t)(row0 + ai * 128 + m * 16) * 2048 + col0;
#pragma unroll
                for (int bj = 0; bj < 2; ++bj) { f32x4 g0, g1; unpack8(*(const GAS u32x4*)(gb + off + bj * 128), g0, g1);
                    f32x4 a, b; unpack8(*(const GAS u32x4*)(t1 + off + bj * 128), a, b);
                    *(GAS u32x2*)(merged + off + bj * 128) = pack8_fp8((a + acc[ai][bj][m][0] * g0) * 32.f, (b + acc[ai][bj][m][1] * g1) * 32.f); } }
    }
};
struct EpiP6 {
    static constexpr bool PERM = true, HAS_PRE = false;
    const float* x; float* h2; bf16_t* h2b; float* ssq2;
    __device__ __forceinline__ void operator()(const f32x4 (&acc)[2][2][4][2], const Unit& u, int wr, int wc, int fr, int fq, const LAS float* rowsc) const {
        const int row0 = u.pm * 256 + wr * 64 + fr, col0 = u.pn * 256 + wc * 32 + 8 * fq;
#pragma unroll
        for (int ai = 0; ai < 2; ++ai)
#pragma unroll
            for (int m = 0; m < 4; ++m) { const int row = row0 + ai * 128 + m * 16; const size_t off = (size_t)row * 2048 + col0; float s = 0.f;
#pragma unroll
                for (int bj = 0; bj < 2; ++bj) { const f32x4 a = *(const GAS f32x4*)(x + off + bj * 128) + acc[ai][bj][m][0], b = *(const GAS f32x4*)(x + off + bj * 128 + 4) + acc[ai][bj][m][1];
                    s += (a[0] * a[0] + a[1] * a[1]) + (a[2] * a[2] + a[3] * a[3]) + (b[0] * b[0] + b[1] * b[1]) + (b[2] * b[2] + b[3] * b[3]);
                    *(GAS f32x4*)(h2 + off + bj * 128) = a; *(GAS f32x4*)(h2 + off + bj * 128 + 4) = b; *(GAS u32x4*)(h2b + off + bj * 128) = pack8(a, b); }
                s += __shfl_xor(s, 16); s += __shfl_xor(s, 32);
                if (fq == 0) ssq2[(size_t)(u.pn * 4 + wc) * MREAL + row] = s; }
    }
};
struct EpiP7 {
    static constexpr bool PERM = false, HAS_PRE = true;
    const float* ssq2; float* sc;
    __device__ __forceinline__ void pre(const Unit& u, LAS float* sc, int tid) const { if (tid < 256) sc[tid] = rstd_slabs<32, MREAL>(ssq2, u.pm * 256 + tid, 1.f / 2048.f); }
    __device__ __forceinline__ void operator()(const f32x4 (&acc)[2][2][4][2], const Unit& u, int wr, int wc, int fr, int fq, const LAS float* rowsc) const {
        const int row0 = u.pm * 256 + wr * 64 + fr, col0 = u.pn * 256 + wc * 32 + 4 * fq;
#pragma unroll
        for (int ai = 0; ai < 2; ++ai)
#pragma unroll
            for (int m = 0; m < 4; ++m) { const int row = row0 + ai * 128 + m * 16; const float rs = rowsc[ai * 128 + wr * 64 + m * 16 + fr]; const size_t off = (size_t)row * 2048 + col0;
#pragma unroll
                for (int bj = 0; bj < 2; ++bj)
#pragma unroll
                    for (int n = 0; n < 2; ++n) *(GAS f32x4*)(sc + off + bj * 128 + n * 16) = acc[ai][bj][m][n] * rs; }
    }
};
namespace att {
#define KSWZ(row, colB) ((row) * 256 + ((colB) ^ (((row) & 7) << 4)))
#define KRSWZ(row, colB) ((row) * 128 + ((colB) ^ ((((row) >> 1) & 7) << 4)))
constexpr float L2E = 1.4426950408889634f;
template <int DUMMY = 0>
__device__ __forceinline__ void partialSM(f32x16& p0, f32x16& p1, float& m_reg, float& mn, float& alpha, const float C, const float THRS) {
  float pmax = p0[0];
#pragma unroll
  for (int r = 1; r < 16; ++r) pmax = fmaxf(pmax, p0[r]);
#pragma unroll
  for (int r = 0; r < 16; ++r) pmax = fmaxf(pmax, p1[r]);
  { auto rr = __builtin_amdgcn_permlane32_swap(__float_as_uint(pmax), __float_as_uint(pmax), false, false);
    pmax = fmaxf(__uint_as_float(rr[0]), __uint_as_float(rr[1])); }
  if (__builtin_expect(__all(pmax - m_reg <= THRS), 1)) { mn = m_reg; alpha = 1.f; }
  else { mn = fmaxf(m_reg, pmax); alpha = __builtin_amdgcn_exp2f((m_reg - mn) * C); m_reg = mn; }
  const float mnC = -mn * C;
#pragma unroll
  for (int r = 0; r < 16; ++r) p0[r] = fmaf(p0[r], C, mnC);
#pragma unroll
  for (int r = 0; r < 16; ++r) p1[r] = fmaf(p1[r], C, mnC);
#pragma unroll
  for (int r = 0; r < 16; ++r) p0[r] = __builtin_amdgcn_exp2f(p0[r]);
}
__device__ __forceinline__ void finishSM(f32x16& p0, f32x16& p1, float alpha, float& l_reg, bf16x8& pa0, bf16x8& pa1, bf16x8& pa2, bf16x8& pa3) {
#pragma unroll
  for (int r = 0; r < 16; ++r) p1[r] = __builtin_amdgcn_exp2f(p1[r]);
  float ps = 0;
#pragma unroll
  for (int r = 0; r < 16; ++r) ps += p0[r];
#pragma unroll
  for (int r = 0; r < 16; ++r) ps += p1[r];
  { auto rr = __builtin_amdgcn_permlane32_swap(__float_as_uint(ps), __float_as_uint(ps), false, false);
    ps = __uint_as_float(rr[0]) + __uint_as_float(rr[1]); }
  l_reg = l_reg * alpha + ps;
#define PK4(P, BASE, OUT) do { unsigned a0 = cvt_pk_bf16(P[BASE + 0], P[BASE + 1]), a1 = cvt_pk_bf16(P[BASE + 2], P[BASE + 3]);   \
    unsigned b0 = cvt_pk_bf16(P[BASE + 4], P[BASE + 5]), b1 = cvt_pk_bf16(P[BASE + 6], P[BASE + 7]);                              \
    auto r0 = __builtin_amdgcn_permlane32_swap(a0, b0, false, false); auto r1 = __builtin_amdgcn_permlane32_swap(a1, b1, false, false); \
    u32x4 w = {r0[0], r1[0], r0[1], r1[1]}; OUT = __builtin_bit_cast(bf16x8, w); } while (0)
  PK4(p0, 0, pa0); PK4(p0, 8, pa1); PK4(p1, 0, pa2); PK4(p1, 8, pa3);
#undef PK4
}
constexpr int NW = 8, QBLK = 32, KVBLK = 64;
constexpr float MLA_SCALE = 0.07216878364870322f;
constexpr float MLA_THR = 8.f;
constexpr int SHM_V = KVBLK * 128 * 2, SHM_KN = KVBLK * 128 * 2, SHM_KR = KVBLK * 64 * 2;
constexpr int OFF_V = 0, OFF_KN = 2 * SHM_V, OFF_KR = OFF_KN + 2 * SHM_KN, OFF_WS = OFF_KR + 2 * SHM_KR, OFF_QR = OFF_WS + NW * 64 * 4, MLA_LDS = OFF_QR + NW * 4096;
__device__ __forceinline__ void qkt(f32x16& p0, f32x16& p1, const LAS char* Kn, const LAS char* Kr, const bf16x8* qr, const LAS char* qrp, const int* kb, const int* krb) {
  p0 = f32x16{}; p1 = f32x16{};
#pragma unroll
  for (int d0 = 0; d0 < 8; ++d0) {
    const bf16x8 b0 = *(const LAS bf16x8*)(Kn + kb[d0 & 3] + (d0 >> 2) * 128);
    const bf16x8 b1 = *(const LAS bf16x8*)(Kn + kb[d0 & 3] + (d0 >> 2) * 128 + 8192);
    p0 = __builtin_amdgcn_mfma_f32_32x32x16_bf16(b0, qr[d0], p0, 0, 0, 0);
    p1 = __builtin_amdgcn_mfma_f32_32x32x16_bf16(b1, qr[d0], p1, 0, 0, 0); }
#pragma unroll
  for (int d0 = 0; d0 < 4; ++d0) {
    const bf16x8 b0 = *(const LAS bf16x8*)(Kr + krb[d0]);
    const bf16x8 b1 = *(const LAS bf16x8*)(Kr + krb[d0] + 4096);
    const bf16x8 qf = *(const LAS bf16x8*)(qrp + d0 * 1024);
    p0 = __builtin_amdgcn_mfma_f32_32x32x16_bf16(b0, qf, p0, 0, 0, 0);
    p1 = __builtin_amdgcn_mfma_f32_32x32x16_bf16(b1, qf, p1, 0, 0, 0); }
}
__device__ __forceinline__ int v_st(int k, int c) { const int kk = (k & ~0xC) | ((k & 4) << 1) | ((k & 8) >> 1); return ((kk >> 3) * 4 + (c >> 5)) * 512 + ((kk & 7) * 32 + (c & 31)) * 2; }
__device__ __forceinline__ int v_rd_base(int lane) { return ((lane & 3) << 3) | (((lane >> 2) & 3) << 6) | (((lane >> 4) & 1) << 5) | (((lane >> 5) & 1) << 8); }
constexpr int v_rd_off(int d0, int ks, int half) { return d0 * 512 + ks * 4096 + half * 2048; }
template <int OFF> __device__ __forceinline__ s16x4 tr_read(int vb) {
  s16x4 r; asm volatile("ds_read_b64_tr_b16 %0, %1 offset:%2" : "=&v"(r) : "v"(vb), "i"(OFF) : "memory"); return r;
}
template <int D0> __device__ __forceinline__ void pv_one(f32x16& od, int vb, bf16x8 pa0, bf16x8 pa1, bf16x8 pa2, bf16x8 pa3) {
  const s16x4 l0 = tr_read<v_rd_off(D0, 0, 0)>(vb), h0 = tr_read<v_rd_off(D0, 0, 1)>(vb), l1 = tr_read<v_rd_off(D0, 1, 0)>(vb), h1 = tr_read<v_rd_off(D0, 1, 1)>(vb);
  const s16x4 l2 = tr_read<v_rd_off(D0, 2, 0)>(vb), h2 = tr_read<v_rd_off(D0, 2, 1)>(vb), l3 = tr_read<v_rd_off(D0, 3, 0)>(vb), h3 = tr_read<v_rd_off(D0, 3, 1)>(vb);
  asm volatile("s_waitcnt lgkmcnt(0)" ::: "memory"); SBAR();
#define PK(L, H) (bf16x8){L[0], L[1], L[2], L[3], H[0], H[1], H[2], H[3]}
  od = __builtin_amdgcn_mfma_f32_32x32x16_bf16(pa0, PK(l0, h0), od, 0, 0, 0);
  od = __builtin_amdgcn_mfma_f32_32x32x16_bf16(pa1, PK(l1, h1), od, 0, 0, 0);
  od = __builtin_amdgcn_mfma_f32_32x32x16_bf16(pa2, PK(l2, h2), od, 0, 0, 0);
  od = __builtin_amdgcn_mfma_f32_32x32x16_bf16(pa3, PK(l3, h3), od, 0, 0, 0);
#undef PK
}
__device__ __forceinline__ void pv_d0(f32x16* o, int vb, bf16x8 pa0, bf16x8 pa1, bf16x8 pa2, bf16x8 pa3) {
  pv_one<0>(o[0], vb, pa0, pa1, pa2, pa3); pv_one<1>(o[1], vb, pa0, pa1, pa2, pa3); pv_one<2>(o[2], vb, pa0, pa1, pa2, pa3); pv_one<3>(o[3], vb, pa0, pa1, pa2, pa3);
}
__device__ __forceinline__ void mla_unit(int b, int h, int qb, const bf16_t* __restrict__ QM, const bf16_t* __restrict__ KN, const bf16_t* __restrict__ KR, const bf16_t* __restrict__ VV, unsigned char* __restrict__ OM, LAS char* lds) {
  const int tid = threadIdx.x, wid = tid >> 6, lane = tid & 63, r32 = lane & 31, hi = lane >> 5;
  constexpr float C = MLA_SCALE * L2E, THRS = MLA_THR / MLA_SCALE;
  constexpr int NT = 33;
  LAS char* V_lds = lds + OFF_V; LAS char* Kn_lds = lds + OFF_KN; LAS char* Kr_lds = lds + OFF_KR;
  LAS float* ws = (LAS float*)(lds + OFF_WS) + wid * 64; LAS float* li_l = ws; LAS float* al_l = ws + 32;
  float m_reg = -1e30f, l_reg = 0; f32x16 o[4] = {}; bf16x8 qr[8];
  LAS char* qrp = lds + OFF_QR + wid * 4096 + lane * 16;
  const int qrow = b * SEQ + qb * 256 + wid * QBLK + r32;
  const bf16_t* Qw = QM + (size_t)qrow * 3072 + h * 192 + hi * 8;
#pragma unroll
  for (int d0 = 0; d0 < 8; ++d0) qr[d0] = *(const GAS bf16x8*)(Qw + d0 * 16);
  __syncthreads();
#pragma unroll
  for (int d0 = 0; d0 < 4; ++d0) *(LAS bf16x8*)(qrp + d0 * 1024) = *(const GAS bf16x8*)(Qw + (8 + d0) * 16);
  const int sr = tid >> 4, sc = (tid & 15) * 8, vst0 = v_st(sr, sc), vst1 = v_st(32 + sr, sc);
  const int krr = tid >> 3, krc = (tid & 7) * 8;
  const int vb0 = (int)(uintptr_t)V_lds + v_rd_base(lane);
  bf16x8 s_v0, s_v1, s_k0, s_k1, s_kr;
  const int realbase = b * SEQ - KVBLK;
  const unsigned voff = (unsigned)(sr * 2048 + sc) * 2u, kroff = (unsigned)(krr * 64 + krc) * 2u;
  int kb[4], krb[4];
#pragma unroll
  for (int bq = 0; bq < 4; ++bq) { kb[bq] = KSWZ(r32, bq * 32 + hi * 16); krb[bq] = KRSWZ(r32, bq * 32 + hi * 16); }
#define TROW(t) ((t) == 0 ? MREAL : realbase + (t) * KVBLK)
#define SLOAD(t) do { const int k0_ = TROW(t); const size_t ro_ = ((size_t)k0_ * 2048 + h * 128) * 2; \
    const GAS char* vb_ = (const GAS char*)VV + ro_; const GAS char* nb_ = (const GAS char*)KN + ro_; const GAS char* rb_ = (const GAS char*)KR + (size_t)k0_ * 128; \
    s_v0 = *(const GAS bf16x8*)(vb_ + voff); s_v1 = *(const GAS bf16x8*)(vb_ + 32 * 4096 + voff); \
    s_k0 = *(const GAS bf16x8*)(nb_ + voff); s_k1 = *(const GAS bf16x8*)(nb_ + 32 * 4096 + voff); \
    s_kr = *(const GAS bf16x8*)(rb_ + kroff); } while (0)
#define SWRITE(bf) do { *(LAS bf16x8*)(V_lds + (bf) * SHM_V + vst0) = s_v0; *(LAS bf16x8*)(V_lds + (bf) * SHM_V + vst1) = s_v1; const int kc_ = sc * 2; \
    *(LAS bf16x8*)(Kn_lds + (bf) * SHM_KN + KSWZ(sr, kc_)) = s_k0; *(LAS bf16x8*)(Kn_lds + (bf) * SHM_KN + KSWZ(32 + sr, kc_)) = s_k1; \
    *(LAS bf16x8*)(Kr_lds + (bf) * SHM_KR + KRSWZ(krr, krc * 2)) = s_kr; } while (0)
#define SWAIT() asm volatile("s_waitcnt vmcnt(0)" ::: "memory")
#define RESC(a) do { if (__any((a) < 1.f)) { if (hi == 0) al_l[r32] = (a); asm volatile("s_waitcnt lgkmcnt(0)" ::: "memory"); \
    _Pragma("unroll") for (int d = 0; d < 4; ++d) _Pragma("unroll") for (int r = 0; r < 16; ++r) o[d][r] *= al_l[crow(r, hi)]; } } while (0)
  f32x16 pA0, pA1, pB0, pB1; float mnA, mnB, alA, alB; bf16x8 pa0, pa1, pa2, pa3;
  SLOAD(0); SWAIT(); SWRITE(0); __syncthreads();
  qkt(pA0, pA1, Kn_lds, Kr_lds, qr, qrp, kb, krb);
  { const float NEG = -INFINITY;
#pragma unroll
    for (int r = 8; r < 16; ++r) pA0[r] = NEG;
#pragma unroll
    for (int r = 0; r < 16; ++r) pA1[r] = NEG; }
  partialSM(pA0, pA1, m_reg, mnA, alA, C, THRS);
  SLOAD(1); SWAIT(); SWRITE(1); __syncthreads();
  for (int j = 1; j + 1 < NT; j += 2) {
    SBAR(); qkt(pB0, pB1, Kn_lds + SHM_KN, Kr_lds + SHM_KR, qr, qrp, kb, krb);
    finishSM(pA0, pA1, alA, l_reg, pa0, pa1, pa2, pa3); SBAR();
    SLOAD(j + 1); SBAR();
    pv_d0(o, vb0, pa0, pa1, pa2, pa3); partialSM(pB0, pB1, m_reg, mnB, alB, C, THRS);
    __syncthreads(); SWAIT(); SWRITE(0);
    RESC(alB); __syncthreads();
    SBAR(); qkt(pA0, pA1, Kn_lds, Kr_lds, qr, qrp, kb, krb);
    finishSM(pB0, pB1, alB, l_reg, pa0, pa1, pa2, pa3); SBAR();
    if (j + 2 < NT) SLOAD(j + 2); SBAR();
    pv_d0(o, vb0 + SHM_V, pa0, pa1, pa2, pa3); partialSM(pA0, pA1, m_reg, mnA, alA, C, THRS);
    __syncthreads(); if (j + 2 < NT) { SWAIT(); SWRITE(1); }
    RESC(alA); __syncthreads();
  }
  finishSM(pA0, pA1, alA, l_reg, pa0, pa1, pa2, pa3); SBAR();
  pv_d0(o, vb0, pa0, pa1, pa2, pa3);
  if (hi == 0) li_l[r32] = l_reg; asm volatile("s_waitcnt lgkmcnt(0)" ::: "memory");
  float rli[16];
#pragma unroll
  for (int r = 0; r < 16; ++r) rli[r] = __builtin_amdgcn_rcpf(li_l[crow(r, hi)]);
  unsigned char* Ow = OM + (size_t)(b * SEQ + qb * 256 + wid * QBLK) * 2048 + h * 128;
#pragma unroll
  for (int r = 0; r < 16; ++r) { const int orow = crow(r, hi);
#pragma unroll
    for (int d0 = 0; d0 < 4; ++d0) Ow[(size_t)orow * 2048 + d0 * 32 + r32] = f32_to_fp8(o[d0][r] * rli[r] * 32.f); }
#undef TROW
#undef SLOAD
#undef SWRITE
#undef SWAIT
#undef RESC
}
__device__ __forceinline__ void na_task(int task, const bf16_t* __restrict__ NAQ, const bf16_t* __restrict__ NAK, const bf16_t* __restrict__ VT, unsigned char* __restrict__ ONA,
                                        const LAS float* relb, const LAS float* metab, LAS float* wsf, int lane) {
  const int r32 = lane & 31, hi = lane >> 5;
  const int half = task & 1, r = (task >> 1) & 31, h = (task >> 6) & 15, b = task >> 10;
  const int qc = half * 32 + r32;
  const int cs = min(max(qc - 8, 0), 48), rs = min(max(r - 4, 0), 24);
  const int qtok = b * SEQ + r * 64 + qc;
  constexpr float C = L2E, THRS = 8.f, SCALE = 0.125f;
  bf16x8 qr[4];
#pragma unroll
  for (int d0 = 0; d0 < 4; ++d0) qr[d0] = *(const GAS bf16x8*)(NAQ + (size_t)qtok * 1024 + h * 64 + d0 * 16 + hi * 8);
  float m_reg = -1e30f, l_reg = 0.f; f32x16 o[2] = {};
  LAS float* al_l = wsf; LAS float* li_l = wsf + 32;
  const float NEG = -INFINITY;
  const unsigned long long wm = 0xFFFFull << cs;
  const unsigned mh0 = (unsigned)wm >> (4 * hi), mh1 = (unsigned)(wm >> 32) >> (4 * hi);
  const bf16_t* kq = NAK + (size_t)r32 * 1024 + h * 64 + hi * 8;
  const bf16_t* vq = VT + (size_t)(h * 64 + r32) * VT_PITCH + 8 * hi;
#define NA_KTOK(w) ((w) == 8 ? MREAL : b * SEQ + (rs + (w)) * 64)
#define NA_LOADK(KF, w) do { const bf16_t* kp_ = kq + (size_t)NA_KTOK(w) * 1024; _Pragma("unroll") for (int d0 = 0; d0 < 4; ++d0) { KF[d0] = *(const GAS bf16x8*)(kp_ + d0 * 16); KF[4 + d0] = *(const GAS bf16x8*)(kp_ + 32 * 1024 + d0 * 16); } } while (0)
#define NA_TILE(KF, w) do { \
    bf16x8 vf[8]; { const bf16_t* vp_ = vq + NA_KTOK(w); _Pragma("unroll") for (int ks = 0; ks < 4; ++ks) { vf[ks] = *(const GAS bf16x8*)(vp_ + 16 * ks); vf[4 + ks] = *(const GAS bf16x8*)(vp_ + (size_t)32 * VT_PITCH + 16 * ks); } } \
    f32x16 p0 = {}, p1 = {}; \
    _Pragma("unroll") for (int d0 = 0; d0 < 4; ++d0) { p0 = __builtin_amdgcn_mfma_f32_32x32x16_bf16(KF[d0], qr[d0], p0, 0, 0, 0); p1 = __builtin_amdgcn_mfma_f32_32x32x16_bf16(KF[4 + d0], qr[d0], p1, 0, 0, 0); } \
    if ((w) + 1 < 9) NA_LOADK(KF, (w) + 1);            \
    if ((w) < 8) { const LAS float* bp_ = relb + ((h * 15 + (rs + (w) - r + 7)) * 31 + 15 - qc + 4 * hi);     \
      _Pragma("unroll") for (int rg = 0; rg < 16; ++rg) { const int c_ = (rg & 3) + 8 * (rg >> 2); \
        { const bool ok = (mh0 >> c_) & 1u; const float bv = bp_[c_]; p0[rg] = ok ? fmaf(p0[rg], SCALE, bv) : NEG; } \
        { const bool ok = (mh1 >> c_) & 1u; const float bv = bp_[c_ + 32]; p1[rg] = ok ? fmaf(p1[rg], SCALE, bv) : NEG; } } \
    } else { const LAS float* bp = metab + h * 16; \
      _Pragma("unroll") for (int rg = 0; rg < 16; ++rg) { const int kc = crow(rg, hi); p0[rg] = (rg < 8) ? fmaf(p0[rg], SCALE, bp[kc & 15]) : NEG; p1[rg] = NEG; } } \
    float mn, alpha; partialSM(p0, p1, m_reg, mn, alpha, C, THRS); \
    bf16x8 pa0, pa1, pa2, pa3; finishSM(p0, p1, alpha, l_reg, pa0, pa1, pa2, pa3); \
    if (__any(alpha < 1.f)) { if (hi == 0) al_l[r32] = alpha; asm volatile("s_waitcnt lgkmcnt(0)" ::: "memory"); \
      _Pragma("unroll") for (int d = 0; d < 2; ++d) _Pragma("unroll") for (int rg = 0; rg < 16; ++rg) o[d][rg] *= al_l[crow(rg, hi)]; } \
    _Pragma("unroll") for (int d0 = 0; d0 < 2; ++d0) { \
      o[d0] = __builtin_amdgcn_mfma_f32_32x32x16_bf16(pa0, vf[4 * d0 + 0], o[d0], 0, 0, 0); o[d0] = __builtin_amdgcn_mfma_f32_32x32x16_bf16(pa1, vf[4 * d0 + 1], o[d0], 0, 0, 0); \
      o[d0] = __builtin_amdgcn_mfma_f32_32x32x16_bf16(pa2, vf[4 * d0 + 2], o[d0], 0, 0, 0); o[d0] = __builtin_amdgcn_mfma_f32_32x32x16_bf16(pa3, vf[4 * d0 + 3], o[d0], 0, 0, 0); } } while (0)
  { bf16x8 kA[8];
    NA_LOADK(kA, 0);
#pragma unroll 1
    for (int w = 0; w < 8; ++w) { NA_TILE(kA, w); }
    NA_TILE(kA, 8); }
#undef NA_KTOK
#undef NA_LOADK
#undef NA_TILE
  if (hi == 0) li_l[r32] = l_reg; asm volatile("s_waitcnt lgkmcnt(0)" ::: "memory");
  unsigned char* Ow = ONA + (size_t)(b * SEQ + r * 64 + half * 32) * 1024 + h * 64;
#pragma unroll
  for (int rg = 0; rg < 16; ++rg) { const int orow = crow(rg, hi); const float rl = __builtin_amdgcn_rcpf(li_l[orow]);
#pragma unroll
    for (int d0 = 0; d0 < 2; ++d0) Ow[(size_t)orow * 1024 + d0 * 32 + r32] = f32_to_fp8(o[d0][rg] * rl * 16.f); }
  asm volatile("s_waitcnt lgkmcnt(0)" ::: "memory");
}
}
namespace peer {
constexpr int CH = 32;
constexpr int OFF_TV = 0, OFF_TI = OFF_TV + CH * 16 * 16 * 4, OFF_SE = OFF_TI + CH * 16 * 16 * 4, OFF_SG = OFF_SE + CH * 128 * 4, OFF_SE2 = OFF_SG + CH * 128 * 4, OFF_SG2 = OFF_SE2 + CH * 128 * 4, PEER_LDS = OFF_SG2 + CH * 128 * 4;
static_assert(PEER_LDS <= RING_BYTES, "PEER LDS");
__device__ __forceinline__ float gelu_tanh(float x) {
    const float u = 0.7978845608028654f * (x + 0.044715f * x * x * x);
    const float e = __builtin_amdgcn_exp2f(-2.f * 1.4426950408889634f * fabsf(u));
    const float t = (1.f - e) * __builtin_amdgcn_rcpf(1.f + e);
    return 0.5f * x * (1.f + (u < 0.f ? -t : t));
}
__device__ __forceinline__ void fmac1(float& acc, float a, float b) { asm("v_fmac_f32_e32 %0, %1, %2" : "+v"(acc) : "v"(a), "v"(b)); }
#define PEER_INSERT(x_, xi_) do { float x__ = (x_); int xi__ = (xi_); \
    _Pragma("unroll") for (int j_ = 0; j_ < 16; ++j_) { const bool gt_ = x__ > tv[j_]; const float tvo_ = tv[j_]; const int tio_ = ti[j_]; \
        tv[j_] = gt_ ? x__ : tvo_; ti[j_] = gt_ ? xi__ : tio_; x__ = gt_ ? tvo_ : x__; xi__ = gt_ ? tio_ : xi__; } } while (0)

#define PEER_AUX 0
typedef __amdgpu_buffer_rsrc_t rsrc_t;
__device__ __forceinline__ rsrc_t mk_rsrc(const void* p, unsigned bytes) { return __builtin_amdgcn_make_buffer_rsrc((void*)p, 0, bytes, 0x00020000); }
__device__ __forceinline__ u32x4 ldb128(rsrc_t r, unsigned off) { return __builtin_amdgcn_raw_buffer_load_b128(r, off, 0, PEER_AUX); }
typedef unsigned v6u_t __attribute__((ext_vector_type(6)));
typedef float v32f_t __attribute__((ext_vector_type(32)));
typedef float v16f_t __attribute__((ext_vector_type(16)));
__device__ __forceinline__ u32x2 ldb64(rsrc_t r, unsigned off) { return __builtin_amdgcn_raw_buffer_load_b64(r, off, 0, PEER_AUX); }
__device__ __forceinline__ f32x4 ldf128(rsrc_t r, unsigned off) { return __builtin_bit_cast(f32x4, __builtin_amdgcn_raw_buffer_load_b128(r, off, 0, PEER_AUX)); }
__device__ __forceinline__ f32x4 ldf128_nt(rsrc_t r, unsigned off) { return __builtin_bit_cast(f32x4, __builtin_amdgcn_raw_buffer_load_b128(r, off, 0, 2)); }
__device__ __forceinline__ void peer_select(int chunk, const float* __restrict__ SC, LAS char* lds, int tid, LAS int* SE, LAS float* SG) {
    LAS float* TV = (LAS float*)(lds + OFF_TV); LAS int* TI = (LAS int*)(lds + OFF_TI);
    asm volatile("" : "+v"(tid));
    const int tok0 = chunk * CH;
    const rsrc_t rSC = mk_rsrc(SC, 0x8000000u);
    __syncthreads();
    { const int tl = tid >> 4, g = tid & 15; const unsigned spo = ((unsigned)(tok0 + tl) * 2048u + (unsigned)g * 128u) * 4u;
      int tk[16];
#pragma unroll
      for (int j = 0; j < 16; ++j) tk[j] = (int)0x80000000;
#define PEER_KEY(x_, lowbits_, mask_) ({ const int f_ = __float_as_int(x_); ((f_ ^ ((f_ >> 31) & 0x7fffffff)) & ~(mask_)) | (lowbits_); })
#define PEER_INS(key_) do { int x__ = (key_); _Pragma("unroll") for (int j_ = 0; j_ < 16; ++j_) { const int hi_ = max(x__, tk[j_]); x__ = min(x__, tk[j_]); tk[j_] = hi_; } } while (0)
#pragma unroll 1
      for (int i = 0; i < 32; i += 2) { const f32x4 a = ldf128_nt(rSC, spo + i * 16), b = ldf128_nt(rSC, spo + i * 16 + 16);
#pragma unroll
          for (int e = 0; e < 4; ++e) { PEER_INS(PEER_KEY(a[e], 127 - (4 * i + e), 127)); }
#pragma unroll
          for (int e = 0; e < 4; ++e) { PEER_INS(PEER_KEY(b[e], 127 - (4 * i + 4 + e), 127)); } }
      LAS float* tvp = TV + (tl * 16 + g) * 16; LAS int* tip = TI + (tl * 16 + g) * 16;
#pragma unroll
      for (int j = 0; j < 16; ++j) { const int k_ = tk[j] & ~127; tvp[j] = __int_as_float(k_ ^ ((k_ >> 31) & 0x7fffffff)); tip[j] = 127 - (tk[j] & 127); } }
    __syncthreads();
    asm volatile("" : "+v"(tid));
    { const int tl = tid >> 4, hh = (tid >> 1) & 7, half = tid & 1;
      const LAS float* s1 = TV + (tl * 16 + 2 * hh) * 16; const LAS float* s2 = s1 + 16; const LAS int* i1 = TI + (tl * 16 + 2 * hh) * 16; const LAS int* i2 = i1 + 16;
      float b2[16];
#pragma unroll
      for (int j = 0; j < 16; ++j) b2[j] = s2[j];
      int tk[16];
#pragma unroll
      for (int j = 0; j < 16; ++j) tk[j] = (int)0x80000000;
#pragma unroll
      for (int ii = 0; ii < 8; ++ii) { const int i = 2 * ii + half; const float a = s1[i];
#pragma unroll
          for (int j = 0; j < 16; ++j) if ((2 * ii + 1) * (j + 1) <= 16) { if (half == 0 || (2 * ii + 2) * (j + 1) <= 16) PEER_INS(PEER_KEY(a + b2[j], 255 - (i * 16 + j), 255)); } }
      { int pk[16];
#pragma unroll
        for (int j = 0; j < 16; ++j) pk[j] = __shfl_xor(tk[j], 1);
#pragma unroll
        for (int j = 0; j < 16; ++j) PEER_INS(pk[j]); }
      if (half == 0) { float e[16], sum = 0.f; const int k0_ = tk[0] & ~255; const float v0 = __int_as_float(k0_ ^ ((k0_ >> 31) & 0x7fffffff));
#pragma unroll
        for (int j = 0; j < 16; ++j) { const int k_ = tk[j] & ~255; const float vj = __int_as_float(k_ ^ ((k_ >> 31) & 0x7fffffff)); e[j] = __builtin_amdgcn_exp2f((vj - v0) * 1.4426950408889634f); sum += e[j]; }
        const float inv = 1.0f / sum;
#pragma unroll
        for (int j = 0; j < 16; ++j) { const int ci = 255 - (tk[j] & 255); SE[tl * 128 + hh * 16 + j] = i1[ci >> 4] * 128 + i2[ci & 15]; SG[tl * 128 + hh * 16 + j] = e[j] * inv; } } }
#undef PEER_KEY
#undef PEER_INS
    __syncthreads();
}
__device__ __forceinline__ void peer_gather(int chunk, const float* __restrict__ H2, const unsigned char* __restrict__ U,
                                            const float* __restrict__ g2, const float* __restrict__ gf, float* OUT, int tid, const LAS int* SE, const LAS float* SG) {
    asm volatile("" : "+v"(tid));
    const int tok0 = chunk * CH, lane = tid & 63, wave = tid >> 6;
    const rsrc_t rH2 = mk_rsrc(H2, 0x8000000u), rU = mk_rsrc(U, 0x3000000u), rG2 = mk_rsrc(g2, 8192u), rGF = mk_rsrc(gf, 8192u);
#pragma unroll 1
    for (int tt = 0; tt < CH / NWAVES; ++tt) { const int tl = wave * (CH / NWAVES) + tt, tok = tok0 + tl;
      asm volatile("" ::: "memory");
      float hn[32], acc[32]; float ss = 0.f;
#pragma unroll
      for (int j = 0; j < 2; ++j)
#pragma unroll
          for (int q = 0; q < 4; ++q) { const f32x4 a = ldf128_nt(rH2, ((unsigned)tok * 2048u + 256u * (4 * j + q) + 4u * lane) * 4u);
#pragma unroll
              for (int i = 0; i < 4; ++i) { hn[16 * j + 4 * q + i] = a[i]; ss += a[i] * a[i]; } }
      const float rstd = 1.0f / sqrtf(wave_sum(ss) * (1.f / 2048.f) + NORM_EPS);
#pragma unroll
      for (int j = 0; j < 2; ++j)
#pragma unroll
          for (int q = 0; q < 4; ++q) { const f32x4 a = ldf128(rG2, (256u * (4 * j + q) + 4u * lane) * 4u);
#pragma unroll
              for (int i = 0; i < 4; ++i) hn[16 * j + 4 * q + i] *= rstd * a[i]; }
#pragma unroll
      for (int i = 0; i < 32; ++i) acc[i] = 0.f;
#define NX 4
#define PEER_LOAD(S, kb) do { _Pragma("unroll") for (int x = 0; x < NX; ++x) { const unsigned o = (unsigned)SE[tl * 128 + (kb) + x] * 3072u; \
          S##ua[x] = ldb128(rU, o + (unsigned)lane * 16u); S##ub[x] = ldb64(rU, o + 1024u + (unsigned)lane * 8u); S##va[x] = ldb128(rU, o + 1536u + (unsigned)lane * 16u); S##vb[x] = ldb64(rU, o + 2560u + (unsigned)lane * 8u); } } while (0)
#define PEER_DEC(A, B) ({ v32f_t r_ = __builtin_amdgcn_cvt_scalef32_pk32_f32_fp6((v6u_t){A.x, A.y, A.z, A.w, B.x, B.y}, 1.0f); asm volatile("s_nop 1" : "+v"(r_)); r_; })
#define PEER_COMPUTE(S, kb) do { float d[NX]; \
          _Pragma("unroll") for (int x = 0; x < NX; ++x) { const v32f_t r = PEER_DEC(S##ua[x], S##ub[x]); float dd = 0.f; \
              _Pragma("unroll") for (int i = 0; i < 32; ++i) fmac1(dd, hn[i], r[i]); \
              d[x] = dd; } \
          _Pragma("unroll") for (int o = 1; o < 64; o <<= 1) { _Pragma("unroll") for (int x = 0; x < NX; ++x) d[x] += __shfl_xor(d[x], o); } \
          float c[NX]; \
          _Pragma("unroll") for (int x = 0; x < NX; ++x) c[x] = SG[tl * 128 + (kb) + x] * gelu_tanh(d[x] * (1.f / 64.f)) * 0.25f; \
          _Pragma("unroll") for (int x = 0; x < NX; ++x) { const v32f_t r = PEER_DEC(S##va[x], S##vb[x]); \
              _Pragma("unroll") for (int i = 0; i < 32; ++i) fmac1(acc[i], c[x], r[i]); } } while (0)
      { u32x4 Aua[NX], Ava[NX], Bua[NX], Bva[NX]; u32x2 Aub[NX], Avb[NX], Bub[NX], Bvb[NX];
        PEER_LOAD(A, 0);
#pragma unroll 1
        for (int k = 0; k < 128; k += 2 * NX) {
            PEER_LOAD(B, k + NX); PEER_COMPUTE(A, k);
            { const int kn = min(k + 2 * NX, 128 - NX); PEER_LOAD(A, kn); }
            PEER_COMPUTE(B, k + NX);
        } }
#undef PEER_DEC
#undef NX
#undef PEER_LOAD
#undef PEER_COMPUTE
      asm volatile("" ::: "memory");
      int tok2 = tok, lane2 = lane; asm volatile("" : "+v"(tok2), "+v"(lane2));
      float s2 = 0.f;
#pragma unroll
      for (int j = 0; j < 2; ++j)
#pragma unroll
          for (int q = 0; q < 4; ++q) { const f32x4 a = ldf128_nt(rH2, ((unsigned)tok2 * 2048u + 256u * (4 * j + q) + 4u * lane2) * 4u);
#pragma unroll
              for (int i = 0; i < 4; ++i) { acc[16 * j + 4 * q + i] += a[i]; s2 += acc[16 * j + 4 * q + i] * acc[16 * j + 4 * q + i]; } }
      const float rf = 1.0f / sqrtf(wave_sum(s2) * (1.f / 2048.f) + NORM_EPS);
#pragma unroll
      for (int j = 0; j < 2; ++j)
#pragma unroll
          for (int q = 0; q < 4; ++q) { const f32x4 a = ldf128(rGF, (256u * (4 * j + q) + 4u * lane2) * 4u); f32x4 oa;
#pragma unroll
              for (int i = 0; i < 4; ++i) oa[i] = acc[16 * j + 4 * q + i] * rf * a[i];
              float* op = OUT + (size_t)tok2 * 2048 + 256 * (4 * j + q) + 4 * lane2;
              __builtin_nontemporal_store(oa, (GAS f32x4*)op); }
    }
}
}
#ifndef MK_N_LAUNCHES
#define MK_N_LAUNCHES 1
#endif
#define MK_PROBE_PH -1
#define MK_PROBE_DIV 2
constexpr int N_PHASES = 9;
constexpr int N_LAUNCHES = MK_N_LAUNCHES;
struct Args { const float* in[19]; float* out; unsigned char* ws; int ph_lo, ph_hi; };
static_assert(sizeof(Args) == 19 * 8 + 8 + 8 + 8, "no padding");

__global__ void __launch_bounds__(NWAVES * 64, 2) hybrid_fwd(Args args) {
    extern __shared__ __attribute__((aligned(16))) unsigned char lds_raw[];
    Frame F;
    F.lds = (LAS unsigned char*)lds_raw;
    F.MISC = (volatile LAS unsigned*)(F.lds + MISC_OFF);
    F.tid = threadIdx.x; F.lane = F.tid & 63; F.wave = __builtin_amdgcn_readfirstlane(F.tid >> 6);
    F.G = gridDim.x; { const int bx = blockIdx.x; F.vcu = (F.G % 8 == 0) ? (bx % 8) * (F.G / 8) + bx / 8 : bx; }
    F.ws = args.ws; F.out = args.out;
#pragma unroll
    for (int i = 0; i < 19; ++i) F.in[i] = args.in[i];
    for (int u = F.tid; u < (LDS_BYTES - LDSCTL_OFF) / 4; u += NWAVES * 64) ((LAS unsigned*)(F.lds + LDSCTL_OFF))[u] = 0u;
    __syncthreads();
    unsigned* ctl = (unsigned*)(F.ws + WS_CTL);
    XcdBarrier bar; bar.bar = ctl + CW_BAR; bar.x = 0; bar.st = nullptr;
    if (N_LAUNCHES == 1 && blockIdx.x == 0) {
        for (int i = F.tid; i < XCD_BAR_WORDS; i += NWAVES * 64) __hip_atomic_store(ctl + CW_BAR + i, 0u, __ATOMIC_RELAXED, __HIP_MEMORY_SCOPE_AGENT);
        if (F.tid == 0) __hip_atomic_store(ctl + CW_DONE, 0u, __ATOMIC_RELAXED, __HIP_MEMORY_SCOPE_AGENT);
        __builtin_amdgcn_fence(__ATOMIC_RELEASE, "agent"); asm volatile("s_waitcnt vmcnt(0)" ::: "memory");
        __syncthreads();
        if (F.tid == 0) { __builtin_amdgcn_fence(__ATOMIC_RELEASE, "agent"); __hip_atomic_store(ctl + CW_FLAG, CTL_MAGIC, __ATOMIC_RELAXED, __HIP_MEMORY_SCOPE_AGENT); } }
    const int lo = args.ph_lo, hi = args.ph_hi;
#define IN(k) (lo <= (k) && (k) < hi)
#if MK_PROBE_PH >= 0
    unsigned long long tp0 = (MK_PROBE_PH == 0 || MK_PROBE_PH == 9) ? __builtin_amdgcn_s_memrealtime() : 0ull, tp1 = 0ull;
#define SEAM(k) do { if (IN(k) && IN((k) + 1)) xcd_barrier(bar); if (MK_PROBE_PH == (k)) tp1 = __builtin_amdgcn_s_memrealtime(); if (MK_PROBE_PH == (k) + 1) tp0 = __builtin_amdgcn_s_memrealtime(); } while (0)
#else
#define SEAM(k) do { if (IN(k) && IN((k) + 1)) xcd_barrier(bar); } while (0)
#endif
    const size_t T2048 = (size_t)256 * 2048 * 2, T1024 = (size_t)256 * 1024 * 2, T512 = (size_t)256 * 512 * 2;
    float* cosT = WSP(float, WS_COS); float* sinT = WSP(float, WS_SIN);
    float* ssq_q = WSP(float, WS_SSQ_Q); float* ssq_kv = WSP(float, WS_SSQ_KV); float* ssq2 = WSP(float, WS_SSQ_2);

    if (IN(0)) { p0_prologue<0>(F, F.vcu, F.G); }
    if (N_LAUNCHES == 1) {
        if (F.tid == 0) { unsigned sp = 0u; while (__hip_atomic_load(ctl + CW_FLAG, __ATOMIC_RELAXED, __HIP_MEMORY_SCOPE_AGENT) != CTL_MAGIC && ++sp < (1u << 24)) __builtin_amdgcn_s_sleep(2);
            __builtin_amdgcn_fence(__ATOMIC_ACQUIRE, "agent"); }
        __syncthreads();
        bar = xcd_barrier_post(ctl + CW_BAR, F.MISC + 8); }
    SEAM(0);
    if (IN(1)) {
        SchedP1 S{F.G, (int)blockIdx.x, (const char*)(F.ws + WS_HN1), (const char*)(F.ws + WS_WIN), (const char*)(F.ws + WS_WVT), T1024};
        EpiP1 E{WSP(bf16_t, WS_NAQ), WSP(bf16_t, WS_NAK), WSP(bf16_t, WS_VT), WSP(unsigned char, WS_CQ), WSP(unsigned char, WS_CKV), WSP(bf16_t, WS_KR), WSP(bf16_t, WS_GA), WSP(bf16_t, WS_GB), ssq_q, ssq_kv, cosT, sinT};
        pg8::gemm_phase<EpiP1, SchedP1, true, -6>(F.lds, 2048, S, E);
        { const int extra = P1_UNITS % F.G, bx = (int)blockIdx.x; if (extra != 0 && bx >= extra) p0_prologue<1>(F, bx - extra, F.G - extra); else if (extra == 0) p0_prologue<1>(F, bx, F.G); }
    } SEAM(1);
    if (IN(2)) {
        LAS float* relb = (LAS float*)F.lds + 64; LAS float* metab = relb + 16 * 15 * 31 + 128; LAS float* wsf = metab + 256 + F.wave * 64;
        for (int i = F.tid; i < 16 * 15 * 31; i += NWAVES * 64) relb[i] = F.in[4][i];
        if (F.tid < 256) metab[F.tid] = F.in[5][F.tid];
        __syncthreads();
        const int gw = F.vcu * NWAVES + F.wave, NGW = F.G * NWAVES;
        for (int task = gw; task < NBATCH * 16 * 32 * 2; task += NGW)
            att::na_task(task, WSP(bf16_t, WS_NAQ), WSP(bf16_t, WS_NAK), WSP(bf16_t, WS_VT), WSP(unsigned char, WS_ONA), relb, metab, wsf, F.lane);
        __syncthreads();
    } SEAM(2);
    if (IN(3)) {
        SchedP3 S{F.G, (int)blockIdx.x, (const char*)(F.ws + WS_CQ), (const char*)(F.ws + WS_CKV), (const char*)(F.ws + WS_WUQ), (const char*)(F.ws + WS_WUKV), T512 / 2};
        EpiP3 E{WSP(bf16_t, WS_QM), WSP(bf16_t, WS_KN), WSP(bf16_t, WS_VV), ssq_q, ssq_kv, cosT, sinT};
        pg8::gemm_phase<EpiP3, SchedP3, true, -4>(F.lds, 512, S, E);
    } SEAM(3);
    if (IN(4)) {
        for (int id = F.vcu; id < NBATCH * 16 * 8; id += F.G) { const int bh = id >> 3, qb = id & 7;
            att::mla_unit(bh >> 4, bh & 15, qb, WSP(bf16_t, WS_QM), WSP(bf16_t, WS_KN), WSP(bf16_t, WS_KR), WSP(bf16_t, WS_VV), WSP(unsigned char, WS_OMLA), (LAS char*)F.lds); }
        __syncthreads();
    } SEAM(4);
    if (IN(5)) {
        { SchedGrid S{F.G, (int)blockIdx.x, 64, 8, (const char*)(F.ws + WS_ONA), (const char*)(F.ws + WS_WNA), T512};
          EpiP5a E{WSP(bf16_t, WS_GA), WSP(bf16_t, WS_T1)};
          pg8::gemm_phase<EpiP5a, SchedGrid, true, -9>(F.lds, 1024, S, E); }
        { SchedGrid S{F.G, (int)blockIdx.x, 64, 8, (const char*)(F.ws + WS_OMLA), (const char*)(F.ws + WS_WMLA), T1024};
          EpiP5b E{WSP(bf16_t, WS_GB), WSP(bf16_t, WS_T1), WSP(unsigned char, WS_MERGED)};
          pg8::gemm_phase<EpiP5b, SchedGrid, true, -11>(F.lds, 2048, S, E); }
    } SEAM(5);
    if (IN(6)) {
        { SchedGrid S{F.G, (int)blockIdx.x, 64, 8, (const char*)(F.ws + WS_MERGED), (const char*)(F.ws + WS_WOUT), T1024};
          EpiP6 E{F.in[0], WSP(float, WS_H2), WSP(bf16_t, WS_H2B), ssq2};
          pg8::gemm_phase<EpiP6, SchedGrid, true, -11>(F.lds, 2048, S, E); }
        {
          for (unsigned i = (unsigned)F.vcu * 512u + F.tid; i < 2u * 16384u * 64u; i += (unsigned)F.G * 512u) { const unsigned isv = i >> 20, row = (i >> 6) & 16383u, l = i & 63u; const float sc = isv ? 4.f : 64.f;
              const float* src = (isv ? F.in[17] : F.in[16]) + (size_t)row * 2048 + 4 * l; peer::v16f_t a, b;
#pragma unroll
              for (int q = 0; q < 4; ++q) { const f32x4 x0 = *(const GAS f32x4*)(src + 256 * q) * sc, x1 = *(const GAS f32x4*)(src + 1024 + 256 * q) * sc;
#pragma unroll
                  for (int e = 0; e < 4; ++e) { const int k0_ = 4 * q + e, k1_ = 16 + 4 * q + e;
                      if (k0_ & 1) b[k0_ >> 1] = x0[e]; else a[k0_ >> 1] = x0[e];
                      if (k1_ & 1) b[k1_ >> 1] = x1[e]; else a[k1_ >> 1] = x1[e]; } }
              const peer::v6u_t w = __builtin_amdgcn_cvt_scalef32_2xpk16_fp6_f32(a, b, 1.0f);
              unsigned char* rec = WSP(unsigned char, WS_U) + (size_t)row * 3072 + (isv ? 1536 : 0);
              *(GAS u32x4*)(rec + l * 16) = (u32x4){w[0], w[1], w[2], w[3]}; *(GAS u32x2*)(rec + 1024 + l * 8) = (u32x2){w[4], w[5]}; } }
    } SEAM(6);
    if (IN(7)) {
        SchedGrid S{F.G, (int)blockIdx.x, 64, 8, (const char*)(F.ws + WS_H2B), (const char*)(F.ws + WS_WSC), T2048};
        EpiP7 E{ssq2, WSP(float, WS_SC)};
        pg8::gemm_phase<EpiP7, SchedGrid>(F.lds, 2048, S, E);
    } SEAM(7);
    if (IN(8)) {
        const int nch = (MREAL / peer::CH - F.vcu + F.G - 1) / F.G; const bool both_first = (nch == 2) && (F.vcu & 1);
        for (int op = 0; op < 2 * nch; ++op) {
            const bool sel = both_first ? (op < 2) : !(op & 1); const int ci = both_first ? (op & 1) : (op >> 1), chunk = F.vcu + ci * F.G;
            const int b2 = both_first ? ci : 0;
            LAS int* SE = (LAS int*)(F.lds + (b2 ? peer::OFF_SE2 : peer::OFF_SE)); LAS float* SG = (LAS float*)(F.lds + (b2 ? peer::OFF_SG2 : peer::OFF_SG));
            if (sel) peer::peer_select(chunk, WSP(float, WS_SC), (LAS char*)F.lds, F.tid, SE, SG);
            else peer::peer_gather(chunk, WSP(float, WS_H2), WSP(unsigned char, WS_U), F.in[13], F.in[18], F.out, F.tid, SE, SG); }
    }
#if MK_PROBE_PH >= 0
    xcd_barrier(bar); tp1 = (MK_PROBE_PH >= 8) ? __builtin_amdgcn_s_memrealtime() : tp1;
    if (blockIdx.x == 0 && F.tid == 0) F.out[0] = (float)(tp1 - tp0) * (0.01f / MK_PROBE_DIV);
#endif
    if (N_LAUNCHES == 1 && F.tid == 0) { const unsigned old = xb_add(ctl + CW_DONE, 1u); if (old + 1u == gridDim.x) __hip_atomic_store(ctl + CW_FLAG, 0u, __ATOMIC_RELAXED, __HIP_MEMORY_SCOPE_AGENT); }
#undef IN
#undef SEAM
}

extern "C" void kernel_launch(void* const* d_in, const int* in_sizes, int n_in, void* d_out, int out_size, void* d_ws, size_t ws_size, hipStream_t stream) {
    static int grid = 0;
    if (grid == 0) {
        if (n_in != 19 || in_sizes[0] != MREAL * DM || out_size != MREAL * DM || ws_size < WS_END) {
            fprintf(stderr, "kernel_launch: shape/workspace mismatch: n_in %d in0 %d out %d ws %zu (need %zu); nothing launched\n", n_in, n_in > 0 ? in_sizes[0] : -1, out_size, ws_size, (size_t)WS_END); grid = -1; return; }
        int dev = 0, cus = 0, per_cu = 0;
        if (hipGetDevice(&dev) != hipSuccess || hipDeviceGetAttribute(&cus, hipDeviceAttributeMultiprocessorCount, dev) != hipSuccess) { fprintf(stderr, "kernel_launch: device query failed\n"); grid = -1; return; }
        if (hipFuncSetAttribute((const void*)hybrid_fwd, hipFuncAttributeMaxDynamicSharedMemorySize, LDS_BYTES) != hipSuccess) { fprintf(stderr, "kernel_launch: hipFuncSetAttribute failed\n"); grid = -1; return; }
        if (hipOccupancyMaxActiveBlocksPerMultiprocessor(&per_cu, (const void*)hybrid_fwd, NWAVES * 64, LDS_BYTES) != hipSuccess || per_cu < 1)
            fprintf(stderr, "kernel_launch: note: occupancy query reports %d workgroups per CU\n", per_cu);
        (void)hipGetLastError();
        grid = cus;
    }
    if (grid < 0) return;
    if (N_LAUNCHES != 1 && hipMemsetAsync((char*)d_ws + WS_CTL, 0, CTL_ZERO_BYTES, stream) != hipSuccess) { fprintf(stderr, "kernel_launch: hipMemsetAsync failed\n"); return; }
    Args a{};
    for (int i = 0; i < 19; ++i) a.in[i] = (const float*)d_in[i];
    a.out = (float*)d_out; a.ws = (unsigned char*)d_ws;
    for (int li = 0; li < N_LAUNCHES; ++li) {
        a.ph_lo = (N_LAUNCHES == 1) ? 0 : li; a.ph_hi = (N_LAUNCHES == 1) ? N_PHASES : li + 1;
        hipLaunchKernelGGL(hybrid_fwd, dim3(grid), dim3(NWAVES * 64), LDS_BYTES, stream, a);
        const hipError_t le = hipPeekAtLastError();
        if (le != hipSuccess) { fprintf(stderr, "kernel_launch: launch %d failed: %s\n", li, hipGetErrorName(le)); break; }
    }
}
```

```cpp
#include <hip/hip_runtime.h>
#include <cstdio>
#include <cstdint>

#define LAS __attribute__((address_space(3)))
#define GAS __attribute__((address_space(1)))
typedef unsigned short bf16_t;
typedef short bf16x8 __attribute__((ext_vector_type(8)));
typedef short s16x4 __attribute__((ext_vector_type(4)));
typedef float f32x4 __attribute__((ext_vector_type(4)));
typedef float f32x2 __attribute__((ext_vector_type(2)));
typedef float f32x16 __attribute__((ext_vector_type(16)));
typedef unsigned u32x4 __attribute__((ext_vector_type(4)));
typedef unsigned u32x2 __attribute__((ext_vector_type(2)));

constexpr int DM = 2048, NBATCH = 8, SEQ = 2048, NMETA = 16;
constexpr int MREAL = NBATCH * SEQ;
constexpr int MPAD = MREAL + 256;
constexpr int NPOS = SEQ + NMETA;
constexpr float NORM_EPS = 1e-6f;
constexpr int C_NAQ = 0, C_NAK = 1024, C_CQ = 2048, C_CKV = 2560, C_GA = 3072, C_GB = 5120, C_KR = 7168, NMAIN = 7424;
constexpr int VT_PITCH = MPAD;

constexpr size_t MiB = 1u << 20;
constexpr size_t WS_CTL = 0, CTL_ZERO_BYTES = 1 * MiB;
constexpr size_t WS_SSQ_Q = 481 * MiB, WS_SSQ_KV = 482 * MiB, WS_SSQ_2 = 486 * MiB;
constexpr size_t WS_COS = 1 * MiB, WS_SIN = 1 * MiB + 512 * 1024;
constexpr size_t WS_WUQ = 2 * MiB, WS_WUKV = 5 * MiB, WS_WNA = 9 * MiB, WS_WMLA = 13 * MiB, WS_WOUT = 21 * MiB, WS_WSC = 29 * MiB;
constexpr size_t WS_GA = 37 * MiB, WS_GB = 101 * MiB;
constexpr size_t WS_KR = 165 * MiB;
constexpr size_t WS_WIN = 167 * MiB + 256 * 1024, WS_WVT = WS_WIN + 29 * MiB;
constexpr size_t WS_ONA = 190 * MiB;
constexpr size_t WS_NAQ = 222 * MiB, WS_NAK = 254 * MiB, WS_VT = WS_NAK + 32 * MiB + 512 * 1024;
constexpr size_t WS_HN1 = 319 * MiB;
constexpr size_t WS_CQ = 448 * MiB, WS_CKV = 464 * MiB;
constexpr size_t WS_QM = 222 * MiB, WS_KN = 318 * MiB, WS_VV = 383 * MiB;
constexpr size_t WS_OMLA = 448 * MiB;
constexpr size_t WS_MERGED = 222 * MiB, WS_T1 = 286 * MiB;
constexpr size_t WS_H2 = 37 * MiB, WS_H2B = 293 * MiB;
constexpr size_t WS_U = 357 * MiB, WS_V = 421 * MiB;
constexpr size_t WS_SC = 165 * MiB;
constexpr size_t WS_END = 512 * MiB;
static_assert(WS_CKV + (size_t)MPAD * 512 * 2 <= WS_SSQ_Q && WS_SSQ_Q + (size_t)8 * MPAD * 4 <= WS_SSQ_KV && WS_SSQ_KV + (size_t)8 * MPAD * 4 <= 483 * MiB && WS_V + 64 * MiB <= WS_SSQ_2 && WS_SSQ_2 + (size_t)32 * MREAL * 4 <= WS_END, "ssq slabs");
static_assert(WS_VT + (size_t)1024 * MPAD * 2 <= WS_HN1 && WS_HN1 + (size_t)MPAD * 2048 * 2 <= WS_CQ && WS_CKV + (size_t)MPAD * 512 * 2 <= WS_END, "map P1");
static_assert(WS_WVT + 4 * MiB <= WS_NAQ && WS_KR + (size_t)MPAD * 64 * 2 <= WS_WIN && WS_ONA + 32 * MiB <= WS_NAQ, "map P1b");
static_assert(WS_QM + 96 * MiB <= WS_KN && WS_KN + 65 * MiB <= WS_VV && WS_VV + 65 * MiB <= WS_OMLA && WS_OMLA + 64 * MiB <= WS_END, "map P3");
static_assert(WS_T1 + 128 * MiB <= WS_OMLA && WS_H2 + 128 * MiB <= WS_KR && WS_SC + 128 * MiB <= WS_H2B && WS_H2B + 64 * MiB <= WS_U && WS_V + 64 * MiB <= WS_END, "map P5+");

constexpr int CW_BAR = 4096;

constexpr int RING_BYTES = 131072;
constexpr int LDSCTL_OFF = RING_BYTES, MISC_OFF = LDSCTL_OFF + 320;
constexpr int LDS_BYTES = 147456;
constexpr int NWAVES = 8;

#define LDS_WAIT() asm volatile("s_waitcnt lgkmcnt(0)" ::: "memory")
#define VM_WAIT() asm volatile("s_waitcnt vmcnt(0)" ::: "memory")
#define SBAR() __builtin_amdgcn_sched_barrier(0)
typedef __bf16 bf16x2_t __attribute__((ext_vector_type(2)));
__device__ __forceinline__ unsigned cvt_pk_bf16(float lo, float hi) { const f32x2 v = {lo, hi}; const bf16x2_t b = __builtin_convertvector(v, bf16x2_t); return __builtin_bit_cast(unsigned, b); }
__device__ __forceinline__ float bf_lo(unsigned w) { return __uint_as_float(w << 16); }
__device__ __forceinline__ float bf_hi(unsigned w) { return __uint_as_float(w & 0xffff0000u); }
__device__ __forceinline__ u32x4 pack8(const f32x4 a, const f32x4 b) { u32x4 w; w.x = cvt_pk_bf16(a[0], a[1]); w.y = cvt_pk_bf16(a[2], a[3]); w.z = cvt_pk_bf16(b[0], b[1]); w.w = cvt_pk_bf16(b[2], b[3]); return w; }
__device__ __forceinline__ u32x2 pack8_fp8(f32x4 a, f32x4 b) {
#pragma unroll
    for (int i = 0; i < 4; ++i) { a[i] = __builtin_fminf(__builtin_fmaxf(a[i], -448.f), 448.f); b[i] = __builtin_fminf(__builtin_fmaxf(b[i], -448.f), 448.f); }
    int w0 = 0, w1 = 0; w0 = __builtin_amdgcn_cvt_pk_fp8_f32(a[0], a[1], w0, false); w0 = __builtin_amdgcn_cvt_pk_fp8_f32(a[2], a[3], w0, true);
    w1 = __builtin_amdgcn_cvt_pk_fp8_f32(b[0], b[1], w1, false); w1 = __builtin_amdgcn_cvt_pk_fp8_f32(b[2], b[3], w1, true); return (u32x2){(unsigned)w0, (unsigned)w1}; }
__device__ __forceinline__ unsigned char f32_to_fp8(float x) { x = __builtin_fminf(__builtin_fmaxf(x, -448.f), 448.f); return (unsigned char)(__builtin_amdgcn_cvt_pk_fp8_f32(x, 0.f, 0, false) & 0xff); }
__device__ __forceinline__ u32x2 pack4(const f32x4 a) { u32x2 w; w.x = cvt_pk_bf16(a[0], a[1]); w.y = cvt_pk_bf16(a[2], a[3]); return w; }
__device__ __forceinline__ float wave_sum(float v) {
#pragma unroll
    for (int o = 1; o < 64; o <<= 1) v += __shfl_xor(v, o);
    return v;
}
__device__ __forceinline__ float sigmoidf_(float x) { return __builtin_amdgcn_rcpf(1.0f + __builtin_amdgcn_exp2f(-1.4426950408889634f * x)); }
__device__ __forceinline__ int crow(int r, int hi) { return (r & 3) + 8 * (r >> 2) + 4 * hi; }
#define PG8_AUX 0
namespace pg8 {
constexpr int BM = 256, BK = 64, HALF = 128, HTB = HALF * BK * 2  , STAGE_BYTES = 8 * HTB, NXCD = 8, WGM = 8;
__host__ __device__ __forceinline__ int lds_byte(int r, int c) { const int st = (r >> 4) * 2 + (c >> 5), rr = r & 15, cc = c & 31, ob = rr * 64 + cc * 2; return st * 1024 + (ob ^ (((ob >> 9) & 1) << 5)); }
__host__ __device__ __forceinline__ void stage_rc(int b, int& R, int& C) { const int st = b / 1024, sb = b % 1024, swz = sb ^ (((sb >> 9) & 1) << 5); R = (st >> 1) * 16 + swz / 64; C = (st & 1) * 32 + (swz % 64) / 2; }
__host__ __device__ __forceinline__ int perm32(int rho) { const int n = rho >> 4, i = rho & 15; return 8 * (i >> 2) + 4 * n + (i & 3); }

struct Unit { int pm, pn, kind; };

__device__ __forceinline__ void grid_order(int L, int nM, int nN, int& pm, int& pn) {
    const int nwg = nM * nN; int wgid = L;
    { const int q = nwg / NXCD, r = nwg % NXCD, xcd = wgid % NXCD, off = wgid / NXCD; wgid = (xcd < r ? xcd * (q + 1) : r * (q + 1) + (xcd - r) * q) + off; }
    const int nig = WGM * nN, gid = wgid / nig, fm = gid * WGM, gsz = (nM - fm) < WGM ? (nM - fm) : WGM;
    pm = fm + ((wgid % nig) % gsz); pn = (wgid % nig) / gsz;
}

typedef int v8i_t __attribute__((ext_vector_type(8)));
template <class Epi, class Sched, bool F8 = false, int F8_SCALE_EXP = 0>
__device__ __forceinline__ void gemm_phase(LAS unsigned char* lds, const int K, const Sched& S, const Epi& E) {
    const int tid = threadIdx.x, wid = __builtin_amdgcn_readfirstlane(tid >> 6), lane = tid & 63, wr = wid >> 2, wc = wid & 3, fr = lane & 15, fq = lane >> 4;
    int f8sa = 0x01010101 * (127 + F8_SCALE_EXP), f8sb = 0x7f7f7f7f; asm volatile("" : "+v"(f8sa), "+v"(f8sb));
    const int Kb = F8 ? K : 2 * K;
    const int nt = Kb / 128;
    unsigned voffA[2], voffB[2];
#pragma unroll
    for (int i = 0; i < 2; ++i) { int R, C; stage_rc(tid * 16 + i * 8192, R, C); const int Rb = Epi::PERM ? ((R & ~31) + perm32(R & 31)) : R;
        voffA[i] = (unsigned)(R * Kb + C * 2); voffB[i] = (unsigned)(Rb * Kb + C * 2); }
    const size_t kstep = (size_t)128;
    const size_t hstep = (size_t)HALF * Kb;
    const unsigned ldsw = (unsigned)wid * 1024u;
    const int aoff = lds_byte(wr * 64 + fr, F8 ? fq * 16 : fq * 8), boff = lds_byte(wc * 32 + fr, F8 ? fq * 16 : fq * 8);
#define PG8_SA(b, h) (((b) * 2 + (h)) * HTB)
#define PG8_SB(b, h) ((4 + (b) * 2 + (h)) * HTB)
#define PG8_STAGE(bufoff, gbase, voff) do { _Pragma("unroll") for (int _i = 0; _i < 2; ++_i) \
        __builtin_amdgcn_global_load_lds((const unsigned*)((const char*)(gbase) + (voff)[_i]), (LAS unsigned*)(lds + (bufoff) + ldsw + _i * 8192), 16, 0, PG8_AUX); } while (0)
#define PG8_LDA(dst, b, h) do { _Pragma("unroll") for (int m = 0; m < 4; ++m) _Pragma("unroll") for (int k = 0; k < 2; ++k) dst[m][k] = *(const LAS bf16x8*)(lds + PG8_SA(b, h) + aoff + m * 2048 + (F8 ? k * 16 : k * 1024)); } while (0)
#define PG8_LDB(dst, b, h) do { _Pragma("unroll") for (int n = 0; n < 2; ++n) _Pragma("unroll") for (int k = 0; k < 2; ++k) dst[n][k] = *(const LAS bf16x8*)(lds + PG8_SB(b, h) + boff + n * 2048 + (F8 ? k * 16 : k * 1024)); } while (0)
#define PG8_F8OP(X) __builtin_bit_cast(v8i_t, __builtin_shufflevector(X[0], X[1], 0, 1, 2, 3, 4, 5, 6, 7, 8, 9, 10, 11, 12, 13, 14, 15))
#define PG8_MMA(ai, bj, At, Bt) do { __builtin_amdgcn_s_setprio(1); \
        if constexpr (F8) { _Pragma("unroll") for (int m = 0; m < 4; ++m) _Pragma("unroll") for (int n = 0; n < 2; ++n) \
            asm volatile("v_mfma_scale_f32_16x16x128_f8f6f4 %0, %1, %2, %0, %3, %4 op_sel_hi:[0,0,0]" : "+v"(acc[ai][bj][m][n]) : "v"(PG8_F8OP(Bt[n])), "v"(PG8_F8OP(At[m])), "v"(f8sa), "v"(f8sb)); } \
        else { _Pragma("unroll") for (int m = 0; m < 4; ++m) _Pragma("unroll") for (int n = 0; n < 2; ++n) _Pragma("unroll") for (int k = 0; k < 2; ++k) \
            acc[ai][bj][m][n] = __builtin_amdgcn_mfma_f32_16x16x32_bf16(Bt[n][k], At[m][k], acc[ai][bj][m][n], 0, 0, 0); } \
        __builtin_amdgcn_s_setprio(0); } while (0)
#define PG8_WAIT_V(n) asm volatile("s_waitcnt vmcnt(" #n ")" ::: "memory")
#define PG8_WAIT_L(n) asm volatile("s_waitcnt lgkmcnt(" #n ")" ::: "memory")
#define PG8_BAR __builtin_amdgcn_s_barrier()
#define PG8_SCHED __builtin_amdgcn_sched_barrier(0)
    Unit cur, nxt; int ui = 0;
    if (!S.next(0, cur)) return;
    f32x4 acc[2][2][4][2];
#pragma unroll
    for (int a = 0; a < 2; ++a)
#pragma unroll
        for (int b = 0; b < 2; ++b)
#pragma unroll
            for (int m = 0; m < 4; ++m)
#pragma unroll
                for (int n = 0; n < 2; ++n) acc[a][b][m][n] = (f32x4){0.f, 0.f, 0.f, 0.f};
    bf16x8 At[4][2], B0[2][2], B1[2][2];
    const char* cA = S.pa(cur); const char* cB = S.pb(cur);
    PG8_STAGE(PG8_SB(0, 0), cB, voffB); PG8_STAGE(PG8_SB(0, 1), cB + hstep, voffB); PG8_STAGE(PG8_SA(0, 0), cA, voffA); PG8_STAGE(PG8_SA(0, 1), cA + hstep, voffA);
    if (wr == 1) PG8_BAR;
    PG8_WAIT_V(2); PG8_BAR;
    PG8_STAGE(PG8_SB(1, 0), cB + kstep, voffB); PG8_STAGE(PG8_SA(1, 0), cA + kstep, voffA); PG8_STAGE(PG8_SB(1, 1), cB + hstep + kstep, voffB);
    PG8_WAIT_V(6); PG8_BAR;
    for (;;) {
        const bool has_next = S.next(ui + 1, nxt);
        const char* nA = has_next ? S.pa(nxt) : cA; const char* nB = has_next ? S.pb(nxt) : cB;
        for (int t = 0; t < nt; t += 2) {
            const bool last = (t == nt - 2);
            const char* a1 = cA + (size_t)(t + 1) * kstep;
            const char* a2 = last ? nA : cA + (size_t)(t + 2) * kstep; const char* b2 = last ? nB : cB + (size_t)(t + 2) * kstep;
            const char* a3 = a2 + kstep; const char* b3 = b2 + kstep;
            PG8_LDB(B0, 0, 0); PG8_LDB(B1, 0, 1); PG8_SCHED; PG8_LDA(At, 0, 0); PG8_STAGE(PG8_SA(1, 1), a1 + hstep, voffA);
            PG8_WAIT_V(8); PG8_WAIT_L(0); PG8_BAR; PG8_MMA(0, 0, At, B0); PG8_MMA(0, 1, At, B1); PG8_BAR; PG8_SCHED;
            PG8_LDA(At, 0, 1); PG8_STAGE(PG8_SB(0, 0), b2, voffB); PG8_STAGE(PG8_SB(0, 1), b2 + hstep, voffB); PG8_STAGE(PG8_SA(0, 0), a2, voffA);
            PG8_WAIT_V(8); PG8_WAIT_L(0); PG8_BAR; PG8_MMA(1, 0, At, B0); PG8_MMA(1, 1, At, B1); PG8_BAR; PG8_SCHED;
            PG8_LDB(B0, 1, 0); PG8_LDB(B1, 1, 1); PG8_SCHED; PG8_LDA(At, 1, 0); PG8_STAGE(PG8_SA(0, 1), a2 + hstep, voffA);
            PG8_WAIT_V(8); PG8_WAIT_L(0); PG8_BAR; PG8_MMA(0, 0, At, B0); PG8_MMA(0, 1, At, B1); PG8_BAR; PG8_SCHED;
            PG8_LDA(At, 1, 1); PG8_STAGE(PG8_SB(1, 0), b3, voffB); PG8_STAGE(PG8_SB(1, 1), b3 + hstep, voffB); PG8_STAGE(PG8_SA(1, 0), a3, voffA);
            PG8_WAIT_V(8); PG8_WAIT_L(0); PG8_BAR; PG8_MMA(1, 0, At, B0); PG8_MMA(1, 1, At, B1); PG8_BAR; PG8_SCHED;
        }
        if (wr == 0) PG8_BAR;
        if constexpr (F8) asm volatile("s_nop 15\n\ts_nop 7" ::: "memory");
        if constexpr (Epi::HAS_PRE) {
            E.pre(cur, (LAS float*)(lds + STAGE_BYTES + 1024), tid); PG8_WAIT_L(0); PG8_BAR; }
        E(acc, cur, wr, wc, fr, fq, (const LAS float*)(lds + STAGE_BYTES + 1024));
        if (!has_next) break;
#pragma unroll
        for (int a = 0; a < 2; ++a)
#pragma unroll
            for (int b = 0; b < 2; ++b)
#pragma unroll
                for (int m = 0; m < 4; ++m)
#pragma unroll
                    for (int n = 0; n < 2; ++n) acc[a][b][m][n] = (f32x4){0.f, 0.f, 0.f, 0.f};
        cur = nxt; cA = nA; cB = nB; ++ui;
        if (wr == 1) PG8_BAR;
    }
    PG8_WAIT_V(0);
    PG8_BAR;
#undef PG8_SA
#undef PG8_SB
#undef PG8_STAGE
#undef PG8_LDA
#undef PG8_LDB
#undef PG8_MMA
#undef PG8_F8OP
#undef PG8_WAIT_V
#undef PG8_WAIT_L
#undef PG8_BAR
#undef PG8_SCHED
}
}
typedef GAS unsigned gu32;
#define RLX_AGENT __ATOMIC_RELAXED, __HIP_MEMORY_SCOPE_AGENT
#define XB_TMO      128
#define XB_XCNT(j)  (256  + 64 * (j))
#define XB_XSUB(j)  (1280 + 64 * (j))
#define XB_XGEN(j)  (2304 + 64 * (j))
#define XB_TOP      3328
#define XB_TOPGEN   3392
#define XCD_BAR_WORDS 3456
#define XB_SPIN_CAP (1u << 18)
__device__ __forceinline__ unsigned xb_ld(unsigned* p)              { return __hip_atomic_load(p, __ATOMIC_RELAXED, __HIP_MEMORY_SCOPE_AGENT); }
__device__ __forceinline__ unsigned xb_add(unsigned* p, unsigned v) { return __hip_atomic_fetch_add(p, v, __ATOMIC_RELAXED, __HIP_MEMORY_SCOPE_AGENT); }
__device__ __forceinline__ unsigned xb_xcc_id() { return (unsigned)__builtin_amdgcn_s_getreg((3 << 11) | 20) & 0xFu; }
#define XB_SPIN(cond, bar) do { unsigned _sp = 0; while (cond) { __builtin_amdgcn_s_sleep(1); \
    if ((++_sp & 255u) == 0u) { if (xb_ld(&(bar)[XB_TMO])) break; if (_sp > XB_SPIN_CAP) { atomicAdd(&(bar)[XB_TMO], 1u); break; } } } } while (0)
struct XcdBarrier { unsigned* bar; unsigned x; volatile LAS unsigned* st; };
__device__ __forceinline__ XcdBarrier xcd_barrier_post(unsigned* bar, volatile LAS unsigned* st) {
    XcdBarrier b; b.bar = bar; b.x = xb_xcc_id(); b.st = st;
    if (threadIdx.x == 0) (void)xb_add(&bar[XB_XCNT(b.x)], 1u);
    return b;
}
__device__ __forceinline__ void xcd_barrier_complete(unsigned* bar, unsigned x, unsigned& nloc, unsigned& nx) {
    const unsigned G = gridDim.x * gridDim.y * gridDim.z;
    unsigned sum, cnt, mine, sp = 0u;
    for (;;) {
        sum = 0u; cnt = 0u; mine = 0u;
#pragma unroll
        for (unsigned j = 0; j < 16; ++j) { const unsigned c = xb_ld(&bar[XB_XCNT(j)]); sum += c; cnt += (c > 0u) ? 1u : 0u; mine = (j == x) ? c : mine; }
        if (sum == G) break;
        __builtin_amdgcn_s_sleep(1);
        if ((++sp & 255u) == 0u) { if (xb_ld(&bar[XB_TMO])) break; if (sp > XB_SPIN_CAP) { atomicAdd(&bar[XB_TMO], 1u); break; } }
    }
    nloc = mine > 0u ? mine : 1u; nx = cnt > 0u ? cnt : 1u;
}
__device__ __forceinline__ void xcd_barrier(const XcdBarrier& b) {
    asm volatile("s_waitcnt vmcnt(0)" ::: "memory");
    __syncthreads();
    if (threadIdx.x == 0) {
        unsigned* bar = b.bar;
        __builtin_amdgcn_s_waitcnt(0);
        unsigned nloc = b.st[0], nx = b.st[1];
        if (nloc == 0u) { xcd_barrier_complete(bar, b.x, nloc, nx); b.st[0] = nloc; b.st[1] = nx; }
        const unsigned old = xb_add(&bar[XB_XSUB(b.x)], 1u);
        const unsigned gen = old / nloc;
        if (old + 1u == (gen + 1u) * nloc) {
            __builtin_amdgcn_fence(__ATOMIC_RELEASE, "agent");
            asm volatile("s_waitcnt vmcnt(0)" ::: "memory");
            const unsigned og = xb_add(&bar[XB_TOP], 1u);
            const unsigned tg = og / nx;
            if (og + 1u == (tg + 1u) * nx) xb_add(&bar[XB_TOPGEN], 1u);
            else XB_SPIN(xb_ld(&bar[XB_TOPGEN]) == tg, bar);
            __builtin_amdgcn_fence(__ATOMIC_ACQUIRE, "agent");
            xb_add(&bar[XB_XGEN(b.x)], 1u);
            asm volatile("s_waitcnt vmcnt(0)" ::: "memory");
        } else {
            XB_SPIN(xb_ld(&bar[XB_XGEN(b.x)]) == gen, bar);
            __builtin_amdgcn_fence(__ATOMIC_ACQUIRE, "agent");
            asm volatile("s_waitcnt vmcnt(0)" ::: "memory");
        }
    }
    __syncthreads();
}
struct Frame {
    LAS unsigned char* lds;
    volatile LAS unsigned* MISC;
    unsigned char* ws;
    int tid, lane, wave;
    int vcu, G;
    const float* in[19];
    float* out;
};
#define WSP(T, off) ((T*)(F.ws + (off)))

__device__ __forceinline__ void p0_transpose_item(const float* W, int K, int N, int k0, int n0, bf16_t* WT, int drow, bool rope, const float* gain, LAS float* scr, int lane) {
    { f32x4 v[8]; float gk[8];
#pragma unroll
      for (int i = 0; i < 8; ++i) { const int kk = 8 * i + (lane >> 3); v[i] = *(const GAS f32x4*)(W + (size_t)(k0 + kk) * N + n0 + 4 * (lane & 7)); gk[i] = gain ? gain[k0 + kk] : 1.f; }
#pragma unroll
      for (int i = 0; i < 8; ++i) { const int kk = 8 * i + (lane >> 3); LAS float* d = scr + kk * 33 + 4 * (lane & 7);
#pragma unroll
          for (int e = 0; e < 4; ++e) d[e] = v[i][e] * gk[i]; } }
    LDS_WAIT(); asm volatile("" ::: "memory");
    const int c = lane & 7;
#pragma unroll
    for (int j = 0; j < 4; ++j) { const int n = (lane >> 3) + 8 * j; const LAS float* s = scr + (8 * c) * 33 + n;
        u32x4 o; o.x = cvt_pk_bf16(s[0 * 33], s[1 * 33]); o.y = cvt_pk_bf16(s[2 * 33], s[3 * 33]); o.z = cvt_pk_bf16(s[4 * 33], s[5 * 33]); o.w = cvt_pk_bf16(s[6 * 33], s[7 * 33]);
        const int dr = drow + (rope ? (8 * (n >> 2) + (n & 3)) : n);
        *(GAS u32x4*)(WT + (size_t)dr * K + k0 + 8 * c) = o; }
    LDS_WAIT(); asm volatile("" ::: "memory");
}
__device__ __forceinline__ void p0_transpose_item8(const float* W, int K, int N, int k0, int n0, unsigned char* WT, int drow, bool rope, float scale, LAS float* scr, int lane, const float* gain = nullptr) {
    { f32x4 v[8]; float gk[8];
#pragma unroll
      for (int i = 0; i < 8; ++i) { const int kk = 8 * i + (lane >> 3); v[i] = *(const GAS f32x4*)(W + (size_t)(k0 + kk) * N + n0 + 4 * (lane & 7)); gk[i] = gain ? gain[k0 + kk] * scale : scale; }
#pragma unroll
      for (int i = 0; i < 8; ++i) { const int kk = 8 * i + (lane >> 3); LAS float* d = scr + kk * 33 + 4 * (lane & 7);
#pragma unroll
          for (int e = 0; e < 4; ++e) d[e] = v[i][e] * gk[i]; } }
    LDS_WAIT(); asm volatile("" ::: "memory");
#pragma unroll
    for (int j = 0; j < 2; ++j) { const int q = lane + 64 * j, n = q >> 2, c = q & 3; const LAS float* s = scr + (16 * c) * 33 + n; u32x4 o;
#pragma unroll
        for (int d = 0; d < 4; ++d) { int w = 0; w = __builtin_amdgcn_cvt_pk_fp8_f32(s[(4 * d) * 33], s[(4 * d + 1) * 33], w, false); w = __builtin_amdgcn_cvt_pk_fp8_f32(s[(4 * d + 2) * 33], s[(4 * d + 3) * 33], w, true); o[d] = (unsigned)w; }
        const int dr = drow + (rope ? (8 * (n >> 2) + (n & 3)) : n);
        *(GAS u32x4*)(WT + (size_t)dr * K + k0 + 16 * c) = o; }
    LDS_WAIT(); asm volatile("" ::: "memory");
}
__device__ __forceinline__ void rms_row_to_fp8(const float* xrow, const float* g, unsigned char* orow, int lane) {
    const GAS f32x4* xr = (const GAS f32x4*)xrow + lane; const GAS f32x4* gr = (const GAS f32x4*)g + lane;
    f32x4 v[8]; float s = 0.f;
#pragma unroll
    for (int j = 0; j < 8; ++j) { v[j] = xr[64 * j]; s += (v[j].x * v[j].x + v[j].y * v[j].y) + (v[j].z * v[j].z + v[j].w * v[j].w); }
    const float rstd = 1.0f / sqrtf(wave_sum(s) * (1.f / DM) + NORM_EPS);
    GAS unsigned* o4 = (GAS unsigned*)orow + lane;
#pragma unroll
    for (int j = 0; j < 8; ++j) { const f32x4 y = (v[j] * rstd) * gr[64 * j]; int w = 0; w = __builtin_amdgcn_cvt_pk_fp8_f32(y[0], y[1], w, false); w = __builtin_amdgcn_cvt_pk_fp8_f32(y[2], y[3], w, true); o4[64 * j] = (unsigned)w; }
}
__device__ __forceinline__ void rms_row_to_bf16(const float* xrow, const float* g, bf16_t* orow, int lane) {
    const GAS f32x4* xr = (const GAS f32x4*)xrow + lane; const GAS f32x4* gr = (const GAS f32x4*)g + lane;
    f32x4 v[8]; float s = 0.f;
#pragma unroll
    for (int j = 0; j < 8; ++j) { v[j] = xr[64 * j]; s += (v[j].x * v[j].x + v[j].y * v[j].y) + (v[j].z * v[j].z + v[j].w * v[j].w); }
    const float rstd = 1.0f / sqrtf(wave_sum(s) * (1.f / DM) + NORM_EPS);
    GAS u32x2* o8 = (GAS u32x2*)orow + lane;
#pragma unroll
    for (int j = 0; j < 8; ++j) { const f32x4 gg = gr[64 * j]; o8[64 * j] = pack4((v[j] * rstd) * gg); }
}
template <int PART>
__device__ __forceinline__ void p0_prologue(Frame& F, int rank, int nrank) {
    LAS float* scr = (LAS float*)(F.lds + F.wave * 16384);
    const int gw = rank * NWAVES + F.wave, NGW = nrank * NWAVES, lane = F.lane; const int gt = rank * 512 + F.tid, NGT = nrank * 512;
    unsigned char* WIN = WSP(unsigned char, WS_WIN); unsigned char* WVT = WSP(unsigned char, WS_WVT);
    constexpr int I_IN = 32 * 258, I_UQ = 8 * 96, I_UKV = 8 * 128, I_NA = 16 * 64, I_MLA = 32 * 64, I_OUT = 32 * 64;
    constexpr int NEARLY = I_IN + I_UQ + I_UKV, NITEMS = NEARLY + I_NA + I_MLA + I_OUT;
    for (int it = (PART == 0 ? 0 : NEARLY) + gw; it < (PART == 0 ? NEARLY : NITEMS); it += NGW) {
        int r = it;
        if (r < I_IN) { const int kb = r / 258, sb = r % 258, n0 = 32 * sb, k0 = 64 * kb; const float* W = F.in[3];
            unsigned char* dst = WIN; int drow; bool rope = false;
            if (n0 < 1024) drow = C_NAQ + n0;
            else if (n0 < 2048) drow = C_NAK + (n0 - 1024);
            else if (n0 < 3072) { dst = WVT; drow = n0 - 2048; }
            else if (n0 < 3584) drow = C_CQ + (n0 - 3072);
            else if (n0 < 4096) drow = C_CKV + (n0 - 3584);
            else if (n0 < 4160) { drow = C_KR + ((n0 - 4096) ? 4 : 0); rope = true; }
            else if (n0 < 6208) drow = C_GA + (n0 - 4160);
            else drow = C_GB + (n0 - 6208);
            p0_transpose_item8(W, 2048, 8256, k0, n0, dst, drow, rope, 64.f, scr, lane); continue; } r -= I_IN;
        if (r < I_UQ) { const int kb = r / 96, sb = r % 96, n0 = 32 * sb, k0 = 64 * kb; const int hd = n0 / 192, w = n0 % 192;
            int drow = n0; bool rope = false; if (w >= 128) { rope = true; drow = hd * 192 + 128 + ((w - 128) ? 4 : 0); }
            p0_transpose_item8(F.in[7], 512, 3072, k0, n0, WSP(unsigned char, WS_WUQ), drow, rope, 16.f, scr, lane, F.in[6]); continue; } r -= I_UQ;
        if (r < I_UKV) { const int kb = r / 128, sb = r % 128; p0_transpose_item8(F.in[9], 512, 4096, 64 * kb, 32 * sb, WSP(unsigned char, WS_WUKV), 32 * sb, false, 16.f, scr, lane, F.in[8]); continue; } r -= I_UKV;
        if (r < I_NA) { const int kb = r / 64, sb = r % 64; p0_transpose_item8(F.in[10], 1024, 2048, 64 * kb, 32 * sb, WSP(unsigned char, WS_WNA), 32 * sb, false, 32.f, scr, lane); continue; } r -= I_NA;
        if (r < I_MLA) { const int kb = r / 64, sb = r % 64; p0_transpose_item8(F.in[11], 2048, 2048, 64 * kb, 32 * sb, WSP(unsigned char, WS_WMLA), 32 * sb, false, 64.f, scr, lane); continue; } r -= I_MLA;
        { const int kb = r / 64, sb = r % 64; p0_transpose_item8(F.in[12], 2048, 2048, 64 * kb, 32 * sb, WSP(unsigned char, WS_WOUT), 32 * sb, false, 64.f, scr, lane); }
    }
    if (PART == 0) { GAS u32x4* z = (GAS u32x4*)(WIN + (size_t)(C_KR + 64) * 2048); const int n16 = (NMAIN - C_KR - 64) * 2048 / 16;
      for (int i = gt; i < n16; i += NGT) z[i] = (u32x4){0u, 0u, 0u, 0u}; }
    if (PART == 0) { unsigned char* HN1 = WSP(unsigned char, WS_HN1);
#define P0_ROWSRC(m_) (((m_) < MREAL) ? F.in[0] + (size_t)(m_) * DM : F.in[1] + (size_t)((m_) - MREAL) * DM)
      { f32x4 v[8]; int m = gw;
        if (m < MREAL + NMETA) { const GAS f32x4* xr = (const GAS f32x4*)P0_ROWSRC(m) + lane;
#pragma unroll
            for (int j = 0; j < 8; ++j) v[j] = xr[64 * j]; }
        const GAS f32x4* gr = (const GAS f32x4*)F.in[2] + lane;
        while (m < MREAL + NMETA) { const int mn = m + NGW; f32x4 vn[8];
            { const int ml = mn < MREAL + NMETA ? mn : m; const GAS f32x4* xr = (const GAS f32x4*)P0_ROWSRC(ml) + lane;
#pragma unroll
              for (int j = 0; j < 8; ++j) vn[j] = xr[64 * j]; }
            float sq = 0.f;
#pragma unroll
            for (int j = 0; j < 8; ++j) sq += (v[j].x * v[j].x + v[j].y * v[j].y) + (v[j].z * v[j].z + v[j].w * v[j].w);
            const float rstd = 1.0f / sqrtf(wave_sum(sq) * (1.f / DM) + NORM_EPS);
            GAS unsigned* o4 = (GAS unsigned*)(HN1 + (size_t)m * DM) + lane;
#pragma unroll
            for (int j = 0; j < 8; ++j) { const f32x4 y = (v[j] * rstd) * gr[64 * j]; int w = 0; w = __builtin_amdgcn_cvt_pk_fp8_f32(y[0], y[1], w, false); w = __builtin_amdgcn_cvt_pk_fp8_f32(y[2], y[3], w, true); o4[64 * j] = (unsigned)w; }
#pragma unroll
            for (int j = 0; j < 8; ++j) v[j] = vn[j];
            m = mn; } }
#undef P0_ROWSRC
      GAS u32x4* z = (GAS u32x4*)(HN1 + (size_t)(MREAL + NMETA) * DM); const int n16 = (MPAD - MREAL - NMETA) * DM / 16;
      for (int i = gt; i < n16; i += NGT) z[i] = (u32x4){0u, 0u, 0u, 0u}; }
    if (PART == 0) { float* ct = WSP(float, WS_COS); float* st = WSP(float, WS_SIN);
      for (int i = gt; i < NPOS * 32; i += NGT) { const int p = i >> 5, j = i & 31;
          const float inv = __builtin_powf(10000.0f, -(float)(2 * j) / 64.0f); const float ang = (float)p * inv;
          double r = (double)ang * 0.15915494309189535; r -= __builtin_rint(r); const float rf = (float)r;
          ct[i] = __builtin_amdgcn_cosf(rf); st[i] = __builtin_amdgcn_sinf(rf); } }
    if (PART == 1) { const float* SK = F.in[15]; const float* WQ = F.in[14]; const float* g2 = F.in[13]; bf16_t* WSCp = WSP(bf16_t, WS_WSC);
      const int l15 = lane & 15, l4 = lane >> 4;
      for (int task = gw; task < 2048; task += NGW) { const int g = task >> 7, nt = (task >> 4) & 7, kc = task & 15, n0 = nt * 16;
          bf16x8 bfr[4];
#pragma unroll
          for (int kk = 0; kk < 4; ++kk) { const float* p = SK + ((size_t)g * 128 + n0 + l15) * 128 + 32 * kk + 8 * l4; const f32x4 a = *(const GAS f32x4*)p, b = *(const GAS f32x4*)(p + 4);
              const u32x4 w = pack8(a, b); bfr[kk] = __builtin_bit_cast(bf16x8, w); }
          for (int kt = 0; kt < 8; ++kt) { const int k0 = (kc * 8 + kt) * 16; f32x4 acc = (f32x4){0.f, 0.f, 0.f, 0.f};
#pragma unroll
              for (int kk = 0; kk < 4; ++kk) { const float* p = WQ + (size_t)(k0 + l15) * 2048 + g * 128 + 32 * kk + 8 * l4; const f32x4 a = *(const GAS f32x4*)p, b = *(const GAS f32x4*)(p + 4);
                  const u32x4 w = pack8(a, b); acc = __builtin_amdgcn_mfma_f32_16x16x32_bf16(__builtin_bit_cast(bf16x8, w), bfr[kk], acc, 0, 0, 0); }
              const f32x4 gg = *(const GAS f32x4*)(g2 + k0 + 4 * l4);
              *(GAS u32x2*)(WSCp + (size_t)(g * 128 + n0 + l15) * 2048 + k0 + 4 * l4) = pack4(acc * gg); } } }
}
using pg8::Unit;
struct SchedGrid {
    int G, c, nM, nN; const char* A; const char* B; size_t tstep;
    __device__ __forceinline__ bool next(int i, Unit& u) const { const int L = i * G + c; if (L >= nM * nN) return false; pg8::grid_order(L, nM, nN, u.pm, u.pn); u.kind = 0; return true; }
    __device__ __forceinline__ const char* pa(const Unit& u) const { return A + (size_t)u.pm * tstep; }
    __device__ __forceinline__ const char* pb(const Unit& u) const { return B + (size_t)u.pn * tstep; }
};
constexpr int P1_MAIN = 64 * 29, P1_VT = 4 * 65, P1_META = 7, P1_UNITS = P1_MAIN + P1_VT + P1_META;
struct SchedP1 {
    int G, c; const char* hn1; const char* win; const char* wvt; size_t tstep;
    __device__ __forceinline__ bool next(int i, Unit& u) const {
        const int L = i * G + c; if (L >= P1_UNITS) return false;
        if (L < P1_MAIN) { pg8::grid_order(L, 64, 29, u.pm, u.pn); u.kind = 0; }
        else if (L < P1_MAIN + P1_VT) { const int idx = L - P1_MAIN; u.pm = idx & 3; u.pn = idx >> 2; u.kind = 1; }
        else { const int idx = L - P1_MAIN - P1_VT; u.pm = 64; u.pn = idx < 4 ? 4 + idx : (idx < 6 ? 10 + (idx - 4) : 28); u.kind = 0; }
        return true; }
    __device__ __forceinline__ const char* pa(const Unit& u) const { return (u.kind == 1 ? wvt : hn1) + (size_t)u.pm * tstep; }
    __device__ __forceinline__ const char* pb(const Unit& u) const { return (u.kind == 1 ? hn1 : win) + (size_t)u.pn * tstep; }
};
__device__ __forceinline__ void rope4(const f32x4 x1, const f32x4 x2, const float* cosT, const float* sinT, int pos, int j0, f32x4& lo, f32x4& hi) {
    const f32x4 c = *(const GAS f32x4*)(cosT + pos * 32 + j0), s = *(const GAS f32x4*)(sinT + pos * 32 + j0);
    lo = x1 * c - x2 * s; hi = x2 * c + x1 * s;
}
struct EpiP1 {
    static constexpr bool PERM = true, HAS_PRE = false;
    bf16_t *naq, *nak, *vt; unsigned char *cq, *ckv; bf16_t *kr, *ga, *gb; float *ssq_q, *ssq_kv; const float *cosT, *sinT;
    __device__ __forceinline__ void operator()(const f32x4 (&acc)[2][2][4][2], const Unit& u, int wr, int wc, int fr, int fq, const LAS float* rowsc) const {
        const int row0 = u.pm * 256 + wr * 64 + fr, colu = wc * 32 + 8 * fq;
        if (u.kind == 1) {
#pragma unroll
            for (int ai = 0; ai < 2; ++ai)
#pragma unroll
                for (int m = 0; m < 4; ++m) { bf16_t* rp = vt + (size_t)(row0 + ai * 128 + m * 16) * VT_PITCH + u.pn * 256 + colu;
#pragma unroll
                    for (int bj = 0; bj < 2; ++bj) *(GAS u32x4*)(rp + bj * 128) = pack8(acc[ai][bj][m][0], acc[ai][bj][m][1]); }
            return; }
        const int pn = u.pn;
        if (pn == 28) {
            if (wc < 2) { const int j0 = 4 * (4 * wc + fq);
#pragma unroll
                for (int ai = 0; ai < 2; ++ai)
#pragma unroll
                    for (int m = 0; m < 4; ++m) { const int row = row0 + ai * 128 + m * 16; const int pos = row < MREAL ? NMETA + (row & (SEQ - 1)) : row - MREAL;
                        f32x4 lo, hi; rope4(acc[ai][0][m][0], acc[ai][0][m][1], cosT, sinT, pos, j0, lo, hi);
                        *(GAS u32x2*)(kr + (size_t)row * 64 + j0) = pack4(lo); *(GAS u32x2*)(kr + (size_t)row * 64 + 32 + j0) = pack4(hi); } }
            return; }
        if (pn >= 12) {
            bf16_t* base = pn < 20 ? ga : gb; const int colt = (pn < 20 ? pn - 12 : pn - 20) * 256 + colu;
#pragma unroll
            for (int ai = 0; ai < 2; ++ai)
#pragma unroll
                for (int m = 0; m < 4; ++m) { bf16_t* rp = base + (size_t)(row0 + ai * 128 + m * 16) * 2048 + colt;
#pragma unroll
                    for (int bj = 0; bj < 2; ++bj) { f32x4 a = acc[ai][bj][m][0], b = acc[ai][bj][m][1];
#pragma unroll
                        for (int i = 0; i < 4; ++i) { a[i] = sigmoidf_(a[i]); b[i] = sigmoidf_(b[i]); }
                        *(GAS u32x4*)(rp + bj * 128) = pack8(a, b); } }
            return; }
        if (pn >= 8) {
            const bool isq = pn < 10; unsigned char* base = isq ? cq : ckv; float* ssq = isq ? ssq_q : ssq_kv; const int colt = (isq ? pn - 8 : pn - 10) * 256 + colu;
#pragma unroll
            for (int ai = 0; ai < 2; ++ai)
#pragma unroll
                for (int m = 0; m < 4; ++m) { const int row = row0 + ai * 128 + m * 16; unsigned char* rp = base + (size_t)row * 512 + colt; float s = 0.f;
#pragma unroll
                    for (int bj = 0; bj < 2; ++bj) { const f32x4 a = acc[ai][bj][m][0], b = acc[ai][bj][m][1];
                        s += (a[0] * a[0] + a[1] * a[1]) + (a[2] * a[2] + a[3] * a[3]) + (b[0] * b[0] + b[1] * b[1]) + (b[2] * b[2] + b[3] * b[3]);
                        *(GAS u32x2*)(rp + bj * 128) = pack8_fp8(a, b); }
                    s += __shfl_xor(s, 16); s += __shfl_xor(s, 32);
                    if (fq == 0) ssq[(size_t)((pn & 1) * 4 + wc) * MPAD + row] = s; }
            return; }
        {
            bf16_t* base = pn < 4 ? naq : nak; const int colt = (pn & 3) * 256 + colu;
#pragma unroll
            for (int ai = 0; ai < 2; ++ai)
#pragma unroll
                for (int m = 0; m < 4; ++m) { bf16_t* rp = base + (size_t)(row0 + ai * 128 + m * 16) * 1024 + colt;
#pragma unroll
                    for (int bj = 0; bj < 2; ++bj) *(GAS u32x4*)(rp + bj * 128) = pack8(acc[ai][bj][m][0], acc[ai][bj][m][1]); }
        }
    }
};
constexpr int P3_Q = 64 * 12, P3_KV = 65 * 16, P3_UNITS = P3_Q + P3_KV;
struct SchedP3 {
    int G, c; const char* cq; const char* ckv; const char* wuq; const char* wukv; size_t tstep;
    __device__ __forceinline__ bool next(int i, Unit& u) const {
        const int L = i * G + c; if (L >= P3_UNITS) return false;
        if (L < P3_Q) { pg8::grid_order(L, 64, 12, u.pm, u.pn); u.kind = 0; } else { pg8::grid_order(L - P3_Q, 65, 16, u.pm, u.pn); u.kind = 1; }
        return true; }
    __device__ __forceinline__ const char* pa(const Unit& u) const { return (u.kind ? ckv : cq) + (size_t)u.pm * tstep; }
    __device__ __forceinline__ const char* pb(const Unit& u) const { return (u.kind ? wukv : wuq) + (size_t)u.pn * tstep; }
};
template <int NS, int LD> __device__ __forceinline__ float rstd_slabs(const float* part, int row, float invn) {
    float s = 0.f;
#pragma unroll
    for (int i = 0; i < NS; ++i) s += part[(size_t)i * LD + row];
    return 1.0f / sqrtf(s * invn + NORM_EPS);
}
struct EpiP3 {
    static constexpr bool PERM = true, HAS_PRE = true;
    bf16_t *qm, *kn, *vv; const float *ssq_q, *ssq_kv; const float *cosT, *sinT;
    __device__ __forceinline__ void pre(const Unit& u, LAS float* sc, int tid) const { if (tid < 256) { const int row = u.pm * 256 + tid; sc[tid] = u.kind ? rstd_slabs<8, MPAD>(ssq_kv, row, 1.f / 512.f) : rstd_slabs<8, MPAD>(ssq_q, row, 1.f / 512.f); } }
    __device__ __forceinline__ void operator()(const f32x4 (&acc)[2][2][4][2], const Unit& u, int wr, int wc, int fr, int fq, const LAS float* rowsc) const {
        const int row0 = u.pm * 256 + wr * 64 + fr, colu = wc * 32 + 8 * fq;
        if (u.kind == 1) {
#pragma unroll
            for (int ai = 0; ai < 2; ++ai)
#pragma unroll
                for (int m = 0; m < 4; ++m) { const int row = row0 + ai * 128 + m * 16; const float rs = rowsc[ai * 128 + wr * 64 + m * 16 + fr];
                    const size_t off = (size_t)row * 2048 + u.pn * 128 + colu;
                    *(GAS u32x4*)(kn + off) = pack8(acc[ai][0][m][0] * rs, acc[ai][0][m][1] * rs);
                    *(GAS u32x4*)(vv + off) = pack8(acc[ai][1][m][0] * rs, acc[ai][1][m][1] * rs); }
            return; }
#pragma unroll
        for (int bj = 0; bj < 2; ++bj) { const int c8 = u.pn * 256 + bj * 128 + colu; const int hd = c8 / 192, w = c8 - hd * 192;
            if (w < 128) {
#pragma unroll
                for (int ai = 0; ai < 2; ++ai)
#pragma unroll
                    for (int m = 0; m < 4; ++m) { const int row = row0 + ai * 128 + m * 16; const float rs = rowsc[ai * 128 + wr * 64 + m * 16 + fr];
                        *(GAS u32x4*)(qm + (size_t)row * 3072 + c8) = pack8(acc[ai][bj][m][0] * rs, acc[ai][bj][m][1] * rs); }
            } else { const int j0 = (w - 128) >> 1;
#pragma unroll
                for (int ai = 0; ai < 2; ++ai)
#pragma unroll
                    for (int m = 0; m < 4; ++m) { const int row = row0 + ai * 128 + m * 16; const float rs = rowsc[ai * 128 + wr * 64 + m * 16 + fr];
                        const int pos = NMETA + (row & (SEQ - 1)); f32x4 lo, hi; rope4(acc[ai][bj][m][0] * rs, acc[ai][bj][m][1] * rs, cosT, sinT, pos, j0, lo, hi);
                        bf16_t* qp = qm + (size_t)row * 3072 + hd * 192 + 128 + j0; *(GAS u32x2*)qp = pack4(lo); *(GAS u32x2*)(qp + 32) = pack4(hi); }
            } }
    }
};
__device__ __forceinline__ void unpack8(const u32x4 w, f32x4& a, f32x4& b) { a = (f32x4){bf_lo(w.x), bf_hi(w.x), bf_lo(w.y), bf_hi(w.y)}; b = (f32x4){bf_lo(w.z), bf_hi(w.z), bf_lo(w.w), bf_hi(w.w)}; }
struct EpiP5a {
    static constexpr bool PERM = true, HAS_PRE = false;
    const bf16_t* ga; bf16_t* t1;
    __device__ __forceinline__ void operator()(const f32x4 (&acc)[2][2][4][2], const Unit& u, int wr, int wc, int fr, int fq, const LAS float* rowsc) const {
        const int row0 = u.pm * 256 + wr * 64 + fr, col0 = u.pn * 256 + wc * 32 + 8 * fq;
#pragma unroll
        for (int ai = 0; ai < 2; ++ai)
#pragma unroll
            for (int m = 0; m < 4; ++m) { const size_t off = (size_t)(row0 + ai * 128 + m * 16) * 2048 + col0;
#pragma unroll
                for (int bj = 0; bj < 2; ++bj) { f32x4 g0, g1; unpack8(*(const GAS u32x4*)(ga + off + bj * 128), g0, g1);
                    *(GAS u32x4*)(t1 + off + bj * 128) = pack8(acc[ai][bj][m][0] * g0, acc[ai][bj][m][1] * g1); } }
    }
};
struct EpiP5b {
    static constexpr bool PERM = true, HAS_PRE = false;
    const bf16_t* gb; const bf16_t* t1; unsigned char* merged;
    __device__ __forceinline__ void operator()(const f32x4 (&acc)[2][2][4][2], const Unit& u, int wr, int wc, int fr, int fq, const LAS float* rowsc) const {
        const int row0 = u.pm * 256 + wr * 64 + fr, col0 = u.pn * 256 + wc * 32 + 8 * fq;
#pragma unroll
        for (int ai = 0; ai < 2; ++ai)
#pragma unroll
            for (int m = 0; m < 4; ++m) { const size_t off = (size_t)(row0 + ai * 128 + m * 16) * 2048 + col0;
#pragma unroll
                for (int bj = 0; bj < 2; ++bj) { f32x4 g0, g1; unpack8(*(const GAS u32x4*)(gb + off + bj * 128), g0, g1);
                    f32x4 a, b; unpack8(*(const GAS u32x4*)(t1 + off + bj * 128), a, b);
                    *(GAS u32x2*)(merged + off + bj * 128) = pack8_fp8((a + acc[ai][bj][m][0] * g0) * 32.f, (b + acc[ai][bj][m][1] * g1) * 32.f); } }
    }
};
struct EpiP6 {
    static constexpr bool PERM = true, HAS_PRE = false;
    const float* x; bf16_t* h2b; float* ssq2;
    __device__ __forceinline__ void operator()(const f32x4 (&acc)[2][2][4][2], const Unit& u, int wr, int wc, int fr, int fq, const LAS float* rowsc) const {
        const int row0 = u.pm * 256 + wr * 64 + fr, col0 = u.pn * 256 + wc * 32 + 8 * fq;
#pragma unroll
        for (int ai = 0; ai < 2; ++ai)
#pragma unroll
            for (int m = 0; m < 4; ++m) { const int row = row0 + ai * 128 + m * 16; const size_t off = (size_t)row * 2048 + col0; float s = 0.f;
#pragma unroll
                for (int bj = 0; bj < 2; ++bj) { const f32x4 a = *(const GAS f32x4*)(x + off + bj * 128) + acc[ai][bj][m][0], b = *(const GAS f32x4*)(x + off + bj * 128 + 4) + acc[ai][bj][m][1];
                    s += (a[0] * a[0] + a[1] * a[1]) + (a[2] * a[2] + a[3] * a[3]) + (b[0] * b[0] + b[1] * b[1]) + (b[2] * b[2] + b[3] * b[3]);
                    *(GAS u32x4*)(h2b + off + bj * 128) = pack8(a, b); }
                s += __shfl_xor(s, 16); s += __shfl_xor(s, 32);
                if (fq == 0) ssq2[(size_t)(u.pn * 4 + wc) * MREAL + row] = s; }
    }
};
struct EpiP7 {
    static constexpr bool PERM = false, HAS_PRE = true;
    const float* ssq2; float* sc;
    __device__ __forceinline__ void pre(const Unit& u, LAS float* sc, int tid) const { if (tid < 256) sc[tid] = rstd_slabs<32, MREAL>(ssq2, u.pm * 256 + tid, 1.f / 2048.f); }
    __device__ __forceinline__ void operator()(const f32x4 (&acc)[2][2][4][2], const Unit& u, int wr, int wc, int fr, int fq, const LAS float* rowsc) const {
        const int row0 = u.pm * 256 + wr * 64 + fr, col0 = u.pn * 256 + wc * 32 + 4 * fq;
#pragma unroll
        for (int ai = 0; ai < 2; ++ai)
#pragma unroll
            for (int m = 0; m < 4; ++m) { const int row = row0 + ai * 128 + m * 16; const float rs = rowsc[ai * 128 + wr * 64 + m * 16 + fr]; const size_t off = (size_t)row * 2048 + col0;
#pragma unroll
                for (int bj = 0; bj < 2; ++bj)
#pragma unroll
                    for (int n = 0; n < 2; ++n) *(GAS f32x4*)(sc + off + bj * 128 + n * 16) = acc[ai][bj][m][n] * rs; }
    }
};
namespace att {
#define KSWZ(row, colB) ((row) * 256 + ((colB) ^ (((row) & 7) << 4)))
#define KRSWZ(row, colB) ((row) * 128 + ((colB) ^ ((((row) >> 1) & 7) << 4)))
constexpr float L2E = 1.4426950408889634f;
template <int DUMMY = 0>
__device__ __forceinline__ void partialSM(f32x16& p0, f32x16& p1, float& m_reg, float& mn, float& alpha, const float C, const float THRS) {
  float pmax = p0[0];
#pragma unroll
  for (int r = 1; r < 16; ++r) pmax = fmaxf(pmax, p0[r]);
#pragma unroll
  for (int r = 0; r < 16; ++r) pmax = fmaxf(pmax, p1[r]);
  { auto rr = __builtin_amdgcn_permlane32_swap(__float_as_uint(pmax), __float_as_uint(pmax), false, false);
    pmax = fmaxf(__uint_as_float(rr[0]), __uint_as_float(rr[1])); }
  if (__builtin_expect(__all(pmax - m_reg <= THRS), 1)) { mn = m_reg; alpha = 1.f; }
  else { mn = fmaxf(m_reg, pmax); alpha = __builtin_amdgcn_exp2f((m_reg - mn) * C); m_reg = mn; }
  const float mnC = -mn * C;
#pragma unroll
  for (int r = 0; r < 16; ++r) p0[r] = fmaf(p0[r], C, mnC);
#pragma unroll
  for (int r = 0; r < 16; ++r) p1[r] = fmaf(p1[r], C, mnC);
#pragma unroll
  for (int r = 0; r < 16; ++r) p0[r] = __builtin_amdgcn_exp2f(p0[r]);
}
__device__ __forceinline__ void finishSM(f32x16& p0, f32x16& p1, float alpha, float& l_reg, bf16x8& pa0, bf16x8& pa1, bf16x8& pa2, bf16x8& pa3) {
#pragma unroll
  for (int r = 0; r < 16; ++r) p1[r] = __builtin_amdgcn_exp2f(p1[r]);
  float ps = 0;
#pragma unroll
  for (int r = 0; r < 16; ++r) ps += p0[r];
#pragma unroll
  for (int r = 0; r < 16; ++r) ps += p1[r];
  { auto rr = __builtin_amdgcn_permlane32_swap(__float_as_uint(ps), __float_as_uint(ps), false, false);
    ps = __uint_as_float(rr[0]) + __uint_as_float(rr[1]); }
  l_reg = l_reg * alpha + ps;
#define PK4(P, BASE, OUT) do { unsigned a0 = cvt_pk_bf16(P[BASE + 0], P[BASE + 1]), a1 = cvt_pk_bf16(P[BASE + 2], P[BASE + 3]);   \
    unsigned b0 = cvt_pk_bf16(P[BASE + 4], P[BASE + 5]), b1 = cvt_pk_bf16(P[BASE + 6], P[BASE + 7]);                              \
    auto r0 = __builtin_amdgcn_permlane32_swap(a0, b0, false, false); auto r1 = __builtin_amdgcn_permlane32_swap(a1, b1, false, false); \
    u32x4 w = {r0[0], r1[0], r0[1], r1[1]}; OUT = __builtin_bit_cast(bf16x8, w); } while (0)
  PK4(p0, 0, pa0); PK4(p0, 8, pa1); PK4(p1, 0, pa2); PK4(p1, 8, pa3);
#undef PK4
}
constexpr int NW = 8, QBLK = 32, KVBLK = 64;
constexpr float MLA_SCALE = 0.07216878364870322f;
constexpr float MLA_THR = 8.f;
constexpr int SHM_V = KVBLK * 128 * 2, SHM_KN = KVBLK * 128 * 2, SHM_KR = KVBLK * 64 * 2;
constexpr int OFF_V = 0, OFF_KN = 2 * SHM_V, OFF_KR = OFF_KN + 2 * SHM_KN, OFF_WS = OFF_KR + 2 * SHM_KR, OFF_QR = OFF_WS + NW * 64 * 4, MLA_LDS = OFF_QR + NW * 4096;
__device__ __forceinline__ void qkt(f32x16& p0, f32x16& p1, const LAS char* Kn, const LAS char* Kr, const bf16x8* qr, const LAS char* qrp, const int* kb, const int* krb) {
  p0 = f32x16{}; p1 = f32x16{};
#pragma unroll
  for (int d0 = 0; d0 < 8; ++d0) {
    const bf16x8 b0 = *(const LAS bf16x8*)(Kn + kb[d0 & 3] + (d0 >> 2) * 128);
    const bf16x8 b1 = *(const LAS bf16x8*)(Kn + kb[d0 & 3] + (d0 >> 2) * 128 + 8192);
    p0 = __builtin_amdgcn_mfma_f32_32x32x16_bf16(b0, qr[d0], p0, 0, 0, 0);
    p1 = __builtin_amdgcn_mfma_f32_32x32x16_bf16(b1, qr[d0], p1, 0, 0, 0); }
#pragma unroll
  for (int d0 = 0; d0 < 4; ++d0) {
    const bf16x8 b0 = *(const LAS bf16x8*)(Kr + krb[d0]);
    const bf16x8 b1 = *(const LAS bf16x8*)(Kr + krb[d0] + 4096);
    const bf16x8 qf = *(const LAS bf16x8*)(qrp + d0 * 1024);
    p0 = __builtin_amdgcn_mfma_f32_32x32x16_bf16(b0, qf, p0, 0, 0, 0);
    p1 = __builtin_amdgcn_mfma_f32_32x32x16_bf16(b1, qf, p1, 0, 0, 0); }
}
__device__ __forceinline__ int v_st(int k, int c) { const int kk = (k & ~0xC) | ((k & 4) << 1) | ((k & 8) >> 1); return ((kk >> 3) * 4 + (c >> 5)) * 512 + ((kk & 7) * 32 + (c & 31)) * 2; }
__device__ __forceinline__ int v_rd_base(int lane) { return ((lane & 3) << 3) | (((lane >> 2) & 3) << 6) | (((lane >> 4) & 1) << 5) | (((lane >> 5) & 1) << 8); }
constexpr int v_rd_off(int d0, int ks, int half) { return d0 * 512 + ks * 4096 + half * 2048; }
template <int OFF> __device__ __forceinline__ s16x4 tr_read(int vb) {
  s16x4 r; asm volatile("ds_read_b64_tr_b16 %0, %1 offset:%2" : "=&v"(r) : "v"(vb), "i"(OFF) : "memory"); return r;
}
template <int D0> __device__ __forceinline__ void pv_one(f32x16& od, int vb, bf16x8 pa0, bf16x8 pa1, bf16x8 pa2, bf16x8 pa3) {
  const s16x4 l0 = tr_read<v_rd_off(D0, 0, 0)>(vb), h0 = tr_read<v_rd_off(D0, 0, 1)>(vb), l1 = tr_read<v_rd_off(D0, 1, 0)>(vb), h1 = tr_read<v_rd_off(D0, 1, 1)>(vb);
  const s16x4 l2 = tr_read<v_rd_off(D0, 2, 0)>(vb), h2 = tr_read<v_rd_off(D0, 2, 1)>(vb), l3 = tr_read<v_rd_off(D0, 3, 0)>(vb), h3 = tr_read<v_rd_off(D0, 3, 1)>(vb);
  asm volatile("s_waitcnt lgkmcnt(0)" ::: "memory"); SBAR();
#define PK(L, H) (bf16x8){L[0], L[1], L[2], L[3], H[0], H[1], H[2], H[3]}
  od = __builtin_amdgcn_mfma_f32_32x32x16_bf16(pa0, PK(l0, h0), od, 0, 0, 0);
  od = __builtin_amdgcn_mfma_f32_32x32x16_bf16(pa1, PK(l1, h1), od, 0, 0, 0);
  od = __builtin_amdgcn_mfma_f32_32x32x16_bf16(pa2, PK(l2, h2), od, 0, 0, 0);
  od = __builtin_amdgcn_mfma_f32_32x32x16_bf16(pa3, PK(l3, h3), od, 0, 0, 0);
#undef PK
}
__device__ __forceinline__ void pv_d0(f32x16* o, int vb, bf16x8 pa0, bf16x8 pa1, bf16x8 pa2, bf16x8 pa3) {
  pv_one<0>(o[0], vb, pa0, pa1, pa2, pa3); pv_one<1>(o[1], vb, pa0, pa1, pa2, pa3); pv_one<2>(o[2], vb, pa0, pa1, pa2, pa3); pv_one<3>(o[3], vb, pa0, pa1, pa2, pa3);
}
__device__ __forceinline__ void mla_unit(int b, int h, int qb, const bf16_t* __restrict__ QM, const bf16_t* __restrict__ KN, const bf16_t* __restrict__ KR, const bf16_t* __restrict__ VV, unsigned char* __restrict__ OM, LAS char* lds) {
  const int tid = threadIdx.x, wid = tid >> 6, lane = tid & 63, r32 = lane & 31, hi = lane >> 5;
  constexpr float C = MLA_SCALE * L2E, THRS = MLA_THR / MLA_SCALE;
  constexpr int NT = 33;
  LAS char* V_lds = lds + OFF_V; LAS char* Kn_lds = lds + OFF_KN; LAS char* Kr_lds = lds + OFF_KR;
  LAS float* ws = (LAS float*)(lds + OFF_WS) + wid * 64; LAS float* li_l = ws; LAS float* al_l = ws + 32;
  float m_reg = -1e30f, l_reg = 0; f32x16 o[4] = {}; bf16x8 qr[8];
  LAS char* qrp = lds + OFF_QR + wid * 4096 + lane * 16;
  const int qrow = b * SEQ + qb * 256 + wid * QBLK + r32;
  const bf16_t* Qw = QM + (size_t)qrow * 3072 + h * 192 + hi * 8;
#pragma unroll
  for (int d0 = 0; d0 < 8; ++d0) qr[d0] = *(const GAS bf16x8*)(Qw + d0 * 16);
  __syncthreads();
#pragma unroll
  for (int d0 = 0; d0 < 4; ++d0) *(LAS bf16x8*)(qrp + d0 * 1024) = *(const GAS bf16x8*)(Qw + (8 + d0) * 16);
  const int sr = tid >> 4, sc = (tid & 15) * 8, vst0 = v_st(sr, sc), vst1 = v_st(32 + sr, sc);
  const int krr = tid >> 3, krc = (tid & 7) * 8;
  const int vb0 = (int)(uintptr_t)V_lds + v_rd_base(lane);
  bf16x8 s_v0, s_v1, s_k0, s_k1, s_kr;
  const int realbase = b * SEQ - KVBLK;
  const unsigned voff = (unsigned)(sr * 2048 + sc) * 2u, kroff = (unsigned)(krr * 64 + krc) * 2u;
  int kb[4], krb[4];
#pragma unroll
  for (int bq = 0; bq < 4; ++bq) { kb[bq] = KSWZ(r32, bq * 32 + hi * 16); krb[bq] = KRSWZ(r32, bq * 32 + hi * 16); }
#define TROW(t) ((t) == 0 ? MREAL : realbase + (t) * KVBLK)
#define SLOAD(t) do { const int k0_ = TROW(t); const size_t ro_ = ((size_t)k0_ * 2048 + h * 128) * 2; \
    const GAS char* vb_ = (const GAS char*)VV + ro_; const GAS char* nb_ = (const GAS char*)KN + ro_; const GAS char* rb_ = (const GAS char*)KR + (size_t)k0_ * 128; \
    s_v0 = *(const GAS bf16x8*)(vb_ + voff); s_v1 = *(const GAS bf16x8*)(vb_ + 32 * 4096 + voff); \
    s_k0 = *(const GAS bf16x8*)(nb_ + voff); s_k1 = *(const GAS bf16x8*)(nb_ + 32 * 4096 + voff); \
    s_kr = *(const GAS bf16x8*)(rb_ + kroff); } while (0)
#define SWRITE(bf) do { *(LAS bf16x8*)(V_lds + (bf) * SHM_V + vst0) = s_v0; *(LAS bf16x8*)(V_lds + (bf) * SHM_V + vst1) = s_v1; const int kc_ = sc * 2; \
    *(LAS bf16x8*)(Kn_lds + (bf) * SHM_KN + KSWZ(sr, kc_)) = s_k0; *(LAS bf16x8*)(Kn_lds + (bf) * SHM_KN + KSWZ(32 + sr, kc_)) = s_k1; \
    *(LAS bf16x8*)(Kr_lds + (bf) * SHM_KR + KRSWZ(krr, krc * 2)) = s_kr; } while (0)
#define SWAIT() asm volatile("s_waitcnt vmcnt(0)" ::: "memory")
#define RESC(a) do { if (__any((a) < 1.f)) { if (hi == 0) al_l[r32] = (a); asm volatile("s_waitcnt lgkmcnt(0)" ::: "memory"); \
    _Pragma("unroll") for (int d = 0; d < 4; ++d) _Pragma("unroll") for (int r = 0; r < 16; ++r) o[d][r] *= al_l[crow(r, hi)]; } } while (0)
  f32x16 pA0, pA1, pB0, pB1; float mnA, mnB, alA, alB; bf16x8 pa0, pa1, pa2, pa3;
  SLOAD(0); SWAIT(); SWRITE(0); __syncthreads();
  qkt(pA0, pA1, Kn_lds, Kr_lds, qr, qrp, kb, krb);
  { const float NEG = -INFINITY;
#pragma unroll
    for (int r = 8; r < 16; ++r) pA0[r] = NEG;
#pragma unroll
    for (int r = 0; r < 16; ++r) pA1[r] = NEG; }
  partialSM(pA0, pA1, m_reg, mnA, alA, C, THRS);
  SLOAD(1); SWAIT(); SWRITE(1); __syncthreads();
  for (int j = 1; j + 1 < NT; j += 2) {
    SBAR(); qkt(pB0, pB1, Kn_lds + SHM_KN, Kr_lds + SHM_KR, qr, qrp, kb, krb);
    finishSM(pA0, pA1, alA, l_reg, pa0, pa1, pa2, pa3); SBAR();
    SLOAD(j + 1); SBAR();
    pv_d0(o, vb0, pa0, pa1, pa2, pa3); partialSM(pB0, pB1, m_reg, mnB, alB, C, THRS);
    __syncthreads(); SWAIT(); SWRITE(0);
    RESC(alB); __syncthreads();
    SBAR(); qkt(pA0, pA1, Kn_lds, Kr_lds, qr, qrp, kb, krb);
    finishSM(pB0, pB1, alB, l_reg, pa0, pa1, pa2, pa3); SBAR();
    if (j + 2 < NT) SLOAD(j + 2); SBAR();
    pv_d0(o, vb0 + SHM_V, pa0, pa1, pa2, pa3); partialSM(pA0, pA1, m_reg, mnA, alA, C, THRS);
    __syncthreads(); if (j + 2 < NT) { SWAIT(); SWRITE(1); }
    RESC(alA); __syncthreads();
  }
  finishSM(pA0, pA1, alA, l_reg, pa0, pa1, pa2, pa3); SBAR();
  pv_d0(o, vb0, pa0, pa1, pa2, pa3);
  if (hi == 0) li_l[r32] = l_reg; asm volatile("s_waitcnt lgkmcnt(0)" ::: "memory");
  float rli[16];
#pragma unroll
  for (int r = 0; r < 16; ++r) rli[r] = __builtin_amdgcn_rcpf(li_l[crow(r, hi)]);
  unsigned char* Ow = OM + (size_t)(b * SEQ + qb * 256 + wid * QBLK) * 2048 + h * 128;
#pragma unroll
  for (int r = 0; r < 16; ++r) { const int orow = crow(r, hi);
#pragma unroll
    for (int d0 = 0; d0 < 4; ++d0) Ow[(size_t)orow * 2048 + d0 * 32 + r32] = f32_to_fp8(o[d0][r] * rli[r] * 32.f); }
#undef TROW
#undef SLOAD
#undef SWRITE
#undef SWAIT
#undef RESC
}
__device__ __forceinline__ void na_task(int task, const bf16_t* __restrict__ NAQ, const bf16_t* __restrict__ NAK, const bf16_t* __restrict__ VT, unsigned char* __restrict__ ONA,
                                        const LAS float* relb, const LAS float* metab, LAS float* wsf, int lane) {
  const int r32 = lane & 31, hi = lane >> 5;
  const int half = task & 1, r = (task >> 1) & 31, h = (task >> 6) & 15, b = task >> 10;
  const int qc = half * 32 + r32;
  const int cs = min(max(qc - 8, 0), 48), rs = min(max(r - 4, 0), 24);
  const int qtok = b * SEQ + r * 64 + qc;
  constexpr float C = L2E, THRS = 8.f, SCALE = 0.125f;
  bf16x8 qr[4];
#pragma unroll
  for (int d0 = 0; d0 < 4; ++d0) qr[d0] = *(const GAS bf16x8*)(NAQ + (size_t)qtok * 1024 + h * 64 + d0 * 16 + hi * 8);
  float m_reg = -1e30f, l_reg = 0.f; f32x16 o[2] = {};
  LAS float* al_l = wsf; LAS float* li_l = wsf + 32;
  const float NEG = -INFINITY;
  const unsigned long long wm = 0xFFFFull << cs;
  const unsigned mh0 = (unsigned)wm >> (4 * hi), mh1 = (unsigned)(wm >> 32) >> (4 * hi);
  const bf16_t* kq = NAK + (size_t)r32 * 1024 + h * 64 + hi * 8;
  const bf16_t* vq = VT + (size_t)(h * 64 + r32) * VT_PITCH + 8 * hi;
#define NA_KTOK(w) ((w) == 8 ? MREAL : b * SEQ + (rs + (w)) * 64)
#define NA_LOADK(KF, w) do { const bf16_t* kp_ = kq + (size_t)NA_KTOK(w) * 1024; _Pragma("unroll") for (int d0 = 0; d0 < 4; ++d0) { KF[d0] = *(const GAS bf16x8*)(kp_ + d0 * 16); KF[4 + d0] = *(const GAS bf16x8*)(kp_ + 32 * 1024 + d0 * 16); } } while (0)
#define NA_TILE(KF, w) do { \
    bf16x8 vf[8]; { const bf16_t* vp_ = vq + NA_KTOK(w); _Pragma("unroll") for (int ks = 0; ks < 4; ++ks) { vf[ks] = *(const GAS bf16x8*)(vp_ + 16 * ks); vf[4 + ks] = *(const GAS bf16x8*)(vp_ + (size_t)32 * VT_PITCH + 16 * ks); } } \
    f32x16 p0 = {}, p1 = {}; \
    _Pragma("unroll") for (int d0 = 0; d0 < 4; ++d0) { p0 = __builtin_amdgcn_mfma_f32_32x32x16_bf16(KF[d0], qr[d0], p0, 0, 0, 0); p1 = __builtin_amdgcn_mfma_f32_32x32x16_bf16(KF[4 + d0], qr[d0], p1, 0, 0, 0); } \
    if ((w) + 1 < 9) NA_LOADK(KF, (w) + 1);            \
    if ((w) < 8) { const LAS float* bp_ = relb + ((h * 15 + (rs + (w) - r + 7)) * 31 + 15 - qc + 4 * hi);     \
      _Pragma("unroll") for (int rg = 0; rg < 16; ++rg) { const int c_ = (rg & 3) + 8 * (rg >> 2); \
        { const bool ok = (mh0 >> c_) & 1u; const float bv = bp_[c_]; p0[rg] = ok ? fmaf(p0[rg], SCALE, bv) : NEG; } \
        { const bool ok = (mh1 >> c_) & 1u; const float bv = bp_[c_ + 32]; p1[rg] = ok ? fmaf(p1[rg], SCALE, bv) : NEG; } } \
    } else { const LAS float* bp = metab + h * 16; \
      _Pragma("unroll") for (int rg = 0; rg < 16; ++rg) { const int kc = crow(rg, hi); p0[rg] = (rg < 8) ? fmaf(p0[rg], SCALE, bp[kc & 15]) : NEG; p1[rg] = NEG; } } \
    float mn, alpha; partialSM(p0, p1, m_reg, mn, alpha, C, THRS); \
    bf16x8 pa0, pa1, pa2, pa3; finishSM(p0, p1, alpha, l_reg, pa0, pa1, pa2, pa3); \
    if (__any(alpha < 1.f)) { if (hi == 0) al_l[r32] = alpha; asm volatile("s_waitcnt lgkmcnt(0)" ::: "memory"); \
      _Pragma("unroll") for (int d = 0; d < 2; ++d) _Pragma("unroll") for (int rg = 0; rg < 16; ++rg) o[d][rg] *= al_l[crow(rg, hi)]; } \
    _Pragma("unroll") for (int d0 = 0; d0 < 2; ++d0) { \
      o[d0] = __builtin_amdgcn_mfma_f32_32x32x16_bf16(pa0, vf[4 * d0 + 0], o[d0], 0, 0, 0); o[d0] = __builtin_amdgcn_mfma_f32_32x32x16_bf16(pa1, vf[4 * d0 + 1], o[d0], 0, 0, 0); \
      o[d0] = __builtin_amdgcn_mfma_f32_32x32x16_bf16(pa2, vf[4 * d0 + 2], o[d0], 0, 0, 0); o[d0] = __builtin_amdgcn_mfma_f32_32x32x16_bf16(pa3, vf[4 * d0 + 3], o[d0], 0, 0, 0); } } while (0)
  { bf16x8 kA[8];
    NA_LOADK(kA, 0);
#pragma unroll 1
    for (int w = 0; w < 8; ++w) { NA_TILE(kA, w); }
    NA_TILE(kA, 8); }
#undef NA_KTOK
#undef NA_LOADK
#undef NA_TILE
  if (hi == 0) li_l[r32] = l_reg; asm volatile("s_waitcnt lgkmcnt(0)" ::: "memory");
  unsigned char* Ow = ONA + (size_t)(b * SEQ + r * 64 + half * 32) * 1024 + h * 64;
#pragma unroll
  for (int rg = 0; rg < 16; ++rg) { const int orow = crow(rg, hi); const float rl = __builtin_amdgcn_rcpf(li_l[orow]);
#pragma unroll
    for (int d0 = 0; d0 < 2; ++d0) Ow[(size_t)orow * 1024 + d0 * 32 + r32] = f32_to_fp8(o[d0][rg] * rl * 16.f); }
  asm volatile("s_waitcnt lgkmcnt(0)" ::: "memory");
}
}
namespace peer {
constexpr int CH = 32;
constexpr int OFF_TV = 0, OFF_TI = OFF_TV + CH * 16 * 16 * 4, OFF_SE = OFF_TI + CH * 16 * 16 * 4, OFF_SG = OFF_SE + CH * 128 * 4, OFF_SE2 = OFF_SG + CH * 128 * 4, OFF_SG2 = OFF_SE2 + CH * 128 * 4, PEER_LDS = OFF_SG2 + CH * 128 * 4;
static_assert(PEER_LDS <= RING_BYTES, "PEER LDS");
__device__ __forceinline__ float gelu_tanh(float x) {
    const float u = 0.7978845608028654f * (x + 0.044715f * x * x * x);
    const float e = __builtin_amdgcn_exp2f(-2.f * 1.4426950408889634f * fabsf(u));
    const float t = (1.f - e) * __builtin_amdgcn_rcpf(1.f + e);
    return 0.5f * x * (1.f + (u < 0.f ? -t : t));
}
__device__ __forceinline__ void fmac1(float& acc, float a, float b) { asm("v_fmac_f32_e32 %0, %1, %2" : "+v"(acc) : "v"(a), "v"(b)); }
#define PEER_INSERT(x_, xi_) do { float x__ = (x_); int xi__ = (xi_); \
    _Pragma("unroll") for (int j_ = 0; j_ < 16; ++j_) { const bool gt_ = x__ > tv[j_]; const float tvo_ = tv[j_]; const int tio_ = ti[j_]; \
        tv[j_] = gt_ ? x__ : tvo_; ti[j_] = gt_ ? xi__ : tio_; x__ = gt_ ? tvo_ : x__; xi__ = gt_ ? tio_ : xi__; } } while (0)

#define PEER_AUX 0
typedef __amdgpu_buffer_rsrc_t rsrc_t;
__device__ __forceinline__ rsrc_t mk_rsrc(const void* p, unsigned bytes) { return __builtin_amdgcn_make_buffer_rsrc((void*)p, 0, bytes, 0x00020000); }
__device__ __forceinline__ u32x4 ldb128(rsrc_t r, unsigned off) { return __builtin_amdgcn_raw_buffer_load_b128(r, off, 0, PEER_AUX); }
typedef unsigned v6u_t __attribute__((ext_vector_type(6)));
typedef float v32f_t __attribute__((ext_vector_type(32)));
typedef float v16f_t __attribute__((ext_vector_type(16)));
__device__ __forceinline__ u32x2 ldb64(rsrc_t r, unsigned off) { return __builtin_amdgcn_raw_buffer_load_b64(r, off, 0, PEER_AUX); }
__device__ __forceinline__ f32x4 ldf128(rsrc_t r, unsigned off) { return __builtin_bit_cast(f32x4, __builtin_amdgcn_raw_buffer_load_b128(r, off, 0, PEER_AUX)); }
__device__ __forceinline__ f32x4 ldf128_nt(rsrc_t r, unsigned off) { return __builtin_bit_cast(f32x4, __builtin_amdgcn_raw_buffer_load_b128(r, off, 0, 2)); }
__device__ __forceinline__ void peer_select(int chunk, const float* __restrict__ SC, LAS char* lds, int tid, LAS int* SE, LAS float* SG) {
    LAS float* TV = (LAS float*)(lds + OFF_TV); LAS int* TI = (LAS int*)(lds + OFF_TI);
    asm volatile("" : "+v"(tid));
    const int tok0 = chunk * CH;
    const rsrc_t rSC = mk_rsrc(SC, 0x8000000u);
    __syncthreads();
    { const int tl = tid >> 4, g = tid & 15; const unsigned spo = ((unsigned)(tok0 + tl) * 2048u + (unsigned)g * 128u) * 4u;
      int tk[16];
#pragma unroll
      for (int j = 0; j < 16; ++j) tk[j] = (int)0x80000000;
#define PEER_KEY(x_, lowbits_, mask_) ({ const int f_ = __float_as_int(x_); ((f_ ^ ((f_ >> 31) & 0x7fffffff)) & ~(mask_)) | (lowbits_); })
#define PEER_INS(key_) do { int x__ = (key_); _Pragma("unroll") for (int j_ = 0; j_ < 16; ++j_) { const int hi_ = max(x__, tk[j_]); x__ = min(x__, tk[j_]); tk[j_] = hi_; } } while (0)
#pragma unroll 1
      for (int i = 0; i < 32; i += 2) { const f32x4 a = ldf128_nt(rSC, spo + i * 16), b = ldf128_nt(rSC, spo + i * 16 + 16);
#pragma unroll
          for (int e = 0; e < 4; ++e) { PEER_INS(PEER_KEY(a[e], 127 - (4 * i + e), 127)); }
#pragma unroll
          for (int e = 0; e < 4; ++e) { PEER_INS(PEER_KEY(b[e], 127 - (4 * i + 4 + e), 127)); } }
      LAS float* tvp = TV + (tl * 16 + g) * 16; LAS int* tip = TI + (tl * 16 + g) * 16;
#pragma unroll
      for (int j = 0; j < 16; ++j) { const int k_ = tk[j] & ~127; tvp[j] = __int_as_float(k_ ^ ((k_ >> 31) & 0x7fffffff)); tip[j] = 127 - (tk[j] & 127); } }
    __syncthreads();
    asm volatile("" : "+v"(tid));
    { const int tl = tid >> 4, hh = (tid >> 1) & 7, half = tid & 1;
      const LAS float* s1 = TV + (tl * 16 + 2 * hh) * 16; const LAS float* s2 = s1 + 16; const LAS int* i1 = TI + (tl * 16 + 2 * hh) * 16; const LAS int* i2 = i1 + 16;
      float b2[16];
#pragma unroll
      for (int j = 0; j < 16; ++j) b2[j] = s2[j];
      int tk[16];
#pragma unroll
      for (int j = 0; j < 16; ++j) tk[j] = (int)0x80000000;
#pragma unroll
      for (int ii = 0; ii < 8; ++ii) { const int i = 2 * ii + half; const float a = s1[i];
#pragma unroll
          for (int j = 0; j < 16; ++j) if ((2 * ii + 1) * (j + 1) <= 16) { if (half == 0 || (2 * ii + 2) * (j + 1) <= 16) PEER_INS(PEER_KEY(a + b2[j], 255 - (i * 16 + j), 255)); } }
      { int pk[16];
#pragma unroll
        for (int j = 0; j < 16; ++j) pk[j] = __shfl_xor(tk[j], 1);
#pragma unroll
        for (int j = 0; j < 16; ++j) PEER_INS(pk[j]); }
      if (half == 0) { float e[16], sum = 0.f; const int k0_ = tk[0] & ~255; const float v0 = __int_as_float(k0_ ^ ((k0_ >> 31) & 0x7fffffff));
#pragma unroll
        for (int j = 0; j < 16; ++j) { const int k_ = tk[j] & ~255; const float vj = __int_as_float(k_ ^ ((k_ >> 31) & 0x7fffffff)); e[j] = __builtin_amdgcn_exp2f((vj - v0) * 1.4426950408889634f); sum += e[j]; }
        const float inv = 1.0f / sum;
#pragma unroll
        for (int j = 0; j < 16; ++j) { const int ci = 255 - (tk[j] & 255); SE[tl * 128 + hh * 16 + j] = i1[ci >> 4] * 128 + i2[ci & 15]; SG[tl * 128 + hh * 16 + j] = e[j] * inv; } } }
#undef PEER_KEY
#undef PEER_INS
    __syncthreads();
}
__device__ __forceinline__ void peer_gather(int chunk, const bf16_t* __restrict__ H2, const unsigned char* __restrict__ U,
                                            const float* __restrict__ g2, const float* __restrict__ gf, float* OUT, int tid, const LAS int* SE, const LAS float* SG) {
    asm volatile("" : "+v"(tid));
    const int tok0 = chunk * CH, lane = tid & 63, wave = tid >> 6;
    const rsrc_t rH2 = mk_rsrc(H2, 0x4000000u), rU = mk_rsrc(U, 0x3000000u), rG2 = mk_rsrc(g2, 8192u), rGF = mk_rsrc(gf, 8192u);
#pragma unroll 1
    for (int tt = 0; tt < CH / NWAVES; ++tt) { const int tl = wave * (CH / NWAVES) + tt, tok = tok0 + tl;
      asm volatile("" ::: "memory");
      float hn[32], acc[32]; float ss = 0.f;
#pragma unroll
      for (int j = 0; j < 2; ++j)
#pragma unroll
          for (int q = 0; q < 4; ++q) { const u32x2 w = ldb64(rH2, ((unsigned)tok * 2048u + 256u * (4 * j + q) + 4u * lane) * 2u);
              const f32x4 a = (f32x4){__uint_as_float(w.x << 16), __uint_as_float(w.x & 0xffff0000u), __uint_as_float(w.y << 16), __uint_as_float(w.y & 0xffff0000u)};
#pragma unroll
              for (int i = 0; i < 4; ++i) { hn[16 * j + 4 * q + i] = a[i]; ss += a[i] * a[i]; } }
      const float rstd = 1.0f / sqrtf(wave_sum(ss) * (1.f / 2048.f) + NORM_EPS);
#pragma unroll
      for (int j = 0; j < 2; ++j)
#pragma unroll
          for (int q = 0; q < 4; ++q) { const f32x4 a = ldf128(rG2, (256u * (4 * j + q) + 4u * lane) * 4u);
#pragma unroll
              for (int i = 0; i < 4; ++i) hn[16 * j + 4 * q + i] *= rstd * a[i]; }
#pragma unroll
      for (int i = 0; i < 32; ++i) acc[i] = 0.f;
#define NX 4
#define PEER_LOAD(S, kb) do { _Pragma("unroll") for (int x = 0; x < NX; ++x) { const unsigned o = (unsigned)SE[tl * 128 + (kb) + x] * 3072u; \
          S##ua[x] = ldb128(rU, o + (unsigned)lane * 16u); S##ub[x] = ldb64(rU, o + 1024u + (unsigned)lane * 8u); S##va[x] = ldb128(rU, o + 1536u + (unsigned)lane * 16u); S##vb[x] = ldb64(rU, o + 2560u + (unsigned)lane * 8u); } } while (0)
#define PEER_DEC(A, B) ({ v32f_t r_ = __builtin_amdgcn_cvt_scalef32_pk32_f32_fp6((v6u_t){A.x, A.y, A.z, A.w, B.x, B.y}, 1.0f); asm volatile("s_nop 1" : "+v"(r_)); r_; })
#define PEER_COMPUTE(S, kb) do { float d[NX]; \
          _Pragma("unroll") for (int x = 0; x < NX; ++x) { const v32f_t r = PEER_DEC(S##ua[x], S##ub[x]); float dd = 0.f; \
              _Pragma("unroll") for (int i = 0; i < 32; ++i) fmac1(dd, hn[i], r[i]); \
              d[x] = dd; } \
          _Pragma("unroll") for (int o = 1; o < 64; o <<= 1) { _Pragma("unroll") for (int x = 0; x < NX; ++x) d[x] += __shfl_xor(d[x], o); } \
          float c[NX]; \
          _Pragma("unroll") for (int x = 0; x < NX; ++x) c[x] = SG[tl * 128 + (kb) + x] * gelu_tanh(d[x] * (1.f / 64.f)) * 0.25f; \
          _Pragma("unroll") for (int x = 0; x < NX; ++x) { const v32f_t r = PEER_DEC(S##va[x], S##vb[x]); \
              _Pragma("unroll") for (int i = 0; i < 32; ++i) fmac1(acc[i], c[x], r[i]); } } while (0)
      { u32x4 Aua[NX], Ava[NX], Bua[NX], Bva[NX]; u32x2 Aub[NX], Avb[NX], Bub[NX], Bvb[NX];
        PEER_LOAD(A, 0);
#pragma unroll 1
        for (int k = 0; k < 128; k += 2 * NX) {
            PEER_LOAD(B, k + NX); PEER_COMPUTE(A, k);
            { const int kn = min(k + 2 * NX, 128 - NX); PEER_LOAD(A, kn); }
            PEER_COMPUTE(B, k + NX);
        } }
#undef PEER_DEC
#undef NX
#undef PEER_LOAD
#undef PEER_COMPUTE
      asm volatile("" ::: "memory");
      int tok2 = tok, lane2 = lane; asm volatile("" : "+v"(tok2), "+v"(lane2));
      float s2 = 0.f;
#pragma unroll
      for (int j = 0; j < 2; ++j)
#pragma unroll
          for (int q = 0; q < 4; ++q) { const u32x2 w = ldb64(rH2, ((unsigned)tok2 * 2048u + 256u * (4 * j + q) + 4u * lane2) * 2u);
              const f32x4 a = (f32x4){__uint_as_float(w.x << 16), __uint_as_float(w.x & 0xffff0000u), __uint_as_float(w.y << 16), __uint_as_float(w.y & 0xffff0000u)};
#pragma unroll
              for (int i = 0; i < 4; ++i) { acc[16 * j + 4 * q + i] += a[i]; s2 += acc[16 * j + 4 * q + i] * acc[16 * j + 4 * q + i]; } }
      const float rf = 1.0f / sqrtf(wave_sum(s2) * (1.f / 2048.f) + NORM_EPS);
#pragma unroll
      for (int j = 0; j < 2; ++j)
#pragma unroll
          for (int q = 0; q < 4; ++q) { const f32x4 a = ldf128(rGF, (256u * (4 * j + q) + 4u * lane2) * 4u); f32x4 oa;
#pragma unroll
              for (int i = 0; i < 4; ++i) oa[i] = acc[16 * j + 4 * q + i] * rf * a[i];
              float* op = OUT + (size_t)tok2 * 2048 + 256 * (4 * j + q) + 4 * lane2;
              __builtin_nontemporal_store(oa, (GAS f32x4*)op); }
    }
}
}
#ifndef MK_N_LAUNCHES
#define MK_N_LAUNCHES 1
#endif
#define MK_PROBE_PH -1
#define MK_PROBE_DIV 2
constexpr int N_PHASES = 9;
constexpr int N_LAUNCHES = MK_N_LAUNCHES;
struct Args { const float* in[19]; float* out; unsigned char* ws; int ph_lo, ph_hi; };
static_assert(sizeof(Args) == 19 * 8 + 8 + 8 + 8, "no padding");

__global__ void __launch_bounds__(NWAVES * 64, 2) hybrid_fwd(Args args) {
    extern __shared__ __attribute__((aligned(16))) unsigned char lds_raw[];
    Frame F;
    F.lds = (LAS unsigned char*)lds_raw;
    F.MISC = (volatile LAS unsigned*)(F.lds + MISC_OFF);
    F.tid = threadIdx.x; F.lane = F.tid & 63; F.wave = __builtin_amdgcn_readfirstlane(F.tid >> 6);
    F.G = gridDim.x; { const int bx = blockIdx.x; F.vcu = (F.G % 8 == 0) ? (bx % 8) * (F.G / 8) + bx / 8 : bx; }
    F.ws = args.ws; F.out = args.out;
#pragma unroll
    for (int i = 0; i < 19; ++i) F.in[i] = args.in[i];
    for (int u = F.tid; u < (LDS_BYTES - LDSCTL_OFF) / 4; u += NWAVES * 64) ((LAS unsigned*)(F.lds + LDSCTL_OFF))[u] = 0u;
    __syncthreads();
    XcdBarrier bar; bar.bar = (unsigned*)(F.ws + WS_CTL) + CW_BAR; bar.x = 0; bar.st = nullptr;
    if (N_LAUNCHES == 1) bar = xcd_barrier_post((unsigned*)(F.ws + WS_CTL) + CW_BAR, F.MISC + 8);
    const int lo = args.ph_lo, hi = args.ph_hi;
#define IN(k) (lo <= (k) && (k) < hi)
#if MK_PROBE_PH >= 0
    unsigned long long tp0 = (MK_PROBE_PH == 0 || MK_PROBE_PH == 9) ? __builtin_amdgcn_s_memrealtime() : 0ull, tp1 = 0ull;
#define SEAM(k) do { if (IN(k) && IN((k) + 1)) xcd_barrier(bar); if (MK_PROBE_PH == (k)) tp1 = __builtin_amdgcn_s_memrealtime(); if (MK_PROBE_PH == (k) + 1) tp0 = __builtin_amdgcn_s_memrealtime(); } while (0)
#else
#define SEAM(k) do { if (IN(k) && IN((k) + 1)) xcd_barrier(bar); } while (0)
#endif
    const size_t T2048 = (size_t)256 * 2048 * 2, T1024 = (size_t)256 * 1024 * 2, T512 = (size_t)256 * 512 * 2;
    float* cosT = WSP(float, WS_COS); float* sinT = WSP(float, WS_SIN);
    float* ssq_q = WSP(float, WS_SSQ_Q); float* ssq_kv = WSP(float, WS_SSQ_KV); float* ssq2 = WSP(float, WS_SSQ_2);

    if (IN(0)) { p0_prologue<0>(F, F.vcu, F.G); } SEAM(0);
    if (IN(1)) {
        SchedP1 S{F.G, (int)blockIdx.x, (const char*)(F.ws + WS_HN1), (const char*)(F.ws + WS_WIN), (const char*)(F.ws + WS_WVT), T1024};
        EpiP1 E{WSP(bf16_t, WS_NAQ), WSP(bf16_t, WS_NAK), WSP(bf16_t, WS_VT), WSP(unsigned char, WS_CQ), WSP(unsigned char, WS_CKV), WSP(bf16_t, WS_KR), WSP(bf16_t, WS_GA), WSP(bf16_t, WS_GB), ssq_q, ssq_kv, cosT, sinT};
        pg8::gemm_phase<EpiP1, SchedP1, true, -6>(F.lds, 2048, S, E);
        { const int extra = P1_UNITS % F.G, bx = (int)blockIdx.x; if (extra != 0 && bx >= extra) p0_prologue<1>(F, bx - extra, F.G - extra); else if (extra == 0) p0_prologue<1>(F, bx, F.G); }
    } SEAM(1);
    if (IN(2)) {
        LAS float* relb = (LAS float*)F.lds + 64; LAS float* metab = relb + 16 * 15 * 31 + 128; LAS float* wsf = metab + 256 + F.wave * 64;
        for (int i = F.tid; i < 16 * 15 * 31; i += NWAVES * 64) relb[i] = F.in[4][i];
        if (F.tid < 256) metab[F.tid] = F.in[5][F.tid];
        __syncthreads();
        const int gw = F.vcu * NWAVES + F.wave, NGW = F.G * NWAVES;
        for (int task = gw; task < NBATCH * 16 * 32 * 2; task += NGW)
            att::na_task(task, WSP(bf16_t, WS_NAQ), WSP(bf16_t, WS_NAK), WSP(bf16_t, WS_VT), WSP(unsigned char, WS_ONA), relb, metab, wsf, F.lane);
        __syncthreads();
    } SEAM(2);
    if (IN(3)) {
        SchedP3 S{F.G, (int)blockIdx.x, (const char*)(F.ws + WS_CQ), (const char*)(F.ws + WS_CKV), (const char*)(F.ws + WS_WUQ), (const char*)(F.ws + WS_WUKV), T512 / 2};
        EpiP3 E{WSP(bf16_t, WS_QM), WSP(bf16_t, WS_KN), WSP(bf16_t, WS_VV), ssq_q, ssq_kv, cosT, sinT};
        pg8::gemm_phase<EpiP3, SchedP3, true, -4>(F.lds, 512, S, E);
    } SEAM(3);
    if (IN(4)) {
        for (int id = F.vcu; id < NBATCH * 16 * 8; id += F.G) { const int bh = id >> 3, qb = id & 7;
            att::mla_unit(bh >> 4, bh & 15, qb, WSP(bf16_t, WS_QM), WSP(bf16_t, WS_KN), WSP(bf16_t, WS_KR), WSP(bf16_t, WS_VV), WSP(unsigned char, WS_OMLA), (LAS char*)F.lds); }
        __syncthreads();
    } SEAM(4);
    if (IN(5)) {
        { SchedGrid S{F.G, (int)blockIdx.x, 64, 8, (const char*)(F.ws + WS_ONA), (const char*)(F.ws + WS_WNA), T512};
          EpiP5a E{WSP(bf16_t, WS_GA), WSP(bf16_t, WS_T1)};
          pg8::gemm_phase<EpiP5a, SchedGrid, true, -9>(F.lds, 1024, S, E); }
        { SchedGrid S{F.G, (int)blockIdx.x, 64, 8, (const char*)(F.ws + WS_OMLA), (const char*)(F.ws + WS_WMLA), T1024};
          EpiP5b E{WSP(bf16_t, WS_GB), WSP(bf16_t, WS_T1), WSP(unsigned char, WS_MERGED)};
          pg8::gemm_phase<EpiP5b, SchedGrid, true, -11>(F.lds, 2048, S, E); }
    } SEAM(5);
    if (IN(6)) {
        { SchedGrid S{F.G, (int)blockIdx.x, 64, 8, (const char*)(F.ws + WS_MERGED), (const char*)(F.ws + WS_WOUT), T1024};
          EpiP6 E{F.in[0], WSP(bf16_t, WS_H2B), ssq2};
          pg8::gemm_phase<EpiP6, SchedGrid, true, -11>(F.lds, 2048, S, E); }
        {
#define P6_SRC(i_) (((i_) >> 20 ? F.in[17] : F.in[16]) + (size_t)(((i_) >> 6) & 16383u) * 2048 + 4 * ((i_) & 63u))
          const unsigned NTOT = 2u * 16384u * 64u, STEP = (unsigned)F.G * 512u; unsigned i = (unsigned)F.vcu * 512u + F.tid;
          f32x4 xc[8];
          if (i < NTOT) { const float* src = P6_SRC(i);
#pragma unroll
              for (int q = 0; q < 8; ++q) xc[q] = *(const GAS f32x4*)(src + 256 * q); }
          while (i < NTOT) { const unsigned in_ = i + STEP; f32x4 xn[8];
              { const float* src = P6_SRC(in_ < NTOT ? in_ : i);
#pragma unroll
                for (int q = 0; q < 8; ++q) xn[q] = *(const GAS f32x4*)(src + 256 * q); }
              const unsigned isv = i >> 20, row = (i >> 6) & 16383u, l = i & 63u; const float sc = isv ? 4.f : 64.f; peer::v16f_t a, b;
#pragma unroll
              for (int q = 0; q < 8; ++q)
#pragma unroll
                  for (int e = 0; e < 4; ++e) { const int k_ = 4 * q + e;
                      if (k_ & 1) b[k_ >> 1] = xc[q][e] * sc; else a[k_ >> 1] = xc[q][e] * sc; }
              const peer::v6u_t w = __builtin_amdgcn_cvt_scalef32_2xpk16_fp6_f32(a, b, 1.0f);
              unsigned char* rec = WSP(unsigned char, WS_U) + (size_t)row * 3072 + (isv ? 1536 : 0);
              *(GAS u32x4*)(rec + l * 16) = (u32x4){w[0], w[1], w[2], w[3]}; *(GAS u32x2*)(rec + 1024 + l * 8) = (u32x2){w[4], w[5]};
#pragma unroll
              for (int q = 0; q < 8; ++q) xc[q] = xn[q];
              i = in_; }
#undef P6_SRC
        }
    } SEAM(6);
    if (IN(7)) {
        SchedGrid S{F.G, (int)blockIdx.x, 64, 8, (const char*)(F.ws + WS_H2B), (const char*)(F.ws + WS_WSC), T2048};
        EpiP7 E{ssq2, WSP(float, WS_SC)};
        pg8::gemm_phase<EpiP7, SchedGrid>(F.lds, 2048, S, E);
    } SEAM(7);
    if (IN(8)) {
        const int nch = (MREAL / peer::CH - F.vcu + F.G - 1) / F.G; const bool both_first = (nch == 2) && (F.vcu & 1);
        for (int op = 0; op < 2 * nch; ++op) {
            const bool sel = both_first ? (op < 2) : !(op & 1); const int ci = both_first ? (op & 1) : (op >> 1), chunk = F.vcu + ci * F.G;
            const int b2 = both_first ? ci : 0;
            LAS int* SE = (LAS int*)(F.lds + (b2 ? peer::OFF_SE2 : peer::OFF_SE)); LAS float* SG = (LAS float*)(F.lds + (b2 ? peer::OFF_SG2 : peer::OFF_SG));
            if (sel) peer::peer_select(chunk, WSP(float, WS_SC), (LAS char*)F.lds, F.tid, SE, SG);
            else peer::peer_gather(chunk, WSP(bf16_t, WS_H2B), WSP(unsigned char, WS_U), F.in[13], F.in[18], F.out, F.tid, SE, SG); }
    }
#if MK_PROBE_PH >= 0
    xcd_barrier(bar); tp1 = (MK_PROBE_PH >= 8) ? __builtin_amdgcn_s_memrealtime() : tp1;
    if (blockIdx.x == 0 && F.tid == 0) F.out[0] = (float)(tp1 - tp0) * (0.01f / MK_PROBE_DIV);
#endif
#undef IN
#undef SEAM
}

extern "C" void kernel_launch(void* const* d_in, const int* in_sizes, int n_in, void* d_out, int out_size, void* d_ws, size_t ws_size, hipStream_t stream) {
    static int grid = 0;
    if (grid == 0) {
        if (n_in != 19 || in_sizes[0] != MREAL * DM || out_size != MREAL * DM || ws_size < WS_END) {
            fprintf(stderr, "kernel_launch: shape/workspace mismatch: n_in %d in0 %d out %d ws %zu (need %zu); nothing launched\n", n_in, n_in > 0 ? in_sizes[0] : -1, out_size, ws_size, (size_t)WS_END); grid = -1; return; }
        int dev = 0, cus = 0, per_cu = 0;
        if (hipGetDevice(&dev) != hipSuccess || hipDeviceGetAttribute(&cus, hipDeviceAttributeMultiprocessorCount, dev) != hipSuccess) { fprintf(stderr, "kernel_launch: device query failed\n"); grid = -1; return; }
        if (hipFuncSetAttribute((const void*)hybrid_fwd, hipFuncAttributeMaxDynamicSharedMemorySize, LDS_BYTES) != hipSuccess) { fprintf(stderr, "kernel_launch: hipFuncSetAttribute failed\n"); grid = -1; return; }
        if (hipOccupancyMaxActiveBlocksPerMultiprocessor(&per_cu, (const void*)hybrid_fwd, NWAVES * 64, LDS_BYTES) != hipSuccess || per_cu < 1)
            fprintf(stderr, "kernel_launch: note: occupancy query reports %d workgroups per CU\n", per_cu);
        (void)hipGetLastError();
        grid = cus;
    }
    if (grid < 0) return;
    if (hipMemsetAsync((char*)d_ws + WS_CTL, 0, CTL_ZERO_BYTES, stream) != hipSuccess) { fprintf(stderr, "kernel_launch: hipMemsetAsync failed\n"); return; }
    Args a{};
    for (int i = 0; i < 19; ++i) a.in[i] = (const float*)d_in[i];
    a.out = (float*)d_out; a.ws = (unsigned char*)d_ws;
    for (int li = 0; li < N_LAUNCHES; ++li) {
        a.ph_lo = (N_LAUNCHES == 1) ? 0 : li; a.ph_hi = (N_LAUNCHES == 1) ? N_PHASES : li + 1;
        hipLaunchKernelGGL(hybrid_fwd, dim3(grid), dim3(NWAVES * 64), LDS_BYTES, stream, a);
        const hipError_t le = hipPeekAtLastError();
        if (le != hipSuccess) { fprintf(stderr, "kernel_launch: launch %d failed: %s\n", li, hipGetErrorName(le)); break; }
    }
}
```

```cpp
#include <hip/hip_runtime.h>
#include <cstdio>
#include <cstdint>

#define LAS __attribute__((address_space(3)))
#define GAS __attribute__((address_space(1)))
typedef unsigned short bf16_t;
typedef short bf16x8 __attribute__((ext_vector_type(8)));
typedef short s16x4 __attribute__((ext_vector_type(4)));
typedef float f32x4 __attribute__((ext_vector_type(4)));
typedef float f32x2 __attribute__((ext_vector_type(2)));
typedef float f32x16 __attribute__((ext_vector_type(16)));
typedef unsigned u32x4 __attribute__((ext_vector_type(4)));
typedef unsigned u32x2 __attribute__((ext_vector_type(2)));

constexpr int DM = 2048, NBATCH = 8, SEQ = 2048, NMETA = 16;
constexpr int MREAL = NBATCH * SEQ;
constexpr int MPAD = MREAL + 256;
constexpr int NPOS = SEQ + NMETA;
constexpr float NORM_EPS = 1e-6f;
constexpr int C_NAQ = 0, C_NAK = 1024, C_CQ = 2048, C_CKV = 2560, C_GA = 3072, C_GB = 5120, C_KR = 7168, NMAIN = 7424;
constexpr int VT_PITCH = MPAD;

constexpr size_t MiB = 1u << 20;
constexpr size_t WS_CTL = 0, CTL_ZERO_BYTES = 1 * MiB;
constexpr size_t WS_SSQ_Q = 481 * MiB, WS_SSQ_KV = 482 * MiB, WS_SSQ_2 = 486 * MiB;
constexpr size_t WS_COS = 1 * MiB, WS_SIN = 1 * MiB + 512 * 1024;
constexpr size_t WS_WUQ = 2 * MiB, WS_WUKV = 5 * MiB, WS_WNA = 9 * MiB, WS_WMLA = 13 * MiB, WS_WOUT = 21 * MiB, WS_WSC = 29 * MiB;
constexpr size_t WS_GA = 37 * MiB, WS_GB = 101 * MiB;
constexpr size_t WS_KR = 165 * MiB;
constexpr size_t WS_WIN = 167 * MiB + 256 * 1024, WS_WVT = WS_WIN + 29 * MiB;
constexpr size_t WS_ONA = 190 * MiB;
constexpr size_t WS_NAQ = 222 * MiB, WS_NAK = 254 * MiB, WS_VT = WS_NAK + 32 * MiB + 512 * 1024;
constexpr size_t WS_HN1 = 319 * MiB;
constexpr size_t WS_CQ = 448 * MiB, WS_CKV = 464 * MiB;
constexpr size_t WS_QM = 222 * MiB, WS_KN = 318 * MiB, WS_VV = 383 * MiB;
constexpr size_t WS_OMLA = 448 * MiB;
constexpr size_t WS_MERGED = 222 * MiB, WS_T1 = 286 * MiB;
constexpr size_t WS_H2 = 37 * MiB, WS_H2B = 293 * MiB;
constexpr size_t WS_U = 357 * MiB, WS_V = 421 * MiB;
constexpr size_t WS_SC = 165 * MiB;
constexpr size_t WS_END = 512 * MiB;
static_assert(WS_CKV + (size_t)MPAD * 512 * 2 <= WS_SSQ_Q && WS_SSQ_Q + (size_t)8 * MPAD * 4 <= WS_SSQ_KV && WS_SSQ_KV + (size_t)8 * MPAD * 4 <= 483 * MiB && WS_V + 64 * MiB <= WS_SSQ_2 && WS_SSQ_2 + (size_t)32 * MREAL * 4 <= WS_END, "ssq slabs");
static_assert(WS_VT + (size_t)1024 * MPAD * 2 <= WS_HN1 && WS_HN1 + (size_t)MPAD * 2048 * 2 <= WS_CQ && WS_CKV + (size_t)MPAD * 512 * 2 <= WS_END, "map P1");
static_assert(WS_WVT + 4 * MiB <= WS_NAQ && WS_KR + (size_t)MPAD * 64 * 2 <= WS_WIN && WS_ONA + 32 * MiB <= WS_NAQ, "map P1b");
static_assert(WS_QM + 96 * MiB <= WS_KN && WS_KN + 65 * MiB <= WS_VV && WS_VV + 65 * MiB <= WS_OMLA && WS_OMLA + 64 * MiB <= WS_END, "map P3");
static_assert(WS_T1 + 128 * MiB <= WS_OMLA && WS_H2 + 128 * MiB <= WS_KR && WS_SC + 128 * MiB <= WS_H2B && WS_H2B + 64 * MiB <= WS_U && WS_V + 64 * MiB <= WS_END, "map P5+");

constexpr int CW_BAR = 4096;

constexpr int RING_BYTES = 131072;
constexpr int LDSCTL_OFF = RING_BYTES, MISC_OFF = LDSCTL_OFF + 320;
constexpr int LDS_BYTES = 147456;
constexpr int NWAVES = 8;

#define LDS_WAIT() asm volatile("s_waitcnt lgkmcnt(0)" ::: "memory")
#define VM_WAIT() asm volatile("s_waitcnt vmcnt(0)" ::: "memory")
#define SBAR() __builtin_amdgcn_sched_barrier(0)
typedef __bf16 bf16x2_t __attribute__((ext_vector_type(2)));
__device__ __forceinline__ unsigned cvt_pk_bf16(float lo, float hi) { const f32x2 v = {lo, hi}; const bf16x2_t b = __builtin_convertvector(v, bf16x2_t); return __builtin_bit_cast(unsigned, b); }
__device__ __forceinline__ float bf_lo(unsigned w) { return __uint_as_float(w << 16); }
__device__ __forceinline__ float bf_hi(unsigned w) { return __uint_as_float(w & 0xffff0000u); }
__device__ __forceinline__ u32x4 pack8(const f32x4 a, const f32x4 b) { u32x4 w; w.x = cvt_pk_bf16(a[0], a[1]); w.y = cvt_pk_bf16(a[2], a[3]); w.z = cvt_pk_bf16(b[0], b[1]); w.w = cvt_pk_bf16(b[2], b[3]); return w; }
__device__ __forceinline__ u32x2 pack8_fp8(f32x4 a, f32x4 b) {
#pragma unroll
    for (int i = 0; i < 4; ++i) { a[i] = __builtin_fminf(__builtin_fmaxf(a[i], -448.f), 448.f); b[i] = __builtin_fminf(__builtin_fmaxf(b[i], -448.f), 448.f); }
    int w0 = 0, w1 = 0; w0 = __builtin_amdgcn_cvt_pk_fp8_f32(a[0], a[1], w0, false); w0 = __builtin_amdgcn_cvt_pk_fp8_f32(a[2], a[3], w0, true);
    w1 = __builtin_amdgcn_cvt_pk_fp8_f32(b[0], b[1], w1, false); w1 = __builtin_amdgcn_cvt_pk_fp8_f32(b[2], b[3], w1, true); return (u32x2){(unsigned)w0, (unsigned)w1}; }
__device__ __forceinline__ unsigned char f32_to_fp8(float x) { x = __builtin_fminf(__builtin_fmaxf(x, -448.f), 448.f); return (unsigned char)(__builtin_amdgcn_cvt_pk_fp8_f32(x, 0.f, 0, false) & 0xff); }
__device__ __forceinline__ u32x2 pack4(const f32x4 a) { u32x2 w; w.x = cvt_pk_bf16(a[0], a[1]); w.y = cvt_pk_bf16(a[2], a[3]); return w; }
__device__ __forceinline__ float wave_sum(float v) {
#pragma unroll
    for (int o = 1; o < 64; o <<= 1) v += __shfl_xor(v, o);
    return v;
}
__device__ __forceinline__ float sigmoidf_(float x) { return __builtin_amdgcn_rcpf(1.0f + __builtin_amdgcn_exp2f(-1.4426950408889634f * x)); }
__device__ __forceinline__ int crow(int r, int hi) { return (r & 3) + 8 * (r >> 2) + 4 * hi; }
#define PG8_AUX 0
namespace pg8 {
constexpr int BM = 256, BK = 64, HALF = 128, HTB = HALF * BK * 2  , STAGE_BYTES = 8 * HTB, NXCD = 8, WGM = 8;
__host__ __device__ __forceinline__ int lds_byte(int r, int c) { const int st = (r >> 4) * 2 + (c >> 5), rr = r & 15, cc = c & 31, ob = rr * 64 + cc * 2; return st * 1024 + (ob ^ (((ob >> 9) & 1) << 5)); }
__host__ __device__ __forceinline__ void stage_rc(int b, int& R, int& C) { const int st = b / 1024, sb = b % 1024, swz = sb ^ (((sb >> 9) & 1) << 5); R = (st >> 1) * 16 + swz / 64; C = (st & 1) * 32 + (swz % 64) / 2; }
__host__ __device__ __forceinline__ int perm32(int rho) { const int n = rho >> 4, i = rho & 15; return 8 * (i >> 2) + 4 * n + (i & 3); }

struct Unit { int pm, pn, kind; };

__device__ __forceinline__ void grid_order(int L, int nM, int nN, int& pm, int& pn) {
    const int nwg = nM * nN; int wgid = L;
    { const int q = nwg / NXCD, r = nwg % NXCD, xcd = wgid % NXCD, off = wgid / NXCD; wgid = (xcd < r ? xcd * (q + 1) : r * (q + 1) + (xcd - r) * q) + off; }
    const int nig = WGM * nN, gid = wgid / nig, fm = gid * WGM, gsz = (nM - fm) < WGM ? (nM - fm) : WGM;
    pm = fm + ((wgid % nig) % gsz); pn = (wgid % nig) / gsz;
}

typedef int v8i_t __attribute__((ext_vector_type(8)));
template <class Epi, class Sched, bool F8 = false, int F8_SCALE_EXP = 0>
__device__ __forceinline__ void gemm_phase(LAS unsigned char* lds, const int K, const Sched& S, const Epi& E) {
    const int tid = threadIdx.x, wid = __builtin_amdgcn_readfirstlane(tid >> 6), lane = tid & 63, wr = wid >> 2, wc = wid & 3, fr = lane & 15, fq = lane >> 4;
    int f8sa = 0x01010101 * (127 + F8_SCALE_EXP), f8sb = 0x7f7f7f7f; asm volatile("" : "+v"(f8sa), "+v"(f8sb));
    const int Kb = F8 ? K : 2 * K;
    const int nt = Kb / 128;
    unsigned voffA[2], voffB[2];
#pragma unroll
    for (int i = 0; i < 2; ++i) { int R, C; stage_rc(tid * 16 + i * 8192, R, C); const int Rb = Epi::PERM ? ((R & ~31) + perm32(R & 31)) : R;
        voffA[i] = (unsigned)(R * Kb + C * 2); voffB[i] = (unsigned)(Rb * Kb + C * 2); }
    const size_t kstep = (size_t)128;
    const size_t hstep = (size_t)HALF * Kb;
    const unsigned ldsw = (unsigned)wid * 1024u;
    const int aoff = lds_byte(wr * 64 + fr, F8 ? fq * 16 : fq * 8), boff = lds_byte(wc * 32 + fr, F8 ? fq * 16 : fq * 8);
#define PG8_SA(b, h) (((b) * 2 + (h)) * HTB)
#define PG8_SB(b, h) ((4 + (b) * 2 + (h)) * HTB)
#define PG8_STAGE(bufoff, gbase, voff) do { _Pragma("unroll") for (int _i = 0; _i < 2; ++_i) \
        __builtin_amdgcn_global_load_lds((const unsigned*)((const char*)(gbase) + (voff)[_i]), (LAS unsigned*)(lds + (bufoff) + ldsw + _i * 8192), 16, 0, PG8_AUX); } while (0)
#define PG8_LDA(dst, b, h) do { _Pragma("unroll") for (int m = 0; m < 4; ++m) _Pragma("unroll") for (int k = 0; k < 2; ++k) dst[m][k] = *(const LAS bf16x8*)(lds + PG8_SA(b, h) + aoff + m * 2048 + (F8 ? k * 16 : k * 1024)); } while (0)
#define PG8_LDB(dst, b, h) do { _Pragma("unroll") for (int n = 0; n < 2; ++n) _Pragma("unroll") for (int k = 0; k < 2; ++k) dst[n][k] = *(const LAS bf16x8*)(lds + PG8_SB(b, h) + boff + n * 2048 + (F8 ? k * 16 : k * 1024)); } while (0)
#define PG8_F8OP(X) __builtin_bit_cast(v8i_t, __builtin_shufflevector(X[0], X[1], 0, 1, 2, 3, 4, 5, 6, 7, 8, 9, 10, 11, 12, 13, 14, 15))
#define PG8_MMA(ai, bj, At, Bt) do { __builtin_amdgcn_s_setprio(1); \
        if constexpr (F8) { _Pragma("unroll") for (int m = 0; m < 4; ++m) _Pragma("unroll") for (int n = 0; n < 2; ++n) \
            asm volatile("v_mfma_scale_f32_16x16x128_f8f6f4 %0, %1, %2, %0, %3, %4 op_sel_hi:[0,0,0]" : "+v"(acc[ai][bj][m][n]) : "v"(PG8_F8OP(Bt[n])), "v"(PG8_F8OP(At[m])), "v"(f8sa), "v"(f8sb)); } \
        else { _Pragma("unroll") for (int m = 0; m < 4; ++m) _Pragma("unroll") for (int n = 0; n < 2; ++n) _Pragma("unroll") for (int k = 0; k < 2; ++k) \
            acc[ai][bj][m][n] = __builtin_amdgcn_mfma_f32_16x16x32_bf16(Bt[n][k], At[m][k], acc[ai][bj][m][n], 0, 0, 0); } \
        __builtin_amdgcn_s_setprio(0); } while (0)
#define PG8_WAIT_V(n) asm volatile("s_waitcnt vmcnt(" #n ")" ::: "memory")
#define PG8_WAIT_L(n) asm volatile("s_waitcnt lgkmcnt(" #n ")" ::: "memory")
#define PG8_BAR __builtin_amdgcn_s_barrier()
#define PG8_SCHED __builtin_amdgcn_sched_barrier(0)
    Unit cur, nxt; int ui = 0;
    if (!S.next(0, cur)) return;
    f32x4 acc[2][2][4][2];
#pragma unroll
    for (int a = 0; a < 2; ++a)
#pragma unroll
        for (int b = 0; b < 2; ++b)
#pragma unroll
            for (int m = 0; m < 4; ++m)
#pragma unroll
                for (int n = 0; n < 2; ++n) acc[a][b][m][n] = (f32x4){0.f, 0.f, 0.f, 0.f};
    bf16x8 At[4][2], B0[2][2], B1[2][2];
    const char* cA = S.pa(cur); const char* cB = S.pb(cur);
    PG8_STAGE(PG8_SB(0, 0), cB, voffB); PG8_STAGE(PG8_SB(0, 1), cB + hstep, voffB); PG8_STAGE(PG8_SA(0, 0), cA, voffA); PG8_STAGE(PG8_SA(0, 1), cA + hstep, voffA);
    if (wr == 1) PG8_BAR;
    PG8_WAIT_V(2); PG8_BAR;
    PG8_STAGE(PG8_SB(1, 0), cB + kstep, voffB); PG8_STAGE(PG8_SA(1, 0), cA + kstep, voffA); PG8_STAGE(PG8_SB(1, 1), cB + hstep + kstep, voffB);
    PG8_WAIT_V(6); PG8_BAR;
    for (;;) {
        const bool has_next = S.next(ui + 1, nxt);
        const char* nA = has_next ? S.pa(nxt) : cA; const char* nB = has_next ? S.pb(nxt) : cB;
        for (int t = 0; t < nt; t += 2) {
            const bool last = (t == nt - 2);
            const char* a1 = cA + (size_t)(t + 1) * kstep;
            const char* a2 = last ? nA : cA + (size_t)(t + 2) * kstep; const char* b2 = last ? nB : cB + (size_t)(t + 2) * kstep;
            const char* a3 = a2 + kstep; const char* b3 = b2 + kstep;
            PG8_LDB(B0, 0, 0); PG8_LDB(B1, 0, 1); PG8_SCHED; PG8_LDA(At, 0, 0); PG8_STAGE(PG8_SA(1, 1), a1 + hstep, voffA);
            PG8_WAIT_V(8); PG8_WAIT_L(0); PG8_BAR; PG8_MMA(0, 0, At, B0); PG8_MMA(0, 1, At, B1); PG8_BAR; PG8_SCHED;
            PG8_LDA(At, 0, 1); PG8_STAGE(PG8_SB(0, 0), b2, voffB); PG8_STAGE(PG8_SB(0, 1), b2 + hstep, voffB); PG8_STAGE(PG8_SA(0, 0), a2, voffA);
            PG8_WAIT_V(8); PG8_WAIT_L(0); PG8_BAR; PG8_MMA(1, 0, At, B0); PG8_MMA(1, 1, At, B1); PG8_BAR; PG8_SCHED;
            PG8_LDB(B0, 1, 0); PG8_LDB(B1, 1, 1); PG8_SCHED; PG8_LDA(At, 1, 0); PG8_STAGE(PG8_SA(0, 1), a2 + hstep, voffA);
            PG8_WAIT_V(8); PG8_WAIT_L(0); PG8_BAR; PG8_MMA(0, 0, At, B0); PG8_MMA(0, 1, At, B1); PG8_BAR; PG8_SCHED;
            PG8_LDA(At, 1, 1); PG8_STAGE(PG8_SB(1, 0), b3, voffB); PG8_STAGE(PG8_SB(1, 1), b3 + hstep, voffB); PG8_STAGE(PG8_SA(1, 0), a3, voffA);
            PG8_WAIT_V(8); PG8_WAIT_L(0); PG8_BAR; PG8_MMA(1, 0, At, B0); PG8_MMA(1, 1, At, B1); PG8_BAR; PG8_SCHED;
        }
        if (wr == 0) PG8_BAR;
        if constexpr (F8) asm volatile("s_nop 15\n\ts_nop 7" ::: "memory");
        if constexpr (Epi::HAS_PRE) {
            E.pre(cur, (LAS float*)(lds + STAGE_BYTES + 1024), tid); PG8_WAIT_L(0); PG8_BAR; }
        E(acc, cur, wr, wc, fr, fq, (const LAS float*)(lds + STAGE_BYTES + 1024));
        if (!has_next) break;
#pragma unroll
        for (int a = 0; a < 2; ++a)
#pragma unroll
            for (int b = 0; b < 2; ++b)
#pragma unroll
                for (int m = 0; m < 4; ++m)
#pragma unroll
                    for (int n = 0; n < 2; ++n) acc[a][b][m][n] = (f32x4){0.f, 0.f, 0.f, 0.f};
        cur = nxt; cA = nA; cB = nB; ++ui;
        if (wr == 1) PG8_BAR;
    }
    PG8_WAIT_V(0);
    PG8_BAR;
#undef PG8_SA
#undef PG8_SB
#undef PG8_STAGE
#undef PG8_LDA
#undef PG8_LDB
#undef PG8_MMA
#undef PG8_F8OP
#undef PG8_WAIT_V
#undef PG8_WAIT_L
#undef PG8_BAR
#undef PG8_SCHED
}
}
typedef GAS unsigned gu32;
#define RLX_AGENT __ATOMIC_RELAXED, __HIP_MEMORY_SCOPE_AGENT
#define XB_TMO      128
#define XB_XCNT(j)  (256  + 64 * (j))
#define XB_XSUB(j)  (1280 + 64 * (j))
#define XB_XGEN(j)  (2304 + 64 * (j))
#define XB_TOP      3328
#define XB_TOPGEN   3392
#define XCD_BAR_WORDS 3456
#define XB_SPIN_CAP (1u << 18)
__device__ __forceinline__ unsigned xb_ld(unsigned* p)              { return __hip_atomic_load(p, __ATOMIC_RELAXED, __HIP_MEMORY_SCOPE_AGENT); }
__device__ __forceinline__ unsigned xb_add(unsigned* p, unsigned v) { return __hip_atomic_fetch_add(p, v, __ATOMIC_RELAXED, __HIP_MEMORY_SCOPE_AGENT); }
__device__ __forceinline__ unsigned xb_xcc_id() { return (unsigned)__builtin_amdgcn_s_getreg((3 << 11) | 20) & 0xFu; }
#define XB_SPIN(cond, bar) do { unsigned _sp = 0; while (cond) { __builtin_amdgcn_s_sleep(1); \
    if ((++_sp & 255u) == 0u) { if (xb_ld(&(bar)[XB_TMO])) break; if (_sp > XB_SPIN_CAP) { atomicAdd(&(bar)[XB_TMO], 1u); break; } } } } while (0)
struct XcdBarrier { unsigned* bar; unsigned x; volatile LAS unsigned* st; };
__device__ __forceinline__ XcdBarrier xcd_barrier_post(unsigned* bar, volatile LAS unsigned* st) {
    XcdBarrier b; b.bar = bar; b.x = xb_xcc_id(); b.st = st;
    if (threadIdx.x == 0) (void)xb_add(&bar[XB_XCNT(b.x)], 1u);
    return b;
}
__device__ __forceinline__ void xcd_barrier_complete(unsigned* bar, unsigned x, unsigned& nloc, unsigned& nx) {
    const unsigned G = gridDim.x * gridDim.y * gridDim.z;
    unsigned sum, cnt, mine, sp = 0u;
    for (;;) {
        sum = 0u; cnt = 0u; mine = 0u;
#pragma unroll
        for (unsigned j = 0; j < 16; ++j) { const unsigned c = xb_ld(&bar[XB_XCNT(j)]); sum += c; cnt += (c > 0u) ? 1u : 0u; mine = (j == x) ? c : mine; }
        if (sum == G) break;
        __builtin_amdgcn_s_sleep(1);
        if ((++sp & 255u) == 0u) { if (xb_ld(&bar[XB_TMO])) break; if (sp > XB_SPIN_CAP) { atomicAdd(&bar[XB_TMO], 1u); break; } }
    }
    nloc = mine > 0u ? mine : 1u; nx = cnt > 0u ? cnt : 1u;
}
__device__ __forceinline__ void xcd_barrier(const XcdBarrier& b) {
    asm volatile("s_waitcnt vmcnt(0)" ::: "memory");
    __syncthreads();
    if (threadIdx.x == 0) {
        unsigned* bar = b.bar;
        __builtin_amdgcn_s_waitcnt(0);
        unsigned nloc = b.st[0], nx = b.st[1];
        if (nloc == 0u) { xcd_barrier_complete(bar, b.x, nloc, nx); b.st[0] = nloc; b.st[1] = nx; }
        const unsigned old = xb_add(&bar[XB_XSUB(b.x)], 1u);
        const unsigned gen = old / nloc;
        if (old + 1u == (gen + 1u) * nloc) {
            __builtin_amdgcn_fence(__ATOMIC_RELEASE, "agent");
            asm volatile("s_waitcnt vmcnt(0)" ::: "memory");
            const unsigned og = xb_add(&bar[XB_TOP], 1u);
            const unsigned tg = og / nx;
            if (og + 1u == (tg + 1u) * nx) xb_add(&bar[XB_TOPGEN], 1u);
            else XB_SPIN(xb_ld(&bar[XB_TOPGEN]) == tg, bar);
            __builtin_amdgcn_fence(__ATOMIC_ACQUIRE, "agent");
            xb_add(&bar[XB_XGEN(b.x)], 1u);
            asm volatile("s_waitcnt vmcnt(0)" ::: "memory");
        } else {
            XB_SPIN(xb_ld(&bar[XB_XGEN(b.x)]) == gen, bar);
            __builtin_amdgcn_fence(__ATOMIC_ACQUIRE, "agent");
            asm volatile("s_waitcnt vmcnt(0)" ::: "memory");
        }
    }
    __syncthreads();
}
struct Frame {
    LAS unsigned char* lds;
    volatile LAS unsigned* MISC;
    unsigned char* ws;
    int tid, lane, wave;
    int vcu, G;
    const float* in[19];
    float* out;
};
#define WSP(T, off) ((T*)(F.ws + (off)))

__device__ __forceinline__ void p0_transpose_item(const float* W, int K, int N, int k0, int n0, bf16_t* WT, int drow, bool rope, const float* gain, LAS float* scr, int lane) {
    { f32x4 v[8]; float gk[8];
#pragma unroll
      for (int i = 0; i < 8; ++i) { const int kk = 8 * i + (lane >> 3); v[i] = *(const GAS f32x4*)(W + (size_t)(k0 + kk) * N + n0 + 4 * (lane & 7)); gk[i] = gain ? gain[k0 + kk] : 1.f; }
#pragma unroll
      for (int i = 0; i < 8; ++i) { const int kk = 8 * i + (lane >> 3); LAS float* d = scr + kk * 33 + 4 * (lane & 7);
#pragma unroll
          for (int e = 0; e < 4; ++e) d[e] = v[i][e] * gk[i]; } }
    LDS_WAIT(); asm volatile("" ::: "memory");
    const int c = lane & 7;
#pragma unroll
    for (int j = 0; j < 4; ++j) { const int n = (lane >> 3) + 8 * j; const LAS float* s = scr + (8 * c) * 33 + n;
        u32x4 o; o.x = cvt_pk_bf16(s[0 * 33], s[1 * 33]); o.y = cvt_pk_bf16(s[2 * 33], s[3 * 33]); o.z = cvt_pk_bf16(s[4 * 33], s[5 * 33]); o.w = cvt_pk_bf16(s[6 * 33], s[7 * 33]);
        const int dr = drow + (rope ? (8 * (n >> 2) + (n & 3)) : n);
        *(GAS u32x4*)(WT + (size_t)dr * K + k0 + 8 * c) = o; }
    LDS_WAIT(); asm volatile("" ::: "memory");
}
__device__ __forceinline__ void p0_transpose_item8(const float* W, int K, int N, int k0, int n0, unsigned char* WT, int drow, bool rope, float scale, LAS float* scr, int lane, const float* gain = nullptr) {
    { f32x4 v[8]; float gk[8];
#pragma unroll
      for (int i = 0; i < 8; ++i) { const int kk = 8 * i + (lane >> 3); v[i] = *(const GAS f32x4*)(W + (size_t)(k0 + kk) * N + n0 + 4 * (lane & 7)); gk[i] = gain ? gain[k0 + kk] * scale : scale; }
#pragma unroll
      for (int i = 0; i < 8; ++i) { const int kk = 8 * i + (lane >> 3); LAS float* d = scr + kk * 33 + 4 * (lane & 7);
#pragma unroll
          for (int e = 0; e < 4; ++e) d[e] = v[i][e] * gk[i]; } }
    LDS_WAIT(); asm volatile("" ::: "memory");
#pragma unroll
    for (int j = 0; j < 2; ++j) { const int q = lane + 64 * j, n = q >> 2, c = q & 3; const LAS float* s = scr + (16 * c) * 33 + n; u32x4 o;
#pragma unroll
        for (int d = 0; d < 4; ++d) { int w = 0; w = __builtin_amdgcn_cvt_pk_fp8_f32(s[(4 * d) * 33], s[(4 * d + 1) * 33], w, false); w = __builtin_amdgcn_cvt_pk_fp8_f32(s[(4 * d + 2) * 33], s[(4 * d + 3) * 33], w, true); o[d] = (unsigned)w; }
        const int dr = drow + (rope ? (8 * (n >> 2) + (n & 3)) : n);
        *(GAS u32x4*)(WT + (size_t)dr * K + k0 + 16 * c) = o; }
    LDS_WAIT(); asm volatile("" ::: "memory");
}
__device__ __forceinline__ void rms_row_to_fp8(const float* xrow, const float* g, unsigned char* orow, int lane) {
    const GAS f32x4* xr = (const GAS f32x4*)xrow + lane; const GAS f32x4* gr = (const GAS f32x4*)g + lane;
    f32x4 v[8]; float s = 0.f;
#pragma unroll
    for (int j = 0; j < 8; ++j) { v[j] = xr[64 * j]; s += (v[j].x * v[j].x + v[j].y * v[j].y) + (v[j].z * v[j].z + v[j].w * v[j].w); }
    const float rstd = 1.0f / sqrtf(wave_sum(s) * (1.f / DM) + NORM_EPS);
    GAS unsigned* o4 = (GAS unsigned*)orow + lane;
#pragma unroll
    for (int j = 0; j < 8; ++j) { const f32x4 y = (v[j] * rstd) * gr[64 * j]; int w = 0; w = __builtin_amdgcn_cvt_pk_fp8_f32(y[0], y[1], w, false); w = __builtin_amdgcn_cvt_pk_fp8_f32(y[2], y[3], w, true); o4[64 * j] = (unsigned)w; }
}
__device__ __forceinline__ void rms_row_to_bf16(const float* xrow, const float* g, bf16_t* orow, int lane) {
    const GAS f32x4* xr = (const GAS f32x4*)xrow + lane; const GAS f32x4* gr = (const GAS f32x4*)g + lane;
    f32x4 v[8]; float s = 0.f;
#pragma unroll
    for (int j = 0; j < 8; ++j) { v[j] = xr[64 * j]; s += (v[j].x * v[j].x + v[j].y * v[j].y) + (v[j].z * v[j].z + v[j].w * v[j].w); }
    const float rstd = 1.0f / sqrtf(wave_sum(s) * (1.f / DM) + NORM_EPS);
    GAS u32x2* o8 = (GAS u32x2*)orow + lane;
#pragma unroll
    for (int j = 0; j < 8; ++j) { const f32x4 gg = gr[64 * j]; o8[64 * j] = pack4((v[j] * rstd) * gg); }
}
template <int PART>
__device__ __forceinline__ void p0_prologue(Frame& F, int rank, int nrank) {
    LAS float* scr = (LAS float*)(F.lds + F.wave * 16384);
    const int gw = rank * NWAVES + F.wave, NGW = nrank * NWAVES, lane = F.lane; const int gt = rank * 512 + F.tid, NGT = nrank * 512;
    unsigned char* WIN = WSP(unsigned char, WS_WIN); unsigned char* WVT = WSP(unsigned char, WS_WVT);
    constexpr int I_IN = 32 * 258, I_UQ = 8 * 96, I_UKV = 8 * 128, I_NA = 16 * 64, I_MLA = 32 * 64, I_OUT = 32 * 64;
    constexpr int NEARLY = I_IN + I_UQ + I_UKV, NITEMS = NEARLY + I_NA + I_MLA + I_OUT;
    for (int it = (PART == 0 ? 0 : NEARLY) + gw; it < (PART == 0 ? NEARLY : NITEMS); it += NGW) {
        int r = it;
        if (r < I_IN) { const int kb = r / 258, sb = r % 258, n0 = 32 * sb, k0 = 64 * kb; const float* W = F.in[3];
            unsigned char* dst = WIN; int drow; bool rope = false;
            if (n0 < 1024) drow = C_NAQ + n0;
            else if (n0 < 2048) drow = C_NAK + (n0 - 1024);
            else if (n0 < 3072) { dst = WVT; drow = n0 - 2048; }
            else if (n0 < 3584) drow = C_CQ + (n0 - 3072);
            else if (n0 < 4096) drow = C_CKV + (n0 - 3584);
            else if (n0 < 4160) { drow = C_KR + ((n0 - 4096) ? 4 : 0); rope = true; }
            else if (n0 < 6208) drow = C_GA + (n0 - 4160);
            else drow = C_GB + (n0 - 6208);
            p0_transpose_item8(W, 2048, 8256, k0, n0, dst, drow, rope, 64.f, scr, lane); continue; } r -= I_IN;
        if (r < I_UQ) { const int kb = r / 96, sb = r % 96, n0 = 32 * sb, k0 = 64 * kb; const int hd = n0 / 192, w = n0 % 192;
            int drow = n0; bool rope = false; if (w >= 128) { rope = true; drow = hd * 192 + 128 + ((w - 128) ? 4 : 0); }
            p0_transpose_item8(F.in[7], 512, 3072, k0, n0, WSP(unsigned char, WS_WUQ), drow, rope, 16.f, scr, lane, F.in[6]); continue; } r -= I_UQ;
        if (r < I_UKV) { const int kb = r / 128, sb = r % 128; p0_transpose_item8(F.in[9], 512, 4096, 64 * kb, 32 * sb, WSP(unsigned char, WS_WUKV), 32 * sb, false, 16.f, scr, lane, F.in[8]); continue; } r -= I_UKV;
        if (r < I_NA) { const int kb = r / 64, sb = r % 64; p0_transpose_item8(F.in[10], 1024, 2048, 64 * kb, 32 * sb, WSP(unsigned char, WS_WNA), 32 * sb, false, 32.f, scr, lane); continue; } r -= I_NA;
        if (r < I_MLA) { const int kb = r / 64, sb = r % 64; p0_transpose_item8(F.in[11], 2048, 2048, 64 * kb, 32 * sb, WSP(unsigned char, WS_WMLA), 32 * sb, false, 64.f, scr, lane); continue; } r -= I_MLA;
        { const int kb = r / 64, sb = r % 64; p0_transpose_item8(F.in[12], 2048, 2048, 64 * kb, 32 * sb, WSP(unsigned char, WS_WOUT), 32 * sb, false, 64.f, scr, lane); }
    }
    if (PART == 0) { GAS u32x4* z = (GAS u32x4*)(WIN + (size_t)(C_KR + 64) * 2048); const int n16 = (NMAIN - C_KR - 64) * 2048 / 16;
      for (int i = gt; i < n16; i += NGT) z[i] = (u32x4){0u, 0u, 0u, 0u}; }
    if (PART == 0) { unsigned char* HN1 = WSP(unsigned char, WS_HN1);
#define P0_ROWSRC(m_) (((m_) < MREAL) ? F.in[0] + (size_t)(m_) * DM : F.in[1] + (size_t)((m_) - MREAL) * DM)
      { f32x4 v[8]; int m = gw;
        if (m < MREAL + NMETA) { const GAS f32x4* xr = (const GAS f32x4*)P0_ROWSRC(m) + lane;
#pragma unroll
            for (int j = 0; j < 8; ++j) v[j] = xr[64 * j]; }
        const GAS f32x4* gr = (const GAS f32x4*)F.in[2] + lane;
        while (m < MREAL + NMETA) { const int mn = m + NGW; f32x4 vn[8];
            { const int ml = mn < MREAL + NMETA ? mn : m; const GAS f32x4* xr = (const GAS f32x4*)P0_ROWSRC(ml) + lane;
#pragma unroll
              for (int j = 0; j < 8; ++j) vn[j] = xr[64 * j]; }
            float sq = 0.f;
#pragma unroll
            for (int j = 0; j < 8; ++j) sq += (v[j].x * v[j].x + v[j].y * v[j].y) + (v[j].z * v[j].z + v[j].w * v[j].w);
            const float rstd = 1.0f / sqrtf(wave_sum(sq) * (1.f / DM) + NORM_EPS);
            GAS unsigned* o4 = (GAS unsigned*)(HN1 + (size_t)m * DM) + lane;
#pragma unroll
            for (int j = 0; j < 8; ++j) { const f32x4 y = (v[j] * rstd) * gr[64 * j]; int w = 0; w = __builtin_amdgcn_cvt_pk_fp8_f32(y[0], y[1], w, false); w = __builtin_amdgcn_cvt_pk_fp8_f32(y[2], y[3], w, true); o4[64 * j] = (unsigned)w; }
#pragma unroll
            for (int j = 0; j < 8; ++j) v[j] = vn[j];
            m = mn; } }
#undef P0_ROWSRC
      GAS u32x4* z = (GAS u32x4*)(HN1 + (size_t)(MREAL + NMETA) * DM); const int n16 = (MPAD - MREAL - NMETA) * DM / 16;
      for (int i = gt; i < n16; i += NGT) z[i] = (u32x4){0u, 0u, 0u, 0u}; }
    if (PART == 0) { float* ct = WSP(float, WS_COS); float* st = WSP(float, WS_SIN);
      for (int i = gt; i < NPOS * 32; i += NGT) { const int p = i >> 5, j = i & 31;
          const float inv = __builtin_powf(10000.0f, -(float)(2 * j) / 64.0f); const float ang = (float)p * inv;
          double r = (double)ang * 0.15915494309189535; r -= __builtin_rint(r); const float rf = (float)r;
          ct[i] = __builtin_amdgcn_cosf(rf); st[i] = __builtin_amdgcn_sinf(rf); } }
    if (PART == 1) { const float* SK = F.in[15]; const float* WQ = F.in[14]; const float* g2 = F.in[13]; bf16_t* WSCp = WSP(bf16_t, WS_WSC);
      const int l15 = lane & 15, l4 = lane >> 4;
      for (int task = gw; task < 2048; task += NGW) { const int g = task >> 7, nt = (task >> 4) & 7, kc = task & 15, n0 = nt * 16;
          bf16x8 bfr[4];
#pragma unroll
          for (int kk = 0; kk < 4; ++kk) { const float* p = SK + ((size_t)g * 128 + n0 + l15) * 128 + 32 * kk + 8 * l4; const f32x4 a = *(const GAS f32x4*)p, b = *(const GAS f32x4*)(p + 4);
              const u32x4 w = pack8(a, b); bfr[kk] = __builtin_bit_cast(bf16x8, w); }
          for (int kt = 0; kt < 8; ++kt) { const int k0 = (kc * 8 + kt) * 16; f32x4 acc = (f32x4){0.f, 0.f, 0.f, 0.f};
#pragma unroll
              for (int kk = 0; kk < 4; ++kk) { const float* p = WQ + (size_t)(k0 + l15) * 2048 + g * 128 + 32 * kk + 8 * l4; const f32x4 a = *(const GAS f32x4*)p, b = *(const GAS f32x4*)(p + 4);
                  const u32x4 w = pack8(a, b); acc = __builtin_amdgcn_mfma_f32_16x16x32_bf16(__builtin_bit_cast(bf16x8, w), bfr[kk], acc, 0, 0, 0); }
              const f32x4 gg = *(const GAS f32x4*)(g2 + k0 + 4 * l4);
              *(GAS u32x2*)(WSCp + (size_t)(g * 128 + n0 + l15) * 2048 + k0 + 4 * l4) = pack4(acc * gg); } } }
}
using pg8::Unit;
struct SchedGrid {
    int G, c, nM, nN; const char* A; const char* B; size_t tstep;
    __device__ __forceinline__ bool next(int i, Unit& u) const { const int L = i * G + c; if (L >= nM * nN) return false; pg8::grid_order(L, nM, nN, u.pm, u.pn); u.kind = 0; return true; }
    __device__ __forceinline__ const char* pa(const Unit& u) const { return A + (size_t)u.pm * tstep; }
    __device__ __forceinline__ const char* pb(const Unit& u) const { return B + (size_t)u.pn * tstep; }
};
constexpr int P1_MAIN = 64 * 29, P1_VT = 4 * 65, P1_META = 7, P1_UNITS = P1_MAIN + P1_VT + P1_META;
struct SchedP1 {
    int G, c; const char* hn1; const char* win; const char* wvt; size_t tstep;
    __device__ __forceinline__ bool next(int i, Unit& u) const {
        const int L = i * G + c; if (L >= P1_UNITS) return false;
        if (L < P1_MAIN) { pg8::grid_order(L, 64, 29, u.pm, u.pn); u.kind = 0; }
        else if (L < P1_MAIN + P1_VT) { const int idx = L - P1_MAIN; u.pm = idx & 3; u.pn = idx >> 2; u.kind = 1; }
        else { const int idx = L - P1_MAIN - P1_VT; u.pm = 64; u.pn = idx < 4 ? 4 + idx : (idx < 6 ? 10 + (idx - 4) : 28); u.kind = 0; }
        return true; }
    __device__ __forceinline__ const char* pa(const Unit& u) const { return (u.kind == 1 ? wvt : hn1) + (size_t)u.pm * tstep; }
    __device__ __forceinline__ const char* pb(const Unit& u) const { return (u.kind == 1 ? hn1 : win) + (size_t)u.pn * tstep; }
};
__device__ __forceinline__ void rope4(const f32x4 x1, const f32x4 x2, const float* cosT, const float* sinT, int pos, int j0, f32x4& lo, f32x4& hi) {
    const f32x4 c = *(const GAS f32x4*)(cosT + pos * 32 + j0), s = *(const GAS f32x4*)(sinT + pos * 32 + j0);
    lo = x1 * c - x2 * s; hi = x2 * c + x1 * s;
}
struct EpiP1 {
    static constexpr bool PERM = true, HAS_PRE = false;
    bf16_t *naq, *nak, *vt; unsigned char *cq, *ckv; bf16_t *kr, *ga, *gb; float *ssq_q, *ssq_kv; const float *cosT, *sinT;
    __device__ __forceinline__ void operator()(const f32x4 (&acc)[2][2][4][2], const Unit& u, int wr, int wc, int fr, int fq, const LAS float* rowsc) const {
        const int row0 = u.pm * 256 + wr * 64 + fr, colu = wc * 32 + 8 * fq;
        if (u.kind == 1) {
#pragma unroll
            for (int ai = 0; ai < 2; ++ai)
#pragma unroll
                for (int m = 0; m < 4; ++m) { bf16_t* rp = vt + (size_t)(row0 + ai * 128 + m * 16) * VT_PITCH + u.pn * 256 + colu;
#pragma unroll
                    for (int bj = 0; bj < 2; ++bj) *(GAS u32x4*)(rp + bj * 128) = pack8(acc[ai][bj][m][0], acc[ai][bj][m][1]); }
            return; }
        const int pn = u.pn;
        if (pn == 28) {
            if (wc < 2) { const int j0 = 4 * (4 * wc + fq);
#pragma unroll
                for (int ai = 0; ai < 2; ++ai)
#pragma unroll
                    for (int m = 0; m < 4; ++m) { const int row = row0 + ai * 128 + m * 16; const int pos = row < MREAL ? NMETA + (row & (SEQ - 1)) : row - MREAL;
                        f32x4 lo, hi; rope4(acc[ai][0][m][0], acc[ai][0][m][1], cosT, sinT, pos, j0, lo, hi);
                        *(GAS u32x2*)(kr + (size_t)row * 64 + j0) = pack4(lo); *(GAS u32x2*)(kr + (size_t)row * 64 + 32 + j0) = pack4(hi); } }
            return; }
        if (pn >= 12) {
            bf16_t* base = pn < 20 ? ga : gb; const int colt = (pn < 20 ? pn - 12 : pn - 20) * 256 + colu;
#pragma unroll
            for (int ai = 0; ai < 2; ++ai)
#pragma unroll
                for (int m = 0; m < 4; ++m) { bf16_t* rp = base + (size_t)(row0 + ai * 128 + m * 16) * 2048 + colt;
#pragma unroll
                    for (int bj = 0; bj < 2; ++bj) { f32x4 a = acc[ai][bj][m][0], b = acc[ai][bj][m][1];
#pragma unroll
                        for (int i = 0; i < 4; ++i) { a[i] = sigmoidf_(a[i]); b[i] = sigmoidf_(b[i]); }
                        *(GAS u32x4*)(rp + bj * 128) = pack8(a, b); } }
            return; }
        if (pn >= 8) {
            const bool isq = pn < 10; unsigned char* base = isq ? cq : ckv; float* ssq = isq ? ssq_q : ssq_kv; const int colt = (isq ? pn - 8 : pn - 10) * 256 + colu;
#pragma unroll
            for (int ai = 0; ai < 2; ++ai)
#pragma unroll
                for (int m = 0; m < 4; ++m) { const int row = row0 + ai * 128 + m * 16; unsigned char* rp = base + (size_t)row * 512 + colt; float s = 0.f;
#pragma unroll
                    for (int bj = 0; bj < 2; ++bj) { const f32x4 a = acc[ai][bj][m][0], b = acc[ai][bj][m][1];
                        s += (a[0] * a[0] + a[1] * a[1]) + (a[2] * a[2] + a[3] * a[3]) + (b[0] * b[0] + b[1] * b[1]) + (b[2] * b[2] + b[3] * b[3]);
                        *(GAS u32x2*)(rp + bj * 128) = pack8_fp8(a, b); }
                    s += __shfl_xor(s, 16); s += __shfl_xor(s, 32);
                    if (fq == 0) ssq[(size_t)((pn & 1) * 4 + wc) * MPAD + row] = s; }
            return; }
        {
            bf16_t* base = pn < 4 ? naq : nak; const int colt = (pn & 3) * 256 + colu;
#pragma unroll
            for (int ai = 0; ai < 2; ++ai)
#pragma unroll
                for (int m = 0; m < 4; ++m) { bf16_t* rp = base + (size_t)(row0 + ai * 128 + m * 16) * 1024 + colt;
#pragma unroll
                    for (int bj = 0; bj < 2; ++bj) *(GAS u32x4*)(rp + bj * 128) = pack8(acc[ai][bj][m][0], acc[ai][bj][m][1]); }
        }
    }
};
constexpr int P3_Q = 64 * 12, P3_KV = 65 * 16, P3_UNITS = P3_Q + P3_KV;
struct SchedP3 {
    int G, c; const char* cq; const char* ckv; const char* wuq; const char* wukv; size_t tstep;
    __device__ __forceinline__ bool next(int i, Unit& u) const {
        const int L = i * G + c; if (L >= P3_UNITS) return false;
        if (L < P3_Q) { pg8::grid_order(L, 64, 12, u.pm, u.pn); u.kind = 0; } else { pg8::grid_order(L - P3_Q, 65, 16, u.pm, u.pn); u.kind = 1; }
        return true; }
    __device__ __forceinline__ const char* pa(const Unit& u) const { return (u.kind ? ckv : cq) + (size_t)u.pm * tstep; }
    __device__ __forceinline__ const char* pb(const Unit& u) const { return (u.kind ? wukv : wuq) + (size_t)u.pn * tstep; }
};
template <int NS, int LD> __device__ __forceinline__ float rstd_slabs(const float* part, int row, float invn) {
    float s = 0.f;
#pragma unroll
    for (int i = 0; i < NS; ++i) s += part[(size_t)i * LD + row];
    return 1.0f / sqrtf(s * invn + NORM_EPS);
}
struct EpiP3 {
    static constexpr bool PERM = true, HAS_PRE = true;
    bf16_t *qm, *kn, *vv; const float *ssq_q, *ssq_kv; const float *cosT, *sinT;
    __device__ __forceinline__ void pre(const Unit& u, LAS float* sc, int tid) const { if (tid < 256) { const int row = u.pm * 256 + tid; sc[tid] = u.kind ? rstd_slabs<8, MPAD>(ssq_kv, row, 1.f / 512.f) : rstd_slabs<8, MPAD>(ssq_q, row, 1.f / 512.f); } }
    __device__ __forceinline__ void operator()(const f32x4 (&acc)[2][2][4][2], const Unit& u, int wr, int wc, int fr, int fq, const LAS float* rowsc) const {
        const int row0 = u.pm * 256 + wr * 64 + fr, colu = wc * 32 + 8 * fq;
        if (u.kind == 1) {
#pragma unroll
            for (int ai = 0; ai < 2; ++ai)
#pragma unroll
                for (int m = 0; m < 4; ++m) { const int row = row0 + ai * 128 + m * 16; const float rs = rowsc[ai * 128 + wr * 64 + m * 16 + fr];
                    const size_t off = (size_t)row * 2048 + u.pn * 128 + colu;
                    *(GAS u32x4*)(kn + off) = pack8(acc[ai][0][m][0] * rs, acc[ai][0][m][1] * rs);
                    *(GAS u32x4*)(vv + off) = pack8(acc[ai][1][m][0] * rs, acc[ai][1][m][1] * rs); }
            return; }
#pragma unroll
        for (int bj = 0; bj < 2; ++bj) { const int c8 = u.pn * 256 + bj * 128 + colu; const int hd = c8 / 192, w = c8 - hd * 192;
            if (w < 128) {
#pragma unroll
                for (int ai = 0; ai < 2; ++ai)
#pragma unroll
                    for (int m = 0; m < 4; ++m) { const int row = row0 + ai * 128 + m * 16; const float rs = rowsc[ai * 128 + wr * 64 + m * 16 + fr];
                        *(GAS u32x4*)(qm + (size_t)row * 3072 + c8) = pack8(acc[ai][bj][m][0] * rs, acc[ai][bj][m][1] * rs); }
            } else { const int j0 = (w - 128) >> 1;
#pragma unroll
                for (int ai = 0; ai < 2; ++ai)
#pragma unroll
                    for (int m = 0; m < 4; ++m) { const int row = row0 + ai * 128 + m * 16; const float rs = rowsc[ai * 128 + wr * 64 + m * 16 + fr];
                        const int pos = NMETA + (row & (SEQ - 1)); f32x4 lo, hi; rope4(acc[ai][bj][m][0] * rs, acc[ai][bj][m][1] * rs, cosT, sinT, pos, j0, lo, hi);
                        bf16_t* qp = qm + (size_t)row * 3072 + hd * 192 + 128 + j0; *(GAS u32x2*)qp = pack4(lo); *(GAS u32x2*)(qp + 32) = pack4(hi); }
            } }
    }
};
__device__ __forceinline__ void unpack8(const u32x4 w, f32x4& a, f32x4& b) { a = (f32x4){bf_lo(w.x), bf_hi(w.x), bf_lo(w.y), bf_hi(w.y)}; b = (f32x4){bf_lo(w.z), bf_hi(w.z), bf_lo(w.w), bf_hi(w.w)}; }
struct EpiP5a {
    static constexpr bool PERM = true, HAS_PRE = false;
    const bf16_t* ga; bf16_t* t1;
    __device__ __forceinline__ void operator()(const f32x4 (&acc)[2][2][4][2], const Unit& u, int wr, int wc, int fr, int fq, const LAS float* rowsc) const {
        const int row0 = u.pm * 256 + wr * 64 + fr, col0 = u.pn * 256 + wc * 32 + 8 * fq;
#pragma unroll
        for (int ai = 0; ai < 2; ++ai)
#pragma unroll
            for (int m = 0; m < 4; ++m) { const size_t off = (size_t)(row0 + ai * 128 + m * 16) * 2048 + col0;
#pragma unroll
                for (int bj = 0; bj < 2; ++bj) { f32x4 g0, g1; unpack8(*(const GAS u32x4*)(ga + off + bj * 128), g0, g1);
                    *(GAS u32x4*)(t1 + off + bj * 128) = pack8(acc[ai][bj][m][0] * g0, acc[ai][bj][m][1] * g1); } }
    }
};
struct EpiP5b {
    static constexpr bool PERM = true, HAS_PRE = false;
    const bf16_t* gb; const bf16_t* t1; unsigned char* merged;
    __device__ __forceinline__ void operator()(const f32x4 (&acc)[2][2][4][2], const Unit& u, int wr, int wc, int fr, int fq, const LAS float* rowsc) const {
        const int row0 = u.pm * 256 + wr * 64 + fr, col0 = u.pn * 256 + wc * 32 + 8 * fq;
#pragma unroll
        for (int ai = 0; ai < 2; ++ai)
#pragma unroll
            for (int m = 0; m < 4; ++m) { const size_t off = (size_t)(row0 + ai * 128 + m * 16) * 2048 + col0;
#pragma unroll
                for (int bj = 0; bj < 2; ++bj) { f32x4 g0, g1; unpack8(*(const GAS u32x4*)(gb + off + bj * 128), g0, g1);
                    f32x4 a, b; unpack8(*(const GAS u32x4*)(t1 + off + bj * 128), a, b);
                    *(GAS u32x2*)(merged + off + bj * 128) = pack8_fp8((a + acc[ai][bj][m][0] * g0) * 32.f, (b + acc[ai][bj][m][1] * g1) * 32.f); } }
    }
};
struct EpiP6 {
    static constexpr bool PERM = true, HAS_PRE = false;
    const float* x; bf16_t* h2b; float* ssq2;
    __device__ __forceinline__ void operator()(const f32x4 (&acc)[2][2][4][2], const Unit& u, int wr, int wc, int fr, int fq, const LAS float* rowsc) const {
        const int row0 = u.pm * 256 + wr * 64 + fr, col0 = u.pn * 256 + wc * 32 + 8 * fq;
#pragma unroll
        for (int ai = 0; ai < 2; ++ai)
#pragma unroll
            for (int m = 0; m < 4; ++m) { const int row = row0 + ai * 128 + m * 16; const size_t off = (size_t)row * 2048 + col0; float s = 0.f;
#pragma unroll
                for (int bj = 0; bj < 2; ++bj) { const f32x4 a = *(const GAS f32x4*)(x + off + bj * 128) + acc[ai][bj][m][0], b = *(const GAS f32x4*)(x + off + bj * 128 + 4) + acc[ai][bj][m][1];
                    s += (a[0] * a[0] + a[1] * a[1]) + (a[2] * a[2] + a[3] * a[3]) + (b[0] * b[0] + b[1] * b[1]) + (b[2] * b[2] + b[3] * b[3]);
                    *(GAS u32x4*)(h2b + off + bj * 128) = pack8(a, b); }
                s += __shfl_xor(s, 16); s += __shfl_xor(s, 32);
                if (fq == 0) ssq2[(size_t)(u.pn * 4 + wc) * MREAL + row] = s; }
    }
};
struct EpiP7 {
    static constexpr bool PERM = false, HAS_PRE = true;
    const float* ssq2; float* sc;
    __device__ __forceinline__ void pre(const Unit& u, LAS float* sc, int tid) const { if (tid < 256) sc[tid] = rstd_slabs<32, MREAL>(ssq2, u.pm * 256 + tid, 1.f / 2048.f); }
    __device__ __forceinline__ void operator()(const f32x4 (&acc)[2][2][4][2], const Unit& u, int wr, int wc, int fr, int fq, const LAS float* rowsc) const {
        const int row0 = u.pm * 256 + wr * 64 + fr, col0 = u.pn * 256 + wc * 32 + 4 * fq;
#pragma unroll
        for (int ai = 0; ai < 2; ++ai)
#pragma unroll
            for (int m = 0; m < 4; ++m) { const int row = row0 + ai * 128 + m * 16; const float rs = rowsc[ai * 128 + wr * 64 + m * 16 + fr]; const size_t off = (size_t)row * 2048 + col0;
#pragma unroll
                for (int bj = 0; bj < 2; ++bj)
#pragma unroll
                    for (int n = 0; n < 2; ++n) *(GAS f32x4*)(sc + off + bj * 128 + n * 16) = acc[ai][bj][m][n] * rs; }
    }
};
namespace att {
#define KSWZ(row, colB) ((row) * 256 + ((colB) ^ (((row) & 7) << 4)))
#define KRSWZ(row, colB) ((row) * 128 + ((colB) ^ ((((row) >> 1) & 7) << 4)))
constexpr float L2E = 1.4426950408889634f;
template <int DUMMY = 0>
__device__ __forceinline__ void partialSM(f32x16& p0, f32x16& p1, float& m_reg, float& mn, float& alpha, const float C, const float THRS) {
  float pmax = p0[0];
#pragma unroll
  for (int r = 1; r < 16; ++r) pmax = fmaxf(pmax, p0[r]);
#pragma unroll
  for (int r = 0; r < 16; ++r) pmax = fmaxf(pmax, p1[r]);
  { auto rr = __builtin_amdgcn_permlane32_swap(__float_as_uint(pmax), __float_as_uint(pmax), false, false);
    pmax = fmaxf(__uint_as_float(rr[0]), __uint_as_float(rr[1])); }
  if (__builtin_expect(__all(pmax - m_reg <= THRS), 1)) { mn = m_reg; alpha = 1.f; }
  else { mn = fmaxf(m_reg, pmax); alpha = __builtin_amdgcn_exp2f((m_reg - mn) * C); m_reg = mn; }
  const float mnC = -mn * C;
#pragma unroll
  for (int r = 0; r < 16; ++r) p0[r] = fmaf(p0[r], C, mnC);
#pragma unroll
  for (int r = 0; r < 16; ++r) p1[r] = fmaf(p1[r], C, mnC);
#pragma unroll
  for (int r = 0; r < 16; ++r) p0[r] = __builtin_amdgcn_exp2f(p0[r]);
}
__device__ __forceinline__ void finishSM(f32x16& p0, f32x16& p1, float alpha, float& l_reg, bf16x8& pa0, bf16x8& pa1, bf16x8& pa2, bf16x8& pa3) {
#pragma unroll
  for (int r = 0; r < 16; ++r) p1[r] = __builtin_amdgcn_exp2f(p1[r]);
  float ps = 0;
#pragma unroll
  for (int r = 0; r < 16; ++r) ps += p0[r];
#pragma unroll
  for (int r = 0; r < 16; ++r) ps += p1[r];
  { auto rr = __builtin_amdgcn_permlane32_swap(__float_as_uint(ps), __float_as_uint(ps), false, false);
    ps = __uint_as_float(rr[0]) + __uint_as_float(rr[1]); }
  l_reg = l_reg * alpha + ps;
#define PK4(P, BASE, OUT) do { unsigned a0 = cvt_pk_bf16(P[BASE + 0], P[BASE + 1]), a1 = cvt_pk_bf16(P[BASE + 2], P[BASE + 3]);   \
    unsigned b0 = cvt_pk_bf16(P[BASE + 4], P[BASE + 5]), b1 = cvt_pk_bf16(P[BASE + 6], P[BASE + 7]);                              \
    auto r0 = __builtin_amdgcn_permlane32_swap(a0, b0, false, false); auto r1 = __builtin_amdgcn_permlane32_swap(a1, b1, false, false); \
    u32x4 w = {r0[0], r1[0], r0[1], r1[1]}; OUT = __builtin_bit_cast(bf16x8, w); } while (0)
  PK4(p0, 0, pa0); PK4(p0, 8, pa1); PK4(p1, 0, pa2); PK4(p1, 8, pa3);
#undef PK4
}
constexpr int NW = 8, QBLK = 32, KVBLK = 64;
constexpr float MLA_SCALE = 0.07216878364870322f;
constexpr float MLA_THR = 8.f;
constexpr int SHM_V = KVBLK * 128 * 2, SHM_KN = KVBLK * 128 * 2, SHM_KR = KVBLK * 64 * 2;
constexpr int OFF_V = 0, OFF_KN = 2 * SHM_V, OFF_KR = OFF_KN + 2 * SHM_KN, OFF_WS = OFF_KR + 2 * SHM_KR, OFF_QR = OFF_WS + NW * 64 * 4, MLA_LDS = OFF_QR + NW * 4096;
__device__ __forceinline__ void qkt(f32x16& p0, f32x16& p1, const LAS char* Kn, const LAS char* Kr, const bf16x8* qr, const LAS char* qrp, const int* kb, const int* krb) {
  p0 = f32x16{}; p1 = f32x16{};
#pragma unroll
  for (int d0 = 0; d0 < 8; ++d0) {
    const bf16x8 b0 = *(const LAS bf16x8*)(Kn + kb[d0 & 3] + (d0 >> 2) * 128);
    const bf16x8 b1 = *(const LAS bf16x8*)(Kn + kb[d0 & 3] + (d0 >> 2) * 128 + 8192);
    p0 = __builtin_amdgcn_mfma_f32_32x32x16_bf16(b0, qr[d0], p0, 0, 0, 0);
    p1 = __builtin_amdgcn_mfma_f32_32x32x16_bf16(b1, qr[d0], p1, 0, 0, 0); }
#pragma unroll
  for (int d0 = 0; d0 < 4; ++d0) {
    const bf16x8 b0 = *(const LAS bf16x8*)(Kr + krb[d0]);
    const bf16x8 b1 = *(const LAS bf16x8*)(Kr + krb[d0] + 4096);
    const bf16x8 qf = *(const LAS bf16x8*)(qrp + d0 * 1024);
    p0 = __builtin_amdgcn_mfma_f32_32x32x16_bf16(b0, qf, p0, 0, 0, 0);
    p1 = __builtin_amdgcn_mfma_f32_32x32x16_bf16(b1, qf, p1, 0, 0, 0); }
}
__device__ __forceinline__ int v_st(int k, int c) { const int kk = (k & ~0xC) | ((k & 4) << 1) | ((k & 8) >> 1); return ((kk >> 3) * 4 + (c >> 5)) * 512 + ((kk & 7) * 32 + (c & 31)) * 2; }
__device__ __forceinline__ int v_rd_base(int lane) { return ((lane & 3) << 3) | (((lane >> 2) & 3) << 6) | (((lane >> 4) & 1) << 5) | (((lane >> 5) & 1) << 8); }
constexpr int v_rd_off(int d0, int ks, int half) { return d0 * 512 + ks * 4096 + half * 2048; }
template <int OFF> __device__ __forceinline__ s16x4 tr_read(int vb) {
  s16x4 r; asm volatile("ds_read_b64_tr_b16 %0, %1 offset:%2" : "=&v"(r) : "v"(vb), "i"(OFF) : "memory"); return r;
}
template <int D0> __device__ __forceinline__ void pv_one(f32x16& od, int vb, bf16x8 pa0, bf16x8 pa1, bf16x8 pa2, bf16x8 pa3) {
  const s16x4 l0 = tr_read<v_rd_off(D0, 0, 0)>(vb), h0 = tr_read<v_rd_off(D0, 0, 1)>(vb), l1 = tr_read<v_rd_off(D0, 1, 0)>(vb), h1 = tr_read<v_rd_off(D0, 1, 1)>(vb);
  const s16x4 l2 = tr_read<v_rd_off(D0, 2, 0)>(vb), h2 = tr_read<v_rd_off(D0, 2, 1)>(vb), l3 = tr_read<v_rd_off(D0, 3, 0)>(vb), h3 = tr_read<v_rd_off(D0, 3, 1)>(vb);
  asm volatile("s_waitcnt lgkmcnt(0)" ::: "memory"); SBAR();
#define PK(L, H) (bf16x8){L[0], L[1], L[2], L[3], H[0], H[1], H[2], H[3]}
  od = __builtin_amdgcn_mfma_f32_32x32x16_bf16(pa0, PK(l0, h0), od, 0, 0, 0);
  od = __builtin_amdgcn_mfma_f32_32x32x16_bf16(pa1, PK(l1, h1), od, 0, 0, 0);
  od = __builtin_amdgcn_mfma_f32_32x32x16_bf16(pa2, PK(l2, h2), od, 0, 0, 0);
  od = __builtin_amdgcn_mfma_f32_32x32x16_bf16(pa3, PK(l3, h3), od, 0, 0, 0);
#undef PK
}
__device__ __forceinline__ void pv_d0(f32x16* o, int vb, bf16x8 pa0, bf16x8 pa1, bf16x8 pa2, bf16x8 pa3) {
  pv_one<0>(o[0], vb, pa0, pa1, pa2, pa3); pv_one<1>(o[1], vb, pa0, pa1, pa2, pa3); pv_one<2>(o[2], vb, pa0, pa1, pa2, pa3); pv_one<3>(o[3], vb, pa0, pa1, pa2, pa3);
}
__device__ __forceinline__ void mla_unit(int b, int h, int qb, const bf16_t* __restrict__ QM, const bf16_t* __restrict__ KN, const bf16_t* __restrict__ KR, const bf16_t* __restrict__ VV, unsigned char* __restrict__ OM, LAS char* lds) {
  const int tid = threadIdx.x, wid = tid >> 6, lane = tid & 63, r32 = lane & 31, hi = lane >> 5;
  constexpr float C = MLA_SCALE * L2E, THRS = MLA_THR / MLA_SCALE;
  constexpr int NT = 33;
  LAS char* V_lds = lds + OFF_V; LAS char* Kn_lds = lds + OFF_KN; LAS char* Kr_lds = lds + OFF_KR;
  LAS float* ws = (LAS float*)(lds + OFF_WS) + wid * 64; LAS float* li_l = ws; LAS float* al_l = ws + 32;
  float m_reg = -1e30f, l_reg = 0; f32x16 o[4] = {}; bf16x8 qr[8];
  LAS char* qrp = lds + OFF_QR + wid * 4096 + lane * 16;
  const int qrow = b * SEQ + qb * 256 + wid * QBLK + r32;
  const bf16_t* Qw = QM + (size_t)qrow * 3072 + h * 192 + hi * 8;
#pragma unroll
  for (int d0 = 0; d0 < 8; ++d0) qr[d0] = *(const GAS bf16x8*)(Qw + d0 * 16);
  __syncthreads();
#pragma unroll
  for (int d0 = 0; d0 < 4; ++d0) *(LAS bf16x8*)(qrp + d0 * 1024) = *(const GAS bf16x8*)(Qw + (8 + d0) * 16);
  const int sr = tid >> 4, sc = (tid & 15) * 8, vst0 = v_st(sr, sc), vst1 = v_st(32 + sr, sc);
  const int krr = tid >> 3, krc = (tid & 7) * 8;
  const int vb0 = (int)(uintptr_t)V_lds + v_rd_base(lane);
  bf16x8 s_v0, s_v1, s_k0, s_k1, s_kr;
  const int realbase = b * SEQ - KVBLK;
  const unsigned voff = (unsigned)(sr * 2048 + sc) * 2u, kroff = (unsigned)(krr * 64 + krc) * 2u;
  int kb[4], krb[4];
#pragma unroll
  for (int bq = 0; bq < 4; ++bq) { kb[bq] = KSWZ(r32, bq * 32 + hi * 16); krb[bq] = KRSWZ(r32, bq * 32 + hi * 16); }
#define TROW(t) ((t) == 0 ? MREAL : realbase + (t) * KVBLK)
#define SLOAD(t) do { const int k0_ = TROW(t); const size_t ro_ = ((size_t)k0_ * 2048 + h * 128) * 2; \
    const GAS char* vb_ = (const GAS char*)VV + ro_; const GAS char* nb_ = (const GAS char*)KN + ro_; const GAS char* rb_ = (const GAS char*)KR + (size_t)k0_ * 128; \
    s_v0 = *(const GAS bf16x8*)(vb_ + voff); s_v1 = *(const GAS bf16x8*)(vb_ + 32 * 4096 + voff); \
    s_k0 = *(const GAS bf16x8*)(nb_ + voff); s_k1 = *(const GAS bf16x8*)(nb_ + 32 * 4096 + voff); \
    s_kr = *(const GAS bf16x8*)(rb_ + kroff); } while (0)
#define SWRITE(bf) do { *(LAS bf16x8*)(V_lds + (bf) * SHM_V + vst0) = s_v0; *(LAS bf16x8*)(V_lds + (bf) * SHM_V + vst1) = s_v1; const int kc_ = sc * 2; \
    *(LAS bf16x8*)(Kn_lds + (bf) * SHM_KN + KSWZ(sr, kc_)) = s_k0; *(LAS bf16x8*)(Kn_lds + (bf) * SHM_KN + KSWZ(32 + sr, kc_)) = s_k1; \
    *(LAS bf16x8*)(Kr_lds + (bf) * SHM_KR + KRSWZ(krr, krc * 2)) = s_kr; } while (0)
#define SWAIT() asm volatile("s_waitcnt vmcnt(0)" ::: "memory")
#define RESC(a) do { if (__any((a) < 1.f)) { if (hi == 0) al_l[r32] = (a); asm volatile("s_waitcnt lgkmcnt(0)" ::: "memory"); \
    _Pragma("unroll") for (int d = 0; d < 4; ++d) _Pragma("unroll") for (int r = 0; r < 16; ++r) o[d][r] *= al_l[crow(r, hi)]; } } while (0)
  f32x16 pA0, pA1, pB0, pB1; float mnA, mnB, alA, alB; bf16x8 pa0, pa1, pa2, pa3;
  SLOAD(0); SWAIT(); SWRITE(0); __syncthreads();
  qkt(pA0, pA1, Kn_lds, Kr_lds, qr, qrp, kb, krb);
  { const float NEG = -INFINITY;
#pragma unroll
    for (int r = 8; r < 16; ++r) pA0[r] = NEG;
#pragma unroll
    for (int r = 0; r < 16; ++r) pA1[r] = NEG; }
  partialSM(pA0, pA1, m_reg, mnA, alA, C, THRS);
  SLOAD(1); SWAIT(); SWRITE(1); __syncthreads();
  for (int j = 1; j + 1 < NT; j += 2) {
    SBAR(); qkt(pB0, pB1, Kn_lds + SHM_KN, Kr_lds + SHM_KR, qr, qrp, kb, krb);
    finishSM(pA0, pA1, alA, l_reg, pa0, pa1, pa2, pa3); SBAR();
    SLOAD(j + 1); SBAR();
    pv_d0(o, vb0, pa0, pa1, pa2, pa3); partialSM(pB0, pB1, m_reg, mnB, alB, C, THRS);
    __syncthreads(); SWAIT(); SWRITE(0);
    RESC(alB); __syncthreads();
    SBAR(); qkt(pA0, pA1, Kn_lds, Kr_lds, qr, qrp, kb, krb);
    finishSM(pB0, pB1, alB, l_reg, pa0, pa1, pa2, pa3); SBAR();
    if (j + 2 < NT) SLOAD(j + 2); SBAR();
    pv_d0(o, vb0 + SHM_V, pa0, pa1, pa2, pa3); partialSM(pA0, pA1, m_reg, mnA, alA, C, THRS);
    __syncthreads(); if (j + 2 < NT) { SWAIT(); SWRITE(1); }
    RESC(alA); __syncthreads();
  }
  finishSM(pA0, pA1, alA, l_reg, pa0, pa1, pa2, pa3); SBAR();
  pv_d0(o, vb0, pa0, pa1, pa2, pa3);
  if (hi == 0) li_l[r32] = l_reg; asm volatile("s_waitcnt lgkmcnt(0)" ::: "memory");
  float rli[16];
#pragma unroll
  for (int r = 0; r < 16; ++r) rli[r] = __builtin_amdgcn_rcpf(li_l[crow(r, hi)]);
  unsigned char* Ow = OM + (size_t)(b * SEQ + qb * 256 + wid * QBLK) * 2048 + h * 128;
#pragma unroll
  for (int r = 0; r < 16; ++r) { const int orow = crow(r, hi);
#pragma unroll
    for (int d0 = 0; d0 < 4; ++d0) Ow[(size_t)orow * 2048 + d0 * 32 + r32] = f32_to_fp8(o[d0][r] * rli[r] * 32.f); }
#undef TROW
#undef SLOAD
#undef SWRITE
#undef SWAIT
#undef RESC
}
__device__ __forceinline__ void na_task(int task, const bf16_t* __restrict__ NAQ, const bf16_t* __restrict__ NAK, const bf16_t* __restrict__ VT, unsigned char* __restrict__ ONA,
                                        const LAS float* relb, const LAS float* metab, LAS float* wsf, int lane) {
  const int r32 = lane & 31, hi = lane >> 5;
  const int half = task & 1, r = (task >> 1) & 31, h = (task >> 6) & 15, b = task >> 10;
  const int qc = half * 32 + r32;
  const int cs = min(max(qc - 8, 0), 48), rs = min(max(r - 4, 0), 24);
  const int qtok = b * SEQ + r * 64 + qc;
  constexpr float C = L2E, THRS = 8.f, SCALE = 0.125f;
  bf16x8 qr[4];
#pragma unroll
  for (int d0 = 0; d0 < 4; ++d0) qr[d0] = *(const GAS bf16x8*)(NAQ + (size_t)qtok * 1024 + h * 64 + d0 * 16 + hi * 8);
  float m_reg = -1e30f, l_reg = 0.f; f32x16 o[2] = {};
  LAS float* al_l = wsf; LAS float* li_l = wsf + 32;
  const float NEG = -INFINITY;
  const int kb0 = half * 16;
  const unsigned long long wm = 0xFFFFull << (cs - kb0);
  const unsigned mh0 = (unsigned)wm >> (4 * hi), mh1 = (unsigned)(wm >> 32) >> (4 * hi);
  const bf16_t* kq = NAK + (size_t)r32 * 1024 + h * 64 + hi * 8;
  const bf16_t* kq2 = NAK + (size_t)(32 + (r32 & 15)) * 1024 + h * 64 + hi * 8;
  const bf16_t* vq = VT + (size_t)(h * 64 + r32) * VT_PITCH + 8 * hi;
#define NA_KTOK(w) ((w) == 8 ? MREAL : b * SEQ + (rs + (w)) * 64 + kb0)
#define NA_LOADK(KF, w) do { const size_t ko_ = (size_t)NA_KTOK(w) * 1024; _Pragma("unroll") for (int d0 = 0; d0 < 4; ++d0) { KF[d0] = *(const GAS bf16x8*)(kq + ko_ + d0 * 16); KF[4 + d0] = *(const GAS bf16x8*)(kq2 + ko_ + d0 * 16); } } while (0)
#define NA_TILE(KF, w) do { \
    bf16x8 vf[6]; { const bf16_t* vp_ = vq + NA_KTOK(w); _Pragma("unroll") for (int ks = 0; ks < 3; ++ks) { vf[ks] = *(const GAS bf16x8*)(vp_ + 16 * ks); vf[3 + ks] = *(const GAS bf16x8*)(vp_ + (size_t)32 * VT_PITCH + 16 * ks); } } \
    f32x16 p0 = {}, p1 = {}; \
    _Pragma("unroll") for (int d0 = 0; d0 < 4; ++d0) { p0 = __builtin_amdgcn_mfma_f32_32x32x16_bf16(KF[d0], qr[d0], p0, 0, 0, 0); p1 = __builtin_amdgcn_mfma_f32_32x32x16_bf16(KF[4 + d0], qr[d0], p1, 0, 0, 0); } \
    if ((w) + 1 < 9) NA_LOADK(KF, (w) + 1);            \
    if ((w) < 8) { const LAS float* bp_ = relb + ((h * 15 + (rs + (w) - r + 7)) * 31 + 15 - qc + 4 * hi + kb0);     \
      _Pragma("unroll") for (int rg = 0; rg < 16; ++rg) { const int c_ = (rg & 3) + 8 * (rg >> 2); \
        { const bool ok = (mh0 >> c_) & 1u; const float bv = bp_[c_]; p0[rg] = ok ? fmaf(p0[rg], SCALE, bv) : NEG; } \
        if (rg < 8) { const bool ok = (mh1 >> c_) & 1u; const float bv = bp_[c_ + 32]; p1[rg] = ok ? fmaf(p1[rg], SCALE, bv) : NEG; } } \
    } else { const LAS float* bp = metab + h * 16; \
      _Pragma("unroll") for (int rg = 0; rg < 16; ++rg) { const int kc = crow(rg, hi); p0[rg] = (rg < 8) ? fmaf(p0[rg], SCALE, bp[kc & 15]) : NEG; if (rg < 8) p1[rg] = NEG; } } \
      \
    float pmax = p0[0]; \
    _Pragma("unroll") for (int rg = 1; rg < 16; ++rg) pmax = fmaxf(pmax, p0[rg]); \
    _Pragma("unroll") for (int rg = 0; rg < 8; ++rg) pmax = fmaxf(pmax, p1[rg]); \
    { auto rr = __builtin_amdgcn_permlane32_swap(__float_as_uint(pmax), __float_as_uint(pmax), false, false); pmax = fmaxf(__uint_as_float(rr[0]), __uint_as_float(rr[1])); } \
    float mn, alpha; \
    if (__builtin_expect(__all(pmax - m_reg <= THRS), 1)) { mn = m_reg; alpha = 1.f; } \
    else { mn = fmaxf(m_reg, pmax); alpha = __builtin_amdgcn_exp2f((m_reg - mn) * C); m_reg = mn; } \
    const float mnC = -mn * C; float ps = 0.f; \
    _Pragma("unroll") for (int rg = 0; rg < 16; ++rg) { p0[rg] = __builtin_amdgcn_exp2f(fmaf(p0[rg], C, mnC)); ps += p0[rg]; } \
    _Pragma("unroll") for (int rg = 0; rg < 8; ++rg) { p1[rg] = __builtin_amdgcn_exp2f(fmaf(p1[rg], C, mnC)); ps += p1[rg]; } \
    { auto rr = __builtin_amdgcn_permlane32_swap(__float_as_uint(ps), __float_as_uint(ps), false, false); ps = __uint_as_float(rr[0]) + __uint_as_float(rr[1]); } \
    l_reg = l_reg * alpha + ps; \
    bf16x8 pa0, pa1, pa2; NA_PK4(p0, 0, pa0); NA_PK4(p0, 8, pa1); NA_PK4(p1, 0, pa2); \
    if (__any(alpha < 1.f)) { if (hi == 0) al_l[r32] = alpha; asm volatile("s_waitcnt lgkmcnt(0)" ::: "memory"); \
      _Pragma("unroll") for (int d = 0; d < 2; ++d) _Pragma("unroll") for (int rg = 0; rg < 16; ++rg) o[d][rg] *= al_l[crow(rg, hi)]; } \
    _Pragma("unroll") for (int d0 = 0; d0 < 2; ++d0) { \
      o[d0] = __builtin_amdgcn_mfma_f32_32x32x16_bf16(pa0, vf[3 * d0 + 0], o[d0], 0, 0, 0); o[d0] = __builtin_amdgcn_mfma_f32_32x32x16_bf16(pa1, vf[3 * d0 + 1], o[d0], 0, 0, 0); \
      o[d0] = __builtin_amdgcn_mfma_f32_32x32x16_bf16(pa2, vf[3 * d0 + 2], o[d0], 0, 0, 0); } } while (0)
#define NA_PK4(P, BASE, OUT) do { unsigned a0 = cvt_pk_bf16(P[BASE + 0], P[BASE + 1]), a1 = cvt_pk_bf16(P[BASE + 2], P[BASE + 3]);   \
    unsigned b0 = cvt_pk_bf16(P[BASE + 4], P[BASE + 5]), b1 = cvt_pk_bf16(P[BASE + 6], P[BASE + 7]);                              \
    auto r0 = __builtin_amdgcn_permlane32_swap(a0, b0, false, false); auto r1 = __builtin_amdgcn_permlane32_swap(a1, b1, false, false); \
    u32x4 w_ = {r0[0], r1[0], r0[1], r1[1]}; OUT = __builtin_bit_cast(bf16x8, w_); } while (0)
  { bf16x8 kA[8];
    NA_LOADK(kA, 0);
#pragma unroll 1
    for (int w = 0; w < 8; ++w) { NA_TILE(kA, w); }
    NA_TILE(kA, 8); }
#undef NA_PK4
#undef NA_KTOK
#undef NA_LOADK
#undef NA_TILE
  if (hi == 0) li_l[r32] = l_reg; asm volatile("s_waitcnt lgkmcnt(0)" ::: "memory");
  unsigned char* Ow = ONA + (size_t)(b * SEQ + r * 64 + half * 32) * 1024 + h * 64;
#pragma unroll
  for (int rg = 0; rg < 16; ++rg) { const int orow = crow(rg, hi); const float rl = __builtin_amdgcn_rcpf(li_l[orow]);
#pragma unroll
    for (int d0 = 0; d0 < 2; ++d0) Ow[(size_t)orow * 1024 + d0 * 32 + r32] = f32_to_fp8(o[d0][rg] * rl * 16.f); }
  asm volatile("s_waitcnt lgkmcnt(0)" ::: "memory");
}
}
namespace peer {
constexpr int CH = 32;
constexpr int OFF_TV = 0, OFF_TI = OFF_TV + CH * 16 * 16 * 4, OFF_SE = OFF_TI + CH * 16 * 16 * 4, OFF_SG = OFF_SE + CH * 128 * 4, OFF_SE2 = OFF_SG + CH * 128 * 4, OFF_SG2 = OFF_SE2 + CH * 128 * 4, PEER_LDS = OFF_SG2 + CH * 128 * 4;
static_assert(PEER_LDS <= RING_BYTES, "PEER LDS");
__device__ __forceinline__ float gelu_tanh(float x) {
    const float u = 0.7978845608028654f * (x + 0.044715f * x * x * x);
    const float e = __builtin_amdgcn_exp2f(-2.f * 1.4426950408889634f * fabsf(u));
    const float t = (1.f - e) * __builtin_amdgcn_rcpf(1.f + e);
    return 0.5f * x * (1.f + (u < 0.f ? -t : t));
}
__device__ __forceinline__ void fmac1(float& acc, float a, float b) { asm("v_fmac_f32_e32 %0, %1, %2" : "+v"(acc) : "v"(a), "v"(b)); }
#define PEER_INSERT(x_, xi_) do { float x__ = (x_); int xi__ = (xi_); \
    _Pragma("unroll") for (int j_ = 0; j_ < 16; ++j_) { const bool gt_ = x__ > tv[j_]; const float tvo_ = tv[j_]; const int tio_ = ti[j_]; \
        tv[j_] = gt_ ? x__ : tvo_; ti[j_] = gt_ ? xi__ : tio_; x__ = gt_ ? tvo_ : x__; xi__ = gt_ ? tio_ : xi__; } } while (0)

#define PEER_AUX 0
typedef __amdgpu_buffer_rsrc_t rsrc_t;
__device__ __forceinline__ rsrc_t mk_rsrc(const void* p, unsigned bytes) { return __builtin_amdgcn_make_buffer_rsrc((void*)p, 0, bytes, 0x00020000); }
__device__ __forceinline__ u32x4 ldb128(rsrc_t r, unsigned off) { return __builtin_amdgcn_raw_buffer_load_b128(r, off, 0, PEER_AUX); }
typedef unsigned v6u_t __attribute__((ext_vector_type(6)));
typedef float v32f_t __attribute__((ext_vector_type(32)));
typedef float v16f_t __attribute__((ext_vector_type(16)));
__device__ __forceinline__ u32x2 ldb64(rsrc_t r, unsigned off) { return __builtin_amdgcn_raw_buffer_load_b64(r, off, 0, PEER_AUX); }
__device__ __forceinline__ f32x4 ldf128(rsrc_t r, unsigned off) { return __builtin_bit_cast(f32x4, __builtin_amdgcn_raw_buffer_load_b128(r, off, 0, PEER_AUX)); }
__device__ __forceinline__ f32x4 ldf128_nt(rsrc_t r, unsigned off) { return __builtin_bit_cast(f32x4, __builtin_amdgcn_raw_buffer_load_b128(r, off, 0, 2)); }
__device__ __forceinline__ void peer_select(int chunk, const float* __restrict__ SC, LAS char* lds, int tid, LAS int* SE, LAS float* SG) {
    LAS float* TV = (LAS float*)(lds + OFF_TV); LAS int* TI = (LAS int*)(lds + OFF_TI);
    asm volatile("" : "+v"(tid));
    const int tok0 = chunk * CH;
    const rsrc_t rSC = mk_rsrc(SC, 0x8000000u);
    __syncthreads();
    { const int tl = tid >> 4, g = tid & 15; const unsigned spo = ((unsigned)(tok0 + tl) * 2048u + (unsigned)g * 128u) * 4u;
      int tk[16];
#pragma unroll
      for (int j = 0; j < 16; ++j) tk[j] = (int)0x80000000;
#define PEER_KEY(x_, lowbits_, mask_) ({ const int f_ = __float_as_int(x_); ((f_ ^ ((f_ >> 31) & 0x7fffffff)) & ~(mask_)) | (lowbits_); })
#define PEER_INS(key_) do { int x__ = (key_); _Pragma("unroll") for (int j_ = 0; j_ < 16; ++j_) { const int hi_ = max(x__, tk[j_]); x__ = min(x__, tk[j_]); tk[j_] = hi_; } } while (0)
#pragma unroll 1
      for (int i = 0; i < 32; i += 2) { const f32x4 a = ldf128_nt(rSC, spo + i * 16), b = ldf128_nt(rSC, spo + i * 16 + 16);
#pragma unroll
          for (int e = 0; e < 4; ++e) { PEER_INS(PEER_KEY(a[e], 127 - (4 * i + e), 127)); }
#pragma unroll
          for (int e = 0; e < 4; ++e) { PEER_INS(PEER_KEY(b[e], 127 - (4 * i + 4 + e), 127)); } }
      LAS float* tvp = TV + (tl * 16 + g) * 16; LAS int* tip = TI + (tl * 16 + g) * 16;
#pragma unroll
      for (int j = 0; j < 16; ++j) { const int k_ = tk[j] & ~127; tvp[j] = __int_as_float(k_ ^ ((k_ >> 31) & 0x7fffffff)); tip[j] = 127 - (tk[j] & 127); } }
    __syncthreads();
    asm volatile("" : "+v"(tid));
    { const int tl = tid >> 4, hh = (tid >> 1) & 7, half = tid & 1;
      const LAS float* s1 = TV + (tl * 16 + 2 * hh) * 16; const LAS float* s2 = s1 + 16; const LAS int* i1 = TI + (tl * 16 + 2 * hh) * 16; const LAS int* i2 = i1 + 16;
      float b2[16];
#pragma unroll
      for (int j = 0; j < 16; ++j) b2[j] = s2[j];
      int tk[16];
#pragma unroll
      for (int j = 0; j < 16; ++j) tk[j] = (int)0x80000000;
#pragma unroll
      for (int ii = 0; ii < 8; ++ii) { const int i = 2 * ii + half; const float a = s1[i];
#pragma unroll
          for (int j = 0; j < 16; ++j) if ((2 * ii + 1) * (j + 1) <= 16) { if (half == 0 || (2 * ii + 2) * (j + 1) <= 16) PEER_INS(PEER_KEY(a + b2[j], 255 - (i * 16 + j), 255)); } }
      { int pk[16];
#pragma unroll
        for (int j = 0; j < 16; ++j) pk[j] = __shfl_xor(tk[j], 1);
#pragma unroll
        for (int j = 0; j < 16; ++j) PEER_INS(pk[j]); }
      if (half == 0) { float e[16], sum = 0.f; const int k0_ = tk[0] & ~255; const float v0 = __int_as_float(k0_ ^ ((k0_ >> 31) & 0x7fffffff));
#pragma unroll
        for (int j = 0; j < 16; ++j) { const int k_ = tk[j] & ~255; const float vj = __int_as_float(k_ ^ ((k_ >> 31) & 0x7fffffff)); e[j] = __builtin_amdgcn_exp2f((vj - v0) * 1.4426950408889634f); sum += e[j]; }
        const float inv = 1.0f / sum;
#pragma unroll
        for (int j = 0; j < 16; ++j) { const int ci = 255 - (tk[j] & 255); SE[tl * 128 + hh * 16 + j] = i1[ci >> 4] * 128 + i2[ci & 15]; SG[tl * 128 + hh * 16 + j] = e[j] * inv; } } }
#undef PEER_KEY
#undef PEER_INS
    __syncthreads();
}
__device__ __forceinline__ void peer_gather(int chunk, const bf16_t* __restrict__ H2, const unsigned char* __restrict__ U,
                                            const float* __restrict__ g2, const float* __restrict__ gf, float* OUT, int tid, const LAS int* SE, const LAS float* SG) {
    asm volatile("" : "+v"(tid));
    const int tok0 = chunk * CH, lane = tid & 63, wave = tid >> 6;
    const rsrc_t rH2 = mk_rsrc(H2, 0x4000000u), rU = mk_rsrc(U, 0x3000000u), rG2 = mk_rsrc(g2, 8192u), rGF = mk_rsrc(gf, 8192u);
#pragma unroll 1
    for (int tt = 0; tt < CH / NWAVES; ++tt) { const int tl = wave * (CH / NWAVES) + tt, tok = tok0 + tl;
      asm volatile("" ::: "memory");
      float hn[32], acc[32]; float ss = 0.f;
#pragma unroll
      for (int j = 0; j < 2; ++j)
#pragma unroll
          for (int q = 0; q < 4; ++q) { const u32x2 w = ldb64(rH2, ((unsigned)tok * 2048u + 256u * (4 * j + q) + 4u * lane) * 2u);
              const f32x4 a = (f32x4){__uint_as_float(w.x << 16), __uint_as_float(w.x & 0xffff0000u), __uint_as_float(w.y << 16), __uint_as_float(w.y & 0xffff0000u)};
#pragma unroll
              for (int i = 0; i < 4; ++i) { hn[16 * j + 4 * q + i] = a[i]; ss += a[i] * a[i]; } }
      const float rstd = 1.0f / sqrtf(wave_sum(ss) * (1.f / 2048.f) + NORM_EPS);
#pragma unroll
      for (int j = 0; j < 2; ++j)
#pragma unroll
          for (int q = 0; q < 4; ++q) { const f32x4 a = ldf128(rG2, (256u * (4 * j + q) + 4u * lane) * 4u);
#pragma unroll
              for (int i = 0; i < 4; ++i) hn[16 * j + 4 * q + i] *= rstd * a[i]; }
#pragma unroll
      for (int i = 0; i < 32; ++i) acc[i] = 0.f;
#define NX 4
#define PEER_LOAD(S, kb) do { _Pragma("unroll") for (int x = 0; x < NX; ++x) { const unsigned o = (unsigned)SE[tl * 128 + (kb) + x] * 3072u; \
          S##ua[x] = ldb128(rU, o + (unsigned)lane * 16u); S##ub[x] = ldb64(rU, o + 1024u + (unsigned)lane * 8u); S##va[x] = ldb128(rU, o + 1536u + (unsigned)lane * 16u); S##vb[x] = ldb64(rU, o + 2560u + (unsigned)lane * 8u); } } while (0)
#define PEER_DEC(A, B) ({ v32f_t r_ = __builtin_amdgcn_cvt_scalef32_pk32_f32_fp6((v6u_t){A.x, A.y, A.z, A.w, B.x, B.y}, 1.0f); asm volatile("s_nop 1" : "+v"(r_)); r_; })
#define PEER_COMPUTE(S, kb) do { float d[NX]; \
          _Pragma("unroll") for (int x = 0; x < NX; ++x) { const v32f_t r = PEER_DEC(S##ua[x], S##ub[x]); float dd = 0.f; \
              _Pragma("unroll") for (int i = 0; i < 32; ++i) fmac1(dd, hn[i], r[i]); \
              d[x] = dd; } \
          _Pragma("unroll") for (int o = 1; o < 64; o <<= 1) { _Pragma("unroll") for (int x = 0; x < NX; ++x) d[x] += __shfl_xor(d[x], o); } \
          float c[NX]; \
          _Pragma("unroll") for (int x = 0; x < NX; ++x) c[x] = SG[tl * 128 + (kb) + x] * gelu_tanh(d[x] * (1.f / 64.f)) * 0.25f; \
          _Pragma("unroll") for (int x = 0; x < NX; ++x) { const v32f_t r = PEER_DEC(S##va[x], S##vb[x]); \
              _Pragma("unroll") for (int i = 0; i < 32; ++i) fmac1(acc[i], c[x], r[i]); } } while (0)
      { u32x4 Aua[NX], Ava[NX], Bua[NX], Bva[NX]; u32x2 Aub[NX], Avb[NX], Bub[NX], Bvb[NX];
        PEER_LOAD(A, 0);
#pragma unroll 1
        for (int k = 0; k < 128; k += 2 * NX) {
            PEER_LOAD(B, k + NX); PEER_COMPUTE(A, k);
            { const int kn = min(k + 2 * NX, 128 - NX); PEER_LOAD(A, kn); }
            PEER_COMPUTE(B, k + NX);
        } }
#undef PEER_DEC
#undef NX
#undef PEER_LOAD
#undef PEER_COMPUTE
      asm volatile("" ::: "memory");
      int tok2 = tok, lane2 = lane; asm volatile("" : "+v"(tok2), "+v"(lane2));
      float s2 = 0.f;
#pragma unroll
      for (int j = 0; j < 2; ++j)
#pragma unroll
          for (int q = 0; q < 4; ++q) { const u32x2 w = ldb64(rH2, ((unsigned)tok2 * 2048u + 256u * (4 * j + q) + 4u * lane2) * 2u);
              const f32x4 a = (f32x4){__uint_as_float(w.x << 16), __uint_as_float(w.x & 0xffff0000u), __uint_as_float(w.y << 16), __uint_as_float(w.y & 0xffff0000u)};
#pragma unroll
              for (int i = 0; i < 4; ++i) { acc[16 * j + 4 * q + i] += a[i]; s2 += acc[16 * j + 4 * q + i] * acc[16 * j + 4 * q + i]; } }
      const float rf = 1.0f / sqrtf(wave_sum(s2) * (1.f / 2048.f) + NORM_EPS);
#pragma unroll
      for (int j = 0; j < 2; ++j)
#pragma unroll
          for (int q = 0; q < 4; ++q) { const f32x4 a = ldf128(rGF, (256u * (4 * j + q) + 4u * lane2) * 4u); f32x4 oa;
#pragma unroll
              for (int i = 0; i < 4; ++i) oa[i] = acc[16 * j + 4 * q + i] * rf * a[i];
              float* op = OUT + (size_t)tok2 * 2048 + 256 * (4 * j + q) + 4 * lane2;
              __builtin_nontemporal_store(oa, (GAS f32x4*)op); }
    }
}
}
#ifndef MK_N_LAUNCHES
#define MK_N_LAUNCHES 1
#endif
#define MK_PROBE_PH -1
#define MK_PROBE_DIV 2
constexpr int N_PHASES = 9;
constexpr int N_LAUNCHES = MK_N_LAUNCHES;
struct Args { const float* in[19]; float* out; unsigned char* ws; int ph_lo, ph_hi; };
static_assert(sizeof(Args) == 19 * 8 + 8 + 8 + 8, "no padding");

__global__ void __launch_bounds__(NWAVES * 64, 2) hybrid_fwd(Args args) {
    extern __shared__ __attribute__((aligned(16))) unsigned char lds_raw[];
    Frame F;
    F.lds = (LAS unsigned char*)lds_raw;
    F.MISC = (volatile LAS unsigned*)(F.lds + MISC_OFF);
    F.tid = threadIdx.x; F.lane = F.tid & 63; F.wave = __builtin_amdgcn_readfirstlane(F.tid >> 6);
    F.G = gridDim.x; { const int bx = blockIdx.x; F.vcu = (F.G % 8 == 0) ? (bx % 8) * (F.G / 8) + bx / 8 : bx; }
    F.ws = args.ws; F.out = args.out;
#pragma unroll
    for (int i = 0; i < 19; ++i) F.in[i] = args.in[i];
    for (int u = F.tid; u < (LDS_BYTES - LDSCTL_OFF) / 4; u += NWAVES * 64) ((LAS unsigned*)(F.lds + LDSCTL_OFF))[u] = 0u;
    __syncthreads();
    XcdBarrier bar; bar.bar = (unsigned*)(F.ws + WS_CTL) + CW_BAR; bar.x = 0; bar.st = nullptr;
    if (N_LAUNCHES == 1) bar = xcd_barrier_post((unsigned*)(F.ws + WS_CTL) + CW_BAR, F.MISC + 8);
    const int lo = args.ph_lo, hi = args.ph_hi;
#define IN(k) (lo <= (k) && (k) < hi)
#if MK_PROBE_PH >= 0
    unsigned long long tp0 = (MK_PROBE_PH == 0 || MK_PROBE_PH == 9) ? __builtin_amdgcn_s_memrealtime() : 0ull, tp1 = 0ull;
#define SEAM(k) do { if (IN(k) && IN((k) + 1)) xcd_barrier(bar); if (MK_PROBE_PH == (k)) tp1 = __builtin_amdgcn_s_memrealtime(); if (MK_PROBE_PH == (k) + 1) tp0 = __builtin_amdgcn_s_memrealtime(); } while (0)
#else
#define SEAM(k) do { if (IN(k) && IN((k) + 1)) xcd_barrier(bar); } while (0)
#endif
    const size_t T2048 = (size_t)256 * 2048 * 2, T1024 = (size_t)256 * 1024 * 2, T512 = (size_t)256 * 512 * 2;
    float* cosT = WSP(float, WS_COS); float* sinT = WSP(float, WS_SIN);
    float* ssq_q = WSP(float, WS_SSQ_Q); float* ssq_kv = WSP(float, WS_SSQ_KV); float* ssq2 = WSP(float, WS_SSQ_2);

    if (IN(0)) { p0_prologue<0>(F, F.vcu, F.G); } SEAM(0);
    if (IN(1)) {
        SchedP1 S{F.G, (int)blockIdx.x, (const char*)(F.ws + WS_HN1), (const char*)(F.ws + WS_WIN), (const char*)(F.ws + WS_WVT), T1024};
        EpiP1 E{WSP(bf16_t, WS_NAQ), WSP(bf16_t, WS_NAK), WSP(bf16_t, WS_VT), WSP(unsigned char, WS_CQ), WSP(unsigned char, WS_CKV), WSP(bf16_t, WS_KR), WSP(bf16_t, WS_GA), WSP(bf16_t, WS_GB), ssq_q, ssq_kv, cosT, sinT};
        pg8::gemm_phase<EpiP1, SchedP1, true, -6>(F.lds, 2048, S, E);
        { const int extra = P1_UNITS % F.G, bx = (int)blockIdx.x; if (extra != 0 && bx >= extra) p0_prologue<1>(F, bx - extra, F.G - extra); else if (extra == 0) p0_prologue<1>(F, bx, F.G); }
    } SEAM(1);
    if (IN(2)) {
        LAS float* relb = (LAS float*)F.lds + 64; LAS float* metab = relb + 16 * 15 * 31 + 128; LAS float* wsf = metab + 256 + F.wave * 64;
        for (int i = F.tid; i < 16 * 15 * 31; i += NWAVES * 64) relb[i] = F.in[4][i];
        if (F.tid < 256) metab[F.tid] = F.in[5][F.tid];
        __syncthreads();
        const int gw = F.vcu * NWAVES + F.wave, NGW = F.G * NWAVES;
        for (int task = gw; task < NBATCH * 16 * 32 * 2; task += NGW)
            att::na_task(task, WSP(bf16_t, WS_NAQ), WSP(bf16_t, WS_NAK), WSP(bf16_t, WS_VT), WSP(unsigned char, WS_ONA), relb, metab, wsf, F.lane);
        __syncthreads();
    } SEAM(2);
    if (IN(3)) {
        SchedP3 S{F.G, (int)blockIdx.x, (const char*)(F.ws + WS_CQ), (const char*)(F.ws + WS_CKV), (const char*)(F.ws + WS_WUQ), (const char*)(F.ws + WS_WUKV), T512 / 2};
        EpiP3 E{WSP(bf16_t, WS_QM), WSP(bf16_t, WS_KN), WSP(bf16_t, WS_VV), ssq_q, ssq_kv, cosT, sinT};
        pg8::gemm_phase<EpiP3, SchedP3, true, -4>(F.lds, 512, S, E);
    } SEAM(3);
    if (IN(4)) {
        for (int id = F.vcu; id < NBATCH * 16 * 8; id += F.G) { const int bh = id >> 3, qb = id & 7;
            att::mla_unit(bh >> 4, bh & 15, qb, WSP(bf16_t, WS_QM), WSP(bf16_t, WS_KN), WSP(bf16_t, WS_KR), WSP(bf16_t, WS_VV), WSP(unsigned char, WS_OMLA), (LAS char*)F.lds); }
        __syncthreads();
    } SEAM(4);
    if (IN(5)) {
        { SchedGrid S{F.G, (int)blockIdx.x, 64, 8, (const char*)(F.ws + WS_ONA), (const char*)(F.ws + WS_WNA), T512};
          EpiP5a E{WSP(bf16_t, WS_GA), WSP(bf16_t, WS_T1)};
          pg8::gemm_phase<EpiP5a, SchedGrid, true, -9>(F.lds, 1024, S, E); }
        { SchedGrid S{F.G, (int)blockIdx.x, 64, 8, (const char*)(F.ws + WS_OMLA), (const char*)(F.ws + WS_WMLA), T1024};
          EpiP5b E{WSP(bf16_t, WS_GB), WSP(bf16_t, WS_T1), WSP(unsigned char, WS_MERGED)};
          pg8::gemm_phase<EpiP5b, SchedGrid, true, -11>(F.lds, 2048, S, E); }
    } SEAM(5);
    if (IN(6)) {
        { SchedGrid S{F.G, (int)blockIdx.x, 64, 8, (const char*)(F.ws + WS_MERGED), (const char*)(F.ws + WS_WOUT), T1024};
          EpiP6 E{F.in[0], WSP(bf16_t, WS_H2B), ssq2};
          pg8::gemm_phase<EpiP6, SchedGrid, true, -11>(F.lds, 2048, S, E); }
        {
#define P6_SRC(i_) (((i_) >> 20 ? F.in[17] : F.in[16]) + (size_t)(((i_) >> 6) & 16383u) * 2048 + 4 * ((i_) & 63u))
          const unsigned NTOT = 2u * 16384u * 64u, STEP = (unsigned)F.G * 512u; unsigned i = (unsigned)F.vcu * 512u + F.tid;
          f32x4 xc[8];
          if (i < NTOT) { const float* src = P6_SRC(i);
#pragma unroll
              for (int q = 0; q < 8; ++q) xc[q] = *(const GAS f32x4*)(src + 256 * q); }
          while (i < NTOT) { const unsigned in_ = i + STEP; f32x4 xn[8];
              { const float* src = P6_SRC(in_ < NTOT ? in_ : i);
#pragma unroll
                for (int q = 0; q < 8; ++q) xn[q] = *(const GAS f32x4*)(src + 256 * q); }
              const unsigned isv = i >> 20, row = (i >> 6) & 16383u, l = i & 63u; const float sc = isv ? 4.f : 64.f; peer::v16f_t a, b;
#pragma unroll
              for (int q = 0; q < 8; ++q)
#pragma unroll
                  for (int e = 0; e < 4; ++e) { const int k_ = 4 * q + e;
                      if (k_ & 1) b[k_ >> 1] = xc[q][e] * sc; else a[k_ >> 1] = xc[q][e] * sc; }
              const peer::v6u_t w = __builtin_amdgcn_cvt_scalef32_2xpk16_fp6_f32(a, b, 1.0f);
              unsigned char* rec = WSP(unsigned char, WS_U) + (size_t)row * 3072 + (isv ? 1536 : 0);
              *(GAS u32x4*)(rec + l * 16) = (u32x4){w[0], w[1], w[2], w[3]}; *(GAS u32x2*)(rec + 1024 + l * 8) = (u32x2){w[4], w[5]};
#pragma unroll
              for (int q = 0; q < 8; ++q) xc[q] = xn[q];
              i = in_; }
#undef P6_SRC
        }
    } SEAM(6);
    if (IN(7)) {
        SchedGrid S{F.G, (int)blockIdx.x, 64, 8, (const char*)(F.ws + WS_H2B), (const char*)(F.ws + WS_WSC), T2048};
        EpiP7 E{ssq2, WSP(float, WS_SC)};
        pg8::gemm_phase<EpiP7, SchedGrid>(F.lds, 2048, S, E);
    } SEAM(7);
    if (IN(8)) {
        const int nch = (MREAL / peer::CH - F.vcu + F.G - 1) / F.G; const bool both_first = (nch == 2) && (F.vcu & 1);
        for (int op = 0; op < 2 * nch; ++op) {
            const bool sel = both_first ? (op < 2) : !(op & 1); const int ci = both_first ? (op & 1) : (op >> 1), chunk = F.vcu + ci * F.G;
            const int b2 = both_first ? ci : 0;
            LAS int* SE = (LAS int*)(F.lds + (b2 ? peer::OFF_SE2 : peer::OFF_SE)); LAS float* SG = (LAS float*)(F.lds + (b2 ? peer::OFF_SG2 : peer::OFF_SG));
            if (sel) peer::peer_select(chunk, WSP(float, WS_SC), (LAS char*)F.lds, F.tid, SE, SG);
            else peer::peer_gather(chunk, WSP(bf16_t, WS_H2B), WSP(unsigned char, WS_U), F.in[13], F.in[18], F.out, F.tid, SE, SG); }
    }
#if MK_PROBE_PH >= 0
    xcd_barrier(bar); tp1 = (MK_PROBE_PH >= 8) ? __builtin_amdgcn_s_memrealtime() : tp1;
    if (blockIdx.x == 0 && F.tid == 0) F.out[0] = (float)(tp1 - tp0) * (0.01f / MK_PROBE_DIV);
#endif
#undef IN
#undef SEAM
}

extern "C" void kernel_launch(void* const* d_in, const int* in_sizes, int n_in, void* d_out, int out_size, void* d_ws, size_t ws_size, hipStream_t stream) {
    static int grid = 0;
    if (grid == 0) {
        if (n_in != 19 || in_sizes[0] != MREAL * DM || out_size != MREAL * DM || ws_size < WS_END) {
            fprintf(stderr, "kernel_launch: shape/workspace mismatch: n_in %d in0 %d out %d ws %zu (need %zu); nothing launched\n", n_in, n_in > 0 ? in_sizes[0] : -1, out_size, ws_size, (size_t)WS_END); grid = -1; return; }
        int dev = 0, cus = 0, per_cu = 0;
        if (hipGetDevice(&dev) != hipSuccess || hipDeviceGetAttribute(&cus, hipDeviceAttributeMultiprocessorCount, dev) != hipSuccess) { fprintf(stderr, "kernel_launch: device query failed\n"); grid = -1; return; }
        if (hipFuncSetAttribute((const void*)hybrid_fwd, hipFuncAttributeMaxDynamicSharedMemorySize, LDS_BYTES) != hipSuccess) { fprintf(stderr, "kernel_launch: hipFuncSetAttribute failed\n"); grid = -1; return; }
        if (hipOccupancyMaxActiveBlocksPerMultiprocessor(&per_cu, (const void*)hybrid_fwd, NWAVES * 64, LDS_BYTES) != hipSuccess || per_cu < 1)
            fprintf(stderr, "kernel_launch: note: occupancy query reports %d workgroups per CU\n", per_cu);
        (void)hipGetLastError();
        grid = cus;
    }
    if (grid < 0) return;
    if (hipMemsetAsync((char*)d_ws + WS_CTL, 0, CTL_ZERO_BYTES, stream) != hipSuccess) { fprintf(stderr, "kernel_launch: hipMemsetAsync failed\n"); return; }
    Args a{};
    for (int i = 0; i < 19; ++i) a.in[i] = (const float*)d_in[i];
    a.out = (float*)d_out; a.ws = (unsigned char*)d_ws;
    for (int li = 0; li < N_LAUNCHES; ++li) {
        a.ph_lo = (N_LAUNCHES == 1) ? 0 : li; a.ph_hi = (N_LAUNCHES == 1) ? N_PHASES : li + 1;
        hipLaunchKernelGGL(hybrid_fwd, dim3(grid), dim3(NWAVES * 64), LDS_BYTES, stream, a);
        const hipError_t le = hipPeekAtLastError();
        if (le != hipSuccess) { fprintf(stderr, "kernel_launch: launch %d failed: %s\n", li, hipGetErrorName(le)); break; }
    }
}
```

```cpp
#include <hip/hip_runtime.h>
#include <cstdio>
#include <cstdint>

#define LAS __attribute__((address_space(3)))
#define GAS __attribute__((address_space(1)))
typedef unsigned short bf16_t;
typedef short bf16x8 __attribute__((ext_vector_type(8)));
typedef short s16x4 __attribute__((ext_vector_type(4)));
typedef float f32x4 __attribute__((ext_vector_type(4)));
typedef float f32x2 __attribute__((ext_vector_type(2)));
typedef float f32x16 __attribute__((ext_vector_type(16)));
typedef unsigned u32x4 __attribute__((ext_vector_type(4)));
typedef unsigned u32x2 __attribute__((ext_vector_type(2)));

constexpr int DM = 2048, NBATCH = 8, SEQ = 2048, NMETA = 16;
constexpr int MREAL = NBATCH * SEQ;
constexpr int MPAD = MREAL + 256;
constexpr int NPOS = SEQ + NMETA;
constexpr float NORM_EPS = 1e-6f;
constexpr int C_NAQ = 0, C_NAK = 1024, C_CQ = 2048, C_CKV = 2560, C_GA = 3072, C_GB = 5120, C_KR = 7168, NMAIN = 7424;
constexpr int VT_PITCH = MPAD;

constexpr size_t MiB = 1u << 20;
constexpr size_t WS_CTL = 0, CTL_ZERO_BYTES = 1 * MiB;
constexpr size_t WS_SSQ_Q = 481 * MiB, WS_SSQ_KV = 482 * MiB, WS_SSQ_2 = 486 * MiB;
constexpr size_t WS_COS = 1 * MiB, WS_SIN = 1 * MiB + 512 * 1024;
constexpr size_t WS_WUQ = 2 * MiB, WS_WUKV = 5 * MiB, WS_WNA = 9 * MiB, WS_WMLA = 13 * MiB, WS_WOUT = 21 * MiB, WS_WSC = 29 * MiB;
constexpr size_t WS_GA = 37 * MiB, WS_GB = 101 * MiB;
constexpr size_t WS_KR = 165 * MiB;
constexpr size_t WS_WIN = 167 * MiB + 256 * 1024, WS_WVT = WS_WIN + 29 * MiB;
constexpr size_t WS_ONA = 190 * MiB;
constexpr size_t WS_NAQ = 222 * MiB, WS_NAK = 254 * MiB, WS_VT = WS_NAK + 32 * MiB + 512 * 1024;
constexpr size_t WS_HN1 = 319 * MiB;
constexpr size_t WS_CQ = 448 * MiB, WS_CKV = 464 * MiB;
constexpr size_t WS_QM = 222 * MiB, WS_KN = 318 * MiB, WS_VV = 383 * MiB;
constexpr size_t WS_OMLA = 448 * MiB;
constexpr size_t WS_MERGED = 222 * MiB, WS_T1 = 286 * MiB;
constexpr size_t WS_H2 = 37 * MiB, WS_H2B = 293 * MiB;
constexpr size_t WS_U = 357 * MiB, WS_V = 421 * MiB;
constexpr size_t WS_SC = 165 * MiB;
constexpr size_t WS_END = 512 * MiB;
static_assert(WS_CKV + (size_t)MPAD * 512 * 2 <= WS_SSQ_Q && WS_SSQ_Q + (size_t)8 * MPAD * 4 <= WS_SSQ_KV && WS_SSQ_KV + (size_t)8 * MPAD * 4 <= 483 * MiB && WS_V + 64 * MiB <= WS_SSQ_2 && WS_SSQ_2 + (size_t)32 * MREAL * 4 <= WS_END, "ssq slabs");
static_assert(WS_VT + (size_t)1024 * MPAD * 2 <= WS_HN1 && WS_HN1 + (size_t)MPAD * 2048 * 2 <= WS_CQ && WS_CKV + (size_t)MPAD * 512 * 2 <= WS_END, "map P1");
static_assert(WS_WVT + 4 * MiB <= WS_NAQ && WS_KR + (size_t)MPAD * 64 * 2 <= WS_WIN && WS_ONA + 32 * MiB <= WS_NAQ, "map P1b");
static_assert(WS_QM + 96 * MiB <= WS_KN && WS_KN + 65 * MiB <= WS_VV && WS_VV + 65 * MiB <= WS_OMLA && WS_OMLA + 64 * MiB <= WS_END, "map P3");
static_assert(WS_T1 + 128 * MiB <= WS_OMLA && WS_H2 + 128 * MiB <= WS_KR && WS_SC + 128 * MiB <= WS_H2B && WS_H2B + 64 * MiB <= WS_U && WS_V + 64 * MiB <= WS_END, "map P5+");

constexpr int CW_BAR = 4096;

constexpr int RING_BYTES = 131072;
constexpr int LDSCTL_OFF = RING_BYTES, MISC_OFF = LDSCTL_OFF + 320;
constexpr int LDS_BYTES = 147456;
constexpr int NWAVES = 8;

#define LDS_WAIT() asm volatile("s_waitcnt lgkmcnt(0)" ::: "memory")
#define VM_WAIT() asm volatile("s_waitcnt vmcnt(0)" ::: "memory")
#define SBAR() __builtin_amdgcn_sched_barrier(0)
typedef __bf16 bf16x2_t __attribute__((ext_vector_type(2)));
__device__ __forceinline__ unsigned cvt_pk_bf16(float lo, float hi) { const f32x2 v = {lo, hi}; const bf16x2_t b = __builtin_convertvector(v, bf16x2_t); return __builtin_bit_cast(unsigned, b); }
__device__ __forceinline__ float bf_lo(unsigned w) { return __uint_as_float(w << 16); }
__device__ __forceinline__ float bf_hi(unsigned w) { return __uint_as_float(w & 0xffff0000u); }
__device__ __forceinline__ u32x4 pack8(const f32x4 a, const f32x4 b) { u32x4 w; w.x = cvt_pk_bf16(a[0], a[1]); w.y = cvt_pk_bf16(a[2], a[3]); w.z = cvt_pk_bf16(b[0], b[1]); w.w = cvt_pk_bf16(b[2], b[3]); return w; }
__device__ __forceinline__ u32x2 pack8_fp8(f32x4 a, f32x4 b) {
#pragma unroll
    for (int i = 0; i < 4; ++i) { a[i] = __builtin_fminf(__builtin_fmaxf(a[i], -448.f), 448.f); b[i] = __builtin_fminf(__builtin_fmaxf(b[i], -448.f), 448.f); }
    int w0 = 0, w1 = 0; w0 = __builtin_amdgcn_cvt_pk_fp8_f32(a[0], a[1], w0, false); w0 = __builtin_amdgcn_cvt_pk_fp8_f32(a[2], a[3], w0, true);
    w1 = __builtin_amdgcn_cvt_pk_fp8_f32(b[0], b[1], w1, false); w1 = __builtin_amdgcn_cvt_pk_fp8_f32(b[2], b[3], w1, true); return (u32x2){(unsigned)w0, (unsigned)w1}; }
__device__ __forceinline__ unsigned char f32_to_fp8(float x) { x = __builtin_fminf(__builtin_fmaxf(x, -448.f), 448.f); return (unsigned char)(__builtin_amdgcn_cvt_pk_fp8_f32(x, 0.f, 0, false) & 0xff); }
__device__ __forceinline__ u32x2 pack4(const f32x4 a) { u32x2 w; w.x = cvt_pk_bf16(a[0], a[1]); w.y = cvt_pk_bf16(a[2], a[3]); return w; }
__device__ __forceinline__ float wave_sum(float v) {
#pragma unroll
    for (int o = 1; o < 64; o <<= 1) v += __shfl_xor(v, o);
    return v;
}
__device__ __forceinline__ float sigmoidf_(float x) { return __builtin_amdgcn_rcpf(1.0f + __builtin_amdgcn_exp2f(-1.4426950408889634f * x)); }
__device__ __forceinline__ int crow(int r, int hi) { return (r & 3) + 8 * (r >> 2) + 4 * hi; }
#define PG8_AUX 0
namespace pg8 {
constexpr int BM = 256, BK = 64, HALF = 128, HTB = HALF * BK * 2  , STAGE_BYTES = 8 * HTB, NXCD = 8, WGM = 8;
__host__ __device__ __forceinline__ int lds_byte(int r, int c) { const int st = (r >> 4) * 2 + (c >> 5), rr = r & 15, cc = c & 31, ob = rr * 64 + cc * 2; return st * 1024 + (ob ^ (((ob >> 9) & 1) << 5)); }
__host__ __device__ __forceinline__ void stage_rc(int b, int& R, int& C) { const int st = b / 1024, sb = b % 1024, swz = sb ^ (((sb >> 9) & 1) << 5); R = (st >> 1) * 16 + swz / 64; C = (st & 1) * 32 + (swz % 64) / 2; }
__host__ __device__ __forceinline__ int perm32(int rho) { const int n = rho >> 4, i = rho & 15; return 8 * (i >> 2) + 4 * n + (i & 3); }

struct Unit { int pm, pn, kind; };

__device__ __forceinline__ void grid_order(int L, int nM, int nN, int& pm, int& pn) {
    const int nwg = nM * nN; int wgid = L;
    { const int q = nwg / NXCD, r = nwg % NXCD, xcd = wgid % NXCD, off = wgid / NXCD; wgid = (xcd < r ? xcd * (q + 1) : r * (q + 1) + (xcd - r) * q) + off; }
    const int nig = WGM * nN, gid = wgid / nig, fm = gid * WGM, gsz = (nM - fm) < WGM ? (nM - fm) : WGM;
    pm = fm + ((wgid % nig) % gsz); pn = (wgid % nig) / gsz;
}

typedef int v8i_t __attribute__((ext_vector_type(8)));
template <class Epi, class Sched, bool F8 = false, int F8_SCALE_EXP = 0>
__device__ __forceinline__ void gemm_phase(LAS unsigned char* lds, const int K, const Sched& S, const Epi& E) {
    const int tid = threadIdx.x, wid = __builtin_amdgcn_readfirstlane(tid >> 6), lane = tid & 63, wr = wid >> 2, wc = wid & 3, fr = lane & 15, fq = lane >> 4;
    int f8sa = 0x01010101 * (127 + F8_SCALE_EXP), f8sb = 0x7f7f7f7f; asm volatile("" : "+v"(f8sa), "+v"(f8sb));
    const int Kb = F8 ? K : 2 * K;
    const int nt = Kb / 128;
    unsigned voffA[2], voffB[2];
#pragma unroll
    for (int i = 0; i < 2; ++i) { int R, C; stage_rc(tid * 16 + i * 8192, R, C); const int Rb = Epi::PERM ? ((R & ~31) + perm32(R & 31)) : R;
        voffA[i] = (unsigned)(R * Kb + C * 2); voffB[i] = (unsigned)(Rb * Kb + C * 2); }
    const size_t kstep = (size_t)128;
    const size_t hstep = (size_t)HALF * Kb;
    const unsigned ldsw = (unsigned)wid * 1024u;
    const int aoff = lds_byte(wr * 64 + fr, F8 ? fq * 16 : fq * 8), boff = lds_byte(wc * 32 + fr, F8 ? fq * 16 : fq * 8);
#define PG8_SA(b, h) (((b) * 2 + (h)) * HTB)
#define PG8_SB(b, h) ((4 + (b) * 2 + (h)) * HTB)
#define PG8_STAGE(bufoff, gbase, voff) do { _Pragma("unroll") for (int _i = 0; _i < 2; ++_i) \
        __builtin_amdgcn_global_load_lds((const unsigned*)((const char*)(gbase) + (voff)[_i]), (LAS unsigned*)(lds + (bufoff) + ldsw + _i * 8192), 16, 0, PG8_AUX); } while (0)
#define PG8_LDA(dst, b, h) do { _Pragma("unroll") for (int m = 0; m < 4; ++m) _Pragma("unroll") for (int k = 0; k < 2; ++k) dst[m][k] = *(const LAS bf16x8*)(lds + PG8_SA(b, h) + aoff + m * 2048 + (F8 ? k * 16 : k * 1024)); } while (0)
#define PG8_LDB(dst, b, h) do { _Pragma("unroll") for (int n = 0; n < 2; ++n) _Pragma("unroll") for (int k = 0; k < 2; ++k) dst[n][k] = *(const LAS bf16x8*)(lds + PG8_SB(b, h) + boff + n * 2048 + (F8 ? k * 16 : k * 1024)); } while (0)
#define PG8_F8OP(X) __builtin_bit_cast(v8i_t, __builtin_shufflevector(X[0], X[1], 0, 1, 2, 3, 4, 5, 6, 7, 8, 9, 10, 11, 12, 13, 14, 15))
#define PG8_MMA(ai, bj, At, Bt) do { __builtin_amdgcn_s_setprio(1); \
        if constexpr (F8) { _Pragma("unroll") for (int m = 0; m < 4; ++m) _Pragma("unroll") for (int n = 0; n < 2; ++n) \
            asm volatile("v_mfma_scale_f32_16x16x128_f8f6f4 %0, %1, %2, %0, %3, %4 op_sel_hi:[0,0,0]" : "+v"(acc[ai][bj][m][n]) : "v"(PG8_F8OP(Bt[n])), "v"(PG8_F8OP(At[m])), "v"(f8sa), "v"(f8sb)); } \
        else { _Pragma("unroll") for (int m = 0; m < 4; ++m) _Pragma("unroll") for (int n = 0; n < 2; ++n) _Pragma("unroll") for (int k = 0; k < 2; ++k) \
            acc[ai][bj][m][n] = __builtin_amdgcn_mfma_f32_16x16x32_bf16(Bt[n][k], At[m][k], acc[ai][bj][m][n], 0, 0, 0); } \
        __builtin_amdgcn_s_setprio(0); } while (0)
#define PG8_WAIT_V(n) asm volatile("s_waitcnt vmcnt(" #n ")" ::: "memory")
#define PG8_WAIT_L(n) asm volatile("s_waitcnt lgkmcnt(" #n ")" ::: "memory")
#define PG8_BAR __builtin_amdgcn_s_barrier()
#define PG8_SCHED __builtin_amdgcn_sched_barrier(0)
    Unit cur, nxt; int ui = 0;
    if (!S.next(0, cur)) return;
    f32x4 acc[2][2][4][2];
#pragma unroll
    for (int a = 0; a < 2; ++a)
#pragma unroll
        for (int b = 0; b < 2; ++b)
#pragma unroll
            for (int m = 0; m < 4; ++m)
#pragma unroll
                for (int n = 0; n < 2; ++n) acc[a][b][m][n] = (f32x4){0.f, 0.f, 0.f, 0.f};
    bf16x8 At[4][2], B0[2][2], B1[2][2];
    const char* cA = S.pa(cur); const char* cB = S.pb(cur);
    PG8_STAGE(PG8_SB(0, 0), cB, voffB); PG8_STAGE(PG8_SB(0, 1), cB + hstep, voffB); PG8_STAGE(PG8_SA(0, 0), cA, voffA); PG8_STAGE(PG8_SA(0, 1), cA + hstep, voffA);
    if (wr == 1) PG8_BAR;
    PG8_WAIT_V(2); PG8_BAR;
    PG8_STAGE(PG8_SB(1, 0), cB + kstep, voffB); PG8_STAGE(PG8_SA(1, 0), cA + kstep, voffA); PG8_STAGE(PG8_SB(1, 1), cB + hstep + kstep, voffB);
    PG8_WAIT_V(6); PG8_BAR;
    for (;;) {
        const bool has_next = S.next(ui + 1, nxt);
        const char* nA = has_next ? S.pa(nxt) : cA; const char* nB = has_next ? S.pb(nxt) : cB;
        for (int t = 0; t < nt; t += 2) {
            const bool last = (t == nt - 2);
            const char* a1 = cA + (size_t)(t + 1) * kstep;
            const char* a2 = last ? nA : cA + (size_t)(t + 2) * kstep; const char* b2 = last ? nB : cB + (size_t)(t + 2) * kstep;
            const char* a3 = a2 + kstep; const char* b3 = b2 + kstep;
            PG8_LDB(B0, 0, 0); PG8_LDB(B1, 0, 1); PG8_SCHED; PG8_LDA(At, 0, 0); PG8_STAGE(PG8_SA(1, 1), a1 + hstep, voffA);
            PG8_WAIT_V(8); PG8_WAIT_L(0); PG8_BAR; PG8_MMA(0, 0, At, B0); PG8_MMA(0, 1, At, B1); PG8_BAR; PG8_SCHED;
            PG8_LDA(At, 0, 1); PG8_STAGE(PG8_SB(0, 0), b2, voffB); PG8_STAGE(PG8_SB(0, 1), b2 + hstep, voffB); PG8_STAGE(PG8_SA(0, 0), a2, voffA);
            PG8_WAIT_V(8); PG8_WAIT_L(0); PG8_BAR; PG8_MMA(1, 0, At, B0); PG8_MMA(1, 1, At, B1); PG8_BAR; PG8_SCHED;
            PG8_LDB(B0, 1, 0); PG8_LDB(B1, 1, 1); PG8_SCHED; PG8_LDA(At, 1, 0); PG8_STAGE(PG8_SA(0, 1), a2 + hstep, voffA);
            PG8_WAIT_V(8); PG8_WAIT_L(0); PG8_BAR; PG8_MMA(0, 0, At, B0); PG8_MMA(0, 1, At, B1); PG8_BAR; PG8_SCHED;
            PG8_LDA(At, 1, 1); PG8_STAGE(PG8_SB(1, 0), b3, voffB); PG8_STAGE(PG8_SB(1, 1), b3 + hstep, voffB); PG8_STAGE(PG8_SA(1, 0), a3, voffA);
            PG8_WAIT_V(8); PG8_WAIT_L(0); PG8_BAR; PG8_MMA(1, 0, At, B0); PG8_MMA(1, 1, At, B1); PG8_BAR; PG8_SCHED;
        }
        if (wr == 0) PG8_BAR;
        if constexpr (F8) asm volatile("s_nop 15\n\ts_nop 7" ::: "memory");
        if constexpr (Epi::HAS_PRE) {
            E.pre(cur, (LAS float*)(lds + STAGE_BYTES + 1024), tid); PG8_WAIT_L(0); PG8_BAR; }
        E(acc, cur, wr, wc, fr, fq, (const LAS float*)(lds + STAGE_BYTES + 1024));
        if (!has_next) break;
#pragma unroll
        for (int a = 0; a < 2; ++a)
#pragma unroll
            for (int b = 0; b < 2; ++b)
#pragma unroll
                for (int m = 0; m < 4; ++m)
#pragma unroll
                    for (int n = 0; n < 2; ++n) acc[a][b][m][n] = (f32x4){0.f, 0.f, 0.f, 0.f};
        cur = nxt; cA = nA; cB = nB; ++ui;
        if (wr == 1) PG8_BAR;
    }
    PG8_WAIT_V(0);
    PG8_BAR;
#undef PG8_SA
#undef PG8_SB
#undef PG8_STAGE
#undef PG8_LDA
#undef PG8_LDB
#undef PG8_MMA
#undef PG8_F8OP
#undef PG8_WAIT_V
#undef PG8_WAIT_L
#undef PG8_BAR
#undef PG8_SCHED
}
}
typedef GAS unsigned gu32;
#define RLX_AGENT __ATOMIC_RELAXED, __HIP_MEMORY_SCOPE_AGENT
#define XB_TMO      128
#define XB_XCNT(j)  (256  + 64 * (j))
#define XB_XSUB(j)  (1280 + 64 * (j))
#define XB_XGEN(j)  (2304 + 64 * (j))
#define XB_TOP      3328
#define XB_TOPGEN   3392
#define XCD_BAR_WORDS 3456
#define XB_SPIN_CAP (1u << 18)
__device__ __forceinline__ unsigned xb_ld(unsigned* p)              { return __hip_atomic_load(p, __ATOMIC_RELAXED, __HIP_MEMORY_SCOPE_AGENT); }
__device__ __forceinline__ unsigned xb_add(unsigned* p, unsigned v) { return __hip_atomic_fetch_add(p, v, __ATOMIC_RELAXED, __HIP_MEMORY_SCOPE_AGENT); }
__device__ __forceinline__ unsigned xb_xcc_id() { return (unsigned)__builtin_amdgcn_s_getreg((3 << 11) | 20) & 0xFu; }
#define XB_SPIN(cond, bar) do { unsigned _sp = 0; while (cond) { __builtin_amdgcn_s_sleep(1); \
    if ((++_sp & 255u) == 0u) { if (xb_ld(&(bar)[XB_TMO])) break; if (_sp > XB_SPIN_CAP) { atomicAdd(&(bar)[XB_TMO], 1u); break; } } } } while (0)
struct XcdBarrier { unsigned* bar; unsigned x; volatile LAS unsigned* st; };
__device__ __forceinline__ XcdBarrier xcd_barrier_post(unsigned* bar, volatile LAS unsigned* st) {
    XcdBarrier b; b.bar = bar; b.x = xb_xcc_id(); b.st = st;
    if (threadIdx.x == 0) (void)xb_add(&bar[XB_XCNT(b.x)], 1u);
    return b;
}
__device__ __forceinline__ void xcd_barrier_complete(unsigned* bar, unsigned x, unsigned& nloc, unsigned& nx) {
    const unsigned G = gridDim.x * gridDim.y * gridDim.z;
    unsigned sum, cnt, mine, sp = 0u;
    for (;;) {
        sum = 0u; cnt = 0u; mine = 0u;
#pragma unroll
        for (unsigned j = 0; j < 16; ++j) { const unsigned c = xb_ld(&bar[XB_XCNT(j)]); sum += c; cnt += (c > 0u) ? 1u : 0u; mine = (j == x) ? c : mine; }
        if (sum == G) break;
        __builtin_amdgcn_s_sleep(1);
        if ((++sp & 255u) == 0u) { if (xb_ld(&bar[XB_TMO])) break; if (sp > XB_SPIN_CAP) { atomicAdd(&bar[XB_TMO], 1u); break; } }
    }
    nloc = mine > 0u ? mine : 1u; nx = cnt > 0u ? cnt : 1u;
}
__device__ __forceinline__ void xcd_barrier(const XcdBarrier& b) {
    asm volatile("s_waitcnt vmcnt(0)" ::: "memory");
    __syncthreads();
    if (threadIdx.x == 0) {
        unsigned* bar = b.bar;
        __builtin_amdgcn_s_waitcnt(0);
        unsigned nloc = b.st[0], nx = b.st[1];
        if (nloc == 0u) { xcd_barrier_complete(bar, b.x, nloc, nx); b.st[0] = nloc; b.st[1] = nx; }
        const unsigned old = xb_add(&bar[XB_XSUB(b.x)], 1u);
        const unsigned gen = old / nloc;
        if (old + 1u == (gen + 1u) * nloc) {
            __builtin_amdgcn_fence(__ATOMIC_RELEASE, "agent");
            asm volatile("s_waitcnt vmcnt(0)" ::: "memory");
            const unsigned og = xb_add(&bar[XB_TOP], 1u);
            const unsigned tg = og / nx;
            if (og + 1u == (tg + 1u) * nx) xb_add(&bar[XB_TOPGEN], 1u);
            else XB_SPIN(xb_ld(&bar[XB_TOPGEN]) == tg, bar);
            __builtin_amdgcn_fence(__ATOMIC_ACQUIRE, "agent");
            xb_add(&bar[XB_XGEN(b.x)], 1u);
            asm volatile("s_waitcnt vmcnt(0)" ::: "memory");
        } else {
            XB_SPIN(xb_ld(&bar[XB_XGEN(b.x)]) == gen, bar);
            __builtin_amdgcn_fence(__ATOMIC_ACQUIRE, "agent");
            asm volatile("s_waitcnt vmcnt(0)" ::: "memory");
        }
    }
    __syncthreads();
}
struct Frame {
    LAS unsigned char* lds;
    volatile LAS unsigned* MISC;
    unsigned char* ws;
    int tid, lane, wave;
    int vcu, G;
    const float* in[19];
    float* out;
};
#define WSP(T, off) ((T*)(F.ws + (off)))

__device__ __forceinline__ void p0_transpose_item(const float* W, int K, int N, int k0, int n0, bf16_t* WT, int drow, bool rope, const float* gain, LAS float* scr, int lane) {
    { f32x4 v[8]; float gk[8];
#pragma unroll
      for (int i = 0; i < 8; ++i) { const int kk = 8 * i + (lane >> 3); v[i] = *(const GAS f32x4*)(W + (size_t)(k0 + kk) * N + n0 + 4 * (lane & 7)); gk[i] = gain ? gain[k0 + kk] : 1.f; }
#pragma unroll
      for (int i = 0; i < 8; ++i) { const int kk = 8 * i + (lane >> 3); LAS float* d = scr + kk * 33 + 4 * (lane & 7);
#pragma unroll
          for (int e = 0; e < 4; ++e) d[e] = v[i][e] * gk[i]; } }
    LDS_WAIT(); asm volatile("" ::: "memory");
    const int c = lane & 7;
#pragma unroll
    for (int j = 0; j < 4; ++j) { const int n = (lane >> 3) + 8 * j; const LAS float* s = scr + (8 * c) * 33 + n;
        u32x4 o; o.x = cvt_pk_bf16(s[0 * 33], s[1 * 33]); o.y = cvt_pk_bf16(s[2 * 33], s[3 * 33]); o.z = cvt_pk_bf16(s[4 * 33], s[5 * 33]); o.w = cvt_pk_bf16(s[6 * 33], s[7 * 33]);
        const int dr = drow + (rope ? (8 * (n >> 2) + (n & 3)) : n);
        *(GAS u32x4*)(WT + (size_t)dr * K + k0 + 8 * c) = o; }
    LDS_WAIT(); asm volatile("" ::: "memory");
}
__device__ __forceinline__ void p0_transpose_item8(const float* W, int K, int N, int k0, int n0, unsigned char* WT, int drow, bool rope, float scale, LAS float* scr, int lane, const float* gain = nullptr) {
    { f32x4 v[8]; float gk[8];
#pragma unroll
      for (int i = 0; i < 8; ++i) { const int kk = 8 * i + (lane >> 3); v[i] = *(const GAS f32x4*)(W + (size_t)(k0 + kk) * N + n0 + 4 * (lane & 7)); gk[i] = gain ? gain[k0 + kk] * scale : scale; }
#pragma unroll
      for (int i = 0; i < 8; ++i) { const int kk = 8 * i + (lane >> 3); LAS float* d = scr + kk * 33 + 4 * (lane & 7);
#pragma unroll
          for (int e = 0; e < 4; ++e) d[e] = v[i][e] * gk[i]; } }
    LDS_WAIT(); asm volatile("" ::: "memory");
#pragma unroll
    for (int j = 0; j < 2; ++j) { const int q = lane + 64 * j, n = q >> 2, c = q & 3; const LAS float* s = scr + (16 * c) * 33 + n; u32x4 o;
#pragma unroll
        for (int d = 0; d < 4; ++d) { int w = 0; w = __builtin_amdgcn_cvt_pk_fp8_f32(s[(4 * d) * 33], s[(4 * d + 1) * 33], w, false); w = __builtin_amdgcn_cvt_pk_fp8_f32(s[(4 * d + 2) * 33], s[(4 * d + 3) * 33], w, true); o[d] = (unsigned)w; }
        const int dr = drow + (rope ? (8 * (n >> 2) + (n & 3)) : n);
        *(GAS u32x4*)(WT + (size_t)dr * K + k0 + 16 * c) = o; }
    LDS_WAIT(); asm volatile("" ::: "memory");
}
__device__ __forceinline__ void rms_row_to_fp8(const float* xrow, const float* g, unsigned char* orow, int lane) {
    const GAS f32x4* xr = (const GAS f32x4*)xrow + lane; const GAS f32x4* gr = (const GAS f32x4*)g + lane;
    f32x4 v[8]; float s = 0.f;
#pragma unroll
    for (int j = 0; j < 8; ++j) { v[j] = xr[64 * j]; s += (v[j].x * v[j].x + v[j].y * v[j].y) + (v[j].z * v[j].z + v[j].w * v[j].w); }
    const float rstd = 1.0f / sqrtf(wave_sum(s) * (1.f / DM) + NORM_EPS);
    GAS unsigned* o4 = (GAS unsigned*)orow + lane;
#pragma unroll
    for (int j = 0; j < 8; ++j) { const f32x4 y = (v[j] * rstd) * gr[64 * j]; int w = 0; w = __builtin_amdgcn_cvt_pk_fp8_f32(y[0], y[1], w, false); w = __builtin_amdgcn_cvt_pk_fp8_f32(y[2], y[3], w, true); o4[64 * j] = (unsigned)w; }
}
__device__ __forceinline__ void rms_row_to_bf16(const float* xrow, const float* g, bf16_t* orow, int lane) {
    const GAS f32x4* xr = (const GAS f32x4*)xrow + lane; const GAS f32x4* gr = (const GAS f32x4*)g + lane;
    f32x4 v[8]; float s = 0.f;
#pragma unroll
    for (int j = 0; j < 8; ++j) { v[j] = xr[64 * j]; s += (v[j].x * v[j].x + v[j].y * v[j].y) + (v[j].z * v[j].z + v[j].w * v[j].w); }
    const float rstd = 1.0f / sqrtf(wave_sum(s) * (1.f / DM) + NORM_EPS);
    GAS u32x2* o8 = (GAS u32x2*)orow + lane;
#pragma unroll
    for (int j = 0; j < 8; ++j) { const f32x4 gg = gr[64 * j]; o8[64 * j] = pack4((v[j] * rstd) * gg); }
}
template <int PART>
__device__ __forceinline__ void p0_prologue(Frame& F, int rank, int nrank) {
    LAS float* scr = (LAS float*)(F.lds + F.wave * 16384);
    const int gw = rank * NWAVES + F.wave, NGW = nrank * NWAVES, lane = F.lane; const int gt = rank * 512 + F.tid, NGT = nrank * 512;
    unsigned char* WIN = WSP(unsigned char, WS_WIN); unsigned char* WVT = WSP(unsigned char, WS_WVT);
    constexpr int I_IN = 32 * 258, I_UQ = 8 * 96, I_UKV = 8 * 128, I_NA = 16 * 64, I_MLA = 32 * 64, I_OUT = 32 * 64;
    constexpr int NEARLY = I_IN + I_UQ + I_UKV, NITEMS = NEARLY + I_NA + I_MLA + I_OUT;
    for (int it = (PART == 0 ? 0 : NEARLY) + gw; it < (PART == 0 ? NEARLY : NITEMS); it += NGW) {
        int r = it;
        if (r < I_IN) { const int kb = r / 258, sb = r % 258, n0 = 32 * sb, k0 = 64 * kb; const float* W = F.in[3];
            unsigned char* dst = WIN; int drow; bool rope = false;
            if (n0 < 1024) drow = C_NAQ + n0;
            else if (n0 < 2048) drow = C_NAK + (n0 - 1024);
            else if (n0 < 3072) { dst = WVT; drow = n0 - 2048; }
            else if (n0 < 3584) drow = C_CQ + (n0 - 3072);
            else if (n0 < 4096) drow = C_CKV + (n0 - 3584);
            else if (n0 < 4160) { drow = C_KR + ((n0 - 4096) ? 4 : 0); rope = true; }
            else if (n0 < 6208) drow = C_GA + (n0 - 4160);
            else drow = C_GB + (n0 - 6208);
            p0_transpose_item8(W, 2048, 8256, k0, n0, dst, drow, rope, 64.f, scr, lane); continue; } r -= I_IN;
        if (r < I_UQ) { const int kb = r / 96, sb = r % 96, n0 = 32 * sb, k0 = 64 * kb; const int hd = n0 / 192, w = n0 % 192;
            int drow = n0; bool rope = false; if (w >= 128) { rope = true; drow = hd * 192 + 128 + ((w - 128) ? 4 : 0); }
            p0_transpose_item8(F.in[7], 512, 3072, k0, n0, WSP(unsigned char, WS_WUQ), drow, rope, 16.f, scr, lane, F.in[6]); continue; } r -= I_UQ;
        if (r < I_UKV) { const int kb = r / 128, sb = r % 128; p0_transpose_item8(F.in[9], 512, 4096, 64 * kb, 32 * sb, WSP(unsigned char, WS_WUKV), 32 * sb, false, 16.f, scr, lane, F.in[8]); continue; } r -= I_UKV;
        if (r < I_NA) { const int kb = r / 64, sb = r % 64; p0_transpose_item8(F.in[10], 1024, 2048, 64 * kb, 32 * sb, WSP(unsigned char, WS_WNA), 32 * sb, false, 32.f, scr, lane); continue; } r -= I_NA;
        if (r < I_MLA) { const int kb = r / 64, sb = r % 64; p0_transpose_item8(F.in[11], 2048, 2048, 64 * kb, 32 * sb, WSP(unsigned char, WS_WMLA), 32 * sb, false, 64.f, scr, lane); continue; } r -= I_MLA;
        { const int kb = r / 64, sb = r % 64; p0_transpose_item8(F.in[12], 2048, 2048, 64 * kb, 32 * sb, WSP(unsigned char, WS_WOUT), 32 * sb, false, 64.f, scr, lane); }
    }
    if (PART == 0) { GAS u32x4* z = (GAS u32x4*)(WIN + (size_t)(C_KR + 64) * 2048); const int n16 = (NMAIN - C_KR - 64) * 2048 / 16;
      for (int i = gt; i < n16; i += NGT) z[i] = (u32x4){0u, 0u, 0u, 0u}; }
    if (PART == 0) { unsigned char* HN1 = WSP(unsigned char, WS_HN1);
#define P0_ROWSRC(m_) (((m_) < MREAL) ? F.in[0] + (size_t)(m_) * DM : F.in[1] + (size_t)((m_) - MREAL) * DM)
      { f32x4 v[8]; int m = gw;
        if (m < MREAL + NMETA) { const GAS f32x4* xr = (const GAS f32x4*)P0_ROWSRC(m) + lane;
#pragma unroll
            for (int j = 0; j < 8; ++j) v[j] = xr[64 * j]; }
        const GAS f32x4* gr = (const GAS f32x4*)F.in[2] + lane;
        while (m < MREAL + NMETA) { const int mn = m + NGW; f32x4 vn[8];
            { const int ml = mn < MREAL + NMETA ? mn : m; const GAS f32x4* xr = (const GAS f32x4*)P0_ROWSRC(ml) + lane;
#pragma unroll
              for (int j = 0; j < 8; ++j) vn[j] = xr[64 * j]; }
            float sq = 0.f;
#pragma unroll
            for (int j = 0; j < 8; ++j) sq += (v[j].x * v[j].x + v[j].y * v[j].y) + (v[j].z * v[j].z + v[j].w * v[j].w);
            const float rstd = 1.0f / sqrtf(wave_sum(sq) * (1.f / DM) + NORM_EPS);
            GAS unsigned* o4 = (GAS unsigned*)(HN1 + (size_t)m * DM) + lane;
#pragma unroll
            for (int j = 0; j < 8; ++j) { const f32x4 y = (v[j] * rstd) * gr[64 * j]; int w = 0; w = __builtin_amdgcn_cvt_pk_fp8_f32(y[0], y[1], w, false); w = __builtin_amdgcn_cvt_pk_fp8_f32(y[2], y[3], w, true); o4[64 * j] = (unsigned)w; }
#pragma unroll
            for (int j = 0; j < 8; ++j) v[j] = vn[j];
            m = mn; } }
#undef P0_ROWSRC
      GAS u32x4* z = (GAS u32x4*)(HN1 + (size_t)(MREAL + NMETA) * DM); const int n16 = (MPAD - MREAL - NMETA) * DM / 16;
      for (int i = gt; i < n16; i += NGT) z[i] = (u32x4){0u, 0u, 0u, 0u}; }
    if (PART == 0) { float* ct = WSP(float, WS_COS); float* st = WSP(float, WS_SIN);
      for (int i = gt; i < NPOS * 32; i += NGT) { const int p = i >> 5, j = i & 31;
          const float inv = __builtin_powf(10000.0f, -(float)(2 * j) / 64.0f); const float ang = (float)p * inv;
          double r = (double)ang * 0.15915494309189535; r -= __builtin_rint(r); const float rf = (float)r;
          ct[i] = __builtin_amdgcn_cosf(rf); st[i] = __builtin_amdgcn_sinf(rf); } }
    if (PART == 1) { const float* SK = F.in[15]; const float* WQ = F.in[14]; const float* g2 = F.in[13]; bf16_t* WSCp = WSP(bf16_t, WS_WSC);
      const int l15 = lane & 15, l4 = lane >> 4;
      for (int task = gw; task < 2048; task += NGW) { const int g = task >> 7, nt = (task >> 4) & 7, kc = task & 15, n0 = nt * 16;
          bf16x8 bfr[4];
#pragma unroll
          for (int kk = 0; kk < 4; ++kk) { const float* p = SK + ((size_t)g * 128 + n0 + l15) * 128 + 32 * kk + 8 * l4; const f32x4 a = *(const GAS f32x4*)p, b = *(const GAS f32x4*)(p + 4);
              const u32x4 w = pack8(a, b); bfr[kk] = __builtin_bit_cast(bf16x8, w); }
          for (int kt = 0; kt < 8; ++kt) { const int k0 = (kc * 8 + kt) * 16; f32x4 acc = (f32x4){0.f, 0.f, 0.f, 0.f};
#pragma unroll
              for (int kk = 0; kk < 4; ++kk) { const float* p = WQ + (size_t)(k0 + l15) * 2048 + g * 128 + 32 * kk + 8 * l4; const f32x4 a = *(const GAS f32x4*)p, b = *(const GAS f32x4*)(p + 4);
                  const u32x4 w = pack8(a, b); acc = __builtin_amdgcn_mfma_f32_16x16x32_bf16(__builtin_bit_cast(bf16x8, w), bfr[kk], acc, 0, 0, 0); }
              const f32x4 gg = *(const GAS f32x4*)(g2 + k0 + 4 * l4);
              *(GAS u32x2*)(WSCp + (size_t)(g * 128 + n0 + l15) * 2048 + k0 + 4 * l4) = pack4(acc * gg); } } }
}
using pg8::Unit;
struct SchedGrid {
    int G, c, nM, nN; const char* A; const char* B; size_t tstep;
    __device__ __forceinline__ bool next(int i, Unit& u) const { const int L = i * G + c; if (L >= nM * nN) return false; pg8::grid_order(L, nM, nN, u.pm, u.pn); u.kind = 0; return true; }
    __device__ __forceinline__ const char* pa(const Unit& u) const { return A + (size_t)u.pm * tstep; }
    __device__ __forceinline__ const char* pb(const Unit& u) const { return B + (size_t)u.pn * tstep; }
};
constexpr int P1_MAIN = 64 * 29, P1_VT = 4 * 65, P1_META = 7, P1_UNITS = P1_MAIN + P1_VT + P1_META;
struct SchedP1 {
    int G, c; const char* hn1; const char* win; const char* wvt; size_t tstep;
    __device__ __forceinline__ bool next(int i, Unit& u) const {
        const int L = i * G + c; if (L >= P1_UNITS) return false;
        if (L < P1_MAIN) { pg8::grid_order(L, 64, 29, u.pm, u.pn); u.kind = 0; }
        else if (L < P1_MAIN + P1_VT) { const int idx = L - P1_MAIN; u.pm = idx & 3; u.pn = idx >> 2; u.kind = 1; }
        else { const int idx = L - P1_MAIN - P1_VT; u.pm = 64; u.pn = idx < 4 ? 4 + idx : (idx < 6 ? 10 + (idx - 4) : 28); u.kind = 0; }
        return true; }
    __device__ __forceinline__ const char* pa(const Unit& u) const { return (u.kind == 1 ? wvt : hn1) + (size_t)u.pm * tstep; }
    __device__ __forceinline__ const char* pb(const Unit& u) const { return (u.kind == 1 ? hn1 : win) + (size_t)u.pn * tstep; }
};
__device__ __forceinline__ void rope4(const f32x4 x1, const f32x4 x2, const float* cosT, const float* sinT, int pos, int j0, f32x4& lo, f32x4& hi) {
    const f32x4 c = *(const GAS f32x4*)(cosT + pos * 32 + j0), s = *(const GAS f32x4*)(sinT + pos * 32 + j0);
    lo = x1 * c - x2 * s; hi = x2 * c + x1 * s;
}
struct EpiP1 {
    static constexpr bool PERM = true, HAS_PRE = false;
    bf16_t *naq, *nak, *vt; unsigned char *cq, *ckv; bf16_t *kr, *ga, *gb; float *ssq_q, *ssq_kv; const float *cosT, *sinT;
    __device__ __forceinline__ void operator()(const f32x4 (&acc)[2][2][4][2], const Unit& u, int wr, int wc, int fr, int fq, const LAS float* rowsc) const {
        const int row0 = u.pm * 256 + wr * 64 + fr, colu = wc * 32 + 8 * fq;
        if (u.kind == 1) {
#pragma unroll
            for (int ai = 0; ai < 2; ++ai)
#pragma unroll
                for (int m = 0; m < 4; ++m) { bf16_t* rp = vt + (size_t)(row0 + ai * 128 + m * 16) * VT_PITCH + u.pn * 256 + colu;
#pragma unroll
                    for (int bj = 0; bj < 2; ++bj) *(GAS u32x4*)(rp + bj * 128) = pack8(acc[ai][bj][m][0], acc[ai][bj][m][1]); }
            return; }
        const int pn = u.pn;
        if (pn == 28) {
            if (wc < 2) { const int j0 = 4 * (4 * wc + fq);
#pragma unroll
                for (int ai = 0; ai < 2; ++ai)
#pragma unroll
                    for (int m = 0; m < 4; ++m) { const int row = row0 + ai * 128 + m * 16; const int pos = row < MREAL ? NMETA + (row & (SEQ - 1)) : row - MREAL;
                        f32x4 lo, hi; rope4(acc[ai][0][m][0], acc[ai][0][m][1], cosT, sinT, pos, j0, lo, hi);
                        *(GAS u32x2*)(kr + (size_t)row * 64 + j0) = pack4(lo); *(GAS u32x2*)(kr + (size_t)row * 64 + 32 + j0) = pack4(hi); } }
            return; }
        if (pn >= 12) {
            bf16_t* base = pn < 20 ? ga : gb; const int colt = (pn < 20 ? pn - 12 : pn - 20) * 256 + colu;
#pragma unroll
            for (int ai = 0; ai < 2; ++ai)
#pragma unroll
                for (int m = 0; m < 4; ++m) { bf16_t* rp = base + (size_t)(row0 + ai * 128 + m * 16) * 2048 + colt;
#pragma unroll
                    for (int bj = 0; bj < 2; ++bj) { f32x4 a = acc[ai][bj][m][0], b = acc[ai][bj][m][1];
#pragma unroll
                        for (int i = 0; i < 4; ++i) { a[i] = sigmoidf_(a[i]); b[i] = sigmoidf_(b[i]); }
                        *(GAS u32x4*)(rp + bj * 128) = pack8(a, b); } }
            return; }
        if (pn >= 8) {
            const bool isq = pn < 10; unsigned char* base = isq ? cq : ckv; float* ssq = isq ? ssq_q : ssq_kv; const int colt = (isq ? pn - 8 : pn - 10) * 256 + colu;
#pragma unroll
            for (int ai = 0; ai < 2; ++ai)
#pragma unroll
                for (int m = 0; m < 4; ++m) { const int row = row0 + ai * 128 + m * 16; unsigned char* rp = base + (size_t)row * 512 + colt; float s = 0.f;
#pragma unroll
                    for (int bj = 0; bj < 2; ++bj) { const f32x4 a = acc[ai][bj][m][0], b = acc[ai][bj][m][1];
                        s += (a[0] * a[0] + a[1] * a[1]) + (a[2] * a[2] + a[3] * a[3]) + (b[0] * b[0] + b[1] * b[1]) + (b[2] * b[2] + b[3] * b[3]);
                        *(GAS u32x2*)(rp + bj * 128) = pack8_fp8(a, b); }
                    s += __shfl_xor(s, 16); s += __shfl_xor(s, 32);
                    if (fq == 0) ssq[(size_t)((pn & 1) * 4 + wc) * MPAD + row] = s; }
            return; }
        {
            bf16_t* base = pn < 4 ? naq : nak; const int colt = (pn & 3) * 256 + colu;
#pragma unroll
            for (int ai = 0; ai < 2; ++ai)
#pragma unroll
                for (int m = 0; m < 4; ++m) { bf16_t* rp = base + (size_t)(row0 + ai * 128 + m * 16) * 1024 + colt;
#pragma unroll
                    for (int bj = 0; bj < 2; ++bj) *(GAS u32x4*)(rp + bj * 128) = pack8(acc[ai][bj][m][0], acc[ai][bj][m][1]); }
        }
    }
};
constexpr int P3_Q = 64 * 12, P3_KV = 65 * 16, P3_UNITS = P3_Q + P3_KV;
struct SchedP3 {
    int G, c; const char* cq; const char* ckv; const char* wuq; const char* wukv; size_t tstep;
    __device__ __forceinline__ bool next(int i, Unit& u) const {
        const int L = i * G + c; if (L >= P3_UNITS) return false;
        if (L < P3_Q) { pg8::grid_order(L, 64, 12, u.pm, u.pn); u.kind = 0; } else { pg8::grid_order(L - P3_Q, 65, 16, u.pm, u.pn); u.kind = 1; }
        return true; }
    __device__ __forceinline__ const char* pa(const Unit& u) const { return (u.kind ? ckv : cq) + (size_t)u.pm * tstep; }
    __device__ __forceinline__ const char* pb(const Unit& u) const { return (u.kind ? wukv : wuq) + (size_t)u.pn * tstep; }
};
template <int NS, int LD> __device__ __forceinline__ float rstd_slabs(const float* part, int row, float invn) {
    float s = 0.f;
#pragma unroll
    for (int i = 0; i < NS; ++i) s += part[(size_t)i * LD + row];
    return 1.0f / sqrtf(s * invn + NORM_EPS);
}
struct EpiP3 {
    static constexpr bool PERM = true, HAS_PRE = true;
    bf16_t *qm, *kn, *vv; const float *ssq_q, *ssq_kv; const float *cosT, *sinT;
    __device__ __forceinline__ void pre(const Unit& u, LAS float* sc, int tid) const { if (tid < 256) { const int row = u.pm * 256 + tid; sc[tid] = u.kind ? rstd_slabs<8, MPAD>(ssq_kv, row, 1.f / 512.f) : rstd_slabs<8, MPAD>(ssq_q, row, 1.f / 512.f); } }
    __device__ __forceinline__ void operator()(const f32x4 (&acc)[2][2][4][2], const Unit& u, int wr, int wc, int fr, int fq, const LAS float* rowsc) const {
        const int row0 = u.pm * 256 + wr * 64 + fr, colu = wc * 32 + 8 * fq;
        if (u.kind == 1) {
#pragma unroll
            for (int ai = 0; ai < 2; ++ai)
#pragma unroll
                for (int m = 0; m < 4; ++m) { const int row = row0 + ai * 128 + m * 16; const float rs = rowsc[ai * 128 + wr * 64 + m * 16 + fr];
                    const size_t off = (size_t)row * 2048 + u.pn * 128 + colu;
                    *(GAS u32x4*)(kn + off) = pack8(acc[ai][0][m][0] * rs, acc[ai][0][m][1] * rs);
                    *(GAS u32x4*)(vv + off) = pack8(acc[ai][1][m][0] * rs, acc[ai][1][m][1] * rs); }
            return; }
#pragma unroll
        for (int bj = 0; bj < 2; ++bj) { const int c8 = u.pn * 256 + bj * 128 + colu; const int hd = c8 / 192, w = c8 - hd * 192;
            if (w < 128) {
#pragma unroll
                for (int ai = 0; ai < 2; ++ai)
#pragma unroll
                    for (int m = 0; m < 4; ++m) { const int row = row0 + ai * 128 + m * 16; const float rs = rowsc[ai * 128 + wr * 64 + m * 16 + fr];
                        *(GAS u32x4*)(qm + (size_t)row * 3072 + c8) = pack8(acc[ai][bj][m][0] * rs, acc[ai][bj][m][1] * rs); }
            } else { const int j0 = (w - 128) >> 1;
#pragma unroll
                for (int ai = 0; ai < 2; ++ai)
#pragma unroll
                    for (int m = 0; m < 4; ++m) { const int row = row0 + ai * 128 + m * 16; const float rs = rowsc[ai * 128 + wr * 64 + m * 16 + fr];
                        const int pos = NMETA + (row & (SEQ - 1)); f32x4 lo, hi; rope4(acc[ai][bj][m][0] * rs, acc[ai][bj][m][1] * rs, cosT, sinT, pos, j0, lo, hi);
                        bf16_t* qp = qm + (size_t)row * 3072 + hd * 192 + 128 + j0; *(GAS u32x2*)qp = pack4(lo); *(GAS u32x2*)(qp + 32) = pack4(hi); }
            } }
    }
};
__device__ __forceinline__ void unpack8(const u32x4 w, f32x4& a, f32x4& b) { a = (f32x4){bf_lo(w.x), bf_hi(w.x), bf_lo(w.y), bf_hi(w.y)}; b = (f32x4){bf_lo(w.z), bf_hi(w.z), bf_lo(w.w), bf_hi(w.w)}; }
struct EpiP5a {
    static constexpr bool PERM = true, HAS_PRE = false;
    const bf16_t* ga; bf16_t* t1;
    __device__ __forceinline__ void operator()(const f32x4 (&acc)[2][2][4][2], const Unit& u, int wr, int wc, int fr, int fq, const LAS float* rowsc) const {
        const int row0 = u.pm * 256 + wr * 64 + fr, col0 = u.pn * 256 + wc * 32 + 8 * fq;
#pragma unroll
        for (int ai = 0; ai < 2; ++ai)
#pragma unroll
            for (int m = 0; m < 4; ++m) { const size_t off = (size_t)(row0 + ai * 128 + m * 16) * 2048 + col0;
#pragma unroll
                for (int bj = 0; bj < 2; ++bj) { f32x4 g0, g1; unpack8(*(const GAS u32x4*)(ga + off + bj * 128), g0, g1);
                    *(GAS u32x4*)(t1 + off + bj * 128) = pack8(acc[ai][bj][m][0] * g0, acc[ai][bj][m][1] * g1); } }
    }
};
struct EpiP5b {
    static constexpr bool PERM = true, HAS_PRE = false;
    const bf16_t* gb; const bf16_t* t1; unsigned char* merged;
    __device__ __forceinline__ void operator()(const f32x4 (&acc)[2][2][4][2], const Unit& u, int wr, int wc, int fr, int fq, const LAS float* rowsc) const {
        const int row0 = u.pm * 256 + wr * 64 + fr, col0 = u.pn * 256 + wc * 32 + 8 * fq;
#pragma unroll
        for (int ai = 0; ai < 2; ++ai)
#pragma unroll
            for (int m = 0; m < 4; ++m) { const size_t off = (size_t)(row0 + ai * 128 + m * 16) * 2048 + col0;
#pragma unroll
                for (int bj = 0; bj < 2; ++bj) { f32x4 g0, g1; unpack8(*(const GAS u32x4*)(gb + off + bj * 128), g0, g1);
                    f32x4 a, b; unpack8(*(const GAS u32x4*)(t1 + off + bj * 128), a, b);
                    *(GAS u32x2*)(merged + off + bj * 128) = pack8_fp8((a + acc[ai][bj][m][0] * g0) * 32.f, (b + acc[ai][bj][m][1] * g1) * 32.f); } }
    }
};
struct EpiP6 {
    static constexpr bool PERM = true, HAS_PRE = false;
    const float* x; bf16_t* h2b; float* ssq2;
    __device__ __forceinline__ void operator()(const f32x4 (&acc)[2][2][4][2], const Unit& u, int wr, int wc, int fr, int fq, const LAS float* rowsc) const {
        const int row0 = u.pm * 256 + wr * 64 + fr, col0 = u.pn * 256 + wc * 32 + 8 * fq;
#pragma unroll
        for (int ai = 0; ai < 2; ++ai)
#pragma unroll
            for (int m = 0; m < 4; ++m) { const int row = row0 + ai * 128 + m * 16; const size_t off = (size_t)row * 2048 + col0; float s = 0.f;
#pragma unroll
                for (int bj = 0; bj < 2; ++bj) { const f32x4 a = *(const GAS f32x4*)(x + off + bj * 128) + acc[ai][bj][m][0], b = *(const GAS f32x4*)(x + off + bj * 128 + 4) + acc[ai][bj][m][1];
                    s += (a[0] * a[0] + a[1] * a[1]) + (a[2] * a[2] + a[3] * a[3]) + (b[0] * b[0] + b[1] * b[1]) + (b[2] * b[2] + b[3] * b[3]);
                    *(GAS u32x4*)(h2b + off + bj * 128) = pack8(a, b); }
                s += __shfl_xor(s, 16); s += __shfl_xor(s, 32);
                if (fq == 0) ssq2[(size_t)(u.pn * 4 + wc) * MREAL + row] = s; }
    }
};
struct EpiP7 {
    static constexpr bool PERM = true, HAS_PRE = true;
    const float* ssq2; _Float16* sc;
    __device__ __forceinline__ void pre(const Unit& u, LAS float* sc, int tid) const { if (tid < 256) sc[tid] = rstd_slabs<32, MREAL>(ssq2, u.pm * 256 + tid, 1.f / 2048.f); }
    __device__ __forceinline__ void operator()(const f32x4 (&acc)[2][2][4][2], const Unit& u, int wr, int wc, int fr, int fq, const LAS float* rowsc) const {
        typedef _Float16 h4_t __attribute__((ext_vector_type(4)));
        const int row0 = u.pm * 256 + wr * 64 + fr, col0 = u.pn * 256 + wc * 32 + 8 * fq;
#pragma unroll
        for (int ai = 0; ai < 2; ++ai)
#pragma unroll
            for (int m = 0; m < 4; ++m) { const int row = row0 + ai * 128 + m * 16; const float rs = rowsc[ai * 128 + wr * 64 + m * 16 + fr]; const size_t off = (size_t)row * 2048 + col0;
#pragma unroll
                for (int bj = 0; bj < 2; ++bj) { const h4_t lo = __builtin_convertvector(acc[ai][bj][m][0] * rs, h4_t), hi = __builtin_convertvector(acc[ai][bj][m][1] * rs, h4_t);
                    const u32x2 wl = __builtin_bit_cast(u32x2, lo), wh = __builtin_bit_cast(u32x2, hi);
                    *(GAS u32x4*)(sc + off + bj * 128) = (u32x4){wl.x, wl.y, wh.x, wh.y}; } }
    }
};
namespace att {
#define KSWZ(row, colB) ((row) * 256 + ((colB) ^ (((row) & 7) << 4)))
#define KRSWZ(row, colB) ((row) * 128 + ((colB) ^ ((((row) >> 1) & 7) << 4)))
constexpr float L2E = 1.4426950408889634f;
template <int DUMMY = 0>
__device__ __forceinline__ void partialSM(f32x16& p0, f32x16& p1, float& m_reg, float& mn, float& alpha, const float C, const float THRS) {
  float pmax = p0[0];
#pragma unroll
  for (int r = 1; r < 16; ++r) pmax = fmaxf(pmax, p0[r]);
#pragma unroll
  for (int r = 0; r < 16; ++r) pmax = fmaxf(pmax, p1[r]);
  { auto rr = __builtin_amdgcn_permlane32_swap(__float_as_uint(pmax), __float_as_uint(pmax), false, false);
    pmax = fmaxf(__uint_as_float(rr[0]), __uint_as_float(rr[1])); }
  if (__builtin_expect(__all(pmax - m_reg <= THRS), 1)) { mn = m_reg; alpha = 1.f; }
  else { mn = fmaxf(m_reg, pmax); alpha = __builtin_amdgcn_exp2f((m_reg - mn) * C); m_reg = mn; }
  const float mnC = -mn * C;
#pragma unroll
  for (int r = 0; r < 16; ++r) p0[r] = fmaf(p0[r], C, mnC);
#pragma unroll
  for (int r = 0; r < 16; ++r) p1[r] = fmaf(p1[r], C, mnC);
#pragma unroll
  for (int r = 0; r < 16; ++r) p0[r] = __builtin_amdgcn_exp2f(p0[r]);
}
__device__ __forceinline__ void finishSM(f32x16& p0, f32x16& p1, float alpha, float& l_reg, bf16x8& pa0, bf16x8& pa1, bf16x8& pa2, bf16x8& pa3) {
#pragma unroll
  for (int r = 0; r < 16; ++r) p1[r] = __builtin_amdgcn_exp2f(p1[r]);
  float ps = 0;
#pragma unroll
  for (int r = 0; r < 16; ++r) ps += p0[r];
#pragma unroll
  for (int r = 0; r < 16; ++r) ps += p1[r];
  { auto rr = __builtin_amdgcn_permlane32_swap(__float_as_uint(ps), __float_as_uint(ps), false, false);
    ps = __uint_as_float(rr[0]) + __uint_as_float(rr[1]); }
  l_reg = l_reg * alpha + ps;
#define PK4(P, BASE, OUT) do { unsigned a0 = cvt_pk_bf16(P[BASE + 0], P[BASE + 1]), a1 = cvt_pk_bf16(P[BASE + 2], P[BASE + 3]);   \
    unsigned b0 = cvt_pk_bf16(P[BASE + 4], P[BASE + 5]), b1 = cvt_pk_bf16(P[BASE + 6], P[BASE + 7]);                              \
    auto r0 = __builtin_amdgcn_permlane32_swap(a0, b0, false, false); auto r1 = __builtin_amdgcn_permlane32_swap(a1, b1, false, false); \
    u32x4 w = {r0[0], r1[0], r0[1], r1[1]}; OUT = __builtin_bit_cast(bf16x8, w); } while (0)
  PK4(p0, 0, pa0); PK4(p0, 8, pa1); PK4(p1, 0, pa2); PK4(p1, 8, pa3);
#undef PK4
}
constexpr int NW = 8, QBLK = 32, KVBLK = 64;
constexpr float MLA_SCALE = 0.07216878364870322f;
constexpr float MLA_THR = 8.f;
constexpr int SHM_V = KVBLK * 128 * 2, SHM_KN = KVBLK * 128 * 2, SHM_KR = KVBLK * 64 * 2;
constexpr int OFF_V = 0, OFF_KN = 2 * SHM_V, OFF_KR = OFF_KN + 2 * SHM_KN, OFF_WS = OFF_KR + 2 * SHM_KR, OFF_QR = OFF_WS + NW * 64 * 4, MLA_LDS = OFF_QR + NW * 4096;
__device__ __forceinline__ void qkt(f32x16& p0, f32x16& p1, const LAS char* Kn, const LAS char* Kr, const bf16x8* qr, const LAS char* qrp, const int* kb, const int* krb) {
  p0 = f32x16{}; p1 = f32x16{};
#pragma unroll
  for (int d0 = 0; d0 < 8; ++d0) {
    const bf16x8 b0 = *(const LAS bf16x8*)(Kn + kb[d0 & 3] + (d0 >> 2) * 128);
    const bf16x8 b1 = *(const LAS bf16x8*)(Kn + kb[d0 & 3] + (d0 >> 2) * 128 + 8192);
    p0 = __builtin_amdgcn_mfma_f32_32x32x16_bf16(b0, qr[d0], p0, 0, 0, 0);
    p1 = __builtin_amdgcn_mfma_f32_32x32x16_bf16(b1, qr[d0], p1, 0, 0, 0); }
#pragma unroll
  for (int d0 = 0; d0 < 4; ++d0) {
    const bf16x8 b0 = *(const LAS bf16x8*)(Kr + krb[d0]);
    const bf16x8 b1 = *(const LAS bf16x8*)(Kr + krb[d0] + 4096);
    const bf16x8 qf = *(const LAS bf16x8*)(qrp + d0 * 1024);
    p0 = __builtin_amdgcn_mfma_f32_32x32x16_bf16(b0, qf, p0, 0, 0, 0);
    p1 = __builtin_amdgcn_mfma_f32_32x32x16_bf16(b1, qf, p1, 0, 0, 0); }
}
__device__ __forceinline__ int v_st(int k, int c) { const int kk = (k & ~0xC) | ((k & 4) << 1) | ((k & 8) >> 1); return ((kk >> 3) * 4 + (c >> 5)) * 512 + ((kk & 7) * 32 + (c & 31)) * 2; }
__device__ __forceinline__ int v_rd_base(int lane) { return ((lane & 3) << 3) | (((lane >> 2) & 3) << 6) | (((lane >> 4) & 1) << 5) | (((lane >> 5) & 1) << 8); }
constexpr int v_rd_off(int d0, int ks, int half) { return d0 * 512 + ks * 4096 + half * 2048; }
template <int OFF> __device__ __forceinline__ s16x4 tr_read(int vb) {
  s16x4 r; asm volatile("ds_read_b64_tr_b16 %0, %1 offset:%2" : "=&v"(r) : "v"(vb), "i"(OFF) : "memory"); return r;
}
template <int D0> __device__ __forceinline__ void pv_one(f32x16& od, int vb, bf16x8 pa0, bf16x8 pa1, bf16x8 pa2, bf16x8 pa3) {
  const s16x4 l0 = tr_read<v_rd_off(D0, 0, 0)>(vb), h0 = tr_read<v_rd_off(D0, 0, 1)>(vb), l1 = tr_read<v_rd_off(D0, 1, 0)>(vb), h1 = tr_read<v_rd_off(D0, 1, 1)>(vb);
  const s16x4 l2 = tr_read<v_rd_off(D0, 2, 0)>(vb), h2 = tr_read<v_rd_off(D0, 2, 1)>(vb), l3 = tr_read<v_rd_off(D0, 3, 0)>(vb), h3 = tr_read<v_rd_off(D0, 3, 1)>(vb);
  asm volatile("s_waitcnt lgkmcnt(0)" ::: "memory"); SBAR();
#define PK(L, H) (bf16x8){L[0], L[1], L[2], L[3], H[0], H[1], H[2], H[3]}
  od = __builtin_amdgcn_mfma_f32_32x32x16_bf16(pa0, PK(l0, h0), od, 0, 0, 0);
  od = __builtin_amdgcn_mfma_f32_32x32x16_bf16(pa1, PK(l1, h1), od, 0, 0, 0);
  od = __builtin_amdgcn_mfma_f32_32x32x16_bf16(pa2, PK(l2, h2), od, 0, 0, 0);
  od = __builtin_amdgcn_mfma_f32_32x32x16_bf16(pa3, PK(l3, h3), od, 0, 0, 0);
#undef PK
}
__device__ __forceinline__ void pv_d0(f32x16* o, int vb, bf16x8 pa0, bf16x8 pa1, bf16x8 pa2, bf16x8 pa3) {
  pv_one<0>(o[0], vb, pa0, pa1, pa2, pa3); pv_one<1>(o[1], vb, pa0, pa1, pa2, pa3); pv_one<2>(o[2], vb, pa0, pa1, pa2, pa3); pv_one<3>(o[3], vb, pa0, pa1, pa2, pa3);
}
__device__ __forceinline__ void mla_unit(int b, int h, int qb, const bf16_t* __restrict__ QM, const bf16_t* __restrict__ KN, const bf16_t* __restrict__ KR, const bf16_t* __restrict__ VV, unsigned char* __restrict__ OM, LAS char* lds) {
  const int tid = threadIdx.x, wid = tid >> 6, lane = tid & 63, r32 = lane & 31, hi = lane >> 5;
  constexpr float C = MLA_SCALE * L2E, THRS = MLA_THR / MLA_SCALE;
  constexpr int NT = 33;
  LAS char* V_lds = lds + OFF_V; LAS char* Kn_lds = lds + OFF_KN; LAS char* Kr_lds = lds + OFF_KR;
  LAS float* ws = (LAS float*)(lds + OFF_WS) + wid * 64; LAS float* li_l = ws; LAS float* al_l = ws + 32;
  float m_reg = -1e30f, l_reg = 0; f32x16 o[4] = {}; bf16x8 qr[8];
  LAS char* qrp = lds + OFF_QR + wid * 4096 + lane * 16;
  const int qrow = b * SEQ + qb * 256 + wid * QBLK + r32;
  const bf16_t* Qw = QM + (size_t)qrow * 3072 + h * 192 + hi * 8;
#pragma unroll
  for (int d0 = 0; d0 < 8; ++d0) qr[d0] = *(const GAS bf16x8*)(Qw + d0 * 16);
  __syncthreads();
#pragma unroll
  for (int d0 = 0; d0 < 4; ++d0) *(LAS bf16x8*)(qrp + d0 * 1024) = *(const GAS bf16x8*)(Qw + (8 + d0) * 16);
  const int sr = tid >> 4, sc = (tid & 15) * 8, vst0 = v_st(sr, sc), vst1 = v_st(32 + sr, sc);
  const int krr = tid >> 3, krc = (tid & 7) * 8;
  const int vb0 = (int)(uintptr_t)V_lds + v_rd_base(lane);
  bf16x8 s_v0, s_v1, s_k0, s_k1, s_kr;
  const int realbase = b * SEQ - KVBLK;
  const unsigned voff = (unsigned)(sr * 2048 + sc) * 2u, kroff = (unsigned)(krr * 64 + krc) * 2u;
  int kb[4], krb[4];
#pragma unroll
  for (int bq = 0; bq < 4; ++bq) { kb[bq] = KSWZ(r32, bq * 32 + hi * 16); krb[bq] = KRSWZ(r32, bq * 32 + hi * 16); }
#define TROW(t) ((t) == 0 ? MREAL : realbase + (t) * KVBLK)
#define SLOAD(t) do { const int k0_ = TROW(t); const size_t ro_ = ((size_t)k0_ * 2048 + h * 128) * 2; \
    const GAS char* vb_ = (const GAS char*)VV + ro_; const GAS char* nb_ = (const GAS char*)KN + ro_; const GAS char* rb_ = (const GAS char*)KR + (size_t)k0_ * 128; \
    s_v0 = *(const GAS bf16x8*)(vb_ + voff); s_v1 = *(const GAS bf16x8*)(vb_ + 32 * 4096 + voff); \
    s_k0 = *(const GAS bf16x8*)(nb_ + voff); s_k1 = *(const GAS bf16x8*)(nb_ + 32 * 4096 + voff); \
    s_kr = *(const GAS bf16x8*)(rb_ + kroff); } while (0)
#define SWRITE(bf) do { *(LAS bf16x8*)(V_lds + (bf) * SHM_V + vst0) = s_v0; *(LAS bf16x8*)(V_lds + (bf) * SHM_V + vst1) = s_v1; const int kc_ = sc * 2; \
    *(LAS bf16x8*)(Kn_lds + (bf) * SHM_KN + KSWZ(sr, kc_)) = s_k0; *(LAS bf16x8*)(Kn_lds + (bf) * SHM_KN + KSWZ(32 + sr, kc_)) = s_k1; \
    *(LAS bf16x8*)(Kr_lds + (bf) * SHM_KR + KRSWZ(krr, krc * 2)) = s_kr; } while (0)
#define SWAIT() asm volatile("s_waitcnt vmcnt(0)" ::: "memory")
#define RESC(a) do { if (__any((a) < 1.f)) { if (hi == 0) al_l[r32] = (a); asm volatile("s_waitcnt lgkmcnt(0)" ::: "memory"); \
    _Pragma("unroll") for (int d = 0; d < 4; ++d) _Pragma("unroll") for (int r = 0; r < 16; ++r) o[d][r] *= al_l[crow(r, hi)]; } } while (0)
  f32x16 pA0, pA1, pB0, pB1; float mnA, mnB, alA, alB; bf16x8 pa0, pa1, pa2, pa3;
  SLOAD(0); SWAIT(); SWRITE(0); __syncthreads();
  qkt(pA0, pA1, Kn_lds, Kr_lds, qr, qrp, kb, krb);
  { const float NEG = -INFINITY;
#pragma unroll
    for (int r = 8; r < 16; ++r) pA0[r] = NEG;
#pragma unroll
    for (int r = 0; r < 16; ++r) pA1[r] = NEG; }
  partialSM(pA0, pA1, m_reg, mnA, alA, C, THRS);
  SLOAD(1); SWAIT(); SWRITE(1); __syncthreads();
  for (int j = 1; j + 1 < NT; j += 2) {
    SBAR(); qkt(pB0, pB1, Kn_lds + SHM_KN, Kr_lds + SHM_KR, qr, qrp, kb, krb);
    finishSM(pA0, pA1, alA, l_reg, pa0, pa1, pa2, pa3); SBAR();
    SLOAD(j + 1); SBAR();
    pv_d0(o, vb0, pa0, pa1, pa2, pa3); partialSM(pB0, pB1, m_reg, mnB, alB, C, THRS);
    __syncthreads(); SWAIT(); SWRITE(0);
    RESC(alB); __syncthreads();
    SBAR(); qkt(pA0, pA1, Kn_lds, Kr_lds, qr, qrp, kb, krb);
    finishSM(pB0, pB1, alB, l_reg, pa0, pa1, pa2, pa3); SBAR();
    if (j + 2 < NT) SLOAD(j + 2); SBAR();
    pv_d0(o, vb0 + SHM_V, pa0, pa1, pa2, pa3); partialSM(pA0, pA1, m_reg, mnA, alA, C, THRS);
    __syncthreads(); if (j + 2 < NT) { SWAIT(); SWRITE(1); }
    RESC(alA); __syncthreads();
  }
  finishSM(pA0, pA1, alA, l_reg, pa0, pa1, pa2, pa3); SBAR();
  pv_d0(o, vb0, pa0, pa1, pa2, pa3);
  if (hi == 0) li_l[r32] = l_reg; asm volatile("s_waitcnt lgkmcnt(0)" ::: "memory");
  float rli[16];
#pragma unroll
  for (int r = 0; r < 16; ++r) rli[r] = __builtin_amdgcn_rcpf(li_l[crow(r, hi)]);
  unsigned char* Ow = OM + (size_t)(b * SEQ + qb * 256 + wid * QBLK) * 2048 + h * 128;
#pragma unroll
  for (int r = 0; r < 16; ++r) { const int orow = crow(r, hi);
#pragma unroll
    for (int d0 = 0; d0 < 4; ++d0) Ow[(size_t)orow * 2048 + d0 * 32 + r32] = f32_to_fp8(o[d0][r] * rli[r] * 32.f); }
#undef TROW
#undef SLOAD
#undef SWRITE
#undef SWAIT
#undef RESC
}
__device__ __forceinline__ void na_task(int task, const bf16_t* __restrict__ NAQ, const bf16_t* __restrict__ NAK, const bf16_t* __restrict__ VT, unsigned char* __restrict__ ONA,
                                        const LAS float* relb, const LAS float* metab, LAS float* wsf, int lane) {
  const int r32 = lane & 31, hi = lane >> 5;
  const int half = task & 1, r = (task >> 1) & 31, h = (task >> 6) & 15, b = task >> 10;
  const int qc = half * 32 + r32;
  const int cs = min(max(qc - 8, 0), 48), rs = min(max(r - 4, 0), 24);
  const int qtok = b * SEQ + r * 64 + qc;
  constexpr float C = L2E, THRS = 8.f, SCALE = 0.125f;
  bf16x8 qr[4];
#pragma unroll
  for (int d0 = 0; d0 < 4; ++d0) qr[d0] = *(const GAS bf16x8*)(NAQ + (size_t)qtok * 1024 + h * 64 + d0 * 16 + hi * 8);
  float m_reg = -1e30f, l_reg = 0.f; f32x16 o[2] = {};
  LAS float* al_l = wsf; LAS float* li_l = wsf + 32;
  const float NEG = -INFINITY;
  const int kb0 = half * 16;
  const unsigned long long wm = 0xFFFFull << (cs - kb0);
  const unsigned mh0 = (unsigned)wm >> (4 * hi), mh1 = (unsigned)(wm >> 32) >> (4 * hi);
  const bf16_t* kq = NAK + (size_t)r32 * 1024 + h * 64 + hi * 8;
  const bf16_t* kq2 = NAK + (size_t)(32 + (r32 & 15)) * 1024 + h * 64 + hi * 8;
  const bf16_t* vq = VT + (size_t)(h * 64 + r32) * VT_PITCH + 8 * hi;
#define NA_KTOK(w) ((w) == 8 ? MREAL : b * SEQ + (rs + (w)) * 64 + kb0)
#define NA_LOADK(KF, w) do { const size_t ko_ = (size_t)NA_KTOK(w) * 1024; _Pragma("unroll") for (int d0 = 0; d0 < 4; ++d0) { KF[d0] = *(const GAS bf16x8*)(kq + ko_ + d0 * 16); KF[4 + d0] = *(const GAS bf16x8*)(kq2 + ko_ + d0 * 16); } } while (0)
#define NA_TILE(KF, w) do { \
    bf16x8 vf[6]; { const bf16_t* vp_ = vq + NA_KTOK(w); _Pragma("unroll") for (int ks = 0; ks < 3; ++ks) { vf[ks] = *(const GAS bf16x8*)(vp_ + 16 * ks); vf[3 + ks] = *(const GAS bf16x8*)(vp_ + (size_t)32 * VT_PITCH + 16 * ks); } } \
    f32x16 p0 = {}, p1 = {}; \
    _Pragma("unroll") for (int d0 = 0; d0 < 4; ++d0) { p0 = __builtin_amdgcn_mfma_f32_32x32x16_bf16(KF[d0], qr[d0], p0, 0, 0, 0); p1 = __builtin_amdgcn_mfma_f32_32x32x16_bf16(KF[4 + d0], qr[d0], p1, 0, 0, 0); } \
    if ((w) + 1 < 9) NA_LOADK(KF, (w) + 1);            \
    if ((w) < 8) { const LAS float* bp_ = relb + ((h * 15 + (rs + (w) - r + 7)) * 31 + 15 - qc + 4 * hi + kb0);     \
      float bv0[16], bv1[8];        \
      _Pragma("unroll") for (int rg = 0; rg < 16; ++rg) { const int c_ = (rg & 3) + 8 * (rg >> 2); bv0[rg] = bp_[c_]; if (rg < 8) bv1[rg] = bp_[c_ + 32]; } \
      _Pragma("unroll") for (int rg = 0; rg < 16; ++rg) { asm volatile("" : "+v"(bv0[rg])); if (rg < 8) asm volatile("" : "+v"(bv1[rg])); } \
      _Pragma("unroll") for (int rg = 0; rg < 16; ++rg) { const int c_ = (rg & 3) + 8 * (rg >> 2); \
        { const bool ok = (mh0 >> c_) & 1u; p0[rg] = ok ? fmaf(p0[rg], SCALE, bv0[rg]) : NEG; } \
        if (rg < 8) { const bool ok = (mh1 >> c_) & 1u; p1[rg] = ok ? fmaf(p1[rg], SCALE, bv1[rg]) : NEG; } } \
    } else { const LAS float* bp = metab + h * 16; \
      _Pragma("unroll") for (int rg = 0; rg < 16; ++rg) { const int kc = crow(rg, hi); p0[rg] = (rg < 8) ? fmaf(p0[rg], SCALE, bp[kc & 15]) : NEG; if (rg < 8) p1[rg] = NEG; } } \
      \
    float pmax = p0[0]; \
    _Pragma("unroll") for (int rg = 1; rg < 16; ++rg) pmax = fmaxf(pmax, p0[rg]); \
    _Pragma("unroll") for (int rg = 0; rg < 8; ++rg) pmax = fmaxf(pmax, p1[rg]); \
    { auto rr = __builtin_amdgcn_permlane32_swap(__float_as_uint(pmax), __float_as_uint(pmax), false, false); pmax = fmaxf(__uint_as_float(rr[0]), __uint_as_float(rr[1])); } \
    float mn, alpha; \
    if (__builtin_expect(__all(pmax - m_reg <= THRS), 1)) { mn = m_reg; alpha = 1.f; } \
    else { mn = fmaxf(m_reg, pmax); alpha = __builtin_amdgcn_exp2f((m_reg - mn) * C); m_reg = mn; } \
    const float mnC = -mn * C; float ps = 0.f; \
    _Pragma("unroll") for (int rg = 0; rg < 16; ++rg) { p0[rg] = __builtin_amdgcn_exp2f(fmaf(p0[rg], C, mnC)); ps += p0[rg]; } \
    _Pragma("unroll") for (int rg = 0; rg < 8; ++rg) { p1[rg] = __builtin_amdgcn_exp2f(fmaf(p1[rg], C, mnC)); ps += p1[rg]; } \
    { auto rr = __builtin_amdgcn_permlane32_swap(__float_as_uint(ps), __float_as_uint(ps), false, false); ps = __uint_as_float(rr[0]) + __uint_as_float(rr[1]); } \
    l_reg = l_reg * alpha + ps; \
    bf16x8 pa0, pa1, pa2; NA_PK4(p0, 0, pa0); NA_PK4(p0, 8, pa1); NA_PK4(p1, 0, pa2); \
    if (__any(alpha < 1.f)) { if (hi == 0) al_l[r32] = alpha; asm volatile("s_waitcnt lgkmcnt(0)" ::: "memory"); \
      _Pragma("unroll") for (int d = 0; d < 2; ++d) _Pragma("unroll") for (int rg = 0; rg < 16; ++rg) o[d][rg] *= al_l[crow(rg, hi)]; } \
    _Pragma("unroll") for (int d0 = 0; d0 < 2; ++d0) { \
      o[d0] = __builtin_amdgcn_mfma_f32_32x32x16_bf16(pa0, vf[3 * d0 + 0], o[d0], 0, 0, 0); o[d0] = __builtin_amdgcn_mfma_f32_32x32x16_bf16(pa1, vf[3 * d0 + 1], o[d0], 0, 0, 0); \
      o[d0] = __builtin_amdgcn_mfma_f32_32x32x16_bf16(pa2, vf[3 * d0 + 2], o[d0], 0, 0, 0); } } while (0)
#define NA_PK4(P, BASE, OUT) do { unsigned a0 = cvt_pk_bf16(P[BASE + 0], P[BASE + 1]), a1 = cvt_pk_bf16(P[BASE + 2], P[BASE + 3]);   \
    unsigned b0 = cvt_pk_bf16(P[BASE + 4], P[BASE + 5]), b1 = cvt_pk_bf16(P[BASE + 6], P[BASE + 7]);                              \
    auto r0 = __builtin_amdgcn_permlane32_swap(a0, b0, false, false); auto r1 = __builtin_amdgcn_permlane32_swap(a1, b1, false, false); \
    u32x4 w_ = {r0[0], r1[0], r0[1], r1[1]}; OUT = __builtin_bit_cast(bf16x8, w_); } while (0)
  { bf16x8 kA[8];
    NA_LOADK(kA, 0);
#pragma unroll 1
    for (int w = 0; w < 8; ++w) { NA_TILE(kA, w); }
    NA_TILE(kA, 8); }
#undef NA_PK4
#undef NA_KTOK
#undef NA_LOADK
#undef NA_TILE
  if (hi == 0) li_l[r32] = l_reg; asm volatile("s_waitcnt lgkmcnt(0)" ::: "memory");
  unsigned char* Ow = ONA + (size_t)(b * SEQ + r * 64 + half * 32) * 1024 + h * 64;
#pragma unroll
  for (int rg = 0; rg < 16; ++rg) { const int orow = crow(rg, hi); const float rl = __builtin_amdgcn_rcpf(li_l[orow]);
#pragma unroll
    for (int d0 = 0; d0 < 2; ++d0) Ow[(size_t)orow * 1024 + d0 * 32 + r32] = f32_to_fp8(o[d0][rg] * rl * 16.f); }
  asm volatile("s_waitcnt lgkmcnt(0)" ::: "memory");
}
}
namespace peer {
constexpr int CH = 32;
constexpr int OFF_TV = 0, OFF_TI = OFF_TV + CH * 16 * 16 * 4, OFF_SE = OFF_TI + CH * 16 * 16 * 4, OFF_SG = OFF_SE + CH * 128 * 4, OFF_SE2 = OFF_SG + CH * 128 * 4, OFF_SG2 = OFF_SE2 + CH * 128 * 4, PEER_LDS = OFF_SG2 + CH * 128 * 4;
static_assert(PEER_LDS <= RING_BYTES, "PEER LDS");
__device__ __forceinline__ float gelu_tanh(float x) {
    const float u = 0.7978845608028654f * (x + 0.044715f * x * x * x);
    const float e = __builtin_amdgcn_exp2f(-2.f * 1.4426950408889634f * fabsf(u));
    const float t = (1.f - e) * __builtin_amdgcn_rcpf(1.f + e);
    return 0.5f * x * (1.f + (u < 0.f ? -t : t));
}
__device__ __forceinline__ void fmac1(float& acc, float a, float b) { asm("v_fmac_f32_e32 %0, %1, %2" : "+v"(acc) : "v"(a), "v"(b)); }
#define PEER_INSERT(x_, xi_) do { float x__ = (x_); int xi__ = (xi_); \
    _Pragma("unroll") for (int j_ = 0; j_ < 16; ++j_) { const bool gt_ = x__ > tv[j_]; const float tvo_ = tv[j_]; const int tio_ = ti[j_]; \
        tv[j_] = gt_ ? x__ : tvo_; ti[j_] = gt_ ? xi__ : tio_; x__ = gt_ ? tvo_ : x__; xi__ = gt_ ? tio_ : xi__; } } while (0)

#define PEER_AUX 0
typedef __amdgpu_buffer_rsrc_t rsrc_t;
__device__ __forceinline__ rsrc_t mk_rsrc(const void* p, unsigned bytes) { return __builtin_amdgcn_make_buffer_rsrc((void*)p, 0, bytes, 0x00020000); }
__device__ __forceinline__ u32x4 ldb128(rsrc_t r, unsigned off) { return __builtin_amdgcn_raw_buffer_load_b128(r, off, 0, PEER_AUX); }
typedef unsigned v6u_t __attribute__((ext_vector_type(6)));
typedef float v32f_t __attribute__((ext_vector_type(32)));
typedef float v16f_t __attribute__((ext_vector_type(16)));
__device__ __forceinline__ u32x2 ldb64(rsrc_t r, unsigned off) { return __builtin_amdgcn_raw_buffer_load_b64(r, off, 0, PEER_AUX); }
__device__ __forceinline__ f32x4 ldf128(rsrc_t r, unsigned off) { return __builtin_bit_cast(f32x4, __builtin_amdgcn_raw_buffer_load_b128(r, off, 0, PEER_AUX)); }
__device__ __forceinline__ f32x4 ldf128_nt(rsrc_t r, unsigned off) { return __builtin_bit_cast(f32x4, __builtin_amdgcn_raw_buffer_load_b128(r, off, 0, 2)); }
__device__ __forceinline__ void peer_select(int chunk, const _Float16* __restrict__ SC, LAS char* lds, int tid, LAS int* SE, LAS float* SG) {
    LAS float* TV = (LAS float*)(lds + OFF_TV); LAS int* TI = (LAS int*)(lds + OFF_TI);
    asm volatile("" : "+v"(tid));
    const int tok0 = chunk * CH;
    const rsrc_t rSC = mk_rsrc(SC, 0x4000000u);
    __syncthreads();
    { const int tl = tid >> 4, g = tid & 15; const unsigned spo = ((unsigned)(tok0 + tl) * 2048u + (unsigned)g * 128u) * 2u;
      int tk[16];
#pragma unroll
      for (int j = 0; j < 16; ++j) tk[j] = (int)0x80000000;
#define PEER_KEY(x_, lowbits_, mask_) ({ const int f_ = __float_as_int(x_); ((f_ ^ ((f_ >> 31) & 0x7fffffff)) & ~(mask_)) | (lowbits_); })
#define PEER_INS(key_) do { int x__ = (key_); _Pragma("unroll") for (int j_ = 0; j_ < 16; ++j_) { const int hi_ = max(x__, tk[j_]); x__ = min(x__, tk[j_]); tk[j_] = hi_; } } while (0)
#pragma unroll 1
      for (int i = 0; i < 16; i += 2) { typedef _Float16 h8_t __attribute__((ext_vector_type(8)));
          const h8_t a = __builtin_bit_cast(h8_t, __builtin_amdgcn_raw_buffer_load_b128(rSC, spo + i * 16, 0, 2)), b = __builtin_bit_cast(h8_t, __builtin_amdgcn_raw_buffer_load_b128(rSC, spo + i * 16 + 16, 0, 2));
#pragma unroll
          for (int e = 0; e < 8; ++e) { PEER_INS(PEER_KEY((float)a[e], 127 - (8 * i + e), 127)); }
#pragma unroll
          for (int e = 0; e < 8; ++e) { PEER_INS(PEER_KEY((float)b[e], 127 - (8 * i + 8 + e), 127)); } }
      LAS float* tvp = TV + (tl * 16 + g) * 16; LAS int* tip = TI + (tl * 16 + g) * 16;
#pragma unroll
      for (int j = 0; j < 16; ++j) { const int k_ = tk[j] & ~127; tvp[j] = __int_as_float(k_ ^ ((k_ >> 31) & 0x7fffffff)); tip[j] = 127 - (tk[j] & 127); } }
    __syncthreads();
    asm volatile("" : "+v"(tid));
    { const int tl = tid >> 4, hh = (tid >> 1) & 7, half = tid & 1;
      const LAS float* s1 = TV + (tl * 16 + 2 * hh) * 16; const LAS float* s2 = s1 + 16; const LAS int* i1 = TI + (tl * 16 + 2 * hh) * 16; const LAS int* i2 = i1 + 16;
      float b2[16];
#pragma unroll
      for (int j = 0; j < 16; ++j) b2[j] = s2[j];
      int tk[16];
#pragma unroll
      for (int j = 0; j < 16; ++j) tk[j] = (int)0x80000000;
#pragma unroll
      for (int ii = 0; ii < 8; ++ii) { const int i = 2 * ii + half; const float a = s1[i];
#pragma unroll
          for (int j = 0; j < 16; ++j) if ((2 * ii + 1) * (j + 1) <= 16) { if (half == 0 || (2 * ii + 2) * (j + 1) <= 16) PEER_INS(PEER_KEY(a + b2[j], 255 - (i * 16 + j), 255)); } }
      { int pk[16];
#pragma unroll
        for (int j = 0; j < 16; ++j) pk[j] = __shfl_xor(tk[j], 1);
#pragma unroll
        for (int j = 0; j < 16; ++j) PEER_INS(pk[j]); }
      if (half == 0) { float e[16], sum = 0.f; const int k0_ = tk[0] & ~255; const float v0 = __int_as_float(k0_ ^ ((k0_ >> 31) & 0x7fffffff));
#pragma unroll
        for (int j = 0; j < 16; ++j) { const int k_ = tk[j] & ~255; const float vj = __int_as_float(k_ ^ ((k_ >> 31) & 0x7fffffff)); e[j] = __builtin_amdgcn_exp2f((vj - v0) * 1.4426950408889634f); sum += e[j]; }
        const float inv = 1.0f / sum;
#pragma unroll
        for (int j = 0; j < 16; ++j) { const int ci = 255 - (tk[j] & 255); SE[tl * 128 + hh * 16 + j] = i1[ci >> 4] * 128 + i2[ci & 15]; SG[tl * 128 + hh * 16 + j] = e[j] * inv; } } }
#undef PEER_KEY
#undef PEER_INS
    __syncthreads();
}
__device__ __forceinline__ void peer_gather(int chunk, const bf16_t* __restrict__ H2, const unsigned char* __restrict__ U,
                                            const float* __restrict__ g2, const float* __restrict__ gf, float* OUT, int tid, const LAS int* SE, const LAS float* SG) {
    asm volatile("" : "+v"(tid));
    const int tok0 = chunk * CH, lane = tid & 63, wave = tid >> 6;
    const rsrc_t rH2 = mk_rsrc(H2, 0x4000000u), rU = mk_rsrc(U, 0x3000000u), rG2 = mk_rsrc(g2, 8192u), rGF = mk_rsrc(gf, 8192u);
#pragma unroll 1
    for (int tt = 0; tt < CH / NWAVES; ++tt) { const int tl = wave * (CH / NWAVES) + tt, tok = tok0 + tl;
      asm volatile("" ::: "memory");
      float hn[32], acc[32]; float ss = 0.f;
#pragma unroll
      for (int j = 0; j < 2; ++j)
#pragma unroll
          for (int q = 0; q < 4; ++q) { const u32x2 w = ldb64(rH2, ((unsigned)tok * 2048u + 256u * (4 * j + q) + 4u * lane) * 2u);
              const f32x4 a = (f32x4){__uint_as_float(w.x << 16), __uint_as_float(w.x & 0xffff0000u), __uint_as_float(w.y << 16), __uint_as_float(w.y & 0xffff0000u)};
#pragma unroll
              for (int i = 0; i < 4; ++i) { hn[16 * j + 4 * q + i] = a[i]; ss += a[i] * a[i]; } }
      const float rstd = 1.0f / sqrtf(wave_sum(ss) * (1.f / 2048.f) + NORM_EPS);
#pragma unroll
      for (int j = 0; j < 2; ++j)
#pragma unroll
          for (int q = 0; q < 4; ++q) { const f32x4 a = ldf128(rG2, (256u * (4 * j + q) + 4u * lane) * 4u);
#pragma unroll
              for (int i = 0; i < 4; ++i) hn[16 * j + 4 * q + i] *= rstd * a[i]; }
#pragma unroll
      for (int i = 0; i < 32; ++i) acc[i] = 0.f;
#define NX 4
#define PEER_LOAD(S, kb) do { _Pragma("unroll") for (int x = 0; x < NX; ++x) { const unsigned o = (unsigned)SE[tl * 128 + (kb) + x] * 3072u; \
          S##ua[x] = ldb128(rU, o + (unsigned)lane * 16u); S##ub[x] = ldb64(rU, o + 1024u + (unsigned)lane * 8u); S##va[x] = ldb128(rU, o + 1536u + (unsigned)lane * 16u); S##vb[x] = ldb64(rU, o + 2560u + (unsigned)lane * 8u); } } while (0)
#define PEER_DEC(A, B) ({ v32f_t r_ = __builtin_amdgcn_cvt_scalef32_pk32_f32_fp6((v6u_t){A.x, A.y, A.z, A.w, B.x, B.y}, 1.0f); asm volatile("s_nop 1" : "+v"(r_)); r_; })
#define PEER_COMPUTE(S, kb) do { float d[NX]; \
          _Pragma("unroll") for (int x = 0; x < NX; ++x) { const v32f_t r = PEER_DEC(S##ua[x], S##ub[x]); float dd = 0.f; \
              _Pragma("unroll") for (int i = 0; i < 32; ++i) fmac1(dd, hn[i], r[i]); \
              d[x] = dd; } \
          _Pragma("unroll") for (int o = 1; o < 64; o <<= 1) { _Pragma("unroll") for (int x = 0; x < NX; ++x) d[x] += __shfl_xor(d[x], o); } \
          float c[NX]; \
          _Pragma("unroll") for (int x = 0; x < NX; ++x) c[x] = SG[tl * 128 + (kb) + x] * gelu_tanh(d[x] * (1.f / 64.f)) * 0.25f; \
          _Pragma("unroll") for (int x = 0; x < NX; ++x) { const v32f_t r = PEER_DEC(S##va[x], S##vb[x]); \
              _Pragma("unroll") for (int i = 0; i < 32; ++i) fmac1(acc[i], c[x], r[i]); } } while (0)
      { u32x4 Aua[NX], Ava[NX], Bua[NX], Bva[NX]; u32x2 Aub[NX], Avb[NX], Bub[NX], Bvb[NX];
        PEER_LOAD(A, 0);
#pragma unroll 1
        for (int k = 0; k < 128; k += 2 * NX) {
            PEER_LOAD(B, k + NX); PEER_COMPUTE(A, k);
            { const int kn = min(k + 2 * NX, 128 - NX); PEER_LOAD(A, kn); }
            PEER_COMPUTE(B, k + NX);
        } }
#undef PEER_DEC
#undef NX
#undef PEER_LOAD
#undef PEER_COMPUTE
      asm volatile("" ::: "memory");
      int tok2 = tok, lane2 = lane; asm volatile("" : "+v"(tok2), "+v"(lane2));
      float s2 = 0.f;
#pragma unroll
      for (int j = 0; j < 2; ++j)
#pragma unroll
          for (int q = 0; q < 4; ++q) { const u32x2 w = ldb64(rH2, ((unsigned)tok2 * 2048u + 256u * (4 * j + q) + 4u * lane2) * 2u);
              const f32x4 a = (f32x4){__uint_as_float(w.x << 16), __uint_as_float(w.x & 0xffff0000u), __uint_as_float(w.y << 16), __uint_as_float(w.y & 0xffff0000u)};
#pragma unroll
              for (int i = 0; i < 4; ++i) { acc[16 * j + 4 * q + i] += a[i]; s2 += acc[16 * j + 4 * q + i] * acc[16 * j + 4 * q + i]; } }
      const float rf = 1.0f / sqrtf(wave_sum(s2) * (1.f / 2048.f) + NORM_EPS);
#pragma unroll
      for (int j = 0; j < 2; ++j)
#pragma unroll
          for (int q = 0; q < 4; ++q) { const f32x4 a = ldf128(rGF, (256u * (4 * j + q) + 4u * lane2) * 4u); f32x4 oa;
#pragma unroll
              for (int i = 0; i < 4; ++i) oa[i] = acc[16 * j + 4 * q + i] * rf * a[i];
              float* op = OUT + (size_t)tok2 * 2048 + 256 * (4 * j + q) + 4 * lane2;
              __builtin_nontemporal_store(oa, (GAS f32x4*)op); }
    }
}
}
#ifndef MK_N_LAUNCHES
#define MK_N_LAUNCHES 1
#endif
#define MK_PROBE_PH -1
#define MK_PROBE_DIV 2
constexpr int N_PHASES = 9;
constexpr int N_LAUNCHES = MK_N_LAUNCHES;
struct Args { const float* in[19]; float* out; unsigned char* ws; int ph_lo, ph_hi; };
static_assert(sizeof(Args) == 19 * 8 + 8 + 8 + 8, "no padding");

__global__ void __launch_bounds__(NWAVES * 64, 2) hybrid_fwd(Args args) {
    extern __shared__ __attribute__((aligned(16))) unsigned char lds_raw[];
    Frame F;
    F.lds = (LAS unsigned char*)lds_raw;
    F.MISC = (volatile LAS unsigned*)(F.lds + MISC_OFF);
    F.tid = threadIdx.x; F.lane = F.tid & 63; F.wave = __builtin_amdgcn_readfirstlane(F.tid >> 6);
    F.G = gridDim.x; { const int bx = blockIdx.x; F.vcu = (F.G % 8 == 0) ? (bx % 8) * (F.G / 8) + bx / 8 : bx; }
    F.ws = args.ws; F.out = args.out;
#pragma unroll
    for (int i = 0; i < 19; ++i) F.in[i] = args.in[i];
    for (int u = F.tid; u < (LDS_BYTES - LDSCTL_OFF) / 4; u += NWAVES * 64) ((LAS unsigned*)(F.lds + LDSCTL_OFF))[u] = 0u;
    __syncthreads();
    XcdBarrier bar; bar.bar = (unsigned*)(F.ws + WS_CTL) + CW_BAR; bar.x = 0; bar.st = nullptr;
    if (N_LAUNCHES == 1) bar = xcd_barrier_post((unsigned*)(F.ws + WS_CTL) + CW_BAR, F.MISC + 8);
    const int lo = args.ph_lo, hi = args.ph_hi;
#define IN(k) (lo <= (k) && (k) < hi)
#if MK_PROBE_PH >= 0
    unsigned long long tp0 = (MK_PROBE_PH == 0 || MK_PROBE_PH == 9) ? __builtin_amdgcn_s_memrealtime() : 0ull, tp1 = 0ull;
#define SEAM(k) do { if (IN(k) && IN((k) + 1)) xcd_barrier(bar); if (MK_PROBE_PH == (k)) tp1 = __builtin_amdgcn_s_memrealtime(); if (MK_PROBE_PH == (k) + 1) tp0 = __builtin_amdgcn_s_memrealtime(); } while (0)
#else
#define SEAM(k) do { if (IN(k) && IN((k) + 1)) xcd_barrier(bar); } while (0)
#endif
    const size_t T2048 = (size_t)256 * 2048 * 2, T1024 = (size_t)256 * 1024 * 2, T512 = (size_t)256 * 512 * 2;
    float* cosT = WSP(float, WS_COS); float* sinT = WSP(float, WS_SIN);
    float* ssq_q = WSP(float, WS_SSQ_Q); float* ssq_kv = WSP(float, WS_SSQ_KV); float* ssq2 = WSP(float, WS_SSQ_2);

    if (IN(0)) { p0_prologue<0>(F, F.vcu, F.G); } SEAM(0);
    if (IN(1)) {
        SchedP1 S{F.G, (int)blockIdx.x, (const char*)(F.ws + WS_HN1), (const char*)(F.ws + WS_WIN), (const char*)(F.ws + WS_WVT), T1024};
        EpiP1 E{WSP(bf16_t, WS_NAQ), WSP(bf16_t, WS_NAK), WSP(bf16_t, WS_VT), WSP(unsigned char, WS_CQ), WSP(unsigned char, WS_CKV), WSP(bf16_t, WS_KR), WSP(bf16_t, WS_GA), WSP(bf16_t, WS_GB), ssq_q, ssq_kv, cosT, sinT};
        pg8::gemm_phase<EpiP1, SchedP1, true, -6>(F.lds, 2048, S, E);
        { const int extra = P1_UNITS % F.G, bx = (int)blockIdx.x; if (extra != 0 && bx >= extra) p0_prologue<1>(F, bx - extra, F.G - extra); else if (extra == 0) p0_prologue<1>(F, bx, F.G); }
    } SEAM(1);
    if (IN(2)) {
        LAS float* relb = (LAS float*)F.lds + 64; LAS float* metab = relb + 16 * 15 * 31 + 128; LAS float* wsf = metab + 256 + F.wave * 64;
        for (int i = F.tid; i < 16 * 15 * 31; i += NWAVES * 64) relb[i] = F.in[4][i];
        if (F.tid < 256) metab[F.tid] = F.in[5][F.tid];
        __syncthreads();
        const int gw = F.vcu * NWAVES + F.wave, NGW = F.G * NWAVES;
        for (int task = gw; task < NBATCH * 16 * 32 * 2; task += NGW)
            att::na_task(task, WSP(bf16_t, WS_NAQ), WSP(bf16_t, WS_NAK), WSP(bf16_t, WS_VT), WSP(unsigned char, WS_ONA), relb, metab, wsf, F.lane);
        __syncthreads();
    } SEAM(2);
    if (IN(3)) {
        SchedP3 S{F.G, (int)blockIdx.x, (const char*)(F.ws + WS_CQ), (const char*)(F.ws + WS_CKV), (const char*)(F.ws + WS_WUQ), (const char*)(F.ws + WS_WUKV), T512 / 2};
        EpiP3 E{WSP(bf16_t, WS_QM), WSP(bf16_t, WS_KN), WSP(bf16_t, WS_VV), ssq_q, ssq_kv, cosT, sinT};
        pg8::gemm_phase<EpiP3, SchedP3, true, -4>(F.lds, 512, S, E);
    } SEAM(3);
    if (IN(4)) {
        for (int id = F.vcu; id < NBATCH * 16 * 8; id += F.G) { const int bh = id >> 3, qb = id & 7;
            att::mla_unit(bh >> 4, bh & 15, qb, WSP(bf16_t, WS_QM), WSP(bf16_t, WS_KN), WSP(bf16_t, WS_KR), WSP(bf16_t, WS_VV), WSP(unsigned char, WS_OMLA), (LAS char*)F.lds); }
        __syncthreads();
    } SEAM(4);
    if (IN(5)) {
        { SchedGrid S{F.G, (int)blockIdx.x, 64, 8, (const char*)(F.ws + WS_ONA), (const char*)(F.ws + WS_WNA), T512};
          EpiP5a E{WSP(bf16_t, WS_GA), WSP(bf16_t, WS_T1)};
          pg8::gemm_phase<EpiP5a, SchedGrid, true, -9>(F.lds, 1024, S, E); }
        { SchedGrid S{F.G, (int)blockIdx.x, 64, 8, (const char*)(F.ws + WS_OMLA), (const char*)(F.ws + WS_WMLA), T1024};
          EpiP5b E{WSP(bf16_t, WS_GB), WSP(bf16_t, WS_T1), WSP(unsigned char, WS_MERGED)};
          pg8::gemm_phase<EpiP5b, SchedGrid, true, -11>(F.lds, 2048, S, E); }
    } SEAM(5);
    if (IN(6)) {
        { SchedGrid S{F.G, (int)blockIdx.x, 64, 8, (const char*)(F.ws + WS_MERGED), (const char*)(F.ws + WS_WOUT), T1024};
          EpiP6 E{F.in[0], WSP(bf16_t, WS_H2B), ssq2};
          pg8::gemm_phase<EpiP6, SchedGrid, true, -11>(F.lds, 2048, S, E); }
        {
#define P6_SRC(i_) (((i_) >> 20 ? F.in[17] : F.in[16]) + (size_t)(((i_) >> 6) & 16383u) * 2048 + 4 * ((i_) & 63u))
          const unsigned NTOT = 2u * 16384u * 64u, STEP = (unsigned)F.G * 512u; unsigned i = (unsigned)F.vcu * 512u + F.tid;
          f32x4 xc[8];
          if (i < NTOT) { const float* src = P6_SRC(i);
#pragma unroll
              for (int q = 0; q < 8; ++q) xc[q] = *(const GAS f32x4*)(src + 256 * q); }
          while (i < NTOT) { const unsigned in_ = i + STEP; f32x4 xn[8];
              { const float* src = P6_SRC(in_ < NTOT ? in_ : i);
#pragma unroll
                for (int q = 0; q < 8; ++q) xn[q] = *(const GAS f32x4*)(src + 256 * q); }
              const unsigned isv = i >> 20, row = (i >> 6) & 16383u, l = i & 63u; const float sc = isv ? 4.f : 64.f; peer::v16f_t a, b;
#pragma unroll
              for (int q = 0; q < 8; ++q)
#pragma unroll
                  for (int e = 0; e < 4; ++e) { const int k_ = 4 * q + e;
                      if (k_ & 1) b[k_ >> 1] = xc[q][e] * sc; else a[k_ >> 1] = xc[q][e] * sc; }
              const peer::v6u_t w = __builtin_amdgcn_cvt_scalef32_2xpk16_fp6_f32(a, b, 1.0f);
              unsigned char* rec = WSP(unsigned char, WS_U) + (size_t)row * 3072 + (isv ? 1536 : 0);
              *(GAS u32x4*)(rec + l * 16) = (u32x4){w[0], w[1], w[2], w[3]}; *(GAS u32x2*)(rec + 1024 + l * 8) = (u32x2){w[4], w[5]};
#pragma unroll
              for (int q = 0; q < 8; ++q) xc[q] = xn[q];
              i = in_; }
#undef P6_SRC
        }
    } SEAM(6);
    if (IN(7)) {
        SchedGrid S{F.G, (int)blockIdx.x, 64, 8, (const char*)(F.ws + WS_H2B), (const char*)(F.ws + WS_WSC), T2048};
        EpiP7 E{ssq2, WSP(_Float16, WS_SC)};
        pg8::gemm_phase<EpiP7, SchedGrid>(F.lds, 2048, S, E);
    } SEAM(7);
    if (IN(8)) {
        const int nch = (MREAL / peer::CH - F.vcu + F.G - 1) / F.G; const bool both_first = (nch == 2) && (F.vcu & 1);
        for (int op = 0; op < 2 * nch; ++op) {
            const bool sel = both_first ? (op < 2) : !(op & 1); const int ci = both_first ? (op & 1) : (op >> 1), chunk = F.vcu + ci * F.G;
            const int b2 = both_first ? ci : 0;
            LAS int* SE = (LAS int*)(F.lds + (b2 ? peer::OFF_SE2 : peer::OFF_SE)); LAS float* SG = (LAS float*)(F.lds + (b2 ? peer::OFF_SG2 : peer::OFF_SG));
            if (sel) peer::peer_select(chunk, WSP(_Float16, WS_SC), (LAS char*)F.lds, F.tid, SE, SG);
            else peer::peer_gather(chunk, WSP(bf16_t, WS_H2B), WSP(unsigned char, WS_U), F.in[13], F.in[18], F.out, F.tid, SE, SG); }
    }
#if MK_PROBE_PH >= 0
    xcd_barrier(bar); tp1 = (MK_PROBE_PH >= 8) ? __builtin_amdgcn_s_memrealtime() : tp1;
    if (blockIdx.x == 0 && F.tid == 0) F.out[0] = (float)(tp1 - tp0) * (0.01f / MK_PROBE_DIV);
#endif
#undef IN
#undef SEAM
}

extern "C" void kernel_launch(void* const* d_in, const int* in_sizes, int n_in, void* d_out, int out_size, void* d_ws, size_t ws_size, hipStream_t stream) {
    static int grid = 0;
    if (grid == 0) {
        if (n_in != 19 || in_sizes[0] != MREAL * DM || out_size != MREAL * DM || ws_size < WS_END) {
            fprintf(stderr, "kernel_launch: shape/workspace mismatch: n_in %d in0 %d out %d ws %zu (need %zu); nothing launched\n", n_in, n_in > 0 ? in_sizes[0] : -1, out_size, ws_size, (size_t)WS_END); grid = -1; return; }
        int dev = 0, cus = 0, per_cu = 0;
        if (hipGetDevice(&dev) != hipSuccess || hipDeviceGetAttribute(&cus, hipDeviceAttributeMultiprocessorCount, dev) != hipSuccess) { fprintf(stderr, "kernel_launch: device query failed\n"); grid = -1; return; }
        if (hipFuncSetAttribute((const void*)hybrid_fwd, hipFuncAttributeMaxDynamicSharedMemorySize, LDS_BYTES) != hipSuccess) { fprintf(stderr, "kernel_launch: hipFuncSetAttribute failed\n"); grid = -1; return; }
        if (hipOccupancyMaxActiveBlocksPerMultiprocessor(&per_cu, (const void*)hybrid_fwd, NWAVES * 64, LDS_BYTES) != hipSuccess || per_cu < 1)
            fprintf(stderr, "kernel_launch: note: occupancy query reports %d workgroups per CU\n", per_cu);
        (void)hipGetLastError();
        grid = cus;
    }
    if (grid < 0) return;
    if (hipMemsetAsync((char*)d_ws + WS_CTL, 0, CTL_ZERO_BYTES, stream) != hipSuccess) { fprintf(stderr, "kernel_launch: hipMemsetAsync failed\n"); return; }
    Args a{};
    for (int i = 0; i < 19; ++i) a.in[i] = (const float*)d_in[i];
    a.out = (float*)d_out; a.ws = (unsigned char*)d_ws;
    for (int li = 0; li < N_LAUNCHES; ++li) {
        a.ph_lo = (N_LAUNCHES == 1) ? 0 : li; a.ph_hi = (N_LAUNCHES == 1) ? N_PHASES : li + 1;
        hipLaunchKernelGGL(hybrid_fwd, dim3(grid), dim3(NWAVES * 64), LDS_BYTES, stream, a);
        const hipError_t le = hipPeekAtLastError();
        if (le != hipSuccess) { fprintf(stderr, "kernel_launch: launch %d failed: %s\n", li, hipGetErrorName(le)); break; }
    }
}
```

```cpp
#include <hip/hip_runtime.h>
#include <cstdio>
#include <cstdint>

#define LAS __attribute__((address_space(3)))
#define GAS __attribute__((address_space(1)))
typedef unsigned short bf16_t;
typedef short bf16x8 __attribute__((ext_vector_type(8)));
typedef short s16x4 __attribute__((ext_vector_type(4)));
typedef float f32x4 __attribute__((ext_vector_type(4)));
typedef float f32x2 __attribute__((ext_vector_type(2)));
typedef float f32x16 __attribute__((ext_vector_type(16)));
typedef unsigned u32x4 __attribute__((ext_vector_type(4)));
typedef unsigned u32x2 __attribute__((ext_vector_type(2)));

constexpr int DM = 2048, NBATCH = 8, SEQ = 2048, NMETA = 16;
constexpr int MREAL = NBATCH * SEQ;
constexpr int MPAD = MREAL + 256;
constexpr int NPOS = SEQ + NMETA;
constexpr float NORM_EPS = 1e-6f;
constexpr int C_NAQ = 0, C_NAK = 1024, C_CQ = 2048, C_CKV = 2560, C_GA = 3072, C_GB = 5120, C_KR = 7168, NMAIN = 7424;
constexpr int VT_PITCH = MPAD;

constexpr size_t MiB = 1u << 20;
constexpr size_t WS_CTL = 0, CTL_ZERO_BYTES = 1 * MiB;
constexpr size_t WS_SSQ_Q = 481 * MiB, WS_SSQ_KV = 482 * MiB, WS_SSQ_2 = 486 * MiB;
constexpr size_t WS_COS = 1 * MiB, WS_SIN = 1 * MiB + 512 * 1024;
constexpr size_t WS_WUQ = 2 * MiB, WS_WUKV = 5 * MiB, WS_WNA = 9 * MiB, WS_WMLA = 13 * MiB, WS_WOUT = 21 * MiB, WS_WSC = 29 * MiB;
constexpr size_t WS_GA = 37 * MiB, WS_GB = 101 * MiB;
constexpr size_t WS_KR = 165 * MiB;
constexpr size_t WS_WIN = 167 * MiB + 256 * 1024, WS_WVT = WS_WIN + 29 * MiB;
constexpr size_t WS_ONA = 190 * MiB;
constexpr size_t WS_NAQ = 222 * MiB, WS_NAK = 254 * MiB, WS_VT = WS_NAK + 32 * MiB + 512 * 1024;
constexpr size_t WS_HN1 = 319 * MiB;
constexpr size_t WS_CQ = 448 * MiB, WS_CKV = 464 * MiB;
constexpr size_t WS_QM = 222 * MiB, WS_KN = 318 * MiB, WS_VV = 383 * MiB;
constexpr size_t WS_OMLA = 448 * MiB;
constexpr size_t WS_MERGED = 222 * MiB, WS_T1 = 286 * MiB;
constexpr size_t WS_H2 = 37 * MiB, WS_H2B = 293 * MiB;
constexpr size_t WS_U = 357 * MiB, WS_V = 421 * MiB;
constexpr size_t WS_SC = 165 * MiB;
constexpr size_t WS_END = 512 * MiB;
static_assert(WS_CKV + (size_t)MPAD * 512 * 2 <= WS_SSQ_Q && WS_SSQ_Q + (size_t)8 * MPAD * 4 <= WS_SSQ_KV && WS_SSQ_KV + (size_t)8 * MPAD * 4 <= 483 * MiB && WS_V + 64 * MiB <= WS_SSQ_2 && WS_SSQ_2 + (size_t)32 * MREAL * 4 <= WS_END, "ssq slabs");
static_assert(WS_VT + (size_t)1024 * MPAD * 2 <= WS_HN1 && WS_HN1 + (size_t)MPAD * 2048 * 2 <= WS_CQ && WS_CKV + (size_t)MPAD * 512 * 2 <= WS_END, "map P1");
static_assert(WS_WVT + 4 * MiB <= WS_NAQ && WS_KR + (size_t)MPAD * 64 * 2 <= WS_WIN && WS_ONA + 32 * MiB <= WS_NAQ, "map P1b");
static_assert(WS_QM + 96 * MiB <= WS_KN && WS_KN + 65 * MiB <= WS_VV && WS_VV + 65 * MiB <= WS_OMLA && WS_OMLA + 64 * MiB <= WS_END, "map P3");
static_assert(WS_T1 + 128 * MiB <= WS_OMLA && WS_H2 + 128 * MiB <= WS_KR && WS_SC + 128 * MiB <= WS_H2B && WS_H2B + 64 * MiB <= WS_U && WS_V + 64 * MiB <= WS_END, "map P5+");

constexpr int CW_BAR = 4096;

constexpr int RING_BYTES = 131072;
constexpr int LDSCTL_OFF = RING_BYTES, MISC_OFF = LDSCTL_OFF + 320;
constexpr int LDS_BYTES = 147456;
constexpr int NWAVES = 8;

#define LDS_WAIT() asm volatile("s_waitcnt lgkmcnt(0)" ::: "memory")
#define VM_WAIT() asm volatile("s_waitcnt vmcnt(0)" ::: "memory")
#define SBAR() __builtin_amdgcn_sched_barrier(0)
typedef __bf16 bf16x2_t __attribute__((ext_vector_type(2)));
__device__ __forceinline__ unsigned cvt_pk_bf16(float lo, float hi) { const f32x2 v = {lo, hi}; const bf16x2_t b = __builtin_convertvector(v, bf16x2_t); return __builtin_bit_cast(unsigned, b); }
__device__ __forceinline__ float bf_lo(unsigned w) { return __uint_as_float(w << 16); }
__device__ __forceinline__ float bf_hi(unsigned w) { return __uint_as_float(w & 0xffff0000u); }
__device__ __forceinline__ u32x4 pack8(const f32x4 a, const f32x4 b) { u32x4 w; w.x = cvt_pk_bf16(a[0], a[1]); w.y = cvt_pk_bf16(a[2], a[3]); w.z = cvt_pk_bf16(b[0], b[1]); w.w = cvt_pk_bf16(b[2], b[3]); return w; }
__device__ __forceinline__ u32x2 pack8_fp8(f32x4 a, f32x4 b) {
#pragma unroll
    for (int i = 0; i < 4; ++i) { a[i] = __builtin_fminf(__builtin_fmaxf(a[i], -448.f), 448.f); b[i] = __builtin_fminf(__builtin_fmaxf(b[i], -448.f), 448.f); }
    int w0 = 0, w1 = 0; w0 = __builtin_amdgcn_cvt_pk_fp8_f32(a[0], a[1], w0, false); w0 = __builtin_amdgcn_cvt_pk_fp8_f32(a[2], a[3], w0, true);
    w1 = __builtin_amdgcn_cvt_pk_fp8_f32(b[0], b[1], w1, false); w1 = __builtin_amdgcn_cvt_pk_fp8_f32(b[2], b[3], w1, true); return (u32x2){(unsigned)w0, (unsigned)w1}; }
__device__ __forceinline__ unsigned char f32_to_fp8(float x) { x = __builtin_fminf(__builtin_fmaxf(x, -448.f), 448.f); return (unsigned char)(__builtin_amdgcn_cvt_pk_fp8_f32(x, 0.f, 0, false) & 0xff); }
__device__ __forceinline__ u32x2 pack8_u8(const f32x4 a, const f32x4 b) { u32x2 w; unsigned x = 0u, y = 0u;
    x = __builtin_amdgcn_cvt_pk_u8_f32(a[0] * 255.f, 0u, x); x = __builtin_amdgcn_cvt_pk_u8_f32(a[1] * 255.f, 1u, x); x = __builtin_amdgcn_cvt_pk_u8_f32(a[2] * 255.f, 2u, x); x = __builtin_amdgcn_cvt_pk_u8_f32(a[3] * 255.f, 3u, x);
    y = __builtin_amdgcn_cvt_pk_u8_f32(b[0] * 255.f, 0u, y); y = __builtin_amdgcn_cvt_pk_u8_f32(b[1] * 255.f, 1u, y); y = __builtin_amdgcn_cvt_pk_u8_f32(b[2] * 255.f, 2u, y); y = __builtin_amdgcn_cvt_pk_u8_f32(b[3] * 255.f, 3u, y);
    w.x = x; w.y = y; return w; }
__device__ __forceinline__ void unpack8_u8(const u32x2 w, f32x4& a, f32x4& b) { const float k = 1.f / 255.f;
    a = (f32x4){(float)(w.x & 0xffu), (float)((w.x >> 8) & 0xffu), (float)((w.x >> 16) & 0xffu), (float)(w.x >> 24)} * k;
    b = (f32x4){(float)(w.y & 0xffu), (float)((w.y >> 8) & 0xffu), (float)((w.y >> 16) & 0xffu), (float)(w.y >> 24)} * k; }
__device__ __forceinline__ u32x2 pack4(const f32x4 a) { u32x2 w; w.x = cvt_pk_bf16(a[0], a[1]); w.y = cvt_pk_bf16(a[2], a[3]); return w; }
__device__ __forceinline__ float wave_sum(float v) {
#pragma unroll
    for (int o = 1; o < 64; o <<= 1) v += __shfl_xor(v, o);
    return v;
}
__device__ __forceinline__ float sigmoidf_(float x) { return __builtin_amdgcn_rcpf(1.0f + __builtin_amdgcn_exp2f(-1.4426950408889634f * x)); }
__device__ __forceinline__ int crow(int r, int hi) { return (r & 3) + 8 * (r >> 2) + 4 * hi; }
#define PG8_AUX 0
namespace pg8 {
constexpr int BM = 256, BK = 64, HALF = 128, HTB = HALF * BK * 2  , STAGE_BYTES = 8 * HTB, NXCD = 8, WGM = 8;
__host__ __device__ __forceinline__ int lds_byte(int r, int c) { const int st = (r >> 4) * 2 + (c >> 5), rr = r & 15, cc = c & 31, ob = rr * 64 + cc * 2; return st * 1024 + (ob ^ (((ob >> 9) & 1) << 5)); }
__host__ __device__ __forceinline__ void stage_rc(int b, int& R, int& C) { const int st = b / 1024, sb = b % 1024, swz = sb ^ (((sb >> 9) & 1) << 5); R = (st >> 1) * 16 + swz / 64; C = (st & 1) * 32 + (swz % 64) / 2; }
__host__ __device__ __forceinline__ int perm32(int rho) { const int n = rho >> 4, i = rho & 15; return 8 * (i >> 2) + 4 * n + (i & 3); }

struct Unit { int pm, pn, kind; };

__device__ __forceinline__ void grid_order(int L, int nM, int nN, int& pm, int& pn) {
    const int nwg = nM * nN; int wgid = L;
    { const int q = nwg / NXCD, r = nwg % NXCD, xcd = wgid % NXCD, off = wgid / NXCD; wgid = (xcd < r ? xcd * (q + 1) : r * (q + 1) + (xcd - r) * q) + off; }
    const int nig = WGM * nN, gid = wgid / nig, fm = gid * WGM, gsz = (nM - fm) < WGM ? (nM - fm) : WGM;
    pm = fm + ((wgid % nig) % gsz); pn = (wgid % nig) / gsz;
}

typedef int v8i_t __attribute__((ext_vector_type(8)));
template <class Epi, class Sched, bool F8 = false, int F8_SCALE_EXP = 0>
__device__ __forceinline__ void gemm_phase(LAS unsigned char* lds, const int K, const Sched& S, const Epi& E) {
    const int tid = threadIdx.x, wid = __builtin_amdgcn_readfirstlane(tid >> 6), lane = tid & 63, wr = wid >> 2, wc = wid & 3, fr = lane & 15, fq = lane >> 4;
    int f8sa = 0x01010101 * (127 + F8_SCALE_EXP), f8sb = 0x7f7f7f7f; asm volatile("" : "+v"(f8sa), "+v"(f8sb));
    const int Kb = F8 ? K : 2 * K;
    const int nt = Kb / 128;
    unsigned voffA[2], voffB[2];
#pragma unroll
    for (int i = 0; i < 2; ++i) { int R, C; stage_rc(tid * 16 + i * 8192, R, C); const int Rb = Epi::PERM ? ((R & ~31) + perm32(R & 31)) : R;
        voffA[i] = (unsigned)(R * Kb + C * 2); voffB[i] = (unsigned)(Rb * Kb + C * 2); }
    const size_t kstep = (size_t)128;
    const size_t hstep = (size_t)HALF * Kb;
    const unsigned ldsw = (unsigned)wid * 1024u;
    const int aoff = lds_byte(wr * 64 + fr, F8 ? fq * 16 : fq * 8), boff = lds_byte(wc * 32 + fr, F8 ? fq * 16 : fq * 8);
#define PG8_SA(b, h) (((b) * 2 + (h)) * HTB)
#define PG8_SB(b, h) ((4 + (b) * 2 + (h)) * HTB)
#define PG8_STAGE(bufoff, gbase, voff) do { _Pragma("unroll") for (int _i = 0; _i < 2; ++_i) \
        __builtin_amdgcn_global_load_lds((const unsigned*)((const char*)(gbase) + (voff)[_i]), (LAS unsigned*)(lds + (bufoff) + ldsw + _i * 8192), 16, 0, PG8_AUX); } while (0)
#define PG8_LDA(dst, b, h) do { _Pragma("unroll") for (int m = 0; m < 4; ++m) _Pragma("unroll") for (int k = 0; k < 2; ++k) dst[m][k] = *(const LAS bf16x8*)(lds + PG8_SA(b, h) + aoff + m * 2048 + (F8 ? k * 16 : k * 1024)); } while (0)
#define PG8_LDB(dst, b, h) do { _Pragma("unroll") for (int n = 0; n < 2; ++n) _Pragma("unroll") for (int k = 0; k < 2; ++k) dst[n][k] = *(const LAS bf16x8*)(lds + PG8_SB(b, h) + boff + n * 2048 + (F8 ? k * 16 : k * 1024)); } while (0)
#define PG8_F8OP(X) __builtin_bit_cast(v8i_t, __builtin_shufflevector(X[0], X[1], 0, 1, 2, 3, 4, 5, 6, 7, 8, 9, 10, 11, 12, 13, 14, 15))
#define PG8_MMA(ai, bj, At, Bt) do { __builtin_amdgcn_s_setprio(1); \
        if constexpr (F8) { _Pragma("unroll") for (int m = 0; m < 4; ++m) _Pragma("unroll") for (int n = 0; n < 2; ++n) \
            asm volatile("v_mfma_scale_f32_16x16x128_f8f6f4 %0, %1, %2, %0, %3, %4 op_sel_hi:[0,0,0]" : "+v"(acc[ai][bj][m][n]) : "v"(PG8_F8OP(Bt[n])), "v"(PG8_F8OP(At[m])), "v"(f8sa), "v"(f8sb)); } \
        else { _Pragma("unroll") for (int m = 0; m < 4; ++m) _Pragma("unroll") for (int n = 0; n < 2; ++n) _Pragma("unroll") for (int k = 0; k < 2; ++k) \
            acc[ai][bj][m][n] = __builtin_amdgcn_mfma_f32_16x16x32_bf16(Bt[n][k], At[m][k], acc[ai][bj][m][n], 0, 0, 0); } \
        __builtin_amdgcn_s_setprio(0); } while (0)
#define PG8_WAIT_V(n) asm volatile("s_waitcnt vmcnt(" #n ")" ::: "memory")
#define PG8_WAIT_L(n) asm volatile("s_waitcnt lgkmcnt(" #n ")" ::: "memory")
#define PG8_BAR __builtin_amdgcn_s_barrier()
#define PG8_SCHED __builtin_amdgcn_sched_barrier(0)
    Unit cur, nxt; int ui = 0;
    if (!S.next(0, cur)) return;
    f32x4 acc[2][2][4][2];
#pragma unroll
    for (int a = 0; a < 2; ++a)
#pragma unroll
        for (int b = 0; b < 2; ++b)
#pragma unroll
            for (int m = 0; m < 4; ++m)
#pragma unroll
                for (int n = 0; n < 2; ++n) acc[a][b][m][n] = (f32x4){0.f, 0.f, 0.f, 0.f};
    bf16x8 At[4][2], B0[2][2], B1[2][2];
    const char* cA = S.pa(cur); const char* cB = S.pb(cur);
    PG8_STAGE(PG8_SB(0, 0), cB, voffB); PG8_STAGE(PG8_SB(0, 1), cB + hstep, voffB); PG8_STAGE(PG8_SA(0, 0), cA, voffA); PG8_STAGE(PG8_SA(0, 1), cA + hstep, voffA);
    if (wr == 1) PG8_BAR;
    PG8_WAIT_V(2); PG8_BAR;
    PG8_STAGE(PG8_SB(1, 0), cB + kstep, voffB); PG8_STAGE(PG8_SA(1, 0), cA + kstep, voffA); PG8_STAGE(PG8_SB(1, 1), cB + hstep + kstep, voffB);
    PG8_WAIT_V(6); PG8_BAR;
    for (;;) {
        const bool has_next = S.next(ui + 1, nxt);
        const char* nA = has_next ? S.pa(nxt) : cA; const char* nB = has_next ? S.pb(nxt) : cB;
        for (int t = 0; t < nt; t += 2) {
            const bool last = (t == nt - 2);
            const char* a1 = cA + (size_t)(t + 1) * kstep;
            const char* a2 = last ? nA : cA + (size_t)(t + 2) * kstep; const char* b2 = last ? nB : cB + (size_t)(t + 2) * kstep;
            const char* a3 = a2 + kstep; const char* b3 = b2 + kstep;
            PG8_LDB(B0, 0, 0); PG8_LDB(B1, 0, 1); PG8_SCHED; PG8_LDA(At, 0, 0); PG8_STAGE(PG8_SA(1, 1), a1 + hstep, voffA);
            PG8_WAIT_V(8); PG8_WAIT_L(0); PG8_BAR; PG8_MMA(0, 0, At, B0); PG8_MMA(0, 1, At, B1); PG8_BAR; PG8_SCHED;
            PG8_LDA(At, 0, 1); PG8_STAGE(PG8_SB(0, 0), b2, voffB); PG8_STAGE(PG8_SB(0, 1), b2 + hstep, voffB); PG8_STAGE(PG8_SA(0, 0), a2, voffA);
            PG8_WAIT_V(8); PG8_WAIT_L(0); PG8_BAR; PG8_MMA(1, 0, At, B0); PG8_MMA(1, 1, At, B1); PG8_BAR; PG8_SCHED;
            PG8_LDB(B0, 1, 0); PG8_LDB(B1, 1, 1); PG8_SCHED; PG8_LDA(At, 1, 0); PG8_STAGE(PG8_SA(0, 1), a2 + hstep, voffA);
            PG8_WAIT_V(8); PG8_WAIT_L(0); PG8_BAR; PG8_MMA(0, 0, At, B0); PG8_MMA(0, 1, At, B1); PG8_BAR; PG8_SCHED;
            PG8_LDA(At, 1, 1); PG8_STAGE(PG8_SB(1, 0), b3, voffB); PG8_STAGE(PG8_SB(1, 1), b3 + hstep, voffB); PG8_STAGE(PG8_SA(1, 0), a3, voffA);
            PG8_WAIT_V(8); PG8_WAIT_L(0); PG8_BAR; PG8_MMA(1, 0, At, B0); PG8_MMA(1, 1, At, B1); PG8_BAR; PG8_SCHED;
        }
        if (wr == 0) PG8_BAR;
        if constexpr (F8) asm volatile("s_nop 15\n\ts_nop 7" ::: "memory");
        if constexpr (Epi::HAS_PRE) {
            E.pre(cur, (LAS float*)(lds + STAGE_BYTES + 1024), tid); PG8_WAIT_L(0); PG8_BAR; }
        E(acc, cur, wr, wc, fr, fq, (const LAS float*)(lds + STAGE_BYTES + 1024));
        if (!has_next) break;
#pragma unroll
        for (int a = 0; a < 2; ++a)
#pragma unroll
            for (int b = 0; b < 2; ++b)
#pragma unroll
                for (int m = 0; m < 4; ++m)
#pragma unroll
                    for (int n = 0; n < 2; ++n) acc[a][b][m][n] = (f32x4){0.f, 0.f, 0.f, 0.f};
        cur = nxt; cA = nA; cB = nB; ++ui;
        if (wr == 1) PG8_BAR;
    }
    PG8_WAIT_V(0);
    PG8_BAR;
#undef PG8_SA
#undef PG8_SB
#undef PG8_STAGE
#undef PG8_LDA
#undef PG8_LDB
#undef PG8_MMA
#undef PG8_F8OP
#undef PG8_WAIT_V
#undef PG8_WAIT_L
#undef PG8_BAR
#undef PG8_SCHED
}
}
typedef GAS unsigned gu32;
#define RLX_AGENT __ATOMIC_RELAXED, __HIP_MEMORY_SCOPE_AGENT
#define XB_TMO      128
#define XB_XCNT(j)  (256  + 64 * (j))
#define XB_XSUB(j)  (1280 + 64 * (j))
#define XB_XGEN(j)  (2304 + 64 * (j))
#define XB_TOP      3328
#define XB_TOPGEN   3392
#define XCD_BAR_WORDS 3456
#define XB_SPIN_CAP (1u << 18)
__device__ __forceinline__ unsigned xb_ld(unsigned* p)              { return __hip_atomic_load(p, __ATOMIC_RELAXED, __HIP_MEMORY_SCOPE_AGENT); }
__device__ __forceinline__ unsigned xb_add(unsigned* p, unsigned v) { return __hip_atomic_fetch_add(p, v, __ATOMIC_RELAXED, __HIP_MEMORY_SCOPE_AGENT); }
__device__ __forceinline__ unsigned xb_xcc_id() { return (unsigned)__builtin_amdgcn_s_getreg((3 << 11) | 20) & 0xFu; }
#define XB_SPIN(cond, bar) do { unsigned _sp = 0; while (cond) { __builtin_amdgcn_s_sleep(1); \
    if ((++_sp & 255u) == 0u) { if (xb_ld(&(bar)[XB_TMO])) break; if (_sp > XB_SPIN_CAP) { atomicAdd(&(bar)[XB_TMO], 1u); break; } } } } while (0)
struct XcdBarrier { unsigned* bar; unsigned x; volatile LAS unsigned* st; };
__device__ __forceinline__ XcdBarrier xcd_barrier_post(unsigned* bar, volatile LAS unsigned* st) {
    XcdBarrier b; b.bar = bar; b.x = xb_xcc_id(); b.st = st;
    if (threadIdx.x == 0) (void)xb_add(&bar[XB_XCNT(b.x)], 1u);
    return b;
}
__device__ __forceinline__ void xcd_barrier_complete(unsigned* bar, unsigned x, unsigned& nloc, unsigned& nx) {
    const unsigned G = gridDim.x * gridDim.y * gridDim.z;
    unsigned sum, cnt, mine, sp = 0u;
    for (;;) {
        sum = 0u; cnt = 0u; mine = 0u;
#pragma unroll
        for (unsigned j = 0; j < 16; ++j) { const unsigned c = xb_ld(&bar[XB_XCNT(j)]); sum += c; cnt += (c > 0u) ? 1u : 0u; mine = (j == x) ? c : mine; }
        if (sum == G) break;
        __builtin_amdgcn_s_sleep(1);
        if ((++sp & 255u) == 0u) { if (xb_ld(&bar[XB_TMO])) break; if (sp > XB_SPIN_CAP) { atomicAdd(&bar[XB_TMO], 1u); break; } }
    }
    nloc = mine > 0u ? mine : 1u; nx = cnt > 0u ? cnt : 1u;
}
__device__ __forceinline__ void xcd_barrier(const XcdBarrier& b) {
    asm volatile("s_waitcnt vmcnt(0)" ::: "memory");
    __syncthreads();
    if (threadIdx.x == 0) {
        unsigned* bar = b.bar;
        __builtin_amdgcn_s_waitcnt(0);
        unsigned nloc = b.st[0], nx = b.st[1];
        if (nloc == 0u) { xcd_barrier_complete(bar, b.x, nloc, nx); b.st[0] = nloc; b.st[1] = nx; }
        const unsigned old = xb_add(&bar[XB_XSUB(b.x)], 1u);
        const unsigned gen = old / nloc;
        if (old + 1u == (gen + 1u) * nloc) {
            __builtin_amdgcn_fence(__ATOMIC_RELEASE, "agent");
            asm volatile("s_waitcnt vmcnt(0)" ::: "memory");
            const unsigned og = xb_add(&bar[XB_TOP], 1u);
            const unsigned tg = og / nx;
            if (og + 1u == (tg + 1u) * nx) xb_add(&bar[XB_TOPGEN], 1u);
            else XB_SPIN(xb_ld(&bar[XB_TOPGEN]) == tg, bar);
            __builtin_amdgcn_fence(__ATOMIC_ACQUIRE, "agent");
            xb_add(&bar[XB_XGEN(b.x)], 1u);
            asm volatile("s_waitcnt vmcnt(0)" ::: "memory");
        } else {
            XB_SPIN(xb_ld(&bar[XB_XGEN(b.x)]) == gen, bar);
            __builtin_amdgcn_fence(__ATOMIC_ACQUIRE, "agent");
            asm volatile("s_waitcnt vmcnt(0)" ::: "memory");
        }
    }
    __syncthreads();
}
struct Frame {
    LAS unsigned char* lds;
    volatile LAS unsigned* MISC;
    unsigned char* ws;
    int tid, lane, wave;
    int vcu, G;
    const float* in[19];
    float* out;
};
#define WSP(T, off) ((T*)(F.ws + (off)))

__device__ __forceinline__ void p0_transpose_item(const float* W, int K, int N, int k0, int n0, bf16_t* WT, int drow, bool rope, const float* gain, LAS float* scr, int lane) {
    { f32x4 v[8]; float gk[8];
#pragma unroll
      for (int i = 0; i < 8; ++i) { const int kk = 8 * i + (lane >> 3); v[i] = *(const GAS f32x4*)(W + (size_t)(k0 + kk) * N + n0 + 4 * (lane & 7)); gk[i] = gain ? gain[k0 + kk] : 1.f; }
#pragma unroll
      for (int i = 0; i < 8; ++i) { const int kk = 8 * i + (lane >> 3); LAS float* d = scr + kk * 33 + 4 * (lane & 7);
#pragma unroll
          for (int e = 0; e < 4; ++e) d[e] = v[i][e] * gk[i]; } }
    LDS_WAIT(); asm volatile("" ::: "memory");
    const int c = lane & 7;
#pragma unroll
    for (int j = 0; j < 4; ++j) { const int n = (lane >> 3) + 8 * j; const LAS float* s = scr + (8 * c) * 33 + n;
        u32x4 o; o.x = cvt_pk_bf16(s[0 * 33], s[1 * 33]); o.y = cvt_pk_bf16(s[2 * 33], s[3 * 33]); o.z = cvt_pk_bf16(s[4 * 33], s[5 * 33]); o.w = cvt_pk_bf16(s[6 * 33], s[7 * 33]);
        const int dr = drow + (rope ? (8 * (n >> 2) + (n & 3)) : n);
        *(GAS u32x4*)(WT + (size_t)dr * K + k0 + 8 * c) = o; }
    LDS_WAIT(); asm volatile("" ::: "memory");
}
__device__ __forceinline__ void p0_transpose_item8(const float* W, int K, int N, int k0, int n0, unsigned char* WT, int drow, bool rope, float scale, LAS float* scr, int lane, const float* gain = nullptr) {
    { f32x4 v[8]; float gk[8];
#pragma unroll
      for (int i = 0; i < 8; ++i) { const int kk = 8 * i + (lane >> 3); v[i] = *(const GAS f32x4*)(W + (size_t)(k0 + kk) * N + n0 + 4 * (lane & 7)); gk[i] = gain ? gain[k0 + kk] * scale : scale; }
#pragma unroll
      for (int i = 0; i < 8; ++i) { const int kk = 8 * i + (lane >> 3); LAS float* d = scr + kk * 33 + 4 * (lane & 7);
#pragma unroll
          for (int e = 0; e < 4; ++e) d[e] = v[i][e] * gk[i]; } }
    LDS_WAIT(); asm volatile("" ::: "memory");
#pragma unroll
    for (int j = 0; j < 2; ++j) { const int q = lane + 64 * j, n = q >> 2, c = q & 3; const LAS float* s = scr + (16 * c) * 33 + n; u32x4 o;
#pragma unroll
        for (int d = 0; d < 4; ++d) { int w = 0; w = __builtin_amdgcn_cvt_pk_fp8_f32(s[(4 * d) * 33], s[(4 * d + 1) * 33], w, false); w = __builtin_amdgcn_cvt_pk_fp8_f32(s[(4 * d + 2) * 33], s[(4 * d + 3) * 33], w, true); o[d] = (unsigned)w; }
        const int dr = drow + (rope ? (8 * (n >> 2) + (n & 3)) : n);
        *(GAS u32x4*)(WT + (size_t)dr * K + k0 + 16 * c) = o; }
    LDS_WAIT(); asm volatile("" ::: "memory");
}
__device__ __forceinline__ void rms_row_to_fp8(const float* xrow, const float* g, unsigned char* orow, int lane) {
    const GAS f32x4* xr = (const GAS f32x4*)xrow + lane; const GAS f32x4* gr = (const GAS f32x4*)g + lane;
    f32x4 v[8]; float s = 0.f;
#pragma unroll
    for (int j = 0; j < 8; ++j) { v[j] = xr[64 * j]; s += (v[j].x * v[j].x + v[j].y * v[j].y) + (v[j].z * v[j].z + v[j].w * v[j].w); }
    const float rstd = 1.0f / sqrtf(wave_sum(s) * (1.f / DM) + NORM_EPS);
    GAS unsigned* o4 = (GAS unsigned*)orow + lane;
#pragma unroll
    for (int j = 0; j < 8; ++j) { const f32x4 y = (v[j] * rstd) * gr[64 * j]; int w = 0; w = __builtin_amdgcn_cvt_pk_fp8_f32(y[0], y[1], w, false); w = __builtin_amdgcn_cvt_pk_fp8_f32(y[2], y[3], w, true); o4[64 * j] = (unsigned)w; }
}
__device__ __forceinline__ void rms_row_to_bf16(const float* xrow, const float* g, bf16_t* orow, int lane) {
    const GAS f32x4* xr = (const GAS f32x4*)xrow + lane; const GAS f32x4* gr = (const GAS f32x4*)g + lane;
    f32x4 v[8]; float s = 0.f;
#pragma unroll
    for (int j = 0; j < 8; ++j) { v[j] = xr[64 * j]; s += (v[j].x * v[j].x + v[j].y * v[j].y) + (v[j].z * v[j].z + v[j].w * v[j].w); }
    const float rstd = 1.0f / sqrtf(wave_sum(s) * (1.f / DM) + NORM_EPS);
    GAS u32x2* o8 = (GAS u32x2*)orow + lane;
#pragma unroll
    for (int j = 0; j < 8; ++j) { const f32x4 gg = gr[64 * j]; o8[64 * j] = pack4((v[j] * rstd) * gg); }
}
template <int PART>
__device__ __forceinline__ void p0_prologue(Frame& F, int rank, int nrank) {
    LAS float* scr = (LAS float*)(F.lds + F.wave * 16384);
    const int gw = rank * NWAVES + F.wave, NGW = nrank * NWAVES, lane = F.lane; const int gt = rank * 512 + F.tid, NGT = nrank * 512;
    unsigned char* WIN = WSP(unsigned char, WS_WIN); unsigned char* WVT = WSP(unsigned char, WS_WVT);
    constexpr int I_IN = 32 * 258, I_UQ = 8 * 96, I_UKV = 8 * 128, I_NA = 16 * 64, I_MLA = 32 * 64, I_OUT = 32 * 64;
    constexpr int NEARLY = I_IN + I_UQ + I_UKV, NITEMS = NEARLY + I_NA + I_MLA + I_OUT;
    for (int it = (PART == 0 ? 0 : NEARLY) + gw; it < (PART == 0 ? NEARLY : NITEMS); it += NGW) {
        int r = it;
        if (r < I_IN) { const int kb = r / 258, sb = r % 258, n0 = 32 * sb, k0 = 64 * kb; const float* W = F.in[3];
            unsigned char* dst = WIN; int drow; bool rope = false;
            if (n0 < 1024) drow = C_NAQ + n0;
            else if (n0 < 2048) drow = C_NAK + (n0 - 1024);
            else if (n0 < 3072) { dst = WVT; drow = n0 - 2048; }
            else if (n0 < 3584) drow = C_CQ + (n0 - 3072);
            else if (n0 < 4096) drow = C_CKV + (n0 - 3584);
            else if (n0 < 4160) { drow = C_KR + ((n0 - 4096) ? 4 : 0); rope = true; }
            else if (n0 < 6208) drow = C_GA + (n0 - 4160);
            else drow = C_GB + (n0 - 6208);
            p0_transpose_item8(W, 2048, 8256, k0, n0, dst, drow, rope, 64.f, scr, lane); continue; } r -= I_IN;
        if (r < I_UQ) { const int kb = r / 96, sb = r % 96, n0 = 32 * sb, k0 = 64 * kb; const int hd = n0 / 192, w = n0 % 192;
            int drow = n0; bool rope = false; if (w >= 128) { rope = true; drow = hd * 192 + 128 + ((w - 128) ? 4 : 0); }
            p0_transpose_item8(F.in[7], 512, 3072, k0, n0, WSP(unsigned char, WS_WUQ), drow, rope, 16.f, scr, lane, F.in[6]); continue; } r -= I_UQ;
        if (r < I_UKV) { const int kb = r / 128, sb = r % 128; p0_transpose_item8(F.in[9], 512, 4096, 64 * kb, 32 * sb, WSP(unsigned char, WS_WUKV), 32 * sb, false, 16.f, scr, lane, F.in[8]); continue; } r -= I_UKV;
        if (r < I_NA) { const int kb = r / 64, sb = r % 64; p0_transpose_item8(F.in[10], 1024, 2048, 64 * kb, 32 * sb, WSP(unsigned char, WS_WNA), 32 * sb, false, 32.f, scr, lane); continue; } r -= I_NA;
        if (r < I_MLA) { const int kb = r / 64, sb = r % 64; p0_transpose_item8(F.in[11], 2048, 2048, 64 * kb, 32 * sb, WSP(unsigned char, WS_WMLA), 32 * sb, false, 64.f, scr, lane); continue; } r -= I_MLA;
        { const int kb = r / 64, sb = r % 64; p0_transpose_item8(F.in[12], 2048, 2048, 64 * kb, 32 * sb, WSP(unsigned char, WS_WOUT), 32 * sb, false, 64.f, scr, lane); }
    }
    if (PART == 0) { GAS u32x4* z = (GAS u32x4*)(WIN + (size_t)(C_KR + 64) * 2048); const int n16 = (NMAIN - C_KR - 64) * 2048 / 16;
      for (int i = gt; i < n16; i += NGT) z[i] = (u32x4){0u, 0u, 0u, 0u}; }
    if (PART == 0) { unsigned char* HN1 = WSP(unsigned char, WS_HN1);
#define P0_ROWSRC(m_) (((m_) < MREAL) ? F.in[0] + (size_t)(m_) * DM : F.in[1] + (size_t)((m_) - MREAL) * DM)
      { f32x4 v[8]; int m = gw;
        if (m < MREAL + NMETA) { const GAS f32x4* xr = (const GAS f32x4*)P0_ROWSRC(m) + lane;
#pragma unroll
            for (int j = 0; j < 8; ++j) v[j] = xr[64 * j]; }
        const GAS f32x4* gr = (const GAS f32x4*)F.in[2] + lane;
        while (m < MREAL + NMETA) { const int mn = m + NGW; f32x4 vn[8];
            { const int ml = mn < MREAL + NMETA ? mn : m; const GAS f32x4* xr = (const GAS f32x4*)P0_ROWSRC(ml) + lane;
#pragma unroll
              for (int j = 0; j < 8; ++j) vn[j] = xr[64 * j]; }
            float sq = 0.f;
#pragma unroll
            for (int j = 0; j < 8; ++j) sq += (v[j].x * v[j].x + v[j].y * v[j].y) + (v[j].z * v[j].z + v[j].w * v[j].w);
            const float rstd = 1.0f / sqrtf(wave_sum(sq) * (1.f / DM) + NORM_EPS);
            GAS unsigned* o4 = (GAS unsigned*)(HN1 + (size_t)m * DM) + lane;
#pragma unroll
            for (int j = 0; j < 8; ++j) { const f32x4 y = (v[j] * rstd) * gr[64 * j]; int w = 0; w = __builtin_amdgcn_cvt_pk_fp8_f32(y[0], y[1], w, false); w = __builtin_amdgcn_cvt_pk_fp8_f32(y[2], y[3], w, true); o4[64 * j] = (unsigned)w; }
#pragma unroll
            for (int j = 0; j < 8; ++j) v[j] = vn[j];
            m = mn; } }
#undef P0_ROWSRC
      GAS u32x4* z = (GAS u32x4*)(HN1 + (size_t)(MREAL + NMETA) * DM); const int n16 = (MPAD - MREAL - NMETA) * DM / 16;
      for (int i = gt; i < n16; i += NGT) z[i] = (u32x4){0u, 0u, 0u, 0u}; }
    if (PART == 0) { float* ct = WSP(float, WS_COS); float* st = WSP(float, WS_SIN);
      for (int i = gt; i < NPOS * 32; i += NGT) { const int p = i >> 5, j = i & 31;
          const float inv = __builtin_powf(10000.0f, -(float)(2 * j) / 64.0f); const float ang = (float)p * inv;
          double r = (double)ang * 0.15915494309189535; r -= __builtin_rint(r); const float rf = (float)r;
          ct[i] = __builtin_amdgcn_cosf(rf); st[i] = __builtin_amdgcn_sinf(rf); } }
    if (PART == 1) { const float* SK = F.in[15]; const float* WQ = F.in[14]; const float* g2 = F.in[13]; bf16_t* WSCp = WSP(bf16_t, WS_WSC);
      const int l15 = lane & 15, l4 = lane >> 4;
      for (int task = gw; task < 2048; task += NGW) { const int g = task >> 7, nt = (task >> 4) & 7, kc = task & 15, n0 = nt * 16;
          bf16x8 bfr[4];
#pragma unroll
          for (int kk = 0; kk < 4; ++kk) { const float* p = SK + ((size_t)g * 128 + n0 + l15) * 128 + 32 * kk + 8 * l4; const f32x4 a = *(const GAS f32x4*)p, b = *(const GAS f32x4*)(p + 4);
              const u32x4 w = pack8(a, b); bfr[kk] = __builtin_bit_cast(bf16x8, w); }
          for (int kt = 0; kt < 8; ++kt) { const int k0 = (kc * 8 + kt) * 16; f32x4 acc = (f32x4){0.f, 0.f, 0.f, 0.f};
#pragma unroll
              for (int kk = 0; kk < 4; ++kk) { const float* p = WQ + (size_t)(k0 + l15) * 2048 + g * 128 + 32 * kk + 8 * l4; const f32x4 a = *(const GAS f32x4*)p, b = *(const GAS f32x4*)(p + 4);
                  const u32x4 w = pack8(a, b); acc = __builtin_amdgcn_mfma_f32_16x16x32_bf16(__builtin_bit_cast(bf16x8, w), bfr[kk], acc, 0, 0, 0); }
              const f32x4 gg = *(const GAS f32x4*)(g2 + k0 + 4 * l4);
              *(GAS u32x2*)(WSCp + (size_t)(g * 128 + n0 + l15) * 2048 + k0 + 4 * l4) = pack4(acc * gg); } } }
}
using pg8::Unit;
struct SchedGrid {
    int G, c, nM, nN; const char* A; const char* B; size_t tstep;
    __device__ __forceinline__ bool next(int i, Unit& u) const { const int L = i * G + c; if (L >= nM * nN) return false; pg8::grid_order(L, nM, nN, u.pm, u.pn); u.kind = 0; return true; }
    __device__ __forceinline__ const char* pa(const Unit& u) const { return A + (size_t)u.pm * tstep; }
    __device__ __forceinline__ const char* pb(const Unit& u) const { return B + (size_t)u.pn * tstep; }
};
constexpr int P1_MAIN = 64 * 29, P1_VT = 4 * 65, P1_META = 7, P1_UNITS = P1_MAIN + P1_VT + P1_META;
struct SchedP1 {
    int G, c; const char* hn1; const char* win; const char* wvt; size_t tstep;
    __device__ __forceinline__ bool next(int i, Unit& u) const {
        const int L = i * G + c; if (L >= P1_UNITS) return false;
        if (L < P1_MAIN) { pg8::grid_order(L, 64, 29, u.pm, u.pn); u.kind = 0; }
        else if (L < P1_MAIN + P1_VT) { const int idx = L - P1_MAIN; u.pm = idx & 3; u.pn = idx >> 2; u.kind = 1; }
        else { const int idx = L - P1_MAIN - P1_VT; u.pm = 64; u.pn = idx < 4 ? 4 + idx : (idx < 6 ? 10 + (idx - 4) : 28); u.kind = 0; }
        return true; }
    __device__ __forceinline__ const char* pa(const Unit& u) const { return (u.kind == 1 ? wvt : hn1) + (size_t)u.pm * tstep; }
    __device__ __forceinline__ const char* pb(const Unit& u) const { return (u.kind == 1 ? hn1 : win) + (size_t)u.pn * tstep; }
};
__device__ __forceinline__ void rope4(const f32x4 x1, const f32x4 x2, const float* cosT, const float* sinT, int pos, int j0, f32x4& lo, f32x4& hi) {
    const f32x4 c = *(const GAS f32x4*)(cosT + pos * 32 + j0), s = *(const GAS f32x4*)(sinT + pos * 32 + j0);
    lo = x1 * c - x2 * s; hi = x2 * c + x1 * s;
}
struct EpiP1 {
    static constexpr bool PERM = true, HAS_PRE = false;
    bf16_t *naq, *nak, *vt; unsigned char *cq, *ckv; bf16_t *kr; unsigned char *ga, *gb; float *ssq_q, *ssq_kv; const float *cosT, *sinT;
    __device__ __forceinline__ void operator()(const f32x4 (&acc)[2][2][4][2], const Unit& u, int wr, int wc, int fr, int fq, const LAS float* rowsc) const {
        const int row0 = u.pm * 256 + wr * 64 + fr, colu = wc * 32 + 8 * fq;
        if (u.kind == 1) {
#pragma unroll
            for (int ai = 0; ai < 2; ++ai)
#pragma unroll
                for (int m = 0; m < 4; ++m) { bf16_t* rp = vt + (size_t)(row0 + ai * 128 + m * 16) * VT_PITCH + u.pn * 256 + colu;
#pragma unroll
                    for (int bj = 0; bj < 2; ++bj) *(GAS u32x4*)(rp + bj * 128) = pack8(acc[ai][bj][m][0], acc[ai][bj][m][1]); }
            return; }
        const int pn = u.pn;
        if (pn == 28) {
            if (wc < 2) { const int j0 = 4 * (4 * wc + fq);
#pragma unroll
                for (int ai = 0; ai < 2; ++ai)
#pragma unroll
                    for (int m = 0; m < 4; ++m) { const int row = row0 + ai * 128 + m * 16; const int pos = row < MREAL ? NMETA + (row & (SEQ - 1)) : row - MREAL;
                        f32x4 lo, hi; rope4(acc[ai][0][m][0], acc[ai][0][m][1], cosT, sinT, pos, j0, lo, hi);
                        *(GAS u32x2*)(kr + (size_t)row * 64 + j0) = pack4(lo); *(GAS u32x2*)(kr + (size_t)row * 64 + 32 + j0) = pack4(hi); } }
            return; }
        if (pn >= 12) {
            unsigned char* base = pn < 20 ? ga : gb; const int colt = (pn < 20 ? pn - 12 : pn - 20) * 256 + colu;
#pragma unroll
            for (int ai = 0; ai < 2; ++ai)
#pragma unroll
                for (int m = 0; m < 4; ++m) { unsigned char* rp = base + (size_t)(row0 + ai * 128 + m * 16) * 2048 + colt;
#pragma unroll
                    for (int bj = 0; bj < 2; ++bj) { f32x4 a = acc[ai][bj][m][0], b = acc[ai][bj][m][1];
#pragma unroll
                        for (int i = 0; i < 4; ++i) { a[i] = sigmoidf_(a[i]); b[i] = sigmoidf_(b[i]); }
                        *(GAS u32x2*)(rp + bj * 128) = pack8_u8(a, b); } }
            return; }
        if (pn >= 8) {
            const bool isq = pn < 10; unsigned char* base = isq ? cq : ckv; float* ssq = isq ? ssq_q : ssq_kv; const int colt = (isq ? pn - 8 : pn - 10) * 256 + colu;
#pragma unroll
            for (int ai = 0; ai < 2; ++ai)
#pragma unroll
                for (int m = 0; m < 4; ++m) { const int row = row0 + ai * 128 + m * 16; unsigned char* rp = base + (size_t)row * 512 + colt; float s = 0.f;
#pragma unroll
                    for (int bj = 0; bj < 2; ++bj) { const f32x4 a = acc[ai][bj][m][0], b = acc[ai][bj][m][1];
                        s += (a[0] * a[0] + a[1] * a[1]) + (a[2] * a[2] + a[3] * a[3]) + (b[0] * b[0] + b[1] * b[1]) + (b[2] * b[2] + b[3] * b[3]);
                        *(GAS u32x2*)(rp + bj * 128) = pack8_fp8(a, b); }
                    s += __shfl_xor(s, 16); s += __shfl_xor(s, 32);
                    if (fq == 0) ssq[(size_t)((pn & 1) * 4 + wc) * MPAD + row] = s; }
            return; }
        {
            bf16_t* base = pn < 4 ? naq : nak; const int colt = (pn & 3) * 256 + colu;
#pragma unroll
            for (int ai = 0; ai < 2; ++ai)
#pragma unroll
                for (int m = 0; m < 4; ++m) { bf16_t* rp = base + (size_t)(row0 + ai * 128 + m * 16) * 1024 + colt;
#pragma unroll
                    for (int bj = 0; bj < 2; ++bj) *(GAS u32x4*)(rp + bj * 128) = pack8(acc[ai][bj][m][0], acc[ai][bj][m][1]); }
        }
    }
};
constexpr int P3_Q = 64 * 12, P3_KV = 65 * 16, P3_UNITS = P3_Q + P3_KV;
struct SchedP3 {
    int G, c; const char* cq; const char* ckv; const char* wuq; const char* wukv; size_t tstep;
    __device__ __forceinline__ bool next(int i, Unit& u) const {
        const int L = i * G + c; if (L >= P3_UNITS) return false;
        if (L < P3_Q) { pg8::grid_order(L, 64, 12, u.pm, u.pn); u.kind = 0; } else { pg8::grid_order(L - P3_Q, 65, 16, u.pm, u.pn); u.kind = 1; }
        return true; }
    __device__ __forceinline__ const char* pa(const Unit& u) const { return (u.kind ? ckv : cq) + (size_t)u.pm * tstep; }
    __device__ __forceinline__ const char* pb(const Unit& u) const { return (u.kind ? wukv : wuq) + (size_t)u.pn * tstep; }
};
template <int NS, int LD> __device__ __forceinline__ float rstd_slabs(const float* part, int row, float invn) {
    float s = 0.f;
#pragma unroll
    for (int i = 0; i < NS; ++i) s += part[(size_t)i * LD + row];
    return 1.0f / sqrtf(s * invn + NORM_EPS);
}
struct EpiP3 {
    static constexpr bool PERM = true, HAS_PRE = true;
    bf16_t *qm, *kn, *vv; const float *ssq_q, *ssq_kv; const float *cosT, *sinT;
    __device__ __forceinline__ void pre(const Unit& u, LAS float* sc, int tid) const { if (tid < 256) { const int row = u.pm * 256 + tid; sc[tid] = u.kind ? rstd_slabs<8, MPAD>(ssq_kv, row, 1.f / 512.f) : rstd_slabs<8, MPAD>(ssq_q, row, 1.f / 512.f); } }
    __device__ __forceinline__ void operator()(const f32x4 (&acc)[2][2][4][2], const Unit& u, int wr, int wc, int fr, int fq, const LAS float* rowsc) const {
        const int row0 = u.pm * 256 + wr * 64 + fr, colu = wc * 32 + 8 * fq;
        if (u.kind == 1) {
#pragma unroll
            for (int ai = 0; ai < 2; ++ai)
#pragma unroll
                for (int m = 0; m < 4; ++m) { const int row = row0 + ai * 128 + m * 16; const float rs = rowsc[ai * 128 + wr * 64 + m * 16 + fr];
                    const size_t off = (size_t)row * 2048 + u.pn * 128 + colu;
                    *(GAS u32x4*)(kn + off) = pack8(acc[ai][0][m][0] * rs, acc[ai][0][m][1] * rs);
                    *(GAS u32x4*)(vv + off) = pack8(acc[ai][1][m][0] * rs, acc[ai][1][m][1] * rs); }
            return; }
#pragma unroll
        for (int bj = 0; bj < 2; ++bj) { const int c8 = u.pn * 256 + bj * 128 + colu; const int hd = c8 / 192, w = c8 - hd * 192;
            if (w < 128) {
#pragma unroll
                for (int ai = 0; ai < 2; ++ai)
#pragma unroll
                    for (int m = 0; m < 4; ++m) { const int row = row0 + ai * 128 + m * 16; const float rs = rowsc[ai * 128 + wr * 64 + m * 16 + fr];
                        *(GAS u32x4*)(qm + (size_t)row * 3072 + c8) = pack8(acc[ai][bj][m][0] * rs, acc[ai][bj][m][1] * rs); }
            } else { const int j0 = (w - 128) >> 1;
#pragma unroll
                for (int ai = 0; ai < 2; ++ai)
#pragma unroll
                    for (int m = 0; m < 4; ++m) { const int row = row0 + ai * 128 + m * 16; const float rs = rowsc[ai * 128 + wr * 64 + m * 16 + fr];
                        const int pos = NMETA + (row & (SEQ - 1)); f32x4 lo, hi; rope4(acc[ai][bj][m][0] * rs, acc[ai][bj][m][1] * rs, cosT, sinT, pos, j0, lo, hi);
                        bf16_t* qp = qm + (size_t)row * 3072 + hd * 192 + 128 + j0; *(GAS u32x2*)qp = pack4(lo); *(GAS u32x2*)(qp + 32) = pack4(hi); }
            } }
    }
};
__device__ __forceinline__ void unpack8(const u32x4 w, f32x4& a, f32x4& b) { a = (f32x4){bf_lo(w.x), bf_hi(w.x), bf_lo(w.y), bf_hi(w.y)}; b = (f32x4){bf_lo(w.z), bf_hi(w.z), bf_lo(w.w), bf_hi(w.w)}; }
struct EpiP5a {
    static constexpr bool PERM = true, HAS_PRE = false;
    const unsigned char* ga; bf16_t* t1;
    __device__ __forceinline__ void operator()(const f32x4 (&acc)[2][2][4][2], const Unit& u, int wr, int wc, int fr, int fq, const LAS float* rowsc) const {
        const int row0 = u.pm * 256 + wr * 64 + fr, col0 = u.pn * 256 + wc * 32 + 8 * fq;
#pragma unroll
        for (int ai = 0; ai < 2; ++ai)
#pragma unroll
            for (int m = 0; m < 4; ++m) { const size_t off = (size_t)(row0 + ai * 128 + m * 16) * 2048 + col0;
#pragma unroll
                for (int bj = 0; bj < 2; ++bj) { f32x4 g0, g1; unpack8_u8(*(const GAS u32x2*)(ga + off + bj * 128), g0, g1);
                    *(GAS u32x4*)(t1 + off + bj * 128) = pack8(acc[ai][bj][m][0] * g0, acc[ai][bj][m][1] * g1); } }
    }
};
struct EpiP5b {
    static constexpr bool PERM = true, HAS_PRE = false;
    const unsigned char* gb; const bf16_t* t1; unsigned char* merged;
    __device__ __forceinline__ void operator()(const f32x4 (&acc)[2][2][4][2], const Unit& u, int wr, int wc, int fr, int fq, const LAS float* rowsc) const {
        const int row0 = u.pm * 256 + wr * 64 + fr, col0 = u.pn * 256 + wc * 32 + 8 * fq;
#pragma unroll
        for (int ai = 0; ai < 2; ++ai)
#pragma unroll
            for (int m = 0; m < 4; ++m) { const size_t off = (size_t)(row0 + ai * 128 + m * 16) * 2048 + col0;
#pragma unroll
                for (int bj = 0; bj < 2; ++bj) { f32x4 g0, g1; unpack8_u8(*(const GAS u32x2*)(gb + off + bj * 128), g0, g1);
                    f32x4 a, b; unpack8(*(const GAS u32x4*)(t1 + off + bj * 128), a, b);
                    *(GAS u32x2*)(merged + off + bj * 128) = pack8_fp8((a + acc[ai][bj][m][0] * g0) * 32.f, (b + acc[ai][bj][m][1] * g1) * 32.f); } }
    }
};
struct EpiP6 {
    static constexpr bool PERM = true, HAS_PRE = false;
    const float* x; bf16_t* h2b; float* ssq2;
    __device__ __forceinline__ void operator()(const f32x4 (&acc)[2][2][4][2], const Unit& u, int wr, int wc, int fr, int fq, const LAS float* rowsc) const {
        const int row0 = u.pm * 256 + wr * 64 + fr, col0 = u.pn * 256 + wc * 32 + 8 * fq;
#pragma unroll
        for (int ai = 0; ai < 2; ++ai)
#pragma unroll
            for (int m = 0; m < 4; ++m) { const int row = row0 + ai * 128 + m * 16; const size_t off = (size_t)row * 2048 + col0; float s = 0.f;
#pragma unroll
                for (int bj = 0; bj < 2; ++bj) { const f32x4 a = *(const GAS f32x4*)(x + off + bj * 128) + acc[ai][bj][m][0], b = *(const GAS f32x4*)(x + off + bj * 128 + 4) + acc[ai][bj][m][1];
                    s += (a[0] * a[0] + a[1] * a[1]) + (a[2] * a[2] + a[3] * a[3]) + (b[0] * b[0] + b[1] * b[1]) + (b[2] * b[2] + b[3] * b[3]);
                    *(GAS u32x4*)(h2b + off + bj * 128) = pack8(a, b); }
                s += __shfl_xor(s, 16); s += __shfl_xor(s, 32);
                if (fq == 0) ssq2[(size_t)(u.pn * 4 + wc) * MREAL + row] = s; }
    }
};
struct EpiP7 {
    static constexpr bool PERM = true, HAS_PRE = true;
    const float* ssq2; _Float16* sc;
    __device__ __forceinline__ void pre(const Unit& u, LAS float* sc, int tid) const { if (tid < 256) sc[tid] = rstd_slabs<32, MREAL>(ssq2, u.pm * 256 + tid, 1.f / 2048.f); }
    __device__ __forceinline__ void operator()(const f32x4 (&acc)[2][2][4][2], const Unit& u, int wr, int wc, int fr, int fq, const LAS float* rowsc) const {
        typedef _Float16 h4_t __attribute__((ext_vector_type(4)));
        const int row0 = u.pm * 256 + wr * 64 + fr, col0 = u.pn * 256 + wc * 32 + 8 * fq;
#pragma unroll
        for (int ai = 0; ai < 2; ++ai)
#pragma unroll
            for (int m = 0; m < 4; ++m) { const int row = row0 + ai * 128 + m * 16; const float rs = rowsc[ai * 128 + wr * 64 + m * 16 + fr]; const size_t off = (size_t)row * 2048 + col0;
#pragma unroll
                for (int bj = 0; bj < 2; ++bj) { const h4_t lo = __builtin_convertvector(acc[ai][bj][m][0] * rs, h4_t), hi = __builtin_convertvector(acc[ai][bj][m][1] * rs, h4_t);
                    const u32x2 wl = __builtin_bit_cast(u32x2, lo), wh = __builtin_bit_cast(u32x2, hi);
                    *(GAS u32x4*)(sc + off + bj * 128) = (u32x4){wl.x, wl.y, wh.x, wh.y}; } }
    }
};
namespace att {
#define KSWZ(row, colB) ((row) * 256 + ((colB) ^ (((row) & 7) << 4)))
#define KRSWZ(row, colB) ((row) * 128 + ((colB) ^ ((((row) >> 1) & 7) << 4)))
constexpr float L2E = 1.4426950408889634f;
template <int DUMMY = 0>
__device__ __forceinline__ void partialSM(f32x16& p0, f32x16& p1, float& m_reg, float& mn, float& alpha, const float C, const float THRS) {
  float pmax = p0[0];
#pragma unroll
  for (int r = 1; r < 16; ++r) pmax = fmaxf(pmax, p0[r]);
#pragma unroll
  for (int r = 0; r < 16; ++r) pmax = fmaxf(pmax, p1[r]);
  { auto rr = __builtin_amdgcn_permlane32_swap(__float_as_uint(pmax), __float_as_uint(pmax), false, false);
    pmax = fmaxf(__uint_as_float(rr[0]), __uint_as_float(rr[1])); }
  if (__builtin_expect(__all(pmax - m_reg <= THRS), 1)) { mn = m_reg; alpha = 1.f; }
  else { mn = fmaxf(m_reg, pmax); alpha = __builtin_amdgcn_exp2f((m_reg - mn) * C); m_reg = mn; }
  const float mnC = -mn * C;
#pragma unroll
  for (int r = 0; r < 16; ++r) p0[r] = fmaf(p0[r], C, mnC);
#pragma unroll
  for (int r = 0; r < 16; ++r) p1[r] = fmaf(p1[r], C, mnC);
#pragma unroll
  for (int r = 0; r < 16; ++r) p0[r] = __builtin_amdgcn_exp2f(p0[r]);
}
__device__ __forceinline__ void finishSM(f32x16& p0, f32x16& p1, float alpha, float& l_reg, bf16x8& pa0, bf16x8& pa1, bf16x8& pa2, bf16x8& pa3) {
#pragma unroll
  for (int r = 0; r < 16; ++r) p1[r] = __builtin_amdgcn_exp2f(p1[r]);
  float ps = 0;
#pragma unroll
  for (int r = 0; r < 16; ++r) ps += p0[r];
#pragma unroll
  for (int r = 0; r < 16; ++r) ps += p1[r];
  { auto rr = __builtin_amdgcn_permlane32_swap(__float_as_uint(ps), __float_as_uint(ps), false, false);
    ps = __uint_as_float(rr[0]) + __uint_as_float(rr[1]); }
  l_reg = l_reg * alpha + ps;
#define PK4(P, BASE, OUT) do { unsigned a0 = cvt_pk_bf16(P[BASE + 0], P[BASE + 1]), a1 = cvt_pk_bf16(P[BASE + 2], P[BASE + 3]);   \
    unsigned b0 = cvt_pk_bf16(P[BASE + 4], P[BASE + 5]), b1 = cvt_pk_bf16(P[BASE + 6], P[BASE + 7]);                              \
    auto r0 = __builtin_amdgcn_permlane32_swap(a0, b0, false, false); auto r1 = __builtin_amdgcn_permlane32_swap(a1, b1, false, false); \
    u32x4 w = {r0[0], r1[0], r0[1], r1[1]}; OUT = __builtin_bit_cast(bf16x8, w); } while (0)
  PK4(p0, 0, pa0); PK4(p0, 8, pa1); PK4(p1, 0, pa2); PK4(p1, 8, pa3);
#undef PK4
}
constexpr int NW = 8, QBLK = 32, KVBLK = 64;
constexpr float MLA_SCALE = 0.07216878364870322f;
constexpr float MLA_THR = 8.f;
constexpr int SHM_V = KVBLK * 128 * 2, SHM_KN = KVBLK * 128 * 2, SHM_KR = KVBLK * 64 * 2;
constexpr int OFF_V = 0, OFF_KN = 2 * SHM_V, OFF_KR = OFF_KN + 2 * SHM_KN, OFF_WS = OFF_KR + 2 * SHM_KR, OFF_QR = OFF_WS + NW * 64 * 4, MLA_LDS = OFF_QR + NW * 4096;
__device__ __forceinline__ void qkt(f32x16& p0, f32x16& p1, const LAS char* Kn, const LAS char* Kr, const bf16x8* qr, const LAS char* qrp, const int* kb, const int* krb) {
  p0 = f32x16{}; p1 = f32x16{};
#pragma unroll
  for (int d0 = 0; d0 < 8; ++d0) {
    const bf16x8 b0 = *(const LAS bf16x8*)(Kn + kb[d0 & 3] + (d0 >> 2) * 128);
    const bf16x8 b1 = *(const LAS bf16x8*)(Kn + kb[d0 & 3] + (d0 >> 2) * 128 + 8192);
    p0 = __builtin_amdgcn_mfma_f32_32x32x16_bf16(b0, qr[d0], p0, 0, 0, 0);
    p1 = __builtin_amdgcn_mfma_f32_32x32x16_bf16(b1, qr[d0], p1, 0, 0, 0); }
#pragma unroll
  for (int d0 = 0; d0 < 4; ++d0) {
    const bf16x8 b0 = *(const LAS bf16x8*)(Kr + krb[d0]);
    const bf16x8 b1 = *(const LAS bf16x8*)(Kr + krb[d0] + 4096);
    const bf16x8 qf = *(const LAS bf16x8*)(qrp + d0 * 1024);
    p0 = __builtin_amdgcn_mfma_f32_32x32x16_bf16(b0, qf, p0, 0, 0, 0);
    p1 = __builtin_amdgcn_mfma_f32_32x32x16_bf16(b1, qf, p1, 0, 0, 0); }
}
__device__ __forceinline__ int v_st(int k, int c) { const int kk = (k & ~0xC) | ((k & 4) << 1) | ((k & 8) >> 1); return ((kk >> 3) * 4 + (c >> 5)) * 512 + ((kk & 7) * 32 + (c & 31)) * 2; }
__device__ __forceinline__ int v_rd_base(int lane) { return ((lane & 3) << 3) | (((lane >> 2) & 3) << 6) | (((lane >> 4) & 1) << 5) | (((lane >> 5) & 1) << 8); }
constexpr int v_rd_off(int d0, int ks, int half) { return d0 * 512 + ks * 4096 + half * 2048; }
template <int OFF> __device__ __forceinline__ s16x4 tr_read(int vb) {
  s16x4 r; asm volatile("ds_read_b64_tr_b16 %0, %1 offset:%2" : "=&v"(r) : "v"(vb), "i"(OFF) : "memory"); return r;
}
template <int D0> __device__ __forceinline__ void pv_one(f32x16& od, int vb, bf16x8 pa0, bf16x8 pa1, bf16x8 pa2, bf16x8 pa3) {
  const s16x4 l0 = tr_read<v_rd_off(D0, 0, 0)>(vb), h0 = tr_read<v_rd_off(D0, 0, 1)>(vb), l1 = tr_read<v_rd_off(D0, 1, 0)>(vb), h1 = tr_read<v_rd_off(D0, 1, 1)>(vb);
  const s16x4 l2 = tr_read<v_rd_off(D0, 2, 0)>(vb), h2 = tr_read<v_rd_off(D0, 2, 1)>(vb), l3 = tr_read<v_rd_off(D0, 3, 0)>(vb), h3 = tr_read<v_rd_off(D0, 3, 1)>(vb);
  asm volatile("s_waitcnt lgkmcnt(0)" ::: "memory"); SBAR();
#define PK(L, H) (bf16x8){L[0], L[1], L[2], L[3], H[0], H[1], H[2], H[3]}
  od = __builtin_amdgcn_mfma_f32_32x32x16_bf16(pa0, PK(l0, h0), od, 0, 0, 0);
  od = __builtin_amdgcn_mfma_f32_32x32x16_bf16(pa1, PK(l1, h1), od, 0, 0, 0);
  od = __builtin_amdgcn_mfma_f32_32x32x16_bf16(pa2, PK(l2, h2), od, 0, 0, 0);
  od = __builtin_amdgcn_mfma_f32_32x32x16_bf16(pa3, PK(l3, h3), od, 0, 0, 0);
#undef PK
}
__device__ __forceinline__ void pv_d0(f32x16* o, int vb, bf16x8 pa0, bf16x8 pa1, bf16x8 pa2, bf16x8 pa3) {
  pv_one<0>(o[0], vb, pa0, pa1, pa2, pa3); pv_one<1>(o[1], vb, pa0, pa1, pa2, pa3); pv_one<2>(o[2], vb, pa0, pa1, pa2, pa3); pv_one<3>(o[3], vb, pa0, pa1, pa2, pa3);
}
__device__ __forceinline__ void mla_unit(int b, int h, int qb, const bf16_t* __restrict__ QM, const bf16_t* __restrict__ KN, const bf16_t* __restrict__ KR, const bf16_t* __restrict__ VV, unsigned char* __restrict__ OM, LAS char* lds) {
  const int tid = threadIdx.x, wid = tid >> 6, lane = tid & 63, r32 = lane & 31, hi = lane >> 5;
  constexpr float C = MLA_SCALE * L2E, THRS = MLA_THR / MLA_SCALE;
  constexpr int NT = 33;
  LAS char* V_lds = lds + OFF_V; LAS char* Kn_lds = lds + OFF_KN; LAS char* Kr_lds = lds + OFF_KR;
  LAS float* ws = (LAS float*)(lds + OFF_WS) + wid * 64; LAS float* li_l = ws; LAS float* al_l = ws + 32;
  float m_reg = -1e30f, l_reg = 0; f32x16 o[4] = {}; bf16x8 qr[8];
  LAS char* qrp = lds + OFF_QR + wid * 4096 + lane * 16;
  const int qrow = b * SEQ + qb * 256 + wid * QBLK + r32;
  const bf16_t* Qw = QM + (size_t)qrow * 3072 + h * 192 + hi * 8;
#pragma unroll
  for (int d0 = 0; d0 < 8; ++d0) qr[d0] = *(const GAS bf16x8*)(Qw + d0 * 16);
  __syncthreads();
#pragma unroll
  for (int d0 = 0; d0 < 4; ++d0) *(LAS bf16x8*)(qrp + d0 * 1024) = *(const GAS bf16x8*)(Qw + (8 + d0) * 16);
  const int sr = tid >> 4, sc = (tid & 15) * 8, vst0 = v_st(sr, sc), vst1 = v_st(32 + sr, sc);
  const int krr = tid >> 3, krc = (tid & 7) * 8;
  const int vb0 = (int)(uintptr_t)V_lds + v_rd_base(lane);
  bf16x8 s_v0, s_v1, s_k0, s_k1, s_kr;
  const int realbase = b * SEQ - KVBLK;
  const unsigned voff = (unsigned)(sr * 2048 + sc) * 2u, kroff = (unsigned)(krr * 64 + krc) * 2u;
  int kb[4], krb[4];
#pragma unroll
  for (int bq = 0; bq < 4; ++bq) { kb[bq] = KSWZ(r32, bq * 32 + hi * 16); krb[bq] = KRSWZ(r32, bq * 32 + hi * 16); }
#define TROW(t) ((t) == 0 ? MREAL : realbase + (t) * KVBLK)
#define SLOAD(t) do { const int k0_ = TROW(t); const size_t ro_ = ((size_t)k0_ * 2048 + h * 128) * 2; \
    const GAS char* vb_ = (const GAS char*)VV + ro_; const GAS char* nb_ = (const GAS char*)KN + ro_; const GAS char* rb_ = (const GAS char*)KR + (size_t)k0_ * 128; \
    s_v0 = *(const GAS bf16x8*)(vb_ + voff); s_v1 = *(const GAS bf16x8*)(vb_ + 32 * 4096 + voff); \
    s_k0 = *(const GAS bf16x8*)(nb_ + voff); s_k1 = *(const GAS bf16x8*)(nb_ + 32 * 4096 + voff); \
    s_kr = *(const GAS bf16x8*)(rb_ + kroff); } while (0)
#define SWRITE(bf) do { *(LAS bf16x8*)(V_lds + (bf) * SHM_V + vst0) = s_v0; *(LAS bf16x8*)(V_lds + (bf) * SHM_V + vst1) = s_v1; const int kc_ = sc * 2; \
    *(LAS bf16x8*)(Kn_lds + (bf) * SHM_KN + KSWZ(sr, kc_)) = s_k0; *(LAS bf16x8*)(Kn_lds + (bf) * SHM_KN + KSWZ(32 + sr, kc_)) = s_k1; \
    *(LAS bf16x8*)(Kr_lds + (bf) * SHM_KR + KRSWZ(krr, krc * 2)) = s_kr; } while (0)
#define SWAIT() asm volatile("s_waitcnt vmcnt(0)" ::: "memory")
#define RESC(a) do { if (__any((a) < 1.f)) { if (hi == 0) al_l[r32] = (a); asm volatile("s_waitcnt lgkmcnt(0)" ::: "memory"); \
    _Pragma("unroll") for (int d = 0; d < 4; ++d) _Pragma("unroll") for (int r = 0; r < 16; ++r) o[d][r] *= al_l[crow(r, hi)]; } } while (0)
  f32x16 pA0, pA1, pB0, pB1; float mnA, mnB, alA, alB; bf16x8 pa0, pa1, pa2, pa3;
  SLOAD(0); SWAIT(); SWRITE(0); __syncthreads();
  qkt(pA0, pA1, Kn_lds, Kr_lds, qr, qrp, kb, krb);
  { const float NEG = -INFINITY;
#pragma unroll
    for (int r = 8; r < 16; ++r) pA0[r] = NEG;
#pragma unroll
    for (int r = 0; r < 16; ++r) pA1[r] = NEG; }
  partialSM(pA0, pA1, m_reg, mnA, alA, C, THRS);
  SLOAD(1); SWAIT(); SWRITE(1); __syncthreads();
  for (int j = 1; j + 1 < NT; j += 2) {
    SBAR(); qkt(pB0, pB1, Kn_lds + SHM_KN, Kr_lds + SHM_KR, qr, qrp, kb, krb);
    finishSM(pA0, pA1, alA, l_reg, pa0, pa1, pa2, pa3); SBAR();
    SLOAD(j + 1); SBAR();
    pv_d0(o, vb0, pa0, pa1, pa2, pa3); partialSM(pB0, pB1, m_reg, mnB, alB, C, THRS);
    __syncthreads(); SWAIT(); SWRITE(0);
    RESC(alB); __syncthreads();
    SBAR(); qkt(pA0, pA1, Kn_lds, Kr_lds, qr, qrp, kb, krb);
    finishSM(pB0, pB1, alB, l_reg, pa0, pa1, pa2, pa3); SBAR();
    if (j + 2 < NT) SLOAD(j + 2); SBAR();
    pv_d0(o, vb0 + SHM_V, pa0, pa1, pa2, pa3); partialSM(pA0, pA1, m_reg, mnA, alA, C, THRS);
    __syncthreads(); if (j + 2 < NT) { SWAIT(); SWRITE(1); }
    RESC(alA); __syncthreads();
  }
  finishSM(pA0, pA1, alA, l_reg, pa0, pa1, pa2, pa3); SBAR();
  pv_d0(o, vb0, pa0, pa1, pa2, pa3);
  if (hi == 0) li_l[r32] = l_reg; asm volatile("s_waitcnt lgkmcnt(0)" ::: "memory");
  float rli[16];
#pragma unroll
  for (int r = 0; r < 16; ++r) rli[r] = __builtin_amdgcn_rcpf(li_l[crow(r, hi)]);
  unsigned char* Ow = OM + (size_t)(b * SEQ + qb * 256 + wid * QBLK) * 2048 + h * 128;
#pragma unroll
  for (int r = 0; r < 16; ++r) { const int orow = crow(r, hi);
#pragma unroll
    for (int d0 = 0; d0 < 4; ++d0) Ow[(size_t)orow * 2048 + d0 * 32 + r32] = f32_to_fp8(o[d0][r] * rli[r] * 32.f); }
#undef TROW
#undef SLOAD
#undef SWRITE
#undef SWAIT
#undef RESC
}
__device__ __forceinline__ void na_task(int task, const bf16_t* __restrict__ NAQ, const bf16_t* __restrict__ NAK, const bf16_t* __restrict__ VT, unsigned char* __restrict__ ONA,
                                        const LAS float* relb, const LAS float* metab, LAS float* wsf, int lane) {
  const int r32 = lane & 31, hi = lane >> 5;
  const int half = task & 1, r = (task >> 1) & 31, h = (task >> 6) & 15, b = task >> 10;
  const int qc = half * 32 + r32;
  const int cs = min(max(qc - 8, 0), 48), rs = min(max(r - 4, 0), 24);
  const int qtok = b * SEQ + r * 64 + qc;
  constexpr float C = L2E, THRS = 8.f, SCALE = 0.125f;
  bf16x8 qr[4];
#pragma unroll
  for (int d0 = 0; d0 < 4; ++d0) qr[d0] = *(const GAS bf16x8*)(NAQ + (size_t)qtok * 1024 + h * 64 + d0 * 16 + hi * 8);
  float m_reg = -1e30f, l_reg = 0.f; f32x16 o[2] = {};
  LAS float* al_l = wsf; LAS float* li_l = wsf + 32;
  const float NEG = -INFINITY;
  const int kb0 = half * 16;
  const unsigned long long wm = 0xFFFFull << (cs - kb0);
  const unsigned mh0 = (unsigned)wm >> (4 * hi), mh1 = (unsigned)(wm >> 32) >> (4 * hi);
  const bf16_t* kq = NAK + (size_t)r32 * 1024 + h * 64 + hi * 8;
  const bf16_t* kq2 = NAK + (size_t)(32 + (r32 & 15)) * 1024 + h * 64 + hi * 8;
  const bf16_t* vq = VT + (size_t)(h * 64 + r32) * VT_PITCH + 8 * hi;
#define NA_KTOK(w) ((w) == 8 ? MREAL : b * SEQ + (rs + (w)) * 64 + kb0)
#define NA_LOADK(KF, w) do { const size_t ko_ = (size_t)NA_KTOK(w) * 1024; _Pragma("unroll") for (int d0 = 0; d0 < 4; ++d0) { KF[d0] = *(const GAS bf16x8*)(kq + ko_ + d0 * 16); KF[4 + d0] = *(const GAS bf16x8*)(kq2 + ko_ + d0 * 16); } } while (0)
#define NA_TILE(KF, w) do { \
    bf16x8 vf[6]; { const bf16_t* vp_ = vq + NA_KTOK(w); _Pragma("unroll") for (int ks = 0; ks < 3; ++ks) { vf[ks] = *(const GAS bf16x8*)(vp_ + 16 * ks); vf[3 + ks] = *(const GAS bf16x8*)(vp_ + (size_t)32 * VT_PITCH + 16 * ks); } } \
    f32x16 p0 = {}, p1 = {}; \
    _Pragma("unroll") for (int d0 = 0; d0 < 4; ++d0) { p0 = __builtin_amdgcn_mfma_f32_32x32x16_bf16(KF[d0], qr[d0], p0, 0, 0, 0); p1 = __builtin_amdgcn_mfma_f32_32x32x16_bf16(KF[4 + d0], qr[d0], p1, 0, 0, 0); } \
    if ((w) + 1 < 9) NA_LOADK(KF, (w) + 1);            \
    if ((w) < 8) { const LAS float* bp_ = relb + ((h * 15 + (rs + (w) - r + 7)) * 31 + 15 - qc + 4 * hi + kb0);     \
      float bv0[16], bv1[8];        \
      _Pragma("unroll") for (int rg = 0; rg < 16; ++rg) { const int c_ = (rg & 3) + 8 * (rg >> 2); bv0[rg] = bp_[c_]; if (rg < 8) bv1[rg] = bp_[c_ + 32]; } \
      _Pragma("unroll") for (int rg = 0; rg < 16; ++rg) { asm volatile("" : "+v"(bv0[rg])); if (rg < 8) asm volatile("" : "+v"(bv1[rg])); } \
      _Pragma("unroll") for (int rg = 0; rg < 16; ++rg) { const int c_ = (rg & 3) + 8 * (rg >> 2); \
        { const bool ok = (mh0 >> c_) & 1u; p0[rg] = ok ? fmaf(p0[rg], SCALE, bv0[rg]) : NEG; } \
        if (rg < 8) { const bool ok = (mh1 >> c_) & 1u; p1[rg] = ok ? fmaf(p1[rg], SCALE, bv1[rg]) : NEG; } } \
    } else { const LAS float* bp = metab + h * 16; \
      _Pragma("unroll") for (int rg = 0; rg < 16; ++rg) { const int kc = crow(rg, hi); p0[rg] = (rg < 8) ? fmaf(p0[rg], SCALE, bp[kc & 15]) : NEG; if (rg < 8) p1[rg] = NEG; } } \
      \
    float pmax = p0[0]; \
    _Pragma("unroll") for (int rg = 1; rg < 16; ++rg) pmax = fmaxf(pmax, p0[rg]); \
    _Pragma("unroll") for (int rg = 0; rg < 8; ++rg) pmax = fmaxf(pmax, p1[rg]); \
    { auto rr = __builtin_amdgcn_permlane32_swap(__float_as_uint(pmax), __float_as_uint(pmax), false, false); pmax = fmaxf(__uint_as_float(rr[0]), __uint_as_float(rr[1])); } \
    float mn, alpha; \
    if (__builtin_expect(__all(pmax - m_reg <= THRS), 1)) { mn = m_reg; alpha = 1.f; } \
    else { mn = fmaxf(m_reg, pmax); alpha = __builtin_amdgcn_exp2f((m_reg - mn) * C); m_reg = mn; } \
    const float mnC = -mn * C; float ps = 0.f; \
    _Pragma("unroll") for (int rg = 0; rg < 16; ++rg) { p0[rg] = __builtin_amdgcn_exp2f(fmaf(p0[rg], C, mnC)); ps += p0[rg]; } \
    _Pragma("unroll") for (int rg = 0; rg < 8; ++rg) { p1[rg] = __builtin_amdgcn_exp2f(fmaf(p1[rg], C, mnC)); ps += p1[rg]; } \
    { auto rr = __builtin_amdgcn_permlane32_swap(__float_as_uint(ps), __float_as_uint(ps), false, false); ps = __uint_as_float(rr[0]) + __uint_as_float(rr[1]); } \
    l_reg = l_reg * alpha + ps; \
    bf16x8 pa0, pa1, pa2; NA_PK4(p0, 0, pa0); NA_PK4(p0, 8, pa1); NA_PK4(p1, 0, pa2); \
    if (__any(alpha < 1.f)) { if (hi == 0) al_l[r32] = alpha; asm volatile("s_waitcnt lgkmcnt(0)" ::: "memory"); \
      _Pragma("unroll") for (int d = 0; d < 2; ++d) _Pragma("unroll") for (int rg = 0; rg < 16; ++rg) o[d][rg] *= al_l[crow(rg, hi)]; } \
    _Pragma("unroll") for (int d0 = 0; d0 < 2; ++d0) { \
      o[d0] = __builtin_amdgcn_mfma_f32_32x32x16_bf16(pa0, vf[3 * d0 + 0], o[d0], 0, 0, 0); o[d0] = __builtin_amdgcn_mfma_f32_32x32x16_bf16(pa1, vf[3 * d0 + 1], o[d0], 0, 0, 0); \
      o[d0] = __builtin_amdgcn_mfma_f32_32x32x16_bf16(pa2, vf[3 * d0 + 2], o[d0], 0, 0, 0); } } while (0)
#define NA_PK4(P, BASE, OUT) do { unsigned a0 = cvt_pk_bf16(P[BASE + 0], P[BASE + 1]), a1 = cvt_pk_bf16(P[BASE + 2], P[BASE + 3]);   \
    unsigned b0 = cvt_pk_bf16(P[BASE + 4], P[BASE + 5]), b1 = cvt_pk_bf16(P[BASE + 6], P[BASE + 7]);                              \
    auto r0 = __builtin_amdgcn_permlane32_swap(a0, b0, false, false); auto r1 = __builtin_amdgcn_permlane32_swap(a1, b1, false, false); \
    u32x4 w_ = {r0[0], r1[0], r0[1], r1[1]}; OUT = __builtin_bit_cast(bf16x8, w_); } while (0)
  { bf16x8 kA[8];
    NA_LOADK(kA, 0);
#pragma unroll 1
    for (int w = 0; w < 8; ++w) { NA_TILE(kA, w); }
    NA_TILE(kA, 8); }
#undef NA_PK4
#undef NA_KTOK
#undef NA_LOADK
#undef NA_TILE
  if (hi == 0) li_l[r32] = l_reg; asm volatile("s_waitcnt lgkmcnt(0)" ::: "memory");
  unsigned char* Ow = ONA + (size_t)(b * SEQ + r * 64 + half * 32) * 1024 + h * 64;
#pragma unroll
  for (int rg = 0; rg < 16; ++rg) { const int orow = crow(rg, hi); const float rl = __builtin_amdgcn_rcpf(li_l[orow]);
#pragma unroll
    for (int d0 = 0; d0 < 2; ++d0) Ow[(size_t)orow * 1024 + d0 * 32 + r32] = f32_to_fp8(o[d0][rg] * rl * 16.f); }
  asm volatile("s_waitcnt lgkmcnt(0)" ::: "memory");
}
}
namespace peer {
constexpr int CH = 32;
constexpr int OFF_TV = 0, OFF_TI = OFF_TV + CH * 16 * 16 * 4, OFF_SE = OFF_TI + CH * 16 * 16 * 4, OFF_SG = OFF_SE + CH * 128 * 4, OFF_SE2 = OFF_SG + CH * 128 * 4, OFF_SG2 = OFF_SE2 + CH * 128 * 4, PEER_LDS = OFF_SG2 + CH * 128 * 4;
static_assert(PEER_LDS <= RING_BYTES, "PEER LDS");
__device__ __forceinline__ float gelu_tanh(float x) {
    const float u = 0.7978845608028654f * (x + 0.044715f * x * x * x);
    const float e = __builtin_amdgcn_exp2f(-2.f * 1.4426950408889634f * fabsf(u));
    const float t = (1.f - e) * __builtin_amdgcn_rcpf(1.f + e);
    return 0.5f * x * (1.f + (u < 0.f ? -t : t));
}
__device__ __forceinline__ void fmac1(float& acc, float a, float b) { asm("v_fmac_f32_e32 %0, %1, %2" : "+v"(acc) : "v"(a), "v"(b)); }
#define PEER_INSERT(x_, xi_) do { float x__ = (x_); int xi__ = (xi_); \
    _Pragma("unroll") for (int j_ = 0; j_ < 16; ++j_) { const bool gt_ = x__ > tv[j_]; const float tvo_ = tv[j_]; const int tio_ = ti[j_]; \
        tv[j_] = gt_ ? x__ : tvo_; ti[j_] = gt_ ? xi__ : tio_; x__ = gt_ ? tvo_ : x__; xi__ = gt_ ? tio_ : xi__; } } while (0)

#define PEER_AUX 0
typedef __amdgpu_buffer_rsrc_t rsrc_t;
__device__ __forceinline__ rsrc_t mk_rsrc(const void* p, unsigned bytes) { return __builtin_amdgcn_make_buffer_rsrc((void*)p, 0, bytes, 0x00020000); }
__device__ __forceinline__ u32x4 ldb128(rsrc_t r, unsigned off) { return __builtin_amdgcn_raw_buffer_load_b128(r, off, 0, PEER_AUX); }
typedef unsigned v6u_t __attribute__((ext_vector_type(6)));
typedef float v32f_t __attribute__((ext_vector_type(32)));
typedef float v16f_t __attribute__((ext_vector_type(16)));
__device__ __forceinline__ u32x2 ldb64(rsrc_t r, unsigned off) { return __builtin_amdgcn_raw_buffer_load_b64(r, off, 0, PEER_AUX); }
__device__ __forceinline__ f32x4 ldf128(rsrc_t r, unsigned off) { return __builtin_bit_cast(f32x4, __builtin_amdgcn_raw_buffer_load_b128(r, off, 0, PEER_AUX)); }
__device__ __forceinline__ f32x4 ldf128_nt(rsrc_t r, unsigned off) { return __builtin_bit_cast(f32x4, __builtin_amdgcn_raw_buffer_load_b128(r, off, 0, 2)); }
__device__ __forceinline__ void peer_select(int chunk, const _Float16* __restrict__ SC, LAS char* lds, int tid, LAS int* SE, LAS float* SG) {
    LAS float* TV = (LAS float*)(lds + OFF_TV); LAS int* TI = (LAS int*)(lds + OFF_TI);
    asm volatile("" : "+v"(tid));
    const int tok0 = chunk * CH;
    const rsrc_t rSC = mk_rsrc(SC, 0x4000000u);
    __syncthreads();
    { const int tl = tid >> 4, g = tid & 15; const unsigned spo = ((unsigned)(tok0 + tl) * 2048u + (unsigned)g * 128u) * 2u;
      int tk[16];
#pragma unroll
      for (int j = 0; j < 16; ++j) tk[j] = (int)0x80000000;
#define PEER_KEY(x_, lowbits_, mask_) ({ const int f_ = __float_as_int(x_); ((f_ ^ ((f_ >> 31) & 0x7fffffff)) & ~(mask_)) | (lowbits_); })
#define PEER_INS(key_) do { int x__ = (key_); _Pragma("unroll") for (int j_ = 0; j_ < 16; ++j_) { const int hi_ = max(x__, tk[j_]); x__ = min(x__, tk[j_]); tk[j_] = hi_; } } while (0)
#pragma unroll 1
      for (int i = 0; i < 16; i += 2) { typedef _Float16 h8_t __attribute__((ext_vector_type(8)));
          const h8_t a = __builtin_bit_cast(h8_t, __builtin_amdgcn_raw_buffer_load_b128(rSC, spo + i * 16, 0, 2)), b = __builtin_bit_cast(h8_t, __builtin_amdgcn_raw_buffer_load_b128(rSC, spo + i * 16 + 16, 0, 2));
#pragma unroll
          for (int e = 0; e < 8; ++e) { PEER_INS(PEER_KEY((float)a[e], 127 - (8 * i + e), 127)); }
#pragma unroll
          for (int e = 0; e < 8; ++e) { PEER_INS(PEER_KEY((float)b[e], 127 - (8 * i + 8 + e), 127)); } }
      LAS float* tvp = TV + (tl * 16 + g) * 16; LAS int* tip = TI + (tl * 16 + g) * 16;
#pragma unroll
      for (int j = 0; j < 16; ++j) { const int k_ = tk[j] & ~127; tvp[j] = __int_as_float(k_ ^ ((k_ >> 31) & 0x7fffffff)); tip[j] = 127 - (tk[j] & 127); } }
    __syncthreads();
    asm volatile("" : "+v"(tid));
    { const int tl = tid >> 4, hh = (tid >> 1) & 7, half = tid & 1;
      const LAS float* s1 = TV + (tl * 16 + 2 * hh) * 16; const LAS float* s2 = s1 + 16; const LAS int* i1 = TI + (tl * 16 + 2 * hh) * 16; const LAS int* i2 = i1 + 16;
      float b2[16];
#pragma unroll
      for (int j = 0; j < 16; ++j) b2[j] = s2[j];
      int tk[16];
#pragma unroll
      for (int j = 0; j < 16; ++j) tk[j] = (int)0x80000000;
#pragma unroll
      for (int ii = 0; ii < 8; ++ii) { const int i = 2 * ii + half; const float a = s1[i];
#pragma unroll
          for (int j = 0; j < 16; ++j) if ((2 * ii + 1) * (j + 1) <= 16) { if (half == 0 || (2 * ii + 2) * (j + 1) <= 16) PEER_INS(PEER_KEY(a + b2[j], 255 - (i * 16 + j), 255)); } }
      { int pk[16];
#pragma unroll
        for (int j = 0; j < 16; ++j) pk[j] = __shfl_xor(tk[j], 1);
#pragma unroll
        for (int j = 0; j < 16; ++j) PEER_INS(pk[j]); }
      if (half == 0) { float e[16], sum = 0.f; const int k0_ = tk[0] & ~255; const float v0 = __int_as_float(k0_ ^ ((k0_ >> 31) & 0x7fffffff));
#pragma unroll
        for (int j = 0; j < 16; ++j) { const int k_ = tk[j] & ~255; const float vj = __int_as_float(k_ ^ ((k_ >> 31) & 0x7fffffff)); e[j] = __builtin_amdgcn_exp2f((vj - v0) * 1.4426950408889634f); sum += e[j]; }
        const float inv = 1.0f / sum;
#pragma unroll
        for (int j = 0; j < 16; ++j) { const int ci = 255 - (tk[j] & 255); SE[tl * 128 + hh * 16 + j] = i1[ci >> 4] * 128 + i2[ci & 15]; SG[tl * 128 + hh * 16 + j] = e[j] * inv; } } }
#undef PEER_KEY
#undef PEER_INS
    __syncthreads();
}
__device__ __forceinline__ void peer_gather(int chunk, const bf16_t* __restrict__ H2, const unsigned char* __restrict__ U,
                                            const float* __restrict__ g2, const float* __restrict__ gf, float* OUT, int tid, const LAS int* SE, const LAS float* SG) {
    asm volatile("" : "+v"(tid));
    const int tok0 = chunk * CH, lane = tid & 63, wave = tid >> 6;
    const rsrc_t rH2 = mk_rsrc(H2, 0x4000000u), rU = mk_rsrc(U, 0x3000000u), rG2 = mk_rsrc(g2, 8192u), rGF = mk_rsrc(gf, 8192u);
#pragma unroll 1
    for (int tt = 0; tt < CH / NWAVES; ++tt) { const int tl = wave * (CH / NWAVES) + tt, tok = tok0 + tl;
      asm volatile("" ::: "memory");
      float hn[32], acc[32]; float ss = 0.f;
#pragma unroll
      for (int j = 0; j < 2; ++j)
#pragma unroll
          for (int q = 0; q < 4; ++q) { const u32x2 w = ldb64(rH2, ((unsigned)tok * 2048u + 256u * (4 * j + q) + 4u * lane) * 2u);
              const f32x4 a = (f32x4){__uint_as_float(w.x << 16), __uint_as_float(w.x & 0xffff0000u), __uint_as_float(w.y << 16), __uint_as_float(w.y & 0xffff0000u)};
#pragma unroll
              for (int i = 0; i < 4; ++i) { hn[16 * j + 4 * q + i] = a[i]; ss += a[i] * a[i]; } }
      const float rstd = 1.0f / sqrtf(wave_sum(ss) * (1.f / 2048.f) + NORM_EPS);
#pragma unroll
      for (int j = 0; j < 2; ++j)
#pragma unroll
          for (int q = 0; q < 4; ++q) { const f32x4 a = ldf128(rG2, (256u * (4 * j + q) + 4u * lane) * 4u);
#pragma unroll
              for (int i = 0; i < 4; ++i) hn[16 * j + 4 * q + i] *= rstd * a[i]; }
#pragma unroll
      for (int i = 0; i < 32; ++i) acc[i] = 0.f;
#define NX 4
#define PEER_LOAD(S, kb) do { _Pragma("unroll") for (int x = 0; x < NX; ++x) { const unsigned o = (unsigned)SE[tl * 128 + (kb) + x] * 3072u; \
          S##ua[x] = ldb128(rU, o + (unsigned)lane * 16u); S##ub[x] = ldb64(rU, o + 1024u + (unsigned)lane * 8u); S##va[x] = ldb128(rU, o + 1536u + (unsigned)lane * 16u); S##vb[x] = ldb64(rU, o + 2560u + (unsigned)lane * 8u); } } while (0)
#define PEER_DEC(A, B) ({ v32f_t r_ = __builtin_amdgcn_cvt_scalef32_pk32_f32_fp6((v6u_t){A.x, A.y, A.z, A.w, B.x, B.y}, 1.0f); asm volatile("s_nop 1" : "+v"(r_)); r_; })
#define PEER_COMPUTE(S, kb) do { float d[NX]; \
          _Pragma("unroll") for (int x = 0; x < NX; ++x) { const v32f_t r = PEER_DEC(S##ua[x], S##ub[x]); float dd = 0.f; \
              _Pragma("unroll") for (int i = 0; i < 32; ++i) fmac1(dd, hn[i], r[i]); \
              d[x] = dd; } \
          _Pragma("unroll") for (int o = 1; o < 64; o <<= 1) { _Pragma("unroll") for (int x = 0; x < NX; ++x) d[x] += __shfl_xor(d[x], o); } \
          float c[NX]; \
          _Pragma("unroll") for (int x = 0; x < NX; ++x) c[x] = SG[tl * 128 + (kb) + x] * gelu_tanh(d[x] * (1.f / 64.f)) * 0.25f; \
          _Pragma("unroll") for (int x = 0; x < NX; ++x) { const v32f_t r = PEER_DEC(S##va[x], S##vb[x]); \
              _Pragma("unroll") for (int i = 0; i < 32; ++i) fmac1(acc[i], c[x], r[i]); } } while (0)
      { u32x4 Aua[NX], Ava[NX], Bua[NX], Bva[NX]; u32x2 Aub[NX], Avb[NX], Bub[NX], Bvb[NX];
        PEER_LOAD(A, 0);
#pragma unroll 1
        for (int k = 0; k < 128; k += 2 * NX) {
            PEER_LOAD(B, k + NX); PEER_COMPUTE(A, k);
            { const int kn = min(k + 2 * NX, 128 - NX); PEER_LOAD(A, kn); }
            PEER_COMPUTE(B, k + NX);
        } }
#undef PEER_DEC
#undef NX
#undef PEER_LOAD
#undef PEER_COMPUTE
      asm volatile("" ::: "memory");
      int tok2 = tok, lane2 = lane; asm volatile("" : "+v"(tok2), "+v"(lane2));
      float s2 = 0.f;
#pragma unroll
      for (int j = 0; j < 2; ++j)
#pragma unroll
          for (int q = 0; q < 4; ++q) { const u32x2 w = ldb64(rH2, ((unsigned)tok2 * 2048u + 256u * (4 * j + q) + 4u * lane2) * 2u);
              const f32x4 a = (f32x4){__uint_as_float(w.x << 16), __uint_as_float(w.x & 0xffff0000u), __uint_as_float(w.y << 16), __uint_as_float(w.y & 0xffff0000u)};
#pragma unroll
              for (int i = 0; i < 4; ++i) { acc[16 * j + 4 * q + i] += a[i]; s2 += acc[16 * j + 4 * q + i] * acc[16 * j + 4 * q + i]; } }
      const float rf = 1.0f / sqrtf(wave_sum(s2) * (1.f / 2048.f) + NORM_EPS);
#pragma unroll
      for (int j = 0; j < 2; ++j)
#pragma unroll
          for (int q = 0; q < 4; ++q) { const f32x4 a = ldf128(rGF, (256u * (4 * j + q) + 4u * lane2) * 4u); f32x4 oa;
#pragma unroll
              for (int i = 0; i < 4; ++i) oa[i] = acc[16 * j + 4 * q + i] * rf * a[i];
              float* op = OUT + (size_t)tok2 * 2048 + 256 * (4 * j + q) + 4 * lane2;
              __builtin_nontemporal_store(oa, (GAS f32x4*)op); }
    }
}
}
#ifndef MK_N_LAUNCHES
#define MK_N_LAUNCHES 1
#endif
#define MK_PROBE_PH -1
#define MK_PROBE_DIV 2
constexpr int N_PHASES = 9;
constexpr int N_LAUNCHES = MK_N_LAUNCHES;
struct Args { const float* in[19]; float* out; unsigned char* ws; int ph_lo, ph_hi; };
static_assert(sizeof(Args) == 19 * 8 + 8 + 8 + 8, "no padding");

__global__ void __launch_bounds__(NWAVES * 64, 2) hybrid_fwd(Args args) {
    extern __shared__ __attribute__((aligned(16))) unsigned char lds_raw[];
    Frame F;
    F.lds = (LAS unsigned char*)lds_raw;
    F.MISC = (volatile LAS unsigned*)(F.lds + MISC_OFF);
    F.tid = threadIdx.x; F.lane = F.tid & 63; F.wave = __builtin_amdgcn_readfirstlane(F.tid >> 6);
    F.G = gridDim.x; { const int bx = blockIdx.x; F.vcu = (F.G % 8 == 0) ? (bx % 8) * (F.G / 8) + bx / 8 : bx; }
    F.ws = args.ws; F.out = args.out;
#pragma unroll
    for (int i = 0; i < 19; ++i) F.in[i] = args.in[i];
    for (int u = F.tid; u < (LDS_BYTES - LDSCTL_OFF) / 4; u += NWAVES * 64) ((LAS unsigned*)(F.lds + LDSCTL_OFF))[u] = 0u;
    __syncthreads();
    XcdBarrier bar; bar.bar = (unsigned*)(F.ws + WS_CTL) + CW_BAR; bar.x = 0; bar.st = nullptr;
    if (N_LAUNCHES == 1) bar = xcd_barrier_post((unsigned*)(F.ws + WS_CTL) + CW_BAR, F.MISC + 8);
    const int lo = args.ph_lo, hi = args.ph_hi;
#define IN(k) (lo <= (k) && (k) < hi)
#if MK_PROBE_PH >= 0
    unsigned long long tp0 = (MK_PROBE_PH == 0 || MK_PROBE_PH == 9) ? __builtin_amdgcn_s_memrealtime() : 0ull, tp1 = 0ull;
#define SEAM(k) do { if (IN(k) && IN((k) + 1)) xcd_barrier(bar); if (MK_PROBE_PH == (k)) tp1 = __builtin_amdgcn_s_memrealtime(); if (MK_PROBE_PH == (k) + 1) tp0 = __builtin_amdgcn_s_memrealtime(); } while (0)
#else
#define SEAM(k) do { if (IN(k) && IN((k) + 1)) xcd_barrier(bar); } while (0)
#endif
    const size_t T2048 = (size_t)256 * 2048 * 2, T1024 = (size_t)256 * 1024 * 2, T512 = (size_t)256 * 512 * 2;
    float* cosT = WSP(float, WS_COS); float* sinT = WSP(float, WS_SIN);
    float* ssq_q = WSP(float, WS_SSQ_Q); float* ssq_kv = WSP(float, WS_SSQ_KV); float* ssq2 = WSP(float, WS_SSQ_2);

    if (IN(0)) { p0_prologue<0>(F, F.vcu, F.G); } SEAM(0);
    if (IN(1)) {
        SchedP1 S{F.G, (int)blockIdx.x, (const char*)(F.ws + WS_HN1), (const char*)(F.ws + WS_WIN), (const char*)(F.ws + WS_WVT), T1024};
        EpiP1 E{WSP(bf16_t, WS_NAQ), WSP(bf16_t, WS_NAK), WSP(bf16_t, WS_VT), WSP(unsigned char, WS_CQ), WSP(unsigned char, WS_CKV), WSP(bf16_t, WS_KR), WSP(unsigned char, WS_GA), WSP(unsigned char, WS_GB), ssq_q, ssq_kv, cosT, sinT};
        pg8::gemm_phase<EpiP1, SchedP1, true, -6>(F.lds, 2048, S, E);
        { const int extra = P1_UNITS % F.G, bx = (int)blockIdx.x; if (extra != 0 && bx >= extra) p0_prologue<1>(F, bx - extra, F.G - extra); else if (extra == 0) p0_prologue<1>(F, bx, F.G); }
    } SEAM(1);
    if (IN(2)) {
        LAS float* relb = (LAS float*)F.lds + 64; LAS float* metab = relb + 16 * 15 * 31 + 128; LAS float* wsf = metab + 256 + F.wave * 64;
        for (int i = F.tid; i < 16 * 15 * 31; i += NWAVES * 64) relb[i] = F.in[4][i];
        if (F.tid < 256) metab[F.tid] = F.in[5][F.tid];
        __syncthreads();
        const int gw = F.vcu * NWAVES + F.wave, NGW = F.G * NWAVES;
        for (int task = gw; task < NBATCH * 16 * 32 * 2; task += NGW)
            att::na_task(task, WSP(bf16_t, WS_NAQ), WSP(bf16_t, WS_NAK), WSP(bf16_t, WS_VT), WSP(unsigned char, WS_ONA), relb, metab, wsf, F.lane);
        __syncthreads();
    } SEAM(2);
    if (IN(3)) {
        SchedP3 S{F.G, (int)blockIdx.x, (const char*)(F.ws + WS_CQ), (const char*)(F.ws + WS_CKV), (const char*)(F.ws + WS_WUQ), (const char*)(F.ws + WS_WUKV), T512 / 2};
        EpiP3 E{WSP(bf16_t, WS_QM), WSP(bf16_t, WS_KN), WSP(bf16_t, WS_VV), ssq_q, ssq_kv, cosT, sinT};
        pg8::gemm_phase<EpiP3, SchedP3, true, -4>(F.lds, 512, S, E);
    } SEAM(3);
    if (IN(4)) {
        for (int id = F.vcu; id < NBATCH * 16 * 8; id += F.G) { const int bh = id >> 3, qb = id & 7;
            att::mla_unit(bh >> 4, bh & 15, qb, WSP(bf16_t, WS_QM), WSP(bf16_t, WS_KN), WSP(bf16_t, WS_KR), WSP(bf16_t, WS_VV), WSP(unsigned char, WS_OMLA), (LAS char*)F.lds); }
        __syncthreads();
    } SEAM(4);
    if (IN(5)) {
        { SchedGrid S{F.G, (int)blockIdx.x, 64, 8, (const char*)(F.ws + WS_ONA), (const char*)(F.ws + WS_WNA), T512};
          EpiP5a E{WSP(unsigned char, WS_GA), WSP(bf16_t, WS_T1)};
          pg8::gemm_phase<EpiP5a, SchedGrid, true, -9>(F.lds, 1024, S, E); }
        { SchedGrid S{F.G, (int)blockIdx.x, 64, 8, (const char*)(F.ws + WS_OMLA), (const char*)(F.ws + WS_WMLA), T1024};
          EpiP5b E{WSP(unsigned char, WS_GB), WSP(bf16_t, WS_T1), WSP(unsigned char, WS_MERGED)};
          pg8::gemm_phase<EpiP5b, SchedGrid, true, -11>(F.lds, 2048, S, E); }
    } SEAM(5);
    if (IN(6)) {
        { SchedGrid S{F.G, (int)blockIdx.x, 64, 8, (const char*)(F.ws + WS_MERGED), (const char*)(F.ws + WS_WOUT), T1024};
          EpiP6 E{F.in[0], WSP(bf16_t, WS_H2B), ssq2};
          pg8::gemm_phase<EpiP6, SchedGrid, true, -11>(F.lds, 2048, S, E); }
        {
#define P6_SRC(i_) (((i_) >> 20 ? F.in[17] : F.in[16]) + (size_t)(((i_) >> 6) & 16383u) * 2048 + 4 * ((i_) & 63u))
          const unsigned NTOT = 2u * 16384u * 64u, STEP = (unsigned)F.G * 512u; unsigned i = (unsigned)F.vcu * 512u + F.tid;
          f32x4 xc[8];
          if (i < NTOT) { const float* src = P6_SRC(i);
#pragma unroll
              for (int q = 0; q < 8; ++q) xc[q] = *(const GAS f32x4*)(src + 256 * q); }
          while (i < NTOT) { const unsigned in_ = i + STEP; f32x4 xn[8];
              { const float* src = P6_SRC(in_ < NTOT ? in_ : i);
#pragma unroll
                for (int q = 0; q < 8; ++q) xn[q] = *(const GAS f32x4*)(src + 256 * q); }
              const unsigned isv = i >> 20, row = (i >> 6) & 16383u, l = i & 63u; const float sc = isv ? 4.f : 64.f; peer::v16f_t a, b;
#pragma unroll
              for (int q = 0; q < 8; ++q)
#pragma unroll
                  for (int e = 0; e < 4; ++e) { const int k_ = 4 * q + e;
                      if (k_ & 1) b[k_ >> 1] = xc[q][e] * sc; else a[k_ >> 1] = xc[q][e] * sc; }
              const peer::v6u_t w = __builtin_amdgcn_cvt_scalef32_2xpk16_fp6_f32(a, b, 1.0f);
              unsigned char* rec = WSP(unsigned char, WS_U) + (size_t)row * 3072 + (isv ? 1536 : 0);
              *(GAS u32x4*)(rec + l * 16) = (u32x4){w[0], w[1], w[2], w[3]}; *(GAS u32x2*)(rec + 1024 + l * 8) = (u32x2){w[4], w[5]};
#pragma unroll
              for (int q = 0; q < 8; ++q) xc[q] = xn[q];
              i = in_; }
#undef P6_SRC
        }
    } SEAM(6);
    if (IN(7)) {
        SchedGrid S{F.G, (int)blockIdx.x, 64, 8, (const char*)(F.ws + WS_H2B), (const char*)(F.ws + WS_WSC), T2048};
        EpiP7 E{ssq2, WSP(_Float16, WS_SC)};
        pg8::gemm_phase<EpiP7, SchedGrid>(F.lds, 2048, S, E);
    } SEAM(7);
    if (IN(8)) {
        const int nch = (MREAL / peer::CH - F.vcu + F.G - 1) / F.G; const bool both_first = (nch == 2) && (F.vcu & 1);
        for (int op = 0; op < 2 * nch; ++op) {
            const bool sel = both_first ? (op < 2) : !(op & 1); const int ci = both_first ? (op & 1) : (op >> 1), chunk = F.vcu + ci * F.G;
            const int b2 = both_first ? ci : 0;
            LAS int* SE = (LAS int*)(F.lds + (b2 ? peer::OFF_SE2 : peer::OFF_SE)); LAS float* SG = (LAS float*)(F.lds + (b2 ? peer::OFF_SG2 : peer::OFF_SG));
            if (sel) peer::peer_select(chunk, WSP(_Float16, WS_SC), (LAS char*)F.lds, F.tid, SE, SG);
            else peer::peer_gather(chunk, WSP(bf16_t, WS_H2B), WSP(unsigned char, WS_U), F.in[13], F.in[18], F.out, F.tid, SE, SG); }
    }
#if MK_PROBE_PH >= 0
    xcd_barrier(bar); tp1 = (MK_PROBE_PH >= 8) ? __builtin_amdgcn_s_memrealtime() : tp1;
    if (blockIdx.x == 0 && F.tid == 0) F.out[0] = (float)(tp1 - tp0) * (0.01f / MK_PROBE_DIV);
#endif
#undef IN
#undef SEAM
}

extern "C" void kernel_launch(void* const* d_in, const int* in_sizes, int n_in, void* d_out, int out_size, void* d_ws, size_t ws_size, hipStream_t stream) {
    static int grid = 0;
    if (grid == 0) {
        if (n_in != 19 || in_sizes[0] != MREAL * DM || out_size != MREAL * DM || ws_size < WS_END) {
            fprintf(stderr, "kernel_launch: shape/workspace mismatch: n_in %d in0 %d out %d ws %zu (need %zu); nothing launched\n", n_in, n_in > 0 ? in_sizes[0] : -1, out_size, ws_size, (size_t)WS_END); grid = -1; return; }
        int dev = 0, cus = 0, per_cu = 0;
        if (hipGetDevice(&dev) != hipSuccess || hipDeviceGetAttribute(&cus, hipDeviceAttributeMultiprocessorCount, dev) != hipSuccess) { fprintf(stderr, "kernel_launch: device query failed\n"); grid = -1; return; }
        if (hipFuncSetAttribute((const void*)hybrid_fwd, hipFuncAttributeMaxDynamicSharedMemorySize, LDS_BYTES) != hipSuccess) { fprintf(stderr, "kernel_launch: hipFuncSetAttribute failed\n"); grid = -1; return; }
        if (hipOccupancyMaxActiveBlocksPerMultiprocessor(&per_cu, (const void*)hybrid_fwd, NWAVES * 64, LDS_BYTES) != hipSuccess || per_cu < 1)
            fprintf(stderr, "kernel_launch: note: occupancy query reports %d workgroups per CU\n", per_cu);
        (void)hipGetLastError();
        grid = cus;
    }
    if (grid < 0) return;
    if (hipMemsetAsync((char*)d_ws + WS_CTL, 0, CTL_ZERO_BYTES, stream) != hipSuccess) { fprintf(stderr, "kernel_launch: hipMemsetAsync failed\n"); return; }
    Args a{};
    for (int i = 0; i < 19; ++i) a.in[i] = (const float*)d_in[i];
    a.out = (float*)d_out; a.ws = (unsigned char*)d_ws;
    for (int li = 0; li < N_LAUNCHES; ++li) {
        a.ph_lo = (N_LAUNCHES == 1) ? 0 : li; a.ph_hi = (N_LAUNCHES == 1) ? N_PHASES : li + 1;
        hipLaunchKernelGGL(hybrid_fwd, dim3(grid), dim3(NWAVES * 64), LDS_BYTES, stream, a);
        const hipError_t le = hipPeekAtLastError();
        if (le != hipSuccess) { fprintf(stderr, "kernel_launch: launch %d failed: %s\n", li, hipGetErrorName(le)); break; }
    }
}
```

```cpp
#include <hip/hip_runtime.h>
#include <cstdio>
#include <cstdint>

#define LAS __attribute__((address_space(3)))
#define GAS __attribute__((address_space(1)))
typedef unsigned short bf16_t;
typedef short bf16x8 __attribute__((ext_vector_type(8)));
typedef short s16x4 __attribute__((ext_vector_type(4)));
typedef float f32x4 __attribute__((ext_vector_type(4)));
typedef float f32x2 __attribute__((ext_vector_type(2)));
typedef float f32x16 __attribute__((ext_vector_type(16)));
typedef unsigned u32x4 __attribute__((ext_vector_type(4)));
typedef unsigned u32x2 __attribute__((ext_vector_type(2)));

constexpr int DM = 2048, NBATCH = 8, SEQ = 2048, NMETA = 16;
constexpr int MREAL = NBATCH * SEQ;
constexpr int MPAD = MREAL + 256;
constexpr int NPOS = SEQ + NMETA;
constexpr float NORM_EPS = 1e-6f;
constexpr int C_NAQ = 0, C_NAK = 1024, C_CQ = 2048, C_CKV = 2560, C_GA = 3072, C_GB = 5120, C_KR = 7168, NMAIN = 7424;
constexpr int VT_PITCH = MPAD;

constexpr size_t MiB = 1u << 20;
constexpr size_t WS_CTL = 0, CTL_ZERO_BYTES = 1 * MiB;
constexpr size_t WS_SSQ_Q = 481 * MiB, WS_SSQ_KV = 482 * MiB, WS_SSQ_2 = 486 * MiB;
constexpr size_t WS_COS = 1 * MiB, WS_SIN = 1 * MiB + 512 * 1024;
constexpr size_t WS_WUQ = 2 * MiB, WS_WUKV = 5 * MiB, WS_WNA = 9 * MiB, WS_WMLA = 13 * MiB, WS_WOUT = 21 * MiB, WS_WSC = 29 * MiB;
constexpr size_t WS_GA = 37 * MiB, WS_GB = 101 * MiB;
constexpr size_t WS_KR = 165 * MiB;
constexpr size_t WS_WIN = 167 * MiB + 256 * 1024, WS_WVT = WS_WIN + 29 * MiB;
constexpr size_t WS_ONA = 190 * MiB;
constexpr size_t WS_NAQ = 222 * MiB, WS_NAK = 254 * MiB, WS_VT = WS_NAK + 32 * MiB + 512 * 1024;
constexpr size_t WS_HN1 = 319 * MiB;
constexpr size_t WS_CQ = 448 * MiB, WS_CKV = 464 * MiB;
constexpr size_t WS_QM = 222 * MiB, WS_KN = 318 * MiB, WS_VV = 383 * MiB;
constexpr size_t WS_OMLA = 448 * MiB;
constexpr size_t WS_MERGED = 222 * MiB, WS_T1 = 286 * MiB;
constexpr size_t WS_H2 = 37 * MiB, WS_H2B = 293 * MiB;
constexpr size_t WS_U = 69 * MiB, WS_V = 133 * MiB;
constexpr size_t WS_SC = 165 * MiB;
constexpr size_t WS_END = 512 * MiB;
static_assert(WS_CKV + (size_t)MPAD * 512 * 2 <= WS_SSQ_Q && WS_SSQ_Q + (size_t)8 * MPAD * 4 <= WS_SSQ_KV && WS_SSQ_KV + (size_t)8 * MPAD * 4 <= 483 * MiB && WS_SSQ_2 + (size_t)32 * MREAL * 4 <= WS_END, "ssq slabs");
static_assert(WS_VT + (size_t)1024 * MPAD * 2 <= WS_HN1 && WS_HN1 + (size_t)MPAD * 2048 * 2 <= WS_CQ && WS_CKV + (size_t)MPAD * 512 * 2 <= WS_END, "map P1");
static_assert(WS_WVT + 4 * MiB <= WS_NAQ && WS_KR + (size_t)MPAD * 64 * 2 <= WS_WIN && WS_ONA + 32 * MiB <= WS_NAQ, "map P1b");
static_assert(WS_QM + 96 * MiB <= WS_KN && WS_KN + 65 * MiB <= WS_VV && WS_VV + 65 * MiB <= WS_OMLA && WS_OMLA + 64 * MiB <= WS_END, "map P3");
static_assert(WS_T1 + 128 * MiB <= WS_OMLA && WS_H2 + 128 * MiB <= WS_KR && WS_SC + 128 * MiB <= WS_H2B && WS_H2B + 64 * MiB <= WS_END, "map P5+");
static_assert(WS_GA + 32 * MiB <= WS_U && WS_U + 24 * MiB <= WS_GB && WS_GB + 32 * MiB <= WS_V && WS_V + 24 * MiB <= WS_KR, "expert tables between the gate codes");

constexpr int CW_BAR = 4096;

constexpr int RING_BYTES = 131072;
constexpr int LDSCTL_OFF = RING_BYTES, MISC_OFF = LDSCTL_OFF + 320;
constexpr int LDS_BYTES = 147456;
constexpr int NWAVES = 8;

#define LDS_WAIT() asm volatile("s_waitcnt lgkmcnt(0)" ::: "memory")
#define VM_WAIT() asm volatile("s_waitcnt vmcnt(0)" ::: "memory")
#define SBAR() __builtin_amdgcn_sched_barrier(0)
typedef __bf16 bf16x2_t __attribute__((ext_vector_type(2)));
__device__ __forceinline__ unsigned cvt_pk_bf16(float lo, float hi) { const f32x2 v = {lo, hi}; const bf16x2_t b = __builtin_convertvector(v, bf16x2_t); return __builtin_bit_cast(unsigned, b); }
__device__ __forceinline__ float bf_lo(unsigned w) { return __uint_as_float(w << 16); }
__device__ __forceinline__ float bf_hi(unsigned w) { return __uint_as_float(w & 0xffff0000u); }
__device__ __forceinline__ u32x4 pack8(const f32x4 a, const f32x4 b) { u32x4 w; w.x = cvt_pk_bf16(a[0], a[1]); w.y = cvt_pk_bf16(a[2], a[3]); w.z = cvt_pk_bf16(b[0], b[1]); w.w = cvt_pk_bf16(b[2], b[3]); return w; }
__device__ __forceinline__ u32x2 pack8_fp8(f32x4 a, f32x4 b) {
#pragma unroll
    for (int i = 0; i < 4; ++i) { a[i] = __builtin_fminf(__builtin_fmaxf(a[i], -448.f), 448.f); b[i] = __builtin_fminf(__builtin_fmaxf(b[i], -448.f), 448.f); }
    int w0 = 0, w1 = 0; w0 = __builtin_amdgcn_cvt_pk_fp8_f32(a[0], a[1], w0, false); w0 = __builtin_amdgcn_cvt_pk_fp8_f32(a[2], a[3], w0, true);
    w1 = __builtin_amdgcn_cvt_pk_fp8_f32(b[0], b[1], w1, false); w1 = __builtin_amdgcn_cvt_pk_fp8_f32(b[2], b[3], w1, true); return (u32x2){(unsigned)w0, (unsigned)w1}; }
__device__ __forceinline__ unsigned char f32_to_fp8(float x) { x = __builtin_fminf(__builtin_fmaxf(x, -448.f), 448.f); return (unsigned char)(__builtin_amdgcn_cvt_pk_fp8_f32(x, 0.f, 0, false) & 0xff); }
__device__ __forceinline__ u32x2 pack8_u8(const f32x4 a, const f32x4 b) { u32x2 w; unsigned x = 0u, y = 0u;
    x = __builtin_amdgcn_cvt_pk_u8_f32(a[0] * 255.f, 0u, x); x = __builtin_amdgcn_cvt_pk_u8_f32(a[1] * 255.f, 1u, x); x = __builtin_amdgcn_cvt_pk_u8_f32(a[2] * 255.f, 2u, x); x = __builtin_amdgcn_cvt_pk_u8_f32(a[3] * 255.f, 3u, x);
    y = __builtin_amdgcn_cvt_pk_u8_f32(b[0] * 255.f, 0u, y); y = __builtin_amdgcn_cvt_pk_u8_f32(b[1] * 255.f, 1u, y); y = __builtin_amdgcn_cvt_pk_u8_f32(b[2] * 255.f, 2u, y); y = __builtin_amdgcn_cvt_pk_u8_f32(b[3] * 255.f, 3u, y);
    w.x = x; w.y = y; return w; }
__device__ __forceinline__ void unpack8_u8(const u32x2 w, f32x4& a, f32x4& b) { const float k = 1.f / 255.f;
    a = (f32x4){(float)(w.x & 0xffu), (float)((w.x >> 8) & 0xffu), (float)((w.x >> 16) & 0xffu), (float)(w.x >> 24)} * k;
    b = (f32x4){(float)(w.y & 0xffu), (float)((w.y >> 8) & 0xffu), (float)((w.y >> 16) & 0xffu), (float)(w.y >> 24)} * k; }
__device__ __forceinline__ u32x2 pack4(const f32x4 a) { u32x2 w; w.x = cvt_pk_bf16(a[0], a[1]); w.y = cvt_pk_bf16(a[2], a[3]); return w; }
__device__ __forceinline__ float wave_sum(float v) {
#pragma unroll
    for (int o = 1; o < 64; o <<= 1) v += __shfl_xor(v, o);
    return v;
}
__device__ __forceinline__ float sigmoidf_(float x) { return __builtin_amdgcn_rcpf(1.0f + __builtin_amdgcn_exp2f(-1.4426950408889634f * x)); }
__device__ __forceinline__ int crow(int r, int hi) { return (r & 3) + 8 * (r >> 2) + 4 * hi; }
#define PG8_AUX 0
namespace pg8 {
constexpr int BM = 256, BK = 64, HALF = 128, HTB = HALF * BK * 2  , STAGE_BYTES = 8 * HTB, NXCD = 8, WGM = 8;
__host__ __device__ __forceinline__ int lds_byte(int r, int c) { const int st = (r >> 4) * 2 + (c >> 5), rr = r & 15, cc = c & 31, ob = rr * 64 + cc * 2; return st * 1024 + (ob ^ (((ob >> 9) & 1) << 5)); }
__host__ __device__ __forceinline__ void stage_rc(int b, int& R, int& C) { const int st = b / 1024, sb = b % 1024, swz = sb ^ (((sb >> 9) & 1) << 5); R = (st >> 1) * 16 + swz / 64; C = (st & 1) * 32 + (swz % 64) / 2; }
__host__ __device__ __forceinline__ int perm32(int rho) { const int n = rho >> 4, i = rho & 15; return 8 * (i >> 2) + 4 * n + (i & 3); }

struct Unit { int pm, pn, kind; };

__device__ __forceinline__ void grid_order(int L, int nM, int nN, int& pm, int& pn) {
    const int nwg = nM * nN; int wgid = L;
    { const int q = nwg / NXCD, r = nwg % NXCD, xcd = wgid % NXCD, off = wgid / NXCD; wgid = (xcd < r ? xcd * (q + 1) : r * (q + 1) + (xcd - r) * q) + off; }
    const int nig = WGM * nN, gid = wgid / nig, fm = gid * WGM, gsz = (nM - fm) < WGM ? (nM - fm) : WGM;
    pm = fm + ((wgid % nig) % gsz); pn = (wgid % nig) / gsz;
}

typedef int v8i_t __attribute__((ext_vector_type(8)));
template <class Epi, class Sched, bool F8 = false, int F8_SCALE_EXP = 0>
__device__ __forceinline__ void gemm_phase(LAS unsigned char* lds, const int K, const Sched& S, const Epi& E) {
    const int tid = threadIdx.x, wid = __builtin_amdgcn_readfirstlane(tid >> 6), lane = tid & 63, wr = wid >> 2, wc = wid & 3, fr = lane & 15, fq = lane >> 4;
    int f8sa = 0x01010101 * (127 + F8_SCALE_EXP), f8sb = 0x7f7f7f7f; asm volatile("" : "+v"(f8sa), "+v"(f8sb));
    const int Kb = F8 ? K : 2 * K;
    const int nt = Kb / 128;
    unsigned voffA[2], voffB[2];
#pragma unroll
    for (int i = 0; i < 2; ++i) { int R, C; stage_rc(tid * 16 + i * 8192, R, C); const int Rb = Epi::PERM ? ((R & ~31) + perm32(R & 31)) : R;
        voffA[i] = (unsigned)(R * Kb + C * 2); voffB[i] = (unsigned)(Rb * Kb + C * 2); }
    const size_t kstep = (size_t)128;
    const size_t hstep = (size_t)HALF * Kb;
    const unsigned ldsw = (unsigned)wid * 1024u;
    const int aoff = lds_byte(wr * 64 + fr, F8 ? fq * 16 : fq * 8), boff = lds_byte(wc * 32 + fr, F8 ? fq * 16 : fq * 8);
#define PG8_SA(b, h) (((b) * 2 + (h)) * HTB)
#define PG8_SB(b, h) ((4 + (b) * 2 + (h)) * HTB)
#define PG8_STAGE(bufoff, gbase, voff) do { _Pragma("unroll") for (int _i = 0; _i < 2; ++_i) \
        __builtin_amdgcn_global_load_lds((const unsigned*)((const char*)(gbase) + (voff)[_i]), (LAS unsigned*)(lds + (bufoff) + ldsw + _i * 8192), 16, 0, PG8_AUX); } while (0)
#define PG8_LDA(dst, b, h) do { _Pragma("unroll") for (int m = 0; m < 4; ++m) _Pragma("unroll") for (int k = 0; k < 2; ++k) dst[m][k] = *(const LAS bf16x8*)(lds + PG8_SA(b, h) + aoff + m * 2048 + (F8 ? k * 16 : k * 1024)); } while (0)
#define PG8_LDB(dst, b, h) do { _Pragma("unroll") for (int n = 0; n < 2; ++n) _Pragma("unroll") for (int k = 0; k < 2; ++k) dst[n][k] = *(const LAS bf16x8*)(lds + PG8_SB(b, h) + boff + n * 2048 + (F8 ? k * 16 : k * 1024)); } while (0)
#define PG8_F8OP(X) __builtin_bit_cast(v8i_t, __builtin_shufflevector(X[0], X[1], 0, 1, 2, 3, 4, 5, 6, 7, 8, 9, 10, 11, 12, 13, 14, 15))
#define PG8_MMA(ai, bj, At, Bt) do { __builtin_amdgcn_s_setprio(1); \
        if constexpr (F8) { _Pragma("unroll") for (int m = 0; m < 4; ++m) _Pragma("unroll") for (int n = 0; n < 2; ++n) \
            asm volatile("v_mfma_scale_f32_16x16x128_f8f6f4 %0, %1, %2, %0, %3, %4 op_sel_hi:[0,0,0]" : "+v"(acc[ai][bj][m][n]) : "v"(PG8_F8OP(Bt[n])), "v"(PG8_F8OP(At[m])), "v"(f8sa), "v"(f8sb)); } \
        else { _Pragma("unroll") for (int m = 0; m < 4; ++m) _Pragma("unroll") for (int n = 0; n < 2; ++n) _Pragma("unroll") for (int k = 0; k < 2; ++k) \
            acc[ai][bj][m][n] = __builtin_amdgcn_mfma_f32_16x16x32_bf16(Bt[n][k], At[m][k], acc[ai][bj][m][n], 0, 0, 0); } \
        __builtin_amdgcn_s_setprio(0); } while (0)
#define PG8_WAIT_V(n) asm volatile("s_waitcnt vmcnt(" #n ")" ::: "memory")
#define PG8_WAIT_L(n) asm volatile("s_waitcnt lgkmcnt(" #n ")" ::: "memory")
#define PG8_BAR __builtin_amdgcn_s_barrier()
#define PG8_SCHED __builtin_amdgcn_sched_barrier(0)
    Unit cur, nxt; int ui = 0;
    if (!S.next(0, cur)) return;
    f32x4 acc[2][2][4][2];
#pragma unroll
    for (int a = 0; a < 2; ++a)
#pragma unroll
        for (int b = 0; b < 2; ++b)
#pragma unroll
            for (int m = 0; m < 4; ++m)
#pragma unroll
                for (int n = 0; n < 2; ++n) acc[a][b][m][n] = (f32x4){0.f, 0.f, 0.f, 0.f};
    bf16x8 At[4][2], B0[2][2], B1[2][2];
    const char* cA = S.pa(cur); const char* cB = S.pb(cur);
    PG8_STAGE(PG8_SB(0, 0), cB, voffB); PG8_STAGE(PG8_SB(0, 1), cB + hstep, voffB); PG8_STAGE(PG8_SA(0, 0), cA, voffA); PG8_STAGE(PG8_SA(0, 1), cA + hstep, voffA);
    if (wr == 1) PG8_BAR;
    PG8_WAIT_V(2); PG8_BAR;
    PG8_STAGE(PG8_SB(1, 0), cB + kstep, voffB); PG8_STAGE(PG8_SA(1, 0), cA + kstep, voffA); PG8_STAGE(PG8_SB(1, 1), cB + hstep + kstep, voffB);
    PG8_WAIT_V(6); PG8_BAR;
    for (;;) {
        const bool has_next = S.next(ui + 1, nxt);
        const char* nA = has_next ? S.pa(nxt) : cA; const char* nB = has_next ? S.pb(nxt) : cB;
        for (int t = 0; t < nt; t += 2) {
            const bool last = (t == nt - 2);
            const char* a1 = cA + (size_t)(t + 1) * kstep;
            const char* a2 = last ? nA : cA + (size_t)(t + 2) * kstep; const char* b2 = last ? nB : cB + (size_t)(t + 2) * kstep;
            const char* a3 = a2 + kstep; const char* b3 = b2 + kstep;
            PG8_LDB(B0, 0, 0); PG8_LDB(B1, 0, 1); PG8_SCHED; PG8_LDA(At, 0, 0); PG8_STAGE(PG8_SA(1, 1), a1 + hstep, voffA);
            PG8_WAIT_V(8); PG8_WAIT_L(0); PG8_BAR; PG8_MMA(0, 0, At, B0); PG8_MMA(0, 1, At, B1); PG8_BAR; PG8_SCHED;
            PG8_LDA(At, 0, 1); PG8_STAGE(PG8_SB(0, 0), b2, voffB); PG8_STAGE(PG8_SB(0, 1), b2 + hstep, voffB); PG8_STAGE(PG8_SA(0, 0), a2, voffA);
            PG8_WAIT_V(8); PG8_WAIT_L(0); PG8_BAR; PG8_MMA(1, 0, At, B0); PG8_MMA(1, 1, At, B1); PG8_BAR; PG8_SCHED;
            PG8_LDB(B0, 1, 0); PG8_LDB(B1, 1, 1); PG8_SCHED; PG8_LDA(At, 1, 0); PG8_STAGE(PG8_SA(0, 1), a2 + hstep, voffA);
            PG8_WAIT_V(8); PG8_WAIT_L(0); PG8_BAR; PG8_MMA(0, 0, At, B0); PG8_MMA(0, 1, At, B1); PG8_BAR; PG8_SCHED;
            PG8_LDA(At, 1, 1); PG8_STAGE(PG8_SB(1, 0), b3, voffB); PG8_STAGE(PG8_SB(1, 1), b3 + hstep, voffB); PG8_STAGE(PG8_SA(1, 0), a3, voffA);
            PG8_WAIT_V(8); PG8_WAIT_L(0); PG8_BAR; PG8_MMA(1, 0, At, B0); PG8_MMA(1, 1, At, B1); PG8_BAR; PG8_SCHED;
        }
        if (wr == 0) PG8_BAR;
        if constexpr (F8) asm volatile("s_nop 15\n\ts_nop 7" ::: "memory");
        if constexpr (Epi::HAS_PRE) {
            E.pre(cur, (LAS float*)(lds + STAGE_BYTES + 1024), tid); PG8_WAIT_L(0); PG8_BAR; }
        E(acc, cur, wr, wc, fr, fq, (const LAS float*)(lds + STAGE_BYTES + 1024));
        if (!has_next) break;
#pragma unroll
        for (int a = 0; a < 2; ++a)
#pragma unroll
            for (int b = 0; b < 2; ++b)
#pragma unroll
                for (int m = 0; m < 4; ++m)
#pragma unroll
                    for (int n = 0; n < 2; ++n) acc[a][b][m][n] = (f32x4){0.f, 0.f, 0.f, 0.f};
        cur = nxt; cA = nA; cB = nB; ++ui;
        if (wr == 1) PG8_BAR;
    }
    PG8_WAIT_V(0);
    PG8_BAR;
#undef PG8_SA
#undef PG8_SB
#undef PG8_STAGE
#undef PG8_LDA
#undef PG8_LDB
#undef PG8_MMA
#undef PG8_F8OP
#undef PG8_WAIT_V
#undef PG8_WAIT_L
#undef PG8_BAR
#undef PG8_SCHED
}
}
typedef GAS unsigned gu32;
#define RLX_AGENT __ATOMIC_RELAXED, __HIP_MEMORY_SCOPE_AGENT
#define XB_TMO      128
#define XB_XCNT(j)  (256  + 64 * (j))
#define XB_XSUB(j)  (1280 + 64 * (j))
#define XB_XGEN(j)  (2304 + 64 * (j))
#define XB_TOP      3328
#define XB_TOPGEN   3392
#define XCD_BAR_WORDS 3456
#define XB_SPIN_CAP (1u << 18)
__device__ __forceinline__ unsigned xb_ld(unsigned* p)              { return __hip_atomic_load(p, __ATOMIC_RELAXED, __HIP_MEMORY_SCOPE_AGENT); }
__device__ __forceinline__ unsigned xb_add(unsigned* p, unsigned v) { return __hip_atomic_fetch_add(p, v, __ATOMIC_RELAXED, __HIP_MEMORY_SCOPE_AGENT); }
__device__ __forceinline__ unsigned xb_xcc_id() { return (unsigned)__builtin_amdgcn_s_getreg((3 << 11) | 20) & 0xFu; }
#define XB_SPIN(cond, bar) do { unsigned _sp = 0; while (cond) { __builtin_amdgcn_s_sleep(1); \
    if ((++_sp & 255u) == 0u) { if (xb_ld(&(bar)[XB_TMO])) break; if (_sp > XB_SPIN_CAP) { atomicAdd(&(bar)[XB_TMO], 1u); break; } } } } while (0)
struct XcdBarrier { unsigned* bar; unsigned x; volatile LAS unsigned* st; };
__device__ __forceinline__ XcdBarrier xcd_barrier_post(unsigned* bar, volatile LAS unsigned* st) {
    XcdBarrier b; b.bar = bar; b.x = xb_xcc_id(); b.st = st;
    if (threadIdx.x == 0) (void)xb_add(&bar[XB_XCNT(b.x)], 1u);
    return b;
}
__device__ __forceinline__ void xcd_barrier_complete(unsigned* bar, unsigned x, unsigned& nloc, unsigned& nx) {
    const unsigned G = gridDim.x * gridDim.y * gridDim.z;
    unsigned sum, cnt, mine, sp = 0u;
    for (;;) {
        sum = 0u; cnt = 0u; mine = 0u;
#pragma unroll
        for (unsigned j = 0; j < 16; ++j) { const unsigned c = xb_ld(&bar[XB_XCNT(j)]); sum += c; cnt += (c > 0u) ? 1u : 0u; mine = (j == x) ? c : mine; }
        if (sum == G) break;
        __builtin_amdgcn_s_sleep(1);
        if ((++sp & 255u) == 0u) { if (xb_ld(&bar[XB_TMO])) break; if (sp > XB_SPIN_CAP) { atomicAdd(&bar[XB_TMO], 1u); break; } }
    }
    nloc = mine > 0u ? mine : 1u; nx = cnt > 0u ? cnt : 1u;
}
__device__ __forceinline__ void xcd_barrier(const XcdBarrier& b) {
    asm volatile("s_waitcnt vmcnt(0)" ::: "memory");
    __syncthreads();
    if (threadIdx.x == 0) {
        unsigned* bar = b.bar;
        __builtin_amdgcn_s_waitcnt(0);
        unsigned nloc = b.st[0], nx = b.st[1];
        if (nloc == 0u) { xcd_barrier_complete(bar, b.x, nloc, nx); b.st[0] = nloc; b.st[1] = nx; }
        const unsigned old = xb_add(&bar[XB_XSUB(b.x)], 1u);
        const unsigned gen = old / nloc;
        if (old + 1u == (gen + 1u) * nloc) {
            __builtin_amdgcn_fence(__ATOMIC_RELEASE, "agent");
            asm volatile("s_waitcnt vmcnt(0)" ::: "memory");
            const unsigned og = xb_add(&bar[XB_TOP], 1u);
            const unsigned tg = og / nx;
            if (og + 1u == (tg + 1u) * nx) xb_add(&bar[XB_TOPGEN], 1u);
            else XB_SPIN(xb_ld(&bar[XB_TOPGEN]) == tg, bar);
            __builtin_amdgcn_fence(__ATOMIC_ACQUIRE, "agent");
            xb_add(&bar[XB_XGEN(b.x)], 1u);
            asm volatile("s_waitcnt vmcnt(0)" ::: "memory");
        } else {
            XB_SPIN(xb_ld(&bar[XB_XGEN(b.x)]) == gen, bar);
            __builtin_amdgcn_fence(__ATOMIC_ACQUIRE, "agent");
            asm volatile("s_waitcnt vmcnt(0)" ::: "memory");
        }
    }
    __syncthreads();
}
struct Frame {
    LAS unsigned char* lds;
    volatile LAS unsigned* MISC;
    unsigned char* ws;
    int tid, lane, wave;
    int vcu, G;
    const float* in[19];
    float* out;
};
#define WSP(T, off) ((T*)(F.ws + (off)))

typedef float cv16f_t __attribute__((ext_vector_type(16)));
typedef unsigned cv6u_t __attribute__((ext_vector_type(6)));
struct Conv { const float* pu; const float* pv; unsigned char* u8; unsigned char* v8; LAS unsigned char* lbuf; int next, stride, end, pend; };
__device__ __forceinline__ void conv_issue(const Conv& c, int item, int lane) {
    const float* src = ((item >> 14) ? c.pv : c.pu) + (size_t)(item & 16383) * 2048 + 4 * lane;
#pragma unroll
    for (int q = 0; q < 8; ++q) __builtin_amdgcn_global_load_lds((const unsigned*)(src + 256 * q), (LAS unsigned*)(c.lbuf + q * 1024), 16, 0, 0);
}
__device__ __forceinline__ void conv_finish(const Conv& c, int item, int lane) {
    const int isv = item >> 14, row = item & 16383; const float sc = isv ? 4.f : 64.f; cv16f_t a, b;
#pragma unroll
    for (int q = 0; q < 8; ++q) { const f32x4 x = *(const LAS f32x4*)(c.lbuf + q * 1024 + lane * 16);
#pragma unroll
        for (int e = 0; e < 4; ++e) { const int k_ = 4 * q + e;
            if (k_ & 1) b[k_ >> 1] = x[e] * sc; else a[k_ >> 1] = x[e] * sc; } }
    const cv6u_t w = __builtin_amdgcn_cvt_scalef32_2xpk16_fp6_f32(a, b, 1.0f);
    unsigned char* rec = (isv ? c.v8 : c.u8) + (size_t)row * 1536;
    *(GAS u32x4*)(rec + lane * 16) = (u32x4){w[0], w[1], w[2], w[3]}; *(GAS u32x2*)(rec + 1024 + lane * 8) = (u32x2){w[4], w[5]};
}
template <int YOUNGER>
__device__ __forceinline__ void conv_step(Conv& c, int lane) {
    if (c.pend >= 0) { if constexpr (YOUNGER == 0) asm volatile("s_waitcnt vmcnt(0)" ::: "memory"); else if constexpr (YOUNGER == 6) asm volatile("s_waitcnt vmcnt(6)" ::: "memory"); else { static_assert(YOUNGER == 14, "wait count"); asm volatile("s_waitcnt vmcnt(14)" ::: "memory"); }
        conv_finish(c, c.pend, lane); c.pend = -1; asm volatile("s_waitcnt lgkmcnt(0)" ::: "memory"); }
    if (c.next < c.end) { conv_issue(c, c.next, lane); c.pend = c.next; c.next += c.stride; }
}
__device__ __forceinline__ void p0_transpose_item(const float* W, int K, int N, int k0, int n0, bf16_t* WT, int drow, bool rope, const float* gain, LAS float* scr, int lane) {
    { f32x4 v[8]; float gk[8];
#pragma unroll
      for (int i = 0; i < 8; ++i) { const int kk = 8 * i + (lane >> 3); v[i] = *(const GAS f32x4*)(W + (size_t)(k0 + kk) * N + n0 + 4 * (lane & 7)); gk[i] = gain ? gain[k0 + kk] : 1.f; }
#pragma unroll
      for (int i = 0; i < 8; ++i) { const int kk = 8 * i + (lane >> 3); LAS float* d = scr + kk * 33 + 4 * (lane & 7);
#pragma unroll
          for (int e = 0; e < 4; ++e) d[e] = v[i][e] * gk[i]; } }
    LDS_WAIT(); asm volatile("" ::: "memory");
    const int c = lane & 7;
#pragma unroll
    for (int j = 0; j < 4; ++j) { const int n = (lane >> 3) + 8 * j; const LAS float* s = scr + (8 * c) * 33 + n;
        u32x4 o; o.x = cvt_pk_bf16(s[0 * 33], s[1 * 33]); o.y = cvt_pk_bf16(s[2 * 33], s[3 * 33]); o.z = cvt_pk_bf16(s[4 * 33], s[5 * 33]); o.w = cvt_pk_bf16(s[6 * 33], s[7 * 33]);
        const int dr = drow + (rope ? (8 * (n >> 2) + (n & 3)) : n);
        *(GAS u32x4*)(WT + (size_t)dr * K + k0 + 8 * c) = o; }
    LDS_WAIT(); asm volatile("" ::: "memory");
}
__device__ __forceinline__ void p0_transpose_item8(const float* W, int K, int N, int k0, int n0, unsigned char* WT, int drow, bool rope, float scale, LAS float* scr, int lane, const float* gain = nullptr) {
    { f32x4 v[8]; float gk[8];
#pragma unroll
      for (int i = 0; i < 8; ++i) { const int kk = 8 * i + (lane >> 3); v[i] = *(const GAS f32x4*)(W + (size_t)(k0 + kk) * N + n0 + 4 * (lane & 7)); gk[i] = gain ? gain[k0 + kk] * scale : scale; }
#pragma unroll
      for (int i = 0; i < 8; ++i) { const int kk = 8 * i + (lane >> 3); LAS float* d = scr + kk * 33 + 4 * (lane & 7);
#pragma unroll
          for (int e = 0; e < 4; ++e) d[e] = v[i][e] * gk[i]; } }
    LDS_WAIT(); asm volatile("" ::: "memory");
#pragma unroll
    for (int j = 0; j < 2; ++j) { const int q = lane + 64 * j, n = q >> 2, c = q & 3; const LAS float* s = scr + (16 * c) * 33 + n; u32x4 o;
#pragma unroll
        for (int d = 0; d < 4; ++d) { int w = 0; w = __builtin_amdgcn_cvt_pk_fp8_f32(s[(4 * d) * 33], s[(4 * d + 1) * 33], w, false); w = __builtin_amdgcn_cvt_pk_fp8_f32(s[(4 * d + 2) * 33], s[(4 * d + 3) * 33], w, true); o[d] = (unsigned)w; }
        const int dr = drow + (rope ? (8 * (n >> 2) + (n & 3)) : n);
        *(GAS u32x4*)(WT + (size_t)dr * K + k0 + 16 * c) = o; }
    LDS_WAIT(); asm volatile("" ::: "memory");
}
__device__ __forceinline__ void rms_row_to_fp8(const float* xrow, const float* g, unsigned char* orow, int lane) {
    const GAS f32x4* xr = (const GAS f32x4*)xrow + lane; const GAS f32x4* gr = (const GAS f32x4*)g + lane;
    f32x4 v[8]; float s = 0.f;
#pragma unroll
    for (int j = 0; j < 8; ++j) { v[j] = xr[64 * j]; s += (v[j].x * v[j].x + v[j].y * v[j].y) + (v[j].z * v[j].z + v[j].w * v[j].w); }
    const float rstd = 1.0f / sqrtf(wave_sum(s) * (1.f / DM) + NORM_EPS);
    GAS unsigned* o4 = (GAS unsigned*)orow + lane;
#pragma unroll
    for (int j = 0; j < 8; ++j) { const f32x4 y = (v[j] * rstd) * gr[64 * j]; int w = 0; w = __builtin_amdgcn_cvt_pk_fp8_f32(y[0], y[1], w, false); w = __builtin_amdgcn_cvt_pk_fp8_f32(y[2], y[3], w, true); o4[64 * j] = (unsigned)w; }
}
__device__ __forceinline__ void rms_row_to_bf16(const float* xrow, const float* g, bf16_t* orow, int lane) {
    const GAS f32x4* xr = (const GAS f32x4*)xrow + lane; const GAS f32x4* gr = (const GAS f32x4*)g + lane;
    f32x4 v[8]; float s = 0.f;
#pragma unroll
    for (int j = 0; j < 8; ++j) { v[j] = xr[64 * j]; s += (v[j].x * v[j].x + v[j].y * v[j].y) + (v[j].z * v[j].z + v[j].w * v[j].w); }
    const float rstd = 1.0f / sqrtf(wave_sum(s) * (1.f / DM) + NORM_EPS);
    GAS u32x2* o8 = (GAS u32x2*)orow + lane;
#pragma unroll
    for (int j = 0; j < 8; ++j) { const f32x4 gg = gr[64 * j]; o8[64 * j] = pack4((v[j] * rstd) * gg); }
}
template <int PART>
__device__ __forceinline__ void p0_prologue(Frame& F, int rank, int nrank) {
    LAS float* scr = (LAS float*)(F.lds + F.wave * 16384);
    const int gw = rank * NWAVES + F.wave, NGW = nrank * NWAVES, lane = F.lane; const int gt = rank * 512 + F.tid, NGT = nrank * 512;
    unsigned char* WIN = WSP(unsigned char, WS_WIN); unsigned char* WVT = WSP(unsigned char, WS_WVT);
    constexpr int I_IN = 32 * 258, I_UQ = 8 * 96, I_UKV = 8 * 128, I_NA = 16 * 64, I_MLA = 32 * 64, I_OUT = 32 * 64;
    constexpr int NEARLY = I_IN + I_UQ + I_UKV, NITEMS = NEARLY + I_NA + I_MLA + I_OUT;
    for (int it = (PART == 0 ? 0 : NEARLY) + gw; it < (PART == 0 ? NEARLY : NITEMS); it += NGW) {
        int r = it;
        if (r < I_IN) { const int kb = r / 258, sb = r % 258, n0 = 32 * sb, k0 = 64 * kb; const float* W = F.in[3];
            unsigned char* dst = WIN; int drow; bool rope = false;
            if (n0 < 1024) drow = C_NAQ + n0;
            else if (n0 < 2048) drow = C_NAK + (n0 - 1024);
            else if (n0 < 3072) { dst = WVT; drow = n0 - 2048; }
            else if (n0 < 3584) drow = C_CQ + (n0 - 3072);
            else if (n0 < 4096) drow = C_CKV + (n0 - 3584);
            else if (n0 < 4160) { drow = C_KR + ((n0 - 4096) ? 4 : 0); rope = true; }
            else if (n0 < 6208) drow = C_GA + (n0 - 4160);
            else drow = C_GB + (n0 - 6208);
            p0_transpose_item8(W, 2048, 8256, k0, n0, dst, drow, rope, 64.f, scr, lane); continue; } r -= I_IN;
        if (r < I_UQ) { const int kb = r / 96, sb = r % 96, n0 = 32 * sb, k0 = 64 * kb; const int hd = n0 / 192, w = n0 % 192;
            int drow = n0; bool rope = false; if (w >= 128) { rope = true; drow = hd * 192 + 128 + ((w - 128) ? 4 : 0); }
            p0_transpose_item8(F.in[7], 512, 3072, k0, n0, WSP(unsigned char, WS_WUQ), drow, rope, 16.f, scr, lane, F.in[6]); continue; } r -= I_UQ;
        if (r < I_UKV) { const int kb = r / 128, sb = r % 128; p0_transpose_item8(F.in[9], 512, 4096, 64 * kb, 32 * sb, WSP(unsigned char, WS_WUKV), 32 * sb, false, 16.f, scr, lane, F.in[8]); continue; } r -= I_UKV;
        if (r < I_NA) { const int kb = r / 64, sb = r % 64; p0_transpose_item8(F.in[10], 1024, 2048, 64 * kb, 32 * sb, WSP(unsigned char, WS_WNA), 32 * sb, false, 32.f, scr, lane); continue; } r -= I_NA;
        if (r < I_MLA) { const int kb = r / 64, sb = r % 64; p0_transpose_item8(F.in[11], 2048, 2048, 64 * kb, 32 * sb, WSP(unsigned char, WS_WMLA), 32 * sb, false, 64.f, scr, lane); continue; } r -= I_MLA;
        { const int kb = r / 64, sb = r % 64; p0_transpose_item8(F.in[12], 2048, 2048, 64 * kb, 32 * sb, WSP(unsigned char, WS_WOUT), 32 * sb, false, 64.f, scr, lane); }
    }
    if (PART == 0) { GAS u32x4* z = (GAS u32x4*)(WIN + (size_t)(C_KR + 64) * 2048); const int n16 = (NMAIN - C_KR - 64) * 2048 / 16;
      for (int i = gt; i < n16; i += NGT) z[i] = (u32x4){0u, 0u, 0u, 0u}; }
    if (PART == 0) { unsigned char* HN1 = WSP(unsigned char, WS_HN1);
#define P0_ROWSRC(m_) (((m_) < MREAL) ? F.in[0] + (size_t)(m_) * DM : F.in[1] + (size_t)((m_) - MREAL) * DM)
      { f32x4 v[8]; int m = gw;
        if (m < MREAL + NMETA) { const GAS f32x4* xr = (const GAS f32x4*)P0_ROWSRC(m) + lane;
#pragma unroll
            for (int j = 0; j < 8; ++j) v[j] = xr[64 * j]; }
        const GAS f32x4* gr = (const GAS f32x4*)F.in[2] + lane;
        while (m < MREAL + NMETA) { const int mn = m + NGW; f32x4 vn[8];
            { const int ml = mn < MREAL + NMETA ? mn : m; const GAS f32x4* xr = (const GAS f32x4*)P0_ROWSRC(ml) + lane;
#pragma unroll
              for (int j = 0; j < 8; ++j) vn[j] = xr[64 * j]; }
            float sq = 0.f;
#pragma unroll
            for (int j = 0; j < 8; ++j) sq += (v[j].x * v[j].x + v[j].y * v[j].y) + (v[j].z * v[j].z + v[j].w * v[j].w);
            const float rstd = 1.0f / sqrtf(wave_sum(sq) * (1.f / DM) + NORM_EPS);
            GAS unsigned* o4 = (GAS unsigned*)(HN1 + (size_t)m * DM) + lane;
#pragma unroll
            for (int j = 0; j < 8; ++j) { const f32x4 y = (v[j] * rstd) * gr[64 * j]; int w = 0; w = __builtin_amdgcn_cvt_pk_fp8_f32(y[0], y[1], w, false); w = __builtin_amdgcn_cvt_pk_fp8_f32(y[2], y[3], w, true); o4[64 * j] = (unsigned)w; }
#pragma unroll
            for (int j = 0; j < 8; ++j) v[j] = vn[j];
            m = mn; } }
#undef P0_ROWSRC
      GAS u32x4* z = (GAS u32x4*)(HN1 + (size_t)(MREAL + NMETA) * DM); const int n16 = (MPAD - MREAL - NMETA) * DM / 16;
      for (int i = gt; i < n16; i += NGT) z[i] = (u32x4){0u, 0u, 0u, 0u}; }
    if (PART == 0) { float* ct = WSP(float, WS_COS); float* st = WSP(float, WS_SIN);
      for (int i = gt; i < NPOS * 32; i += NGT) { const int p = i >> 5, j = i & 31;
          const float inv = __builtin_powf(10000.0f, -(float)(2 * j) / 64.0f); const float ang = (float)p * inv;
          double r = (double)ang * 0.15915494309189535; r -= __builtin_rint(r); const float rf = (float)r;
          ct[i] = __builtin_amdgcn_cosf(rf); st[i] = __builtin_amdgcn_sinf(rf); } }
    if (PART == 1) { const float* SK = F.in[15]; const float* WQ = F.in[14]; const float* g2 = F.in[13]; bf16_t* WSCp = WSP(bf16_t, WS_WSC);
      const int l15 = lane & 15, l4 = lane >> 4;
      for (int task = gw; task < 2048; task += NGW) { const int g = task >> 7, nt = (task >> 4) & 7, kc = task & 15, n0 = nt * 16;
          bf16x8 bfr[4];
#pragma unroll
          for (int kk = 0; kk < 4; ++kk) { const float* p = SK + ((size_t)g * 128 + n0 + l15) * 128 + 32 * kk + 8 * l4; const f32x4 a = *(const GAS f32x4*)p, b = *(const GAS f32x4*)(p + 4);
              const u32x4 w = pack8(a, b); bfr[kk] = __builtin_bit_cast(bf16x8, w); }
          for (int kt = 0; kt < 8; ++kt) { const int k0 = (kc * 8 + kt) * 16; f32x4 acc = (f32x4){0.f, 0.f, 0.f, 0.f};
#pragma unroll
              for (int kk = 0; kk < 4; ++kk) { const float* p = WQ + (size_t)(k0 + l15) * 2048 + g * 128 + 32 * kk + 8 * l4; const f32x4 a = *(const GAS f32x4*)p, b = *(const GAS f32x4*)(p + 4);
                  const u32x4 w = pack8(a, b); acc = __builtin_amdgcn_mfma_f32_16x16x32_bf16(__builtin_bit_cast(bf16x8, w), bfr[kk], acc, 0, 0, 0); }
              const f32x4 gg = *(const GAS f32x4*)(g2 + k0 + 4 * l4);
              *(GAS u32x2*)(WSCp + (size_t)(g * 128 + n0 + l15) * 2048 + k0 + 4 * l4) = pack4(acc * gg); } } }
}
using pg8::Unit;
struct SchedGrid {
    int G, c, nM, nN; const char* A; const char* B; size_t tstep;
    __device__ __forceinline__ bool next(int i, Unit& u) const { const int L = i * G + c; if (L >= nM * nN) return false; pg8::grid_order(L, nM, nN, u.pm, u.pn); u.kind = 0; return true; }
    __device__ __forceinline__ const char* pa(const Unit& u) const { return A + (size_t)u.pm * tstep; }
    __device__ __forceinline__ const char* pb(const Unit& u) const { return B + (size_t)u.pn * tstep; }
};
constexpr int P1_MAIN = 64 * 29, P1_VT = 4 * 65, P1_META = 7, P1_UNITS = P1_MAIN + P1_VT + P1_META;
struct SchedP1 {
    int G, c; const char* hn1; const char* win; const char* wvt; size_t tstep;
    __device__ __forceinline__ bool next(int i, Unit& u) const {
        const int L = i * G + c; if (L >= P1_UNITS) return false;
        if (L < P1_MAIN) { pg8::grid_order(L, 64, 29, u.pm, u.pn); u.kind = 0; }
        else if (L < P1_MAIN + P1_VT) { const int idx = L - P1_MAIN; u.pm = idx & 3; u.pn = idx >> 2; u.kind = 1; }
        else { const int idx = L - P1_MAIN - P1_VT; u.pm = 64; u.pn = idx < 4 ? 4 + idx : (idx < 6 ? 10 + (idx - 4) : 28); u.kind = 0; }
        return true; }
    __device__ __forceinline__ const char* pa(const Unit& u) const { return (u.kind == 1 ? wvt : hn1) + (size_t)u.pm * tstep; }
    __device__ __forceinline__ const char* pb(const Unit& u) const { return (u.kind == 1 ? hn1 : win) + (size_t)u.pn * tstep; }
};
__device__ __forceinline__ void rope4(const f32x4 x1, const f32x4 x2, const float* cosT, const float* sinT, int pos, int j0, f32x4& lo, f32x4& hi) {
    const f32x4 c = *(const GAS f32x4*)(cosT + pos * 32 + j0), s = *(const GAS f32x4*)(sinT + pos * 32 + j0);
    lo = x1 * c - x2 * s; hi = x2 * c + x1 * s;
}
struct EpiP1 {
    static constexpr bool PERM = true, HAS_PRE = false;
    bf16_t *naq, *nak, *vt; unsigned char *cq, *ckv; bf16_t *kr; unsigned char *ga, *gb; float *ssq_q, *ssq_kv; const float *cosT, *sinT;
    __device__ __forceinline__ void operator()(const f32x4 (&acc)[2][2][4][2], const Unit& u, int wr, int wc, int fr, int fq, const LAS float* rowsc) const {
        const int row0 = u.pm * 256 + wr * 64 + fr, colu = wc * 32 + 8 * fq;
        if (u.kind == 1) {
#pragma unroll
            for (int ai = 0; ai < 2; ++ai)
#pragma unroll
                for (int m = 0; m < 4; ++m) { bf16_t* rp = vt + (size_t)(row0 + ai * 128 + m * 16) * VT_PITCH + u.pn * 256 + colu;
#pragma unroll
                    for (int bj = 0; bj < 2; ++bj) *(GAS u32x4*)(rp + bj * 128) = pack8(acc[ai][bj][m][0], acc[ai][bj][m][1]); }
            return; }
        const int pn = u.pn;
        if (pn == 28) {
            if (wc < 2) { const int j0 = 4 * (4 * wc + fq);
#pragma unroll
                for (int ai = 0; ai < 2; ++ai)
#pragma unroll
                    for (int m = 0; m < 4; ++m) { const int row = row0 + ai * 128 + m * 16; const int pos = row < MREAL ? NMETA + (row & (SEQ - 1)) : row - MREAL;
                        f32x4 lo, hi; rope4(acc[ai][0][m][0], acc[ai][0][m][1], cosT, sinT, pos, j0, lo, hi);
                        *(GAS u32x2*)(kr + (size_t)row * 64 + j0) = pack4(lo); *(GAS u32x2*)(kr + (size_t)row * 64 + 32 + j0) = pack4(hi); } }
            return; }
        if (pn >= 12) {
            unsigned char* base = pn < 20 ? ga : gb; const int colt = (pn < 20 ? pn - 12 : pn - 20) * 256 + colu;
#pragma unroll
            for (int ai = 0; ai < 2; ++ai)
#pragma unroll
                for (int m = 0; m < 4; ++m) { unsigned char* rp = base + (size_t)(row0 + ai * 128 + m * 16) * 2048 + colt;
#pragma unroll
                    for (int bj = 0; bj < 2; ++bj) { f32x4 a = acc[ai][bj][m][0], b = acc[ai][bj][m][1];
#pragma unroll
                        for (int i = 0; i < 4; ++i) { a[i] = sigmoidf_(a[i]); b[i] = sigmoidf_(b[i]); }
                        *(GAS u32x2*)(rp + bj * 128) = pack8_u8(a, b); } }
            return; }
        if (pn >= 8) {
            const bool isq = pn < 10; unsigned char* base = isq ? cq : ckv; float* ssq = isq ? ssq_q : ssq_kv; const int colt = (isq ? pn - 8 : pn - 10) * 256 + colu;
#pragma unroll
            for (int ai = 0; ai < 2; ++ai)
#pragma unroll
                for (int m = 0; m < 4; ++m) { const int row = row0 + ai * 128 + m * 16; unsigned char* rp = base + (size_t)row * 512 + colt; float s = 0.f;
#pragma unroll
                    for (int bj = 0; bj < 2; ++bj) { const f32x4 a = acc[ai][bj][m][0], b = acc[ai][bj][m][1];
                        s += (a[0] * a[0] + a[1] * a[1]) + (a[2] * a[2] + a[3] * a[3]) + (b[0] * b[0] + b[1] * b[1]) + (b[2] * b[2] + b[3] * b[3]);
                        *(GAS u32x2*)(rp + bj * 128) = pack8_fp8(a, b); }
                    s += __shfl_xor(s, 16); s += __shfl_xor(s, 32);
                    if (fq == 0) ssq[(size_t)((pn & 1) * 4 + wc) * MPAD + row] = s; }
            return; }
        {
            bf16_t* base = pn < 4 ? naq : nak; const int colt = (pn & 3) * 256 + colu;
#pragma unroll
            for (int ai = 0; ai < 2; ++ai)
#pragma unroll
                for (int m = 0; m < 4; ++m) { bf16_t* rp = base + (size_t)(row0 + ai * 128 + m * 16) * 1024 + colt;
#pragma unroll
                    for (int bj = 0; bj < 2; ++bj) *(GAS u32x4*)(rp + bj * 128) = pack8(acc[ai][bj][m][0], acc[ai][bj][m][1]); }
        }
    }
};
constexpr int P3_Q = 64 * 12, P3_KV = 65 * 16, P3_UNITS = P3_Q + P3_KV;
struct SchedP3 {
    int G, c; const char* cq; const char* ckv; const char* wuq; const char* wukv; size_t tstep;
    __device__ __forceinline__ bool next(int i, Unit& u) const {
        const int L = i * G + c; if (L >= P3_UNITS) return false;
        if (L < P3_Q) { pg8::grid_order(L, 64, 12, u.pm, u.pn); u.kind = 0; } else { pg8::grid_order(L - P3_Q, 65, 16, u.pm, u.pn); u.kind = 1; }
        return true; }
    __device__ __forceinline__ const char* pa(const Unit& u) const { return (u.kind ? ckv : cq) + (size_t)u.pm * tstep; }
    __device__ __forceinline__ const char* pb(const Unit& u) const { return (u.kind ? wukv : wuq) + (size_t)u.pn * tstep; }
};
template <int NS, int LD> __device__ __forceinline__ float rstd_slabs(const float* part, int row, float invn) {
    float s = 0.f;
#pragma unroll
    for (int i = 0; i < NS; ++i) s += part[(size_t)i * LD + row];
    return 1.0f / sqrtf(s * invn + NORM_EPS);
}
struct EpiP3 {
    static constexpr bool PERM = true, HAS_PRE = true;
    bf16_t *qm, *kn, *vv; const float *ssq_q, *ssq_kv; const float *cosT, *sinT;
    __device__ __forceinline__ void pre(const Unit& u, LAS float* sc, int tid) const { if (tid < 256) { const int row = u.pm * 256 + tid; sc[tid] = u.kind ? rstd_slabs<8, MPAD>(ssq_kv, row, 1.f / 512.f) : rstd_slabs<8, MPAD>(ssq_q, row, 1.f / 512.f); } }
    __device__ __forceinline__ void operator()(const f32x4 (&acc)[2][2][4][2], const Unit& u, int wr, int wc, int fr, int fq, const LAS float* rowsc) const {
        const int row0 = u.pm * 256 + wr * 64 + fr, colu = wc * 32 + 8 * fq;
        if (u.kind == 1) {
#pragma unroll
            for (int ai = 0; ai < 2; ++ai)
#pragma unroll
                for (int m = 0; m < 4; ++m) { const int row = row0 + ai * 128 + m * 16; const float rs = rowsc[ai * 128 + wr * 64 + m * 16 + fr];
                    const size_t off = (size_t)row * 2048 + u.pn * 128 + colu;
                    *(GAS u32x4*)(kn + off) = pack8(acc[ai][0][m][0] * rs, acc[ai][0][m][1] * rs);
                    *(GAS u32x4*)(vv + off) = pack8(acc[ai][1][m][0] * rs, acc[ai][1][m][1] * rs); }
            return; }
#pragma unroll
        for (int bj = 0; bj < 2; ++bj) { const int c8 = u.pn * 256 + bj * 128 + colu; const int hd = c8 / 192, w = c8 - hd * 192;
            if (w < 128) {
#pragma unroll
                for (int ai = 0; ai < 2; ++ai)
#pragma unroll
                    for (int m = 0; m < 4; ++m) { const int row = row0 + ai * 128 + m * 16; const float rs = rowsc[ai * 128 + wr * 64 + m * 16 + fr];
                        *(GAS u32x4*)(qm + (size_t)row * 3072 + c8) = pack8(acc[ai][bj][m][0] * rs, acc[ai][bj][m][1] * rs); }
            } else { const int j0 = (w - 128) >> 1;
#pragma unroll
                for (int ai = 0; ai < 2; ++ai)
#pragma unroll
                    for (int m = 0; m < 4; ++m) { const int row = row0 + ai * 128 + m * 16; const float rs = rowsc[ai * 128 + wr * 64 + m * 16 + fr];
                        const int pos = NMETA + (row & (SEQ - 1)); f32x4 lo, hi; rope4(acc[ai][bj][m][0] * rs, acc[ai][bj][m][1] * rs, cosT, sinT, pos, j0, lo, hi);
                        bf16_t* qp = qm + (size_t)row * 3072 + hd * 192 + 128 + j0; *(GAS u32x2*)qp = pack4(lo); *(GAS u32x2*)(qp + 32) = pack4(hi); }
            } }
    }
};
__device__ __forceinline__ void unpack8(const u32x4 w, f32x4& a, f32x4& b) { a = (f32x4){bf_lo(w.x), bf_hi(w.x), bf_lo(w.y), bf_hi(w.y)}; b = (f32x4){bf_lo(w.z), bf_hi(w.z), bf_lo(w.w), bf_hi(w.w)}; }
struct EpiP5a {
    static constexpr bool PERM = true, HAS_PRE = false;
    const unsigned char* ga; bf16_t* t1;
    __device__ __forceinline__ void operator()(const f32x4 (&acc)[2][2][4][2], const Unit& u, int wr, int wc, int fr, int fq, const LAS float* rowsc) const {
        const int row0 = u.pm * 256 + wr * 64 + fr, col0 = u.pn * 256 + wc * 32 + 8 * fq;
#pragma unroll
        for (int ai = 0; ai < 2; ++ai)
#pragma unroll
            for (int m = 0; m < 4; ++m) { const size_t off = (size_t)(row0 + ai * 128 + m * 16) * 2048 + col0;
#pragma unroll
                for (int bj = 0; bj < 2; ++bj) { f32x4 g0, g1; unpack8_u8(*(const GAS u32x2*)(ga + off + bj * 128), g0, g1);
                    *(GAS u32x4*)(t1 + off + bj * 128) = pack8(acc[ai][bj][m][0] * g0, acc[ai][bj][m][1] * g1); } }
    }
};
struct EpiP5b {
    static constexpr bool PERM = true, HAS_PRE = false;
    const unsigned char* gb; const bf16_t* t1; unsigned char* merged;
    __device__ __forceinline__ void operator()(const f32x4 (&acc)[2][2][4][2], const Unit& u, int wr, int wc, int fr, int fq, const LAS float* rowsc) const {
        const int row0 = u.pm * 256 + wr * 64 + fr, col0 = u.pn * 256 + wc * 32 + 8 * fq;
#pragma unroll
        for (int ai = 0; ai < 2; ++ai)
#pragma unroll
            for (int m = 0; m < 4; ++m) { const size_t off = (size_t)(row0 + ai * 128 + m * 16) * 2048 + col0;
#pragma unroll
                for (int bj = 0; bj < 2; ++bj) { f32x4 g0, g1; unpack8_u8(*(const GAS u32x2*)(gb + off + bj * 128), g0, g1);
                    f32x4 a, b; unpack8(*(const GAS u32x4*)(t1 + off + bj * 128), a, b);
                    *(GAS u32x2*)(merged + off + bj * 128) = pack8_fp8((a + acc[ai][bj][m][0] * g0) * 32.f, (b + acc[ai][bj][m][1] * g1) * 32.f); } }
    }
};
struct EpiP6 {
    static constexpr bool PERM = true, HAS_PRE = false;
    const float* x; bf16_t* h2b; float* ssq2;
    __device__ __forceinline__ void operator()(const f32x4 (&acc)[2][2][4][2], const Unit& u, int wr, int wc, int fr, int fq, const LAS float* rowsc) const {
        const int row0 = u.pm * 256 + wr * 64 + fr, col0 = u.pn * 256 + wc * 32 + 8 * fq;
#pragma unroll
        for (int ai = 0; ai < 2; ++ai)
#pragma unroll
            for (int m = 0; m < 4; ++m) { const int row = row0 + ai * 128 + m * 16; const size_t off = (size_t)row * 2048 + col0; float s = 0.f;
#pragma unroll
                for (int bj = 0; bj < 2; ++bj) { const f32x4 a = *(const GAS f32x4*)(x + off + bj * 128) + acc[ai][bj][m][0], b = *(const GAS f32x4*)(x + off + bj * 128 + 4) + acc[ai][bj][m][1];
                    s += (a[0] * a[0] + a[1] * a[1]) + (a[2] * a[2] + a[3] * a[3]) + (b[0] * b[0] + b[1] * b[1]) + (b[2] * b[2] + b[3] * b[3]);
                    *(GAS u32x4*)(h2b + off + bj * 128) = pack8(a, b); }
                s += __shfl_xor(s, 16); s += __shfl_xor(s, 32);
                if (fq == 0) ssq2[(size_t)(u.pn * 4 + wc) * MREAL + row] = s; }
    }
};
struct EpiP7 {
    static constexpr bool PERM = true, HAS_PRE = true;
    const float* ssq2; _Float16* sc;
    __device__ __forceinline__ void pre(const Unit& u, LAS float* sc, int tid) const { if (tid < 256) sc[tid] = rstd_slabs<32, MREAL>(ssq2, u.pm * 256 + tid, 1.f / 2048.f); }
    __device__ __forceinline__ void operator()(const f32x4 (&acc)[2][2][4][2], const Unit& u, int wr, int wc, int fr, int fq, const LAS float* rowsc) const {
        typedef _Float16 h4_t __attribute__((ext_vector_type(4)));
        const int row0 = u.pm * 256 + wr * 64 + fr, col0 = u.pn * 256 + wc * 32 + 8 * fq;
#pragma unroll
        for (int ai = 0; ai < 2; ++ai)
#pragma unroll
            for (int m = 0; m < 4; ++m) { const int row = row0 + ai * 128 + m * 16; const float rs = rowsc[ai * 128 + wr * 64 + m * 16 + fr]; const size_t off = (size_t)row * 2048 + col0;
#pragma unroll
                for (int bj = 0; bj < 2; ++bj) { const h4_t lo = __builtin_convertvector(acc[ai][bj][m][0] * rs, h4_t), hi = __builtin_convertvector(acc[ai][bj][m][1] * rs, h4_t);
                    const u32x2 wl = __builtin_bit_cast(u32x2, lo), wh = __builtin_bit_cast(u32x2, hi);
                    *(GAS u32x4*)(sc + off + bj * 128) = (u32x4){wl.x, wl.y, wh.x, wh.y}; } }
    }
};
namespace att {
#define KSWZ(row, colB) ((row) * 256 + ((colB) ^ (((row) & 7) << 4)))
#define KRSWZ(row, colB) ((row) * 128 + ((colB) ^ ((((row) >> 1) & 7) << 4)))
constexpr float L2E = 1.4426950408889634f;
template <int DUMMY = 0>
__device__ __forceinline__ void partialSM(f32x16& p0, f32x16& p1, float& m_reg, float& mn, float& alpha, const float C, const float THRS) {
  float pmax = p0[0];
#pragma unroll
  for (int r = 1; r < 16; ++r) pmax = fmaxf(pmax, p0[r]);
#pragma unroll
  for (int r = 0; r < 16; ++r) pmax = fmaxf(pmax, p1[r]);
  { auto rr = __builtin_amdgcn_permlane32_swap(__float_as_uint(pmax), __float_as_uint(pmax), false, false);
    pmax = fmaxf(__uint_as_float(rr[0]), __uint_as_float(rr[1])); }
  if (__builtin_expect(__all(pmax - m_reg <= THRS), 1)) { mn = m_reg; alpha = 1.f; }
  else { mn = fmaxf(m_reg, pmax); alpha = __builtin_amdgcn_exp2f((m_reg - mn) * C); m_reg = mn; }
  const float mnC = -mn * C;
#pragma unroll
  for (int r = 0; r < 16; ++r) p0[r] = fmaf(p0[r], C, mnC);
#pragma unroll
  for (int r = 0; r < 16; ++r) p1[r] = fmaf(p1[r], C, mnC);
#pragma unroll
  for (int r = 0; r < 16; ++r) p0[r] = __builtin_amdgcn_exp2f(p0[r]);
}
__device__ __forceinline__ void finishSM(f32x16& p0, f32x16& p1, float alpha, float& l_reg, bf16x8& pa0, bf16x8& pa1, bf16x8& pa2, bf16x8& pa3) {
#pragma unroll
  for (int r = 0; r < 16; ++r) p1[r] = __builtin_amdgcn_exp2f(p1[r]);
  float ps = 0;
#pragma unroll
  for (int r = 0; r < 16; ++r) ps += p0[r];
#pragma unroll
  for (int r = 0; r < 16; ++r) ps += p1[r];
  { auto rr = __builtin_amdgcn_permlane32_swap(__float_as_uint(ps), __float_as_uint(ps), false, false);
    ps = __uint_as_float(rr[0]) + __uint_as_float(rr[1]); }
  l_reg = l_reg * alpha + ps;
#define PK4(P, BASE, OUT) do { unsigned a0 = cvt_pk_bf16(P[BASE + 0], P[BASE + 1]), a1 = cvt_pk_bf16(P[BASE + 2], P[BASE + 3]);   \
    unsigned b0 = cvt_pk_bf16(P[BASE + 4], P[BASE + 5]), b1 = cvt_pk_bf16(P[BASE + 6], P[BASE + 7]);                              \
    auto r0 = __builtin_amdgcn_permlane32_swap(a0, b0, false, false); auto r1 = __builtin_amdgcn_permlane32_swap(a1, b1, false, false); \
    u32x4 w = {r0[0], r1[0], r0[1], r1[1]}; OUT = __builtin_bit_cast(bf16x8, w); } while (0)
  PK4(p0, 0, pa0); PK4(p0, 8, pa1); PK4(p1, 0, pa2); PK4(p1, 8, pa3);
#undef PK4
}
constexpr int NW = 8, QBLK = 32, KVBLK = 64;
constexpr float MLA_SCALE = 0.07216878364870322f;
constexpr float MLA_THR = 8.f;
constexpr int SHM_V = KVBLK * 128 * 2, SHM_KN = KVBLK * 128 * 2, SHM_KR = KVBLK * 64 * 2;
constexpr int OFF_V = 0, OFF_KN = 2 * SHM_V, OFF_KR = OFF_KN + 2 * SHM_KN, OFF_WS = OFF_KR + 2 * SHM_KR, OFF_QR = OFF_WS + NW * 64 * 4, MLA_LDS = OFF_QR + NW * 4096;
__device__ __forceinline__ void qkt(f32x16& p0, f32x16& p1, const LAS char* Kn, const LAS char* Kr, const bf16x8* qr, const LAS char* qrp, const int* kb, const int* krb) {
  p0 = f32x16{}; p1 = f32x16{};
#pragma unroll
  for (int d0 = 0; d0 < 8; ++d0) {
    const bf16x8 b0 = *(const LAS bf16x8*)(Kn + kb[d0 & 3] + (d0 >> 2) * 128);
    const bf16x8 b1 = *(const LAS bf16x8*)(Kn + kb[d0 & 3] + (d0 >> 2) * 128 + 8192);
    p0 = __builtin_amdgcn_mfma_f32_32x32x16_bf16(b0, qr[d0], p0, 0, 0, 0);
    p1 = __builtin_amdgcn_mfma_f32_32x32x16_bf16(b1, qr[d0], p1, 0, 0, 0); }
#pragma unroll
  for (int d0 = 0; d0 < 4; ++d0) {
    const bf16x8 b0 = *(const LAS bf16x8*)(Kr + krb[d0]);
    const bf16x8 b1 = *(const LAS bf16x8*)(Kr + krb[d0] + 4096);
    const bf16x8 qf = *(const LAS bf16x8*)(qrp + d0 * 1024);
    p0 = __builtin_amdgcn_mfma_f32_32x32x16_bf16(b0, qf, p0, 0, 0, 0);
    p1 = __builtin_amdgcn_mfma_f32_32x32x16_bf16(b1, qf, p1, 0, 0, 0); }
}
__device__ __forceinline__ int v_st(int k, int c) { const int kk = (k & ~0xC) | ((k & 4) << 1) | ((k & 8) >> 1); return ((kk >> 3) * 4 + (c >> 5)) * 512 + ((kk & 7) * 32 + (c & 31)) * 2; }
__device__ __forceinline__ int v_rd_base(int lane) { return ((lane & 3) << 3) | (((lane >> 2) & 3) << 6) | (((lane >> 4) & 1) << 5) | (((lane >> 5) & 1) << 8); }
constexpr int v_rd_off(int d0, int ks, int half) { return d0 * 512 + ks * 4096 + half * 2048; }
template <int OFF> __device__ __forceinline__ s16x4 tr_read(int vb) {
  s16x4 r; asm volatile("ds_read_b64_tr_b16 %0, %1 offset:%2" : "=&v"(r) : "v"(vb), "i"(OFF) : "memory"); return r;
}
template <int D0> __device__ __forceinline__ void pv_one(f32x16& od, int vb, bf16x8 pa0, bf16x8 pa1, bf16x8 pa2, bf16x8 pa3) {
  const s16x4 l0 = tr_read<v_rd_off(D0, 0, 0)>(vb), h0 = tr_read<v_rd_off(D0, 0, 1)>(vb), l1 = tr_read<v_rd_off(D0, 1, 0)>(vb), h1 = tr_read<v_rd_off(D0, 1, 1)>(vb);
  const s16x4 l2 = tr_read<v_rd_off(D0, 2, 0)>(vb), h2 = tr_read<v_rd_off(D0, 2, 1)>(vb), l3 = tr_read<v_rd_off(D0, 3, 0)>(vb), h3 = tr_read<v_rd_off(D0, 3, 1)>(vb);
  asm volatile("s_waitcnt lgkmcnt(0)" ::: "memory"); SBAR();
#define PK(L, H) (bf16x8){L[0], L[1], L[2], L[3], H[0], H[1], H[2], H[3]}
  od = __builtin_amdgcn_mfma_f32_32x32x16_bf16(pa0, PK(l0, h0), od, 0, 0, 0);
  od = __builtin_amdgcn_mfma_f32_32x32x16_bf16(pa1, PK(l1, h1), od, 0, 0, 0);
  od = __builtin_amdgcn_mfma_f32_32x32x16_bf16(pa2, PK(l2, h2), od, 0, 0, 0);
  od = __builtin_amdgcn_mfma_f32_32x32x16_bf16(pa3, PK(l3, h3), od, 0, 0, 0);
#undef PK
}
__device__ __forceinline__ void pv_d0(f32x16* o, int vb, bf16x8 pa0, bf16x8 pa1, bf16x8 pa2, bf16x8 pa3) {
  pv_one<0>(o[0], vb, pa0, pa1, pa2, pa3); pv_one<1>(o[1], vb, pa0, pa1, pa2, pa3); pv_one<2>(o[2], vb, pa0, pa1, pa2, pa3); pv_one<3>(o[3], vb, pa0, pa1, pa2, pa3);
}
__device__ __forceinline__ void mla_unit(int b, int h, int qb, const bf16_t* __restrict__ QM, const bf16_t* __restrict__ KN, const bf16_t* __restrict__ KR, const bf16_t* __restrict__ VV, unsigned char* __restrict__ OM, LAS char* lds) {
  const int tid = threadIdx.x, wid = tid >> 6, lane = tid & 63, r32 = lane & 31, hi = lane >> 5;
  constexpr float C = MLA_SCALE * L2E, THRS = MLA_THR / MLA_SCALE;
  constexpr int NT = 33;
  LAS char* V_lds = lds + OFF_V; LAS char* Kn_lds = lds + OFF_KN; LAS char* Kr_lds = lds + OFF_KR;
  LAS float* ws = (LAS float*)(lds + OFF_WS) + wid * 64; LAS float* li_l = ws; LAS float* al_l = ws + 32;
  float m_reg = -1e30f, l_reg = 0; f32x16 o[4] = {}; bf16x8 qr[8];
  LAS char* qrp = lds + OFF_QR + wid * 4096 + lane * 16;
  const int qrow = b * SEQ + qb * 256 + wid * QBLK + r32;
  const bf16_t* Qw = QM + (size_t)qrow * 3072 + h * 192 + hi * 8;
#pragma unroll
  for (int d0 = 0; d0 < 8; ++d0) qr[d0] = *(const GAS bf16x8*)(Qw + d0 * 16);
  __syncthreads();
#pragma unroll
  for (int d0 = 0; d0 < 4; ++d0) *(LAS bf16x8*)(qrp + d0 * 1024) = *(const GAS bf16x8*)(Qw + (8 + d0) * 16);
  const int sr = tid >> 4, sc = (tid & 15) * 8, vst0 = v_st(sr, sc), vst1 = v_st(32 + sr, sc);
  const int krr = tid >> 3, krc = (tid & 7) * 8;
  const int vb0 = (int)(uintptr_t)V_lds + v_rd_base(lane);
  bf16x8 s_v0, s_v1, s_k0, s_k1, s_kr;
  const int realbase = b * SEQ - KVBLK;
  const unsigned voff = (unsigned)(sr * 2048 + sc) * 2u, kroff = (unsigned)(krr * 64 + krc) * 2u;
  int kb[4], krb[4];
#pragma unroll
  for (int bq = 0; bq < 4; ++bq) { kb[bq] = KSWZ(r32, bq * 32 + hi * 16); krb[bq] = KRSWZ(r32, bq * 32 + hi * 16); }
#define TROW(t) ((t) == 0 ? MREAL : realbase + (t) * KVBLK)
#define SLOAD(t) do { const int k0_ = TROW(t); const size_t ro_ = ((size_t)k0_ * 2048 + h * 128) * 2; \
    const GAS char* vb_ = (const GAS char*)VV + ro_; const GAS char* nb_ = (const GAS char*)KN + ro_; const GAS char* rb_ = (const GAS char*)KR + (size_t)k0_ * 128; \
    s_v0 = *(const GAS bf16x8*)(vb_ + voff); s_v1 = *(const GAS bf16x8*)(vb_ + 32 * 4096 + voff); \
    s_k0 = *(const GAS bf16x8*)(nb_ + voff); s_k1 = *(const GAS bf16x8*)(nb_ + 32 * 4096 + voff); \
    s_kr = *(const GAS bf16x8*)(rb_ + kroff); } while (0)
#define SWRITE(bf) do { *(LAS bf16x8*)(V_lds + (bf) * SHM_V + vst0) = s_v0; *(LAS bf16x8*)(V_lds + (bf) * SHM_V + vst1) = s_v1; const int kc_ = sc * 2; \
    *(LAS bf16x8*)(Kn_lds + (bf) * SHM_KN + KSWZ(sr, kc_)) = s_k0; *(LAS bf16x8*)(Kn_lds + (bf) * SHM_KN + KSWZ(32 + sr, kc_)) = s_k1; \
    *(LAS bf16x8*)(Kr_lds + (bf) * SHM_KR + KRSWZ(krr, krc * 2)) = s_kr; } while (0)
#define SWAIT() asm volatile("s_waitcnt vmcnt(0)" ::: "memory")
#define RESC(a) do { if (__any((a) < 1.f)) { if (hi == 0) al_l[r32] = (a); asm volatile("s_waitcnt lgkmcnt(0)" ::: "memory"); \
    _Pragma("unroll") for (int d = 0; d < 4; ++d) _Pragma("unroll") for (int r = 0; r < 16; ++r) o[d][r] *= al_l[crow(r, hi)]; } } while (0)
  f32x16 pA0, pA1, pB0, pB1; float mnA, mnB, alA, alB; bf16x8 pa0, pa1, pa2, pa3;
  SLOAD(0); SWAIT(); SWRITE(0); __syncthreads();
  qkt(pA0, pA1, Kn_lds, Kr_lds, qr, qrp, kb, krb);
  { const float NEG = -INFINITY;
#pragma unroll
    for (int r = 8; r < 16; ++r) pA0[r] = NEG;
#pragma unroll
    for (int r = 0; r < 16; ++r) pA1[r] = NEG; }
  partialSM(pA0, pA1, m_reg, mnA, alA, C, THRS);
  SLOAD(1); SWAIT(); SWRITE(1); __syncthreads();
  for (int j = 1; j + 1 < NT; j += 2) {
    SBAR(); qkt(pB0, pB1, Kn_lds + SHM_KN, Kr_lds + SHM_KR, qr, qrp, kb, krb);
    finishSM(pA0, pA1, alA, l_reg, pa0, pa1, pa2, pa3); SBAR();
    SLOAD(j + 1); SBAR();
    pv_d0(o, vb0, pa0, pa1, pa2, pa3); partialSM(pB0, pB1, m_reg, mnB, alB, C, THRS);
    __syncthreads(); SWAIT(); SWRITE(0);
    RESC(alB); __syncthreads();
    SBAR(); qkt(pA0, pA1, Kn_lds, Kr_lds, qr, qrp, kb, krb);
    finishSM(pB0, pB1, alB, l_reg, pa0, pa1, pa2, pa3); SBAR();
    if (j + 2 < NT) SLOAD(j + 2); SBAR();
    pv_d0(o, vb0 + SHM_V, pa0, pa1, pa2, pa3); partialSM(pA0, pA1, m_reg, mnA, alA, C, THRS);
    __syncthreads(); if (j + 2 < NT) { SWAIT(); SWRITE(1); }
    RESC(alA); __syncthreads();
  }
  finishSM(pA0, pA1, alA, l_reg, pa0, pa1, pa2, pa3); SBAR();
  pv_d0(o, vb0, pa0, pa1, pa2, pa3);
  if (hi == 0) li_l[r32] = l_reg; asm volatile("s_waitcnt lgkmcnt(0)" ::: "memory");
  float rli[16];
#pragma unroll
  for (int r = 0; r < 16; ++r) rli[r] = __builtin_amdgcn_rcpf(li_l[crow(r, hi)]);
  unsigned char* Ow = OM + (size_t)(b * SEQ + qb * 256 + wid * QBLK) * 2048 + h * 128;
#pragma unroll
  for (int r = 0; r < 16; ++r) { const int orow = crow(r, hi);
#pragma unroll
    for (int d0 = 0; d0 < 4; ++d0) Ow[(size_t)orow * 2048 + d0 * 32 + r32] = f32_to_fp8(o[d0][r] * rli[r] * 32.f); }
#undef TROW
#undef SLOAD
#undef SWRITE
#undef SWAIT
#undef RESC
}
__device__ __forceinline__ void na_task(int task, const bf16_t* __restrict__ NAQ, const bf16_t* __restrict__ NAK, const bf16_t* __restrict__ VT, unsigned char* __restrict__ ONA,
                                        const LAS float* relb, const LAS float* metab, LAS float* wsf, int lane, Conv& cv) {
  const int r32 = lane & 31, hi = lane >> 5;
  const int half = task & 1, r = (task >> 1) & 31, h = (task >> 6) & 15, b = task >> 10;
  const int qc = half * 32 + r32;
  const int cs = min(max(qc - 8, 0), 48), rs = min(max(r - 4, 0), 24);
  const int qtok = b * SEQ + r * 64 + qc;
  constexpr float C = L2E, THRS = 8.f, SCALE = 0.125f;
  bf16x8 qr[4];
#pragma unroll
  for (int d0 = 0; d0 < 4; ++d0) qr[d0] = *(const GAS bf16x8*)(NAQ + (size_t)qtok * 1024 + h * 64 + d0 * 16 + hi * 8);
  float m_reg = -1e30f, l_reg = 0.f; f32x16 o[2] = {};
  LAS float* al_l = wsf; LAS float* li_l = wsf + 32;
  const float NEG = -INFINITY;
  const int kb0 = half * 16;
  const unsigned long long wm = 0xFFFFull << (cs - kb0);
  const unsigned mh0 = (unsigned)wm >> (4 * hi), mh1 = (unsigned)(wm >> 32) >> (4 * hi);
  const bf16_t* kq = NAK + (size_t)r32 * 1024 + h * 64 + hi * 8;
  const bf16_t* kq2 = NAK + (size_t)(32 + (r32 & 15)) * 1024 + h * 64 + hi * 8;
  const bf16_t* vq = VT + (size_t)(h * 64 + r32) * VT_PITCH + 8 * hi;
#define NA_KTOK(w) ((w) == 8 ? MREAL : b * SEQ + (rs + (w)) * 64 + kb0)
#define NA_LOADK(KF, w) do { const size_t ko_ = (size_t)NA_KTOK(w) * 1024; _Pragma("unroll") for (int d0 = 0; d0 < 4; ++d0) { KF[d0] = *(const GAS bf16x8*)(kq + ko_ + d0 * 16); KF[4 + d0] = *(const GAS bf16x8*)(kq2 + ko_ + d0 * 16); } } while (0)
#define NA_TILE(KF, w, YN) do { \
    bf16x8 vf[6]; { const bf16_t* vp_ = vq + NA_KTOK(w); _Pragma("unroll") for (int ks = 0; ks < 3; ++ks) { vf[ks] = *(const GAS bf16x8*)(vp_ + 16 * ks); vf[3 + ks] = *(const GAS bf16x8*)(vp_ + (size_t)32 * VT_PITCH + 16 * ks); } } \
    f32x16 p0 = {}, p1 = {}; \
    _Pragma("unroll") for (int d0 = 0; d0 < 4; ++d0) { p0 = __builtin_amdgcn_mfma_f32_32x32x16_bf16(KF[d0], qr[d0], p0, 0, 0, 0); p1 = __builtin_amdgcn_mfma_f32_32x32x16_bf16(KF[4 + d0], qr[d0], p1, 0, 0, 0); } \
    if ((w) + 1 < 9) NA_LOADK(KF, (w) + 1);            \
    asm volatile("" ::: "memory"); conv_step<YN>(cv, lane);     \
    if ((w) < 8) { const LAS float* bp_ = relb + ((h * 15 + (rs + (w) - r + 7)) * 31 + 15 - qc + 4 * hi + kb0);     \
      float bv0[16], bv1[8];        \
      _Pragma("unroll") for (int rg = 0; rg < 16; ++rg) { const int c_ = (rg & 3) + 8 * (rg >> 2); bv0[rg] = bp_[c_]; if (rg < 8) bv1[rg] = bp_[c_ + 32]; } \
      _Pragma("unroll") for (int rg = 0; rg < 16; ++rg) { asm volatile("" : "+v"(bv0[rg])); if (rg < 8) asm volatile("" : "+v"(bv1[rg])); } \
      _Pragma("unroll") for (int rg = 0; rg < 16; ++rg) { const int c_ = (rg & 3) + 8 * (rg >> 2); \
        { const bool ok = (mh0 >> c_) & 1u; p0[rg] = ok ? fmaf(p0[rg], SCALE, bv0[rg]) : NEG; } \
        if (rg < 8) { const bool ok = (mh1 >> c_) & 1u; p1[rg] = ok ? fmaf(p1[rg], SCALE, bv1[rg]) : NEG; } } \
    } else { const LAS float* bp = metab + h * 16; \
      _Pragma("unroll") for (int rg = 0; rg < 16; ++rg) { const int kc = crow(rg, hi); p0[rg] = (rg < 8) ? fmaf(p0[rg], SCALE, bp[kc & 15]) : NEG; if (rg < 8) p1[rg] = NEG; } } \
      \
    float pmax = p0[0]; \
    _Pragma("unroll") for (int rg = 1; rg < 16; ++rg) pmax = fmaxf(pmax, p0[rg]); \
    _Pragma("unroll") for (int rg = 0; rg < 8; ++rg) pmax = fmaxf(pmax, p1[rg]); \
    { auto rr = __builtin_amdgcn_permlane32_swap(__float_as_uint(pmax), __float_as_uint(pmax), false, false); pmax = fmaxf(__uint_as_float(rr[0]), __uint_as_float(rr[1])); } \
    float mn, alpha; \
    if (__builtin_expect(__all(pmax - m_reg <= THRS), 1)) { mn = m_reg; alpha = 1.f; } \
    else { mn = fmaxf(m_reg, pmax); alpha = __builtin_amdgcn_exp2f((m_reg - mn) * C); m_reg = mn; } \
    const float mnC = -mn * C; float ps = 0.f; \
    _Pragma("unroll") for (int rg = 0; rg < 16; ++rg) { p0[rg] = __builtin_amdgcn_exp2f(fmaf(p0[rg], C, mnC)); ps += p0[rg]; } \
    _Pragma("unroll") for (int rg = 0; rg < 8; ++rg) { p1[rg] = __builtin_amdgcn_exp2f(fmaf(p1[rg], C, mnC)); ps += p1[rg]; } \
    { auto rr = __builtin_amdgcn_permlane32_swap(__float_as_uint(ps), __float_as_uint(ps), false, false); ps = __uint_as_float(rr[0]) + __uint_as_float(rr[1]); } \
    l_reg = l_reg * alpha + ps; \
    bf16x8 pa0, pa1, pa2; NA_PK4(p0, 0, pa0); NA_PK4(p0, 8, pa1); NA_PK4(p1, 0, pa2); \
    if (__any(alpha < 1.f)) { if (hi == 0) al_l[r32] = alpha; asm volatile("s_waitcnt lgkmcnt(0)" ::: "memory"); \
      _Pragma("unroll") for (int d = 0; d < 2; ++d) _Pragma("unroll") for (int rg = 0; rg < 16; ++rg) o[d][rg] *= al_l[crow(rg, hi)]; } \
    _Pragma("unroll") for (int d0 = 0; d0 < 2; ++d0) { \
      o[d0] = __builtin_amdgcn_mfma_f32_32x32x16_bf16(pa0, vf[3 * d0 + 0], o[d0], 0, 0, 0); o[d0] = __builtin_amdgcn_mfma_f32_32x32x16_bf16(pa1, vf[3 * d0 + 1], o[d0], 0, 0, 0); \
      o[d0] = __builtin_amdgcn_mfma_f32_32x32x16_bf16(pa2, vf[3 * d0 + 2], o[d0], 0, 0, 0); } } while (0)
#define NA_PK4(P, BASE, OUT) do { unsigned a0 = cvt_pk_bf16(P[BASE + 0], P[BASE + 1]), a1 = cvt_pk_bf16(P[BASE + 2], P[BASE + 3]);   \
    unsigned b0 = cvt_pk_bf16(P[BASE + 4], P[BASE + 5]), b1 = cvt_pk_bf16(P[BASE + 6], P[BASE + 7]);                              \
    auto r0 = __builtin_amdgcn_permlane32_swap(a0, b0, false, false); auto r1 = __builtin_amdgcn_permlane32_swap(a1, b1, false, false); \
    u32x4 w_ = {r0[0], r1[0], r0[1], r1[1]}; OUT = __builtin_bit_cast(bf16x8, w_); } while (0)
  { bf16x8 kA[8];
    NA_LOADK(kA, 0);
#pragma unroll 1
    for (int w = 0; w < 8; ++w) { NA_TILE(kA, w, 14); }
    NA_TILE(kA, 8, 6); }
#undef NA_PK4
#undef NA_KTOK
#undef NA_LOADK
#undef NA_TILE
  if (hi == 0) li_l[r32] = l_reg; asm volatile("s_waitcnt lgkmcnt(0)" ::: "memory");
  unsigned char* Ow = ONA + (size_t)(b * SEQ + r * 64 + half * 32) * 1024 + h * 64;
#pragma unroll
  for (int rg = 0; rg < 16; ++rg) { const int orow = crow(rg, hi); const float rl = __builtin_amdgcn_rcpf(li_l[orow]);
#pragma unroll
    for (int d0 = 0; d0 < 2; ++d0) Ow[(size_t)orow * 1024 + d0 * 32 + r32] = f32_to_fp8(o[d0][rg] * rl * 16.f); }
  asm volatile("s_waitcnt lgkmcnt(0)" ::: "memory");
}
}
namespace peer {
constexpr int CH = 32;
constexpr int OFF_TV = 0, OFF_TI = OFF_TV + CH * 16 * 16 * 4, OFF_SE = OFF_TI + CH * 16 * 16 * 4, OFF_SG = OFF_SE + CH * 128 * 4, OFF_SE2 = OFF_SG + CH * 128 * 4, OFF_SG2 = OFF_SE2 + CH * 128 * 4, PEER_LDS = OFF_SG2 + CH * 128 * 4;
static_assert(PEER_LDS <= RING_BYTES, "PEER LDS");
__device__ __forceinline__ float gelu_tanh(float x) {
    const float u = 0.7978845608028654f * (x + 0.044715f * x * x * x);
    const float e = __builtin_amdgcn_exp2f(-2.f * 1.4426950408889634f * fabsf(u));
    const float t = (1.f - e) * __builtin_amdgcn_rcpf(1.f + e);
    return 0.5f * x * (1.f + (u < 0.f ? -t : t));
}
__device__ __forceinline__ void fmac1(float& acc, float a, float b) { asm("v_fmac_f32_e32 %0, %1, %2" : "+v"(acc) : "v"(a), "v"(b)); }
#define PEER_INSERT(x_, xi_) do { float x__ = (x_); int xi__ = (xi_); \
    _Pragma("unroll") for (int j_ = 0; j_ < 16; ++j_) { const bool gt_ = x__ > tv[j_]; const float tvo_ = tv[j_]; const int tio_ = ti[j_]; \
        tv[j_] = gt_ ? x__ : tvo_; ti[j_] = gt_ ? xi__ : tio_; x__ = gt_ ? tvo_ : x__; xi__ = gt_ ? tio_ : xi__; } } while (0)

#define PEER_AUX 0
typedef __amdgpu_buffer_rsrc_t rsrc_t;
__device__ __forceinline__ rsrc_t mk_rsrc(const void* p, unsigned bytes) { return __builtin_amdgcn_make_buffer_rsrc((void*)p, 0, bytes, 0x00020000); }
__device__ __forceinline__ u32x4 ldb128(rsrc_t r, unsigned off) { return __builtin_amdgcn_raw_buffer_load_b128(r, off, 0, PEER_AUX); }
typedef unsigned v6u_t __attribute__((ext_vector_type(6)));
typedef float v32f_t __attribute__((ext_vector_type(32)));
typedef float v16f_t __attribute__((ext_vector_type(16)));
__device__ __forceinline__ u32x2 ldb64(rsrc_t r, unsigned off) { return __builtin_amdgcn_raw_buffer_load_b64(r, off, 0, PEER_AUX); }
__device__ __forceinline__ f32x4 ldf128(rsrc_t r, unsigned off) { return __builtin_bit_cast(f32x4, __builtin_amdgcn_raw_buffer_load_b128(r, off, 0, PEER_AUX)); }
__device__ __forceinline__ f32x4 ldf128_nt(rsrc_t r, unsigned off) { return __builtin_bit_cast(f32x4, __builtin_amdgcn_raw_buffer_load_b128(r, off, 0, 2)); }
__device__ __forceinline__ void peer_select(int chunk, const _Float16* __restrict__ SC, LAS char* lds, int tid, LAS int* SE, LAS float* SG) {
    LAS float* TV = (LAS float*)(lds + OFF_TV); LAS int* TI = (LAS int*)(lds + OFF_TI);
    asm volatile("" : "+v"(tid));
    const int tok0 = chunk * CH;
    const rsrc_t rSC = mk_rsrc(SC, 0x4000000u);
    __syncthreads();
    { const int tl = tid >> 4, g = tid & 15; const unsigned spo = ((unsigned)(tok0 + tl) * 2048u + (unsigned)g * 128u) * 2u;
      int tk[16];
#pragma unroll
      for (int j = 0; j < 16; ++j) tk[j] = (int)0x80000000;
#define PEER_KEY(x_, lowbits_, mask_) ({ const int f_ = __float_as_int(x_); ((f_ ^ ((f_ >> 31) & 0x7fffffff)) & ~(mask_)) | (lowbits_); })
#define PEER_INS(key_) do { int x__ = (key_); _Pragma("unroll") for (int j_ = 0; j_ < 16; ++j_) { const int hi_ = max(x__, tk[j_]); x__ = min(x__, tk[j_]); tk[j_] = hi_; } } while (0)
#pragma unroll 1
      for (int i = 0; i < 16; i += 2) { typedef _Float16 h8_t __attribute__((ext_vector_type(8)));
          const h8_t a = __builtin_bit_cast(h8_t, __builtin_amdgcn_raw_buffer_load_b128(rSC, spo + i * 16, 0, 2)), b = __builtin_bit_cast(h8_t, __builtin_amdgcn_raw_buffer_load_b128(rSC, spo + i * 16 + 16, 0, 2));
#pragma unroll
          for (int e = 0; e < 8; ++e) { PEER_INS(PEER_KEY((float)a[e], 127 - (8 * i + e), 127)); }
#pragma unroll
          for (int e = 0; e < 8; ++e) { PEER_INS(PEER_KEY((float)b[e], 127 - (8 * i + 8 + e), 127)); } }
      LAS float* tvp = TV + (tl * 16 + g) * 16; LAS int* tip = TI + (tl * 16 + g) * 16;
#pragma unroll
      for (int j = 0; j < 16; ++j) { const int k_ = tk[j] & ~127; tvp[j] = __int_as_float(k_ ^ ((k_ >> 31) & 0x7fffffff)); tip[j] = 127 - (tk[j] & 127); } }
    __syncthreads();
    asm volatile("" : "+v"(tid));
    { const int tl = tid >> 4, hh = (tid >> 1) & 7, half = tid & 1;
      const LAS float* s1 = TV + (tl * 16 + 2 * hh) * 16; const LAS float* s2 = s1 + 16; const LAS int* i1 = TI + (tl * 16 + 2 * hh) * 16; const LAS int* i2 = i1 + 16;
      float b2[16];
#pragma unroll
      for (int j = 0; j < 16; ++j) b2[j] = s2[j];
      int tk[16];
#pragma unroll
      for (int j = 0; j < 16; ++j) tk[j] = (int)0x80000000;
#pragma unroll
      for (int ii = 0; ii < 8; ++ii) { const int i = 2 * ii + half; const float a = s1[i];
#pragma unroll
          for (int j = 0; j < 16; ++j) if ((2 * ii + 1) * (j + 1) <= 16) { if (half == 0 || (2 * ii + 2) * (j + 1) <= 16) PEER_INS(PEER_KEY(a + b2[j], 255 - (i * 16 + j), 255)); } }
      { int pk[16];
#pragma unroll
        for (int j = 0; j < 16; ++j) pk[j] = __shfl_xor(tk[j], 1);
#pragma unroll
        for (int j = 0; j < 16; ++j) PEER_INS(pk[j]); }
      if (half == 0) { float e[16], sum = 0.f; const int k0_ = tk[0] & ~255; const float v0 = __int_as_float(k0_ ^ ((k0_ >> 31) & 0x7fffffff));
#pragma unroll
        for (int j = 0; j < 16; ++j) { const int k_ = tk[j] & ~255; const float vj = __int_as_float(k_ ^ ((k_ >> 31) & 0x7fffffff)); e[j] = __builtin_amdgcn_exp2f((vj - v0) * 1.4426950408889634f); sum += e[j]; }
        const float inv = 1.0f / sum;
#pragma unroll
        for (int j = 0; j < 16; ++j) { const int ci = 255 - (tk[j] & 255); SE[tl * 128 + hh * 16 + j] = i1[ci >> 4] * 128 + i2[ci & 15]; SG[tl * 128 + hh * 16 + j] = e[j] * inv; } } }
#undef PEER_KEY
#undef PEER_INS
    __syncthreads();
}
__device__ __forceinline__ void peer_gather(int chunk, const bf16_t* __restrict__ H2, const unsigned char* __restrict__ U, const unsigned char* __restrict__ V,
                                            const float* __restrict__ g2, const float* __restrict__ gf, float* OUT, int tid, const LAS int* SE, const LAS float* SG) {
    asm volatile("" : "+v"(tid));
    const int tok0 = chunk * CH, lane = tid & 63, wave = tid >> 6;
    const rsrc_t rH2 = mk_rsrc(H2, 0x4000000u), rU = mk_rsrc(U, 0x1800000u), rV = mk_rsrc(V, 0x1800000u), rG2 = mk_rsrc(g2, 8192u), rGF = mk_rsrc(gf, 8192u);
#pragma unroll 1
    for (int tt = 0; tt < CH / NWAVES; ++tt) { const int tl = wave * (CH / NWAVES) + tt, tok = tok0 + tl;
      asm volatile("" ::: "memory");
      float hn[32], acc[32]; float ss = 0.f;
#pragma unroll
      for (int j = 0; j < 2; ++j)
#pragma unroll
          for (int q = 0; q < 4; ++q) { const u32x2 w = ldb64(rH2, ((unsigned)tok * 2048u + 256u * (4 * j + q) + 4u * lane) * 2u);
              const f32x4 a = (f32x4){__uint_as_float(w.x << 16), __uint_as_float(w.x & 0xffff0000u), __uint_as_float(w.y << 16), __uint_as_float(w.y & 0xffff0000u)};
#pragma unroll
              for (int i = 0; i < 4; ++i) { hn[16 * j + 4 * q + i] = a[i]; ss += a[i] * a[i]; } }
      const float rstd = 1.0f / sqrtf(wave_sum(ss) * (1.f / 2048.f) + NORM_EPS);
#pragma unroll
      for (int j = 0; j < 2; ++j)
#pragma unroll
          for (int q = 0; q < 4; ++q) { const f32x4 a = ldf128(rG2, (256u * (4 * j + q) + 4u * lane) * 4u);
#pragma unroll
              for (int i = 0; i < 4; ++i) hn[16 * j + 4 * q + i] *= rstd * a[i]; }
#pragma unroll
      for (int i = 0; i < 32; ++i) acc[i] = 0.f;
#define NX 4
#define PEER_LOAD(S, kb) do { _Pragma("unroll") for (int x = 0; x < NX; ++x) { const unsigned o = (unsigned)SE[tl * 128 + (kb) + x] * 1536u; \
          S##ua[x] = ldb128(rU, o + (unsigned)lane * 16u); S##ub[x] = ldb64(rU, o + 1024u + (unsigned)lane * 8u); S##va[x] = ldb128(rV, o + (unsigned)lane * 16u); S##vb[x] = ldb64(rV, o + 1024u + (unsigned)lane * 8u); } } while (0)
#define PEER_DEC(A, B) ({ v32f_t r_ = __builtin_amdgcn_cvt_scalef32_pk32_f32_fp6((v6u_t){A.x, A.y, A.z, A.w, B.x, B.y}, 1.0f); asm volatile("s_nop 1" : "+v"(r_)); r_; })
#define PEER_COMPUTE(S, kb) do { float d[NX]; \
          _Pragma("unroll") for (int x = 0; x < NX; ++x) { const v32f_t r = PEER_DEC(S##ua[x], S##ub[x]); float dd = 0.f; \
              _Pragma("unroll") for (int i = 0; i < 32; ++i) fmac1(dd, hn[i], r[i]); \
              d[x] = dd; } \
          _Pragma("unroll") for (int o = 1; o < 64; o <<= 1) { _Pragma("unroll") for (int x = 0; x < NX; ++x) d[x] += __shfl_xor(d[x], o); } \
          float c[NX]; \
          _Pragma("unroll") for (int x = 0; x < NX; ++x) c[x] = SG[tl * 128 + (kb) + x] * gelu_tanh(d[x] * (1.f / 64.f)) * 0.25f; \
          _Pragma("unroll") for (int x = 0; x < NX; ++x) { const v32f_t r = PEER_DEC(S##va[x], S##vb[x]); \
              _Pragma("unroll") for (int i = 0; i < 32; ++i) fmac1(acc[i], c[x], r[i]); } } while (0)
      { u32x4 Aua[NX], Ava[NX], Bua[NX], Bva[NX]; u32x2 Aub[NX], Avb[NX], Bub[NX], Bvb[NX];
        PEER_LOAD(A, 0);
#pragma unroll 1
        for (int k = 0; k < 128; k += 2 * NX) {
            PEER_LOAD(B, k + NX); PEER_COMPUTE(A, k);
            { const int kn = min(k + 2 * NX, 128 - NX); PEER_LOAD(A, kn); }
            PEER_COMPUTE(B, k + NX);
        } }
#undef PEER_DEC
#undef NX
#undef PEER_LOAD
#undef PEER_COMPUTE
      asm volatile("" ::: "memory");
      int tok2 = tok, lane2 = lane; asm volatile("" : "+v"(tok2), "+v"(lane2));
      float s2 = 0.f;
#pragma unroll
      for (int j = 0; j < 2; ++j)
#pragma unroll
          for (int q = 0; q < 4; ++q) { const u32x2 w = ldb64(rH2, ((unsigned)tok2 * 2048u + 256u * (4 * j + q) + 4u * lane2) * 2u);
              const f32x4 a = (f32x4){__uint_as_float(w.x << 16), __uint_as_float(w.x & 0xffff0000u), __uint_as_float(w.y << 16), __uint_as_float(w.y & 0xffff0000u)};
#pragma unroll
              for (int i = 0; i < 4; ++i) { acc[16 * j + 4 * q + i] += a[i]; s2 += acc[16 * j + 4 * q + i] * acc[16 * j + 4 * q + i]; } }
      const float rf = 1.0f / sqrtf(wave_sum(s2) * (1.f / 2048.f) + NORM_EPS);
#pragma unroll
      for (int j = 0; j < 2; ++j)
#pragma unroll
          for (int q = 0; q < 4; ++q) { const f32x4 a = ldf128(rGF, (256u * (4 * j + q) + 4u * lane2) * 4u); f32x4 oa;
#pragma unroll
              for (int i = 0; i < 4; ++i) oa[i] = acc[16 * j + 4 * q + i] * rf * a[i];
              float* op = OUT + (size_t)tok2 * 2048 + 256 * (4 * j + q) + 4 * lane2;
              __builtin_nontemporal_store(oa, (GAS f32x4*)op); }
    }
}
}
#ifndef MK_N_LAUNCHES
#define MK_N_LAUNCHES 1
#endif
#define MK_PROBE_PH -1
#define MK_PROBE_DIV 2
constexpr int N_PHASES = 9;
constexpr int N_LAUNCHES = MK_N_LAUNCHES;
struct Args { const float* in[19]; float* out; unsigned char* ws; int ph_lo, ph_hi; };
static_assert(sizeof(Args) == 19 * 8 + 8 + 8 + 8, "no padding");

__global__ void __launch_bounds__(NWAVES * 64, 2) hybrid_fwd(Args args) {
    extern __shared__ __attribute__((aligned(16))) unsigned char lds_raw[];
    Frame F;
    F.lds = (LAS unsigned char*)lds_raw;
    F.MISC = (volatile LAS unsigned*)(F.lds + MISC_OFF);
    F.tid = threadIdx.x; F.lane = F.tid & 63; F.wave = __builtin_amdgcn_readfirstlane(F.tid >> 6);
    F.G = gridDim.x; { const int bx = blockIdx.x; F.vcu = (F.G % 8 == 0) ? (bx % 8) * (F.G / 8) + bx / 8 : bx; }
    F.ws = args.ws; F.out = args.out;
#pragma unroll
    for (int i = 0; i < 19; ++i) F.in[i] = args.in[i];
    for (int u = F.tid; u < (LDS_BYTES - LDSCTL_OFF) / 4; u += NWAVES * 64) ((LAS unsigned*)(F.lds + LDSCTL_OFF))[u] = 0u;
    __syncthreads();
    XcdBarrier bar; bar.bar = (unsigned*)(F.ws + WS_CTL) + CW_BAR; bar.x = 0; bar.st = nullptr;
    if (N_LAUNCHES == 1) bar = xcd_barrier_post((unsigned*)(F.ws + WS_CTL) + CW_BAR, F.MISC + 8);
    const int lo = args.ph_lo, hi = args.ph_hi;
#define IN(k) (lo <= (k) && (k) < hi)
#if MK_PROBE_PH >= 0
    unsigned long long tp0 = (MK_PROBE_PH == 0 || MK_PROBE_PH == 9) ? __builtin_amdgcn_s_memrealtime() : 0ull, tp1 = 0ull;
#define SEAM(k) do { if (IN(k) && IN((k) + 1)) xcd_barrier(bar); if (MK_PROBE_PH == (k)) tp1 = __builtin_amdgcn_s_memrealtime(); if (MK_PROBE_PH == (k) + 1) tp0 = __builtin_amdgcn_s_memrealtime(); } while (0)
#else
#define SEAM(k) do { if (IN(k) && IN((k) + 1)) xcd_barrier(bar); } while (0)
#endif
    const size_t T2048 = (size_t)256 * 2048 * 2, T1024 = (size_t)256 * 1024 * 2, T512 = (size_t)256 * 512 * 2;
    float* cosT = WSP(float, WS_COS); float* sinT = WSP(float, WS_SIN);
    float* ssq_q = WSP(float, WS_SSQ_Q); float* ssq_kv = WSP(float, WS_SSQ_KV); float* ssq2 = WSP(float, WS_SSQ_2);

    if (IN(0)) { p0_prologue<0>(F, F.vcu, F.G); } SEAM(0);
    if (IN(1)) {
        SchedP1 S{F.G, (int)blockIdx.x, (const char*)(F.ws + WS_HN1), (const char*)(F.ws + WS_WIN), (const char*)(F.ws + WS_WVT), T1024};
        EpiP1 E{WSP(bf16_t, WS_NAQ), WSP(bf16_t, WS_NAK), WSP(bf16_t, WS_VT), WSP(unsigned char, WS_CQ), WSP(unsigned char, WS_CKV), WSP(bf16_t, WS_KR), WSP(unsigned char, WS_GA), WSP(unsigned char, WS_GB), ssq_q, ssq_kv, cosT, sinT};
        pg8::gemm_phase<EpiP1, SchedP1, true, -6>(F.lds, 2048, S, E);
        { const int extra = P1_UNITS % F.G, bx = (int)blockIdx.x; if (extra != 0 && bx >= extra) p0_prologue<1>(F, bx - extra, F.G - extra); else if (extra == 0) p0_prologue<1>(F, bx, F.G); }
    } SEAM(1);
    if (IN(2)) {
        LAS float* relb = (LAS float*)F.lds + 64; LAS float* metab = relb + 16 * 15 * 31 + 128; LAS float* wsf = metab + 256 + F.wave * 64;
        for (int i = F.tid; i < 16 * 15 * 31; i += NWAVES * 64) relb[i] = F.in[4][i];
        if (F.tid < 256) metab[F.tid] = F.in[5][F.tid];
        __syncthreads();
        const int gw = F.vcu * NWAVES + F.wave, NGW = F.G * NWAVES;
        Conv cv{F.in[16], F.in[17], WSP(unsigned char, WS_U), WSP(unsigned char, WS_V), F.lds + 65536 + F.wave * 8192, gw, NGW, 2 * 16384, -1};
        for (int task = gw; task < NBATCH * 16 * 32 * 2; task += NGW)
            att::na_task(task, WSP(bf16_t, WS_NAQ), WSP(bf16_t, WS_NAK), WSP(bf16_t, WS_VT), WSP(unsigned char, WS_ONA), relb, metab, wsf, F.lane, cv);
        while (cv.pend >= 0 || cv.next < cv.end) conv_step<0>(cv, F.lane);
        __syncthreads();
    } SEAM(2);
    if (IN(3)) {
        SchedP3 S{F.G, (int)blockIdx.x, (const char*)(F.ws + WS_CQ), (const char*)(F.ws + WS_CKV), (const char*)(F.ws + WS_WUQ), (const char*)(F.ws + WS_WUKV), T512 / 2};
        EpiP3 E{WSP(bf16_t, WS_QM), WSP(bf16_t, WS_KN), WSP(bf16_t, WS_VV), ssq_q, ssq_kv, cosT, sinT};
        pg8::gemm_phase<EpiP3, SchedP3, true, -4>(F.lds, 512, S, E);
    } SEAM(3);
    if (IN(4)) {
        for (int id = F.vcu; id < NBATCH * 16 * 8; id += F.G) { const int bh = id >> 3, qb = id & 7;
            att::mla_unit(bh >> 4, bh & 15, qb, WSP(bf16_t, WS_QM), WSP(bf16_t, WS_KN), WSP(bf16_t, WS_KR), WSP(bf16_t, WS_VV), WSP(unsigned char, WS_OMLA), (LAS char*)F.lds); }
        __syncthreads();
    } SEAM(4);
    if (IN(5)) {
        { SchedGrid S{F.G, (int)blockIdx.x, 64, 8, (const char*)(F.ws + WS_ONA), (const char*)(F.ws + WS_WNA), T512};
          EpiP5a E{WSP(unsigned char, WS_GA), WSP(bf16_t, WS_T1)};
          pg8::gemm_phase<EpiP5a, SchedGrid, true, -9>(F.lds, 1024, S, E); }
        { SchedGrid S{F.G, (int)blockIdx.x, 64, 8, (const char*)(F.ws + WS_OMLA), (const char*)(F.ws + WS_WMLA), T1024};
          EpiP5b E{WSP(unsigned char, WS_GB), WSP(bf16_t, WS_T1), WSP(unsigned char, WS_MERGED)};
          pg8::gemm_phase<EpiP5b, SchedGrid, true, -11>(F.lds, 2048, S, E); }
    } SEAM(5);
    if (IN(6)) {
        { SchedGrid S{F.G, (int)blockIdx.x, 64, 8, (const char*)(F.ws + WS_MERGED), (const char*)(F.ws + WS_WOUT), T1024};
          EpiP6 E{F.in[0], WSP(bf16_t, WS_H2B), ssq2};
          pg8::gemm_phase<EpiP6, SchedGrid, true, -11>(F.lds, 2048, S, E); }
    } SEAM(6);
    if (IN(7)) {
        SchedGrid S{F.G, (int)blockIdx.x, 64, 8, (const char*)(F.ws + WS_H2B), (const char*)(F.ws + WS_WSC), T2048};
        EpiP7 E{ssq2, WSP(_Float16, WS_SC)};
        pg8::gemm_phase<EpiP7, SchedGrid>(F.lds, 2048, S, E);
    } SEAM(7);
    if (IN(8)) {
        const int nch = (MREAL / peer::CH - F.vcu + F.G - 1) / F.G; const bool both_first = (nch == 2) && (F.vcu & 1);
        for (int op = 0; op < 2 * nch; ++op) {
            const bool sel = both_first ? (op < 2) : !(op & 1); const int ci = both_first ? (op & 1) : (op >> 1), chunk = F.vcu + ci * F.G;
            const int b2 = both_first ? ci : 0;
            LAS int* SE = (LAS int*)(F.lds + (b2 ? peer::OFF_SE2 : peer::OFF_SE)); LAS float* SG = (LAS float*)(F.lds + (b2 ? peer::OFF_SG2 : peer::OFF_SG));
            if (sel) peer::peer_select(chunk, WSP(_Float16, WS_SC), (LAS char*)F.lds, F.tid, SE, SG);
            else peer::peer_gather(chunk, WSP(bf16_t, WS_H2B), WSP(unsigned char, WS_U), WSP(unsigned char, WS_V), F.in[13], F.in[18], F.out, F.tid, SE, SG); }
    }
#if MK_PROBE_PH >= 0
    xcd_barrier(bar); tp1 = (MK_PROBE_PH >= 8) ? __builtin_amdgcn_s_memrealtime() : tp1;
    if (blockIdx.x == 0 && F.tid == 0) F.out[0] = (float)(tp1 - tp0) * (0.01f / MK_PROBE_DIV);
#endif
#undef IN
#undef SEAM
}

extern "C" void kernel_launch(void* const* d_in, const int* in_sizes, int n_in, void* d_out, int out_size, void* d_ws, size_t ws_size, hipStream_t stream) {
    static int grid = 0;
    if (grid == 0) {
        if (n_in != 19 || in_sizes[0] != MREAL * DM || out_size != MREAL * DM || ws_size < WS_END) {
            fprintf(stderr, "kernel_launch: shape/workspace mismatch: n_in %d in0 %d out %d ws %zu (need %zu); nothing launched\n", n_in, n_in > 0 ? in_sizes[0] : -1, out_size, ws_size, (size_t)WS_END); grid = -1; return; }
        int dev = 0, cus = 0, per_cu = 0;
        if (hipGetDevice(&dev) != hipSuccess || hipDeviceGetAttribute(&cus, hipDeviceAttributeMultiprocessorCount, dev) != hipSuccess) { fprintf(stderr, "kernel_launch: device query failed\n"); grid = -1; return; }
        if (hipFuncSetAttribute((const void*)hybrid_fwd, hipFuncAttributeMaxDynamicSharedMemorySize, LDS_BYTES) != hipSuccess) { fprintf(stderr, "kernel_launch: hipFuncSetAttribute failed\n"); grid = -1; return; }
        if (hipOccupancyMaxActiveBlocksPerMultiprocessor(&per_cu, (const void*)hybrid_fwd, NWAVES * 64, LDS_BYTES) != hipSuccess || per_cu < 1)
            fprintf(stderr, "kernel_launch: note: occupancy query reports %d workgroups per CU\n", per_cu);
        (void)hipGetLastError();
        grid = cus;
    }
    if (grid < 0) return;
    if (hipMemsetAsync((char*)d_ws + WS_CTL, 0, CTL_ZERO_BYTES, stream) != hipSuccess) { fprintf(stderr, "kernel_launch: hipMemsetAsync failed\n"); return; }
    Args a{};
    for (int i = 0; i < 19; ++i) a.in[i] = (const float*)d_in[i];
    a.out = (float*)d_out; a.ws = (unsigned char*)d_ws;
    for (int li = 0; li < N_LAUNCHES; ++li) {
        a.ph_lo = (N_LAUNCHES == 1) ? 0 : li; a.ph_hi = (N_LAUNCHES == 1) ? N_PHASES : li + 1;
        hipLaunchKernelGGL(hybrid_fwd, dim3(grid), dim3(NWAVES * 64), LDS_BYTES, stream, a);
        const hipError_t le = hipPeekAtLastError();
        if (le != hipSuccess) { fprintf(stderr, "kernel_launch: launch %d failed: %s\n", li, hipGetErrorName(le)); break; }
    }
}
```

```cpp
#include <hip/hip_runtime.h>
#include <cstdio>
#include <cstdint>

#define LAS __attribute__((address_space(3)))
#define GAS __attribute__((address_space(1)))
typedef unsigned short bf16_t;
typedef short bf16x8 __attribute__((ext_vector_type(8)));
typedef short s16x4 __attribute__((ext_vector_type(4)));
typedef float f32x4 __attribute__((ext_vector_type(4)));
typedef float f32x2 __attribute__((ext_vector_type(2)));
typedef float f32x16 __attribute__((ext_vector_type(16)));
typedef unsigned u32x4 __attribute__((ext_vector_type(4)));
typedef unsigned u32x2 __attribute__((ext_vector_type(2)));

constexpr int DM = 2048, NBATCH = 8, SEQ = 2048, NMETA = 16;
constexpr int MREAL = NBATCH * SEQ;
constexpr int MPAD = MREAL + 256;
constexpr int NPOS = SEQ + NMETA;
constexpr float NORM_EPS = 1e-6f;
constexpr int C_NAQ = 0, C_NAK = 1024, C_CQ = 2048, C_CKV = 2560, C_GA = 3072, C_GB = 5120, C_KR = 7168, NMAIN = 7424;
constexpr int VT_PITCH = MPAD;

constexpr size_t MiB = 1u << 20;
constexpr size_t WS_CTL = 0, CTL_ZERO_BYTES = 1 * MiB;
constexpr size_t WS_SSQ_Q = 481 * MiB, WS_SSQ_KV = 482 * MiB, WS_SSQ_2 = 486 * MiB;
constexpr size_t WS_COS = 1 * MiB, WS_SIN = 1 * MiB + 512 * 1024;
constexpr size_t WS_WUQ = 2 * MiB, WS_WUKV = 5 * MiB, WS_WNA = 9 * MiB, WS_WMLA = 13 * MiB, WS_WOUT = 21 * MiB, WS_WSC = 29 * MiB;
constexpr size_t WS_GA = 37 * MiB, WS_GB = 101 * MiB;
constexpr size_t WS_KR = 165 * MiB;
constexpr size_t WS_WIN = 167 * MiB + 256 * 1024, WS_WVT = WS_WIN + 29 * MiB;
constexpr size_t WS_ONA = 190 * MiB;
constexpr size_t WS_NAQ = 222 * MiB, WS_NAK = 254 * MiB, WS_VT = WS_NAK + 32 * MiB + 512 * 1024;
constexpr size_t WS_HN1 = 319 * MiB;
constexpr size_t WS_CQ = 448 * MiB, WS_CKV = 464 * MiB;
constexpr size_t WS_QM = 222 * MiB, WS_KN = 318 * MiB, WS_VV = 383 * MiB;
constexpr size_t WS_OMLA = 448 * MiB;
constexpr size_t WS_MERGED = 222 * MiB, WS_T1 = 286 * MiB;
constexpr size_t WS_H2 = 37 * MiB, WS_H2B = 293 * MiB;
constexpr size_t WS_U = 69 * MiB, WS_V = 133 * MiB;
constexpr size_t WS_SC = 165 * MiB;
constexpr size_t WS_END = 512 * MiB;
static_assert(WS_CKV + (size_t)MPAD * 512 * 2 <= WS_SSQ_Q && WS_SSQ_Q + (size_t)8 * MPAD * 4 <= WS_SSQ_KV && WS_SSQ_KV + (size_t)8 * MPAD * 4 <= 483 * MiB && WS_SSQ_2 + (size_t)32 * MREAL * 4 <= WS_END, "ssq slabs");
static_assert(WS_VT + (size_t)1024 * MPAD * 2 <= WS_HN1 && WS_HN1 + (size_t)MPAD * 2048 * 2 <= WS_CQ && WS_CKV + (size_t)MPAD * 512 * 2 <= WS_END, "map P1");
static_assert(WS_WVT + 4 * MiB <= WS_NAQ && WS_KR + (size_t)MPAD * 64 * 2 <= WS_WIN && WS_ONA + 32 * MiB <= WS_NAQ, "map P1b");
static_assert(WS_QM + 96 * MiB <= WS_KN && WS_KN + 65 * MiB <= WS_VV && WS_VV + 65 * MiB <= WS_OMLA && WS_OMLA + 64 * MiB <= WS_END, "map P3");
static_assert(WS_T1 + 128 * MiB <= WS_OMLA && WS_H2 + 128 * MiB <= WS_KR && WS_SC + 128 * MiB <= WS_H2B && WS_H2B + 64 * MiB <= WS_END, "map P5+");
static_assert(WS_GA + 32 * MiB <= WS_U && WS_U + 24 * MiB <= WS_GB && WS_GB + 32 * MiB <= WS_V && WS_V + 24 * MiB <= WS_KR, "expert tables between the gate codes");

constexpr int CW_BAR = 4096;

constexpr int RING_BYTES = 131072;
constexpr int LDSCTL_OFF = RING_BYTES, MISC_OFF = LDSCTL_OFF + 320;
constexpr int LDS_BYTES = 147456;
constexpr int NWAVES = 8;

#define LDS_WAIT() asm volatile("s_waitcnt lgkmcnt(0)" ::: "memory")
#define VM_WAIT() asm volatile("s_waitcnt vmcnt(0)" ::: "memory")
#define SBAR() __builtin_amdgcn_sched_barrier(0)
typedef __bf16 bf16x2_t __attribute__((ext_vector_type(2)));
__device__ __forceinline__ unsigned cvt_pk_bf16(float lo, float hi) { const f32x2 v = {lo, hi}; const bf16x2_t b = __builtin_convertvector(v, bf16x2_t); return __builtin_bit_cast(unsigned, b); }
__device__ __forceinline__ float bf_lo(unsigned w) { return __uint_as_float(w << 16); }
__device__ __forceinline__ float bf_hi(unsigned w) { return __uint_as_float(w & 0xffff0000u); }
__device__ __forceinline__ u32x4 pack8(const f32x4 a, const f32x4 b) { u32x4 w; w.x = cvt_pk_bf16(a[0], a[1]); w.y = cvt_pk_bf16(a[2], a[3]); w.z = cvt_pk_bf16(b[0], b[1]); w.w = cvt_pk_bf16(b[2], b[3]); return w; }
__device__ __forceinline__ u32x2 pack8_fp8(f32x4 a, f32x4 b) {
#pragma unroll
    for (int i = 0; i < 4; ++i) { a[i] = __builtin_fminf(__builtin_fmaxf(a[i], -448.f), 448.f); b[i] = __builtin_fminf(__builtin_fmaxf(b[i], -448.f), 448.f); }
    int w0 = 0, w1 = 0; w0 = __builtin_amdgcn_cvt_pk_fp8_f32(a[0], a[1], w0, false); w0 = __builtin_amdgcn_cvt_pk_fp8_f32(a[2], a[3], w0, true);
    w1 = __builtin_amdgcn_cvt_pk_fp8_f32(b[0], b[1], w1, false); w1 = __builtin_amdgcn_cvt_pk_fp8_f32(b[2], b[3], w1, true); return (u32x2){(unsigned)w0, (unsigned)w1}; }
__device__ __forceinline__ unsigned char f32_to_fp8(float x) { x = __builtin_fminf(__builtin_fmaxf(x, -448.f), 448.f); return (unsigned char)(__builtin_amdgcn_cvt_pk_fp8_f32(x, 0.f, 0, false) & 0xff); }
__device__ __forceinline__ u32x2 pack8_u8(const f32x4 a, const f32x4 b) { u32x2 w; unsigned x = 0u, y = 0u;
    x = __builtin_amdgcn_cvt_pk_u8_f32(a[0] * 255.f, 0u, x); x = __builtin_amdgcn_cvt_pk_u8_f32(a[1] * 255.f, 1u, x); x = __builtin_amdgcn_cvt_pk_u8_f32(a[2] * 255.f, 2u, x); x = __builtin_amdgcn_cvt_pk_u8_f32(a[3] * 255.f, 3u, x);
    y = __builtin_amdgcn_cvt_pk_u8_f32(b[0] * 255.f, 0u, y); y = __builtin_amdgcn_cvt_pk_u8_f32(b[1] * 255.f, 1u, y); y = __builtin_amdgcn_cvt_pk_u8_f32(b[2] * 255.f, 2u, y); y = __builtin_amdgcn_cvt_pk_u8_f32(b[3] * 255.f, 3u, y);
    w.x = x; w.y = y; return w; }
__device__ __forceinline__ void unpack8_u8(const u32x2 w, f32x4& a, f32x4& b) { const float k = 1.f / 255.f;
    a = (f32x4){(float)(w.x & 0xffu), (float)((w.x >> 8) & 0xffu), (float)((w.x >> 16) & 0xffu), (float)(w.x >> 24)} * k;
    b = (f32x4){(float)(w.y & 0xffu), (float)((w.y >> 8) & 0xffu), (float)((w.y >> 16) & 0xffu), (float)(w.y >> 24)} * k; }
__device__ __forceinline__ u32x2 pack4(const f32x4 a) { u32x2 w; w.x = cvt_pk_bf16(a[0], a[1]); w.y = cvt_pk_bf16(a[2], a[3]); return w; }
__device__ __forceinline__ float wave_sum(float v) {
#pragma unroll
    for (int o = 1; o < 64; o <<= 1) v += __shfl_xor(v, o);
    return v;
}
__device__ __forceinline__ float sigmoidf_(float x) { return __builtin_amdgcn_rcpf(1.0f + __builtin_amdgcn_exp2f(-1.4426950408889634f * x)); }
__device__ __forceinline__ int crow(int r, int hi) { return (r & 3) + 8 * (r >> 2) + 4 * hi; }
#define PG8_AUX 0
namespace pg8 {
constexpr int BM = 256, BK = 64, HALF = 128, HTB = HALF * BK * 2  , STAGE_BYTES = 8 * HTB, NXCD = 8, WGM = 8;
__host__ __device__ __forceinline__ int lds_byte(int r, int c) { const int st = (r >> 4) * 2 + (c >> 5), rr = r & 15, cc = c & 31, ob = rr * 64 + cc * 2; return st * 1024 + (ob ^ (((ob >> 9) & 1) << 5)); }
__host__ __device__ __forceinline__ void stage_rc(int b, int& R, int& C) { const int st = b / 1024, sb = b % 1024, swz = sb ^ (((sb >> 9) & 1) << 5); R = (st >> 1) * 16 + swz / 64; C = (st & 1) * 32 + (swz % 64) / 2; }
__host__ __device__ __forceinline__ int perm32(int rho) { const int n = rho >> 4, i = rho & 15; return 8 * (i >> 2) + 4 * n + (i & 3); }

struct Unit { int pm, pn, kind; };

__device__ __forceinline__ void grid_order(int L, int nM, int nN, int& pm, int& pn) {
    const int nwg = nM * nN; int wgid = L;
    { const int q = nwg / NXCD, r = nwg % NXCD, xcd = wgid % NXCD, off = wgid / NXCD; wgid = (xcd < r ? xcd * (q + 1) : r * (q + 1) + (xcd - r) * q) + off; }
    const int nig = WGM * nN, gid = wgid / nig, fm = gid * WGM, gsz = (nM - fm) < WGM ? (nM - fm) : WGM;
    pm = fm + ((wgid % nig) % gsz); pn = (wgid % nig) / gsz;
}

typedef int v8i_t __attribute__((ext_vector_type(8)));
template <class Epi, class Sched, bool F8 = false, int F8_SCALE_EXP = 0>
__device__ __forceinline__ void gemm_phase(LAS unsigned char* lds, const int K, const Sched& S, const Epi& E) {
    const int tid = threadIdx.x, wid = __builtin_amdgcn_readfirstlane(tid >> 6), lane = tid & 63, wr = wid >> 2, wc = wid & 3, fr = lane & 15, fq = lane >> 4;
    int f8sa = 0x01010101 * (127 + F8_SCALE_EXP), f8sb = 0x7f7f7f7f; asm volatile("" : "+v"(f8sa), "+v"(f8sb));
    const int Kb = F8 ? K : 2 * K;
    const int nt = Kb / 128;
    unsigned voffA[2], voffB[2];
#pragma unroll
    for (int i = 0; i < 2; ++i) { int R, C; stage_rc(tid * 16 + i * 8192, R, C); const int Rb = Epi::PERM ? ((R & ~31) + perm32(R & 31)) : R;
        voffA[i] = (unsigned)(R * Kb + C * 2); voffB[i] = (unsigned)(Rb * Kb + C * 2); }
    const size_t kstep = (size_t)128;
    const size_t hstep = (size_t)HALF * Kb;
    const unsigned ldsw = (unsigned)wid * 1024u;
    const int aoff = lds_byte(wr * 64 + fr, F8 ? fq * 16 : fq * 8), boff = lds_byte(wc * 32 + fr, F8 ? fq * 16 : fq * 8);
#define PG8_SA(b, h) (((b) * 2 + (h)) * HTB)
#define PG8_SB(b, h) ((4 + (b) * 2 + (h)) * HTB)
#define PG8_STAGE(bufoff, gbase, voff) do { _Pragma("unroll") for (int _i = 0; _i < 2; ++_i) \
        __builtin_amdgcn_global_load_lds((const unsigned*)((const char*)(gbase) + (voff)[_i]), (LAS unsigned*)(lds + (bufoff) + ldsw + _i * 8192), 16, 0, PG8_AUX); } while (0)
#define PG8_LDA(dst, b, h) do { _Pragma("unroll") for (int m = 0; m < 4; ++m) _Pragma("unroll") for (int k = 0; k < 2; ++k) dst[m][k] = *(const LAS bf16x8*)(lds + PG8_SA(b, h) + aoff + m * 2048 + (F8 ? k * 16 : k * 1024)); } while (0)
#define PG8_LDB(dst, b, h) do { _Pragma("unroll") for (int n = 0; n < 2; ++n) _Pragma("unroll") for (int k = 0; k < 2; ++k) dst[n][k] = *(const LAS bf16x8*)(lds + PG8_SB(b, h) + boff + n * 2048 + (F8 ? k * 16 : k * 1024)); } while (0)
#define PG8_F8OP(X) __builtin_bit_cast(v8i_t, __builtin_shufflevector(X[0], X[1], 0, 1, 2, 3, 4, 5, 6, 7, 8, 9, 10, 11, 12, 13, 14, 15))
#define PG8_MMA(ai, bj, At, Bt) do { __builtin_amdgcn_s_setprio(1); \
        if constexpr (F8) { _Pragma("unroll") for (int m = 0; m < 4; ++m) _Pragma("unroll") for (int n = 0; n < 2; ++n) \
            asm volatile("v_mfma_scale_f32_16x16x128_f8f6f4 %0, %1, %2, %0, %3, %4 op_sel_hi:[0,0,0]" : "+v"(acc[ai][bj][m][n]) : "v"(PG8_F8OP(Bt[n])), "v"(PG8_F8OP(At[m])), "v"(f8sa), "v"(f8sb)); } \
        else { _Pragma("unroll") for (int m = 0; m < 4; ++m) _Pragma("unroll") for (int n = 0; n < 2; ++n) _Pragma("unroll") for (int k = 0; k < 2; ++k) \
            acc[ai][bj][m][n] = __builtin_amdgcn_mfma_f32_16x16x32_bf16(Bt[n][k], At[m][k], acc[ai][bj][m][n], 0, 0, 0); } \
        __builtin_amdgcn_s_setprio(0); } while (0)
#define PG8_WAIT_V(n) asm volatile("s_waitcnt vmcnt(" #n ")" ::: "memory")
#define PG8_WAIT_L(n) asm volatile("s_waitcnt lgkmcnt(" #n ")" ::: "memory")
#define PG8_BAR __builtin_amdgcn_s_barrier()
#define PG8_SCHED __builtin_amdgcn_sched_barrier(0)
    Unit cur, nxt; int ui = 0;
    if (!S.next(0, cur)) return;
    f32x4 acc[2][2][4][2];
#pragma unroll
    for (int a = 0; a < 2; ++a)
#pragma unroll
        for (int b = 0; b < 2; ++b)
#pragma unroll
            for (int m = 0; m < 4; ++m)
#pragma unroll
                for (int n = 0; n < 2; ++n) acc[a][b][m][n] = (f32x4){0.f, 0.f, 0.f, 0.f};
    bf16x8 At[4][2], B0[2][2], B1[2][2];
    const char* cA = S.pa(cur); const char* cB = S.pb(cur);
    PG8_STAGE(PG8_SB(0, 0), cB, voffB); PG8_STAGE(PG8_SB(0, 1), cB + hstep, voffB); PG8_STAGE(PG8_SA(0, 0), cA, voffA); PG8_STAGE(PG8_SA(0, 1), cA + hstep, voffA);
    if (wr == 1) PG8_BAR;
    PG8_WAIT_V(2); PG8_BAR;
    PG8_STAGE(PG8_SB(1, 0), cB + kstep, voffB); PG8_STAGE(PG8_SA(1, 0), cA + kstep, voffA); PG8_STAGE(PG8_SB(1, 1), cB + hstep + kstep, voffB);
    PG8_WAIT_V(6); PG8_BAR;
    for (;;) {
        const bool has_next = S.next(ui + 1, nxt);
        const char* nA = has_next ? S.pa(nxt) : cA; const char* nB = has_next ? S.pb(nxt) : cB;
        for (int t = 0; t < nt; t += 2) {
            const bool last = (t == nt - 2);
            const char* a1 = cA + (size_t)(t + 1) * kstep;
            const char* a2 = last ? nA : cA + (size_t)(t + 2) * kstep; const char* b2 = last ? nB : cB + (size_t)(t + 2) * kstep;
            const char* a3 = a2 + kstep; const char* b3 = b2 + kstep;
            PG8_LDB(B0, 0, 0); PG8_LDB(B1, 0, 1); PG8_SCHED; PG8_LDA(At, 0, 0); PG8_STAGE(PG8_SA(1, 1), a1 + hstep, voffA);
            PG8_WAIT_V(8); PG8_WAIT_L(0); PG8_BAR; PG8_MMA(0, 0, At, B0); PG8_MMA(0, 1, At, B1); PG8_BAR; PG8_SCHED;
            PG8_LDA(At, 0, 1); PG8_STAGE(PG8_SB(0, 0), b2, voffB); PG8_STAGE(PG8_SB(0, 1), b2 + hstep, voffB); PG8_STAGE(PG8_SA(0, 0), a2, voffA);
            PG8_WAIT_V(8); PG8_WAIT_L(0); PG8_BAR; PG8_MMA(1, 0, At, B0); PG8_MMA(1, 1, At, B1); PG8_BAR; PG8_SCHED;
            PG8_LDB(B0, 1, 0); PG8_LDB(B1, 1, 1); PG8_SCHED; PG8_LDA(At, 1, 0); PG8_STAGE(PG8_SA(0, 1), a2 + hstep, voffA);
            PG8_WAIT_V(8); PG8_WAIT_L(0); PG8_BAR; PG8_MMA(0, 0, At, B0); PG8_MMA(0, 1, At, B1); PG8_BAR; PG8_SCHED;
            PG8_LDA(At, 1, 1); PG8_STAGE(PG8_SB(1, 0), b3, voffB); PG8_STAGE(PG8_SB(1, 1), b3 + hstep, voffB); PG8_STAGE(PG8_SA(1, 0), a3, voffA);
            PG8_WAIT_V(8); PG8_WAIT_L(0); PG8_BAR; PG8_MMA(1, 0, At, B0); PG8_MMA(1, 1, At, B1); PG8_BAR; PG8_SCHED;
        }
        if (wr == 0) PG8_BAR;
        if constexpr (F8) asm volatile("s_nop 15\n\ts_nop 7" ::: "memory");
        if constexpr (Epi::HAS_PRE) {
            E.pre(cur, (LAS float*)(lds + STAGE_BYTES + 1024), tid); PG8_WAIT_L(0); PG8_BAR; }
        E(acc, cur, wr, wc, fr, fq, (const LAS float*)(lds + STAGE_BYTES + 1024));
        if (!has_next) break;
#pragma unroll
        for (int a = 0; a < 2; ++a)
#pragma unroll
            for (int b = 0; b < 2; ++b)
#pragma unroll
                for (int m = 0; m < 4; ++m)
#pragma unroll
                    for (int n = 0; n < 2; ++n) acc[a][b][m][n] = (f32x4){0.f, 0.f, 0.f, 0.f};
        cur = nxt; cA = nA; cB = nB; ++ui;
        if (wr == 1) PG8_BAR;
    }
    PG8_WAIT_V(0);
    PG8_BAR;
#undef PG8_SA
#undef PG8_SB
#undef PG8_STAGE
#undef PG8_LDA
#undef PG8_LDB
#undef PG8_MMA
#undef PG8_F8OP
#undef PG8_WAIT_V
#undef PG8_WAIT_L
#undef PG8_BAR
#undef PG8_SCHED
}
}
typedef GAS unsigned gu32;
#define RLX_AGENT __ATOMIC_RELAXED, __HIP_MEMORY_SCOPE_AGENT
#define XB_TMO      128
#define XB_XCNT(j)  (256  + 64 * (j))
#define XB_XSUB(j)  (1280 + 64 * (j))
#define XB_XGEN(j)  (2304 + 64 * (j))
#define XB_TOP      3328
#define XB_TOPGEN   3392
#define XCD_BAR_WORDS 3456
#define XB_SPIN_CAP (1u << 18)
__device__ __forceinline__ unsigned xb_ld(unsigned* p)              { return __hip_atomic_load(p, __ATOMIC_RELAXED, __HIP_MEMORY_SCOPE_AGENT); }
__device__ __forceinline__ unsigned xb_add(unsigned* p, unsigned v) { return __hip_atomic_fetch_add(p, v, __ATOMIC_RELAXED, __HIP_MEMORY_SCOPE_AGENT); }
__device__ __forceinline__ unsigned xb_xcc_id() { return (unsigned)__builtin_amdgcn_s_getreg((3 << 11) | 20) & 0xFu; }
#define XB_SPIN(cond, bar) do { unsigned _sp = 0; while (cond) { __builtin_amdgcn_s_sleep(1); \
    if ((++_sp & 255u) == 0u) { if (xb_ld(&(bar)[XB_TMO])) break; if (_sp > XB_SPIN_CAP) { atomicAdd(&(bar)[XB_TMO], 1u); break; } } } } while (0)
struct XcdBarrier { unsigned* bar; unsigned x; volatile LAS unsigned* st; };
__device__ __forceinline__ XcdBarrier xcd_barrier_post(unsigned* bar, volatile LAS unsigned* st) {
    XcdBarrier b; b.bar = bar; b.x = xb_xcc_id(); b.st = st;
    if (threadIdx.x == 0) (void)xb_add(&bar[XB_XCNT(b.x)], 1u);
    return b;
}
__device__ __forceinline__ void xcd_barrier_complete(unsigned* bar, unsigned x, unsigned& nloc, unsigned& nx) {
    const unsigned G = gridDim.x * gridDim.y * gridDim.z;
    unsigned sum, cnt, mine, sp = 0u;
    for (;;) {
        sum = 0u; cnt = 0u; mine = 0u;
#pragma unroll
        for (unsigned j = 0; j < 16; ++j) { const unsigned c = xb_ld(&bar[XB_XCNT(j)]); sum += c; cnt += (c > 0u) ? 1u : 0u; mine = (j == x) ? c : mine; }
        if (sum == G) break;
        __builtin_amdgcn_s_sleep(1);
        if ((++sp & 255u) == 0u) { if (xb_ld(&bar[XB_TMO])) break; if (sp > XB_SPIN_CAP) { atomicAdd(&bar[XB_TMO], 1u); break; } }
    }
    nloc = mine > 0u ? mine : 1u; nx = cnt > 0u ? cnt : 1u;
}
__device__ __forceinline__ void xcd_barrier(const XcdBarrier& b) {
    asm volatile("s_waitcnt vmcnt(0)" ::: "memory");
    __syncthreads();
    if (threadIdx.x == 0) {
        unsigned* bar = b.bar;
        __builtin_amdgcn_s_waitcnt(0);
        unsigned nloc = b.st[0], nx = b.st[1];
        if (nloc == 0u) { xcd_barrier_complete(bar, b.x, nloc, nx); b.st[0] = nloc; b.st[1] = nx; }
        const unsigned old = xb_add(&bar[XB_XSUB(b.x)], 1u);
        const unsigned gen = old / nloc;
        if (old + 1u == (gen + 1u) * nloc) {
            __builtin_amdgcn_fence(__ATOMIC_RELEASE, "agent");
            asm volatile("s_waitcnt vmcnt(0)" ::: "memory");
            const unsigned og = xb_add(&bar[XB_TOP], 1u);
            const unsigned tg = og / nx;
            if (og + 1u == (tg + 1u) * nx) xb_add(&bar[XB_TOPGEN], 1u);
            else XB_SPIN(xb_ld(&bar[XB_TOPGEN]) == tg, bar);
            __builtin_amdgcn_fence(__ATOMIC_ACQUIRE, "agent");
            xb_add(&bar[XB_XGEN(b.x)], 1u);
            asm volatile("s_waitcnt vmcnt(0)" ::: "memory");
        } else {
            XB_SPIN(xb_ld(&bar[XB_XGEN(b.x)]) == gen, bar);
            __builtin_amdgcn_fence(__ATOMIC_ACQUIRE, "agent");
            asm volatile("s_waitcnt vmcnt(0)" ::: "memory");
        }
    }
    __syncthreads();
}
struct Frame {
    LAS unsigned char* lds;
    volatile LAS unsigned* MISC;
    unsigned char* ws;
    int tid, lane, wave;
    int vcu, G;
    const float* in[19];
    float* out;
};
#define WSP(T, off) ((T*)(F.ws + (off)))

typedef float cv16f_t __attribute__((ext_vector_type(16)));
typedef unsigned cv6u_t __attribute__((ext_vector_type(6)));
struct Conv { const float* pu; const float* pv; unsigned char* u8; unsigned char* v8; LAS unsigned char* lbuf; int next, stride, end, pend; };
__device__ __forceinline__ void conv_issue(const Conv& c, int item, int lane) {
    const float* src = ((item >> 14) ? c.pv : c.pu) + (size_t)(item & 16383) * 2048 + 4 * lane;
#pragma unroll
    for (int q = 0; q < 8; ++q) __builtin_amdgcn_global_load_lds((const unsigned*)(src + 256 * q), (LAS unsigned*)(c.lbuf + q * 1024), 16, 0, 0);
}
__device__ __forceinline__ void conv_finish(const Conv& c, int item, int lane) {
    const int isv = item >> 14, row = item & 16383; const float sc = isv ? 4.f : 64.f; cv16f_t a, b;
#pragma unroll
    for (int q = 0; q < 8; ++q) { const f32x4 x = *(const LAS f32x4*)(c.lbuf + q * 1024 + lane * 16);
#pragma unroll
        for (int e = 0; e < 4; ++e) { const int k_ = 4 * q + e;
            if (k_ & 1) b[k_ >> 1] = x[e] * sc; else a[k_ >> 1] = x[e] * sc; } }
    const cv6u_t w = __builtin_amdgcn_cvt_scalef32_2xpk16_fp6_f32(a, b, 1.0f);
    unsigned char* rec = (isv ? c.v8 : c.u8) + (size_t)row * 1536;
    *(GAS u32x4*)(rec + lane * 16) = (u32x4){w[0], w[1], w[2], w[3]}; *(GAS u32x2*)(rec + 1024 + lane * 8) = (u32x2){w[4], w[5]};
}
template <int YOUNGER>
__device__ __forceinline__ void conv_step(Conv& c, int lane) {
    if (c.pend >= 0) { if constexpr (YOUNGER == 0) asm volatile("s_waitcnt vmcnt(0)" ::: "memory"); else if constexpr (YOUNGER == 6) asm volatile("s_waitcnt vmcnt(6)" ::: "memory"); else { static_assert(YOUNGER == 14, "wait count"); asm volatile("s_waitcnt vmcnt(14)" ::: "memory"); }
        conv_finish(c, c.pend, lane); c.pend = -1; asm volatile("s_waitcnt lgkmcnt(0)" ::: "memory"); }
    if (c.next < c.end) { conv_issue(c, c.next, lane); c.pend = c.next; c.next += c.stride; }
}
__device__ __forceinline__ void p0_transpose_item(const float* W, int K, int N, int k0, int n0, bf16_t* WT, int drow, bool rope, const float* gain, LAS float* scr, int lane) {
    { f32x4 v[8]; float gk[8];
#pragma unroll
      for (int i = 0; i < 8; ++i) { const int kk = 8 * i + (lane >> 3); v[i] = *(const GAS f32x4*)(W + (size_t)(k0 + kk) * N + n0 + 4 * (lane & 7)); gk[i] = gain ? gain[k0 + kk] : 1.f; }
#pragma unroll
      for (int i = 0; i < 8; ++i) { const int kk = 8 * i + (lane >> 3); LAS float* d = scr + kk * 33 + 4 * (lane & 7);
#pragma unroll
          for (int e = 0; e < 4; ++e) d[e] = v[i][e] * gk[i]; } }
    LDS_WAIT(); asm volatile("" ::: "memory");
    const int c = lane & 7;
#pragma unroll
    for (int j = 0; j < 4; ++j) { const int n = (lane >> 3) + 8 * j; const LAS float* s = scr + (8 * c) * 33 + n;
        u32x4 o; o.x = cvt_pk_bf16(s[0 * 33], s[1 * 33]); o.y = cvt_pk_bf16(s[2 * 33], s[3 * 33]); o.z = cvt_pk_bf16(s[4 * 33], s[5 * 33]); o.w = cvt_pk_bf16(s[6 * 33], s[7 * 33]);
        const int dr = drow + (rope ? (8 * (n >> 2) + (n & 3)) : n);
        *(GAS u32x4*)(WT + (size_t)dr * K + k0 + 8 * c) = o; }
    LDS_WAIT(); asm volatile("" ::: "memory");
}
__device__ __forceinline__ void p0_transpose_item8(const float* W, int K, int N, int k0, int n0, unsigned char* WT, int drow, bool rope, float scale, LAS float* scr, int lane, const float* gain = nullptr) {
    { f32x4 v[8]; float gk[8];
#pragma unroll
      for (int i = 0; i < 8; ++i) { const int kk = 8 * i + (lane >> 3); v[i] = *(const GAS f32x4*)(W + (size_t)(k0 + kk) * N + n0 + 4 * (lane & 7)); gk[i] = gain ? gain[k0 + kk] * scale : scale; }
#pragma unroll
      for (int i = 0; i < 8; ++i) { const int kk = 8 * i + (lane >> 3); LAS float* d = scr + kk * 33 + 4 * (lane & 7);
#pragma unroll
          for (int e = 0; e < 4; ++e) d[e] = v[i][e] * gk[i]; } }
    LDS_WAIT(); asm volatile("" ::: "memory");
#pragma unroll
    for (int j = 0; j < 2; ++j) { const int q = lane + 64 * j, n = q >> 2, c = q & 3; const LAS float* s = scr + (16 * c) * 33 + n; u32x4 o;
#pragma unroll
        for (int d = 0; d < 4; ++d) { int w = 0; w = __builtin_amdgcn_cvt_pk_fp8_f32(s[(4 * d) * 33], s[(4 * d + 1) * 33], w, false); w = __builtin_amdgcn_cvt_pk_fp8_f32(s[(4 * d + 2) * 33], s[(4 * d + 3) * 33], w, true); o[d] = (unsigned)w; }
        const int dr = drow + (rope ? (8 * (n >> 2) + (n & 3)) : n);
        *(GAS u32x4*)(WT + (size_t)dr * K + k0 + 16 * c) = o; }
    LDS_WAIT(); asm volatile("" ::: "memory");
}
__device__ __forceinline__ void rms_row_to_fp8(const float* xrow, const float* g, unsigned char* orow, int lane) {
    const GAS f32x4* xr = (const GAS f32x4*)xrow + lane; const GAS f32x4* gr = (const GAS f32x4*)g + lane;
    f32x4 v[8]; float s = 0.f;
#pragma unroll
    for (int j = 0; j < 8; ++j) { v[j] = xr[64 * j]; s += (v[j].x * v[j].x + v[j].y * v[j].y) + (v[j].z * v[j].z + v[j].w * v[j].w); }
    const float rstd = 1.0f / sqrtf(wave_sum(s) * (1.f / DM) + NORM_EPS);
    GAS unsigned* o4 = (GAS unsigned*)orow + lane;
#pragma unroll
    for (int j = 0; j < 8; ++j) { const f32x4 y = (v[j] * rstd) * gr[64 * j]; int w = 0; w = __builtin_amdgcn_cvt_pk_fp8_f32(y[0], y[1], w, false); w = __builtin_amdgcn_cvt_pk_fp8_f32(y[2], y[3], w, true); o4[64 * j] = (unsigned)w; }
}
__device__ __forceinline__ void rms_row_to_bf16(const float* xrow, const float* g, bf16_t* orow, int lane) {
    const GAS f32x4* xr = (const GAS f32x4*)xrow + lane; const GAS f32x4* gr = (const GAS f32x4*)g + lane;
    f32x4 v[8]; float s = 0.f;
#pragma unroll
    for (int j = 0; j < 8; ++j) { v[j] = xr[64 * j]; s += (v[j].x * v[j].x + v[j].y * v[j].y) + (v[j].z * v[j].z + v[j].w * v[j].w); }
    const float rstd = 1.0f / sqrtf(wave_sum(s) * (1.f / DM) + NORM_EPS);
    GAS u32x2* o8 = (GAS u32x2*)orow + lane;
#pragma unroll
    for (int j = 0; j < 8; ++j) { const f32x4 gg = gr[64 * j]; o8[64 * j] = pack4((v[j] * rstd) * gg); }
}
template <int PART>
__device__ __forceinline__ void p0_prologue(Frame& F, int rank, int nrank) {
    LAS float* scr = (LAS float*)(F.lds + F.wave * 16384);
    const int gw = rank * NWAVES + F.wave, NGW = nrank * NWAVES, lane = F.lane; const int gt = rank * 512 + F.tid, NGT = nrank * 512;
    unsigned char* WIN = WSP(unsigned char, WS_WIN); unsigned char* WVT = WSP(unsigned char, WS_WVT);
    constexpr int I_IN = 32 * 258, I_UQ = 8 * 96, I_UKV = 8 * 128, I_NA = 16 * 64, I_MLA = 32 * 64, I_OUT = 32 * 64;
    constexpr int NEARLY = I_IN + I_UQ + I_UKV, NITEMS = NEARLY + I_NA + I_MLA + I_OUT;
    for (int it = (PART == 0 ? 0 : NEARLY) + gw; it < (PART == 0 ? NEARLY : NITEMS); it += NGW) {
        int r = it;
        if (r < I_IN) { const int kb = r / 258, sb = r % 258, n0 = 32 * sb, k0 = 64 * kb; const float* W = F.in[3];
            unsigned char* dst = WIN; int drow; bool rope = false;
            if (n0 < 1024) drow = C_NAQ + n0;
            else if (n0 < 2048) drow = C_NAK + (n0 - 1024);
            else if (n0 < 3072) { dst = WVT; drow = n0 - 2048; }
            else if (n0 < 3584) drow = C_CQ + (n0 - 3072);
            else if (n0 < 4096) drow = C_CKV + (n0 - 3584);
            else if (n0 < 4160) { drow = C_KR + ((n0 - 4096) ? 4 : 0); rope = true; }
            else if (n0 < 6208) drow = C_GA + (n0 - 4160);
            else drow = C_GB + (n0 - 6208);
            p0_transpose_item8(W, 2048, 8256, k0, n0, dst, drow, rope, 64.f, scr, lane); continue; } r -= I_IN;
        if (r < I_UQ) { const int kb = r / 96, sb = r % 96, n0 = 32 * sb, k0 = 64 * kb; const int hd = n0 / 192, w = n0 % 192;
            int drow = n0; bool rope = false; if (w >= 128) { rope = true; drow = hd * 192 + 128 + ((w - 128) ? 4 : 0); }
            p0_transpose_item8(F.in[7], 512, 3072, k0, n0, WSP(unsigned char, WS_WUQ), drow, rope, 16.f, scr, lane, F.in[6]); continue; } r -= I_UQ;
        if (r < I_UKV) { const int kb = r / 128, sb = r % 128; p0_transpose_item8(F.in[9], 512, 4096, 64 * kb, 32 * sb, WSP(unsigned char, WS_WUKV), 32 * sb, false, 16.f, scr, lane, F.in[8]); continue; } r -= I_UKV;
        if (r < I_NA) { const int kb = r / 64, sb = r % 64; p0_transpose_item8(F.in[10], 1024, 2048, 64 * kb, 32 * sb, WSP(unsigned char, WS_WNA), 32 * sb, false, 32.f, scr, lane); continue; } r -= I_NA;
        if (r < I_MLA) { const int kb = r / 64, sb = r % 64; p0_transpose_item8(F.in[11], 2048, 2048, 64 * kb, 32 * sb, WSP(unsigned char, WS_WMLA), 32 * sb, false, 64.f, scr, lane); continue; } r -= I_MLA;
        { const int kb = r / 64, sb = r % 64; p0_transpose_item8(F.in[12], 2048, 2048, 64 * kb, 32 * sb, WSP(unsigned char, WS_WOUT), 32 * sb, false, 64.f, scr, lane); }
    }
    if (PART == 0) { GAS u32x4* z = (GAS u32x4*)(WIN + (size_t)(C_KR + 64) * 2048); const int n16 = (NMAIN - C_KR - 64) * 2048 / 16;
      for (int i = gt; i < n16; i += NGT) z[i] = (u32x4){0u, 0u, 0u, 0u}; }
    if (PART == 0) { unsigned char* HN1 = WSP(unsigned char, WS_HN1);
#define P0_ROWSRC(m_) (((m_) < MREAL) ? F.in[0] + (size_t)(m_) * DM : F.in[1] + (size_t)((m_) - MREAL) * DM)
      { f32x4 v[8]; int m = gw;
        if (m < MREAL + NMETA) { const GAS f32x4* xr = (const GAS f32x4*)P0_ROWSRC(m) + lane;
#pragma unroll
            for (int j = 0; j < 8; ++j) v[j] = xr[64 * j]; }
        const GAS f32x4* gr = (const GAS f32x4*)F.in[2] + lane;
        while (m < MREAL + NMETA) { const int mn = m + NGW; f32x4 vn[8];
            { const int ml = mn < MREAL + NMETA ? mn : m; const GAS f32x4* xr = (const GAS f32x4*)P0_ROWSRC(ml) + lane;
#pragma unroll
              for (int j = 0; j < 8; ++j) vn[j] = xr[64 * j]; }
            float sq = 0.f;
#pragma unroll
            for (int j = 0; j < 8; ++j) sq += (v[j].x * v[j].x + v[j].y * v[j].y) + (v[j].z * v[j].z + v[j].w * v[j].w);
            const float rstd = 1.0f / sqrtf(wave_sum(sq) * (1.f / DM) + NORM_EPS);
            GAS unsigned* o4 = (GAS unsigned*)(HN1 + (size_t)m * DM) + lane;
#pragma unroll
            for (int j = 0; j < 8; ++j) { const f32x4 y = (v[j] * rstd) * gr[64 * j]; int w = 0; w = __builtin_amdgcn_cvt_pk_fp8_f32(y[0], y[1], w, false); w = __builtin_amdgcn_cvt_pk_fp8_f32(y[2], y[3], w, true); o4[64 * j] = (unsigned)w; }
#pragma unroll
            for (int j = 0; j < 8; ++j) v[j] = vn[j];
            m = mn; } }
#undef P0_ROWSRC
      GAS u32x4* z = (GAS u32x4*)(HN1 + (size_t)(MREAL + NMETA) * DM); const int n16 = (MPAD - MREAL - NMETA) * DM / 16;
      for (int i = gt; i < n16; i += NGT) z[i] = (u32x4){0u, 0u, 0u, 0u}; }
    if (PART == 0) { float* ct = WSP(float, WS_COS); float* st = WSP(float, WS_SIN);
      for (int i = gt; i < NPOS * 32; i += NGT) { const int p = i >> 5, j = i & 31;
          const float inv = __builtin_powf(10000.0f, -(float)(2 * j) / 64.0f); const float ang = (float)p * inv;
          double r = (double)ang * 0.15915494309189535; r -= __builtin_rint(r); const float rf = (float)r;
          ct[i] = __builtin_amdgcn_cosf(rf); st[i] = __builtin_amdgcn_sinf(rf); } }
    if (PART == 1) { const float* SK = F.in[15]; const float* WQ = F.in[14]; const float* g2 = F.in[13]; bf16_t* WSCp = WSP(bf16_t, WS_WSC);
      const int l15 = lane & 15, l4 = lane >> 4;
      for (int task = gw; task < 2048; task += NGW) { const int g = task >> 7, nt = (task >> 4) & 7, kc = task & 15, n0 = nt * 16;
          bf16x8 bfr[4];
#pragma unroll
          for (int kk = 0; kk < 4; ++kk) { const float* p = SK + ((size_t)g * 128 + n0 + l15) * 128 + 32 * kk + 8 * l4; const f32x4 a = *(const GAS f32x4*)p, b = *(const GAS f32x4*)(p + 4);
              const u32x4 w = pack8(a, b); bfr[kk] = __builtin_bit_cast(bf16x8, w); }
          for (int kt = 0; kt < 8; ++kt) { const int k0 = (kc * 8 + kt) * 16; f32x4 acc = (f32x4){0.f, 0.f, 0.f, 0.f};
#pragma unroll
              for (int kk = 0; kk < 4; ++kk) { const float* p = WQ + (size_t)(k0 + l15) * 2048 + g * 128 + 32 * kk + 8 * l4; const f32x4 a = *(const GAS f32x4*)p, b = *(const GAS f32x4*)(p + 4);
                  const u32x4 w = pack8(a, b); acc = __builtin_amdgcn_mfma_f32_16x16x32_bf16(__builtin_bit_cast(bf16x8, w), bfr[kk], acc, 0, 0, 0); }
              const f32x4 gg = *(const GAS f32x4*)(g2 + k0 + 4 * l4);
              *(GAS u32x2*)(WSCp + (size_t)(g * 128 + n0 + l15) * 2048 + k0 + 4 * l4) = pack4(acc * gg); } } }
}
using pg8::Unit;
struct SchedGrid {
    int G, c, nM, nN; const char* A; const char* B; size_t tstep;
    __device__ __forceinline__ bool next(int i, Unit& u) const { const int L = i * G + c; if (L >= nM * nN) return false; pg8::grid_order(L, nM, nN, u.pm, u.pn); u.kind = 0; return true; }
    __device__ __forceinline__ const char* pa(const Unit& u) const { return A + (size_t)u.pm * tstep; }
    __device__ __forceinline__ const char* pb(const Unit& u) const { return B + (size_t)u.pn * tstep; }
};
constexpr int P1_MAIN = 64 * 29, P1_VT = 4 * 65, P1_META = 7, P1_UNITS = P1_MAIN + P1_VT + P1_META;
struct SchedP1 {
    int G, c; const char* hn1; const char* win; const char* wvt; size_t tstep;
    __device__ __forceinline__ bool next(int i, Unit& u) const {
        const int L = i * G + c; if (L >= P1_UNITS) return false;
        if (L < P1_MAIN) { pg8::grid_order(L, 64, 29, u.pm, u.pn); u.kind = 0; }
        else if (L < P1_MAIN + P1_VT) { const int idx = L - P1_MAIN; u.pm = idx & 3; u.pn = idx >> 2; u.kind = 1; }
        else { const int idx = L - P1_MAIN - P1_VT; u.pm = 64; u.pn = idx < 4 ? 4 + idx : (idx < 6 ? 10 + (idx - 4) : 28); u.kind = 0; }
        return true; }
    __device__ __forceinline__ const char* pa(const Unit& u) const { return (u.kind == 1 ? wvt : hn1) + (size_t)u.pm * tstep; }
    __device__ __forceinline__ const char* pb(const Unit& u) const { return (u.kind == 1 ? hn1 : win) + (size_t)u.pn * tstep; }
};
__device__ __forceinline__ void rope4(const f32x4 x1, const f32x4 x2, const float* cosT, const float* sinT, int pos, int j0, f32x4& lo, f32x4& hi) {
    const f32x4 c = *(const GAS f32x4*)(cosT + pos * 32 + j0), s = *(const GAS f32x4*)(sinT + pos * 32 + j0);
    lo = x1 * c - x2 * s; hi = x2 * c + x1 * s;
}
struct EpiP1 {
    static constexpr bool PERM = true, HAS_PRE = false;
    bf16_t *naq, *nak, *vt; unsigned char *cq, *ckv; bf16_t *kr; unsigned char *ga, *gb; float *ssq_q, *ssq_kv; const float *cosT, *sinT;
    __device__ __forceinline__ void operator()(const f32x4 (&acc)[2][2][4][2], const Unit& u, int wr, int wc, int fr, int fq, const LAS float* rowsc) const {
        const int row0 = u.pm * 256 + wr * 64 + fr, colu = wc * 32 + 8 * fq;
        if (u.kind == 1) {
#pragma unroll
            for (int ai = 0; ai < 2; ++ai)
#pragma unroll
                for (int m = 0; m < 4; ++m) { bf16_t* rp = vt + (size_t)(row0 + ai * 128 + m * 16) * VT_PITCH + u.pn * 256 + colu;
#pragma unroll
                    for (int bj = 0; bj < 2; ++bj) *(GAS u32x4*)(rp + bj * 128) = pack8(acc[ai][bj][m][0], acc[ai][bj][m][1]); }
            return; }
        const int pn = u.pn;
        if (pn == 28) {
            if (wc < 2) { const int j0 = 4 * (4 * wc + fq);
#pragma unroll
                for (int ai = 0; ai < 2; ++ai)
#pragma unroll
                    for (int m = 0; m < 4; ++m) { const int row = row0 + ai * 128 + m * 16; const int pos = row < MREAL ? NMETA + (row & (SEQ - 1)) : row - MREAL;
                        f32x4 lo, hi; rope4(acc[ai][0][m][0], acc[ai][0][m][1], cosT, sinT, pos, j0, lo, hi);
                        *(GAS u32x2*)(kr + (size_t)row * 64 + j0) = pack4(lo); *(GAS u32x2*)(kr + (size_t)row * 64 + 32 + j0) = pack4(hi); } }
            return; }
        if (pn >= 12) {
            unsigned char* base = pn < 20 ? ga : gb; const int colt = (pn < 20 ? pn - 12 : pn - 20) * 256 + colu;
#pragma unroll
            for (int ai = 0; ai < 2; ++ai)
#pragma unroll
                for (int m = 0; m < 4; ++m) { unsigned char* rp = base + (size_t)(row0 + ai * 128 + m * 16) * 2048 + colt;
#pragma unroll
                    for (int bj = 0; bj < 2; ++bj) { f32x4 a = acc[ai][bj][m][0], b = acc[ai][bj][m][1];
#pragma unroll
                        for (int i = 0; i < 4; ++i) { a[i] = sigmoidf_(a[i]); b[i] = sigmoidf_(b[i]); }
                        *(GAS u32x2*)(rp + bj * 128) = pack8_u8(a, b); } }
            return; }
        if (pn >= 8) {
            const bool isq = pn < 10; unsigned char* base = isq ? cq : ckv; float* ssq = isq ? ssq_q : ssq_kv; const int colt = (isq ? pn - 8 : pn - 10) * 256 + colu;
#pragma unroll
            for (int ai = 0; ai < 2; ++ai)
#pragma unroll
                for (int m = 0; m < 4; ++m) { const int row = row0 + ai * 128 + m * 16; unsigned char* rp = base + (size_t)row * 512 + colt; float s = 0.f;
#pragma unroll
                    for (int bj = 0; bj < 2; ++bj) { const f32x4 a = acc[ai][bj][m][0], b = acc[ai][bj][m][1];
                        s += (a[0] * a[0] + a[1] * a[1]) + (a[2] * a[2] + a[3] * a[3]) + (b[0] * b[0] + b[1] * b[1]) + (b[2] * b[2] + b[3] * b[3]);
                        *(GAS u32x2*)(rp + bj * 128) = pack8_fp8(a, b); }
                    s += __shfl_xor(s, 16); s += __shfl_xor(s, 32);
                    if (fq == 0) ssq[(size_t)((pn & 1) * 4 + wc) * MPAD + row] = s; }
            return; }
        {
            bf16_t* base = pn < 4 ? naq : nak; const int colt = (pn & 3) * 256 + colu;
#pragma unroll
            for (int ai = 0; ai < 2; ++ai)
#pragma unroll
                for (int m = 0; m < 4; ++m) { bf16_t* rp = base + (size_t)(row0 + ai * 128 + m * 16) * 1024 + colt;
#pragma unroll
                    for (int bj = 0; bj < 2; ++bj) *(GAS u32x4*)(rp + bj * 128) = pack8(acc[ai][bj][m][0], acc[ai][bj][m][1]); }
        }
    }
};
constexpr int P3_Q = 64 * 12, P3_KV = 65 * 16, P3_UNITS = P3_Q + P3_KV;
struct SchedP3 {
    int G, c; const char* cq; const char* ckv; const char* wuq; const char* wukv; size_t tstep;
    __device__ __forceinline__ bool next(int i, Unit& u) const {
        const int L = i * G + c; if (L >= P3_UNITS) return false;
        if (L < P3_Q) { pg8::grid_order(L, 64, 12, u.pm, u.pn); u.kind = 0; } else { pg8::grid_order(L - P3_Q, 65, 16, u.pm, u.pn); u.kind = 1; }
        return true; }
    __device__ __forceinline__ const char* pa(const Unit& u) const { return (u.kind ? ckv : cq) + (size_t)u.pm * tstep; }
    __device__ __forceinline__ const char* pb(const Unit& u) const { return (u.kind ? wukv : wuq) + (size_t)u.pn * tstep; }
};
template <int NS, int LD> __device__ __forceinline__ float rstd_slabs(const float* part, int row, float invn) {
    float s = 0.f;
#pragma unroll
    for (int i = 0; i < NS; ++i) s += part[(size_t)i * LD + row];
    return 1.0f / sqrtf(s * invn + NORM_EPS);
}
struct EpiP3 {
    static constexpr bool PERM = true, HAS_PRE = true;
    bf16_t *qm, *kn, *vv; const float *ssq_q, *ssq_kv; const float *cosT, *sinT;
    __device__ __forceinline__ void pre(const Unit& u, LAS float* sc, int tid) const { if (tid < 256) { const int row = u.pm * 256 + tid; sc[tid] = u.kind ? rstd_slabs<8, MPAD>(ssq_kv, row, 1.f / 512.f) : rstd_slabs<8, MPAD>(ssq_q, row, 1.f / 512.f); } }
    __device__ __forceinline__ void operator()(const f32x4 (&acc)[2][2][4][2], const Unit& u, int wr, int wc, int fr, int fq, const LAS float* rowsc) const {
        const int row0 = u.pm * 256 + wr * 64 + fr, colu = wc * 32 + 8 * fq;
        if (u.kind == 1) {
#pragma unroll
            for (int ai = 0; ai < 2; ++ai)
#pragma unroll
                for (int m = 0; m < 4; ++m) { const int row = row0 + ai * 128 + m * 16; const float rs = rowsc[ai * 128 + wr * 64 + m * 16 + fr];
                    const size_t off = (size_t)row * 2048 + u.pn * 128 + colu;
                    *(GAS u32x4*)(kn + off) = pack8(acc[ai][0][m][0] * rs, acc[ai][0][m][1] * rs);
                    *(GAS u32x4*)(vv + off) = pack8(acc[ai][1][m][0] * rs, acc[ai][1][m][1] * rs); }
            return; }
#pragma unroll
        for (int bj = 0; bj < 2; ++bj) { const int c8 = u.pn * 256 + bj * 128 + colu; const int hd = c8 / 192, w = c8 - hd * 192;
            if (w < 128) {
#pragma unroll
                for (int ai = 0; ai < 2; ++ai)
#pragma unroll
                    for (int m = 0; m < 4; ++m) { const int row = row0 + ai * 128 + m * 16; const float rs = rowsc[ai * 128 + wr * 64 + m * 16 + fr];
                        *(GAS u32x4*)(qm + (size_t)row * 3072 + c8) = pack8(acc[ai][bj][m][0] * rs, acc[ai][bj][m][1] * rs); }
            } else { const int j0 = (w - 128) >> 1;
#pragma unroll
                for (int ai = 0; ai < 2; ++ai)
#pragma unroll
                    for (int m = 0; m < 4; ++m) { const int row = row0 + ai * 128 + m * 16; const float rs = rowsc[ai * 128 + wr * 64 + m * 16 + fr];
                        const int pos = NMETA + (row & (SEQ - 1)); f32x4 lo, hi; rope4(acc[ai][bj][m][0] * rs, acc[ai][bj][m][1] * rs, cosT, sinT, pos, j0, lo, hi);
                        bf16_t* qp = qm + (size_t)row * 3072 + hd * 192 + 128 + j0; *(GAS u32x2*)qp = pack4(lo); *(GAS u32x2*)(qp + 32) = pack4(hi); }
            } }
    }
};
__device__ __forceinline__ void unpack8(const u32x4 w, f32x4& a, f32x4& b) { a = (f32x4){bf_lo(w.x), bf_hi(w.x), bf_lo(w.y), bf_hi(w.y)}; b = (f32x4){bf_lo(w.z), bf_hi(w.z), bf_lo(w.w), bf_hi(w.w)}; }
struct EpiP5a {
    static constexpr bool PERM = true, HAS_PRE = false;
    const unsigned char* ga; bf16_t* t1;
    __device__ __forceinline__ void operator()(const f32x4 (&acc)[2][2][4][2], const Unit& u, int wr, int wc, int fr, int fq, const LAS float* rowsc) const {
        const int row0 = u.pm * 256 + wr * 64 + fr, col0 = u.pn * 256 + wc * 32 + 8 * fq;
#pragma unroll
        for (int ai = 0; ai < 2; ++ai)
#pragma unroll
            for (int m = 0; m < 4; ++m) { const size_t off = (size_t)(row0 + ai * 128 + m * 16) * 2048 + col0;
#pragma unroll
                for (int bj = 0; bj < 2; ++bj) { f32x4 g0, g1; unpack8_u8(*(const GAS u32x2*)(ga + off + bj * 128), g0, g1);
                    *(GAS u32x4*)(t1 + off + bj * 128) = pack8(acc[ai][bj][m][0] * g0, acc[ai][bj][m][1] * g1); } }
    }
};
struct EpiP5b {
    static constexpr bool PERM = true, HAS_PRE = false;
    const unsigned char* gb; const bf16_t* t1; unsigned char* merged;
    __device__ __forceinline__ void operator()(const f32x4 (&acc)[2][2][4][2], const Unit& u, int wr, int wc, int fr, int fq, const LAS float* rowsc) const {
        const int row0 = u.pm * 256 + wr * 64 + fr, col0 = u.pn * 256 + wc * 32 + 8 * fq;
#pragma unroll
        for (int ai = 0; ai < 2; ++ai)
#pragma unroll
            for (int m = 0; m < 4; ++m) { const size_t off = (size_t)(row0 + ai * 128 + m * 16) * 2048 + col0;
#pragma unroll
                for (int bj = 0; bj < 2; ++bj) { f32x4 g0, g1; unpack8_u8(*(const GAS u32x2*)(gb + off + bj * 128), g0, g1);
                    f32x4 a, b; unpack8(*(const GAS u32x4*)(t1 + off + bj * 128), a, b);
                    *(GAS u32x2*)(merged + off + bj * 128) = pack8_fp8((a + acc[ai][bj][m][0] * g0) * 32.f, (b + acc[ai][bj][m][1] * g1) * 32.f); } }
    }
};
struct EpiP6 {
    static constexpr bool PERM = true, HAS_PRE = false;
    const float* x; bf16_t* h2b; float* ssq2;
    __device__ __forceinline__ void operator()(const f32x4 (&acc)[2][2][4][2], const Unit& u, int wr, int wc, int fr, int fq, const LAS float* rowsc) const {
        const int row0 = u.pm * 256 + wr * 64 + fr, col0 = u.pn * 256 + wc * 32 + 8 * fq;
#pragma unroll
        for (int ai = 0; ai < 2; ++ai)
#pragma unroll
            for (int m = 0; m < 4; ++m) { const int row = row0 + ai * 128 + m * 16; const size_t off = (size_t)row * 2048 + col0; float s = 0.f;
#pragma unroll
                for (int bj = 0; bj < 2; ++bj) { const f32x4 a = *(const GAS f32x4*)(x + off + bj * 128) + acc[ai][bj][m][0], b = *(const GAS f32x4*)(x + off + bj * 128 + 4) + acc[ai][bj][m][1];
                    s += (a[0] * a[0] + a[1] * a[1]) + (a[2] * a[2] + a[3] * a[3]) + (b[0] * b[0] + b[1] * b[1]) + (b[2] * b[2] + b[3] * b[3]);
                    *(GAS u32x4*)(h2b + off + bj * 128) = pack8(a, b); }
                s += __shfl_xor(s, 16); s += __shfl_xor(s, 32);
                if (fq == 0) ssq2[(size_t)(u.pn * 4 + wc) * MREAL + row] = s; }
    }
};
struct EpiP7 {
    static constexpr bool PERM = true, HAS_PRE = true;
    const float* ssq2; _Float16* sc;
    __device__ __forceinline__ void pre(const Unit& u, LAS float* sc, int tid) const { if (tid < 256) sc[tid] = rstd_slabs<32, MREAL>(ssq2, u.pm * 256 + tid, 1.f / 2048.f); }
    __device__ __forceinline__ void operator()(const f32x4 (&acc)[2][2][4][2], const Unit& u, int wr, int wc, int fr, int fq, const LAS float* rowsc) const {
        typedef _Float16 h4_t __attribute__((ext_vector_type(4)));
        const int row0 = u.pm * 256 + wr * 64 + fr, col0 = u.pn * 256 + wc * 32 + 8 * fq;
#pragma unroll
        for (int ai = 0; ai < 2; ++ai)
#pragma unroll
            for (int m = 0; m < 4; ++m) { const int row = row0 + ai * 128 + m * 16; const float rs = rowsc[ai * 128 + wr * 64 + m * 16 + fr]; const size_t off = (size_t)row * 2048 + col0;
#pragma unroll
                for (int bj = 0; bj < 2; ++bj) { const h4_t lo = __builtin_convertvector(acc[ai][bj][m][0] * rs, h4_t), hi = __builtin_convertvector(acc[ai][bj][m][1] * rs, h4_t);
                    const u32x2 wl = __builtin_bit_cast(u32x2, lo), wh = __builtin_bit_cast(u32x2, hi);
                    *(GAS u32x4*)(sc + off + bj * 128) = (u32x4){wl.x, wl.y, wh.x, wh.y}; } }
    }
};
namespace att {
#define KSWZ(row, colB) ((row) * 256 + ((colB) ^ (((row) & 7) << 4)))
#define KRSWZ(row, colB) ((row) * 128 + ((colB) ^ ((((row) >> 1) & 7) << 4)))
constexpr float L2E = 1.4426950408889634f;
template <int DUMMY = 0>
__device__ __forceinline__ void partialSM(f32x16& p0, f32x16& p1, float& m_reg, float& mn, float& alpha, const float C, const float THRS) {
  float pmax = p0[0];
#pragma unroll
  for (int r = 1; r < 16; ++r) pmax = fmaxf(pmax, p0[r]);
#pragma unroll
  for (int r = 0; r < 16; ++r) pmax = fmaxf(pmax, p1[r]);
  { auto rr = __builtin_amdgcn_permlane32_swap(__float_as_uint(pmax), __float_as_uint(pmax), false, false);
    pmax = fmaxf(__uint_as_float(rr[0]), __uint_as_float(rr[1])); }
  if (__builtin_expect(__all(pmax - m_reg <= THRS), 1)) { mn = m_reg; alpha = 1.f; }
  else { mn = fmaxf(m_reg, pmax); alpha = __builtin_amdgcn_exp2f((m_reg - mn) * C); m_reg = mn; }
  const float mnC = -mn * C;
#pragma unroll
  for (int r = 0; r < 16; ++r) p0[r] = fmaf(p0[r], C, mnC);
#pragma unroll
  for (int r = 0; r < 16; ++r) p1[r] = fmaf(p1[r], C, mnC);
#pragma unroll
  for (int r = 0; r < 16; ++r) p0[r] = __builtin_amdgcn_exp2f(p0[r]);
}
__device__ __forceinline__ void finishSM(f32x16& p0, f32x16& p1, float alpha, float& l_reg, bf16x8& pa0, bf16x8& pa1, bf16x8& pa2, bf16x8& pa3) {
#pragma unroll
  for (int r = 0; r < 16; ++r) p1[r] = __builtin_amdgcn_exp2f(p1[r]);
  float ps = 0;
#pragma unroll
  for (int r = 0; r < 16; ++r) ps += p0[r];
#pragma unroll
  for (int r = 0; r < 16; ++r) ps += p1[r];
  { auto rr = __builtin_amdgcn_permlane32_swap(__float_as_uint(ps), __float_as_uint(ps), false, false);
    ps = __uint_as_float(rr[0]) + __uint_as_float(rr[1]); }
  l_reg = l_reg * alpha + ps;
#define PK4(P, BASE, OUT) do { unsigned a0 = cvt_pk_bf16(P[BASE + 0], P[BASE + 1]), a1 = cvt_pk_bf16(P[BASE + 2], P[BASE + 3]);   \
    unsigned b0 = cvt_pk_bf16(P[BASE + 4], P[BASE + 5]), b1 = cvt_pk_bf16(P[BASE + 6], P[BASE + 7]);                              \
    auto r0 = __builtin_amdgcn_permlane32_swap(a0, b0, false, false); auto r1 = __builtin_amdgcn_permlane32_swap(a1, b1, false, false); \
    u32x4 w = {r0[0], r1[0], r0[1], r1[1]}; OUT = __builtin_bit_cast(bf16x8, w); } while (0)
  PK4(p0, 0, pa0); PK4(p0, 8, pa1); PK4(p1, 0, pa2); PK4(p1, 8, pa3);
#undef PK4
}
constexpr int NW = 8, QBLK = 32, KVBLK = 64;
constexpr float MLA_SCALE = 0.07216878364870322f;
constexpr float MLA_THR = 8.f;
constexpr int SHM_V = KVBLK * 128 * 2, SHM_KN = KVBLK * 128 * 2, SHM_KR = KVBLK * 64 * 2;
constexpr int OFF_V = 0, OFF_KN = 2 * SHM_V, OFF_KR = OFF_KN + 2 * SHM_KN, OFF_WS = OFF_KR + 2 * SHM_KR, OFF_QR = OFF_WS + NW * 64 * 4, MLA_LDS = OFF_QR + NW * 4096;
__device__ __forceinline__ void qkt(f32x16& p0, f32x16& p1, const LAS char* Kn, const LAS char* Kr, const bf16x8* qr, const LAS char* qrp, const int* kb, const int* krb) {
  p0 = f32x16{}; p1 = f32x16{};
#pragma unroll
  for (int d0 = 0; d0 < 8; ++d0) {
    const bf16x8 b0 = *(const LAS bf16x8*)(Kn + kb[d0 & 3] + (d0 >> 2) * 128);
    const bf16x8 b1 = *(const LAS bf16x8*)(Kn + kb[d0 & 3] + (d0 >> 2) * 128 + 8192);
    p0 = __builtin_amdgcn_mfma_f32_32x32x16_bf16(b0, qr[d0], p0, 0, 0, 0);
    p1 = __builtin_amdgcn_mfma_f32_32x32x16_bf16(b1, qr[d0], p1, 0, 0, 0); }
#pragma unroll
  for (int d0 = 0; d0 < 4; ++d0) {
    const bf16x8 b0 = *(const LAS bf16x8*)(Kr + krb[d0]);
    const bf16x8 b1 = *(const LAS bf16x8*)(Kr + krb[d0] + 4096);
    const bf16x8 qf = *(const LAS bf16x8*)(qrp + d0 * 1024);
    p0 = __builtin_amdgcn_mfma_f32_32x32x16_bf16(b0, qf, p0, 0, 0, 0);
    p1 = __builtin_amdgcn_mfma_f32_32x32x16_bf16(b1, qf, p1, 0, 0, 0); }
}
__device__ __forceinline__ int v_st(int k, int c) { const int kk = (k & ~0xC) | ((k & 4) << 1) | ((k & 8) >> 1); return ((kk >> 3) * 4 + (c >> 5)) * 512 + ((kk & 7) * 32 + (c & 31)) * 2; }
__device__ __forceinline__ int v_rd_base(int lane) { return ((lane & 3) << 3) | (((lane >> 2) & 3) << 6) | (((lane >> 4) & 1) << 5) | (((lane >> 5) & 1) << 8); }
constexpr int v_rd_off(int d0, int ks, int half) { return d0 * 512 + ks * 4096 + half * 2048; }
template <int OFF> __device__ __forceinline__ s16x4 tr_read(int vb) {
  s16x4 r; asm volatile("ds_read_b64_tr_b16 %0, %1 offset:%2" : "=&v"(r) : "v"(vb), "i"(OFF) : "memory"); return r;
}
template <int D0> __device__ __forceinline__ void pv_one(f32x16& od, int vb, bf16x8 pa0, bf16x8 pa1, bf16x8 pa2, bf16x8 pa3) {
  const s16x4 l0 = tr_read<v_rd_off(D0, 0, 0)>(vb), h0 = tr_read<v_rd_off(D0, 0, 1)>(vb), l1 = tr_read<v_rd_off(D0, 1, 0)>(vb), h1 = tr_read<v_rd_off(D0, 1, 1)>(vb);
  const s16x4 l2 = tr_read<v_rd_off(D0, 2, 0)>(vb), h2 = tr_read<v_rd_off(D0, 2, 1)>(vb), l3 = tr_read<v_rd_off(D0, 3, 0)>(vb), h3 = tr_read<v_rd_off(D0, 3, 1)>(vb);
  asm volatile("s_waitcnt lgkmcnt(0)" ::: "memory"); SBAR();
#define PK(L, H) (bf16x8){L[0], L[1], L[2], L[3], H[0], H[1], H[2], H[3]}
  od = __builtin_amdgcn_mfma_f32_32x32x16_bf16(pa0, PK(l0, h0), od, 0, 0, 0);
  od = __builtin_amdgcn_mfma_f32_32x32x16_bf16(pa1, PK(l1, h1), od, 0, 0, 0);
  od = __builtin_amdgcn_mfma_f32_32x32x16_bf16(pa2, PK(l2, h2), od, 0, 0, 0);
  od = __builtin_amdgcn_mfma_f32_32x32x16_bf16(pa3, PK(l3, h3), od, 0, 0, 0);
#undef PK
}
__device__ __forceinline__ void pv_d0(f32x16* o, int vb, bf16x8 pa0, bf16x8 pa1, bf16x8 pa2, bf16x8 pa3) {
  pv_one<0>(o[0], vb, pa0, pa1, pa2, pa3); pv_one<1>(o[1], vb, pa0, pa1, pa2, pa3); pv_one<2>(o[2], vb, pa0, pa1, pa2, pa3); pv_one<3>(o[3], vb, pa0, pa1, pa2, pa3);
}
__device__ __forceinline__ void mla_unit(int b, int h, int qb, const bf16_t* __restrict__ QM, const bf16_t* __restrict__ KN, const bf16_t* __restrict__ KR, const bf16_t* __restrict__ VV, unsigned char* __restrict__ OM, LAS char* lds) {
  const int tid = threadIdx.x, wid = tid >> 6, lane = tid & 63, r32 = lane & 31, hi = lane >> 5;
  constexpr float C = MLA_SCALE * L2E, THRS = MLA_THR / MLA_SCALE;
  constexpr int NT = 33;
  LAS char* V_lds = lds + OFF_V; LAS char* Kn_lds = lds + OFF_KN; LAS char* Kr_lds = lds + OFF_KR;
  LAS float* ws = (LAS float*)(lds + OFF_WS) + wid * 64; LAS float* li_l = ws; LAS float* al_l = ws + 32;
  float m_reg = -1e30f, l_reg = 0; f32x16 o[4] = {}; bf16x8 qr[8];
  LAS char* qrp = lds + OFF_QR + wid * 4096 + lane * 16;
  const int qrow = b * SEQ + qb * 256 + wid * QBLK + r32;
  const bf16_t* Qw = QM + (size_t)qrow * 3072 + h * 192 + hi * 8;
#pragma unroll
  for (int d0 = 0; d0 < 8; ++d0) qr[d0] = *(const GAS bf16x8*)(Qw + d0 * 16);
  __syncthreads();
#pragma unroll
  for (int d0 = 0; d0 < 4; ++d0) *(LAS bf16x8*)(qrp + d0 * 1024) = *(const GAS bf16x8*)(Qw + (8 + d0) * 16);
  const int sr = tid >> 4, sc = (tid & 15) * 8, vst0 = v_st(sr, sc), vst1 = v_st(32 + sr, sc);
  const int krr = tid >> 3, krc = (tid & 7) * 8;
  const int vb0 = (int)(uintptr_t)V_lds + v_rd_base(lane);
  bf16x8 s_v0, s_v1, s_k0, s_k1, s_kr;
  const int realbase = b * SEQ - KVBLK;
  const unsigned voff = (unsigned)(sr * 2048 + sc) * 2u, kroff = (unsigned)(krr * 64 + krc) * 2u;
  int kb[4], krb[4];
#pragma unroll
  for (int bq = 0; bq < 4; ++bq) { kb[bq] = KSWZ(r32, bq * 32 + hi * 16); krb[bq] = KRSWZ(r32, bq * 32 + hi * 16); }
#define TROW(t) ((t) == 0 ? MREAL : realbase + (t) * KVBLK)
#define SLOAD(t) do { const int k0_ = TROW(t); const size_t ro_ = ((size_t)k0_ * 2048 + h * 128) * 2; \
    const GAS char* vb_ = (const GAS char*)VV + ro_; const GAS char* nb_ = (const GAS char*)KN + ro_; const GAS char* rb_ = (const GAS char*)KR + (size_t)k0_ * 128; \
    s_v0 = *(const GAS bf16x8*)(vb_ + voff); s_v1 = *(const GAS bf16x8*)(vb_ + 32 * 4096 + voff); \
    s_k0 = *(const GAS bf16x8*)(nb_ + voff); s_k1 = *(const GAS bf16x8*)(nb_ + 32 * 4096 + voff); \
    s_kr = *(const GAS bf16x8*)(rb_ + kroff); } while (0)
#define SWRITE(bf) do { *(LAS bf16x8*)(V_lds + (bf) * SHM_V + vst0) = s_v0; *(LAS bf16x8*)(V_lds + (bf) * SHM_V + vst1) = s_v1; const int kc_ = sc * 2; \
    *(LAS bf16x8*)(Kn_lds + (bf) * SHM_KN + KSWZ(sr, kc_)) = s_k0; *(LAS bf16x8*)(Kn_lds + (bf) * SHM_KN + KSWZ(32 + sr, kc_)) = s_k1; \
    *(LAS bf16x8*)(Kr_lds + (bf) * SHM_KR + KRSWZ(krr, krc * 2)) = s_kr; } while (0)
#define SWAIT() asm volatile("s_waitcnt vmcnt(0)" ::: "memory")
#define RESC(a) do { if (__any((a) < 1.f)) { if (hi == 0) al_l[r32] = (a); asm volatile("s_waitcnt lgkmcnt(0)" ::: "memory"); \
    _Pragma("unroll") for (int d = 0; d < 4; ++d) _Pragma("unroll") for (int r = 0; r < 16; ++r) o[d][r] *= al_l[crow(r, hi)]; } } while (0)
  f32x16 pA0, pA1, pB0, pB1; float mnA, mnB, alA, alB; bf16x8 pa0, pa1, pa2, pa3;
  SLOAD(0); SWAIT(); SWRITE(0); __syncthreads();
  qkt(pA0, pA1, Kn_lds, Kr_lds, qr, qrp, kb, krb);
  { const float NEG = -INFINITY;
#pragma unroll
    for (int r = 8; r < 16; ++r) pA0[r] = NEG;
#pragma unroll
    for (int r = 0; r < 16; ++r) pA1[r] = NEG; }
  partialSM(pA0, pA1, m_reg, mnA, alA, C, THRS);
  SLOAD(1); SWAIT(); SWRITE(1); __syncthreads();
  for (int j = 1; j + 1 < NT; j += 2) {
    SBAR(); qkt(pB0, pB1, Kn_lds + SHM_KN, Kr_lds + SHM_KR, qr, qrp, kb, krb);
    finishSM(pA0, pA1, alA, l_reg, pa0, pa1, pa2, pa3); SBAR();
    SLOAD(j + 1); SBAR();
    pv_d0(o, vb0, pa0, pa1, pa2, pa3); partialSM(pB0, pB1, m_reg, mnB, alB, C, THRS);
    __syncthreads(); SWAIT(); SWRITE(0);
    RESC(alB); __syncthreads();
    SBAR(); qkt(pA0, pA1, Kn_lds, Kr_lds, qr, qrp, kb, krb);
    finishSM(pB0, pB1, alB, l_reg, pa0, pa1, pa2, pa3); SBAR();
    if (j + 2 < NT) SLOAD(j + 2); SBAR();
    pv_d0(o, vb0 + SHM_V, pa0, pa1, pa2, pa3); partialSM(pA0, pA1, m_reg, mnA, alA, C, THRS);
    __syncthreads(); if (j + 2 < NT) { SWAIT(); SWRITE(1); }
    RESC(alA); __syncthreads();
  }
  finishSM(pA0, pA1, alA, l_reg, pa0, pa1, pa2, pa3); SBAR();
  pv_d0(o, vb0, pa0, pa1, pa2, pa3);
  if (hi == 0) li_l[r32] = l_reg; asm volatile("s_waitcnt lgkmcnt(0)" ::: "memory");
  float rli[16];
#pragma unroll
  for (int r = 0; r < 16; ++r) rli[r] = __builtin_amdgcn_rcpf(li_l[crow(r, hi)]);
  unsigned char* Ow = OM + (size_t)(b * SEQ + qb * 256 + wid * QBLK) * 2048 + h * 128;
#pragma unroll
  for (int r = 0; r < 16; ++r) { const int orow = crow(r, hi);
#pragma unroll
    for (int d0 = 0; d0 < 4; ++d0) Ow[(size_t)orow * 2048 + d0 * 32 + r32] = f32_to_fp8(o[d0][r] * rli[r] * 32.f); }
#undef TROW
#undef SLOAD
#undef SWRITE
#undef SWAIT
#undef RESC
}
__device__ __forceinline__ void na_task(int task, const bf16_t* __restrict__ NAQ, const bf16_t* __restrict__ NAK, const bf16_t* __restrict__ VT, unsigned char* __restrict__ ONA,
                                        const LAS float* relb, const LAS float* metab, LAS float* wsf, int lane, Conv& cv) {
  const int r32 = lane & 31, hi = lane >> 5;
  const int half = task & 1, r = (task >> 1) & 31, h = (task >> 6) & 15, b = task >> 10;
  const int qc = half * 32 + r32;
  const int cs = min(max(qc - 8, 0), 48), rs = min(max(r - 4, 0), 24);
  const int qtok = b * SEQ + r * 64 + qc;
  constexpr float C = L2E, THRS = 8.f, SCALE = 0.125f;
  bf16x8 qr[4];
#pragma unroll
  for (int d0 = 0; d0 < 4; ++d0) qr[d0] = *(const GAS bf16x8*)(NAQ + (size_t)qtok * 1024 + h * 64 + d0 * 16 + hi * 8);
  float m_reg = -1e30f, l_reg = 0.f; f32x16 o[2] = {};
  LAS float* al_l = wsf; LAS float* li_l = wsf + 32;
  const float NEG = -INFINITY;
  const int kb0 = half * 16;
  const unsigned long long wm = 0xFFFFull << (cs - kb0);
  const unsigned mh0 = (unsigned)wm >> (4 * hi), mh1 = (unsigned)(wm >> 32) >> (4 * hi);
  const bf16_t* kq = NAK + (size_t)r32 * 1024 + h * 64 + hi * 8;
  const bf16_t* kq2 = NAK + (size_t)(32 + (r32 & 15)) * 1024 + h * 64 + hi * 8;
  const bf16_t* vq = VT + (size_t)(h * 64 + r32) * VT_PITCH + 8 * hi;
#define NA_KTOK(w) ((w) == 8 ? MREAL : b * SEQ + (rs + (w)) * 64 + kb0)
#define NA_LOADK(KF, w) do { const size_t ko_ = (size_t)NA_KTOK(w) * 1024; _Pragma("unroll") for (int d0 = 0; d0 < 4; ++d0) { KF[d0] = *(const GAS bf16x8*)(kq + ko_ + d0 * 16); KF[4 + d0] = *(const GAS bf16x8*)(kq2 + ko_ + d0 * 16); } } while (0)
#define NA_TILE(KF, w, YN) do { \
    bf16x8 vf[6]; { const bf16_t* vp_ = vq + NA_KTOK(w); _Pragma("unroll") for (int ks = 0; ks < 3; ++ks) { vf[ks] = *(const GAS bf16x8*)(vp_ + 16 * ks); vf[3 + ks] = *(const GAS bf16x8*)(vp_ + (size_t)32 * VT_PITCH + 16 * ks); } } \
    f32x16 p0 = {}, p1 = {}; \
    _Pragma("unroll") for (int d0 = 0; d0 < 4; ++d0) { p0 = __builtin_amdgcn_mfma_f32_32x32x16_bf16(KF[d0], qr[d0], p0, 0, 0, 0); p1 = __builtin_amdgcn_mfma_f32_32x32x16_bf16(KF[4 + d0], qr[d0], p1, 0, 0, 0); } \
    if ((w) + 1 < 9) NA_LOADK(KF, (w) + 1);            \
    asm volatile("" ::: "memory"); conv_step<YN>(cv, lane);     \
    if ((w) < 8) { const LAS float* bp_ = relb + ((h * 15 + (rs + (w) - r + 7)) * 31 + 15 - qc + 4 * hi + kb0);     \
      float bv0[16], bv1[8];        \
      _Pragma("unroll") for (int rg = 0; rg < 16; ++rg) { const int c_ = (rg & 3) + 8 * (rg >> 2); bv0[rg] = bp_[c_]; if (rg < 8) bv1[rg] = bp_[c_ + 32]; } \
      _Pragma("unroll") for (int rg = 0; rg < 16; ++rg) { asm volatile("" : "+v"(bv0[rg])); if (rg < 8) asm volatile("" : "+v"(bv1[rg])); } \
      _Pragma("unroll") for (int rg = 0; rg < 16; ++rg) { const int c_ = (rg & 3) + 8 * (rg >> 2); \
        { const bool ok = (mh0 >> c_) & 1u; p0[rg] = ok ? fmaf(p0[rg], SCALE, bv0[rg]) : NEG; } \
        if (rg < 8) { const bool ok = (mh1 >> c_) & 1u; p1[rg] = ok ? fmaf(p1[rg], SCALE, bv1[rg]) : NEG; } } \
    } else { const LAS float* bp = metab + h * 16; \
      _Pragma("unroll") for (int rg = 0; rg < 16; ++rg) { const int kc = crow(rg, hi); p0[rg] = (rg < 8) ? fmaf(p0[rg], SCALE, bp[kc & 15]) : NEG; if (rg < 8) p1[rg] = NEG; } } \
      \
    float pmax = p0[0]; \
    _Pragma("unroll") for (int rg = 1; rg < 16; ++rg) pmax = fmaxf(pmax, p0[rg]); \
    _Pragma("unroll") for (int rg = 0; rg < 8; ++rg) pmax = fmaxf(pmax, p1[rg]); \
    { auto rr = __builtin_amdgcn_permlane32_swap(__float_as_uint(pmax), __float_as_uint(pmax), false, false); pmax = fmaxf(__uint_as_float(rr[0]), __uint_as_float(rr[1])); } \
    float mn, alpha; \
    if (__builtin_expect(__all(pmax - m_reg <= THRS), 1)) { mn = m_reg; alpha = 1.f; } \
    else { mn = fmaxf(m_reg, pmax); alpha = __builtin_amdgcn_exp2f((m_reg - mn) * C); m_reg = mn; } \
    const float mnC = -mn * C; float ps = 0.f; \
    _Pragma("unroll") for (int rg = 0; rg < 16; ++rg) { p0[rg] = __builtin_amdgcn_exp2f(fmaf(p0[rg], C, mnC)); ps += p0[rg]; } \
    _Pragma("unroll") for (int rg = 0; rg < 8; ++rg) { p1[rg] = __builtin_amdgcn_exp2f(fmaf(p1[rg], C, mnC)); ps += p1[rg]; } \
    { auto rr = __builtin_amdgcn_permlane32_swap(__float_as_uint(ps), __float_as_uint(ps), false, false); ps = __uint_as_float(rr[0]) + __uint_as_float(rr[1]); } \
    l_reg = l_reg * alpha + ps; \
    bf16x8 pa0, pa1, pa2; NA_PK4(p0, 0, pa0); NA_PK4(p0, 8, pa1); NA_PK4(p1, 0, pa2); \
    if (__any(alpha < 1.f)) { if (hi == 0) al_l[r32] = alpha; asm volatile("s_waitcnt lgkmcnt(0)" ::: "memory"); \
      _Pragma("unroll") for (int d = 0; d < 2; ++d) _Pragma("unroll") for (int rg = 0; rg < 16; ++rg) o[d][rg] *= al_l[crow(rg, hi)]; } \
    _Pragma("unroll") for (int d0 = 0; d0 < 2; ++d0) { \
      o[d0] = __builtin_amdgcn_mfma_f32_32x32x16_bf16(pa0, vf[3 * d0 + 0], o[d0], 0, 0, 0); o[d0] = __builtin_amdgcn_mfma_f32_32x32x16_bf16(pa1, vf[3 * d0 + 1], o[d0], 0, 0, 0); \
      o[d0] = __builtin_amdgcn_mfma_f32_32x32x16_bf16(pa2, vf[3 * d0 + 2], o[d0], 0, 0, 0); } } while (0)
#define NA_PK4(P, BASE, OUT) do { unsigned a0 = cvt_pk_bf16(P[BASE + 0], P[BASE + 1]), a1 = cvt_pk_bf16(P[BASE + 2], P[BASE + 3]);   \
    unsigned b0 = cvt_pk_bf16(P[BASE + 4], P[BASE + 5]), b1 = cvt_pk_bf16(P[BASE + 6], P[BASE + 7]);                              \
    auto r0 = __builtin_amdgcn_permlane32_swap(a0, b0, false, false); auto r1 = __builtin_amdgcn_permlane32_swap(a1, b1, false, false); \
    u32x4 w_ = {r0[0], r1[0], r0[1], r1[1]}; OUT = __builtin_bit_cast(bf16x8, w_); } while (0)
  { bf16x8 kA[8];
    NA_LOADK(kA, 0);
#pragma unroll 1
    for (int w = 0; w < 8; ++w) { NA_TILE(kA, w, 14); }
    NA_TILE(kA, 8, 6); }
#undef NA_PK4
#undef NA_KTOK
#undef NA_LOADK
#undef NA_TILE
  if (hi == 0) li_l[r32] = l_reg; asm volatile("s_waitcnt lgkmcnt(0)" ::: "memory");
  unsigned char* Ow = ONA + (size_t)(b * SEQ + r * 64 + half * 32) * 1024 + h * 64;
#pragma unroll
  for (int rg = 0; rg < 16; ++rg) { const int orow = crow(rg, hi); const float rl = __builtin_amdgcn_rcpf(li_l[orow]);
#pragma unroll
    for (int d0 = 0; d0 < 2; ++d0) Ow[(size_t)orow * 1024 + d0 * 32 + r32] = f32_to_fp8(o[d0][rg] * rl * 16.f); }
  asm volatile("s_waitcnt lgkmcnt(0)" ::: "memory");
}
}
namespace peer {
constexpr int CH = 32;
constexpr int OFF_TV = 0, OFF_TI = OFF_TV + CH * 16 * 16 * 4, OFF_SE = OFF_TI + CH * 16 * 16 * 4, OFF_SG = OFF_SE + CH * 128 * 4, OFF_SE2 = OFF_SG + CH * 128 * 4, OFF_SG2 = OFF_SE2 + CH * 128 * 4, PEER_LDS = OFF_SG2 + CH * 128 * 4;
static_assert(PEER_LDS <= RING_BYTES, "PEER LDS");
__device__ __forceinline__ float gelu_tanh(float x) {
    const float u = 0.7978845608028654f * (x + 0.044715f * x * x * x);
    const float e = __builtin_amdgcn_exp2f(-2.f * 1.4426950408889634f * fabsf(u));
    const float t = (1.f - e) * __builtin_amdgcn_rcpf(1.f + e);
    return 0.5f * x * (1.f + (u < 0.f ? -t : t));
}
__device__ __forceinline__ void fmac1(float& acc, float a, float b) { asm("v_fmac_f32_e32 %0, %1, %2" : "+v"(acc) : "v"(a), "v"(b)); }
#define PEER_INSERT(x_, xi_) do { float x__ = (x_); int xi__ = (xi_); \
    _Pragma("unroll") for (int j_ = 0; j_ < 16; ++j_) { const bool gt_ = x__ > tv[j_]; const float tvo_ = tv[j_]; const int tio_ = ti[j_]; \
        tv[j_] = gt_ ? x__ : tvo_; ti[j_] = gt_ ? xi__ : tio_; x__ = gt_ ? tvo_ : x__; xi__ = gt_ ? tio_ : xi__; } } while (0)

#define PEER_AUX 0
typedef __amdgpu_buffer_rsrc_t rsrc_t;
__device__ __forceinline__ rsrc_t mk_rsrc(const void* p, unsigned bytes) { return __builtin_amdgcn_make_buffer_rsrc((void*)p, 0, bytes, 0x00020000); }
__device__ __forceinline__ u32x4 ldb128(rsrc_t r, unsigned off) { return __builtin_amdgcn_raw_buffer_load_b128(r, off, 0, PEER_AUX); }
typedef unsigned v6u_t __attribute__((ext_vector_type(6)));
typedef float v32f_t __attribute__((ext_vector_type(32)));
typedef float v16f_t __attribute__((ext_vector_type(16)));
__device__ __forceinline__ u32x2 ldb64(rsrc_t r, unsigned off) { return __builtin_amdgcn_raw_buffer_load_b64(r, off, 0, PEER_AUX); }
__device__ __forceinline__ f32x4 ldf128(rsrc_t r, unsigned off) { return __builtin_bit_cast(f32x4, __builtin_amdgcn_raw_buffer_load_b128(r, off, 0, PEER_AUX)); }
__device__ __forceinline__ f32x4 ldf128_nt(rsrc_t r, unsigned off) { return __builtin_bit_cast(f32x4, __builtin_amdgcn_raw_buffer_load_b128(r, off, 0, 2)); }
__device__ __forceinline__ void peer_select(int chunk, const _Float16* __restrict__ SC, LAS char* lds, int tid, LAS int* SE, LAS float* SG) {
    LAS float* TV = (LAS float*)(lds + OFF_TV); LAS int* TI = (LAS int*)(lds + OFF_TI);
    asm volatile("" : "+v"(tid));
    const int tok0 = chunk * CH;
    const rsrc_t rSC = mk_rsrc(SC, 0x4000000u);
    __syncthreads();
    { const int tl = tid >> 4, g = tid & 15; const unsigned spo = ((unsigned)(tok0 + tl) * 2048u + (unsigned)g * 128u) * 2u;
      int tk[16];
#pragma unroll
      for (int j = 0; j < 16; ++j) tk[j] = (int)0x80000000;
#define PEER_KEY(x_, lowbits_, mask_) ({ const int f_ = __float_as_int(x_); ((f_ ^ ((f_ >> 31) & 0x7fffffff)) & ~(mask_)) | (lowbits_); })
#define PEER_INS(key_) do { int x__ = (key_); _Pragma("unroll") for (int j_ = 0; j_ < 16; ++j_) { const int hi_ = max(x__, tk[j_]); x__ = min(x__, tk[j_]); tk[j_] = hi_; } } while (0)
      typedef _Float16 h8_t __attribute__((ext_vector_type(8)));
#define PEER_CX(a_, b_) do { const int hi_ = max(a_, b_), lo_ = min(a_, b_); a_ = hi_; b_ = lo_; } while (0)
      u32x4 na = __builtin_amdgcn_raw_buffer_load_b128(rSC, spo, 0, 2), nb = __builtin_amdgcn_raw_buffer_load_b128(rSC, spo + 16, 0, 2);
#pragma unroll 1
      for (int i = 0; i < 16; i += 2) { const h8_t a = __builtin_bit_cast(h8_t, na), b = __builtin_bit_cast(h8_t, nb);
          { const unsigned on = spo + (unsigned)min(i + 2, 14) * 16u; na = __builtin_amdgcn_raw_buffer_load_b128(rSC, on, 0, 2); nb = __builtin_amdgcn_raw_buffer_load_b128(rSC, on + 16, 0, 2); }
          int kk[16];
#pragma unroll
          for (int e = 0; e < 8; ++e) { kk[e] = PEER_KEY((float)a[e], 127 - (8 * i + e), 127); kk[8 + e] = PEER_KEY((float)b[e], 127 - (8 * i + 8 + e), 127); }
          PEER_CX(kk[0], kk[13]); PEER_CX(kk[1], kk[12]); PEER_CX(kk[2], kk[15]); PEER_CX(kk[3], kk[14]); PEER_CX(kk[4], kk[8]); PEER_CX(kk[5], kk[6]); PEER_CX(kk[7], kk[11]); PEER_CX(kk[9], kk[10]); PEER_CX(kk[0], kk[5]); PEER_CX(kk[1], kk[7]); PEER_CX(kk[2], kk[9]); PEER_CX(kk[3], kk[4]); PEER_CX(kk[6], kk[13]); PEER_CX(kk[8], kk[14]); PEER_CX(kk[10], kk[15]); PEER_CX(kk[11], kk[12]); PEER_CX(kk[0], kk[1]); PEER_CX(kk[2], kk[3]); PEER_CX(kk[4], kk[5]); PEER_CX(kk[6], kk[8]); PEER_CX(kk[7], kk[9]); PEER_CX(kk[10], kk[11]); PEER_CX(kk[12], kk[13]); PEER_CX(kk[14], kk[15]); PEER_CX(kk[0], kk[2]); PEER_CX(kk[1], kk[3]); PEER_CX(kk[4], kk[10]); PEER_CX(kk[5], kk[11]); PEER_CX(kk[6], kk[7]); PEER_CX(kk[8], kk[9]); PEER_CX(kk[12], kk[14]); PEER_CX(kk[13], kk[15]); PEER_CX(kk[1], kk[2]); PEER_CX(kk[3], kk[12]); PEER_CX(kk[4], kk[6]); PEER_CX(kk[5], kk[7]); PEER_CX(kk[8], kk[10]); PEER_CX(kk[9], kk[11]); PEER_CX(kk[13], kk[14]); PEER_CX(kk[1], kk[4]); PEER_CX(kk[2], kk[6]); PEER_CX(kk[5], kk[8]); PEER_CX(kk[7], kk[10]); PEER_CX(kk[9], kk[13]); PEER_CX(kk[11], kk[14]); PEER_CX(kk[2], kk[4]); PEER_CX(kk[3], kk[6]); PEER_CX(kk[9], kk[12]); PEER_CX(kk[11], kk[13]); PEER_CX(kk[3], kk[5]); PEER_CX(kk[6], kk[8]); PEER_CX(kk[7], kk[9]); PEER_CX(kk[10], kk[12]); PEER_CX(kk[3], kk[4]); PEER_CX(kk[5], kk[6]); PEER_CX(kk[7], kk[8]); PEER_CX(kk[9], kk[10]); PEER_CX(kk[11], kk[12]); PEER_CX(kk[6], kk[7]); PEER_CX(kk[8], kk[9]);
#pragma unroll
          for (int e = 0; e < 16; ++e) tk[e] = max(tk[e], kk[15 - e]);
          PEER_CX(tk[0], tk[8]); PEER_CX(tk[1], tk[9]); PEER_CX(tk[2], tk[10]); PEER_CX(tk[3], tk[11]); PEER_CX(tk[4], tk[12]); PEER_CX(tk[5], tk[13]); PEER_CX(tk[6], tk[14]); PEER_CX(tk[7], tk[15]); PEER_CX(tk[0], tk[4]); PEER_CX(tk[1], tk[5]); PEER_CX(tk[2], tk[6]); PEER_CX(tk[3], tk[7]); PEER_CX(tk[8], tk[12]); PEER_CX(tk[9], tk[13]); PEER_CX(tk[10], tk[14]); PEER_CX(tk[11], tk[15]); PEER_CX(tk[0], tk[2]); PEER_CX(tk[1], tk[3]); PEER_CX(tk[4], tk[6]); PEER_CX(tk[5], tk[7]); PEER_CX(tk[8], tk[10]); PEER_CX(tk[9], tk[11]); PEER_CX(tk[12], tk[14]); PEER_CX(tk[13], tk[15]); PEER_CX(tk[0], tk[1]); PEER_CX(tk[2], tk[3]); PEER_CX(tk[4], tk[5]); PEER_CX(tk[6], tk[7]); PEER_CX(tk[8], tk[9]); PEER_CX(tk[10], tk[11]); PEER_CX(tk[12], tk[13]); PEER_CX(tk[14], tk[15]); }
#undef PEER_CX
      LAS float* tvp = TV + (tl * 16 + g) * 16; LAS int* tip = TI + (tl * 16 + g) * 16;
#pragma unroll
      for (int j = 0; j < 16; ++j) { const int k_ = tk[j] & ~127; tvp[j] = __int_as_float(k_ ^ ((k_ >> 31) & 0x7fffffff)); tip[j] = 127 - (tk[j] & 127); } }
    __syncthreads();
    asm volatile("" : "+v"(tid));
    { const int tl = tid >> 4, hh = (tid >> 1) & 7, half = tid & 1;
      const LAS float* s1 = TV + (tl * 16 + 2 * hh) * 16; const LAS float* s2 = s1 + 16; const LAS int* i1 = TI + (tl * 16 + 2 * hh) * 16; const LAS int* i2 = i1 + 16;
      float b2[16];
#pragma unroll
      for (int j = 0; j < 16; ++j) b2[j] = s2[j];
      int tk[16];
#pragma unroll
      for (int j = 0; j < 16; ++j) tk[j] = (int)0x80000000;
#pragma unroll
      for (int ii = 0; ii < 8; ++ii) { const int i = 2 * ii + half; const float a = s1[i];
#pragma unroll
          for (int j = 0; j < 16; ++j) if ((2 * ii + 1) * (j + 1) <= 16) { if (half == 0 || (2 * ii + 2) * (j + 1) <= 16) PEER_INS(PEER_KEY(a + b2[j], 255 - (i * 16 + j), 255)); } }
      { int pk[16];
#pragma unroll
        for (int j = 0; j < 16; ++j) pk[j] = __shfl_xor(tk[j], 1);
#pragma unroll
        for (int j = 0; j < 16; ++j) PEER_INS(pk[j]); }
      if (half == 0) { float e[16], sum = 0.f; const int k0_ = tk[0] & ~255; const float v0 = __int_as_float(k0_ ^ ((k0_ >> 31) & 0x7fffffff));
#pragma unroll
        for (int j = 0; j < 16; ++j) { const int k_ = tk[j] & ~255; const float vj = __int_as_float(k_ ^ ((k_ >> 31) & 0x7fffffff)); e[j] = __builtin_amdgcn_exp2f((vj - v0) * 1.4426950408889634f); sum += e[j]; }
        const float inv = 1.0f / sum;
#pragma unroll
        for (int j = 0; j < 16; ++j) { const int ci = 255 - (tk[j] & 255); SE[tl * 128 + hh * 16 + j] = i1[ci >> 4] * 128 + i2[ci & 15]; SG[tl * 128 + hh * 16 + j] = e[j] * inv; } } }
#undef PEER_KEY
#undef PEER_INS
    __syncthreads();
}
__device__ __forceinline__ void peer_gather(int chunk, const bf16_t* __restrict__ H2, const unsigned char* __restrict__ U, const unsigned char* __restrict__ V,
                                            const float* __restrict__ g2, const float* __restrict__ gf, float* OUT, int tid, const LAS int* SE, const LAS float* SG) {
    asm volatile("" : "+v"(tid));
    const int tok0 = chunk * CH, lane = tid & 63, wave = tid >> 6;
    const rsrc_t rH2 = mk_rsrc(H2, 0x4000000u), rU = mk_rsrc(U, 0x1800000u), rV = mk_rsrc(V, 0x1800000u), rG2 = mk_rsrc(g2, 8192u), rGF = mk_rsrc(gf, 8192u);
#pragma unroll 1
    for (int tt = 0; tt < CH / NWAVES; ++tt) { const int tl = wave * (CH / NWAVES) + tt, tok = tok0 + tl;
      asm volatile("" ::: "memory");
      float hn[32], acc[32]; float ss = 0.f;
#pragma unroll
      for (int j = 0; j < 2; ++j)
#pragma unroll
          for (int q = 0; q < 4; ++q) { const u32x2 w = ldb64(rH2, ((unsigned)tok * 2048u + 256u * (4 * j + q) + 4u * lane) * 2u);
              const f32x4 a = (f32x4){__uint_as_float(w.x << 16), __uint_as_float(w.x & 0xffff0000u), __uint_as_float(w.y << 16), __uint_as_float(w.y & 0xffff0000u)};
#pragma unroll
              for (int i = 0; i < 4; ++i) { hn[16 * j + 4 * q + i] = a[i]; ss += a[i] * a[i]; } }
      const float rstd = 1.0f / sqrtf(wave_sum(ss) * (1.f / 2048.f) + NORM_EPS);
#pragma unroll
      for (int j = 0; j < 2; ++j)
#pragma unroll
          for (int q = 0; q < 4; ++q) { const f32x4 a = ldf128(rG2, (256u * (4 * j + q) + 4u * lane) * 4u);
#pragma unroll
              for (int i = 0; i < 4; ++i) hn[16 * j + 4 * q + i] *= rstd * a[i]; }
#pragma unroll
      for (int i = 0; i < 32; ++i) acc[i] = 0.f;
#define NX 4
#define PEER_LOAD(S, kb) do { _Pragma("unroll") for (int x = 0; x < NX; ++x) { const unsigned o = (unsigned)SE[tl * 128 + (kb) + x] * 1536u; \
          S##ua[x] = ldb128(rU, o + (unsigned)lane * 16u); S##ub[x] = ldb64(rU, o + 1024u + (unsigned)lane * 8u); S##va[x] = ldb128(rV, o + (unsigned)lane * 16u); S##vb[x] = ldb64(rV, o + 1024u + (unsigned)lane * 8u); } } while (0)
#define PEER_DEC(A, B) ({ v32f_t r_ = __builtin_amdgcn_cvt_scalef32_pk32_f32_fp6((v6u_t){A.x, A.y, A.z, A.w, B.x, B.y}, 1.0f); asm volatile("s_nop 1" : "+v"(r_)); r_; })
#define PEER_COMPUTE(S, kb) do { float d[NX]; \
          _Pragma("unroll") for (int x = 0; x < NX; ++x) { const v32f_t r = PEER_DEC(S##ua[x], S##ub[x]); float dd = 0.f; \
              _Pragma("unroll") for (int i = 0; i < 32; ++i) fmac1(dd, hn[i], r[i]); \
              d[x] = dd; } \
          _Pragma("unroll") for (int o = 1; o < 64; o <<= 1) { _Pragma("unroll") for (int x = 0; x < NX; ++x) d[x] += __shfl_xor(d[x], o); } \
          float c[NX]; \
          _Pragma("unroll") for (int x = 0; x < NX; ++x) c[x] = SG[tl * 128 + (kb) + x] * gelu_tanh(d[x] * (1.f / 64.f)) * 0.25f; \
          _Pragma("unroll") for (int x = 0; x < NX; ++x) { const v32f_t r = PEER_DEC(S##va[x], S##vb[x]); \
              _Pragma("unroll") for (int i = 0; i < 32; ++i) fmac1(acc[i], c[x], r[i]); } } while (0)
      { u32x4 Aua[NX], Ava[NX], Bua[NX], Bva[NX]; u32x2 Aub[NX], Avb[NX], Bub[NX], Bvb[NX];
        PEER_LOAD(A, 0);
#pragma unroll 1
        for (int k = 0; k < 128; k += 2 * NX) {
            PEER_LOAD(B, k + NX); PEER_COMPUTE(A, k);
            { const int kn = min(k + 2 * NX, 128 - NX); PEER_LOAD(A, kn); }
            PEER_COMPUTE(B, k + NX);
        } }
#undef PEER_DEC
#undef NX
#undef PEER_LOAD
#undef PEER_COMPUTE
      asm volatile("" ::: "memory");
      int tok2 = tok, lane2 = lane; asm volatile("" : "+v"(tok2), "+v"(lane2));
      float s2 = 0.f;
#pragma unroll
      for (int j = 0; j < 2; ++j)
#pragma unroll
          for (int q = 0; q < 4; ++q) { const u32x2 w = ldb64(rH2, ((unsigned)tok2 * 2048u + 256u * (4 * j + q) + 4u * lane2) * 2u);
              const f32x4 a = (f32x4){__uint_as_float(w.x << 16), __uint_as_float(w.x & 0xffff0000u), __uint_as_float(w.y << 16), __uint_as_float(w.y & 0xffff0000u)};
#pragma unroll
              for (int i = 0; i < 4; ++i) { acc[16 * j + 4 * q + i] += a[i]; s2 += acc[16 * j + 4 * q + i] * acc[16 * j + 4 * q + i]; } }
      const float rf = 1.0f / sqrtf(wave_sum(s2) * (1.f / 2048.f) + NORM_EPS);
#pragma unroll
      for (int j = 0; j < 2; ++j)
#pragma unroll
          for (int q = 0; q < 4; ++q) { const f32x4 a = ldf128(rGF, (256u * (4 * j + q) + 4u * lane2) * 4u); f32x4 oa;
#pragma unroll
              for (int i = 0; i < 4; ++i) oa[i] = acc[16 * j + 4 * q + i] * rf * a[i];
              float* op = OUT + (size_t)tok2 * 2048 + 256 * (4 * j + q) + 4 * lane2;
              __builtin_nontemporal_store(oa, (GAS f32x4*)op); }
    }
}
}
#ifndef MK_N_LAUNCHES
#define MK_N_LAUNCHES 1
#endif
#define MK_PROBE_PH -1
#define MK_PROBE_DIV 2
constexpr int N_PHASES = 9;
constexpr int N_LAUNCHES = MK_N_LAUNCHES;
struct Args { const float* in[19]; float* out; unsigned char* ws; int ph_lo, ph_hi; };
static_assert(sizeof(Args) == 19 * 8 + 8 + 8 + 8, "no padding");

__global__ void __launch_bounds__(NWAVES * 64, 2) hybrid_fwd(Args args) {
    extern __shared__ __attribute__((aligned(16))) unsigned char lds_raw[];
    Frame F;
    F.lds = (LAS unsigned char*)lds_raw;
    F.MISC = (volatile LAS unsigned*)(F.lds + MISC_OFF);
    F.tid = threadIdx.x; F.lane = F.tid & 63; F.wave = __builtin_amdgcn_readfirstlane(F.tid >> 6);
    F.G = gridDim.x; { const int bx = blockIdx.x; F.vcu = (F.G % 8 == 0) ? (bx % 8) * (F.G / 8) + bx / 8 : bx; }
    F.ws = args.ws; F.out = args.out;
#pragma unroll
    for (int i = 0; i < 19; ++i) F.in[i] = args.in[i];
    for (int u = F.tid; u < (LDS_BYTES - LDSCTL_OFF) / 4; u += NWAVES * 64) ((LAS unsigned*)(F.lds + LDSCTL_OFF))[u] = 0u;
    __syncthreads();
    XcdBarrier bar; bar.bar = (unsigned*)(F.ws + WS_CTL) + CW_BAR; bar.x = 0; bar.st = nullptr;
    if (N_LAUNCHES == 1) bar = xcd_barrier_post((unsigned*)(F.ws + WS_CTL) + CW_BAR, F.MISC + 8);
    const int lo = args.ph_lo, hi = args.ph_hi;
#define IN(k) (lo <= (k) && (k) < hi)
#if MK_PROBE_PH >= 0
    unsigned long long tp0 = (MK_PROBE_PH == 0 || MK_PROBE_PH == 9) ? __builtin_amdgcn_s_memrealtime() : 0ull, tp1 = 0ull;
#define SEAM(k) do { if (IN(k) && IN((k) + 1)) xcd_barrier(bar); if (MK_PROBE_PH == (k)) tp1 = __builtin_amdgcn_s_memrealtime(); if (MK_PROBE_PH == (k) + 1) tp0 = __builtin_amdgcn_s_memrealtime(); } while (0)
#else
#define SEAM(k) do { if (IN(k) && IN((k) + 1)) xcd_barrier(bar); } while (0)
#endif
    const size_t T2048 = (size_t)256 * 2048 * 2, T1024 = (size_t)256 * 1024 * 2, T512 = (size_t)256 * 512 * 2;
    float* cosT = WSP(float, WS_COS); float* sinT = WSP(float, WS_SIN);
    float* ssq_q = WSP(float, WS_SSQ_Q); float* ssq_kv = WSP(float, WS_SSQ_KV); float* ssq2 = WSP(float, WS_SSQ_2);

    if (IN(0)) { p0_prologue<0>(F, F.vcu, F.G); } SEAM(0);
    if (IN(1)) {
        SchedP1 S{F.G, (int)blockIdx.x, (const char*)(F.ws + WS_HN1), (const char*)(F.ws + WS_WIN), (const char*)(F.ws + WS_WVT), T1024};
        EpiP1 E{WSP(bf16_t, WS_NAQ), WSP(bf16_t, WS_NAK), WSP(bf16_t, WS_VT), WSP(unsigned char, WS_CQ), WSP(unsigned char, WS_CKV), WSP(bf16_t, WS_KR), WSP(unsigned char, WS_GA), WSP(unsigned char, WS_GB), ssq_q, ssq_kv, cosT, sinT};
        pg8::gemm_phase<EpiP1, SchedP1, true, -6>(F.lds, 2048, S, E);
        { const int extra = P1_UNITS % F.G, bx = (int)blockIdx.x; if (extra != 0 && bx >= extra) p0_prologue<1>(F, bx - extra, F.G - extra); else if (extra == 0) p0_prologue<1>(F, bx, F.G); }
    } SEAM(1);
    if (IN(2)) {
        LAS float* relb = (LAS float*)F.lds + 64; LAS float* metab = relb + 16 * 15 * 31 + 128; LAS float* wsf = metab + 256 + F.wave * 64;
        for (int i = F.tid; i < 16 * 15 * 31; i += NWAVES * 64) relb[i] = F.in[4][i];
        if (F.tid < 256) metab[F.tid] = F.in[5][F.tid];
        __syncthreads();
        const int gw = F.vcu * NWAVES + F.wave, NGW = F.G * NWAVES;
        Conv cv{F.in[16], F.in[17], WSP(unsigned char, WS_U), WSP(unsigned char, WS_V), F.lds + 65536 + F.wave * 8192, gw, NGW, 2 * 16384, -1};
        for (int task = gw; task < NBATCH * 16 * 32 * 2; task += NGW)
            att::na_task(task, WSP(bf16_t, WS_NAQ), WSP(bf16_t, WS_NAK), WSP(bf16_t, WS_VT), WSP(unsigned char, WS_ONA), relb, metab, wsf, F.lane, cv);
        while (cv.pend >= 0 || cv.next < cv.end) conv_step<0>(cv, F.lane);
        __syncthreads();
    } SEAM(2);
    if (IN(3)) {
        SchedP3 S{F.G, (int)blockIdx.x, (const char*)(F.ws + WS_CQ), (const char*)(F.ws + WS_CKV), (const char*)(F.ws + WS_WUQ), (const char*)(F.ws + WS_WUKV), T512 / 2};
        EpiP3 E{WSP(bf16_t, WS_QM), WSP(bf16_t, WS_KN), WSP(bf16_t, WS_VV), ssq_q, ssq_kv, cosT, sinT};
        pg8::gemm_phase<EpiP3, SchedP3, true, -4>(F.lds, 512, S, E);
    } SEAM(3);
    if (IN(4)) {
        for (int id = F.vcu; id < NBATCH * 16 * 8; id += F.G) { const int bh = id >> 3, qb = id & 7;
            att::mla_unit(bh >> 4, bh & 15, qb, WSP(bf16_t, WS_QM), WSP(bf16_t, WS_KN), WSP(bf16_t, WS_KR), WSP(bf16_t, WS_VV), WSP(unsigned char, WS_OMLA), (LAS char*)F.lds); }
        __syncthreads();
    } SEAM(4);
    if (IN(5)) {
        { SchedGrid S{F.G, (int)blockIdx.x, 64, 8, (const char*)(F.ws + WS_ONA), (const char*)(F.ws + WS_WNA), T512};
          EpiP5a E{WSP(unsigned char, WS_GA), WSP(bf16_t, WS_T1)};
          pg8::gemm_phase<EpiP5a, SchedGrid, true, -9>(F.lds, 1024, S, E); }
        { SchedGrid S{F.G, (int)blockIdx.x, 64, 8, (const char*)(F.ws + WS_OMLA), (const char*)(F.ws + WS_WMLA), T1024};
          EpiP5b E{WSP(unsigned char, WS_GB), WSP(bf16_t, WS_T1), WSP(unsigned char, WS_MERGED)};
          pg8::gemm_phase<EpiP5b, SchedGrid, true, -11>(F.lds, 2048, S, E); }
    } SEAM(5);
    if (IN(6)) {
        { SchedGrid S{F.G, (int)blockIdx.x, 64, 8, (const char*)(F.ws + WS_MERGED), (const char*)(F.ws + WS_WOUT), T1024};
          EpiP6 E{F.in[0], WSP(bf16_t, WS_H2B), ssq2};
          pg8::gemm_phase<EpiP6, SchedGrid, true, -11>(F.lds, 2048, S, E); }
    } SEAM(6);
    if (IN(7)) {
        SchedGrid S{F.G, (int)blockIdx.x, 64, 8, (const char*)(F.ws + WS_H2B), (const char*)(F.ws + WS_WSC), T2048};
        EpiP7 E{ssq2, WSP(_Float16, WS_SC)};
        pg8::gemm_phase<EpiP7, SchedGrid>(F.lds, 2048, S, E);
    } SEAM(7);
    if (IN(8)) {
        const int nch = (MREAL / peer::CH - F.vcu + F.G - 1) / F.G; const bool both_first = (nch == 2) && (F.vcu & 1);
        for (int op = 0; op < 2 * nch; ++op) {
            const bool sel = both_first ? (op < 2) : !(op & 1); const int ci = both_first ? (op & 1) : (op >> 1), chunk = F.vcu + ci * F.G;
            const int b2 = both_first ? ci : 0;
            LAS int* SE = (LAS int*)(F.lds + (b2 ? peer::OFF_SE2 : peer::OFF_SE)); LAS float* SG = (LAS float*)(F.lds + (b2 ? peer::OFF_SG2 : peer::OFF_SG));
            if (sel) peer::peer_select(chunk, WSP(_Float16, WS_SC), (LAS char*)F.lds, F.tid, SE, SG);
            else peer::peer_gather(chunk, WSP(bf16_t, WS_H2B), WSP(unsigned char, WS_U), WSP(unsigned char, WS_V), F.in[13], F.in[18], F.out, F.tid, SE, SG); }
    }
#if MK_PROBE_PH >= 0
    xcd_barrier(bar); tp1 = (MK_PROBE_PH >= 8) ? __builtin_amdgcn_s_memrealtime() : tp1;
    if (blockIdx.x == 0 && F.tid == 0) F.out[0] = (float)(tp1 - tp0) * (0.01f / MK_PROBE_DIV);
#endif
#undef IN
#undef SEAM
}

extern "C" void kernel_launch(void* const* d_in, const int* in_sizes, int n_in, void* d_out, int out_size, void* d_ws, size_t ws_size, hipStream_t stream) {
    static int grid = 0;
    if (grid == 0) {
        if (n_in != 19 || in_sizes[0] != MREAL * DM || out_size != MREAL * DM || ws_size < WS_END) {
            fprintf(stderr, "kernel_launch: shape/workspace mismatch: n_in %d in0 %d out %d ws %zu (need %zu); nothing launched\n", n_in, n_in > 0 ? in_sizes[0] : -1, out_size, ws_size, (size_t)WS_END); grid = -1; return; }
        int dev = 0, cus = 0, per_cu = 0;
        if (hipGetDevice(&dev) != hipSuccess || hipDeviceGetAttribute(&cus, hipDeviceAttributeMultiprocessorCount, dev) != hipSuccess) { fprintf(stderr, "kernel_launch: device query failed\n"); grid = -1; return; }
        if (hipFuncSetAttribute((const void*)hybrid_fwd, hipFuncAttributeMaxDynamicSharedMemorySize, LDS_BYTES) != hipSuccess) { fprintf(stderr, "kernel_launch: hipFuncSetAttribute failed\n"); grid = -1; return; }
        if (hipOccupancyMaxActiveBlocksPerMultiprocessor(&per_cu, (const void*)hybrid_fwd, NWAVES * 64, LDS_BYTES) != hipSuccess || per_cu < 1)
            fprintf(stderr, "kernel_launch: note: occupancy query reports %d workgroups per CU\n", per_cu);
        (void)hipGetLastError();
        grid = cus;
    }
    if (grid < 0) return;
    if (hipMemsetAsync((char*)d_ws + WS_CTL, 0, CTL_ZERO_BYTES, stream) != hipSuccess) { fprintf(stderr, "kernel_launch: hipMemsetAsync failed\n"); return; }
    Args a{};
    for (int i = 0; i < 19; ++i) a.in[i] = (const float*)d_in[i];
    a.out = (float*)d_out; a.ws = (unsigned char*)d_ws;
    for (int li = 0; li < N_LAUNCHES; ++li) {
        a.ph_lo = (N_LAUNCHES == 1) ? 0 : li; a.ph_hi = (N_LAUNCHES == 1) ? N_PHASES : li + 1;
        hipLaunchKernelGGL(hybrid_fwd, dim3(grid), dim3(NWAVES * 64), LDS_BYTES, stream, a);
        const hipError_t le = hipPeekAtLastError();
        if (le != hipSuccess) { fprintf(stderr, "kernel_launch: launch %d failed: %s\n", li, hipGetErrorName(le)); break; }
    }
}
```

```cpp
#include <hip/hip_runtime.h>
#include <cstdio>
#include <cstdint>

#define LAS __attribute__((address_space(3)))
#define GAS __attribute__((address_space(1)))
typedef unsigned short bf16_t;
typedef short bf16x8 __attribute__((ext_vector_type(8)));
typedef short s16x4 __attribute__((ext_vector_type(4)));
typedef float f32x4 __attribute__((ext_vector_type(4)));
typedef float f32x2 __attribute__((ext_vector_type(2)));
typedef float f32x16 __attribute__((ext_vector_type(16)));
typedef unsigned u32x4 __attribute__((ext_vector_type(4)));
typedef unsigned u32x2 __attribute__((ext_vector_type(2)));

constexpr int DM = 2048, NBATCH = 8, SEQ = 2048, NMETA = 16;
constexpr int MREAL = NBATCH * SEQ;
constexpr int MPAD = MREAL + 256;
constexpr int NPOS = SEQ + NMETA;
constexpr float NORM_EPS = 1e-6f;
constexpr int C_NAQ = 0, C_NAK = 1024, C_CQ = 2048, C_CKV = 2560, C_GA = 3072, C_GB = 5120, C_KR = 7168, NMAIN = 7424;
constexpr int VT_PITCH = MPAD;

constexpr size_t MiB = 1u << 20;
constexpr size_t WS_CTL = 0, CTL_ZERO_BYTES = 1 * MiB;
constexpr size_t WS_SSQ_Q = 481 * MiB, WS_SSQ_KV = 482 * MiB, WS_SSQ_2 = 486 * MiB;
constexpr size_t WS_COS = 1 * MiB, WS_SIN = 1 * MiB + 512 * 1024;
constexpr size_t WS_WUQ = 2 * MiB, WS_WUKV = 5 * MiB, WS_WNA = 9 * MiB, WS_WMLA = 13 * MiB, WS_WOUT = 21 * MiB, WS_WSC = 29 * MiB;
constexpr size_t WS_GA = 37 * MiB, WS_GB = 101 * MiB;
constexpr size_t WS_KR = 165 * MiB;
constexpr size_t WS_WIN = 167 * MiB + 256 * 1024, WS_WVT = WS_WIN + 29 * MiB;
constexpr size_t WS_ONA = 190 * MiB;
constexpr size_t WS_NAQ = 222 * MiB, WS_NAK = 254 * MiB, WS_VT = WS_NAK + 32 * MiB + 512 * 1024;
constexpr size_t WS_HN1 = 319 * MiB;
constexpr size_t WS_CQ = 448 * MiB, WS_CKV = 464 * MiB;
constexpr size_t WS_QM = 222 * MiB, WS_KN = 318 * MiB, WS_VV = 383 * MiB;
constexpr size_t WS_OMLA = 448 * MiB;
constexpr size_t WS_MERGED = 222 * MiB, WS_T1 = 286 * MiB;
constexpr size_t WS_H2 = 37 * MiB, WS_H2B = 293 * MiB;
constexpr size_t WS_U = 69 * MiB, WS_V = 133 * MiB;
constexpr size_t WS_SC = 165 * MiB;
constexpr size_t WS_END = 512 * MiB;
static_assert(WS_CKV + (size_t)MPAD * 512 * 2 <= WS_SSQ_Q && WS_SSQ_Q + (size_t)8 * MPAD * 4 <= WS_SSQ_KV && WS_SSQ_KV + (size_t)8 * MPAD * 4 <= 483 * MiB && WS_SSQ_2 + (size_t)32 * MREAL * 4 <= WS_END, "ssq slabs");
static_assert(WS_VT + (size_t)1024 * MPAD * 2 <= WS_HN1 && WS_HN1 + (size_t)MPAD * 2048 * 2 <= WS_CQ && WS_CKV + (size_t)MPAD * 512 * 2 <= WS_END, "map P1");
static_assert(WS_WVT + 4 * MiB <= WS_NAQ && WS_KR + (size_t)MPAD * 64 * 2 <= WS_WIN && WS_ONA + 32 * MiB <= WS_NAQ, "map P1b");
static_assert(WS_QM + 96 * MiB <= WS_KN && WS_KN + 65 * MiB <= WS_VV && WS_VV + 65 * MiB <= WS_OMLA && WS_OMLA + 64 * MiB <= WS_END, "map P3");
static_assert(WS_T1 + 128 * MiB <= WS_OMLA && WS_H2 + 128 * MiB <= WS_KR && WS_SC + 128 * MiB <= WS_H2B && WS_H2B + 64 * MiB <= WS_END, "map P5+");
static_assert(WS_GA + 32 * MiB <= WS_U && WS_U + 24 * MiB <= WS_GB && WS_GB + 32 * MiB <= WS_V && WS_V + 24 * MiB <= WS_KR, "expert tables between the gate codes");

constexpr int CW_BAR = 4096;

constexpr int RING_BYTES = 131072;
constexpr int LDSCTL_OFF = RING_BYTES, MISC_OFF = LDSCTL_OFF + 320;
constexpr int LDS_BYTES = 147456;
constexpr int NWAVES = 8;

#define LDS_WAIT() asm volatile("s_waitcnt lgkmcnt(0)" ::: "memory")
#define VM_WAIT() asm volatile("s_waitcnt vmcnt(0)" ::: "memory")
#define SBAR() __builtin_amdgcn_sched_barrier(0)
typedef __bf16 bf16x2_t __attribute__((ext_vector_type(2)));
__device__ __forceinline__ unsigned cvt_pk_bf16(float lo, float hi) { const f32x2 v = {lo, hi}; const bf16x2_t b = __builtin_convertvector(v, bf16x2_t); return __builtin_bit_cast(unsigned, b); }
__device__ __forceinline__ float bf_lo(unsigned w) { return __uint_as_float(w << 16); }
__device__ __forceinline__ float bf_hi(unsigned w) { return __uint_as_float(w & 0xffff0000u); }
__device__ __forceinline__ u32x4 pack8(const f32x4 a, const f32x4 b) { u32x4 w; w.x = cvt_pk_bf16(a[0], a[1]); w.y = cvt_pk_bf16(a[2], a[3]); w.z = cvt_pk_bf16(b[0], b[1]); w.w = cvt_pk_bf16(b[2], b[3]); return w; }
__device__ __forceinline__ u32x2 pack8_fp8(f32x4 a, f32x4 b) {
#pragma unroll
    for (int i = 0; i < 4; ++i) { a[i] = __builtin_fminf(__builtin_fmaxf(a[i], -448.f), 448.f); b[i] = __builtin_fminf(__builtin_fmaxf(b[i], -448.f), 448.f); }
    int w0 = 0, w1 = 0; w0 = __builtin_amdgcn_cvt_pk_fp8_f32(a[0], a[1], w0, false); w0 = __builtin_amdgcn_cvt_pk_fp8_f32(a[2], a[3], w0, true);
    w1 = __builtin_amdgcn_cvt_pk_fp8_f32(b[0], b[1], w1, false); w1 = __builtin_amdgcn_cvt_pk_fp8_f32(b[2], b[3], w1, true); return (u32x2){(unsigned)w0, (unsigned)w1}; }
__device__ __forceinline__ unsigned char f32_to_fp8(float x) { x = __builtin_fminf(__builtin_fmaxf(x, -448.f), 448.f); return (unsigned char)(__builtin_amdgcn_cvt_pk_fp8_f32(x, 0.f, 0, false) & 0xff); }
__device__ __forceinline__ u32x2 pack8_u8(const f32x4 a, const f32x4 b) { u32x2 w; unsigned x = 0u, y = 0u;
    x = __builtin_amdgcn_cvt_pk_u8_f32(a[0] * 255.f, 0u, x); x = __builtin_amdgcn_cvt_pk_u8_f32(a[1] * 255.f, 1u, x); x = __builtin_amdgcn_cvt_pk_u8_f32(a[2] * 255.f, 2u, x); x = __builtin_amdgcn_cvt_pk_u8_f32(a[3] * 255.f, 3u, x);
    y = __builtin_amdgcn_cvt_pk_u8_f32(b[0] * 255.f, 0u, y); y = __builtin_amdgcn_cvt_pk_u8_f32(b[1] * 255.f, 1u, y); y = __builtin_amdgcn_cvt_pk_u8_f32(b[2] * 255.f, 2u, y); y = __builtin_amdgcn_cvt_pk_u8_f32(b[3] * 255.f, 3u, y);
    w.x = x; w.y = y; return w; }
__device__ __forceinline__ void unpack8_fp8(const u32x2 w, f32x4& a, f32x4& b) {
    const f32x2 a0 = __builtin_amdgcn_cvt_pk_f32_fp8((int)w.x, false), a1 = __builtin_amdgcn_cvt_pk_f32_fp8((int)w.x, true), b0 = __builtin_amdgcn_cvt_pk_f32_fp8((int)w.y, false), b1 = __builtin_amdgcn_cvt_pk_f32_fp8((int)w.y, true);
    a = (f32x4){a0[0], a0[1], a1[0], a1[1]}; b = (f32x4){b0[0], b0[1], b1[0], b1[1]}; }
__device__ __forceinline__ void unpack8_u8(const u32x2 w, f32x4& a, f32x4& b) { const float k = 1.f / 255.f;
    a = (f32x4){(float)(w.x & 0xffu), (float)((w.x >> 8) & 0xffu), (float)((w.x >> 16) & 0xffu), (float)(w.x >> 24)} * k;
    b = (f32x4){(float)(w.y & 0xffu), (float)((w.y >> 8) & 0xffu), (float)((w.y >> 16) & 0xffu), (float)(w.y >> 24)} * k; }
__device__ __forceinline__ u32x2 pack4(const f32x4 a) { u32x2 w; w.x = cvt_pk_bf16(a[0], a[1]); w.y = cvt_pk_bf16(a[2], a[3]); return w; }
__device__ __forceinline__ float wave_sum(float v) {
#pragma unroll
    for (int o = 1; o < 64; o <<= 1) v += __shfl_xor(v, o);
    return v;
}
__device__ __forceinline__ float sigmoidf_(float x) { return __builtin_amdgcn_rcpf(1.0f + __builtin_amdgcn_exp2f(-1.4426950408889634f * x)); }
__device__ __forceinline__ int crow(int r, int hi) { return (r & 3) + 8 * (r >> 2) + 4 * hi; }
#define PG8_AUX 0
namespace pg8 {
constexpr int BM = 256, BK = 64, HALF = 128, HTB = HALF * BK * 2  , STAGE_BYTES = 8 * HTB, NXCD = 8, WGM = 8;
__host__ __device__ __forceinline__ int lds_byte(int r, int c) { const int st = (r >> 4) * 2 + (c >> 5), rr = r & 15, cc = c & 31, ob = rr * 64 + cc * 2; return st * 1024 + (ob ^ (((ob >> 9) & 1) << 5)); }
__host__ __device__ __forceinline__ void stage_rc(int b, int& R, int& C) { const int st = b / 1024, sb = b % 1024, swz = sb ^ (((sb >> 9) & 1) << 5); R = (st >> 1) * 16 + swz / 64; C = (st & 1) * 32 + (swz % 64) / 2; }
__host__ __device__ __forceinline__ int perm32(int rho) { const int n = rho >> 4, i = rho & 15; return 8 * (i >> 2) + 4 * n + (i & 3); }

struct Unit { int pm, pn, kind; };

__device__ __forceinline__ void grid_order(int L, int nM, int nN, int& pm, int& pn) {
    const int nwg = nM * nN; int wgid = L;
    { const int q = nwg / NXCD, r = nwg % NXCD, xcd = wgid % NXCD, off = wgid / NXCD; wgid = (xcd < r ? xcd * (q + 1) : r * (q + 1) + (xcd - r) * q) + off; }
    const int nig = WGM * nN, gid = wgid / nig, fm = gid * WGM, gsz = (nM - fm) < WGM ? (nM - fm) : WGM;
    pm = fm + ((wgid % nig) % gsz); pn = (wgid % nig) / gsz;
}

typedef int v8i_t __attribute__((ext_vector_type(8)));
template <class Epi, class Sched, bool F8 = false, int F8_SCALE_EXP = 0>
__device__ __forceinline__ void gemm_phase(LAS unsigned char* lds, const int K, const Sched& S, const Epi& E) {
    const int tid = threadIdx.x, wid = __builtin_amdgcn_readfirstlane(tid >> 6), lane = tid & 63, wr = wid >> 2, wc = wid & 3, fr = lane & 15, fq = lane >> 4;
    int f8sa = 0x01010101 * (127 + F8_SCALE_EXP), f8sb = 0x7f7f7f7f; asm volatile("" : "+v"(f8sa), "+v"(f8sb));
    const int Kb = F8 ? K : 2 * K;
    const int nt = Kb / 128;
    unsigned voffA[2], voffB[2];
#pragma unroll
    for (int i = 0; i < 2; ++i) { int R, C; stage_rc(tid * 16 + i * 8192, R, C); const int Rb = Epi::PERM ? ((R & ~31) + perm32(R & 31)) : R;
        voffA[i] = (unsigned)(R * Kb + C * 2); voffB[i] = (unsigned)(Rb * Kb + C * 2); }
    const size_t kstep = (size_t)128;
    const size_t hstep = (size_t)HALF * Kb;
    const unsigned ldsw = (unsigned)wid * 1024u;
    const int aoff = lds_byte(wr * 64 + fr, F8 ? fq * 16 : fq * 8), boff = lds_byte(wc * 32 + fr, F8 ? fq * 16 : fq * 8);
#define PG8_SA(b, h) (((b) * 2 + (h)) * HTB)
#define PG8_SB(b, h) ((4 + (b) * 2 + (h)) * HTB)
#define PG8_STAGE(bufoff, gbase, voff) do { _Pragma("unroll") for (int _i = 0; _i < 2; ++_i) \
        __builtin_amdgcn_global_load_lds((const unsigned*)((const char*)(gbase) + (voff)[_i]), (LAS unsigned*)(lds + (bufoff) + ldsw + _i * 8192), 16, 0, PG8_AUX); } while (0)
#define PG8_LDA(dst, b, h) do { _Pragma("unroll") for (int m = 0; m < 4; ++m) _Pragma("unroll") for (int k = 0; k < 2; ++k) dst[m][k] = *(const LAS bf16x8*)(lds + PG8_SA(b, h) + aoff + m * 2048 + (F8 ? k * 16 : k * 1024)); } while (0)
#define PG8_LDB(dst, b, h) do { _Pragma("unroll") for (int n = 0; n < 2; ++n) _Pragma("unroll") for (int k = 0; k < 2; ++k) dst[n][k] = *(const LAS bf16x8*)(lds + PG8_SB(b, h) + boff + n * 2048 + (F8 ? k * 16 : k * 1024)); } while (0)
#define PG8_F8OP(X) __builtin_bit_cast(v8i_t, __builtin_shufflevector(X[0], X[1], 0, 1, 2, 3, 4, 5, 6, 7, 8, 9, 10, 11, 12, 13, 14, 15))
#define PG8_MMA(ai, bj, At, Bt) do { __builtin_amdgcn_s_setprio(1); \
        if constexpr (F8) { _Pragma("unroll") for (int m = 0; m < 4; ++m) _Pragma("unroll") for (int n = 0; n < 2; ++n) \
            asm volatile("v_mfma_scale_f32_16x16x128_f8f6f4 %0, %1, %2, %0, %3, %4 op_sel_hi:[0,0,0]" : "+v"(acc[ai][bj][m][n]) : "v"(PG8_F8OP(Bt[n])), "v"(PG8_F8OP(At[m])), "v"(f8sa), "v"(f8sb)); } \
        else { _Pragma("unroll") for (int m = 0; m < 4; ++m) _Pragma("unroll") for (int n = 0; n < 2; ++n) _Pragma("unroll") for (int k = 0; k < 2; ++k) \
            acc[ai][bj][m][n] = __builtin_amdgcn_mfma_f32_16x16x32_bf16(Bt[n][k], At[m][k], acc[ai][bj][m][n], 0, 0, 0); } \
        __builtin_amdgcn_s_setprio(0); } while (0)
#define PG8_WAIT_V(n) asm volatile("s_waitcnt vmcnt(" #n ")" ::: "memory")
#define PG8_WAIT_L(n) asm volatile("s_waitcnt lgkmcnt(" #n ")" ::: "memory")
#define PG8_BAR __builtin_amdgcn_s_barrier()
#define PG8_SCHED __builtin_amdgcn_sched_barrier(0)
    Unit cur, nxt; int ui = 0;
    if (!S.next(0, cur)) return;
    f32x4 acc[2][2][4][2];
#pragma unroll
    for (int a = 0; a < 2; ++a)
#pragma unroll
        for (int b = 0; b < 2; ++b)
#pragma unroll
            for (int m = 0; m < 4; ++m)
#pragma unroll
                for (int n = 0; n < 2; ++n) acc[a][b][m][n] = (f32x4){0.f, 0.f, 0.f, 0.f};
    bf16x8 At[4][2], B0[2][2], B1[2][2];
    const char* cA = S.pa(cur); const char* cB = S.pb(cur);
    PG8_STAGE(PG8_SB(0, 0), cB, voffB); PG8_STAGE(PG8_SB(0, 1), cB + hstep, voffB); PG8_STAGE(PG8_SA(0, 0), cA, voffA); PG8_STAGE(PG8_SA(0, 1), cA + hstep, voffA);
    if (wr == 1) PG8_BAR;
    PG8_WAIT_V(2); PG8_BAR;
    PG8_STAGE(PG8_SB(1, 0), cB + kstep, voffB); PG8_STAGE(PG8_SA(1, 0), cA + kstep, voffA); PG8_STAGE(PG8_SB(1, 1), cB + hstep + kstep, voffB);
    PG8_WAIT_V(6); PG8_BAR;
    for (;;) {
        const bool has_next = S.next(ui + 1, nxt);
        const char* nA = has_next ? S.pa(nxt) : cA; const char* nB = has_next ? S.pb(nxt) : cB;
        for (int t = 0; t < nt; t += 2) {
            const bool last = (t == nt - 2);
            const char* a1 = cA + (size_t)(t + 1) * kstep;
            const char* a2 = last ? nA : cA + (size_t)(t + 2) * kstep; const char* b2 = last ? nB : cB + (size_t)(t + 2) * kstep;
            const char* a3 = a2 + kstep; const char* b3 = b2 + kstep;
            PG8_LDB(B0, 0, 0); PG8_LDB(B1, 0, 1); PG8_SCHED; PG8_LDA(At, 0, 0); PG8_STAGE(PG8_SA(1, 1), a1 + hstep, voffA);
            PG8_WAIT_V(8); PG8_WAIT_L(0); PG8_BAR; PG8_MMA(0, 0, At, B0); PG8_MMA(0, 1, At, B1); PG8_BAR; PG8_SCHED;
            PG8_LDA(At, 0, 1); PG8_STAGE(PG8_SB(0, 0), b2, voffB); PG8_STAGE(PG8_SB(0, 1), b2 + hstep, voffB); PG8_STAGE(PG8_SA(0, 0), a2, voffA);
            PG8_WAIT_V(8); PG8_WAIT_L(0); PG8_BAR; PG8_MMA(1, 0, At, B0); PG8_MMA(1, 1, At, B1); PG8_BAR; PG8_SCHED;
            PG8_LDB(B0, 1, 0); PG8_LDB(B1, 1, 1); PG8_SCHED; PG8_LDA(At, 1, 0); PG8_STAGE(PG8_SA(0, 1), a2 + hstep, voffA);
            PG8_WAIT_V(8); PG8_WAIT_L(0); PG8_BAR; PG8_MMA(0, 0, At, B0); PG8_MMA(0, 1, At, B1); PG8_BAR; PG8_SCHED;
            PG8_LDA(At, 1, 1); PG8_STAGE(PG8_SB(1, 0), b3, voffB); PG8_STAGE(PG8_SB(1, 1), b3 + hstep, voffB); PG8_STAGE(PG8_SA(1, 0), a3, voffA);
            PG8_WAIT_V(8); PG8_WAIT_L(0); PG8_BAR; PG8_MMA(1, 0, At, B0); PG8_MMA(1, 1, At, B1); PG8_BAR; PG8_SCHED;
        }
        if (wr == 0) PG8_BAR;
        if constexpr (F8) asm volatile("s_nop 15\n\ts_nop 7" ::: "memory");
        if constexpr (Epi::HAS_PRE) {
            E.pre(cur, (LAS float*)(lds + STAGE_BYTES + 1024), tid); PG8_WAIT_L(0); PG8_BAR; }
        E(acc, cur, wr, wc, fr, fq, (const LAS float*)(lds + STAGE_BYTES + 1024));
        if (!has_next) break;
#pragma unroll
        for (int a = 0; a < 2; ++a)
#pragma unroll
            for (int b = 0; b < 2; ++b)
#pragma unroll
                for (int m = 0; m < 4; ++m)
#pragma unroll
                    for (int n = 0; n < 2; ++n) acc[a][b][m][n] = (f32x4){0.f, 0.f, 0.f, 0.f};
        cur = nxt; cA = nA; cB = nB; ++ui;
        if (wr == 1) PG8_BAR;
    }
    PG8_WAIT_V(0);
    PG8_BAR;
#undef PG8_SA
#undef PG8_SB
#undef PG8_STAGE
#undef PG8_LDA
#undef PG8_LDB
#undef PG8_MMA
#undef PG8_F8OP
#undef PG8_WAIT_V
#undef PG8_WAIT_L
#undef PG8_BAR
#undef PG8_SCHED
}
}
typedef GAS unsigned gu32;
#define RLX_AGENT __ATOMIC_RELAXED, __HIP_MEMORY_SCOPE_AGENT
#define XB_TMO      128
#define XB_XCNT(j)  (256  + 64 * (j))
#define XB_XSUB(j)  (1280 + 64 * (j))
#define XB_XGEN(j)  (2304 + 64 * (j))
#define XB_TOP      3328
#define XB_TOPGEN   3392
#define XCD_BAR_WORDS 3456
#define XB_SPIN_CAP (1u << 18)
__device__ __forceinline__ unsigned xb_ld(unsigned* p)              { return __hip_atomic_load(p, __ATOMIC_RELAXED, __HIP_MEMORY_SCOPE_AGENT); }
__device__ __forceinline__ unsigned xb_add(unsigned* p, unsigned v) { return __hip_atomic_fetch_add(p, v, __ATOMIC_RELAXED, __HIP_MEMORY_SCOPE_AGENT); }
__device__ __forceinline__ unsigned xb_xcc_id() { return (unsigned)__builtin_amdgcn_s_getreg((3 << 11) | 20) & 0xFu; }
#define XB_SPIN(cond, bar) do { unsigned _sp = 0; while (cond) { __builtin_amdgcn_s_sleep(1); \
    if ((++_sp & 255u) == 0u) { if (xb_ld(&(bar)[XB_TMO])) break; if (_sp > XB_SPIN_CAP) { atomicAdd(&(bar)[XB_TMO], 1u); break; } } } } while (0)
struct XcdBarrier { unsigned* bar; unsigned x; volatile LAS unsigned* st; };
__device__ __forceinline__ XcdBarrier xcd_barrier_post(unsigned* bar, volatile LAS unsigned* st) {
    XcdBarrier b; b.bar = bar; b.x = xb_xcc_id(); b.st = st;
    if (threadIdx.x == 0) (void)xb_add(&bar[XB_XCNT(b.x)], 1u);
    return b;
}
__device__ __forceinline__ void xcd_barrier_complete(unsigned* bar, unsigned x, unsigned& nloc, unsigned& nx) {
    const unsigned G = gridDim.x * gridDim.y * gridDim.z;
    unsigned sum, cnt, mine, sp = 0u;
    for (;;) {
        sum = 0u; cnt = 0u; mine = 0u;
#pragma unroll
        for (unsigned j = 0; j < 16; ++j) { const unsigned c = xb_ld(&bar[XB_XCNT(j)]); sum += c; cnt += (c > 0u) ? 1u : 0u; mine = (j == x) ? c : mine; }
        if (sum == G) break;
        __builtin_amdgcn_s_sleep(1);
        if ((++sp & 255u) == 0u) { if (xb_ld(&bar[XB_TMO])) break; if (sp > XB_SPIN_CAP) { atomicAdd(&bar[XB_TMO], 1u); break; } }
    }
    nloc = mine > 0u ? mine : 1u; nx = cnt > 0u ? cnt : 1u;
}
__device__ __forceinline__ void xcd_barrier(const XcdBarrier& b) {
    asm volatile("s_waitcnt vmcnt(0)" ::: "memory");
    __syncthreads();
    if (threadIdx.x == 0) {
        unsigned* bar = b.bar;
        __builtin_amdgcn_s_waitcnt(0);
        unsigned nloc = b.st[0], nx = b.st[1];
        if (nloc == 0u) { xcd_barrier_complete(bar, b.x, nloc, nx); b.st[0] = nloc; b.st[1] = nx; }
        const unsigned old = xb_add(&bar[XB_XSUB(b.x)], 1u);
        const unsigned gen = old / nloc;
        if (old + 1u == (gen + 1u) * nloc) {
            __builtin_amdgcn_fence(__ATOMIC_RELEASE, "agent");
            asm volatile("s_waitcnt vmcnt(0)" ::: "memory");
            const unsigned og = xb_add(&bar[XB_TOP], 1u);
            const unsigned tg = og / nx;
            if (og + 1u == (tg + 1u) * nx) xb_add(&bar[XB_TOPGEN], 1u);
            else XB_SPIN(xb_ld(&bar[XB_TOPGEN]) == tg, bar);
            __builtin_amdgcn_fence(__ATOMIC_ACQUIRE, "agent");
            xb_add(&bar[XB_XGEN(b.x)], 1u);
            asm volatile("s_waitcnt vmcnt(0)" ::: "memory");
        } else {
            XB_SPIN(xb_ld(&bar[XB_XGEN(b.x)]) == gen, bar);
            __builtin_amdgcn_fence(__ATOMIC_ACQUIRE, "agent");
            asm volatile("s_waitcnt vmcnt(0)" ::: "memory");
        }
    }
    __syncthreads();
}
struct Frame {
    LAS unsigned char* lds;
    volatile LAS unsigned* MISC;
    unsigned char* ws;
    int tid, lane, wave;
    int vcu, G;
    const float* in[19];
    float* out;
};
#define WSP(T, off) ((T*)(F.ws + (off)))

typedef float cv16f_t __attribute__((ext_vector_type(16)));
typedef unsigned cv6u_t __attribute__((ext_vector_type(6)));
struct Conv { const float* pu; const float* pv; unsigned char* u8; unsigned char* v8; LAS unsigned char* lbuf; int next, stride, end, pend; };
__device__ __forceinline__ void conv_issue(const Conv& c, int item, int lane) {
    const float* src = ((item >> 14) ? c.pv : c.pu) + (size_t)(item & 16383) * 2048 + 4 * lane;
#pragma unroll
    for (int q = 0; q < 8; ++q) __builtin_amdgcn_global_load_lds((const unsigned*)(src + 256 * q), (LAS unsigned*)(c.lbuf + q * 1024), 16, 0, 0);
}
__device__ __forceinline__ void conv_finish(const Conv& c, int item, int lane) {
    const int isv = item >> 14, row = item & 16383; const float sc = isv ? 4.f : 64.f; cv16f_t a, b;
#pragma unroll
    for (int q = 0; q < 8; ++q) { const f32x4 x = *(const LAS f32x4*)(c.lbuf + q * 1024 + lane * 16);
#pragma unroll
        for (int e = 0; e < 4; ++e) { const int k_ = 4 * q + e;
            if (k_ & 1) b[k_ >> 1] = x[e] * sc; else a[k_ >> 1] = x[e] * sc; } }
    const cv6u_t w = __builtin_amdgcn_cvt_scalef32_2xpk16_fp6_f32(a, b, 1.0f);
    unsigned char* rec = (isv ? c.v8 : c.u8) + (size_t)row * 1536;
    *(GAS u32x4*)(rec + lane * 16) = (u32x4){w[0], w[1], w[2], w[3]}; *(GAS u32x2*)(rec + 1024 + lane * 8) = (u32x2){w[4], w[5]};
}
template <int YOUNGER>
__device__ __forceinline__ void conv_step(Conv& c, int lane) {
    if (c.pend >= 0) { if constexpr (YOUNGER == 0) asm volatile("s_waitcnt vmcnt(0)" ::: "memory"); else if constexpr (YOUNGER == 6) asm volatile("s_waitcnt vmcnt(6)" ::: "memory"); else { static_assert(YOUNGER == 14, "wait count"); asm volatile("s_waitcnt vmcnt(14)" ::: "memory"); }
        conv_finish(c, c.pend, lane); c.pend = -1; asm volatile("s_waitcnt lgkmcnt(0)" ::: "memory"); }
    if (c.next < c.end) { conv_issue(c, c.next, lane); c.pend = c.next; c.next += c.stride; }
}
__device__ __forceinline__ void p0_transpose_item(const float* W, int K, int N, int k0, int n0, bf16_t* WT, int drow, bool rope, const float* gain, LAS float* scr, int lane) {
    { f32x4 v[8]; float gk[8];
#pragma unroll
      for (int i = 0; i < 8; ++i) { const int kk = 8 * i + (lane >> 3); v[i] = *(const GAS f32x4*)(W + (size_t)(k0 + kk) * N + n0 + 4 * (lane & 7)); gk[i] = gain ? gain[k0 + kk] : 1.f; }
#pragma unroll
      for (int i = 0; i < 8; ++i) { const int kk = 8 * i + (lane >> 3); LAS float* d = scr + kk * 33 + 4 * (lane & 7);
#pragma unroll
          for (int e = 0; e < 4; ++e) d[e] = v[i][e] * gk[i]; } }
    LDS_WAIT(); asm volatile("" ::: "memory");
    const int c = lane & 7;
#pragma unroll
    for (int j = 0; j < 4; ++j) { const int n = (lane >> 3) + 8 * j; const LAS float* s = scr + (8 * c) * 33 + n;
        u32x4 o; o.x = cvt_pk_bf16(s[0 * 33], s[1 * 33]); o.y = cvt_pk_bf16(s[2 * 33], s[3 * 33]); o.z = cvt_pk_bf16(s[4 * 33], s[5 * 33]); o.w = cvt_pk_bf16(s[6 * 33], s[7 * 33]);
        const int dr = drow + (rope ? (8 * (n >> 2) + (n & 3)) : n);
        *(GAS u32x4*)(WT + (size_t)dr * K + k0 + 8 * c) = o; }
    LDS_WAIT(); asm volatile("" ::: "memory");
}
__device__ __forceinline__ void p0_transpose_item8(const float* W, int K, int N, int k0, int n0, unsigned char* WT, int drow, bool rope, float scale, LAS float* scr, int lane, const float* gain = nullptr) {
    { f32x4 v[8]; float gk[8];
#pragma unroll
      for (int i = 0; i < 8; ++i) { const int kk = 8 * i + (lane >> 3); v[i] = *(const GAS f32x4*)(W + (size_t)(k0 + kk) * N + n0 + 4 * (lane & 7)); gk[i] = gain ? gain[k0 + kk] * scale : scale; }
#pragma unroll
      for (int i = 0; i < 8; ++i) { const int kk = 8 * i + (lane >> 3); LAS float* d = scr + kk * 33 + 4 * (lane & 7);
#pragma unroll
          for (int e = 0; e < 4; ++e) d[e] = v[i][e] * gk[i]; } }
    LDS_WAIT(); asm volatile("" ::: "memory");
#pragma unroll
    for (int j = 0; j < 2; ++j) { const int q = lane + 64 * j, n = q >> 2, c = q & 3; const LAS float* s = scr + (16 * c) * 33 + n; u32x4 o;
#pragma unroll
        for (int d = 0; d < 4; ++d) { int w = 0; w = __builtin_amdgcn_cvt_pk_fp8_f32(s[(4 * d) * 33], s[(4 * d + 1) * 33], w, false); w = __builtin_amdgcn_cvt_pk_fp8_f32(s[(4 * d + 2) * 33], s[(4 * d + 3) * 33], w, true); o[d] = (unsigned)w; }
        const int dr = drow + (rope ? (8 * (n >> 2) + (n & 3)) : n);
        *(GAS u32x4*)(WT + (size_t)dr * K + k0 + 16 * c) = o; }
    LDS_WAIT(); asm volatile("" ::: "memory");
}
__device__ __forceinline__ void rms_row_to_fp8(const float* xrow, const float* g, unsigned char* orow, int lane) {
    const GAS f32x4* xr = (const GAS f32x4*)xrow + lane; const GAS f32x4* gr = (const GAS f32x4*)g + lane;
    f32x4 v[8]; float s = 0.f;
#pragma unroll
    for (int j = 0; j < 8; ++j) { v[j] = xr[64 * j]; s += (v[j].x * v[j].x + v[j].y * v[j].y) + (v[j].z * v[j].z + v[j].w * v[j].w); }
    const float rstd = 1.0f / sqrtf(wave_sum(s) * (1.f / DM) + NORM_EPS);
    GAS unsigned* o4 = (GAS unsigned*)orow + lane;
#pragma unroll
    for (int j = 0; j < 8; ++j) { const f32x4 y = (v[j] * rstd) * gr[64 * j]; int w = 0; w = __builtin_amdgcn_cvt_pk_fp8_f32(y[0], y[1], w, false); w = __builtin_amdgcn_cvt_pk_fp8_f32(y[2], y[3], w, true); o4[64 * j] = (unsigned)w; }
}
__device__ __forceinline__ void rms_row_to_bf16(const float* xrow, const float* g, bf16_t* orow, int lane) {
    const GAS f32x4* xr = (const GAS f32x4*)xrow + lane; const GAS f32x4* gr = (const GAS f32x4*)g + lane;
    f32x4 v[8]; float s = 0.f;
#pragma unroll
    for (int j = 0; j < 8; ++j) { v[j] = xr[64 * j]; s += (v[j].x * v[j].x + v[j].y * v[j].y) + (v[j].z * v[j].z + v[j].w * v[j].w); }
    const float rstd = 1.0f / sqrtf(wave_sum(s) * (1.f / DM) + NORM_EPS);
    GAS u32x2* o8 = (GAS u32x2*)orow + lane;
#pragma unroll
    for (int j = 0; j < 8; ++j) { const f32x4 gg = gr[64 * j]; o8[64 * j] = pack4((v[j] * rstd) * gg); }
}
template <int PART>
__device__ __forceinline__ void p0_prologue(Frame& F, int rank, int nrank) {
    LAS float* scr = (LAS float*)(F.lds + F.wave * 16384);
    const int gw = rank * NWAVES + F.wave, NGW = nrank * NWAVES, lane = F.lane; const int gt = rank * 512 + F.tid, NGT = nrank * 512;
    unsigned char* WIN = WSP(unsigned char, WS_WIN); unsigned char* WVT = WSP(unsigned char, WS_WVT);
    constexpr int I_IN = 32 * 258, I_UQ = 8 * 96, I_UKV = 8 * 128, I_NA = 16 * 64, I_MLA = 32 * 64, I_OUT = 32 * 64;
    constexpr int NEARLY = I_IN + I_UQ + I_UKV, NITEMS = NEARLY + I_NA + I_MLA + I_OUT;
    for (int it = (PART == 0 ? 0 : NEARLY) + gw; it < (PART == 0 ? NEARLY : NITEMS); it += NGW) {
        int r = it;
        if (r < I_IN) { const int kb = r / 258, sb = r % 258, n0 = 32 * sb, k0 = 64 * kb; const float* W = F.in[3];
            unsigned char* dst = WIN; int drow; bool rope = false;
            if (n0 < 1024) drow = C_NAQ + n0;
            else if (n0 < 2048) drow = C_NAK + (n0 - 1024);
            else if (n0 < 3072) { dst = WVT; drow = n0 - 2048; }
            else if (n0 < 3584) drow = C_CQ + (n0 - 3072);
            else if (n0 < 4096) drow = C_CKV + (n0 - 3584);
            else if (n0 < 4160) { drow = C_KR + ((n0 - 4096) ? 4 : 0); rope = true; }
            else if (n0 < 6208) drow = C_GA + (n0 - 4160);
            else drow = C_GB + (n0 - 6208);
            p0_transpose_item8(W, 2048, 8256, k0, n0, dst, drow, rope, 64.f, scr, lane); continue; } r -= I_IN;
        if (r < I_UQ) { const int kb = r / 96, sb = r % 96, n0 = 32 * sb, k0 = 64 * kb; const int hd = n0 / 192, w = n0 % 192;
            int drow = n0; bool rope = false; if (w >= 128) { rope = true; drow = hd * 192 + 128 + ((w - 128) ? 4 : 0); }
            p0_transpose_item8(F.in[7], 512, 3072, k0, n0, WSP(unsigned char, WS_WUQ), drow, rope, 16.f, scr, lane, F.in[6]); continue; } r -= I_UQ;
        if (r < I_UKV) { const int kb = r / 128, sb = r % 128; p0_transpose_item8(F.in[9], 512, 4096, 64 * kb, 32 * sb, WSP(unsigned char, WS_WUKV), 32 * sb, false, 16.f, scr, lane, F.in[8]); continue; } r -= I_UKV;
        if (r < I_NA) { const int kb = r / 64, sb = r % 64; p0_transpose_item8(F.in[10], 1024, 2048, 64 * kb, 32 * sb, WSP(unsigned char, WS_WNA), 32 * sb, false, 32.f, scr, lane); continue; } r -= I_NA;
        if (r < I_MLA) { const int kb = r / 64, sb = r % 64; p0_transpose_item8(F.in[11], 2048, 2048, 64 * kb, 32 * sb, WSP(unsigned char, WS_WMLA), 32 * sb, false, 64.f, scr, lane); continue; } r -= I_MLA;
        { const int kb = r / 64, sb = r % 64; p0_transpose_item8(F.in[12], 2048, 2048, 64 * kb, 32 * sb, WSP(unsigned char, WS_WOUT), 32 * sb, false, 64.f, scr, lane); }
    }
    if (PART == 0) { GAS u32x4* z = (GAS u32x4*)(WIN + (size_t)(C_KR + 64) * 2048); const int n16 = (NMAIN - C_KR - 64) * 2048 / 16;
      for (int i = gt; i < n16; i += NGT) z[i] = (u32x4){0u, 0u, 0u, 0u}; }
    if (PART == 0) { unsigned char* HN1 = WSP(unsigned char, WS_HN1);
#define P0_ROWSRC(m_) (((m_) < MREAL) ? F.in[0] + (size_t)(m_) * DM : F.in[1] + (size_t)((m_) - MREAL) * DM)
      { f32x4 v[8]; int m = gw;
        if (m < MREAL + NMETA) { const GAS f32x4* xr = (const GAS f32x4*)P0_ROWSRC(m) + lane;
#pragma unroll
            for (int j = 0; j < 8; ++j) v[j] = xr[64 * j]; }
        const GAS f32x4* gr = (const GAS f32x4*)F.in[2] + lane;
        while (m < MREAL + NMETA) { const int mn = m + NGW; f32x4 vn[8];
            { const int ml = mn < MREAL + NMETA ? mn : m; const GAS f32x4* xr = (const GAS f32x4*)P0_ROWSRC(ml) + lane;
#pragma unroll
              for (int j = 0; j < 8; ++j) vn[j] = xr[64 * j]; }
            float sq = 0.f;
#pragma unroll
            for (int j = 0; j < 8; ++j) sq += (v[j].x * v[j].x + v[j].y * v[j].y) + (v[j].z * v[j].z + v[j].w * v[j].w);
            const float rstd = 1.0f / sqrtf(wave_sum(sq) * (1.f / DM) + NORM_EPS);
            GAS unsigned* o4 = (GAS unsigned*)(HN1 + (size_t)m * DM) + lane;
#pragma unroll
            for (int j = 0; j < 8; ++j) { const f32x4 y = (v[j] * rstd) * gr[64 * j]; int w = 0; w = __builtin_amdgcn_cvt_pk_fp8_f32(y[0], y[1], w, false); w = __builtin_amdgcn_cvt_pk_fp8_f32(y[2], y[3], w, true); o4[64 * j] = (unsigned)w; }
#pragma unroll
            for (int j = 0; j < 8; ++j) v[j] = vn[j];
            m = mn; } }
#undef P0_ROWSRC
      GAS u32x4* z = (GAS u32x4*)(HN1 + (size_t)(MREAL + NMETA) * DM); const int n16 = (MPAD - MREAL - NMETA) * DM / 16;
      for (int i = gt; i < n16; i += NGT) z[i] = (u32x4){0u, 0u, 0u, 0u}; }
    if (PART == 0) { float* ct = WSP(float, WS_COS); float* st = WSP(float, WS_SIN);
      for (int i = gt; i < NPOS * 32; i += NGT) { const int p = i >> 5, j = i & 31;
          const float inv = __builtin_powf(10000.0f, -(float)(2 * j) / 64.0f); const float ang = (float)p * inv;
          double r = (double)ang * 0.15915494309189535; r -= __builtin_rint(r); const float rf = (float)r;
          ct[i] = __builtin_amdgcn_cosf(rf); st[i] = __builtin_amdgcn_sinf(rf); } }
    if (PART == 1) { const float* SK = F.in[15]; const float* WQ = F.in[14]; const float* g2 = F.in[13]; bf16_t* WSCp = WSP(bf16_t, WS_WSC);
      const int l15 = lane & 15, l4 = lane >> 4;
      for (int task = gw; task < 2048; task += NGW) { const int g = task >> 7, nt = (task >> 4) & 7, kc = task & 15, n0 = nt * 16;
          bf16x8 bfr[4];
#pragma unroll
          for (int kk = 0; kk < 4; ++kk) { const float* p = SK + ((size_t)g * 128 + n0 + l15) * 128 + 32 * kk + 8 * l4; const f32x4 a = *(const GAS f32x4*)p, b = *(const GAS f32x4*)(p + 4);
              const u32x4 w = pack8(a, b); bfr[kk] = __builtin_bit_cast(bf16x8, w); }
          for (int kt = 0; kt < 8; ++kt) { const int k0 = (kc * 8 + kt) * 16; f32x4 acc = (f32x4){0.f, 0.f, 0.f, 0.f};
#pragma unroll
              for (int kk = 0; kk < 4; ++kk) { const float* p = WQ + (size_t)(k0 + l15) * 2048 + g * 128 + 32 * kk + 8 * l4; const f32x4 a = *(const GAS f32x4*)p, b = *(const GAS f32x4*)(p + 4);
                  const u32x4 w = pack8(a, b); acc = __builtin_amdgcn_mfma_f32_16x16x32_bf16(__builtin_bit_cast(bf16x8, w), bfr[kk], acc, 0, 0, 0); }
              const f32x4 gg = *(const GAS f32x4*)(g2 + k0 + 4 * l4);
              *(GAS u32x2*)(WSCp + (size_t)(g * 128 + n0 + l15) * 2048 + k0 + 4 * l4) = pack4(acc * gg); } } }
}
using pg8::Unit;
struct SchedGrid {
    int G, c, nM, nN; const char* A; const char* B; size_t tstep;
    __device__ __forceinline__ bool next(int i, Unit& u) const { const int L = i * G + c; if (L >= nM * nN) return false; pg8::grid_order(L, nM, nN, u.pm, u.pn); u.kind = 0; return true; }
    __device__ __forceinline__ const char* pa(const Unit& u) const { return A + (size_t)u.pm * tstep; }
    __device__ __forceinline__ const char* pb(const Unit& u) const { return B + (size_t)u.pn * tstep; }
};
constexpr int P1_MAIN = 64 * 29, P1_VT = 4 * 65, P1_META = 7, P1_UNITS = P1_MAIN + P1_VT + P1_META;
struct SchedP1 {
    int G, c; const char* hn1; const char* win; const char* wvt; size_t tstep;
    __device__ __forceinline__ bool next(int i, Unit& u) const {
        const int L = i * G + c; if (L >= P1_UNITS) return false;
        if (L < P1_MAIN) { pg8::grid_order(L, 64, 29, u.pm, u.pn); u.kind = 0; }
        else if (L < P1_MAIN + P1_VT) { const int idx = L - P1_MAIN; u.pm = idx & 3; u.pn = idx >> 2; u.kind = 1; }
        else { const int idx = L - P1_MAIN - P1_VT; u.pm = 64; u.pn = idx < 4 ? 4 + idx : (idx < 6 ? 10 + (idx - 4) : 28); u.kind = 0; }
        return true; }
    __device__ __forceinline__ const char* pa(const Unit& u) const { return (u.kind == 1 ? wvt : hn1) + (size_t)u.pm * tstep; }
    __device__ __forceinline__ const char* pb(const Unit& u) const { return (u.kind == 1 ? hn1 : win) + (size_t)u.pn * tstep; }
};
__device__ __forceinline__ void rope4(const f32x4 x1, const f32x4 x2, const float* cosT, const float* sinT, int pos, int j0, f32x4& lo, f32x4& hi) {
    const f32x4 c = *(const GAS f32x4*)(cosT + pos * 32 + j0), s = *(const GAS f32x4*)(sinT + pos * 32 + j0);
    lo = x1 * c - x2 * s; hi = x2 * c + x1 * s;
}
struct EpiP1 {
    static constexpr bool PERM = true, HAS_PRE = false;
    bf16_t *naq, *nak, *vt; unsigned char *cq, *ckv; bf16_t *kr; unsigned char *ga, *gb; float *ssq_q, *ssq_kv; const float *cosT, *sinT;
    __device__ __forceinline__ void operator()(const f32x4 (&acc)[2][2][4][2], const Unit& u, int wr, int wc, int fr, int fq, const LAS float* rowsc) const {
        const int row0 = u.pm * 256 + wr * 64 + fr, colu = wc * 32 + 8 * fq;
        if (u.kind == 1) {
#pragma unroll
            for (int ai = 0; ai < 2; ++ai)
#pragma unroll
                for (int m = 0; m < 4; ++m) { bf16_t* rp = vt + (size_t)(row0 + ai * 128 + m * 16) * VT_PITCH + u.pn * 256 + colu;
#pragma unroll
                    for (int bj = 0; bj < 2; ++bj) *(GAS u32x4*)(rp + bj * 128) = pack8(acc[ai][bj][m][0], acc[ai][bj][m][1]); }
            return; }
        const int pn = u.pn;
        if (pn == 28) {
            if (wc < 2) { const int j0 = 4 * (4 * wc + fq);
#pragma unroll
                for (int ai = 0; ai < 2; ++ai)
#pragma unroll
                    for (int m = 0; m < 4; ++m) { const int row = row0 + ai * 128 + m * 16; const int pos = row < MREAL ? NMETA + (row & (SEQ - 1)) : row - MREAL;
                        f32x4 lo, hi; rope4(acc[ai][0][m][0], acc[ai][0][m][1], cosT, sinT, pos, j0, lo, hi);
                        *(GAS u32x2*)(kr + (size_t)row * 64 + j0) = pack4(lo); *(GAS u32x2*)(kr + (size_t)row * 64 + 32 + j0) = pack4(hi); } }
            return; }
        if (pn >= 12) {
            unsigned char* base = pn < 20 ? ga : gb; const int colt = (pn < 20 ? pn - 12 : pn - 20) * 256 + colu;
#pragma unroll
            for (int ai = 0; ai < 2; ++ai)
#pragma unroll
                for (int m = 0; m < 4; ++m) { unsigned char* rp = base + (size_t)(row0 + ai * 128 + m * 16) * 2048 + colt;
#pragma unroll
                    for (int bj = 0; bj < 2; ++bj) { f32x4 a = acc[ai][bj][m][0], b = acc[ai][bj][m][1];
#pragma unroll
                        for (int i = 0; i < 4; ++i) { a[i] = sigmoidf_(a[i]); b[i] = sigmoidf_(b[i]); }
                        *(GAS u32x2*)(rp + bj * 128) = pack8_u8(a, b); } }
            return; }
        if (pn >= 8) {
            const bool isq = pn < 10; unsigned char* base = isq ? cq : ckv; float* ssq = isq ? ssq_q : ssq_kv; const int colt = (isq ? pn - 8 : pn - 10) * 256 + colu;
#pragma unroll
            for (int ai = 0; ai < 2; ++ai)
#pragma unroll
                for (int m = 0; m < 4; ++m) { const int row = row0 + ai * 128 + m * 16; unsigned char* rp = base + (size_t)row * 512 + colt; float s = 0.f;
#pragma unroll
                    for (int bj = 0; bj < 2; ++bj) { const f32x4 a = acc[ai][bj][m][0], b = acc[ai][bj][m][1];
                        s += (a[0] * a[0] + a[1] * a[1]) + (a[2] * a[2] + a[3] * a[3]) + (b[0] * b[0] + b[1] * b[1]) + (b[2] * b[2] + b[3] * b[3]);
                        *(GAS u32x2*)(rp + bj * 128) = pack8_fp8(a, b); }
                    s += __shfl_xor(s, 16); s += __shfl_xor(s, 32);
                    if (fq == 0) ssq[(size_t)((pn & 1) * 4 + wc) * MPAD + row] = s; }
            return; }
        {
            bf16_t* base = pn < 4 ? naq : nak; const int colt = (pn & 3) * 256 + colu;
#pragma unroll
            for (int ai = 0; ai < 2; ++ai)
#pragma unroll
                for (int m = 0; m < 4; ++m) { bf16_t* rp = base + (size_t)(row0 + ai * 128 + m * 16) * 1024 + colt;
#pragma unroll
                    for (int bj = 0; bj < 2; ++bj) *(GAS u32x4*)(rp + bj * 128) = pack8(acc[ai][bj][m][0], acc[ai][bj][m][1]); }
        }
    }
};
constexpr int P3_Q = 64 * 12, P3_KV = 65 * 16, P3_UNITS = P3_Q + P3_KV;
struct SchedP3 {
    int G, c; const char* cq; const char* ckv; const char* wuq; const char* wukv; size_t tstep;
    __device__ __forceinline__ bool next(int i, Unit& u) const {
        const int L = i * G + c; if (L >= P3_UNITS) return false;
        if (L < P3_Q) { pg8::grid_order(L, 64, 12, u.pm, u.pn); u.kind = 0; } else { pg8::grid_order(L - P3_Q, 65, 16, u.pm, u.pn); u.kind = 1; }
        return true; }
    __device__ __forceinline__ const char* pa(const Unit& u) const { return (u.kind ? ckv : cq) + (size_t)u.pm * tstep; }
    __device__ __forceinline__ const char* pb(const Unit& u) const { return (u.kind ? wukv : wuq) + (size_t)u.pn * tstep; }
};
template <int NS, int LD> __device__ __forceinline__ float rstd_slabs(const float* part, int row, float invn) {
    float s = 0.f;
#pragma unroll
    for (int i = 0; i < NS; ++i) s += part[(size_t)i * LD + row];
    return 1.0f / sqrtf(s * invn + NORM_EPS);
}
struct EpiP3 {
    static constexpr bool PERM = true, HAS_PRE = true;
    bf16_t *qm, *kn, *vv; const float *ssq_q, *ssq_kv; const float *cosT, *sinT;
    __device__ __forceinline__ void pre(const Unit& u, LAS float* sc, int tid) const { if (tid < 256) { const int row = u.pm * 256 + tid; sc[tid] = u.kind ? rstd_slabs<8, MPAD>(ssq_kv, row, 1.f / 512.f) : rstd_slabs<8, MPAD>(ssq_q, row, 1.f / 512.f); } }
    __device__ __forceinline__ void operator()(const f32x4 (&acc)[2][2][4][2], const Unit& u, int wr, int wc, int fr, int fq, const LAS float* rowsc) const {
        const int row0 = u.pm * 256 + wr * 64 + fr, colu = wc * 32 + 8 * fq;
        if (u.kind == 1) {
#pragma unroll
            for (int ai = 0; ai < 2; ++ai)
#pragma unroll
                for (int m = 0; m < 4; ++m) { const int row = row0 + ai * 128 + m * 16; const float rs = rowsc[ai * 128 + wr * 64 + m * 16 + fr];
                    const size_t off = (size_t)row * 2048 + u.pn * 128 + colu;
                    *(GAS u32x4*)(kn + off) = pack8(acc[ai][0][m][0] * rs, acc[ai][0][m][1] * rs);
                    *(GAS u32x4*)(vv + off) = pack8(acc[ai][1][m][0] * rs, acc[ai][1][m][1] * rs); }
            return; }
#pragma unroll
        for (int bj = 0; bj < 2; ++bj) { const int c8 = u.pn * 256 + bj * 128 + colu; const int hd = c8 / 192, w = c8 - hd * 192;
            if (w < 128) {
#pragma unroll
                for (int ai = 0; ai < 2; ++ai)
#pragma unroll
                    for (int m = 0; m < 4; ++m) { const int row = row0 + ai * 128 + m * 16; const float rs = rowsc[ai * 128 + wr * 64 + m * 16 + fr];
                        *(GAS u32x4*)(qm + (size_t)row * 3072 + c8) = pack8(acc[ai][bj][m][0] * rs, acc[ai][bj][m][1] * rs); }
            } else { const int j0 = (w - 128) >> 1;
#pragma unroll
                for (int ai = 0; ai < 2; ++ai)
#pragma unroll
                    for (int m = 0; m < 4; ++m) { const int row = row0 + ai * 128 + m * 16; const float rs = rowsc[ai * 128 + wr * 64 + m * 16 + fr];
                        const int pos = NMETA + (row & (SEQ - 1)); f32x4 lo, hi; rope4(acc[ai][bj][m][0] * rs, acc[ai][bj][m][1] * rs, cosT, sinT, pos, j0, lo, hi);
                        bf16_t* qp = qm + (size_t)row * 3072 + hd * 192 + 128 + j0; *(GAS u32x2*)qp = pack4(lo); *(GAS u32x2*)(qp + 32) = pack4(hi); }
            } }
    }
};
__device__ __forceinline__ void unpack8(const u32x4 w, f32x4& a, f32x4& b) { a = (f32x4){bf_lo(w.x), bf_hi(w.x), bf_lo(w.y), bf_hi(w.y)}; b = (f32x4){bf_lo(w.z), bf_hi(w.z), bf_lo(w.w), bf_hi(w.w)}; }
struct EpiP5a {
    static constexpr bool PERM = true, HAS_PRE = false;
    const unsigned char* ga; unsigned char* t1;
    __device__ __forceinline__ void operator()(const f32x4 (&acc)[2][2][4][2], const Unit& u, int wr, int wc, int fr, int fq, const LAS float* rowsc) const {
        const int row0 = u.pm * 256 + wr * 64 + fr, col0 = u.pn * 256 + wc * 32 + 8 * fq;
#pragma unroll
        for (int ai = 0; ai < 2; ++ai)
#pragma unroll
            for (int m = 0; m < 4; ++m) { const size_t off = (size_t)(row0 + ai * 128 + m * 16) * 2048 + col0;
#pragma unroll
                for (int bj = 0; bj < 2; ++bj) { f32x4 g0, g1; unpack8_u8(*(const GAS u32x2*)(ga + off + bj * 128), g0, g1);
                    *(GAS u32x2*)(t1 + off + bj * 128) = pack8_fp8(acc[ai][bj][m][0] * g0 * 32.f, acc[ai][bj][m][1] * g1 * 32.f); } }
    }
};
struct EpiP5b {
    static constexpr bool PERM = true, HAS_PRE = false;
    const unsigned char* gb; const unsigned char* t1; unsigned char* merged;
    __device__ __forceinline__ void operator()(const f32x4 (&acc)[2][2][4][2], const Unit& u, int wr, int wc, int fr, int fq, const LAS float* rowsc) const {
        const int row0 = u.pm * 256 + wr * 64 + fr, col0 = u.pn * 256 + wc * 32 + 8 * fq;
#pragma unroll
        for (int ai = 0; ai < 2; ++ai)
#pragma unroll
            for (int m = 0; m < 4; ++m) { const size_t off = (size_t)(row0 + ai * 128 + m * 16) * 2048 + col0;
#pragma unroll
                for (int bj = 0; bj < 2; ++bj) { f32x4 g0, g1; unpack8_u8(*(const GAS u32x2*)(gb + off + bj * 128), g0, g1);
                    f32x4 a, b; unpack8_fp8(*(const GAS u32x2*)(t1 + off + bj * 128), a, b);
                    *(GAS u32x2*)(merged + off + bj * 128) = pack8_fp8(a + acc[ai][bj][m][0] * g0 * 32.f, b + acc[ai][bj][m][1] * g1 * 32.f); } }
    }
};
struct EpiP6 {
    static constexpr bool PERM = true, HAS_PRE = false;
    const float* x; bf16_t* h2b; float* ssq2;
    __device__ __forceinline__ void operator()(const f32x4 (&acc)[2][2][4][2], const Unit& u, int wr, int wc, int fr, int fq, const LAS float* rowsc) const {
        const int row0 = u.pm * 256 + wr * 64 + fr, col0 = u.pn * 256 + wc * 32 + 8 * fq;
#pragma unroll
        for (int ai = 0; ai < 2; ++ai)
#pragma unroll
            for (int m = 0; m < 4; ++m) { const int row = row0 + ai * 128 + m * 16; const size_t off = (size_t)row * 2048 + col0; float s = 0.f;
#pragma unroll
                for (int bj = 0; bj < 2; ++bj) { const f32x4 a = *(const GAS f32x4*)(x + off + bj * 128) + acc[ai][bj][m][0], b = *(const GAS f32x4*)(x + off + bj * 128 + 4) + acc[ai][bj][m][1];
                    s += (a[0] * a[0] + a[1] * a[1]) + (a[2] * a[2] + a[3] * a[3]) + (b[0] * b[0] + b[1] * b[1]) + (b[2] * b[2] + b[3] * b[3]);
                    *(GAS u32x4*)(h2b + off + bj * 128) = pack8(a, b); }
                s += __shfl_xor(s, 16); s += __shfl_xor(s, 32);
                if (fq == 0) ssq2[(size_t)(u.pn * 4 + wc) * MREAL + row] = s; }
    }
};
struct EpiP7 {
    static constexpr bool PERM = true, HAS_PRE = true;
    const float* ssq2; _Float16* sc;
    __device__ __forceinline__ void pre(const Unit& u, LAS float* sc, int tid) const { if (tid < 256) sc[tid] = rstd_slabs<32, MREAL>(ssq2, u.pm * 256 + tid, 1.f / 2048.f); }
    __device__ __forceinline__ void operator()(const f32x4 (&acc)[2][2][4][2], const Unit& u, int wr, int wc, int fr, int fq, const LAS float* rowsc) const {
        typedef _Float16 h4_t __attribute__((ext_vector_type(4)));
        const int row0 = u.pm * 256 + wr * 64 + fr, col0 = u.pn * 256 + wc * 32 + 8 * fq;
#pragma unroll
        for (int ai = 0; ai < 2; ++ai)
#pragma unroll
            for (int m = 0; m < 4; ++m) { const int row = row0 + ai * 128 + m * 16; const float rs = rowsc[ai * 128 + wr * 64 + m * 16 + fr]; const size_t off = (size_t)row * 2048 + col0;
#pragma unroll
                for (int bj = 0; bj < 2; ++bj) { const h4_t lo = __builtin_convertvector(acc[ai][bj][m][0] * rs, h4_t), hi = __builtin_convertvector(acc[ai][bj][m][1] * rs, h4_t);
                    const u32x2 wl = __builtin_bit_cast(u32x2, lo), wh = __builtin_bit_cast(u32x2, hi);
                    *(GAS u32x4*)(sc + off + bj * 128) = (u32x4){wl.x, wl.y, wh.x, wh.y}; } }
    }
};
namespace att {
#define KSWZ(row, colB) ((row) * 256 + ((colB) ^ (((row) & 7) << 4)))
#define KRSWZ(row, colB) ((row) * 128 + ((colB) ^ ((((row) >> 1) & 7) << 4)))
constexpr float L2E = 1.4426950408889634f;
template <int DUMMY = 0>
__device__ __forceinline__ void partialSM(f32x16& p0, f32x16& p1, float& m_reg, float& mn, float& alpha, const float C, const float THRS) {
  float pmax = p0[0];
#pragma unroll
  for (int r = 1; r < 16; ++r) pmax = fmaxf(pmax, p0[r]);
#pragma unroll
  for (int r = 0; r < 16; ++r) pmax = fmaxf(pmax, p1[r]);
  { auto rr = __builtin_amdgcn_permlane32_swap(__float_as_uint(pmax), __float_as_uint(pmax), false, false);
    pmax = fmaxf(__uint_as_float(rr[0]), __uint_as_float(rr[1])); }
  if (__builtin_expect(__all(pmax - m_reg <= THRS), 1)) { mn = m_reg; alpha = 1.f; }
  else { mn = fmaxf(m_reg, pmax); alpha = __builtin_amdgcn_exp2f((m_reg - mn) * C); m_reg = mn; }
  const float mnC = -mn * C;
#pragma unroll
  for (int r = 0; r < 16; ++r) p0[r] = fmaf(p0[r], C, mnC);
#pragma unroll
  for (int r = 0; r < 16; ++r) p1[r] = fmaf(p1[r], C, mnC);
#pragma unroll
  for (int r = 0; r < 16; ++r) p0[r] = __builtin_amdgcn_exp2f(p0[r]);
}
__device__ __forceinline__ void finishSM(f32x16& p0, f32x16& p1, float alpha, float& l_reg, bf16x8& pa0, bf16x8& pa1, bf16x8& pa2, bf16x8& pa3) {
#pragma unroll
  for (int r = 0; r < 16; ++r) p1[r] = __builtin_amdgcn_exp2f(p1[r]);
  float ps = 0;
#pragma unroll
  for (int r = 0; r < 16; ++r) ps += p0[r];
#pragma unroll
  for (int r = 0; r < 16; ++r) ps += p1[r];
  { auto rr = __builtin_amdgcn_permlane32_swap(__float_as_uint(ps), __float_as_uint(ps), false, false);
    ps = __uint_as_float(rr[0]) + __uint_as_float(rr[1]); }
  l_reg = l_reg * alpha + ps;
#define PK4(P, BASE, OUT) do { unsigned a0 = cvt_pk_bf16(P[BASE + 0], P[BASE + 1]), a1 = cvt_pk_bf16(P[BASE + 2], P[BASE + 3]);   \
    unsigned b0 = cvt_pk_bf16(P[BASE + 4], P[BASE + 5]), b1 = cvt_pk_bf16(P[BASE + 6], P[BASE + 7]);                              \
    auto r0 = __builtin_amdgcn_permlane32_swap(a0, b0, false, false); auto r1 = __builtin_amdgcn_permlane32_swap(a1, b1, false, false); \
    u32x4 w = {r0[0], r1[0], r0[1], r1[1]}; OUT = __builtin_bit_cast(bf16x8, w); } while (0)
  PK4(p0, 0, pa0); PK4(p0, 8, pa1); PK4(p1, 0, pa2); PK4(p1, 8, pa3);
#undef PK4
}
constexpr int NW = 8, QBLK = 32, KVBLK = 64;
constexpr float MLA_SCALE = 0.07216878364870322f;
constexpr float MLA_THR = 8.f;
constexpr int SHM_V = KVBLK * 128 * 2, SHM_KN = KVBLK * 128 * 2, SHM_KR = KVBLK * 64 * 2;
constexpr int OFF_V = 0, OFF_KN = 2 * SHM_V, OFF_KR = OFF_KN + 2 * SHM_KN, OFF_WS = OFF_KR + 2 * SHM_KR, OFF_QR = OFF_WS + NW * 64 * 4, MLA_LDS = OFF_QR + NW * 4096;
__device__ __forceinline__ void qkt(f32x16& p0, f32x16& p1, const LAS char* Kn, const LAS char* Kr, const bf16x8* qr, const LAS char* qrp, const int* kb, const int* krb) {
  p0 = f32x16{}; p1 = f32x16{};
#pragma unroll
  for (int d0 = 0; d0 < 8; ++d0) {
    const bf16x8 b0 = *(const LAS bf16x8*)(Kn + kb[d0 & 3] + (d0 >> 2) * 128);
    const bf16x8 b1 = *(const LAS bf16x8*)(Kn + kb[d0 & 3] + (d0 >> 2) * 128 + 8192);
    p0 = __builtin_amdgcn_mfma_f32_32x32x16_bf16(b0, qr[d0], p0, 0, 0, 0);
    p1 = __builtin_amdgcn_mfma_f32_32x32x16_bf16(b1, qr[d0], p1, 0, 0, 0); }
#pragma unroll
  for (int d0 = 0; d0 < 4; ++d0) {
    const bf16x8 b0 = *(const LAS bf16x8*)(Kr + krb[d0]);
    const bf16x8 b1 = *(const LAS bf16x8*)(Kr + krb[d0] + 4096);
    const bf16x8 qf = *(const LAS bf16x8*)(qrp + d0 * 1024);
    p0 = __builtin_amdgcn_mfma_f32_32x32x16_bf16(b0, qf, p0, 0, 0, 0);
    p1 = __builtin_amdgcn_mfma_f32_32x32x16_bf16(b1, qf, p1, 0, 0, 0); }
}
__device__ __forceinline__ int v_st(int k, int c) { const int kk = (k & ~0xC) | ((k & 4) << 1) | ((k & 8) >> 1); return ((kk >> 3) * 4 + (c >> 5)) * 512 + ((kk & 7) * 32 + (c & 31)) * 2; }
__device__ __forceinline__ int v_rd_base(int lane) { return ((lane & 3) << 3) | (((lane >> 2) & 3) << 6) | (((lane >> 4) & 1) << 5) | (((lane >> 5) & 1) << 8); }
constexpr int v_rd_off(int d0, int ks, int half) { return d0 * 512 + ks * 4096 + half * 2048; }
template <int OFF> __device__ __forceinline__ s16x4 tr_read(int vb) {
  s16x4 r; asm volatile("ds_read_b64_tr_b16 %0, %1 offset:%2" : "=&v"(r) : "v"(vb), "i"(OFF) : "memory"); return r;
}
template <int D0> __device__ __forceinline__ void pv_one(f32x16& od, int vb, bf16x8 pa0, bf16x8 pa1, bf16x8 pa2, bf16x8 pa3) {
  const s16x4 l0 = tr_read<v_rd_off(D0, 0, 0)>(vb), h0 = tr_read<v_rd_off(D0, 0, 1)>(vb), l1 = tr_read<v_rd_off(D0, 1, 0)>(vb), h1 = tr_read<v_rd_off(D0, 1, 1)>(vb);
  const s16x4 l2 = tr_read<v_rd_off(D0, 2, 0)>(vb), h2 = tr_read<v_rd_off(D0, 2, 1)>(vb), l3 = tr_read<v_rd_off(D0, 3, 0)>(vb), h3 = tr_read<v_rd_off(D0, 3, 1)>(vb);
  asm volatile("s_waitcnt lgkmcnt(0)" ::: "memory"); SBAR();
#define PK(L, H) (bf16x8){L[0], L[1], L[2], L[3], H[0], H[1], H[2], H[3]}
  od = __builtin_amdgcn_mfma_f32_32x32x16_bf16(pa0, PK(l0, h0), od, 0, 0, 0);
  od = __builtin_amdgcn_mfma_f32_32x32x16_bf16(pa1, PK(l1, h1), od, 0, 0, 0);
  od = __builtin_amdgcn_mfma_f32_32x32x16_bf16(pa2, PK(l2, h2), od, 0, 0, 0);
  od = __builtin_amdgcn_mfma_f32_32x32x16_bf16(pa3, PK(l3, h3), od, 0, 0, 0);
#undef PK
}
__device__ __forceinline__ void pv_d0(f32x16* o, int vb, bf16x8 pa0, bf16x8 pa1, bf16x8 pa2, bf16x8 pa3) {
  pv_one<0>(o[0], vb, pa0, pa1, pa2, pa3); pv_one<1>(o[1], vb, pa0, pa1, pa2, pa3); pv_one<2>(o[2], vb, pa0, pa1, pa2, pa3); pv_one<3>(o[3], vb, pa0, pa1, pa2, pa3);
}
__device__ __forceinline__ void mla_unit(int b, int h, int qb, const bf16_t* __restrict__ QM, const bf16_t* __restrict__ KN, const bf16_t* __restrict__ KR, const bf16_t* __restrict__ VV, unsigned char* __restrict__ OM, LAS char* lds) {
  const int tid = threadIdx.x, wid = tid >> 6, lane = tid & 63, r32 = lane & 31, hi = lane >> 5;
  constexpr float C = MLA_SCALE * L2E, THRS = MLA_THR / MLA_SCALE;
  constexpr int NT = 33;
  LAS char* V_lds = lds + OFF_V; LAS char* Kn_lds = lds + OFF_KN; LAS char* Kr_lds = lds + OFF_KR;
  LAS float* ws = (LAS float*)(lds + OFF_WS) + wid * 64; LAS float* li_l = ws; LAS float* al_l = ws + 32;
  float m_reg = -1e30f, l_reg = 0; f32x16 o[4] = {}; bf16x8 qr[8];
  LAS char* qrp = lds + OFF_QR + wid * 4096 + lane * 16;
  const int qrow = b * SEQ + qb * 256 + wid * QBLK + r32;
  const bf16_t* Qw = QM + (size_t)qrow * 3072 + h * 192 + hi * 8;
#pragma unroll
  for (int d0 = 0; d0 < 8; ++d0) qr[d0] = *(const GAS bf16x8*)(Qw + d0 * 16);
  __syncthreads();
#pragma unroll
  for (int d0 = 0; d0 < 4; ++d0) *(LAS bf16x8*)(qrp + d0 * 1024) = *(const GAS bf16x8*)(Qw + (8 + d0) * 16);
  const int sr = tid >> 4, sc = (tid & 15) * 8, vst0 = v_st(sr, sc), vst1 = v_st(32 + sr, sc);
  const int krr = tid >> 3, krc = (tid & 7) * 8;
  const int vb0 = (int)(uintptr_t)V_lds + v_rd_base(lane);
  bf16x8 s_v0, s_v1, s_k0, s_k1, s_kr;
  const int realbase = b * SEQ - KVBLK;
  const unsigned voff = (unsigned)(sr * 2048 + sc) * 2u, kroff = (unsigned)(krr * 64 + krc) * 2u;
  int kb[4], krb[4];
#pragma unroll
  for (int bq = 0; bq < 4; ++bq) { kb[bq] = KSWZ(r32, bq * 32 + hi * 16); krb[bq] = KRSWZ(r32, bq * 32 + hi * 16); }
#define TROW(t) ((t) == 0 ? MREAL : realbase + (t) * KVBLK)
#define SLOAD(t) do { const int k0_ = TROW(t); const size_t ro_ = ((size_t)k0_ * 2048 + h * 128) * 2; \
    const GAS char* vb_ = (const GAS char*)VV + ro_; const GAS char* nb_ = (const GAS char*)KN + ro_; const GAS char* rb_ = (const GAS char*)KR + (size_t)k0_ * 128; \
    s_v0 = *(const GAS bf16x8*)(vb_ + voff); s_v1 = *(const GAS bf16x8*)(vb_ + 32 * 4096 + voff); \
    s_k0 = *(const GAS bf16x8*)(nb_ + voff); s_k1 = *(const GAS bf16x8*)(nb_ + 32 * 4096 + voff); \
    s_kr = *(const GAS bf16x8*)(rb_ + kroff); } while (0)
#define SWRITE(bf) do { *(LAS bf16x8*)(V_lds + (bf) * SHM_V + vst0) = s_v0; *(LAS bf16x8*)(V_lds + (bf) * SHM_V + vst1) = s_v1; const int kc_ = sc * 2; \
    *(LAS bf16x8*)(Kn_lds + (bf) * SHM_KN + KSWZ(sr, kc_)) = s_k0; *(LAS bf16x8*)(Kn_lds + (bf) * SHM_KN + KSWZ(32 + sr, kc_)) = s_k1; \
    *(LAS bf16x8*)(Kr_lds + (bf) * SHM_KR + KRSWZ(krr, krc * 2)) = s_kr; } while (0)
#define SWAIT() asm volatile("s_waitcnt vmcnt(0)" ::: "memory")
#define RESC(a) do { if (__any((a) < 1.f)) { if (hi == 0) al_l[r32] = (a); asm volatile("s_waitcnt lgkmcnt(0)" ::: "memory"); \
    _Pragma("unroll") for (int d = 0; d < 4; ++d) _Pragma("unroll") for (int r = 0; r < 16; ++r) o[d][r] *= al_l[crow(r, hi)]; } } while (0)
  f32x16 pA0, pA1, pB0, pB1; float mnA, mnB, alA, alB; bf16x8 pa0, pa1, pa2, pa3;
  SLOAD(0); SWAIT(); SWRITE(0); __syncthreads();
  qkt(pA0, pA1, Kn_lds, Kr_lds, qr, qrp, kb, krb);
  { const float NEG = -INFINITY;
#pragma unroll
    for (int r = 8; r < 16; ++r) pA0[r] = NEG;
#pragma unroll
    for (int r = 0; r < 16; ++r) pA1[r] = NEG; }
  partialSM(pA0, pA1, m_reg, mnA, alA, C, THRS);
  SLOAD(1); SWAIT(); SWRITE(1); __syncthreads();
  for (int j = 1; j + 1 < NT; j += 2) {
    SBAR(); qkt(pB0, pB1, Kn_lds + SHM_KN, Kr_lds + SHM_KR, qr, qrp, kb, krb);
    finishSM(pA0, pA1, alA, l_reg, pa0, pa1, pa2, pa3); SBAR();
    SLOAD(j + 1); SBAR();
    pv_d0(o, vb0, pa0, pa1, pa2, pa3); partialSM(pB0, pB1, m_reg, mnB, alB, C, THRS);
    __syncthreads(); SWAIT(); SWRITE(0);
    RESC(alB); __syncthreads();
    SBAR(); qkt(pA0, pA1, Kn_lds, Kr_lds, qr, qrp, kb, krb);
    finishSM(pB0, pB1, alB, l_reg, pa0, pa1, pa2, pa3); SBAR();
    if (j + 2 < NT) SLOAD(j + 2); SBAR();
    pv_d0(o, vb0 + SHM_V, pa0, pa1, pa2, pa3); partialSM(pA0, pA1, m_reg, mnA, alA, C, THRS);
    __syncthreads(); if (j + 2 < NT) { SWAIT(); SWRITE(1); }
    RESC(alA); __syncthreads();
  }
  finishSM(pA0, pA1, alA, l_reg, pa0, pa1, pa2, pa3); SBAR();
  pv_d0(o, vb0, pa0, pa1, pa2, pa3);
  if (hi == 0) li_l[r32] = l_reg; asm volatile("s_waitcnt lgkmcnt(0)" ::: "memory");
  float rli[16];
#pragma unroll
  for (int r = 0; r < 16; ++r) rli[r] = __builtin_amdgcn_rcpf(li_l[crow(r, hi)]);
  unsigned char* Ow = OM + (size_t)(b * SEQ + qb * 256 + wid * QBLK) * 2048 + h * 128;
#pragma unroll
  for (int r = 0; r < 16; ++r) { const int orow = crow(r, hi);
#pragma unroll
    for (int d0 = 0; d0 < 4; ++d0) Ow[(size_t)orow * 2048 + d0 * 32 + r32] = f32_to_fp8(o[d0][r] * rli[r] * 32.f); }
#undef TROW
#undef SLOAD
#undef SWRITE
#undef SWAIT
#undef RESC
}
__device__ __forceinline__ void na_task(int task, const bf16_t* __restrict__ NAQ, const bf16_t* __restrict__ NAK, const bf16_t* __restrict__ VT, unsigned char* __restrict__ ONA,
                                        const LAS float* relb, const LAS float* metab, LAS float* wsf, int lane, Conv& cv) {
  const int r32 = lane & 31, hi = lane >> 5;
  const int half = task & 1, r = (task >> 1) & 31, h = (task >> 6) & 15, b = task >> 10;
  const int qc = half * 32 + r32;
  const int cs = min(max(qc - 8, 0), 48), rs = min(max(r - 4, 0), 24);
  const int qtok = b * SEQ + r * 64 + qc;
  constexpr float C = L2E, THRS = 8.f, SCALE = 0.125f;
  bf16x8 qr[4];
#pragma unroll
  for (int d0 = 0; d0 < 4; ++d0) qr[d0] = *(const GAS bf16x8*)(NAQ + (size_t)qtok * 1024 + h * 64 + d0 * 16 + hi * 8);
  float m_reg = -1e30f, l_reg = 0.f; f32x16 o[2] = {};
  LAS float* al_l = wsf; LAS float* li_l = wsf + 32;
  const float NEG = -INFINITY;
  const int kb0 = half * 16;
  const unsigned long long wm = 0xFFFFull << (cs - kb0);
  const unsigned mh0 = (unsigned)wm >> (4 * hi), mh1 = (unsigned)(wm >> 32) >> (4 * hi);
  const bf16_t* kq = NAK + (size_t)r32 * 1024 + h * 64 + hi * 8;
  const bf16_t* kq2 = NAK + (size_t)(32 + (r32 & 15)) * 1024 + h * 64 + hi * 8;
  const bf16_t* vq = VT + (size_t)(h * 64 + r32) * VT_PITCH + 8 * hi;
#define NA_KTOK(w) ((w) == 8 ? MREAL : b * SEQ + (rs + (w)) * 64 + kb0)
#define NA_LOADK(KF, w) do { const size_t ko_ = (size_t)NA_KTOK(w) * 1024; _Pragma("unroll") for (int d0 = 0; d0 < 4; ++d0) { KF[d0] = *(const GAS bf16x8*)(kq + ko_ + d0 * 16); KF[4 + d0] = *(const GAS bf16x8*)(kq2 + ko_ + d0 * 16); } } while (0)
#define NA_TILE(KF, w, YN) do { \
    bf16x8 vf[6]; { const bf16_t* vp_ = vq + NA_KTOK(w); _Pragma("unroll") for (int ks = 0; ks < 3; ++ks) { vf[ks] = *(const GAS bf16x8*)(vp_ + 16 * ks); vf[3 + ks] = *(const GAS bf16x8*)(vp_ + (size_t)32 * VT_PITCH + 16 * ks); } } \
    f32x16 p0 = {}, p1 = {}; \
    _Pragma("unroll") for (int d0 = 0; d0 < 4; ++d0) { p0 = __builtin_amdgcn_mfma_f32_32x32x16_bf16(KF[d0], qr[d0], p0, 0, 0, 0); p1 = __builtin_amdgcn_mfma_f32_32x32x16_bf16(KF[4 + d0], qr[d0], p1, 0, 0, 0); } \
    if ((w) + 1 < 9) NA_LOADK(KF, (w) + 1);            \
    asm volatile("" ::: "memory"); conv_step<YN>(cv, lane);     \
    if ((w) < 8) { const LAS float* bp_ = relb + ((h * 15 + (rs + (w) - r + 7)) * 31 + 15 - qc + 4 * hi + kb0);     \
      float bv0[16], bv1[8];        \
      _Pragma("unroll") for (int rg = 0; rg < 16; ++rg) { const int c_ = (rg & 3) + 8 * (rg >> 2); bv0[rg] = bp_[c_]; if (rg < 8) bv1[rg] = bp_[c_ + 32]; } \
      _Pragma("unroll") for (int rg = 0; rg < 16; ++rg) { asm volatile("" : "+v"(bv0[rg])); if (rg < 8) asm volatile("" : "+v"(bv1[rg])); } \
      _Pragma("unroll") for (int rg = 0; rg < 16; ++rg) { const int c_ = (rg & 3) + 8 * (rg >> 2); \
        { const bool ok = (mh0 >> c_) & 1u; p0[rg] = ok ? fmaf(p0[rg], SCALE, bv0[rg]) : NEG; } \
        if (rg < 8) { const bool ok = (mh1 >> c_) & 1u; p1[rg] = ok ? fmaf(p1[rg], SCALE, bv1[rg]) : NEG; } } \
    } else { const LAS float* bp = metab + h * 16; \
      _Pragma("unroll") for (int rg = 0; rg < 16; ++rg) { const int kc = crow(rg, hi); p0[rg] = (rg < 8) ? fmaf(p0[rg], SCALE, bp[kc & 15]) : NEG; if (rg < 8) p1[rg] = NEG; } } \
      \
    float pmax = p0[0]; \
    _Pragma("unroll") for (int rg = 1; rg < 16; ++rg) pmax = fmaxf(pmax, p0[rg]); \
    _Pragma("unroll") for (int rg = 0; rg < 8; ++rg) pmax = fmaxf(pmax, p1[rg]); \
    { auto rr = __builtin_amdgcn_permlane32_swap(__float_as_uint(pmax), __float_as_uint(pmax), false, false); pmax = fmaxf(__uint_as_float(rr[0]), __uint_as_float(rr[1])); } \
    float mn, alpha; \
    if (__builtin_expect(__all(pmax - m_reg <= THRS), 1)) { mn = m_reg; alpha = 1.f; } \
    else { mn = fmaxf(m_reg, pmax); alpha = __builtin_amdgcn_exp2f((m_reg - mn) * C); m_reg = mn; } \
    const float mnC = -mn * C; float ps = 0.f; \
    _Pragma("unroll") for (int rg = 0; rg < 16; ++rg) { p0[rg] = __builtin_amdgcn_exp2f(fmaf(p0[rg], C, mnC)); ps += p0[rg]; } \
    _Pragma("unroll") for (int rg = 0; rg < 8; ++rg) { p1[rg] = __builtin_amdgcn_exp2f(fmaf(p1[rg], C, mnC)); ps += p1[rg]; } \
    { auto rr = __builtin_amdgcn_permlane32_swap(__float_as_uint(ps), __float_as_uint(ps), false, false); ps = __uint_as_float(rr[0]) + __uint_as_float(rr[1]); } \
    l_reg = l_reg * alpha + ps; \
    bf16x8 pa0, pa1, pa2; NA_PK4(p0, 0, pa0); NA_PK4(p0, 8, pa1); NA_PK4(p1, 0, pa2); \
    if (__any(alpha < 1.f)) { if (hi == 0) al_l[r32] = alpha; asm volatile("s_waitcnt lgkmcnt(0)" ::: "memory"); \
      _Pragma("unroll") for (int d = 0; d < 2; ++d) _Pragma("unroll") for (int rg = 0; rg < 16; ++rg) o[d][rg] *= al_l[crow(rg, hi)]; } \
    _Pragma("unroll") for (int d0 = 0; d0 < 2; ++d0) { \
      o[d0] = __builtin_amdgcn_mfma_f32_32x32x16_bf16(pa0, vf[3 * d0 + 0], o[d0], 0, 0, 0); o[d0] = __builtin_amdgcn_mfma_f32_32x32x16_bf16(pa1, vf[3 * d0 + 1], o[d0], 0, 0, 0); \
      o[d0] = __builtin_amdgcn_mfma_f32_32x32x16_bf16(pa2, vf[3 * d0 + 2], o[d0], 0, 0, 0); } } while (0)
#define NA_PK4(P, BASE, OUT) do { unsigned a0 = cvt_pk_bf16(P[BASE + 0], P[BASE + 1]), a1 = cvt_pk_bf16(P[BASE + 2], P[BASE + 3]);   \
    unsigned b0 = cvt_pk_bf16(P[BASE + 4], P[BASE + 5]), b1 = cvt_pk_bf16(P[BASE + 6], P[BASE + 7]);                              \
    auto r0 = __builtin_amdgcn_permlane32_swap(a0, b0, false, false); auto r1 = __builtin_amdgcn_permlane32_swap(a1, b1, false, false); \
    u32x4 w_ = {r0[0], r1[0], r0[1], r1[1]}; OUT = __builtin_bit_cast(bf16x8, w_); } while (0)
  { bf16x8 kA[8];
    NA_LOADK(kA, 0);
#pragma unroll 1
    for (int w = 0; w < 8; ++w) { NA_TILE(kA, w, 14); }
    NA_TILE(kA, 8, 6); }
#undef NA_PK4
#undef NA_KTOK
#undef NA_LOADK
#undef NA_TILE
  if (hi == 0) li_l[r32] = l_reg; asm volatile("s_waitcnt lgkmcnt(0)" ::: "memory");
  unsigned char* Ow = ONA + (size_t)(b * SEQ + r * 64 + half * 32) * 1024 + h * 64;
#pragma unroll
  for (int rg = 0; rg < 16; ++rg) { const int orow = crow(rg, hi); const float rl = __builtin_amdgcn_rcpf(li_l[orow]);
#pragma unroll
    for (int d0 = 0; d0 < 2; ++d0) Ow[(size_t)orow * 1024 + d0 * 32 + r32] = f32_to_fp8(o[d0][rg] * rl * 16.f); }
  asm volatile("s_waitcnt lgkmcnt(0)" ::: "memory");
}
}
namespace peer {
constexpr int CH = 32;
constexpr int OFF_TV = 0, OFF_TI = OFF_TV + CH * 16 * 16 * 4, OFF_SE = OFF_TI + CH * 16 * 16 * 4, OFF_SG = OFF_SE + CH * 128 * 4, OFF_SE2 = OFF_SG + CH * 128 * 4, OFF_SG2 = OFF_SE2 + CH * 128 * 4, PEER_LDS = OFF_SG2 + CH * 128 * 4;
static_assert(PEER_LDS <= RING_BYTES, "PEER LDS");
__device__ __forceinline__ float gelu_tanh(float x) {
    const float u = 0.7978845608028654f * (x + 0.044715f * x * x * x);
    const float e = __builtin_amdgcn_exp2f(-2.f * 1.4426950408889634f * fabsf(u));
    const float t = (1.f - e) * __builtin_amdgcn_rcpf(1.f + e);
    return 0.5f * x * (1.f + (u < 0.f ? -t : t));
}
__device__ __forceinline__ void fmac1(float& acc, float a, float b) { asm("v_fmac_f32_e32 %0, %1, %2" : "+v"(acc) : "v"(a), "v"(b)); }
#define PEER_INSERT(x_, xi_) do { float x__ = (x_); int xi__ = (xi_); \
    _Pragma("unroll") for (int j_ = 0; j_ < 16; ++j_) { const bool gt_ = x__ > tv[j_]; const float tvo_ = tv[j_]; const int tio_ = ti[j_]; \
        tv[j_] = gt_ ? x__ : tvo_; ti[j_] = gt_ ? xi__ : tio_; x__ = gt_ ? tvo_ : x__; xi__ = gt_ ? tio_ : xi__; } } while (0)

#define PEER_AUX 0
typedef __amdgpu_buffer_rsrc_t rsrc_t;
__device__ __forceinline__ rsrc_t mk_rsrc(const void* p, unsigned bytes) { return __builtin_amdgcn_make_buffer_rsrc((void*)p, 0, bytes, 0x00020000); }
__device__ __forceinline__ u32x4 ldb128(rsrc_t r, unsigned off) { return __builtin_amdgcn_raw_buffer_load_b128(r, off, 0, PEER_AUX); }
typedef unsigned v6u_t __attribute__((ext_vector_type(6)));
typedef float v32f_t __attribute__((ext_vector_type(32)));
typedef float v16f_t __attribute__((ext_vector_type(16)));
__device__ __forceinline__ u32x2 ldb64(rsrc_t r, unsigned off) { return __builtin_amdgcn_raw_buffer_load_b64(r, off, 0, PEER_AUX); }
__device__ __forceinline__ f32x4 ldf128(rsrc_t r, unsigned off) { return __builtin_bit_cast(f32x4, __builtin_amdgcn_raw_buffer_load_b128(r, off, 0, PEER_AUX)); }
__device__ __forceinline__ f32x4 ldf128_nt(rsrc_t r, unsigned off) { return __builtin_bit_cast(f32x4, __builtin_amdgcn_raw_buffer_load_b128(r, off, 0, 2)); }
__device__ __forceinline__ void peer_select(int chunk, const _Float16* __restrict__ SC, LAS char* lds, int tid, LAS int* SE, LAS float* SG) {
    LAS float* TV = (LAS float*)(lds + OFF_TV); LAS int* TI = (LAS int*)(lds + OFF_TI);
    asm volatile("" : "+v"(tid));
    const int tok0 = chunk * CH;
    const rsrc_t rSC = mk_rsrc(SC, 0x4000000u);
    __syncthreads();
    { const int tl = tid >> 4, g = tid & 15; const unsigned spo = ((unsigned)(tok0 + tl) * 2048u + (unsigned)g * 128u) * 2u;
      int tk[16];
#pragma unroll
      for (int j = 0; j < 16; ++j) tk[j] = (int)0x80000000;
#define PEER_KEY(x_, lowbits_, mask_) ({ const int f_ = __float_as_int(x_); ((f_ ^ ((f_ >> 31) & 0x7fffffff)) & ~(mask_)) | (lowbits_); })
#define PEER_INS(key_) do { int x__ = (key_); _Pragma("unroll") for (int j_ = 0; j_ < 16; ++j_) { const int hi_ = max(x__, tk[j_]); x__ = min(x__, tk[j_]); tk[j_] = hi_; } } while (0)
      typedef _Float16 h8_t __attribute__((ext_vector_type(8)));
#define PEER_CX(a_, b_) do { const int hi_ = max(a_, b_), lo_ = min(a_, b_); a_ = hi_; b_ = lo_; } while (0)
      u32x4 na = __builtin_amdgcn_raw_buffer_load_b128(rSC, spo, 0, 2), nb = __builtin_amdgcn_raw_buffer_load_b128(rSC, spo + 16, 0, 2);
#pragma unroll 1
      for (int i = 0; i < 16; i += 2) { const h8_t a = __builtin_bit_cast(h8_t, na), b = __builtin_bit_cast(h8_t, nb);
          { const unsigned on = spo + (unsigned)min(i + 2, 14) * 16u; na = __builtin_amdgcn_raw_buffer_load_b128(rSC, on, 0, 2); nb = __builtin_amdgcn_raw_buffer_load_b128(rSC, on + 16, 0, 2); }
          int kk[16];
#pragma unroll
          for (int e = 0; e < 8; ++e) { kk[e] = PEER_KEY((float)a[e], 127 - (8 * i + e), 127); kk[8 + e] = PEER_KEY((float)b[e], 127 - (8 * i + 8 + e), 127); }
          PEER_CX(kk[0], kk[13]); PEER_CX(kk[1], kk[12]); PEER_CX(kk[2], kk[15]); PEER_CX(kk[3], kk[14]); PEER_CX(kk[4], kk[8]); PEER_CX(kk[5], kk[6]); PEER_CX(kk[7], kk[11]); PEER_CX(kk[9], kk[10]); PEER_CX(kk[0], kk[5]); PEER_CX(kk[1], kk[7]); PEER_CX(kk[2], kk[9]); PEER_CX(kk[3], kk[4]); PEER_CX(kk[6], kk[13]); PEER_CX(kk[8], kk[14]); PEER_CX(kk[10], kk[15]); PEER_CX(kk[11], kk[12]); PEER_CX(kk[0], kk[1]); PEER_CX(kk[2], kk[3]); PEER_CX(kk[4], kk[5]); PEER_CX(kk[6], kk[8]); PEER_CX(kk[7], kk[9]); PEER_CX(kk[10], kk[11]); PEER_CX(kk[12], kk[13]); PEER_CX(kk[14], kk[15]); PEER_CX(kk[0], kk[2]); PEER_CX(kk[1], kk[3]); PEER_CX(kk[4], kk[10]); PEER_CX(kk[5], kk[11]); PEER_CX(kk[6], kk[7]); PEER_CX(kk[8], kk[9]); PEER_CX(kk[12], kk[14]); PEER_CX(kk[13], kk[15]); PEER_CX(kk[1], kk[2]); PEER_CX(kk[3], kk[12]); PEER_CX(kk[4], kk[6]); PEER_CX(kk[5], kk[7]); PEER_CX(kk[8], kk[10]); PEER_CX(kk[9], kk[11]); PEER_CX(kk[13], kk[14]); PEER_CX(kk[1], kk[4]); PEER_CX(kk[2], kk[6]); PEER_CX(kk[5], kk[8]); PEER_CX(kk[7], kk[10]); PEER_CX(kk[9], kk[13]); PEER_CX(kk[11], kk[14]); PEER_CX(kk[2], kk[4]); PEER_CX(kk[3], kk[6]); PEER_CX(kk[9], kk[12]); PEER_CX(kk[11], kk[13]); PEER_CX(kk[3], kk[5]); PEER_CX(kk[6], kk[8]); PEER_CX(kk[7], kk[9]); PEER_CX(kk[10], kk[12]); PEER_CX(kk[3], kk[4]); PEER_CX(kk[5], kk[6]); PEER_CX(kk[7], kk[8]); PEER_CX(kk[9], kk[10]); PEER_CX(kk[11], kk[12]); PEER_CX(kk[6], kk[7]); PEER_CX(kk[8], kk[9]);
#pragma unroll
          for (int e = 0; e < 16; ++e) tk[e] = max(tk[e], kk[15 - e]);
          PEER_CX(tk[0], tk[8]); PEER_CX(tk[1], tk[9]); PEER_CX(tk[2], tk[10]); PEER_CX(tk[3], tk[11]); PEER_CX(tk[4], tk[12]); PEER_CX(tk[5], tk[13]); PEER_CX(tk[6], tk[14]); PEER_CX(tk[7], tk[15]); PEER_CX(tk[0], tk[4]); PEER_CX(tk[1], tk[5]); PEER_CX(tk[2], tk[6]); PEER_CX(tk[3], tk[7]); PEER_CX(tk[8], tk[12]); PEER_CX(tk[9], tk[13]); PEER_CX(tk[10], tk[14]); PEER_CX(tk[11], tk[15]); PEER_CX(tk[0], tk[2]); PEER_CX(tk[1], tk[3]); PEER_CX(tk[4], tk[6]); PEER_CX(tk[5], tk[7]); PEER_CX(tk[8], tk[10]); PEER_CX(tk[9], tk[11]); PEER_CX(tk[12], tk[14]); PEER_CX(tk[13], tk[15]); PEER_CX(tk[0], tk[1]); PEER_CX(tk[2], tk[3]); PEER_CX(tk[4], tk[5]); PEER_CX(tk[6], tk[7]); PEER_CX(tk[8], tk[9]); PEER_CX(tk[10], tk[11]); PEER_CX(tk[12], tk[13]); PEER_CX(tk[14], tk[15]); }
#undef PEER_CX
      LAS float* tvp = TV + (tl * 16 + g) * 16; LAS int* tip = TI + (tl * 16 + g) * 16;
#pragma unroll
      for (int j = 0; j < 16; ++j) { const int k_ = tk[j] & ~127; tvp[j] = __int_as_float(k_ ^ ((k_ >> 31) & 0x7fffffff)); tip[j] = 127 - (tk[j] & 127); } }
    __syncthreads();
    asm volatile("" : "+v"(tid));
    { const int tl = tid >> 4, hh = (tid >> 1) & 7, half = tid & 1;
      const LAS float* s1 = TV + (tl * 16 + 2 * hh) * 16; const LAS float* s2 = s1 + 16; const LAS int* i1 = TI + (tl * 16 + 2 * hh) * 16; const LAS int* i2 = i1 + 16;
      float b2[16];
#pragma unroll
      for (int j = 0; j < 16; ++j) b2[j] = s2[j];
      int tk[16];
#pragma unroll
      for (int j = 0; j < 16; ++j) tk[j] = (int)0x80000000;
#pragma unroll
      for (int ii = 0; ii < 8; ++ii) { const int i = 2 * ii + half; const float a = s1[i];
#pragma unroll
          for (int j = 0; j < 16; ++j) if ((2 * ii + 1) * (j + 1) <= 16) { if (half == 0 || (2 * ii + 2) * (j + 1) <= 16) PEER_INS(PEER_KEY(a + b2[j], 255 - (i * 16 + j), 255)); } }
      { int pk[16];
#pragma unroll
        for (int j = 0; j < 16; ++j) pk[j] = __shfl_xor(tk[j], 1);
#pragma unroll
        for (int j = 0; j < 16; ++j) PEER_INS(pk[j]); }
      if (half == 0) { float e[16], sum = 0.f; const int k0_ = tk[0] & ~255; const float v0 = __int_as_float(k0_ ^ ((k0_ >> 31) & 0x7fffffff));
#pragma unroll
        for (int j = 0; j < 16; ++j) { const int k_ = tk[j] & ~255; const float vj = __int_as_float(k_ ^ ((k_ >> 31) & 0x7fffffff)); e[j] = __builtin_amdgcn_exp2f((vj - v0) * 1.4426950408889634f); sum += e[j]; }
        const float inv = 1.0f / sum;
#pragma unroll
        for (int j = 0; j < 16; ++j) { const int ci = 255 - (tk[j] & 255); SE[tl * 128 + hh * 16 + j] = i1[ci >> 4] * 128 + i2[ci & 15]; SG[tl * 128 + hh * 16 + j] = e[j] * inv; } } }
#undef PEER_KEY
#undef PEER_INS
    __syncthreads();
}
__device__ __forceinline__ void peer_gather(int chunk, const bf16_t* __restrict__ H2, const unsigned char* __restrict__ U, const unsigned char* __restrict__ V,
                                            const float* __restrict__ g2, const float* __restrict__ gf, float* OUT, int tid, const LAS int* SE, const LAS float* SG) {
    asm volatile("" : "+v"(tid));
    const int tok0 = chunk * CH, lane = tid & 63, wave = tid >> 6;
    const rsrc_t rH2 = mk_rsrc(H2, 0x4000000u), rU = mk_rsrc(U, 0x1800000u), rV = mk_rsrc(V, 0x1800000u), rG2 = mk_rsrc(g2, 8192u), rGF = mk_rsrc(gf, 8192u);
#pragma unroll 1
    for (int tt = 0; tt < CH / NWAVES; ++tt) { const int tl = wave * (CH / NWAVES) + tt, tok = tok0 + tl;
      asm volatile("" ::: "memory");
      float hn[32], acc[32]; float ss = 0.f;
#pragma unroll
      for (int j = 0; j < 2; ++j)
#pragma unroll
          for (int q = 0; q < 4; ++q) { const u32x2 w = ldb64(rH2, ((unsigned)tok * 2048u + 256u * (4 * j + q) + 4u * lane) * 2u);
              const f32x4 a = (f32x4){__uint_as_float(w.x << 16), __uint_as_float(w.x & 0xffff0000u), __uint_as_float(w.y << 16), __uint_as_float(w.y & 0xffff0000u)};
#pragma unroll
              for (int i = 0; i < 4; ++i) { hn[16 * j + 4 * q + i] = a[i]; ss += a[i] * a[i]; } }
      const float rstd = 1.0f / sqrtf(wave_sum(ss) * (1.f / 2048.f) + NORM_EPS);
#pragma unroll
      for (int j = 0; j < 2; ++j)
#pragma unroll
          for (int q = 0; q < 4; ++q) { const f32x4 a = ldf128(rG2, (256u * (4 * j + q) + 4u * lane) * 4u);
#pragma unroll
              for (int i = 0; i < 4; ++i) hn[16 * j + 4 * q + i] *= rstd * a[i]; }
#pragma unroll
      for (int i = 0; i < 32; ++i) acc[i] = 0.f;
#define NX 4
#define PEER_LOAD(S, kb) do { _Pragma("unroll") for (int x = 0; x < NX; ++x) { const unsigned o = (unsigned)SE[tl * 128 + (kb) + x] * 1536u; \
          S##ua[x] = ldb128(rU, o + (unsigned)lane * 16u); S##ub[x] = ldb64(rU, o + 1024u + (unsigned)lane * 8u); S##va[x] = ldb128(rV, o + (unsigned)lane * 16u); S##vb[x] = ldb64(rV, o + 1024u + (unsigned)lane * 8u); } } while (0)
#define PEER_DEC(A, B) ({ v32f_t r_ = __builtin_amdgcn_cvt_scalef32_pk32_f32_fp6((v6u_t){A.x, A.y, A.z, A.w, B.x, B.y}, 1.0f); asm volatile("s_nop 1" : "+v"(r_)); r_; })
#define PEER_COMPUTE(S, kb) do { float d[NX]; \
          _Pragma("unroll") for (int x = 0; x < NX; ++x) { const v32f_t r = PEER_DEC(S##ua[x], S##ub[x]); float dd = 0.f; \
              _Pragma("unroll") for (int i = 0; i < 32; ++i) fmac1(dd, hn[i], r[i]); \
              d[x] = dd; } \
          _Pragma("unroll") for (int o = 1; o < 64; o <<= 1) { _Pragma("unroll") for (int x = 0; x < NX; ++x) d[x] += __shfl_xor(d[x], o); } \
          float c[NX]; \
          _Pragma("unroll") for (int x = 0; x < NX; ++x) c[x] = SG[tl * 128 + (kb) + x] * gelu_tanh(d[x] * (1.f / 64.f)) * 0.25f; \
          _Pragma("unroll") for (int x = 0; x < NX; ++x) { const v32f_t r = PEER_DEC(S##va[x], S##vb[x]); \
              _Pragma("unroll") for (int i = 0; i < 32; ++i) fmac1(acc[i], c[x], r[i]); } } while (0)
      { u32x4 Aua[NX], Ava[NX], Bua[NX], Bva[NX]; u32x2 Aub[NX], Avb[NX], Bub[NX], Bvb[NX];
        PEER_LOAD(A, 0);
#pragma unroll 1
        for (int k = 0; k < 128; k += 2 * NX) {
            PEER_LOAD(B, k + NX); PEER_COMPUTE(A, k);
            { const int kn = min(k + 2 * NX, 128 - NX); PEER_LOAD(A, kn); }
            PEER_COMPUTE(B, k + NX);
        } }
#undef PEER_DEC
#undef NX
#undef PEER_LOAD
#undef PEER_COMPUTE
      asm volatile("" ::: "memory");
      int tok2 = tok, lane2 = lane; asm volatile("" : "+v"(tok2), "+v"(lane2));
      float s2 = 0.f;
#pragma unroll
      for (int j = 0; j < 2; ++j)
#pragma unroll
          for (int q = 0; q < 4; ++q) { const u32x2 w = ldb64(rH2, ((unsigned)tok2 * 2048u + 256u * (4 * j + q) + 4u * lane2) * 2u);
              const f32x4 a = (f32x4){__uint_as_float(w.x << 16), __uint_as_float(w.x & 0xffff0000u), __uint_as_float(w.y << 16), __uint_as_float(w.y & 0xffff0000u)};
#pragma unroll
              for (int i = 0; i < 4; ++i) { acc[16 * j + 4 * q + i] += a[i]; s2 += acc[16 * j + 4 * q + i] * acc[16 * j + 4 * q + i]; } }
      const float rf = 1.0f / sqrtf(wave_sum(s2) * (1.f / 2048.f) + NORM_EPS);
#pragma unroll
      for (int j = 0; j < 2; ++j)
#pragma unroll
          for (int q = 0; q < 4; ++q) { const f32x4 a = ldf128(rGF, (256u * (4 * j + q) + 4u * lane2) * 4u); f32x4 oa;
#pragma unroll
              for (int i = 0; i < 4; ++i) oa[i] = acc[16 * j + 4 * q + i] * rf * a[i];
              float* op = OUT + (size_t)tok2 * 2048 + 256 * (4 * j + q) + 4 * lane2;
              __builtin_nontemporal_store(oa, (GAS f32x4*)op); }
    }
}
}
#ifndef MK_N_LAUNCHES
#define MK_N_LAUNCHES 1
#endif
#define MK_PROBE_PH -1
#define MK_PROBE_DIV 2
constexpr int N_PHASES = 9;
constexpr int N_LAUNCHES = MK_N_LAUNCHES;
struct Args { const float* in[19]; float* out; unsigned char* ws; int ph_lo, ph_hi; };
static_assert(sizeof(Args) == 19 * 8 + 8 + 8 + 8, "no padding");

__global__ void __launch_bounds__(NWAVES * 64, 2) hybrid_fwd(Args args) {
    extern __shared__ __attribute__((aligned(16))) unsigned char lds_raw[];
    Frame F;
    F.lds = (LAS unsigned char*)lds_raw;
    F.MISC = (volatile LAS unsigned*)(F.lds + MISC_OFF);
    F.tid = threadIdx.x; F.lane = F.tid & 63; F.wave = __builtin_amdgcn_readfirstlane(F.tid >> 6);
    F.G = gridDim.x; { const int bx = blockIdx.x; F.vcu = (F.G % 8 == 0) ? (bx % 8) * (F.G / 8) + bx / 8 : bx; }
    F.ws = args.ws; F.out = args.out;
#pragma unroll
    for (int i = 0; i < 19; ++i) F.in[i] = args.in[i];
    for (int u = F.tid; u < (LDS_BYTES - LDSCTL_OFF) / 4; u += NWAVES * 64) ((LAS unsigned*)(F.lds + LDSCTL_OFF))[u] = 0u;
    __syncthreads();
    XcdBarrier bar; bar.bar = (unsigned*)(F.ws + WS_CTL) + CW_BAR; bar.x = 0; bar.st = nullptr;
    if (N_LAUNCHES == 1) bar = xcd_barrier_post((unsigned*)(F.ws + WS_CTL) + CW_BAR, F.MISC + 8);
    const int lo = args.ph_lo, hi = args.ph_hi;
#define IN(k) (lo <= (k) && (k) < hi)
#if MK_PROBE_PH >= 0
    unsigned long long tp0 = (MK_PROBE_PH == 0 || MK_PROBE_PH == 9) ? __builtin_amdgcn_s_memrealtime() : 0ull, tp1 = 0ull;
#define SEAM(k) do { if (IN(k) && IN((k) + 1)) xcd_barrier(bar); if (MK_PROBE_PH == (k)) tp1 = __builtin_amdgcn_s_memrealtime(); if (MK_PROBE_PH == (k) + 1) tp0 = __builtin_amdgcn_s_memrealtime(); } while (0)
#else
#define SEAM(k) do { if (IN(k) && IN((k) + 1)) xcd_barrier(bar); } while (0)
#endif
    const size_t T2048 = (size_t)256 * 2048 * 2, T1024 = (size_t)256 * 1024 * 2, T512 = (size_t)256 * 512 * 2;
    float* cosT = WSP(float, WS_COS); float* sinT = WSP(float, WS_SIN);
    float* ssq_q = WSP(float, WS_SSQ_Q); float* ssq_kv = WSP(float, WS_SSQ_KV); float* ssq2 = WSP(float, WS_SSQ_2);

    if (IN(0)) { p0_prologue<0>(F, F.vcu, F.G); } SEAM(0);
    if (IN(1)) {
        SchedP1 S{F.G, (int)blockIdx.x, (const char*)(F.ws + WS_HN1), (const char*)(F.ws + WS_WIN), (const char*)(F.ws + WS_WVT), T1024};
        EpiP1 E{WSP(bf16_t, WS_NAQ), WSP(bf16_t, WS_NAK), WSP(bf16_t, WS_VT), WSP(unsigned char, WS_CQ), WSP(unsigned char, WS_CKV), WSP(bf16_t, WS_KR), WSP(unsigned char, WS_GA), WSP(unsigned char, WS_GB), ssq_q, ssq_kv, cosT, sinT};
        pg8::gemm_phase<EpiP1, SchedP1, true, -6>(F.lds, 2048, S, E);
        { const int extra = P1_UNITS % F.G, bx = (int)blockIdx.x; if (extra != 0 && bx >= extra) p0_prologue<1>(F, bx - extra, F.G - extra); else if (extra == 0) p0_prologue<1>(F, bx, F.G); }
    } SEAM(1);
    if (IN(2)) {
        LAS float* relb = (LAS float*)F.lds + 64; LAS float* metab = relb + 16 * 15 * 31 + 128; LAS float* wsf = metab + 256 + F.wave * 64;
        for (int i = F.tid; i < 16 * 15 * 31; i += NWAVES * 64) relb[i] = F.in[4][i];
        if (F.tid < 256) metab[F.tid] = F.in[5][F.tid];
        __syncthreads();
        const int gw = F.vcu * NWAVES + F.wave, NGW = F.G * NWAVES;
        Conv cv{F.in[16], F.in[17], WSP(unsigned char, WS_U), WSP(unsigned char, WS_V), F.lds + 65536 + F.wave * 8192, gw, NGW, 2 * 16384, -1};
        for (int task = gw; task < NBATCH * 16 * 32 * 2; task += NGW)
            att::na_task(task, WSP(bf16_t, WS_NAQ), WSP(bf16_t, WS_NAK), WSP(bf16_t, WS_VT), WSP(unsigned char, WS_ONA), relb, metab, wsf, F.lane, cv);
        while (cv.pend >= 0 || cv.next < cv.end) conv_step<0>(cv, F.lane);
        __syncthreads();
    } SEAM(2);
    if (IN(3)) {
        SchedP3 S{F.G, (int)blockIdx.x, (const char*)(F.ws + WS_CQ), (const char*)(F.ws + WS_CKV), (const char*)(F.ws + WS_WUQ), (const char*)(F.ws + WS_WUKV), T512 / 2};
        EpiP3 E{WSP(bf16_t, WS_QM), WSP(bf16_t, WS_KN), WSP(bf16_t, WS_VV), ssq_q, ssq_kv, cosT, sinT};
        pg8::gemm_phase<EpiP3, SchedP3, true, -4>(F.lds, 512, S, E);
    } SEAM(3);
    if (IN(4)) {
        for (int id = F.vcu; id < NBATCH * 16 * 8; id += F.G) { const int bh = id >> 3, qb = id & 7;
            att::mla_unit(bh >> 4, bh & 15, qb, WSP(bf16_t, WS_QM), WSP(bf16_t, WS_KN), WSP(bf16_t, WS_KR), WSP(bf16_t, WS_VV), WSP(unsigned char, WS_OMLA), (LAS char*)F.lds); }
        __syncthreads();
    } SEAM(4);
    if (IN(5)) {
        { SchedGrid S{F.G, (int)blockIdx.x, 64, 8, (const char*)(F.ws + WS_ONA), (const char*)(F.ws + WS_WNA), T512};
          EpiP5a E{WSP(unsigned char, WS_GA), WSP(unsigned char, WS_T1)};
          pg8::gemm_phase<EpiP5a, SchedGrid, true, -9>(F.lds, 1024, S, E); }
        { SchedGrid S{F.G, (int)blockIdx.x, 64, 8, (const char*)(F.ws + WS_OMLA), (const char*)(F.ws + WS_WMLA), T1024};
          EpiP5b E{WSP(unsigned char, WS_GB), WSP(unsigned char, WS_T1), WSP(unsigned char, WS_MERGED)};
          pg8::gemm_phase<EpiP5b, SchedGrid, true, -11>(F.lds, 2048, S, E); }
    } SEAM(5);
    if (IN(6)) {
        { SchedGrid S{F.G, (int)blockIdx.x, 64, 8, (const char*)(F.ws + WS_MERGED), (const char*)(F.ws + WS_WOUT), T1024};
          EpiP6 E{F.in[0], WSP(bf16_t, WS_H2B), ssq2};
          pg8::gemm_phase<EpiP6, SchedGrid, true, -11>(F.lds, 2048, S, E); }
    } SEAM(6);
    if (IN(7)) {
        SchedGrid S{F.G, (int)blockIdx.x, 64, 8, (const char*)(F.ws + WS_H2B), (const char*)(F.ws + WS_WSC), T2048};
        EpiP7 E{ssq2, WSP(_Float16, WS_SC)};
        pg8::gemm_phase<EpiP7, SchedGrid>(F.lds, 2048, S, E);
    } SEAM(7);
    if (IN(8)) {
        const int nch = (MREAL / peer::CH - F.vcu + F.G - 1) / F.G; const bool both_first = (nch == 2) && (F.vcu & 1);
        for (int op = 0; op < 2 * nch; ++op) {
            const bool sel = both_first ? (op < 2) : !(op & 1); const int ci = both_first ? (op & 1) : (op >> 1), chunk = F.vcu + ci * F.G;
            const int b2 = both_first ? ci : 0;
            LAS int* SE = (LAS int*)(F.lds + (b2 ? peer::OFF_SE2 : peer::OFF_SE)); LAS float* SG = (LAS float*)(F.lds + (b2 ? peer::OFF_SG2 : peer::OFF_SG));
            if (sel) peer::peer_select(chunk, WSP(_Float16, WS_SC), (LAS char*)F.lds, F.tid, SE, SG);
            else peer::peer_gather(chunk, WSP(bf16_t, WS_H2B), WSP(unsigned char, WS_U), WSP(unsigned char, WS_V), F.in[13], F.in[18], F.out, F.tid, SE, SG); }
    }
#if MK_PROBE_PH >= 0
    xcd_barrier(bar); tp1 = (MK_PROBE_PH >= 8) ? __builtin_amdgcn_s_memrealtime() : tp1;
    if (blockIdx.x == 0 && F.tid == 0) F.out[0] = (float)(tp1 - tp0) * (0.01f / MK_PROBE_DIV);
#endif
#undef IN
#undef SEAM
}

extern "C" void kernel_launch(void* const* d_in, const int* in_sizes, int n_in, void* d_out, int out_size, void* d_ws, size_t ws_size, hipStream_t stream) {
    static int grid = 0;
    if (grid == 0) {
        if (n_in != 19 || in_sizes[0] != MREAL * DM || out_size != MREAL * DM || ws_size < WS_END) {
            fprintf(stderr, "kernel_launch: shape/workspace mismatch: n_in %d in0 %d out %d ws %zu (need %zu); nothing launched\n", n_in, n_in > 0 ? in_sizes[0] : -1, out_size, ws_size, (size_t)WS_END); grid = -1; return; }
        int dev = 0, cus = 0, per_cu = 0;
        if (hipGetDevice(&dev) != hipSuccess || hipDeviceGetAttribute(&cus, hipDeviceAttributeMultiprocessorCount, dev) != hipSuccess) { fprintf(stderr, "kernel_launch: device query failed\n"); grid = -1; return; }
        if (hipFuncSetAttribute((const void*)hybrid_fwd, hipFuncAttributeMaxDynamicSharedMemorySize, LDS_BYTES) != hipSuccess) { fprintf(stderr, "kernel_launch: hipFuncSetAttribute failed\n"); grid = -1; return; }
        if (hipOccupancyMaxActiveBlocksPerMultiprocessor(&per_cu, (const void*)hybrid_fwd, NWAVES * 64, LDS_BYTES) != hipSuccess || per_cu < 1)
            fprintf(stderr, "kernel_launch: note: occupancy query reports %d workgroups per CU\n", per_cu);
        (void)hipGetLastError();
        grid = cus;
    }
    if (grid < 0) return;
    if (hipMemsetAsync((char*)d_ws + WS_CTL, 0, CTL_ZERO_BYTES, stream) != hipSuccess) { fprintf(stderr, "kernel_launch: hipMemsetAsync failed\n"); return; }
    Args a{};
    for (int i = 0; i < 19; ++i) a.in[i] = (const float*)d_in[i];
    a.out = (float*)d_out; a.ws = (unsigned char*)d_ws;
    for (int li = 0; li < N_LAUNCHES; ++li) {
        a.ph_lo = (N_LAUNCHES == 1) ? 0 : li; a.ph_hi = (N_LAUNCHES == 1) ? N_PHASES : li + 1;
        hipLaunchKernelGGL(hybrid_fwd, dim3(grid), dim3(NWAVES * 64), LDS_BYTES, stream, a);
        const hipError_t le = hipPeekAtLastError();
        if (le != hipSuccess) { fprintf(stderr, "kernel_launch: launch %d failed: %s\n", li, hipGetErrorName(le)); break; }
    }
}
```

```cpp
#include <hip/hip_runtime.h>
#include <cstdio>
#include <cstdint>

#define LAS __attribute__((address_space(3)))
#define GAS __attribute__((address_space(1)))
typedef unsigned short bf16_t;
typedef short bf16x8 __attribute__((ext_vector_type(8)));
typedef short s16x4 __attribute__((ext_vector_type(4)));
typedef float f32x4 __attribute__((ext_vector_type(4)));
typedef float f32x2 __attribute__((ext_vector_type(2)));
typedef float f32x16 __attribute__((ext_vector_type(16)));
typedef unsigned u32x4 __attribute__((ext_vector_type(4)));
typedef unsigned u32x2 __attribute__((ext_vector_type(2)));

constexpr int DM = 2048, NBATCH = 8, SEQ = 2048, NMETA = 16;
constexpr int MREAL = NBATCH * SEQ;
constexpr int MPAD = MREAL + 256;
constexpr int NPOS = SEQ + NMETA;
constexpr float NORM_EPS = 1e-6f;
constexpr int C_NAQ = 0, C_NAK = 1024, C_CQ = 2048, C_CKV = 2560, C_GA = 3072, C_GB = 5120, C_KR = 7168, NMAIN = 7424;
constexpr int VT_PITCH = MPAD;

constexpr size_t MiB = 1u << 20;
constexpr size_t WS_CTL = 0, CTL_ZERO_BYTES = 1 * MiB;
constexpr size_t WS_SSQ_Q = 481 * MiB, WS_SSQ_KV = 482 * MiB, WS_SSQ_2 = 486 * MiB;
constexpr size_t WS_COS = 1 * MiB, WS_SIN = 1 * MiB + 512 * 1024;
constexpr size_t WS_WUQ = 2 * MiB, WS_WUKV = 5 * MiB, WS_WNA = 9 * MiB, WS_WMLA = 13 * MiB, WS_WOUT = 21 * MiB, WS_WSC = 29 * MiB;
constexpr size_t WS_GA = 37 * MiB, WS_GB = 101 * MiB;
constexpr size_t WS_KR = 165 * MiB;
constexpr size_t WS_WIN = 167 * MiB + 256 * 1024, WS_WVT = WS_WIN + 29 * MiB;
constexpr size_t WS_ONA = 190 * MiB;
constexpr size_t WS_NAQ = 222 * MiB, WS_NAK = 254 * MiB, WS_VT = WS_NAK + 32 * MiB + 512 * 1024;
constexpr size_t WS_HN1 = 319 * MiB;
constexpr size_t WS_CQ = 448 * MiB, WS_CKV = 464 * MiB;
constexpr size_t WS_QM = 222 * MiB, WS_KN = 318 * MiB, WS_VV = 383 * MiB;
constexpr size_t WS_OMLA = 448 * MiB;
constexpr size_t WS_MERGED = 222 * MiB, WS_T1 = 286 * MiB;
constexpr size_t WS_H2 = 37 * MiB, WS_H2B = 293 * MiB;
constexpr size_t WS_U = 69 * MiB, WS_V = 133 * MiB;
constexpr size_t WS_SC = 165 * MiB;
constexpr size_t WS_END = 512 * MiB;
static_assert(WS_CKV + (size_t)MPAD * 512 * 2 <= WS_SSQ_Q && WS_SSQ_Q + (size_t)8 * MPAD * 4 <= WS_SSQ_KV && WS_SSQ_KV + (size_t)8 * MPAD * 4 <= 483 * MiB && WS_SSQ_2 + (size_t)32 * MREAL * 4 <= WS_END, "ssq slabs");
static_assert(WS_VT + (size_t)1024 * MPAD * 2 <= WS_HN1 && WS_HN1 + (size_t)MPAD * 2048 * 2 <= WS_CQ && WS_CKV + (size_t)MPAD * 512 * 2 <= WS_END, "map P1");
static_assert(WS_WVT + 4 * MiB <= WS_NAQ && WS_KR + (size_t)MPAD * 64 * 2 <= WS_WIN && WS_ONA + 32 * MiB <= WS_NAQ, "map P1b");
static_assert(WS_QM + 96 * MiB <= WS_KN && WS_KN + 65 * MiB <= WS_VV && WS_VV + 65 * MiB <= WS_OMLA && WS_OMLA + 64 * MiB <= WS_END, "map P3");
static_assert(WS_T1 + 128 * MiB <= WS_OMLA && WS_H2 + 128 * MiB <= WS_KR && WS_SC + 128 * MiB <= WS_H2B && WS_H2B + 64 * MiB <= WS_END, "map P5+");
static_assert(WS_GA + 32 * MiB <= WS_U && WS_U + 24 * MiB <= WS_GB && WS_GB + 32 * MiB <= WS_V && WS_V + 24 * MiB <= WS_KR, "expert tables between the gate codes");

constexpr int CW_BAR = 4096;

constexpr int RING_BYTES = 131072;
constexpr int LDSCTL_OFF = RING_BYTES, MISC_OFF = LDSCTL_OFF + 320;
constexpr int LDS_BYTES = 147456;
constexpr int NWAVES = 8;

#define LDS_WAIT() asm volatile("s_waitcnt lgkmcnt(0)" ::: "memory")
#define VM_WAIT() asm volatile("s_waitcnt vmcnt(0)" ::: "memory")
#define SBAR() __builtin_amdgcn_sched_barrier(0)
typedef __bf16 bf16x2_t __attribute__((ext_vector_type(2)));
__device__ __forceinline__ unsigned cvt_pk_bf16(float lo, float hi) { const f32x2 v = {lo, hi}; const bf16x2_t b = __builtin_convertvector(v, bf16x2_t); return __builtin_bit_cast(unsigned, b); }
__device__ __forceinline__ float bf_lo(unsigned w) { return __uint_as_float(w << 16); }
__device__ __forceinline__ float bf_hi(unsigned w) { return __uint_as_float(w & 0xffff0000u); }
__device__ __forceinline__ u32x4 pack8(const f32x4 a, const f32x4 b) { u32x4 w; w.x = cvt_pk_bf16(a[0], a[1]); w.y = cvt_pk_bf16(a[2], a[3]); w.z = cvt_pk_bf16(b[0], b[1]); w.w = cvt_pk_bf16(b[2], b[3]); return w; }
__device__ __forceinline__ u32x2 pack8_fp8(f32x4 a, f32x4 b) {
#pragma unroll
    for (int i = 0; i < 4; ++i) { a[i] = __builtin_fminf(__builtin_fmaxf(a[i], -448.f), 448.f); b[i] = __builtin_fminf(__builtin_fmaxf(b[i], -448.f), 448.f); }
    int w0 = 0, w1 = 0; w0 = __builtin_amdgcn_cvt_pk_fp8_f32(a[0], a[1], w0, false); w0 = __builtin_amdgcn_cvt_pk_fp8_f32(a[2], a[3], w0, true);
    w1 = __builtin_amdgcn_cvt_pk_fp8_f32(b[0], b[1], w1, false); w1 = __builtin_amdgcn_cvt_pk_fp8_f32(b[2], b[3], w1, true); return (u32x2){(unsigned)w0, (unsigned)w1}; }
__device__ __forceinline__ unsigned char f32_to_fp8(float x) { x = __builtin_fminf(__builtin_fmaxf(x, -448.f), 448.f); return (unsigned char)(__builtin_amdgcn_cvt_pk_fp8_f32(x, 0.f, 0, false) & 0xff); }
__device__ __forceinline__ u32x2 pack8_u8(const f32x4 a, const f32x4 b) { u32x2 w; unsigned x = 0u, y = 0u;
    x = __builtin_amdgcn_cvt_pk_u8_f32(a[0] * 255.f, 0u, x); x = __builtin_amdgcn_cvt_pk_u8_f32(a[1] * 255.f, 1u, x); x = __builtin_amdgcn_cvt_pk_u8_f32(a[2] * 255.f, 2u, x); x = __builtin_amdgcn_cvt_pk_u8_f32(a[3] * 255.f, 3u, x);
    y = __builtin_amdgcn_cvt_pk_u8_f32(b[0] * 255.f, 0u, y); y = __builtin_amdgcn_cvt_pk_u8_f32(b[1] * 255.f, 1u, y); y = __builtin_amdgcn_cvt_pk_u8_f32(b[2] * 255.f, 2u, y); y = __builtin_amdgcn_cvt_pk_u8_f32(b[3] * 255.f, 3u, y);
    w.x = x; w.y = y; return w; }
__device__ __forceinline__ void unpack8_fp8(const u32x2 w, f32x4& a, f32x4& b) {
    const f32x2 a0 = __builtin_amdgcn_cvt_pk_f32_fp8((int)w.x, false), a1 = __builtin_amdgcn_cvt_pk_f32_fp8((int)w.x, true), b0 = __builtin_amdgcn_cvt_pk_f32_fp8((int)w.y, false), b1 = __builtin_amdgcn_cvt_pk_f32_fp8((int)w.y, true);
    a = (f32x4){a0[0], a0[1], a1[0], a1[1]}; b = (f32x4){b0[0], b0[1], b1[0], b1[1]}; }
__device__ __forceinline__ void unpack8_u8(const u32x2 w, f32x4& a, f32x4& b) { const float k = 1.f / 255.f;
    a = (f32x4){(float)(w.x & 0xffu), (float)((w.x >> 8) & 0xffu), (float)((w.x >> 16) & 0xffu), (float)(w.x >> 24)} * k;
    b = (f32x4){(float)(w.y & 0xffu), (float)((w.y >> 8) & 0xffu), (float)((w.y >> 16) & 0xffu), (float)(w.y >> 24)} * k; }
__device__ __forceinline__ u32x2 pack4(const f32x4 a) { u32x2 w; w.x = cvt_pk_bf16(a[0], a[1]); w.y = cvt_pk_bf16(a[2], a[3]); return w; }
__device__ __forceinline__ float wave_sum(float v) {
#pragma unroll
    for (int o = 1; o < 64; o <<= 1) v += __shfl_xor(v, o);
    return v;
}
__device__ __forceinline__ float sigmoidf_(float x) { return __builtin_amdgcn_rcpf(1.0f + __builtin_amdgcn_exp2f(-1.4426950408889634f * x)); }
__device__ __forceinline__ int crow(int r, int hi) { return (r & 3) + 8 * (r >> 2) + 4 * hi; }
#define PG8_AUX 0
namespace pg8 {
constexpr int BM = 256, BK = 64, HALF = 128, HTB = HALF * BK * 2  , STAGE_BYTES = 8 * HTB, NXCD = 8, WGM = 8;
__host__ __device__ __forceinline__ int lds_byte(int r, int c) { const int st = (r >> 4) * 2 + (c >> 5), rr = r & 15, cc = c & 31, ob = rr * 64 + cc * 2; return st * 1024 + (ob ^ (((ob >> 9) & 1) << 5)); }
__host__ __device__ __forceinline__ void stage_rc(int b, int& R, int& C) { const int st = b / 1024, sb = b % 1024, swz = sb ^ (((sb >> 9) & 1) << 5); R = (st >> 1) * 16 + swz / 64; C = (st & 1) * 32 + (swz % 64) / 2; }
__host__ __device__ __forceinline__ int perm32(int rho) { const int n = rho >> 4, i = rho & 15; return 8 * (i >> 2) + 4 * n + (i & 3); }

struct Unit { int pm, pn, kind; };

__device__ __forceinline__ void grid_order(int L, int nM, int nN, int& pm, int& pn) {
    const int nwg = nM * nN; int wgid = L;
    { const int q = nwg / NXCD, r = nwg % NXCD, xcd = wgid % NXCD, off = wgid / NXCD; wgid = (xcd < r ? xcd * (q + 1) : r * (q + 1) + (xcd - r) * q) + off; }
    const int nig = WGM * nN, gid = wgid / nig, fm = gid * WGM, gsz = (nM - fm) < WGM ? (nM - fm) : WGM;
    pm = fm + ((wgid % nig) % gsz); pn = (wgid % nig) / gsz;
}

typedef int v8i_t __attribute__((ext_vector_type(8)));
template <class Epi, class Sched, bool F8 = false, int F8_SCALE_EXP = 0>
__device__ __forceinline__ void gemm_phase(LAS unsigned char* lds, const int K, const Sched& S, const Epi& E) {
    const int tid = threadIdx.x, wid = __builtin_amdgcn_readfirstlane(tid >> 6), lane = tid & 63, wr = wid >> 2, wc = wid & 3, fr = lane & 15, fq = lane >> 4;
    int f8sa = 0x01010101 * (127 + F8_SCALE_EXP), f8sb = 0x7f7f7f7f; asm volatile("" : "+v"(f8sa), "+v"(f8sb));
    const int Kb = F8 ? K : 2 * K;
    const int nt = Kb / 128;
    unsigned voffA[2], voffB[2];
#pragma unroll
    for (int i = 0; i < 2; ++i) { int R, C; stage_rc(tid * 16 + i * 8192, R, C); const int Rb = Epi::PERM ? ((R & ~31) + perm32(R & 31)) : R;
        voffA[i] = (unsigned)(R * Kb + C * 2); voffB[i] = (unsigned)(Rb * Kb + C * 2); }
    const size_t kstep = (size_t)128;
    const size_t hstep = (size_t)HALF * Kb;
    const unsigned ldsw = (unsigned)wid * 1024u;
    const int aoff = lds_byte(wr * 64 + fr, F8 ? fq * 16 : fq * 8), boff = lds_byte(wc * 32 + fr, F8 ? fq * 16 : fq * 8);
#define PG8_SA(b, h) (((b) * 2 + (h)) * HTB)
#define PG8_SB(b, h) ((4 + (b) * 2 + (h)) * HTB)
#define PG8_STAGE(bufoff, gbase, voff) do { _Pragma("unroll") for (int _i = 0; _i < 2; ++_i) \
        __builtin_amdgcn_global_load_lds((const unsigned*)((const char*)(gbase) + (voff)[_i]), (LAS unsigned*)(lds + (bufoff) + ldsw + _i * 8192), 16, 0, PG8_AUX); } while (0)
#define PG8_LDA(dst, b, h) do { _Pragma("unroll") for (int m = 0; m < 4; ++m) _Pragma("unroll") for (int k = 0; k < 2; ++k) dst[m][k] = *(const LAS bf16x8*)(lds + PG8_SA(b, h) + aoff + m * 2048 + (F8 ? k * 16 : k * 1024)); } while (0)
#define PG8_LDB(dst, b, h) do { _Pragma("unroll") for (int n = 0; n < 2; ++n) _Pragma("unroll") for (int k = 0; k < 2; ++k) dst[n][k] = *(const LAS bf16x8*)(lds + PG8_SB(b, h) + boff + n * 2048 + (F8 ? k * 16 : k * 1024)); } while (0)
#define PG8_F8OP(X) __builtin_bit_cast(v8i_t, __builtin_shufflevector(X[0], X[1], 0, 1, 2, 3, 4, 5, 6, 7, 8, 9, 10, 11, 12, 13, 14, 15))
#define PG8_MMA(ai, bj, At, Bt) do { __builtin_amdgcn_s_setprio(1); \
        if constexpr (F8) { _Pragma("unroll") for (int m = 0; m < 4; ++m) _Pragma("unroll") for (int n = 0; n < 2; ++n) \
            asm volatile("v_mfma_scale_f32_16x16x128_f8f6f4 %0, %1, %2, %0, %3, %4 op_sel_hi:[0,0,0]" : "+v"(acc[ai][bj][m][n]) : "v"(PG8_F8OP(Bt[n])), "v"(PG8_F8OP(At[m])), "v"(f8sa), "v"(f8sb)); } \
        else { _Pragma("unroll") for (int m = 0; m < 4; ++m) _Pragma("unroll") for (int n = 0; n < 2; ++n) _Pragma("unroll") for (int k = 0; k < 2; ++k) \
            acc[ai][bj][m][n] = __builtin_amdgcn_mfma_f32_16x16x32_bf16(Bt[n][k], At[m][k], acc[ai][bj][m][n], 0, 0, 0); } \
        __builtin_amdgcn_s_setprio(0); } while (0)
#define PG8_WAIT_V(n) asm volatile("s_waitcnt vmcnt(" #n ")" ::: "memory")
#define PG8_WAIT_L(n) asm volatile("s_waitcnt lgkmcnt(" #n ")" ::: "memory")
#define PG8_BAR __builtin_amdgcn_s_barrier()
#define PG8_SCHED __builtin_amdgcn_sched_barrier(0)
    Unit cur, nxt; int ui = 0;
    if (!S.next(0, cur)) return;
    f32x4 acc[2][2][4][2];
#pragma unroll
    for (int a = 0; a < 2; ++a)
#pragma unroll
        for (int b = 0; b < 2; ++b)
#pragma unroll
            for (int m = 0; m < 4; ++m)
#pragma unroll
                for (int n = 0; n < 2; ++n) acc[a][b][m][n] = (f32x4){0.f, 0.f, 0.f, 0.f};
    bf16x8 At[4][2], B0[2][2], B1[2][2];
    const char* cA = S.pa(cur); const char* cB = S.pb(cur);
    PG8_STAGE(PG8_SB(0, 0), cB, voffB); PG8_STAGE(PG8_SB(0, 1), cB + hstep, voffB); PG8_STAGE(PG8_SA(0, 0), cA, voffA); PG8_STAGE(PG8_SA(0, 1), cA + hstep, voffA);
    if (wr == 1) PG8_BAR;
    PG8_WAIT_V(2); PG8_BAR;
    PG8_STAGE(PG8_SB(1, 0), cB + kstep, voffB); PG8_STAGE(PG8_SA(1, 0), cA + kstep, voffA); PG8_STAGE(PG8_SB(1, 1), cB + hstep + kstep, voffB);
    PG8_WAIT_V(6); PG8_BAR;
    for (;;) {
        const bool has_next = S.next(ui + 1, nxt);
        const char* nA = has_next ? S.pa(nxt) : cA; const char* nB = has_next ? S.pb(nxt) : cB;
        for (int t = 0; t < nt; t += 2) {
            const bool last = (t == nt - 2);
            const char* a1 = cA + (size_t)(t + 1) * kstep;
            const char* a2 = last ? nA : cA + (size_t)(t + 2) * kstep; const char* b2 = last ? nB : cB + (size_t)(t + 2) * kstep;
            const char* a3 = a2 + kstep; const char* b3 = b2 + kstep;
            PG8_LDB(B0, 0, 0); PG8_LDB(B1, 0, 1); PG8_SCHED; PG8_LDA(At, 0, 0); PG8_STAGE(PG8_SA(1, 1), a1 + hstep, voffA);
            PG8_WAIT_V(8); PG8_WAIT_L(0); PG8_BAR; PG8_MMA(0, 0, At, B0); PG8_MMA(0, 1, At, B1); PG8_BAR; PG8_SCHED;
            PG8_LDA(At, 0, 1); PG8_STAGE(PG8_SB(0, 0), b2, voffB); PG8_STAGE(PG8_SB(0, 1), b2 + hstep, voffB); PG8_STAGE(PG8_SA(0, 0), a2, voffA);
            PG8_WAIT_V(8); PG8_WAIT_L(0); PG8_BAR; PG8_MMA(1, 0, At, B0); PG8_MMA(1, 1, At, B1); PG8_BAR; PG8_SCHED;
            PG8_LDB(B0, 1, 0); PG8_LDB(B1, 1, 1); PG8_SCHED; PG8_LDA(At, 1, 0); PG8_STAGE(PG8_SA(0, 1), a2 + hstep, voffA);
            PG8_WAIT_V(8); PG8_WAIT_L(0); PG8_BAR; PG8_MMA(0, 0, At, B0); PG8_MMA(0, 1, At, B1); PG8_BAR; PG8_SCHED;
            PG8_LDA(At, 1, 1); PG8_STAGE(PG8_SB(1, 0), b3, voffB); PG8_STAGE(PG8_SB(1, 1), b3 + hstep, voffB); PG8_STAGE(PG8_SA(1, 0), a3, voffA);
            PG8_WAIT_V(8); PG8_WAIT_L(0); PG8_BAR; PG8_MMA(1, 0, At, B0); PG8_MMA(1, 1, At, B1); PG8_BAR; PG8_SCHED;
        }
        if (wr == 0) PG8_BAR;
        if constexpr (F8) asm volatile("s_nop 15\n\ts_nop 7" ::: "memory");
        if constexpr (Epi::HAS_PRE) {
            E.pre(cur, (LAS float*)(lds + STAGE_BYTES + 1024), tid); PG8_WAIT_L(0); PG8_BAR; }
        E(acc, cur, wr, wc, fr, fq, (const LAS float*)(lds + STAGE_BYTES + 1024));
        if (!has_next) break;
#pragma unroll
        for (int a = 0; a < 2; ++a)
#pragma unroll
            for (int b = 0; b < 2; ++b)
#pragma unroll
                for (int m = 0; m < 4; ++m)
#pragma unroll
                    for (int n = 0; n < 2; ++n) acc[a][b][m][n] = (f32x4){0.f, 0.f, 0.f, 0.f};
        cur = nxt; cA = nA; cB = nB; ++ui;
        if (wr == 1) PG8_BAR;
    }
    PG8_WAIT_V(0);
    PG8_BAR;
#undef PG8_SA
#undef PG8_SB
#undef PG8_STAGE
#undef PG8_LDA
#undef PG8_LDB
#undef PG8_MMA
#undef PG8_F8OP
#undef PG8_WAIT_V
#undef PG8_WAIT_L
#undef PG8_BAR
#undef PG8_SCHED
}
}
typedef GAS unsigned gu32;
#define RLX_AGENT __ATOMIC_RELAXED, __HIP_MEMORY_SCOPE_AGENT
#define XB_TMO      128
#define XB_XCNT(j)  (256  + 64 * (j))
#define XB_XSUB(j)  (1280 + 64 * (j))
#define XB_XGEN(j)  (2304 + 64 * (j))
#define XB_TOP      3328
#define XB_TOPGEN   3392
#define XCD_BAR_WORDS 3456
#define XB_SPIN_CAP (1u << 18)
__device__ __forceinline__ unsigned xb_ld(unsigned* p)              { return __hip_atomic_load(p, __ATOMIC_RELAXED, __HIP_MEMORY_SCOPE_AGENT); }
__device__ __forceinline__ unsigned xb_add(unsigned* p, unsigned v) { return __hip_atomic_fetch_add(p, v, __ATOMIC_RELAXED, __HIP_MEMORY_SCOPE_AGENT); }
__device__ __forceinline__ unsigned xb_xcc_id() { return (unsigned)__builtin_amdgcn_s_getreg((3 << 11) | 20) & 0xFu; }
#define XB_SPIN(cond, bar) do { unsigned _sp = 0; while (cond) { __builtin_amdgcn_s_sleep(1); \
    if ((++_sp & 255u) == 0u) { if (xb_ld(&(bar)[XB_TMO])) break; if (_sp > XB_SPIN_CAP) { atomicAdd(&(bar)[XB_TMO], 1u); break; } } } } while (0)
struct XcdBarrier { unsigned* bar; unsigned x; volatile LAS unsigned* st; };
__device__ __forceinline__ XcdBarrier xcd_barrier_post(unsigned* bar, volatile LAS unsigned* st) {
    XcdBarrier b; b.bar = bar; b.x = xb_xcc_id(); b.st = st;
    if (threadIdx.x == 0) (void)xb_add(&bar[XB_XCNT(b.x)], 1u);
    return b;
}
__device__ __forceinline__ void xcd_barrier_complete(unsigned* bar, unsigned x, unsigned& nloc, unsigned& nx) {
    const unsigned G = gridDim.x * gridDim.y * gridDim.z;
    unsigned sum, cnt, mine, sp = 0u;
    for (;;) {
        sum = 0u; cnt = 0u; mine = 0u;
#pragma unroll
        for (unsigned j = 0; j < 16; ++j) { const unsigned c = xb_ld(&bar[XB_XCNT(j)]); sum += c; cnt += (c > 0u) ? 1u : 0u; mine = (j == x) ? c : mine; }
        if (sum == G) break;
        __builtin_amdgcn_s_sleep(1);
        if ((++sp & 255u) == 0u) { if (xb_ld(&bar[XB_TMO])) break; if (sp > XB_SPIN_CAP) { atomicAdd(&bar[XB_TMO], 1u); break; } }
    }
    nloc = mine > 0u ? mine : 1u; nx = cnt > 0u ? cnt : 1u;
}
__device__ __forceinline__ void xcd_barrier(const XcdBarrier& b) {
    asm volatile("s_waitcnt vmcnt(0)" ::: "memory");
    __syncthreads();
    if (threadIdx.x == 0) {
        unsigned* bar = b.bar;
        __builtin_amdgcn_s_waitcnt(0);
        unsigned nloc = b.st[0], nx = b.st[1];
        if (nloc == 0u) { xcd_barrier_complete(bar, b.x, nloc, nx); b.st[0] = nloc; b.st[1] = nx; }
        const unsigned old = xb_add(&bar[XB_XSUB(b.x)], 1u);
        const unsigned gen = old / nloc;
        if (old + 1u == (gen + 1u) * nloc) {
            __builtin_amdgcn_fence(__ATOMIC_RELEASE, "agent");
            asm volatile("s_waitcnt vmcnt(0)" ::: "memory");
            const unsigned og = xb_add(&bar[XB_TOP], 1u);
            const unsigned tg = og / nx;
            if (og + 1u == (tg + 1u) * nx) xb_add(&bar[XB_TOPGEN], 1u);
            else XB_SPIN(xb_ld(&bar[XB_TOPGEN]) == tg, bar);
            __builtin_amdgcn_fence(__ATOMIC_ACQUIRE, "agent");
            xb_add(&bar[XB_XGEN(b.x)], 1u);
            asm volatile("s_waitcnt vmcnt(0)" ::: "memory");
        } else {
            XB_SPIN(xb_ld(&bar[XB_XGEN(b.x)]) == gen, bar);
            __builtin_amdgcn_fence(__ATOMIC_ACQUIRE, "agent");
            asm volatile("s_waitcnt vmcnt(0)" ::: "memory");
        }
    }
    __syncthreads();
}
struct Frame {
    LAS unsigned char* lds;
    volatile LAS unsigned* MISC;
    unsigned char* ws;
    int tid, lane, wave;
    int vcu, G;
    const float* in[19];
    float* out;
};
#define WSP(T, off) ((T*)(F.ws + (off)))

typedef float cv16f_t __attribute__((ext_vector_type(16)));
typedef unsigned cv6u_t __attribute__((ext_vector_type(6)));
struct Conv { const float* pu; const float* pv; unsigned char* u8; unsigned char* v8; LAS unsigned char* lbuf; int next, stride, end, pend, tick; };
__device__ __forceinline__ void conv_issue(const Conv& c, int item, int lane) {
    const float* src = ((item >> 14) ? c.pv : c.pu) + (size_t)(item & 16383) * 2048 + 4 * lane;
#pragma unroll
    for (int q = 0; q < 8; ++q) __builtin_amdgcn_global_load_lds((const unsigned*)(src + 256 * q), (LAS unsigned*)(c.lbuf + q * 1024), 16, 0, 0);
}
__device__ __forceinline__ void conv_finish(const Conv& c, int item, int lane) {
    const int isv = item >> 14, row = item & 16383; const float sc = isv ? 4.f : 64.f; cv16f_t a, b;
#pragma unroll
    for (int q = 0; q < 8; ++q) { const f32x4 x = *(const LAS f32x4*)(c.lbuf + q * 1024 + lane * 16);
#pragma unroll
        for (int e = 0; e < 4; ++e) { const int k_ = 4 * q + e;
            if (k_ & 1) b[k_ >> 1] = x[e] * sc; else a[k_ >> 1] = x[e] * sc; } }
    const cv6u_t w = __builtin_amdgcn_cvt_scalef32_2xpk16_fp6_f32(a, b, 1.0f);
    unsigned char* rec = (isv ? c.v8 : c.u8) + (size_t)row * 1536;
    *(GAS u32x4*)(rec + lane * 16) = (u32x4){w[0], w[1], w[2], w[3]}; *(GAS u32x2*)(rec + 1024 + lane * 8) = (u32x2){w[4], w[5]};
}
template <int YOUNGER>
__device__ __forceinline__ void conv_step(Conv& c, int lane) {
    if (c.pend >= 0) { if constexpr (YOUNGER == 0) asm volatile("s_waitcnt vmcnt(0)" ::: "memory"); else { static_assert(YOUNGER == 20, "wait count"); asm volatile("s_waitcnt vmcnt(20)" ::: "memory"); }
        conv_finish(c, c.pend, lane); c.pend = -1; asm volatile("s_waitcnt lgkmcnt(0)" ::: "memory"); }
    if (c.next < c.end) { conv_issue(c, c.next, lane); c.pend = c.next; c.next += c.stride; }
}
__device__ __forceinline__ void p0_transpose_item(const float* W, int K, int N, int k0, int n0, bf16_t* WT, int drow, bool rope, const float* gain, LAS float* scr, int lane) {
    { f32x4 v[8]; float gk[8];
#pragma unroll
      for (int i = 0; i < 8; ++i) { const int kk = 8 * i + (lane >> 3); v[i] = *(const GAS f32x4*)(W + (size_t)(k0 + kk) * N + n0 + 4 * (lane & 7)); gk[i] = gain ? gain[k0 + kk] : 1.f; }
#pragma unroll
      for (int i = 0; i < 8; ++i) { const int kk = 8 * i + (lane >> 3); LAS float* d = scr + kk * 33 + 4 * (lane & 7);
#pragma unroll
          for (int e = 0; e < 4; ++e) d[e] = v[i][e] * gk[i]; } }
    LDS_WAIT(); asm volatile("" ::: "memory");
    const int c = lane & 7;
#pragma unroll
    for (int j = 0; j < 4; ++j) { const int n = (lane >> 3) + 8 * j; const LAS float* s = scr + (8 * c) * 33 + n;
        u32x4 o; o.x = cvt_pk_bf16(s[0 * 33], s[1 * 33]); o.y = cvt_pk_bf16(s[2 * 33], s[3 * 33]); o.z = cvt_pk_bf16(s[4 * 33], s[5 * 33]); o.w = cvt_pk_bf16(s[6 * 33], s[7 * 33]);
        const int dr = drow + (rope ? (8 * (n >> 2) + (n & 3)) : n);
        *(GAS u32x4*)(WT + (size_t)dr * K + k0 + 8 * c) = o; }
    LDS_WAIT(); asm volatile("" ::: "memory");
}
__device__ __forceinline__ void p0_transpose_item8(const float* W, int K, int N, int k0, int n0, unsigned char* WT, int drow, bool rope, float scale, LAS float* scr, int lane, const float* gain = nullptr) {
    { f32x4 v[8]; float gk[8];
#pragma unroll
      for (int i = 0; i < 8; ++i) { const int kk = 8 * i + (lane >> 3); v[i] = *(const GAS f32x4*)(W + (size_t)(k0 + kk) * N + n0 + 4 * (lane & 7)); gk[i] = gain ? gain[k0 + kk] * scale : scale; }
#pragma unroll
      for (int i = 0; i < 8; ++i) { const int kk = 8 * i + (lane >> 3); LAS float* d = scr + kk * 33 + 4 * (lane & 7);
#pragma unroll
          for (int e = 0; e < 4; ++e) d[e] = v[i][e] * gk[i]; } }
    LDS_WAIT(); asm volatile("" ::: "memory");
#pragma unroll
    for (int j = 0; j < 2; ++j) { const int q = lane + 64 * j, n = q >> 2, c = q & 3; const LAS float* s = scr + (16 * c) * 33 + n; u32x4 o;
#pragma unroll
        for (int d = 0; d < 4; ++d) { int w = 0; w = __builtin_amdgcn_cvt_pk_fp8_f32(s[(4 * d) * 33], s[(4 * d + 1) * 33], w, false); w = __builtin_amdgcn_cvt_pk_fp8_f32(s[(4 * d + 2) * 33], s[(4 * d + 3) * 33], w, true); o[d] = (unsigned)w; }
        const int dr = drow + (rope ? (8 * (n >> 2) + (n & 3)) : n);
        *(GAS u32x4*)(WT + (size_t)dr * K + k0 + 16 * c) = o; }
    LDS_WAIT(); asm volatile("" ::: "memory");
}
__device__ __forceinline__ void rms_row_to_fp8(const float* xrow, const float* g, unsigned char* orow, int lane) {
    const GAS f32x4* xr = (const GAS f32x4*)xrow + lane; const GAS f32x4* gr = (const GAS f32x4*)g + lane;
    f32x4 v[8]; float s = 0.f;
#pragma unroll
    for (int j = 0; j < 8; ++j) { v[j] = xr[64 * j]; s += (v[j].x * v[j].x + v[j].y * v[j].y) + (v[j].z * v[j].z + v[j].w * v[j].w); }
    const float rstd = 1.0f / sqrtf(wave_sum(s) * (1.f / DM) + NORM_EPS);
    GAS unsigned* o4 = (GAS unsigned*)orow + lane;
#pragma unroll
    for (int j = 0; j < 8; ++j) { const f32x4 y = (v[j] * rstd) * gr[64 * j]; int w = 0; w = __builtin_amdgcn_cvt_pk_fp8_f32(y[0], y[1], w, false); w = __builtin_amdgcn_cvt_pk_fp8_f32(y[2], y[3], w, true); o4[64 * j] = (unsigned)w; }
}
__device__ __forceinline__ void rms_row_to_bf16(const float* xrow, const float* g, bf16_t* orow, int lane) {
    const GAS f32x4* xr = (const GAS f32x4*)xrow + lane; const GAS f32x4* gr = (const GAS f32x4*)g + lane;
    f32x4 v[8]; float s = 0.f;
#pragma unroll
    for (int j = 0; j < 8; ++j) { v[j] = xr[64 * j]; s += (v[j].x * v[j].x + v[j].y * v[j].y) + (v[j].z * v[j].z + v[j].w * v[j].w); }
    const float rstd = 1.0f / sqrtf(wave_sum(s) * (1.f / DM) + NORM_EPS);
    GAS u32x2* o8 = (GAS u32x2*)orow + lane;
#pragma unroll
    for (int j = 0; j < 8; ++j) { const f32x4 gg = gr[64 * j]; o8[64 * j] = pack4((v[j] * rstd) * gg); }
}
template <int PART>
__device__ __forceinline__ void p0_prologue(Frame& F, int rank, int nrank) {
    LAS float* scr = (LAS float*)(F.lds + F.wave * 16384);
    const int gw = rank * NWAVES + F.wave, NGW = nrank * NWAVES, lane = F.lane; const int gt = rank * 512 + F.tid, NGT = nrank * 512;
    unsigned char* WIN = WSP(unsigned char, WS_WIN); unsigned char* WVT = WSP(unsigned char, WS_WVT);
    constexpr int I_IN = 32 * 258, I_UQ = 8 * 96, I_UKV = 8 * 128, I_NA = 16 * 64, I_MLA = 32 * 64, I_OUT = 32 * 64;
    constexpr int NEARLY = I_IN + I_UQ + I_UKV, NITEMS = NEARLY + I_NA + I_MLA + I_OUT;
    for (int it = (PART == 0 ? 0 : NEARLY) + gw; it < (PART == 0 ? NEARLY : NITEMS); it += NGW) {
        int r = it;
        if (r < I_IN) { const int kb = r / 258, sb = r % 258, n0 = 32 * sb, k0 = 64 * kb; const float* W = F.in[3];
            unsigned char* dst = WIN; int drow; bool rope = false;
            if (n0 < 1024) drow = C_NAQ + n0;
            else if (n0 < 2048) drow = C_NAK + (n0 - 1024);
            else if (n0 < 3072) { dst = WVT; drow = n0 - 2048; }
            else if (n0 < 3584) drow = C_CQ + (n0 - 3072);
            else if (n0 < 4096) drow = C_CKV + (n0 - 3584);
            else if (n0 < 4160) { drow = C_KR + ((n0 - 4096) ? 4 : 0); rope = true; }
            else if (n0 < 6208) drow = C_GA + (n0 - 4160);
            else drow = C_GB + (n0 - 6208);
            p0_transpose_item8(W, 2048, 8256, k0, n0, dst, drow, rope, 64.f, scr, lane); continue; } r -= I_IN;
        if (r < I_UQ) { const int kb = r / 96, sb = r % 96, n0 = 32 * sb, k0 = 64 * kb; const int hd = n0 / 192, w = n0 % 192;
            int drow = n0; bool rope = false; if (w >= 128) { rope = true; drow = hd * 192 + 128 + ((w - 128) ? 4 : 0); }
            p0_transpose_item8(F.in[7], 512, 3072, k0, n0, WSP(unsigned char, WS_WUQ), drow, rope, 16.f, scr, lane, F.in[6]); continue; } r -= I_UQ;
        if (r < I_UKV) { const int kb = r / 128, sb = r % 128; p0_transpose_item8(F.in[9], 512, 4096, 64 * kb, 32 * sb, WSP(unsigned char, WS_WUKV), 32 * sb, false, 16.f, scr, lane, F.in[8]); continue; } r -= I_UKV;
        if (r < I_NA) { const int kb = r / 64, sb = r % 64; p0_transpose_item8(F.in[10], 1024, 2048, 64 * kb, 32 * sb, WSP(unsigned char, WS_WNA), 32 * sb, false, 32.f, scr, lane); continue; } r -= I_NA;
        if (r < I_MLA) { const int kb = r / 64, sb = r % 64; p0_transpose_item8(F.in[11], 2048, 2048, 64 * kb, 32 * sb, WSP(unsigned char, WS_WMLA), 32 * sb, false, 64.f, scr, lane); continue; } r -= I_MLA;
        { const int kb = r / 64, sb = r % 64; p0_transpose_item8(F.in[12], 2048, 2048, 64 * kb, 32 * sb, WSP(unsigned char, WS_WOUT), 32 * sb, false, 64.f, scr, lane); }
    }
    if (PART == 0) { GAS u32x4* z = (GAS u32x4*)(WIN + (size_t)(C_KR + 64) * 2048); const int n16 = (NMAIN - C_KR - 64) * 2048 / 16;
      for (int i = gt; i < n16; i += NGT) z[i] = (u32x4){0u, 0u, 0u, 0u}; }
    if (PART == 0) { unsigned char* HN1 = WSP(unsigned char, WS_HN1);
#define P0_ROWSRC(m_) (((m_) < MREAL) ? F.in[0] + (size_t)(m_) * DM : F.in[1] + (size_t)((m_) - MREAL) * DM)
      { f32x4 v[8]; int m = gw;
        if (m < MREAL + NMETA) { const GAS f32x4* xr = (const GAS f32x4*)P0_ROWSRC(m) + lane;
#pragma unroll
            for (int j = 0; j < 8; ++j) v[j] = xr[64 * j]; }
        const GAS f32x4* gr = (const GAS f32x4*)F.in[2] + lane;
        while (m < MREAL + NMETA) { const int mn = m + NGW; f32x4 vn[8];
            { const int ml = mn < MREAL + NMETA ? mn : m; const GAS f32x4* xr = (const GAS f32x4*)P0_ROWSRC(ml) + lane;
#pragma unroll
              for (int j = 0; j < 8; ++j) vn[j] = xr[64 * j]; }
            float sq = 0.f;
#pragma unroll
            for (int j = 0; j < 8; ++j) sq += (v[j].x * v[j].x + v[j].y * v[j].y) + (v[j].z * v[j].z + v[j].w * v[j].w);
            const float rstd = 1.0f / sqrtf(wave_sum(sq) * (1.f / DM) + NORM_EPS);
            GAS unsigned* o4 = (GAS unsigned*)(HN1 + (size_t)m * DM) + lane;
#pragma unroll
            for (int j = 0; j < 8; ++j) { const f32x4 y = (v[j] * rstd) * gr[64 * j]; int w = 0; w = __builtin_amdgcn_cvt_pk_fp8_f32(y[0], y[1], w, false); w = __builtin_amdgcn_cvt_pk_fp8_f32(y[2], y[3], w, true); o4[64 * j] = (unsigned)w; }
#pragma unroll
            for (int j = 0; j < 8; ++j) v[j] = vn[j];
            m = mn; } }
#undef P0_ROWSRC
      GAS u32x4* z = (GAS u32x4*)(HN1 + (size_t)(MREAL + NMETA) * DM); const int n16 = (MPAD - MREAL - NMETA) * DM / 16;
      for (int i = gt; i < n16; i += NGT) z[i] = (u32x4){0u, 0u, 0u, 0u}; }
    if (PART == 0) { float* ct = WSP(float, WS_COS); float* st = WSP(float, WS_SIN);
      for (int i = gt; i < NPOS * 32; i += NGT) { const int p = i >> 5, j = i & 31;
          const float inv = __builtin_powf(10000.0f, -(float)(2 * j) / 64.0f); const float ang = (float)p * inv;
          double r = (double)ang * 0.15915494309189535; r -= __builtin_rint(r); const float rf = (float)r;
          ct[i] = __builtin_amdgcn_cosf(rf); st[i] = __builtin_amdgcn_sinf(rf); } }
    if (PART == 1) { const float* SK = F.in[15]; const float* WQ = F.in[14]; const float* g2 = F.in[13]; bf16_t* WSCp = WSP(bf16_t, WS_WSC);
      const int l15 = lane & 15, l4 = lane >> 4;
      for (int task = gw; task < 2048; task += NGW) { const int g = task >> 7, nt = (task >> 4) & 7, kc = task & 15, n0 = nt * 16;
          bf16x8 bfr[4];
#pragma unroll
          for (int kk = 0; kk < 4; ++kk) { const float* p = SK + ((size_t)g * 128 + n0 + l15) * 128 + 32 * kk + 8 * l4; const f32x4 a = *(const GAS f32x4*)p, b = *(const GAS f32x4*)(p + 4);
              const u32x4 w = pack8(a, b); bfr[kk] = __builtin_bit_cast(bf16x8, w); }
          for (int kt = 0; kt < 8; ++kt) { const int k0 = (kc * 8 + kt) * 16; f32x4 acc = (f32x4){0.f, 0.f, 0.f, 0.f};
#pragma unroll
              for (int kk = 0; kk < 4; ++kk) { const float* p = WQ + (size_t)(k0 + l15) * 2048 + g * 128 + 32 * kk + 8 * l4; const f32x4 a = *(const GAS f32x4*)p, b = *(const GAS f32x4*)(p + 4);
                  const u32x4 w = pack8(a, b); acc = __builtin_amdgcn_mfma_f32_16x16x32_bf16(__builtin_bit_cast(bf16x8, w), bfr[kk], acc, 0, 0, 0); }
              const f32x4 gg = *(const GAS f32x4*)(g2 + k0 + 4 * l4);
              *(GAS u32x2*)(WSCp + (size_t)(g * 128 + n0 + l15) * 2048 + k0 + 4 * l4) = pack4(acc * gg); } } }
}
using pg8::Unit;
struct SchedGrid {
    int G, c, nM, nN; const char* A; const char* B; size_t tstep;
    __device__ __forceinline__ bool next(int i, Unit& u) const { const int L = i * G + c; if (L >= nM * nN) return false; pg8::grid_order(L, nM, nN, u.pm, u.pn); u.kind = 0; return true; }
    __device__ __forceinline__ const char* pa(const Unit& u) const { return A + (size_t)u.pm * tstep; }
    __device__ __forceinline__ const char* pb(const Unit& u) const { return B + (size_t)u.pn * tstep; }
};
constexpr int P1_MAIN = 64 * 29, P1_VT = 4 * 65, P1_META = 7, P1_UNITS = P1_MAIN + P1_VT + P1_META;
struct SchedP1 {
    int G, c; const char* hn1; const char* win; const char* wvt; size_t tstep;
    __device__ __forceinline__ bool next(int i, Unit& u) const {
        const int L = i * G + c; if (L >= P1_UNITS) return false;
        if (L < P1_MAIN) { pg8::grid_order(L, 64, 29, u.pm, u.pn); u.kind = 0; }
        else if (L < P1_MAIN + P1_VT) { const int idx = L - P1_MAIN; u.pm = idx & 3; u.pn = idx >> 2; u.kind = 1; }
        else { const int idx = L - P1_MAIN - P1_VT; u.pm = 64; u.pn = idx < 4 ? 4 + idx : (idx < 6 ? 10 + (idx - 4) : 28); u.kind = 0; }
        return true; }
    __device__ __forceinline__ const char* pa(const Unit& u) const { return (u.kind == 1 ? wvt : hn1) + (size_t)u.pm * tstep; }
    __device__ __forceinline__ const char* pb(const Unit& u) const { return (u.kind == 1 ? hn1 : win) + (size_t)u.pn * tstep; }
};
__device__ __forceinline__ void rope4(const f32x4 x1, const f32x4 x2, const float* cosT, const float* sinT, int pos, int j0, f32x4& lo, f32x4& hi) {
    const f32x4 c = *(const GAS f32x4*)(cosT + pos * 32 + j0), s = *(const GAS f32x4*)(sinT + pos * 32 + j0);
    lo = x1 * c - x2 * s; hi = x2 * c + x1 * s;
}
struct EpiP1 {
    static constexpr bool PERM = true, HAS_PRE = false;
    bf16_t *naq, *nak, *vt; unsigned char *cq, *ckv; bf16_t *kr; unsigned char *ga, *gb; float *ssq_q, *ssq_kv; const float *cosT, *sinT;
    __device__ __forceinline__ void operator()(const f32x4 (&acc)[2][2][4][2], const Unit& u, int wr, int wc, int fr, int fq, const LAS float* rowsc) const {
        const int row0 = u.pm * 256 + wr * 64 + fr, colu = wc * 32 + 8 * fq;
        if (u.kind == 1) {
#pragma unroll
            for (int ai = 0; ai < 2; ++ai)
#pragma unroll
                for (int m = 0; m < 4; ++m) { bf16_t* rp = vt + (size_t)(row0 + ai * 128 + m * 16) * VT_PITCH + u.pn * 256 + colu;
#pragma unroll
                    for (int bj = 0; bj < 2; ++bj) *(GAS u32x4*)(rp + bj * 128) = pack8(acc[ai][bj][m][0], acc[ai][bj][m][1]); }
            return; }
        const int pn = u.pn;
        if (pn == 28) {
            if (wc < 2) { const int j0 = 4 * (4 * wc + fq);
#pragma unroll
                for (int ai = 0; ai < 2; ++ai)
#pragma unroll
                    for (int m = 0; m < 4; ++m) { const int row = row0 + ai * 128 + m * 16; const int pos = row < MREAL ? NMETA + (row & (SEQ - 1)) : row - MREAL;
                        f32x4 lo, hi; rope4(acc[ai][0][m][0], acc[ai][0][m][1], cosT, sinT, pos, j0, lo, hi);
                        *(GAS u32x2*)(kr + (size_t)row * 64 + j0) = pack4(lo); *(GAS u32x2*)(kr + (size_t)row * 64 + 32 + j0) = pack4(hi); } }
            return; }
        if (pn >= 12) {
            unsigned char* base = pn < 20 ? ga : gb; const int colt = (pn < 20 ? pn - 12 : pn - 20) * 256 + colu;
#pragma unroll
            for (int ai = 0; ai < 2; ++ai)
#pragma unroll
                for (int m = 0; m < 4; ++m) { unsigned char* rp = base + (size_t)(row0 + ai * 128 + m * 16) * 2048 + colt;
#pragma unroll
                    for (int bj = 0; bj < 2; ++bj) { f32x4 a = acc[ai][bj][m][0], b = acc[ai][bj][m][1];
#pragma unroll
                        for (int i = 0; i < 4; ++i) { a[i] = sigmoidf_(a[i]); b[i] = sigmoidf_(b[i]); }
                        *(GAS u32x2*)(rp + bj * 128) = pack8_u8(a, b); } }
            return; }
        if (pn >= 8) {
            const bool isq = pn < 10; unsigned char* base = isq ? cq : ckv; float* ssq = isq ? ssq_q : ssq_kv; const int colt = (isq ? pn - 8 : pn - 10) * 256 + colu;
#pragma unroll
            for (int ai = 0; ai < 2; ++ai)
#pragma unroll
                for (int m = 0; m < 4; ++m) { const int row = row0 + ai * 128 + m * 16; unsigned char* rp = base + (size_t)row * 512 + colt; float s = 0.f;
#pragma unroll
                    for (int bj = 0; bj < 2; ++bj) { const f32x4 a = acc[ai][bj][m][0], b = acc[ai][bj][m][1];
                        s += (a[0] * a[0] + a[1] * a[1]) + (a[2] * a[2] + a[3] * a[3]) + (b[0] * b[0] + b[1] * b[1]) + (b[2] * b[2] + b[3] * b[3]);
                        *(GAS u32x2*)(rp + bj * 128) = pack8_fp8(a, b); }
                    s += __shfl_xor(s, 16); s += __shfl_xor(s, 32);
                    if (fq == 0) ssq[(size_t)((pn & 1) * 4 + wc) * MPAD + row] = s; }
            return; }
        {
            bf16_t* base = pn < 4 ? naq : nak; const int colt = (pn & 3) * 256 + colu;
#pragma unroll
            for (int ai = 0; ai < 2; ++ai)
#pragma unroll
                for (int m = 0; m < 4; ++m) { bf16_t* rp = base + (size_t)(row0 + ai * 128 + m * 16) * 1024 + colt;
#pragma unroll
                    for (int bj = 0; bj < 2; ++bj) *(GAS u32x4*)(rp + bj * 128) = pack8(acc[ai][bj][m][0], acc[ai][bj][m][1]); }
        }
    }
};
constexpr int P3_Q = 64 * 12, P3_KV = 65 * 16, P3_UNITS = P3_Q + P3_KV;
struct SchedP3 {
    int G, c; const char* cq; const char* ckv; const char* wuq; const char* wukv; size_t tstep;
    __device__ __forceinline__ bool next(int i, Unit& u) const {
        const int L = i * G + c; if (L >= P3_UNITS) return false;
        if (L < P3_Q) { pg8::grid_order(L, 64, 12, u.pm, u.pn); u.kind = 0; } else { pg8::grid_order(L - P3_Q, 65, 16, u.pm, u.pn); u.kind = 1; }
        return true; }
    __device__ __forceinline__ const char* pa(const Unit& u) const { return (u.kind ? ckv : cq) + (size_t)u.pm * tstep; }
    __device__ __forceinline__ const char* pb(const Unit& u) const { return (u.kind ? wukv : wuq) + (size_t)u.pn * tstep; }
};
template <int NS, int LD> __device__ __forceinline__ float rstd_slabs(const float* part, int row, float invn) {
    float s = 0.f;
#pragma unroll
    for (int i = 0; i < NS; ++i) s += part[(size_t)i * LD + row];
    return 1.0f / sqrtf(s * invn + NORM_EPS);
}
struct EpiP3 {
    static constexpr bool PERM = true, HAS_PRE = true;
    bf16_t *qm, *kn, *vv; const float *ssq_q, *ssq_kv; const float *cosT, *sinT;
    __device__ __forceinline__ void pre(const Unit& u, LAS float* sc, int tid) const { if (tid < 256) { const int row = u.pm * 256 + tid; sc[tid] = u.kind ? rstd_slabs<8, MPAD>(ssq_kv, row, 1.f / 512.f) : rstd_slabs<8, MPAD>(ssq_q, row, 1.f / 512.f); } }
    __device__ __forceinline__ void operator()(const f32x4 (&acc)[2][2][4][2], const Unit& u, int wr, int wc, int fr, int fq, const LAS float* rowsc) const {
        const int row0 = u.pm * 256 + wr * 64 + fr, colu = wc * 32 + 8 * fq;
        if (u.kind == 1) {
#pragma unroll
            for (int ai = 0; ai < 2; ++ai)
#pragma unroll
                for (int m = 0; m < 4; ++m) { const int row = row0 + ai * 128 + m * 16; const float rs = rowsc[ai * 128 + wr * 64 + m * 16 + fr];
                    const size_t off = (size_t)row * 2048 + u.pn * 128 + colu;
                    *(GAS u32x4*)(kn + off) = pack8(acc[ai][0][m][0] * rs, acc[ai][0][m][1] * rs);
                    *(GAS u32x4*)(vv + off) = pack8(acc[ai][1][m][0] * rs, acc[ai][1][m][1] * rs); }
            return; }
#pragma unroll
        for (int bj = 0; bj < 2; ++bj) { const int c8 = u.pn * 256 + bj * 128 + colu; const int hd = c8 / 192, w = c8 - hd * 192;
            if (w < 128) {
#pragma unroll
                for (int ai = 0; ai < 2; ++ai)
#pragma unroll
                    for (int m = 0; m < 4; ++m) { const int row = row0 + ai * 128 + m * 16; const float rs = rowsc[ai * 128 + wr * 64 + m * 16 + fr];
                        *(GAS u32x4*)(qm + (size_t)row * 3072 + c8) = pack8(acc[ai][bj][m][0] * rs, acc[ai][bj][m][1] * rs); }
            } else { const int j0 = (w - 128) >> 1;
#pragma unroll
                for (int ai = 0; ai < 2; ++ai)
#pragma unroll
                    for (int m = 0; m < 4; ++m) { const int row = row0 + ai * 128 + m * 16; const float rs = rowsc[ai * 128 + wr * 64 + m * 16 + fr];
                        const int pos = NMETA + (row & (SEQ - 1)); f32x4 lo, hi; rope4(acc[ai][bj][m][0] * rs, acc[ai][bj][m][1] * rs, cosT, sinT, pos, j0, lo, hi);
                        bf16_t* qp = qm + (size_t)row * 3072 + hd * 192 + 128 + j0; *(GAS u32x2*)qp = pack4(lo); *(GAS u32x2*)(qp + 32) = pack4(hi); }
            } }
    }
};
__device__ __forceinline__ void unpack8(const u32x4 w, f32x4& a, f32x4& b) { a = (f32x4){bf_lo(w.x), bf_hi(w.x), bf_lo(w.y), bf_hi(w.y)}; b = (f32x4){bf_lo(w.z), bf_hi(w.z), bf_lo(w.w), bf_hi(w.w)}; }
struct EpiP5a {
    static constexpr bool PERM = true, HAS_PRE = false;
    const unsigned char* ga; unsigned char* t1;
    __device__ __forceinline__ void operator()(const f32x4 (&acc)[2][2][4][2], const Unit& u, int wr, int wc, int fr, int fq, const LAS float* rowsc) const {
        const int row0 = u.pm * 256 + wr * 64 + fr, col0 = u.pn * 256 + wc * 32 + 8 * fq;
#pragma unroll
        for (int ai = 0; ai < 2; ++ai)
#pragma unroll
            for (int m = 0; m < 4; ++m) { const size_t off = (size_t)(row0 + ai * 128 + m * 16) * 2048 + col0;
#pragma unroll
                for (int bj = 0; bj < 2; ++bj) { f32x4 g0, g1; unpack8_u8(*(const GAS u32x2*)(ga + off + bj * 128), g0, g1);
                    *(GAS u32x2*)(t1 + off + bj * 128) = pack8_fp8(acc[ai][bj][m][0] * g0 * 32.f, acc[ai][bj][m][1] * g1 * 32.f); } }
    }
};
struct EpiP5b {
    static constexpr bool PERM = true, HAS_PRE = false;
    const unsigned char* gb; const unsigned char* t1; unsigned char* merged;
    __device__ __forceinline__ void operator()(const f32x4 (&acc)[2][2][4][2], const Unit& u, int wr, int wc, int fr, int fq, const LAS float* rowsc) const {
        const int row0 = u.pm * 256 + wr * 64 + fr, col0 = u.pn * 256 + wc * 32 + 8 * fq;
#pragma unroll
        for (int ai = 0; ai < 2; ++ai)
#pragma unroll
            for (int m = 0; m < 4; ++m) { const size_t off = (size_t)(row0 + ai * 128 + m * 16) * 2048 + col0;
#pragma unroll
                for (int bj = 0; bj < 2; ++bj) { f32x4 g0, g1; unpack8_u8(*(const GAS u32x2*)(gb + off + bj * 128), g0, g1);
                    f32x4 a, b; unpack8_fp8(*(const GAS u32x2*)(t1 + off + bj * 128), a, b);
                    *(GAS u32x2*)(merged + off + bj * 128) = pack8_fp8(a + acc[ai][bj][m][0] * g0 * 32.f, b + acc[ai][bj][m][1] * g1 * 32.f); } }
    }
};
struct EpiP6 {
    static constexpr bool PERM = true, HAS_PRE = false;
    const float* x; bf16_t* h2b; float* ssq2;
    __device__ __forceinline__ void operator()(const f32x4 (&acc)[2][2][4][2], const Unit& u, int wr, int wc, int fr, int fq, const LAS float* rowsc) const {
        const int row0 = u.pm * 256 + wr * 64 + fr, col0 = u.pn * 256 + wc * 32 + 8 * fq;
#pragma unroll
        for (int ai = 0; ai < 2; ++ai)
#pragma unroll
            for (int m = 0; m < 4; ++m) { const int row = row0 + ai * 128 + m * 16; const size_t off = (size_t)row * 2048 + col0; float s = 0.f;
#pragma unroll
                for (int bj = 0; bj < 2; ++bj) { const f32x4 a = *(const GAS f32x4*)(x + off + bj * 128) + acc[ai][bj][m][0], b = *(const GAS f32x4*)(x + off + bj * 128 + 4) + acc[ai][bj][m][1];
                    s += (a[0] * a[0] + a[1] * a[1]) + (a[2] * a[2] + a[3] * a[3]) + (b[0] * b[0] + b[1] * b[1]) + (b[2] * b[2] + b[3] * b[3]);
                    *(GAS u32x4*)(h2b + off + bj * 128) = pack8(a, b); }
                s += __shfl_xor(s, 16); s += __shfl_xor(s, 32);
                if (fq == 0) ssq2[(size_t)(u.pn * 4 + wc) * MREAL + row] = s; }
    }
};
struct EpiP7 {
    static constexpr bool PERM = true, HAS_PRE = true;
    const float* ssq2; _Float16* sc;
    __device__ __forceinline__ void pre(const Unit& u, LAS float* sc, int tid) const { if (tid < 256) sc[tid] = rstd_slabs<32, MREAL>(ssq2, u.pm * 256 + tid, 1.f / 2048.f); }
    __device__ __forceinline__ void operator()(const f32x4 (&acc)[2][2][4][2], const Unit& u, int wr, int wc, int fr, int fq, const LAS float* rowsc) const {
        typedef _Float16 h4_t __attribute__((ext_vector_type(4)));
        const int row0 = u.pm * 256 + wr * 64 + fr, col0 = u.pn * 256 + wc * 32 + 8 * fq;
#pragma unroll
        for (int ai = 0; ai < 2; ++ai)
#pragma unroll
            for (int m = 0; m < 4; ++m) { const int row = row0 + ai * 128 + m * 16; const float rs = rowsc[ai * 128 + wr * 64 + m * 16 + fr]; const size_t off = (size_t)row * 2048 + col0;
#pragma unroll
                for (int bj = 0; bj < 2; ++bj) { const h4_t lo = __builtin_convertvector(acc[ai][bj][m][0] * rs, h4_t), hi = __builtin_convertvector(acc[ai][bj][m][1] * rs, h4_t);
                    const u32x2 wl = __builtin_bit_cast(u32x2, lo), wh = __builtin_bit_cast(u32x2, hi);
                    *(GAS u32x4*)(sc + off + bj * 128) = (u32x4){wl.x, wl.y, wh.x, wh.y}; } }
    }
};
namespace att {
#define KSWZ(row, colB) ((row) * 256 + ((colB) ^ (((row) & 7) << 4)))
#define KRSWZ(row, colB) ((row) * 128 + ((colB) ^ ((((row) >> 1) & 7) << 4)))
constexpr float L2E = 1.4426950408889634f;
template <int DUMMY = 0>
__device__ __forceinline__ void partialSM(f32x16& p0, f32x16& p1, float& m_reg, float& mn, float& alpha, const float C, const float THRS) {
  float pmax = p0[0];
#pragma unroll
  for (int r = 1; r < 16; ++r) pmax = fmaxf(pmax, p0[r]);
#pragma unroll
  for (int r = 0; r < 16; ++r) pmax = fmaxf(pmax, p1[r]);
  { auto rr = __builtin_amdgcn_permlane32_swap(__float_as_uint(pmax), __float_as_uint(pmax), false, false);
    pmax = fmaxf(__uint_as_float(rr[0]), __uint_as_float(rr[1])); }
  if (__builtin_expect(__all(pmax - m_reg <= THRS), 1)) { mn = m_reg; alpha = 1.f; }
  else { mn = fmaxf(m_reg, pmax); alpha = __builtin_amdgcn_exp2f((m_reg - mn) * C); m_reg = mn; }
  const float mnC = -mn * C;
#pragma unroll
  for (int r = 0; r < 16; ++r) p0[r] = fmaf(p0[r], C, mnC);
#pragma unroll
  for (int r = 0; r < 16; ++r) p1[r] = fmaf(p1[r], C, mnC);
#pragma unroll
  for (int r = 0; r < 16; ++r) p0[r] = __builtin_amdgcn_exp2f(p0[r]);
}
__device__ __forceinline__ void finishSM(f32x16& p0, f32x16& p1, float alpha, float& l_reg, bf16x8& pa0, bf16x8& pa1, bf16x8& pa2, bf16x8& pa3) {
#pragma unroll
  for (int r = 0; r < 16; ++r) p1[r] = __builtin_amdgcn_exp2f(p1[r]);
  float ps = 0;
#pragma unroll
  for (int r = 0; r < 16; ++r) ps += p0[r];
#pragma unroll
  for (int r = 0; r < 16; ++r) ps += p1[r];
  { auto rr = __builtin_amdgcn_permlane32_swap(__float_as_uint(ps), __float_as_uint(ps), false, false);
    ps = __uint_as_float(rr[0]) + __uint_as_float(rr[1]); }
  l_reg = l_reg * alpha + ps;
#define PK4(P, BASE, OUT) do { unsigned a0 = cvt_pk_bf16(P[BASE + 0], P[BASE + 1]), a1 = cvt_pk_bf16(P[BASE + 2], P[BASE + 3]);   \
    unsigned b0 = cvt_pk_bf16(P[BASE + 4], P[BASE + 5]), b1 = cvt_pk_bf16(P[BASE + 6], P[BASE + 7]);                              \
    auto r0 = __builtin_amdgcn_permlane32_swap(a0, b0, false, false); auto r1 = __builtin_amdgcn_permlane32_swap(a1, b1, false, false); \
    u32x4 w = {r0[0], r1[0], r0[1], r1[1]}; OUT = __builtin_bit_cast(bf16x8, w); } while (0)
  PK4(p0, 0, pa0); PK4(p0, 8, pa1); PK4(p1, 0, pa2); PK4(p1, 8, pa3);
#undef PK4
}
constexpr int NW = 8, QBLK = 32, KVBLK = 64;
constexpr float MLA_SCALE = 0.07216878364870322f;
constexpr float MLA_THR = 8.f;
constexpr int SHM_V = KVBLK * 128 * 2, SHM_KN = KVBLK * 128 * 2, SHM_KR = KVBLK * 64 * 2;
constexpr int OFF_V = 0, OFF_KN = 2 * SHM_V, OFF_KR = OFF_KN + 2 * SHM_KN, OFF_WS = OFF_KR + 2 * SHM_KR, OFF_QR = OFF_WS + NW * 64 * 4, MLA_LDS = OFF_QR + NW * 4096;
__device__ __forceinline__ void qkt(f32x16& p0, f32x16& p1, const LAS char* Kn, const LAS char* Kr, const bf16x8* qr, const LAS char* qrp, const int* kb, const int* krb) {
  p0 = f32x16{}; p1 = f32x16{};
#pragma unroll
  for (int d0 = 0; d0 < 8; ++d0) {
    const bf16x8 b0 = *(const LAS bf16x8*)(Kn + kb[d0 & 3] + (d0 >> 2) * 128);
    const bf16x8 b1 = *(const LAS bf16x8*)(Kn + kb[d0 & 3] + (d0 >> 2) * 128 + 8192);
    p0 = __builtin_amdgcn_mfma_f32_32x32x16_bf16(b0, qr[d0], p0, 0, 0, 0);
    p1 = __builtin_amdgcn_mfma_f32_32x32x16_bf16(b1, qr[d0], p1, 0, 0, 0); }
#pragma unroll
  for (int d0 = 0; d0 < 4; ++d0) {
    const bf16x8 b0 = *(const LAS bf16x8*)(Kr + krb[d0]);
    const bf16x8 b1 = *(const LAS bf16x8*)(Kr + krb[d0] + 4096);
    const bf16x8 qf = *(const LAS bf16x8*)(qrp + d0 * 1024);
    p0 = __builtin_amdgcn_mfma_f32_32x32x16_bf16(b0, qf, p0, 0, 0, 0);
    p1 = __builtin_amdgcn_mfma_f32_32x32x16_bf16(b1, qf, p1, 0, 0, 0); }
}
__device__ __forceinline__ int v_st(int k, int c) { const int kk = (k & ~0xC) | ((k & 4) << 1) | ((k & 8) >> 1); return ((kk >> 3) * 4 + (c >> 5)) * 512 + ((kk & 7) * 32 + (c & 31)) * 2; }
__device__ __forceinline__ int v_rd_base(int lane) { return ((lane & 3) << 3) | (((lane >> 2) & 3) << 6) | (((lane >> 4) & 1) << 5) | (((lane >> 5) & 1) << 8); }
constexpr int v_rd_off(int d0, int ks, int half) { return d0 * 512 + ks * 4096 + half * 2048; }
template <int OFF> __device__ __forceinline__ s16x4 tr_read(int vb) {
  s16x4 r; asm volatile("ds_read_b64_tr_b16 %0, %1 offset:%2" : "=&v"(r) : "v"(vb), "i"(OFF) : "memory"); return r;
}
template <int D0> __device__ __forceinline__ void pv_one(f32x16& od, int vb, bf16x8 pa0, bf16x8 pa1, bf16x8 pa2, bf16x8 pa3) {
  const s16x4 l0 = tr_read<v_rd_off(D0, 0, 0)>(vb), h0 = tr_read<v_rd_off(D0, 0, 1)>(vb), l1 = tr_read<v_rd_off(D0, 1, 0)>(vb), h1 = tr_read<v_rd_off(D0, 1, 1)>(vb);
  const s16x4 l2 = tr_read<v_rd_off(D0, 2, 0)>(vb), h2 = tr_read<v_rd_off(D0, 2, 1)>(vb), l3 = tr_read<v_rd_off(D0, 3, 0)>(vb), h3 = tr_read<v_rd_off(D0, 3, 1)>(vb);
  asm volatile("s_waitcnt lgkmcnt(0)" ::: "memory"); SBAR();
#define PK(L, H) (bf16x8){L[0], L[1], L[2], L[3], H[0], H[1], H[2], H[3]}
  od = __builtin_amdgcn_mfma_f32_32x32x16_bf16(pa0, PK(l0, h0), od, 0, 0, 0);
  od = __builtin_amdgcn_mfma_f32_32x32x16_bf16(pa1, PK(l1, h1), od, 0, 0, 0);
  od = __builtin_amdgcn_mfma_f32_32x32x16_bf16(pa2, PK(l2, h2), od, 0, 0, 0);
  od = __builtin_amdgcn_mfma_f32_32x32x16_bf16(pa3, PK(l3, h3), od, 0, 0, 0);
#undef PK
}
__device__ __forceinline__ void pv_d0(f32x16* o, int vb, bf16x8 pa0, bf16x8 pa1, bf16x8 pa2, bf16x8 pa3) {
  pv_one<0>(o[0], vb, pa0, pa1, pa2, pa3); pv_one<1>(o[1], vb, pa0, pa1, pa2, pa3); pv_one<2>(o[2], vb, pa0, pa1, pa2, pa3); pv_one<3>(o[3], vb, pa0, pa1, pa2, pa3);
}
__device__ __forceinline__ void mla_unit(int b, int h, int qb, const bf16_t* __restrict__ QM, const bf16_t* __restrict__ KN, const bf16_t* __restrict__ KR, const bf16_t* __restrict__ VV, unsigned char* __restrict__ OM, LAS char* lds) {
  const int tid = threadIdx.x, wid = tid >> 6, lane = tid & 63, r32 = lane & 31, hi = lane >> 5;
  constexpr float C = MLA_SCALE * L2E, THRS = MLA_THR / MLA_SCALE;
  constexpr int NT = 33;
  LAS char* V_lds = lds + OFF_V; LAS char* Kn_lds = lds + OFF_KN; LAS char* Kr_lds = lds + OFF_KR;
  LAS float* ws = (LAS float*)(lds + OFF_WS) + wid * 64; LAS float* li_l = ws; LAS float* al_l = ws + 32;
  float m_reg = -1e30f, l_reg = 0; f32x16 o[4] = {}; bf16x8 qr[8];
  LAS char* qrp = lds + OFF_QR + wid * 4096 + lane * 16;
  const int qrow = b * SEQ + qb * 256 + wid * QBLK + r32;
  const bf16_t* Qw = QM + (size_t)qrow * 3072 + h * 192 + hi * 8;
#pragma unroll
  for (int d0 = 0; d0 < 8; ++d0) qr[d0] = *(const GAS bf16x8*)(Qw + d0 * 16);
  __syncthreads();
#pragma unroll
  for (int d0 = 0; d0 < 4; ++d0) *(LAS bf16x8*)(qrp + d0 * 1024) = *(const GAS bf16x8*)(Qw + (8 + d0) * 16);
  const int sr = tid >> 4, sc = (tid & 15) * 8, vst0 = v_st(sr, sc), vst1 = v_st(32 + sr, sc);
  const int krr = tid >> 3, krc = (tid & 7) * 8;
  const int vb0 = (int)(uintptr_t)V_lds + v_rd_base(lane);
  bf16x8 s_v0, s_v1, s_k0, s_k1, s_kr;
  const int realbase = b * SEQ - KVBLK;
  const unsigned voff = (unsigned)(sr * 2048 + sc) * 2u, kroff = (unsigned)(krr * 64 + krc) * 2u;
  int kb[4], krb[4];
#pragma unroll
  for (int bq = 0; bq < 4; ++bq) { kb[bq] = KSWZ(r32, bq * 32 + hi * 16); krb[bq] = KRSWZ(r32, bq * 32 + hi * 16); }
#define TROW(t) ((t) == 0 ? MREAL : realbase + (t) * KVBLK)
#define SLOAD(t) do { const int k0_ = TROW(t); const size_t ro_ = ((size_t)k0_ * 2048 + h * 128) * 2; \
    const GAS char* vb_ = (const GAS char*)VV + ro_; const GAS char* nb_ = (const GAS char*)KN + ro_; const GAS char* rb_ = (const GAS char*)KR + (size_t)k0_ * 128; \
    s_v0 = *(const GAS bf16x8*)(vb_ + voff); s_v1 = *(const GAS bf16x8*)(vb_ + 32 * 4096 + voff); \
    s_k0 = *(const GAS bf16x8*)(nb_ + voff); s_k1 = *(const GAS bf16x8*)(nb_ + 32 * 4096 + voff); \
    s_kr = *(const GAS bf16x8*)(rb_ + kroff); } while (0)
#define SWRITE(bf) do { *(LAS bf16x8*)(V_lds + (bf) * SHM_V + vst0) = s_v0; *(LAS bf16x8*)(V_lds + (bf) * SHM_V + vst1) = s_v1; const int kc_ = sc * 2; \
    *(LAS bf16x8*)(Kn_lds + (bf) * SHM_KN + KSWZ(sr, kc_)) = s_k0; *(LAS bf16x8*)(Kn_lds + (bf) * SHM_KN + KSWZ(32 + sr, kc_)) = s_k1; \
    *(LAS bf16x8*)(Kr_lds + (bf) * SHM_KR + KRSWZ(krr, krc * 2)) = s_kr; } while (0)
#define SWAIT() asm volatile("s_waitcnt vmcnt(0)" ::: "memory")
#define RESC(a) do { if (__any((a) < 1.f)) { if (hi == 0) al_l[r32] = (a); asm volatile("s_waitcnt lgkmcnt(0)" ::: "memory"); \
    _Pragma("unroll") for (int d = 0; d < 4; ++d) _Pragma("unroll") for (int r = 0; r < 16; ++r) o[d][r] *= al_l[crow(r, hi)]; } } while (0)
  f32x16 pA0, pA1, pB0, pB1; float mnA, mnB, alA, alB; bf16x8 pa0, pa1, pa2, pa3;
  SLOAD(0); SWAIT(); SWRITE(0); __syncthreads();
  qkt(pA0, pA1, Kn_lds, Kr_lds, qr, qrp, kb, krb);
  { const float NEG = -INFINITY;
#pragma unroll
    for (int r = 8; r < 16; ++r) pA0[r] = NEG;
#pragma unroll
    for (int r = 0; r < 16; ++r) pA1[r] = NEG; }
  partialSM(pA0, pA1, m_reg, mnA, alA, C, THRS);
  SLOAD(1); SWAIT(); SWRITE(1); __syncthreads();
  for (int j = 1; j + 1 < NT; j += 2) {
    SBAR(); qkt(pB0, pB1, Kn_lds + SHM_KN, Kr_lds + SHM_KR, qr, qrp, kb, krb);
    finishSM(pA0, pA1, alA, l_reg, pa0, pa1, pa2, pa3); SBAR();
    SLOAD(j + 1); SBAR();
    pv_d0(o, vb0, pa0, pa1, pa2, pa3); partialSM(pB0, pB1, m_reg, mnB, alB, C, THRS);
    __syncthreads(); SWAIT(); SWRITE(0);
    RESC(alB); __syncthreads();
    SBAR(); qkt(pA0, pA1, Kn_lds, Kr_lds, qr, qrp, kb, krb);
    finishSM(pB0, pB1, alB, l_reg, pa0, pa1, pa2, pa3); SBAR();
    if (j + 2 < NT) SLOAD(j + 2); SBAR();
    pv_d0(o, vb0 + SHM_V, pa0, pa1, pa2, pa3); partialSM(pA0, pA1, m_reg, mnA, alA, C, THRS);
    __syncthreads(); if (j + 2 < NT) { SWAIT(); SWRITE(1); }
    RESC(alA); __syncthreads();
  }
  finishSM(pA0, pA1, alA, l_reg, pa0, pa1, pa2, pa3); SBAR();
  pv_d0(o, vb0, pa0, pa1, pa2, pa3);
  if (hi == 0) li_l[r32] = l_reg; asm volatile("s_waitcnt lgkmcnt(0)" ::: "memory");
  float rli[16];
#pragma unroll
  for (int r = 0; r < 16; ++r) rli[r] = __builtin_amdgcn_rcpf(li_l[crow(r, hi)]);
  unsigned char* Ow = OM + (size_t)(b * SEQ + qb * 256 + wid * QBLK) * 2048 + h * 128;
#pragma unroll
  for (int r = 0; r < 16; ++r) { const int orow = crow(r, hi);
#pragma unroll
    for (int d0 = 0; d0 < 4; ++d0) Ow[(size_t)orow * 2048 + d0 * 32 + r32] = f32_to_fp8(o[d0][r] * rli[r] * 32.f); }
#undef TROW
#undef SLOAD
#undef SWRITE
#undef SWAIT
#undef RESC
}
__device__ __forceinline__ void na_task(int task, const bf16_t* __restrict__ NAQ, const bf16_t* __restrict__ NAK, const bf16_t* __restrict__ VT, unsigned char* __restrict__ ONA,
                                        const LAS float* relb, const LAS float* metab, LAS float* wsf, int lane, Conv& cv) {
  const int r32 = lane & 31, hi = lane >> 5;
  const int half = task & 1, r = (task >> 1) & 31, h = (task >> 6) & 15, b = task >> 10;
  const int qc = half * 32 + r32;
  const int cs = min(max(qc - 8, 0), 48), rs = min(max(r - 4, 0), 24);
  const int qtok = b * SEQ + r * 64 + qc;
  constexpr float C = L2E, THRS = 8.f, SCALE = 0.125f;
  bf16x8 qr[4];
#pragma unroll
  for (int d0 = 0; d0 < 4; ++d0) qr[d0] = *(const GAS bf16x8*)(NAQ + (size_t)qtok * 1024 + h * 64 + d0 * 16 + hi * 8);
  float m_reg = -1e30f, l_reg = 0.f; f32x16 o[2] = {};
  LAS float* al_l = wsf; LAS float* li_l = wsf + 32;
  const float NEG = -INFINITY;
  const int kb0 = half * 16;
  const unsigned long long wm = 0xFFFFull << (cs - kb0);
  const unsigned mh0 = (unsigned)wm >> (4 * hi), mh1 = (unsigned)(wm >> 32) >> (4 * hi);
  const bf16_t* kq = NAK + (size_t)r32 * 1024 + h * 64 + hi * 8;
  const bf16_t* kq2 = NAK + (size_t)(32 + (r32 & 15)) * 1024 + h * 64 + hi * 8;
  const bf16_t* vq = VT + (size_t)(h * 64 + r32) * VT_PITCH + 8 * hi;
#define NA_KTOK(w) ((w) == 8 ? MREAL : b * SEQ + (rs + (w)) * 64 + kb0)
#define NA_LOADK(KF, w) do { const size_t ko_ = (size_t)NA_KTOK(w) * 1024; _Pragma("unroll") for (int d0 = 0; d0 < 4; ++d0) { KF[d0] = *(const GAS bf16x8*)(kq + ko_ + d0 * 16); KF[4 + d0] = *(const GAS bf16x8*)(kq2 + ko_ + d0 * 16); } } while (0)
#define NA_TILE(KF, w, YN) do { \
    bf16x8 vf[6]; { const bf16_t* vp_ = vq + NA_KTOK(w); _Pragma("unroll") for (int ks = 0; ks < 3; ++ks) { vf[ks] = *(const GAS bf16x8*)(vp_ + 16 * ks); vf[3 + ks] = *(const GAS bf16x8*)(vp_ + (size_t)32 * VT_PITCH + 16 * ks); } } \
    f32x16 p0 = {}, p1 = {}; \
    _Pragma("unroll") for (int d0 = 0; d0 < 4; ++d0) { p0 = __builtin_amdgcn_mfma_f32_32x32x16_bf16(KF[d0], qr[d0], p0, 0, 0, 0); p1 = __builtin_amdgcn_mfma_f32_32x32x16_bf16(KF[4 + d0], qr[d0], p1, 0, 0, 0); } \
    if ((w) + 1 < 9) NA_LOADK(KF, (w) + 1);            \
    asm volatile("" ::: "memory"); if ((cv.tick++ & 1) == 0) conv_step<20>(cv, lane);     \
    if ((w) < 8) { const LAS float* bp_ = relb + ((h * 15 + (rs + (w) - r + 7)) * 31 + 15 - qc + 4 * hi + kb0);     \
      float bv0[16], bv1[8];        \
      _Pragma("unroll") for (int rg = 0; rg < 16; ++rg) { const int c_ = (rg & 3) + 8 * (rg >> 2); bv0[rg] = bp_[c_]; if (rg < 8) bv1[rg] = bp_[c_ + 32]; } \
      _Pragma("unroll") for (int rg = 0; rg < 16; ++rg) { asm volatile("" : "+v"(bv0[rg])); if (rg < 8) asm volatile("" : "+v"(bv1[rg])); } \
      _Pragma("unroll") for (int rg = 0; rg < 16; ++rg) { const int c_ = (rg & 3) + 8 * (rg >> 2); \
        { const bool ok = (mh0 >> c_) & 1u; p0[rg] = ok ? fmaf(p0[rg], SCALE, bv0[rg]) : NEG; } \
        if (rg < 8) { const bool ok = (mh1 >> c_) & 1u; p1[rg] = ok ? fmaf(p1[rg], SCALE, bv1[rg]) : NEG; } } \
    } else { const LAS float* bp = metab + h * 16; \
      _Pragma("unroll") for (int rg = 0; rg < 16; ++rg) { const int kc = crow(rg, hi); p0[rg] = (rg < 8) ? fmaf(p0[rg], SCALE, bp[kc & 15]) : NEG; if (rg < 8) p1[rg] = NEG; } } \
      \
    float pmax = p0[0]; \
    _Pragma("unroll") for (int rg = 1; rg < 16; ++rg) pmax = fmaxf(pmax, p0[rg]); \
    _Pragma("unroll") for (int rg = 0; rg < 8; ++rg) pmax = fmaxf(pmax, p1[rg]); \
    { auto rr = __builtin_amdgcn_permlane32_swap(__float_as_uint(pmax), __float_as_uint(pmax), false, false); pmax = fmaxf(__uint_as_float(rr[0]), __uint_as_float(rr[1])); } \
    float mn, alpha; \
    if (__builtin_expect(__all(pmax - m_reg <= THRS), 1)) { mn = m_reg; alpha = 1.f; } \
    else { mn = fmaxf(m_reg, pmax); alpha = __builtin_amdgcn_exp2f((m_reg - mn) * C); m_reg = mn; } \
    const float mnC = -mn * C; float ps = 0.f; \
    _Pragma("unroll") for (int rg = 0; rg < 16; ++rg) { p0[rg] = __builtin_amdgcn_exp2f(fmaf(p0[rg], C, mnC)); ps += p0[rg]; } \
    _Pragma("unroll") for (int rg = 0; rg < 8; ++rg) { p1[rg] = __builtin_amdgcn_exp2f(fmaf(p1[rg], C, mnC)); ps += p1[rg]; } \
    { auto rr = __builtin_amdgcn_permlane32_swap(__float_as_uint(ps), __float_as_uint(ps), false, false); ps = __uint_as_float(rr[0]) + __uint_as_float(rr[1]); } \
    l_reg = l_reg * alpha + ps; \
    bf16x8 pa0, pa1, pa2; NA_PK4(p0, 0, pa0); NA_PK4(p0, 8, pa1); NA_PK4(p1, 0, pa2); \
    if (__any(alpha < 1.f)) { if (hi == 0) al_l[r32] = alpha; asm volatile("s_waitcnt lgkmcnt(0)" ::: "memory"); \
      _Pragma("unroll") for (int d = 0; d < 2; ++d) _Pragma("unroll") for (int rg = 0; rg < 16; ++rg) o[d][rg] *= al_l[crow(rg, hi)]; } \
    _Pragma("unroll") for (int d0 = 0; d0 < 2; ++d0) { \
      o[d0] = __builtin_amdgcn_mfma_f32_32x32x16_bf16(pa0, vf[3 * d0 + 0], o[d0], 0, 0, 0); o[d0] = __builtin_amdgcn_mfma_f32_32x32x16_bf16(pa1, vf[3 * d0 + 1], o[d0], 0, 0, 0); \
      o[d0] = __builtin_amdgcn_mfma_f32_32x32x16_bf16(pa2, vf[3 * d0 + 2], o[d0], 0, 0, 0); } } while (0)
#define NA_PK4(P, BASE, OUT) do { unsigned a0 = cvt_pk_bf16(P[BASE + 0], P[BASE + 1]), a1 = cvt_pk_bf16(P[BASE + 2], P[BASE + 3]);   \
    unsigned b0 = cvt_pk_bf16(P[BASE + 4], P[BASE + 5]), b1 = cvt_pk_bf16(P[BASE + 6], P[BASE + 7]);                              \
    auto r0 = __builtin_amdgcn_permlane32_swap(a0, b0, false, false); auto r1 = __builtin_amdgcn_permlane32_swap(a1, b1, false, false); \
    u32x4 w_ = {r0[0], r1[0], r0[1], r1[1]}; OUT = __builtin_bit_cast(bf16x8, w_); } while (0)
  { bf16x8 kA[8];
    NA_LOADK(kA, 0);
#pragma unroll 1
    for (int w = 0; w < 8; ++w) { NA_TILE(kA, w, 14); }
    NA_TILE(kA, 8, 6); }
#undef NA_PK4
#undef NA_KTOK
#undef NA_LOADK
#undef NA_TILE
  if (hi == 0) li_l[r32] = l_reg; asm volatile("s_waitcnt lgkmcnt(0)" ::: "memory");
  unsigned char* Ow = ONA + (size_t)(b * SEQ + r * 64 + half * 32) * 1024 + h * 64;
#pragma unroll
  for (int rg = 0; rg < 16; ++rg) { const int orow = crow(rg, hi); const float rl = __builtin_amdgcn_rcpf(li_l[orow]);
#pragma unroll
    for (int d0 = 0; d0 < 2; ++d0) Ow[(size_t)orow * 1024 + d0 * 32 + r32] = f32_to_fp8(o[d0][rg] * rl * 16.f); }
  asm volatile("s_waitcnt lgkmcnt(0)" ::: "memory");
}
}
namespace peer {
constexpr int CH = 32;
constexpr int OFF_TV = 0, OFF_TI = OFF_TV + CH * 16 * 16 * 4, OFF_SE = OFF_TI + CH * 16 * 16 * 4, OFF_SG = OFF_SE + CH * 128 * 4, OFF_SE2 = OFF_SG + CH * 128 * 4, OFF_SG2 = OFF_SE2 + CH * 128 * 4, PEER_LDS = OFF_SG2 + CH * 128 * 4;
static_assert(PEER_LDS <= RING_BYTES, "PEER LDS");
__device__ __forceinline__ float gelu_tanh(float x) {
    const float u = 0.7978845608028654f * (x + 0.044715f * x * x * x);
    const float e = __builtin_amdgcn_exp2f(-2.f * 1.4426950408889634f * fabsf(u));
    const float t = (1.f - e) * __builtin_amdgcn_rcpf(1.f + e);
    return 0.5f * x * (1.f + (u < 0.f ? -t : t));
}
__device__ __forceinline__ void fmac1(float& acc, float a, float b) { asm("v_fmac_f32_e32 %0, %1, %2" : "+v"(acc) : "v"(a), "v"(b)); }
#define PEER_INSERT(x_, xi_) do { float x__ = (x_); int xi__ = (xi_); \
    _Pragma("unroll") for (int j_ = 0; j_ < 16; ++j_) { const bool gt_ = x__ > tv[j_]; const float tvo_ = tv[j_]; const int tio_ = ti[j_]; \
        tv[j_] = gt_ ? x__ : tvo_; ti[j_] = gt_ ? xi__ : tio_; x__ = gt_ ? tvo_ : x__; xi__ = gt_ ? tio_ : xi__; } } while (0)

#define PEER_AUX 0
typedef __amdgpu_buffer_rsrc_t rsrc_t;
__device__ __forceinline__ rsrc_t mk_rsrc(const void* p, unsigned bytes) { return __builtin_amdgcn_make_buffer_rsrc((void*)p, 0, bytes, 0x00020000); }
__device__ __forceinline__ u32x4 ldb128(rsrc_t r, unsigned off) { return __builtin_amdgcn_raw_buffer_load_b128(r, off, 0, PEER_AUX); }
typedef unsigned v6u_t __attribute__((ext_vector_type(6)));
typedef float v32f_t __attribute__((ext_vector_type(32)));
typedef float v16f_t __attribute__((ext_vector_type(16)));
__device__ __forceinline__ u32x2 ldb64(rsrc_t r, unsigned off) { return __builtin_amdgcn_raw_buffer_load_b64(r, off, 0, PEER_AUX); }
__device__ __forceinline__ f32x4 ldf128(rsrc_t r, unsigned off) { return __builtin_bit_cast(f32x4, __builtin_amdgcn_raw_buffer_load_b128(r, off, 0, PEER_AUX)); }
__device__ __forceinline__ f32x4 ldf128_nt(rsrc_t r, unsigned off) { return __builtin_bit_cast(f32x4, __builtin_amdgcn_raw_buffer_load_b128(r, off, 0, 2)); }
__device__ __forceinline__ void peer_select(int chunk, const _Float16* __restrict__ SC, LAS char* lds, int tid, LAS int* SE, LAS float* SG) {
    LAS float* TV = (LAS float*)(lds + OFF_TV); LAS int* TI = (LAS int*)(lds + OFF_TI);
    asm volatile("" : "+v"(tid));
    const int tok0 = chunk * CH;
    const rsrc_t rSC = mk_rsrc(SC, 0x4000000u);
    __syncthreads();
    { const int tl = tid >> 4, g = tid & 15; const unsigned spo = ((unsigned)(tok0 + tl) * 2048u + (unsigned)g * 128u) * 2u;
      int tk[16];
#pragma unroll
      for (int j = 0; j < 16; ++j) tk[j] = (int)0x80000000;
#define PEER_KEY(x_, lowbits_, mask_) ({ const int f_ = __float_as_int(x_); ((f_ ^ ((f_ >> 31) & 0x7fffffff)) & ~(mask_)) | (lowbits_); })
#define PEER_INS(key_) do { int x__ = (key_); _Pragma("unroll") for (int j_ = 0; j_ < 16; ++j_) { const int hi_ = max(x__, tk[j_]); x__ = min(x__, tk[j_]); tk[j_] = hi_; } } while (0)
      typedef _Float16 h8_t __attribute__((ext_vector_type(8)));
#define PEER_CX(a_, b_) do { const int hi_ = max(a_, b_), lo_ = min(a_, b_); a_ = hi_; b_ = lo_; } while (0)
      u32x4 na = __builtin_amdgcn_raw_buffer_load_b128(rSC, spo, 0, 2), nb = __builtin_amdgcn_raw_buffer_load_b128(rSC, spo + 16, 0, 2);
#pragma unroll 1
      for (int i = 0; i < 16; i += 2) { const h8_t a = __builtin_bit_cast(h8_t, na), b = __builtin_bit_cast(h8_t, nb);
          { const unsigned on = spo + (unsigned)min(i + 2, 14) * 16u; na = __builtin_amdgcn_raw_buffer_load_b128(rSC, on, 0, 2); nb = __builtin_amdgcn_raw_buffer_load_b128(rSC, on + 16, 0, 2); }
          int kk[16];
#pragma unroll
          for (int e = 0; e < 8; ++e) { kk[e] = PEER_KEY((float)a[e], 127 - (8 * i + e), 127); kk[8 + e] = PEER_KEY((float)b[e], 127 - (8 * i + 8 + e), 127); }
          PEER_CX(kk[0], kk[13]); PEER_CX(kk[1], kk[12]); PEER_CX(kk[2], kk[15]); PEER_CX(kk[3], kk[14]); PEER_CX(kk[4], kk[8]); PEER_CX(kk[5], kk[6]); PEER_CX(kk[7], kk[11]); PEER_CX(kk[9], kk[10]); PEER_CX(kk[0], kk[5]); PEER_CX(kk[1], kk[7]); PEER_CX(kk[2], kk[9]); PEER_CX(kk[3], kk[4]); PEER_CX(kk[6], kk[13]); PEER_CX(kk[8], kk[14]); PEER_CX(kk[10], kk[15]); PEER_CX(kk[11], kk[12]); PEER_CX(kk[0], kk[1]); PEER_CX(kk[2], kk[3]); PEER_CX(kk[4], kk[5]); PEER_CX(kk[6], kk[8]); PEER_CX(kk[7], kk[9]); PEER_CX(kk[10], kk[11]); PEER_CX(kk[12], kk[13]); PEER_CX(kk[14], kk[15]); PEER_CX(kk[0], kk[2]); PEER_CX(kk[1], kk[3]); PEER_CX(kk[4], kk[10]); PEER_CX(kk[5], kk[11]); PEER_CX(kk[6], kk[7]); PEER_CX(kk[8], kk[9]); PEER_CX(kk[12], kk[14]); PEER_CX(kk[13], kk[15]); PEER_CX(kk[1], kk[2]); PEER_CX(kk[3], kk[12]); PEER_CX(kk[4], kk[6]); PEER_CX(kk[5], kk[7]); PEER_CX(kk[8], kk[10]); PEER_CX(kk[9], kk[11]); PEER_CX(kk[13], kk[14]); PEER_CX(kk[1], kk[4]); PEER_CX(kk[2], kk[6]); PEER_CX(kk[5], kk[8]); PEER_CX(kk[7], kk[10]); PEER_CX(kk[9], kk[13]); PEER_CX(kk[11], kk[14]); PEER_CX(kk[2], kk[4]); PEER_CX(kk[3], kk[6]); PEER_CX(kk[9], kk[12]); PEER_CX(kk[11], kk[13]); PEER_CX(kk[3], kk[5]); PEER_CX(kk[6], kk[8]); PEER_CX(kk[7], kk[9]); PEER_CX(kk[10], kk[12]); PEER_CX(kk[3], kk[4]); PEER_CX(kk[5], kk[6]); PEER_CX(kk[7], kk[8]); PEER_CX(kk[9], kk[10]); PEER_CX(kk[11], kk[12]); PEER_CX(kk[6], kk[7]); PEER_CX(kk[8], kk[9]);
#pragma unroll
          for (int e = 0; e < 16; ++e) tk[e] = max(tk[e], kk[15 - e]);
          PEER_CX(tk[0], tk[8]); PEER_CX(tk[1], tk[9]); PEER_CX(tk[2], tk[10]); PEER_CX(tk[3], tk[11]); PEER_CX(tk[4], tk[12]); PEER_CX(tk[5], tk[13]); PEER_CX(tk[6], tk[14]); PEER_CX(tk[7], tk[15]); PEER_CX(tk[0], tk[4]); PEER_CX(tk[1], tk[5]); PEER_CX(tk[2], tk[6]); PEER_CX(tk[3], tk[7]); PEER_CX(tk[8], tk[12]); PEER_CX(tk[9], tk[13]); PEER_CX(tk[10], tk[14]); PEER_CX(tk[11], tk[15]); PEER_CX(tk[0], tk[2]); PEER_CX(tk[1], tk[3]); PEER_CX(tk[4], tk[6]); PEER_CX(tk[5], tk[7]); PEER_CX(tk[8], tk[10]); PEER_CX(tk[9], tk[11]); PEER_CX(tk[12], tk[14]); PEER_CX(tk[13], tk[15]); PEER_CX(tk[0], tk[1]); PEER_CX(tk[2], tk[3]); PEER_CX(tk[4], tk[5]); PEER_CX(tk[6], tk[7]); PEER_CX(tk[8], tk[9]); PEER_CX(tk[10], tk[11]); PEER_CX(tk[12], tk[13]); PEER_CX(tk[14], tk[15]); }
#undef PEER_CX
      LAS float* tvp = TV + (tl * 16 + g) * 16; LAS int* tip = TI + (tl * 16 + g) * 16;
#pragma unroll
      for (int j = 0; j < 16; ++j) { const int k_ = tk[j] & ~127; tvp[j] = __int_as_float(k_ ^ ((k_ >> 31) & 0x7fffffff)); tip[j] = 127 - (tk[j] & 127); } }
    __syncthreads();
    asm volatile("" : "+v"(tid));
    { const int tl = tid >> 4, hh = (tid >> 1) & 7, half = tid & 1;
      const LAS float* s1 = TV + (tl * 16 + 2 * hh) * 16; const LAS float* s2 = s1 + 16; const LAS int* i1 = TI + (tl * 16 + 2 * hh) * 16; const LAS int* i2 = i1 + 16;
      float b2[16];
#pragma unroll
      for (int j = 0; j < 16; ++j) b2[j] = s2[j];
      int tk[16];
#pragma unroll
      for (int j = 0; j < 16; ++j) tk[j] = (int)0x80000000;
#pragma unroll
      for (int ii = 0; ii < 8; ++ii) { const int i = 2 * ii + half; const float a = s1[i];
#pragma unroll
          for (int j = 0; j < 16; ++j) if ((2 * ii + 1) * (j + 1) <= 16) { if (half == 0 || (2 * ii + 2) * (j + 1) <= 16) PEER_INS(PEER_KEY(a + b2[j], 255 - (i * 16 + j), 255)); } }
      { int pk[16];
#pragma unroll
        for (int j = 0; j < 16; ++j) pk[j] = __shfl_xor(tk[j], 1);
#pragma unroll
        for (int j = 0; j < 16; ++j) PEER_INS(pk[j]); }
      if (half == 0) { float e[16], sum = 0.f; const int k0_ = tk[0] & ~255; const float v0 = __int_as_float(k0_ ^ ((k0_ >> 31) & 0x7fffffff));
#pragma unroll
        for (int j = 0; j < 16; ++j) { const int k_ = tk[j] & ~255; const float vj = __int_as_float(k_ ^ ((k_ >> 31) & 0x7fffffff)); e[j] = __builtin_amdgcn_exp2f((vj - v0) * 1.4426950408889634f); sum += e[j]; }
        const float inv = 1.0f / sum;
#pragma unroll
        for (int j = 0; j < 16; ++j) { const int ci = 255 - (tk[j] & 255); SE[tl * 128 + hh * 16 + j] = i1[ci >> 4] * 128 + i2[ci & 15]; SG[tl * 128 + hh * 16 + j] = e[j] * inv; } } }
#undef PEER_KEY
#undef PEER_INS
    __syncthreads();
}
__device__ __forceinline__ void peer_gather(int chunk, const bf16_t* __restrict__ H2, const unsigned char* __restrict__ U, const unsigned char* __restrict__ V,
                                            const float* __restrict__ g2, const float* __restrict__ gf, float* OUT, int tid, const LAS int* SE, const LAS float* SG) {
    asm volatile("" : "+v"(tid));
    const int tok0 = chunk * CH, lane = tid & 63, wave = tid >> 6;
    const rsrc_t rH2 = mk_rsrc(H2, 0x4000000u), rU = mk_rsrc(U, 0x1800000u), rV = mk_rsrc(V, 0x1800000u), rG2 = mk_rsrc(g2, 8192u), rGF = mk_rsrc(gf, 8192u);
#pragma unroll 1
    for (int tt = 0; tt < CH / NWAVES; ++tt) { const int tl = wave * (CH / NWAVES) + tt, tok = tok0 + tl;
      asm volatile("" ::: "memory");
      float hn[32], acc[32]; float ss = 0.f;
#pragma unroll
      for (int j = 0; j < 2; ++j)
#pragma unroll
          for (int q = 0; q < 4; ++q) { const u32x2 w = ldb64(rH2, ((unsigned)tok * 2048u + 256u * (4 * j + q) + 4u * lane) * 2u);
              const f32x4 a = (f32x4){__uint_as_float(w.x << 16), __uint_as_float(w.x & 0xffff0000u), __uint_as_float(w.y << 16), __uint_as_float(w.y & 0xffff0000u)};
#pragma unroll
              for (int i = 0; i < 4; ++i) { hn[16 * j + 4 * q + i] = a[i]; ss += a[i] * a[i]; } }
      const float rstd = 1.0f / sqrtf(wave_sum(ss) * (1.f / 2048.f) + NORM_EPS);
#pragma unroll
      for (int j = 0; j < 2; ++j)
#pragma unroll
          for (int q = 0; q < 4; ++q) { const f32x4 a = ldf128(rG2, (256u * (4 * j + q) + 4u * lane) * 4u);
#pragma unroll
              for (int i = 0; i < 4; ++i) hn[16 * j + 4 * q + i] *= rstd * a[i]; }
#pragma unroll
      for (int i = 0; i < 32; ++i) acc[i] = 0.f;
#define NX 4
#define PEER_LOAD(S, kb) do { _Pragma("unroll") for (int x = 0; x < NX; ++x) { const unsigned o = (unsigned)SE[tl * 128 + (kb) + x] * 1536u; \
          S##ua[x] = ldb128(rU, o + (unsigned)lane * 16u); S##ub[x] = ldb64(rU, o + 1024u + (unsigned)lane * 8u); S##va[x] = ldb128(rV, o + (unsigned)lane * 16u); S##vb[x] = ldb64(rV, o + 1024u + (unsigned)lane * 8u); } } while (0)
#define PEER_DEC(A, B) ({ v32f_t r_ = __builtin_amdgcn_cvt_scalef32_pk32_f32_fp6((v6u_t){A.x, A.y, A.z, A.w, B.x, B.y}, 1.0f); asm volatile("s_nop 1" : "+v"(r_)); r_; })
#define PEER_COMPUTE(S, kb) do { float d[NX]; \
          _Pragma("unroll") for (int x = 0; x < NX; ++x) { const v32f_t r = PEER_DEC(S##ua[x], S##ub[x]); float dd = 0.f; \
              _Pragma("unroll") for (int i = 0; i < 32; ++i) fmac1(dd, hn[i], r[i]); \
              d[x] = dd; } \
          _Pragma("unroll") for (int o = 1; o < 64; o <<= 1) { _Pragma("unroll") for (int x = 0; x < NX; ++x) d[x] += __shfl_xor(d[x], o); } \
          float c[NX]; \
          _Pragma("unroll") for (int x = 0; x < NX; ++x) c[x] = SG[tl * 128 + (kb) + x] * gelu_tanh(d[x] * (1.f / 64.f)) * 0.25f; \
          _Pragma("unroll") for (int x = 0; x < NX; ++x) { const v32f_t r = PEER_DEC(S##va[x], S##vb[x]); \
              _Pragma("unroll") for (int i = 0; i < 32; ++i) fmac1(acc[i], c[x], r[i]); } } while (0)
      { u32x4 Aua[NX], Ava[NX], Bua[NX], Bva[NX]; u32x2 Aub[NX], Avb[NX], Bub[NX], Bvb[NX];
        PEER_LOAD(A, 0);
#pragma unroll 1
        for (int k = 0; k < 128; k += 2 * NX) {
            PEER_LOAD(B, k + NX); PEER_COMPUTE(A, k);
            { const int kn = min(k + 2 * NX, 128 - NX); PEER_LOAD(A, kn); }
            PEER_COMPUTE(B, k + NX);
        } }
#undef PEER_DEC
#undef NX
#undef PEER_LOAD
#undef PEER_COMPUTE
      asm volatile("" ::: "memory");
      int tok2 = tok, lane2 = lane; asm volatile("" : "+v"(tok2), "+v"(lane2));
      float s2 = 0.f;
#pragma unroll
      for (int j = 0; j < 2; ++j)
#pragma unroll
          for (int q = 0; q < 4; ++q) { const u32x2 w = ldb64(rH2, ((unsigned)tok2 * 2048u + 256u * (4 * j + q) + 4u * lane2) * 2u);
              const f32x4 a = (f32x4){__uint_as_float(w.x << 16), __uint_as_float(w.x & 0xffff0000u), __uint_as_float(w.y << 16), __uint_as_float(w.y & 0xffff0000u)};
#pragma unroll
              for (int i = 0; i < 4; ++i) { acc[16 * j + 4 * q + i] += a[i]; s2 += acc[16 * j + 4 * q + i] * acc[16 * j + 4 * q + i]; } }
      const float rf = 1.0f / sqrtf(wave_sum(s2) * (1.f / 2048.f) + NORM_EPS);
#pragma unroll
      for (int j = 0; j < 2; ++j)
#pragma unroll
          for (int q = 0; q < 4; ++q) { const f32x4 a = ldf128(rGF, (256u * (4 * j + q) + 4u * lane2) * 4u); f32x4 oa;
#pragma unroll
              for (int i = 0; i < 4; ++i) oa[i] = acc[16 * j + 4 * q + i] * rf * a[i];
              float* op = OUT + (size_t)tok2 * 2048 + 256 * (4 * j + q) + 4 * lane2;
              __builtin_nontemporal_store(oa, (GAS f32x4*)op); }
    }
}
}
#ifndef MK_N_LAUNCHES
#define MK_N_LAUNCHES 1
#endif
#define MK_PROBE_PH -1
#define MK_PROBE_DIV 2
constexpr int N_PHASES = 9;
constexpr int N_LAUNCHES = MK_N_LAUNCHES;
struct Args { const float* in[19]; float* out; unsigned char* ws; int ph_lo, ph_hi; };
static_assert(sizeof(Args) == 19 * 8 + 8 + 8 + 8, "no padding");

__global__ void __launch_bounds__(NWAVES * 64, 2) hybrid_fwd(Args args) {
    extern __shared__ __attribute__((aligned(16))) unsigned char lds_raw[];
    Frame F;
    F.lds = (LAS unsigned char*)lds_raw;
    F.MISC = (volatile LAS unsigned*)(F.lds + MISC_OFF);
    F.tid = threadIdx.x; F.lane = F.tid & 63; F.wave = __builtin_amdgcn_readfirstlane(F.tid >> 6);
    F.G = gridDim.x; { const int bx = blockIdx.x; F.vcu = (F.G % 8 == 0) ? (bx % 8) * (F.G / 8) + bx / 8 : bx; }
    F.ws = args.ws; F.out = args.out;
#pragma unroll
    for (int i = 0; i < 19; ++i) F.in[i] = args.in[i];
    for (int u = F.tid; u < (LDS_BYTES - LDSCTL_OFF) / 4; u += NWAVES * 64) ((LAS unsigned*)(F.lds + LDSCTL_OFF))[u] = 0u;
    __syncthreads();
    XcdBarrier bar; bar.bar = (unsigned*)(F.ws + WS_CTL) + CW_BAR; bar.x = 0; bar.st = nullptr;
    if (N_LAUNCHES == 1) bar = xcd_barrier_post((unsigned*)(F.ws + WS_CTL) + CW_BAR, F.MISC + 8);
    const int lo = args.ph_lo, hi = args.ph_hi;
#define IN(k) (lo <= (k) && (k) < hi)
#if MK_PROBE_PH >= 0
    unsigned long long tp0 = (MK_PROBE_PH == 0 || MK_PROBE_PH == 9) ? __builtin_amdgcn_s_memrealtime() : 0ull, tp1 = 0ull;
#define SEAM(k) do { if (IN(k) && IN((k) + 1)) xcd_barrier(bar); if (MK_PROBE_PH == (k)) tp1 = __builtin_amdgcn_s_memrealtime(); if (MK_PROBE_PH == (k) + 1) tp0 = __builtin_amdgcn_s_memrealtime(); } while (0)
#else
#define SEAM(k) do { if (IN(k) && IN((k) + 1)) xcd_barrier(bar); } while (0)
#endif
    const size_t T2048 = (size_t)256 * 2048 * 2, T1024 = (size_t)256 * 1024 * 2, T512 = (size_t)256 * 512 * 2;
    float* cosT = WSP(float, WS_COS); float* sinT = WSP(float, WS_SIN);
    float* ssq_q = WSP(float, WS_SSQ_Q); float* ssq_kv = WSP(float, WS_SSQ_KV); float* ssq2 = WSP(float, WS_SSQ_2);

    if (IN(0)) { p0_prologue<0>(F, F.vcu, F.G); } SEAM(0);
    if (IN(1)) {
        SchedP1 S{F.G, (int)blockIdx.x, (const char*)(F.ws + WS_HN1), (const char*)(F.ws + WS_WIN), (const char*)(F.ws + WS_WVT), T1024};
        EpiP1 E{WSP(bf16_t, WS_NAQ), WSP(bf16_t, WS_NAK), WSP(bf16_t, WS_VT), WSP(unsigned char, WS_CQ), WSP(unsigned char, WS_CKV), WSP(bf16_t, WS_KR), WSP(unsigned char, WS_GA), WSP(unsigned char, WS_GB), ssq_q, ssq_kv, cosT, sinT};
        pg8::gemm_phase<EpiP1, SchedP1, true, -6>(F.lds, 2048, S, E);
        { const int extra = P1_UNITS % F.G, bx = (int)blockIdx.x; if (extra != 0 && bx >= extra) p0_prologue<1>(F, bx - extra, F.G - extra); else if (extra == 0) p0_prologue<1>(F, bx, F.G); }
    } SEAM(1);
    if (IN(2)) {
        LAS float* relb = (LAS float*)F.lds + 64; LAS float* metab = relb + 16 * 15 * 31 + 128; LAS float* wsf = metab + 256 + F.wave * 64;
        for (int i = F.tid; i < 16 * 15 * 31; i += NWAVES * 64) relb[i] = F.in[4][i];
        if (F.tid < 256) metab[F.tid] = F.in[5][F.tid];
        __syncthreads();
        const int gw = F.vcu * NWAVES + F.wave, NGW = F.G * NWAVES;
        Conv cv{F.in[16], F.in[17], WSP(unsigned char, WS_U), WSP(unsigned char, WS_V), F.lds + 65536 + F.wave * 8192, gw, NGW, 2 * 16384, -1, 0};
        for (int task = gw; task < NBATCH * 16 * 32 * 2; task += NGW)
            att::na_task(task, WSP(bf16_t, WS_NAQ), WSP(bf16_t, WS_NAK), WSP(bf16_t, WS_VT), WSP(unsigned char, WS_ONA), relb, metab, wsf, F.lane, cv);
        while (cv.pend >= 0 || cv.next < cv.end) conv_step<0>(cv, F.lane);
        __syncthreads();
    } SEAM(2);
    if (IN(3)) {
        SchedP3 S{F.G, (int)blockIdx.x, (const char*)(F.ws + WS_CQ), (const char*)(F.ws + WS_CKV), (const char*)(F.ws + WS_WUQ), (const char*)(F.ws + WS_WUKV), T512 / 2};
        EpiP3 E{WSP(bf16_t, WS_QM), WSP(bf16_t, WS_KN), WSP(bf16_t, WS_VV), ssq_q, ssq_kv, cosT, sinT};
        pg8::gemm_phase<EpiP3, SchedP3, true, -4>(F.lds, 512, S, E);
    } SEAM(3);
    if (IN(4)) {
        for (int id = F.vcu; id < NBATCH * 16 * 8; id += F.G) { const int bh = id >> 3, qb = id & 7;
            att::mla_unit(bh >> 4, bh & 15, qb, WSP(bf16_t, WS_QM), WSP(bf16_t, WS_KN), WSP(bf16_t, WS_KR), WSP(bf16_t, WS_VV), WSP(unsigned char, WS_OMLA), (LAS char*)F.lds); }
        __syncthreads();
    } SEAM(4);
    if (IN(5)) {
        { SchedGrid S{F.G, (int)blockIdx.x, 64, 8, (const char*)(F.ws + WS_ONA), (const char*)(F.ws + WS_WNA), T512};
          EpiP5a E{WSP(unsigned char, WS_GA), WSP(unsigned char, WS_T1)};
          pg8::gemm_phase<EpiP5a, SchedGrid, true, -9>(F.lds, 1024, S, E); }
        { SchedGrid S{F.G, (int)blockIdx.x, 64, 8, (const char*)(F.ws + WS_OMLA), (const char*)(F.ws + WS_WMLA), T1024};
          EpiP5b E{WSP(unsigned char, WS_GB), WSP(unsigned char, WS_T1), WSP(unsigned char, WS_MERGED)};
          pg8::gemm_phase<EpiP5b, SchedGrid, true, -11>(F.lds, 2048, S, E); }
    } SEAM(5);
    if (IN(6)) {
        { SchedGrid S{F.G, (int)blockIdx.x, 64, 8, (const char*)(F.ws + WS_MERGED), (const char*)(F.ws + WS_WOUT), T1024};
          EpiP6 E{F.in[0], WSP(bf16_t, WS_H2B), ssq2};
          pg8::gemm_phase<EpiP6, SchedGrid, true, -11>(F.lds, 2048, S, E); }
    } SEAM(6);
    if (IN(7)) {
        SchedGrid S{F.G, (int)blockIdx.x, 64, 8, (const char*)(F.ws + WS_H2B), (const char*)(F.ws + WS_WSC), T2048};
        EpiP7 E{ssq2, WSP(_Float16, WS_SC)};
        pg8::gemm_phase<EpiP7, SchedGrid>(F.lds, 2048, S, E);
    } SEAM(7);
    if (IN(8)) {
        const int nch = (MREAL / peer::CH - F.vcu + F.G - 1) / F.G; const bool both_first = (nch == 2) && (F.vcu & 1);
        for (int op = 0; op < 2 * nch; ++op) {
            const bool sel = both_first ? (op < 2) : !(op & 1); const int ci = both_first ? (op & 1) : (op >> 1), chunk = F.vcu + ci * F.G;
            const int b2 = both_first ? ci : 0;
            LAS int* SE = (LAS int*)(F.lds + (b2 ? peer::OFF_SE2 : peer::OFF_SE)); LAS float* SG = (LAS float*)(F.lds + (b2 ? peer::OFF_SG2 : peer::OFF_SG));
            if (sel) peer::peer_select(chunk, WSP(_Float16, WS_SC), (LAS char*)F.lds, F.tid, SE, SG);
            else peer::peer_gather(chunk, WSP(bf16_t, WS_H2B), WSP(unsigned char, WS_U), WSP(unsigned char, WS_V), F.in[13], F.in[18], F.out, F.tid, SE, SG); }
    }
#if MK_PROBE_PH >= 0
    xcd_barrier(bar); tp1 = (MK_PROBE_PH >= 8) ? __builtin_amdgcn_s_memrealtime() : tp1;
    if (blockIdx.x == 0 && F.tid == 0) F.out[0] = (float)(tp1 - tp0) * (0.01f / MK_PROBE_DIV);
#endif
#undef IN
#undef SEAM
}

extern "C" void kernel_launch(void* const* d_in, const int* in_sizes, int n_in, void* d_out, int out_size, void* d_ws, size_t ws_size, hipStream_t stream) {
    static int grid = 0;
    if (grid == 0) {
        if (n_in != 19 || in_sizes[0] != MREAL * DM || out_size != MREAL * DM || ws_size < WS_END) {
            fprintf(stderr, "kernel_launch: shape/workspace mismatch: n_in %d in0 %d out %d ws %zu (need %zu); nothing launched\n", n_in, n_in > 0 ? in_sizes[0] : -1, out_size, ws_size, (size_t)WS_END); grid = -1; return; }
        int dev = 0, cus = 0, per_cu = 0;
        if (hipGetDevice(&dev) != hipSuccess || hipDeviceGetAttribute(&cus, hipDeviceAttributeMultiprocessorCount, dev) != hipSuccess) { fprintf(stderr, "kernel_launch: device query failed\n"); grid = -1; return; }
        if (hipFuncSetAttribute((const void*)hybrid_fwd, hipFuncAttributeMaxDynamicSharedMemorySize, LDS_BYTES) != hipSuccess) { fprintf(stderr, "kernel_launch: hipFuncSetAttribute failed\n"); grid = -1; return; }
        if (hipOccupancyMaxActiveBlocksPerMultiprocessor(&per_cu, (const void*)hybrid_fwd, NWAVES * 64, LDS_BYTES) != hipSuccess || per_cu < 1)
            fprintf(stderr, "kernel_launch: note: occupancy query reports %d workgroups per CU\n", per_cu);
        (void)hipGetLastError();
        grid = cus;
    }
    if (grid < 0) return;
    if (hipMemsetAsync((char*)d_ws + WS_CTL, 0, CTL_ZERO_BYTES, stream) != hipSuccess) { fprintf(stderr, "kernel_launch: hipMemsetAsync failed\n"); return; }
    Args a{};
    for (int i = 0; i < 19; ++i) a.in[i] = (const float*)d_in[i];
    a.out = (float*)d_out; a.ws = (unsigned char*)d_ws;
    for (int li = 0; li < N_LAUNCHES; ++li) {
        a.ph_lo = (N_LAUNCHES == 1) ? 0 : li; a.ph_hi = (N_LAUNCHES == 1) ? N_PHASES : li + 1;
        hipLaunchKernelGGL(hybrid_fwd, dim3(grid), dim3(NWAVES * 64), LDS_BYTES, stream, a);
        const hipError_t le = hipPeekAtLastError();
        if (le != hipSuccess) { fprintf(stderr, "kernel_launch: launch %d failed: %s\n", li, hipGetErrorName(le)); break; }
    }
}
```

```cpp
#include <hip/hip_runtime.h>
#include <cstdio>
#include <cstdint>

#define LAS __attribute__((address_space(3)))
#define GAS __attribute__((address_space(1)))
typedef unsigned short bf16_t;
typedef short bf16x8 __attribute__((ext_vector_type(8)));
typedef short s16x4 __attribute__((ext_vector_type(4)));
typedef float f32x4 __attribute__((ext_vector_type(4)));
typedef float f32x2 __attribute__((ext_vector_type(2)));
typedef float f32x16 __attribute__((ext_vector_type(16)));
typedef unsigned u32x4 __attribute__((ext_vector_type(4)));
typedef unsigned u32x2 __attribute__((ext_vector_type(2)));

constexpr int DM = 2048, NBATCH = 8, SEQ = 2048, NMETA = 16;
constexpr int MREAL = NBATCH * SEQ;
constexpr int MPAD = MREAL + 256;
constexpr int NPOS = SEQ + NMETA;
constexpr float NORM_EPS = 1e-6f;
constexpr int C_NAQ = 0, C_NAK = 1024, C_CQ = 2048, C_CKV = 2560, C_GA = 3072, C_GB = 5120, C_KR = 7168, NMAIN = 7424;
constexpr int VT_PITCH = MPAD;

constexpr size_t MiB = 1u << 20;
constexpr size_t WS_CTL = 0, CTL_ZERO_BYTES = 1 * MiB;
constexpr size_t WS_SSQ_Q = 481 * MiB, WS_SSQ_KV = 482 * MiB, WS_SSQ_2 = 486 * MiB;
constexpr size_t WS_COS = 1 * MiB, WS_SIN = 1 * MiB + 512 * 1024;
constexpr size_t WS_WUQ = 2 * MiB, WS_WUKV = 5 * MiB, WS_WNA = 9 * MiB, WS_WMLA = 13 * MiB, WS_WOUT = 21 * MiB, WS_WSC = 29 * MiB;
constexpr size_t WS_GA = 37 * MiB, WS_GB = 101 * MiB;
constexpr size_t WS_KR = 165 * MiB;
constexpr size_t WS_WIN = 167 * MiB + 256 * 1024, WS_WVT = WS_WIN + 29 * MiB;
constexpr size_t WS_ONA = 190 * MiB;
constexpr size_t WS_NAQ = 222 * MiB, WS_NAK = 254 * MiB, WS_VT = WS_NAK + 32 * MiB + 512 * 1024;
constexpr size_t WS_HN1 = 319 * MiB;
constexpr size_t WS_CQ = 448 * MiB, WS_CKV = 464 * MiB;
constexpr size_t WS_QM = 222 * MiB, WS_KN = 318 * MiB, WS_VV = 383 * MiB;
constexpr size_t WS_OMLA = 448 * MiB;
constexpr size_t WS_MERGED = 222 * MiB, WS_T1 = 286 * MiB;
constexpr size_t WS_H2 = 37 * MiB, WS_H2B = 293 * MiB;
constexpr size_t WS_U = 69 * MiB, WS_V = 133 * MiB;
constexpr size_t WS_SC = 165 * MiB;
constexpr size_t WS_END = 512 * MiB;
static_assert(WS_CKV + (size_t)MPAD * 512 * 2 <= WS_SSQ_Q && WS_SSQ_Q + (size_t)8 * MPAD * 4 <= WS_SSQ_KV && WS_SSQ_KV + (size_t)8 * MPAD * 4 <= 483 * MiB && WS_SSQ_2 + (size_t)32 * MREAL * 4 <= WS_END, "ssq slabs");
static_assert(WS_VT + (size_t)1024 * MPAD * 2 <= WS_HN1 && WS_HN1 + (size_t)MPAD * 2048 * 2 <= WS_CQ && WS_CKV + (size_t)MPAD * 512 * 2 <= WS_END, "map P1");
static_assert(WS_WVT + 4 * MiB <= WS_NAQ && WS_KR + (size_t)MPAD * 64 * 2 <= WS_WIN && WS_ONA + 32 * MiB <= WS_NAQ, "map P1b");
static_assert(WS_QM + 96 * MiB <= WS_KN && WS_KN + 65 * MiB <= WS_VV && WS_VV + 65 * MiB <= WS_OMLA && WS_OMLA + 64 * MiB <= WS_END, "map P3");
static_assert(WS_T1 + 128 * MiB <= WS_OMLA && WS_H2 + 128 * MiB <= WS_KR && WS_SC + 128 * MiB <= WS_H2B && WS_H2B + 64 * MiB <= WS_END, "map P5+");
static_assert(WS_GA + 32 * MiB <= WS_U && WS_U + 24 * MiB <= WS_GB && WS_GB + 32 * MiB <= WS_V && WS_V + 24 * MiB <= WS_KR, "expert tables between the gate codes");

constexpr int CW_BAR = 4096;

constexpr int RING_BYTES = 131072;
constexpr int LDSCTL_OFF = RING_BYTES, MISC_OFF = LDSCTL_OFF + 320;
constexpr int LDS_BYTES = 147456;
constexpr int NWAVES = 8;

#define LDS_WAIT() asm volatile("s_waitcnt lgkmcnt(0)" ::: "memory")
#define VM_WAIT() asm volatile("s_waitcnt vmcnt(0)" ::: "memory")
#define SBAR() __builtin_amdgcn_sched_barrier(0)
typedef __bf16 bf16x2_t __attribute__((ext_vector_type(2)));
__device__ __forceinline__ unsigned cvt_pk_bf16(float lo, float hi) { const f32x2 v = {lo, hi}; const bf16x2_t b = __builtin_convertvector(v, bf16x2_t); return __builtin_bit_cast(unsigned, b); }
__device__ __forceinline__ float bf_lo(unsigned w) { return __uint_as_float(w << 16); }
__device__ __forceinline__ float bf_hi(unsigned w) { return __uint_as_float(w & 0xffff0000u); }
__device__ __forceinline__ u32x4 pack8(const f32x4 a, const f32x4 b) { u32x4 w; w.x = cvt_pk_bf16(a[0], a[1]); w.y = cvt_pk_bf16(a[2], a[3]); w.z = cvt_pk_bf16(b[0], b[1]); w.w = cvt_pk_bf16(b[2], b[3]); return w; }
__device__ __forceinline__ u32x2 pack8_fp8(f32x4 a, f32x4 b) {
#pragma unroll
    for (int i = 0; i < 4; ++i) { a[i] = __builtin_fminf(__builtin_fmaxf(a[i], -448.f), 448.f); b[i] = __builtin_fminf(__builtin_fmaxf(b[i], -448.f), 448.f); }
    int w0 = 0, w1 = 0; w0 = __builtin_amdgcn_cvt_pk_fp8_f32(a[0], a[1], w0, false); w0 = __builtin_amdgcn_cvt_pk_fp8_f32(a[2], a[3], w0, true);
    w1 = __builtin_amdgcn_cvt_pk_fp8_f32(b[0], b[1], w1, false); w1 = __builtin_amdgcn_cvt_pk_fp8_f32(b[2], b[3], w1, true); return (u32x2){(unsigned)w0, (unsigned)w1}; }
__device__ __forceinline__ unsigned char f32_to_fp8(float x) { x = __builtin_fminf(__builtin_fmaxf(x, -448.f), 448.f); return (unsigned char)(__builtin_amdgcn_cvt_pk_fp8_f32(x, 0.f, 0, false) & 0xff); }
__device__ __forceinline__ u32x2 pack8_u8(const f32x4 a, const f32x4 b) { u32x2 w; unsigned x = 0u, y = 0u;
    x = __builtin_amdgcn_cvt_pk_u8_f32(a[0] * 255.f, 0u, x); x = __builtin_amdgcn_cvt_pk_u8_f32(a[1] * 255.f, 1u, x); x = __builtin_amdgcn_cvt_pk_u8_f32(a[2] * 255.f, 2u, x); x = __builtin_amdgcn_cvt_pk_u8_f32(a[3] * 255.f, 3u, x);
    y = __builtin_amdgcn_cvt_pk_u8_f32(b[0] * 255.f, 0u, y); y = __builtin_amdgcn_cvt_pk_u8_f32(b[1] * 255.f, 1u, y); y = __builtin_amdgcn_cvt_pk_u8_f32(b[2] * 255.f, 2u, y); y = __builtin_amdgcn_cvt_pk_u8_f32(b[3] * 255.f, 3u, y);
    w.x = x; w.y = y; return w; }
__device__ __forceinline__ unsigned pack4_fp8(f32x4 a) {
#pragma unroll
    for (int i = 0; i < 4; ++i) a[i] = __builtin_fminf(__builtin_fmaxf(a[i], -448.f), 448.f);
    int w0 = 0; w0 = __builtin_amdgcn_cvt_pk_fp8_f32(a[0], a[1], w0, false); w0 = __builtin_amdgcn_cvt_pk_fp8_f32(a[2], a[3], w0, true); return (unsigned)w0; }
__device__ __forceinline__ void unpack8_fp8(const u32x2 w, f32x4& a, f32x4& b) {
    const f32x2 a0 = __builtin_amdgcn_cvt_pk_f32_fp8((int)w.x, false), a1 = __builtin_amdgcn_cvt_pk_f32_fp8((int)w.x, true), b0 = __builtin_amdgcn_cvt_pk_f32_fp8((int)w.y, false), b1 = __builtin_amdgcn_cvt_pk_f32_fp8((int)w.y, true);
    a = (f32x4){a0[0], a0[1], a1[0], a1[1]}; b = (f32x4){b0[0], b0[1], b1[0], b1[1]}; }
__device__ __forceinline__ void unpack8_u8(const u32x2 w, f32x4& a, f32x4& b) { const float k = 1.f / 255.f;
    a = (f32x4){(float)(w.x & 0xffu), (float)((w.x >> 8) & 0xffu), (float)((w.x >> 16) & 0xffu), (float)(w.x >> 24)} * k;
    b = (f32x4){(float)(w.y & 0xffu), (float)((w.y >> 8) & 0xffu), (float)((w.y >> 16) & 0xffu), (float)(w.y >> 24)} * k; }
__device__ __forceinline__ u32x2 pack4(const f32x4 a) { u32x2 w; w.x = cvt_pk_bf16(a[0], a[1]); w.y = cvt_pk_bf16(a[2], a[3]); return w; }
__device__ __forceinline__ float wave_sum(float v) {
#pragma unroll
    for (int o = 1; o < 64; o <<= 1) v += __shfl_xor(v, o);
    return v;
}
__device__ __forceinline__ float sigmoidf_(float x) { return __builtin_amdgcn_rcpf(1.0f + __builtin_amdgcn_exp2f(-1.4426950408889634f * x)); }
__device__ __forceinline__ int crow(int r, int hi) { return (r & 3) + 8 * (r >> 2) + 4 * hi; }
#define PG8_AUX 0
namespace pg8 {
constexpr int BM = 256, BK = 64, HALF = 128, HTB = HALF * BK * 2  , STAGE_BYTES = 8 * HTB, NXCD = 8, WGM = 8;
__host__ __device__ __forceinline__ int lds_byte(int r, int c) { const int st = (r >> 4) * 2 + (c >> 5), rr = r & 15, cc = c & 31, ob = rr * 64 + cc * 2; return st * 1024 + (ob ^ (((ob >> 9) & 1) << 5)); }
__host__ __device__ __forceinline__ void stage_rc(int b, int& R, int& C) { const int st = b / 1024, sb = b % 1024, swz = sb ^ (((sb >> 9) & 1) << 5); R = (st >> 1) * 16 + swz / 64; C = (st & 1) * 32 + (swz % 64) / 2; }
__host__ __device__ __forceinline__ int perm32(int rho) { const int n = rho >> 4, i = rho & 15; return 8 * (i >> 2) + 4 * n + (i & 3); }

struct Unit { int pm, pn, kind; };

__device__ __forceinline__ void grid_order(int L, int nM, int nN, int& pm, int& pn) {
    const int nwg = nM * nN; int wgid = L;
    { const int q = nwg / NXCD, r = nwg % NXCD, xcd = wgid % NXCD, off = wgid / NXCD; wgid = (xcd < r ? xcd * (q + 1) : r * (q + 1) + (xcd - r) * q) + off; }
    const int nig = WGM * nN, gid = wgid / nig, fm = gid * WGM, gsz = (nM - fm) < WGM ? (nM - fm) : WGM;
    pm = fm + ((wgid % nig) % gsz); pn = (wgid % nig) / gsz;
}

typedef int v8i_t __attribute__((ext_vector_type(8)));
template <class Epi, class Sched, bool F8 = false, int F8_SCALE_EXP = 0>
__device__ __forceinline__ void gemm_phase(LAS unsigned char* lds, const int K, const Sched& S, const Epi& E) {
    const int tid = threadIdx.x, wid = __builtin_amdgcn_readfirstlane(tid >> 6), lane = tid & 63, wr = wid >> 2, wc = wid & 3, fr = lane & 15, fq = lane >> 4;
    int f8sa = 0x01010101 * (127 + F8_SCALE_EXP), f8sb = 0x7f7f7f7f; asm volatile("" : "+v"(f8sa), "+v"(f8sb));
    const int Kb = F8 ? K : 2 * K;
    const int nt = Kb / 128;
    unsigned voffA[2], voffB[2];
#pragma unroll
    for (int i = 0; i < 2; ++i) { int R, C; stage_rc(tid * 16 + i * 8192, R, C); const int Rb = Epi::PERM ? ((R & ~31) + perm32(R & 31)) : R;
        voffA[i] = (unsigned)(R * Kb + C * 2); voffB[i] = (unsigned)(Rb * Kb + C * 2); }
    const size_t kstep = (size_t)128;
    const size_t hstep = (size_t)HALF * Kb;
    const unsigned ldsw = (unsigned)wid * 1024u;
    const int aoff = lds_byte(wr * 64 + fr, F8 ? fq * 16 : fq * 8), boff = lds_byte(wc * 32 + fr, F8 ? fq * 16 : fq * 8);
#define PG8_SA(b, h) (((b) * 2 + (h)) * HTB)
#define PG8_SB(b, h) ((4 + (b) * 2 + (h)) * HTB)
#define PG8_STAGE(bufoff, gbase, voff) do { _Pragma("unroll") for (int _i = 0; _i < 2; ++_i) \
        __builtin_amdgcn_global_load_lds((const unsigned*)((const char*)(gbase) + (voff)[_i]), (LAS unsigned*)(lds + (bufoff) + ldsw + _i * 8192), 16, 0, PG8_AUX); } while (0)
#define PG8_LDA(dst, b, h) do { _Pragma("unroll") for (int m = 0; m < 4; ++m) _Pragma("unroll") for (int k = 0; k < 2; ++k) dst[m][k] = *(const LAS bf16x8*)(lds + PG8_SA(b, h) + aoff + m * 2048 + (F8 ? k * 16 : k * 1024)); } while (0)
#define PG8_LDB(dst, b, h) do { _Pragma("unroll") for (int n = 0; n < 2; ++n) _Pragma("unroll") for (int k = 0; k < 2; ++k) dst[n][k] = *(const LAS bf16x8*)(lds + PG8_SB(b, h) + boff + n * 2048 + (F8 ? k * 16 : k * 1024)); } while (0)
#define PG8_F8OP(X) __builtin_bit_cast(v8i_t, __builtin_shufflevector(X[0], X[1], 0, 1, 2, 3, 4, 5, 6, 7, 8, 9, 10, 11, 12, 13, 14, 15))
#define PG8_MMA(ai, bj, At, Bt) do { __builtin_amdgcn_s_setprio(1); \
        if constexpr (F8) { _Pragma("unroll") for (int m = 0; m < 4; ++m) _Pragma("unroll") for (int n = 0; n < 2; ++n) \
            asm volatile("v_mfma_scale_f32_16x16x128_f8f6f4 %0, %1, %2, %0, %3, %4 op_sel_hi:[0,0,0]" : "+v"(acc[ai][bj][m][n]) : "v"(PG8_F8OP(Bt[n])), "v"(PG8_F8OP(At[m])), "v"(f8sa), "v"(f8sb)); } \
        else { _Pragma("unroll") for (int m = 0; m < 4; ++m) _Pragma("unroll") for (int n = 0; n < 2; ++n) _Pragma("unroll") for (int k = 0; k < 2; ++k) \
            acc[ai][bj][m][n] = __builtin_amdgcn_mfma_f32_16x16x32_bf16(Bt[n][k], At[m][k], acc[ai][bj][m][n], 0, 0, 0); } \
        __builtin_amdgcn_s_setprio(0); } while (0)
#define PG8_WAIT_V(n) asm volatile("s_waitcnt vmcnt(" #n ")" ::: "memory")
#define PG8_WAIT_L(n) asm volatile("s_waitcnt lgkmcnt(" #n ")" ::: "memory")
#define PG8_BAR __builtin_amdgcn_s_barrier()
#define PG8_SCHED __builtin_amdgcn_sched_barrier(0)
    Unit cur, nxt; int ui = 0;
    if (!S.next(0, cur)) return;
    f32x4 acc[2][2][4][2];
#pragma unroll
    for (int a = 0; a < 2; ++a)
#pragma unroll
        for (int b = 0; b < 2; ++b)
#pragma unroll
            for (int m = 0; m < 4; ++m)
#pragma unroll
                for (int n = 0; n < 2; ++n) acc[a][b][m][n] = (f32x4){0.f, 0.f, 0.f, 0.f};
    bf16x8 At[4][2], B0[2][2], B1[2][2];
    const char* cA = S.pa(cur); const char* cB = S.pb(cur);
    PG8_STAGE(PG8_SB(0, 0), cB, voffB); PG8_STAGE(PG8_SB(0, 1), cB + hstep, voffB); PG8_STAGE(PG8_SA(0, 0), cA, voffA); PG8_STAGE(PG8_SA(0, 1), cA + hstep, voffA);
    if (wr == 1) PG8_BAR;
    PG8_WAIT_V(2); PG8_BAR;
    PG8_STAGE(PG8_SB(1, 0), cB + kstep, voffB); PG8_STAGE(PG8_SA(1, 0), cA + kstep, voffA); PG8_STAGE(PG8_SB(1, 1), cB + hstep + kstep, voffB);
    PG8_WAIT_V(6); PG8_BAR;
    for (;;) {
        const bool has_next = S.next(ui + 1, nxt);
        const char* nA = has_next ? S.pa(nxt) : cA; const char* nB = has_next ? S.pb(nxt) : cB;
        for (int t = 0; t < nt; t += 2) {
            const bool last = (t == nt - 2);
            const char* a1 = cA + (size_t)(t + 1) * kstep;
            const char* a2 = last ? nA : cA + (size_t)(t + 2) * kstep; const char* b2 = last ? nB : cB + (size_t)(t + 2) * kstep;
            const char* a3 = a2 + kstep; const char* b3 = b2 + kstep;
            PG8_LDB(B0, 0, 0); PG8_LDB(B1, 0, 1); PG8_SCHED; PG8_LDA(At, 0, 0); PG8_STAGE(PG8_SA(1, 1), a1 + hstep, voffA);
            PG8_WAIT_V(8); PG8_WAIT_L(0); PG8_BAR; PG8_MMA(0, 0, At, B0); PG8_MMA(0, 1, At, B1); PG8_BAR; PG8_SCHED;
            PG8_LDA(At, 0, 1); PG8_STAGE(PG8_SB(0, 0), b2, voffB); PG8_STAGE(PG8_SB(0, 1), b2 + hstep, voffB); PG8_STAGE(PG8_SA(0, 0), a2, voffA);
            PG8_WAIT_V(8); PG8_WAIT_L(0); PG8_BAR; PG8_MMA(1, 0, At, B0); PG8_MMA(1, 1, At, B1); PG8_BAR; PG8_SCHED;
            PG8_LDB(B0, 1, 0); PG8_LDB(B1, 1, 1); PG8_SCHED; PG8_LDA(At, 1, 0); PG8_STAGE(PG8_SA(0, 1), a2 + hstep, voffA);
            PG8_WAIT_V(8); PG8_WAIT_L(0); PG8_BAR; PG8_MMA(0, 0, At, B0); PG8_MMA(0, 1, At, B1); PG8_BAR; PG8_SCHED;
            PG8_LDA(At, 1, 1); PG8_STAGE(PG8_SB(1, 0), b3, voffB); PG8_STAGE(PG8_SB(1, 1), b3 + hstep, voffB); PG8_STAGE(PG8_SA(1, 0), a3, voffA);
            PG8_WAIT_V(8); PG8_WAIT_L(0); PG8_BAR; PG8_MMA(1, 0, At, B0); PG8_MMA(1, 1, At, B1); PG8_BAR; PG8_SCHED;
        }
        if (wr == 0) PG8_BAR;
        if constexpr (F8) asm volatile("s_nop 15\n\ts_nop 7" ::: "memory");
        if constexpr (Epi::HAS_PRE) {
            E.pre(cur, (LAS float*)(lds + STAGE_BYTES + 1024), tid); PG8_WAIT_L(0); PG8_BAR; }
        E(acc, cur, wr, wc, fr, fq, (const LAS float*)(lds + STAGE_BYTES + 1024));
        if (!has_next) break;
#pragma unroll
        for (int a = 0; a < 2; ++a)
#pragma unroll
            for (int b = 0; b < 2; ++b)
#pragma unroll
                for (int m = 0; m < 4; ++m)
#pragma unroll
                    for (int n = 0; n < 2; ++n) acc[a][b][m][n] = (f32x4){0.f, 0.f, 0.f, 0.f};
        cur = nxt; cA = nA; cB = nB; ++ui;
        if (wr == 1) PG8_BAR;
    }
    PG8_WAIT_V(0);
    PG8_BAR;
#undef PG8_SA
#undef PG8_SB
#undef PG8_STAGE
#undef PG8_LDA
#undef PG8_LDB
#undef PG8_MMA
#undef PG8_F8OP
#undef PG8_WAIT_V
#undef PG8_WAIT_L
#undef PG8_BAR
#undef PG8_SCHED
}
}
typedef GAS unsigned gu32;
#define RLX_AGENT __ATOMIC_RELAXED, __HIP_MEMORY_SCOPE_AGENT
#define XB_TMO      128
#define XB_XCNT(j)  (256  + 64 * (j))
#define XB_XSUB(j)  (1280 + 64 * (j))
#define XB_XGEN(j)  (2304 + 64 * (j))
#define XB_TOP      3328
#define XB_TOPGEN   3392
#define XCD_BAR_WORDS 3456
#define XB_SPIN_CAP (1u << 18)
__device__ __forceinline__ unsigned xb_ld(unsigned* p)              { return __hip_atomic_load(p, __ATOMIC_RELAXED, __HIP_MEMORY_SCOPE_AGENT); }
__device__ __forceinline__ unsigned xb_add(unsigned* p, unsigned v) { return __hip_atomic_fetch_add(p, v, __ATOMIC_RELAXED, __HIP_MEMORY_SCOPE_AGENT); }
__device__ __forceinline__ unsigned xb_xcc_id() { return (unsigned)__builtin_amdgcn_s_getreg((3 << 11) | 20) & 0xFu; }
#define XB_SPIN(cond, bar) do { unsigned _sp = 0; while (cond) { __builtin_amdgcn_s_sleep(1); \
    if ((++_sp & 255u) == 0u) { if (xb_ld(&(bar)[XB_TMO])) break; if (_sp > XB_SPIN_CAP) { atomicAdd(&(bar)[XB_TMO], 1u); break; } } } } while (0)
struct XcdBarrier { unsigned* bar; unsigned x; volatile LAS unsigned* st; };
__device__ __forceinline__ XcdBarrier xcd_barrier_post(unsigned* bar, volatile LAS unsigned* st) {
    XcdBarrier b; b.bar = bar; b.x = xb_xcc_id(); b.st = st;
    if (threadIdx.x == 0) (void)xb_add(&bar[XB_XCNT(b.x)], 1u);
    return b;
}
__device__ __forceinline__ void xcd_barrier_complete(unsigned* bar, unsigned x, unsigned& nloc, unsigned& nx) {
    const unsigned G = gridDim.x * gridDim.y * gridDim.z;
    unsigned sum, cnt, mine, sp = 0u;
    for (;;) {
        sum = 0u; cnt = 0u; mine = 0u;
#pragma unroll
        for (unsigned j = 0; j < 16; ++j) { const unsigned c = xb_ld(&bar[XB_XCNT(j)]); sum += c; cnt += (c > 0u) ? 1u : 0u; mine = (j == x) ? c : mine; }
        if (sum == G) break;
        __builtin_amdgcn_s_sleep(1);
        if ((++sp & 255u) == 0u) { if (xb_ld(&bar[XB_TMO])) break; if (sp > XB_SPIN_CAP) { atomicAdd(&bar[XB_TMO], 1u); break; } }
    }
    nloc = mine > 0u ? mine : 1u; nx = cnt > 0u ? cnt : 1u;
}
__device__ __forceinline__ void xcd_barrier(const XcdBarrier& b) {
    asm volatile("s_waitcnt vmcnt(0)" ::: "memory");
    __syncthreads();
    if (threadIdx.x == 0) {
        unsigned* bar = b.bar;
        __builtin_amdgcn_s_waitcnt(0);
        unsigned nloc = b.st[0], nx = b.st[1];
        if (nloc == 0u) { xcd_barrier_complete(bar, b.x, nloc, nx); b.st[0] = nloc; b.st[1] = nx; }
        const unsigned old = xb_add(&bar[XB_XSUB(b.x)], 1u);
        const unsigned gen = old / nloc;
        if (old + 1u == (gen + 1u) * nloc) {
            __builtin_amdgcn_fence(__ATOMIC_RELEASE, "agent");
            asm volatile("s_waitcnt vmcnt(0)" ::: "memory");
            const unsigned og = xb_add(&bar[XB_TOP], 1u);
            const unsigned tg = og / nx;
            if (og + 1u == (tg + 1u) * nx) xb_add(&bar[XB_TOPGEN], 1u);
            else XB_SPIN(xb_ld(&bar[XB_TOPGEN]) == tg, bar);
            __builtin_amdgcn_fence(__ATOMIC_ACQUIRE, "agent");
            xb_add(&bar[XB_XGEN(b.x)], 1u);
            asm volatile("s_waitcnt vmcnt(0)" ::: "memory");
        } else {
            XB_SPIN(xb_ld(&bar[XB_XGEN(b.x)]) == gen, bar);
            __builtin_amdgcn_fence(__ATOMIC_ACQUIRE, "agent");
            asm volatile("s_waitcnt vmcnt(0)" ::: "memory");
        }
    }
    __syncthreads();
}
struct Frame {
    LAS unsigned char* lds;
    volatile LAS unsigned* MISC;
    unsigned char* ws;
    int tid, lane, wave;
    int vcu, G;
    const float* in[19];
    float* out;
};
#define WSP(T, off) ((T*)(F.ws + (off)))

typedef float cv16f_t __attribute__((ext_vector_type(16)));
typedef unsigned cv6u_t __attribute__((ext_vector_type(6)));
struct Conv { const float* pu; const float* pv; unsigned char* u8; unsigned char* v8; LAS unsigned char* lbuf; int next, stride, end, pend, tick; };
__device__ __forceinline__ void conv_issue(const Conv& c, int item, int lane) {
    const float* src = ((item >> 14) ? c.pv : c.pu) + (size_t)(item & 16383) * 2048 + 4 * lane;
#pragma unroll
    for (int q = 0; q < 8; ++q) __builtin_amdgcn_global_load_lds((const unsigned*)(src + 256 * q), (LAS unsigned*)(c.lbuf + q * 1024), 16, 0, 0);
}
__device__ __forceinline__ void conv_finish(const Conv& c, int item, int lane) {
    const int isv = item >> 14, row = item & 16383; const float sc = isv ? 4.f : 64.f; cv16f_t a, b;
#pragma unroll
    for (int q = 0; q < 8; ++q) { const f32x4 x = *(const LAS f32x4*)(c.lbuf + q * 1024 + lane * 16);
#pragma unroll
        for (int e = 0; e < 4; ++e) { const int k_ = 4 * q + e;
            if (k_ & 1) b[k_ >> 1] = x[e] * sc; else a[k_ >> 1] = x[e] * sc; } }
    const cv6u_t w = __builtin_amdgcn_cvt_scalef32_2xpk16_fp6_f32(a, b, 1.0f);
    unsigned char* rec = (isv ? c.v8 : c.u8) + (size_t)row * 1536;
    *(GAS u32x4*)(rec + lane * 16) = (u32x4){w[0], w[1], w[2], w[3]}; *(GAS u32x2*)(rec + 1024 + lane * 8) = (u32x2){w[4], w[5]};
}
template <int YOUNGER>
__device__ __forceinline__ void conv_step(Conv& c, int lane) {
    if (c.pend >= 0) { if constexpr (YOUNGER == 0) asm volatile("s_waitcnt vmcnt(0)" ::: "memory"); else { static_assert(YOUNGER == 20, "wait count"); asm volatile("s_waitcnt vmcnt(20)" ::: "memory"); }
        conv_finish(c, c.pend, lane); c.pend = -1; asm volatile("s_waitcnt lgkmcnt(0)" ::: "memory"); }
    if (c.next < c.end) { conv_issue(c, c.next, lane); c.pend = c.next; c.next += c.stride; }
}
__device__ __forceinline__ void p0_transpose_item(const float* W, int K, int N, int k0, int n0, bf16_t* WT, int drow, bool rope, const float* gain, LAS float* scr, int lane) {
    { f32x4 v[8]; float gk[8];
#pragma unroll
      for (int i = 0; i < 8; ++i) { const int kk = 8 * i + (lane >> 3); v[i] = *(const GAS f32x4*)(W + (size_t)(k0 + kk) * N + n0 + 4 * (lane & 7)); gk[i] = gain ? gain[k0 + kk] : 1.f; }
#pragma unroll
      for (int i = 0; i < 8; ++i) { const int kk = 8 * i + (lane >> 3); LAS float* d = scr + kk * 33 + 4 * (lane & 7);
#pragma unroll
          for (int e = 0; e < 4; ++e) d[e] = v[i][e] * gk[i]; } }
    LDS_WAIT(); asm volatile("" ::: "memory");
    const int c = lane & 7;
#pragma unroll
    for (int j = 0; j < 4; ++j) { const int n = (lane >> 3) + 8 * j; const LAS float* s = scr + (8 * c) * 33 + n;
        u32x4 o; o.x = cvt_pk_bf16(s[0 * 33], s[1 * 33]); o.y = cvt_pk_bf16(s[2 * 33], s[3 * 33]); o.z = cvt_pk_bf16(s[4 * 33], s[5 * 33]); o.w = cvt_pk_bf16(s[6 * 33], s[7 * 33]);
        const int dr = drow + (rope ? (8 * (n >> 2) + (n & 3)) : n);
        *(GAS u32x4*)(WT + (size_t)dr * K + k0 + 8 * c) = o; }
    LDS_WAIT(); asm volatile("" ::: "memory");
}
__device__ __forceinline__ void p0_transpose_item8(const float* W, int K, int N, int k0, int n0, unsigned char* WT, int drow, bool rope, float scale, LAS float* scr, int lane, const float* gain = nullptr) {
    { f32x4 v[8]; float gk[8];
#pragma unroll
      for (int i = 0; i < 8; ++i) { const int kk = 8 * i + (lane >> 3); v[i] = *(const GAS f32x4*)(W + (size_t)(k0 + kk) * N + n0 + 4 * (lane & 7)); gk[i] = gain ? gain[k0 + kk] * scale : scale; }
#pragma unroll
      for (int i = 0; i < 8; ++i) { const int kk = 8 * i + (lane >> 3); LAS float* d = scr + kk * 33 + 4 * (lane & 7);
#pragma unroll
          for (int e = 0; e < 4; ++e) d[e] = v[i][e] * gk[i]; } }
    LDS_WAIT(); asm volatile("" ::: "memory");
#pragma unroll
    for (int j = 0; j < 2; ++j) { const int q = lane + 64 * j, n = q >> 2, c = q & 3; const LAS float* s = scr + (16 * c) * 33 + n; u32x4 o;
#pragma unroll
        for (int d = 0; d < 4; ++d) { int w = 0; w = __builtin_amdgcn_cvt_pk_fp8_f32(s[(4 * d) * 33], s[(4 * d + 1) * 33], w, false); w = __builtin_amdgcn_cvt_pk_fp8_f32(s[(4 * d + 2) * 33], s[(4 * d + 3) * 33], w, true); o[d] = (unsigned)w; }
        const int dr = drow + (rope ? (8 * (n >> 2) + (n & 3)) : n);
        *(GAS u32x4*)(WT + (size_t)dr * K + k0 + 16 * c) = o; }
    LDS_WAIT(); asm volatile("" ::: "memory");
}
__device__ __forceinline__ void rms_row_to_fp8(const float* xrow, const float* g, unsigned char* orow, int lane) {
    const GAS f32x4* xr = (const GAS f32x4*)xrow + lane; const GAS f32x4* gr = (const GAS f32x4*)g + lane;
    f32x4 v[8]; float s = 0.f;
#pragma unroll
    for (int j = 0; j < 8; ++j) { v[j] = xr[64 * j]; s += (v[j].x * v[j].x + v[j].y * v[j].y) + (v[j].z * v[j].z + v[j].w * v[j].w); }
    const float rstd = 1.0f / sqrtf(wave_sum(s) * (1.f / DM) + NORM_EPS);
    GAS unsigned* o4 = (GAS unsigned*)orow + lane;
#pragma unroll
    for (int j = 0; j < 8; ++j) { const f32x4 y = (v[j] * rstd) * gr[64 * j]; int w = 0; w = __builtin_amdgcn_cvt_pk_fp8_f32(y[0], y[1], w, false); w = __builtin_amdgcn_cvt_pk_fp8_f32(y[2], y[3], w, true); o4[64 * j] = (unsigned)w; }
}
__device__ __forceinline__ void rms_row_to_bf16(const float* xrow, const float* g, bf16_t* orow, int lane) {
    const GAS f32x4* xr = (const GAS f32x4*)xrow + lane; const GAS f32x4* gr = (const GAS f32x4*)g + lane;
    f32x4 v[8]; float s = 0.f;
#pragma unroll
    for (int j = 0; j < 8; ++j) { v[j] = xr[64 * j]; s += (v[j].x * v[j].x + v[j].y * v[j].y) + (v[j].z * v[j].z + v[j].w * v[j].w); }
    const float rstd = 1.0f / sqrtf(wave_sum(s) * (1.f / DM) + NORM_EPS);
    GAS u32x2* o8 = (GAS u32x2*)orow + lane;
#pragma unroll
    for (int j = 0; j < 8; ++j) { const f32x4 gg = gr[64 * j]; o8[64 * j] = pack4((v[j] * rstd) * gg); }
}
template <int PART>
__device__ __forceinline__ void p0_prologue(Frame& F, int rank, int nrank) {
    LAS float* scr = (LAS float*)(F.lds + F.wave * 16384);
    const int gw = rank * NWAVES + F.wave, NGW = nrank * NWAVES, lane = F.lane; const int gt = rank * 512 + F.tid, NGT = nrank * 512;
    unsigned char* WIN = WSP(unsigned char, WS_WIN); unsigned char* WVT = WSP(unsigned char, WS_WVT);
    constexpr int I_IN = 32 * 258, I_UQ = 8 * 96, I_UKV = 8 * 128, I_NA = 16 * 64, I_MLA = 32 * 64, I_OUT = 32 * 64;
    constexpr int NEARLY = I_IN + I_UQ + I_UKV, NITEMS = NEARLY + I_NA + I_MLA + I_OUT;
    for (int it = (PART == 0 ? 0 : NEARLY) + gw; it < (PART == 0 ? NEARLY : NITEMS); it += NGW) {
        int r = it;
        if (r < I_IN) { const int kb = r / 258, sb = r % 258, n0 = 32 * sb, k0 = 64 * kb; const float* W = F.in[3];
            unsigned char* dst = WIN; int drow; bool rope = false;
            if (n0 < 1024) drow = C_NAQ + n0;
            else if (n0 < 2048) drow = C_NAK + (n0 - 1024);
            else if (n0 < 3072) { dst = WVT; drow = n0 - 2048; }
            else if (n0 < 3584) drow = C_CQ + (n0 - 3072);
            else if (n0 < 4096) drow = C_CKV + (n0 - 3584);
            else if (n0 < 4160) { drow = C_KR + ((n0 - 4096) ? 4 : 0); rope = true; }
            else if (n0 < 6208) drow = C_GA + (n0 - 4160);
            else drow = C_GB + (n0 - 6208);
            p0_transpose_item8(W, 2048, 8256, k0, n0, dst, drow, rope, 64.f, scr, lane); continue; } r -= I_IN;
        if (r < I_UQ) { const int kb = r / 96, sb = r % 96, n0 = 32 * sb, k0 = 64 * kb; const int hd = n0 / 192, w = n0 % 192;
            int drow = n0; bool rope = false; if (w >= 128) { rope = true; drow = hd * 192 + 128 + ((w - 128) ? 4 : 0); }
            p0_transpose_item8(F.in[7], 512, 3072, k0, n0, WSP(unsigned char, WS_WUQ), drow, rope, 16.f, scr, lane, F.in[6]); continue; } r -= I_UQ;
        if (r < I_UKV) { const int kb = r / 128, sb = r % 128; const int n0 = 32 * sb, hd = n0 >> 8, w = n0 & 255;
            p0_transpose_item8(F.in[9], 512, 4096, 64 * kb, n0, WSP(unsigned char, WS_WUKV), (w >= 128 ? 2048 : 0) + hd * 128 + (w & 127), false, 16.f, scr, lane, F.in[8]); continue; } r -= I_UKV;
        if (r < I_NA) { const int kb = r / 64, sb = r % 64; p0_transpose_item8(F.in[10], 1024, 2048, 64 * kb, 32 * sb, WSP(unsigned char, WS_WNA), 32 * sb, false, 32.f, scr, lane); continue; } r -= I_NA;
        if (r < I_MLA) { const int kb = r / 64, sb = r % 64; p0_transpose_item8(F.in[11], 2048, 2048, 64 * kb, 32 * sb, WSP(unsigned char, WS_WMLA), 32 * sb, false, 64.f, scr, lane); continue; } r -= I_MLA;
        { const int kb = r / 64, sb = r % 64; p0_transpose_item8(F.in[12], 2048, 2048, 64 * kb, 32 * sb, WSP(unsigned char, WS_WOUT), 32 * sb, false, 64.f, scr, lane); }
    }
    if (PART == 0) { GAS u32x4* z = (GAS u32x4*)(WIN + (size_t)(C_KR + 64) * 2048); const int n16 = (NMAIN - C_KR - 64) * 2048 / 16;
      for (int i = gt; i < n16; i += NGT) z[i] = (u32x4){0u, 0u, 0u, 0u}; }
    if (PART == 0) { unsigned char* HN1 = WSP(unsigned char, WS_HN1);
#define P0_ROWSRC(m_) (((m_) < MREAL) ? F.in[0] + (size_t)(m_) * DM : F.in[1] + (size_t)((m_) - MREAL) * DM)
      { f32x4 v[8]; int m = gw;
        if (m < MREAL + NMETA) { const GAS f32x4* xr = (const GAS f32x4*)P0_ROWSRC(m) + lane;
#pragma unroll
            for (int j = 0; j < 8; ++j) v[j] = xr[64 * j]; }
        const GAS f32x4* gr = (const GAS f32x4*)F.in[2] + lane;
        while (m < MREAL + NMETA) { const int mn = m + NGW; f32x4 vn[8];
            { const int ml = mn < MREAL + NMETA ? mn : m; const GAS f32x4* xr = (const GAS f32x4*)P0_ROWSRC(ml) + lane;
#pragma unroll
              for (int j = 0; j < 8; ++j) vn[j] = xr[64 * j]; }
            float sq = 0.f;
#pragma unroll
            for (int j = 0; j < 8; ++j) sq += (v[j].x * v[j].x + v[j].y * v[j].y) + (v[j].z * v[j].z + v[j].w * v[j].w);
            const float rstd = 1.0f / sqrtf(wave_sum(sq) * (1.f / DM) + NORM_EPS);
            GAS unsigned* o4 = (GAS unsigned*)(HN1 + (size_t)m * DM) + lane;
#pragma unroll
            for (int j = 0; j < 8; ++j) { const f32x4 y = (v[j] * rstd) * gr[64 * j]; int w = 0; w = __builtin_amdgcn_cvt_pk_fp8_f32(y[0], y[1], w, false); w = __builtin_amdgcn_cvt_pk_fp8_f32(y[2], y[3], w, true); o4[64 * j] = (unsigned)w; }
#pragma unroll
            for (int j = 0; j < 8; ++j) v[j] = vn[j];
            m = mn; } }
#undef P0_ROWSRC
      GAS u32x4* z = (GAS u32x4*)(HN1 + (size_t)(MREAL + NMETA) * DM); const int n16 = (MPAD - MREAL - NMETA) * DM / 16;
      for (int i = gt; i < n16; i += NGT) z[i] = (u32x4){0u, 0u, 0u, 0u}; }
    if (PART == 0) { float* ct = WSP(float, WS_COS); float* st = WSP(float, WS_SIN);
      for (int i = gt; i < NPOS * 32; i += NGT) { const int p = i >> 5, j = i & 31;
          const float inv = __builtin_powf(10000.0f, -(float)(2 * j) / 64.0f); const float ang = (float)p * inv;
          double r = (double)ang * 0.15915494309189535; r -= __builtin_rint(r); const float rf = (float)r;
          ct[i] = __builtin_amdgcn_cosf(rf); st[i] = __builtin_amdgcn_sinf(rf); } }
    if (PART == 1) { const float* SK = F.in[15]; const float* WQ = F.in[14]; const float* g2 = F.in[13]; bf16_t* WSCp = WSP(bf16_t, WS_WSC);
      const int l15 = lane & 15, l4 = lane >> 4;
      for (int task = gw; task < 2048; task += NGW) { const int g = task >> 7, nt = (task >> 4) & 7, kc = task & 15, n0 = nt * 16;
          bf16x8 bfr[4];
#pragma unroll
          for (int kk = 0; kk < 4; ++kk) { const float* p = SK + ((size_t)g * 128 + n0 + l15) * 128 + 32 * kk + 8 * l4; const f32x4 a = *(const GAS f32x4*)p, b = *(const GAS f32x4*)(p + 4);
              const u32x4 w = pack8(a, b); bfr[kk] = __builtin_bit_cast(bf16x8, w); }
          for (int kt = 0; kt < 8; ++kt) { const int k0 = (kc * 8 + kt) * 16; f32x4 acc = (f32x4){0.f, 0.f, 0.f, 0.f};
#pragma unroll
              for (int kk = 0; kk < 4; ++kk) { const float* p = WQ + (size_t)(k0 + l15) * 2048 + g * 128 + 32 * kk + 8 * l4; const f32x4 a = *(const GAS f32x4*)p, b = *(const GAS f32x4*)(p + 4);
                  const u32x4 w = pack8(a, b); acc = __builtin_amdgcn_mfma_f32_16x16x32_bf16(__builtin_bit_cast(bf16x8, w), bfr[kk], acc, 0, 0, 0); }
              const f32x4 gg = *(const GAS f32x4*)(g2 + k0 + 4 * l4);
              *(GAS u32x2*)(WSCp + (size_t)(g * 128 + n0 + l15) * 2048 + k0 + 4 * l4) = pack4(acc * gg); } } }
}
using pg8::Unit;
struct SchedGrid {
    int G, c, nM, nN; const char* A; const char* B; size_t tstep;
    __device__ __forceinline__ bool next(int i, Unit& u) const { const int L = i * G + c; if (L >= nM * nN) return false; pg8::grid_order(L, nM, nN, u.pm, u.pn); u.kind = 0; return true; }
    __device__ __forceinline__ const char* pa(const Unit& u) const { return A + (size_t)u.pm * tstep; }
    __device__ __forceinline__ const char* pb(const Unit& u) const { return B + (size_t)u.pn * tstep; }
};
constexpr int P1_MAIN = 64 * 29, P1_VT = 4 * 65, P1_META = 7, P1_UNITS = P1_MAIN + P1_VT + P1_META;
struct SchedP1 {
    int G, c; const char* hn1; const char* win; const char* wvt; size_t tstep;
    __device__ __forceinline__ bool next(int i, Unit& u) const {
        const int L = i * G + c; if (L >= P1_UNITS) return false;
        if (L < P1_MAIN) { pg8::grid_order(L, 64, 29, u.pm, u.pn); u.kind = 0; }
        else if (L < P1_MAIN + P1_VT) { const int idx = L - P1_MAIN; u.pm = idx & 3; u.pn = idx >> 2; u.kind = 1; }
        else { const int idx = L - P1_MAIN - P1_VT; u.pm = 64; u.pn = idx < 4 ? 4 + idx : (idx < 6 ? 10 + (idx - 4) : 28); u.kind = 0; }
        return true; }
    __device__ __forceinline__ const char* pa(const Unit& u) const { return (u.kind == 1 ? wvt : hn1) + (size_t)u.pm * tstep; }
    __device__ __forceinline__ const char* pb(const Unit& u) const { return (u.kind == 1 ? hn1 : win) + (size_t)u.pn * tstep; }
};
__device__ __forceinline__ void rope4(const f32x4 x1, const f32x4 x2, const float* cosT, const float* sinT, int pos, int j0, f32x4& lo, f32x4& hi) {
    const f32x4 c = *(const GAS f32x4*)(cosT + pos * 32 + j0), s = *(const GAS f32x4*)(sinT + pos * 32 + j0);
    lo = x1 * c - x2 * s; hi = x2 * c + x1 * s;
}
struct EpiP1 {
    static constexpr bool PERM = true, HAS_PRE = false;
    bf16_t *naq, *nak, *vt; unsigned char *cq, *ckv; unsigned char *kr; unsigned char *ga, *gb; float *ssq_q, *ssq_kv; const float *cosT, *sinT;
    __device__ __forceinline__ void operator()(const f32x4 (&acc)[2][2][4][2], const Unit& u, int wr, int wc, int fr, int fq, const LAS float* rowsc) const {
        const int row0 = u.pm * 256 + wr * 64 + fr, colu = wc * 32 + 8 * fq;
        if (u.kind == 1) {
#pragma unroll
            for (int ai = 0; ai < 2; ++ai)
#pragma unroll
                for (int m = 0; m < 4; ++m) { bf16_t* rp = vt + (size_t)(row0 + ai * 128 + m * 16) * VT_PITCH + u.pn * 256 + colu;
#pragma unroll
                    for (int bj = 0; bj < 2; ++bj) *(GAS u32x4*)(rp + bj * 128) = pack8(acc[ai][bj][m][0], acc[ai][bj][m][1]); }
            return; }
        const int pn = u.pn;
        if (pn == 28) {
            if (wc < 2) { const int j0 = 4 * (4 * wc + fq);
#pragma unroll
                for (int ai = 0; ai < 2; ++ai)
#pragma unroll
                    for (int m = 0; m < 4; ++m) { const int row = row0 + ai * 128 + m * 16; const int pos = row < MREAL ? NMETA + (row & (SEQ - 1)) : row - MREAL;
                        f32x4 lo, hi; rope4(acc[ai][0][m][0], acc[ai][0][m][1], cosT, sinT, pos, j0, lo, hi);
                        *(GAS unsigned*)(kr + (size_t)row * 64 + j0) = pack4_fp8(lo); *(GAS unsigned*)(kr + (size_t)row * 64 + 32 + j0) = pack4_fp8(hi); } }
            return; }
        if (pn >= 12) {
            unsigned char* base = pn < 20 ? ga : gb; const int colt = (pn < 20 ? pn - 12 : pn - 20) * 256 + colu;
#pragma unroll
            for (int ai = 0; ai < 2; ++ai)
#pragma unroll
                for (int m = 0; m < 4; ++m) { unsigned char* rp = base + (size_t)(row0 + ai * 128 + m * 16) * 2048 + colt;
#pragma unroll
                    for (int bj = 0; bj < 2; ++bj) { f32x4 a = acc[ai][bj][m][0], b = acc[ai][bj][m][1];
#pragma unroll
                        for (int i = 0; i < 4; ++i) { a[i] = sigmoidf_(a[i]); b[i] = sigmoidf_(b[i]); }
                        *(GAS u32x2*)(rp + bj * 128) = pack8_u8(a, b); } }
            return; }
        if (pn >= 8) {
            const bool isq = pn < 10; unsigned char* base = isq ? cq : ckv; float* ssq = isq ? ssq_q : ssq_kv; const int colt = (isq ? pn - 8 : pn - 10) * 256 + colu;
#pragma unroll
            for (int ai = 0; ai < 2; ++ai)
#pragma unroll
                for (int m = 0; m < 4; ++m) { const int row = row0 + ai * 128 + m * 16; unsigned char* rp = base + (size_t)row * 512 + colt; float s = 0.f;
#pragma unroll
                    for (int bj = 0; bj < 2; ++bj) { const f32x4 a = acc[ai][bj][m][0], b = acc[ai][bj][m][1];
                        s += (a[0] * a[0] + a[1] * a[1]) + (a[2] * a[2] + a[3] * a[3]) + (b[0] * b[0] + b[1] * b[1]) + (b[2] * b[2] + b[3] * b[3]);
                        *(GAS u32x2*)(rp + bj * 128) = pack8_fp8(a, b); }
                    s += __shfl_xor(s, 16); s += __shfl_xor(s, 32);
                    if (fq == 0) ssq[(size_t)((pn & 1) * 4 + wc) * MPAD + row] = s; }
            return; }
        {
            bf16_t* base = pn < 4 ? naq : nak; const int colt = (pn & 3) * 256 + colu;
#pragma unroll
            for (int ai = 0; ai < 2; ++ai)
#pragma unroll
                for (int m = 0; m < 4; ++m) { bf16_t* rp = base + (size_t)(row0 + ai * 128 + m * 16) * 1024 + colt;
#pragma unroll
                    for (int bj = 0; bj < 2; ++bj) *(GAS u32x4*)(rp + bj * 128) = pack8(acc[ai][bj][m][0], acc[ai][bj][m][1]); }
        }
    }
};
constexpr int P3_Q = 64 * 12, P3_K = 65 * 8, P3_V = 8 * 65, P3_UNITS = P3_Q + P3_K + P3_V;
struct SchedP3 {
    int G, c; const char* ws; size_t tstep;
    __device__ __forceinline__ bool next(int i, Unit& u) const {
        const int L = i * G + c; if (L >= P3_UNITS) return false;
        if (L < P3_Q) { pg8::grid_order(L, 64, 12, u.pm, u.pn); u.kind = 0; }
        else if (L < P3_Q + P3_K) { pg8::grid_order(L - P3_Q, 65, 8, u.pm, u.pn); u.kind = 1; }
        else { const int idx = L - P3_Q - P3_K; u.pm = idx & 7; u.pn = idx >> 3; u.kind = 2; }
        return true; }
    __device__ __forceinline__ const char* pa(const Unit& u) const { const size_t o = u.kind == 0 ? WS_CQ : (u.kind == 1 ? WS_CKV : WS_WUKV + (size_t)2048 * 512); return ws + o + (size_t)u.pm * tstep; }
    __device__ __forceinline__ const char* pb(const Unit& u) const { const size_t o = u.kind == 0 ? WS_WUQ : (u.kind == 1 ? WS_WUKV : WS_CKV); return ws + o + (size_t)u.pn * tstep; }
};
template <int NS, int LD> __device__ __forceinline__ float rstd_slabs(const float* part, int row, float invn) {
    float s = 0.f;
#pragma unroll
    for (int i = 0; i < NS; ++i) s += part[(size_t)i * LD + row];
    return 1.0f / sqrtf(s * invn + NORM_EPS);
}
struct EpiP3 {
    static constexpr bool PERM = true, HAS_PRE = true;
    unsigned char *qm, *kn, *vt; const float *ssq_q, *ssq_kv; const float *cosT, *sinT;
    __device__ __forceinline__ void pre(const Unit& u, LAS float* sc, int tid) const { if (tid < 256) { const int row = (u.kind == 2 ? u.pn : u.pm) * 256 + tid; sc[tid] = u.kind ? rstd_slabs<8, MPAD>(ssq_kv, row, 1.f / 512.f) : rstd_slabs<8, MPAD>(ssq_q, row, 1.f / 512.f); } }
    __device__ __forceinline__ void operator()(const f32x4 (&acc)[2][2][4][2], const Unit& u, int wr, int wc, int fr, int fq, const LAS float* rowsc) const {
        const int row0 = u.pm * 256 + wr * 64 + fr, colu = wc * 32 + 8 * fq;
        if (u.kind == 2) {
#pragma unroll
            for (int bj = 0; bj < 2; ++bj) { const int cl = bj * 128 + colu, t0 = u.pn * 256 + cl;
                const f32x4 s0 = *(const LAS f32x4*)(rowsc + cl), s1 = *(const LAS f32x4*)(rowsc + cl + 4);
                const int g = (t0 >> 3) & 7, pos = (t0 & ~63) + 16 * (g >> 2) + 4 * (g & 3);
#pragma unroll
                for (int ai = 0; ai < 2; ++ai)
#pragma unroll
                    for (int m = 0; m < 4; ++m) { unsigned char* rp = vt + (size_t)(row0 + ai * 128 + m * 16) * MPAD + pos;
                        *(GAS unsigned*)rp = pack4_fp8(acc[ai][bj][m][0] * s0); *(GAS unsigned*)(rp + 32) = pack4_fp8(acc[ai][bj][m][1] * s1); } }
            return; }
        if (u.kind == 1) {
#pragma unroll
            for (int ai = 0; ai < 2; ++ai)
#pragma unroll
                for (int m = 0; m < 4; ++m) { const int row = row0 + ai * 128 + m * 16; const float rs = rowsc[ai * 128 + wr * 64 + m * 16 + fr];
                    unsigned char* rp = kn + (size_t)row * 2048 + u.pn * 256 + colu;
#pragma unroll
                    for (int bj = 0; bj < 2; ++bj) *(GAS u32x2*)(rp + bj * 128) = pack8_fp8(acc[ai][bj][m][0] * rs, acc[ai][bj][m][1] * rs); }
            return; }
#pragma unroll
        for (int bj = 0; bj < 2; ++bj) { const int c8 = u.pn * 256 + bj * 128 + colu; const int hd = c8 / 192, w = c8 - hd * 192;
            if (w < 128) {
#pragma unroll
                for (int ai = 0; ai < 2; ++ai)
#pragma unroll
                    for (int m = 0; m < 4; ++m) { const int row = row0 + ai * 128 + m * 16; const float rs = rowsc[ai * 128 + wr * 64 + m * 16 + fr];
                        *(GAS u32x2*)(qm + (size_t)row * 3072 + c8) = pack8_fp8(acc[ai][bj][m][0] * rs, acc[ai][bj][m][1] * rs); }
            } else { const int j0 = (w - 128) >> 1;
#pragma unroll
                for (int ai = 0; ai < 2; ++ai)
#pragma unroll
                    for (int m = 0; m < 4; ++m) { const int row = row0 + ai * 128 + m * 16; const float rs = rowsc[ai * 128 + wr * 64 + m * 16 + fr];
                        const int pos = NMETA + (row & (SEQ - 1)); f32x4 lo, hi; rope4(acc[ai][bj][m][0] * rs, acc[ai][bj][m][1] * rs, cosT, sinT, pos, j0, lo, hi);
                        unsigned char* qp = qm + (size_t)row * 3072 + hd * 192 + 128 + j0; *(GAS unsigned*)qp = pack4_fp8(lo); *(GAS unsigned*)(qp + 32) = pack4_fp8(hi); }
            } }
    }
};

__device__ __forceinline__ void unpack8(const u32x4 w, f32x4& a, f32x4& b) { a = (f32x4){bf_lo(w.x), bf_hi(w.x), bf_lo(w.y), bf_hi(w.y)}; b = (f32x4){bf_lo(w.z), bf_hi(w.z), bf_lo(w.w), bf_hi(w.w)}; }
struct EpiP5a {
    static constexpr bool PERM = true, HAS_PRE = false;
    const unsigned char* ga; unsigned char* t1;
    __device__ __forceinline__ void operator()(const f32x4 (&acc)[2][2][4][2], const Unit& u, int wr, int wc, int fr, int fq, const LAS float* rowsc) const {
        const int row0 = u.pm * 256 + wr * 64 + fr, col0 = u.pn * 256 + wc * 32 + 8 * fq;
#pragma unroll
        for (int ai = 0; ai < 2; ++ai)
#pragma unroll
            for (int m = 0; m < 4; ++m) { const size_t off = (size_t)(row0 + ai * 128 + m * 16) * 2048 + col0;
#pragma unroll
                for (int bj = 0; bj < 2; ++bj) { f32x4 g0, g1; unpack8_u8(*(const GAS u32x2*)(ga + off + bj * 128), g0, g1);
                    *(GAS u32x2*)(t1 + off + bj * 128) = pack8_fp8(acc[ai][bj][m][0] * g0 * 32.f, acc[ai][bj][m][1] * g1 * 32.f); } }
    }
};
struct EpiP5b {
    static constexpr bool PERM = true, HAS_PRE = false;
    const unsigned char* gb; const unsigned char* t1; unsigned char* merged;
    __device__ __forceinline__ void operator()(const f32x4 (&acc)[2][2][4][2], const Unit& u, int wr, int wc, int fr, int fq, const LAS float* rowsc) const {
        const int row0 = u.pm * 256 + wr * 64 + fr, col0 = u.pn * 256 + wc * 32 + 8 * fq;
#pragma unroll
        for (int ai = 0; ai < 2; ++ai)
#pragma unroll
            for (int m = 0; m < 4; ++m) { const size_t off = (size_t)(row0 + ai * 128 + m * 16) * 2048 + col0;
#pragma unroll
                for (int bj = 0; bj < 2; ++bj) { f32x4 g0, g1; unpack8_u8(*(const GAS u32x2*)(gb + off + bj * 128), g0, g1);
                    f32x4 a, b; unpack8_fp8(*(const GAS u32x2*)(t1 + off + bj * 128), a, b);
                    *(GAS u32x2*)(merged + off + bj * 128) = pack8_fp8(a + acc[ai][bj][m][0] * g0 * 32.f, b + acc[ai][bj][m][1] * g1 * 32.f); } }
    }
};
struct EpiP6 {
    static constexpr bool PERM = true, HAS_PRE = false;
    const float* x; bf16_t* h2b; float* ssq2;
    __device__ __forceinline__ void operator()(const f32x4 (&acc)[2][2][4][2], const Unit& u, int wr, int wc, int fr, int fq, const LAS float* rowsc) const {
        const int row0 = u.pm * 256 + wr * 64 + fr, col0 = u.pn * 256 + wc * 32 + 8 * fq;
#pragma unroll
        for (int ai = 0; ai < 2; ++ai)
#pragma unroll
            for (int m = 0; m < 4; ++m) { const int row = row0 + ai * 128 + m * 16; const size_t off = (size_t)row * 2048 + col0; float s = 0.f;
#pragma unroll
                for (int bj = 0; bj < 2; ++bj) { const f32x4 a = *(const GAS f32x4*)(x + off + bj * 128) + acc[ai][bj][m][0], b = *(const GAS f32x4*)(x + off + bj * 128 + 4) + acc[ai][bj][m][1];
                    s += (a[0] * a[0] + a[1] * a[1]) + (a[2] * a[2] + a[3] * a[3]) + (b[0] * b[0] + b[1] * b[1]) + (b[2] * b[2] + b[3] * b[3]);
                    *(GAS u32x4*)(h2b + off + bj * 128) = pack8(a, b); }
                s += __shfl_xor(s, 16); s += __shfl_xor(s, 32);
                if (fq == 0) ssq2[(size_t)(u.pn * 4 + wc) * MREAL + row] = s; }
    }
};
struct EpiP7 {
    static constexpr bool PERM = true, HAS_PRE = true;
    const float* ssq2; _Float16* sc;
    __device__ __forceinline__ void pre(const Unit& u, LAS float* sc, int tid) const { if (tid < 256) sc[tid] = rstd_slabs<32, MREAL>(ssq2, u.pm * 256 + tid, 1.f / 2048.f); }
    __device__ __forceinline__ void operator()(const f32x4 (&acc)[2][2][4][2], const Unit& u, int wr, int wc, int fr, int fq, const LAS float* rowsc) const {
        typedef _Float16 h4_t __attribute__((ext_vector_type(4)));
        const int row0 = u.pm * 256 + wr * 64 + fr, col0 = u.pn * 256 + wc * 32 + 8 * fq;
#pragma unroll
        for (int ai = 0; ai < 2; ++ai)
#pragma unroll
            for (int m = 0; m < 4; ++m) { const int row = row0 + ai * 128 + m * 16; const float rs = rowsc[ai * 128 + wr * 64 + m * 16 + fr]; const size_t off = (size_t)row * 2048 + col0;
#pragma unroll
                for (int bj = 0; bj < 2; ++bj) { const h4_t lo = __builtin_convertvector(acc[ai][bj][m][0] * rs, h4_t), hi = __builtin_convertvector(acc[ai][bj][m][1] * rs, h4_t);
                    const u32x2 wl = __builtin_bit_cast(u32x2, lo), wh = __builtin_bit_cast(u32x2, hi);
                    *(GAS u32x4*)(sc + off + bj * 128) = (u32x4){wl.x, wl.y, wh.x, wh.y}; } }
    }
};
namespace att {
#define KSWZ(row, colB) ((row) * 256 + ((colB) ^ (((row) & 7) << 4)))
#define KRSWZ(row, colB) ((row) * 128 + ((colB) ^ ((((row) >> 1) & 7) << 4)))
constexpr float L2E = 1.4426950408889634f;
template <int DUMMY = 0>
__device__ __forceinline__ void partialSM(f32x16& p0, f32x16& p1, float& m_reg, float& mn, float& alpha, const float C, const float THRS) {
  float pmax = p0[0];
#pragma unroll
  for (int r = 1; r < 16; ++r) pmax = fmaxf(pmax, p0[r]);
#pragma unroll
  for (int r = 0; r < 16; ++r) pmax = fmaxf(pmax, p1[r]);
  { auto rr = __builtin_amdgcn_permlane32_swap(__float_as_uint(pmax), __float_as_uint(pmax), false, false);
    pmax = fmaxf(__uint_as_float(rr[0]), __uint_as_float(rr[1])); }
  if (__builtin_expect(__all(pmax - m_reg <= THRS), 1)) { mn = m_reg; alpha = 1.f; }
  else { mn = fmaxf(m_reg, pmax); alpha = __builtin_amdgcn_exp2f((m_reg - mn) * C); m_reg = mn; }
  const float mnC = -mn * C;
#pragma unroll
  for (int r = 0; r < 16; ++r) p0[r] = fmaf(p0[r], C, mnC);
#pragma unroll
  for (int r = 0; r < 16; ++r) p1[r] = fmaf(p1[r], C, mnC);
#pragma unroll
  for (int r = 0; r < 16; ++r) p0[r] = __builtin_amdgcn_exp2f(p0[r]);
}
__device__ __forceinline__ void finishSM(f32x16& p0, f32x16& p1, float alpha, float& l_reg, bf16x8& pa0, bf16x8& pa1, bf16x8& pa2, bf16x8& pa3) {
#pragma unroll
  for (int r = 0; r < 16; ++r) p1[r] = __builtin_amdgcn_exp2f(p1[r]);
  float ps = 0;
#pragma unroll
  for (int r = 0; r < 16; ++r) ps += p0[r];
#pragma unroll
  for (int r = 0; r < 16; ++r) ps += p1[r];
  { auto rr = __builtin_amdgcn_permlane32_swap(__float_as_uint(ps), __float_as_uint(ps), false, false);
    ps = __uint_as_float(rr[0]) + __uint_as_float(rr[1]); }
  l_reg = l_reg * alpha + ps;
#define PK4(P, BASE, OUT) do { unsigned a0 = cvt_pk_bf16(P[BASE + 0], P[BASE + 1]), a1 = cvt_pk_bf16(P[BASE + 2], P[BASE + 3]);   \
    unsigned b0 = cvt_pk_bf16(P[BASE + 4], P[BASE + 5]), b1 = cvt_pk_bf16(P[BASE + 6], P[BASE + 7]);                              \
    auto r0 = __builtin_amdgcn_permlane32_swap(a0, b0, false, false); auto r1 = __builtin_amdgcn_permlane32_swap(a1, b1, false, false); \
    u32x4 w = {r0[0], r1[0], r0[1], r1[1]}; OUT = __builtin_bit_cast(bf16x8, w); } while (0)
  PK4(p0, 0, pa0); PK4(p0, 8, pa1); PK4(p1, 0, pa2); PK4(p1, 8, pa3);
#undef PK4
}
constexpr int NW = 8, QBLK = 32, KVBLK = 64;
constexpr float MLA_SCALE = 0.07216878364870322f;
constexpr float MLA_THR = 8.f;
constexpr int SHM_V = KVBLK * 128 * 2, SHM_KN = KVBLK * 128 * 2, SHM_KR = KVBLK * 64 * 2;
constexpr int OFF_V = 0, OFF_KN = 2 * SHM_V, OFF_KR = OFF_KN + 2 * SHM_KN, OFF_WS = OFF_KR + 2 * SHM_KR, OFF_QR = OFF_WS + NW * 64 * 4, MLA_LDS = OFF_QR + NW * 4096;
__device__ __forceinline__ void qkt(f32x16& p0, f32x16& p1, const LAS char* Kn, const LAS char* Kr, const bf16x8* qr, const LAS char* qrp, const int* kb, const int* krb) {
  p0 = f32x16{}; p1 = f32x16{};
#pragma unroll
  for (int d0 = 0; d0 < 8; ++d0) {
    const bf16x8 b0 = *(const LAS bf16x8*)(Kn + kb[d0 & 3] + (d0 >> 2) * 128);
    const bf16x8 b1 = *(const LAS bf16x8*)(Kn + kb[d0 & 3] + (d0 >> 2) * 128 + 8192);
    p0 = __builtin_amdgcn_mfma_f32_32x32x16_bf16(b0, qr[d0], p0, 0, 0, 0);
    p1 = __builtin_amdgcn_mfma_f32_32x32x16_bf16(b1, qr[d0], p1, 0, 0, 0); }
#pragma unroll
  for (int d0 = 0; d0 < 4; ++d0) {
    const bf16x8 b0 = *(const LAS bf16x8*)(Kr + krb[d0]);
    const bf16x8 b1 = *(const LAS bf16x8*)(Kr + krb[d0] + 4096);
    const bf16x8 qf = *(const LAS bf16x8*)(qrp + d0 * 1024);
    p0 = __builtin_amdgcn_mfma_f32_32x32x16_bf16(b0, qf, p0, 0, 0, 0);
    p1 = __builtin_amdgcn_mfma_f32_32x32x16_bf16(b1, qf, p1, 0, 0, 0); }
}
__device__ __forceinline__ int v_st(int k, int c) { const int kk = (k & ~0xC) | ((k & 4) << 1) | ((k & 8) >> 1); return ((kk >> 3) * 4 + (c >> 5)) * 512 + ((kk & 7) * 32 + (c & 31)) * 2; }
__device__ __forceinline__ int v_rd_base(int lane) { return ((lane & 3) << 3) | (((lane >> 2) & 3) << 6) | (((lane >> 4) & 1) << 5) | (((lane >> 5) & 1) << 8); }
constexpr int v_rd_off(int d0, int ks, int half) { return d0 * 512 + ks * 4096 + half * 2048; }
template <int OFF> __device__ __forceinline__ s16x4 tr_read(int vb) {
  s16x4 r; asm volatile("ds_read_b64_tr_b16 %0, %1 offset:%2" : "=&v"(r) : "v"(vb), "i"(OFF) : "memory"); return r;
}
template <int D0> __device__ __forceinline__ void pv_one(f32x16& od, int vb, bf16x8 pa0, bf16x8 pa1, bf16x8 pa2, bf16x8 pa3) {
  const s16x4 l0 = tr_read<v_rd_off(D0, 0, 0)>(vb), h0 = tr_read<v_rd_off(D0, 0, 1)>(vb), l1 = tr_read<v_rd_off(D0, 1, 0)>(vb), h1 = tr_read<v_rd_off(D0, 1, 1)>(vb);
  const s16x4 l2 = tr_read<v_rd_off(D0, 2, 0)>(vb), h2 = tr_read<v_rd_off(D0, 2, 1)>(vb), l3 = tr_read<v_rd_off(D0, 3, 0)>(vb), h3 = tr_read<v_rd_off(D0, 3, 1)>(vb);
  asm volatile("s_waitcnt lgkmcnt(0)" ::: "memory"); SBAR();
#define PK(L, H) (bf16x8){L[0], L[1], L[2], L[3], H[0], H[1], H[2], H[3]}
  od = __builtin_amdgcn_mfma_f32_32x32x16_bf16(pa0, PK(l0, h0), od, 0, 0, 0);
  od = __builtin_amdgcn_mfma_f32_32x32x16_bf16(pa1, PK(l1, h1), od, 0, 0, 0);
  od = __builtin_amdgcn_mfma_f32_32x32x16_bf16(pa2, PK(l2, h2), od, 0, 0, 0);
  od = __builtin_amdgcn_mfma_f32_32x32x16_bf16(pa3, PK(l3, h3), od, 0, 0, 0);
#undef PK
}
__device__ __forceinline__ void pv_d0(f32x16* o, int vb, bf16x8 pa0, bf16x8 pa1, bf16x8 pa2, bf16x8 pa3) {
  pv_one<0>(o[0], vb, pa0, pa1, pa2, pa3); pv_one<1>(o[1], vb, pa0, pa1, pa2, pa3); pv_one<2>(o[2], vb, pa0, pa1, pa2, pa3); pv_one<3>(o[3], vb, pa0, pa1, pa2, pa3);
}
__device__ __forceinline__ void mla_unit(int b, int h, int qb, const bf16_t* __restrict__ QM, const bf16_t* __restrict__ KN, const bf16_t* __restrict__ KR, const bf16_t* __restrict__ VV, unsigned char* __restrict__ OM, LAS char* lds) {
  const int tid = threadIdx.x, wid = tid >> 6, lane = tid & 63, r32 = lane & 31, hi = lane >> 5;
  constexpr float C = MLA_SCALE * L2E, THRS = MLA_THR / MLA_SCALE;
  constexpr int NT = 33;
  LAS char* V_lds = lds + OFF_V; LAS char* Kn_lds = lds + OFF_KN; LAS char* Kr_lds = lds + OFF_KR;
  LAS float* ws = (LAS float*)(lds + OFF_WS) + wid * 64; LAS float* li_l = ws; LAS float* al_l = ws + 32;
  float m_reg = -1e30f, l_reg = 0; f32x16 o[4] = {}; bf16x8 qr[8];
  LAS char* qrp = lds + OFF_QR + wid * 4096 + lane * 16;
  const int qrow = b * SEQ + qb * 256 + wid * QBLK + r32;
  const bf16_t* Qw = QM + (size_t)qrow * 3072 + h * 192 + hi * 8;
#pragma unroll
  for (int d0 = 0; d0 < 8; ++d0) qr[d0] = *(const GAS bf16x8*)(Qw + d0 * 16);
  __syncthreads();
#pragma unroll
  for (int d0 = 0; d0 < 4; ++d0) *(LAS bf16x8*)(qrp + d0 * 1024) = *(const GAS bf16x8*)(Qw + (8 + d0) * 16);
  const int sr = tid >> 4, sc = (tid & 15) * 8, vst0 = v_st(sr, sc), vst1 = v_st(32 + sr, sc);
  const int krr = tid >> 3, krc = (tid & 7) * 8;
  const int vb0 = (int)(uintptr_t)V_lds + v_rd_base(lane);
  bf16x8 s_v0, s_v1, s_k0, s_k1, s_kr;
  const int realbase = b * SEQ - KVBLK;
  const unsigned voff = (unsigned)(sr * 2048 + sc) * 2u, kroff = (unsigned)(krr * 64 + krc) * 2u;
  int kb[4], krb[4];
#pragma unroll
  for (int bq = 0; bq < 4; ++bq) { kb[bq] = KSWZ(r32, bq * 32 + hi * 16); krb[bq] = KRSWZ(r32, bq * 32 + hi * 16); }
#define TROW(t) ((t) == 0 ? MREAL : realbase + (t) * KVBLK)
#define SLOAD(t) do { const int k0_ = TROW(t); const size_t ro_ = ((size_t)k0_ * 2048 + h * 128) * 2; \
    const GAS char* vb_ = (const GAS char*)VV + ro_; const GAS char* nb_ = (const GAS char*)KN + ro_; const GAS char* rb_ = (const GAS char*)KR + (size_t)k0_ * 128; \
    s_v0 = *(const GAS bf16x8*)(vb_ + voff); s_v1 = *(const GAS bf16x8*)(vb_ + 32 * 4096 + voff); \
    s_k0 = *(const GAS bf16x8*)(nb_ + voff); s_k1 = *(const GAS bf16x8*)(nb_ + 32 * 4096 + voff); \
    s_kr = *(const GAS bf16x8*)(rb_ + kroff); } while (0)
#define SWRITE(bf) do { *(LAS bf16x8*)(V_lds + (bf) * SHM_V + vst0) = s_v0; *(LAS bf16x8*)(V_lds + (bf) * SHM_V + vst1) = s_v1; const int kc_ = sc * 2; \
    *(LAS bf16x8*)(Kn_lds + (bf) * SHM_KN + KSWZ(sr, kc_)) = s_k0; *(LAS bf16x8*)(Kn_lds + (bf) * SHM_KN + KSWZ(32 + sr, kc_)) = s_k1; \
    *(LAS bf16x8*)(Kr_lds + (bf) * SHM_KR + KRSWZ(krr, krc * 2)) = s_kr; } while (0)
#define SWAIT() asm volatile("s_waitcnt vmcnt(0)" ::: "memory")
#define RESC(a) do { if (__any((a) < 1.f)) { if (hi == 0) al_l[r32] = (a); asm volatile("s_waitcnt lgkmcnt(0)" ::: "memory"); \
    _Pragma("unroll") for (int d = 0; d < 4; ++d) _Pragma("unroll") for (int r = 0; r < 16; ++r) o[d][r] *= al_l[crow(r, hi)]; } } while (0)
  f32x16 pA0, pA1, pB0, pB1; float mnA, mnB, alA, alB; bf16x8 pa0, pa1, pa2, pa3;
  SLOAD(0); SWAIT(); SWRITE(0); __syncthreads();
  qkt(pA0, pA1, Kn_lds, Kr_lds, qr, qrp, kb, krb);
  { const float NEG = -INFINITY;
#pragma unroll
    for (int r = 8; r < 16; ++r) pA0[r] = NEG;
#pragma unroll
    for (int r = 0; r < 16; ++r) pA1[r] = NEG; }
  partialSM(pA0, pA1, m_reg, mnA, alA, C, THRS);
  SLOAD(1); SWAIT(); SWRITE(1); __syncthreads();
  for (int j = 1; j + 1 < NT; j += 2) {
    SBAR(); qkt(pB0, pB1, Kn_lds + SHM_KN, Kr_lds + SHM_KR, qr, qrp, kb, krb);
    finishSM(pA0, pA1, alA, l_reg, pa0, pa1, pa2, pa3); SBAR();
    SLOAD(j + 1); SBAR();
    pv_d0(o, vb0, pa0, pa1, pa2, pa3); partialSM(pB0, pB1, m_reg, mnB, alB, C, THRS);
    __syncthreads(); SWAIT(); SWRITE(0);
    RESC(alB); __syncthreads();
    SBAR(); qkt(pA0, pA1, Kn_lds, Kr_lds, qr, qrp, kb, krb);
    finishSM(pB0, pB1, alB, l_reg, pa0, pa1, pa2, pa3); SBAR();
    if (j + 2 < NT) SLOAD(j + 2); SBAR();
    pv_d0(o, vb0 + SHM_V, pa0, pa1, pa2, pa3); partialSM(pA0, pA1, m_reg, mnA, alA, C, THRS);
    __syncthreads(); if (j + 2 < NT) { SWAIT(); SWRITE(1); }
    RESC(alA); __syncthreads();
  }
  finishSM(pA0, pA1, alA, l_reg, pa0, pa1, pa2, pa3); SBAR();
  pv_d0(o, vb0, pa0, pa1, pa2, pa3);
  if (hi == 0) li_l[r32] = l_reg; asm volatile("s_waitcnt lgkmcnt(0)" ::: "memory");
  float rli[16];
#pragma unroll
  for (int r = 0; r < 16; ++r) rli[r] = __builtin_amdgcn_rcpf(li_l[crow(r, hi)]);
  unsigned char* Ow = OM + (size_t)(b * SEQ + qb * 256 + wid * QBLK) * 2048 + h * 128;
#pragma unroll
  for (int r = 0; r < 16; ++r) { const int orow = crow(r, hi);
#pragma unroll
    for (int d0 = 0; d0 < 4; ++d0) Ow[(size_t)orow * 2048 + d0 * 32 + r32] = f32_to_fp8(o[d0][r] * rli[r] * 32.f); }
#undef TROW
#undef SLOAD
#undef SWRITE
#undef SWAIT
#undef RESC
}
constexpr int K8S = 208, V8S = 80, SHM8_K = 64 * K8S, SHM8_V = 128 * V8S;
constexpr int OFF8_K = 0, OFF8_V = 2 * SHM8_K, OFF8_WS = OFF8_V + 2 * SHM8_V, MLA8_LDS = OFF8_WS + NW * 64 * 4;
constexpr float MLA8_THR = 0.5f;
typedef int a8_t __attribute__((ext_vector_type(8)));
#define MFMA8(acc_, a_, b_, sa_, sb_) asm volatile("s_nop 1\n\tv_mfma_scale_f32_32x32x64_f8f6f4 %0, %1, %2, %0, %3, %4 op_sel_hi:[0,0,0]" : "+v"(acc_) : "v"(a_), "v"(b_), "v"(sa_), "v"(sb_))
__device__ __forceinline__ a8_t ld_frag8(const LAS char* p) { const u32x4 lo = *(const LAS u32x4*)p, hi = *(const LAS u32x4*)(p + 16); return (a8_t){(int)lo.x, (int)lo.y, (int)lo.z, (int)lo.w, (int)hi.x, (int)hi.y, (int)hi.z, (int)hi.w}; }
__device__ __forceinline__ void qkt8(f32x16& p0, f32x16& p1, const LAS char* Kb, const a8_t& q0, const a8_t& q1, const a8_t& q2, int s1) {
  p0 = f32x16{}; p1 = f32x16{};
  { const a8_t a0 = ld_frag8(Kb), a1 = ld_frag8(Kb + 32 * K8S); MFMA8(p0, a0, q0, s1, s1); MFMA8(p1, a1, q0, s1, s1); }
  { const a8_t a0 = ld_frag8(Kb + 64), a1 = ld_frag8(Kb + 32 * K8S + 64); MFMA8(p0, a0, q1, s1, s1); MFMA8(p1, a1, q1, s1, s1); }
  { const a8_t a0 = ld_frag8(Kb + 128), a1 = ld_frag8(Kb + 32 * K8S + 128); MFMA8(p0, a0, q2, s1, s1); MFMA8(p1, a1, q2, s1, s1); }
  asm volatile("s_nop 15\n\ts_nop 15" : "+v"(p0), "+v"(p1));
}
__device__ __forceinline__ void partialSM8(f32x16& p0, f32x16& p1, float& m_reg, float& mn, float& alpha, const float C, const float THRS) {
  float pmax = p0[0];
#pragma unroll
  for (int r = 1; r < 16; ++r) pmax = fmaxf(pmax, p0[r]);
#pragma unroll
  for (int r = 0; r < 16; ++r) pmax = fmaxf(pmax, p1[r]);
  { auto rr = __builtin_amdgcn_permlane32_swap(__float_as_uint(pmax), __float_as_uint(pmax), false, false);
    pmax = fmaxf(__uint_as_float(rr[0]), __uint_as_float(rr[1])); }
  if (__builtin_expect(__all(pmax - m_reg <= THRS), 1)) { mn = m_reg; alpha = 1.f; }
  else { mn = fmaxf(m_reg, pmax); alpha = __builtin_amdgcn_exp2f((m_reg - mn) * C); m_reg = mn; }
  const float mnC = 8.f - mn * C;
#pragma unroll
  for (int r = 0; r < 16; ++r) p0[r] = fmaf(p0[r], C, mnC);
#pragma unroll
  for (int r = 0; r < 16; ++r) p1[r] = fmaf(p1[r], C, mnC);
#pragma unroll
  for (int r = 0; r < 16; ++r) p0[r] = __builtin_amdgcn_exp2f(p0[r]);
}
__device__ __forceinline__ void finishSM8(f32x16& p0, f32x16& p1, float alpha, float& l_reg, a8_t& pf) {
#pragma unroll
  for (int r = 0; r < 16; ++r) p1[r] = __builtin_amdgcn_exp2f(p1[r]);
  float ps = 0;
#pragma unroll
  for (int r = 0; r < 16; ++r) ps += p0[r];
#pragma unroll
  for (int r = 0; r < 16; ++r) ps += p1[r];
  { auto rr = __builtin_amdgcn_permlane32_swap(__float_as_uint(ps), __float_as_uint(ps), false, false);
    ps = __uint_as_float(rr[0]) + __uint_as_float(rr[1]); }
  l_reg = l_reg * alpha + ps;
#pragma unroll
  for (int w = 0; w < 4; ++w) { int x = 0, y = 0;
    x = __builtin_amdgcn_cvt_pk_fp8_f32(p0[4 * w], p0[4 * w + 1], x, false); x = __builtin_amdgcn_cvt_pk_fp8_f32(p0[4 * w + 2], p0[4 * w + 3], x, true);
    y = __builtin_amdgcn_cvt_pk_fp8_f32(p1[4 * w], p1[4 * w + 1], y, false); y = __builtin_amdgcn_cvt_pk_fp8_f32(p1[4 * w + 2], p1[4 * w + 3], y, true);
    pf[w] = x; pf[4 + w] = y; }
}
__device__ __forceinline__ void pv8(f32x16* o, const LAS char* Vb, const a8_t& pf, int sP, int s1) {
  const a8_t b0 = ld_frag8(Vb), b1 = ld_frag8(Vb + 32 * V8S), b2 = ld_frag8(Vb + 64 * V8S), b3 = ld_frag8(Vb + 96 * V8S);
  MFMA8(o[0], pf, b0, sP, s1); MFMA8(o[1], pf, b1, sP, s1); MFMA8(o[2], pf, b2, sP, s1); MFMA8(o[3], pf, b3, sP, s1);
  asm volatile("s_nop 15\n\ts_nop 15" : "+v"(o[0]), "+v"(o[1]), "+v"(o[2]), "+v"(o[3]));
}
__device__ __forceinline__ void mla_unit8(int b, int h, int qb, const unsigned char* __restrict__ QM8, const unsigned char* __restrict__ KN8, const unsigned char* __restrict__ KR8, const unsigned char* __restrict__ VT8,
                                          unsigned char* __restrict__ OM, LAS char* lds) {
  const int tid = threadIdx.x, wid = tid >> 6, lane = tid & 63, r32 = lane & 31, hi = lane >> 5;
  constexpr float C = MLA_SCALE * L2E, THRS = MLA8_THR / MLA_SCALE;
  constexpr int NT = 33;
  LAS char* K_lds = lds + OFF8_K; LAS char* V_lds = lds + OFF8_V;
  LAS float* ws = (LAS float*)(lds + OFF8_WS) + wid * 64; LAS float* li_l = ws; LAS float* al_l = ws + 32;
  int s1 = 0x7f7f7f7f, sP = 0x77777777; asm volatile("" : "+v"(s1), "+v"(sP));
  float m_reg = -1e30f, l_reg = 0; f32x16 o[4] = {};
  const int qrow = b * SEQ + qb * 256 + wid * QBLK + r32;
  a8_t q0, q1, q2;
  { const unsigned char* Qw = QM8 + (size_t)qrow * 3072 + h * 192 + hi * 32;
    const u32x4 a = *(const GAS u32x4*)Qw, bq = *(const GAS u32x4*)(Qw + 16), c = *(const GAS u32x4*)(Qw + 64), d = *(const GAS u32x4*)(Qw + 80), e = *(const GAS u32x4*)(Qw + 128), f = *(const GAS u32x4*)(Qw + 144);
    q0 = (a8_t){(int)a.x, (int)a.y, (int)a.z, (int)a.w, (int)bq.x, (int)bq.y, (int)bq.z, (int)bq.w};
    q1 = (a8_t){(int)c.x, (int)c.y, (int)c.z, (int)c.w, (int)d.x, (int)d.y, (int)d.z, (int)d.w};
    q2 = (a8_t){(int)e.x, (int)e.y, (int)e.z, (int)e.w, (int)f.x, (int)f.y, (int)f.z, (int)f.w}; }
  __syncthreads();
  const int kkey = tid >> 3, kch = tid & 7, rkey = (tid >> 2) & 63, rch = tid & 3, vdim = tid >> 2, vch = tid & 3;
  const LAS char* Kf = K_lds + r32 * K8S + 32 * hi; const LAS char* Vf = V_lds + r32 * V8S + 32 * hi;
  u32x4 s_k, s_r, s_v;
  const int realbase = b * SEQ - KVBLK;
#define TROW(t) ((t) == 0 ? MREAL : realbase + (t) * KVBLK)
#define SLOAD(t) do { const int k0_ = TROW(t); \
    s_k = *(const GAS u32x4*)(KN8 + (size_t)(k0_ + kkey) * 2048 + h * 128 + kch * 16); \
    s_r = *(const GAS u32x4*)(KR8 + (size_t)(k0_ + rkey) * 64 + rch * 16); \
    s_v = *(const GAS u32x4*)(VT8 + (size_t)(h * 128 + vdim) * MPAD + k0_ + vch * 16); } while (0)
#define SWRITE(bf) do { *(LAS u32x4*)(K_lds + (bf) * SHM8_K + kkey * K8S + kch * 16) = s_k; if (tid < 256) *(LAS u32x4*)(K_lds + (bf) * SHM8_K + rkey * K8S + 128 + rch * 16) = s_r; \
    *(LAS u32x4*)(V_lds + (bf) * SHM8_V + vdim * V8S + vch * 16) = s_v; } while (0)
#define SWAIT() asm volatile("s_waitcnt vmcnt(0)" ::: "memory")
#define RESC(a) do { if (__any((a) < 1.f)) { if (hi == 0) al_l[r32] = (a); asm volatile("s_waitcnt lgkmcnt(0)" ::: "memory"); \
    _Pragma("unroll") for (int d = 0; d < 4; ++d) _Pragma("unroll") for (int r = 0; r < 16; ++r) o[d][r] *= al_l[crow(r, hi)]; } } while (0)
  f32x16 pA0, pA1, pB0, pB1; float mnA, mnB, alA, alB; a8_t pf;
  SLOAD(0); SWAIT(); SWRITE(0); __syncthreads();
  qkt8(pA0, pA1, Kf, q0, q1, q2, s1);
  { const float NEG = -INFINITY;
#pragma unroll
    for (int r = 8; r < 16; ++r) pA0[r] = NEG;
#pragma unroll
    for (int r = 0; r < 16; ++r) pA1[r] = NEG; }
  partialSM8(pA0, pA1, m_reg, mnA, alA, C, THRS);
  SLOAD(1); SWAIT(); SWRITE(1); __syncthreads();
  for (int j = 1; j + 1 < NT; j += 2) {
    SBAR(); qkt8(pB0, pB1, Kf + SHM8_K, q0, q1, q2, s1);
    finishSM8(pA0, pA1, alA, l_reg, pf); SBAR();
    SLOAD(j + 1); SBAR();
    pv8(o, Vf, pf, sP, s1); partialSM8(pB0, pB1, m_reg, mnB, alB, C, THRS);
    __syncthreads(); SWAIT(); SWRITE(0);
    RESC(alB); __syncthreads();
    SBAR(); qkt8(pA0, pA1, Kf, q0, q1, q2, s1);
    finishSM8(pB0, pB1, alB, l_reg, pf); SBAR();
    if (j + 2 < NT) SLOAD(j + 2); SBAR();
    pv8(o, Vf + SHM8_V, pf, sP, s1); partialSM8(pA0, pA1, m_reg, mnA, alA, C, THRS);
    __syncthreads(); if (j + 2 < NT) { SWAIT(); SWRITE(1); }
    RESC(alA); __syncthreads();
  }
  finishSM8(pA0, pA1, alA, l_reg, pf); SBAR();
  pv8(o, Vf, pf, sP, s1);
  if (hi == 0) li_l[r32] = l_reg; asm volatile("s_waitcnt lgkmcnt(0)" ::: "memory");
  float rli[16];
#pragma unroll
  for (int r = 0; r < 16; ++r) rli[r] = __builtin_amdgcn_rcpf(li_l[crow(r, hi)]) * (256.f * 32.f);
  unsigned char* Ow = OM + (size_t)(b * SEQ + qb * 256 + wid * QBLK) * 2048 + h * 128;
#pragma unroll
  for (int r = 0; r < 16; ++r) { const int orow = crow(r, hi);
#pragma unroll
    for (int d0 = 0; d0 < 4; ++d0) Ow[(size_t)orow * 2048 + d0 * 32 + r32] = f32_to_fp8(o[d0][r] * rli[r]); }
#undef TROW
#undef SLOAD
#undef SWRITE
#undef SWAIT
#undef RESC
}
__device__ __forceinline__ void na_task(int task, const bf16_t* __restrict__ NAQ, const bf16_t* __restrict__ NAK, const bf16_t* __restrict__ VT, unsigned char* __restrict__ ONA,
                                        const LAS float* relb, const LAS float* metab, LAS float* wsf, int lane, Conv& cv) {
  const int r32 = lane & 31, hi = lane >> 5;
  const int half = task & 1, r = (task >> 1) & 31, h = (task >> 6) & 15, b = task >> 10;
  const int qc = half * 32 + r32;
  const int cs = min(max(qc - 8, 0), 48), rs = min(max(r - 4, 0), 24);
  const int qtok = b * SEQ + r * 64 + qc;
  constexpr float C = L2E, THRS = 8.f, SCALE = 0.125f;
  bf16x8 qr[4];
#pragma unroll
  for (int d0 = 0; d0 < 4; ++d0) qr[d0] = *(const GAS bf16x8*)(NAQ + (size_t)qtok * 1024 + h * 64 + d0 * 16 + hi * 8);
  float m_reg = -1e30f, l_reg = 0.f; f32x16 o[2] = {};
  LAS float* al_l = wsf; LAS float* li_l = wsf + 32;
  const float NEG = -INFINITY;
  const int kb0 = half * 16;
  const unsigned long long wm = 0xFFFFull << (cs - kb0);
  const unsigned mh0 = (unsigned)wm >> (4 * hi), mh1 = (unsigned)(wm >> 32) >> (4 * hi);
  const bf16_t* kq = NAK + (size_t)r32 * 1024 + h * 64 + hi * 8;
  const bf16_t* kq2 = NAK + (size_t)(32 + (r32 & 15)) * 1024 + h * 64 + hi * 8;
  const bf16_t* vq = VT + (size_t)(h * 64 + r32) * VT_PITCH + 8 * hi;
#define NA_KTOK(w) ((w) == 8 ? MREAL : b * SEQ + (rs + (w)) * 64 + kb0)
#define NA_LOADK(KF, w) do { const size_t ko_ = (size_t)NA_KTOK(w) * 1024; _Pragma("unroll") for (int d0 = 0; d0 < 4; ++d0) { KF[d0] = *(const GAS bf16x8*)(kq + ko_ + d0 * 16); KF[4 + d0] = *(const GAS bf16x8*)(kq2 + ko_ + d0 * 16); } } while (0)
#define NA_TILE(KF, w, YN) do { \
    bf16x8 vf[6]; { const bf16_t* vp_ = vq + NA_KTOK(w); _Pragma("unroll") for (int ks = 0; ks < 3; ++ks) { vf[ks] = *(const GAS bf16x8*)(vp_ + 16 * ks); vf[3 + ks] = *(const GAS bf16x8*)(vp_ + (size_t)32 * VT_PITCH + 16 * ks); } } \
    f32x16 p0 = {}, p1 = {}; \
    _Pragma("unroll") for (int d0 = 0; d0 < 4; ++d0) { p0 = __builtin_amdgcn_mfma_f32_32x32x16_bf16(KF[d0], qr[d0], p0, 0, 0, 0); p1 = __builtin_amdgcn_mfma_f32_32x32x16_bf16(KF[4 + d0], qr[d0], p1, 0, 0, 0); } \
    if ((w) + 1 < 9) NA_LOADK(KF, (w) + 1);            \
    asm volatile("" ::: "memory"); if ((cv.tick++ & 1) == 0) conv_step<20>(cv, lane);     \
    if ((w) < 8) { const LAS float* bp_ = relb + ((h * 15 + (rs + (w) - r + 7)) * 31 + 15 - qc + 4 * hi + kb0);     \
      float bv0[16], bv1[8];        \
      _Pragma("unroll") for (int rg = 0; rg < 16; ++rg) { const int c_ = (rg & 3) + 8 * (rg >> 2); bv0[rg] = bp_[c_]; if (rg < 8) bv1[rg] = bp_[c_ + 32]; } \
      _Pragma("unroll") for (int rg = 0; rg < 16; ++rg) { asm volatile("" : "+v"(bv0[rg])); if (rg < 8) asm volatile("" : "+v"(bv1[rg])); } \
      _Pragma("unroll") for (int rg = 0; rg < 16; ++rg) { const int c_ = (rg & 3) + 8 * (rg >> 2); \
        { const bool ok = (mh0 >> c_) & 1u; p0[rg] = ok ? fmaf(p0[rg], SCALE, bv0[rg]) : NEG; } \
        if (rg < 8) { const bool ok = (mh1 >> c_) & 1u; p1[rg] = ok ? fmaf(p1[rg], SCALE, bv1[rg]) : NEG; } } \
    } else { const LAS float* bp = metab + h * 16; \
      _Pragma("unroll") for (int rg = 0; rg < 16; ++rg) { const int kc = crow(rg, hi); p0[rg] = (rg < 8) ? fmaf(p0[rg], SCALE, bp[kc & 15]) : NEG; if (rg < 8) p1[rg] = NEG; } } \
      \
    float pmax = p0[0]; \
    _Pragma("unroll") for (int rg = 1; rg < 16; ++rg) pmax = fmaxf(pmax, p0[rg]); \
    _Pragma("unroll") for (int rg = 0; rg < 8; ++rg) pmax = fmaxf(pmax, p1[rg]); \
    { auto rr = __builtin_amdgcn_permlane32_swap(__float_as_uint(pmax), __float_as_uint(pmax), false, false); pmax = fmaxf(__uint_as_float(rr[0]), __uint_as_float(rr[1])); } \
    float mn, alpha; \
    if (__builtin_expect(__all(pmax - m_reg <= THRS), 1)) { mn = m_reg; alpha = 1.f; } \
    else { mn = fmaxf(m_reg, pmax); alpha = __builtin_amdgcn_exp2f((m_reg - mn) * C); m_reg = mn; } \
    const float mnC = -mn * C; float ps = 0.f; \
    _Pragma("unroll") for (int rg = 0; rg < 16; ++rg) { p0[rg] = __builtin_amdgcn_exp2f(fmaf(p0[rg], C, mnC)); ps += p0[rg]; } \
    _Pragma("unroll") for (int rg = 0; rg < 8; ++rg) { p1[rg] = __builtin_amdgcn_exp2f(fmaf(p1[rg], C, mnC)); ps += p1[rg]; } \
    { auto rr = __builtin_amdgcn_permlane32_swap(__float_as_uint(ps), __float_as_uint(ps), false, false); ps = __uint_as_float(rr[0]) + __uint_as_float(rr[1]); } \
    l_reg = l_reg * alpha + ps; \
    bf16x8 pa0, pa1, pa2; NA_PK4(p0, 0, pa0); NA_PK4(p0, 8, pa1); NA_PK4(p1, 0, pa2); \
    if (__any(alpha < 1.f)) { if (hi == 0) al_l[r32] = alpha; asm volatile("s_waitcnt lgkmcnt(0)" ::: "memory"); \
      _Pragma("unroll") for (int d = 0; d < 2; ++d) _Pragma("unroll") for (int rg = 0; rg < 16; ++rg) o[d][rg] *= al_l[crow(rg, hi)]; } \
    _Pragma("unroll") for (int d0 = 0; d0 < 2; ++d0) { \
      o[d0] = __builtin_amdgcn_mfma_f32_32x32x16_bf16(pa0, vf[3 * d0 + 0], o[d0], 0, 0, 0); o[d0] = __builtin_amdgcn_mfma_f32_32x32x16_bf16(pa1, vf[3 * d0 + 1], o[d0], 0, 0, 0); \
      o[d0] = __builtin_amdgcn_mfma_f32_32x32x16_bf16(pa2, vf[3 * d0 + 2], o[d0], 0, 0, 0); } } while (0)
#define NA_PK4(P, BASE, OUT) do { unsigned a0 = cvt_pk_bf16(P[BASE + 0], P[BASE + 1]), a1 = cvt_pk_bf16(P[BASE + 2], P[BASE + 3]);   \
    unsigned b0 = cvt_pk_bf16(P[BASE + 4], P[BASE + 5]), b1 = cvt_pk_bf16(P[BASE + 6], P[BASE + 7]);                              \
    auto r0 = __builtin_amdgcn_permlane32_swap(a0, b0, false, false); auto r1 = __builtin_amdgcn_permlane32_swap(a1, b1, false, false); \
    u32x4 w_ = {r0[0], r1[0], r0[1], r1[1]}; OUT = __builtin_bit_cast(bf16x8, w_); } while (0)
  { bf16x8 kA[8];
    NA_LOADK(kA, 0);
#pragma unroll 1
    for (int w = 0; w < 8; ++w) { NA_TILE(kA, w, 14); }
    NA_TILE(kA, 8, 6); }
#undef NA_PK4
#undef NA_KTOK
#undef NA_LOADK
#undef NA_TILE
  if (hi == 0) li_l[r32] = l_reg; asm volatile("s_waitcnt lgkmcnt(0)" ::: "memory");
  unsigned char* Ow = ONA + (size_t)(b * SEQ + r * 64 + half * 32) * 1024 + h * 64;
#pragma unroll
  for (int rg = 0; rg < 16; ++rg) { const int orow = crow(rg, hi); const float rl = __builtin_amdgcn_rcpf(li_l[orow]);
#pragma unroll
    for (int d0 = 0; d0 < 2; ++d0) Ow[(size_t)orow * 1024 + d0 * 32 + r32] = f32_to_fp8(o[d0][rg] * rl * 16.f); }
  asm volatile("s_waitcnt lgkmcnt(0)" ::: "memory");
}
}
namespace peer {
constexpr int CH = 32;
constexpr int OFF_TV = 0, OFF_TI = OFF_TV + CH * 16 * 16 * 4, OFF_SE = OFF_TI + CH * 16 * 16 * 4, OFF_SG = OFF_SE + CH * 128 * 4, OFF_SE2 = OFF_SG + CH * 128 * 4, OFF_SG2 = OFF_SE2 + CH * 128 * 4, PEER_LDS = OFF_SG2 + CH * 128 * 4;
static_assert(PEER_LDS <= RING_BYTES, "PEER LDS");
__device__ __forceinline__ float gelu_tanh(float x) {
    const float u = 0.7978845608028654f * (x + 0.044715f * x * x * x);
    const float e = __builtin_amdgcn_exp2f(-2.f * 1.4426950408889634f * fabsf(u));
    const float t = (1.f - e) * __builtin_amdgcn_rcpf(1.f + e);
    return 0.5f * x * (1.f + (u < 0.f ? -t : t));
}
__device__ __forceinline__ void fmac1(float& acc, float a, float b) { asm("v_fmac_f32_e32 %0, %1, %2" : "+v"(acc) : "v"(a), "v"(b)); }
#define PEER_INSERT(x_, xi_) do { float x__ = (x_); int xi__ = (xi_); \
    _Pragma("unroll") for (int j_ = 0; j_ < 16; ++j_) { const bool gt_ = x__ > tv[j_]; const float tvo_ = tv[j_]; const int tio_ = ti[j_]; \
        tv[j_] = gt_ ? x__ : tvo_; ti[j_] = gt_ ? xi__ : tio_; x__ = gt_ ? tvo_ : x__; xi__ = gt_ ? tio_ : xi__; } } while (0)

#define PEER_AUX 0
typedef __amdgpu_buffer_rsrc_t rsrc_t;
__device__ __forceinline__ rsrc_t mk_rsrc(const void* p, unsigned bytes) { return __builtin_amdgcn_make_buffer_rsrc((void*)p, 0, bytes, 0x00020000); }
__device__ __forceinline__ u32x4 ldb128(rsrc_t r, unsigned off) { return __builtin_amdgcn_raw_buffer_load_b128(r, off, 0, PEER_AUX); }
typedef unsigned v6u_t __attribute__((ext_vector_type(6)));
typedef float v32f_t __attribute__((ext_vector_type(32)));
typedef float v16f_t __attribute__((ext_vector_type(16)));
__device__ __forceinline__ u32x2 ldb64(rsrc_t r, unsigned off) { return __builtin_amdgcn_raw_buffer_load_b64(r, off, 0, PEER_AUX); }
__device__ __forceinline__ f32x4 ldf128(rsrc_t r, unsigned off) { return __builtin_bit_cast(f32x4, __builtin_amdgcn_raw_buffer_load_b128(r, off, 0, PEER_AUX)); }
__device__ __forceinline__ f32x4 ldf128_nt(rsrc_t r, unsigned off) { return __builtin_bit_cast(f32x4, __builtin_amdgcn_raw_buffer_load_b128(r, off, 0, 2)); }
__device__ __forceinline__ void peer_select(int chunk, const _Float16* __restrict__ SC, LAS char* lds, int tid, LAS int* SE, LAS float* SG) {
    LAS float* TV = (LAS float*)(lds + OFF_TV); LAS int* TI = (LAS int*)(lds + OFF_TI);
    asm volatile("" : "+v"(tid));
    const int tok0 = chunk * CH;
    const rsrc_t rSC = mk_rsrc(SC, 0x4000000u);
    __syncthreads();
    { const int tl = tid >> 4, g = tid & 15; const unsigned spo = ((unsigned)(tok0 + tl) * 2048u + (unsigned)g * 128u) * 2u;
      int tk[16];
#pragma unroll
      for (int j = 0; j < 16; ++j) tk[j] = (int)0x80000000;
#define PEER_KEY(x_, lowbits_, mask_) ({ const int f_ = __float_as_int(x_); ((f_ ^ ((f_ >> 31) & 0x7fffffff)) & ~(mask_)) | (lowbits_); })
#define PEER_INS(key_) do { int x__ = (key_); _Pragma("unroll") for (int j_ = 0; j_ < 16; ++j_) { const int hi_ = max(x__, tk[j_]); x__ = min(x__, tk[j_]); tk[j_] = hi_; } } while (0)
      typedef _Float16 h8_t __attribute__((ext_vector_type(8)));
#define PEER_CX(a_, b_) do { const int hi_ = max(a_, b_), lo_ = min(a_, b_); a_ = hi_; b_ = lo_; } while (0)
      u32x4 na = __builtin_amdgcn_raw_buffer_load_b128(rSC, spo, 0, 2), nb = __builtin_amdgcn_raw_buffer_load_b128(rSC, spo + 16, 0, 2);
#pragma unroll 1
      for (int i = 0; i < 16; i += 2) { const h8_t a = __builtin_bit_cast(h8_t, na), b = __builtin_bit_cast(h8_t, nb);
          { const unsigned on = spo + (unsigned)min(i + 2, 14) * 16u; na = __builtin_amdgcn_raw_buffer_load_b128(rSC, on, 0, 2); nb = __builtin_amdgcn_raw_buffer_load_b128(rSC, on + 16, 0, 2); }
          int kk[16];
#pragma unroll
          for (int e = 0; e < 8; ++e) { kk[e] = PEER_KEY((float)a[e], 127 - (8 * i + e), 127); kk[8 + e] = PEER_KEY((float)b[e], 127 - (8 * i + 8 + e), 127); }
          PEER_CX(kk[0], kk[13]); PEER_CX(kk[1], kk[12]); PEER_CX(kk[2], kk[15]); PEER_CX(kk[3], kk[14]); PEER_CX(kk[4], kk[8]); PEER_CX(kk[5], kk[6]); PEER_CX(kk[7], kk[11]); PEER_CX(kk[9], kk[10]); PEER_CX(kk[0], kk[5]); PEER_CX(kk[1], kk[7]); PEER_CX(kk[2], kk[9]); PEER_CX(kk[3], kk[4]); PEER_CX(kk[6], kk[13]); PEER_CX(kk[8], kk[14]); PEER_CX(kk[10], kk[15]); PEER_CX(kk[11], kk[12]); PEER_CX(kk[0], kk[1]); PEER_CX(kk[2], kk[3]); PEER_CX(kk[4], kk[5]); PEER_CX(kk[6], kk[8]); PEER_CX(kk[7], kk[9]); PEER_CX(kk[10], kk[11]); PEER_CX(kk[12], kk[13]); PEER_CX(kk[14], kk[15]); PEER_CX(kk[0], kk[2]); PEER_CX(kk[1], kk[3]); PEER_CX(kk[4], kk[10]); PEER_CX(kk[5], kk[11]); PEER_CX(kk[6], kk[7]); PEER_CX(kk[8], kk[9]); PEER_CX(kk[12], kk[14]); PEER_CX(kk[13], kk[15]); PEER_CX(kk[1], kk[2]); PEER_CX(kk[3], kk[12]); PEER_CX(kk[4], kk[6]); PEER_CX(kk[5], kk[7]); PEER_CX(kk[8], kk[10]); PEER_CX(kk[9], kk[11]); PEER_CX(kk[13], kk[14]); PEER_CX(kk[1], kk[4]); PEER_CX(kk[2], kk[6]); PEER_CX(kk[5], kk[8]); PEER_CX(kk[7], kk[10]); PEER_CX(kk[9], kk[13]); PEER_CX(kk[11], kk[14]); PEER_CX(kk[2], kk[4]); PEER_CX(kk[3], kk[6]); PEER_CX(kk[9], kk[12]); PEER_CX(kk[11], kk[13]); PEER_CX(kk[3], kk[5]); PEER_CX(kk[6], kk[8]); PEER_CX(kk[7], kk[9]); PEER_CX(kk[10], kk[12]); PEER_CX(kk[3], kk[4]); PEER_CX(kk[5], kk[6]); PEER_CX(kk[7], kk[8]); PEER_CX(kk[9], kk[10]); PEER_CX(kk[11], kk[12]); PEER_CX(kk[6], kk[7]); PEER_CX(kk[8], kk[9]);
#pragma unroll
          for (int e = 0; e < 16; ++e) tk[e] = max(tk[e], kk[15 - e]);
          PEER_CX(tk[0], tk[8]); PEER_CX(tk[1], tk[9]); PEER_CX(tk[2], tk[10]); PEER_CX(tk[3], tk[11]); PEER_CX(tk[4], tk[12]); PEER_CX(tk[5], tk[13]); PEER_CX(tk[6], tk[14]); PEER_CX(tk[7], tk[15]); PEER_CX(tk[0], tk[4]); PEER_CX(tk[1], tk[5]); PEER_CX(tk[2], tk[6]); PEER_CX(tk[3], tk[7]); PEER_CX(tk[8], tk[12]); PEER_CX(tk[9], tk[13]); PEER_CX(tk[10], tk[14]); PEER_CX(tk[11], tk[15]); PEER_CX(tk[0], tk[2]); PEER_CX(tk[1], tk[3]); PEER_CX(tk[4], tk[6]); PEER_CX(tk[5], tk[7]); PEER_CX(tk[8], tk[10]); PEER_CX(tk[9], tk[11]); PEER_CX(tk[12], tk[14]); PEER_CX(tk[13], tk[15]); PEER_CX(tk[0], tk[1]); PEER_CX(tk[2], tk[3]); PEER_CX(tk[4], tk[5]); PEER_CX(tk[6], tk[7]); PEER_CX(tk[8], tk[9]); PEER_CX(tk[10], tk[11]); PEER_CX(tk[12], tk[13]); PEER_CX(tk[14], tk[15]); }
#undef PEER_CX
      LAS float* tvp = TV + (tl * 16 + g) * 16; LAS int* tip = TI + (tl * 16 + g) * 16;
#pragma unroll
      for (int j = 0; j < 16; ++j) { const int k_ = tk[j] & ~127; tvp[j] = __int_as_float(k_ ^ ((k_ >> 31) & 0x7fffffff)); tip[j] = 127 - (tk[j] & 127); } }
    __syncthreads();
    asm volatile("" : "+v"(tid));
    { const int tl = tid >> 4, hh = (tid >> 1) & 7, half = tid & 1;
      const LAS float* s1 = TV + (tl * 16 + 2 * hh) * 16; const LAS float* s2 = s1 + 16; const LAS int* i1 = TI + (tl * 16 + 2 * hh) * 16; const LAS int* i2 = i1 + 16;
      float b2[16];
#pragma unroll
      for (int j = 0; j < 16; ++j) b2[j] = s2[j];
      int tk[16];
#pragma unroll
      for (int j = 0; j < 16; ++j) tk[j] = (int)0x80000000;
#pragma unroll
      for (int ii = 0; ii < 8; ++ii) { const int i = 2 * ii + half; const float a = s1[i];
#pragma unroll
          for (int j = 0; j < 16; ++j) if ((2 * ii + 1) * (j + 1) <= 16) { if (half == 0 || (2 * ii + 2) * (j + 1) <= 16) PEER_INS(PEER_KEY(a + b2[j], 255 - (i * 16 + j), 255)); } }
      { int pk[16];
#pragma unroll
        for (int j = 0; j < 16; ++j) pk[j] = __shfl_xor(tk[j], 1);
#pragma unroll
        for (int j = 0; j < 16; ++j) PEER_INS(pk[j]); }
      if (half == 0) { float e[16], sum = 0.f; const int k0_ = tk[0] & ~255; const float v0 = __int_as_float(k0_ ^ ((k0_ >> 31) & 0x7fffffff));
#pragma unroll
        for (int j = 0; j < 16; ++j) { const int k_ = tk[j] & ~255; const float vj = __int_as_float(k_ ^ ((k_ >> 31) & 0x7fffffff)); e[j] = __builtin_amdgcn_exp2f((vj - v0) * 1.4426950408889634f); sum += e[j]; }
        const float inv = 1.0f / sum;
#pragma unroll
        for (int j = 0; j < 16; ++j) { const int ci = 255 - (tk[j] & 255); SE[tl * 128 + hh * 16 + j] = i1[ci >> 4] * 128 + i2[ci & 15]; SG[tl * 128 + hh * 16 + j] = e[j] * inv; } } }
#undef PEER_KEY
#undef PEER_INS
    __syncthreads();
}
__device__ __forceinline__ void peer_gather(int chunk, const bf16_t* __restrict__ H2, const unsigned char* __restrict__ U, const unsigned char* __restrict__ V,
                                            const float* __restrict__ g2, const float* __restrict__ gf, float* OUT, int tid, const LAS int* SE, const LAS float* SG) {
    asm volatile("" : "+v"(tid));
    const int tok0 = chunk * CH, lane = tid & 63, wave = tid >> 6;
    const rsrc_t rH2 = mk_rsrc(H2, 0x4000000u), rU = mk_rsrc(U, 0x1800000u), rV = mk_rsrc(V, 0x1800000u), rG2 = mk_rsrc(g2, 8192u), rGF = mk_rsrc(gf, 8192u);
#pragma unroll 1
    for (int tt = 0; tt < CH / NWAVES; ++tt) { const int tl = wave * (CH / NWAVES) + tt, tok = tok0 + tl;
      asm volatile("" ::: "memory");
      float hn[32], acc[32]; float ss = 0.f;
#pragma unroll
      for (int j = 0; j < 2; ++j)
#pragma unroll
          for (int q = 0; q < 4; ++q) { const u32x2 w = ldb64(rH2, ((unsigned)tok * 2048u + 256u * (4 * j + q) + 4u * lane) * 2u);
              const f32x4 a = (f32x4){__uint_as_float(w.x << 16), __uint_as_float(w.x & 0xffff0000u), __uint_as_float(w.y << 16), __uint_as_float(w.y & 0xffff0000u)};
#pragma unroll
              for (int i = 0; i < 4; ++i) { hn[16 * j + 4 * q + i] = a[i]; ss += a[i] * a[i]; } }
      const float rstd = 1.0f / sqrtf(wave_sum(ss) * (1.f / 2048.f) + NORM_EPS);
#pragma unroll
      for (int j = 0; j < 2; ++j)
#pragma unroll
          for (int q = 0; q < 4; ++q) { const f32x4 a = ldf128(rG2, (256u * (4 * j + q) + 4u * lane) * 4u);
#pragma unroll
              for (int i = 0; i < 4; ++i) hn[16 * j + 4 * q + i] *= rstd * a[i]; }
#pragma unroll
      for (int i = 0; i < 32; ++i) acc[i] = 0.f;
#define NX 4
#define PEER_LOAD(S, kb) do { _Pragma("unroll") for (int x = 0; x < NX; ++x) { const unsigned o = (unsigned)SE[tl * 128 + (kb) + x] * 1536u; \
          S##ua[x] = ldb128(rU, o + (unsigned)lane * 16u); S##ub[x] = ldb64(rU, o + 1024u + (unsigned)lane * 8u); S##va[x] = ldb128(rV, o + (unsigned)lane * 16u); S##vb[x] = ldb64(rV, o + 1024u + (unsigned)lane * 8u); } } while (0)
#define PEER_DEC(A, B) ({ v32f_t r_ = __builtin_amdgcn_cvt_scalef32_pk32_f32_fp6((v6u_t){A.x, A.y, A.z, A.w, B.x, B.y}, 1.0f); asm volatile("s_nop 1" : "+v"(r_)); r_; })
#define PEER_COMPUTE(S, kb) do { float d[NX]; \
          _Pragma("unroll") for (int x = 0; x < NX; ++x) { const v32f_t r = PEER_DEC(S##ua[x], S##ub[x]); float dd = 0.f; \
              _Pragma("unroll") for (int i = 0; i < 32; ++i) fmac1(dd, hn[i], r[i]); \
              d[x] = dd; } \
          _Pragma("unroll") for (int o = 1; o < 64; o <<= 1) { _Pragma("unroll") for (int x = 0; x < NX; ++x) d[x] += __shfl_xor(d[x], o); } \
          float c[NX]; \
          _Pragma("unroll") for (int x = 0; x < NX; ++x) c[x] = SG[tl * 128 + (kb) + x] * gelu_tanh(d[x] * (1.f / 64.f)) * 0.25f; \
          _Pragma("unroll") for (int x = 0; x < NX; ++x) { const v32f_t r = PEER_DEC(S##va[x], S##vb[x]); \
              _Pragma("unroll") for (int i = 0; i < 32; ++i) fmac1(acc[i], c[x], r[i]); } } while (0)
      { u32x4 Aua[NX], Ava[NX], Bua[NX], Bva[NX]; u32x2 Aub[NX], Avb[NX], Bub[NX], Bvb[NX];
        PEER_LOAD(A, 0);
#pragma unroll 1
        for (int k = 0; k < 128; k += 2 * NX) {
            PEER_LOAD(B, k + NX); PEER_COMPUTE(A, k);
            { const int kn = min(k + 2 * NX, 128 - NX); PEER_LOAD(A, kn); }
            PEER_COMPUTE(B, k + NX);
        } }
#undef PEER_DEC
#undef NX
#undef PEER_LOAD
#undef PEER_COMPUTE
      asm volatile("" ::: "memory");
      int tok2 = tok, lane2 = lane; asm volatile("" : "+v"(tok2), "+v"(lane2));
      float s2 = 0.f;
#pragma unroll
      for (int j = 0; j < 2; ++j)
#pragma unroll
          for (int q = 0; q < 4; ++q) { const u32x2 w = ldb64(rH2, ((unsigned)tok2 * 2048u + 256u * (4 * j + q) + 4u * lane2) * 2u);
              const f32x4 a = (f32x4){__uint_as_float(w.x << 16), __uint_as_float(w.x & 0xffff0000u), __uint_as_float(w.y << 16), __uint_as_float(w.y & 0xffff0000u)};
#pragma unroll
              for (int i = 0; i < 4; ++i) { acc[16 * j + 4 * q + i] += a[i]; s2 += acc[16 * j + 4 * q + i] * acc[16 * j + 4 * q + i]; } }
      const float rf = 1.0f / sqrtf(wave_sum(s2) * (1.f / 2048.f) + NORM_EPS);
#pragma unroll
      for (int j = 0; j < 2; ++j)
#pragma unroll
          for (int q = 0; q < 4; ++q) { const f32x4 a = ldf128(rGF, (256u * (4 * j + q) + 4u * lane2) * 4u); f32x4 oa;
#pragma unroll
              for (int i = 0; i < 4; ++i) oa[i] = acc[16 * j + 4 * q + i] * rf * a[i];
              float* op = OUT + (size_t)tok2 * 2048 + 256 * (4 * j + q) + 4 * lane2;
              __builtin_nontemporal_store(oa, (GAS f32x4*)op); }
    }
}
}
#ifndef MK_N_LAUNCHES
#define MK_N_LAUNCHES 1
#endif
#define MK_PROBE_PH -1
#define MK_PROBE_DIV 2
constexpr int N_PHASES = 9;
constexpr int N_LAUNCHES = MK_N_LAUNCHES;
struct Args { const float* in[19]; float* out; unsigned char* ws; int ph_lo, ph_hi; };
static_assert(sizeof(Args) == 19 * 8 + 8 + 8 + 8, "no padding");

__global__ void __launch_bounds__(NWAVES * 64, 2) hybrid_fwd(Args args) {
    extern __shared__ __attribute__((aligned(16))) unsigned char lds_raw[];
    Frame F;
    F.lds = (LAS unsigned char*)lds_raw;
    F.MISC = (volatile LAS unsigned*)(F.lds + MISC_OFF);
    F.tid = threadIdx.x; F.lane = F.tid & 63; F.wave = __builtin_amdgcn_readfirstlane(F.tid >> 6);
    F.G = gridDim.x; { const int bx = blockIdx.x; F.vcu = (F.G % 8 == 0) ? (bx % 8) * (F.G / 8) + bx / 8 : bx; }
    F.ws = args.ws; F.out = args.out;
#pragma unroll
    for (int i = 0; i < 19; ++i) F.in[i] = args.in[i];
    for (int u = F.tid; u < (LDS_BYTES - LDSCTL_OFF) / 4; u += NWAVES * 64) ((LAS unsigned*)(F.lds + LDSCTL_OFF))[u] = 0u;
    __syncthreads();
    XcdBarrier bar; bar.bar = (unsigned*)(F.ws + WS_CTL) + CW_BAR; bar.x = 0; bar.st = nullptr;
    if (N_LAUNCHES == 1) bar = xcd_barrier_post((unsigned*)(F.ws + WS_CTL) + CW_BAR, F.MISC + 8);
    const int lo = args.ph_lo, hi = args.ph_hi;
#define IN(k) (lo <= (k) && (k) < hi)
#if MK_PROBE_PH >= 0
    unsigned long long tp0 = (MK_PROBE_PH == 0 || MK_PROBE_PH == 9) ? __builtin_amdgcn_s_memrealtime() : 0ull, tp1 = 0ull;
#define SEAM(k) do { if (IN(k) && IN((k) + 1)) xcd_barrier(bar); if (MK_PROBE_PH == (k)) tp1 = __builtin_amdgcn_s_memrealtime(); if (MK_PROBE_PH == (k) + 1) tp0 = __builtin_amdgcn_s_memrealtime(); } while (0)
#else
#define SEAM(k) do { if (IN(k) && IN((k) + 1)) xcd_barrier(bar); } while (0)
#endif
    const size_t T2048 = (size_t)256 * 2048 * 2, T1024 = (size_t)256 * 1024 * 2, T512 = (size_t)256 * 512 * 2;
    float* cosT = WSP(float, WS_COS); float* sinT = WSP(float, WS_SIN);
    float* ssq_q = WSP(float, WS_SSQ_Q); float* ssq_kv = WSP(float, WS_SSQ_KV); float* ssq2 = WSP(float, WS_SSQ_2);

    if (IN(0)) { p0_prologue<0>(F, F.vcu, F.G); } SEAM(0);
    if (IN(1)) {
        SchedP1 S{F.G, (int)blockIdx.x, (const char*)(F.ws + WS_HN1), (const char*)(F.ws + WS_WIN), (const char*)(F.ws + WS_WVT), T1024};
        EpiP1 E{WSP(bf16_t, WS_NAQ), WSP(bf16_t, WS_NAK), WSP(bf16_t, WS_VT), WSP(unsigned char, WS_CQ), WSP(unsigned char, WS_CKV), WSP(unsigned char, WS_KR), WSP(unsigned char, WS_GA), WSP(unsigned char, WS_GB), ssq_q, ssq_kv, cosT, sinT};
        pg8::gemm_phase<EpiP1, SchedP1, true, -6>(F.lds, 2048, S, E);
        { const int extra = P1_UNITS % F.G, bx = (int)blockIdx.x; if (extra != 0 && bx >= extra) p0_prologue<1>(F, bx - extra, F.G - extra); else if (extra == 0) p0_prologue<1>(F, bx, F.G); }
    } SEAM(1);
    if (IN(2)) {
        LAS float* relb = (LAS float*)F.lds + 64; LAS float* metab = relb + 16 * 15 * 31 + 128; LAS float* wsf = metab + 256 + F.wave * 64;
        for (int i = F.tid; i < 16 * 15 * 31; i += NWAVES * 64) relb[i] = F.in[4][i];
        if (F.tid < 256) metab[F.tid] = F.in[5][F.tid];
        __syncthreads();
        const int gw = F.vcu * NWAVES + F.wave, NGW = F.G * NWAVES;
        Conv cv{F.in[16], F.in[17], WSP(unsigned char, WS_U), WSP(unsigned char, WS_V), F.lds + 65536 + F.wave * 8192, gw, NGW, 2 * 16384, -1, 0};
        for (int task = gw; task < NBATCH * 16 * 32 * 2; task += NGW)
            att::na_task(task, WSP(bf16_t, WS_NAQ), WSP(bf16_t, WS_NAK), WSP(bf16_t, WS_VT), WSP(unsigned char, WS_ONA), relb, metab, wsf, F.lane, cv);
        while (cv.pend >= 0 || cv.next < cv.end) conv_step<0>(cv, F.lane);
        __syncthreads();
    } SEAM(2);
    if (IN(3)) {
        SchedP3 S{F.G, (int)blockIdx.x, (const char*)F.ws, T512 / 2};
        EpiP3 E{WSP(unsigned char, WS_QM), WSP(unsigned char, WS_KN), WSP(unsigned char, WS_VV), ssq_q, ssq_kv, cosT, sinT};
        pg8::gemm_phase<EpiP3, SchedP3, true, -4>(F.lds, 512, S, E);
    } SEAM(3);
    if (IN(4)) {
        for (int id = F.vcu; id < NBATCH * 16 * 8; id += F.G) { const int bh = id >> 3, qb = id & 7;
            att::mla_unit8(bh >> 4, bh & 15, qb, WSP(unsigned char, WS_QM), WSP(unsigned char, WS_KN), WSP(unsigned char, WS_KR), WSP(unsigned char, WS_VV), WSP(unsigned char, WS_OMLA), (LAS char*)F.lds); }
        __syncthreads();
    } SEAM(4);
    if (IN(5)) {
        { SchedGrid S{F.G, (int)blockIdx.x, 64, 8, (const char*)(F.ws + WS_ONA), (const char*)(F.ws + WS_WNA), T512};
          EpiP5a E{WSP(unsigned char, WS_GA), WSP(unsigned char, WS_T1)};
          pg8::gemm_phase<EpiP5a, SchedGrid, true, -9>(F.lds, 1024, S, E); }
        { SchedGrid S{F.G, (int)blockIdx.x, 64, 8, (const char*)(F.ws + WS_OMLA), (const char*)(F.ws + WS_WMLA), T1024};
          EpiP5b E{WSP(unsigned char, WS_GB), WSP(unsigned char, WS_T1), WSP(unsigned char, WS_MERGED)};
          pg8::gemm_phase<EpiP5b, SchedGrid, true, -11>(F.lds, 2048, S, E); }
    } SEAM(5);
    if (IN(6)) {
        { SchedGrid S{F.G, (int)blockIdx.x, 64, 8, (const char*)(F.ws + WS_MERGED), (const char*)(F.ws + WS_WOUT), T1024};
          EpiP6 E{F.in[0], WSP(bf16_t, WS_H2B), ssq2};
          pg8::gemm_phase<EpiP6, SchedGrid, true, -11>(F.lds, 2048, S, E); }
    } SEAM(6);
    if (IN(7)) {
        SchedGrid S{F.G, (int)blockIdx.x, 64, 8, (const char*)(F.ws + WS_H2B), (const char*)(F.ws + WS_WSC), T2048};
        EpiP7 E{ssq2, WSP(_Float16, WS_SC)};
        pg8::gemm_phase<EpiP7, SchedGrid>(F.lds, 2048, S, E);
    } SEAM(7);
    if (IN(8)) {
        const int nch = (MREAL / peer::CH - F.vcu + F.G - 1) / F.G; const bool both_first = (nch == 2) && (F.vcu & 1);
        for (int op = 0; op < 2 * nch; ++op) {
            const bool sel = both_first ? (op < 2) : !(op & 1); const int ci = both_first ? (op & 1) : (op >> 1), chunk = F.vcu + ci * F.G;
            const int b2 = both_first ? ci : 0;
            LAS int* SE = (LAS int*)(F.lds + (b2 ? peer::OFF_SE2 : peer::OFF_SE)); LAS float* SG = (LAS float*)(F.lds + (b2 ? peer::OFF_SG2 : peer::OFF_SG));
            if (sel) peer::peer_select(chunk, WSP(_Float16, WS_SC), (LAS char*)F.lds, F.tid, SE, SG);
            else peer::peer_gather(chunk, WSP(bf16_t, WS_H2B), WSP(unsigned char, WS_U), WSP(unsigned char, WS_V), F.in[13], F.in[18], F.out, F.tid, SE, SG); }
    }
#if MK_PROBE_PH >= 0
    xcd_barrier(bar); tp1 = (MK_PROBE_PH >= 8) ? __builtin_amdgcn_s_memrealtime() : tp1;
    if (blockIdx.x == 0 && F.tid == 0) F.out[0] = (float)(tp1 - tp0) * (0.01f / MK_PROBE_DIV);
#endif
#undef IN
#undef SEAM
}

extern "C" void kernel_launch(void* const* d_in, const int* in_sizes, int n_in, void* d_out, int out_size, void* d_ws, size_t ws_size, hipStream_t stream) {
    static int grid = 0;
    if (grid == 0) {
        if (n_in != 19 || in_sizes[0] != MREAL * DM || out_size != MREAL * DM || ws_size < WS_END) {
            fprintf(stderr, "kernel_launch: shape/workspace mismatch: n_in %d in0 %d out %d ws %zu (need %zu); nothing launched\n", n_in, n_in > 0 ? in_sizes[0] : -1, out_size, ws_size, (size_t)WS_END); grid = -1; return; }
        int dev = 0, cus = 0, per_cu = 0;
        if (hipGetDevice(&dev) != hipSuccess || hipDeviceGetAttribute(&cus, hipDeviceAttributeMultiprocessorCount, dev) != hipSuccess) { fprintf(stderr, "kernel_launch: device query failed\n"); grid = -1; return; }
        if (hipFuncSetAttribute((const void*)hybrid_fwd, hipFuncAttributeMaxDynamicSharedMemorySize, LDS_BYTES) != hipSuccess) { fprintf(stderr, "kernel_launch: hipFuncSetAttribute failed\n"); grid = -1; return; }
        if (hipOccupancyMaxActiveBlocksPerMultiprocessor(&per_cu, (const void*)hybrid_fwd, NWAVES * 64, LDS_BYTES) != hipSuccess || per_cu < 1)
            fprintf(stderr, "kernel_launch: note: occupancy query reports %d workgroups per CU\n", per_cu);
        (void)hipGetLastError();
        grid = cus;
    }
    if (grid < 0) return;
    if (hipMemsetAsync((char*)d_ws + WS_CTL, 0, CTL_ZERO_BYTES, stream) != hipSuccess) { fprintf(stderr, "kernel_launch: hipMemsetAsync failed\n"); return; }
    Args a{};
    for (int i = 0; i < 19; ++i) a.in[i] = (const float*)d_in[i];
    a.out = (float*)d_out; a.ws = (unsigned char*)d_ws;
    for (int li = 0; li < N_LAUNCHES; ++li) {
        a.ph_lo = (N_LAUNCHES == 1) ? 0 : li; a.ph_hi = (N_LAUNCHES == 1) ? N_PHASES : li + 1;
        hipLaunchKernelGGL(hybrid_fwd, dim3(grid), dim3(NWAVES * 64), LDS_BYTES, stream, a);
        const hipError_t le = hipPeekAtLastError();
        if (le != hipSuccess) { fprintf(stderr, "kernel_launch: launch %d failed: %s\n", li, hipGetErrorName(le)); break; }
    }
}
```

```cpp
#include <hip/hip_runtime.h>
#include <cstdio>
#include <cstdint>

#define LAS __attribute__((address_space(3)))
#define GAS __attribute__((address_space(1)))
typedef unsigned short bf16_t;
typedef short bf16x8 __attribute__((ext_vector_type(8)));
typedef short s16x4 __attribute__((ext_vector_type(4)));
typedef float f32x4 __attribute__((ext_vector_type(4)));
typedef float f32x2 __attribute__((ext_vector_type(2)));
typedef float f32x16 __attribute__((ext_vector_type(16)));
typedef unsigned u32x4 __attribute__((ext_vector_type(4)));
typedef unsigned u32x2 __attribute__((ext_vector_type(2)));

constexpr int DM = 2048, NBATCH = 8, SEQ = 2048, NMETA = 16;
constexpr int MREAL = NBATCH * SEQ;
constexpr int MPAD = MREAL + 256;
constexpr int NPOS = SEQ + NMETA;
constexpr float NORM_EPS = 1e-6f;
constexpr int C_NAQ = 0, C_NAK = 1024, C_CQ = 2048, C_CKV = 2560, C_GA = 3072, C_GB = 5120, C_KR = 7168, NMAIN = 7424;
constexpr int VT_PITCH = MPAD;

constexpr size_t MiB = 1u << 20;
constexpr size_t WS_CTL = 0, CTL_ZERO_BYTES = 1 * MiB;
constexpr size_t WS_SSQ_Q = 481 * MiB, WS_SSQ_KV = 482 * MiB, WS_SSQ_2 = 486 * MiB;
constexpr size_t WS_COS = 1 * MiB, WS_SIN = 1 * MiB + 512 * 1024;
constexpr size_t WS_WUQ = 2 * MiB, WS_WUKV = 5 * MiB, WS_WNA = 9 * MiB, WS_WMLA = 13 * MiB, WS_WOUT = 21 * MiB, WS_WSC = 29 * MiB;
constexpr size_t WS_GA = 37 * MiB, WS_GB = 101 * MiB;
constexpr size_t WS_KR = 165 * MiB;
constexpr size_t WS_WIN = 167 * MiB + 256 * 1024, WS_WVT = WS_WIN + 29 * MiB;
constexpr size_t WS_ONA = 190 * MiB;
constexpr size_t WS_NAQ = 222 * MiB, WS_NAK = 254 * MiB, WS_VT = WS_NAK + 32 * MiB + 512 * 1024;
constexpr size_t WS_HN1 = 319 * MiB;
constexpr size_t WS_CQ = 448 * MiB, WS_CKV = 464 * MiB;
constexpr size_t WS_QM = 222 * MiB, WS_KN = 318 * MiB, WS_VV = 383 * MiB;
constexpr size_t WS_OMLA = 448 * MiB;
constexpr size_t WS_MERGED = 222 * MiB, WS_T1 = 286 * MiB;
constexpr size_t WS_H2 = 37 * MiB, WS_H2B = 293 * MiB;
constexpr size_t WS_U = 69 * MiB, WS_V = 133 * MiB;
constexpr size_t WS_SC = 165 * MiB;
constexpr size_t WS_END = 512 * MiB;
static_assert(WS_CKV + (size_t)MPAD * 512 * 2 <= WS_SSQ_Q && WS_SSQ_Q + (size_t)8 * MPAD * 4 <= WS_SSQ_KV && WS_SSQ_KV + (size_t)8 * MPAD * 4 <= 483 * MiB && WS_SSQ_2 + (size_t)32 * MREAL * 4 <= WS_END, "ssq slabs");
static_assert(WS_VT + (size_t)1024 * MPAD * 2 <= WS_HN1 && WS_HN1 + (size_t)MPAD * 2048 * 2 <= WS_CQ && WS_CKV + (size_t)MPAD * 512 * 2 <= WS_END, "map P1");
static_assert(WS_WVT + 4 * MiB <= WS_NAQ && WS_KR + (size_t)MPAD * 64 * 2 <= WS_WIN && WS_ONA + 32 * MiB <= WS_NAQ, "map P1b");
static_assert(WS_QM + 96 * MiB <= WS_KN && WS_KN + 65 * MiB <= WS_VV && WS_VV + 65 * MiB <= WS_OMLA && WS_OMLA + 64 * MiB <= WS_END, "map P3");
static_assert(WS_T1 + 128 * MiB <= WS_OMLA && WS_H2 + 128 * MiB <= WS_KR && WS_SC + 128 * MiB <= WS_H2B && WS_H2B + 64 * MiB <= WS_END, "map P5+");
static_assert(WS_GA + 32 * MiB <= WS_U && WS_U + 24 * MiB <= WS_GB && WS_GB + 32 * MiB <= WS_V && WS_V + 24 * MiB <= WS_KR, "expert tables between the gate codes");

constexpr int CW_BAR = 4096;

constexpr int RING_BYTES = 131072;
constexpr int LDSCTL_OFF = RING_BYTES, MISC_OFF = LDSCTL_OFF + 320;
constexpr int LDS_BYTES = 147456;
constexpr int NWAVES = 8;

#define LDS_WAIT() asm volatile("s_waitcnt lgkmcnt(0)" ::: "memory")
#define VM_WAIT() asm volatile("s_waitcnt vmcnt(0)" ::: "memory")
#define SBAR() __builtin_amdgcn_sched_barrier(0)
typedef __bf16 bf16x2_t __attribute__((ext_vector_type(2)));
__device__ __forceinline__ unsigned cvt_pk_bf16(float lo, float hi) { const f32x2 v = {lo, hi}; const bf16x2_t b = __builtin_convertvector(v, bf16x2_t); return __builtin_bit_cast(unsigned, b); }
__device__ __forceinline__ float bf_lo(unsigned w) { return __uint_as_float(w << 16); }
__device__ __forceinline__ float bf_hi(unsigned w) { return __uint_as_float(w & 0xffff0000u); }
__device__ __forceinline__ u32x4 pack8(const f32x4 a, const f32x4 b) { u32x4 w; w.x = cvt_pk_bf16(a[0], a[1]); w.y = cvt_pk_bf16(a[2], a[3]); w.z = cvt_pk_bf16(b[0], b[1]); w.w = cvt_pk_bf16(b[2], b[3]); return w; }
__device__ __forceinline__ u32x2 pack8_fp8(f32x4 a, f32x4 b) {
#pragma unroll
    for (int i = 0; i < 4; ++i) { a[i] = __builtin_fminf(__builtin_fmaxf(a[i], -448.f), 448.f); b[i] = __builtin_fminf(__builtin_fmaxf(b[i], -448.f), 448.f); }
    int w0 = 0, w1 = 0; w0 = __builtin_amdgcn_cvt_pk_fp8_f32(a[0], a[1], w0, false); w0 = __builtin_amdgcn_cvt_pk_fp8_f32(a[2], a[3], w0, true);
    w1 = __builtin_amdgcn_cvt_pk_fp8_f32(b[0], b[1], w1, false); w1 = __builtin_amdgcn_cvt_pk_fp8_f32(b[2], b[3], w1, true); return (u32x2){(unsigned)w0, (unsigned)w1}; }
__device__ __forceinline__ unsigned char f32_to_fp8(float x) { x = __builtin_fminf(__builtin_fmaxf(x, -448.f), 448.f); return (unsigned char)(__builtin_amdgcn_cvt_pk_fp8_f32(x, 0.f, 0, false) & 0xff); }
__device__ __forceinline__ u32x2 pack8_u8(const f32x4 a, const f32x4 b) { u32x2 w; unsigned x = 0u, y = 0u;
    x = __builtin_amdgcn_cvt_pk_u8_f32(a[0] * 255.f, 0u, x); x = __builtin_amdgcn_cvt_pk_u8_f32(a[1] * 255.f, 1u, x); x = __builtin_amdgcn_cvt_pk_u8_f32(a[2] * 255.f, 2u, x); x = __builtin_amdgcn_cvt_pk_u8_f32(a[3] * 255.f, 3u, x);
    y = __builtin_amdgcn_cvt_pk_u8_f32(b[0] * 255.f, 0u, y); y = __builtin_amdgcn_cvt_pk_u8_f32(b[1] * 255.f, 1u, y); y = __builtin_amdgcn_cvt_pk_u8_f32(b[2] * 255.f, 2u, y); y = __builtin_amdgcn_cvt_pk_u8_f32(b[3] * 255.f, 3u, y);
    w.x = x; w.y = y; return w; }
__device__ __forceinline__ unsigned pack4_fp8(f32x4 a) {
#pragma unroll
    for (int i = 0; i < 4; ++i) a[i] = __builtin_fminf(__builtin_fmaxf(a[i], -448.f), 448.f);
    int w0 = 0; w0 = __builtin_amdgcn_cvt_pk_fp8_f32(a[0], a[1], w0, false); w0 = __builtin_amdgcn_cvt_pk_fp8_f32(a[2], a[3], w0, true); return (unsigned)w0; }
__device__ __forceinline__ void unpack8_fp8(const u32x2 w, f32x4& a, f32x4& b) {
    const f32x2 a0 = __builtin_amdgcn_cvt_pk_f32_fp8((int)w.x, false), a1 = __builtin_amdgcn_cvt_pk_f32_fp8((int)w.x, true), b0 = __builtin_amdgcn_cvt_pk_f32_fp8((int)w.y, false), b1 = __builtin_amdgcn_cvt_pk_f32_fp8((int)w.y, true);
    a = (f32x4){a0[0], a0[1], a1[0], a1[1]}; b = (f32x4){b0[0], b0[1], b1[0], b1[1]}; }
__device__ __forceinline__ void unpack8_u8(const u32x2 w, f32x4& a, f32x4& b) { const float k = 1.f / 255.f;
    a = (f32x4){(float)(w.x & 0xffu), (float)((w.x >> 8) & 0xffu), (float)((w.x >> 16) & 0xffu), (float)(w.x >> 24)} * k;
    b = (f32x4){(float)(w.y & 0xffu), (float)((w.y >> 8) & 0xffu), (float)((w.y >> 16) & 0xffu), (float)(w.y >> 24)} * k; }
__device__ __forceinline__ u32x2 pack4(const f32x4 a) { u32x2 w; w.x = cvt_pk_bf16(a[0], a[1]); w.y = cvt_pk_bf16(a[2], a[3]); return w; }
__device__ __forceinline__ float wave_sum(float v) {
#pragma unroll
    for (int o = 1; o < 64; o <<= 1) v += __shfl_xor(v, o);
    return v;
}
__device__ __forceinline__ float sigmoidf_(float x) { return __builtin_amdgcn_rcpf(1.0f + __builtin_amdgcn_exp2f(-1.4426950408889634f * x)); }
__device__ __forceinline__ int crow(int r, int hi) { return (r & 3) + 8 * (r >> 2) + 4 * hi; }
#define PG8_AUX 0
namespace pg8 {
constexpr int BM = 256, BK = 64, HALF = 128, HTB = HALF * BK * 2  , STAGE_BYTES = 8 * HTB, NXCD = 8, WGM = 8;
__host__ __device__ __forceinline__ int lds_byte(int r, int c) { const int st = (r >> 4) * 2 + (c >> 5), rr = r & 15, cc = c & 31, ob = rr * 64 + cc * 2; return st * 1024 + (ob ^ (((ob >> 9) & 1) << 5)); }
__host__ __device__ __forceinline__ void stage_rc(int b, int& R, int& C) { const int st = b / 1024, sb = b % 1024, swz = sb ^ (((sb >> 9) & 1) << 5); R = (st >> 1) * 16 + swz / 64; C = (st & 1) * 32 + (swz % 64) / 2; }
__host__ __device__ __forceinline__ int perm32(int rho) { const int n = rho >> 4, i = rho & 15; return 8 * (i >> 2) + 4 * n + (i & 3); }

struct Unit { int pm, pn, kind; };

__device__ __forceinline__ void grid_order(int L, int nM, int nN, int& pm, int& pn) {
    const int nwg = nM * nN; int wgid = L;
    { const int q = nwg / NXCD, r = nwg % NXCD, xcd = wgid % NXCD, off = wgid / NXCD; wgid = (xcd < r ? xcd * (q + 1) : r * (q + 1) + (xcd - r) * q) + off; }
    const int nig = WGM * nN, gid = wgid / nig, fm = gid * WGM, gsz = (nM - fm) < WGM ? (nM - fm) : WGM;
    pm = fm + ((wgid % nig) % gsz); pn = (wgid % nig) / gsz;
}

typedef int v8i_t __attribute__((ext_vector_type(8)));
template <class Epi, class Sched, bool F8 = false, int F8_SCALE_EXP = 0>
__device__ __forceinline__ void gemm_phase(LAS unsigned char* lds, const int K, const Sched& S, const Epi& E) {
    const int tid = threadIdx.x, wid = __builtin_amdgcn_readfirstlane(tid >> 6), lane = tid & 63, wr = wid >> 2, wc = wid & 3, fr = lane & 15, fq = lane >> 4;
    int f8sa = 0x01010101 * (127 + F8_SCALE_EXP), f8sb = 0x7f7f7f7f; asm volatile("" : "+v"(f8sa), "+v"(f8sb));
    const int Kb = F8 ? K : 2 * K;
    const int nt = Kb / 128;
    unsigned voffA[2], voffB[2];
#pragma unroll
    for (int i = 0; i < 2; ++i) { int R, C; stage_rc(tid * 16 + i * 8192, R, C); const int Rb = Epi::PERM ? ((R & ~31) + perm32(R & 31)) : R;
        voffA[i] = (unsigned)(R * Kb + C * 2); voffB[i] = (unsigned)(Rb * Kb + C * 2); }
    const size_t kstep = (size_t)128;
    const size_t hstep = (size_t)HALF * Kb;
    const unsigned ldsw = (unsigned)wid * 1024u;
    const int aoff = lds_byte(wr * 64 + fr, F8 ? fq * 16 : fq * 8), boff = lds_byte(wc * 32 + fr, F8 ? fq * 16 : fq * 8);
#define PG8_SA(b, h) (((b) * 2 + (h)) * HTB)
#define PG8_SB(b, h) ((4 + (b) * 2 + (h)) * HTB)
#define PG8_STAGE(bufoff, gbase, voff) do { _Pragma("unroll") for (int _i = 0; _i < 2; ++_i) \
        __builtin_amdgcn_global_load_lds((const unsigned*)((const char*)(gbase) + (voff)[_i]), (LAS unsigned*)(lds + (bufoff) + ldsw + _i * 8192), 16, 0, PG8_AUX); } while (0)
#define PG8_LDA(dst, b, h) do { _Pragma("unroll") for (int m = 0; m < 4; ++m) _Pragma("unroll") for (int k = 0; k < 2; ++k) dst[m][k] = *(const LAS bf16x8*)(lds + PG8_SA(b, h) + aoff + m * 2048 + (F8 ? k * 16 : k * 1024)); } while (0)
#define PG8_LDB(dst, b, h) do { _Pragma("unroll") for (int n = 0; n < 2; ++n) _Pragma("unroll") for (int k = 0; k < 2; ++k) dst[n][k] = *(const LAS bf16x8*)(lds + PG8_SB(b, h) + boff + n * 2048 + (F8 ? k * 16 : k * 1024)); } while (0)
#define PG8_F8OP(X) __builtin_bit_cast(v8i_t, __builtin_shufflevector(X[0], X[1], 0, 1, 2, 3, 4, 5, 6, 7, 8, 9, 10, 11, 12, 13, 14, 15))
#define PG8_MMA(ai, bj, At, Bt) do { __builtin_amdgcn_s_setprio(1); \
        if constexpr (F8) { _Pragma("unroll") for (int m = 0; m < 4; ++m) _Pragma("unroll") for (int n = 0; n < 2; ++n) \
            asm volatile("v_mfma_scale_f32_16x16x128_f8f6f4 %0, %1, %2, %0, %3, %4 op_sel_hi:[0,0,0]" : "+v"(acc[ai][bj][m][n]) : "v"(PG8_F8OP(Bt[n])), "v"(PG8_F8OP(At[m])), "v"(f8sa), "v"(f8sb)); } \
        else { _Pragma("unroll") for (int m = 0; m < 4; ++m) _Pragma("unroll") for (int n = 0; n < 2; ++n) _Pragma("unroll") for (int k = 0; k < 2; ++k) \
            acc[ai][bj][m][n] = __builtin_amdgcn_mfma_f32_16x16x32_bf16(Bt[n][k], At[m][k], acc[ai][bj][m][n], 0, 0, 0); } \
        __builtin_amdgcn_s_setprio(0); } while (0)
#define PG8_WAIT_V(n) asm volatile("s_waitcnt vmcnt(" #n ")" ::: "memory")
#define PG8_WAIT_L(n) asm volatile("s_waitcnt lgkmcnt(" #n ")" ::: "memory")
#define PG8_BAR __builtin_amdgcn_s_barrier()
#define PG8_SCHED __builtin_amdgcn_sched_barrier(0)
    Unit cur, nxt; int ui = 0;
    if (!S.next(0, cur)) return;
    f32x4 acc[2][2][4][2];
#pragma unroll
    for (int a = 0; a < 2; ++a)
#pragma unroll
        for (int b = 0; b < 2; ++b)
#pragma unroll
            for (int m = 0; m < 4; ++m)
#pragma unroll
                for (int n = 0; n < 2; ++n) acc[a][b][m][n] = (f32x4){0.f, 0.f, 0.f, 0.f};
    bf16x8 At[4][2], B0[2][2], B1[2][2];
    const char* cA = S.pa(cur); const char* cB = S.pb(cur);
    PG8_STAGE(PG8_SB(0, 0), cB, voffB); PG8_STAGE(PG8_SB(0, 1), cB + hstep, voffB); PG8_STAGE(PG8_SA(0, 0), cA, voffA); PG8_STAGE(PG8_SA(0, 1), cA + hstep, voffA);
    if (wr == 1) PG8_BAR;
    PG8_WAIT_V(2); PG8_BAR;
    PG8_STAGE(PG8_SB(1, 0), cB + kstep, voffB); PG8_STAGE(PG8_SA(1, 0), cA + kstep, voffA); PG8_STAGE(PG8_SB(1, 1), cB + hstep + kstep, voffB);
    PG8_WAIT_V(6); PG8_BAR;
    for (;;) {
        const bool has_next = S.next(ui + 1, nxt);
        const char* nA = has_next ? S.pa(nxt) : cA; const char* nB = has_next ? S.pb(nxt) : cB;
        for (int t = 0; t < nt; t += 2) {
            const bool last = (t == nt - 2);
            const char* a1 = cA + (size_t)(t + 1) * kstep;
            const char* a2 = last ? nA : cA + (size_t)(t + 2) * kstep; const char* b2 = last ? nB : cB + (size_t)(t + 2) * kstep;
            const char* a3 = a2 + kstep; const char* b3 = b2 + kstep;
            PG8_LDB(B0, 0, 0); PG8_LDB(B1, 0, 1); PG8_SCHED; PG8_LDA(At, 0, 0); PG8_STAGE(PG8_SA(1, 1), a1 + hstep, voffA);
            PG8_WAIT_V(8); PG8_WAIT_L(0); PG8_BAR; PG8_MMA(0, 0, At, B0); PG8_MMA(0, 1, At, B1); PG8_BAR; PG8_SCHED;
            PG8_LDA(At, 0, 1); PG8_STAGE(PG8_SB(0, 0), b2, voffB); PG8_STAGE(PG8_SB(0, 1), b2 + hstep, voffB); PG8_STAGE(PG8_SA(0, 0), a2, voffA);
            PG8_WAIT_V(8); PG8_WAIT_L(0); PG8_BAR; PG8_MMA(1, 0, At, B0); PG8_MMA(1, 1, At, B1); PG8_BAR; PG8_SCHED;
            PG8_LDB(B0, 1, 0); PG8_LDB(B1, 1, 1); PG8_SCHED; PG8_LDA(At, 1, 0); PG8_STAGE(PG8_SA(0, 1), a2 + hstep, voffA);
            PG8_WAIT_V(8); PG8_WAIT_L(0); PG8_BAR; PG8_MMA(0, 0, At, B0); PG8_MMA(0, 1, At, B1); PG8_BAR; PG8_SCHED;
            PG8_LDA(At, 1, 1); PG8_STAGE(PG8_SB(1, 0), b3, voffB); PG8_STAGE(PG8_SB(1, 1), b3 + hstep, voffB); PG8_STAGE(PG8_SA(1, 0), a3, voffA);
            PG8_WAIT_V(8); PG8_WAIT_L(0); PG8_BAR; PG8_MMA(1, 0, At, B0); PG8_MMA(1, 1, At, B1); PG8_BAR; PG8_SCHED;
        }
        if (wr == 0) PG8_BAR;
        if constexpr (F8) asm volatile("s_nop 15\n\ts_nop 7" ::: "memory");
        if constexpr (Epi::HAS_PRE) {
            E.pre(cur, (LAS float*)(lds + STAGE_BYTES + 1024), tid); PG8_WAIT_L(0); PG8_BAR; }
        E(acc, cur, wr, wc, fr, fq, (const LAS float*)(lds + STAGE_BYTES + 1024));
        if (!has_next) break;
#pragma unroll
        for (int a = 0; a < 2; ++a)
#pragma unroll
            for (int b = 0; b < 2; ++b)
#pragma unroll
                for (int m = 0; m < 4; ++m)
#pragma unroll
                    for (int n = 0; n < 2; ++n) acc[a][b][m][n] = (f32x4){0.f, 0.f, 0.f, 0.f};
        cur = nxt; cA = nA; cB = nB; ++ui;
        if (wr == 1) PG8_BAR;
    }
    PG8_WAIT_V(0);
    PG8_BAR;
#undef PG8_SA
#undef PG8_SB
#undef PG8_STAGE
#undef PG8_LDA
#undef PG8_LDB
#undef PG8_MMA
#undef PG8_F8OP
#undef PG8_WAIT_V
#undef PG8_WAIT_L
#undef PG8_BAR
#undef PG8_SCHED
}
}
typedef GAS unsigned gu32;
#define RLX_AGENT __ATOMIC_RELAXED, __HIP_MEMORY_SCOPE_AGENT
#define XB_TMO      128
#define XB_XCNT(j)  (256  + 64 * (j))
#define XB_XSUB(j)  (1280 + 64 * (j))
#define XB_XGEN(j)  (2304 + 64 * (j))
#define XB_TOP      3328
#define XB_TOPGEN   3392
#define XCD_BAR_WORDS 3456
#define XB_SPIN_CAP (1u << 18)
__device__ __forceinline__ unsigned xb_ld(unsigned* p)              { return __hip_atomic_load(p, __ATOMIC_RELAXED, __HIP_MEMORY_SCOPE_AGENT); }
__device__ __forceinline__ unsigned xb_add(unsigned* p, unsigned v) { return __hip_atomic_fetch_add(p, v, __ATOMIC_RELAXED, __HIP_MEMORY_SCOPE_AGENT); }
__device__ __forceinline__ unsigned xb_xcc_id() { return (unsigned)__builtin_amdgcn_s_getreg((3 << 11) | 20) & 0xFu; }
#define XB_SPIN(cond, bar) do { unsigned _sp = 0; while (cond) { __builtin_amdgcn_s_sleep(1); \
    if ((++_sp & 255u) == 0u) { if (xb_ld(&(bar)[XB_TMO])) break; if (_sp > XB_SPIN_CAP) { atomicAdd(&(bar)[XB_TMO], 1u); break; } } } } while (0)
struct XcdBarrier { unsigned* bar; unsigned x; volatile LAS unsigned* st; };
__device__ __forceinline__ XcdBarrier xcd_barrier_post(unsigned* bar, volatile LAS unsigned* st) {
    XcdBarrier b; b.bar = bar; b.x = xb_xcc_id(); b.st = st;
    if (threadIdx.x == 0) (void)xb_add(&bar[XB_XCNT(b.x)], 1u);
    return b;
}
__device__ __forceinline__ void xcd_barrier_complete(unsigned* bar, unsigned x, unsigned& nloc, unsigned& nx) {
    const unsigned G = gridDim.x * gridDim.y * gridDim.z;
    unsigned sum, cnt, mine, sp = 0u;
    for (;;) {
        sum = 0u; cnt = 0u; mine = 0u;
#pragma unroll
        for (unsigned j = 0; j < 16; ++j) { const unsigned c = xb_ld(&bar[XB_XCNT(j)]); sum += c; cnt += (c > 0u) ? 1u : 0u; mine = (j == x) ? c : mine; }
        if (sum == G) break;
        __builtin_amdgcn_s_sleep(1);
        if ((++sp & 255u) == 0u) { if (xb_ld(&bar[XB_TMO])) break; if (sp > XB_SPIN_CAP) { atomicAdd(&bar[XB_TMO], 1u); break; } }
    }
    nloc = mine > 0u ? mine : 1u; nx = cnt > 0u ? cnt : 1u;
}
__device__ __forceinline__ void xcd_barrier(const XcdBarrier& b) {
    asm volatile("s_waitcnt vmcnt(0)" ::: "memory");
    __syncthreads();
    if (threadIdx.x == 0) {
        unsigned* bar = b.bar;
        __builtin_amdgcn_s_waitcnt(0);
        unsigned nloc = b.st[0], nx = b.st[1];
        if (nloc == 0u) { xcd_barrier_complete(bar, b.x, nloc, nx); b.st[0] = nloc; b.st[1] = nx; }
        const unsigned old = xb_add(&bar[XB_XSUB(b.x)], 1u);
        const unsigned gen = old / nloc;
        if (old + 1u == (gen + 1u) * nloc) {
            __builtin_amdgcn_fence(__ATOMIC_RELEASE, "agent");
            asm volatile("s_waitcnt vmcnt(0)" ::: "memory");
            const unsigned og = xb_add(&bar[XB_TOP], 1u);
            const unsigned tg = og / nx;
            if (og + 1u == (tg + 1u) * nx) xb_add(&bar[XB_TOPGEN], 1u);
            else XB_SPIN(xb_ld(&bar[XB_TOPGEN]) == tg, bar);
            __builtin_amdgcn_fence(__ATOMIC_ACQUIRE, "agent");
            xb_add(&bar[XB_XGEN(b.x)], 1u);
            asm volatile("s_waitcnt vmcnt(0)" ::: "memory");
        } else {
            XB_SPIN(xb_ld(&bar[XB_XGEN(b.x)]) == gen, bar);
            __builtin_amdgcn_fence(__ATOMIC_ACQUIRE, "agent");
            asm volatile("s_waitcnt vmcnt(0)" ::: "memory");
        }
    }
    __syncthreads();
}
struct Frame {
    LAS unsigned char* lds;
    volatile LAS unsigned* MISC;
    unsigned char* ws;
    int tid, lane, wave;
    int vcu, G;
    const float* in[19];
    float* out;
};
#define WSP(T, off) ((T*)(F.ws + (off)))

typedef float cv16f_t __attribute__((ext_vector_type(16)));
typedef unsigned cv6u_t __attribute__((ext_vector_type(6)));
struct Conv { const float* pu; const float* pv; unsigned char* u8; unsigned char* v8; LAS unsigned char* lbuf; int next, stride, end, pend, tick; };
__device__ __forceinline__ void conv_issue(const Conv& c, int item, int lane) {
    const float* src = ((item >> 14) ? c.pv : c.pu) + (size_t)(item & 16383) * 2048 + 4 * lane;
#pragma unroll
    for (int q = 0; q < 8; ++q) __builtin_amdgcn_global_load_lds((const unsigned*)(src + 256 * q), (LAS unsigned*)(c.lbuf + q * 1024), 16, 0, 0);
}
__device__ __forceinline__ void conv_finish(const Conv& c, int item, int lane) {
    const int isv = item >> 14, row = item & 16383; const float sc = isv ? 4.f : 64.f; cv16f_t a, b;
#pragma unroll
    for (int q = 0; q < 8; ++q) { const f32x4 x = *(const LAS f32x4*)(c.lbuf + q * 1024 + lane * 16);
#pragma unroll
        for (int e = 0; e < 4; ++e) { const int k_ = 4 * q + e;
            if (k_ & 1) b[k_ >> 1] = x[e] * sc; else a[k_ >> 1] = x[e] * sc; } }
    const cv6u_t w = __builtin_amdgcn_cvt_scalef32_2xpk16_fp6_f32(a, b, 1.0f);
    unsigned char* rec = (isv ? c.v8 : c.u8) + (size_t)row * 1536;
    *(GAS u32x4*)(rec + lane * 16) = (u32x4){w[0], w[1], w[2], w[3]}; *(GAS u32x2*)(rec + 1024 + lane * 8) = (u32x2){w[4], w[5]};
}
template <int YOUNGER>
__device__ __forceinline__ void conv_step(Conv& c, int lane) {
    if (c.pend >= 0) { if constexpr (YOUNGER == 0) asm volatile("s_waitcnt vmcnt(0)" ::: "memory"); else { static_assert(YOUNGER == 20, "wait count"); asm volatile("s_waitcnt vmcnt(20)" ::: "memory"); }
        conv_finish(c, c.pend, lane); c.pend = -1; asm volatile("s_waitcnt lgkmcnt(0)" ::: "memory"); }
    if (c.next < c.end) { conv_issue(c, c.next, lane); c.pend = c.next; c.next += c.stride; }
}
__device__ __forceinline__ void p0_transpose_item(const float* W, int K, int N, int k0, int n0, bf16_t* WT, int drow, bool rope, const float* gain, LAS float* scr, int lane) {
    { f32x4 v[8]; float gk[8];
#pragma unroll
      for (int i = 0; i < 8; ++i) { const int kk = 8 * i + (lane >> 3); v[i] = *(const GAS f32x4*)(W + (size_t)(k0 + kk) * N + n0 + 4 * (lane & 7)); gk[i] = gain ? gain[k0 + kk] : 1.f; }
#pragma unroll
      for (int i = 0; i < 8; ++i) { const int kk = 8 * i + (lane >> 3); LAS float* d = scr + kk * 33 + 4 * (lane & 7);
#pragma unroll
          for (int e = 0; e < 4; ++e) d[e] = v[i][e] * gk[i]; } }
    LDS_WAIT(); asm volatile("" ::: "memory");
    const int c = lane & 7;
#pragma unroll
    for (int j = 0; j < 4; ++j) { const int n = (lane >> 3) + 8 * j; const LAS float* s = scr + (8 * c) * 33 + n;
        u32x4 o; o.x = cvt_pk_bf16(s[0 * 33], s[1 * 33]); o.y = cvt_pk_bf16(s[2 * 33], s[3 * 33]); o.z = cvt_pk_bf16(s[4 * 33], s[5 * 33]); o.w = cvt_pk_bf16(s[6 * 33], s[7 * 33]);
        const int dr = drow + (rope ? (8 * (n >> 2) + (n & 3)) : n);
        *(GAS u32x4*)(WT + (size_t)dr * K + k0 + 8 * c) = o; }
    LDS_WAIT(); asm volatile("" ::: "memory");
}
__device__ __forceinline__ void p0_transpose_item8(const float* W, int K, int N, int k0, int n0, unsigned char* WT, int drow, bool rope, float scale, LAS float* scr, int lane, const float* gain = nullptr) {
    { f32x4 v[8]; float gk[8];
#pragma unroll
      for (int i = 0; i < 8; ++i) { const int kk = 8 * i + (lane >> 3); v[i] = *(const GAS f32x4*)(W + (size_t)(k0 + kk) * N + n0 + 4 * (lane & 7)); gk[i] = gain ? gain[k0 + kk] * scale : scale; }
#pragma unroll
      for (int i = 0; i < 8; ++i) { const int kk = 8 * i + (lane >> 3); LAS float* d = scr + kk * 33 + 4 * (lane & 7);
#pragma unroll
          for (int e = 0; e < 4; ++e) d[e] = v[i][e] * gk[i]; } }
    LDS_WAIT(); asm volatile("" ::: "memory");
#pragma unroll
    for (int j = 0; j < 2; ++j) { const int q = lane + 64 * j, n = q >> 2, c = q & 3; const LAS float* s = scr + (16 * c) * 33 + n; u32x4 o;
#pragma unroll
        for (int d = 0; d < 4; ++d) { int w = 0; w = __builtin_amdgcn_cvt_pk_fp8_f32(s[(4 * d) * 33], s[(4 * d + 1) * 33], w, false); w = __builtin_amdgcn_cvt_pk_fp8_f32(s[(4 * d + 2) * 33], s[(4 * d + 3) * 33], w, true); o[d] = (unsigned)w; }
        const int dr = drow + (rope ? (8 * (n >> 2) + (n & 3)) : n);
        *(GAS u32x4*)(WT + (size_t)dr * K + k0 + 16 * c) = o; }
    LDS_WAIT(); asm volatile("" ::: "memory");
}
__device__ __forceinline__ void rms_row_to_fp8(const float* xrow, const float* g, unsigned char* orow, int lane) {
    const GAS f32x4* xr = (const GAS f32x4*)xrow + lane; const GAS f32x4* gr = (const GAS f32x4*)g + lane;
    f32x4 v[8]; float s = 0.f;
#pragma unroll
    for (int j = 0; j < 8; ++j) { v[j] = xr[64 * j]; s += (v[j].x * v[j].x + v[j].y * v[j].y) + (v[j].z * v[j].z + v[j].w * v[j].w); }
    const float rstd = 1.0f / sqrtf(wave_sum(s) * (1.f / DM) + NORM_EPS);
    GAS unsigned* o4 = (GAS unsigned*)orow + lane;
#pragma unroll
    for (int j = 0; j < 8; ++j) { const f32x4 y = (v[j] * rstd) * gr[64 * j]; int w = 0; w = __builtin_amdgcn_cvt_pk_fp8_f32(y[0], y[1], w, false); w = __builtin_amdgcn_cvt_pk_fp8_f32(y[2], y[3], w, true); o4[64 * j] = (unsigned)w; }
}
__device__ __forceinline__ void rms_row_to_bf16(const float* xrow, const float* g, bf16_t* orow, int lane) {
    const GAS f32x4* xr = (const GAS f32x4*)xrow + lane; const GAS f32x4* gr = (const GAS f32x4*)g + lane;
    f32x4 v[8]; float s = 0.f;
#pragma unroll
    for (int j = 0; j < 8; ++j) { v[j] = xr[64 * j]; s += (v[j].x * v[j].x + v[j].y * v[j].y) + (v[j].z * v[j].z + v[j].w * v[j].w); }
    const float rstd = 1.0f / sqrtf(wave_sum(s) * (1.f / DM) + NORM_EPS);
    GAS u32x2* o8 = (GAS u32x2*)orow + lane;
#pragma unroll
    for (int j = 0; j < 8; ++j) { const f32x4 gg = gr[64 * j]; o8[64 * j] = pack4((v[j] * rstd) * gg); }
}
template <int PART>
__device__ __forceinline__ void p0_prologue(Frame& F, int rank, int nrank) {
    LAS float* scr = (LAS float*)(F.lds + F.wave * 16384);
    const int gw = rank * NWAVES + F.wave, NGW = nrank * NWAVES, lane = F.lane; const int gt = rank * 512 + F.tid, NGT = nrank * 512;
    unsigned char* WIN = WSP(unsigned char, WS_WIN); unsigned char* WVT = WSP(unsigned char, WS_WVT);
    constexpr int I_IN = 32 * 258, I_UQ = 8 * 96, I_UKV = 8 * 128, I_NA = 16 * 64, I_MLA = 32 * 64, I_OUT = 32 * 64;
    constexpr int NEARLY = I_IN + I_UQ + I_UKV, NITEMS = NEARLY + I_NA + I_MLA + I_OUT;
    for (int it = (PART == 0 ? 0 : NEARLY) + gw; it < (PART == 0 ? NEARLY : NITEMS); it += NGW) {
        int r = it;
        if (r < I_IN) { const int kb = r / 258, sb = r % 258, n0 = 32 * sb, k0 = 64 * kb; const float* W = F.in[3];
            unsigned char* dst = WIN; int drow; bool rope = false;
            if (n0 < 1024) drow = C_NAQ + n0;
            else if (n0 < 2048) drow = C_NAK + (n0 - 1024);
            else if (n0 < 3072) { dst = WVT; drow = n0 - 2048; }
            else if (n0 < 3584) drow = C_CQ + (n0 - 3072);
            else if (n0 < 4096) drow = C_CKV + (n0 - 3584);
            else if (n0 < 4160) { drow = C_KR + ((n0 - 4096) ? 4 : 0); rope = true; }
            else if (n0 < 6208) drow = C_GA + (n0 - 4160);
            else drow = C_GB + (n0 - 6208);
            p0_transpose_item8(W, 2048, 8256, k0, n0, dst, drow, rope, 64.f, scr, lane); continue; } r -= I_IN;
        if (r < I_UQ) { const int kb = r / 96, sb = r % 96, n0 = 32 * sb, k0 = 64 * kb; const int hd = n0 / 192, w = n0 % 192;
            int drow = n0; bool rope = false; if (w >= 128) { rope = true; drow = hd * 192 + 128 + ((w - 128) ? 4 : 0); }
            p0_transpose_item8(F.in[7], 512, 3072, k0, n0, WSP(unsigned char, WS_WUQ), drow, rope, 16.f, scr, lane, F.in[6]); continue; } r -= I_UQ;
        if (r < I_UKV) { const int kb = r / 128, sb = r % 128; const int n0 = 32 * sb, hd = n0 >> 8, w = n0 & 255;
            p0_transpose_item8(F.in[9], 512, 4096, 64 * kb, n0, WSP(unsigned char, WS_WUKV), (w >= 128 ? 2048 : 0) + hd * 128 + (w & 127), false, 16.f, scr, lane, F.in[8]); continue; } r -= I_UKV;
        if (r < I_NA) { const int kb = r / 64, sb = r % 64; p0_transpose_item8(F.in[10], 1024, 2048, 64 * kb, 32 * sb, WSP(unsigned char, WS_WNA), 32 * sb, false, 32.f, scr, lane); continue; } r -= I_NA;
        if (r < I_MLA) { const int kb = r / 64, sb = r % 64; p0_transpose_item8(F.in[11], 2048, 2048, 64 * kb, 32 * sb, WSP(unsigned char, WS_WMLA), 32 * sb, false, 64.f, scr, lane); continue; } r -= I_MLA;
        { const int kb = r / 64, sb = r % 64; p0_transpose_item8(F.in[12], 2048, 2048, 64 * kb, 32 * sb, WSP(unsigned char, WS_WOUT), 32 * sb, false, 64.f, scr, lane); }
    }
    if (PART == 0) { GAS u32x4* z = (GAS u32x4*)(WIN + (size_t)(C_KR + 64) * 2048); const int n16 = (NMAIN - C_KR - 64) * 2048 / 16;
      for (int i = gt; i < n16; i += NGT) z[i] = (u32x4){0u, 0u, 0u, 0u}; }
    if (PART == 0) { unsigned char* HN1 = WSP(unsigned char, WS_HN1);
#define P0_ROWSRC(m_) (((m_) < MREAL) ? F.in[0] + (size_t)(m_) * DM : F.in[1] + (size_t)((m_) - MREAL) * DM)
      { f32x4 v[8]; int m = gw;
        if (m < MREAL + NMETA) { const GAS f32x4* xr = (const GAS f32x4*)P0_ROWSRC(m) + lane;
#pragma unroll
            for (int j = 0; j < 8; ++j) v[j] = xr[64 * j]; }
        const GAS f32x4* gr = (const GAS f32x4*)F.in[2] + lane;
        while (m < MREAL + NMETA) { const int mn = m + NGW; f32x4 vn[8];
            { const int ml = mn < MREAL + NMETA ? mn : m; const GAS f32x4* xr = (const GAS f32x4*)P0_ROWSRC(ml) + lane;
#pragma unroll
              for (int j = 0; j < 8; ++j) vn[j] = xr[64 * j]; }
            float sq = 0.f;
#pragma unroll
            for (int j = 0; j < 8; ++j) sq += (v[j].x * v[j].x + v[j].y * v[j].y) + (v[j].z * v[j].z + v[j].w * v[j].w);
            const float rstd = 1.0f / sqrtf(wave_sum(sq) * (1.f / DM) + NORM_EPS);
            GAS unsigned* o4 = (GAS unsigned*)(HN1 + (size_t)m * DM) + lane;
#pragma unroll
            for (int j = 0; j < 8; ++j) { const f32x4 y = (v[j] * rstd) * gr[64 * j]; int w = 0; w = __builtin_amdgcn_cvt_pk_fp8_f32(y[0], y[1], w, false); w = __builtin_amdgcn_cvt_pk_fp8_f32(y[2], y[3], w, true); o4[64 * j] = (unsigned)w; }
#pragma unroll
            for (int j = 0; j < 8; ++j) v[j] = vn[j];
            m = mn; } }
#undef P0_ROWSRC
      GAS u32x4* z = (GAS u32x4*)(HN1 + (size_t)(MREAL + NMETA) * DM); const int n16 = (MPAD - MREAL - NMETA) * DM / 16;
      for (int i = gt; i < n16; i += NGT) z[i] = (u32x4){0u, 0u, 0u, 0u}; }
    if (PART == 0) { float* ct = WSP(float, WS_COS); float* st = WSP(float, WS_SIN);
      for (int i = gt; i < NPOS * 32; i += NGT) { const int p = i >> 5, j = i & 31;
          const float inv = __builtin_powf(10000.0f, -(float)(2 * j) / 64.0f); const float ang = (float)p * inv;
          double r = (double)ang * 0.15915494309189535; r -= __builtin_rint(r); const float rf = (float)r;
          ct[i] = __builtin_amdgcn_cosf(rf); st[i] = __builtin_amdgcn_sinf(rf); } }
    if (PART == 1) { const float* SK = F.in[15]; const float* WQ = F.in[14]; const float* g2 = F.in[13]; bf16_t* WSCp = WSP(bf16_t, WS_WSC);
      const int l15 = lane & 15, l4 = lane >> 4;
      for (int task = gw; task < 2048; task += NGW) { const int g = task >> 7, nt = (task >> 4) & 7, kc = task & 15, n0 = nt * 16;
          bf16x8 bfr[4];
#pragma unroll
          for (int kk = 0; kk < 4; ++kk) { const float* p = SK + ((size_t)g * 128 + n0 + l15) * 128 + 32 * kk + 8 * l4; const f32x4 a = *(const GAS f32x4*)p, b = *(const GAS f32x4*)(p + 4);
              const u32x4 w = pack8(a, b); bfr[kk] = __builtin_bit_cast(bf16x8, w); }
          for (int kt = 0; kt < 8; ++kt) { const int k0 = (kc * 8 + kt) * 16; f32x4 acc = (f32x4){0.f, 0.f, 0.f, 0.f};
#pragma unroll
              for (int kk = 0; kk < 4; ++kk) { const float* p = WQ + (size_t)(k0 + l15) * 2048 + g * 128 + 32 * kk + 8 * l4; const f32x4 a = *(const GAS f32x4*)p, b = *(const GAS f32x4*)(p + 4);
                  const u32x4 w = pack8(a, b); acc = __builtin_amdgcn_mfma_f32_16x16x32_bf16(__builtin_bit_cast(bf16x8, w), bfr[kk], acc, 0, 0, 0); }
              const f32x4 gg = *(const GAS f32x4*)(g2 + k0 + 4 * l4);
              *(GAS u32x2*)(WSCp + (size_t)(g * 128 + n0 + l15) * 2048 + k0 + 4 * l4) = pack4(acc * gg); } } }
}
using pg8::Unit;
struct SchedGrid {
    int G, c, nM, nN; const char* A; const char* B; size_t tstep;
    __device__ __forceinline__ bool next(int i, Unit& u) const { const int L = i * G + c; if (L >= nM * nN) return false; pg8::grid_order(L, nM, nN, u.pm, u.pn); u.kind = 0; return true; }
    __device__ __forceinline__ const char* pa(const Unit& u) const { return A + (size_t)u.pm * tstep; }
    __device__ __forceinline__ const char* pb(const Unit& u) const { return B + (size_t)u.pn * tstep; }
};
constexpr int P1_MAIN = 64 * 29, P1_VT = 4 * 65, P1_META = 7, P1_UNITS = P1_MAIN + P1_VT + P1_META;
struct SchedP1 {
    int G, c; const char* hn1; const char* win; const char* wvt; size_t tstep;
    __device__ __forceinline__ bool next(int i, Unit& u) const {
        const int L = i * G + c; if (L >= P1_UNITS) return false;
        if (L < P1_MAIN) { pg8::grid_order(L, 64, 29, u.pm, u.pn); u.kind = 0; }
        else if (L < P1_MAIN + P1_VT) { const int idx = L - P1_MAIN; u.pm = idx & 3; u.pn = idx >> 2; u.kind = 1; }
        else { const int idx = L - P1_MAIN - P1_VT; u.pm = 64; u.pn = idx < 4 ? 4 + idx : (idx < 6 ? 10 + (idx - 4) : 28); u.kind = 0; }
        return true; }
    __device__ __forceinline__ const char* pa(const Unit& u) const { return (u.kind == 1 ? wvt : hn1) + (size_t)u.pm * tstep; }
    __device__ __forceinline__ const char* pb(const Unit& u) const { return (u.kind == 1 ? hn1 : win) + (size_t)u.pn * tstep; }
};
__device__ __forceinline__ void rope4(const f32x4 x1, const f32x4 x2, const float* cosT, const float* sinT, int pos, int j0, f32x4& lo, f32x4& hi) {
    const f32x4 c = *(const GAS f32x4*)(cosT + pos * 32 + j0), s = *(const GAS f32x4*)(sinT + pos * 32 + j0);
    lo = x1 * c - x2 * s; hi = x2 * c + x1 * s;
}
struct EpiP1 {
    static constexpr bool PERM = true, HAS_PRE = false;
    bf16_t *naq, *nak, *vt; unsigned char *cq, *ckv; unsigned char *kr; unsigned char *ga, *gb; float *ssq_q, *ssq_kv; const float *cosT, *sinT;
    __device__ __forceinline__ void operator()(const f32x4 (&acc)[2][2][4][2], const Unit& u, int wr, int wc, int fr, int fq, const LAS float* rowsc) const {
        const int row0 = u.pm * 256 + wr * 64 + fr, colu = wc * 32 + 8 * fq;
        if (u.kind == 1) {
#pragma unroll
            for (int ai = 0; ai < 2; ++ai)
#pragma unroll
                for (int m = 0; m < 4; ++m) { bf16_t* rp = vt + (size_t)(row0 + ai * 128 + m * 16) * VT_PITCH + u.pn * 256 + colu;
#pragma unroll
                    for (int bj = 0; bj < 2; ++bj) *(GAS u32x4*)(rp + bj * 128) = pack8(acc[ai][bj][m][0], acc[ai][bj][m][1]); }
            return; }
        const int pn = u.pn;
        if (pn == 28) {
            if (wc < 2) { const int j0 = 4 * (4 * wc + fq);
#pragma unroll
                for (int ai = 0; ai < 2; ++ai)
#pragma unroll
                    for (int m = 0; m < 4; ++m) { const int row = row0 + ai * 128 + m * 16; const int pos = row < MREAL ? NMETA + (row & (SEQ - 1)) : row - MREAL;
                        f32x4 lo, hi; rope4(acc[ai][0][m][0], acc[ai][0][m][1], cosT, sinT, pos, j0, lo, hi);
                        *(GAS unsigned*)(kr + (size_t)row * 64 + j0) = pack4_fp8(lo); *(GAS unsigned*)(kr + (size_t)row * 64 + 32 + j0) = pack4_fp8(hi); } }
            return; }
        if (pn >= 12) {
            unsigned char* base = pn < 20 ? ga : gb; const int colt = (pn < 20 ? pn - 12 : pn - 20) * 256 + colu;
#pragma unroll
            for (int ai = 0; ai < 2; ++ai)
#pragma unroll
                for (int m = 0; m < 4; ++m) { unsigned char* rp = base + (size_t)(row0 + ai * 128 + m * 16) * 2048 + colt;
#pragma unroll
                    for (int bj = 0; bj < 2; ++bj) { f32x4 a = acc[ai][bj][m][0], b = acc[ai][bj][m][1];
#pragma unroll
                        for (int i = 0; i < 4; ++i) { a[i] = sigmoidf_(a[i]); b[i] = sigmoidf_(b[i]); }
                        *(GAS u32x2*)(rp + bj * 128) = pack8_u8(a, b); } }
            return; }
        if (pn >= 8) {
            const bool isq = pn < 10; unsigned char* base = isq ? cq : ckv; float* ssq = isq ? ssq_q : ssq_kv; const int colt = (isq ? pn - 8 : pn - 10) * 256 + colu;
#pragma unroll
            for (int ai = 0; ai < 2; ++ai)
#pragma unroll
                for (int m = 0; m < 4; ++m) { const int row = row0 + ai * 128 + m * 16; unsigned char* rp = base + (size_t)row * 512 + colt; float s = 0.f;
#pragma unroll
                    for (int bj = 0; bj < 2; ++bj) { const f32x4 a = acc[ai][bj][m][0], b = acc[ai][bj][m][1];
                        s += (a[0] * a[0] + a[1] * a[1]) + (a[2] * a[2] + a[3] * a[3]) + (b[0] * b[0] + b[1] * b[1]) + (b[2] * b[2] + b[3] * b[3]);
                        *(GAS u32x2*)(rp + bj * 128) = pack8_fp8(a, b); }
                    s += __shfl_xor(s, 16); s += __shfl_xor(s, 32);
                    if (fq == 0) ssq[(size_t)((pn & 1) * 4 + wc) * MPAD + row] = s; }
            return; }
        {
            bf16_t* base = pn < 4 ? naq : nak; const int colt = (pn & 3) * 256 + colu;
#pragma unroll
            for (int ai = 0; ai < 2; ++ai)
#pragma unroll
                for (int m = 0; m < 4; ++m) { bf16_t* rp = base + (size_t)(row0 + ai * 128 + m * 16) * 1024 + colt;
#pragma unroll
                    for (int bj = 0; bj < 2; ++bj) *(GAS u32x4*)(rp + bj * 128) = pack8(acc[ai][bj][m][0], acc[ai][bj][m][1]); }
        }
    }
};
constexpr int P3_Q = 64 * 12, P3_K = 65 * 8, P3_V = 8 * 65, P3_UNITS = P3_Q + P3_K + P3_V;
struct SchedP3 {
    int G, c; const char* ws; size_t tstep;
    __device__ __forceinline__ bool next(int i, Unit& u) const {
        const int L = i * G + c; if (L >= P3_UNITS) return false;
        if (L < P3_Q) { pg8::grid_order(L, 64, 12, u.pm, u.pn); u.kind = 0; }
        else if (L < P3_Q + P3_K) { pg8::grid_order(L - P3_Q, 65, 8, u.pm, u.pn); u.kind = 1; }
        else { const int idx = L - P3_Q - P3_K; u.pm = idx & 7; u.pn = idx >> 3; u.kind = 2; }
        return true; }
    __device__ __forceinline__ const char* pa(const Unit& u) const { const size_t o = u.kind == 0 ? WS_CQ : (u.kind == 1 ? WS_CKV : WS_WUKV + (size_t)2048 * 512); return ws + o + (size_t)u.pm * tstep; }
    __device__ __forceinline__ const char* pb(const Unit& u) const { const size_t o = u.kind == 0 ? WS_WUQ : (u.kind == 1 ? WS_WUKV : WS_CKV); return ws + o + (size_t)u.pn * tstep; }
};
template <int NS, int LD> __device__ __forceinline__ float rstd_slabs(const float* part, int row, float invn) {
    float s = 0.f;
#pragma unroll
    for (int i = 0; i < NS; ++i) s += part[(size_t)i * LD + row];
    return 1.0f / sqrtf(s * invn + NORM_EPS);
}
struct EpiP3 {
    static constexpr bool PERM = true, HAS_PRE = true;
    unsigned char *qm, *kn, *vt; const float *ssq_q, *ssq_kv; const float *cosT, *sinT;
    __device__ __forceinline__ void pre(const Unit& u, LAS float* sc, int tid) const { if (tid < 256) { const int row = (u.kind == 2 ? u.pn : u.pm) * 256 + tid; sc[tid] = u.kind ? rstd_slabs<8, MPAD>(ssq_kv, row, 1.f / 512.f) : rstd_slabs<8, MPAD>(ssq_q, row, 1.f / 512.f); } }
    __device__ __forceinline__ void operator()(const f32x4 (&acc)[2][2][4][2], const Unit& u, int wr, int wc, int fr, int fq, const LAS float* rowsc) const {
        const int row0 = u.pm * 256 + wr * 64 + fr, colu = wc * 32 + 8 * fq;
        if (u.kind == 2) {
#pragma unroll
            for (int bj = 0; bj < 2; ++bj) { const int cl = bj * 128 + colu, t0 = u.pn * 256 + cl;
                const f32x4 s0 = *(const LAS f32x4*)(rowsc + cl), s1 = *(const LAS f32x4*)(rowsc + cl + 4);
                const int g = (t0 >> 3) & 7, pos = (t0 & ~63) + 16 * (g >> 2) + 4 * (g & 3);
#pragma unroll
                for (int ai = 0; ai < 2; ++ai)
#pragma unroll
                    for (int m = 0; m < 4; ++m) { unsigned char* rp = vt + (size_t)(row0 + ai * 128 + m * 16) * MPAD + pos;
                        *(GAS unsigned*)rp = pack4_fp8(acc[ai][bj][m][0] * s0); *(GAS unsigned*)(rp + 32) = pack4_fp8(acc[ai][bj][m][1] * s1); } }
            return; }
        if (u.kind == 1) {
#pragma unroll
            for (int ai = 0; ai < 2; ++ai)
#pragma unroll
                for (int m = 0; m < 4; ++m) { const int row = row0 + ai * 128 + m * 16; const float rs = rowsc[ai * 128 + wr * 64 + m * 16 + fr];
                    unsigned char* rp = kn + (size_t)row * 2048 + u.pn * 256 + colu;
#pragma unroll
                    for (int bj = 0; bj < 2; ++bj) *(GAS u32x2*)(rp + bj * 128) = pack8_fp8(acc[ai][bj][m][0] * rs, acc[ai][bj][m][1] * rs); }
            return; }
#pragma unroll
        for (int bj = 0; bj < 2; ++bj) { const int c8 = u.pn * 256 + bj * 128 + colu; const int hd = c8 / 192, w = c8 - hd * 192;
            if (w < 128) {
#pragma unroll
                for (int ai = 0; ai < 2; ++ai)
#pragma unroll
                    for (int m = 0; m < 4; ++m) { const int row = row0 + ai * 128 + m * 16; const float rs = rowsc[ai * 128 + wr * 64 + m * 16 + fr];
                        *(GAS u32x2*)(qm + (size_t)row * 3072 + c8) = pack8_fp8(acc[ai][bj][m][0] * rs, acc[ai][bj][m][1] * rs); }
            } else { const int j0 = (w - 128) >> 1;
#pragma unroll
                for (int ai = 0; ai < 2; ++ai)
#pragma unroll
                    for (int m = 0; m < 4; ++m) { const int row = row0 + ai * 128 + m * 16; const float rs = rowsc[ai * 128 + wr * 64 + m * 16 + fr];
                        const int pos = NMETA + (row & (SEQ - 1)); f32x4 lo, hi; rope4(acc[ai][bj][m][0] * rs, acc[ai][bj][m][1] * rs, cosT, sinT, pos, j0, lo, hi);
                        unsigned char* qp = qm + (size_t)row * 3072 + hd * 192 + 128 + j0; *(GAS unsigned*)qp = pack4_fp8(lo); *(GAS unsigned*)(qp + 32) = pack4_fp8(hi); }
            } }
    }
};

__device__ __forceinline__ void unpack8(const u32x4 w, f32x4& a, f32x4& b) { a = (f32x4){bf_lo(w.x), bf_hi(w.x), bf_lo(w.y), bf_hi(w.y)}; b = (f32x4){bf_lo(w.z), bf_hi(w.z), bf_lo(w.w), bf_hi(w.w)}; }
struct EpiP5a {
    static constexpr bool PERM = true, HAS_PRE = false;
    const unsigned char* ga; unsigned char* t1;
    __device__ __forceinline__ void operator()(const f32x4 (&acc)[2][2][4][2], const Unit& u, int wr, int wc, int fr, int fq, const LAS float* rowsc) const {
        const int row0 = u.pm * 256 + wr * 64 + fr, col0 = u.pn * 256 + wc * 32 + 8 * fq;
#pragma unroll
        for (int ai = 0; ai < 2; ++ai)
#pragma unroll
            for (int m = 0; m < 4; ++m) { const size_t off = (size_t)(row0 + ai * 128 + m * 16) * 2048 + col0;
#pragma unroll
                for (int bj = 0; bj < 2; ++bj) { f32x4 g0, g1; unpack8_u8(*(const GAS u32x2*)(ga + off + bj * 128), g0, g1);
                    *(GAS u32x2*)(t1 + off + bj * 128) = pack8_fp8(acc[ai][bj][m][0] * g0 * 32.f, acc[ai][bj][m][1] * g1 * 32.f); } }
    }
};
struct EpiP5b {
    static constexpr bool PERM = true, HAS_PRE = false;
    const unsigned char* gb; const unsigned char* t1; unsigned char* merged;
    __device__ __forceinline__ void operator()(const f32x4 (&acc)[2][2][4][2], const Unit& u, int wr, int wc, int fr, int fq, const LAS float* rowsc) const {
        const int row0 = u.pm * 256 + wr * 64 + fr, col0 = u.pn * 256 + wc * 32 + 8 * fq;
#pragma unroll
        for (int ai = 0; ai < 2; ++ai)
#pragma unroll
            for (int m = 0; m < 4; ++m) { const size_t off = (size_t)(row0 + ai * 128 + m * 16) * 2048 + col0;
#pragma unroll
                for (int bj = 0; bj < 2; ++bj) { f32x4 g0, g1; unpack8_u8(*(const GAS u32x2*)(gb + off + bj * 128), g0, g1);
                    f32x4 a, b; unpack8_fp8(*(const GAS u32x2*)(t1 + off + bj * 128), a, b);
                    *(GAS u32x2*)(merged + off + bj * 128) = pack8_fp8(a + acc[ai][bj][m][0] * g0 * 32.f, b + acc[ai][bj][m][1] * g1 * 32.f); } }
    }
};
struct EpiP6 {
    static constexpr bool PERM = true, HAS_PRE = false;
    const float* x; bf16_t* h2b; float* ssq2;
    __device__ __forceinline__ void operator()(const f32x4 (&acc)[2][2][4][2], const Unit& u, int wr, int wc, int fr, int fq, const LAS float* rowsc) const {
        const int row0 = u.pm * 256 + wr * 64 + fr, col0 = u.pn * 256 + wc * 32 + 8 * fq;
#pragma unroll
        for (int ai = 0; ai < 2; ++ai)
#pragma unroll
            for (int m = 0; m < 4; ++m) { const int row = row0 + ai * 128 + m * 16; const size_t off = (size_t)row * 2048 + col0; float s = 0.f;
#pragma unroll
                for (int bj = 0; bj < 2; ++bj) { const f32x4 a = *(const GAS f32x4*)(x + off + bj * 128) + acc[ai][bj][m][0], b = *(const GAS f32x4*)(x + off + bj * 128 + 4) + acc[ai][bj][m][1];
                    s += (a[0] * a[0] + a[1] * a[1]) + (a[2] * a[2] + a[3] * a[3]) + (b[0] * b[0] + b[1] * b[1]) + (b[2] * b[2] + b[3] * b[3]);
                    *(GAS u32x4*)(h2b + off + bj * 128) = pack8(a, b); }
                s += __shfl_xor(s, 16); s += __shfl_xor(s, 32);
                if (fq == 0) ssq2[(size_t)(u.pn * 4 + wc) * MREAL + row] = s; }
    }
};
struct EpiP7 {
    static constexpr bool PERM = true, HAS_PRE = true;
    const float* ssq2; _Float16* sc;
    __device__ __forceinline__ void pre(const Unit& u, LAS float* sc, int tid) const { if (tid < 256) sc[tid] = rstd_slabs<32, MREAL>(ssq2, u.pm * 256 + tid, 1.f / 2048.f); }
    __device__ __forceinline__ void operator()(const f32x4 (&acc)[2][2][4][2], const Unit& u, int wr, int wc, int fr, int fq, const LAS float* rowsc) const {
        typedef _Float16 h4_t __attribute__((ext_vector_type(4)));
        const int row0 = u.pm * 256 + wr * 64 + fr, col0 = u.pn * 256 + wc * 32 + 8 * fq;
#pragma unroll
        for (int ai = 0; ai < 2; ++ai)
#pragma unroll
            for (int m = 0; m < 4; ++m) { const int row = row0 + ai * 128 + m * 16; const float rs = rowsc[ai * 128 + wr * 64 + m * 16 + fr]; const size_t off = (size_t)row * 2048 + col0;
#pragma unroll
                for (int bj = 0; bj < 2; ++bj) { const h4_t lo = __builtin_convertvector(acc[ai][bj][m][0] * rs, h4_t), hi = __builtin_convertvector(acc[ai][bj][m][1] * rs, h4_t);
                    const u32x2 wl = __builtin_bit_cast(u32x2, lo), wh = __builtin_bit_cast(u32x2, hi);
                    *(GAS u32x4*)(sc + off + bj * 128) = (u32x4){wl.x, wl.y, wh.x, wh.y}; } }
    }
};
namespace att {
#define KSWZ(row, colB) ((row) * 256 + ((colB) ^ (((row) & 7) << 4)))
#define KRSWZ(row, colB) ((row) * 128 + ((colB) ^ ((((row) >> 1) & 7) << 4)))
constexpr float L2E = 1.4426950408889634f;
template <int DUMMY = 0>
__device__ __forceinline__ void partialSM(f32x16& p0, f32x16& p1, float& m_reg, float& mn, float& alpha, const float C, const float THRS) {
  float pmax = p0[0];
#pragma unroll
  for (int r = 1; r < 16; ++r) pmax = fmaxf(pmax, p0[r]);
#pragma unroll
  for (int r = 0; r < 16; ++r) pmax = fmaxf(pmax, p1[r]);
  { auto rr = __builtin_amdgcn_permlane32_swap(__float_as_uint(pmax), __float_as_uint(pmax), false, false);
    pmax = fmaxf(__uint_as_float(rr[0]), __uint_as_float(rr[1])); }
  if (__builtin_expect(__all(pmax - m_reg <= THRS), 1)) { mn = m_reg; alpha = 1.f; }
  else { mn = fmaxf(m_reg, pmax); alpha = __builtin_amdgcn_exp2f((m_reg - mn) * C); m_reg = mn; }
  const float mnC = -mn * C;
#pragma unroll
  for (int r = 0; r < 16; ++r) p0[r] = fmaf(p0[r], C, mnC);
#pragma unroll
  for (int r = 0; r < 16; ++r) p1[r] = fmaf(p1[r], C, mnC);
#pragma unroll
  for (int r = 0; r < 16; ++r) p0[r] = __builtin_amdgcn_exp2f(p0[r]);
}
__device__ __forceinline__ void finishSM(f32x16& p0, f32x16& p1, float alpha, float& l_reg, bf16x8& pa0, bf16x8& pa1, bf16x8& pa2, bf16x8& pa3) {
#pragma unroll
  for (int r = 0; r < 16; ++r) p1[r] = __builtin_amdgcn_exp2f(p1[r]);
  float ps = 0;
#pragma unroll
  for (int r = 0; r < 16; ++r) ps += p0[r];
#pragma unroll
  for (int r = 0; r < 16; ++r) ps += p1[r];
  { auto rr = __builtin_amdgcn_permlane32_swap(__float_as_uint(ps), __float_as_uint(ps), false, false);
    ps = __uint_as_float(rr[0]) + __uint_as_float(rr[1]); }
  l_reg = l_reg * alpha + ps;
#define PK4(P, BASE, OUT) do { unsigned a0 = cvt_pk_bf16(P[BASE + 0], P[BASE + 1]), a1 = cvt_pk_bf16(P[BASE + 2], P[BASE + 3]);   \
    unsigned b0 = cvt_pk_bf16(P[BASE + 4], P[BASE + 5]), b1 = cvt_pk_bf16(P[BASE + 6], P[BASE + 7]);                              \
    auto r0 = __builtin_amdgcn_permlane32_swap(a0, b0, false, false); auto r1 = __builtin_amdgcn_permlane32_swap(a1, b1, false, false); \
    u32x4 w = {r0[0], r1[0], r0[1], r1[1]}; OUT = __builtin_bit_cast(bf16x8, w); } while (0)
  PK4(p0, 0, pa0); PK4(p0, 8, pa1); PK4(p1, 0, pa2); PK4(p1, 8, pa3);
#undef PK4
}
constexpr int NW = 8, QBLK = 32, KVBLK = 64;
constexpr float MLA_SCALE = 0.07216878364870322f;
constexpr float MLA_THR = 8.f;
constexpr int SHM_V = KVBLK * 128 * 2, SHM_KN = KVBLK * 128 * 2, SHM_KR = KVBLK * 64 * 2;
constexpr int OFF_V = 0, OFF_KN = 2 * SHM_V, OFF_KR = OFF_KN + 2 * SHM_KN, OFF_WS = OFF_KR + 2 * SHM_KR, OFF_QR = OFF_WS + NW * 64 * 4, MLA_LDS = OFF_QR + NW * 4096;
__device__ __forceinline__ void qkt(f32x16& p0, f32x16& p1, const LAS char* Kn, const LAS char* Kr, const bf16x8* qr, const LAS char* qrp, const int* kb, const int* krb) {
  p0 = f32x16{}; p1 = f32x16{};
#pragma unroll
  for (int d0 = 0; d0 < 8; ++d0) {
    const bf16x8 b0 = *(const LAS bf16x8*)(Kn + kb[d0 & 3] + (d0 >> 2) * 128);
    const bf16x8 b1 = *(const LAS bf16x8*)(Kn + kb[d0 & 3] + (d0 >> 2) * 128 + 8192);
    p0 = __builtin_amdgcn_mfma_f32_32x32x16_bf16(b0, qr[d0], p0, 0, 0, 0);
    p1 = __builtin_amdgcn_mfma_f32_32x32x16_bf16(b1, qr[d0], p1, 0, 0, 0); }
#pragma unroll
  for (int d0 = 0; d0 < 4; ++d0) {
    const bf16x8 b0 = *(const LAS bf16x8*)(Kr + krb[d0]);
    const bf16x8 b1 = *(const LAS bf16x8*)(Kr + krb[d0] + 4096);
    const bf16x8 qf = *(const LAS bf16x8*)(qrp + d0 * 1024);
    p0 = __builtin_amdgcn_mfma_f32_32x32x16_bf16(b0, qf, p0, 0, 0, 0);
    p1 = __builtin_amdgcn_mfma_f32_32x32x16_bf16(b1, qf, p1, 0, 0, 0); }
}
__device__ __forceinline__ int v_st(int k, int c) { const int kk = (k & ~0xC) | ((k & 4) << 1) | ((k & 8) >> 1); return ((kk >> 3) * 4 + (c >> 5)) * 512 + ((kk & 7) * 32 + (c & 31)) * 2; }
__device__ __forceinline__ int v_rd_base(int lane) { return ((lane & 3) << 3) | (((lane >> 2) & 3) << 6) | (((lane >> 4) & 1) << 5) | (((lane >> 5) & 1) << 8); }
constexpr int v_rd_off(int d0, int ks, int half) { return d0 * 512 + ks * 4096 + half * 2048; }
template <int OFF> __device__ __forceinline__ s16x4 tr_read(int vb) {
  s16x4 r; asm volatile("ds_read_b64_tr_b16 %0, %1 offset:%2" : "=&v"(r) : "v"(vb), "i"(OFF) : "memory"); return r;
}
template <int D0> __device__ __forceinline__ void pv_one(f32x16& od, int vb, bf16x8 pa0, bf16x8 pa1, bf16x8 pa2, bf16x8 pa3) {
  const s16x4 l0 = tr_read<v_rd_off(D0, 0, 0)>(vb), h0 = tr_read<v_rd_off(D0, 0, 1)>(vb), l1 = tr_read<v_rd_off(D0, 1, 0)>(vb), h1 = tr_read<v_rd_off(D0, 1, 1)>(vb);
  const s16x4 l2 = tr_read<v_rd_off(D0, 2, 0)>(vb), h2 = tr_read<v_rd_off(D0, 2, 1)>(vb), l3 = tr_read<v_rd_off(D0, 3, 0)>(vb), h3 = tr_read<v_rd_off(D0, 3, 1)>(vb);
  asm volatile("s_waitcnt lgkmcnt(0)" ::: "memory"); SBAR();
#define PK(L, H) (bf16x8){L[0], L[1], L[2], L[3], H[0], H[1], H[2], H[3]}
  od = __builtin_amdgcn_mfma_f32_32x32x16_bf16(pa0, PK(l0, h0), od, 0, 0, 0);
  od = __builtin_amdgcn_mfma_f32_32x32x16_bf16(pa1, PK(l1, h1), od, 0, 0, 0);
  od = __builtin_amdgcn_mfma_f32_32x32x16_bf16(pa2, PK(l2, h2), od, 0, 0, 0);
  od = __builtin_amdgcn_mfma_f32_32x32x16_bf16(pa3, PK(l3, h3), od, 0, 0, 0);
#undef PK
}
__device__ __forceinline__ void pv_d0(f32x16* o, int vb, bf16x8 pa0, bf16x8 pa1, bf16x8 pa2, bf16x8 pa3) {
  pv_one<0>(o[0], vb, pa0, pa1, pa2, pa3); pv_one<1>(o[1], vb, pa0, pa1, pa2, pa3); pv_one<2>(o[2], vb, pa0, pa1, pa2, pa3); pv_one<3>(o[3], vb, pa0, pa1, pa2, pa3);
}
__device__ __forceinline__ void mla_unit(int b, int h, int qb, const bf16_t* __restrict__ QM, const bf16_t* __restrict__ KN, const bf16_t* __restrict__ KR, const bf16_t* __restrict__ VV, unsigned char* __restrict__ OM, LAS char* lds) {
  const int tid = threadIdx.x, wid = tid >> 6, lane = tid & 63, r32 = lane & 31, hi = lane >> 5;
  constexpr float C = MLA_SCALE * L2E, THRS = MLA_THR / MLA_SCALE;
  constexpr int NT = 33;
  LAS char* V_lds = lds + OFF_V; LAS char* Kn_lds = lds + OFF_KN; LAS char* Kr_lds = lds + OFF_KR;
  LAS float* ws = (LAS float*)(lds + OFF_WS) + wid * 64; LAS float* li_l = ws; LAS float* al_l = ws + 32;
  float m_reg = -1e30f, l_reg = 0; f32x16 o[4] = {}; bf16x8 qr[8];
  LAS char* qrp = lds + OFF_QR + wid * 4096 + lane * 16;
  const int qrow = b * SEQ + qb * 256 + wid * QBLK + r32;
  const bf16_t* Qw = QM + (size_t)qrow * 3072 + h * 192 + hi * 8;
#pragma unroll
  for (int d0 = 0; d0 < 8; ++d0) qr[d0] = *(const GAS bf16x8*)(Qw + d0 * 16);
  __syncthreads();
#pragma unroll
  for (int d0 = 0; d0 < 4; ++d0) *(LAS bf16x8*)(qrp + d0 * 1024) = *(const GAS bf16x8*)(Qw + (8 + d0) * 16);
  const int sr = tid >> 4, sc = (tid & 15) * 8, vst0 = v_st(sr, sc), vst1 = v_st(32 + sr, sc);
  const int krr = tid >> 3, krc = (tid & 7) * 8;
  const int vb0 = (int)(uintptr_t)V_lds + v_rd_base(lane);
  bf16x8 s_v0, s_v1, s_k0, s_k1, s_kr;
  const int realbase = b * SEQ - KVBLK;
  const unsigned voff = (unsigned)(sr * 2048 + sc) * 2u, kroff = (unsigned)(krr * 64 + krc) * 2u;
  int kb[4], krb[4];
#pragma unroll
  for (int bq = 0; bq < 4; ++bq) { kb[bq] = KSWZ(r32, bq * 32 + hi * 16); krb[bq] = KRSWZ(r32, bq * 32 + hi * 16); }
#define TROW(t) ((t) == 0 ? MREAL : realbase + (t) * KVBLK)
#define SLOAD(t) do { const int k0_ = TROW(t); const size_t ro_ = ((size_t)k0_ * 2048 + h * 128) * 2; \
    const GAS char* vb_ = (const GAS char*)VV + ro_; const GAS char* nb_ = (const GAS char*)KN + ro_; const GAS char* rb_ = (const GAS char*)KR + (size_t)k0_ * 128; \
    s_v0 = *(const GAS bf16x8*)(vb_ + voff); s_v1 = *(const GAS bf16x8*)(vb_ + 32 * 4096 + voff); \
    s_k0 = *(const GAS bf16x8*)(nb_ + voff); s_k1 = *(const GAS bf16x8*)(nb_ + 32 * 4096 + voff); \
    s_kr = *(const GAS bf16x8*)(rb_ + kroff); } while (0)
#define SWRITE(bf) do { *(LAS bf16x8*)(V_lds + (bf) * SHM_V + vst0) = s_v0; *(LAS bf16x8*)(V_lds + (bf) * SHM_V + vst1) = s_v1; const int kc_ = sc * 2; \
    *(LAS bf16x8*)(Kn_lds + (bf) * SHM_KN + KSWZ(sr, kc_)) = s_k0; *(LAS bf16x8*)(Kn_lds + (bf) * SHM_KN + KSWZ(32 + sr, kc_)) = s_k1; \
    *(LAS bf16x8*)(Kr_lds + (bf) * SHM_KR + KRSWZ(krr, krc * 2)) = s_kr; } while (0)
#define SWAIT() asm volatile("s_waitcnt vmcnt(0)" ::: "memory")
#define RESC(a) do { if (__any((a) < 1.f)) { if (hi == 0) al_l[r32] = (a); asm volatile("s_waitcnt lgkmcnt(0)" ::: "memory"); \
    _Pragma("unroll") for (int d = 0; d < 4; ++d) _Pragma("unroll") for (int r = 0; r < 16; ++r) o[d][r] *= al_l[crow(r, hi)]; } } while (0)
  f32x16 pA0, pA1, pB0, pB1; float mnA, mnB, alA, alB; bf16x8 pa0, pa1, pa2, pa3;
  SLOAD(0); SWAIT(); SWRITE(0); __syncthreads();
  qkt(pA0, pA1, Kn_lds, Kr_lds, qr, qrp, kb, krb);
  { const float NEG = -INFINITY;
#pragma unroll
    for (int r = 8; r < 16; ++r) pA0[r] = NEG;
#pragma unroll
    for (int r = 0; r < 16; ++r) pA1[r] = NEG; }
  partialSM(pA0, pA1, m_reg, mnA, alA, C, THRS);
  SLOAD(1); SWAIT(); SWRITE(1); __syncthreads();
  for (int j = 1; j + 1 < NT; j += 2) {
    SBAR(); qkt(pB0, pB1, Kn_lds + SHM_KN, Kr_lds + SHM_KR, qr, qrp, kb, krb);
    finishSM(pA0, pA1, alA, l_reg, pa0, pa1, pa2, pa3); SBAR();
    SLOAD(j + 1); SBAR();
    pv_d0(o, vb0, pa0, pa1, pa2, pa3); partialSM(pB0, pB1, m_reg, mnB, alB, C, THRS);
    __syncthreads(); SWAIT(); SWRITE(0);
    RESC(alB); __syncthreads();
    SBAR(); qkt(pA0, pA1, Kn_lds, Kr_lds, qr, qrp, kb, krb);
    finishSM(pB0, pB1, alB, l_reg, pa0, pa1, pa2, pa3); SBAR();
    if (j + 2 < NT) SLOAD(j + 2); SBAR();
    pv_d0(o, vb0 + SHM_V, pa0, pa1, pa2, pa3); partialSM(pA0, pA1, m_reg, mnA, alA, C, THRS);
    __syncthreads(); if (j + 2 < NT) { SWAIT(); SWRITE(1); }
    RESC(alA); __syncthreads();
  }
  finishSM(pA0, pA1, alA, l_reg, pa0, pa1, pa2, pa3); SBAR();
  pv_d0(o, vb0, pa0, pa1, pa2, pa3);
  if (hi == 0) li_l[r32] = l_reg; asm volatile("s_waitcnt lgkmcnt(0)" ::: "memory");
  float rli[16];
#pragma unroll
  for (int r = 0; r < 16; ++r) rli[r] = __builtin_amdgcn_rcpf(li_l[crow(r, hi)]);
  unsigned char* Ow = OM + (size_t)(b * SEQ + qb * 256 + wid * QBLK) * 2048 + h * 128;
#pragma unroll
  for (int r = 0; r < 16; ++r) { const int orow = crow(r, hi);
#pragma unroll
    for (int d0 = 0; d0 < 4; ++d0) Ow[(size_t)orow * 2048 + d0 * 32 + r32] = f32_to_fp8(o[d0][r] * rli[r] * 32.f); }
#undef TROW
#undef SLOAD
#undef SWRITE
#undef SWAIT
#undef RESC
}
constexpr int K8S = 208, V8S = 80, SHM8_K = 64 * K8S, SHM8_V = 128 * V8S;
constexpr int OFF8_K = 0, OFF8_V = 2 * SHM8_K, OFF8_WS = OFF8_V + 2 * SHM8_V, MLA8_LDS = OFF8_WS + NW * 64 * 4;
constexpr float MLA8_THR = 1.9f;
typedef int a8_t __attribute__((ext_vector_type(8)));
#define MFMA8(acc_, a_, b_, sa_, sb_) asm volatile("s_nop 1\n\tv_mfma_scale_f32_32x32x64_f8f6f4 %0, %1, %2, %0, %3, %4 op_sel_hi:[0,0,0]" : "+v"(acc_) : "v"(a_), "v"(b_), "v"(sa_), "v"(sb_))
__device__ __forceinline__ a8_t ld_frag8(const LAS char* p) { const u32x4 lo = *(const LAS u32x4*)p, hi = *(const LAS u32x4*)(p + 16); return (a8_t){(int)lo.x, (int)lo.y, (int)lo.z, (int)lo.w, (int)hi.x, (int)hi.y, (int)hi.z, (int)hi.w}; }
__device__ __forceinline__ void qkt8(f32x16& p0, f32x16& p1, const LAS char* Kb, const a8_t& q0, const a8_t& q1, const a8_t& q2, int s1) {
  p0 = f32x16{}; p1 = f32x16{};
  { const a8_t a0 = ld_frag8(Kb), a1 = ld_frag8(Kb + 32 * K8S); MFMA8(p0, a0, q0, s1, s1); MFMA8(p1, a1, q0, s1, s1); }
  { const a8_t a0 = ld_frag8(Kb + 64), a1 = ld_frag8(Kb + 32 * K8S + 64); MFMA8(p0, a0, q1, s1, s1); MFMA8(p1, a1, q1, s1, s1); }
  { const a8_t a0 = ld_frag8(Kb + 128), a1 = ld_frag8(Kb + 32 * K8S + 128); MFMA8(p0, a0, q2, s1, s1); MFMA8(p1, a1, q2, s1, s1); }
  asm volatile("s_nop 15\n\ts_nop 15" : "+v"(p0), "+v"(p1));
}
__device__ __forceinline__ void partialSM8(f32x16& p0, f32x16& p1, float& m_reg, float& mn, float& alpha, const float C, const float THRS) {
  float pmax = p0[0];
#pragma unroll
  for (int r = 1; r < 16; ++r) pmax = fmaxf(pmax, p0[r]);
#pragma unroll
  for (int r = 0; r < 16; ++r) pmax = fmaxf(pmax, p1[r]);
  { auto rr = __builtin_amdgcn_permlane32_swap(__float_as_uint(pmax), __float_as_uint(pmax), false, false);
    pmax = fmaxf(__uint_as_float(rr[0]), __uint_as_float(rr[1])); }
  if (__builtin_expect(__all(pmax - m_reg <= THRS), 1)) { mn = m_reg; alpha = 1.f; }
  else { mn = fmaxf(m_reg, pmax); alpha = __builtin_amdgcn_exp2f((m_reg - mn) * C); m_reg = mn; }
  const float mnC = 6.f - mn * C;
#pragma unroll
  for (int r = 0; r < 16; ++r) p0[r] = fmaf(p0[r], C, mnC);
#pragma unroll
  for (int r = 0; r < 16; ++r) p1[r] = fmaf(p1[r], C, mnC);
#pragma unroll
  for (int r = 0; r < 16; ++r) p0[r] = __builtin_amdgcn_exp2f(p0[r]);
}
__device__ __forceinline__ void finishSM8(f32x16& p0, f32x16& p1, float alpha, float& l_reg, a8_t& pf) {
#pragma unroll
  for (int r = 0; r < 16; ++r) p1[r] = __builtin_amdgcn_exp2f(p1[r]);
  float ps = 0;
#pragma unroll
  for (int r = 0; r < 16; ++r) ps += p0[r];
#pragma unroll
  for (int r = 0; r < 16; ++r) ps += p1[r];
  { auto rr = __builtin_amdgcn_permlane32_swap(__float_as_uint(ps), __float_as_uint(ps), false, false);
    ps = __uint_as_float(rr[0]) + __uint_as_float(rr[1]); }
  l_reg = l_reg * alpha + ps;
#pragma unroll
  for (int w = 0; w < 4; ++w) { int x = 0, y = 0;
    x = __builtin_amdgcn_cvt_pk_fp8_f32(p0[4 * w], p0[4 * w + 1], x, false); x = __builtin_amdgcn_cvt_pk_fp8_f32(p0[4 * w + 2], p0[4 * w + 3], x, true);
    y = __builtin_amdgcn_cvt_pk_fp8_f32(p1[4 * w], p1[4 * w + 1], y, false); y = __builtin_amdgcn_cvt_pk_fp8_f32(p1[4 * w + 2], p1[4 * w + 3], y, true);
    pf[w] = x; pf[4 + w] = y; }
}
__device__ __forceinline__ void pv8(f32x16* o, const LAS char* Vb, const a8_t& pf, int sP, int s1) {
  const a8_t b0 = ld_frag8(Vb), b1 = ld_frag8(Vb + 32 * V8S), b2 = ld_frag8(Vb + 64 * V8S), b3 = ld_frag8(Vb + 96 * V8S);
  MFMA8(o[0], pf, b0, sP, s1); MFMA8(o[1], pf, b1, sP, s1); MFMA8(o[2], pf, b2, sP, s1); MFMA8(o[3], pf, b3, sP, s1);
  asm volatile("s_nop 15\n\ts_nop 15" : "+v"(o[0]), "+v"(o[1]), "+v"(o[2]), "+v"(o[3]));
}
__device__ __forceinline__ void mla_unit8(int b, int h, int qb, const unsigned char* __restrict__ QM8, const unsigned char* __restrict__ KN8, const unsigned char* __restrict__ KR8, const unsigned char* __restrict__ VT8,
                                          unsigned char* __restrict__ OM, LAS char* lds) {
  const int tid = threadIdx.x, wid = tid >> 6, lane = tid & 63, r32 = lane & 31, hi = lane >> 5;
  constexpr float C = MLA_SCALE * L2E, THRS = MLA8_THR / MLA_SCALE;
  constexpr int NT = 33;
  LAS char* K_lds = lds + OFF8_K; LAS char* V_lds = lds + OFF8_V;
  LAS float* ws = (LAS float*)(lds + OFF8_WS) + wid * 64; LAS float* li_l = ws; LAS float* al_l = ws + 32;
  int s1 = 0x7f7f7f7f, sP = 0x79797979; asm volatile("" : "+v"(s1), "+v"(sP));
  float m_reg = -1e30f, l_reg = 0; f32x16 o[4] = {};
  const int qrow = b * SEQ + qb * 256 + wid * QBLK + r32;
  a8_t q0, q1, q2;
  { const unsigned char* Qw = QM8 + (size_t)qrow * 3072 + h * 192 + hi * 32;
    const u32x4 a = *(const GAS u32x4*)Qw, bq = *(const GAS u32x4*)(Qw + 16), c = *(const GAS u32x4*)(Qw + 64), d = *(const GAS u32x4*)(Qw + 80), e = *(const GAS u32x4*)(Qw + 128), f = *(const GAS u32x4*)(Qw + 144);
    q0 = (a8_t){(int)a.x, (int)a.y, (int)a.z, (int)a.w, (int)bq.x, (int)bq.y, (int)bq.z, (int)bq.w};
    q1 = (a8_t){(int)c.x, (int)c.y, (int)c.z, (int)c.w, (int)d.x, (int)d.y, (int)d.z, (int)d.w};
    q2 = (a8_t){(int)e.x, (int)e.y, (int)e.z, (int)e.w, (int)f.x, (int)f.y, (int)f.z, (int)f.w}; }
  __syncthreads();
  const int kkey = tid >> 3, kch = tid & 7, rkey = (tid >> 2) & 63, rch = tid & 3, vdim = tid >> 2, vch = tid & 3;
  const LAS char* Kf = K_lds + r32 * K8S + 32 * hi; const LAS char* Vf = V_lds + r32 * V8S + 32 * hi;
  u32x4 s_k, s_r, s_v;
  const int realbase = b * SEQ - KVBLK;
#define TROW(t) ((t) == 0 ? MREAL : realbase + (t) * KVBLK)
#define SLOAD(t) do { const int k0_ = TROW(t); \
    s_k = *(const GAS u32x4*)(KN8 + (size_t)(k0_ + kkey) * 2048 + h * 128 + kch * 16); \
    s_r = *(const GAS u32x4*)(KR8 + (size_t)(k0_ + rkey) * 64 + rch * 16); \
    s_v = *(const GAS u32x4*)(VT8 + (size_t)(h * 128 + vdim) * MPAD + k0_ + vch * 16); } while (0)
#define SWRITE(bf) do { *(LAS u32x4*)(K_lds + (bf) * SHM8_K + kkey * K8S + kch * 16) = s_k; if (tid < 256) *(LAS u32x4*)(K_lds + (bf) * SHM8_K + rkey * K8S + 128 + rch * 16) = s_r; \
    *(LAS u32x4*)(V_lds + (bf) * SHM8_V + vdim * V8S + vch * 16) = s_v; } while (0)
#define SWAIT() asm volatile("s_waitcnt vmcnt(0)" ::: "memory")
#define RESC(a) do { if (__any((a) < 1.f)) { if (hi == 0) al_l[r32] = (a); asm volatile("s_waitcnt lgkmcnt(0)" ::: "memory"); \
    _Pragma("unroll") for (int d = 0; d < 4; ++d) _Pragma("unroll") for (int r = 0; r < 16; ++r) o[d][r] *= al_l[crow(r, hi)]; } } while (0)
  f32x16 pA0, pA1, pB0, pB1; float mnA, mnB, alA, alB; a8_t pf;
  SLOAD(0); SWAIT(); SWRITE(0); __syncthreads();
  qkt8(pA0, pA1, Kf, q0, q1, q2, s1);
  { const float NEG = -INFINITY;
#pragma unroll
    for (int r = 8; r < 16; ++r) pA0[r] = NEG;
#pragma unroll
    for (int r = 0; r < 16; ++r) pA1[r] = NEG; }
  partialSM8(pA0, pA1, m_reg, mnA, alA, C, THRS);
  SLOAD(1); SWAIT(); SWRITE(1); __syncthreads();
  for (int j = 1; j + 1 < NT; j += 2) {
    SBAR(); qkt8(pB0, pB1, Kf + SHM8_K, q0, q1, q2, s1);
    finishSM8(pA0, pA1, alA, l_reg, pf); SBAR();
    SLOAD(j + 1); SBAR();
    pv8(o, Vf, pf, sP, s1); partialSM8(pB0, pB1, m_reg, mnB, alB, C, THRS);
    __syncthreads(); SWAIT(); SWRITE(0);
    RESC(alB); __syncthreads();
    SBAR(); qkt8(pA0, pA1, Kf, q0, q1, q2, s1);
    finishSM8(pB0, pB1, alB, l_reg, pf); SBAR();
    if (j + 2 < NT) SLOAD(j + 2); SBAR();
    pv8(o, Vf + SHM8_V, pf, sP, s1); partialSM8(pA0, pA1, m_reg, mnA, alA, C, THRS);
    __syncthreads(); if (j + 2 < NT) { SWAIT(); SWRITE(1); }
    RESC(alA); __syncthreads();
  }
  finishSM8(pA0, pA1, alA, l_reg, pf); SBAR();
  pv8(o, Vf, pf, sP, s1);
  if (hi == 0) li_l[r32] = l_reg; asm volatile("s_waitcnt lgkmcnt(0)" ::: "memory");
  float rli[16];
#pragma unroll
  for (int r = 0; r < 16; ++r) rli[r] = __builtin_amdgcn_rcpf(li_l[crow(r, hi)]) * (64.f * 32.f);
  unsigned char* Ow = OM + (size_t)(b * SEQ + qb * 256 + wid * QBLK) * 2048 + h * 128;
#pragma unroll
  for (int r = 0; r < 16; ++r) { const int orow = crow(r, hi);
#pragma unroll
    for (int d0 = 0; d0 < 4; ++d0) Ow[(size_t)orow * 2048 + d0 * 32 + r32] = f32_to_fp8(o[d0][r] * rli[r]); }
#undef TROW
#undef SLOAD
#undef SWRITE
#undef SWAIT
#undef RESC
}
__device__ __forceinline__ void na_task(int task, const bf16_t* __restrict__ NAQ, const bf16_t* __restrict__ NAK, const bf16_t* __restrict__ VT, unsigned char* __restrict__ ONA,
                                        const LAS float* relb, const LAS float* metab, LAS float* wsf, int lane, Conv& cv) {
  const int r32 = lane & 31, hi = lane >> 5;
  const int half = task & 1, r = (task >> 1) & 31, h = (task >> 6) & 15, b = task >> 10;
  const int qc = half * 32 + r32;
  const int cs = min(max(qc - 8, 0), 48), rs = min(max(r - 4, 0), 24);
  const int qtok = b * SEQ + r * 64 + qc;
  constexpr float C = L2E, THRS = 8.f, SCALE = 0.125f;
  bf16x8 qr[4];
#pragma unroll
  for (int d0 = 0; d0 < 4; ++d0) qr[d0] = *(const GAS bf16x8*)(NAQ + (size_t)qtok * 1024 + h * 64 + d0 * 16 + hi * 8);
  float m_reg = -1e30f, l_reg = 0.f; f32x16 o[2] = {};
  LAS float* al_l = wsf; LAS float* li_l = wsf + 32;
  const float NEG = -INFINITY;
  const int kb0 = half * 16;
  const unsigned long long wm = 0xFFFFull << (cs - kb0);
  const unsigned mh0 = (unsigned)wm >> (4 * hi), mh1 = (unsigned)(wm >> 32) >> (4 * hi);
  const bf16_t* kq = NAK + (size_t)r32 * 1024 + h * 64 + hi * 8;
  const bf16_t* kq2 = NAK + (size_t)(32 + (r32 & 15)) * 1024 + h * 64 + hi * 8;
  const bf16_t* vq = VT + (size_t)(h * 64 + r32) * VT_PITCH + 8 * hi;
#define NA_KTOK(w) ((w) == 8 ? MREAL : b * SEQ + (rs + (w)) * 64 + kb0)
#define NA_LOADK(KF, w) do { const size_t ko_ = (size_t)NA_KTOK(w) * 1024; _Pragma("unroll") for (int d0 = 0; d0 < 4; ++d0) { KF[d0] = *(const GAS bf16x8*)(kq + ko_ + d0 * 16); KF[4 + d0] = *(const GAS bf16x8*)(kq2 + ko_ + d0 * 16); } } while (0)
#define NA_TILE(KF, w, YN) do { \
    bf16x8 vf[6]; { const bf16_t* vp_ = vq + NA_KTOK(w); _Pragma("unroll") for (int ks = 0; ks < 3; ++ks) { vf[ks] = *(const GAS bf16x8*)(vp_ + 16 * ks); vf[3 + ks] = *(const GAS bf16x8*)(vp_ + (size_t)32 * VT_PITCH + 16 * ks); } } \
    f32x16 p0 = {}, p1 = {}; \
    _Pragma("unroll") for (int d0 = 0; d0 < 4; ++d0) { p0 = __builtin_amdgcn_mfma_f32_32x32x16_bf16(KF[d0], qr[d0], p0, 0, 0, 0); p1 = __builtin_amdgcn_mfma_f32_32x32x16_bf16(KF[4 + d0], qr[d0], p1, 0, 0, 0); } \
    if ((w) + 1 < 9) NA_LOADK(KF, (w) + 1);            \
    asm volatile("" ::: "memory"); if ((cv.tick++ & 1) == 0) conv_step<20>(cv, lane);     \
    if ((w) < 8) { const LAS float* bp_ = relb + ((h * 15 + (rs + (w) - r + 7)) * 31 + 15 - qc + 4 * hi + kb0);     \
      float bv0[16], bv1[8];        \
      _Pragma("unroll") for (int rg = 0; rg < 16; ++rg) { const int c_ = (rg & 3) + 8 * (rg >> 2); bv0[rg] = bp_[c_]; if (rg < 8) bv1[rg] = bp_[c_ + 32]; } \
      _Pragma("unroll") for (int rg = 0; rg < 16; ++rg) { asm volatile("" : "+v"(bv0[rg])); if (rg < 8) asm volatile("" : "+v"(bv1[rg])); } \
      _Pragma("unroll") for (int rg = 0; rg < 16; ++rg) { const int c_ = (rg & 3) + 8 * (rg >> 2); \
        { const bool ok = (mh0 >> c_) & 1u; p0[rg] = ok ? fmaf(p0[rg], SCALE, bv0[rg]) : NEG; } \
        if (rg < 8) { const bool ok = (mh1 >> c_) & 1u; p1[rg] = ok ? fmaf(p1[rg], SCALE, bv1[rg]) : NEG; } } \
    } else { const LAS float* bp = metab + h * 16; \
      _Pragma("unroll") for (int rg = 0; rg < 16; ++rg) { const int kc = crow(rg, hi); p0[rg] = (rg < 8) ? fmaf(p0[rg], SCALE, bp[kc & 15]) : NEG; if (rg < 8) p1[rg] = NEG; } } \
      \
    float pmax = p0[0]; \
    _Pragma("unroll") for (int rg = 1; rg < 16; ++rg) pmax = fmaxf(pmax, p0[rg]); \
    _Pragma("unroll") for (int rg = 0; rg < 8; ++rg) pmax = fmaxf(pmax, p1[rg]); \
    { auto rr = __builtin_amdgcn_permlane32_swap(__float_as_uint(pmax), __float_as_uint(pmax), false, false); pmax = fmaxf(__uint_as_float(rr[0]), __uint_as_float(rr[1])); } \
    float mn, alpha; \
    if (__builtin_expect(__all(pmax - m_reg <= THRS), 1)) { mn = m_reg; alpha = 1.f; } \
    else { mn = fmaxf(m_reg, pmax); alpha = __builtin_amdgcn_exp2f((m_reg - mn) * C); m_reg = mn; } \
    const float mnC = -mn * C; float ps = 0.f; \
    _Pragma("unroll") for (int rg = 0; rg < 16; ++rg) { p0[rg] = __builtin_amdgcn_exp2f(fmaf(p0[rg], C, mnC)); ps += p0[rg]; } \
    _Pragma("unroll") for (int rg = 0; rg < 8; ++rg) { p1[rg] = __builtin_amdgcn_exp2f(fmaf(p1[rg], C, mnC)); ps += p1[rg]; } \
    { auto rr = __builtin_amdgcn_permlane32_swap(__float_as_uint(ps), __float_as_uint(ps), false, false); ps = __uint_as_float(rr[0]) + __uint_as_float(rr[1]); } \
    l_reg = l_reg * alpha + ps; \
    bf16x8 pa0, pa1, pa2; NA_PK4(p0, 0, pa0); NA_PK4(p0, 8, pa1); NA_PK4(p1, 0, pa2); \
    if (__any(alpha < 1.f)) { if (hi == 0) al_l[r32] = alpha; asm volatile("s_waitcnt lgkmcnt(0)" ::: "memory"); \
      _Pragma("unroll") for (int d = 0; d < 2; ++d) _Pragma("unroll") for (int rg = 0; rg < 16; ++rg) o[d][rg] *= al_l[crow(rg, hi)]; } \
    _Pragma("unroll") for (int d0 = 0; d0 < 2; ++d0) { \
      o[d0] = __builtin_amdgcn_mfma_f32_32x32x16_bf16(pa0, vf[3 * d0 + 0], o[d0], 0, 0, 0); o[d0] = __builtin_amdgcn_mfma_f32_32x32x16_bf16(pa1, vf[3 * d0 + 1], o[d0], 0, 0, 0); \
      o[d0] = __builtin_amdgcn_mfma_f32_32x32x16_bf16(pa2, vf[3 * d0 + 2], o[d0], 0, 0, 0); } } while (0)
#define NA_PK4(P, BASE, OUT) do { unsigned a0 = cvt_pk_bf16(P[BASE + 0], P[BASE + 1]), a1 = cvt_pk_bf16(P[BASE + 2], P[BASE + 3]);   \
    unsigned b0 = cvt_pk_bf16(P[BASE + 4], P[BASE + 5]), b1 = cvt_pk_bf16(P[BASE + 6], P[BASE + 7]);                              \
    auto r0 = __builtin_amdgcn_permlane32_swap(a0, b0, false, false); auto r1 = __builtin_amdgcn_permlane32_swap(a1, b1, false, false); \
    u32x4 w_ = {r0[0], r1[0], r0[1], r1[1]}; OUT = __builtin_bit_cast(bf16x8, w_); } while (0)
  { bf16x8 kA[8];
    NA_LOADK(kA, 0);
#pragma unroll 1
    for (int w = 0; w < 8; ++w) { NA_TILE(kA, w, 14); }
    NA_TILE(kA, 8, 6); }
#undef NA_PK4
#undef NA_KTOK
#undef NA_LOADK
#undef NA_TILE
  if (hi == 0) li_l[r32] = l_reg; asm volatile("s_waitcnt lgkmcnt(0)" ::: "memory");
  unsigned char* Ow = ONA + (size_t)(b * SEQ + r * 64 + half * 32) * 1024 + h * 64;
#pragma unroll
  for (int rg = 0; rg < 16; ++rg) { const int orow = crow(rg, hi); const float rl = __builtin_amdgcn_rcpf(li_l[orow]);
#pragma unroll
    for (int d0 = 0; d0 < 2; ++d0) Ow[(size_t)orow * 1024 + d0 * 32 + r32] = f32_to_fp8(o[d0][rg] * rl * 16.f); }
  asm volatile("s_waitcnt lgkmcnt(0)" ::: "memory");
}
}
namespace peer {
constexpr int CH = 32;
constexpr int OFF_TV = 0, OFF_TI = OFF_TV + CH * 16 * 16 * 4, OFF_SE = OFF_TI + CH * 16 * 16 * 4, OFF_SG = OFF_SE + CH * 128 * 4, OFF_SE2 = OFF_SG + CH * 128 * 4, OFF_SG2 = OFF_SE2 + CH * 128 * 4, PEER_LDS = OFF_SG2 + CH * 128 * 4;
static_assert(PEER_LDS <= RING_BYTES, "PEER LDS");
__device__ __forceinline__ float gelu_tanh(float x) {
    const float u = 0.7978845608028654f * (x + 0.044715f * x * x * x);
    const float e = __builtin_amdgcn_exp2f(-2.f * 1.4426950408889634f * fabsf(u));
    const float t = (1.f - e) * __builtin_amdgcn_rcpf(1.f + e);
    return 0.5f * x * (1.f + (u < 0.f ? -t : t));
}
__device__ __forceinline__ void fmac1(float& acc, float a, float b) { asm("v_fmac_f32_e32 %0, %1, %2" : "+v"(acc) : "v"(a), "v"(b)); }
#define PEER_INSERT(x_, xi_) do { float x__ = (x_); int xi__ = (xi_); \
    _Pragma("unroll") for (int j_ = 0; j_ < 16; ++j_) { const bool gt_ = x__ > tv[j_]; const float tvo_ = tv[j_]; const int tio_ = ti[j_]; \
        tv[j_] = gt_ ? x__ : tvo_; ti[j_] = gt_ ? xi__ : tio_; x__ = gt_ ? tvo_ : x__; xi__ = gt_ ? tio_ : xi__; } } while (0)

#define PEER_AUX 0
typedef __amdgpu_buffer_rsrc_t rsrc_t;
__device__ __forceinline__ rsrc_t mk_rsrc(const void* p, unsigned bytes) { return __builtin_amdgcn_make_buffer_rsrc((void*)p, 0, bytes, 0x00020000); }
__device__ __forceinline__ u32x4 ldb128(rsrc_t r, unsigned off) { return __builtin_amdgcn_raw_buffer_load_b128(r, off, 0, PEER_AUX); }
typedef unsigned v6u_t __attribute__((ext_vector_type(6)));
typedef float v32f_t __attribute__((ext_vector_type(32)));
typedef float v16f_t __attribute__((ext_vector_type(16)));
__device__ __forceinline__ u32x2 ldb64(rsrc_t r, unsigned off) { return __builtin_amdgcn_raw_buffer_load_b64(r, off, 0, PEER_AUX); }
__device__ __forceinline__ f32x4 ldf128(rsrc_t r, unsigned off) { return __builtin_bit_cast(f32x4, __builtin_amdgcn_raw_buffer_load_b128(r, off, 0, PEER_AUX)); }
__device__ __forceinline__ f32x4 ldf128_nt(rsrc_t r, unsigned off) { return __builtin_bit_cast(f32x4, __builtin_amdgcn_raw_buffer_load_b128(r, off, 0, 2)); }
__device__ __forceinline__ void peer_select(int chunk, const _Float16* __restrict__ SC, LAS char* lds, int tid, LAS int* SE, LAS float* SG) {
    LAS float* TV = (LAS float*)(lds + OFF_TV); LAS int* TI = (LAS int*)(lds + OFF_TI);
    asm volatile("" : "+v"(tid));
    const int tok0 = chunk * CH;
    const rsrc_t rSC = mk_rsrc(SC, 0x4000000u);
    __syncthreads();
    { const int tl = tid >> 4, g = tid & 15; const unsigned spo = ((unsigned)(tok0 + tl) * 2048u + (unsigned)g * 128u) * 2u;
      int tk[16];
#pragma unroll
      for (int j = 0; j < 16; ++j) tk[j] = (int)0x80000000;
#define PEER_KEY(x_, lowbits_, mask_) ({ const int f_ = __float_as_int(x_); ((f_ ^ ((f_ >> 31) & 0x7fffffff)) & ~(mask_)) | (lowbits_); })
#define PEER_INS(key_) do { int x__ = (key_); _Pragma("unroll") for (int j_ = 0; j_ < 16; ++j_) { const int hi_ = max(x__, tk[j_]); x__ = min(x__, tk[j_]); tk[j_] = hi_; } } while (0)
      typedef _Float16 h8_t __attribute__((ext_vector_type(8)));
#define PEER_CX(a_, b_) do { const int hi_ = max(a_, b_), lo_ = min(a_, b_); a_ = hi_; b_ = lo_; } while (0)
      u32x4 na = __builtin_amdgcn_raw_buffer_load_b128(rSC, spo, 0, 2), nb = __builtin_amdgcn_raw_buffer_load_b128(rSC, spo + 16, 0, 2);
#pragma unroll 1
      for (int i = 0; i < 16; i += 2) { const h8_t a = __builtin_bit_cast(h8_t, na), b = __builtin_bit_cast(h8_t, nb);
          { const unsigned on = spo + (unsigned)min(i + 2, 14) * 16u; na = __builtin_amdgcn_raw_buffer_load_b128(rSC, on, 0, 2); nb = __builtin_amdgcn_raw_buffer_load_b128(rSC, on + 16, 0, 2); }
          int kk[16];
#pragma unroll
          for (int e = 0; e < 8; ++e) { kk[e] = PEER_KEY((float)a[e], 127 - (8 * i + e), 127); kk[8 + e] = PEER_KEY((float)b[e], 127 - (8 * i + 8 + e), 127); }
          PEER_CX(kk[0], kk[13]); PEER_CX(kk[1], kk[12]); PEER_CX(kk[2], kk[15]); PEER_CX(kk[3], kk[14]); PEER_CX(kk[4], kk[8]); PEER_CX(kk[5], kk[6]); PEER_CX(kk[7], kk[11]); PEER_CX(kk[9], kk[10]); PEER_CX(kk[0], kk[5]); PEER_CX(kk[1], kk[7]); PEER_CX(kk[2], kk[9]); PEER_CX(kk[3], kk[4]); PEER_CX(kk[6], kk[13]); PEER_CX(kk[8], kk[14]); PEER_CX(kk[10], kk[15]); PEER_CX(kk[11], kk[12]); PEER_CX(kk[0], kk[1]); PEER_CX(kk[2], kk[3]); PEER_CX(kk[4], kk[5]); PEER_CX(kk[6], kk[8]); PEER_CX(kk[7], kk[9]); PEER_CX(kk[10], kk[11]); PEER_CX(kk[12], kk[13]); PEER_CX(kk[14], kk[15]); PEER_CX(kk[0], kk[2]); PEER_CX(kk[1], kk[3]); PEER_CX(kk[4], kk[10]); PEER_CX(kk[5], kk[11]); PEER_CX(kk[6], kk[7]); PEER_CX(kk[8], kk[9]); PEER_CX(kk[12], kk[14]); PEER_CX(kk[13], kk[15]); PEER_CX(kk[1], kk[2]); PEER_CX(kk[3], kk[12]); PEER_CX(kk[4], kk[6]); PEER_CX(kk[5], kk[7]); PEER_CX(kk[8], kk[10]); PEER_CX(kk[9], kk[11]); PEER_CX(kk[13], kk[14]); PEER_CX(kk[1], kk[4]); PEER_CX(kk[2], kk[6]); PEER_CX(kk[5], kk[8]); PEER_CX(kk[7], kk[10]); PEER_CX(kk[9], kk[13]); PEER_CX(kk[11], kk[14]); PEER_CX(kk[2], kk[4]); PEER_CX(kk[3], kk[6]); PEER_CX(kk[9], kk[12]); PEER_CX(kk[11], kk[13]); PEER_CX(kk[3], kk[5]); PEER_CX(kk[6], kk[8]); PEER_CX(kk[7], kk[9]); PEER_CX(kk[10], kk[12]); PEER_CX(kk[3], kk[4]); PEER_CX(kk[5], kk[6]); PEER_CX(kk[7], kk[8]); PEER_CX(kk[9], kk[10]); PEER_CX(kk[11], kk[12]); PEER_CX(kk[6], kk[7]); PEER_CX(kk[8], kk[9]);
#pragma unroll
          for (int e = 0; e < 16; ++e) tk[e] = max(tk[e], kk[15 - e]);
          PEER_CX(tk[0], tk[8]); PEER_CX(tk[1], tk[9]); PEER_CX(tk[2], tk[10]); PEER_CX(tk[3], tk[11]); PEER_CX(tk[4], tk[12]); PEER_CX(tk[5], tk[13]); PEER_CX(tk[6], tk[14]); PEER_CX(tk[7], tk[15]); PEER_CX(tk[0], tk[4]); PEER_CX(tk[1], tk[5]); PEER_CX(tk[2], tk[6]); PEER_CX(tk[3], tk[7]); PEER_CX(tk[8], tk[12]); PEER_CX(tk[9], tk[13]); PEER_CX(tk[10], tk[14]); PEER_CX(tk[11], tk[15]); PEER_CX(tk[0], tk[2]); PEER_CX(tk[1], tk[3]); PEER_CX(tk[4], tk[6]); PEER_CX(tk[5], tk[7]); PEER_CX(tk[8], tk[10]); PEER_CX(tk[9], tk[11]); PEER_CX(tk[12], tk[14]); PEER_CX(tk[13], tk[15]); PEER_CX(tk[0], tk[1]); PEER_CX(tk[2], tk[3]); PEER_CX(tk[4], tk[5]); PEER_CX(tk[6], tk[7]); PEER_CX(tk[8], tk[9]); PEER_CX(tk[10], tk[11]); PEER_CX(tk[12], tk[13]); PEER_CX(tk[14], tk[15]); }
#undef PEER_CX
      LAS float* tvp = TV + (tl * 16 + g) * 16; LAS int* tip = TI + (tl * 16 + g) * 16;
#pragma unroll
      for (int j = 0; j < 16; ++j) { const int k_ = tk[j] & ~127; tvp[j] = __int_as_float(k_ ^ ((k_ >> 31) & 0x7fffffff)); tip[j] = 127 - (tk[j] & 127); } }
    __syncthreads();
    asm volatile("" : "+v"(tid));
    { const int tl = tid >> 4, hh = (tid >> 1) & 7, half = tid & 1;
      const LAS float* s1 = TV + (tl * 16 + 2 * hh) * 16; const LAS float* s2 = s1 + 16; const LAS int* i1 = TI + (tl * 16 + 2 * hh) * 16; const LAS int* i2 = i1 + 16;
      float b2[16];
#pragma unroll
      for (int j = 0; j < 16; ++j) b2[j] = s2[j];
      int tk[16];
#pragma unroll
      for (int j = 0; j < 16; ++j) tk[j] = (int)0x80000000;
#pragma unroll
      for (int ii = 0; ii < 8; ++ii) { const int i = 2 * ii + half; const float a = s1[i];
#pragma unroll
          for (int j = 0; j < 16; ++j) if ((2 * ii + 1) * (j + 1) <= 16) { if (half == 0 || (2 * ii + 2) * (j + 1) <= 16) PEER_INS(PEER_KEY(a + b2[j], 255 - (i * 16 + j), 255)); } }
      { int pk[16];
#pragma unroll
        for (int j = 0; j < 16; ++j) pk[j] = __shfl_xor(tk[j], 1);
#pragma unroll
        for (int j = 0; j < 16; ++j) PEER_INS(pk[j]); }
      if (half == 0) { float e[16], sum = 0.f; const int k0_ = tk[0] & ~255; const float v0 = __int_as_float(k0_ ^ ((k0_ >> 31) & 0x7fffffff));
#pragma unroll
        for (int j = 0; j < 16; ++j) { const int k_ = tk[j] & ~255; const float vj = __int_as_float(k_ ^ ((k_ >> 31) & 0x7fffffff)); e[j] = __builtin_amdgcn_exp2f((vj - v0) * 1.4426950408889634f); sum += e[j]; }
        const float inv = 1.0f / sum;
#pragma unroll
        for (int j = 0; j < 16; ++j) { const int ci = 255 - (tk[j] & 255); SE[tl * 128 + hh * 16 + j] = i1[ci >> 4] * 128 + i2[ci & 15]; SG[tl * 128 + hh * 16 + j] = e[j] * inv; } } }
#undef PEER_KEY
#undef PEER_INS
    __syncthreads();
}
__device__ __forceinline__ void peer_gather(int chunk, const bf16_t* __restrict__ H2, const unsigned char* __restrict__ U, const unsigned char* __restrict__ V,
                                            const float* __restrict__ g2, const float* __restrict__ gf, float* OUT, int tid, const LAS int* SE, const LAS float* SG) {
    asm volatile("" : "+v"(tid));
    const int tok0 = chunk * CH, lane = tid & 63, wave = tid >> 6;
    const rsrc_t rH2 = mk_rsrc(H2, 0x4000000u), rU = mk_rsrc(U, 0x1800000u), rV = mk_rsrc(V, 0x1800000u), rG2 = mk_rsrc(g2, 8192u), rGF = mk_rsrc(gf, 8192u);
#pragma unroll 1
    for (int tt = 0; tt < CH / NWAVES; ++tt) { const int tl = wave * (CH / NWAVES) + tt, tok = tok0 + tl;
      asm volatile("" ::: "memory");
      float hn[32], acc[32]; float ss = 0.f;
#pragma unroll
      for (int j = 0; j < 2; ++j)
#pragma unroll
          for (int q = 0; q < 4; ++q) { const u32x2 w = ldb64(rH2, ((unsigned)tok * 2048u + 256u * (4 * j + q) + 4u * lane) * 2u);
              const f32x4 a = (f32x4){__uint_as_float(w.x << 16), __uint_as_float(w.x & 0xffff0000u), __uint_as_float(w.y << 16), __uint_as_float(w.y & 0xffff0000u)};
#pragma unroll
              for (int i = 0; i < 4; ++i) { hn[16 * j + 4 * q + i] = a[i]; ss += a[i] * a[i]; } }
      const float rstd = 1.0f / sqrtf(wave_sum(ss) * (1.f / 2048.f) + NORM_EPS);
#pragma unroll
      for (int j = 0; j < 2; ++j)
#pragma unroll
          for (int q = 0; q < 4; ++q) { const f32x4 a = ldf128(rG2, (256u * (4 * j + q) + 4u * lane) * 4u);
#pragma unroll
              for (int i = 0; i < 4; ++i) hn[16 * j + 4 * q + i] *= rstd * a[i]; }
#pragma unroll
      for (int i = 0; i < 32; ++i) acc[i] = 0.f;
#define NX 4
#define PEER_LOAD(S, kb) do { _Pragma("unroll") for (int x = 0; x < NX; ++x) { const unsigned o = (unsigned)SE[tl * 128 + (kb) + x] * 1536u; \
          S##ua[x] = ldb128(rU, o + (unsigned)lane * 16u); S##ub[x] = ldb64(rU, o + 1024u + (unsigned)lane * 8u); S##va[x] = ldb128(rV, o + (unsigned)lane * 16u); S##vb[x] = ldb64(rV, o + 1024u + (unsigned)lane * 8u); } } while (0)
#define PEER_DEC(A, B) ({ v32f_t r_ = __builtin_amdgcn_cvt_scalef32_pk32_f32_fp6((v6u_t){A.x, A.y, A.z, A.w, B.x, B.y}, 1.0f); asm volatile("s_nop 1" : "+v"(r_)); r_; })
#define PEER_COMPUTE(S, kb) do { float d[NX]; \
          _Pragma("unroll") for (int x = 0; x < NX; ++x) { const v32f_t r = PEER_DEC(S##ua[x], S##ub[x]); float dd = 0.f; \
              _Pragma("unroll") for (int i = 0; i < 32; ++i) fmac1(dd, hn[i], r[i]); \
              d[x] = dd; } \
          _Pragma("unroll") for (int o = 1; o < 64; o <<= 1) { _Pragma("unroll") for (int x = 0; x < NX; ++x) d[x] += __shfl_xor(d[x], o); } \
          float c[NX]; \
          _Pragma("unroll") for (int x = 0; x < NX; ++x) c[x] = SG[tl * 128 + (kb) + x] * gelu_tanh(d[x] * (1.f / 64.f)) * 0.25f; \
          _Pragma("unroll") for (int x = 0; x < NX; ++x) { const v32f_t r = PEER_DEC(S##va[x], S##vb[x]); \
              _Pragma("unroll") for (int i = 0; i < 32; ++i) fmac1(acc[i], c[x], r[i]); } } while (0)
      { u32x4 Aua[NX], Ava[NX], Bua[NX], Bva[NX]; u32x2 Aub[NX], Avb[NX], Bub[NX], Bvb[NX];
        PEER_LOAD(A, 0);
#pragma unroll 1
        for (int k = 0; k < 128; k += 2 * NX) {
            PEER_LOAD(B, k + NX); PEER_COMPUTE(A, k);
            { const int kn = min(k + 2 * NX, 128 - NX); PEER_LOAD(A, kn); }
            PEER_COMPUTE(B, k + NX);
        } }
#undef PEER_DEC
#undef NX
#undef PEER_LOAD
#undef PEER_COMPUTE
      asm volatile("" ::: "memory");
      int tok2 = tok, lane2 = lane; asm volatile("" : "+v"(tok2), "+v"(lane2));
      float s2 = 0.f;
#pragma unroll
      for (int j = 0; j < 2; ++j)
#pragma unroll
          for (int q = 0; q < 4; ++q) { const u32x2 w = ldb64(rH2, ((unsigned)tok2 * 2048u + 256u * (4 * j + q) + 4u * lane2) * 2u);
              const f32x4 a = (f32x4){__uint_as_float(w.x << 16), __uint_as_float(w.x & 0xffff0000u), __uint_as_float(w.y << 16), __uint_as_float(w.y & 0xffff0000u)};
#pragma unroll
              for (int i = 0; i < 4; ++i) { acc[16 * j + 4 * q + i] += a[i]; s2 += acc[16 * j + 4 * q + i] * acc[16 * j + 4 * q + i]; } }
      const float rf = 1.0f / sqrtf(wave_sum(s2) * (1.f / 2048.f) + NORM_EPS);
#pragma unroll
      for (int j = 0; j < 2; ++j)
#pragma unroll
          for (int q = 0; q < 4; ++q) { const f32x4 a = ldf128(rGF, (256u * (4 * j + q) + 4u * lane2) * 4u); f32x4 oa;
#pragma unroll
              for (int i = 0; i < 4; ++i) oa[i] = acc[16 * j + 4 * q + i] * rf * a[i];
              float* op = OUT + (size_t)tok2 * 2048 + 256 * (4 * j + q) + 4 * lane2;
              __builtin_nontemporal_store(oa, (GAS f32x4*)op); }
    }
}
}
#ifndef MK_N_LAUNCHES
#define MK_N_LAUNCHES 1
#endif
#define MK_PROBE_PH -1
#define MK_PROBE_DIV 2
constexpr int N_PHASES = 9;
constexpr int N_LAUNCHES = MK_N_LAUNCHES;
struct Args { const float* in[19]; float* out; unsigned char* ws; int ph_lo, ph_hi; };
static_assert(sizeof(Args) == 19 * 8 + 8 + 8 + 8, "no padding");

__global__ void __launch_bounds__(NWAVES * 64, 2) hybrid_fwd(Args args) {
    extern __shared__ __attribute__((aligned(16))) unsigned char lds_raw[];
    Frame F;
    F.lds = (LAS unsigned char*)lds_raw;
    F.MISC = (volatile LAS unsigned*)(F.lds + MISC_OFF);
    F.tid = threadIdx.x; F.lane = F.tid & 63; F.wave = __builtin_amdgcn_readfirstlane(F.tid >> 6);
    F.G = gridDim.x; { const int bx = blockIdx.x; F.vcu = (F.G % 8 == 0) ? (bx % 8) * (F.G / 8) + bx / 8 : bx; }
    F.ws = args.ws; F.out = args.out;
#pragma unroll
    for (int i = 0; i < 19; ++i) F.in[i] = args.in[i];
    for (int u = F.tid; u < (LDS_BYTES - LDSCTL_OFF) / 4; u += NWAVES * 64) ((LAS unsigned*)(F.lds + LDSCTL_OFF))[u] = 0u;
    __syncthreads();
    XcdBarrier bar; bar.bar = (unsigned*)(F.ws + WS_CTL) + CW_BAR; bar.x = 0; bar.st = nullptr;
    if (N_LAUNCHES == 1) bar = xcd_barrier_post((unsigned*)(F.ws + WS_CTL) + CW_BAR, F.MISC + 8);
    const int lo = args.ph_lo, hi = args.ph_hi;
#define IN(k) (lo <= (k) && (k) < hi)
#if MK_PROBE_PH >= 0
    unsigned long long tp0 = (MK_PROBE_PH == 0 || MK_PROBE_PH == 9) ? __builtin_amdgcn_s_memrealtime() : 0ull, tp1 = 0ull;
#define SEAM(k) do { if (IN(k) && IN((k) + 1)) xcd_barrier(bar); if (MK_PROBE_PH == (k)) tp1 = __builtin_amdgcn_s_memrealtime(); if (MK_PROBE_PH == (k) + 1) tp0 = __builtin_amdgcn_s_memrealtime(); } while (0)
#else
#define SEAM(k) do { if (IN(k) && IN((k) + 1)) xcd_barrier(bar); } while (0)
#endif
    const size_t T2048 = (size_t)256 * 2048 * 2, T1024 = (size_t)256 * 1024 * 2, T512 = (size_t)256 * 512 * 2;
    float* cosT = WSP(float, WS_COS); float* sinT = WSP(float, WS_SIN);
    float* ssq_q = WSP(float, WS_SSQ_Q); float* ssq_kv = WSP(float, WS_SSQ_KV); float* ssq2 = WSP(float, WS_SSQ_2);

    if (IN(0)) { p0_prologue<0>(F, F.vcu, F.G); } SEAM(0);
    if (IN(1)) {
        SchedP1 S{F.G, (int)blockIdx.x, (const char*)(F.ws + WS_HN1), (const char*)(F.ws + WS_WIN), (const char*)(F.ws + WS_WVT), T1024};
        EpiP1 E{WSP(bf16_t, WS_NAQ), WSP(bf16_t, WS_NAK), WSP(bf16_t, WS_VT), WSP(unsigned char, WS_CQ), WSP(unsigned char, WS_CKV), WSP(unsigned char, WS_KR), WSP(unsigned char, WS_GA), WSP(unsigned char, WS_GB), ssq_q, ssq_kv, cosT, sinT};
        pg8::gemm_phase<EpiP1, SchedP1, true, -6>(F.lds, 2048, S, E);
        { const int extra = P1_UNITS % F.G, bx = (int)blockIdx.x; if (extra != 0 && bx >= extra) p0_prologue<1>(F, bx - extra, F.G - extra); else if (extra == 0) p0_prologue<1>(F, bx, F.G); }
    } SEAM(1);
    if (IN(2)) {
        LAS float* relb = (LAS float*)F.lds + 64; LAS float* metab = relb + 16 * 15 * 31 + 128; LAS float* wsf = metab + 256 + F.wave * 64;
        for (int i = F.tid; i < 16 * 15 * 31; i += NWAVES * 64) relb[i] = F.in[4][i];
        if (F.tid < 256) metab[F.tid] = F.in[5][F.tid];
        __syncthreads();
        const int gw = F.vcu * NWAVES + F.wave, NGW = F.G * NWAVES;
        Conv cv{F.in[16], F.in[17], WSP(unsigned char, WS_U), WSP(unsigned char, WS_V), F.lds + 65536 + F.wave * 8192, gw, NGW, 2 * 16384, -1, 0};
        for (int task = gw; task < NBATCH * 16 * 32 * 2; task += NGW)
            att::na_task(task, WSP(bf16_t, WS_NAQ), WSP(bf16_t, WS_NAK), WSP(bf16_t, WS_VT), WSP(unsigned char, WS_ONA), relb, metab, wsf, F.lane, cv);
        while (cv.pend >= 0 || cv.next < cv.end) conv_step<0>(cv, F.lane);
        __syncthreads();
    } SEAM(2);
    if (IN(3)) {
        SchedP3 S{F.G, (int)blockIdx.x, (const char*)F.ws, T512 / 2};
        EpiP3 E{WSP(unsigned char, WS_QM), WSP(unsigned char, WS_KN), WSP(unsigned char, WS_VV), ssq_q, ssq_kv, cosT, sinT};
        pg8::gemm_phase<EpiP3, SchedP3, true, -4>(F.lds, 512, S, E);
    } SEAM(3);
    if (IN(4)) {
        for (int id = F.vcu; id < NBATCH * 16 * 8; id += F.G) { const int bh = id >> 3, qb = id & 7;
            att::mla_unit8(bh >> 4, bh & 15, qb, WSP(unsigned char, WS_QM), WSP(unsigned char, WS_KN), WSP(unsigned char, WS_KR), WSP(unsigned char, WS_VV), WSP(unsigned char, WS_OMLA), (LAS char*)F.lds); }
        __syncthreads();
    } SEAM(4);
    if (IN(5)) {
        { SchedGrid S{F.G, (int)blockIdx.x, 64, 8, (const char*)(F.ws + WS_ONA), (const char*)(F.ws + WS_WNA), T512};
          EpiP5a E{WSP(unsigned char, WS_GA), WSP(unsigned char, WS_T1)};
          pg8::gemm_phase<EpiP5a, SchedGrid, true, -9>(F.lds, 1024, S, E); }
        { SchedGrid S{F.G, (int)blockIdx.x, 64, 8, (const char*)(F.ws + WS_OMLA), (const char*)(F.ws + WS_WMLA), T1024};
          EpiP5b E{WSP(unsigned char, WS_GB), WSP(unsigned char, WS_T1), WSP(unsigned char, WS_MERGED)};
          pg8::gemm_phase<EpiP5b, SchedGrid, true, -11>(F.lds, 2048, S, E); }
    } SEAM(5);
    if (IN(6)) {
        { SchedGrid S{F.G, (int)blockIdx.x, 64, 8, (const char*)(F.ws + WS_MERGED), (const char*)(F.ws + WS_WOUT), T1024};
          EpiP6 E{F.in[0], WSP(bf16_t, WS_H2B), ssq2};
          pg8::gemm_phase<EpiP6, SchedGrid, true, -11>(F.lds, 2048, S, E); }
    } SEAM(6);
    if (IN(7)) {
        SchedGrid S{F.G, (int)blockIdx.x, 64, 8, (const char*)(F.ws + WS_H2B), (const char*)(F.ws + WS_WSC), T2048};
        EpiP7 E{ssq2, WSP(_Float16, WS_SC)};
        pg8::gemm_phase<EpiP7, SchedGrid>(F.lds, 2048, S, E);
    } SEAM(7);
    if (IN(8)) {
        const int nch = (MREAL / peer::CH - F.vcu + F.G - 1) / F.G; const bool both_first = (nch == 2) && (F.vcu & 1);
        for (int op = 0; op < 2 * nch; ++op) {
            const bool sel = both_first ? (op < 2) : !(op & 1); const int ci = both_first ? (op & 1) : (op >> 1), chunk = F.vcu + ci * F.G;
            const int b2 = both_first ? ci : 0;
            LAS int* SE = (LAS int*)(F.lds + (b2 ? peer::OFF_SE2 : peer::OFF_SE)); LAS float* SG = (LAS float*)(F.lds + (b2 ? peer::OFF_SG2 : peer::OFF_SG));
            if (sel) peer::peer_select(chunk, WSP(_Float16, WS_SC), (LAS char*)F.lds, F.tid, SE, SG);
            else peer::peer_gather(chunk, WSP(bf16_t, WS_H2B), WSP(unsigned char, WS_U), WSP(unsigned char, WS_V), F.in[13], F.in[18], F.out, F.tid, SE, SG); }
    }
#if MK_PROBE_PH >= 0
    xcd_barrier(bar); tp1 = (MK_PROBE_PH >= 8) ? __builtin_amdgcn_s_memrealtime() : tp1;
    if (blockIdx.x == 0 && F.tid == 0) F.out[0] = (float)(tp1 - tp0) * (0.01f / MK_PROBE_DIV);
#endif
#undef IN
#undef SEAM
}

extern "C" void kernel_launch(void* const* d_in, const int* in_sizes, int n_in, void* d_out, int out_size, void* d_ws, size_t ws_size, hipStream_t stream) {
    static int grid = 0;
    if (grid == 0) {
        if (n_in != 19 || in_sizes[0] != MREAL * DM || out_size != MREAL * DM || ws_size < WS_END) {
            fprintf(stderr, "kernel_launch: shape/workspace mismatch: n_in %d in0 %d out %d ws %zu (need %zu); nothing launched\n", n_in, n_in > 0 ? in_sizes[0] : -1, out_size, ws_size, (size_t)WS_END); grid = -1; return; }
        int dev = 0, cus = 0, per_cu = 0;
        if (hipGetDevice(&dev) != hipSuccess || hipDeviceGetAttribute(&cus, hipDeviceAttributeMultiprocessorCount, dev) != hipSuccess) { fprintf(stderr, "kernel_launch: device query failed\n"); grid = -1; return; }
        if (hipFuncSetAttribute((const void*)hybrid_fwd, hipFuncAttributeMaxDynamicSharedMemorySize, LDS_BYTES) != hipSuccess) { fprintf(stderr, "kernel_launch: hipFuncSetAttribute failed\n"); grid = -1; return; }
        if (hipOccupancyMaxActiveBlocksPerMultiprocessor(&per_cu, (const void*)hybrid_fwd, NWAVES * 64, LDS_BYTES) != hipSuccess || per_cu < 1)
            fprintf(stderr, "kernel_launch: note: occupancy query reports %d workgroups per CU\n", per_cu);
        (void)hipGetLastError();
        grid = cus;
    }
    if (grid < 0) return;
    if (hipMemsetAsync((char*)d_ws + WS_CTL, 0, CTL_ZERO_BYTES, stream) != hipSuccess) { fprintf(stderr, "kernel_launch: hipMemsetAsync failed\n"); return; }
    Args a{};
    for (int i = 0; i < 19; ++i) a.in[i] = (const float*)d_in[i];
    a.out = (float*)d_out; a.ws = (unsigned char*)d_ws;
    for (int li = 0; li < N_LAUNCHES; ++li) {
        a.ph_lo = (N_LAUNCHES == 1) ? 0 : li; a.ph_hi = (N_LAUNCHES == 1) ? N_PHASES : li + 1;
        hipLaunchKernelGGL(hybrid_fwd, dim3(grid), dim3(NWAVES * 64), LDS_BYTES, stream, a);
        const hipError_t le = hipPeekAtLastError();
        if (le != hipSuccess) { fprintf(stderr, "kernel_launch: launch %d failed: %s\n", li, hipGetErrorName(le)); break; }
    }
}
```

```cpp
#include <hip/hip_runtime.h>
#include <cstdio>
#include <cstdint>

#define LAS __attribute__((address_space(3)))
#define GAS __attribute__((address_space(1)))
typedef unsigned short bf16_t;
typedef short bf16x8 __attribute__((ext_vector_type(8)));
typedef short s16x4 __attribute__((ext_vector_type(4)));
typedef float f32x4 __attribute__((ext_vector_type(4)));
typedef float f32x2 __attribute__((ext_vector_type(2)));
typedef float f32x16 __attribute__((ext_vector_type(16)));
typedef unsigned u32x4 __attribute__((ext_vector_type(4)));
typedef unsigned u32x2 __attribute__((ext_vector_type(2)));

constexpr int DM = 2048, NBATCH = 8, SEQ = 2048, NMETA = 16;
constexpr int MREAL = NBATCH * SEQ;
constexpr int MPAD = MREAL + 256;
constexpr int NPOS = SEQ + NMETA;
constexpr float NORM_EPS = 1e-6f;
constexpr int C_NAQ = 0, C_NAK = 1024, C_CQ = 2048, C_CKV = 2560, C_GA = 3072, C_GB = 5120, C_KR = 7168, NMAIN = 7424;
constexpr int VT_PITCH = MPAD;

constexpr size_t MiB = 1u << 20;
constexpr size_t WS_CTL = 0, CTL_ZERO_BYTES = 1 * MiB;
constexpr size_t WS_SSQ_Q = 481 * MiB, WS_SSQ_KV = 482 * MiB, WS_SSQ_2 = 486 * MiB;
constexpr size_t WS_COS = 1 * MiB, WS_SIN = 1 * MiB + 512 * 1024;
constexpr size_t WS_WUQ = 2 * MiB, WS_WUKV = 5 * MiB, WS_WNA = 9 * MiB, WS_WMLA = 13 * MiB, WS_WOUT = 21 * MiB, WS_WSC = 29 * MiB;
constexpr size_t WS_GA = 37 * MiB, WS_GB = 101 * MiB;
constexpr size_t WS_KR = 165 * MiB;
constexpr size_t WS_WIN = 167 * MiB + 256 * 1024, WS_WVT = WS_WIN + 29 * MiB;
constexpr size_t WS_ONA = 190 * MiB;
constexpr size_t WS_NAQ = 222 * MiB, WS_NAK = 254 * MiB, WS_VT = WS_NAK + 32 * MiB + 512 * 1024;
constexpr size_t WS_HN1 = 319 * MiB;
constexpr size_t WS_CQ = 448 * MiB, WS_CKV = 464 * MiB;
constexpr size_t WS_QM = 222 * MiB, WS_KN = 318 * MiB, WS_VV = 383 * MiB;
constexpr size_t WS_OMLA = 448 * MiB;
constexpr size_t WS_MERGED = 222 * MiB, WS_T1 = 286 * MiB;
constexpr size_t WS_H2 = 37 * MiB, WS_H2B = 293 * MiB;
constexpr size_t WS_U = 69 * MiB, WS_V = 133 * MiB;
constexpr size_t WS_SC = 165 * MiB;
constexpr size_t WS_END = 512 * MiB;
static_assert(WS_CKV + (size_t)MPAD * 512 * 2 <= WS_SSQ_Q && WS_SSQ_Q + (size_t)8 * MPAD * 4 <= WS_SSQ_KV && WS_SSQ_KV + (size_t)8 * MPAD * 4 <= 483 * MiB && WS_SSQ_2 + (size_t)32 * MREAL * 4 <= WS_END, "ssq slabs");
static_assert(WS_VT + (size_t)1024 * MPAD * 2 <= WS_HN1 && WS_HN1 + (size_t)MPAD * 2048 * 2 <= WS_CQ && WS_CKV + (size_t)MPAD * 512 * 2 <= WS_END, "map P1");
static_assert(WS_WVT + 4 * MiB <= WS_NAQ && WS_KR + (size_t)MPAD * 64 * 2 <= WS_WIN && WS_ONA + 32 * MiB <= WS_NAQ, "map P1b");
static_assert(WS_QM + 96 * MiB <= WS_KN && WS_KN + 65 * MiB <= WS_VV && WS_VV + 65 * MiB <= WS_OMLA && WS_OMLA + 64 * MiB <= WS_END, "map P3");
static_assert(WS_T1 + 128 * MiB <= WS_OMLA && WS_H2 + 128 * MiB <= WS_KR && WS_SC + 128 * MiB <= WS_H2B && WS_H2B + 64 * MiB <= WS_END, "map P5+");
static_assert(WS_GA + 32 * MiB <= WS_U && WS_U + 24 * MiB <= WS_GB && WS_GB + 32 * MiB <= WS_V && WS_V + 24 * MiB <= WS_KR, "expert tables between the gate codes");

constexpr int CW_BAR = 4096;

constexpr int RING_BYTES = 131072;
constexpr int LDSCTL_OFF = RING_BYTES, MISC_OFF = LDSCTL_OFF + 320;
constexpr int LDS_BYTES = 147456;
constexpr int NWAVES = 8;

#define LDS_WAIT() asm volatile("s_waitcnt lgkmcnt(0)" ::: "memory")
#define VM_WAIT() asm volatile("s_waitcnt vmcnt(0)" ::: "memory")
#define SBAR() __builtin_amdgcn_sched_barrier(0)
typedef __bf16 bf16x2_t __attribute__((ext_vector_type(2)));
__device__ __forceinline__ unsigned cvt_pk_bf16(float lo, float hi) { const f32x2 v = {lo, hi}; const bf16x2_t b = __builtin_convertvector(v, bf16x2_t); return __builtin_bit_cast(unsigned, b); }
__device__ __forceinline__ float bf_lo(unsigned w) { return __uint_as_float(w << 16); }
__device__ __forceinline__ float bf_hi(unsigned w) { return __uint_as_float(w & 0xffff0000u); }
__device__ __forceinline__ u32x4 pack8(const f32x4 a, const f32x4 b) { u32x4 w; w.x = cvt_pk_bf16(a[0], a[1]); w.y = cvt_pk_bf16(a[2], a[3]); w.z = cvt_pk_bf16(b[0], b[1]); w.w = cvt_pk_bf16(b[2], b[3]); return w; }
__device__ __forceinline__ u32x2 pack8_fp8(f32x4 a, f32x4 b) {
#pragma unroll
    for (int i = 0; i < 4; ++i) { a[i] = __builtin_fminf(__builtin_fmaxf(a[i], -448.f), 448.f); b[i] = __builtin_fminf(__builtin_fmaxf(b[i], -448.f), 448.f); }
    int w0 = 0, w1 = 0; w0 = __builtin_amdgcn_cvt_pk_fp8_f32(a[0], a[1], w0, false); w0 = __builtin_amdgcn_cvt_pk_fp8_f32(a[2], a[3], w0, true);
    w1 = __builtin_amdgcn_cvt_pk_fp8_f32(b[0], b[1], w1, false); w1 = __builtin_amdgcn_cvt_pk_fp8_f32(b[2], b[3], w1, true); return (u32x2){(unsigned)w0, (unsigned)w1}; }
__device__ __forceinline__ unsigned char f32_to_fp8(float x) { x = __builtin_fminf(__builtin_fmaxf(x, -448.f), 448.f); return (unsigned char)(__builtin_amdgcn_cvt_pk_fp8_f32(x, 0.f, 0, false) & 0xff); }
__device__ __forceinline__ u32x2 pack8_u8(const f32x4 a, const f32x4 b) { u32x2 w; unsigned x = 0u, y = 0u;
    x = __builtin_amdgcn_cvt_pk_u8_f32(a[0] * 255.f, 0u, x); x = __builtin_amdgcn_cvt_pk_u8_f32(a[1] * 255.f, 1u, x); x = __builtin_amdgcn_cvt_pk_u8_f32(a[2] * 255.f, 2u, x); x = __builtin_amdgcn_cvt_pk_u8_f32(a[3] * 255.f, 3u, x);
    y = __builtin_amdgcn_cvt_pk_u8_f32(b[0] * 255.f, 0u, y); y = __builtin_amdgcn_cvt_pk_u8_f32(b[1] * 255.f, 1u, y); y = __builtin_amdgcn_cvt_pk_u8_f32(b[2] * 255.f, 2u, y); y = __builtin_amdgcn_cvt_pk_u8_f32(b[3] * 255.f, 3u, y);
    w.x = x; w.y = y; return w; }
__device__ __forceinline__ unsigned pack4_fp8(f32x4 a) {
#pragma unroll
    for (int i = 0; i < 4; ++i) a[i] = __builtin_fminf(__builtin_fmaxf(a[i], -448.f), 448.f);
    int w0 = 0; w0 = __builtin_amdgcn_cvt_pk_fp8_f32(a[0], a[1], w0, false); w0 = __builtin_amdgcn_cvt_pk_fp8_f32(a[2], a[3], w0, true); return (unsigned)w0; }
__device__ __forceinline__ void unpack8_fp8(const u32x2 w, f32x4& a, f32x4& b) {
    const f32x2 a0 = __builtin_amdgcn_cvt_pk_f32_fp8((int)w.x, false), a1 = __builtin_amdgcn_cvt_pk_f32_fp8((int)w.x, true), b0 = __builtin_amdgcn_cvt_pk_f32_fp8((int)w.y, false), b1 = __builtin_amdgcn_cvt_pk_f32_fp8((int)w.y, true);
    a = (f32x4){a0[0], a0[1], a1[0], a1[1]}; b = (f32x4){b0[0], b0[1], b1[0], b1[1]}; }
__device__ __forceinline__ void unpack8_u8(const u32x2 w, f32x4& a, f32x4& b) { const float k = 1.f / 255.f;
    a = (f32x4){(float)(w.x & 0xffu), (float)((w.x >> 8) & 0xffu), (float)((w.x >> 16) & 0xffu), (float)(w.x >> 24)} * k;
    b = (f32x4){(float)(w.y & 0xffu), (float)((w.y >> 8) & 0xffu), (float)((w.y >> 16) & 0xffu), (float)(w.y >> 24)} * k; }
__device__ __forceinline__ u32x2 pack4(const f32x4 a) { u32x2 w; w.x = cvt_pk_bf16(a[0], a[1]); w.y = cvt_pk_bf16(a[2], a[3]); return w; }
__device__ __forceinline__ float wave_sum(float v) {
#pragma unroll
    for (int o = 1; o < 64; o <<= 1) v += __shfl_xor(v, o);
    return v;
}
__device__ __forceinline__ float sigmoidf_(float x) { return __builtin_amdgcn_rcpf(1.0f + __builtin_amdgcn_exp2f(-1.4426950408889634f * x)); }
__device__ __forceinline__ int crow(int r, int hi) { return (r & 3) + 8 * (r >> 2) + 4 * hi; }
#define PG8_AUX 0
namespace pg8 {
constexpr int BM = 256, BK = 64, HALF = 128, HTB = HALF * BK * 2  , STAGE_BYTES = 8 * HTB, NXCD = 8, WGM = 8;
__host__ __device__ __forceinline__ int lds_byte(int r, int c) { const int st = (r >> 4) * 2 + (c >> 5), rr = r & 15, cc = c & 31, ob = rr * 64 + cc * 2; return st * 1024 + (ob ^ (((ob >> 9) & 1) << 5)); }
__host__ __device__ __forceinline__ void stage_rc(int b, int& R, int& C) { const int st = b / 1024, sb = b % 1024, swz = sb ^ (((sb >> 9) & 1) << 5); R = (st >> 1) * 16 + swz / 64; C = (st & 1) * 32 + (swz % 64) / 2; }
__host__ __device__ __forceinline__ int perm32(int rho) { const int n = rho >> 4, i = rho & 15; return 8 * (i >> 2) + 4 * n + (i & 3); }

struct Unit { int pm, pn, kind; };

__device__ __forceinline__ void grid_order(int L, int nM, int nN, int& pm, int& pn) {
    const int nwg = nM * nN; int wgid = L;
    { const int q = nwg / NXCD, r = nwg % NXCD, xcd = wgid % NXCD, off = wgid / NXCD; wgid = (xcd < r ? xcd * (q + 1) : r * (q + 1) + (xcd - r) * q) + off; }
    const int nig = WGM * nN, gid = wgid / nig, fm = gid * WGM, gsz = (nM - fm) < WGM ? (nM - fm) : WGM;
    pm = fm + ((wgid % nig) % gsz); pn = (wgid % nig) / gsz;
}

typedef int v8i_t __attribute__((ext_vector_type(8)));
template <class Epi, class Sched, bool F8 = false, int F8_SCALE_EXP = 0>
__device__ __forceinline__ void gemm_phase(LAS unsigned char* lds, const int K, const Sched& S, const Epi& E) {
    const int tid = threadIdx.x, wid = __builtin_amdgcn_readfirstlane(tid >> 6), lane = tid & 63, wr = wid >> 2, wc = wid & 3, fr = lane & 15, fq = lane >> 4;
    int f8sa = 0x01010101 * (127 + F8_SCALE_EXP), f8sb = 0x7f7f7f7f; asm volatile("" : "+v"(f8sa), "+v"(f8sb));
    const int Kb = F8 ? K : 2 * K;
    const int nt = Kb / 128;
    unsigned voffA[2], voffB[2];
#pragma unroll
    for (int i = 0; i < 2; ++i) { int R, C; stage_rc(tid * 16 + i * 8192, R, C); const int Rb = Epi::PERM ? ((R & ~31) + perm32(R & 31)) : R;
        voffA[i] = (unsigned)(R * Kb + C * 2); voffB[i] = (unsigned)(Rb * Kb + C * 2); }
    const size_t kstep = (size_t)128;
    const size_t hstep = (size_t)HALF * Kb;
    const unsigned ldsw = (unsigned)wid * 1024u;
    const int aoff = lds_byte(wr * 64 + fr, F8 ? fq * 16 : fq * 8), boff = lds_byte(wc * 32 + fr, F8 ? fq * 16 : fq * 8);
#define PG8_SA(b, h) (((b) * 2 + (h)) * HTB)
#define PG8_SB(b, h) ((4 + (b) * 2 + (h)) * HTB)
#define PG8_STAGE(bufoff, gbase, voff) do { _Pragma("unroll") for (int _i = 0; _i < 2; ++_i) \
        __builtin_amdgcn_global_load_lds((const unsigned*)((const char*)(gbase) + (voff)[_i]), (LAS unsigned*)(lds + (bufoff) + ldsw + _i * 8192), 16, 0, PG8_AUX); } while (0)
#define PG8_LDA(dst, b, h) do { _Pragma("unroll") for (int m = 0; m < 4; ++m) _Pragma("unroll") for (int k = 0; k < 2; ++k) dst[m][k] = *(const LAS bf16x8*)(lds + PG8_SA(b, h) + aoff + m * 2048 + (F8 ? k * 16 : k * 1024)); } while (0)
#define PG8_LDB(dst, b, h) do { _Pragma("unroll") for (int n = 0; n < 2; ++n) _Pragma("unroll") for (int k = 0; k < 2; ++k) dst[n][k] = *(const LAS bf16x8*)(lds + PG8_SB(b, h) + boff + n * 2048 + (F8 ? k * 16 : k * 1024)); } while (0)
#define PG8_F8OP(X) __builtin_bit_cast(v8i_t, __builtin_shufflevector(X[0], X[1], 0, 1, 2, 3, 4, 5, 6, 7, 8, 9, 10, 11, 12, 13, 14, 15))
#define PG8_MMA(ai, bj, At, Bt) do { __builtin_amdgcn_s_setprio(1); \
        if constexpr (F8) { _Pragma("unroll") for (int m = 0; m < 4; ++m) _Pragma("unroll") for (int n = 0; n < 2; ++n) \
            asm volatile("v_mfma_scale_f32_16x16x128_f8f6f4 %0, %1, %2, %0, %3, %4 op_sel_hi:[0,0,0]" : "+v"(acc[ai][bj][m][n]) : "v"(PG8_F8OP(Bt[n])), "v"(PG8_F8OP(At[m])), "v"(f8sa), "v"(f8sb)); } \
        else { _Pragma("unroll") for (int m = 0; m < 4; ++m) _Pragma("unroll") for (int n = 0; n < 2; ++n) _Pragma("unroll") for (int k = 0; k < 2; ++k) \
            acc[ai][bj][m][n] = __builtin_amdgcn_mfma_f32_16x16x32_bf16(Bt[n][k], At[m][k], acc[ai][bj][m][n], 0, 0, 0); } \
        __builtin_amdgcn_s_setprio(0); } while (0)
#define PG8_WAIT_V(n) asm volatile("s_waitcnt vmcnt(" #n ")" ::: "memory")
#define PG8_WAIT_L(n) asm volatile("s_waitcnt lgkmcnt(" #n ")" ::: "memory")
#define PG8_BAR __builtin_amdgcn_s_barrier()
#define PG8_SCHED __builtin_amdgcn_sched_barrier(0)
    Unit cur, nxt; int ui = 0;
    if (!S.next(0, cur)) return;
    f32x4 acc[2][2][4][2];
#pragma unroll
    for (int a = 0; a < 2; ++a)
#pragma unroll
        for (int b = 0; b < 2; ++b)
#pragma unroll
            for (int m = 0; m < 4; ++m)
#pragma unroll
                for (int n = 0; n < 2; ++n) acc[a][b][m][n] = (f32x4){0.f, 0.f, 0.f, 0.f};
    bf16x8 At[4][2], B0[2][2], B1[2][2];
    const char* cA = S.pa(cur); const char* cB = S.pb(cur);
    PG8_STAGE(PG8_SB(0, 0), cB, voffB); PG8_STAGE(PG8_SB(0, 1), cB + hstep, voffB); PG8_STAGE(PG8_SA(0, 0), cA, voffA); PG8_STAGE(PG8_SA(0, 1), cA + hstep, voffA);
    if (wr == 1) PG8_BAR;
    PG8_WAIT_V(2); PG8_BAR;
    PG8_STAGE(PG8_SB(1, 0), cB + kstep, voffB); PG8_STAGE(PG8_SA(1, 0), cA + kstep, voffA); PG8_STAGE(PG8_SB(1, 1), cB + hstep + kstep, voffB);
    PG8_WAIT_V(6); PG8_BAR;
    for (;;) {
        const bool has_next = S.next(ui + 1, nxt);
        const char* nA = has_next ? S.pa(nxt) : cA; const char* nB = has_next ? S.pb(nxt) : cB;
        for (int t = 0; t < nt; t += 2) {
            const bool last = (t == nt - 2);
            const char* a1 = cA + (size_t)(t + 1) * kstep;
            const char* a2 = last ? nA : cA + (size_t)(t + 2) * kstep; const char* b2 = last ? nB : cB + (size_t)(t + 2) * kstep;
            const char* a3 = a2 + kstep; const char* b3 = b2 + kstep;
            PG8_LDB(B0, 0, 0); PG8_LDB(B1, 0, 1); PG8_SCHED; PG8_LDA(At, 0, 0); PG8_STAGE(PG8_SA(1, 1), a1 + hstep, voffA);
            PG8_WAIT_V(8); PG8_WAIT_L(0); PG8_BAR; PG8_MMA(0, 0, At, B0); PG8_MMA(0, 1, At, B1); PG8_BAR; PG8_SCHED;
            PG8_LDA(At, 0, 1); PG8_STAGE(PG8_SB(0, 0), b2, voffB); PG8_STAGE(PG8_SB(0, 1), b2 + hstep, voffB); PG8_STAGE(PG8_SA(0, 0), a2, voffA);
            PG8_WAIT_V(8); PG8_WAIT_L(0); PG8_BAR; PG8_MMA(1, 0, At, B0); PG8_MMA(1, 1, At, B1); PG8_BAR; PG8_SCHED;
            PG8_LDB(B0, 1, 0); PG8_LDB(B1, 1, 1); PG8_SCHED; PG8_LDA(At, 1, 0); PG8_STAGE(PG8_SA(0, 1), a2 + hstep, voffA);
            PG8_WAIT_V(8); PG8_WAIT_L(0); PG8_BAR; PG8_MMA(0, 0, At, B0); PG8_MMA(0, 1, At, B1); PG8_BAR; PG8_SCHED;
            PG8_LDA(At, 1, 1); PG8_STAGE(PG8_SB(1, 0), b3, voffB); PG8_STAGE(PG8_SB(1, 1), b3 + hstep, voffB); PG8_STAGE(PG8_SA(1, 0), a3, voffA);
            PG8_WAIT_V(8); PG8_WAIT_L(0); PG8_BAR; PG8_MMA(1, 0, At, B0); PG8_MMA(1, 1, At, B1); PG8_BAR; PG8_SCHED;
        }
        if (wr == 0) PG8_BAR;
        if constexpr (F8) asm volatile("s_nop 15\n\ts_nop 7" ::: "memory");
        if constexpr (Epi::HAS_PRE) {
            E.pre(cur, (LAS float*)(lds + STAGE_BYTES + 1024), tid); PG8_WAIT_L(0); PG8_BAR; }
        E(acc, cur, wr, wc, fr, fq, (const LAS float*)(lds + STAGE_BYTES + 1024));
        if (!has_next) break;
#pragma unroll
        for (int a = 0; a < 2; ++a)
#pragma unroll
            for (int b = 0; b < 2; ++b)
#pragma unroll
                for (int m = 0; m < 4; ++m)
#pragma unroll
                    for (int n = 0; n < 2; ++n) acc[a][b][m][n] = (f32x4){0.f, 0.f, 0.f, 0.f};
        cur = nxt; cA = nA; cB = nB; ++ui;
        if (wr == 1) PG8_BAR;
    }
    PG8_WAIT_V(0);
    PG8_BAR;
#undef PG8_SA
#undef PG8_SB
#undef PG8_STAGE
#undef PG8_LDA
#undef PG8_LDB
#undef PG8_MMA
#undef PG8_F8OP
#undef PG8_WAIT_V
#undef PG8_WAIT_L
#undef PG8_BAR
#undef PG8_SCHED
}
}
typedef GAS unsigned gu32;
#define RLX_AGENT __ATOMIC_RELAXED, __HIP_MEMORY_SCOPE_AGENT
#define XB_TMO      128
#define XB_XCNT(j)  (256  + 64 * (j))
#define XB_XSUB(j)  (1280 + 64 * (j))
#define XB_XGEN(j)  (2304 + 64 * (j))
#define XB_TOP      3328
#define XB_TOPGEN   3392
#define XCD_BAR_WORDS 3456
#define XB_SPIN_CAP (1u << 18)
__device__ __forceinline__ unsigned xb_ld(unsigned* p)              { return __hip_atomic_load(p, __ATOMIC_RELAXED, __HIP_MEMORY_SCOPE_AGENT); }
__device__ __forceinline__ unsigned xb_add(unsigned* p, unsigned v) { return __hip_atomic_fetch_add(p, v, __ATOMIC_RELAXED, __HIP_MEMORY_SCOPE_AGENT); }
__device__ __forceinline__ unsigned xb_xcc_id() { return (unsigned)__builtin_amdgcn_s_getreg((3 << 11) | 20) & 0xFu; }
#define XB_SPIN(cond, bar) do { unsigned _sp = 0; while (cond) { __builtin_amdgcn_s_sleep(1); \
    if ((++_sp & 255u) == 0u) { if (xb_ld(&(bar)[XB_TMO])) break; if (_sp > XB_SPIN_CAP) { atomicAdd(&(bar)[XB_TMO], 1u); break; } } } } while (0)
struct XcdBarrier { unsigned* bar; unsigned x; volatile LAS unsigned* st; };
__device__ __forceinline__ XcdBarrier xcd_barrier_post(unsigned* bar, volatile LAS unsigned* st) {
    XcdBarrier b; b.bar = bar; b.x = xb_xcc_id(); b.st = st;
    if (threadIdx.x == 0) (void)xb_add(&bar[XB_XCNT(b.x)], 1u);
    return b;
}
__device__ __forceinline__ void xcd_barrier_complete(unsigned* bar, unsigned x, unsigned& nloc, unsigned& nx) {
    const unsigned G = gridDim.x * gridDim.y * gridDim.z;
    unsigned sum, cnt, mine, sp = 0u;
    for (;;) {
        sum = 0u; cnt = 0u; mine = 0u;
#pragma unroll
        for (unsigned j = 0; j < 16; ++j) { const unsigned c = xb_ld(&bar[XB_XCNT(j)]); sum += c; cnt += (c > 0u) ? 1u : 0u; mine = (j == x) ? c : mine; }
        if (sum == G) break;
        __builtin_amdgcn_s_sleep(1);
        if ((++sp & 255u) == 0u) { if (xb_ld(&bar[XB_TMO])) break; if (sp > XB_SPIN_CAP) { atomicAdd(&bar[XB_TMO], 1u); break; } }
    }
    nloc = mine > 0u ? mine : 1u; nx = cnt > 0u ? cnt : 1u;
}
__device__ __forceinline__ void xcd_barrier(const XcdBarrier& b) {
    asm volatile("s_waitcnt vmcnt(0)" ::: "memory");
    __syncthreads();
    if (threadIdx.x == 0) {
        unsigned* bar = b.bar;
        __builtin_amdgcn_s_waitcnt(0);
        unsigned nloc = b.st[0], nx = b.st[1];
        if (nloc == 0u) { xcd_barrier_complete(bar, b.x, nloc, nx); b.st[0] = nloc; b.st[1] = nx; }
        const unsigned old = xb_add(&bar[XB_XSUB(b.x)], 1u);
        const unsigned gen = old / nloc;
        if (old + 1u == (gen + 1u) * nloc) {
            __builtin_amdgcn_fence(__ATOMIC_RELEASE, "agent");
            asm volatile("s_waitcnt vmcnt(0)" ::: "memory");
            const unsigned og = xb_add(&bar[XB_TOP], 1u);
            const unsigned tg = og / nx;
            if (og + 1u == (tg + 1u) * nx) xb_add(&bar[XB_TOPGEN], 1u);
            else XB_SPIN(xb_ld(&bar[XB_TOPGEN]) == tg, bar);
            __builtin_amdgcn_fence(__ATOMIC_ACQUIRE, "agent");
            xb_add(&bar[XB_XGEN(b.x)], 1u);
            asm volatile("s_waitcnt vmcnt(0)" ::: "memory");
        } else {
            XB_SPIN(xb_ld(&bar[XB_XGEN(b.x)]) == gen, bar);
            __builtin_amdgcn_fence(__ATOMIC_ACQUIRE, "agent");
            asm volatile("s_waitcnt vmcnt(0)" ::: "memory");
        }
    }
    __syncthreads();
}
struct Frame {
    LAS unsigned char* lds;
    volatile LAS unsigned* MISC;
    unsigned char* ws;
    int tid, lane, wave;
    int vcu, G;
    const float* in[19];
    float* out;
};
#define WSP(T, off) ((T*)(F.ws + (off)))

typedef float cv16f_t __attribute__((ext_vector_type(16)));
typedef unsigned cv6u_t __attribute__((ext_vector_type(6)));
struct Conv { const float* pu; const float* pv; unsigned char* u8; unsigned char* v8; LAS unsigned char* lbuf; int next, stride, end, pend, tick; };
__device__ __forceinline__ void conv_issue(const Conv& c, int item, int lane) {
    const float* src = ((item >> 14) ? c.pv : c.pu) + (size_t)(item & 16383) * 2048 + 4 * lane;
#pragma unroll
    for (int q = 0; q < 8; ++q) __builtin_amdgcn_global_load_lds((const unsigned*)(src + 256 * q), (LAS unsigned*)(c.lbuf + q * 1024), 16, 0, 0);
}
__device__ __forceinline__ void conv_finish(const Conv& c, int item, int lane) {
    const int isv = item >> 14, row = item & 16383; const float sc = isv ? 4.f : 64.f; cv16f_t a, b;
#pragma unroll
    for (int q = 0; q < 8; ++q) { const f32x4 x = *(const LAS f32x4*)(c.lbuf + q * 1024 + lane * 16);
#pragma unroll
        for (int e = 0; e < 4; ++e) { const int k_ = 4 * q + e;
            if (k_ & 1) b[k_ >> 1] = x[e] * sc; else a[k_ >> 1] = x[e] * sc; } }
    const cv6u_t w = __builtin_amdgcn_cvt_scalef32_2xpk16_fp6_f32(a, b, 1.0f);
    unsigned char* rec = (isv ? c.v8 : c.u8) + (size_t)row * 1536;
    *(GAS u32x4*)(rec + lane * 16) = (u32x4){w[0], w[1], w[2], w[3]}; *(GAS u32x2*)(rec + 1024 + lane * 8) = (u32x2){w[4], w[5]};
}
template <int YOUNGER>
__device__ __forceinline__ void conv_step(Conv& c, int lane) {
    if (c.pend >= 0) { if constexpr (YOUNGER == 0) asm volatile("s_waitcnt vmcnt(0)" ::: "memory"); else { static_assert(YOUNGER == 12, "wait count"); asm volatile("s_waitcnt vmcnt(12)" ::: "memory"); }
        conv_finish(c, c.pend, lane); c.pend = -1; asm volatile("s_waitcnt lgkmcnt(0)" ::: "memory"); }
    if (c.next < c.end) { conv_issue(c, c.next, lane); c.pend = c.next; c.next += c.stride; }
}
__device__ __forceinline__ void p0_transpose_item(const float* W, int K, int N, int k0, int n0, bf16_t* WT, int drow, bool rope, const float* gain, LAS float* scr, int lane) {
    { f32x4 v[8]; float gk[8];
#pragma unroll
      for (int i = 0; i < 8; ++i) { const int kk = 8 * i + (lane >> 3); v[i] = *(const GAS f32x4*)(W + (size_t)(k0 + kk) * N + n0 + 4 * (lane & 7)); gk[i] = gain ? gain[k0 + kk] : 1.f; }
#pragma unroll
      for (int i = 0; i < 8; ++i) { const int kk = 8 * i + (lane >> 3); LAS float* d = scr + kk * 33 + 4 * (lane & 7);
#pragma unroll
          for (int e = 0; e < 4; ++e) d[e] = v[i][e] * gk[i]; } }
    LDS_WAIT(); asm volatile("" ::: "memory");
    const int c = lane & 7;
#pragma unroll
    for (int j = 0; j < 4; ++j) { const int n = (lane >> 3) + 8 * j; const LAS float* s = scr + (8 * c) * 33 + n;
        u32x4 o; o.x = cvt_pk_bf16(s[0 * 33], s[1 * 33]); o.y = cvt_pk_bf16(s[2 * 33], s[3 * 33]); o.z = cvt_pk_bf16(s[4 * 33], s[5 * 33]); o.w = cvt_pk_bf16(s[6 * 33], s[7 * 33]);
        const int dr = drow + (rope ? (8 * (n >> 2) + (n & 3)) : n);
        *(GAS u32x4*)(WT + (size_t)dr * K + k0 + 8 * c) = o; }
    LDS_WAIT(); asm volatile("" ::: "memory");
}
__device__ __forceinline__ void p0_transpose_item8(const float* W, int K, int N, int k0, int n0, unsigned char* WT, int drow, bool rope, float scale, LAS float* scr, int lane, const float* gain = nullptr) {
    { f32x4 v[8]; float gk[8];
#pragma unroll
      for (int i = 0; i < 8; ++i) { const int kk = 8 * i + (lane >> 3); v[i] = *(const GAS f32x4*)(W + (size_t)(k0 + kk) * N + n0 + 4 * (lane & 7)); gk[i] = gain ? gain[k0 + kk] * scale : scale; }
#pragma unroll
      for (int i = 0; i < 8; ++i) { const int kk = 8 * i + (lane >> 3); LAS float* d = scr + kk * 33 + 4 * (lane & 7);
#pragma unroll
          for (int e = 0; e < 4; ++e) d[e] = v[i][e] * gk[i]; } }
    LDS_WAIT(); asm volatile("" ::: "memory");
#pragma unroll
    for (int j = 0; j < 2; ++j) { const int q = lane + 64 * j, n = q >> 2, c = q & 3; const LAS float* s = scr + (16 * c) * 33 + n; u32x4 o;
#pragma unroll
        for (int d = 0; d < 4; ++d) { int w = 0; w = __builtin_amdgcn_cvt_pk_fp8_f32(s[(4 * d) * 33], s[(4 * d + 1) * 33], w, false); w = __builtin_amdgcn_cvt_pk_fp8_f32(s[(4 * d + 2) * 33], s[(4 * d + 3) * 33], w, true); o[d] = (unsigned)w; }
        const int dr = drow + (rope ? (8 * (n >> 2) + (n & 3)) : n);
        *(GAS u32x4*)(WT + (size_t)dr * K + k0 + 16 * c) = o; }
    LDS_WAIT(); asm volatile("" ::: "memory");
}
__device__ __forceinline__ void rms_row_to_fp8(const float* xrow, const float* g, unsigned char* orow, int lane) {
    const GAS f32x4* xr = (const GAS f32x4*)xrow + lane; const GAS f32x4* gr = (const GAS f32x4*)g + lane;
    f32x4 v[8]; float s = 0.f;
#pragma unroll
    for (int j = 0; j < 8; ++j) { v[j] = xr[64 * j]; s += (v[j].x * v[j].x + v[j].y * v[j].y) + (v[j].z * v[j].z + v[j].w * v[j].w); }
    const float rstd = 1.0f / sqrtf(wave_sum(s) * (1.f / DM) + NORM_EPS);
    GAS unsigned* o4 = (GAS unsigned*)orow + lane;
#pragma unroll
    for (int j = 0; j < 8; ++j) { const f32x4 y = (v[j] * rstd) * gr[64 * j]; int w = 0; w = __builtin_amdgcn_cvt_pk_fp8_f32(y[0], y[1], w, false); w = __builtin_amdgcn_cvt_pk_fp8_f32(y[2], y[3], w, true); o4[64 * j] = (unsigned)w; }
}
__device__ __forceinline__ void rms_row_to_bf16(const float* xrow, const float* g, bf16_t* orow, int lane) {
    const GAS f32x4* xr = (const GAS f32x4*)xrow + lane; const GAS f32x4* gr = (const GAS f32x4*)g + lane;
    f32x4 v[8]; float s = 0.f;
#pragma unroll
    for (int j = 0; j < 8; ++j) { v[j] = xr[64 * j]; s += (v[j].x * v[j].x + v[j].y * v[j].y) + (v[j].z * v[j].z + v[j].w * v[j].w); }
    const float rstd = 1.0f / sqrtf(wave_sum(s) * (1.f / DM) + NORM_EPS);
    GAS u32x2* o8 = (GAS u32x2*)orow + lane;
#pragma unroll
    for (int j = 0; j < 8; ++j) { const f32x4 gg = gr[64 * j]; o8[64 * j] = pack4((v[j] * rstd) * gg); }
}
template <int PART>
__device__ __forceinline__ void p0_prologue(Frame& F, int rank, int nrank) {
    LAS float* scr = (LAS float*)(F.lds + F.wave * 16384);
    const int gw = rank * NWAVES + F.wave, NGW = nrank * NWAVES, lane = F.lane; const int gt = rank * 512 + F.tid, NGT = nrank * 512;
    unsigned char* WIN = WSP(unsigned char, WS_WIN); unsigned char* WVT = WSP(unsigned char, WS_WVT);
    constexpr int I_IN = 32 * 258, I_UQ = 8 * 96, I_UKV = 8 * 128, I_NA = 16 * 64, I_MLA = 32 * 64, I_OUT = 32 * 64;
    constexpr int NEARLY = I_IN + I_UQ + I_UKV, NITEMS = NEARLY + I_NA + I_MLA + I_OUT;
    for (int it = (PART == 0 ? 0 : NEARLY) + gw; it < (PART == 0 ? NEARLY : NITEMS); it += NGW) {
        int r = it;
        if (r < I_IN) { const int kb = r / 258, sb = r % 258, n0 = 32 * sb, k0 = 64 * kb; const float* W = F.in[3];
            unsigned char* dst = WIN; int drow; bool rope = false;
            if (n0 < 1024) drow = C_NAQ + n0;
            else if (n0 < 2048) drow = C_NAK + (n0 - 1024);
            else if (n0 < 3072) { dst = WVT; drow = n0 - 2048; }
            else if (n0 < 3584) drow = C_CQ + (n0 - 3072);
            else if (n0 < 4096) drow = C_CKV + (n0 - 3584);
            else if (n0 < 4160) { drow = C_KR + ((n0 - 4096) ? 4 : 0); rope = true; }
            else if (n0 < 6208) drow = C_GA + (n0 - 4160);
            else drow = C_GB + (n0 - 6208);
            p0_transpose_item8(W, 2048, 8256, k0, n0, dst, drow, rope, 64.f, scr, lane); continue; } r -= I_IN;
        if (r < I_UQ) { const int kb = r / 96, sb = r % 96, n0 = 32 * sb, k0 = 64 * kb; const int hd = n0 / 192, w = n0 % 192;
            int drow = n0; bool rope = false; if (w >= 128) { rope = true; drow = hd * 192 + 128 + ((w - 128) ? 4 : 0); }
            p0_transpose_item8(F.in[7], 512, 3072, k0, n0, WSP(unsigned char, WS_WUQ), drow, rope, 16.f, scr, lane, F.in[6]); continue; } r -= I_UQ;
        if (r < I_UKV) { const int kb = r / 128, sb = r % 128; const int n0 = 32 * sb, hd = n0 >> 8, w = n0 & 255;
            p0_transpose_item8(F.in[9], 512, 4096, 64 * kb, n0, WSP(unsigned char, WS_WUKV), (w >= 128 ? 2048 : 0) + hd * 128 + (w & 127), false, 16.f, scr, lane, F.in[8]); continue; } r -= I_UKV;
        if (r < I_NA) { const int kb = r / 64, sb = r % 64; p0_transpose_item8(F.in[10], 1024, 2048, 64 * kb, 32 * sb, WSP(unsigned char, WS_WNA), 32 * sb, false, 32.f, scr, lane); continue; } r -= I_NA;
        if (r < I_MLA) { const int kb = r / 64, sb = r % 64; p0_transpose_item8(F.in[11], 2048, 2048, 64 * kb, 32 * sb, WSP(unsigned char, WS_WMLA), 32 * sb, false, 64.f, scr, lane); continue; } r -= I_MLA;
        { const int kb = r / 64, sb = r % 64; p0_transpose_item8(F.in[12], 2048, 2048, 64 * kb, 32 * sb, WSP(unsigned char, WS_WOUT), 32 * sb, false, 64.f, scr, lane); }
    }
    if (PART == 0) { GAS u32x4* z = (GAS u32x4*)(WIN + (size_t)(C_KR + 64) * 2048); const int n16 = (NMAIN - C_KR - 64) * 2048 / 16;
      for (int i = gt; i < n16; i += NGT) z[i] = (u32x4){0u, 0u, 0u, 0u}; }
    if (PART == 0) { unsigned char* HN1 = WSP(unsigned char, WS_HN1);
#define P0_ROWSRC(m_) (((m_) < MREAL) ? F.in[0] + (size_t)(m_) * DM : F.in[1] + (size_t)((m_) - MREAL) * DM)
      { f32x4 v[8]; int m = gw;
        if (m < MREAL + NMETA) { const GAS f32x4* xr = (const GAS f32x4*)P0_ROWSRC(m) + lane;
#pragma unroll
            for (int j = 0; j < 8; ++j) v[j] = xr[64 * j]; }
        const GAS f32x4* gr = (const GAS f32x4*)F.in[2] + lane;
        while (m < MREAL + NMETA) { const int mn = m + NGW; f32x4 vn[8];
            { const int ml = mn < MREAL + NMETA ? mn : m; const GAS f32x4* xr = (const GAS f32x4*)P0_ROWSRC(ml) + lane;
#pragma unroll
              for (int j = 0; j < 8; ++j) vn[j] = xr[64 * j]; }
            float sq = 0.f;
#pragma unroll
            for (int j = 0; j < 8; ++j) sq += (v[j].x * v[j].x + v[j].y * v[j].y) + (v[j].z * v[j].z + v[j].w * v[j].w);
            const float rstd = 1.0f / sqrtf(wave_sum(sq) * (1.f / DM) + NORM_EPS);
            GAS unsigned* o4 = (GAS unsigned*)(HN1 + (size_t)m * DM) + lane;
#pragma unroll
            for (int j = 0; j < 8; ++j) { const f32x4 y = (v[j] * rstd) * gr[64 * j]; int w = 0; w = __builtin_amdgcn_cvt_pk_fp8_f32(y[0], y[1], w, false); w = __builtin_amdgcn_cvt_pk_fp8_f32(y[2], y[3], w, true); o4[64 * j] = (unsigned)w; }
#pragma unroll
            for (int j = 0; j < 8; ++j) v[j] = vn[j];
            m = mn; } }
#undef P0_ROWSRC
      GAS u32x4* z = (GAS u32x4*)(HN1 + (size_t)(MREAL + NMETA) * DM); const int n16 = (MPAD - MREAL - NMETA) * DM / 16;
      for (int i = gt; i < n16; i += NGT) z[i] = (u32x4){0u, 0u, 0u, 0u}; }
    if (PART == 0) { float* ct = WSP(float, WS_COS); float* st = WSP(float, WS_SIN);
      for (int i = gt; i < NPOS * 32; i += NGT) { const int p = i >> 5, j = i & 31;
          const float inv = __builtin_powf(10000.0f, -(float)(2 * j) / 64.0f); const float ang = (float)p * inv;
          double r = (double)ang * 0.15915494309189535; r -= __builtin_rint(r); const float rf = (float)r;
          ct[i] = __builtin_amdgcn_cosf(rf); st[i] = __builtin_amdgcn_sinf(rf); } }
    if (PART == 1) { const float* SK = F.in[15]; const float* WQ = F.in[14]; const float* g2 = F.in[13]; bf16_t* WSCp = WSP(bf16_t, WS_WSC);
      const int l15 = lane & 15, l4 = lane >> 4;
      for (int task = gw; task < 2048; task += NGW) { const int g = task >> 7, nt = (task >> 4) & 7, kc = task & 15, n0 = nt * 16;
          bf16x8 bfr[4];
#pragma unroll
          for (int kk = 0; kk < 4; ++kk) { const float* p = SK + ((size_t)g * 128 + n0 + l15) * 128 + 32 * kk + 8 * l4; const f32x4 a = *(const GAS f32x4*)p, b = *(const GAS f32x4*)(p + 4);
              const u32x4 w = pack8(a, b); bfr[kk] = __builtin_bit_cast(bf16x8, w); }
          for (int kt = 0; kt < 8; ++kt) { const int k0 = (kc * 8 + kt) * 16; f32x4 acc = (f32x4){0.f, 0.f, 0.f, 0.f};
#pragma unroll
              for (int kk = 0; kk < 4; ++kk) { const float* p = WQ + (size_t)(k0 + l15) * 2048 + g * 128 + 32 * kk + 8 * l4; const f32x4 a = *(const GAS f32x4*)p, b = *(const GAS f32x4*)(p + 4);
                  const u32x4 w = pack8(a, b); acc = __builtin_amdgcn_mfma_f32_16x16x32_bf16(__builtin_bit_cast(bf16x8, w), bfr[kk], acc, 0, 0, 0); }
              const f32x4 gg = *(const GAS f32x4*)(g2 + k0 + 4 * l4);
              *(GAS u32x2*)(WSCp + (size_t)(g * 128 + n0 + l15) * 2048 + k0 + 4 * l4) = pack4(acc * gg); } } }
}
using pg8::Unit;
struct SchedGrid {
    int G, c, nM, nN; const char* A; const char* B; size_t tstep;
    __device__ __forceinline__ bool next(int i, Unit& u) const { const int L = i * G + c; if (L >= nM * nN) return false; pg8::grid_order(L, nM, nN, u.pm, u.pn); u.kind = 0; return true; }
    __device__ __forceinline__ const char* pa(const Unit& u) const { return A + (size_t)u.pm * tstep; }
    __device__ __forceinline__ const char* pb(const Unit& u) const { return B + (size_t)u.pn * tstep; }
};
constexpr int P1_MAIN = 64 * 29, P1_VT = 4 * 65, P1_META = 7, P1_UNITS = P1_MAIN + P1_VT + P1_META;
struct SchedP1 {
    int G, c; const char* hn1; const char* win; const char* wvt; size_t tstep;
    __device__ __forceinline__ bool next(int i, Unit& u) const {
        const int L = i * G + c; if (L >= P1_UNITS) return false;
        if (L < P1_MAIN) { pg8::grid_order(L, 64, 29, u.pm, u.pn); u.kind = 0; }
        else if (L < P1_MAIN + P1_VT) { const int idx = L - P1_MAIN; u.pm = idx & 3; u.pn = idx >> 2; u.kind = 1; }
        else { const int idx = L - P1_MAIN - P1_VT; u.pm = 64; u.pn = idx < 4 ? 4 + idx : (idx < 6 ? 10 + (idx - 4) : 28); u.kind = 0; }
        return true; }
    __device__ __forceinline__ const char* pa(const Unit& u) const { return (u.kind == 1 ? wvt : hn1) + (size_t)u.pm * tstep; }
    __device__ __forceinline__ const char* pb(const Unit& u) const { return (u.kind == 1 ? hn1 : win) + (size_t)u.pn * tstep; }
};
__device__ __forceinline__ void rope4(const f32x4 x1, const f32x4 x2, const float* cosT, const float* sinT, int pos, int j0, f32x4& lo, f32x4& hi) {
    const f32x4 c = *(const GAS f32x4*)(cosT + pos * 32 + j0), s = *(const GAS f32x4*)(sinT + pos * 32 + j0);
    lo = x1 * c - x2 * s; hi = x2 * c + x1 * s;
}
struct EpiP1 {
    static constexpr bool PERM = true, HAS_PRE = false;
    unsigned char *naq, *nak, *vt; unsigned char *cq, *ckv; unsigned char *kr; unsigned char *ga, *gb; float *ssq_q, *ssq_kv; const float *cosT, *sinT;
    __device__ __forceinline__ void operator()(const f32x4 (&acc)[2][2][4][2], const Unit& u, int wr, int wc, int fr, int fq, const LAS float* rowsc) const {
        const int row0 = u.pm * 256 + wr * 64 + fr, colu = wc * 32 + 8 * fq;
        if (u.kind == 1) {
#pragma unroll
            for (int bj = 0; bj < 2; ++bj) { const int t0 = u.pn * 256 + bj * 128 + colu, pos = (t0 & ~63) + ((t0 & 63) >> 1);
#pragma unroll
                for (int ai = 0; ai < 2; ++ai)
#pragma unroll
                    for (int m = 0; m < 4; ++m) { unsigned char* rp = vt + (size_t)(row0 + ai * 128 + m * 16) * VT_PITCH + pos;
                        *(GAS unsigned*)rp = pack4_fp8(acc[ai][bj][m][0]); *(GAS unsigned*)(rp + 32) = pack4_fp8(acc[ai][bj][m][1]); } }
            return; }
        const int pn = u.pn;
        if (pn == 28) {
            if (wc < 2) { const int j0 = 4 * (4 * wc + fq);
#pragma unroll
                for (int ai = 0; ai < 2; ++ai)
#pragma unroll
                    for (int m = 0; m < 4; ++m) { const int row = row0 + ai * 128 + m * 16; const int pos = row < MREAL ? NMETA + (row & (SEQ - 1)) : row - MREAL;
                        f32x4 lo, hi; rope4(acc[ai][0][m][0], acc[ai][0][m][1], cosT, sinT, pos, j0, lo, hi);
                        *(GAS unsigned*)(kr + (size_t)row * 64 + j0) = pack4_fp8(lo); *(GAS unsigned*)(kr + (size_t)row * 64 + 32 + j0) = pack4_fp8(hi); } }
            return; }
        if (pn >= 12) {
            unsigned char* base = pn < 20 ? ga : gb; const int colt = (pn < 20 ? pn - 12 : pn - 20) * 256 + colu;
#pragma unroll
            for (int ai = 0; ai < 2; ++ai)
#pragma unroll
                for (int m = 0; m < 4; ++m) { unsigned char* rp = base + (size_t)(row0 + ai * 128 + m * 16) * 2048 + colt;
#pragma unroll
                    for (int bj = 0; bj < 2; ++bj) { f32x4 a = acc[ai][bj][m][0], b = acc[ai][bj][m][1];
#pragma unroll
                        for (int i = 0; i < 4; ++i) { a[i] = sigmoidf_(a[i]); b[i] = sigmoidf_(b[i]); }
                        *(GAS u32x2*)(rp + bj * 128) = pack8_u8(a, b); } }
            return; }
        if (pn >= 8) {
            const bool isq = pn < 10; unsigned char* base = isq ? cq : ckv; float* ssq = isq ? ssq_q : ssq_kv; const int colt = (isq ? pn - 8 : pn - 10) * 256 + colu;
#pragma unroll
            for (int ai = 0; ai < 2; ++ai)
#pragma unroll
                for (int m = 0; m < 4; ++m) { const int row = row0 + ai * 128 + m * 16; unsigned char* rp = base + (size_t)row * 512 + colt; float s = 0.f;
#pragma unroll
                    for (int bj = 0; bj < 2; ++bj) { const f32x4 a = acc[ai][bj][m][0], b = acc[ai][bj][m][1];
                        s += (a[0] * a[0] + a[1] * a[1]) + (a[2] * a[2] + a[3] * a[3]) + (b[0] * b[0] + b[1] * b[1]) + (b[2] * b[2] + b[3] * b[3]);
                        *(GAS u32x2*)(rp + bj * 128) = pack8_fp8(a, b); }
                    s += __shfl_xor(s, 16); s += __shfl_xor(s, 32);
                    if (fq == 0) ssq[(size_t)((pn & 1) * 4 + wc) * MPAD + row] = s; }
            return; }
        {
            unsigned char* base = pn < 4 ? naq : nak; const int colt = (pn & 3) * 256 + colu;
#pragma unroll
            for (int ai = 0; ai < 2; ++ai)
#pragma unroll
                for (int m = 0; m < 4; ++m) { unsigned char* rp = base + (size_t)(row0 + ai * 128 + m * 16) * 1024 + colt;
#pragma unroll
                    for (int bj = 0; bj < 2; ++bj) *(GAS u32x2*)(rp + bj * 128) = pack8_fp8(acc[ai][bj][m][0], acc[ai][bj][m][1]); }
        }
    }
};
constexpr int P3_Q = 64 * 12, P3_K = 65 * 8, P3_V = 8 * 65, P3_UNITS = P3_Q + P3_K + P3_V;
struct SchedP3 {
    int G, c; const char* ws; size_t tstep;
    __device__ __forceinline__ bool next(int i, Unit& u) const {
        const int L = i * G + c; if (L >= P3_UNITS) return false;
        if (L < P3_Q) { pg8::grid_order(L, 64, 12, u.pm, u.pn); u.kind = 0; }
        else if (L < P3_Q + P3_K) { pg8::grid_order(L - P3_Q, 65, 8, u.pm, u.pn); u.kind = 1; }
        else { const int idx = L - P3_Q - P3_K; u.pm = idx & 7; u.pn = idx >> 3; u.kind = 2; }
        return true; }
    __device__ __forceinline__ const char* pa(const Unit& u) const { const size_t o = u.kind == 0 ? WS_CQ : (u.kind == 1 ? WS_CKV : WS_WUKV + (size_t)2048 * 512); return ws + o + (size_t)u.pm * tstep; }
    __device__ __forceinline__ const char* pb(const Unit& u) const { const size_t o = u.kind == 0 ? WS_WUQ : (u.kind == 1 ? WS_WUKV : WS_CKV); return ws + o + (size_t)u.pn * tstep; }
};
template <int NS, int LD> __device__ __forceinline__ float rstd_slabs(const float* part, int row, float invn) {
    float s = 0.f;
#pragma unroll
    for (int i = 0; i < NS; ++i) s += part[(size_t)i * LD + row];
    return 1.0f / sqrtf(s * invn + NORM_EPS);
}
struct EpiP3 {
    static constexpr bool PERM = true, HAS_PRE = true;
    unsigned char *qm, *kn, *vt; const float *ssq_q, *ssq_kv; const float *cosT, *sinT;
    __device__ __forceinline__ void pre(const Unit& u, LAS float* sc, int tid) const { if (tid < 256) { const int row = (u.kind == 2 ? u.pn : u.pm) * 256 + tid; sc[tid] = u.kind ? rstd_slabs<8, MPAD>(ssq_kv, row, 1.f / 512.f) : rstd_slabs<8, MPAD>(ssq_q, row, 1.f / 512.f); } }
    __device__ __forceinline__ void operator()(const f32x4 (&acc)[2][2][4][2], const Unit& u, int wr, int wc, int fr, int fq, const LAS float* rowsc) const {
        const int row0 = u.pm * 256 + wr * 64 + fr, colu = wc * 32 + 8 * fq;
        if (u.kind == 2) {
#pragma unroll
            for (int bj = 0; bj < 2; ++bj) { const int cl = bj * 128 + colu, t0 = u.pn * 256 + cl;
                const f32x4 s0 = *(const LAS f32x4*)(rowsc + cl), s1 = *(const LAS f32x4*)(rowsc + cl + 4);
                const int g = (t0 >> 3) & 7, pos = (t0 & ~63) + 16 * (g >> 2) + 4 * (g & 3);
#pragma unroll
                for (int ai = 0; ai < 2; ++ai)
#pragma unroll
                    for (int m = 0; m < 4; ++m) { unsigned char* rp = vt + (size_t)(row0 + ai * 128 + m * 16) * MPAD + pos;
                        *(GAS unsigned*)rp = pack4_fp8(acc[ai][bj][m][0] * s0); *(GAS unsigned*)(rp + 32) = pack4_fp8(acc[ai][bj][m][1] * s1); } }
            return; }
        if (u.kind == 1) {
#pragma unroll
            for (int ai = 0; ai < 2; ++ai)
#pragma unroll
                for (int m = 0; m < 4; ++m) { const int row = row0 + ai * 128 + m * 16; const float rs = rowsc[ai * 128 + wr * 64 + m * 16 + fr];
                    unsigned char* rp = kn + (size_t)row * 2048 + u.pn * 256 + colu;
#pragma unroll
                    for (int bj = 0; bj < 2; ++bj) *(GAS u32x2*)(rp + bj * 128) = pack8_fp8(acc[ai][bj][m][0] * rs, acc[ai][bj][m][1] * rs); }
            return; }
#pragma unroll
        for (int bj = 0; bj < 2; ++bj) { const int c8 = u.pn * 256 + bj * 128 + colu; const int hd = c8 / 192, w = c8 - hd * 192;
            if (w < 128) {
#pragma unroll
                for (int ai = 0; ai < 2; ++ai)
#pragma unroll
                    for (int m = 0; m < 4; ++m) { const int row = row0 + ai * 128 + m * 16; const float rs = rowsc[ai * 128 + wr * 64 + m * 16 + fr];
                        *(GAS u32x2*)(qm + (size_t)row * 3072 + c8) = pack8_fp8(acc[ai][bj][m][0] * rs, acc[ai][bj][m][1] * rs); }
            } else { const int j0 = (w - 128) >> 1;
#pragma unroll
                for (int ai = 0; ai < 2; ++ai)
#pragma unroll
                    for (int m = 0; m < 4; ++m) { const int row = row0 + ai * 128 + m * 16; const float rs = rowsc[ai * 128 + wr * 64 + m * 16 + fr];
                        const int pos = NMETA + (row & (SEQ - 1)); f32x4 lo, hi; rope4(acc[ai][bj][m][0] * rs, acc[ai][bj][m][1] * rs, cosT, sinT, pos, j0, lo, hi);
                        unsigned char* qp = qm + (size_t)row * 3072 + hd * 192 + 128 + j0; *(GAS unsigned*)qp = pack4_fp8(lo); *(GAS unsigned*)(qp + 32) = pack4_fp8(hi); }
            } }
    }
};

__device__ __forceinline__ void unpack8(const u32x4 w, f32x4& a, f32x4& b) { a = (f32x4){bf_lo(w.x), bf_hi(w.x), bf_lo(w.y), bf_hi(w.y)}; b = (f32x4){bf_lo(w.z), bf_hi(w.z), bf_lo(w.w), bf_hi(w.w)}; }
struct EpiP5a {
    static constexpr bool PERM = true, HAS_PRE = false;
    const unsigned char* ga; unsigned char* t1;
    __device__ __forceinline__ void operator()(const f32x4 (&acc)[2][2][4][2], const Unit& u, int wr, int wc, int fr, int fq, const LAS float* rowsc) const {
        const int row0 = u.pm * 256 + wr * 64 + fr, col0 = u.pn * 256 + wc * 32 + 8 * fq;
#pragma unroll
        for (int ai = 0; ai < 2; ++ai)
#pragma unroll
            for (int m = 0; m < 4; ++m) { const size_t off = (size_t)(row0 + ai * 128 + m * 16) * 2048 + col0;
#pragma unroll
                for (int bj = 0; bj < 2; ++bj) { f32x4 g0, g1; unpack8_u8(*(const GAS u32x2*)(ga + off + bj * 128), g0, g1);
                    *(GAS u32x2*)(t1 + off + bj * 128) = pack8_fp8(acc[ai][bj][m][0] * g0 * 32.f, acc[ai][bj][m][1] * g1 * 32.f); } }
    }
};
struct EpiP5b {
    static constexpr bool PERM = true, HAS_PRE = false;
    const unsigned char* gb; const unsigned char* t1; unsigned char* merged;
    __device__ __forceinline__ void operator()(const f32x4 (&acc)[2][2][4][2], const Unit& u, int wr, int wc, int fr, int fq, const LAS float* rowsc) const {
        const int row0 = u.pm * 256 + wr * 64 + fr, col0 = u.pn * 256 + wc * 32 + 8 * fq;
#pragma unroll
        for (int ai = 0; ai < 2; ++ai)
#pragma unroll
            for (int m = 0; m < 4; ++m) { const size_t off = (size_t)(row0 + ai * 128 + m * 16) * 2048 + col0;
#pragma unroll
                for (int bj = 0; bj < 2; ++bj) { f32x4 g0, g1; unpack8_u8(*(const GAS u32x2*)(gb + off + bj * 128), g0, g1);
                    f32x4 a, b; unpack8_fp8(*(const GAS u32x2*)(t1 + off + bj * 128), a, b);
                    *(GAS u32x2*)(merged + off + bj * 128) = pack8_fp8(a + acc[ai][bj][m][0] * g0 * 32.f, b + acc[ai][bj][m][1] * g1 * 32.f); } }
    }
};
struct EpiP6 {
    static constexpr bool PERM = true, HAS_PRE = false;
    const float* x; bf16_t* h2b; float* ssq2;
    __device__ __forceinline__ void operator()(const f32x4 (&acc)[2][2][4][2], const Unit& u, int wr, int wc, int fr, int fq, const LAS float* rowsc) const {
        const int row0 = u.pm * 256 + wr * 64 + fr, col0 = u.pn * 256 + wc * 32 + 8 * fq;
#pragma unroll
        for (int ai = 0; ai < 2; ++ai)
#pragma unroll
            for (int m = 0; m < 4; ++m) { const int row = row0 + ai * 128 + m * 16; const size_t off = (size_t)row * 2048 + col0; float s = 0.f;
#pragma unroll
                for (int bj = 0; bj < 2; ++bj) { const f32x4 a = *(const GAS f32x4*)(x + off + bj * 128) + acc[ai][bj][m][0], b = *(const GAS f32x4*)(x + off + bj * 128 + 4) + acc[ai][bj][m][1];
                    s += (a[0] * a[0] + a[1] * a[1]) + (a[2] * a[2] + a[3] * a[3]) + (b[0] * b[0] + b[1] * b[1]) + (b[2] * b[2] + b[3] * b[3]);
                    *(GAS u32x4*)(h2b + off + bj * 128) = pack8(a, b); }
                s += __shfl_xor(s, 16); s += __shfl_xor(s, 32);
                if (fq == 0) ssq2[(size_t)(u.pn * 4 + wc) * MREAL + row] = s; }
    }
};
struct EpiP7 {
    static constexpr bool PERM = true, HAS_PRE = true;
    const float* ssq2; _Float16* sc;
    __device__ __forceinline__ void pre(const Unit& u, LAS float* sc, int tid) const { if (tid < 256) sc[tid] = rstd_slabs<32, MREAL>(ssq2, u.pm * 256 + tid, 1.f / 2048.f); }
    __device__ __forceinline__ void operator()(const f32x4 (&acc)[2][2][4][2], const Unit& u, int wr, int wc, int fr, int fq, const LAS float* rowsc) const {
        typedef _Float16 h4_t __attribute__((ext_vector_type(4)));
        const int row0 = u.pm * 256 + wr * 64 + fr, col0 = u.pn * 256 + wc * 32 + 8 * fq;
#pragma unroll
        for (int ai = 0; ai < 2; ++ai)
#pragma unroll
            for (int m = 0; m < 4; ++m) { const int row = row0 + ai * 128 + m * 16; const float rs = rowsc[ai * 128 + wr * 64 + m * 16 + fr]; const size_t off = (size_t)row * 2048 + col0;
#pragma unroll
                for (int bj = 0; bj < 2; ++bj) { const h4_t lo = __builtin_convertvector(acc[ai][bj][m][0] * rs, h4_t), hi = __builtin_convertvector(acc[ai][bj][m][1] * rs, h4_t);
                    const u32x2 wl = __builtin_bit_cast(u32x2, lo), wh = __builtin_bit_cast(u32x2, hi);
                    *(GAS u32x4*)(sc + off + bj * 128) = (u32x4){wl.x, wl.y, wh.x, wh.y}; } }
    }
};
namespace att {
#define KSWZ(row, colB) ((row) * 256 + ((colB) ^ (((row) & 7) << 4)))
#define KRSWZ(row, colB) ((row) * 128 + ((colB) ^ ((((row) >> 1) & 7) << 4)))
constexpr float L2E = 1.4426950408889634f;
template <int DUMMY = 0>
__device__ __forceinline__ void partialSM(f32x16& p0, f32x16& p1, float& m_reg, float& mn, float& alpha, const float C, const float THRS) {
  float pmax = p0[0];
#pragma unroll
  for (int r = 1; r < 16; ++r) pmax = fmaxf(pmax, p0[r]);
#pragma unroll
  for (int r = 0; r < 16; ++r) pmax = fmaxf(pmax, p1[r]);
  { auto rr = __builtin_amdgcn_permlane32_swap(__float_as_uint(pmax), __float_as_uint(pmax), false, false);
    pmax = fmaxf(__uint_as_float(rr[0]), __uint_as_float(rr[1])); }
  if (__builtin_expect(__all(pmax - m_reg <= THRS), 1)) { mn = m_reg; alpha = 1.f; }
  else { mn = fmaxf(m_reg, pmax); alpha = __builtin_amdgcn_exp2f((m_reg - mn) * C); m_reg = mn; }
  const float mnC = -mn * C;
#pragma unroll
  for (int r = 0; r < 16; ++r) p0[r] = fmaf(p0[r], C, mnC);
#pragma unroll
  for (int r = 0; r < 16; ++r) p1[r] = fmaf(p1[r], C, mnC);
#pragma unroll
  for (int r = 0; r < 16; ++r) p0[r] = __builtin_amdgcn_exp2f(p0[r]);
}
__device__ __forceinline__ void finishSM(f32x16& p0, f32x16& p1, float alpha, float& l_reg, bf16x8& pa0, bf16x8& pa1, bf16x8& pa2, bf16x8& pa3) {
#pragma unroll
  for (int r = 0; r < 16; ++r) p1[r] = __builtin_amdgcn_exp2f(p1[r]);
  float ps = 0;
#pragma unroll
  for (int r = 0; r < 16; ++r) ps += p0[r];
#pragma unroll
  for (int r = 0; r < 16; ++r) ps += p1[r];
  { auto rr = __builtin_amdgcn_permlane32_swap(__float_as_uint(ps), __float_as_uint(ps), false, false);
    ps = __uint_as_float(rr[0]) + __uint_as_float(rr[1]); }
  l_reg = l_reg * alpha + ps;
#define PK4(P, BASE, OUT) do { unsigned a0 = cvt_pk_bf16(P[BASE + 0], P[BASE + 1]), a1 = cvt_pk_bf16(P[BASE + 2], P[BASE + 3]);   \
    unsigned b0 = cvt_pk_bf16(P[BASE + 4], P[BASE + 5]), b1 = cvt_pk_bf16(P[BASE + 6], P[BASE + 7]);                              \
    auto r0 = __builtin_amdgcn_permlane32_swap(a0, b0, false, false); auto r1 = __builtin_amdgcn_permlane32_swap(a1, b1, false, false); \
    u32x4 w = {r0[0], r1[0], r0[1], r1[1]}; OUT = __builtin_bit_cast(bf16x8, w); } while (0)
  PK4(p0, 0, pa0); PK4(p0, 8, pa1); PK4(p1, 0, pa2); PK4(p1, 8, pa3);
#undef PK4
}
constexpr int NW = 8, QBLK = 32, KVBLK = 64;
constexpr float MLA_SCALE = 0.07216878364870322f;
constexpr float MLA_THR = 8.f;
constexpr int SHM_V = KVBLK * 128 * 2, SHM_KN = KVBLK * 128 * 2, SHM_KR = KVBLK * 64 * 2;
constexpr int OFF_V = 0, OFF_KN = 2 * SHM_V, OFF_KR = OFF_KN + 2 * SHM_KN, OFF_WS = OFF_KR + 2 * SHM_KR, OFF_QR = OFF_WS + NW * 64 * 4, MLA_LDS = OFF_QR + NW * 4096;
__device__ __forceinline__ void qkt(f32x16& p0, f32x16& p1, const LAS char* Kn, const LAS char* Kr, const bf16x8* qr, const LAS char* qrp, const int* kb, const int* krb) {
  p0 = f32x16{}; p1 = f32x16{};
#pragma unroll
  for (int d0 = 0; d0 < 8; ++d0) {
    const bf16x8 b0 = *(const LAS bf16x8*)(Kn + kb[d0 & 3] + (d0 >> 2) * 128);
    const bf16x8 b1 = *(const LAS bf16x8*)(Kn + kb[d0 & 3] + (d0 >> 2) * 128 + 8192);
    p0 = __builtin_amdgcn_mfma_f32_32x32x16_bf16(b0, qr[d0], p0, 0, 0, 0);
    p1 = __builtin_amdgcn_mfma_f32_32x32x16_bf16(b1, qr[d0], p1, 0, 0, 0); }
#pragma unroll
  for (int d0 = 0; d0 < 4; ++d0) {
    const bf16x8 b0 = *(const LAS bf16x8*)(Kr + krb[d0]);
    const bf16x8 b1 = *(const LAS bf16x8*)(Kr + krb[d0] + 4096);
    const bf16x8 qf = *(const LAS bf16x8*)(qrp + d0 * 1024);
    p0 = __builtin_amdgcn_mfma_f32_32x32x16_bf16(b0, qf, p0, 0, 0, 0);
    p1 = __builtin_amdgcn_mfma_f32_32x32x16_bf16(b1, qf, p1, 0, 0, 0); }
}
__device__ __forceinline__ int v_st(int k, int c) { const int kk = (k & ~0xC) | ((k & 4) << 1) | ((k & 8) >> 1); return ((kk >> 3) * 4 + (c >> 5)) * 512 + ((kk & 7) * 32 + (c & 31)) * 2; }
__device__ __forceinline__ int v_rd_base(int lane) { return ((lane & 3) << 3) | (((lane >> 2) & 3) << 6) | (((lane >> 4) & 1) << 5) | (((lane >> 5) & 1) << 8); }
constexpr int v_rd_off(int d0, int ks, int half) { return d0 * 512 + ks * 4096 + half * 2048; }
template <int OFF> __device__ __forceinline__ s16x4 tr_read(int vb) {
  s16x4 r; asm volatile("ds_read_b64_tr_b16 %0, %1 offset:%2" : "=&v"(r) : "v"(vb), "i"(OFF) : "memory"); return r;
}
template <int D0> __device__ __forceinline__ void pv_one(f32x16& od, int vb, bf16x8 pa0, bf16x8 pa1, bf16x8 pa2, bf16x8 pa3) {
  const s16x4 l0 = tr_read<v_rd_off(D0, 0, 0)>(vb), h0 = tr_read<v_rd_off(D0, 0, 1)>(vb), l1 = tr_read<v_rd_off(D0, 1, 0)>(vb), h1 = tr_read<v_rd_off(D0, 1, 1)>(vb);
  const s16x4 l2 = tr_read<v_rd_off(D0, 2, 0)>(vb), h2 = tr_read<v_rd_off(D0, 2, 1)>(vb), l3 = tr_read<v_rd_off(D0, 3, 0)>(vb), h3 = tr_read<v_rd_off(D0, 3, 1)>(vb);
  asm volatile("s_waitcnt lgkmcnt(0)" ::: "memory"); SBAR();
#define PK(L, H) (bf16x8){L[0], L[1], L[2], L[3], H[0], H[1], H[2], H[3]}
  od = __builtin_amdgcn_mfma_f32_32x32x16_bf16(pa0, PK(l0, h0), od, 0, 0, 0);
  od = __builtin_amdgcn_mfma_f32_32x32x16_bf16(pa1, PK(l1, h1), od, 0, 0, 0);
  od = __builtin_amdgcn_mfma_f32_32x32x16_bf16(pa2, PK(l2, h2), od, 0, 0, 0);
  od = __builtin_amdgcn_mfma_f32_32x32x16_bf16(pa3, PK(l3, h3), od, 0, 0, 0);
#undef PK
}
__device__ __forceinline__ void pv_d0(f32x16* o, int vb, bf16x8 pa0, bf16x8 pa1, bf16x8 pa2, bf16x8 pa3) {
  pv_one<0>(o[0], vb, pa0, pa1, pa2, pa3); pv_one<1>(o[1], vb, pa0, pa1, pa2, pa3); pv_one<2>(o[2], vb, pa0, pa1, pa2, pa3); pv_one<3>(o[3], vb, pa0, pa1, pa2, pa3);
}
__device__ __forceinline__ void mla_unit(int b, int h, int qb, const bf16_t* __restrict__ QM, const bf16_t* __restrict__ KN, const bf16_t* __restrict__ KR, const bf16_t* __restrict__ VV, unsigned char* __restrict__ OM, LAS char* lds) {
  const int tid = threadIdx.x, wid = tid >> 6, lane = tid & 63, r32 = lane & 31, hi = lane >> 5;
  constexpr float C = MLA_SCALE * L2E, THRS = MLA_THR / MLA_SCALE;
  constexpr int NT = 33;
  LAS char* V_lds = lds + OFF_V; LAS char* Kn_lds = lds + OFF_KN; LAS char* Kr_lds = lds + OFF_KR;
  LAS float* ws = (LAS float*)(lds + OFF_WS) + wid * 64; LAS float* li_l = ws; LAS float* al_l = ws + 32;
  float m_reg = -1e30f, l_reg = 0; f32x16 o[4] = {}; bf16x8 qr[8];
  LAS char* qrp = lds + OFF_QR + wid * 4096 + lane * 16;
  const int qrow = b * SEQ + qb * 256 + wid * QBLK + r32;
  const bf16_t* Qw = QM + (size_t)qrow * 3072 + h * 192 + hi * 8;
#pragma unroll
  for (int d0 = 0; d0 < 8; ++d0) qr[d0] = *(const GAS bf16x8*)(Qw + d0 * 16);
  __syncthreads();
#pragma unroll
  for (int d0 = 0; d0 < 4; ++d0) *(LAS bf16x8*)(qrp + d0 * 1024) = *(const GAS bf16x8*)(Qw + (8 + d0) * 16);
  const int sr = tid >> 4, sc = (tid & 15) * 8, vst0 = v_st(sr, sc), vst1 = v_st(32 + sr, sc);
  const int krr = tid >> 3, krc = (tid & 7) * 8;
  const int vb0 = (int)(uintptr_t)V_lds + v_rd_base(lane);
  bf16x8 s_v0, s_v1, s_k0, s_k1, s_kr;
  const int realbase = b * SEQ - KVBLK;
  const unsigned voff = (unsigned)(sr * 2048 + sc) * 2u, kroff = (unsigned)(krr * 64 + krc) * 2u;
  int kb[4], krb[4];
#pragma unroll
  for (int bq = 0; bq < 4; ++bq) { kb[bq] = KSWZ(r32, bq * 32 + hi * 16); krb[bq] = KRSWZ(r32, bq * 32 + hi * 16); }
#define TROW(t) ((t) == 0 ? MREAL : realbase + (t) * KVBLK)
#define SLOAD(t) do { const int k0_ = TROW(t); const size_t ro_ = ((size_t)k0_ * 2048 + h * 128) * 2; \
    const GAS char* vb_ = (const GAS char*)VV + ro_; const GAS char* nb_ = (const GAS char*)KN + ro_; const GAS char* rb_ = (const GAS char*)KR + (size_t)k0_ * 128; \
    s_v0 = *(const GAS bf16x8*)(vb_ + voff); s_v1 = *(const GAS bf16x8*)(vb_ + 32 * 4096 + voff); \
    s_k0 = *(const GAS bf16x8*)(nb_ + voff); s_k1 = *(const GAS bf16x8*)(nb_ + 32 * 4096 + voff); \
    s_kr = *(const GAS bf16x8*)(rb_ + kroff); } while (0)
#define SWRITE(bf) do { *(LAS bf16x8*)(V_lds + (bf) * SHM_V + vst0) = s_v0; *(LAS bf16x8*)(V_lds + (bf) * SHM_V + vst1) = s_v1; const int kc_ = sc * 2; \
    *(LAS bf16x8*)(Kn_lds + (bf) * SHM_KN + KSWZ(sr, kc_)) = s_k0; *(LAS bf16x8*)(Kn_lds + (bf) * SHM_KN + KSWZ(32 + sr, kc_)) = s_k1; \
    *(LAS bf16x8*)(Kr_lds + (bf) * SHM_KR + KRSWZ(krr, krc * 2)) = s_kr; } while (0)
#define SWAIT() asm volatile("s_waitcnt vmcnt(0)" ::: "memory")
#define RESC(a) do { if (__any((a) < 1.f)) { if (hi == 0) al_l[r32] = (a); asm volatile("s_waitcnt lgkmcnt(0)" ::: "memory"); \
    _Pragma("unroll") for (int d = 0; d < 4; ++d) _Pragma("unroll") for (int r = 0; r < 16; ++r) o[d][r] *= al_l[crow(r, hi)]; } } while (0)
  f32x16 pA0, pA1, pB0, pB1; float mnA, mnB, alA, alB; bf16x8 pa0, pa1, pa2, pa3;
  SLOAD(0); SWAIT(); SWRITE(0); __syncthreads();
  qkt(pA0, pA1, Kn_lds, Kr_lds, qr, qrp, kb, krb);
  { const float NEG = -INFINITY;
#pragma unroll
    for (int r = 8; r < 16; ++r) pA0[r] = NEG;
#pragma unroll
    for (int r = 0; r < 16; ++r) pA1[r] = NEG; }
  partialSM(pA0, pA1, m_reg, mnA, alA, C, THRS);
  SLOAD(1); SWAIT(); SWRITE(1); __syncthreads();
  for (int j = 1; j + 1 < NT; j += 2) {
    SBAR(); qkt(pB0, pB1, Kn_lds + SHM_KN, Kr_lds + SHM_KR, qr, qrp, kb, krb);
    finishSM(pA0, pA1, alA, l_reg, pa0, pa1, pa2, pa3); SBAR();
    SLOAD(j + 1); SBAR();
    pv_d0(o, vb0, pa0, pa1, pa2, pa3); partialSM(pB0, pB1, m_reg, mnB, alB, C, THRS);
    __syncthreads(); SWAIT(); SWRITE(0);
    RESC(alB); __syncthreads();
    SBAR(); qkt(pA0, pA1, Kn_lds, Kr_lds, qr, qrp, kb, krb);
    finishSM(pB0, pB1, alB, l_reg, pa0, pa1, pa2, pa3); SBAR();
    if (j + 2 < NT) SLOAD(j + 2); SBAR();
    pv_d0(o, vb0 + SHM_V, pa0, pa1, pa2, pa3); partialSM(pA0, pA1, m_reg, mnA, alA, C, THRS);
    __syncthreads(); if (j + 2 < NT) { SWAIT(); SWRITE(1); }
    RESC(alA); __syncthreads();
  }
  finishSM(pA0, pA1, alA, l_reg, pa0, pa1, pa2, pa3); SBAR();
  pv_d0(o, vb0, pa0, pa1, pa2, pa3);
  if (hi == 0) li_l[r32] = l_reg; asm volatile("s_waitcnt lgkmcnt(0)" ::: "memory");
  float rli[16];
#pragma unroll
  for (int r = 0; r < 16; ++r) rli[r] = __builtin_amdgcn_rcpf(li_l[crow(r, hi)]);
  unsigned char* Ow = OM + (size_t)(b * SEQ + qb * 256 + wid * QBLK) * 2048 + h * 128;
#pragma unroll
  for (int r = 0; r < 16; ++r) { const int orow = crow(r, hi);
#pragma unroll
    for (int d0 = 0; d0 < 4; ++d0) Ow[(size_t)orow * 2048 + d0 * 32 + r32] = f32_to_fp8(o[d0][r] * rli[r] * 32.f); }
#undef TROW
#undef SLOAD
#undef SWRITE
#undef SWAIT
#undef RESC
}
constexpr int K8S = 208, V8S = 80, SHM8_K = 64 * K8S, SHM8_V = 128 * V8S;
constexpr int OFF8_K = 0, OFF8_V = 2 * SHM8_K, OFF8_WS = OFF8_V + 2 * SHM8_V, MLA8_LDS = OFF8_WS + NW * 64 * 4;
constexpr float MLA8_THR = 1.9f;
typedef int a8_t __attribute__((ext_vector_type(8)));
#define MFMA8(acc_, a_, b_, sa_, sb_) asm volatile("s_nop 1\n\tv_mfma_scale_f32_32x32x64_f8f6f4 %0, %1, %2, %0, %3, %4 op_sel_hi:[0,0,0]" : "+v"(acc_) : "v"(a_), "v"(b_), "v"(sa_), "v"(sb_))
__device__ __forceinline__ a8_t ld_frag8(const LAS char* p) { const u32x4 lo = *(const LAS u32x4*)p, hi = *(const LAS u32x4*)(p + 16); return (a8_t){(int)lo.x, (int)lo.y, (int)lo.z, (int)lo.w, (int)hi.x, (int)hi.y, (int)hi.z, (int)hi.w}; }
__device__ __forceinline__ void qkt8(f32x16& p0, f32x16& p1, const LAS char* Kb, const a8_t& q0, const a8_t& q1, const a8_t& q2, int s1) {
  p0 = f32x16{}; p1 = f32x16{};
  { const a8_t a0 = ld_frag8(Kb), a1 = ld_frag8(Kb + 32 * K8S); MFMA8(p0, a0, q0, s1, s1); MFMA8(p1, a1, q0, s1, s1); }
  { const a8_t a0 = ld_frag8(Kb + 64), a1 = ld_frag8(Kb + 32 * K8S + 64); MFMA8(p0, a0, q1, s1, s1); MFMA8(p1, a1, q1, s1, s1); }
  { const a8_t a0 = ld_frag8(Kb + 128), a1 = ld_frag8(Kb + 32 * K8S + 128); MFMA8(p0, a0, q2, s1, s1); MFMA8(p1, a1, q2, s1, s1); }
  asm volatile("s_nop 15\n\ts_nop 15" : "+v"(p0), "+v"(p1));
}
__device__ __forceinline__ void partialSM8(f32x16& p0, f32x16& p1, float& m_reg, float& mn, float& alpha, const float C, const float THRS) {
  float pmax = p0[0];
#pragma unroll
  for (int r = 1; r < 16; ++r) pmax = fmaxf(pmax, p0[r]);
#pragma unroll
  for (int r = 0; r < 16; ++r) pmax = fmaxf(pmax, p1[r]);
  { auto rr = __builtin_amdgcn_permlane32_swap(__float_as_uint(pmax), __float_as_uint(pmax), false, false);
    pmax = fmaxf(__uint_as_float(rr[0]), __uint_as_float(rr[1])); }
  if (__builtin_expect(__all(pmax - m_reg <= THRS), 1)) { mn = m_reg; alpha = 1.f; }
  else { mn = fmaxf(m_reg, pmax); alpha = __builtin_amdgcn_exp2f((m_reg - mn) * C); m_reg = mn; }
  const float mnC = 6.f - mn * C;
#pragma unroll
  for (int r = 0; r < 16; ++r) p0[r] = fmaf(p0[r], C, mnC);
#pragma unroll
  for (int r = 0; r < 16; ++r) p1[r] = fmaf(p1[r], C, mnC);
#pragma unroll
  for (int r = 0; r < 16; ++r) p0[r] = __builtin_amdgcn_exp2f(p0[r]);
}
__device__ __forceinline__ void finishSM8(f32x16& p0, f32x16& p1, float alpha, float& l_reg, a8_t& pf) {
#pragma unroll
  for (int r = 0; r < 16; ++r) p1[r] = __builtin_amdgcn_exp2f(p1[r]);
  float ps = 0;
#pragma unroll
  for (int r = 0; r < 16; ++r) ps += p0[r];
#pragma unroll
  for (int r = 0; r < 16; ++r) ps += p1[r];
  { auto rr = __builtin_amdgcn_permlane32_swap(__float_as_uint(ps), __float_as_uint(ps), false, false);
    ps = __uint_as_float(rr[0]) + __uint_as_float(rr[1]); }
  l_reg = l_reg * alpha + ps;
#pragma unroll
  for (int w = 0; w < 4; ++w) { int x = 0, y = 0;
    x = __builtin_amdgcn_cvt_pk_fp8_f32(p0[4 * w], p0[4 * w + 1], x, false); x = __builtin_amdgcn_cvt_pk_fp8_f32(p0[4 * w + 2], p0[4 * w + 3], x, true);
    y = __builtin_amdgcn_cvt_pk_fp8_f32(p1[4 * w], p1[4 * w + 1], y, false); y = __builtin_amdgcn_cvt_pk_fp8_f32(p1[4 * w + 2], p1[4 * w + 3], y, true);
    pf[w] = x; pf[4 + w] = y; }
}
__device__ __forceinline__ void pv8(f32x16* o, const LAS char* Vb, const a8_t& pf, int sP, int s1) {
  const a8_t b0 = ld_frag8(Vb), b1 = ld_frag8(Vb + 32 * V8S), b2 = ld_frag8(Vb + 64 * V8S), b3 = ld_frag8(Vb + 96 * V8S);
  MFMA8(o[0], pf, b0, sP, s1); MFMA8(o[1], pf, b1, sP, s1); MFMA8(o[2], pf, b2, sP, s1); MFMA8(o[3], pf, b3, sP, s1);
  asm volatile("s_nop 15\n\ts_nop 15" : "+v"(o[0]), "+v"(o[1]), "+v"(o[2]), "+v"(o[3]));
}
__device__ __forceinline__ void mla_unit8(int b, int h, int qb, const unsigned char* __restrict__ QM8, const unsigned char* __restrict__ KN8, const unsigned char* __restrict__ KR8, const unsigned char* __restrict__ VT8,
                                          unsigned char* __restrict__ OM, LAS char* lds) {
  const int tid = threadIdx.x, wid = tid >> 6, lane = tid & 63, r32 = lane & 31, hi = lane >> 5;
  constexpr float C = MLA_SCALE * L2E, THRS = MLA8_THR / MLA_SCALE;
  constexpr int NT = 33;
  LAS char* K_lds = lds + OFF8_K; LAS char* V_lds = lds + OFF8_V;
  LAS float* ws = (LAS float*)(lds + OFF8_WS) + wid * 64; LAS float* li_l = ws; LAS float* al_l = ws + 32;
  int s1 = 0x7f7f7f7f, sP = 0x79797979; asm volatile("" : "+v"(s1), "+v"(sP));
  float m_reg = -1e30f, l_reg = 0; f32x16 o[4] = {};
  const int qrow = b * SEQ + qb * 256 + wid * QBLK + r32;
  a8_t q0, q1, q2;
  { const unsigned char* Qw = QM8 + (size_t)qrow * 3072 + h * 192 + hi * 32;
    const u32x4 a = *(const GAS u32x4*)Qw, bq = *(const GAS u32x4*)(Qw + 16), c = *(const GAS u32x4*)(Qw + 64), d = *(const GAS u32x4*)(Qw + 80), e = *(const GAS u32x4*)(Qw + 128), f = *(const GAS u32x4*)(Qw + 144);
    q0 = (a8_t){(int)a.x, (int)a.y, (int)a.z, (int)a.w, (int)bq.x, (int)bq.y, (int)bq.z, (int)bq.w};
    q1 = (a8_t){(int)c.x, (int)c.y, (int)c.z, (int)c.w, (int)d.x, (int)d.y, (int)d.z, (int)d.w};
    q2 = (a8_t){(int)e.x, (int)e.y, (int)e.z, (int)e.w, (int)f.x, (int)f.y, (int)f.z, (int)f.w}; }
  __syncthreads();
  const int kkey = tid >> 3, kch = tid & 7, rkey = (tid >> 2) & 63, rch = tid & 3, vdim = tid >> 2, vch = tid & 3;
  const LAS char* Kf = K_lds + r32 * K8S + 32 * hi; const LAS char* Vf = V_lds + r32 * V8S + 32 * hi;
  u32x4 s_k, s_r, s_v;
  const int realbase = b * SEQ - KVBLK;
#define TROW(t) ((t) == 0 ? MREAL : realbase + (t) * KVBLK)
#define SLOAD(t) do { const int k0_ = TROW(t); \
    s_k = *(const GAS u32x4*)(KN8 + (size_t)(k0_ + kkey) * 2048 + h * 128 + kch * 16); \
    s_r = *(const GAS u32x4*)(KR8 + (size_t)(k0_ + rkey) * 64 + rch * 16); \
    s_v = *(const GAS u32x4*)(VT8 + (size_t)(h * 128 + vdim) * MPAD + k0_ + vch * 16); } while (0)
#define SWRITE(bf) do { *(LAS u32x4*)(K_lds + (bf) * SHM8_K + kkey * K8S + kch * 16) = s_k; if (tid < 256) *(LAS u32x4*)(K_lds + (bf) * SHM8_K + rkey * K8S + 128 + rch * 16) = s_r; \
    *(LAS u32x4*)(V_lds + (bf) * SHM8_V + vdim * V8S + vch * 16) = s_v; } while (0)
#define SWAIT() asm volatile("s_waitcnt vmcnt(0)" ::: "memory")
#define RESC(a) do { if (__any((a) < 1.f)) { if (hi == 0) al_l[r32] = (a); asm volatile("s_waitcnt lgkmcnt(0)" ::: "memory"); \
    _Pragma("unroll") for (int d = 0; d < 4; ++d) _Pragma("unroll") for (int r = 0; r < 16; ++r) o[d][r] *= al_l[crow(r, hi)]; } } while (0)
  f32x16 pA0, pA1, pB0, pB1; float mnA, mnB, alA, alB; a8_t pf;
  SLOAD(0); SWAIT(); SWRITE(0); __syncthreads();
  qkt8(pA0, pA1, Kf, q0, q1, q2, s1);
  { const float NEG = -INFINITY;
#pragma unroll
    for (int r = 8; r < 16; ++r) pA0[r] = NEG;
#pragma unroll
    for (int r = 0; r < 16; ++r) pA1[r] = NEG; }
  partialSM8(pA0, pA1, m_reg, mnA, alA, C, THRS);
  SLOAD(1); SWAIT(); SWRITE(1); __syncthreads();
  for (int j = 1; j + 1 < NT; j += 2) {
    SBAR(); qkt8(pB0, pB1, Kf + SHM8_K, q0, q1, q2, s1);
    finishSM8(pA0, pA1, alA, l_reg, pf); SBAR();
    SLOAD(j + 1); SBAR();
    pv8(o, Vf, pf, sP, s1); partialSM8(pB0, pB1, m_reg, mnB, alB, C, THRS);
    __syncthreads(); SWAIT(); SWRITE(0);
    RESC(alB); __syncthreads();
    SBAR(); qkt8(pA0, pA1, Kf, q0, q1, q2, s1);
    finishSM8(pB0, pB1, alB, l_reg, pf); SBAR();
    if (j + 2 < NT) SLOAD(j + 2); SBAR();
    pv8(o, Vf + SHM8_V, pf, sP, s1); partialSM8(pA0, pA1, m_reg, mnA, alA, C, THRS);
    __syncthreads(); if (j + 2 < NT) { SWAIT(); SWRITE(1); }
    RESC(alA); __syncthreads();
  }
  finishSM8(pA0, pA1, alA, l_reg, pf); SBAR();
  pv8(o, Vf, pf, sP, s1);
  if (hi == 0) li_l[r32] = l_reg; asm volatile("s_waitcnt lgkmcnt(0)" ::: "memory");
  float rli[16];
#pragma unroll
  for (int r = 0; r < 16; ++r) rli[r] = __builtin_amdgcn_rcpf(li_l[crow(r, hi)]) * (64.f * 32.f);
  unsigned char* Ow = OM + (size_t)(b * SEQ + qb * 256 + wid * QBLK) * 2048 + h * 128;
#pragma unroll
  for (int r = 0; r < 16; ++r) { const int orow = crow(r, hi);
#pragma unroll
    for (int d0 = 0; d0 < 4; ++d0) Ow[(size_t)orow * 2048 + d0 * 32 + r32] = f32_to_fp8(o[d0][r] * rli[r]); }
#undef TROW
#undef SLOAD
#undef SWRITE
#undef SWAIT
#undef RESC
}
__device__ __forceinline__ void na_task(int task, const unsigned char* __restrict__ NAQ, const unsigned char* __restrict__ NAK, const unsigned char* __restrict__ VT, unsigned char* __restrict__ ONA,
                                        const LAS float* relb, const LAS float* metab, LAS float* wsf, int lane, Conv& cv) {
  const int r32 = lane & 31, hi = lane >> 5;
  const int half = task & 1, r = (task >> 1) & 31, h = (task >> 6) & 15, b = task >> 10;
  const int qc = half * 32 + r32;
  const int cs = min(max(qc - 8, 0), 48), rs = min(max(r - 4, 0), 24);
  const int qtok = b * SEQ + r * 64 + qc;
  constexpr float C = L2E, THRS = 1.9f, SCALE = 0.125f;
  int s1 = 0x7f7f7f7f, sP = 0x79797979; asm volatile("" : "+v"(s1), "+v"(sP));
  a8_t qf; { const unsigned char* qp = NAQ + (size_t)qtok * 1024 + h * 64 + hi * 32; const u32x4 a = *(const GAS u32x4*)qp, c = *(const GAS u32x4*)(qp + 16);
    qf = (a8_t){(int)a.x, (int)a.y, (int)a.z, (int)a.w, (int)c.x, (int)c.y, (int)c.z, (int)c.w}; }
  float m_reg = -1e30f, l_reg = 0.f; f32x16 o[2] = {};
  LAS float* al_l = wsf; LAS float* li_l = wsf + 32;
  const float NEG = -INFINITY;
  const int kb0 = half * 16;
  const unsigned long long wm = 0xFFFFull << (cs - kb0);
  const unsigned mh0 = (unsigned)wm >> (4 * hi), mh1 = (unsigned)(wm >> 32) >> (4 * hi);
  const unsigned char* kq = NAK + (size_t)r32 * 1024 + h * 64 + hi * 32;
  const unsigned char* kq2 = NAK + (size_t)(32 + (r32 & 15)) * 1024 + h * 64 + hi * 32;
  const unsigned char* vq = VT + (size_t)(h * 64 + r32) * VT_PITCH + 32 * hi;
#define NA_KTOK(w) ((w) == 8 ? MREAL : b * SEQ + (rs + (w)) * 64 + kb0)
#define NA_VOFF(w) ((w) == 8 ? MREAL : b * SEQ + (rs + (w)) * 64 + (kb0 >> 1))
#define NA_LOADK(KF, w) do { const size_t ko_ = (size_t)NA_KTOK(w) * 1024; KF[0] = *(const GAS u32x4*)(kq + ko_); KF[1] = *(const GAS u32x4*)(kq + ko_ + 16); KF[2] = *(const GAS u32x4*)(kq2 + ko_); KF[3] = *(const GAS u32x4*)(kq2 + ko_ + 16); } while (0)
#define NA_A8(x_, y_) (a8_t){(int)x_.x, (int)x_.y, (int)x_.z, (int)x_.w, (int)y_.x, (int)y_.y, (int)y_.z, (int)y_.w}
#define NA_TILE(KF, wt, YN) do { \
    u32x4 va0, va1; u32x2 vb0_, vb1_; { const unsigned char* vp_ = vq + NA_VOFF(wt); va0 = *(const GAS u32x4*)vp_; vb0_ = *(const GAS u32x2*)(vp_ + 16); va1 = *(const GAS u32x4*)(vp_ + (size_t)32 * VT_PITCH); vb1_ = *(const GAS u32x2*)(vp_ + (size_t)32 * VT_PITCH + 16); } \
    f32x16 p0 = {}, p1 = {}; \
    { const a8_t k0_ = NA_A8(KF[0], KF[1]), k1_ = NA_A8(KF[2], KF[3]); MFMA8(p0, k0_, qf, s1, s1); MFMA8(p1, k1_, qf, s1, s1); asm volatile("s_nop 15\n\ts_nop 15" : "+v"(p0), "+v"(p1)); } \
    if ((wt) + 1 < 9) NA_LOADK(KF, (wt) + 1);            \
    asm volatile("" ::: "memory"); if ((cv.tick++ & 1) == 0) conv_step<12>(cv, lane);     \
    if ((wt) < 8) { const LAS float* bp_ = relb + ((h * 15 + (rs + (wt) - r + 7)) * 31 + 15 - qc + 4 * hi + kb0);     \
      float bv0[16], bv1[8];        \
      _Pragma("unroll") for (int rg = 0; rg < 16; ++rg) { const int c_ = (rg & 3) + 8 * (rg >> 2); bv0[rg] = bp_[c_]; if (rg < 8) bv1[rg] = bp_[c_ + 32]; } \
      _Pragma("unroll") for (int rg = 0; rg < 16; ++rg) { asm volatile("" : "+v"(bv0[rg])); if (rg < 8) asm volatile("" : "+v"(bv1[rg])); } \
      _Pragma("unroll") for (int rg = 0; rg < 16; ++rg) { const int c_ = (rg & 3) + 8 * (rg >> 2); \
        { const bool ok = (mh0 >> c_) & 1u; p0[rg] = ok ? fmaf(p0[rg], SCALE, bv0[rg]) : NEG; } \
        if (rg < 8) { const bool ok = (mh1 >> c_) & 1u; p1[rg] = ok ? fmaf(p1[rg], SCALE, bv1[rg]) : NEG; } } \
    } else { const LAS float* bp = metab + h * 16; \
      _Pragma("unroll") for (int rg = 0; rg < 16; ++rg) { const int kc = crow(rg, hi); p0[rg] = (rg < 8) ? fmaf(p0[rg], SCALE, bp[kc & 15]) : NEG; if (rg < 8) p1[rg] = NEG; } } \
      \
    float pmax = p0[0]; \
    _Pragma("unroll") for (int rg = 1; rg < 16; ++rg) pmax = fmaxf(pmax, p0[rg]); \
    _Pragma("unroll") for (int rg = 0; rg < 8; ++rg) pmax = fmaxf(pmax, p1[rg]); \
    { auto rr = __builtin_amdgcn_permlane32_swap(__float_as_uint(pmax), __float_as_uint(pmax), false, false); pmax = fmaxf(__uint_as_float(rr[0]), __uint_as_float(rr[1])); } \
    float mn, alpha; \
    if (__builtin_expect(__all(pmax - m_reg <= THRS), 1)) { mn = m_reg; alpha = 1.f; } \
    else { mn = fmaxf(m_reg, pmax); alpha = __builtin_amdgcn_exp2f((m_reg - mn) * C); m_reg = mn; } \
    const float mnC = 6.f - mn * C; float ps = 0.f;        \
    _Pragma("unroll") for (int rg = 0; rg < 16; ++rg) { p0[rg] = __builtin_amdgcn_exp2f(fmaf(p0[rg], C, mnC)); ps += p0[rg]; } \
    _Pragma("unroll") for (int rg = 0; rg < 8; ++rg) { p1[rg] = __builtin_amdgcn_exp2f(fmaf(p1[rg], C, mnC)); ps += p1[rg]; } \
    { auto rr = __builtin_amdgcn_permlane32_swap(__float_as_uint(ps), __float_as_uint(ps), false, false); ps = __uint_as_float(rr[0]) + __uint_as_float(rr[1]); } \
    l_reg = l_reg * alpha + ps; \
    a8_t pf;   \
    _Pragma("unroll") for (int w_ = 0; w_ < 4; ++w_) { int x = 0; x = __builtin_amdgcn_cvt_pk_fp8_f32(p0[4 * w_], p0[4 * w_ + 1], x, false); x = __builtin_amdgcn_cvt_pk_fp8_f32(p0[4 * w_ + 2], p0[4 * w_ + 3], x, true); pf[w_] = x; } \
    _Pragma("unroll") for (int w_ = 0; w_ < 2; ++w_) { int x = 0; x = __builtin_amdgcn_cvt_pk_fp8_f32(p1[4 * w_], p1[4 * w_ + 1], x, false); x = __builtin_amdgcn_cvt_pk_fp8_f32(p1[4 * w_ + 2], p1[4 * w_ + 3], x, true); pf[4 + w_] = x; } \
    pf[6] = 0; pf[7] = 0; \
    if (__any(alpha < 1.f)) { if (hi == 0) al_l[r32] = alpha; asm volatile("s_waitcnt lgkmcnt(0)" ::: "memory"); \
      _Pragma("unroll") for (int d = 0; d < 2; ++d) _Pragma("unroll") for (int rg = 0; rg < 16; ++rg) o[d][rg] *= al_l[crow(rg, hi)]; } \
    { const a8_t v0_ = (a8_t){(int)va0.x, (int)va0.y, (int)va0.z, (int)va0.w, (int)vb0_.x, (int)vb0_.y, 0, 0}, v1_ = (a8_t){(int)va1.x, (int)va1.y, (int)va1.z, (int)va1.w, (int)vb1_.x, (int)vb1_.y, 0, 0}; \
      MFMA8(o[0], pf, v0_, sP, s1); MFMA8(o[1], pf, v1_, sP, s1); asm volatile("s_nop 15\n\ts_nop 15" : "+v"(o[0]), "+v"(o[1])); } } while (0)
  { u32x4 kA[4];
    NA_LOADK(kA, 0);
#pragma unroll 1
    for (int w = 0; w < 8; ++w) { NA_TILE(kA, w, 12); }
    NA_TILE(kA, 8, 12); }
#undef NA_KTOK
#undef NA_VOFF
#undef NA_LOADK
#undef NA_A8
#undef NA_TILE
  if (hi == 0) li_l[r32] = l_reg; asm volatile("s_waitcnt lgkmcnt(0)" ::: "memory");
  unsigned char* Ow = ONA + (size_t)(b * SEQ + r * 64 + half * 32) * 1024 + h * 64;
#pragma unroll
  for (int rg = 0; rg < 16; ++rg) { const int orow = crow(rg, hi); const float rl = __builtin_amdgcn_rcpf(li_l[orow]) * (64.f * 16.f);
#pragma unroll
    for (int d0 = 0; d0 < 2; ++d0) Ow[(size_t)orow * 1024 + d0 * 32 + r32] = f32_to_fp8(o[d0][rg] * rl); }
  asm volatile("s_waitcnt lgkmcnt(0)" ::: "memory");
}
}
namespace peer {
constexpr int CH = 32;
constexpr int OFF_TV = 0, OFF_TI = OFF_TV + CH * 16 * 16 * 4, OFF_SE = OFF_TI + CH * 16 * 16 * 4, OFF_SG = OFF_SE + CH * 128 * 4, OFF_SE2 = OFF_SG + CH * 128 * 4, OFF_SG2 = OFF_SE2 + CH * 128 * 4, PEER_LDS = OFF_SG2 + CH * 128 * 4;
static_assert(PEER_LDS <= RING_BYTES, "PEER LDS");
__device__ __forceinline__ float gelu_tanh(float x) {
    const float u = 0.7978845608028654f * (x + 0.044715f * x * x * x);
    const float e = __builtin_amdgcn_exp2f(-2.f * 1.4426950408889634f * fabsf(u));
    const float t = (1.f - e) * __builtin_amdgcn_rcpf(1.f + e);
    return 0.5f * x * (1.f + (u < 0.f ? -t : t));
}
__device__ __forceinline__ void fmac1(float& acc, float a, float b) { asm("v_fmac_f32_e32 %0, %1, %2" : "+v"(acc) : "v"(a), "v"(b)); }
#define PEER_INSERT(x_, xi_) do { float x__ = (x_); int xi__ = (xi_); \
    _Pragma("unroll") for (int j_ = 0; j_ < 16; ++j_) { const bool gt_ = x__ > tv[j_]; const float tvo_ = tv[j_]; const int tio_ = ti[j_]; \
        tv[j_] = gt_ ? x__ : tvo_; ti[j_] = gt_ ? xi__ : tio_; x__ = gt_ ? tvo_ : x__; xi__ = gt_ ? tio_ : xi__; } } while (0)

#define PEER_AUX 0
typedef __amdgpu_buffer_rsrc_t rsrc_t;
__device__ __forceinline__ rsrc_t mk_rsrc(const void* p, unsigned bytes) { return __builtin_amdgcn_make_buffer_rsrc((void*)p, 0, bytes, 0x00020000); }
__device__ __forceinline__ u32x4 ldb128(rsrc_t r, unsigned off) { return __builtin_amdgcn_raw_buffer_load_b128(r, off, 0, PEER_AUX); }
typedef unsigned v6u_t __attribute__((ext_vector_type(6)));
typedef float v32f_t __attribute__((ext_vector_type(32)));
typedef float v16f_t __attribute__((ext_vector_type(16)));
__device__ __forceinline__ u32x2 ldb64(rsrc_t r, unsigned off) { return __builtin_amdgcn_raw_buffer_load_b64(r, off, 0, PEER_AUX); }
__device__ __forceinline__ f32x4 ldf128(rsrc_t r, unsigned off) { return __builtin_bit_cast(f32x4, __builtin_amdgcn_raw_buffer_load_b128(r, off, 0, PEER_AUX)); }
__device__ __forceinline__ f32x4 ldf128_nt(rsrc_t r, unsigned off) { return __builtin_bit_cast(f32x4, __builtin_amdgcn_raw_buffer_load_b128(r, off, 0, 2)); }
__device__ __forceinline__ void peer_select(int chunk, const _Float16* __restrict__ SC, LAS char* lds, int tid, LAS int* SE, LAS float* SG) {
    LAS float* TV = (LAS float*)(lds + OFF_TV); LAS int* TI = (LAS int*)(lds + OFF_TI);
    asm volatile("" : "+v"(tid));
    const int tok0 = chunk * CH;
    const rsrc_t rSC = mk_rsrc(SC, 0x4000000u);
    __syncthreads();
    { const int tl = tid >> 4, g = tid & 15; const unsigned spo = ((unsigned)(tok0 + tl) * 2048u + (unsigned)g * 128u) * 2u;
      int tk[16];
#pragma unroll
      for (int j = 0; j < 16; ++j) tk[j] = (int)0x80000000;
#define PEER_KEY(x_, lowbits_, mask_) ({ const int f_ = __float_as_int(x_); ((f_ ^ ((f_ >> 31) & 0x7fffffff)) & ~(mask_)) | (lowbits_); })
#define PEER_INS(key_) do { int x__ = (key_); _Pragma("unroll") for (int j_ = 0; j_ < 16; ++j_) { const int hi_ = max(x__, tk[j_]); x__ = min(x__, tk[j_]); tk[j_] = hi_; } } while (0)
      typedef _Float16 h8_t __attribute__((ext_vector_type(8)));
#define PEER_CX(a_, b_) do { const int hi_ = max(a_, b_), lo_ = min(a_, b_); a_ = hi_; b_ = lo_; } while (0)
      u32x4 na = __builtin_amdgcn_raw_buffer_load_b128(rSC, spo, 0, 2), nb = __builtin_amdgcn_raw_buffer_load_b128(rSC, spo + 16, 0, 2);
#pragma unroll 1
      for (int i = 0; i < 16; i += 2) { const h8_t a = __builtin_bit_cast(h8_t, na), b = __builtin_bit_cast(h8_t, nb);
          { const unsigned on = spo + (unsigned)min(i + 2, 14) * 16u; na = __builtin_amdgcn_raw_buffer_load_b128(rSC, on, 0, 2); nb = __builtin_amdgcn_raw_buffer_load_b128(rSC, on + 16, 0, 2); }
          int kk[16];
#pragma unroll
          for (int e = 0; e < 8; ++e) { kk[e] = PEER_KEY((float)a[e], 127 - (8 * i + e), 127); kk[8 + e] = PEER_KEY((float)b[e], 127 - (8 * i + 8 + e), 127); }
          PEER_CX(kk[0], kk[13]); PEER_CX(kk[1], kk[12]); PEER_CX(kk[2], kk[15]); PEER_CX(kk[3], kk[14]); PEER_CX(kk[4], kk[8]); PEER_CX(kk[5], kk[6]); PEER_CX(kk[7], kk[11]); PEER_CX(kk[9], kk[10]); PEER_CX(kk[0], kk[5]); PEER_CX(kk[1], kk[7]); PEER_CX(kk[2], kk[9]); PEER_CX(kk[3], kk[4]); PEER_CX(kk[6], kk[13]); PEER_CX(kk[8], kk[14]); PEER_CX(kk[10], kk[15]); PEER_CX(kk[11], kk[12]); PEER_CX(kk[0], kk[1]); PEER_CX(kk[2], kk[3]); PEER_CX(kk[4], kk[5]); PEER_CX(kk[6], kk[8]); PEER_CX(kk[7], kk[9]); PEER_CX(kk[10], kk[11]); PEER_CX(kk[12], kk[13]); PEER_CX(kk[14], kk[15]); PEER_CX(kk[0], kk[2]); PEER_CX(kk[1], kk[3]); PEER_CX(kk[4], kk[10]); PEER_CX(kk[5], kk[11]); PEER_CX(kk[6], kk[7]); PEER_CX(kk[8], kk[9]); PEER_CX(kk[12], kk[14]); PEER_CX(kk[13], kk[15]); PEER_CX(kk[1], kk[2]); PEER_CX(kk[3], kk[12]); PEER_CX(kk[4], kk[6]); PEER_CX(kk[5], kk[7]); PEER_CX(kk[8], kk[10]); PEER_CX(kk[9], kk[11]); PEER_CX(kk[13], kk[14]); PEER_CX(kk[1], kk[4]); PEER_CX(kk[2], kk[6]); PEER_CX(kk[5], kk[8]); PEER_CX(kk[7], kk[10]); PEER_CX(kk[9], kk[13]); PEER_CX(kk[11], kk[14]); PEER_CX(kk[2], kk[4]); PEER_CX(kk[3], kk[6]); PEER_CX(kk[9], kk[12]); PEER_CX(kk[11], kk[13]); PEER_CX(kk[3], kk[5]); PEER_CX(kk[6], kk[8]); PEER_CX(kk[7], kk[9]); PEER_CX(kk[10], kk[12]); PEER_CX(kk[3], kk[4]); PEER_CX(kk[5], kk[6]); PEER_CX(kk[7], kk[8]); PEER_CX(kk[9], kk[10]); PEER_CX(kk[11], kk[12]); PEER_CX(kk[6], kk[7]); PEER_CX(kk[8], kk[9]);
#pragma unroll
          for (int e = 0; e < 16; ++e) tk[e] = max(tk[e], kk[15 - e]);
          PEER_CX(tk[0], tk[8]); PEER_CX(tk[1], tk[9]); PEER_CX(tk[2], tk[10]); PEER_CX(tk[3], tk[11]); PEER_CX(tk[4], tk[12]); PEER_CX(tk[5], tk[13]); PEER_CX(tk[6], tk[14]); PEER_CX(tk[7], tk[15]); PEER_CX(tk[0], tk[4]); PEER_CX(tk[1], tk[5]); PEER_CX(tk[2], tk[6]); PEER_CX(tk[3], tk[7]); PEER_CX(tk[8], tk[12]); PEER_CX(tk[9], tk[13]); PEER_CX(tk[10], tk[14]); PEER_CX(tk[11], tk[15]); PEER_CX(tk[0], tk[2]); PEER_CX(tk[1], tk[3]); PEER_CX(tk[4], tk[6]); PEER_CX(tk[5], tk[7]); PEER_CX(tk[8], tk[10]); PEER_CX(tk[9], tk[11]); PEER_CX(tk[12], tk[14]); PEER_CX(tk[13], tk[15]); PEER_CX(tk[0], tk[1]); PEER_CX(tk[2], tk[3]); PEER_CX(tk[4], tk[5]); PEER_CX(tk[6], tk[7]); PEER_CX(tk[8], tk[9]); PEER_CX(tk[10], tk[11]); PEER_CX(tk[12], tk[13]); PEER_CX(tk[14], tk[15]); }
#undef PEER_CX
      LAS float* tvp = TV + (tl * 16 + g) * 16; LAS int* tip = TI + (tl * 16 + g) * 16;
#pragma unroll
      for (int j = 0; j < 16; ++j) { const int k_ = tk[j] & ~127; tvp[j] = __int_as_float(k_ ^ ((k_ >> 31) & 0x7fffffff)); tip[j] = 127 - (tk[j] & 127); } }
    __syncthreads();
    asm volatile("" : "+v"(tid));
    { const int tl = tid >> 4, hh = (tid >> 1) & 7, half = tid & 1;
      const LAS float* s1 = TV + (tl * 16 + 2 * hh) * 16; const LAS float* s2 = s1 + 16; const LAS int* i1 = TI + (tl * 16 + 2 * hh) * 16; const LAS int* i2 = i1 + 16;
      float b2[16];
#pragma unroll
      for (int j = 0; j < 16; ++j) b2[j] = s2[j];
      int tk[16];
#pragma unroll
      for (int j = 0; j < 16; ++j) tk[j] = (int)0x80000000;
#pragma unroll
      for (int ii = 0; ii < 8; ++ii) { const int i = 2 * ii + half; const float a = s1[i];
#pragma unroll
          for (int j = 0; j < 16; ++j) if ((2 * ii + 1) * (j + 1) <= 16) { if (half == 0 || (2 * ii + 2) * (j + 1) <= 16) PEER_INS(PEER_KEY(a + b2[j], 255 - (i * 16 + j), 255)); } }
      { int pk[16];
#pragma unroll
        for (int j = 0; j < 16; ++j) pk[j] = __shfl_xor(tk[j], 1);
#pragma unroll
        for (int j = 0; j < 16; ++j) PEER_INS(pk[j]); }
      if (half == 0) { float e[16], sum = 0.f; const int k0_ = tk[0] & ~255; const float v0 = __int_as_float(k0_ ^ ((k0_ >> 31) & 0x7fffffff));
#pragma unroll
        for (int j = 0; j < 16; ++j) { const int k_ = tk[j] & ~255; const float vj = __int_as_float(k_ ^ ((k_ >> 31) & 0x7fffffff)); e[j] = __builtin_amdgcn_exp2f((vj - v0) * 1.4426950408889634f); sum += e[j]; }
        const float inv = 1.0f / sum;
#pragma unroll
        for (int j = 0; j < 16; ++j) { const int ci = 255 - (tk[j] & 255); SE[tl * 128 + hh * 16 + j] = i1[ci >> 4] * 128 + i2[ci & 15]; SG[tl * 128 + hh * 16 + j] = e[j] * inv; } } }
#undef PEER_KEY
#undef PEER_INS
    __syncthreads();
}
__device__ __forceinline__ void peer_gather(int chunk, const bf16_t* __restrict__ H2, const unsigned char* __restrict__ U, const unsigned char* __restrict__ V,
                                            const float* __restrict__ g2, const float* __restrict__ gf, float* OUT, int tid, const LAS int* SE, const LAS float* SG) {
    asm volatile("" : "+v"(tid));
    const int tok0 = chunk * CH, lane = tid & 63, wave = tid >> 6;
    const rsrc_t rH2 = mk_rsrc(H2, 0x4000000u), rU = mk_rsrc(U, 0x1800000u), rV = mk_rsrc(V, 0x1800000u), rG2 = mk_rsrc(g2, 8192u), rGF = mk_rsrc(gf, 8192u);
#pragma unroll 1
    for (int tt = 0; tt < CH / NWAVES; ++tt) { const int tl = wave * (CH / NWAVES) + tt, tok = tok0 + tl;
      asm volatile("" ::: "memory");
      float hn[32], acc[32]; float ss = 0.f;
#pragma unroll
      for (int j = 0; j < 2; ++j)
#pragma unroll
          for (int q = 0; q < 4; ++q) { const u32x2 w = ldb64(rH2, ((unsigned)tok * 2048u + 256u * (4 * j + q) + 4u * lane) * 2u);
              const f32x4 a = (f32x4){__uint_as_float(w.x << 16), __uint_as_float(w.x & 0xffff0000u), __uint_as_float(w.y << 16), __uint_as_float(w.y & 0xffff0000u)};
#pragma unroll
              for (int i = 0; i < 4; ++i) { hn[16 * j + 4 * q + i] = a[i]; ss += a[i] * a[i]; } }
      const float rstd = 1.0f / sqrtf(wave_sum(ss) * (1.f / 2048.f) + NORM_EPS);
#pragma unroll
      for (int j = 0; j < 2; ++j)
#pragma unroll
          for (int q = 0; q < 4; ++q) { const f32x4 a = ldf128(rG2, (256u * (4 * j + q) + 4u * lane) * 4u);
#pragma unroll
              for (int i = 0; i < 4; ++i) hn[16 * j + 4 * q + i] *= rstd * a[i]; }
#pragma unroll
      for (int i = 0; i < 32; ++i) acc[i] = 0.f;
#define NX 4
#define PEER_LOAD(S, kb) do { _Pragma("unroll") for (int x = 0; x < NX; ++x) { const unsigned o = (unsigned)SE[tl * 128 + (kb) + x] * 1536u; \
          S##ua[x] = ldb128(rU, o + (unsigned)lane * 16u); S##ub[x] = ldb64(rU, o + 1024u + (unsigned)lane * 8u); S##va[x] = ldb128(rV, o + (unsigned)lane * 16u); S##vb[x] = ldb64(rV, o + 1024u + (unsigned)lane * 8u); } } while (0)
#define PEER_DEC(A, B) ({ v32f_t r_ = __builtin_amdgcn_cvt_scalef32_pk32_f32_fp6((v6u_t){A.x, A.y, A.z, A.w, B.x, B.y}, 1.0f); asm volatile("s_nop 1" : "+v"(r_)); r_; })
#define PEER_COMPUTE(S, kb) do { float d[NX]; \
          _Pragma("unroll") for (int x = 0; x < NX; ++x) { const v32f_t r = PEER_DEC(S##ua[x], S##ub[x]); float dd = 0.f; \
              _Pragma("unroll") for (int i = 0; i < 32; ++i) fmac1(dd, hn[i], r[i]); \
              d[x] = dd; } \
          _Pragma("unroll") for (int o = 1; o < 64; o <<= 1) { _Pragma("unroll") for (int x = 0; x < NX; ++x) d[x] += __shfl_xor(d[x], o); } \
          float c[NX]; \
          _Pragma("unroll") for (int x = 0; x < NX; ++x) c[x] = SG[tl * 128 + (kb) + x] * gelu_tanh(d[x] * (1.f / 64.f)) * 0.25f; \
          _Pragma("unroll") for (int x = 0; x < NX; ++x) { const v32f_t r = PEER_DEC(S##va[x], S##vb[x]); \
              _Pragma("unroll") for (int i = 0; i < 32; ++i) fmac1(acc[i], c[x], r[i]); } } while (0)
      { u32x4 Aua[NX], Ava[NX], Bua[NX], Bva[NX]; u32x2 Aub[NX], Avb[NX], Bub[NX], Bvb[NX];
        PEER_LOAD(A, 0);
#pragma unroll 1
        for (int k = 0; k < 128; k += 2 * NX) {
            PEER_LOAD(B, k + NX); PEER_COMPUTE(A, k);
            { const int kn = min(k + 2 * NX, 128 - NX); PEER_LOAD(A, kn); }
            PEER_COMPUTE(B, k + NX);
        } }
#undef PEER_DEC
#undef NX
#undef PEER_LOAD
#undef PEER_COMPUTE
      asm volatile("" ::: "memory");
      int tok2 = tok, lane2 = lane; asm volatile("" : "+v"(tok2), "+v"(lane2));
      float s2 = 0.f;
#pragma unroll
      for (int j = 0; j < 2; ++j)
#pragma unroll
          for (int q = 0; q < 4; ++q) { const u32x2 w = ldb64(rH2, ((unsigned)tok2 * 2048u + 256u * (4 * j + q) + 4u * lane2) * 2u);
              const f32x4 a = (f32x4){__uint_as_float(w.x << 16), __uint_as_float(w.x & 0xffff0000u), __uint_as_float(w.y << 16), __uint_as_float(w.y & 0xffff0000u)};
#pragma unroll
              for (int i = 0; i < 4; ++i) { acc[16 * j + 4 * q + i] += a[i]; s2 += acc[16 * j + 4 * q + i] * acc[16 * j + 4 * q + i]; } }
      const float rf = 1.0f / sqrtf(wave_sum(s2) * (1.f / 2048.f) + NORM_EPS);
#pragma unroll
      for (int j = 0; j < 2; ++j)
#pragma unroll
          for (int q = 0; q < 4; ++q) { const f32x4 a = ldf128(rGF, (256u * (4 * j + q) + 4u * lane2) * 4u); f32x4 oa;
#pragma unroll
              for (int i = 0; i < 4; ++i) oa[i] = acc[16 * j + 4 * q + i] * rf * a[i];
              float* op = OUT + (size_t)tok2 * 2048 + 256 * (4 * j + q) + 4 * lane2;
              __builtin_nontemporal_store(oa, (GAS f32x4*)op); }
    }
}
}
#ifndef MK_N_LAUNCHES
#define MK_N_LAUNCHES 1
#endif
#define MK_PROBE_PH -1
#define MK_PROBE_DIV 2
constexpr int N_PHASES = 9;
constexpr int N_LAUNCHES = MK_N_LAUNCHES;
struct Args { const float* in[19]; float* out; unsigned char* ws; int ph_lo, ph_hi; };
static_assert(sizeof(Args) == 19 * 8 + 8 + 8 + 8, "no padding");

__global__ void __launch_bounds__(NWAVES * 64, 2) hybrid_fwd(Args args) {
    extern __shared__ __attribute__((aligned(16))) unsigned char lds_raw[];
    Frame F;
    F.lds = (LAS unsigned char*)lds_raw;
    F.MISC = (volatile LAS unsigned*)(F.lds + MISC_OFF);
    F.tid = threadIdx.x; F.lane = F.tid & 63; F.wave = __builtin_amdgcn_readfirstlane(F.tid >> 6);
    F.G = gridDim.x; { const int bx = blockIdx.x; F.vcu = (F.G % 8 == 0) ? (bx % 8) * (F.G / 8) + bx / 8 : bx; }
    F.ws = args.ws; F.out = args.out;
#pragma unroll
    for (int i = 0; i < 19; ++i) F.in[i] = args.in[i];
    for (int u = F.tid; u < (LDS_BYTES - LDSCTL_OFF) / 4; u += NWAVES * 64) ((LAS unsigned*)(F.lds + LDSCTL_OFF))[u] = 0u;
    __syncthreads();
    XcdBarrier bar; bar.bar = (unsigned*)(F.ws + WS_CTL) + CW_BAR; bar.x = 0; bar.st = nullptr;
    if (N_LAUNCHES == 1) bar = xcd_barrier_post((unsigned*)(F.ws + WS_CTL) + CW_BAR, F.MISC + 8);
    const int lo = args.ph_lo, hi = args.ph_hi;
#define IN(k) (lo <= (k) && (k) < hi)
#if MK_PROBE_PH >= 0
    unsigned long long tp0 = (MK_PROBE_PH == 0 || MK_PROBE_PH == 9) ? __builtin_amdgcn_s_memrealtime() : 0ull, tp1 = 0ull;
#define SEAM(k) do { if (IN(k) && IN((k) + 1)) xcd_barrier(bar); if (MK_PROBE_PH == (k)) tp1 = __builtin_amdgcn_s_memrealtime(); if (MK_PROBE_PH == (k) + 1) tp0 = __builtin_amdgcn_s_memrealtime(); } while (0)
#else
#define SEAM(k) do { if (IN(k) && IN((k) + 1)) xcd_barrier(bar); } while (0)
#endif
    const size_t T2048 = (size_t)256 * 2048 * 2, T1024 = (size_t)256 * 1024 * 2, T512 = (size_t)256 * 512 * 2;
    float* cosT = WSP(float, WS_COS); float* sinT = WSP(float, WS_SIN);
    float* ssq_q = WSP(float, WS_SSQ_Q); float* ssq_kv = WSP(float, WS_SSQ_KV); float* ssq2 = WSP(float, WS_SSQ_2);

    if (IN(0)) { p0_prologue<0>(F, F.vcu, F.G); } SEAM(0);
    if (IN(1)) {
        SchedP1 S{F.G, (int)blockIdx.x, (const char*)(F.ws + WS_HN1), (const char*)(F.ws + WS_WIN), (const char*)(F.ws + WS_WVT), T1024};
        EpiP1 E{WSP(unsigned char, WS_NAQ), WSP(unsigned char, WS_NAK), WSP(unsigned char, WS_VT), WSP(unsigned char, WS_CQ), WSP(unsigned char, WS_CKV), WSP(unsigned char, WS_KR), WSP(unsigned char, WS_GA), WSP(unsigned char, WS_GB), ssq_q, ssq_kv, cosT, sinT};
        pg8::gemm_phase<EpiP1, SchedP1, true, -6>(F.lds, 2048, S, E);
        { const int extra = P1_UNITS % F.G, bx = (int)blockIdx.x; if (extra != 0 && bx >= extra) p0_prologue<1>(F, bx - extra, F.G - extra); else if (extra == 0) p0_prologue<1>(F, bx, F.G); }
    } SEAM(1);
    if (IN(2)) {
        LAS float* relb = (LAS float*)F.lds + 64; LAS float* metab = relb + 16 * 15 * 31 + 128; LAS float* wsf = metab + 256 + F.wave * 64;
        for (int i = F.tid; i < 16 * 15 * 31; i += NWAVES * 64) relb[i] = F.in[4][i];
        if (F.tid < 256) metab[F.tid] = F.in[5][F.tid];
        __syncthreads();
        const int gw = F.vcu * NWAVES + F.wave, NGW = F.G * NWAVES;
        Conv cv{F.in[16], F.in[17], WSP(unsigned char, WS_U), WSP(unsigned char, WS_V), F.lds + 65536 + F.wave * 8192, gw, NGW, 2 * 16384, -1, 0};
        for (int task = gw; task < NBATCH * 16 * 32 * 2; task += NGW)
            att::na_task(task, WSP(unsigned char, WS_NAQ), WSP(unsigned char, WS_NAK), WSP(unsigned char, WS_VT), WSP(unsigned char, WS_ONA), relb, metab, wsf, F.lane, cv);
        while (cv.pend >= 0 || cv.next < cv.end) conv_step<0>(cv, F.lane);
        __syncthreads();
    } SEAM(2);
    if (IN(3)) {
        SchedP3 S{F.G, (int)blockIdx.x, (const char*)F.ws, T512 / 2};
        EpiP3 E{WSP(unsigned char, WS_QM), WSP(unsigned char, WS_KN), WSP(unsigned char, WS_VV), ssq_q, ssq_kv, cosT, sinT};
        pg8::gemm_phase<EpiP3, SchedP3, true, -4>(F.lds, 512, S, E);
    } SEAM(3);
    if (IN(4)) {
        for (int id = F.vcu; id < NBATCH * 16 * 8; id += F.G) { const int bh = id >> 3, qb = id & 7;
            att::mla_unit8(bh >> 4, bh & 15, qb, WSP(unsigned char, WS_QM), WSP(unsigned char, WS_KN), WSP(unsigned char, WS_KR), WSP(unsigned char, WS_VV), WSP(unsigned char, WS_OMLA), (LAS char*)F.lds); }
        __syncthreads();
    } SEAM(4);
    if (IN(5)) {
        { SchedGrid S{F.G, (int)blockIdx.x, 64, 8, (const char*)(F.ws + WS_ONA), (const char*)(F.ws + WS_WNA), T512};
          EpiP5a E{WSP(unsigned char, WS_GA), WSP(unsigned char, WS_T1)};
          pg8::gemm_phase<EpiP5a, SchedGrid, true, -9>(F.lds, 1024, S, E); }
        { SchedGrid S{F.G, (int)blockIdx.x, 64, 8, (const char*)(F.ws + WS_OMLA), (const char*)(F.ws + WS_WMLA), T1024};
          EpiP5b E{WSP(unsigned char, WS_GB), WSP(unsigned char, WS_T1), WSP(unsigned char, WS_MERGED)};
          pg8::gemm_phase<EpiP5b, SchedGrid, true, -11>(F.lds, 2048, S, E); }
    } SEAM(5);
    if (IN(6)) {
        { SchedGrid S{F.G, (int)blockIdx.x, 64, 8, (const char*)(F.ws + WS_MERGED), (const char*)(F.ws + WS_WOUT), T1024};
          EpiP6 E{F.in[0], WSP(bf16_t, WS_H2B), ssq2};
          pg8::gemm_phase<EpiP6, SchedGrid, true, -11>(F.lds, 2048, S, E); }
    } SEAM(6);
    if (IN(7)) {
        SchedGrid S{F.G, (int)blockIdx.x, 64, 8, (const char*)(F.ws + WS_H2B), (const char*)(F.ws + WS_WSC), T2048};
        EpiP7 E{ssq2, WSP(_Float16, WS_SC)};
        pg8::gemm_phase<EpiP7, SchedGrid>(F.lds, 2048, S, E);
    } SEAM(7);
    if (IN(8)) {
        const int nch = (MREAL / peer::CH - F.vcu + F.G - 1) / F.G; const bool both_first = (nch == 2) && (F.vcu & 1);
        for (int op = 0; op < 2 * nch; ++op) {
            const bool sel = both_first ? (op < 2) : !(op & 1); const int ci = both_first ? (op & 1) : (op >> 1), chunk = F.vcu + ci * F.G;
            const int b2 = both_first ? ci : 0;
            LAS int* SE = (LAS int*)(F.lds + (b2 ? peer::OFF_SE2 : peer::OFF_SE)); LAS float* SG = (LAS float*)(F.lds + (b2 ? peer::OFF_SG2 : peer::OFF_SG));
            if (sel) peer::peer_select(chunk, WSP(_Float16, WS_SC), (LAS char*)F.lds, F.tid, SE, SG);
            else peer::peer_gather(chunk, WSP(bf16_t, WS_H2B), WSP(unsigned char, WS_U), WSP(unsigned char, WS_V), F.in[13], F.in[18], F.out, F.tid, SE, SG); }
    }
#if MK_PROBE_PH >= 0
    xcd_barrier(bar); tp1 = (MK_PROBE_PH >= 8) ? __builtin_amdgcn_s_memrealtime() : tp1;
    if (blockIdx.x == 0 && F.tid == 0) F.out[0] = (float)(tp1 - tp0) * (0.01f / MK_PROBE_DIV);
#endif
#undef IN
#undef SEAM
}

extern "C" void kernel_launch(void* const* d_in, const int* in_sizes, int n_in, void* d_out, int out_size, void* d_ws, size_t ws_size, hipStream_t stream) {
    static int grid = 0;
    if (grid == 0) {
        if (n_in != 19 || in_sizes[0] != MREAL * DM || out_size != MREAL * DM || ws_size < WS_END) {
            fprintf(stderr, "kernel_launch: shape/workspace mismatch: n_in %d in0 %d out %d ws %zu (need %zu); nothing launched\n", n_in, n_in > 0 ? in_sizes[0] : -1, out_size, ws_size, (size_t)WS_END); grid = -1; return; }
        int dev = 0, cus = 0, per_cu = 0;
        if (hipGetDevice(&dev) != hipSuccess || hipDeviceGetAttribute(&cus, hipDeviceAttributeMultiprocessorCount, dev) != hipSuccess) { fprintf(stderr, "kernel_launch: device query failed\n"); grid = -1; return; }
        if (hipFuncSetAttribute((const void*)hybrid_fwd, hipFuncAttributeMaxDynamicSharedMemorySize, LDS_BYTES) != hipSuccess) { fprintf(stderr, "kernel_launch: hipFuncSetAttribute failed\n"); grid = -1; return; }
        if (hipOccupancyMaxActiveBlocksPerMultiprocessor(&per_cu, (const void*)hybrid_fwd, NWAVES * 64, LDS_BYTES) != hipSuccess || per_cu < 1)
            fprintf(stderr, "kernel_launch: note: occupancy query reports %d workgroups per CU\n", per_cu);
        (void)hipGetLastError();
        grid = cus;
    }
    if (grid < 0) return;
    if (hipMemsetAsync((char*)d_ws + WS_CTL, 0, CTL_ZERO_BYTES, stream) != hipSuccess) { fprintf(stderr, "kernel_launch: hipMemsetAsync failed\n"); return; }
    Args a{};
    for (int i = 0; i < 19; ++i) a.in[i] = (const float*)d_in[i];
    a.out = (float*)d_out; a.ws = (unsigned char*)d_ws;
    for (int li = 0; li < N_LAUNCHES; ++li) {
        a.ph_lo = (N_LAUNCHES == 1) ? 0 : li; a.ph_hi = (N_LAUNCHES == 1) ? N_PHASES : li + 1;
        hipLaunchKernelGGL(hybrid_fwd, dim3(grid), dim3(NWAVES * 64), LDS_BYTES, stream, a);
        const hipError_t le = hipPeekAtLastError();
        if (le != hipSuccess) { fprintf(stderr, "kernel_launch: launch %d failed: %s\n", li, hipGetErrorName(le)); break; }
    }
}
```

```cpp
#include <hip/hip_runtime.h>
#include <cstdio>
#include <cstdint>

#define LAS __attribute__((address_space(3)))
#define GAS __attribute__((address_space(1)))
typedef unsigned short bf16_t;
typedef short bf16x8 __attribute__((ext_vector_type(8)));
typedef short s16x4 __attribute__((ext_vector_type(4)));
typedef float f32x4 __attribute__((ext_vector_type(4)));
typedef float f32x2 __attribute__((ext_vector_type(2)));
typedef float f32x16 __attribute__((ext_vector_type(16)));
typedef unsigned u32x4 __attribute__((ext_vector_type(4)));
typedef unsigned u32x2 __attribute__((ext_vector_type(2)));

constexpr int DM = 2048, NBATCH = 8, SEQ = 2048, NMETA = 16;
constexpr int MREAL = NBATCH * SEQ;
constexpr int MPAD = MREAL + 256;
constexpr int NPOS = SEQ + NMETA;
constexpr float NORM_EPS = 1e-6f;
constexpr int C_NAQ = 0, C_NAK = 1024, C_CQ = 2048, C_CKV = 2560, C_GA = 3072, C_GB = 5120, C_KR = 7168, NMAIN = 7424;
constexpr int VT_PITCH = MPAD;

constexpr size_t MiB = 1u << 20;
constexpr size_t WS_CTL = 0, CTL_ZERO_BYTES = 1 * MiB;
constexpr size_t WS_SSQ_Q = 481 * MiB, WS_SSQ_KV = 482 * MiB, WS_SSQ_2 = 486 * MiB;
constexpr size_t WS_COS = 1 * MiB, WS_SIN = 1 * MiB + 512 * 1024;
constexpr size_t WS_WUQ = 2 * MiB, WS_WUKV = 5 * MiB, WS_WNA = 9 * MiB, WS_WMLA = 13 * MiB, WS_WOUT = 21 * MiB, WS_WSC = 29 * MiB;
constexpr size_t WS_GA = 37 * MiB, WS_GB = 101 * MiB;
constexpr size_t WS_KR = 165 * MiB;
constexpr size_t WS_WIN = 167 * MiB + 256 * 1024, WS_WVT = WS_WIN + 29 * MiB;
constexpr size_t WS_ONA = 190 * MiB;
constexpr size_t WS_NAQ = 222 * MiB, WS_NAK = 254 * MiB, WS_VT = WS_NAK + 32 * MiB + 512 * 1024;
constexpr size_t WS_HN1 = 319 * MiB;
constexpr size_t WS_CQ = 448 * MiB, WS_CKV = 464 * MiB;
constexpr size_t WS_QM = 222 * MiB, WS_KN = 318 * MiB, WS_VV = 383 * MiB;
constexpr size_t WS_OMLA = 448 * MiB;
constexpr size_t WS_MERGED = 222 * MiB, WS_T1 = 286 * MiB;
constexpr size_t WS_H2 = 37 * MiB, WS_H2B = 293 * MiB;
constexpr size_t WS_U = 69 * MiB, WS_V = 133 * MiB;
constexpr size_t WS_SC = 165 * MiB;
constexpr size_t WS_END = 512 * MiB;
static_assert(WS_CKV + (size_t)MPAD * 512 * 2 <= WS_SSQ_Q && WS_SSQ_Q + (size_t)8 * MPAD * 4 <= WS_SSQ_KV && WS_SSQ_KV + (size_t)8 * MPAD * 4 <= 483 * MiB && WS_SSQ_2 + (size_t)32 * MREAL * 4 <= WS_END, "ssq slabs");
static_assert(WS_VT + (size_t)1024 * MPAD * 2 <= WS_HN1 && WS_HN1 + (size_t)MPAD * 2048 * 2 <= WS_CQ && WS_CKV + (size_t)MPAD * 512 * 2 <= WS_END, "map P1");
static_assert(WS_WVT + 4 * MiB <= WS_NAQ && WS_KR + (size_t)MPAD * 64 * 2 <= WS_WIN && WS_ONA + 32 * MiB <= WS_NAQ, "map P1b");
static_assert(WS_QM + 96 * MiB <= WS_KN && WS_KN + 65 * MiB <= WS_VV && WS_VV + 65 * MiB <= WS_OMLA && WS_OMLA + 64 * MiB <= WS_END, "map P3");
static_assert(WS_T1 + 128 * MiB <= WS_OMLA && WS_H2 + 128 * MiB <= WS_KR && WS_SC + 128 * MiB <= WS_H2B && WS_H2B + 64 * MiB <= WS_END, "map P5+");
static_assert(WS_GA + 32 * MiB <= WS_U && WS_U + 24 * MiB <= WS_GB && WS_GB + 32 * MiB <= WS_V && WS_V + 24 * MiB <= WS_KR, "expert tables between the gate codes");

constexpr int CW_BAR = 4096;
constexpr float PEER_U_SCALE = 90.50966799f, PEER_V_SCALE = 5.656854249f;

constexpr int RING_BYTES = 131072;
constexpr int LDSCTL_OFF = RING_BYTES, MISC_OFF = LDSCTL_OFF + 320;
constexpr int LDS_BYTES = 147456;
constexpr int NWAVES = 8;

#define LDS_WAIT() asm volatile("s_waitcnt lgkmcnt(0)" ::: "memory")
#define VM_WAIT() asm volatile("s_waitcnt vmcnt(0)" ::: "memory")
#define SBAR() __builtin_amdgcn_sched_barrier(0)
typedef __bf16 bf16x2_t __attribute__((ext_vector_type(2)));
__device__ __forceinline__ unsigned cvt_pk_bf16(float lo, float hi) { const f32x2 v = {lo, hi}; const bf16x2_t b = __builtin_convertvector(v, bf16x2_t); return __builtin_bit_cast(unsigned, b); }
__device__ __forceinline__ float bf_lo(unsigned w) { return __uint_as_float(w << 16); }
__device__ __forceinline__ float bf_hi(unsigned w) { return __uint_as_float(w & 0xffff0000u); }
__device__ __forceinline__ u32x4 pack8(const f32x4 a, const f32x4 b) { u32x4 w; w.x = cvt_pk_bf16(a[0], a[1]); w.y = cvt_pk_bf16(a[2], a[3]); w.z = cvt_pk_bf16(b[0], b[1]); w.w = cvt_pk_bf16(b[2], b[3]); return w; }
__device__ __forceinline__ u32x2 pack8_fp8(f32x4 a, f32x4 b) {
#pragma unroll
    for (int i = 0; i < 4; ++i) { a[i] = __builtin_fminf(__builtin_fmaxf(a[i], -448.f), 448.f); b[i] = __builtin_fminf(__builtin_fmaxf(b[i], -448.f), 448.f); }
    int w0 = 0, w1 = 0; w0 = __builtin_amdgcn_cvt_pk_fp8_f32(a[0], a[1], w0, false); w0 = __builtin_amdgcn_cvt_pk_fp8_f32(a[2], a[3], w0, true);
    w1 = __builtin_amdgcn_cvt_pk_fp8_f32(b[0], b[1], w1, false); w1 = __builtin_amdgcn_cvt_pk_fp8_f32(b[2], b[3], w1, true); return (u32x2){(unsigned)w0, (unsigned)w1}; }
__device__ __forceinline__ unsigned char f32_to_fp8(float x) { x = __builtin_fminf(__builtin_fmaxf(x, -448.f), 448.f); return (unsigned char)(__builtin_amdgcn_cvt_pk_fp8_f32(x, 0.f, 0, false) & 0xff); }
__device__ __forceinline__ u32x2 pack8_u8(const f32x4 a, const f32x4 b) { u32x2 w; unsigned x = 0u, y = 0u;
    x = __builtin_amdgcn_cvt_pk_u8_f32(a[0] * 255.f, 0u, x); x = __builtin_amdgcn_cvt_pk_u8_f32(a[1] * 255.f, 1u, x); x = __builtin_amdgcn_cvt_pk_u8_f32(a[2] * 255.f, 2u, x); x = __builtin_amdgcn_cvt_pk_u8_f32(a[3] * 255.f, 3u, x);
    y = __builtin_amdgcn_cvt_pk_u8_f32(b[0] * 255.f, 0u, y); y = __builtin_amdgcn_cvt_pk_u8_f32(b[1] * 255.f, 1u, y); y = __builtin_amdgcn_cvt_pk_u8_f32(b[2] * 255.f, 2u, y); y = __builtin_amdgcn_cvt_pk_u8_f32(b[3] * 255.f, 3u, y);
    w.x = x; w.y = y; return w; }
__device__ __forceinline__ unsigned pack4_fp8(f32x4 a) {
#pragma unroll
    for (int i = 0; i < 4; ++i) a[i] = __builtin_fminf(__builtin_fmaxf(a[i], -448.f), 448.f);
    int w0 = 0; w0 = __builtin_amdgcn_cvt_pk_fp8_f32(a[0], a[1], w0, false); w0 = __builtin_amdgcn_cvt_pk_fp8_f32(a[2], a[3], w0, true); return (unsigned)w0; }
__device__ __forceinline__ void unpack8_fp8(const u32x2 w, f32x4& a, f32x4& b) {
    const f32x2 a0 = __builtin_amdgcn_cvt_pk_f32_fp8((int)w.x, false), a1 = __builtin_amdgcn_cvt_pk_f32_fp8((int)w.x, true), b0 = __builtin_amdgcn_cvt_pk_f32_fp8((int)w.y, false), b1 = __builtin_amdgcn_cvt_pk_f32_fp8((int)w.y, true);
    a = (f32x4){a0[0], a0[1], a1[0], a1[1]}; b = (f32x4){b0[0], b0[1], b1[0], b1[1]}; }
__device__ __forceinline__ void unpack8_u8(const u32x2 w, f32x4& a, f32x4& b) { const float k = 1.f / 255.f;
    a = (f32x4){(float)(w.x & 0xffu), (float)((w.x >> 8) & 0xffu), (float)((w.x >> 16) & 0xffu), (float)(w.x >> 24)} * k;
    b = (f32x4){(float)(w.y & 0xffu), (float)((w.y >> 8) & 0xffu), (float)((w.y >> 16) & 0xffu), (float)(w.y >> 24)} * k; }
__device__ __forceinline__ u32x2 pack4(const f32x4 a) { u32x2 w; w.x = cvt_pk_bf16(a[0], a[1]); w.y = cvt_pk_bf16(a[2], a[3]); return w; }
__device__ __forceinline__ float wave_sum(float v) {
#pragma unroll
    for (int o = 1; o < 64; o <<= 1) v += __shfl_xor(v, o);
    return v;
}
__device__ __forceinline__ float sigmoidf_(float x) { return __builtin_amdgcn_rcpf(1.0f + __builtin_amdgcn_exp2f(-1.4426950408889634f * x)); }
__device__ __forceinline__ int crow(int r, int hi) { return (r & 3) + 8 * (r >> 2) + 4 * hi; }
#define PG8_AUX 0
namespace pg8 {
constexpr int BM = 256, BK = 64, HALF = 128, HTB = HALF * BK * 2  , STAGE_BYTES = 8 * HTB, NXCD = 8, WGM = 8;
__host__ __device__ __forceinline__ int lds_byte(int r, int c) { const int st = (r >> 4) * 2 + (c >> 5), rr = r & 15, cc = c & 31, ob = rr * 64 + cc * 2; return st * 1024 + (ob ^ (((ob >> 9) & 1) << 5)); }
__host__ __device__ __forceinline__ void stage_rc(int b, int& R, int& C) { const int st = b / 1024, sb = b % 1024, swz = sb ^ (((sb >> 9) & 1) << 5); R = (st >> 1) * 16 + swz / 64; C = (st & 1) * 32 + (swz % 64) / 2; }
__host__ __device__ __forceinline__ int perm32(int rho) { const int n = rho >> 4, i = rho & 15; return 8 * (i >> 2) + 4 * n + (i & 3); }

struct Unit { int pm, pn, kind; };

__device__ __forceinline__ void grid_order(int L, int nM, int nN, int& pm, int& pn) {
    const int nwg = nM * nN; int wgid = L;
    { const int q = nwg / NXCD, r = nwg % NXCD, xcd = wgid % NXCD, off = wgid / NXCD; wgid = (xcd < r ? xcd * (q + 1) : r * (q + 1) + (xcd - r) * q) + off; }
    const int nig = WGM * nN, gid = wgid / nig, fm = gid * WGM, gsz = (nM - fm) < WGM ? (nM - fm) : WGM;
    pm = fm + ((wgid % nig) % gsz); pn = (wgid % nig) / gsz;
}

typedef int v8i_t __attribute__((ext_vector_type(8)));
template <class Epi, class Sched, bool F8 = false, int F8_SCALE_EXP = 0>
__device__ __forceinline__ void gemm_phase(LAS unsigned char* lds, const int K, const Sched& S, const Epi& E) {
    const int tid = threadIdx.x, wid = __builtin_amdgcn_readfirstlane(tid >> 6), lane = tid & 63, wr = wid >> 2, wc = wid & 3, fr = lane & 15, fq = lane >> 4;
    int f8sa = 0x01010101 * (127 + F8_SCALE_EXP), f8sb = 0x7f7f7f7f; asm volatile("" : "+v"(f8sa), "+v"(f8sb));
    const int Kb = F8 ? K : 2 * K;
    const int nt = Kb / 128;
    unsigned voffA[2], voffB[2];
#pragma unroll
    for (int i = 0; i < 2; ++i) { int R, C; stage_rc(tid * 16 + i * 8192, R, C); const int Rb = Epi::PERM ? ((R & ~31) + perm32(R & 31)) : R;
        voffA[i] = (unsigned)(R * Kb + C * 2); voffB[i] = (unsigned)(Rb * Kb + C * 2); }
    const size_t kstep = (size_t)128;
    const size_t hstep = (size_t)HALF * Kb;
    const unsigned ldsw = (unsigned)wid * 1024u;
    const int aoff = lds_byte(wr * 64 + fr, F8 ? fq * 16 : fq * 8), boff = lds_byte(wc * 32 + fr, F8 ? fq * 16 : fq * 8);
#define PG8_SA(b, h) (((b) * 2 + (h)) * HTB)
#define PG8_SB(b, h) ((4 + (b) * 2 + (h)) * HTB)
#define PG8_STAGE(bufoff, gbase, voff) do { _Pragma("unroll") for (int _i = 0; _i < 2; ++_i) \
        __builtin_amdgcn_global_load_lds((const unsigned*)((const char*)(gbase) + (voff)[_i]), (LAS unsigned*)(lds + (bufoff) + ldsw + _i * 8192), 16, 0, PG8_AUX); } while (0)
#define PG8_LDA(dst, b, h) do { _Pragma("unroll") for (int m = 0; m < 4; ++m) _Pragma("unroll") for (int k = 0; k < 2; ++k) dst[m][k] = *(const LAS bf16x8*)(lds + PG8_SA(b, h) + aoff + m * 2048 + (F8 ? k * 16 : k * 1024)); } while (0)
#define PG8_LDB(dst, b, h) do { _Pragma("unroll") for (int n = 0; n < 2; ++n) _Pragma("unroll") for (int k = 0; k < 2; ++k) dst[n][k] = *(const LAS bf16x8*)(lds + PG8_SB(b, h) + boff + n * 2048 + (F8 ? k * 16 : k * 1024)); } while (0)
#define PG8_F8OP(X) __builtin_bit_cast(v8i_t, __builtin_shufflevector(X[0], X[1], 0, 1, 2, 3, 4, 5, 6, 7, 8, 9, 10, 11, 12, 13, 14, 15))
#define PG8_MMA(ai, bj, At, Bt) do { __builtin_amdgcn_s_setprio(1); \
        if constexpr (F8) { _Pragma("unroll") for (int m = 0; m < 4; ++m) _Pragma("unroll") for (int n = 0; n < 2; ++n) \
            asm volatile("v_mfma_scale_f32_16x16x128_f8f6f4 %0, %1, %2, %0, %3, %4 op_sel_hi:[0,0,0]" : "+v"(acc[ai][bj][m][n]) : "v"(PG8_F8OP(Bt[n])), "v"(PG8_F8OP(At[m])), "v"(f8sa), "v"(f8sb)); } \
        else { _Pragma("unroll") for (int m = 0; m < 4; ++m) _Pragma("unroll") for (int n = 0; n < 2; ++n) _Pragma("unroll") for (int k = 0; k < 2; ++k) \
            acc[ai][bj][m][n] = __builtin_amdgcn_mfma_f32_16x16x32_bf16(Bt[n][k], At[m][k], acc[ai][bj][m][n], 0, 0, 0); } \
        __builtin_amdgcn_s_setprio(0); } while (0)
#define PG8_WAIT_V(n) asm volatile("s_waitcnt vmcnt(" #n ")" ::: "memory")
#define PG8_WAIT_L(n) asm volatile("s_waitcnt lgkmcnt(" #n ")" ::: "memory")
#define PG8_BAR __builtin_amdgcn_s_barrier()
#define PG8_SCHED __builtin_amdgcn_sched_barrier(0)
    Unit cur, nxt; int ui = 0;
    if (!S.next(0, cur)) return;
    f32x4 acc[2][2][4][2];
#pragma unroll
    for (int a = 0; a < 2; ++a)
#pragma unroll
        for (int b = 0; b < 2; ++b)
#pragma unroll
            for (int m = 0; m < 4; ++m)
#pragma unroll
                for (int n = 0; n < 2; ++n) acc[a][b][m][n] = (f32x4){0.f, 0.f, 0.f, 0.f};
    bf16x8 At[4][2], B0[2][2], B1[2][2];
    const char* cA = S.pa(cur); const char* cB = S.pb(cur);
    PG8_STAGE(PG8_SB(0, 0), cB, voffB); PG8_STAGE(PG8_SB(0, 1), cB + hstep, voffB); PG8_STAGE(PG8_SA(0, 0), cA, voffA); PG8_STAGE(PG8_SA(0, 1), cA + hstep, voffA);
    if (wr == 1) PG8_BAR;
    PG8_WAIT_V(2); PG8_BAR;
    PG8_STAGE(PG8_SB(1, 0), cB + kstep, voffB); PG8_STAGE(PG8_SA(1, 0), cA + kstep, voffA); PG8_STAGE(PG8_SB(1, 1), cB + hstep + kstep, voffB);
    PG8_WAIT_V(6); PG8_BAR;
    for (;;) {
        const bool has_next = S.next(ui + 1, nxt);
        const char* nA = has_next ? S.pa(nxt) : cA; const char* nB = has_next ? S.pb(nxt) : cB;
        for (int t = 0; t < nt; t += 2) {
            const bool last = (t == nt - 2);
            const char* a1 = cA + (size_t)(t + 1) * kstep;
            const char* a2 = last ? nA : cA + (size_t)(t + 2) * kstep; const char* b2 = last ? nB : cB + (size_t)(t + 2) * kstep;
            const char* a3 = a2 + kstep; const char* b3 = b2 + kstep;
            PG8_LDB(B0, 0, 0); PG8_LDB(B1, 0, 1); PG8_SCHED; PG8_LDA(At, 0, 0); PG8_STAGE(PG8_SA(1, 1), a1 + hstep, voffA);
            PG8_WAIT_V(8); PG8_WAIT_L(0); PG8_BAR; PG8_MMA(0, 0, At, B0); PG8_MMA(0, 1, At, B1); PG8_BAR; PG8_SCHED;
            PG8_LDA(At, 0, 1); PG8_STAGE(PG8_SB(0, 0), b2, voffB); PG8_STAGE(PG8_SB(0, 1), b2 + hstep, voffB); PG8_STAGE(PG8_SA(0, 0), a2, voffA);
            PG8_WAIT_V(8); PG8_WAIT_L(0); PG8_BAR; PG8_MMA(1, 0, At, B0); PG8_MMA(1, 1, At, B1); PG8_BAR; PG8_SCHED;
            PG8_LDB(B0, 1, 0); PG8_LDB(B1, 1, 1); PG8_SCHED; PG8_LDA(At, 1, 0); PG8_STAGE(PG8_SA(0, 1), a2 + hstep, voffA);
            PG8_WAIT_V(8); PG8_WAIT_L(0); PG8_BAR; PG8_MMA(0, 0, At, B0); PG8_MMA(0, 1, At, B1); PG8_BAR; PG8_SCHED;
            PG8_LDA(At, 1, 1); PG8_STAGE(PG8_SB(1, 0), b3, voffB); PG8_STAGE(PG8_SB(1, 1), b3 + hstep, voffB); PG8_STAGE(PG8_SA(1, 0), a3, voffA);
            PG8_WAIT_V(8); PG8_WAIT_L(0); PG8_BAR; PG8_MMA(1, 0, At, B0); PG8_MMA(1, 1, At, B1); PG8_BAR; PG8_SCHED;
        }
        if (wr == 0) PG8_BAR;
        if constexpr (F8) asm volatile("s_nop 15\n\ts_nop 7" ::: "memory");
        if constexpr (Epi::HAS_PRE) {
            E.pre(cur, (LAS float*)(lds + STAGE_BYTES + 1024), tid); PG8_WAIT_L(0); PG8_BAR; }
        E(acc, cur, wr, wc, fr, fq, (const LAS float*)(lds + STAGE_BYTES + 1024));
        if (!has_next) break;
#pragma unroll
        for (int a = 0; a < 2; ++a)
#pragma unroll
            for (int b = 0; b < 2; ++b)
#pragma unroll
                for (int m = 0; m < 4; ++m)
#pragma unroll
                    for (int n = 0; n < 2; ++n) acc[a][b][m][n] = (f32x4){0.f, 0.f, 0.f, 0.f};
        cur = nxt; cA = nA; cB = nB; ++ui;
        if (wr == 1) PG8_BAR;
    }
    PG8_WAIT_V(0);
    PG8_BAR;
#undef PG8_SA
#undef PG8_SB
#undef PG8_STAGE
#undef PG8_LDA
#undef PG8_LDB
#undef PG8_MMA
#undef PG8_F8OP
#undef PG8_WAIT_V
#undef PG8_WAIT_L
#undef PG8_BAR
#undef PG8_SCHED
}
}
typedef GAS unsigned gu32;
#define RLX_AGENT __ATOMIC_RELAXED, __HIP_MEMORY_SCOPE_AGENT
#define XB_TMO      128
#define XB_XCNT(j)  (256  + 64 * (j))
#define XB_XSUB(j)  (1280 + 64 * (j))
#define XB_XGEN(j)  (2304 + 64 * (j))
#define XB_TOP      3328
#define XB_TOPGEN   3392
#define XCD_BAR_WORDS 3456
#define XB_SPIN_CAP (1u << 18)
__device__ __forceinline__ unsigned xb_ld(unsigned* p)              { return __hip_atomic_load(p, __ATOMIC_RELAXED, __HIP_MEMORY_SCOPE_AGENT); }
__device__ __forceinline__ unsigned xb_add(unsigned* p, unsigned v) { return __hip_atomic_fetch_add(p, v, __ATOMIC_RELAXED, __HIP_MEMORY_SCOPE_AGENT); }
__device__ __forceinline__ unsigned xb_xcc_id() { return (unsigned)__builtin_amdgcn_s_getreg((3 << 11) | 20) & 0xFu; }
#define XB_SPIN(cond, bar) do { unsigned _sp = 0; while (cond) { __builtin_amdgcn_s_sleep(1); \
    if ((++_sp & 255u) == 0u) { if (xb_ld(&(bar)[XB_TMO])) break; if (_sp > XB_SPIN_CAP) { atomicAdd(&(bar)[XB_TMO], 1u); break; } } } } while (0)
struct XcdBarrier { unsigned* bar; unsigned x; volatile LAS unsigned* st; };
__device__ __forceinline__ XcdBarrier xcd_barrier_post(unsigned* bar, volatile LAS unsigned* st) {
    XcdBarrier b; b.bar = bar; b.x = xb_xcc_id(); b.st = st;
    if (threadIdx.x == 0) (void)xb_add(&bar[XB_XCNT(b.x)], 1u);
    return b;
}
__device__ __forceinline__ void xcd_barrier_complete(unsigned* bar, unsigned x, unsigned& nloc, unsigned& nx) {
    const unsigned G = gridDim.x * gridDim.y * gridDim.z;
    unsigned sum, cnt, mine, sp = 0u;
    for (;;) {
        sum = 0u; cnt = 0u; mine = 0u;
#pragma unroll
        for (unsigned j = 0; j < 16; ++j) { const unsigned c = xb_ld(&bar[XB_XCNT(j)]); sum += c; cnt += (c > 0u) ? 1u : 0u; mine = (j == x) ? c : mine; }
        if (sum == G) break;
        __builtin_amdgcn_s_sleep(1);
        if ((++sp & 255u) == 0u) { if (xb_ld(&bar[XB_TMO])) break; if (sp > XB_SPIN_CAP) { atomicAdd(&bar[XB_TMO], 1u); break; } }
    }
    nloc = mine > 0u ? mine : 1u; nx = cnt > 0u ? cnt : 1u;
}
__device__ __forceinline__ void xcd_barrier(const XcdBarrier& b) {
    asm volatile("s_waitcnt vmcnt(0)" ::: "memory");
    __syncthreads();
    if (threadIdx.x == 0) {
        unsigned* bar = b.bar;
        __builtin_amdgcn_s_waitcnt(0);
        unsigned nloc = b.st[0], nx = b.st[1];
        if (nloc == 0u) { xcd_barrier_complete(bar, b.x, nloc, nx); b.st[0] = nloc; b.st[1] = nx; }
        const unsigned old = xb_add(&bar[XB_XSUB(b.x)], 1u);
        const unsigned gen = old / nloc;
        if (old + 1u == (gen + 1u) * nloc) {
            __builtin_amdgcn_fence(__ATOMIC_RELEASE, "agent");
            asm volatile("s_waitcnt vmcnt(0)" ::: "memory");
            const unsigned og = xb_add(&bar[XB_TOP], 1u);
            const unsigned tg = og / nx;
            if (og + 1u == (tg + 1u) * nx) xb_add(&bar[XB_TOPGEN], 1u);
            else XB_SPIN(xb_ld(&bar[XB_TOPGEN]) == tg, bar);
            __builtin_amdgcn_fence(__ATOMIC_ACQUIRE, "agent");
            xb_add(&bar[XB_XGEN(b.x)], 1u);
            asm volatile("s_waitcnt vmcnt(0)" ::: "memory");
        } else {
            XB_SPIN(xb_ld(&bar[XB_XGEN(b.x)]) == gen, bar);
            __builtin_amdgcn_fence(__ATOMIC_ACQUIRE, "agent");
            asm volatile("s_waitcnt vmcnt(0)" ::: "memory");
        }
    }
    __syncthreads();
}
struct Frame {
    LAS unsigned char* lds;
    volatile LAS unsigned* MISC;
    unsigned char* ws;
    int tid, lane, wave;
    int vcu, G;
    const float* in[19];
    float* out;
};
#define WSP(T, off) ((T*)(F.ws + (off)))

typedef float cv16f_t __attribute__((ext_vector_type(16)));
typedef unsigned cv6u_t __attribute__((ext_vector_type(6)));
struct Conv { const float* pu; const float* pv; unsigned char* u8; unsigned char* v8; LAS unsigned char* lbuf; int next, stride, end, pend, tick; };
__device__ __forceinline__ void conv_issue(const Conv& c, int item, int lane) {
    const float* src = ((item >> 14) ? c.pv : c.pu) + (size_t)(item & 16383) * 2048 + 4 * lane;
#pragma unroll
    for (int q = 0; q < 8; ++q) __builtin_amdgcn_global_load_lds((const unsigned*)(src + 256 * q), (LAS unsigned*)(c.lbuf + q * 1024), 16, 0, 0);
}
__device__ __forceinline__ void conv_finish(const Conv& c, int item, int lane) {
    const int isv = item >> 14, row = item & 16383; const float sc = isv ? PEER_V_SCALE : PEER_U_SCALE; unsigned w[4] = {0u, 0u, 0u, 0u};
#define CONV_Q(q) { const f32x4 x = *(const LAS f32x4*)(c.lbuf + (q) * 1024 + lane * 16) * sc; \
        w[(q) >> 1] = __builtin_amdgcn_cvt_scalef32_pk_fp4_f32(w[(q) >> 1], x[0], x[1], 1.0f, (2 * (q)) & 3); w[(q) >> 1] = __builtin_amdgcn_cvt_scalef32_pk_fp4_f32(w[(q) >> 1], x[2], x[3], 1.0f, (2 * (q) + 1) & 3); }
    CONV_Q(0) CONV_Q(1) CONV_Q(2) CONV_Q(3) CONV_Q(4) CONV_Q(5) CONV_Q(6) CONV_Q(7)
#undef CONV_Q
    unsigned char* rec = (isv ? c.v8 : c.u8) + (size_t)row * 1024;
    *(GAS u32x4*)(rec + lane * 16) = (u32x4){w[0], w[1], w[2], w[3]};
}
template <int YOUNGER>
__device__ __forceinline__ void conv_step(Conv& c, int lane) {
    if (c.pend >= 0) { if constexpr (YOUNGER == 0) asm volatile("s_waitcnt vmcnt(0)" ::: "memory"); else { static_assert(YOUNGER == 12, "wait count"); asm volatile("s_waitcnt vmcnt(12)" ::: "memory"); }
        conv_finish(c, c.pend, lane); c.pend = -1; asm volatile("s_waitcnt lgkmcnt(0)" ::: "memory"); }
    if (c.next < c.end) { conv_issue(c, c.next, lane); c.pend = c.next; c.next += c.stride; }
}
__device__ __forceinline__ void p0_transpose_item(const float* W, int K, int N, int k0, int n0, bf16_t* WT, int drow, bool rope, const float* gain, LAS float* scr, int lane) {
    { f32x4 v[8]; float gk[8];
#pragma unroll
      for (int i = 0; i < 8; ++i) { const int kk = 8 * i + (lane >> 3); v[i] = *(const GAS f32x4*)(W + (size_t)(k0 + kk) * N + n0 + 4 * (lane & 7)); gk[i] = gain ? gain[k0 + kk] : 1.f; }
#pragma unroll
      for (int i = 0; i < 8; ++i) { const int kk = 8 * i + (lane >> 3); LAS float* d = scr + kk * 33 + 4 * (lane & 7);
#pragma unroll
          for (int e = 0; e < 4; ++e) d[e] = v[i][e] * gk[i]; } }
    LDS_WAIT(); asm volatile("" ::: "memory");
    const int c = lane & 7;
#pragma unroll
    for (int j = 0; j < 4; ++j) { const int n = (lane >> 3) + 8 * j; const LAS float* s = scr + (8 * c) * 33 + n;
        u32x4 o; o.x = cvt_pk_bf16(s[0 * 33], s[1 * 33]); o.y = cvt_pk_bf16(s[2 * 33], s[3 * 33]); o.z = cvt_pk_bf16(s[4 * 33], s[5 * 33]); o.w = cvt_pk_bf16(s[6 * 33], s[7 * 33]);
        const int dr = drow + (rope ? (8 * (n >> 2) + (n & 3)) : n);
        *(GAS u32x4*)(WT + (size_t)dr * K + k0 + 8 * c) = o; }
    LDS_WAIT(); asm volatile("" ::: "memory");
}
__device__ __forceinline__ void p0_transpose_item8(const float* W, int K, int N, int k0, int n0, unsigned char* WT, int drow, bool rope, float scale, LAS float* scr, int lane, const float* gain = nullptr) {
    { f32x4 v[8]; float gk[8];
#pragma unroll
      for (int i = 0; i < 8; ++i) { const int kk = 8 * i + (lane >> 3); v[i] = *(const GAS f32x4*)(W + (size_t)(k0 + kk) * N + n0 + 4 * (lane & 7)); gk[i] = gain ? gain[k0 + kk] * scale : scale; }
#pragma unroll
      for (int i = 0; i < 8; ++i) { const int kk = 8 * i + (lane >> 3); LAS float* d = scr + kk * 33 + 4 * (lane & 7);
#pragma unroll
          for (int e = 0; e < 4; ++e) d[e] = v[i][e] * gk[i]; } }
    LDS_WAIT(); asm volatile("" ::: "memory");
#pragma unroll
    for (int j = 0; j < 2; ++j) { const int q = lane + 64 * j, n = q >> 2, c = q & 3; const LAS float* s = scr + (16 * c) * 33 + n; u32x4 o;
#pragma unroll
        for (int d = 0; d < 4; ++d) { int w = 0; w = __builtin_amdgcn_cvt_pk_fp8_f32(s[(4 * d) * 33], s[(4 * d + 1) * 33], w, false); w = __builtin_amdgcn_cvt_pk_fp8_f32(s[(4 * d + 2) * 33], s[(4 * d + 3) * 33], w, true); o[d] = (unsigned)w; }
        const int dr = drow + (rope ? (8 * (n >> 2) + (n & 3)) : n);
        *(GAS u32x4*)(WT + (size_t)dr * K + k0 + 16 * c) = o; }
    LDS_WAIT(); asm volatile("" ::: "memory");
}
__device__ __forceinline__ void rms_row_to_fp8(const float* xrow, const float* g, unsigned char* orow, int lane) {
    const GAS f32x4* xr = (const GAS f32x4*)xrow + lane; const GAS f32x4* gr = (const GAS f32x4*)g + lane;
    f32x4 v[8]; float s = 0.f;
#pragma unroll
    for (int j = 0; j < 8; ++j) { v[j] = xr[64 * j]; s += (v[j].x * v[j].x + v[j].y * v[j].y) + (v[j].z * v[j].z + v[j].w * v[j].w); }
    const float rstd = 1.0f / sqrtf(wave_sum(s) * (1.f / DM) + NORM_EPS);
    GAS unsigned* o4 = (GAS unsigned*)orow + lane;
#pragma unroll
    for (int j = 0; j < 8; ++j) { const f32x4 y = (v[j] * rstd) * gr[64 * j]; int w = 0; w = __builtin_amdgcn_cvt_pk_fp8_f32(y[0], y[1], w, false); w = __builtin_amdgcn_cvt_pk_fp8_f32(y[2], y[3], w, true); o4[64 * j] = (unsigned)w; }
}
__device__ __forceinline__ void rms_row_to_bf16(const float* xrow, const float* g, bf16_t* orow, int lane) {
    const GAS f32x4* xr = (const GAS f32x4*)xrow + lane; const GAS f32x4* gr = (const GAS f32x4*)g + lane;
    f32x4 v[8]; float s = 0.f;
#pragma unroll
    for (int j = 0; j < 8; ++j) { v[j] = xr[64 * j]; s += (v[j].x * v[j].x + v[j].y * v[j].y) + (v[j].z * v[j].z + v[j].w * v[j].w); }
    const float rstd = 1.0f / sqrtf(wave_sum(s) * (1.f / DM) + NORM_EPS);
    GAS u32x2* o8 = (GAS u32x2*)orow + lane;
#pragma unroll
    for (int j = 0; j < 8; ++j) { const f32x4 gg = gr[64 * j]; o8[64 * j] = pack4((v[j] * rstd) * gg); }
}
template <int PART>
__device__ __forceinline__ void p0_prologue(Frame& F, int rank, int nrank) {
    LAS float* scr = (LAS float*)(F.lds + F.wave * 16384);
    const int gw = rank * NWAVES + F.wave, NGW = nrank * NWAVES, lane = F.lane; const int gt = rank * 512 + F.tid, NGT = nrank * 512;
    unsigned char* WIN = WSP(unsigned char, WS_WIN); unsigned char* WVT = WSP(unsigned char, WS_WVT);
    constexpr int I_IN = 32 * 258, I_UQ = 8 * 96, I_UKV = 8 * 128, I_NA = 16 * 64, I_MLA = 32 * 64, I_OUT = 32 * 64;
    constexpr int NEARLY = I_IN + I_UQ + I_UKV, NITEMS = NEARLY + I_NA + I_MLA + I_OUT;
    for (int it = (PART == 0 ? 0 : NEARLY) + gw; it < (PART == 0 ? NEARLY : NITEMS); it += NGW) {
        int r = it;
        if (r < I_IN) { const int kb = r / 258, sb = r % 258, n0 = 32 * sb, k0 = 64 * kb; const float* W = F.in[3];
            unsigned char* dst = WIN; int drow; bool rope = false;
            if (n0 < 1024) drow = C_NAQ + n0;
            else if (n0 < 2048) drow = C_NAK + (n0 - 1024);
            else if (n0 < 3072) { dst = WVT; drow = n0 - 2048; }
            else if (n0 < 3584) drow = C_CQ + (n0 - 3072);
            else if (n0 < 4096) drow = C_CKV + (n0 - 3584);
            else if (n0 < 4160) { drow = C_KR + ((n0 - 4096) ? 4 : 0); rope = true; }
            else if (n0 < 6208) drow = C_GA + (n0 - 4160);
            else drow = C_GB + (n0 - 6208);
            p0_transpose_item8(W, 2048, 8256, k0, n0, dst, drow, rope, 64.f, scr, lane); continue; } r -= I_IN;
        if (r < I_UQ) { const int kb = r / 96, sb = r % 96, n0 = 32 * sb, k0 = 64 * kb; const int hd = n0 / 192, w = n0 % 192;
            int drow = n0; bool rope = false; if (w >= 128) { rope = true; drow = hd * 192 + 128 + ((w - 128) ? 4 : 0); }
            p0_transpose_item8(F.in[7], 512, 3072, k0, n0, WSP(unsigned char, WS_WUQ), drow, rope, 16.f, scr, lane, F.in[6]); continue; } r -= I_UQ;
        if (r < I_UKV) { const int kb = r / 128, sb = r % 128; const int n0 = 32 * sb, hd = n0 >> 8, w = n0 & 255;
            p0_transpose_item8(F.in[9], 512, 4096, 64 * kb, n0, WSP(unsigned char, WS_WUKV), (w >= 128 ? 2048 : 0) + hd * 128 + (w & 127), false, 16.f, scr, lane, F.in[8]); continue; } r -= I_UKV;
        if (r < I_NA) { const int kb = r / 64, sb = r % 64; p0_transpose_item8(F.in[10], 1024, 2048, 64 * kb, 32 * sb, WSP(unsigned char, WS_WNA), 32 * sb, false, 32.f, scr, lane); continue; } r -= I_NA;
        if (r < I_MLA) { const int kb = r / 64, sb = r % 64; p0_transpose_item8(F.in[11], 2048, 2048, 64 * kb, 32 * sb, WSP(unsigned char, WS_WMLA), 32 * sb, false, 64.f, scr, lane); continue; } r -= I_MLA;
        { const int kb = r / 64, sb = r % 64; p0_transpose_item8(F.in[12], 2048, 2048, 64 * kb, 32 * sb, WSP(unsigned char, WS_WOUT), 32 * sb, false, 64.f, scr, lane); }
    }
    if (PART == 0) { GAS u32x4* z = (GAS u32x4*)(WIN + (size_t)(C_KR + 64) * 2048); const int n16 = (NMAIN - C_KR - 64) * 2048 / 16;
      for (int i = gt; i < n16; i += NGT) z[i] = (u32x4){0u, 0u, 0u, 0u}; }
    if (PART == 0) { unsigned char* HN1 = WSP(unsigned char, WS_HN1);
#define P0_ROWSRC(m_) (((m_) < MREAL) ? F.in[0] + (size_t)(m_) * DM : F.in[1] + (size_t)((m_) - MREAL) * DM)
      { f32x4 v[8]; int m = gw;
        if (m < MREAL + NMETA) { const GAS f32x4* xr = (const GAS f32x4*)P0_ROWSRC(m) + lane;
#pragma unroll
            for (int j = 0; j < 8; ++j) v[j] = xr[64 * j]; }
        const GAS f32x4* gr = (const GAS f32x4*)F.in[2] + lane;
        while (m < MREAL + NMETA) { const int mn = m + NGW; f32x4 vn[8];
            { const int ml = mn < MREAL + NMETA ? mn : m; const GAS f32x4* xr = (const GAS f32x4*)P0_ROWSRC(ml) + lane;
#pragma unroll
              for (int j = 0; j < 8; ++j) vn[j] = xr[64 * j]; }
            float sq = 0.f;
#pragma unroll
            for (int j = 0; j < 8; ++j) sq += (v[j].x * v[j].x + v[j].y * v[j].y) + (v[j].z * v[j].z + v[j].w * v[j].w);
            const float rstd = 1.0f / sqrtf(wave_sum(sq) * (1.f / DM) + NORM_EPS);
            GAS unsigned* o4 = (GAS unsigned*)(HN1 + (size_t)m * DM) + lane;
#pragma unroll
            for (int j = 0; j < 8; ++j) { const f32x4 y = (v[j] * rstd) * gr[64 * j]; int w = 0; w = __builtin_amdgcn_cvt_pk_fp8_f32(y[0], y[1], w, false); w = __builtin_amdgcn_cvt_pk_fp8_f32(y[2], y[3], w, true); o4[64 * j] = (unsigned)w; }
#pragma unroll
            for (int j = 0; j < 8; ++j) v[j] = vn[j];
            m = mn; } }
#undef P0_ROWSRC
      GAS u32x4* z = (GAS u32x4*)(HN1 + (size_t)(MREAL + NMETA) * DM); const int n16 = (MPAD - MREAL - NMETA) * DM / 16;
      for (int i = gt; i < n16; i += NGT) z[i] = (u32x4){0u, 0u, 0u, 0u}; }
    if (PART == 0) { float* ct = WSP(float, WS_COS); float* st = WSP(float, WS_SIN);
      for (int i = gt; i < NPOS * 32; i += NGT) { const int p = i >> 5, j = i & 31;
          const float inv = __builtin_powf(10000.0f, -(float)(2 * j) / 64.0f); const float ang = (float)p * inv;
          double r = (double)ang * 0.15915494309189535; r -= __builtin_rint(r); const float rf = (float)r;
          ct[i] = __builtin_amdgcn_cosf(rf); st[i] = __builtin_amdgcn_sinf(rf); } }
    if (PART == 1) { const float* SK = F.in[15]; const float* WQ = F.in[14]; const float* g2 = F.in[13]; bf16_t* WSCp = WSP(bf16_t, WS_WSC);
      const int l15 = lane & 15, l4 = lane >> 4;
      for (int task = gw; task < 2048; task += NGW) { const int g = task >> 7, nt = (task >> 4) & 7, kc = task & 15, n0 = nt * 16;
          bf16x8 bfr[4];
#pragma unroll
          for (int kk = 0; kk < 4; ++kk) { const float* p = SK + ((size_t)g * 128 + n0 + l15) * 128 + 32 * kk + 8 * l4; const f32x4 a = *(const GAS f32x4*)p, b = *(const GAS f32x4*)(p + 4);
              const u32x4 w = pack8(a, b); bfr[kk] = __builtin_bit_cast(bf16x8, w); }
          for (int kt = 0; kt < 8; ++kt) { const int k0 = (kc * 8 + kt) * 16; f32x4 acc = (f32x4){0.f, 0.f, 0.f, 0.f};
#pragma unroll
              for (int kk = 0; kk < 4; ++kk) { const float* p = WQ + (size_t)(k0 + l15) * 2048 + g * 128 + 32 * kk + 8 * l4; const f32x4 a = *(const GAS f32x4*)p, b = *(const GAS f32x4*)(p + 4);
                  const u32x4 w = pack8(a, b); acc = __builtin_amdgcn_mfma_f32_16x16x32_bf16(__builtin_bit_cast(bf16x8, w), bfr[kk], acc, 0, 0, 0); }
              const f32x4 gg = *(const GAS f32x4*)(g2 + k0 + 4 * l4);
              *(GAS u32x2*)(WSCp + (size_t)(g * 128 + n0 + l15) * 2048 + k0 + 4 * l4) = pack4(acc * gg); } } }
}
using pg8::Unit;
struct SchedGrid {
    int G, c, nM, nN; const char* A; const char* B; size_t tstep;
    __device__ __forceinline__ bool next(int i, Unit& u) const { const int L = i * G + c; if (L >= nM * nN) return false; pg8::grid_order(L, nM, nN, u.pm, u.pn); u.kind = 0; return true; }
    __device__ __forceinline__ const char* pa(const Unit& u) const { return A + (size_t)u.pm * tstep; }
    __device__ __forceinline__ const char* pb(const Unit& u) const { return B + (size_t)u.pn * tstep; }
};
constexpr int P1_MAIN = 64 * 29, P1_VT = 4 * 65, P1_META = 7, P1_UNITS = P1_MAIN + P1_VT + P1_META;
struct SchedP1 {
    int G, c; const char* hn1; const char* win; const char* wvt; size_t tstep;
    __device__ __forceinline__ bool next(int i, Unit& u) const {
        const int L = i * G + c; if (L >= P1_UNITS) return false;
        if (L < P1_MAIN) { pg8::grid_order(L, 64, 29, u.pm, u.pn); u.kind = 0; }
        else if (L < P1_MAIN + P1_VT) { const int idx = L - P1_MAIN; u.pm = idx & 3; u.pn = idx >> 2; u.kind = 1; }
        else { const int idx = L - P1_MAIN - P1_VT; u.pm = 64; u.pn = idx < 4 ? 4 + idx : (idx < 6 ? 10 + (idx - 4) : 28); u.kind = 0; }
        return true; }
    __device__ __forceinline__ const char* pa(const Unit& u) const { return (u.kind == 1 ? wvt : hn1) + (size_t)u.pm * tstep; }
    __device__ __forceinline__ const char* pb(const Unit& u) const { return (u.kind == 1 ? hn1 : win) + (size_t)u.pn * tstep; }
};
__device__ __forceinline__ void rope4(const f32x4 x1, const f32x4 x2, const float* cosT, const float* sinT, int pos, int j0, f32x4& lo, f32x4& hi) {
    const f32x4 c = *(const GAS f32x4*)(cosT + pos * 32 + j0), s = *(const GAS f32x4*)(sinT + pos * 32 + j0);
    lo = x1 * c - x2 * s; hi = x2 * c + x1 * s;
}
struct EpiP1 {
    static constexpr bool PERM = true, HAS_PRE = false;
    unsigned char *naq, *nak, *vt; unsigned char *cq, *ckv; unsigned char *kr; unsigned char *ga, *gb; float *ssq_q, *ssq_kv; const float *cosT, *sinT;
    __device__ __forceinline__ void operator()(const f32x4 (&acc)[2][2][4][2], const Unit& u, int wr, int wc, int fr, int fq, const LAS float* rowsc) const {
        const int row0 = u.pm * 256 + wr * 64 + fr, colu = wc * 32 + 8 * fq;
        if (u.kind == 1) {
#pragma unroll
            for (int bj = 0; bj < 2; ++bj) { const int t0 = u.pn * 256 + bj * 128 + colu, pos = (t0 & ~63) + ((t0 & 63) >> 1);
#pragma unroll
                for (int ai = 0; ai < 2; ++ai)
#pragma unroll
                    for (int m = 0; m < 4; ++m) { unsigned char* rp = vt + (size_t)(row0 + ai * 128 + m * 16) * VT_PITCH + pos;
                        *(GAS unsigned*)rp = pack4_fp8(acc[ai][bj][m][0]); *(GAS unsigned*)(rp + 32) = pack4_fp8(acc[ai][bj][m][1]); } }
            return; }
        const int pn = u.pn;
        if (pn == 28) {
            if (wc < 2) { const int j0 = 4 * (4 * wc + fq);
#pragma unroll
                for (int ai = 0; ai < 2; ++ai)
#pragma unroll
                    for (int m = 0; m < 4; ++m) { const int row = row0 + ai * 128 + m * 16; const int pos = row < MREAL ? NMETA + (row & (SEQ - 1)) : row - MREAL;
                        f32x4 lo, hi; rope4(acc[ai][0][m][0], acc[ai][0][m][1], cosT, sinT, pos, j0, lo, hi);
                        *(GAS unsigned*)(kr + (size_t)row * 64 + j0) = pack4_fp8(lo); *(GAS unsigned*)(kr + (size_t)row * 64 + 32 + j0) = pack4_fp8(hi); } }
            return; }
        if (pn >= 12) {
            unsigned char* base = pn < 20 ? ga : gb; const int colt = (pn < 20 ? pn - 12 : pn - 20) * 256 + colu;
#pragma unroll
            for (int ai = 0; ai < 2; ++ai)
#pragma unroll
                for (int m = 0; m < 4; ++m) { unsigned char* rp = base + (size_t)(row0 + ai * 128 + m * 16) * 2048 + colt;
#pragma unroll
                    for (int bj = 0; bj < 2; ++bj) { f32x4 a = acc[ai][bj][m][0], b = acc[ai][bj][m][1];
#pragma unroll
                        for (int i = 0; i < 4; ++i) { a[i] = sigmoidf_(a[i]); b[i] = sigmoidf_(b[i]); }
                        *(GAS u32x2*)(rp + bj * 128) = pack8_u8(a, b); } }
            return; }
        if (pn >= 8) {
            const bool isq = pn < 10; unsigned char* base = isq ? cq : ckv; float* ssq = isq ? ssq_q : ssq_kv; const int colt = (isq ? pn - 8 : pn - 10) * 256 + colu;
#pragma unroll
            for (int ai = 0; ai < 2; ++ai)
#pragma unroll
                for (int m = 0; m < 4; ++m) { const int row = row0 + ai * 128 + m * 16; unsigned char* rp = base + (size_t)row * 512 + colt; float s = 0.f;
#pragma unroll
                    for (int bj = 0; bj < 2; ++bj) { const f32x4 a = acc[ai][bj][m][0], b = acc[ai][bj][m][1];
                        s += (a[0] * a[0] + a[1] * a[1]) + (a[2] * a[2] + a[3] * a[3]) + (b[0] * b[0] + b[1] * b[1]) + (b[2] * b[2] + b[3] * b[3]);
                        *(GAS u32x2*)(rp + bj * 128) = pack8_fp8(a, b); }
                    s += __shfl_xor(s, 16); s += __shfl_xor(s, 32);
                    if (fq == 0) ssq[(size_t)((pn & 1) * 4 + wc) * MPAD + row] = s; }
            return; }
        {
            unsigned char* base = pn < 4 ? naq : nak; const int colt = (pn & 3) * 256 + colu;
#pragma unroll
            for (int ai = 0; ai < 2; ++ai)
#pragma unroll
                for (int m = 0; m < 4; ++m) { unsigned char* rp = base + (size_t)(row0 + ai * 128 + m * 16) * 1024 + colt;
#pragma unroll
                    for (int bj = 0; bj < 2; ++bj) *(GAS u32x2*)(rp + bj * 128) = pack8_fp8(acc[ai][bj][m][0], acc[ai][bj][m][1]); }
        }
    }
};
constexpr int P3_Q = 64 * 12, P3_K = 65 * 8, P3_V = 8 * 65, P3_UNITS = P3_Q + P3_K + P3_V;
struct SchedP3 {
    int G, c; const char* ws; size_t tstep;
    __device__ __forceinline__ bool next(int i, Unit& u) const {
        const int L = i * G + c; if (L >= P3_UNITS) return false;
        if (L < P3_Q) { pg8::grid_order(L, 64, 12, u.pm, u.pn); u.kind = 0; }
        else if (L < P3_Q + P3_K) { pg8::grid_order(L - P3_Q, 65, 8, u.pm, u.pn); u.kind = 1; }
        else { const int idx = L - P3_Q - P3_K; u.pm = idx & 7; u.pn = idx >> 3; u.kind = 2; }
        return true; }
    __device__ __forceinline__ const char* pa(const Unit& u) const { const size_t o = u.kind == 0 ? WS_CQ : (u.kind == 1 ? WS_CKV : WS_WUKV + (size_t)2048 * 512); return ws + o + (size_t)u.pm * tstep; }
    __device__ __forceinline__ const char* pb(const Unit& u) const { const size_t o = u.kind == 0 ? WS_WUQ : (u.kind == 1 ? WS_WUKV : WS_CKV); return ws + o + (size_t)u.pn * tstep; }
};
template <int NS, int LD> __device__ __forceinline__ float rstd_slabs(const float* part, int row, float invn) {
    float s = 0.f;
#pragma unroll
    for (int i = 0; i < NS; ++i) s += part[(size_t)i * LD + row];
    return 1.0f / sqrtf(s * invn + NORM_EPS);
}
struct EpiP3 {
    static constexpr bool PERM = true, HAS_PRE = true;
    unsigned char *qm, *kn, *vt; const float *ssq_q, *ssq_kv; const float *cosT, *sinT;
    __device__ __forceinline__ void pre(const Unit& u, LAS float* sc, int tid) const { if (tid < 256) { const int row = (u.kind == 2 ? u.pn : u.pm) * 256 + tid; sc[tid] = u.kind ? rstd_slabs<8, MPAD>(ssq_kv, row, 1.f / 512.f) : rstd_slabs<8, MPAD>(ssq_q, row, 1.f / 512.f); } }
    __device__ __forceinline__ void operator()(const f32x4 (&acc)[2][2][4][2], const Unit& u, int wr, int wc, int fr, int fq, const LAS float* rowsc) const {
        const int row0 = u.pm * 256 + wr * 64 + fr, colu = wc * 32 + 8 * fq;
        if (u.kind == 2) {
#pragma unroll
            for (int bj = 0; bj < 2; ++bj) { const int cl = bj * 128 + colu, t0 = u.pn * 256 + cl;
                const f32x4 s0 = *(const LAS f32x4*)(rowsc + cl), s1 = *(const LAS f32x4*)(rowsc + cl + 4);
                const int g = (t0 >> 3) & 7, pos = (t0 & ~63) + 16 * (g >> 2) + 4 * (g & 3);
#pragma unroll
                for (int ai = 0; ai < 2; ++ai)
#pragma unroll
                    for (int m = 0; m < 4; ++m) { unsigned char* rp = vt + (size_t)(row0 + ai * 128 + m * 16) * MPAD + pos;
                        *(GAS unsigned*)rp = pack4_fp8(acc[ai][bj][m][0] * s0); *(GAS unsigned*)(rp + 32) = pack4_fp8(acc[ai][bj][m][1] * s1); } }
            return; }
        if (u.kind == 1) {
#pragma unroll
            for (int ai = 0; ai < 2; ++ai)
#pragma unroll
                for (int m = 0; m < 4; ++m) { const int row = row0 + ai * 128 + m * 16; const float rs = rowsc[ai * 128 + wr * 64 + m * 16 + fr];
                    unsigned char* rp = kn + (size_t)row * 2048 + u.pn * 256 + colu;
#pragma unroll
                    for (int bj = 0; bj < 2; ++bj) *(GAS u32x2*)(rp + bj * 128) = pack8_fp8(acc[ai][bj][m][0] * rs, acc[ai][bj][m][1] * rs); }
            return; }
#pragma unroll
        for (int bj = 0; bj < 2; ++bj) { const int c8 = u.pn * 256 + bj * 128 + colu; const int hd = c8 / 192, w = c8 - hd * 192;
            if (w < 128) {
#pragma unroll
                for (int ai = 0; ai < 2; ++ai)
#pragma unroll
                    for (int m = 0; m < 4; ++m) { const int row = row0 + ai * 128 + m * 16; const float rs = rowsc[ai * 128 + wr * 64 + m * 16 + fr];
                        *(GAS u32x2*)(qm + (size_t)row * 3072 + c8) = pack8_fp8(acc[ai][bj][m][0] * rs, acc[ai][bj][m][1] * rs); }
            } else { const int j0 = (w - 128) >> 1;
#pragma unroll
                for (int ai = 0; ai < 2; ++ai)
#pragma unroll
                    for (int m = 0; m < 4; ++m) { const int row = row0 + ai * 128 + m * 16; const float rs = rowsc[ai * 128 + wr * 64 + m * 16 + fr];
                        const int pos = NMETA + (row & (SEQ - 1)); f32x4 lo, hi; rope4(acc[ai][bj][m][0] * rs, acc[ai][bj][m][1] * rs, cosT, sinT, pos, j0, lo, hi);
                        unsigned char* qp = qm + (size_t)row * 3072 + hd * 192 + 128 + j0; *(GAS unsigned*)qp = pack4_fp8(lo); *(GAS unsigned*)(qp + 32) = pack4_fp8(hi); }
            } }
    }
};

__device__ __forceinline__ void unpack8(const u32x4 w, f32x4& a, f32x4& b) { a = (f32x4){bf_lo(w.x), bf_hi(w.x), bf_lo(w.y), bf_hi(w.y)}; b = (f32x4){bf_lo(w.z), bf_hi(w.z), bf_lo(w.w), bf_hi(w.w)}; }
struct EpiP5a {
    static constexpr bool PERM = true, HAS_PRE = false;
    const unsigned char* ga; unsigned char* t1;
    __device__ __forceinline__ void operator()(const f32x4 (&acc)[2][2][4][2], const Unit& u, int wr, int wc, int fr, int fq, const LAS float* rowsc) const {
        const int row0 = u.pm * 256 + wr * 64 + fr, col0 = u.pn * 256 + wc * 32 + 8 * fq;
#pragma unroll
        for (int ai = 0; ai < 2; ++ai)
#pragma unroll
            for (int m = 0; m < 4; ++m) { const size_t off = (size_t)(row0 + ai * 128 + m * 16) * 2048 + col0;
#pragma unroll
                for (int bj = 0; bj < 2; ++bj) { f32x4 g0, g1; unpack8_u8(*(const GAS u32x2*)(ga + off + bj * 128), g0, g1);
                    *(GAS u32x2*)(t1 + off + bj * 128) = pack8_fp8(acc[ai][bj][m][0] * g0 * 32.f, acc[ai][bj][m][1] * g1 * 32.f); } }
    }
};
struct EpiP5b {
    static constexpr bool PERM = true, HAS_PRE = false;
    const unsigned char* gb; const unsigned char* t1; unsigned char* merged;
    __device__ __forceinline__ void operator()(const f32x4 (&acc)[2][2][4][2], const Unit& u, int wr, int wc, int fr, int fq, const LAS float* rowsc) const {
        const int row0 = u.pm * 256 + wr * 64 + fr, col0 = u.pn * 256 + wc * 32 + 8 * fq;
#pragma unroll
        for (int ai = 0; ai < 2; ++ai)
#pragma unroll
            for (int m = 0; m < 4; ++m) { const size_t off = (size_t)(row0 + ai * 128 + m * 16) * 2048 + col0;
#pragma unroll
                for (int bj = 0; bj < 2; ++bj) { f32x4 g0, g1; unpack8_u8(*(const GAS u32x2*)(gb + off + bj * 128), g0, g1);
                    f32x4 a, b; unpack8_fp8(*(const GAS u32x2*)(t1 + off + bj * 128), a, b);
                    *(GAS u32x2*)(merged + off + bj * 128) = pack8_fp8(a + acc[ai][bj][m][0] * g0 * 32.f, b + acc[ai][bj][m][1] * g1 * 32.f); } }
    }
};
struct EpiP6 {
    static constexpr bool PERM = true, HAS_PRE = false;
    const float* x; bf16_t* h2b; float* ssq2;
    __device__ __forceinline__ void operator()(const f32x4 (&acc)[2][2][4][2], const Unit& u, int wr, int wc, int fr, int fq, const LAS float* rowsc) const {
        const int row0 = u.pm * 256 + wr * 64 + fr, col0 = u.pn * 256 + wc * 32 + 8 * fq;
#pragma unroll
        for (int ai = 0; ai < 2; ++ai)
#pragma unroll
            for (int m = 0; m < 4; ++m) { const int row = row0 + ai * 128 + m * 16; const size_t off = (size_t)row * 2048 + col0; float s = 0.f;
#pragma unroll
                for (int bj = 0; bj < 2; ++bj) { const f32x4 a = *(const GAS f32x4*)(x + off + bj * 128) + acc[ai][bj][m][0], b = *(const GAS f32x4*)(x + off + bj * 128 + 4) + acc[ai][bj][m][1];
                    s += (a[0] * a[0] + a[1] * a[1]) + (a[2] * a[2] + a[3] * a[3]) + (b[0] * b[0] + b[1] * b[1]) + (b[2] * b[2] + b[3] * b[3]);
                    *(GAS u32x4*)(h2b + off + bj * 128) = pack8(a, b); }
                s += __shfl_xor(s, 16); s += __shfl_xor(s, 32);
                if (fq == 0) ssq2[(size_t)(u.pn * 4 + wc) * MREAL + row] = s; }
    }
};
struct EpiP7 {
    static constexpr bool PERM = true, HAS_PRE = true;
    const float* ssq2; _Float16* sc;
    __device__ __forceinline__ void pre(const Unit& u, LAS float* sc, int tid) const { if (tid < 256) sc[tid] = rstd_slabs<32, MREAL>(ssq2, u.pm * 256 + tid, 1.f / 2048.f); }
    __device__ __forceinline__ void operator()(const f32x4 (&acc)[2][2][4][2], const Unit& u, int wr, int wc, int fr, int fq, const LAS float* rowsc) const {
        typedef _Float16 h4_t __attribute__((ext_vector_type(4)));
        const int row0 = u.pm * 256 + wr * 64 + fr, col0 = u.pn * 256 + wc * 32 + 8 * fq;
#pragma unroll
        for (int ai = 0; ai < 2; ++ai)
#pragma unroll
            for (int m = 0; m < 4; ++m) { const int row = row0 + ai * 128 + m * 16; const float rs = rowsc[ai * 128 + wr * 64 + m * 16 + fr]; const size_t off = (size_t)row * 2048 + col0;
#pragma unroll
                for (int bj = 0; bj < 2; ++bj) { const h4_t lo = __builtin_convertvector(acc[ai][bj][m][0] * rs, h4_t), hi = __builtin_convertvector(acc[ai][bj][m][1] * rs, h4_t);
                    const u32x2 wl = __builtin_bit_cast(u32x2, lo), wh = __builtin_bit_cast(u32x2, hi);
                    *(GAS u32x4*)(sc + off + bj * 128) = (u32x4){wl.x, wl.y, wh.x, wh.y}; } }
    }
};
namespace att {
#define KSWZ(row, colB) ((row) * 256 + ((colB) ^ (((row) & 7) << 4)))
#define KRSWZ(row, colB) ((row) * 128 + ((colB) ^ ((((row) >> 1) & 7) << 4)))
constexpr float L2E = 1.4426950408889634f;
template <int DUMMY = 0>
__device__ __forceinline__ void partialSM(f32x16& p0, f32x16& p1, float& m_reg, float& mn, float& alpha, const float C, const float THRS) {
  float pmax = p0[0];
#pragma unroll
  for (int r = 1; r < 16; ++r) pmax = fmaxf(pmax, p0[r]);
#pragma unroll
  for (int r = 0; r < 16; ++r) pmax = fmaxf(pmax, p1[r]);
  { auto rr = __builtin_amdgcn_permlane32_swap(__float_as_uint(pmax), __float_as_uint(pmax), false, false);
    pmax = fmaxf(__uint_as_float(rr[0]), __uint_as_float(rr[1])); }
  if (__builtin_expect(__all(pmax - m_reg <= THRS), 1)) { mn = m_reg; alpha = 1.f; }
  else { mn = fmaxf(m_reg, pmax); alpha = __builtin_amdgcn_exp2f((m_reg - mn) * C); m_reg = mn; }
  const float mnC = -mn * C;
#pragma unroll
  for (int r = 0; r < 16; ++r) p0[r] = fmaf(p0[r], C, mnC);
#pragma unroll
  for (int r = 0; r < 16; ++r) p1[r] = fmaf(p1[r], C, mnC);
#pragma unroll
  for (int r = 0; r < 16; ++r) p0[r] = __builtin_amdgcn_exp2f(p0[r]);
}
__device__ __forceinline__ void finishSM(f32x16& p0, f32x16& p1, float alpha, float& l_reg, bf16x8& pa0, bf16x8& pa1, bf16x8& pa2, bf16x8& pa3) {
#pragma unroll
  for (int r = 0; r < 16; ++r) p1[r] = __builtin_amdgcn_exp2f(p1[r]);
  float ps = 0;
#pragma unroll
  for (int r = 0; r < 16; ++r) ps += p0[r];
#pragma unroll
  for (int r = 0; r < 16; ++r) ps += p1[r];
  { auto rr = __builtin_amdgcn_permlane32_swap(__float_as_uint(ps), __float_as_uint(ps), false, false);
    ps = __uint_as_float(rr[0]) + __uint_as_float(rr[1]); }
  l_reg = l_reg * alpha + ps;
#define PK4(P, BASE, OUT) do { unsigned a0 = cvt_pk_bf16(P[BASE + 0], P[BASE + 1]), a1 = cvt_pk_bf16(P[BASE + 2], P[BASE + 3]);   \
    unsigned b0 = cvt_pk_bf16(P[BASE + 4], P[BASE + 5]), b1 = cvt_pk_bf16(P[BASE + 6], P[BASE + 7]);                              \
    auto r0 = __builtin_amdgcn_permlane32_swap(a0, b0, false, false); auto r1 = __builtin_amdgcn_permlane32_swap(a1, b1, false, false); \
    u32x4 w = {r0[0], r1[0], r0[1], r1[1]}; OUT = __builtin_bit_cast(bf16x8, w); } while (0)
  PK4(p0, 0, pa0); PK4(p0, 8, pa1); PK4(p1, 0, pa2); PK4(p1, 8, pa3);
#undef PK4
}
constexpr int NW = 8, QBLK = 32, KVBLK = 64;
constexpr float MLA_SCALE = 0.07216878364870322f;
constexpr float MLA_THR = 8.f;
constexpr int SHM_V = KVBLK * 128 * 2, SHM_KN = KVBLK * 128 * 2, SHM_KR = KVBLK * 64 * 2;
constexpr int OFF_V = 0, OFF_KN = 2 * SHM_V, OFF_KR = OFF_KN + 2 * SHM_KN, OFF_WS = OFF_KR + 2 * SHM_KR, OFF_QR = OFF_WS + NW * 64 * 4, MLA_LDS = OFF_QR + NW * 4096;
__device__ __forceinline__ void qkt(f32x16& p0, f32x16& p1, const LAS char* Kn, const LAS char* Kr, const bf16x8* qr, const LAS char* qrp, const int* kb, const int* krb) {
  p0 = f32x16{}; p1 = f32x16{};
#pragma unroll
  for (int d0 = 0; d0 < 8; ++d0) {
    const bf16x8 b0 = *(const LAS bf16x8*)(Kn + kb[d0 & 3] + (d0 >> 2) * 128);
    const bf16x8 b1 = *(const LAS bf16x8*)(Kn + kb[d0 & 3] + (d0 >> 2) * 128 + 8192);
    p0 = __builtin_amdgcn_mfma_f32_32x32x16_bf16(b0, qr[d0], p0, 0, 0, 0);
    p1 = __builtin_amdgcn_mfma_f32_32x32x16_bf16(b1, qr[d0], p1, 0, 0, 0); }
#pragma unroll
  for (int d0 = 0; d0 < 4; ++d0) {
    const bf16x8 b0 = *(const LAS bf16x8*)(Kr + krb[d0]);
    const bf16x8 b1 = *(const LAS bf16x8*)(Kr + krb[d0] + 4096);
    const bf16x8 qf = *(const LAS bf16x8*)(qrp + d0 * 1024);
    p0 = __builtin_amdgcn_mfma_f32_32x32x16_bf16(b0, qf, p0, 0, 0, 0);
    p1 = __builtin_amdgcn_mfma_f32_32x32x16_bf16(b1, qf, p1, 0, 0, 0); }
}
__device__ __forceinline__ int v_st(int k, int c) { const int kk = (k & ~0xC) | ((k & 4) << 1) | ((k & 8) >> 1); return ((kk >> 3) * 4 + (c >> 5)) * 512 + ((kk & 7) * 32 + (c & 31)) * 2; }
__device__ __forceinline__ int v_rd_base(int lane) { return ((lane & 3) << 3) | (((lane >> 2) & 3) << 6) | (((lane >> 4) & 1) << 5) | (((lane >> 5) & 1) << 8); }
constexpr int v_rd_off(int d0, int ks, int half) { return d0 * 512 + ks * 4096 + half * 2048; }
template <int OFF> __device__ __forceinline__ s16x4 tr_read(int vb) {
  s16x4 r; asm volatile("ds_read_b64_tr_b16 %0, %1 offset:%2" : "=&v"(r) : "v"(vb), "i"(OFF) : "memory"); return r;
}
template <int D0> __device__ __forceinline__ void pv_one(f32x16& od, int vb, bf16x8 pa0, bf16x8 pa1, bf16x8 pa2, bf16x8 pa3) {
  const s16x4 l0 = tr_read<v_rd_off(D0, 0, 0)>(vb), h0 = tr_read<v_rd_off(D0, 0, 1)>(vb), l1 = tr_read<v_rd_off(D0, 1, 0)>(vb), h1 = tr_read<v_rd_off(D0, 1, 1)>(vb);
  const s16x4 l2 = tr_read<v_rd_off(D0, 2, 0)>(vb), h2 = tr_read<v_rd_off(D0, 2, 1)>(vb), l3 = tr_read<v_rd_off(D0, 3, 0)>(vb), h3 = tr_read<v_rd_off(D0, 3, 1)>(vb);
  asm volatile("s_waitcnt lgkmcnt(0)" ::: "memory"); SBAR();
#define PK(L, H) (bf16x8){L[0], L[1], L[2], L[3], H[0], H[1], H[2], H[3]}
  od = __builtin_amdgcn_mfma_f32_32x32x16_bf16(pa0, PK(l0, h0), od, 0, 0, 0);
  od = __builtin_amdgcn_mfma_f32_32x32x16_bf16(pa1, PK(l1, h1), od, 0, 0, 0);
  od = __builtin_amdgcn_mfma_f32_32x32x16_bf16(pa2, PK(l2, h2), od, 0, 0, 0);
  od = __builtin_amdgcn_mfma_f32_32x32x16_bf16(pa3, PK(l3, h3), od, 0, 0, 0);
#undef PK
}
__device__ __forceinline__ void pv_d0(f32x16* o, int vb, bf16x8 pa0, bf16x8 pa1, bf16x8 pa2, bf16x8 pa3) {
  pv_one<0>(o[0], vb, pa0, pa1, pa2, pa3); pv_one<1>(o[1], vb, pa0, pa1, pa2, pa3); pv_one<2>(o[2], vb, pa0, pa1, pa2, pa3); pv_one<3>(o[3], vb, pa0, pa1, pa2, pa3);
}
__device__ __forceinline__ void mla_unit(int b, int h, int qb, const bf16_t* __restrict__ QM, const bf16_t* __restrict__ KN, const bf16_t* __restrict__ KR, const bf16_t* __restrict__ VV, unsigned char* __restrict__ OM, LAS char* lds) {
  const int tid = threadIdx.x, wid = tid >> 6, lane = tid & 63, r32 = lane & 31, hi = lane >> 5;
  constexpr float C = MLA_SCALE * L2E, THRS = MLA_THR / MLA_SCALE;
  constexpr int NT = 33;
  LAS char* V_lds = lds + OFF_V; LAS char* Kn_lds = lds + OFF_KN; LAS char* Kr_lds = lds + OFF_KR;
  LAS float* ws = (LAS float*)(lds + OFF_WS) + wid * 64; LAS float* li_l = ws; LAS float* al_l = ws + 32;
  float m_reg = -1e30f, l_reg = 0; f32x16 o[4] = {}; bf16x8 qr[8];
  LAS char* qrp = lds + OFF_QR + wid * 4096 + lane * 16;
  const int qrow = b * SEQ + qb * 256 + wid * QBLK + r32;
  const bf16_t* Qw = QM + (size_t)qrow * 3072 + h * 192 + hi * 8;
#pragma unroll
  for (int d0 = 0; d0 < 8; ++d0) qr[d0] = *(const GAS bf16x8*)(Qw + d0 * 16);
  __syncthreads();
#pragma unroll
  for (int d0 = 0; d0 < 4; ++d0) *(LAS bf16x8*)(qrp + d0 * 1024) = *(const GAS bf16x8*)(Qw + (8 + d0) * 16);
  const int sr = tid >> 4, sc = (tid & 15) * 8, vst0 = v_st(sr, sc), vst1 = v_st(32 + sr, sc);
  const int krr = tid >> 3, krc = (tid & 7) * 8;
  const int vb0 = (int)(uintptr_t)V_lds + v_rd_base(lane);
  bf16x8 s_v0, s_v1, s_k0, s_k1, s_kr;
  const int realbase = b * SEQ - KVBLK;
  const unsigned voff = (unsigned)(sr * 2048 + sc) * 2u, kroff = (unsigned)(krr * 64 + krc) * 2u;
  int kb[4], krb[4];
#pragma unroll
  for (int bq = 0; bq < 4; ++bq) { kb[bq] = KSWZ(r32, bq * 32 + hi * 16); krb[bq] = KRSWZ(r32, bq * 32 + hi * 16); }
#define TROW(t) ((t) == 0 ? MREAL : realbase + (t) * KVBLK)
#define SLOAD(t) do { const int k0_ = TROW(t); const size_t ro_ = ((size_t)k0_ * 2048 + h * 128) * 2; \
    const GAS char* vb_ = (const GAS char*)VV + ro_; const GAS char* nb_ = (const GAS char*)KN + ro_; const GAS char* rb_ = (const GAS char*)KR + (size_t)k0_ * 128; \
    s_v0 = *(const GAS bf16x8*)(vb_ + voff); s_v1 = *(const GAS bf16x8*)(vb_ + 32 * 4096 + voff); \
    s_k0 = *(const GAS bf16x8*)(nb_ + voff); s_k1 = *(const GAS bf16x8*)(nb_ + 32 * 4096 + voff); \
    s_kr = *(const GAS bf16x8*)(rb_ + kroff); } while (0)
#define SWRITE(bf) do { *(LAS bf16x8*)(V_lds + (bf) * SHM_V + vst0) = s_v0; *(LAS bf16x8*)(V_lds + (bf) * SHM_V + vst1) = s_v1; const int kc_ = sc * 2; \
    *(LAS bf16x8*)(Kn_lds + (bf) * SHM_KN + KSWZ(sr, kc_)) = s_k0; *(LAS bf16x8*)(Kn_lds + (bf) * SHM_KN + KSWZ(32 + sr, kc_)) = s_k1; \
    *(LAS bf16x8*)(Kr_lds + (bf) * SHM_KR + KRSWZ(krr, krc * 2)) = s_kr; } while (0)
#define SWAIT() asm volatile("s_waitcnt vmcnt(0)" ::: "memory")
#define RESC(a) do { if (__any((a) < 1.f)) { if (hi == 0) al_l[r32] = (a); asm volatile("s_waitcnt lgkmcnt(0)" ::: "memory"); \
    _Pragma("unroll") for (int d = 0; d < 4; ++d) _Pragma("unroll") for (int r = 0; r < 16; ++r) o[d][r] *= al_l[crow(r, hi)]; } } while (0)
  f32x16 pA0, pA1, pB0, pB1; float mnA, mnB, alA, alB; bf16x8 pa0, pa1, pa2, pa3;
  SLOAD(0); SWAIT(); SWRITE(0); __syncthreads();
  qkt(pA0, pA1, Kn_lds, Kr_lds, qr, qrp, kb, krb);
  { const float NEG = -INFINITY;
#pragma unroll
    for (int r = 8; r < 16; ++r) pA0[r] = NEG;
#pragma unroll
    for (int r = 0; r < 16; ++r) pA1[r] = NEG; }
  partialSM(pA0, pA1, m_reg, mnA, alA, C, THRS);
  SLOAD(1); SWAIT(); SWRITE(1); __syncthreads();
  for (int j = 1; j + 1 < NT; j += 2) {
    SBAR(); qkt(pB0, pB1, Kn_lds + SHM_KN, Kr_lds + SHM_KR, qr, qrp, kb, krb);
    finishSM(pA0, pA1, alA, l_reg, pa0, pa1, pa2, pa3); SBAR();
    SLOAD(j + 1); SBAR();
    pv_d0(o, vb0, pa0, pa1, pa2, pa3); partialSM(pB0, pB1, m_reg, mnB, alB, C, THRS);
    __syncthreads(); SWAIT(); SWRITE(0);
    RESC(alB); __syncthreads();
    SBAR(); qkt(pA0, pA1, Kn_lds, Kr_lds, qr, qrp, kb, krb);
    finishSM(pB0, pB1, alB, l_reg, pa0, pa1, pa2, pa3); SBAR();
    if (j + 2 < NT) SLOAD(j + 2); SBAR();
    pv_d0(o, vb0 + SHM_V, pa0, pa1, pa2, pa3); partialSM(pA0, pA1, m_reg, mnA, alA, C, THRS);
    __syncthreads(); if (j + 2 < NT) { SWAIT(); SWRITE(1); }
    RESC(alA); __syncthreads();
  }
  finishSM(pA0, pA1, alA, l_reg, pa0, pa1, pa2, pa3); SBAR();
  pv_d0(o, vb0, pa0, pa1, pa2, pa3);
  if (hi == 0) li_l[r32] = l_reg; asm volatile("s_waitcnt lgkmcnt(0)" ::: "memory");
  float rli[16];
#pragma unroll
  for (int r = 0; r < 16; ++r) rli[r] = __builtin_amdgcn_rcpf(li_l[crow(r, hi)]);
  unsigned char* Ow = OM + (size_t)(b * SEQ + qb * 256 + wid * QBLK) * 2048 + h * 128;
#pragma unroll
  for (int r = 0; r < 16; ++r) { const int orow = crow(r, hi);
#pragma unroll
    for (int d0 = 0; d0 < 4; ++d0) Ow[(size_t)orow * 2048 + d0 * 32 + r32] = f32_to_fp8(o[d0][r] * rli[r] * 32.f); }
#undef TROW
#undef SLOAD
#undef SWRITE
#undef SWAIT
#undef RESC
}
constexpr int K8S = 208, V8S = 80, SHM8_K = 64 * K8S, SHM8_V = 128 * V8S;
constexpr int OFF8_K = 0, OFF8_V = 2 * SHM8_K, OFF8_WS = OFF8_V + 2 * SHM8_V, MLA8_LDS = OFF8_WS + NW * 64 * 4;
constexpr float MLA8_THR = 1.9f;
typedef int a8_t __attribute__((ext_vector_type(8)));
#define MFMA8(acc_, a_, b_, sa_, sb_) asm volatile("s_nop 1\n\tv_mfma_scale_f32_32x32x64_f8f6f4 %0, %1, %2, %0, %3, %4 op_sel_hi:[0,0,0]" : "+v"(acc_) : "v"(a_), "v"(b_), "v"(sa_), "v"(sb_))
__device__ __forceinline__ a8_t ld_frag8(const LAS char* p) { const u32x4 lo = *(const LAS u32x4*)p, hi = *(const LAS u32x4*)(p + 16); return (a8_t){(int)lo.x, (int)lo.y, (int)lo.z, (int)lo.w, (int)hi.x, (int)hi.y, (int)hi.z, (int)hi.w}; }
__device__ __forceinline__ void qkt8(f32x16& p0, f32x16& p1, const LAS char* Kb, const a8_t& q0, const a8_t& q1, const a8_t& q2, int s1) {
  p0 = f32x16{}; p1 = f32x16{};
  { const a8_t a0 = ld_frag8(Kb), a1 = ld_frag8(Kb + 32 * K8S); MFMA8(p0, a0, q0, s1, s1); MFMA8(p1, a1, q0, s1, s1); }
  { const a8_t a0 = ld_frag8(Kb + 64), a1 = ld_frag8(Kb + 32 * K8S + 64); MFMA8(p0, a0, q1, s1, s1); MFMA8(p1, a1, q1, s1, s1); }
  { const a8_t a0 = ld_frag8(Kb + 128), a1 = ld_frag8(Kb + 32 * K8S + 128); MFMA8(p0, a0, q2, s1, s1); MFMA8(p1, a1, q2, s1, s1); }
  asm volatile("s_nop 15\n\ts_nop 15" : "+v"(p0), "+v"(p1));
}
__device__ __forceinline__ void partialSM8(f32x16& p0, f32x16& p1, float& m_reg, float& mn, float& alpha, const float C, const float THRS) {
  float pmax = p0[0];
#pragma unroll
  for (int r = 1; r < 16; ++r) pmax = fmaxf(pmax, p0[r]);
#pragma unroll
  for (int r = 0; r < 16; ++r) pmax = fmaxf(pmax, p1[r]);
  { auto rr = __builtin_amdgcn_permlane32_swap(__float_as_uint(pmax), __float_as_uint(pmax), false, false);
    pmax = fmaxf(__uint_as_float(rr[0]), __uint_as_float(rr[1])); }
  if (__builtin_expect(__all(pmax - m_reg <= THRS), 1)) { mn = m_reg; alpha = 1.f; }
  else { mn = fmaxf(m_reg, pmax); alpha = __builtin_amdgcn_exp2f((m_reg - mn) * C); m_reg = mn; }
  const float mnC = 6.f - mn * C;
#pragma unroll
  for (int r = 0; r < 16; ++r) p0[r] = fmaf(p0[r], C, mnC);
#pragma unroll
  for (int r = 0; r < 16; ++r) p1[r] = fmaf(p1[r], C, mnC);
#pragma unroll
  for (int r = 0; r < 16; ++r) p0[r] = __builtin_amdgcn_exp2f(p0[r]);
}
__device__ __forceinline__ void finishSM8(f32x16& p0, f32x16& p1, float alpha, float& l_reg, a8_t& pf) {
#pragma unroll
  for (int r = 0; r < 16; ++r) p1[r] = __builtin_amdgcn_exp2f(p1[r]);
  float ps = 0;
#pragma unroll
  for (int r = 0; r < 16; ++r) ps += p0[r];
#pragma unroll
  for (int r = 0; r < 16; ++r) ps += p1[r];
  { auto rr = __builtin_amdgcn_permlane32_swap(__float_as_uint(ps), __float_as_uint(ps), false, false);
    ps = __uint_as_float(rr[0]) + __uint_as_float(rr[1]); }
  l_reg = l_reg * alpha + ps;
#pragma unroll
  for (int w = 0; w < 4; ++w) { int x = 0, y = 0;
    x = __builtin_amdgcn_cvt_pk_fp8_f32(p0[4 * w], p0[4 * w + 1], x, false); x = __builtin_amdgcn_cvt_pk_fp8_f32(p0[4 * w + 2], p0[4 * w + 3], x, true);
    y = __builtin_amdgcn_cvt_pk_fp8_f32(p1[4 * w], p1[4 * w + 1], y, false); y = __builtin_amdgcn_cvt_pk_fp8_f32(p1[4 * w + 2], p1[4 * w + 3], y, true);
    pf[w] = x; pf[4 + w] = y; }
}
__device__ __forceinline__ void pv8(f32x16* o, const LAS char* Vb, const a8_t& pf, int sP, int s1) {
  const a8_t b0 = ld_frag8(Vb), b1 = ld_frag8(Vb + 32 * V8S), b2 = ld_frag8(Vb + 64 * V8S), b3 = ld_frag8(Vb + 96 * V8S);
  MFMA8(o[0], pf, b0, sP, s1); MFMA8(o[1], pf, b1, sP, s1); MFMA8(o[2], pf, b2, sP, s1); MFMA8(o[3], pf, b3, sP, s1);
  asm volatile("s_nop 15\n\ts_nop 15" : "+v"(o[0]), "+v"(o[1]), "+v"(o[2]), "+v"(o[3]));
}
__device__ __forceinline__ void mla_unit8(int b, int h, int qb, const unsigned char* __restrict__ QM8, const unsigned char* __restrict__ KN8, const unsigned char* __restrict__ KR8, const unsigned char* __restrict__ VT8,
                                          unsigned char* __restrict__ OM, LAS char* lds) {
  const int tid = threadIdx.x, wid = tid >> 6, lane = tid & 63, r32 = lane & 31, hi = lane >> 5;
  constexpr float C = MLA_SCALE * L2E, THRS = MLA8_THR / MLA_SCALE;
  constexpr int NT = 33;
  LAS char* K_lds = lds + OFF8_K; LAS char* V_lds = lds + OFF8_V;
  LAS float* ws = (LAS float*)(lds + OFF8_WS) + wid * 64; LAS float* li_l = ws; LAS float* al_l = ws + 32;
  int s1 = 0x7f7f7f7f, sP = 0x79797979; asm volatile("" : "+v"(s1), "+v"(sP));
  float m_reg = -1e30f, l_reg = 0; f32x16 o[4] = {};
  const int qrow = b * SEQ + qb * 256 + wid * QBLK + r32;
  a8_t q0, q1, q2;
  { const unsigned char* Qw = QM8 + (size_t)qrow * 3072 + h * 192 + hi * 32;
    const u32x4 a = *(const GAS u32x4*)Qw, bq = *(const GAS u32x4*)(Qw + 16), c = *(const GAS u32x4*)(Qw + 64), d = *(const GAS u32x4*)(Qw + 80), e = *(const GAS u32x4*)(Qw + 128), f = *(const GAS u32x4*)(Qw + 144);
    q0 = (a8_t){(int)a.x, (int)a.y, (int)a.z, (int)a.w, (int)bq.x, (int)bq.y, (int)bq.z, (int)bq.w};
    q1 = (a8_t){(int)c.x, (int)c.y, (int)c.z, (int)c.w, (int)d.x, (int)d.y, (int)d.z, (int)d.w};
    q2 = (a8_t){(int)e.x, (int)e.y, (int)e.z, (int)e.w, (int)f.x, (int)f.y, (int)f.z, (int)f.w}; }
  __syncthreads();
  const int kkey = tid >> 3, kch = tid & 7, rkey = (tid >> 2) & 63, rch = tid & 3, vdim = tid >> 2, vch = tid & 3;
  const LAS char* Kf = K_lds + r32 * K8S + 32 * hi; const LAS char* Vf = V_lds + r32 * V8S + 32 * hi;
  u32x4 s_k, s_r, s_v;
  const int realbase = b * SEQ - KVBLK;
#define TROW(t) ((t) == 0 ? MREAL : realbase + (t) * KVBLK)
#define SLOAD(t) do { const int k0_ = TROW(t); \
    s_k = *(const GAS u32x4*)(KN8 + (size_t)(k0_ + kkey) * 2048 + h * 128 + kch * 16); \
    s_r = *(const GAS u32x4*)(KR8 + (size_t)(k0_ + rkey) * 64 + rch * 16); \
    s_v = *(const GAS u32x4*)(VT8 + (size_t)(h * 128 + vdim) * MPAD + k0_ + vch * 16); } while (0)
#define SWRITE(bf) do { *(LAS u32x4*)(K_lds + (bf) * SHM8_K + kkey * K8S + kch * 16) = s_k; if (tid < 256) *(LAS u32x4*)(K_lds + (bf) * SHM8_K + rkey * K8S + 128 + rch * 16) = s_r; \
    *(LAS u32x4*)(V_lds + (bf) * SHM8_V + vdim * V8S + vch * 16) = s_v; } while (0)
#define SWAIT() asm volatile("s_waitcnt vmcnt(0)" ::: "memory")
#define RESC(a) do { if (__any((a) < 1.f)) { if (hi == 0) al_l[r32] = (a); asm volatile("s_waitcnt lgkmcnt(0)" ::: "memory"); \
    _Pragma("unroll") for (int d = 0; d < 4; ++d) _Pragma("unroll") for (int r = 0; r < 16; ++r) o[d][r] *= al_l[crow(r, hi)]; } } while (0)
  f32x16 pA0, pA1, pB0, pB1; float mnA, mnB, alA, alB; a8_t pf;
  SLOAD(0); SWAIT(); SWRITE(0); __syncthreads();
  qkt8(pA0, pA1, Kf, q0, q1, q2, s1);
  { const float NEG = -INFINITY;
#pragma unroll
    for (int r = 8; r < 16; ++r) pA0[r] = NEG;
#pragma unroll
    for (int r = 0; r < 16; ++r) pA1[r] = NEG; }
  partialSM8(pA0, pA1, m_reg, mnA, alA, C, THRS);
  SLOAD(1); SWAIT(); SWRITE(1); __syncthreads();
  for (int j = 1; j + 1 < NT; j += 2) {
    SBAR(); qkt8(pB0, pB1, Kf + SHM8_K, q0, q1, q2, s1);
    finishSM8(pA0, pA1, alA, l_reg, pf); SBAR();
    SLOAD(j + 1); SBAR();
    pv8(o, Vf, pf, sP, s1); partialSM8(pB0, pB1, m_reg, mnB, alB, C, THRS);
    __syncthreads(); SWAIT(); SWRITE(0);
    RESC(alB); __syncthreads();
    SBAR(); qkt8(pA0, pA1, Kf, q0, q1, q2, s1);
    finishSM8(pB0, pB1, alB, l_reg, pf); SBAR();
    if (j + 2 < NT) SLOAD(j + 2); SBAR();
    pv8(o, Vf + SHM8_V, pf, sP, s1); partialSM8(pA0, pA1, m_reg, mnA, alA, C, THRS);
    __syncthreads(); if (j + 2 < NT) { SWAIT(); SWRITE(1); }
    RESC(alA); __syncthreads();
  }
  finishSM8(pA0, pA1, alA, l_reg, pf); SBAR();
  pv8(o, Vf, pf, sP, s1);
  if (hi == 0) li_l[r32] = l_reg; asm volatile("s_waitcnt lgkmcnt(0)" ::: "memory");
  float rli[16];
#pragma unroll
  for (int r = 0; r < 16; ++r) rli[r] = __builtin_amdgcn_rcpf(li_l[crow(r, hi)]) * (64.f * 32.f);
  unsigned char* Ow = OM + (size_t)(b * SEQ + qb * 256 + wid * QBLK) * 2048 + h * 128;
#pragma unroll
  for (int r = 0; r < 16; ++r) { const int orow = crow(r, hi);
#pragma unroll
    for (int d0 = 0; d0 < 4; ++d0) Ow[(size_t)orow * 2048 + d0 * 32 + r32] = f32_to_fp8(o[d0][r] * rli[r]); }
#undef TROW
#undef SLOAD
#undef SWRITE
#undef SWAIT
#undef RESC
}
__device__ __forceinline__ void na_task(int task, const unsigned char* __restrict__ NAQ, const unsigned char* __restrict__ NAK, const unsigned char* __restrict__ VT, unsigned char* __restrict__ ONA,
                                        const LAS float* relb, const LAS float* metab, LAS float* wsf, int lane, Conv& cv) {
  const int r32 = lane & 31, hi = lane >> 5;
  const int half = task & 1, r = (task >> 1) & 31, h = (task >> 6) & 15, b = task >> 10;
  const int qc = half * 32 + r32;
  const int cs = min(max(qc - 8, 0), 48), rs = min(max(r - 4, 0), 24);
  const int qtok = b * SEQ + r * 64 + qc;
  constexpr float C = L2E, THRS = 1.9f, SCALE = 0.125f;
  int s1 = 0x7f7f7f7f, sP = 0x79797979; asm volatile("" : "+v"(s1), "+v"(sP));
  a8_t qf; { const unsigned char* qp = NAQ + (size_t)qtok * 1024 + h * 64 + hi * 32; const u32x4 a = *(const GAS u32x4*)qp, c = *(const GAS u32x4*)(qp + 16);
    qf = (a8_t){(int)a.x, (int)a.y, (int)a.z, (int)a.w, (int)c.x, (int)c.y, (int)c.z, (int)c.w}; }
  float m_reg = -1e30f, l_reg = 0.f; f32x16 o[2] = {};
  LAS float* al_l = wsf; LAS float* li_l = wsf + 32;
  const float NEG = -INFINITY;
  const int kb0 = half * 16;
  const unsigned long long wm = 0xFFFFull << (cs - kb0);
  const unsigned mh0 = (unsigned)wm >> (4 * hi), mh1 = (unsigned)(wm >> 32) >> (4 * hi);
  const unsigned char* kq = NAK + (size_t)r32 * 1024 + h * 64 + hi * 32;
  const unsigned char* kq2 = NAK + (size_t)(32 + (r32 & 15)) * 1024 + h * 64 + hi * 32;
  const unsigned char* vq = VT + (size_t)(h * 64 + r32) * VT_PITCH + 32 * hi;
#define NA_KTOK(w) ((w) == 8 ? MREAL : b * SEQ + (rs + (w)) * 64 + kb0)
#define NA_VOFF(w) ((w) == 8 ? MREAL : b * SEQ + (rs + (w)) * 64 + (kb0 >> 1))
#define NA_LOADK(KF, w) do { const size_t ko_ = (size_t)NA_KTOK(w) * 1024; KF[0] = *(const GAS u32x4*)(kq + ko_); KF[1] = *(const GAS u32x4*)(kq + ko_ + 16); KF[2] = *(const GAS u32x4*)(kq2 + ko_); KF[3] = *(const GAS u32x4*)(kq2 + ko_ + 16); } while (0)
#define NA_A8(x_, y_) (a8_t){(int)x_.x, (int)x_.y, (int)x_.z, (int)x_.w, (int)y_.x, (int)y_.y, (int)y_.z, (int)y_.w}
#define NA_TILE(KF, wt, YN) do { \
    u32x4 va0, va1; u32x2 vb0_, vb1_; { const unsigned char* vp_ = vq + NA_VOFF(wt); va0 = *(const GAS u32x4*)vp_; vb0_ = *(const GAS u32x2*)(vp_ + 16); va1 = *(const GAS u32x4*)(vp_ + (size_t)32 * VT_PITCH); vb1_ = *(const GAS u32x2*)(vp_ + (size_t)32 * VT_PITCH + 16); } \
    f32x16 p0 = {}, p1 = {}; \
    { const a8_t k0_ = NA_A8(KF[0], KF[1]), k1_ = NA_A8(KF[2], KF[3]); MFMA8(p0, k0_, qf, s1, s1); MFMA8(p1, k1_, qf, s1, s1); asm volatile("s_nop 15\n\ts_nop 15" : "+v"(p0), "+v"(p1)); } \
    if ((wt) + 1 < 9) NA_LOADK(KF, (wt) + 1);            \
    asm volatile("" ::: "memory"); if ((cv.tick++ & 1) == 0) conv_step<12>(cv, lane);     \
    if ((wt) < 8) { const LAS float* bp_ = relb + ((h * 15 + (rs + (wt) - r + 7)) * 31 + 15 - qc + 4 * hi + kb0);     \
      float bv0[16], bv1[8];        \
      _Pragma("unroll") for (int rg = 0; rg < 16; ++rg) { const int c_ = (rg & 3) + 8 * (rg >> 2); bv0[rg] = bp_[c_]; if (rg < 8) bv1[rg] = bp_[c_ + 32]; } \
      _Pragma("unroll") for (int rg = 0; rg < 16; ++rg) { asm volatile("" : "+v"(bv0[rg])); if (rg < 8) asm volatile("" : "+v"(bv1[rg])); } \
      _Pragma("unroll") for (int rg = 0; rg < 16; ++rg) { const int c_ = (rg & 3) + 8 * (rg >> 2); \
        { const bool ok = (mh0 >> c_) & 1u; p0[rg] = ok ? fmaf(p0[rg], SCALE, bv0[rg]) : NEG; } \
        if (rg < 8) { const bool ok = (mh1 >> c_) & 1u; p1[rg] = ok ? fmaf(p1[rg], SCALE, bv1[rg]) : NEG; } } \
    } else { const LAS float* bp = metab + h * 16; \
      _Pragma("unroll") for (int rg = 0; rg < 16; ++rg) { const int kc = crow(rg, hi); p0[rg] = (rg < 8) ? fmaf(p0[rg], SCALE, bp[kc & 15]) : NEG; if (rg < 8) p1[rg] = NEG; } } \
      \
    float pmax = p0[0]; \
    _Pragma("unroll") for (int rg = 1; rg < 16; ++rg) pmax = fmaxf(pmax, p0[rg]); \
    _Pragma("unroll") for (int rg = 0; rg < 8; ++rg) pmax = fmaxf(pmax, p1[rg]); \
    { auto rr = __builtin_amdgcn_permlane32_swap(__float_as_uint(pmax), __float_as_uint(pmax), false, false); pmax = fmaxf(__uint_as_float(rr[0]), __uint_as_float(rr[1])); } \
    float mn, alpha; \
    if (__builtin_expect(__all(pmax - m_reg <= THRS), 1)) { mn = m_reg; alpha = 1.f; } \
    else { mn = fmaxf(m_reg, pmax); alpha = __builtin_amdgcn_exp2f((m_reg - mn) * C); m_reg = mn; } \
    const float mnC = 6.f - mn * C; float ps = 0.f;        \
    _Pragma("unroll") for (int rg = 0; rg < 16; ++rg) { p0[rg] = __builtin_amdgcn_exp2f(fmaf(p0[rg], C, mnC)); ps += p0[rg]; } \
    _Pragma("unroll") for (int rg = 0; rg < 8; ++rg) { p1[rg] = __builtin_amdgcn_exp2f(fmaf(p1[rg], C, mnC)); ps += p1[rg]; } \
    { auto rr = __builtin_amdgcn_permlane32_swap(__float_as_uint(ps), __float_as_uint(ps), false, false); ps = __uint_as_float(rr[0]) + __uint_as_float(rr[1]); } \
    l_reg = l_reg * alpha + ps; \
    a8_t pf;   \
    _Pragma("unroll") for (int w_ = 0; w_ < 4; ++w_) { int x = 0; x = __builtin_amdgcn_cvt_pk_fp8_f32(p0[4 * w_], p0[4 * w_ + 1], x, false); x = __builtin_amdgcn_cvt_pk_fp8_f32(p0[4 * w_ + 2], p0[4 * w_ + 3], x, true); pf[w_] = x; } \
    _Pragma("unroll") for (int w_ = 0; w_ < 2; ++w_) { int x = 0; x = __builtin_amdgcn_cvt_pk_fp8_f32(p1[4 * w_], p1[4 * w_ + 1], x, false); x = __builtin_amdgcn_cvt_pk_fp8_f32(p1[4 * w_ + 2], p1[4 * w_ + 3], x, true); pf[4 + w_] = x; } \
    pf[6] = 0; pf[7] = 0; \
    if (__any(alpha < 1.f)) { if (hi == 0) al_l[r32] = alpha; asm volatile("s_waitcnt lgkmcnt(0)" ::: "memory"); \
      _Pragma("unroll") for (int d = 0; d < 2; ++d) _Pragma("unroll") for (int rg = 0; rg < 16; ++rg) o[d][rg] *= al_l[crow(rg, hi)]; } \
    { const a8_t v0_ = (a8_t){(int)va0.x, (int)va0.y, (int)va0.z, (int)va0.w, (int)vb0_.x, (int)vb0_.y, 0, 0}, v1_ = (a8_t){(int)va1.x, (int)va1.y, (int)va1.z, (int)va1.w, (int)vb1_.x, (int)vb1_.y, 0, 0}; \
      MFMA8(o[0], pf, v0_, sP, s1); MFMA8(o[1], pf, v1_, sP, s1); asm volatile("s_nop 15\n\ts_nop 15" : "+v"(o[0]), "+v"(o[1])); } } while (0)
  { u32x4 kA[4];
    NA_LOADK(kA, 0);
#pragma unroll 1
    for (int w = 0; w < 8; ++w) { NA_TILE(kA, w, 12); }
    NA_TILE(kA, 8, 12); }
#undef NA_KTOK
#undef NA_VOFF
#undef NA_LOADK
#undef NA_A8
#undef NA_TILE
  if (hi == 0) li_l[r32] = l_reg; asm volatile("s_waitcnt lgkmcnt(0)" ::: "memory");
  unsigned char* Ow = ONA + (size_t)(b * SEQ + r * 64 + half * 32) * 1024 + h * 64;
#pragma unroll
  for (int rg = 0; rg < 16; ++rg) { const int orow = crow(rg, hi); const float rl = __builtin_amdgcn_rcpf(li_l[orow]) * (64.f * 16.f);
#pragma unroll
    for (int d0 = 0; d0 < 2; ++d0) Ow[(size_t)orow * 1024 + d0 * 32 + r32] = f32_to_fp8(o[d0][rg] * rl); }
  asm volatile("s_waitcnt lgkmcnt(0)" ::: "memory");
}
}
namespace peer {
constexpr int CH = 32;
constexpr int OFF_TV = 0, OFF_TI = OFF_TV + CH * 16 * 16 * 4, OFF_SE = OFF_TI + CH * 16 * 16 * 4, OFF_SG = OFF_SE + CH * 128 * 4, OFF_SE2 = OFF_SG + CH * 128 * 4, OFF_SG2 = OFF_SE2 + CH * 128 * 4, PEER_LDS = OFF_SG2 + CH * 128 * 4;
static_assert(PEER_LDS <= RING_BYTES, "PEER LDS");
__device__ __forceinline__ float gelu_tanh(float x) {
    const float u = 0.7978845608028654f * (x + 0.044715f * x * x * x);
    const float e = __builtin_amdgcn_exp2f(-2.f * 1.4426950408889634f * fabsf(u));
    const float t = (1.f - e) * __builtin_amdgcn_rcpf(1.f + e);
    return 0.5f * x * (1.f + (u < 0.f ? -t : t));
}
__device__ __forceinline__ void fmac1(float& acc, float a, float b) { asm("v_fmac_f32_e32 %0, %1, %2" : "+v"(acc) : "v"(a), "v"(b)); }
#define PEER_INSERT(x_, xi_) do { float x__ = (x_); int xi__ = (xi_); \
    _Pragma("unroll") for (int j_ = 0; j_ < 16; ++j_) { const bool gt_ = x__ > tv[j_]; const float tvo_ = tv[j_]; const int tio_ = ti[j_]; \
        tv[j_] = gt_ ? x__ : tvo_; ti[j_] = gt_ ? xi__ : tio_; x__ = gt_ ? tvo_ : x__; xi__ = gt_ ? tio_ : xi__; } } while (0)

#define PEER_AUX 0
typedef __amdgpu_buffer_rsrc_t rsrc_t;
__device__ __forceinline__ rsrc_t mk_rsrc(const void* p, unsigned bytes) { return __builtin_amdgcn_make_buffer_rsrc((void*)p, 0, bytes, 0x00020000); }
__device__ __forceinline__ u32x4 ldb128(rsrc_t r, unsigned off) { return __builtin_amdgcn_raw_buffer_load_b128(r, off, 0, PEER_AUX); }
typedef unsigned v6u_t __attribute__((ext_vector_type(6)));
typedef float v32f_t __attribute__((ext_vector_type(32)));
typedef float v16f_t __attribute__((ext_vector_type(16)));
__device__ __forceinline__ u32x2 ldb64(rsrc_t r, unsigned off) { return __builtin_amdgcn_raw_buffer_load_b64(r, off, 0, PEER_AUX); }
__device__ __forceinline__ f32x4 ldf128(rsrc_t r, unsigned off) { return __builtin_bit_cast(f32x4, __builtin_amdgcn_raw_buffer_load_b128(r, off, 0, PEER_AUX)); }
__device__ __forceinline__ f32x4 ldf128_nt(rsrc_t r, unsigned off) { return __builtin_bit_cast(f32x4, __builtin_amdgcn_raw_buffer_load_b128(r, off, 0, 2)); }
__device__ __forceinline__ void peer_select(int chunk, const _Float16* __restrict__ SC, LAS char* lds, int tid, LAS int* SE, LAS float* SG) {
    LAS float* TV = (LAS float*)(lds + OFF_TV); LAS int* TI = (LAS int*)(lds + OFF_TI);
    asm volatile("" : "+v"(tid));
    const int tok0 = chunk * CH;
    const rsrc_t rSC = mk_rsrc(SC, 0x4000000u);
    __syncthreads();
    { const int tl = tid >> 4, g = tid & 15; const unsigned spo = ((unsigned)(tok0 + tl) * 2048u + (unsigned)g * 128u) * 2u;
      int tk[16];
#pragma unroll
      for (int j = 0; j < 16; ++j) tk[j] = (int)0x80000000;
#define PEER_KEY(x_, lowbits_, mask_) ({ const int f_ = __float_as_int(x_); ((f_ ^ ((f_ >> 31) & 0x7fffffff)) & ~(mask_)) | (lowbits_); })
#define PEER_INS(key_) do { int x__ = (key_); _Pragma("unroll") for (int j_ = 0; j_ < 16; ++j_) { const int hi_ = max(x__, tk[j_]); x__ = min(x__, tk[j_]); tk[j_] = hi_; } } while (0)
      typedef _Float16 h8_t __attribute__((ext_vector_type(8)));
#define PEER_CX(a_, b_) do { const int hi_ = max(a_, b_), lo_ = min(a_, b_); a_ = hi_; b_ = lo_; } while (0)
      u32x4 na = __builtin_amdgcn_raw_buffer_load_b128(rSC, spo, 0, 2), nb = __builtin_amdgcn_raw_buffer_load_b128(rSC, spo + 16, 0, 2);
#pragma unroll 1
      for (int i = 0; i < 16; i += 2) { const h8_t a = __builtin_bit_cast(h8_t, na), b = __builtin_bit_cast(h8_t, nb);
          { const unsigned on = spo + (unsigned)min(i + 2, 14) * 16u; na = __builtin_amdgcn_raw_buffer_load_b128(rSC, on, 0, 2); nb = __builtin_amdgcn_raw_buffer_load_b128(rSC, on + 16, 0, 2); }
          int kk[16];
#pragma unroll
          for (int e = 0; e < 8; ++e) { kk[e] = PEER_KEY((float)a[e], 127 - (8 * i + e), 127); kk[8 + e] = PEER_KEY((float)b[e], 127 - (8 * i + 8 + e), 127); }
          PEER_CX(kk[0], kk[13]); PEER_CX(kk[1], kk[12]); PEER_CX(kk[2], kk[15]); PEER_CX(kk[3], kk[14]); PEER_CX(kk[4], kk[8]); PEER_CX(kk[5], kk[6]); PEER_CX(kk[7], kk[11]); PEER_CX(kk[9], kk[10]); PEER_CX(kk[0], kk[5]); PEER_CX(kk[1], kk[7]); PEER_CX(kk[2], kk[9]); PEER_CX(kk[3], kk[4]); PEER_CX(kk[6], kk[13]); PEER_CX(kk[8], kk[14]); PEER_CX(kk[10], kk[15]); PEER_CX(kk[11], kk[12]); PEER_CX(kk[0], kk[1]); PEER_CX(kk[2], kk[3]); PEER_CX(kk[4], kk[5]); PEER_CX(kk[6], kk[8]); PEER_CX(kk[7], kk[9]); PEER_CX(kk[10], kk[11]); PEER_CX(kk[12], kk[13]); PEER_CX(kk[14], kk[15]); PEER_CX(kk[0], kk[2]); PEER_CX(kk[1], kk[3]); PEER_CX(kk[4], kk[10]); PEER_CX(kk[5], kk[11]); PEER_CX(kk[6], kk[7]); PEER_CX(kk[8], kk[9]); PEER_CX(kk[12], kk[14]); PEER_CX(kk[13], kk[15]); PEER_CX(kk[1], kk[2]); PEER_CX(kk[3], kk[12]); PEER_CX(kk[4], kk[6]); PEER_CX(kk[5], kk[7]); PEER_CX(kk[8], kk[10]); PEER_CX(kk[9], kk[11]); PEER_CX(kk[13], kk[14]); PEER_CX(kk[1], kk[4]); PEER_CX(kk[2], kk[6]); PEER_CX(kk[5], kk[8]); PEER_CX(kk[7], kk[10]); PEER_CX(kk[9], kk[13]); PEER_CX(kk[11], kk[14]); PEER_CX(kk[2], kk[4]); PEER_CX(kk[3], kk[6]); PEER_CX(kk[9], kk[12]); PEER_CX(kk[11], kk[13]); PEER_CX(kk[3], kk[5]); PEER_CX(kk[6], kk[8]); PEER_CX(kk[7], kk[9]); PEER_CX(kk[10], kk[12]); PEER_CX(kk[3], kk[4]); PEER_CX(kk[5], kk[6]); PEER_CX(kk[7], kk[8]); PEER_CX(kk[9], kk[10]); PEER_CX(kk[11], kk[12]); PEER_CX(kk[6], kk[7]); PEER_CX(kk[8], kk[9]);
#pragma unroll
          for (int e = 0; e < 16; ++e) tk[e] = max(tk[e], kk[15 - e]);
          PEER_CX(tk[0], tk[8]); PEER_CX(tk[1], tk[9]); PEER_CX(tk[2], tk[10]); PEER_CX(tk[3], tk[11]); PEER_CX(tk[4], tk[12]); PEER_CX(tk[5], tk[13]); PEER_CX(tk[6], tk[14]); PEER_CX(tk[7], tk[15]); PEER_CX(tk[0], tk[4]); PEER_CX(tk[1], tk[5]); PEER_CX(tk[2], tk[6]); PEER_CX(tk[3], tk[7]); PEER_CX(tk[8], tk[12]); PEER_CX(tk[9], tk[13]); PEER_CX(tk[10], tk[14]); PEER_CX(tk[11], tk[15]); PEER_CX(tk[0], tk[2]); PEER_CX(tk[1], tk[3]); PEER_CX(tk[4], tk[6]); PEER_CX(tk[5], tk[7]); PEER_CX(tk[8], tk[10]); PEER_CX(tk[9], tk[11]); PEER_CX(tk[12], tk[14]); PEER_CX(tk[13], tk[15]); PEER_CX(tk[0], tk[1]); PEER_CX(tk[2], tk[3]); PEER_CX(tk[4], tk[5]); PEER_CX(tk[6], tk[7]); PEER_CX(tk[8], tk[9]); PEER_CX(tk[10], tk[11]); PEER_CX(tk[12], tk[13]); PEER_CX(tk[14], tk[15]); }
#undef PEER_CX
      LAS float* tvp = TV + (tl * 16 + g) * 16; LAS int* tip = TI + (tl * 16 + g) * 16;
#pragma unroll
      for (int j = 0; j < 16; ++j) { const int k_ = tk[j] & ~127; tvp[j] = __int_as_float(k_ ^ ((k_ >> 31) & 0x7fffffff)); tip[j] = 127 - (tk[j] & 127); } }
    __syncthreads();
    asm volatile("" : "+v"(tid));
    { const int tl = tid >> 4, hh = (tid >> 1) & 7, half = tid & 1;
      const LAS float* s1 = TV + (tl * 16 + 2 * hh) * 16; const LAS float* s2 = s1 + 16; const LAS int* i1 = TI + (tl * 16 + 2 * hh) * 16; const LAS int* i2 = i1 + 16;
      float b2[16];
#pragma unroll
      for (int j = 0; j < 16; ++j) b2[j] = s2[j];
      int tk[16];
#pragma unroll
      for (int j = 0; j < 16; ++j) tk[j] = (int)0x80000000;
#pragma unroll
      for (int ii = 0; ii < 8; ++ii) { const int i = 2 * ii + half; const float a = s1[i];
#pragma unroll
          for (int j = 0; j < 16; ++j) if ((2 * ii + 1) * (j + 1) <= 16) { if (half == 0 || (2 * ii + 2) * (j + 1) <= 16) PEER_INS(PEER_KEY(a + b2[j], 255 - (i * 16 + j), 255)); } }
      { int pk[16];
#pragma unroll
        for (int j = 0; j < 16; ++j) pk[j] = __shfl_xor(tk[j], 1);
#pragma unroll
        for (int j = 0; j < 16; ++j) PEER_INS(pk[j]); }
      if (half == 0) { float e[16], sum = 0.f; const int k0_ = tk[0] & ~255; const float v0 = __int_as_float(k0_ ^ ((k0_ >> 31) & 0x7fffffff));
#pragma unroll
        for (int j = 0; j < 16; ++j) { const int k_ = tk[j] & ~255; const float vj = __int_as_float(k_ ^ ((k_ >> 31) & 0x7fffffff)); e[j] = __builtin_amdgcn_exp2f((vj - v0) * 1.4426950408889634f); sum += e[j]; }
        const float inv = 1.0f / sum;
#pragma unroll
        for (int j = 0; j < 16; ++j) { const int ci = 255 - (tk[j] & 255); SE[tl * 128 + hh * 16 + j] = i1[ci >> 4] * 128 + i2[ci & 15]; SG[tl * 128 + hh * 16 + j] = e[j] * inv; } } }
#undef PEER_KEY
#undef PEER_INS
    __syncthreads();
}
__device__ __forceinline__ void peer_gather(int chunk, const bf16_t* __restrict__ H2, const unsigned char* __restrict__ U, const unsigned char* __restrict__ V,
                                            const float* __restrict__ g2, const float* __restrict__ gf, float* OUT, int tid, const LAS int* SE, const LAS float* SG) {
    asm volatile("" : "+v"(tid));
    const int tok0 = chunk * CH, lane = tid & 63, wave = tid >> 6;
    const rsrc_t rH2 = mk_rsrc(H2, 0x4000000u), rU = mk_rsrc(U, 0x1000000u), rV = mk_rsrc(V, 0x1000000u), rG2 = mk_rsrc(g2, 8192u), rGF = mk_rsrc(gf, 8192u);
#pragma unroll 1
    for (int tt = 0; tt < CH / NWAVES; ++tt) { const int tl = wave * (CH / NWAVES) + tt, tok = tok0 + tl;
      asm volatile("" ::: "memory");
      float hn[32], acc[32]; float ss = 0.f;
#pragma unroll
      for (int j = 0; j < 2; ++j)
#pragma unroll
          for (int q = 0; q < 4; ++q) { const u32x2 w = ldb64(rH2, ((unsigned)tok * 2048u + 256u * (4 * j + q) + 4u * lane) * 2u);
              const f32x4 a = (f32x4){__uint_as_float(w.x << 16), __uint_as_float(w.x & 0xffff0000u), __uint_as_float(w.y << 16), __uint_as_float(w.y & 0xffff0000u)};
#pragma unroll
              for (int i = 0; i < 4; ++i) { hn[16 * j + 4 * q + i] = a[i]; ss += a[i] * a[i]; } }
      const float rstd = 1.0f / sqrtf(wave_sum(ss) * (1.f / 2048.f) + NORM_EPS);
#pragma unroll
      for (int j = 0; j < 2; ++j)
#pragma unroll
          for (int q = 0; q < 4; ++q) { const f32x4 a = ldf128(rG2, (256u * (4 * j + q) + 4u * lane) * 4u);
#pragma unroll
              for (int i = 0; i < 4; ++i) hn[16 * j + 4 * q + i] *= rstd * a[i]; }
#pragma unroll
      for (int i = 0; i < 32; ++i) acc[i] = 0.f;
#define NX 4
#define PEER_LOAD(S, kb) do { _Pragma("unroll") for (int x = 0; x < NX; ++x) { const unsigned o = (unsigned)SE[tl * 128 + (kb) + x] * 1024u + (unsigned)lane * 16u; \
          S##u[x] = ldb128(rU, o); S##v[x] = ldb128(rV, o); } } while (0)
#define PEER_D2(W, k) { const f32x2 d_ = __builtin_amdgcn_cvt_scalef32_pk_f32_fp4(W[(k) >> 2], 1.0f, (k) & 3); r_[2 * (k)] = d_[0]; r_[2 * (k) + 1] = d_[1]; }
#define PEER_DEC(W) ({ v32f_t r_; PEER_D2(W, 0) PEER_D2(W, 1) PEER_D2(W, 2) PEER_D2(W, 3) PEER_D2(W, 4) PEER_D2(W, 5) PEER_D2(W, 6) PEER_D2(W, 7) \
          PEER_D2(W, 8) PEER_D2(W, 9) PEER_D2(W, 10) PEER_D2(W, 11) PEER_D2(W, 12) PEER_D2(W, 13) PEER_D2(W, 14) PEER_D2(W, 15) \
          asm volatile("s_nop 1" : "+v"(r_)); r_; })
#define PEER_COMPUTE(S, kb) do { float d[NX]; \
          _Pragma("unroll") for (int x = 0; x < NX; ++x) { const v32f_t r = PEER_DEC(S##u[x]); float dd = 0.f; \
              _Pragma("unroll") for (int i = 0; i < 32; ++i) fmac1(dd, hn[i], r[i]); \
              d[x] = dd; } \
          _Pragma("unroll") for (int o = 1; o < 64; o <<= 1) { _Pragma("unroll") for (int x = 0; x < NX; ++x) d[x] += __shfl_xor(d[x], o); } \
          float c[NX]; \
          _Pragma("unroll") for (int x = 0; x < NX; ++x) c[x] = SG[tl * 128 + (kb) + x] * gelu_tanh(d[x] * (1.f / PEER_U_SCALE)) * (1.f / PEER_V_SCALE); \
          _Pragma("unroll") for (int x = 0; x < NX; ++x) { const v32f_t r = PEER_DEC(S##v[x]); \
              _Pragma("unroll") for (int i = 0; i < 32; ++i) fmac1(acc[i], c[x], r[i]); } } while (0)
      { u32x4 Au[NX], Av[NX], Bu[NX], Bv[NX];
        PEER_LOAD(A, 0);
#pragma unroll 1
        for (int k = 0; k < 128; k += 2 * NX) {
            PEER_LOAD(B, k + NX); PEER_COMPUTE(A, k);
            { const int kn = min(k + 2 * NX, 128 - NX); PEER_LOAD(A, kn); }
            PEER_COMPUTE(B, k + NX);
        } }
#undef PEER_DEC
#undef PEER_D2
#undef NX
#undef PEER_LOAD
#undef PEER_COMPUTE
      asm volatile("" ::: "memory");
      int tok2 = tok, lane2 = lane; asm volatile("" : "+v"(tok2), "+v"(lane2));
      float s2 = 0.f;
#pragma unroll
      for (int j = 0; j < 2; ++j)
#pragma unroll
          for (int q = 0; q < 4; ++q) { const u32x2 w = ldb64(rH2, ((unsigned)tok2 * 2048u + 256u * (4 * j + q) + 4u * lane2) * 2u);
              const f32x4 a = (f32x4){__uint_as_float(w.x << 16), __uint_as_float(w.x & 0xffff0000u), __uint_as_float(w.y << 16), __uint_as_float(w.y & 0xffff0000u)};
#pragma unroll
              for (int i = 0; i < 4; ++i) { acc[16 * j + 4 * q + i] += a[i]; s2 += acc[16 * j + 4 * q + i] * acc[16 * j + 4 * q + i]; } }
      const float rf = 1.0f / sqrtf(wave_sum(s2) * (1.f / 2048.f) + NORM_EPS);
#pragma unroll
      for (int j = 0; j < 2; ++j)
#pragma unroll
          for (int q = 0; q < 4; ++q) { const f32x4 a = ldf128(rGF, (256u * (4 * j + q) + 4u * lane2) * 4u); f32x4 oa;
#pragma unroll
              for (int i = 0; i < 4; ++i) oa[i] = acc[16 * j + 4 * q + i] * rf * a[i];
              float* op = OUT + (size_t)tok2 * 2048 + 256 * (4 * j + q) + 4 * lane2;
              __builtin_nontemporal_store(oa, (GAS f32x4*)op); }
    }
}
}
#ifndef MK_N_LAUNCHES
#define MK_N_LAUNCHES 1
#endif
#define MK_PROBE_PH -1
#define MK_PROBE_DIV 2
constexpr int N_PHASES = 9;
constexpr int N_LAUNCHES = MK_N_LAUNCHES;
struct Args { const float* in[19]; float* out; unsigned char* ws; int ph_lo, ph_hi; };
static_assert(sizeof(Args) == 19 * 8 + 8 + 8 + 8, "no padding");

__global__ void __launch_bounds__(NWAVES * 64, 2) hybrid_fwd(Args args) {
    extern __shared__ __attribute__((aligned(16))) unsigned char lds_raw[];
    Frame F;
    F.lds = (LAS unsigned char*)lds_raw;
    F.MISC = (volatile LAS unsigned*)(F.lds + MISC_OFF);
    F.tid = threadIdx.x; F.lane = F.tid & 63; F.wave = __builtin_amdgcn_readfirstlane(F.tid >> 6);
    F.G = gridDim.x; { const int bx = blockIdx.x; F.vcu = (F.G % 8 == 0) ? (bx % 8) * (F.G / 8) + bx / 8 : bx; }
    F.ws = args.ws; F.out = args.out;
#pragma unroll
    for (int i = 0; i < 19; ++i) F.in[i] = args.in[i];
    for (int u = F.tid; u < (LDS_BYTES - LDSCTL_OFF) / 4; u += NWAVES * 64) ((LAS unsigned*)(F.lds + LDSCTL_OFF))[u] = 0u;
    __syncthreads();
    XcdBarrier bar; bar.bar = (unsigned*)(F.ws + WS_CTL) + CW_BAR; bar.x = 0; bar.st = nullptr;
    if (N_LAUNCHES == 1) bar = xcd_barrier_post((unsigned*)(F.ws + WS_CTL) + CW_BAR, F.MISC + 8);
    const int lo = args.ph_lo, hi = args.ph_hi;
#define IN(k) (lo <= (k) && (k) < hi)
#if MK_PROBE_PH >= 0
    unsigned long long tp0 = (MK_PROBE_PH == 0 || MK_PROBE_PH == 9) ? __builtin_amdgcn_s_memrealtime() : 0ull, tp1 = 0ull;
#define SEAM(k) do { if (IN(k) && IN((k) + 1)) xcd_barrier(bar); if (MK_PROBE_PH == (k)) tp1 = __builtin_amdgcn_s_memrealtime(); if (MK_PROBE_PH == (k) + 1) tp0 = __builtin_amdgcn_s_memrealtime(); } while (0)
#else
#define SEAM(k) do { if (IN(k) && IN((k) + 1)) xcd_barrier(bar); } while (0)
#endif
    const size_t T2048 = (size_t)256 * 2048 * 2, T1024 = (size_t)256 * 1024 * 2, T512 = (size_t)256 * 512 * 2;
    float* cosT = WSP(float, WS_COS); float* sinT = WSP(float, WS_SIN);
    float* ssq_q = WSP(float, WS_SSQ_Q); float* ssq_kv = WSP(float, WS_SSQ_KV); float* ssq2 = WSP(float, WS_SSQ_2);

    if (IN(0)) { p0_prologue<0>(F, F.vcu, F.G); } SEAM(0);
    if (IN(1)) {
        SchedP1 S{F.G, (int)blockIdx.x, (const char*)(F.ws + WS_HN1), (const char*)(F.ws + WS_WIN), (const char*)(F.ws + WS_WVT), T1024};
        EpiP1 E{WSP(unsigned char, WS_NAQ), WSP(unsigned char, WS_NAK), WSP(unsigned char, WS_VT), WSP(unsigned char, WS_CQ), WSP(unsigned char, WS_CKV), WSP(unsigned char, WS_KR), WSP(unsigned char, WS_GA), WSP(unsigned char, WS_GB), ssq_q, ssq_kv, cosT, sinT};
        pg8::gemm_phase<EpiP1, SchedP1, true, -6>(F.lds, 2048, S, E);
        { const int extra = P1_UNITS % F.G, bx = (int)blockIdx.x; if (extra != 0 && bx >= extra) p0_prologue<1>(F, bx - extra, F.G - extra); else if (extra == 0) p0_prologue<1>(F, bx, F.G); }
    } SEAM(1);
    if (IN(2)) {
        LAS float* relb = (LAS float*)F.lds + 64; LAS float* metab = relb + 16 * 15 * 31 + 128; LAS float* wsf = metab + 256 + F.wave * 64;
        for (int i = F.tid; i < 16 * 15 * 31; i += NWAVES * 64) relb[i] = F.in[4][i];
        if (F.tid < 256) metab[F.tid] = F.in[5][F.tid];
        __syncthreads();
        const int gw = F.vcu * NWAVES + F.wave, NGW = F.G * NWAVES;
        Conv cv{F.in[16], F.in[17], WSP(unsigned char, WS_U), WSP(unsigned char, WS_V), F.lds + 65536 + F.wave * 8192, gw, NGW, 2 * 16384, -1, 0};
        for (int task = gw; task < NBATCH * 16 * 32 * 2; task += NGW)
            att::na_task(task, WSP(unsigned char, WS_NAQ), WSP(unsigned char, WS_NAK), WSP(unsigned char, WS_VT), WSP(unsigned char, WS_ONA), relb, metab, wsf, F.lane, cv);
        while (cv.pend >= 0 || cv.next < cv.end) conv_step<0>(cv, F.lane);
        __syncthreads();
    } SEAM(2);
    if (IN(3)) {
        SchedP3 S{F.G, (int)blockIdx.x, (const char*)F.ws, T512 / 2};
        EpiP3 E{WSP(unsigned char, WS_QM), WSP(unsigned char, WS_KN), WSP(unsigned char, WS_VV), ssq_q, ssq_kv, cosT, sinT};
        pg8::gemm_phase<EpiP3, SchedP3, true, -4>(F.lds, 512, S, E);
    } SEAM(3);
    if (IN(4)) {
        for (int id = F.vcu; id < NBATCH * 16 * 8; id += F.G) { const int bh = id >> 3, qb = id & 7;
            att::mla_unit8(bh >> 4, bh & 15, qb, WSP(unsigned char, WS_QM), WSP(unsigned char, WS_KN), WSP(unsigned char, WS_KR), WSP(unsigned char, WS_VV), WSP(unsigned char, WS_OMLA), (LAS char*)F.lds); }
        __syncthreads();
    } SEAM(4);
    if (IN(5)) {
        { SchedGrid S{F.G, (int)blockIdx.x, 64, 8, (const char*)(F.ws + WS_ONA), (const char*)(F.ws + WS_WNA), T512};
          EpiP5a E{WSP(unsigned char, WS_GA), WSP(unsigned char, WS_T1)};
          pg8::gemm_phase<EpiP5a, SchedGrid, true, -9>(F.lds, 1024, S, E); }
        { SchedGrid S{F.G, (int)blockIdx.x, 64, 8, (const char*)(F.ws + WS_OMLA), (const char*)(F.ws + WS_WMLA), T1024};
          EpiP5b E{WSP(unsigned char, WS_GB), WSP(unsigned char, WS_T1), WSP(unsigned char, WS_MERGED)};
          pg8::gemm_phase<EpiP5b, SchedGrid, true, -11>(F.lds, 2048, S, E); }
    } SEAM(5);
    if (IN(6)) {
        { SchedGrid S{F.G, (int)blockIdx.x, 64, 8, (const char*)(F.ws + WS_MERGED), (const char*)(F.ws + WS_WOUT), T1024};
          EpiP6 E{F.in[0], WSP(bf16_t, WS_H2B), ssq2};
          pg8::gemm_phase<EpiP6, SchedGrid, true, -11>(F.lds, 2048, S, E); }
    } SEAM(6);
    if (IN(7)) {
        SchedGrid S{F.G, (int)blockIdx.x, 64, 8, (const char*)(F.ws + WS_H2B), (const char*)(F.ws + WS_WSC), T2048};
        EpiP7 E{ssq2, WSP(_Float16, WS_SC)};
        pg8::gemm_phase<EpiP7, SchedGrid>(F.lds, 2048, S, E);
    } SEAM(7);
    if (IN(8)) {
        const int nch = (MREAL / peer::CH - F.vcu + F.G - 1) / F.G; const bool both_first = (nch == 2) && (F.vcu & 1);
        for (int op = 0; op < 2 * nch; ++op) {
            const bool sel = both_first ? (op < 2) : !(op & 1); const int ci = both_first ? (op & 1) : (op >> 1), chunk = F.vcu + ci * F.G;
            const int b2 = both_first ? ci : 0;
            LAS int* SE = (LAS int*)(F.lds + (b2 ? peer::OFF_SE2 : peer::OFF_SE)); LAS float* SG = (LAS float*)(F.lds + (b2 ? peer::OFF_SG2 : peer::OFF_SG));
            if (sel) peer::peer_select(chunk, WSP(_Float16, WS_SC), (LAS char*)F.lds, F.tid, SE, SG);
            else peer::peer_gather(chunk, WSP(bf16_t, WS_H2B), WSP(unsigned char, WS_U), WSP(unsigned char, WS_V), F.in[13], F.in[18], F.out, F.tid, SE, SG); }
    }
#if MK_PROBE_PH >= 0
    xcd_barrier(bar); tp1 = (MK_PROBE_PH >= 8) ? __builtin_amdgcn_s_memrealtime() : tp1;
    if (blockIdx.x == 0 && F.tid == 0) F.out[0] = (float)(tp1 - tp0) * (0.01f / MK_PROBE_DIV);
#endif
#undef IN
#undef SEAM
}

extern "C" void kernel_launch(void* const* d_in, const int* in_sizes, int n_in, void* d_out, int out_size, void* d_ws, size_t ws_size, hipStream_t stream) {
    static int grid = 0;
    if (grid == 0) {
        if (n_in != 19 || in_sizes[0] != MREAL * DM || out_size != MREAL * DM || ws_size < WS_END) {
            fprintf(stderr, "kernel_launch: shape/workspace mismatch: n_in %d in0 %d out %d ws %zu (need %zu); nothing launched\n", n_in, n_in > 0 ? in_sizes[0] : -1, out_size, ws_size, (size_t)WS_END); grid = -1; return; }
        int dev = 0, cus = 0, per_cu = 0;
        if (hipGetDevice(&dev) != hipSuccess || hipDeviceGetAttribute(&cus, hipDeviceAttributeMultiprocessorCount, dev) != hipSuccess) { fprintf(stderr, "kernel_launch: device query failed\n"); grid = -1; return; }
        if (hipFuncSetAttribute((const void*)hybrid_fwd, hipFuncAttributeMaxDynamicSharedMemorySize, LDS_BYTES) != hipSuccess) { fprintf(stderr, "kernel_launch: hipFuncSetAttribute failed\n"); grid = -1; return; }
        if (hipOccupancyMaxActiveBlocksPerMultiprocessor(&per_cu, (const void*)hybrid_fwd, NWAVES * 64, LDS_BYTES) != hipSuccess || per_cu < 1)
            fprintf(stderr, "kernel_launch: note: occupancy query reports %d workgroups per CU\n", per_cu);
        (void)hipGetLastError();
        grid = cus;
    }
    if (grid < 0) return;
    if (hipMemsetAsync((char*)d_ws + WS_CTL, 0, CTL_ZERO_BYTES, stream) != hipSuccess) { fprintf(stderr, "kernel_launch: hipMemsetAsync failed\n"); return; }
    Args a{};
    for (int i = 0; i < 19; ++i) a.in[i] = (const float*)d_in[i];
    a.out = (float*)d_out; a.ws = (unsigned char*)d_ws;
    for (int li = 0; li < N_LAUNCHES; ++li) {
        a.ph_lo = (N_LAUNCHES == 1) ? 0 : li; a.ph_hi = (N_LAUNCHES == 1) ? N_PHASES : li + 1;
        hipLaunchKernelGGL(hybrid_fwd, dim3(grid), dim3(NWAVES * 64), LDS_BYTES, stream, a);
        const hipError_t le = hipPeekAtLastError();
        if (le != hipSuccess) { fprintf(stderr, "kernel_launch: launch %d failed: %s\n", li, hipGetErrorName(le)); break; }
    }
}
```

```cpp
#include <hip/hip_runtime.h>
#include <cstdio>
#include <cstdint>

#define LAS __attribute__((address_space(3)))
#define GAS __attribute__((address_space(1)))
typedef unsigned short bf16_t;
typedef short bf16x8 __attribute__((ext_vector_type(8)));
typedef short s16x4 __attribute__((ext_vector_type(4)));
typedef float f32x4 __attribute__((ext_vector_type(4)));
typedef float f32x2 __attribute__((ext_vector_type(2)));
typedef float f32x16 __attribute__((ext_vector_type(16)));
typedef unsigned u32x4 __attribute__((ext_vector_type(4)));
typedef unsigned u32x2 __attribute__((ext_vector_type(2)));

constexpr int DM = 2048, NBATCH = 8, SEQ = 2048, NMETA = 16;
constexpr int MREAL = NBATCH * SEQ;
constexpr int MPAD = MREAL + 256;
constexpr int NPOS = SEQ + NMETA;
constexpr float NORM_EPS = 1e-6f;
constexpr int C_NAQ = 0, C_NAK = 1024, C_CQ = 2048, C_CKV = 2560, C_GA = 3072, C_GB = 5120, C_KR = 7168, NMAIN = 7424;
constexpr int VT_PITCH = MPAD;

constexpr size_t MiB = 1u << 20;
constexpr size_t WS_CTL = 0, CTL_ZERO_BYTES = 1 * MiB;
constexpr size_t WS_SSQ_Q = 481 * MiB, WS_SSQ_KV = 482 * MiB, WS_SSQ_2 = 486 * MiB;
constexpr size_t WS_COS = 1 * MiB, WS_SIN = 1 * MiB + 512 * 1024;
constexpr size_t WS_WUQ = 2 * MiB, WS_WUKV = 5 * MiB, WS_WNA = 9 * MiB, WS_WMLA = 13 * MiB, WS_WOUT = 21 * MiB, WS_WSC = 29 * MiB;
constexpr size_t WS_GA = 37 * MiB, WS_GB = 101 * MiB;
constexpr size_t WS_KR = 165 * MiB;
constexpr size_t WS_WIN = 167 * MiB + 256 * 1024, WS_WVT = WS_WIN + 29 * MiB;
constexpr size_t WS_ONA = 190 * MiB;
constexpr size_t WS_NAQ = 222 * MiB, WS_NAK = 254 * MiB, WS_VT = WS_NAK + 32 * MiB + 512 * 1024;
constexpr size_t WS_HN1 = 319 * MiB;
constexpr size_t WS_CQ = 448 * MiB, WS_CKV = 464 * MiB;
constexpr size_t WS_QM = 222 * MiB, WS_KN = 318 * MiB, WS_VV = 383 * MiB;
constexpr size_t WS_OMLA = 448 * MiB;
constexpr size_t WS_MERGED = 222 * MiB, WS_T1 = 286 * MiB;
constexpr size_t WS_H2 = 37 * MiB, WS_H2B = 293 * MiB;
constexpr size_t WS_U = 69 * MiB, WS_V = 133 * MiB;
constexpr size_t WS_SC = 165 * MiB;
constexpr size_t WS_END = 512 * MiB;
static_assert(WS_CKV + (size_t)MPAD * 512 * 2 <= WS_SSQ_Q && WS_SSQ_Q + (size_t)8 * MPAD * 4 <= WS_SSQ_KV && WS_SSQ_KV + (size_t)8 * MPAD * 4 <= 483 * MiB && WS_SSQ_2 + (size_t)32 * MREAL * 4 <= WS_END, "ssq slabs");
static_assert(WS_VT + (size_t)1024 * MPAD * 2 <= WS_HN1 && WS_HN1 + (size_t)MPAD * 2048 * 2 <= WS_CQ && WS_CKV + (size_t)MPAD * 512 * 2 <= WS_END, "map P1");
static_assert(WS_WVT + 4 * MiB <= WS_NAQ && WS_KR + (size_t)MPAD * 64 * 2 <= WS_WIN && WS_ONA + 32 * MiB <= WS_NAQ, "map P1b");
static_assert(WS_QM + 96 * MiB <= WS_KN && WS_KN + 65 * MiB <= WS_VV && WS_VV + 65 * MiB <= WS_OMLA && WS_OMLA + 64 * MiB <= WS_END, "map P3");
static_assert(WS_T1 + 128 * MiB <= WS_OMLA && WS_H2 + 128 * MiB <= WS_KR && WS_SC + 128 * MiB <= WS_H2B && WS_H2B + 64 * MiB <= WS_END, "map P5+");
static_assert(WS_GA + 32 * MiB <= WS_U && WS_U + 24 * MiB <= WS_GB && WS_GB + 32 * MiB <= WS_V && WS_V + 24 * MiB <= WS_KR, "expert tables between the gate codes");

constexpr int CW_BAR = 4096;
constexpr float PEER_U_SCALE = 90.50966799f, PEER_V_SCALE = 5.656854249f;

constexpr int RING_BYTES = 131072;
constexpr int LDSCTL_OFF = RING_BYTES, MISC_OFF = LDSCTL_OFF + 320;
constexpr int LDS_BYTES = 147456;
constexpr int NWAVES = 8;

#define LDS_WAIT() asm volatile("s_waitcnt lgkmcnt(0)" ::: "memory")
#define VM_WAIT() asm volatile("s_waitcnt vmcnt(0)" ::: "memory")
#define SBAR() __builtin_amdgcn_sched_barrier(0)
typedef __bf16 bf16x2_t __attribute__((ext_vector_type(2)));
__device__ __forceinline__ unsigned cvt_pk_bf16(float lo, float hi) { const f32x2 v = {lo, hi}; const bf16x2_t b = __builtin_convertvector(v, bf16x2_t); return __builtin_bit_cast(unsigned, b); }
__device__ __forceinline__ float bf_lo(unsigned w) { return __uint_as_float(w << 16); }
__device__ __forceinline__ float bf_hi(unsigned w) { return __uint_as_float(w & 0xffff0000u); }
__device__ __forceinline__ u32x4 pack8(const f32x4 a, const f32x4 b) { u32x4 w; w.x = cvt_pk_bf16(a[0], a[1]); w.y = cvt_pk_bf16(a[2], a[3]); w.z = cvt_pk_bf16(b[0], b[1]); w.w = cvt_pk_bf16(b[2], b[3]); return w; }
__device__ __forceinline__ u32x2 pack8_fp8(f32x4 a, f32x4 b) {
#pragma unroll
    for (int i = 0; i < 4; ++i) { a[i] = __builtin_fminf(__builtin_fmaxf(a[i], -448.f), 448.f); b[i] = __builtin_fminf(__builtin_fmaxf(b[i], -448.f), 448.f); }
    int w0 = 0, w1 = 0; w0 = __builtin_amdgcn_cvt_pk_fp8_f32(a[0], a[1], w0, false); w0 = __builtin_amdgcn_cvt_pk_fp8_f32(a[2], a[3], w0, true);
    w1 = __builtin_amdgcn_cvt_pk_fp8_f32(b[0], b[1], w1, false); w1 = __builtin_amdgcn_cvt_pk_fp8_f32(b[2], b[3], w1, true); return (u32x2){(unsigned)w0, (unsigned)w1}; }
__device__ __forceinline__ unsigned char f32_to_fp8(float x) { x = __builtin_fminf(__builtin_fmaxf(x, -448.f), 448.f); return (unsigned char)(__builtin_amdgcn_cvt_pk_fp8_f32(x, 0.f, 0, false) & 0xff); }
__device__ __forceinline__ u32x2 pack8_u8(const f32x4 a, const f32x4 b) { u32x2 w; unsigned x = 0u, y = 0u;
    x = __builtin_amdgcn_cvt_pk_u8_f32(a[0] * 255.f, 0u, x); x = __builtin_amdgcn_cvt_pk_u8_f32(a[1] * 255.f, 1u, x); x = __builtin_amdgcn_cvt_pk_u8_f32(a[2] * 255.f, 2u, x); x = __builtin_amdgcn_cvt_pk_u8_f32(a[3] * 255.f, 3u, x);
    y = __builtin_amdgcn_cvt_pk_u8_f32(b[0] * 255.f, 0u, y); y = __builtin_amdgcn_cvt_pk_u8_f32(b[1] * 255.f, 1u, y); y = __builtin_amdgcn_cvt_pk_u8_f32(b[2] * 255.f, 2u, y); y = __builtin_amdgcn_cvt_pk_u8_f32(b[3] * 255.f, 3u, y);
    w.x = x; w.y = y; return w; }
__device__ __forceinline__ unsigned pack4_fp8(f32x4 a) {
#pragma unroll
    for (int i = 0; i < 4; ++i) a[i] = __builtin_fminf(__builtin_fmaxf(a[i], -448.f), 448.f);
    int w0 = 0; w0 = __builtin_amdgcn_cvt_pk_fp8_f32(a[0], a[1], w0, false); w0 = __builtin_amdgcn_cvt_pk_fp8_f32(a[2], a[3], w0, true); return (unsigned)w0; }
__device__ __forceinline__ void unpack8_fp8(const u32x2 w, f32x4& a, f32x4& b) {
    const f32x2 a0 = __builtin_amdgcn_cvt_pk_f32_fp8((int)w.x, false), a1 = __builtin_amdgcn_cvt_pk_f32_fp8((int)w.x, true), b0 = __builtin_amdgcn_cvt_pk_f32_fp8((int)w.y, false), b1 = __builtin_amdgcn_cvt_pk_f32_fp8((int)w.y, true);
    a = (f32x4){a0[0], a0[1], a1[0], a1[1]}; b = (f32x4){b0[0], b0[1], b1[0], b1[1]}; }
__device__ __forceinline__ void unpack8_u8(const u32x2 w, f32x4& a, f32x4& b) { const float k = 1.f / 255.f;
    a = (f32x4){(float)(w.x & 0xffu), (float)((w.x >> 8) & 0xffu), (float)((w.x >> 16) & 0xffu), (float)(w.x >> 24)} * k;
    b = (f32x4){(float)(w.y & 0xffu), (float)((w.y >> 8) & 0xffu), (float)((w.y >> 16) & 0xffu), (float)(w.y >> 24)} * k; }
__device__ __forceinline__ u32x2 pack4(const f32x4 a) { u32x2 w; w.x = cvt_pk_bf16(a[0], a[1]); w.y = cvt_pk_bf16(a[2], a[3]); return w; }
__device__ __forceinline__ float wave_sum(float v) {
#pragma unroll
    for (int o = 1; o < 64; o <<= 1) v += __shfl_xor(v, o);
    return v;
}
__device__ __forceinline__ float sigmoidf_(float x) { return __builtin_amdgcn_rcpf(1.0f + __builtin_amdgcn_exp2f(-1.4426950408889634f * x)); }
__device__ __forceinline__ int crow(int r, int hi) { return (r & 3) + 8 * (r >> 2) + 4 * hi; }
#define PG8_AUX 0
namespace pg8 {
constexpr int BM = 256, BK = 64, HALF = 128, HTB = HALF * BK * 2  , STAGE_BYTES = 8 * HTB, NXCD = 8, WGM = 8;
__host__ __device__ __forceinline__ int lds_byte(int r, int c) { const int st = (r >> 4) * 2 + (c >> 5), rr = r & 15, cc = c & 31, ob = rr * 64 + cc * 2; return st * 1024 + (ob ^ (((ob >> 9) & 1) << 5)); }
__host__ __device__ __forceinline__ void stage_rc(int b, int& R, int& C) { const int st = b / 1024, sb = b % 1024, swz = sb ^ (((sb >> 9) & 1) << 5); R = (st >> 1) * 16 + swz / 64; C = (st & 1) * 32 + (swz % 64) / 2; }
__host__ __device__ __forceinline__ int perm32(int rho) { const int n = rho >> 4, i = rho & 15; return 8 * (i >> 2) + 4 * n + (i & 3); }

struct Unit { int pm, pn, kind; };

__device__ __forceinline__ void grid_order(int L, int nM, int nN, int& pm, int& pn) {
    const int nwg = nM * nN; int wgid = L;
    { const int q = nwg / NXCD, r = nwg % NXCD, xcd = wgid % NXCD, off = wgid / NXCD; wgid = (xcd < r ? xcd * (q + 1) : r * (q + 1) + (xcd - r) * q) + off; }
    const int nig = WGM * nN, gid = wgid / nig, fm = gid * WGM, gsz = (nM - fm) < WGM ? (nM - fm) : WGM;
    pm = fm + ((wgid % nig) % gsz); pn = (wgid % nig) / gsz;
}

typedef int v8i_t __attribute__((ext_vector_type(8)));
template <class Epi, class Sched, bool F8 = false, int F8_SCALE_EXP = 0>
__device__ __forceinline__ void gemm_phase(LAS unsigned char* lds, const int K, const Sched& S, const Epi& E) {
    const int tid = threadIdx.x, wid = __builtin_amdgcn_readfirstlane(tid >> 6), lane = tid & 63, wr = wid >> 2, wc = wid & 3, fr = lane & 15, fq = lane >> 4;
    int f8sa = 0x01010101 * (127 + F8_SCALE_EXP), f8sb = 0x7f7f7f7f; asm volatile("" : "+v"(f8sa), "+v"(f8sb));
    const int Kb = F8 ? K : 2 * K;
    const int nt = Kb / 128;
    unsigned voffA[2], voffB[2];
#pragma unroll
    for (int i = 0; i < 2; ++i) { int R, C; stage_rc(tid * 16 + i * 8192, R, C); const int Rb = Epi::PERM ? ((R & ~31) + perm32(R & 31)) : R;
        voffA[i] = (unsigned)(R * Kb + C * 2); voffB[i] = (unsigned)(Rb * Kb + C * 2); }
    const size_t kstep = (size_t)128;
    const size_t hstep = (size_t)HALF * Kb;
    const unsigned ldsw = (unsigned)wid * 1024u;
    const int aoff = lds_byte(wr * 64 + fr, F8 ? fq * 16 : fq * 8), boff = lds_byte(wc * 32 + fr, F8 ? fq * 16 : fq * 8);
#define PG8_SA(b, h) (((b) * 2 + (h)) * HTB)
#define PG8_SB(b, h) ((4 + (b) * 2 + (h)) * HTB)
#define PG8_STAGE(bufoff, gbase, voff) do { _Pragma("unroll") for (int _i = 0; _i < 2; ++_i) \
        __builtin_amdgcn_global_load_lds((const unsigned*)((const char*)(gbase) + (voff)[_i]), (LAS unsigned*)(lds + (bufoff) + ldsw + _i * 8192), 16, 0, PG8_AUX); } while (0)
#define PG8_LDA(dst, b, h) do { _Pragma("unroll") for (int m = 0; m < 4; ++m) _Pragma("unroll") for (int k = 0; k < 2; ++k) dst[m][k] = *(const LAS bf16x8*)(lds + PG8_SA(b, h) + aoff + m * 2048 + (F8 ? k * 16 : k * 1024)); } while (0)
#define PG8_LDB(dst, b, h) do { _Pragma("unroll") for (int n = 0; n < 2; ++n) _Pragma("unroll") for (int k = 0; k < 2; ++k) dst[n][k] = *(const LAS bf16x8*)(lds + PG8_SB(b, h) + boff + n * 2048 + (F8 ? k * 16 : k * 1024)); } while (0)
#define PG8_F8OP(X) __builtin_bit_cast(v8i_t, __builtin_shufflevector(X[0], X[1], 0, 1, 2, 3, 4, 5, 6, 7, 8, 9, 10, 11, 12, 13, 14, 15))
#define PG8_MMA(ai, bj, At, Bt) do { __builtin_amdgcn_s_setprio(1); \
        if constexpr (F8) { _Pragma("unroll") for (int m = 0; m < 4; ++m) _Pragma("unroll") for (int n = 0; n < 2; ++n) \
            asm volatile("v_mfma_scale_f32_16x16x128_f8f6f4 %0, %1, %2, %0, %3, %4 op_sel_hi:[0,0,0]" : "+v"(acc[ai][bj][m][n]) : "v"(PG8_F8OP(Bt[n])), "v"(PG8_F8OP(At[m])), "v"(f8sa), "v"(f8sb)); } \
        else { _Pragma("unroll") for (int m = 0; m < 4; ++m) _Pragma("unroll") for (int n = 0; n < 2; ++n) _Pragma("unroll") for (int k = 0; k < 2; ++k) \
            acc[ai][bj][m][n] = __builtin_amdgcn_mfma_f32_16x16x32_bf16(Bt[n][k], At[m][k], acc[ai][bj][m][n], 0, 0, 0); } \
        __builtin_amdgcn_s_setprio(0); } while (0)
#define PG8_WAIT_V(n) asm volatile("s_waitcnt vmcnt(" #n ")" ::: "memory")
#define PG8_WAIT_L(n) asm volatile("s_waitcnt lgkmcnt(" #n ")" ::: "memory")
#define PG8_BAR __builtin_amdgcn_s_barrier()
#define PG8_SCHED __builtin_amdgcn_sched_barrier(0)
    Unit cur, nxt; int ui = 0;
    if (!S.next(0, cur)) return;
    f32x4 acc[2][2][4][2];
#pragma unroll
    for (int a = 0; a < 2; ++a)
#pragma unroll
        for (int b = 0; b < 2; ++b)
#pragma unroll
            for (int m = 0; m < 4; ++m)
#pragma unroll
                for (int n = 0; n < 2; ++n) acc[a][b][m][n] = (f32x4){0.f, 0.f, 0.f, 0.f};
    bf16x8 At[4][2], B0[2][2], B1[2][2];
    const char* cA = S.pa(cur); const char* cB = S.pb(cur);
    PG8_STAGE(PG8_SB(0, 0), cB, voffB); PG8_STAGE(PG8_SB(0, 1), cB + hstep, voffB); PG8_STAGE(PG8_SA(0, 0), cA, voffA); PG8_STAGE(PG8_SA(0, 1), cA + hstep, voffA);
    if (wr == 1) PG8_BAR;
    PG8_WAIT_V(2); PG8_BAR;
    PG8_STAGE(PG8_SB(1, 0), cB + kstep, voffB); PG8_STAGE(PG8_SA(1, 0), cA + kstep, voffA); PG8_STAGE(PG8_SB(1, 1), cB + hstep + kstep, voffB);
    PG8_WAIT_V(6); PG8_BAR;
    for (;;) {
        const bool has_next = S.next(ui + 1, nxt);
        const char* nA = has_next ? S.pa(nxt) : cA; const char* nB = has_next ? S.pb(nxt) : cB;
        for (int t = 0; t < nt; t += 2) {
            const bool last = (t == nt - 2);
            const char* a1 = cA + (size_t)(t + 1) * kstep;
            const char* a2 = last ? nA : cA + (size_t)(t + 2) * kstep; const char* b2 = last ? nB : cB + (size_t)(t + 2) * kstep;
            const char* a3 = a2 + kstep; const char* b3 = b2 + kstep;
            PG8_LDB(B0, 0, 0); PG8_LDB(B1, 0, 1); PG8_SCHED; PG8_LDA(At, 0, 0); PG8_STAGE(PG8_SA(1, 1), a1 + hstep, voffA);
            PG8_WAIT_V(8); PG8_WAIT_L(0); PG8_BAR; PG8_MMA(0, 0, At, B0); PG8_MMA(0, 1, At, B1); PG8_BAR; PG8_SCHED;
            PG8_LDA(At, 0, 1); PG8_STAGE(PG8_SB(0, 0), b2, voffB); PG8_STAGE(PG8_SB(0, 1), b2 + hstep, voffB); PG8_STAGE(PG8_SA(0, 0), a2, voffA);
            PG8_WAIT_V(8); PG8_WAIT_L(0); PG8_BAR; PG8_MMA(1, 0, At, B0); PG8_MMA(1, 1, At, B1); PG8_BAR; PG8_SCHED;
            PG8_LDB(B0, 1, 0); PG8_LDB(B1, 1, 1); PG8_SCHED; PG8_LDA(At, 1, 0); PG8_STAGE(PG8_SA(0, 1), a2 + hstep, voffA);
            PG8_WAIT_V(8); PG8_WAIT_L(0); PG8_BAR; PG8_MMA(0, 0, At, B0); PG8_MMA(0, 1, At, B1); PG8_BAR; PG8_SCHED;
            PG8_LDA(At, 1, 1); PG8_STAGE(PG8_SB(1, 0), b3, voffB); PG8_STAGE(PG8_SB(1, 1), b3 + hstep, voffB); PG8_STAGE(PG8_SA(1, 0), a3, voffA);
            PG8_WAIT_V(8); PG8_WAIT_L(0); PG8_BAR; PG8_MMA(1, 0, At, B0); PG8_MMA(1, 1, At, B1); PG8_BAR; PG8_SCHED;
        }
        if (wr == 0) PG8_BAR;
        if constexpr (F8) asm volatile("s_nop 15\n\ts_nop 7" ::: "memory");
        if constexpr (Epi::HAS_PRE) {
            E.pre(cur, (LAS float*)(lds + STAGE_BYTES + 1024), tid); PG8_WAIT_L(0); PG8_BAR; }
        E(acc, cur, wr, wc, fr, fq, (const LAS float*)(lds + STAGE_BYTES + 1024));
        if (!has_next) break;
#pragma unroll
        for (int a = 0; a < 2; ++a)
#pragma unroll
            for (int b = 0; b < 2; ++b)
#pragma unroll
                for (int m = 0; m < 4; ++m)
#pragma unroll
                    for (int n = 0; n < 2; ++n) acc[a][b][m][n] = (f32x4){0.f, 0.f, 0.f, 0.f};
        cur = nxt; cA = nA; cB = nB; ++ui;
        if (wr == 1) PG8_BAR;
    }
    PG8_WAIT_V(0);
    PG8_BAR;
#undef PG8_SA
#undef PG8_SB
#undef PG8_STAGE
#undef PG8_LDA
#undef PG8_LDB
#undef PG8_MMA
#undef PG8_F8OP
#undef PG8_WAIT_V
#undef PG8_WAIT_L
#undef PG8_BAR
#undef PG8_SCHED
}
}
typedef GAS unsigned gu32;
#define RLX_AGENT __ATOMIC_RELAXED, __HIP_MEMORY_SCOPE_AGENT
#define XB_TMO      128
#define XB_XCNT(j)  (256  + 64 * (j))
#define XB_XSUB(j)  (1280 + 64 * (j))
#define XB_XGEN(j)  (2304 + 64 * (j))
#define XB_TOP      3328
#define XB_TOPGEN   3392
#define XCD_BAR_WORDS 3456
#define XB_SPIN_CAP (1u << 18)
__device__ __forceinline__ unsigned xb_ld(unsigned* p)              { return __hip_atomic_load(p, __ATOMIC_RELAXED, __HIP_MEMORY_SCOPE_AGENT); }
__device__ __forceinline__ unsigned xb_add(unsigned* p, unsigned v) { return __hip_atomic_fetch_add(p, v, __ATOMIC_RELAXED, __HIP_MEMORY_SCOPE_AGENT); }
__device__ __forceinline__ unsigned xb_xcc_id() { return (unsigned)__builtin_amdgcn_s_getreg((3 << 11) | 20) & 0xFu; }
#define XB_SPIN(cond, bar) do { unsigned _sp = 0; while (cond) { __builtin_amdgcn_s_sleep(1); \
    if ((++_sp & 255u) == 0u) { if (xb_ld(&(bar)[XB_TMO])) break; if (_sp > XB_SPIN_CAP) { atomicAdd(&(bar)[XB_TMO], 1u); break; } } } } while (0)
struct XcdBarrier { unsigned* bar; unsigned x; volatile LAS unsigned* st; };
__device__ __forceinline__ XcdBarrier xcd_barrier_post(unsigned* bar, volatile LAS unsigned* st) {
    XcdBarrier b; b.bar = bar; b.x = xb_xcc_id(); b.st = st;
    if (threadIdx.x == 0) (void)xb_add(&bar[XB_XCNT(b.x)], 1u);
    return b;
}
__device__ __forceinline__ void xcd_barrier_complete(unsigned* bar, unsigned x, unsigned& nloc, unsigned& nx) {
    const unsigned G = gridDim.x * gridDim.y * gridDim.z;
    unsigned sum, cnt, mine, sp = 0u;
    for (;;) {
        sum = 0u; cnt = 0u; mine = 0u;
#pragma unroll
        for (unsigned j = 0; j < 16; ++j) { const unsigned c = xb_ld(&bar[XB_XCNT(j)]); sum += c; cnt += (c > 0u) ? 1u : 0u; mine = (j == x) ? c : mine; }
        if (sum == G) break;
        __builtin_amdgcn_s_sleep(1);
        if ((++sp & 255u) == 0u) { if (xb_ld(&bar[XB_TMO])) break; if (sp > XB_SPIN_CAP) { atomicAdd(&bar[XB_TMO], 1u); break; } }
    }
    nloc = mine > 0u ? mine : 1u; nx = cnt > 0u ? cnt : 1u;
}
__device__ __forceinline__ void xcd_barrier(const XcdBarrier& b) {
    asm volatile("s_waitcnt vmcnt(0)" ::: "memory");
    __syncthreads();
    if (threadIdx.x == 0) {
        unsigned* bar = b.bar;
        __builtin_amdgcn_s_waitcnt(0);
        unsigned nloc = b.st[0], nx = b.st[1];
        if (nloc == 0u) { xcd_barrier_complete(bar, b.x, nloc, nx); b.st[0] = nloc; b.st[1] = nx; }
        const unsigned old = xb_add(&bar[XB_XSUB(b.x)], 1u);
        const unsigned gen = old / nloc;
        if (old + 1u == (gen + 1u) * nloc) {
            __builtin_amdgcn_fence(__ATOMIC_RELEASE, "agent");
            asm volatile("s_waitcnt vmcnt(0)" ::: "memory");
            const unsigned og = xb_add(&bar[XB_TOP], 1u);
            const unsigned tg = og / nx;
            if (og + 1u == (tg + 1u) * nx) xb_add(&bar[XB_TOPGEN], 1u);
            else XB_SPIN(xb_ld(&bar[XB_TOPGEN]) == tg, bar);
            __builtin_amdgcn_fence(__ATOMIC_ACQUIRE, "agent");
            xb_add(&bar[XB_XGEN(b.x)], 1u);
            asm volatile("s_waitcnt vmcnt(0)" ::: "memory");
        } else {
            XB_SPIN(xb_ld(&bar[XB_XGEN(b.x)]) == gen, bar);
            __builtin_amdgcn_fence(__ATOMIC_ACQUIRE, "agent");
            asm volatile("s_waitcnt vmcnt(0)" ::: "memory");
        }
    }
    __syncthreads();
}
struct Frame {
    LAS unsigned char* lds;
    volatile LAS unsigned* MISC;
    unsigned char* ws;
    int tid, lane, wave;
    int vcu, G;
    const float* in[19];
    float* out;
};
#define WSP(T, off) ((T*)(F.ws + (off)))

typedef float cv16f_t __attribute__((ext_vector_type(16)));
typedef unsigned cv6u_t __attribute__((ext_vector_type(6)));
struct Conv { const float* pu; const float* pv; unsigned char* u8; unsigned char* v8; LAS unsigned char* lbuf; int next, stride, end, pend, tick; };
__device__ __forceinline__ void conv_issue(const Conv& c, int item, int lane) {
    const float* src = ((item >> 14) ? c.pv : c.pu) + (size_t)(item & 16383) * 2048 + 4 * lane;
#pragma unroll
    for (int q = 0; q < 8; ++q) __builtin_amdgcn_global_load_lds((const unsigned*)(src + 256 * q), (LAS unsigned*)(c.lbuf + q * 1024), 16, 0, 0);
}
__device__ __forceinline__ void conv_finish(const Conv& c, int item, int lane) {
    const int isv = item >> 14, row = item & 16383; const float sc = isv ? PEER_V_SCALE : PEER_U_SCALE; unsigned w[4] = {0u, 0u, 0u, 0u};
#define CONV_Q(q) { const f32x4 x = *(const LAS f32x4*)(c.lbuf + (q) * 1024 + lane * 16) * sc; \
        w[(q) >> 1] = __builtin_amdgcn_cvt_scalef32_pk_fp4_f32(w[(q) >> 1], x[0], x[1], 1.0f, (2 * (q)) & 3); w[(q) >> 1] = __builtin_amdgcn_cvt_scalef32_pk_fp4_f32(w[(q) >> 1], x[2], x[3], 1.0f, (2 * (q) + 1) & 3); }
    CONV_Q(0) CONV_Q(1) CONV_Q(2) CONV_Q(3) CONV_Q(4) CONV_Q(5) CONV_Q(6) CONV_Q(7)
#undef CONV_Q
    unsigned char* rec = (isv ? c.v8 : c.u8) + (size_t)row * 1024;
    *(GAS u32x4*)(rec + lane * 16) = (u32x4){w[0], w[1], w[2], w[3]};
}
template <int YOUNGER>
__device__ __forceinline__ void conv_step(Conv& c, int lane) {
    if (c.pend >= 0) { if constexpr (YOUNGER == 0) asm volatile("s_waitcnt vmcnt(0)" ::: "memory"); else { static_assert(YOUNGER == 12, "wait count"); asm volatile("s_waitcnt vmcnt(12)" ::: "memory"); }
        conv_finish(c, c.pend, lane); c.pend = -1; asm volatile("s_waitcnt lgkmcnt(0)" ::: "memory"); }
    if (c.next < c.end) { conv_issue(c, c.next, lane); c.pend = c.next; c.next += c.stride; }
}
__device__ __forceinline__ void p0_transpose_item(const float* W, int K, int N, int k0, int n0, bf16_t* WT, int drow, bool rope, const float* gain, LAS float* scr, int lane) {
    { f32x4 v[8]; float gk[8];
#pragma unroll
      for (int i = 0; i < 8; ++i) { const int kk = 8 * i + (lane >> 3); v[i] = *(const GAS f32x4*)(W + (size_t)(k0 + kk) * N + n0 + 4 * (lane & 7)); gk[i] = gain ? gain[k0 + kk] : 1.f; }
#pragma unroll
      for (int i = 0; i < 8; ++i) { const int kk = 8 * i + (lane >> 3); LAS float* d = scr + kk * 33 + 4 * (lane & 7);
#pragma unroll
          for (int e = 0; e < 4; ++e) d[e] = v[i][e] * gk[i]; } }
    LDS_WAIT(); asm volatile("" ::: "memory");
    const int c = lane & 7;
#pragma unroll
    for (int j = 0; j < 4; ++j) { const int n = (lane >> 3) + 8 * j; const LAS float* s = scr + (8 * c) * 33 + n;
        u32x4 o; o.x = cvt_pk_bf16(s[0 * 33], s[1 * 33]); o.y = cvt_pk_bf16(s[2 * 33], s[3 * 33]); o.z = cvt_pk_bf16(s[4 * 33], s[5 * 33]); o.w = cvt_pk_bf16(s[6 * 33], s[7 * 33]);
        const int dr = drow + (rope ? (8 * (n >> 2) + (n & 3)) : n);
        *(GAS u32x4*)(WT + (size_t)dr * K + k0 + 8 * c) = o; }
    LDS_WAIT(); asm volatile("" ::: "memory");
}
__device__ __forceinline__ void p0_transpose_item8(const float* W, int K, int N, int k0, int n0, unsigned char* WT, int drow, bool rope, float scale, LAS float* scr, int lane, const float* gain = nullptr) {
    { f32x4 v[8]; float gk[8];
#pragma unroll
      for (int i = 0; i < 8; ++i) { const int kk = 8 * i + (lane >> 3); v[i] = *(const GAS f32x4*)(W + (size_t)(k0 + kk) * N + n0 + 4 * (lane & 7)); gk[i] = gain ? gain[k0 + kk] * scale : scale; }
#pragma unroll
      for (int i = 0; i < 8; ++i) { const int kk = 8 * i + (lane >> 3); LAS float* d = scr + kk * 33 + 4 * (lane & 7);
#pragma unroll
          for (int e = 0; e < 4; ++e) d[e] = v[i][e] * gk[i]; } }
    LDS_WAIT(); asm volatile("" ::: "memory");
#pragma unroll
    for (int j = 0; j < 2; ++j) { const int q = lane + 64 * j, n = q >> 2, c = q & 3; const LAS float* s = scr + (16 * c) * 33 + n; u32x4 o;
#pragma unroll
        for (int d = 0; d < 4; ++d) { int w = 0; w = __builtin_amdgcn_cvt_pk_fp8_f32(s[(4 * d) * 33], s[(4 * d + 1) * 33], w, false); w = __builtin_amdgcn_cvt_pk_fp8_f32(s[(4 * d + 2) * 33], s[(4 * d + 3) * 33], w, true); o[d] = (unsigned)w; }
        const int dr = drow + (rope ? (8 * (n >> 2) + (n & 3)) : n);
        *(GAS u32x4*)(WT + (size_t)dr * K + k0 + 16 * c) = o; }
    LDS_WAIT(); asm volatile("" ::: "memory");
}
__device__ __forceinline__ void rms_row_to_fp8(const float* xrow, const float* g, unsigned char* orow, int lane) {
    const GAS f32x4* xr = (const GAS f32x4*)xrow + lane; const GAS f32x4* gr = (const GAS f32x4*)g + lane;
    f32x4 v[8]; float s = 0.f;
#pragma unroll
    for (int j = 0; j < 8; ++j) { v[j] = xr[64 * j]; s += (v[j].x * v[j].x + v[j].y * v[j].y) + (v[j].z * v[j].z + v[j].w * v[j].w); }
    const float rstd = 1.0f / sqrtf(wave_sum(s) * (1.f / DM) + NORM_EPS);
    GAS unsigned* o4 = (GAS unsigned*)orow + lane;
#pragma unroll
    for (int j = 0; j < 8; ++j) { const f32x4 y = (v[j] * rstd) * gr[64 * j]; int w = 0; w = __builtin_amdgcn_cvt_pk_fp8_f32(y[0], y[1], w, false); w = __builtin_amdgcn_cvt_pk_fp8_f32(y[2], y[3], w, true); o4[64 * j] = (unsigned)w; }
}
__device__ __forceinline__ void rms_row_to_bf16(const float* xrow, const float* g, bf16_t* orow, int lane) {
    const GAS f32x4* xr = (const GAS f32x4*)xrow + lane; const GAS f32x4* gr = (const GAS f32x4*)g + lane;
    f32x4 v[8]; float s = 0.f;
#pragma unroll
    for (int j = 0; j < 8; ++j) { v[j] = xr[64 * j]; s += (v[j].x * v[j].x + v[j].y * v[j].y) + (v[j].z * v[j].z + v[j].w * v[j].w); }
    const float rstd = 1.0f / sqrtf(wave_sum(s) * (1.f / DM) + NORM_EPS);
    GAS u32x2* o8 = (GAS u32x2*)orow + lane;
#pragma unroll
    for (int j = 0; j < 8; ++j) { const f32x4 gg = gr[64 * j]; o8[64 * j] = pack4((v[j] * rstd) * gg); }
}
template <int PART>
__device__ __forceinline__ void p0_prologue(Frame& F, int rank, int nrank) {
    LAS float* scr = (LAS float*)(F.lds + F.wave * 16384);
    const int gw = rank * NWAVES + F.wave, NGW = nrank * NWAVES, lane = F.lane; const int gt = rank * 512 + F.tid, NGT = nrank * 512;
    unsigned char* WIN = WSP(unsigned char, WS_WIN); unsigned char* WVT = WSP(unsigned char, WS_WVT);
    constexpr int I_IN = 32 * 258, I_UQ = 8 * 96, I_UKV = 8 * 128, I_NA = 16 * 64, I_MLA = 32 * 64, I_OUT = 32 * 64;
    constexpr int NEARLY = I_IN + I_UQ + I_UKV, NITEMS = NEARLY + I_NA + I_MLA + I_OUT;
    for (int it = (PART == 0 ? 0 : NEARLY) + gw; it < (PART == 0 ? NEARLY : NITEMS); it += NGW) {
        int r = it;
        if (r < I_IN) { const int kb = r / 258, sb = r % 258, n0 = 32 * sb, k0 = 64 * kb; const float* W = F.in[3];
            unsigned char* dst = WIN; int drow; bool rope = false;
            if (n0 < 1024) drow = C_NAQ + n0;
            else if (n0 < 2048) drow = C_NAK + (n0 - 1024);
            else if (n0 < 3072) { dst = WVT; drow = n0 - 2048; }
            else if (n0 < 3584) drow = C_CQ + (n0 - 3072);
            else if (n0 < 4096) drow = C_CKV + (n0 - 3584);
            else if (n0 < 4160) { drow = C_KR + ((n0 - 4096) ? 4 : 0); rope = true; }
            else if (n0 < 6208) drow = C_GA + (n0 - 4160);
            else drow = C_GB + (n0 - 6208);
            p0_transpose_item8(W, 2048, 8256, k0, n0, dst, drow, rope, 64.f, scr, lane); continue; } r -= I_IN;
        if (r < I_UQ) { const int kb = r / 96, sb = r % 96, n0 = 32 * sb, k0 = 64 * kb; const int hd = n0 / 192, w = n0 % 192;
            int drow = n0; bool rope = false; if (w >= 128) { rope = true; drow = hd * 192 + 128 + ((w - 128) ? 4 : 0); }
            p0_transpose_item8(F.in[7], 512, 3072, k0, n0, WSP(unsigned char, WS_WUQ), drow, rope, 16.f, scr, lane, F.in[6]); continue; } r -= I_UQ;
        if (r < I_UKV) { const int kb = r / 128, sb = r % 128; const int n0 = 32 * sb, hd = n0 >> 8, w = n0 & 255;
            p0_transpose_item8(F.in[9], 512, 4096, 64 * kb, n0, WSP(unsigned char, WS_WUKV), (w >= 128 ? 2048 : 0) + hd * 128 + (w & 127), false, 16.f, scr, lane, F.in[8]); continue; } r -= I_UKV;
        if (r < I_NA) { const int kb = r / 64, sb = r % 64; p0_transpose_item8(F.in[10], 1024, 2048, 64 * kb, 32 * sb, WSP(unsigned char, WS_WNA), 32 * sb, false, 32.f, scr, lane); continue; } r -= I_NA;
        if (r < I_MLA) { const int kb = r / 64, sb = r % 64; p0_transpose_item8(F.in[11], 2048, 2048, 64 * kb, 32 * sb, WSP(unsigned char, WS_WMLA), 32 * sb, false, 64.f, scr, lane); continue; } r -= I_MLA;
        { const int kb = r / 64, sb = r % 64; p0_transpose_item8(F.in[12], 2048, 2048, 64 * kb, 32 * sb, WSP(unsigned char, WS_WOUT), 32 * sb, false, 64.f, scr, lane); }
    }
    if (PART == 0) { GAS u32x4* z = (GAS u32x4*)(WIN + (size_t)(C_KR + 64) * 2048); const int n16 = (NMAIN - C_KR - 64) * 2048 / 16;
      for (int i = gt; i < n16; i += NGT) z[i] = (u32x4){0u, 0u, 0u, 0u}; }
    if (PART == 0) { unsigned char* HN1 = WSP(unsigned char, WS_HN1);
#define P0_ROWSRC(m_) (((m_) < MREAL) ? F.in[0] + (size_t)(m_) * DM : F.in[1] + (size_t)((m_) - MREAL) * DM)
      { f32x4 v[8]; int m = gw;
        if (m < MREAL + NMETA) { const GAS f32x4* xr = (const GAS f32x4*)P0_ROWSRC(m) + lane;
#pragma unroll
            for (int j = 0; j < 8; ++j) v[j] = xr[64 * j]; }
        const GAS f32x4* gr = (const GAS f32x4*)F.in[2] + lane;
        while (m < MREAL + NMETA) { const int mn = m + NGW; f32x4 vn[8];
            { const int ml = mn < MREAL + NMETA ? mn : m; const GAS f32x4* xr = (const GAS f32x4*)P0_ROWSRC(ml) + lane;
#pragma unroll
              for (int j = 0; j < 8; ++j) vn[j] = xr[64 * j]; }
            float sq = 0.f;
#pragma unroll
            for (int j = 0; j < 8; ++j) sq += (v[j].x * v[j].x + v[j].y * v[j].y) + (v[j].z * v[j].z + v[j].w * v[j].w);
            const float rstd = 1.0f / sqrtf(wave_sum(sq) * (1.f / DM) + NORM_EPS);
            GAS unsigned* o4 = (GAS unsigned*)(HN1 + (size_t)m * DM) + lane;
#pragma unroll
            for (int j = 0; j < 8; ++j) { const f32x4 y = (v[j] * rstd) * gr[64 * j]; int w = 0; w = __builtin_amdgcn_cvt_pk_fp8_f32(y[0], y[1], w, false); w = __builtin_amdgcn_cvt_pk_fp8_f32(y[2], y[3], w, true); o4[64 * j] = (unsigned)w; }
#pragma unroll
            for (int j = 0; j < 8; ++j) v[j] = vn[j];
            m = mn; } }
#undef P0_ROWSRC
      GAS u32x4* z = (GAS u32x4*)(HN1 + (size_t)(MREAL + NMETA) * DM); const int n16 = (MPAD - MREAL - NMETA) * DM / 16;
      for (int i = gt; i < n16; i += NGT) z[i] = (u32x4){0u, 0u, 0u, 0u}; }
    if (PART == 0) { float* ct = WSP(float, WS_COS); float* st = WSP(float, WS_SIN);
      for (int i = gt; i < NPOS * 32; i += NGT) { const int p = i >> 5, j = i & 31;
          const float inv = __builtin_powf(10000.0f, -(float)(2 * j) / 64.0f); const float ang = (float)p * inv;
          double r = (double)ang * 0.15915494309189535; r -= __builtin_rint(r); const float rf = (float)r;
          ct[i] = __builtin_amdgcn_cosf(rf); st[i] = __builtin_amdgcn_sinf(rf); } }
    if (PART == 1) { const float* SK = F.in[15]; const float* WQ = F.in[14]; const float* g2 = F.in[13]; bf16_t* WSCp = WSP(bf16_t, WS_WSC);
      const int l15 = lane & 15, l4 = lane >> 4;
      for (int task = gw; task < 2048; task += NGW) { const int g = task >> 7, nt = (task >> 4) & 7, kc = task & 15, n0 = nt * 16;
          bf16x8 bfr[4];
#pragma unroll
          for (int kk = 0; kk < 4; ++kk) { const float* p = SK + ((size_t)g * 128 + n0 + l15) * 128 + 32 * kk + 8 * l4; const f32x4 a = *(const GAS f32x4*)p, b = *(const GAS f32x4*)(p + 4);
              const u32x4 w = pack8(a, b); bfr[kk] = __builtin_bit_cast(bf16x8, w); }
          for (int kt = 0; kt < 8; ++kt) { const int k0 = (kc * 8 + kt) * 16; f32x4 acc = (f32x4){0.f, 0.f, 0.f, 0.f};
#pragma unroll
              for (int kk = 0; kk < 4; ++kk) { const float* p = WQ + (size_t)(k0 + l15) * 2048 + g * 128 + 32 * kk + 8 * l4; const f32x4 a = *(const GAS f32x4*)p, b = *(const GAS f32x4*)(p + 4);
                  const u32x4 w = pack8(a, b); acc = __builtin_amdgcn_mfma_f32_16x16x32_bf16(__builtin_bit_cast(bf16x8, w), bfr[kk], acc, 0, 0, 0); }
              const f32x4 gg = *(const GAS f32x4*)(g2 + k0 + 4 * l4);
              *(GAS u32x2*)(WSCp + (size_t)(g * 128 + n0 + l15) * 2048 + k0 + 4 * l4) = pack4(acc * gg); } } }
}
using pg8::Unit;
struct SchedGrid {
    int G, c, nM, nN; const char* A; const char* B; size_t tstep;
    __device__ __forceinline__ bool next(int i, Unit& u) const { const int L = i * G + c; if (L >= nM * nN) return false; pg8::grid_order(L, nM, nN, u.pm, u.pn); u.kind = 0; return true; }
    __device__ __forceinline__ const char* pa(const Unit& u) const { return A + (size_t)u.pm * tstep; }
    __device__ __forceinline__ const char* pb(const Unit& u) const { return B + (size_t)u.pn * tstep; }
};
constexpr int P1_MAIN = 64 * 29, P1_VT = 4 * 65, P1_META = 7, P1_UNITS = P1_MAIN + P1_VT + P1_META;
struct SchedP1 {
    int G, c; const char* hn1; const char* win; const char* wvt; size_t tstep;
    __device__ __forceinline__ bool next(int i, Unit& u) const {
        const int L = i * G + c; if (L >= P1_UNITS) return false;
        if (L < P1_MAIN) { pg8::grid_order(L, 64, 29, u.pm, u.pn); u.kind = 0; }
        else if (L < P1_MAIN + P1_VT) { const int idx = L - P1_MAIN; u.pm = idx & 3; u.pn = idx >> 2; u.kind = 1; }
        else { const int idx = L - P1_MAIN - P1_VT; u.pm = 64; u.pn = idx < 4 ? 4 + idx : (idx < 6 ? 10 + (idx - 4) : 28); u.kind = 0; }
        return true; }
    __device__ __forceinline__ const char* pa(const Unit& u) const { return (u.kind == 1 ? wvt : hn1) + (size_t)u.pm * tstep; }
    __device__ __forceinline__ const char* pb(const Unit& u) const { return (u.kind == 1 ? hn1 : win) + (size_t)u.pn * tstep; }
};
__device__ __forceinline__ void rope4(const f32x4 x1, const f32x4 x2, const float* cosT, const float* sinT, int pos, int j0, f32x4& lo, f32x4& hi) {
    const f32x4 c = *(const GAS f32x4*)(cosT + pos * 32 + j0), s = *(const GAS f32x4*)(sinT + pos * 32 + j0);
    lo = x1 * c - x2 * s; hi = x2 * c + x1 * s;
}
struct EpiP1 {
    static constexpr bool PERM = true, HAS_PRE = false;
    unsigned char *naq, *nak, *vt; unsigned char *cq, *ckv; unsigned char *kr; unsigned char *ga, *gb; float *ssq_q, *ssq_kv; const float *cosT, *sinT;
    __device__ __forceinline__ void operator()(const f32x4 (&acc)[2][2][4][2], const Unit& u, int wr, int wc, int fr, int fq, const LAS float* rowsc) const {
        const int row0 = u.pm * 256 + wr * 64 + fr, colu = wc * 32 + 8 * fq;
        if (u.kind == 1) {
#pragma unroll
            for (int bj = 0; bj < 2; ++bj) { const int t0 = u.pn * 256 + bj * 128 + colu, pos = (t0 & ~63) + ((t0 & 63) >> 1);
#pragma unroll
                for (int ai = 0; ai < 2; ++ai)
#pragma unroll
                    for (int m = 0; m < 4; ++m) { unsigned char* rp = vt + (size_t)(row0 + ai * 128 + m * 16) * VT_PITCH + pos;
                        *(GAS unsigned*)rp = pack4_fp8(acc[ai][bj][m][0]); *(GAS unsigned*)(rp + 32) = pack4_fp8(acc[ai][bj][m][1]); } }
            return; }
        const int pn = u.pn;
        if (pn == 28) {
            if (wc < 2) { const int j0 = 4 * (4 * wc + fq);
#pragma unroll
                for (int ai = 0; ai < 2; ++ai)
#pragma unroll
                    for (int m = 0; m < 4; ++m) { const int row = row0 + ai * 128 + m * 16; const int pos = row < MREAL ? NMETA + (row & (SEQ - 1)) : row - MREAL;
                        f32x4 lo, hi; rope4(acc[ai][0][m][0], acc[ai][0][m][1], cosT, sinT, pos, j0, lo, hi);
                        *(GAS unsigned*)(kr + (size_t)row * 64 + j0) = pack4_fp8(lo); *(GAS unsigned*)(kr + (size_t)row * 64 + 32 + j0) = pack4_fp8(hi); } }
            return; }
        if (pn >= 12) {
            unsigned char* base = pn < 20 ? ga : gb; const int colt = (pn < 20 ? pn - 12 : pn - 20) * 256 + colu;
#pragma unroll
            for (int ai = 0; ai < 2; ++ai)
#pragma unroll
                for (int m = 0; m < 4; ++m) { unsigned char* rp = base + (size_t)(row0 + ai * 128 + m * 16) * 2048 + colt;
#pragma unroll
                    for (int bj = 0; bj < 2; ++bj) { f32x4 a = acc[ai][bj][m][0], b = acc[ai][bj][m][1];
#pragma unroll
                        for (int i = 0; i < 4; ++i) { a[i] = sigmoidf_(a[i]); b[i] = sigmoidf_(b[i]); }
                        *(GAS u32x2*)(rp + bj * 128) = pack8_u8(a, b); } }
            return; }
        if (pn >= 8) {
            const bool isq = pn < 10; unsigned char* base = isq ? cq : ckv; float* ssq = isq ? ssq_q : ssq_kv; const int colt = (isq ? pn - 8 : pn - 10) * 256 + colu;
#pragma unroll
            for (int ai = 0; ai < 2; ++ai)
#pragma unroll
                for (int m = 0; m < 4; ++m) { const int row = row0 + ai * 128 + m * 16; unsigned char* rp = base + (size_t)row * 512 + colt; float s = 0.f;
#pragma unroll
                    for (int bj = 0; bj < 2; ++bj) { const f32x4 a = acc[ai][bj][m][0], b = acc[ai][bj][m][1];
                        s += (a[0] * a[0] + a[1] * a[1]) + (a[2] * a[2] + a[3] * a[3]) + (b[0] * b[0] + b[1] * b[1]) + (b[2] * b[2] + b[3] * b[3]);
                        *(GAS u32x2*)(rp + bj * 128) = pack8_fp8(a, b); }
                    s += __shfl_xor(s, 16); s += __shfl_xor(s, 32);
                    if (fq == 0) ssq[(size_t)((pn & 1) * 4 + wc) * MPAD + row] = s; }
            return; }
        {
            unsigned char* base = pn < 4 ? naq : nak; const int colt = (pn & 3) * 256 + colu;
#pragma unroll
            for (int ai = 0; ai < 2; ++ai)
#pragma unroll
                for (int m = 0; m < 4; ++m) { unsigned char* rp = base + (size_t)(row0 + ai * 128 + m * 16) * 1024 + colt;
#pragma unroll
                    for (int bj = 0; bj < 2; ++bj) *(GAS u32x2*)(rp + bj * 128) = pack8_fp8(acc[ai][bj][m][0], acc[ai][bj][m][1]); }
        }
    }
};
constexpr int P3_Q = 64 * 12, P3_K = 65 * 8, P3_V = 8 * 65, P3_UNITS = P3_Q + P3_K + P3_V;
struct SchedP3 {
    int G, c; const char* ws; size_t tstep;
    __device__ __forceinline__ bool next(int i, Unit& u) const {
        const int L = i * G + c; if (L >= P3_UNITS) return false;
        if (L < P3_Q) { pg8::grid_order(L, 64, 12, u.pm, u.pn); u.kind = 0; }
        else if (L < P3_Q + P3_K) { pg8::grid_order(L - P3_Q, 65, 8, u.pm, u.pn); u.kind = 1; }
        else { const int idx = L - P3_Q - P3_K; u.pm = idx & 7; u.pn = idx >> 3; u.kind = 2; }
        return true; }
    __device__ __forceinline__ const char* pa(const Unit& u) const { const size_t o = u.kind == 0 ? WS_CQ : (u.kind == 1 ? WS_CKV : WS_WUKV + (size_t)2048 * 512); return ws + o + (size_t)u.pm * tstep; }
    __device__ __forceinline__ const char* pb(const Unit& u) const { const size_t o = u.kind == 0 ? WS_WUQ : (u.kind == 1 ? WS_WUKV : WS_CKV); return ws + o + (size_t)u.pn * tstep; }
};
template <int NS, int LD> __device__ __forceinline__ float rstd_slabs(const float* part, int row, float invn) {
    float s = 0.f;
#pragma unroll
    for (int i = 0; i < NS; ++i) s += part[(size_t)i * LD + row];
    return 1.0f / sqrtf(s * invn + NORM_EPS);
}
struct EpiP3 {
    static constexpr bool PERM = true, HAS_PRE = true;
    unsigned char *qm, *kn, *vt; const float *ssq_q, *ssq_kv; const float *cosT, *sinT;
    __device__ __forceinline__ void pre(const Unit& u, LAS float* sc, int tid) const { if (tid < 256) { const int row = (u.kind == 2 ? u.pn : u.pm) * 256 + tid; sc[tid] = u.kind ? rstd_slabs<8, MPAD>(ssq_kv, row, 1.f / 512.f) : rstd_slabs<8, MPAD>(ssq_q, row, 1.f / 512.f); } }
    __device__ __forceinline__ void operator()(const f32x4 (&acc)[2][2][4][2], const Unit& u, int wr, int wc, int fr, int fq, const LAS float* rowsc) const {
        const int row0 = u.pm * 256 + wr * 64 + fr, colu = wc * 32 + 8 * fq;
        if (u.kind == 2) {
#pragma unroll
            for (int bj = 0; bj < 2; ++bj) { const int cl = bj * 128 + colu, t0 = u.pn * 256 + cl;
                const f32x4 s0 = *(const LAS f32x4*)(rowsc + cl), s1 = *(const LAS f32x4*)(rowsc + cl + 4);
                const int g = (t0 >> 3) & 7, pos = (t0 & ~63) + 16 * (g >> 2) + 4 * (g & 3);
#pragma unroll
                for (int ai = 0; ai < 2; ++ai)
#pragma unroll
                    for (int m = 0; m < 4; ++m) { unsigned char* rp = vt + (size_t)(row0 + ai * 128 + m * 16) * MPAD + pos;
                        *(GAS unsigned*)rp = pack4_fp8(acc[ai][bj][m][0] * s0); *(GAS unsigned*)(rp + 32) = pack4_fp8(acc[ai][bj][m][1] * s1); } }
            return; }
        if (u.kind == 1) {
#pragma unroll
            for (int ai = 0; ai < 2; ++ai)
#pragma unroll
                for (int m = 0; m < 4; ++m) { const int row = row0 + ai * 128 + m * 16; const float rs = rowsc[ai * 128 + wr * 64 + m * 16 + fr];
                    unsigned char* rp = kn + (size_t)row * 2048 + u.pn * 256 + colu;
#pragma unroll
                    for (int bj = 0; bj < 2; ++bj) *(GAS u32x2*)(rp + bj * 128) = pack8_fp8(acc[ai][bj][m][0] * rs, acc[ai][bj][m][1] * rs); }
            return; }
#pragma unroll
        for (int bj = 0; bj < 2; ++bj) { const int c8 = u.pn * 256 + bj * 128 + colu; const int hd = c8 / 192, w = c8 - hd * 192;
            if (w < 128) {
#pragma unroll
                for (int ai = 0; ai < 2; ++ai)
#pragma unroll
                    for (int m = 0; m < 4; ++m) { const int row = row0 + ai * 128 + m * 16; const float rs = rowsc[ai * 128 + wr * 64 + m * 16 + fr];
                        *(GAS u32x2*)(qm + (size_t)row * 3072 + c8) = pack8_fp8(acc[ai][bj][m][0] * rs, acc[ai][bj][m][1] * rs); }
            } else { const int j0 = (w - 128) >> 1;
#pragma unroll
                for (int ai = 0; ai < 2; ++ai)
#pragma unroll
                    for (int m = 0; m < 4; ++m) { const int row = row0 + ai * 128 + m * 16; const float rs = rowsc[ai * 128 + wr * 64 + m * 16 + fr];
                        const int pos = NMETA + (row & (SEQ - 1)); f32x4 lo, hi; rope4(acc[ai][bj][m][0] * rs, acc[ai][bj][m][1] * rs, cosT, sinT, pos, j0, lo, hi);
                        unsigned char* qp = qm + (size_t)row * 3072 + hd * 192 + 128 + j0; *(GAS unsigned*)qp = pack4_fp8(lo); *(GAS unsigned*)(qp + 32) = pack4_fp8(hi); }
            } }
    }
};

__device__ __forceinline__ void unpack8(const u32x4 w, f32x4& a, f32x4& b) { a = (f32x4){bf_lo(w.x), bf_hi(w.x), bf_lo(w.y), bf_hi(w.y)}; b = (f32x4){bf_lo(w.z), bf_hi(w.z), bf_lo(w.w), bf_hi(w.w)}; }
struct EpiP5a {
    static constexpr bool PERM = true, HAS_PRE = false;
    const unsigned char* ga; unsigned char* t1;
    __device__ __forceinline__ void operator()(const f32x4 (&acc)[2][2][4][2], const Unit& u, int wr, int wc, int fr, int fq, const LAS float* rowsc) const {
        const int row0 = u.pm * 256 + wr * 64 + fr, col0 = u.pn * 256 + wc * 32 + 8 * fq;
#pragma unroll
        for (int ai = 0; ai < 2; ++ai)
#pragma unroll
            for (int m = 0; m < 4; ++m) { const size_t off = (size_t)(row0 + ai * 128 + m * 16) * 2048 + col0;
#pragma unroll
                for (int bj = 0; bj < 2; ++bj) { f32x4 g0, g1; unpack8_u8(*(const GAS u32x2*)(ga + off + bj * 128), g0, g1);
                    *(GAS u32x2*)(t1 + off + bj * 128) = pack8_fp8(acc[ai][bj][m][0] * g0 * 32.f, acc[ai][bj][m][1] * g1 * 32.f); } }
    }
};
struct EpiP5b {
    static constexpr bool PERM = true, HAS_PRE = false;
    const unsigned char* gb; const unsigned char* t1; unsigned char* merged;
    __device__ __forceinline__ void operator()(const f32x4 (&acc)[2][2][4][2], const Unit& u, int wr, int wc, int fr, int fq, const LAS float* rowsc) const {
        const int row0 = u.pm * 256 + wr * 64 + fr, col0 = u.pn * 256 + wc * 32 + 8 * fq;
#pragma unroll
        for (int ai = 0; ai < 2; ++ai)
#pragma unroll
            for (int m = 0; m < 4; ++m) { const size_t off = (size_t)(row0 + ai * 128 + m * 16) * 2048 + col0;
#pragma unroll
                for (int bj = 0; bj < 2; ++bj) { f32x4 g0, g1; unpack8_u8(*(const GAS u32x2*)(gb + off + bj * 128), g0, g1);
                    f32x4 a, b; unpack8_fp8(*(const GAS u32x2*)(t1 + off + bj * 128), a, b);
                    *(GAS u32x2*)(merged + off + bj * 128) = pack8_fp8(a + acc[ai][bj][m][0] * g0 * 32.f, b + acc[ai][bj][m][1] * g1 * 32.f); } }
    }
};
struct EpiP6 {
    static constexpr bool PERM = true, HAS_PRE = false;
    const float* x; bf16_t* h2b; float* ssq2;
    __device__ __forceinline__ void operator()(const f32x4 (&acc)[2][2][4][2], const Unit& u, int wr, int wc, int fr, int fq, const LAS float* rowsc) const {
        const int row0 = u.pm * 256 + wr * 64 + fr, col0 = u.pn * 256 + wc * 32 + 8 * fq;
#pragma unroll
        for (int ai = 0; ai < 2; ++ai)
#pragma unroll
            for (int m = 0; m < 4; ++m) { const int row = row0 + ai * 128 + m * 16; const size_t off = (size_t)row * 2048 + col0; float s = 0.f;
#pragma unroll
                for (int bj = 0; bj < 2; ++bj) { const f32x4 a = *(const GAS f32x4*)(x + off + bj * 128) + acc[ai][bj][m][0], b = *(const GAS f32x4*)(x + off + bj * 128 + 4) + acc[ai][bj][m][1];
                    s += (a[0] * a[0] + a[1] * a[1]) + (a[2] * a[2] + a[3] * a[3]) + (b[0] * b[0] + b[1] * b[1]) + (b[2] * b[2] + b[3] * b[3]);
                    *(GAS u32x4*)(h2b + off + bj * 128) = pack8(a, b); }
                s += __shfl_xor(s, 16); s += __shfl_xor(s, 32);
                if (fq == 0) ssq2[(size_t)(u.pn * 4 + wc) * MREAL + row] = s; }
    }
};
struct EpiP7 {
    static constexpr bool PERM = true, HAS_PRE = true;
    const float* ssq2; _Float16* sc;
    __device__ __forceinline__ void pre(const Unit& u, LAS float* sc, int tid) const { if (tid < 256) sc[tid] = rstd_slabs<32, MREAL>(ssq2, u.pm * 256 + tid, 1.f / 2048.f); }
    __device__ __forceinline__ void operator()(const f32x4 (&acc)[2][2][4][2], const Unit& u, int wr, int wc, int fr, int fq, const LAS float* rowsc) const {
        typedef _Float16 h4_t __attribute__((ext_vector_type(4)));
        const int row0 = u.pm * 256 + wr * 64 + fr, col0 = u.pn * 256 + wc * 32 + 8 * fq;
#pragma unroll
        for (int ai = 0; ai < 2; ++ai)
#pragma unroll
            for (int m = 0; m < 4; ++m) { const int row = row0 + ai * 128 + m * 16; const float rs = rowsc[ai * 128 + wr * 64 + m * 16 + fr]; const size_t off = (size_t)row * 2048 + col0;
#pragma unroll
                for (int bj = 0; bj < 2; ++bj) { const h4_t lo = __builtin_convertvector(acc[ai][bj][m][0] * rs, h4_t), hi = __builtin_convertvector(acc[ai][bj][m][1] * rs, h4_t);
                    const u32x2 wl = __builtin_bit_cast(u32x2, lo), wh = __builtin_bit_cast(u32x2, hi);
                    *(GAS u32x4*)(sc + off + bj * 128) = (u32x4){wl.x, wl.y, wh.x, wh.y}; } }
    }
};
namespace att {
#define KSWZ(row, colB) ((row) * 256 + ((colB) ^ (((row) & 7) << 4)))
#define KRSWZ(row, colB) ((row) * 128 + ((colB) ^ ((((row) >> 1) & 7) << 4)))
constexpr float L2E = 1.4426950408889634f;
template <int DUMMY = 0>
__device__ __forceinline__ void partialSM(f32x16& p0, f32x16& p1, float& m_reg, float& mn, float& alpha, const float C, const float THRS) {
  float pmax = p0[0];
#pragma unroll
  for (int r = 1; r < 16; ++r) pmax = fmaxf(pmax, p0[r]);
#pragma unroll
  for (int r = 0; r < 16; ++r) pmax = fmaxf(pmax, p1[r]);
  { auto rr = __builtin_amdgcn_permlane32_swap(__float_as_uint(pmax), __float_as_uint(pmax), false, false);
    pmax = fmaxf(__uint_as_float(rr[0]), __uint_as_float(rr[1])); }
  if (__builtin_expect(__all(pmax - m_reg <= THRS), 1)) { mn = m_reg; alpha = 1.f; }
  else { mn = fmaxf(m_reg, pmax); alpha = __builtin_amdgcn_exp2f((m_reg - mn) * C); m_reg = mn; }
  const float mnC = -mn * C;
#pragma unroll
  for (int r = 0; r < 16; ++r) p0[r] = fmaf(p0[r], C, mnC);
#pragma unroll
  for (int r = 0; r < 16; ++r) p1[r] = fmaf(p1[r], C, mnC);
#pragma unroll
  for (int r = 0; r < 16; ++r) p0[r] = __builtin_amdgcn_exp2f(p0[r]);
}
__device__ __forceinline__ void finishSM(f32x16& p0, f32x16& p1, float alpha, float& l_reg, bf16x8& pa0, bf16x8& pa1, bf16x8& pa2, bf16x8& pa3) {
#pragma unroll
  for (int r = 0; r < 16; ++r) p1[r] = __builtin_amdgcn_exp2f(p1[r]);
  float ps = 0;
#pragma unroll
  for (int r = 0; r < 16; ++r) ps += p0[r];
#pragma unroll
  for (int r = 0; r < 16; ++r) ps += p1[r];
  { auto rr = __builtin_amdgcn_permlane32_swap(__float_as_uint(ps), __float_as_uint(ps), false, false);
    ps = __uint_as_float(rr[0]) + __uint_as_float(rr[1]); }
  l_reg = l_reg * alpha + ps;
#define PK4(P, BASE, OUT) do { unsigned a0 = cvt_pk_bf16(P[BASE + 0], P[BASE + 1]), a1 = cvt_pk_bf16(P[BASE + 2], P[BASE + 3]);   \
    unsigned b0 = cvt_pk_bf16(P[BASE + 4], P[BASE + 5]), b1 = cvt_pk_bf16(P[BASE + 6], P[BASE + 7]);                              \
    auto r0 = __builtin_amdgcn_permlane32_swap(a0, b0, false, false); auto r1 = __builtin_amdgcn_permlane32_swap(a1, b1, false, false); \
    u32x4 w = {r0[0], r1[0], r0[1], r1[1]}; OUT = __builtin_bit_cast(bf16x8, w); } while (0)
  PK4(p0, 0, pa0); PK4(p0, 8, pa1); PK4(p1, 0, pa2); PK4(p1, 8, pa3);
#undef PK4
}
constexpr int NW = 8, QBLK = 32, KVBLK = 64;
constexpr float MLA_SCALE = 0.07216878364870322f;
constexpr float MLA_THR = 8.f;
constexpr int SHM_V = KVBLK * 128 * 2, SHM_KN = KVBLK * 128 * 2, SHM_KR = KVBLK * 64 * 2;
constexpr int OFF_V = 0, OFF_KN = 2 * SHM_V, OFF_KR = OFF_KN + 2 * SHM_KN, OFF_WS = OFF_KR + 2 * SHM_KR, OFF_QR = OFF_WS + NW * 64 * 4, MLA_LDS = OFF_QR + NW * 4096;
__device__ __forceinline__ void qkt(f32x16& p0, f32x16& p1, const LAS char* Kn, const LAS char* Kr, const bf16x8* qr, const LAS char* qrp, const int* kb, const int* krb) {
  p0 = f32x16{}; p1 = f32x16{};
#pragma unroll
  for (int d0 = 0; d0 < 8; ++d0) {
    const bf16x8 b0 = *(const LAS bf16x8*)(Kn + kb[d0 & 3] + (d0 >> 2) * 128);
    const bf16x8 b1 = *(const LAS bf16x8*)(Kn + kb[d0 & 3] + (d0 >> 2) * 128 + 8192);
    p0 = __builtin_amdgcn_mfma_f32_32x32x16_bf16(b0, qr[d0], p0, 0, 0, 0);
    p1 = __builtin_amdgcn_mfma_f32_32x32x16_bf16(b1, qr[d0], p1, 0, 0, 0); }
#pragma unroll
  for (int d0 = 0; d0 < 4; ++d0) {
    const bf16x8 b0 = *(const LAS bf16x8*)(Kr + krb[d0]);
    const bf16x8 b1 = *(const LAS bf16x8*)(Kr + krb[d0] + 4096);
    const bf16x8 qf = *(const LAS bf16x8*)(qrp + d0 * 1024);
    p0 = __builtin_amdgcn_mfma_f32_32x32x16_bf16(b0, qf, p0, 0, 0, 0);
    p1 = __builtin_amdgcn_mfma_f32_32x32x16_bf16(b1, qf, p1, 0, 0, 0); }
}
__device__ __forceinline__ int v_st(int k, int c) { const int kk = (k & ~0xC) | ((k & 4) << 1) | ((k & 8) >> 1); return ((kk >> 3) * 4 + (c >> 5)) * 512 + ((kk & 7) * 32 + (c & 31)) * 2; }
__device__ __forceinline__ int v_rd_base(int lane) { return ((lane & 3) << 3) | (((lane >> 2) & 3) << 6) | (((lane >> 4) & 1) << 5) | (((lane >> 5) & 1) << 8); }
constexpr int v_rd_off(int d0, int ks, int half) { return d0 * 512 + ks * 4096 + half * 2048; }
template <int OFF> __device__ __forceinline__ s16x4 tr_read(int vb) {
  s16x4 r; asm volatile("ds_read_b64_tr_b16 %0, %1 offset:%2" : "=&v"(r) : "v"(vb), "i"(OFF) : "memory"); return r;
}
template <int D0> __device__ __forceinline__ void pv_one(f32x16& od, int vb, bf16x8 pa0, bf16x8 pa1, bf16x8 pa2, bf16x8 pa3) {
  const s16x4 l0 = tr_read<v_rd_off(D0, 0, 0)>(vb), h0 = tr_read<v_rd_off(D0, 0, 1)>(vb), l1 = tr_read<v_rd_off(D0, 1, 0)>(vb), h1 = tr_read<v_rd_off(D0, 1, 1)>(vb);
  const s16x4 l2 = tr_read<v_rd_off(D0, 2, 0)>(vb), h2 = tr_read<v_rd_off(D0, 2, 1)>(vb), l3 = tr_read<v_rd_off(D0, 3, 0)>(vb), h3 = tr_read<v_rd_off(D0, 3, 1)>(vb);
  asm volatile("s_waitcnt lgkmcnt(0)" ::: "memory"); SBAR();
#define PK(L, H) (bf16x8){L[0], L[1], L[2], L[3], H[0], H[1], H[2], H[3]}
  od = __builtin_amdgcn_mfma_f32_32x32x16_bf16(pa0, PK(l0, h0), od, 0, 0, 0);
  od = __builtin_amdgcn_mfma_f32_32x32x16_bf16(pa1, PK(l1, h1), od, 0, 0, 0);
  od = __builtin_amdgcn_mfma_f32_32x32x16_bf16(pa2, PK(l2, h2), od, 0, 0, 0);
  od = __builtin_amdgcn_mfma_f32_32x32x16_bf16(pa3, PK(l3, h3), od, 0, 0, 0);
#undef PK
}
__device__ __forceinline__ void pv_d0(f32x16* o, int vb, bf16x8 pa0, bf16x8 pa1, bf16x8 pa2, bf16x8 pa3) {
  pv_one<0>(o[0], vb, pa0, pa1, pa2, pa3); pv_one<1>(o[1], vb, pa0, pa1, pa2, pa3); pv_one<2>(o[2], vb, pa0, pa1, pa2, pa3); pv_one<3>(o[3], vb, pa0, pa1, pa2, pa3);
}
__device__ __forceinline__ void mla_unit(int b, int h, int qb, const bf16_t* __restrict__ QM, const bf16_t* __restrict__ KN, const bf16_t* __restrict__ KR, const bf16_t* __restrict__ VV, unsigned char* __restrict__ OM, LAS char* lds) {
  const int tid = threadIdx.x, wid = tid >> 6, lane = tid & 63, r32 = lane & 31, hi = lane >> 5;
  constexpr float C = MLA_SCALE * L2E, THRS = MLA_THR / MLA_SCALE;
  constexpr int NT = 33;
  LAS char* V_lds = lds + OFF_V; LAS char* Kn_lds = lds + OFF_KN; LAS char* Kr_lds = lds + OFF_KR;
  LAS float* ws = (LAS float*)(lds + OFF_WS) + wid * 64; LAS float* li_l = ws; LAS float* al_l = ws + 32;
  float m_reg = -1e30f, l_reg = 0; f32x16 o[4] = {}; bf16x8 qr[8];
  LAS char* qrp = lds + OFF_QR + wid * 4096 + lane * 16;
  const int qrow = b * SEQ + qb * 256 + wid * QBLK + r32;
  const bf16_t* Qw = QM + (size_t)qrow * 3072 + h * 192 + hi * 8;
#pragma unroll
  for (int d0 = 0; d0 < 8; ++d0) qr[d0] = *(const GAS bf16x8*)(Qw + d0 * 16);
  __syncthreads();
#pragma unroll
  for (int d0 = 0; d0 < 4; ++d0) *(LAS bf16x8*)(qrp + d0 * 1024) = *(const GAS bf16x8*)(Qw + (8 + d0) * 16);
  const int sr = tid >> 4, sc = (tid & 15) * 8, vst0 = v_st(sr, sc), vst1 = v_st(32 + sr, sc);
  const int krr = tid >> 3, krc = (tid & 7) * 8;
  const int vb0 = (int)(uintptr_t)V_lds + v_rd_base(lane);
  bf16x8 s_v0, s_v1, s_k0, s_k1, s_kr;
  const int realbase = b * SEQ - KVBLK;
  const unsigned voff = (unsigned)(sr * 2048 + sc) * 2u, kroff = (unsigned)(krr * 64 + krc) * 2u;
  int kb[4], krb[4];
#pragma unroll
  for (int bq = 0; bq < 4; ++bq) { kb[bq] = KSWZ(r32, bq * 32 + hi * 16); krb[bq] = KRSWZ(r32, bq * 32 + hi * 16); }
#define TROW(t) ((t) == 0 ? MREAL : realbase + (t) * KVBLK)
#define SLOAD(t) do { const int k0_ = TROW(t); const size_t ro_ = ((size_t)k0_ * 2048 + h * 128) * 2; \
    const GAS char* vb_ = (const GAS char*)VV + ro_; const GAS char* nb_ = (const GAS char*)KN + ro_; const GAS char* rb_ = (const GAS char*)KR + (size_t)k0_ * 128; \
    s_v0 = *(const GAS bf16x8*)(vb_ + voff); s_v1 = *(const GAS bf16x8*)(vb_ + 32 * 4096 + voff); \
    s_k0 = *(const GAS bf16x8*)(nb_ + voff); s_k1 = *(const GAS bf16x8*)(nb_ + 32 * 4096 + voff); \
    s_kr = *(const GAS bf16x8*)(rb_ + kroff); } while (0)
#define SWRITE(bf) do { *(LAS bf16x8*)(V_lds + (bf) * SHM_V + vst0) = s_v0; *(LAS bf16x8*)(V_lds + (bf) * SHM_V + vst1) = s_v1; const int kc_ = sc * 2; \
    *(LAS bf16x8*)(Kn_lds + (bf) * SHM_KN + KSWZ(sr, kc_)) = s_k0; *(LAS bf16x8*)(Kn_lds + (bf) * SHM_KN + KSWZ(32 + sr, kc_)) = s_k1; \
    *(LAS bf16x8*)(Kr_lds + (bf) * SHM_KR + KRSWZ(krr, krc * 2)) = s_kr; } while (0)
#define SWAIT() asm volatile("s_waitcnt vmcnt(0)" ::: "memory")
#define RESC(a) do { if (__any((a) < 1.f)) { if (hi == 0) al_l[r32] = (a); asm volatile("s_waitcnt lgkmcnt(0)" ::: "memory"); \
    _Pragma("unroll") for (int d = 0; d < 4; ++d) _Pragma("unroll") for (int r = 0; r < 16; ++r) o[d][r] *= al_l[crow(r, hi)]; } } while (0)
  f32x16 pA0, pA1, pB0, pB1; float mnA, mnB, alA, alB; bf16x8 pa0, pa1, pa2, pa3;
  SLOAD(0); SWAIT(); SWRITE(0); __syncthreads();
  qkt(pA0, pA1, Kn_lds, Kr_lds, qr, qrp, kb, krb);
  { const float NEG = -INFINITY;
#pragma unroll
    for (int r = 8; r < 16; ++r) pA0[r] = NEG;
#pragma unroll
    for (int r = 0; r < 16; ++r) pA1[r] = NEG; }
  partialSM(pA0, pA1, m_reg, mnA, alA, C, THRS);
  SLOAD(1); SWAIT(); SWRITE(1); __syncthreads();
  for (int j = 1; j + 1 < NT; j += 2) {
    SBAR(); qkt(pB0, pB1, Kn_lds + SHM_KN, Kr_lds + SHM_KR, qr, qrp, kb, krb);
    finishSM(pA0, pA1, alA, l_reg, pa0, pa1, pa2, pa3); SBAR();
    SLOAD(j + 1); SBAR();
    pv_d0(o, vb0, pa0, pa1, pa2, pa3); partialSM(pB0, pB1, m_reg, mnB, alB, C, THRS);
    __syncthreads(); SWAIT(); SWRITE(0);
    RESC(alB); __syncthreads();
    SBAR(); qkt(pA0, pA1, Kn_lds, Kr_lds, qr, qrp, kb, krb);
    finishSM(pB0, pB1, alB, l_reg, pa0, pa1, pa2, pa3); SBAR();
    if (j + 2 < NT) SLOAD(j + 2); SBAR();
    pv_d0(o, vb0 + SHM_V, pa0, pa1, pa2, pa3); partialSM(pA0, pA1, m_reg, mnA, alA, C, THRS);
    __syncthreads(); if (j + 2 < NT) { SWAIT(); SWRITE(1); }
    RESC(alA); __syncthreads();
  }
  finishSM(pA0, pA1, alA, l_reg, pa0, pa1, pa2, pa3); SBAR();
  pv_d0(o, vb0, pa0, pa1, pa2, pa3);
  if (hi == 0) li_l[r32] = l_reg; asm volatile("s_waitcnt lgkmcnt(0)" ::: "memory");
  float rli[16];
#pragma unroll
  for (int r = 0; r < 16; ++r) rli[r] = __builtin_amdgcn_rcpf(li_l[crow(r, hi)]);
  unsigned char* Ow = OM + (size_t)(b * SEQ + qb * 256 + wid * QBLK) * 2048 + h * 128;
#pragma unroll
  for (int r = 0; r < 16; ++r) { const int orow = crow(r, hi);
#pragma unroll
    for (int d0 = 0; d0 < 4; ++d0) Ow[(size_t)orow * 2048 + d0 * 32 + r32] = f32_to_fp8(o[d0][r] * rli[r] * 32.f); }
#undef TROW
#undef SLOAD
#undef SWRITE
#undef SWAIT
#undef RESC
}
constexpr int K8S = 208, V8S = 80, SHM8_K = 64 * K8S, SHM8_V = 128 * V8S;
constexpr int OFF8_K = 0, OFF8_V = 2 * SHM8_K, OFF8_WS = OFF8_V + 2 * SHM8_V, MLA8_LDS = OFF8_WS + NW * 64 * 4;
constexpr float MLA8_THR = 1.9f;
typedef int a8_t __attribute__((ext_vector_type(8)));
#define MFMA8(acc_, a_, b_, sa_, sb_) asm volatile("s_nop 1\n\tv_mfma_scale_f32_32x32x64_f8f6f4 %0, %1, %2, %0, %3, %4 op_sel_hi:[0,0,0]" : "+v"(acc_) : "v"(a_), "v"(b_), "v"(sa_), "v"(sb_))
__device__ __forceinline__ a8_t ld_frag8(const LAS char* p) { const u32x4 lo = *(const LAS u32x4*)p, hi = *(const LAS u32x4*)(p + 16); return (a8_t){(int)lo.x, (int)lo.y, (int)lo.z, (int)lo.w, (int)hi.x, (int)hi.y, (int)hi.z, (int)hi.w}; }
__device__ __forceinline__ void qkt8(f32x16& p0, f32x16& p1, const LAS char* Kb, const a8_t& q0, const a8_t& q1, const a8_t& q2, int s1) {
  p0 = f32x16{}; p1 = f32x16{};
  { const a8_t a0 = ld_frag8(Kb), a1 = ld_frag8(Kb + 32 * K8S); MFMA8(p0, a0, q0, s1, s1); MFMA8(p1, a1, q0, s1, s1); }
  { const a8_t a0 = ld_frag8(Kb + 64), a1 = ld_frag8(Kb + 32 * K8S + 64); MFMA8(p0, a0, q1, s1, s1); MFMA8(p1, a1, q1, s1, s1); }
  { const a8_t a0 = ld_frag8(Kb + 128), a1 = ld_frag8(Kb + 32 * K8S + 128); MFMA8(p0, a0, q2, s1, s1); MFMA8(p1, a1, q2, s1, s1); }
  asm volatile("s_nop 15\n\ts_nop 15" : "+v"(p0), "+v"(p1));
}
__device__ __forceinline__ void partialSM8(f32x16& p0, f32x16& p1, float& m_reg, float& mn, float& alpha, const float C, const float THRS) {
  float pmax = p0[0];
#pragma unroll
  for (int r = 1; r < 16; ++r) pmax = fmaxf(pmax, p0[r]);
#pragma unroll
  for (int r = 0; r < 16; ++r) pmax = fmaxf(pmax, p1[r]);
  { auto rr = __builtin_amdgcn_permlane32_swap(__float_as_uint(pmax), __float_as_uint(pmax), false, false);
    pmax = fmaxf(__uint_as_float(rr[0]), __uint_as_float(rr[1])); }
  if (__builtin_expect(__all(pmax - m_reg <= THRS), 1)) { mn = m_reg; alpha = 1.f; }
  else { mn = fmaxf(m_reg, pmax); alpha = __builtin_amdgcn_exp2f((m_reg - mn) * C); m_reg = mn; }
  const float mnC = 6.f - mn * C;
#pragma unroll
  for (int r = 0; r < 16; ++r) p0[r] = fmaf(p0[r], C, mnC);
#pragma unroll
  for (int r = 0; r < 16; ++r) p1[r] = fmaf(p1[r], C, mnC);
#pragma unroll
  for (int r = 0; r < 16; ++r) p0[r] = __builtin_amdgcn_exp2f(p0[r]);
}
__device__ __forceinline__ void finishSM8(f32x16& p0, f32x16& p1, float alpha, float& l_reg, a8_t& pf) {
#pragma unroll
  for (int r = 0; r < 16; ++r) p1[r] = __builtin_amdgcn_exp2f(p1[r]);
  float ps = 0;
#pragma unroll
  for (int r = 0; r < 16; ++r) ps += p0[r];
#pragma unroll
  for (int r = 0; r < 16; ++r) ps += p1[r];
  { auto rr = __builtin_amdgcn_permlane32_swap(__float_as_uint(ps), __float_as_uint(ps), false, false);
    ps = __uint_as_float(rr[0]) + __uint_as_float(rr[1]); }
  l_reg = l_reg * alpha + ps;
#pragma unroll
  for (int w = 0; w < 4; ++w) { int x = 0, y = 0;
    x = __builtin_amdgcn_cvt_pk_fp8_f32(p0[4 * w], p0[4 * w + 1], x, false); x = __builtin_amdgcn_cvt_pk_fp8_f32(p0[4 * w + 2], p0[4 * w + 3], x, true);
    y = __builtin_amdgcn_cvt_pk_fp8_f32(p1[4 * w], p1[4 * w + 1], y, false); y = __builtin_amdgcn_cvt_pk_fp8_f32(p1[4 * w + 2], p1[4 * w + 3], y, true);
    pf[w] = x; pf[4 + w] = y; }
}
__device__ __forceinline__ void pv8(f32x16* o, const LAS char* Vb, const a8_t& pf, int sP, int s1) {
  const a8_t b0 = ld_frag8(Vb), b1 = ld_frag8(Vb + 32 * V8S), b2 = ld_frag8(Vb + 64 * V8S), b3 = ld_frag8(Vb + 96 * V8S);
  MFMA8(o[0], pf, b0, sP, s1); MFMA8(o[1], pf, b1, sP, s1); MFMA8(o[2], pf, b2, sP, s1); MFMA8(o[3], pf, b3, sP, s1);
  asm volatile("s_nop 15\n\ts_nop 15" : "+v"(o[0]), "+v"(o[1]), "+v"(o[2]), "+v"(o[3]));
}
__device__ __forceinline__ void mla_unit8(int b, int h, int qb, const unsigned char* __restrict__ QM8, const unsigned char* __restrict__ KN8, const unsigned char* __restrict__ KR8, const unsigned char* __restrict__ VT8,
                                          unsigned char* __restrict__ OM, LAS char* lds) {
  const int tid = threadIdx.x, wid = tid >> 6, lane = tid & 63, r32 = lane & 31, hi = lane >> 5;
  constexpr float C = MLA_SCALE * L2E, THRS = MLA8_THR / MLA_SCALE;
  constexpr int NT = 33;
  LAS char* K_lds = lds + OFF8_K; LAS char* V_lds = lds + OFF8_V;
  LAS float* ws = (LAS float*)(lds + OFF8_WS) + wid * 64; LAS float* li_l = ws; LAS float* al_l = ws + 32;
  int s1 = 0x7f7f7f7f, sP = 0x79797979; asm volatile("" : "+v"(s1), "+v"(sP));
  float m_reg = -1e30f, l_reg = 0; f32x16 o[4] = {};
  const int qrow = b * SEQ + qb * 256 + wid * QBLK + r32;
  a8_t q0, q1, q2;
  { const unsigned char* Qw = QM8 + (size_t)qrow * 3072 + h * 192 + hi * 32;
    const u32x4 a = *(const GAS u32x4*)Qw, bq = *(const GAS u32x4*)(Qw + 16), c = *(const GAS u32x4*)(Qw + 64), d = *(const GAS u32x4*)(Qw + 80), e = *(const GAS u32x4*)(Qw + 128), f = *(const GAS u32x4*)(Qw + 144);
    q0 = (a8_t){(int)a.x, (int)a.y, (int)a.z, (int)a.w, (int)bq.x, (int)bq.y, (int)bq.z, (int)bq.w};
    q1 = (a8_t){(int)c.x, (int)c.y, (int)c.z, (int)c.w, (int)d.x, (int)d.y, (int)d.z, (int)d.w};
    q2 = (a8_t){(int)e.x, (int)e.y, (int)e.z, (int)e.w, (int)f.x, (int)f.y, (int)f.z, (int)f.w}; }
  __syncthreads();
  const int kkey = tid >> 3, kch = tid & 7, rkey = (tid >> 2) & 63, rch = tid & 3, vdim = tid >> 2, vch = tid & 3;
  const LAS char* Kf = K_lds + r32 * K8S + 32 * hi; const LAS char* Vf = V_lds + r32 * V8S + 32 * hi;
  u32x4 s_k, s_r, s_v;
  const int realbase = b * SEQ - KVBLK;
#define TROW(t) ((t) == 0 ? MREAL : realbase + (t) * KVBLK)
#define SLOAD(t) do { const int k0_ = TROW(t); \
    s_k = *(const GAS u32x4*)(KN8 + (size_t)(k0_ + kkey) * 2048 + h * 128 + kch * 16); \
    s_r = *(const GAS u32x4*)(KR8 + (size_t)(k0_ + rkey) * 64 + rch * 16); \
    s_v = *(const GAS u32x4*)(VT8 + (size_t)(h * 128 + vdim) * MPAD + k0_ + vch * 16); } while (0)
#define SWRITE(bf) do { *(LAS u32x4*)(K_lds + (bf) * SHM8_K + kkey * K8S + kch * 16) = s_k; if (tid < 256) *(LAS u32x4*)(K_lds + (bf) * SHM8_K + rkey * K8S + 128 + rch * 16) = s_r; \
    *(LAS u32x4*)(V_lds + (bf) * SHM8_V + vdim * V8S + vch * 16) = s_v; } while (0)
#define SWAIT() asm volatile("s_waitcnt vmcnt(0)" ::: "memory")
#define RESC(a) do { if (__any((a) < 1.f)) { if (hi == 0) al_l[r32] = (a); asm volatile("s_waitcnt lgkmcnt(0)" ::: "memory"); \
    _Pragma("unroll") for (int d = 0; d < 4; ++d) _Pragma("unroll") for (int r = 0; r < 16; ++r) o[d][r] *= al_l[crow(r, hi)]; } } while (0)
  f32x16 pA0, pA1, pB0, pB1; float mnA, mnB, alA, alB; a8_t pf;
  SLOAD(0); SWAIT(); SWRITE(0); __syncthreads();
  qkt8(pA0, pA1, Kf, q0, q1, q2, s1);
  { const float NEG = -INFINITY;
#pragma unroll
    for (int r = 8; r < 16; ++r) pA0[r] = NEG;
#pragma unroll
    for (int r = 0; r < 16; ++r) pA1[r] = NEG; }
  partialSM8(pA0, pA1, m_reg, mnA, alA, C, THRS);
  SLOAD(1); SWAIT(); SWRITE(1); __syncthreads();
  for (int j = 1; j + 1 < NT; j += 2) {
    SBAR(); qkt8(pB0, pB1, Kf + SHM8_K, q0, q1, q2, s1);
    finishSM8(pA0, pA1, alA, l_reg, pf); SBAR();
    SLOAD(j + 1); SBAR();
    pv8(o, Vf, pf, sP, s1); partialSM8(pB0, pB1, m_reg, mnB, alB, C, THRS);
    __syncthreads(); SWAIT(); SWRITE(0);
    RESC(alB); __syncthreads();
    SBAR(); qkt8(pA0, pA1, Kf, q0, q1, q2, s1);
    finishSM8(pB0, pB1, alB, l_reg, pf); SBAR();
    if (j + 2 < NT) SLOAD(j + 2); SBAR();
    pv8(o, Vf + SHM8_V, pf, sP, s1); partialSM8(pA0, pA1, m_reg, mnA, alA, C, THRS);
    __syncthreads(); if (j + 2 < NT) { SWAIT(); SWRITE(1); }
    RESC(alA); __syncthreads();
  }
  finishSM8(pA0, pA1, alA, l_reg, pf); SBAR();
  pv8(o, Vf, pf, sP, s1);
  if (hi == 0) li_l[r32] = l_reg; asm volatile("s_waitcnt lgkmcnt(0)" ::: "memory");
  float rli[16];
#pragma unroll
  for (int r = 0; r < 16; ++r) rli[r] = __builtin_amdgcn_rcpf(li_l[crow(r, hi)]) * (64.f * 32.f);
  unsigned char* Ow = OM + (size_t)(b * SEQ + qb * 256 + wid * QBLK) * 2048 + h * 128;
#pragma unroll
  for (int r = 0; r < 16; ++r) { const int orow = crow(r, hi);
#pragma unroll
    for (int d0 = 0; d0 < 4; ++d0) Ow[(size_t)orow * 2048 + d0 * 32 + r32] = f32_to_fp8(o[d0][r] * rli[r]); }
#undef TROW
#undef SLOAD
#undef SWRITE
#undef SWAIT
#undef RESC
}
__device__ __forceinline__ void na_task(int task, const unsigned char* __restrict__ NAQ, const unsigned char* __restrict__ NAK, const unsigned char* __restrict__ VT, unsigned char* __restrict__ ONA,
                                        const LAS float* relb, const LAS float* metab, LAS float* wsf, int lane, Conv& cv) {
  const int r32 = lane & 31, hi = lane >> 5;
  const int half = task & 1, r = (task >> 1) & 31, h = (task >> 6) & 15, b = task >> 10;
  const int qc = half * 32 + r32;
  const int cs = min(max(qc - 8, 0), 48), rs = min(max(r - 4, 0), 24);
  const int qtok = b * SEQ + r * 64 + qc;
  constexpr float C = L2E, THRS = 1.9f, SCALE = 0.125f;
  int s1 = 0x7f7f7f7f, sP = 0x79797979; asm volatile("" : "+v"(s1), "+v"(sP));
  a8_t qf; { const unsigned char* qp = NAQ + (size_t)qtok * 1024 + h * 64 + hi * 32; const u32x4 a = *(const GAS u32x4*)qp, c = *(const GAS u32x4*)(qp + 16);
    qf = (a8_t){(int)a.x, (int)a.y, (int)a.z, (int)a.w, (int)c.x, (int)c.y, (int)c.z, (int)c.w}; }
  float m_reg = -1e30f, l_reg = 0.f; f32x16 o[2] = {};
  LAS float* al_l = wsf; LAS float* li_l = wsf + 32;
  const float NEG = -INFINITY;
  const int kb0 = half * 16;
  const unsigned long long wm = 0xFFFFull << (cs - kb0);
  const unsigned mh0 = (unsigned)wm >> (4 * hi), mh1 = (unsigned)(wm >> 32) >> (4 * hi);
  const unsigned char* kq = NAK + (size_t)r32 * 1024 + h * 64 + hi * 32;
  const unsigned char* kq2 = NAK + (size_t)(32 + (r32 & 15)) * 1024 + h * 64 + hi * 32;
  const unsigned char* vq = VT + (size_t)(h * 64 + r32) * VT_PITCH + 32 * hi;
#define NA_KTOK(w) ((w) == 8 ? MREAL : b * SEQ + (rs + (w)) * 64 + kb0)
#define NA_VOFF(w) ((w) == 8 ? MREAL : b * SEQ + (rs + (w)) * 64 + (kb0 >> 1))
#define NA_LOADK(KF, w) do { const size_t ko_ = (size_t)NA_KTOK(w) * 1024; KF[0] = *(const GAS u32x4*)(kq + ko_); KF[1] = *(const GAS u32x4*)(kq + ko_ + 16); KF[2] = *(const GAS u32x4*)(kq2 + ko_); KF[3] = *(const GAS u32x4*)(kq2 + ko_ + 16); } while (0)
#define NA_A8(x_, y_) (a8_t){(int)x_.x, (int)x_.y, (int)x_.z, (int)x_.w, (int)y_.x, (int)y_.y, (int)y_.z, (int)y_.w}
#define NA_TILE(KF, wt, YN) do { \
    u32x4 va0, va1; u32x2 vb0_, vb1_; { const unsigned char* vp_ = vq + NA_VOFF(wt); va0 = *(const GAS u32x4*)vp_; vb0_ = *(const GAS u32x2*)(vp_ + 16); va1 = *(const GAS u32x4*)(vp_ + (size_t)32 * VT_PITCH); vb1_ = *(const GAS u32x2*)(vp_ + (size_t)32 * VT_PITCH + 16); } \
    f32x16 p0 = {}, p1 = {}; \
    { const a8_t k0_ = NA_A8(KF[0], KF[1]), k1_ = NA_A8(KF[2], KF[3]); MFMA8(p0, k0_, qf, s1, s1); MFMA8(p1, k1_, qf, s1, s1); asm volatile("s_nop 15\n\ts_nop 15" : "+v"(p0), "+v"(p1)); } \
    if ((wt) + 1 < 9) NA_LOADK(KF, (wt) + 1);            \
    asm volatile("" ::: "memory"); if ((cv.tick++ & 1) == 0) conv_step<12>(cv, lane);     \
    if ((wt) < 8) { const LAS float* bp_ = relb + ((h * 15 + (rs + (wt) - r + 7)) * 31 + 15 - qc + 4 * hi + kb0);     \
      float bv0[16], bv1[8];        \
      _Pragma("unroll") for (int rg = 0; rg < 16; ++rg) { const int c_ = (rg & 3) + 8 * (rg >> 2); bv0[rg] = bp_[c_]; if (rg < 8) bv1[rg] = bp_[c_ + 32]; } \
      _Pragma("unroll") for (int rg = 0; rg < 16; ++rg) { asm volatile("" : "+v"(bv0[rg])); if (rg < 8) asm volatile("" : "+v"(bv1[rg])); } \
      _Pragma("unroll") for (int rg = 0; rg < 16; ++rg) { const int c_ = (rg & 3) + 8 * (rg >> 2); \
        { const bool ok = (mh0 >> c_) & 1u; p0[rg] = ok ? fmaf(p0[rg], SCALE, bv0[rg]) : NEG; } \
        if (rg < 8) { const bool ok = (mh1 >> c_) & 1u; p1[rg] = ok ? fmaf(p1[rg], SCALE, bv1[rg]) : NEG; } } \
    } else { const LAS float* bp = metab + h * 16; \
      _Pragma("unroll") for (int rg = 0; rg < 16; ++rg) { const int kc = crow(rg, hi); p0[rg] = (rg < 8) ? fmaf(p0[rg], SCALE, bp[kc & 15]) : NEG; if (rg < 8) p1[rg] = NEG; } } \
      \
    float pmax = p0[0]; \
    _Pragma("unroll") for (int rg = 1; rg < 16; ++rg) pmax = fmaxf(pmax, p0[rg]); \
    _Pragma("unroll") for (int rg = 0; rg < 8; ++rg) pmax = fmaxf(pmax, p1[rg]); \
    { auto rr = __builtin_amdgcn_permlane32_swap(__float_as_uint(pmax), __float_as_uint(pmax), false, false); pmax = fmaxf(__uint_as_float(rr[0]), __uint_as_float(rr[1])); } \
    float mn, alpha; \
    if (__builtin_expect(__all(pmax - m_reg <= THRS), 1)) { mn = m_reg; alpha = 1.f; } \
    else { mn = fmaxf(m_reg, pmax); alpha = __builtin_amdgcn_exp2f((m_reg - mn) * C); m_reg = mn; } \
    const float mnC = 6.f - mn * C; float ps = 0.f;        \
    _Pragma("unroll") for (int rg = 0; rg < 16; ++rg) { p0[rg] = __builtin_amdgcn_exp2f(fmaf(p0[rg], C, mnC)); ps += p0[rg]; } \
    _Pragma("unroll") for (int rg = 0; rg < 8; ++rg) { p1[rg] = __builtin_amdgcn_exp2f(fmaf(p1[rg], C, mnC)); ps += p1[rg]; } \
    { auto rr = __builtin_amdgcn_permlane32_swap(__float_as_uint(ps), __float_as_uint(ps), false, false); ps = __uint_as_float(rr[0]) + __uint_as_float(rr[1]); } \
    l_reg = l_reg * alpha + ps; \
    a8_t pf;   \
    _Pragma("unroll") for (int w_ = 0; w_ < 4; ++w_) { int x = 0; x = __builtin_amdgcn_cvt_pk_fp8_f32(p0[4 * w_], p0[4 * w_ + 1], x, false); x = __builtin_amdgcn_cvt_pk_fp8_f32(p0[4 * w_ + 2], p0[4 * w_ + 3], x, true); pf[w_] = x; } \
    _Pragma("unroll") for (int w_ = 0; w_ < 2; ++w_) { int x = 0; x = __builtin_amdgcn_cvt_pk_fp8_f32(p1[4 * w_], p1[4 * w_ + 1], x, false); x = __builtin_amdgcn_cvt_pk_fp8_f32(p1[4 * w_ + 2], p1[4 * w_ + 3], x, true); pf[4 + w_] = x; } \
    pf[6] = 0; pf[7] = 0; \
    if (__any(alpha < 1.f)) { if (hi == 0) al_l[r32] = alpha; asm volatile("s_waitcnt lgkmcnt(0)" ::: "memory"); \
      _Pragma("unroll") for (int d = 0; d < 2; ++d) _Pragma("unroll") for (int rg = 0; rg < 16; ++rg) o[d][rg] *= al_l[crow(rg, hi)]; } \
    { const a8_t v0_ = (a8_t){(int)va0.x, (int)va0.y, (int)va0.z, (int)va0.w, (int)vb0_.x, (int)vb0_.y, 0, 0}, v1_ = (a8_t){(int)va1.x, (int)va1.y, (int)va1.z, (int)va1.w, (int)vb1_.x, (int)vb1_.y, 0, 0}; \
      MFMA8(o[0], pf, v0_, sP, s1); MFMA8(o[1], pf, v1_, sP, s1); asm volatile("s_nop 15\n\ts_nop 15" : "+v"(o[0]), "+v"(o[1])); } } while (0)
  { u32x4 kA[4];
    NA_LOADK(kA, 0);
#pragma unroll 1
    for (int w = 0; w < 8; ++w) { NA_TILE(kA, w, 12); }
    NA_TILE(kA, 8, 12); }
#undef NA_KTOK
#undef NA_VOFF
#undef NA_LOADK
#undef NA_A8
#undef NA_TILE
  if (hi == 0) li_l[r32] = l_reg; asm volatile("s_waitcnt lgkmcnt(0)" ::: "memory");
  unsigned char* Ow = ONA + (size_t)(b * SEQ + r * 64 + half * 32) * 1024 + h * 64;
#pragma unroll
  for (int rg = 0; rg < 16; ++rg) { const int orow = crow(rg, hi); const float rl = __builtin_amdgcn_rcpf(li_l[orow]) * (64.f * 16.f);
#pragma unroll
    for (int d0 = 0; d0 < 2; ++d0) Ow[(size_t)orow * 1024 + d0 * 32 + r32] = f32_to_fp8(o[d0][rg] * rl); }
  asm volatile("s_waitcnt lgkmcnt(0)" ::: "memory");
}
}
namespace peer {
constexpr int CH = 32;
constexpr int OFF_TV = 0, OFF_TI = OFF_TV + CH * 16 * 16 * 4, OFF_SE = OFF_TI + CH * 16 * 16 * 4, OFF_SG = OFF_SE + CH * 128 * 4, OFF_SE2 = OFF_SG + CH * 128 * 4, OFF_SG2 = OFF_SE2 + CH * 128 * 4, PEER_LDS = OFF_SG2 + CH * 128 * 4;
static_assert(PEER_LDS <= RING_BYTES, "PEER LDS");
__device__ __forceinline__ float gelu_tanh(float x) {
    const float u = 0.7978845608028654f * (x + 0.044715f * x * x * x);
    const float e = __builtin_amdgcn_exp2f(-2.f * 1.4426950408889634f * fabsf(u));
    const float t = (1.f - e) * __builtin_amdgcn_rcpf(1.f + e);
    return 0.5f * x * (1.f + (u < 0.f ? -t : t));
}
__device__ __forceinline__ void fmac1(float& acc, float a, float b) { asm("v_fmac_f32_e32 %0, %1, %2" : "+v"(acc) : "v"(a), "v"(b)); }
#define PEER_INSERT(x_, xi_) do { float x__ = (x_); int xi__ = (xi_); \
    _Pragma("unroll") for (int j_ = 0; j_ < 16; ++j_) { const bool gt_ = x__ > tv[j_]; const float tvo_ = tv[j_]; const int tio_ = ti[j_]; \
        tv[j_] = gt_ ? x__ : tvo_; ti[j_] = gt_ ? xi__ : tio_; x__ = gt_ ? tvo_ : x__; xi__ = gt_ ? tio_ : xi__; } } while (0)

#define PEER_AUX 0
typedef __amdgpu_buffer_rsrc_t rsrc_t;
__device__ __forceinline__ rsrc_t mk_rsrc(const void* p, unsigned bytes) { return __builtin_amdgcn_make_buffer_rsrc((void*)p, 0, bytes, 0x00020000); }
__device__ __forceinline__ u32x4 ldb128(rsrc_t r, unsigned off) { return __builtin_amdgcn_raw_buffer_load_b128(r, off, 0, PEER_AUX); }
typedef unsigned v6u_t __attribute__((ext_vector_type(6)));
typedef float v32f_t __attribute__((ext_vector_type(32)));
typedef float v16f_t __attribute__((ext_vector_type(16)));
__device__ __forceinline__ u32x2 ldb64(rsrc_t r, unsigned off) { return __builtin_amdgcn_raw_buffer_load_b64(r, off, 0, PEER_AUX); }
__device__ __forceinline__ f32x4 ldf128(rsrc_t r, unsigned off) { return __builtin_bit_cast(f32x4, __builtin_amdgcn_raw_buffer_load_b128(r, off, 0, PEER_AUX)); }
__device__ __forceinline__ f32x4 ldf128_nt(rsrc_t r, unsigned off) { return __builtin_bit_cast(f32x4, __builtin_amdgcn_raw_buffer_load_b128(r, off, 0, 2)); }
__device__ __forceinline__ void peer_select(int chunk, const _Float16* __restrict__ SC, LAS char* lds, int tid, LAS int* SE, LAS float* SG) {
    LAS float* TV = (LAS float*)(lds + OFF_TV); LAS int* TI = (LAS int*)(lds + OFF_TI);
    asm volatile("" : "+v"(tid));
    const int tok0 = chunk * CH;
    const rsrc_t rSC = mk_rsrc(SC, 0x4000000u);
    __syncthreads();
    { const int tl = tid >> 4, g = tid & 15; const unsigned spo = ((unsigned)(tok0 + tl) * 2048u + (unsigned)g * 128u) * 2u;
      int tk[16];
#pragma unroll
      for (int j = 0; j < 16; ++j) tk[j] = (int)0x80000000;
#define PEER_KEY(x_, lowbits_, mask_) ({ const int f_ = __float_as_int(x_); ((f_ ^ ((f_ >> 31) & 0x7fffffff)) & ~(mask_)) | (lowbits_); })
#define PEER_INS(key_) do { int x__ = (key_); _Pragma("unroll") for (int j_ = 0; j_ < 16; ++j_) { const int hi_ = max(x__, tk[j_]); x__ = min(x__, tk[j_]); tk[j_] = hi_; } } while (0)
      typedef _Float16 h8_t __attribute__((ext_vector_type(8)));
#define PEER_CX(a_, b_) do { const int hi_ = max(a_, b_), lo_ = min(a_, b_); a_ = hi_; b_ = lo_; } while (0)
      u32x4 na = __builtin_amdgcn_raw_buffer_load_b128(rSC, spo, 0, 2), nb = __builtin_amdgcn_raw_buffer_load_b128(rSC, spo + 16, 0, 2);
#pragma unroll 1
      for (int i = 0; i < 16; i += 2) { const h8_t a = __builtin_bit_cast(h8_t, na), b = __builtin_bit_cast(h8_t, nb);
          { const unsigned on = spo + (unsigned)min(i + 2, 14) * 16u; na = __builtin_amdgcn_raw_buffer_load_b128(rSC, on, 0, 2); nb = __builtin_amdgcn_raw_buffer_load_b128(rSC, on + 16, 0, 2); }
          int kk[16];
#pragma unroll
          for (int e = 0; e < 8; ++e) { kk[e] = PEER_KEY((float)a[e], 127 - (8 * i + e), 127); kk[8 + e] = PEER_KEY((float)b[e], 127 - (8 * i + 8 + e), 127); }
          PEER_CX(kk[0], kk[13]); PEER_CX(kk[1], kk[12]); PEER_CX(kk[2], kk[15]); PEER_CX(kk[3], kk[14]); PEER_CX(kk[4], kk[8]); PEER_CX(kk[5], kk[6]); PEER_CX(kk[7], kk[11]); PEER_CX(kk[9], kk[10]); PEER_CX(kk[0], kk[5]); PEER_CX(kk[1], kk[7]); PEER_CX(kk[2], kk[9]); PEER_CX(kk[3], kk[4]); PEER_CX(kk[6], kk[13]); PEER_CX(kk[8], kk[14]); PEER_CX(kk[10], kk[15]); PEER_CX(kk[11], kk[12]); PEER_CX(kk[0], kk[1]); PEER_CX(kk[2], kk[3]); PEER_CX(kk[4], kk[5]); PEER_CX(kk[6], kk[8]); PEER_CX(kk[7], kk[9]); PEER_CX(kk[10], kk[11]); PEER_CX(kk[12], kk[13]); PEER_CX(kk[14], kk[15]); PEER_CX(kk[0], kk[2]); PEER_CX(kk[1], kk[3]); PEER_CX(kk[4], kk[10]); PEER_CX(kk[5], kk[11]); PEER_CX(kk[6], kk[7]); PEER_CX(kk[8], kk[9]); PEER_CX(kk[12], kk[14]); PEER_CX(kk[13], kk[15]); PEER_CX(kk[1], kk[2]); PEER_CX(kk[3], kk[12]); PEER_CX(kk[4], kk[6]); PEER_CX(kk[5], kk[7]); PEER_CX(kk[8], kk[10]); PEER_CX(kk[9], kk[11]); PEER_CX(kk[13], kk[14]); PEER_CX(kk[1], kk[4]); PEER_CX(kk[2], kk[6]); PEER_CX(kk[5], kk[8]); PEER_CX(kk[7], kk[10]); PEER_CX(kk[9], kk[13]); PEER_CX(kk[11], kk[14]); PEER_CX(kk[2], kk[4]); PEER_CX(kk[3], kk[6]); PEER_CX(kk[9], kk[12]); PEER_CX(kk[11], kk[13]); PEER_CX(kk[3], kk[5]); PEER_CX(kk[6], kk[8]); PEER_CX(kk[7], kk[9]); PEER_CX(kk[10], kk[12]); PEER_CX(kk[3], kk[4]); PEER_CX(kk[5], kk[6]); PEER_CX(kk[7], kk[8]); PEER_CX(kk[9], kk[10]); PEER_CX(kk[11], kk[12]); PEER_CX(kk[6], kk[7]); PEER_CX(kk[8], kk[9]);
#pragma unroll
          for (int e = 0; e < 16; ++e) tk[e] = max(tk[e], kk[15 - e]);
          PEER_CX(tk[0], tk[8]); PEER_CX(tk[1], tk[9]); PEER_CX(tk[2], tk[10]); PEER_CX(tk[3], tk[11]); PEER_CX(tk[4], tk[12]); PEER_CX(tk[5], tk[13]); PEER_CX(tk[6], tk[14]); PEER_CX(tk[7], tk[15]); PEER_CX(tk[0], tk[4]); PEER_CX(tk[1], tk[5]); PEER_CX(tk[2], tk[6]); PEER_CX(tk[3], tk[7]); PEER_CX(tk[8], tk[12]); PEER_CX(tk[9], tk[13]); PEER_CX(tk[10], tk[14]); PEER_CX(tk[11], tk[15]); PEER_CX(tk[0], tk[2]); PEER_CX(tk[1], tk[3]); PEER_CX(tk[4], tk[6]); PEER_CX(tk[5], tk[7]); PEER_CX(tk[8], tk[10]); PEER_CX(tk[9], tk[11]); PEER_CX(tk[12], tk[14]); PEER_CX(tk[13], tk[15]); PEER_CX(tk[0], tk[1]); PEER_CX(tk[2], tk[3]); PEER_CX(tk[4], tk[5]); PEER_CX(tk[6], tk[7]); PEER_CX(tk[8], tk[9]); PEER_CX(tk[10], tk[11]); PEER_CX(tk[12], tk[13]); PEER_CX(tk[14], tk[15]); }
#undef PEER_CX
      LAS float* tvp = TV + (tl * 16 + g) * 16; LAS int* tip = TI + (tl * 16 + g) * 16;
#pragma unroll
      for (int j = 0; j < 16; ++j) { const int k_ = tk[j] & ~127; tvp[j] = __int_as_float(k_ ^ ((k_ >> 31) & 0x7fffffff)); tip[j] = 127 - (tk[j] & 127); } }
    __syncthreads();
    asm volatile("" : "+v"(tid));
    { const int tl = tid >> 4, hh = (tid >> 1) & 7, half = tid & 1;
      const LAS float* s1 = TV + (tl * 16 + 2 * hh) * 16; const LAS float* s2 = s1 + 16; const LAS int* i1 = TI + (tl * 16 + 2 * hh) * 16; const LAS int* i2 = i1 + 16;
      float b2[16];
#pragma unroll
      for (int j = 0; j < 16; ++j) b2[j] = s2[j];
      int tk[16];
#pragma unroll
      for (int j = 0; j < 16; ++j) tk[j] = (int)0x80000000;
#pragma unroll
      for (int ii = 0; ii < 8; ++ii) { const int i = 2 * ii + half; const float a = s1[i];
#pragma unroll
          for (int j = 0; j < 16; ++j) if ((2 * ii + 1) * (j + 1) <= 16) { if (half == 0 || (2 * ii + 2) * (j + 1) <= 16) PEER_INS(PEER_KEY(a + b2[j], 255 - (i * 16 + j), 255)); } }
      { int pk[16];
#pragma unroll
        for (int j = 0; j < 16; ++j) pk[j] = __shfl_xor(tk[j], 1);
#pragma unroll
        for (int j = 0; j < 16; ++j) PEER_INS(pk[j]); }
      if (half == 0) { float e[16], sum = 0.f; const int k0_ = tk[0] & ~255; const float v0 = __int_as_float(k0_ ^ ((k0_ >> 31) & 0x7fffffff));
#pragma unroll
        for (int j = 0; j < 16; ++j) { const int k_ = tk[j] & ~255; const float vj = __int_as_float(k_ ^ ((k_ >> 31) & 0x7fffffff)); e[j] = __builtin_amdgcn_exp2f((vj - v0) * 1.4426950408889634f); sum += e[j]; }
        const float inv = 1.0f / sum;
#pragma unroll
        for (int j = 0; j < 16; ++j) { const int ci = 255 - (tk[j] & 255); SE[tl * 128 + hh * 16 + j] = i1[ci >> 4] * 128 + i2[ci & 15]; SG[tl * 128 + hh * 16 + j] = e[j] * inv; } } }
#undef PEER_KEY
#undef PEER_INS
    __syncthreads();
}
__device__ __forceinline__ void peer_gather(int chunk, const bf16_t* __restrict__ H2, const unsigned char* __restrict__ U, const unsigned char* __restrict__ V,
                                            const float* __restrict__ g2, const float* __restrict__ gf, float* OUT, int tid, const LAS int* SE, const LAS float* SG) {
    asm volatile("" : "+v"(tid));
    const int tok0 = chunk * CH, lane = tid & 63, wave = tid >> 6;
    const rsrc_t rH2 = mk_rsrc(H2, 0x4000000u), rU = mk_rsrc(U, 0x1000000u), rV = mk_rsrc(V, 0x1000000u), rG2 = mk_rsrc(g2, 8192u), rGF = mk_rsrc(gf, 8192u);
#pragma unroll 1
    for (int tt = 0; tt < CH / NWAVES; ++tt) { const int tl = wave * (CH / NWAVES) + tt, tok = tok0 + tl;
      asm volatile("" ::: "memory");
      float hn[32]; float ss = 0.f;
#pragma unroll
      for (int j = 0; j < 2; ++j)
#pragma unroll
          for (int q = 0; q < 4; ++q) { const u32x2 w = ldb64(rH2, ((unsigned)tok * 2048u + 256u * (4 * j + q) + 4u * lane) * 2u);
              const f32x4 a = (f32x4){__uint_as_float(w.x << 16), __uint_as_float(w.x & 0xffff0000u), __uint_as_float(w.y << 16), __uint_as_float(w.y & 0xffff0000u)};
#pragma unroll
              for (int i = 0; i < 4; ++i) { hn[16 * j + 4 * q + i] = a[i]; ss += a[i] * a[i]; } }
      const float rstd = 1.0f / sqrtf(wave_sum(ss) * (1.f / 2048.f) + NORM_EPS);
#pragma unroll
      for (int j = 0; j < 2; ++j)
#pragma unroll
          for (int q = 0; q < 4; ++q) { const f32x4 a = ldf128(rG2, (256u * (4 * j + q) + 4u * lane) * 4u);
#pragma unroll
              for (int i = 0; i < 4; ++i) hn[16 * j + 4 * q + i] *= rstd * a[i]; }
      typedef _Float16 h2_t __attribute__((ext_vector_type(2)));
      h2_t hn16[16]; f32x2 accp[16];
#pragma unroll
      for (int k = 0; k < 16; ++k) { hn16[k] = (h2_t){(_Float16)hn[2 * k], (_Float16)hn[2 * k + 1]}; accp[k] = (f32x2){0.f, 0.f}; }
#define NX 4
#define PEER_LOAD(S, kb) do { _Pragma("unroll") for (int x = 0; x < NX; ++x) { const unsigned o = (unsigned)SE[tl * 128 + (kb) + x] * 1024u + (unsigned)lane * 16u; \
          S##u[x] = ldb128(rU, o); S##v[x] = ldb128(rV, o); } } while (0)
#define PEER_DU(W, k) dd = __builtin_amdgcn_fdot2(__builtin_amdgcn_cvt_scalef32_pk_f16_fp4(W[(k) >> 2], 1.0f, (k) & 3), hn16[k], dd, false);
#define PEER_DV(W, k) accp[k] = __builtin_elementwise_fma(__builtin_amdgcn_cvt_scalef32_pk_f32_fp4(W[(k) >> 2], 1.0f, (k) & 3), c2, accp[k]);
#define PEER_16(M, W) M(W, 0) M(W, 1) M(W, 2) M(W, 3) M(W, 4) M(W, 5) M(W, 6) M(W, 7) M(W, 8) M(W, 9) M(W, 10) M(W, 11) M(W, 12) M(W, 13) M(W, 14) M(W, 15)
#define PEER_COMPUTE(S, kb) do { float d[NX]; \
          _Pragma("unroll") for (int x = 0; x < NX; ++x) { const u32x4 W = S##u[x]; float dd = 0.f; PEER_16(PEER_DU, W) d[x] = dd; } \
          _Pragma("unroll") for (int o = 1; o < 64; o <<= 1) { _Pragma("unroll") for (int x = 0; x < NX; ++x) d[x] += __shfl_xor(d[x], o); } \
          float c[NX]; \
          _Pragma("unroll") for (int x = 0; x < NX; ++x) c[x] = SG[tl * 128 + (kb) + x] * gelu_tanh(d[x] * (1.f / PEER_U_SCALE)) * (1.f / PEER_V_SCALE); \
          _Pragma("unroll") for (int x = 0; x < NX; ++x) { const u32x4 W = S##v[x]; const f32x2 c2 = (f32x2){c[x], c[x]}; PEER_16(PEER_DV, W) } } while (0)
      { u32x4 Au[NX], Av[NX], Bu[NX], Bv[NX];
        PEER_LOAD(A, 0);
#pragma unroll 1
        for (int k = 0; k < 128; k += 2 * NX) {
            PEER_LOAD(B, k + NX); PEER_COMPUTE(A, k);
            { const int kn = min(k + 2 * NX, 128 - NX); PEER_LOAD(A, kn); }
            PEER_COMPUTE(B, k + NX);
        } }
#undef PEER_DU
#undef PEER_DV
#undef PEER_16
#undef NX
#undef PEER_LOAD
#undef PEER_COMPUTE
      asm volatile("" ::: "memory");
      int tok2 = tok, lane2 = lane; asm volatile("" : "+v"(tok2), "+v"(lane2));
      float s2 = 0.f;
#pragma unroll
      for (int j = 0; j < 2; ++j)
#pragma unroll
          for (int q = 0; q < 4; ++q) { const u32x2 w = ldb64(rH2, ((unsigned)tok2 * 2048u + 256u * (4 * j + q) + 4u * lane2) * 2u);
              const f32x4 a = (f32x4){__uint_as_float(w.x << 16), __uint_as_float(w.x & 0xffff0000u), __uint_as_float(w.y << 16), __uint_as_float(w.y & 0xffff0000u)};
#pragma unroll
              for (int i = 0; i < 4; ++i) { const int e_ = 16 * j + 4 * q + i; accp[e_ >> 1][e_ & 1] += a[i]; s2 += accp[e_ >> 1][e_ & 1] * accp[e_ >> 1][e_ & 1]; } }
      const float rf = 1.0f / sqrtf(wave_sum(s2) * (1.f / 2048.f) + NORM_EPS);
#pragma unroll
      for (int j = 0; j < 2; ++j)
#pragma unroll
          for (int q = 0; q < 4; ++q) { const f32x4 a = ldf128(rGF, (256u * (4 * j + q) + 4u * lane2) * 4u); f32x4 oa;
#pragma unroll
              for (int i = 0; i < 4; ++i) { const int e_ = 16 * j + 4 * q + i; oa[i] = accp[e_ >> 1][e_ & 1] * rf * a[i]; }
              float* op = OUT + (size_t)tok2 * 2048 + 256 * (4 * j + q) + 4 * lane2;
              __builtin_nontemporal_store(oa, (GAS f32x4*)op); }
    }
}
}
#ifndef MK_N_LAUNCHES
#define MK_N_LAUNCHES 1
#endif
#define MK_PROBE_PH -1
#define MK_PROBE_DIV 2
constexpr int N_PHASES = 9;
constexpr int N_LAUNCHES = MK_N_LAUNCHES;
struct Args { const float* in[19]; float* out; unsigned char* ws; int ph_lo, ph_hi; };
static_assert(sizeof(Args) == 19 * 8 + 8 + 8 + 8, "no padding");

__global__ void __launch_bounds__(NWAVES * 64, 2) hybrid_fwd(Args args) {
    extern __shared__ __attribute__((aligned(16))) unsigned char lds_raw[];
    Frame F;
    F.lds = (LAS unsigned char*)lds_raw;
    F.MISC = (volatile LAS unsigned*)(F.lds + MISC_OFF);
    F.tid = threadIdx.x; F.lane = F.tid & 63; F.wave = __builtin_amdgcn_readfirstlane(F.tid >> 6);
    F.G = gridDim.x; { const int bx = blockIdx.x; F.vcu = (F.G % 8 == 0) ? (bx % 8) * (F.G / 8) + bx / 8 : bx; }
    F.ws = args.ws; F.out = args.out;
#pragma unroll
    for (int i = 0; i < 19; ++i) F.in[i] = args.in[i];
    for (int u = F.tid; u < (LDS_BYTES - LDSCTL_OFF) / 4; u += NWAVES * 64) ((LAS unsigned*)(F.lds + LDSCTL_OFF))[u] = 0u;
    __syncthreads();
    XcdBarrier bar; bar.bar = (unsigned*)(F.ws + WS_CTL) + CW_BAR; bar.x = 0; bar.st = nullptr;
    if (N_LAUNCHES == 1) bar = xcd_barrier_post((unsigned*)(F.ws + WS_CTL) + CW_BAR, F.MISC + 8);
    const int lo = args.ph_lo, hi = args.ph_hi;
#define IN(k) (lo <= (k) && (k) < hi)
#if MK_PROBE_PH >= 0
    unsigned long long tp0 = (MK_PROBE_PH == 0 || MK_PROBE_PH == 9) ? __builtin_amdgcn_s_memrealtime() : 0ull, tp1 = 0ull;
#define SEAM(k) do { if (IN(k) && IN((k) + 1)) xcd_barrier(bar); if (MK_PROBE_PH == (k)) tp1 = __builtin_amdgcn_s_memrealtime(); if (MK_PROBE_PH == (k) + 1) tp0 = __builtin_amdgcn_s_memrealtime(); } while (0)
#else
#define SEAM(k) do { if (IN(k) && IN((k) + 1)) xcd_barrier(bar); } while (0)
#endif
    const size_t T2048 = (size_t)256 * 2048 * 2, T1024 = (size_t)256 * 1024 * 2, T512 = (size_t)256 * 512 * 2;
    float* cosT = WSP(float, WS_COS); float* sinT = WSP(float, WS_SIN);
    float* ssq_q = WSP(float, WS_SSQ_Q); float* ssq_kv = WSP(float, WS_SSQ_KV); float* ssq2 = WSP(float, WS_SSQ_2);

    if (IN(0)) { p0_prologue<0>(F, F.vcu, F.G); } SEAM(0);
    if (IN(1)) {
        SchedP1 S{F.G, (int)blockIdx.x, (const char*)(F.ws + WS_HN1), (const char*)(F.ws + WS_WIN), (const char*)(F.ws + WS_WVT), T1024};
        EpiP1 E{WSP(unsigned char, WS_NAQ), WSP(unsigned char, WS_NAK), WSP(unsigned char, WS_VT), WSP(unsigned char, WS_CQ), WSP(unsigned char, WS_CKV), WSP(unsigned char, WS_KR), WSP(unsigned char, WS_GA), WSP(unsigned char, WS_GB), ssq_q, ssq_kv, cosT, sinT};
        pg8::gemm_phase<EpiP1, SchedP1, true, -6>(F.lds, 2048, S, E);
        { const int extra = P1_UNITS % F.G, bx = (int)blockIdx.x; if (extra != 0 && bx >= extra) p0_prologue<1>(F, bx - extra, F.G - extra); else if (extra == 0) p0_prologue<1>(F, bx, F.G); }
    } SEAM(1);
    if (IN(2)) {
        LAS float* relb = (LAS float*)F.lds + 64; LAS float* metab = relb + 16 * 15 * 31 + 128; LAS float* wsf = metab + 256 + F.wave * 64;
        for (int i = F.tid; i < 16 * 15 * 31; i += NWAVES * 64) relb[i] = F.in[4][i];
        if (F.tid < 256) metab[F.tid] = F.in[5][F.tid];
        __syncthreads();
        const int gw = F.vcu * NWAVES + F.wave, NGW = F.G * NWAVES;
        Conv cv{F.in[16], F.in[17], WSP(unsigned char, WS_U), WSP(unsigned char, WS_V), F.lds + 65536 + F.wave * 8192, gw, NGW, 2 * 16384, -1, 0};
        for (int task = gw; task < NBATCH * 16 * 32 * 2; task += NGW)
            att::na_task(task, WSP(unsigned char, WS_NAQ), WSP(unsigned char, WS_NAK), WSP(unsigned char, WS_VT), WSP(unsigned char, WS_ONA), relb, metab, wsf, F.lane, cv);
        while (cv.pend >= 0 || cv.next < cv.end) conv_step<0>(cv, F.lane);
        __syncthreads();
    } SEAM(2);
    if (IN(3)) {
        SchedP3 S{F.G, (int)blockIdx.x, (const char*)F.ws, T512 / 2};
        EpiP3 E{WSP(unsigned char, WS_QM), WSP(unsigned char, WS_KN), WSP(unsigned char, WS_VV), ssq_q, ssq_kv, cosT, sinT};
        pg8::gemm_phase<EpiP3, SchedP3, true, -4>(F.lds, 512, S, E);
    } SEAM(3);
    if (IN(4)) {
        for (int id = F.vcu; id < NBATCH * 16 * 8; id += F.G) { const int bh = id >> 3, qb = id & 7;
            att::mla_unit8(bh >> 4, bh & 15, qb, WSP(unsigned char, WS_QM), WSP(unsigned char, WS_KN), WSP(unsigned char, WS_KR), WSP(unsigned char, WS_VV), WSP(unsigned char, WS_OMLA), (LAS char*)F.lds); }
        __syncthreads();
    } SEAM(4);
    if (IN(5)) {
        { SchedGrid S{F.G, (int)blockIdx.x, 64, 8, (const char*)(F.ws + WS_ONA), (const char*)(F.ws + WS_WNA), T512};
          EpiP5a E{WSP(unsigned char, WS_GA), WSP(unsigned char, WS_T1)};
          pg8::gemm_phase<EpiP5a, SchedGrid, true, -9>(F.lds, 1024, S, E); }
        { SchedGrid S{F.G, (int)blockIdx.x, 64, 8, (const char*)(F.ws + WS_OMLA), (const char*)(F.ws + WS_WMLA), T1024};
          EpiP5b E{WSP(unsigned char, WS_GB), WSP(unsigned char, WS_T1), WSP(unsigned char, WS_MERGED)};
          pg8::gemm_phase<EpiP5b, SchedGrid, true, -11>(F.lds, 2048, S, E); }
    } SEAM(5);
    if (IN(6)) {
        { SchedGrid S{F.G, (int)blockIdx.x, 64, 8, (const char*)(F.ws + WS_MERGED), (const char*)(F.ws + WS_WOUT), T1024};
          EpiP6 E{F.in[0], WSP(bf16_t, WS_H2B), ssq2};
          pg8::gemm_phase<EpiP6, SchedGrid, true, -11>(F.lds, 2048, S, E); }
    } SEAM(6);
    if (IN(7)) {
        SchedGrid S{F.G, (int)blockIdx.x, 64, 8, (const char*)(F.ws + WS_H2B), (const char*)(F.ws + WS_WSC), T2048};
        EpiP7 E{ssq2, WSP(_Float16, WS_SC)};
        pg8::gemm_phase<EpiP7, SchedGrid>(F.lds, 2048, S, E);
    } SEAM(7);
    if (IN(8)) {
        const int nch = (MREAL / peer::CH - F.vcu + F.G - 1) / F.G; const bool both_first = (nch == 2) && (F.vcu & 1);
        for (int op = 0; op < 2 * nch; ++op) {
            const bool sel = both_first ? (op < 2) : !(op & 1); const int ci = both_first ? (op & 1) : (op >> 1), chunk = F.vcu + ci * F.G;
            const int b2 = both_first ? ci : 0;
            LAS int* SE = (LAS int*)(F.lds + (b2 ? peer::OFF_SE2 : peer::OFF_SE)); LAS float* SG = (LAS float*)(F.lds + (b2 ? peer::OFF_SG2 : peer::OFF_SG));
            if (sel) peer::peer_select(chunk, WSP(_Float16, WS_SC), (LAS char*)F.lds, F.tid, SE, SG);
            else peer::peer_gather(chunk, WSP(bf16_t, WS_H2B), WSP(unsigned char, WS_U), WSP(unsigned char, WS_V), F.in[13], F.in[18], F.out, F.tid, SE, SG); }
    }
#if MK_PROBE_PH >= 0
    xcd_barrier(bar); tp1 = (MK_PROBE_PH >= 8) ? __builtin_amdgcn_s_memrealtime() : tp1;
    if (blockIdx.x == 0 && F.tid == 0) F.out[0] = (float)(tp1 - tp0) * (0.01f / MK_PROBE_DIV);
#endif
#undef IN
#undef SEAM
}

extern "C" void kernel_launch(void* const* d_in, const int* in_sizes, int n_in, void* d_out, int out_size, void* d_ws, size_t ws_size, hipStream_t stream) {
    static int grid = 0;
    if (grid == 0) {
        if (n_in != 19 || in_sizes[0] != MREAL * DM || out_size != MREAL * DM || ws_size < WS_END) {
            fprintf(stderr, "kernel_launch: shape/workspace mismatch: n_in %d in0 %d out %d ws %zu (need %zu); nothing launched\n", n_in, n_in > 0 ? in_sizes[0] : -1, out_size, ws_size, (size_t)WS_END); grid = -1; return; }
        int dev = 0, cus = 0, per_cu = 0;
        if (hipGetDevice(&dev) != hipSuccess || hipDeviceGetAttribute(&cus, hipDeviceAttributeMultiprocessorCount, dev) != hipSuccess) { fprintf(stderr, "kernel_launch: device query failed\n"); grid = -1; return; }
        if (hipFuncSetAttribute((const void*)hybrid_fwd, hipFuncAttributeMaxDynamicSharedMemorySize, LDS_BYTES) != hipSuccess) { fprintf(stderr, "kernel_launch: hipFuncSetAttribute failed\n"); grid = -1; return; }
        if (hipOccupancyMaxActiveBlocksPerMultiprocessor(&per_cu, (const void*)hybrid_fwd, NWAVES * 64, LDS_BYTES) != hipSuccess || per_cu < 1)
            fprintf(stderr, "kernel_launch: note: occupancy query reports %d workgroups per CU\n", per_cu);
        (void)hipGetLastError();
        grid = cus;
    }
    if (grid < 0) return;
    if (hipMemsetAsync((char*)d_ws + WS_CTL, 0, CTL_ZERO_BYTES, stream) != hipSuccess) { fprintf(stderr, "kernel_launch: hipMemsetAsync failed\n"); return; }
    Args a{};
    for (int i = 0; i < 19; ++i) a.in[i] = (const float*)d_in[i];
    a.out = (float*)d_out; a.ws = (unsigned char*)d_ws;
    for (int li = 0; li < N_LAUNCHES; ++li) {
        a.ph_lo = (N_LAUNCHES == 1) ? 0 : li; a.ph_hi = (N_LAUNCHES == 1) ? N_PHASES : li + 1;
        hipLaunchKernelGGL(hybrid_fwd, dim3(grid), dim3(NWAVES * 64), LDS_BYTES, stream, a);
        const hipError_t le = hipPeekAtLastError();
        if (le != hipSuccess) { fprintf(stderr, "kernel_launch: launch %d failed: %s\n", li, hipGetErrorName(le)); break; }
    }
}
```

```cpp
#include <hip/hip_runtime.h>
#include <cstdio>
#include <cstdint>

#define LAS __attribute__((address_space(3)))
#define GAS __attribute__((address_space(1)))
typedef unsigned short bf16_t;
typedef short bf16x8 __attribute__((ext_vector_type(8)));
typedef short s16x4 __attribute__((ext_vector_type(4)));
typedef float f32x4 __attribute__((ext_vector_type(4)));
typedef float f32x2 __attribute__((ext_vector_type(2)));
typedef float f32x16 __attribute__((ext_vector_type(16)));
typedef unsigned u32x4 __attribute__((ext_vector_type(4)));
typedef unsigned u32x2 __attribute__((ext_vector_type(2)));

constexpr int DM = 2048, NBATCH = 8, SEQ = 2048, NMETA = 16;
constexpr int MREAL = NBATCH * SEQ;
constexpr int MPAD = MREAL + 256;
constexpr int NPOS = SEQ + NMETA;
constexpr float NORM_EPS = 1e-6f;
constexpr int C_NAQ = 0, C_NAK = 1024, C_CQ = 2048, C_CKV = 2560, C_GA = 3072, C_GB = 5120, C_KR = 7168, NMAIN = 7424;
constexpr int VT_PITCH = MPAD;

constexpr size_t MiB = 1u << 20;
constexpr size_t WS_CTL = 0, CTL_ZERO_BYTES = 1 * MiB;
constexpr size_t WS_SSQ_Q = 481 * MiB, WS_SSQ_KV = 482 * MiB, WS_SSQ_2 = 486 * MiB;
constexpr size_t WS_COS = 1 * MiB, WS_SIN = 1 * MiB + 512 * 1024;
constexpr size_t WS_WUQ = 2 * MiB, WS_WUKV = 5 * MiB, WS_WNA = 9 * MiB, WS_WMLA = 13 * MiB, WS_WOUT = 21 * MiB, WS_WSC = 29 * MiB;
constexpr size_t WS_GA = 37 * MiB, WS_GB = 101 * MiB;
constexpr size_t WS_KR = 165 * MiB;
constexpr size_t WS_WIN = 167 * MiB + 256 * 1024, WS_WVT = WS_WIN + 29 * MiB;
constexpr size_t WS_ONA = 190 * MiB;
constexpr size_t WS_NAQ = 222 * MiB, WS_NAK = 254 * MiB, WS_VT = WS_NAK + 32 * MiB + 512 * 1024;
constexpr size_t WS_HN1 = 319 * MiB;
constexpr size_t WS_CQ = 448 * MiB, WS_CKV = 464 * MiB;
constexpr size_t WS_QM = 222 * MiB, WS_KN = 318 * MiB, WS_VV = 383 * MiB;
constexpr size_t WS_OMLA = 448 * MiB;
constexpr size_t WS_MERGED = 222 * MiB, WS_T1 = 286 * MiB;
constexpr size_t WS_H2 = 37 * MiB, WS_H2B = 293 * MiB;
constexpr size_t WS_U = 69 * MiB, WS_V = 133 * MiB;
constexpr size_t WS_SC = 165 * MiB;
constexpr size_t WS_END = 512 * MiB;
static_assert(WS_CKV + (size_t)MPAD * 512 * 2 <= WS_SSQ_Q && WS_SSQ_Q + (size_t)8 * MPAD * 4 <= WS_SSQ_KV && WS_SSQ_KV + (size_t)8 * MPAD * 4 <= 483 * MiB && WS_SSQ_2 + (size_t)32 * MREAL * 4 <= WS_END, "ssq slabs");
static_assert(WS_VT + (size_t)1024 * MPAD * 2 <= WS_HN1 && WS_HN1 + (size_t)MPAD * 2048 * 2 <= WS_CQ && WS_CKV + (size_t)MPAD * 512 * 2 <= WS_END, "map P1");
static_assert(WS_WVT + 4 * MiB <= WS_NAQ && WS_KR + (size_t)MPAD * 64 * 2 <= WS_WIN && WS_ONA + 32 * MiB <= WS_NAQ, "map P1b");
static_assert(WS_QM + 96 * MiB <= WS_KN && WS_KN + 65 * MiB <= WS_VV && WS_VV + 65 * MiB <= WS_OMLA && WS_OMLA + 64 * MiB <= WS_END, "map P3");
static_assert(WS_T1 + 128 * MiB <= WS_OMLA && WS_H2 + 128 * MiB <= WS_KR && WS_SC + 128 * MiB <= WS_H2B && WS_H2B + 64 * MiB <= WS_END, "map P5+");
static_assert(WS_GA + 32 * MiB <= WS_U && WS_U + 24 * MiB <= WS_GB && WS_GB + 32 * MiB <= WS_V && WS_V + 24 * MiB <= WS_KR, "expert tables between the gate codes");

constexpr int CW_BAR = 4096;
constexpr float PEER_U_SCALE = 90.50966799f, PEER_V_SCALE = 5.656854249f;

constexpr int RING_BYTES = 131072;
constexpr int LDSCTL_OFF = RING_BYTES, MISC_OFF = LDSCTL_OFF + 320;
constexpr int LDS_BYTES = 147456;
constexpr int NWAVES = 8;

#define LDS_WAIT() asm volatile("s_waitcnt lgkmcnt(0)" ::: "memory")
#define VM_WAIT() asm volatile("s_waitcnt vmcnt(0)" ::: "memory")
#define SBAR() __builtin_amdgcn_sched_barrier(0)
typedef __bf16 bf16x2_t __attribute__((ext_vector_type(2)));
__device__ __forceinline__ unsigned cvt_pk_bf16(float lo, float hi) { const f32x2 v = {lo, hi}; const bf16x2_t b = __builtin_convertvector(v, bf16x2_t); return __builtin_bit_cast(unsigned, b); }
__device__ __forceinline__ float bf_lo(unsigned w) { return __uint_as_float(w << 16); }
__device__ __forceinline__ float bf_hi(unsigned w) { return __uint_as_float(w & 0xffff0000u); }
__device__ __forceinline__ u32x4 pack8(const f32x4 a, const f32x4 b) { u32x4 w; w.x = cvt_pk_bf16(a[0], a[1]); w.y = cvt_pk_bf16(a[2], a[3]); w.z = cvt_pk_bf16(b[0], b[1]); w.w = cvt_pk_bf16(b[2], b[3]); return w; }
__device__ __forceinline__ u32x2 pack8_fp8(f32x4 a, f32x4 b) {
#pragma unroll
    for (int i = 0; i < 4; ++i) { a[i] = __builtin_fminf(__builtin_fmaxf(a[i], -448.f), 448.f); b[i] = __builtin_fminf(__builtin_fmaxf(b[i], -448.f), 448.f); }
    int w0 = 0, w1 = 0; w0 = __builtin_amdgcn_cvt_pk_fp8_f32(a[0], a[1], w0, false); w0 = __builtin_amdgcn_cvt_pk_fp8_f32(a[2], a[3], w0, true);
    w1 = __builtin_amdgcn_cvt_pk_fp8_f32(b[0], b[1], w1, false); w1 = __builtin_amdgcn_cvt_pk_fp8_f32(b[2], b[3], w1, true); return (u32x2){(unsigned)w0, (unsigned)w1}; }
__device__ __forceinline__ unsigned char f32_to_fp8(float x) { x = __builtin_fminf(__builtin_fmaxf(x, -448.f), 448.f); return (unsigned char)(__builtin_amdgcn_cvt_pk_fp8_f32(x, 0.f, 0, false) & 0xff); }
__device__ __forceinline__ u32x2 pack8_u8(const f32x4 a, const f32x4 b) { u32x2 w; unsigned x = 0u, y = 0u;
    x = __builtin_amdgcn_cvt_pk_u8_f32(a[0] * 255.f, 0u, x); x = __builtin_amdgcn_cvt_pk_u8_f32(a[1] * 255.f, 1u, x); x = __builtin_amdgcn_cvt_pk_u8_f32(a[2] * 255.f, 2u, x); x = __builtin_amdgcn_cvt_pk_u8_f32(a[3] * 255.f, 3u, x);
    y = __builtin_amdgcn_cvt_pk_u8_f32(b[0] * 255.f, 0u, y); y = __builtin_amdgcn_cvt_pk_u8_f32(b[1] * 255.f, 1u, y); y = __builtin_amdgcn_cvt_pk_u8_f32(b[2] * 255.f, 2u, y); y = __builtin_amdgcn_cvt_pk_u8_f32(b[3] * 255.f, 3u, y);
    w.x = x; w.y = y; return w; }
__device__ __forceinline__ unsigned pack4_fp8(f32x4 a) {
#pragma unroll
    for (int i = 0; i < 4; ++i) a[i] = __builtin_fminf(__builtin_fmaxf(a[i], -448.f), 448.f);
    int w0 = 0; w0 = __builtin_amdgcn_cvt_pk_fp8_f32(a[0], a[1], w0, false); w0 = __builtin_amdgcn_cvt_pk_fp8_f32(a[2], a[3], w0, true); return (unsigned)w0; }
__device__ __forceinline__ void unpack8_fp8(const u32x2 w, f32x4& a, f32x4& b) {
    const f32x2 a0 = __builtin_amdgcn_cvt_pk_f32_fp8((int)w.x, false), a1 = __builtin_amdgcn_cvt_pk_f32_fp8((int)w.x, true), b0 = __builtin_amdgcn_cvt_pk_f32_fp8((int)w.y, false), b1 = __builtin_amdgcn_cvt_pk_f32_fp8((int)w.y, true);
    a = (f32x4){a0[0], a0[1], a1[0], a1[1]}; b = (f32x4){b0[0], b0[1], b1[0], b1[1]}; }
__device__ __forceinline__ void unpack8_u8(const u32x2 w, f32x4& a, f32x4& b) { const float k = 1.f / 255.f;
    a = (f32x4){(float)(w.x & 0xffu), (float)((w.x >> 8) & 0xffu), (float)((w.x >> 16) & 0xffu), (float)(w.x >> 24)} * k;
    b = (f32x4){(float)(w.y & 0xffu), (float)((w.y >> 8) & 0xffu), (float)((w.y >> 16) & 0xffu), (float)(w.y >> 24)} * k; }
__device__ __forceinline__ u32x2 pack4(const f32x4 a) { u32x2 w; w.x = cvt_pk_bf16(a[0], a[1]); w.y = cvt_pk_bf16(a[2], a[3]); return w; }
__device__ __forceinline__ float wave_sum(float v) {
#pragma unroll
    for (int o = 1; o < 64; o <<= 1) v += __shfl_xor(v, o);
    return v;
}
__device__ __forceinline__ float sigmoidf_(float x) { return __builtin_amdgcn_rcpf(1.0f + __builtin_amdgcn_exp2f(-1.4426950408889634f * x)); }
__device__ __forceinline__ int crow(int r, int hi) { return (r & 3) + 8 * (r >> 2) + 4 * hi; }
#define PG8_AUX 0
namespace pg8 {
constexpr int BM = 256, BK = 64, HALF = 128, HTB = HALF * BK * 2  , STAGE_BYTES = 8 * HTB, NXCD = 8, WGM = 8;
__host__ __device__ __forceinline__ int lds_byte(int r, int c) { const int st = (r >> 4) * 2 + (c >> 5), rr = r & 15, cc = c & 31, ob = rr * 64 + cc * 2; return st * 1024 + (ob ^ (((ob >> 9) & 1) << 5)); }
__host__ __device__ __forceinline__ void stage_rc(int b, int& R, int& C) { const int st = b / 1024, sb = b % 1024, swz = sb ^ (((sb >> 9) & 1) << 5); R = (st >> 1) * 16 + swz / 64; C = (st & 1) * 32 + (swz % 64) / 2; }
__host__ __device__ __forceinline__ int perm32(int rho) { const int n = rho >> 4, i = rho & 15; return 8 * (i >> 2) + 4 * n + (i & 3); }

struct Unit { int pm, pn, kind; };

__device__ __forceinline__ void grid_order(int L, int nM, int nN, int& pm, int& pn) {
    const int nwg = nM * nN; int wgid = L;
    { const int q = nwg / NXCD, r = nwg % NXCD, xcd = wgid % NXCD, off = wgid / NXCD; wgid = (xcd < r ? xcd * (q + 1) : r * (q + 1) + (xcd - r) * q) + off; }
    const int nig = WGM * nN, gid = wgid / nig, fm = gid * WGM, gsz = (nM - fm) < WGM ? (nM - fm) : WGM;
    pm = fm + ((wgid % nig) % gsz); pn = (wgid % nig) / gsz;
}

typedef int v8i_t __attribute__((ext_vector_type(8)));
template <class Epi, class Sched, bool F8 = false, int F8_SCALE_EXP = 0>
__device__ __forceinline__ void gemm_phase(LAS unsigned char* lds, const int K, const Sched& S, const Epi& E) {
    const int tid = threadIdx.x, wid = __builtin_amdgcn_readfirstlane(tid >> 6), lane = tid & 63, wr = wid >> 2, wc = wid & 3, fr = lane & 15, fq = lane >> 4;
    int f8sa = 0x01010101 * (127 + F8_SCALE_EXP), f8sb = 0x7f7f7f7f; asm volatile("" : "+v"(f8sa), "+v"(f8sb));
    const int Kb = F8 ? K : 2 * K;
    const int nt = Kb / 128;
    unsigned voffA[2], voffB[2];
#pragma unroll
    for (int i = 0; i < 2; ++i) { int R, C; stage_rc(tid * 16 + i * 8192, R, C); const int Rb = Epi::PERM ? ((R & ~31) + perm32(R & 31)) : R;
        voffA[i] = (unsigned)(R * Kb + C * 2); voffB[i] = (unsigned)(Rb * Kb + C * 2); }
    const size_t kstep = (size_t)128;
    const size_t hstep = (size_t)HALF * Kb;
    const unsigned ldsw = (unsigned)wid * 1024u;
    const int aoff = lds_byte(wr * 64 + fr, F8 ? fq * 16 : fq * 8), boff = lds_byte(wc * 32 + fr, F8 ? fq * 16 : fq * 8);
#define PG8_SA(b, h) (((b) * 2 + (h)) * HTB)
#define PG8_SB(b, h) ((4 + (b) * 2 + (h)) * HTB)
#define PG8_STAGE(bufoff, gbase, voff) do { _Pragma("unroll") for (int _i = 0; _i < 2; ++_i) \
        __builtin_amdgcn_global_load_lds((const unsigned*)((const char*)(gbase) + (voff)[_i]), (LAS unsigned*)(lds + (bufoff) + ldsw + _i * 8192), 16, 0, PG8_AUX); } while (0)
#define PG8_LDA(dst, b, h) do { _Pragma("unroll") for (int m = 0; m < 4; ++m) _Pragma("unroll") for (int k = 0; k < 2; ++k) dst[m][k] = *(const LAS bf16x8*)(lds + PG8_SA(b, h) + aoff + m * 2048 + (F8 ? k * 16 : k * 1024)); } while (0)
#define PG8_LDB(dst, b, h) do { _Pragma("unroll") for (int n = 0; n < 2; ++n) _Pragma("unroll") for (int k = 0; k < 2; ++k) dst[n][k] = *(const LAS bf16x8*)(lds + PG8_SB(b, h) + boff + n * 2048 + (F8 ? k * 16 : k * 1024)); } while (0)
#define PG8_F8OP(X) __builtin_bit_cast(v8i_t, __builtin_shufflevector(X[0], X[1], 0, 1, 2, 3, 4, 5, 6, 7, 8, 9, 10, 11, 12, 13, 14, 15))
#define PG8_MMA(ai, bj, At, Bt) do { __builtin_amdgcn_s_setprio(1); \
        if constexpr (F8) { _Pragma("unroll") for (int m = 0; m < 4; ++m) _Pragma("unroll") for (int n = 0; n < 2; ++n) \
            asm volatile("v_mfma_scale_f32_16x16x128_f8f6f4 %0, %1, %2, %0, %3, %4 op_sel_hi:[0,0,0]" : "+v"(acc[ai][bj][m][n]) : "v"(PG8_F8OP(Bt[n])), "v"(PG8_F8OP(At[m])), "v"(f8sa), "v"(f8sb)); } \
        else { _Pragma("unroll") for (int m = 0; m < 4; ++m) _Pragma("unroll") for (int n = 0; n < 2; ++n) _Pragma("unroll") for (int k = 0; k < 2; ++k) \
            acc[ai][bj][m][n] = __builtin_amdgcn_mfma_f32_16x16x32_bf16(Bt[n][k], At[m][k], acc[ai][bj][m][n], 0, 0, 0); } \
        __builtin_amdgcn_s_setprio(0); } while (0)
#define PG8_WAIT_V(n) asm volatile("s_waitcnt vmcnt(" #n ")" ::: "memory")
#define PG8_WAIT_L(n) asm volatile("s_waitcnt lgkmcnt(" #n ")" ::: "memory")
#define PG8_BAR __builtin_amdgcn_s_barrier()
#define PG8_SCHED __builtin_amdgcn_sched_barrier(0)
    Unit cur, nxt; int ui = 0;
    if (!S.next(0, cur)) return;
    f32x4 acc[2][2][4][2];
#pragma unroll
    for (int a = 0; a < 2; ++a)
#pragma unroll
        for (int b = 0; b < 2; ++b)
#pragma unroll
            for (int m = 0; m < 4; ++m)
#pragma unroll
                for (int n = 0; n < 2; ++n) acc[a][b][m][n] = (f32x4){0.f, 0.f, 0.f, 0.f};
    bf16x8 At[4][2], B0[2][2], B1[2][2];
    const char* cA = S.pa(cur); const char* cB = S.pb(cur);
    PG8_STAGE(PG8_SB(0, 0), cB, voffB); PG8_STAGE(PG8_SB(0, 1), cB + hstep, voffB); PG8_STAGE(PG8_SA(0, 0), cA, voffA); PG8_STAGE(PG8_SA(0, 1), cA + hstep, voffA);
    if (wr == 1) PG8_BAR;
    PG8_WAIT_V(2); PG8_BAR;
    PG8_STAGE(PG8_SB(1, 0), cB + kstep, voffB); PG8_STAGE(PG8_SA(1, 0), cA + kstep, voffA); PG8_STAGE(PG8_SB(1, 1), cB + hstep + kstep, voffB);
    PG8_WAIT_V(6); PG8_BAR;
    for (;;) {
        const bool has_next = S.next(ui + 1, nxt);
        const char* nA = has_next ? S.pa(nxt) : cA; const char* nB = has_next ? S.pb(nxt) : cB;
        for (int t = 0; t < nt; t += 2) {
            const bool last = (t == nt - 2);
            const char* a1 = cA + (size_t)(t + 1) * kstep;
            const char* a2 = last ? nA : cA + (size_t)(t + 2) * kstep; const char* b2 = last ? nB : cB + (size_t)(t + 2) * kstep;
            const char* a3 = a2 + kstep; const char* b3 = b2 + kstep;
            PG8_LDB(B0, 0, 0); PG8_LDB(B1, 0, 1); PG8_SCHED; PG8_LDA(At, 0, 0); PG8_STAGE(PG8_SA(1, 1), a1 + hstep, voffA);
            PG8_WAIT_V(8); PG8_WAIT_L(0); PG8_BAR; PG8_MMA(0, 0, At, B0); PG8_MMA(0, 1, At, B1); PG8_BAR; PG8_SCHED;
            PG8_LDA(At, 0, 1); PG8_STAGE(PG8_SB(0, 0), b2, voffB); PG8_STAGE(PG8_SB(0, 1), b2 + hstep, voffB); PG8_STAGE(PG8_SA(0, 0), a2, voffA);
            PG8_WAIT_V(8); PG8_WAIT_L(0); PG8_BAR; PG8_MMA(1, 0, At, B0); PG8_MMA(1, 1, At, B1); PG8_BAR; PG8_SCHED;
            PG8_LDB(B0, 1, 0); PG8_LDB(B1, 1, 1); PG8_SCHED; PG8_LDA(At, 1, 0); PG8_STAGE(PG8_SA(0, 1), a2 + hstep, voffA);
            PG8_WAIT_V(8); PG8_WAIT_L(0); PG8_BAR; PG8_MMA(0, 0, At, B0); PG8_MMA(0, 1, At, B1); PG8_BAR; PG8_SCHED;
            PG8_LDA(At, 1, 1); PG8_STAGE(PG8_SB(1, 0), b3, voffB); PG8_STAGE(PG8_SB(1, 1), b3 + hstep, voffB); PG8_STAGE(PG8_SA(1, 0), a3, voffA);
            PG8_WAIT_V(8); PG8_WAIT_L(0); PG8_BAR; PG8_MMA(1, 0, At, B0); PG8_MMA(1, 1, At, B1); PG8_BAR; PG8_SCHED;
        }
        if (wr == 0) PG8_BAR;
        if constexpr (F8) asm volatile("s_nop 15\n\ts_nop 7" ::: "memory");
        if constexpr (Epi::HAS_PRE) {
            E.pre(cur, (LAS float*)(lds + STAGE_BYTES + 1024), tid); PG8_WAIT_L(0); PG8_BAR; }
        E(acc, cur, wr, wc, fr, fq, (const LAS float*)(lds + STAGE_BYTES + 1024));
        if (!has_next) break;
#pragma unroll
        for (int a = 0; a < 2; ++a)
#pragma unroll
            for (int b = 0; b < 2; ++b)
#pragma unroll
                for (int m = 0; m < 4; ++m)
#pragma unroll
                    for (int n = 0; n < 2; ++n) acc[a][b][m][n] = (f32x4){0.f, 0.f, 0.f, 0.f};
        cur = nxt; cA = nA; cB = nB; ++ui;
        if (wr == 1) PG8_BAR;
    }
    PG8_WAIT_V(0);
    PG8_BAR;
#undef PG8_SA
#undef PG8_SB
#undef PG8_STAGE
#undef PG8_LDA
#undef PG8_LDB
#undef PG8_MMA
#undef PG8_F8OP
#undef PG8_WAIT_V
#undef PG8_WAIT_L
#undef PG8_BAR
#undef PG8_SCHED
}
}
typedef GAS unsigned gu32;
#define RLX_AGENT __ATOMIC_RELAXED, __HIP_MEMORY_SCOPE_AGENT
#define XB_TMO      128
#define XB_XCNT(j)  (256  + 64 * (j))
#define XB_XSUB(j)  (1280 + 64 * (j))
#define XB_XGEN(j)  (2304 + 64 * (j))
#define XB_TOP      3328
#define XB_TOPGEN   3392
#define XCD_BAR_WORDS 3456
#define XB_SPIN_CAP (1u << 18)
__device__ __forceinline__ unsigned xb_ld(unsigned* p)              { return __hip_atomic_load(p, __ATOMIC_RELAXED, __HIP_MEMORY_SCOPE_AGENT); }
__device__ __forceinline__ unsigned xb_add(unsigned* p, unsigned v) { return __hip_atomic_fetch_add(p, v, __ATOMIC_RELAXED, __HIP_MEMORY_SCOPE_AGENT); }
__device__ __forceinline__ unsigned xb_xcc_id() { return (unsigned)__builtin_amdgcn_s_getreg((3 << 11) | 20) & 0xFu; }
#define XB_SPIN(cond, bar) do { unsigned _sp = 0; while (cond) { __builtin_amdgcn_s_sleep(1); \
    if ((++_sp & 255u) == 0u) { if (xb_ld(&(bar)[XB_TMO])) break; if (_sp > XB_SPIN_CAP) { atomicAdd(&(bar)[XB_TMO], 1u); break; } } } } while (0)
struct XcdBarrier { unsigned* bar; unsigned x; volatile LAS unsigned* st; };
__device__ __forceinline__ XcdBarrier xcd_barrier_post(unsigned* bar, volatile LAS unsigned* st) {
    XcdBarrier b; b.bar = bar; b.x = xb_xcc_id(); b.st = st;
    if (threadIdx.x == 0) (void)xb_add(&bar[XB_XCNT(b.x)], 1u);
    return b;
}
__device__ __forceinline__ void xcd_barrier_complete(unsigned* bar, unsigned x, unsigned& nloc, unsigned& nx) {
    const unsigned G = gridDim.x * gridDim.y * gridDim.z;
    unsigned sum, cnt, mine, sp = 0u;
    for (;;) {
        sum = 0u; cnt = 0u; mine = 0u;
#pragma unroll
        for (unsigned j = 0; j < 16; ++j) { const unsigned c = xb_ld(&bar[XB_XCNT(j)]); sum += c; cnt += (c > 0u) ? 1u : 0u; mine = (j == x) ? c : mine; }
        if (sum == G) break;
        __builtin_amdgcn_s_sleep(1);
        if ((++sp & 255u) == 0u) { if (xb_ld(&bar[XB_TMO])) break; if (sp > XB_SPIN_CAP) { atomicAdd(&bar[XB_TMO], 1u); break; } }
    }
    nloc = mine > 0u ? mine : 1u; nx = cnt > 0u ? cnt : 1u;
}
__device__ __forceinline__ void xcd_barrier(const XcdBarrier& b) {
    asm volatile("s_waitcnt vmcnt(0)" ::: "memory");
    __syncthreads();
    if (threadIdx.x == 0) {
        unsigned* bar = b.bar;
        __builtin_amdgcn_s_waitcnt(0);
        unsigned nloc = b.st[0], nx = b.st[1];
        if (nloc == 0u) { xcd_barrier_complete(bar, b.x, nloc, nx); b.st[0] = nloc; b.st[1] = nx; }
        const unsigned old = xb_add(&bar[XB_XSUB(b.x)], 1u);
        const unsigned gen = old / nloc;
        if (old + 1u == (gen + 1u) * nloc) {
            __builtin_amdgcn_fence(__ATOMIC_RELEASE, "agent");
            asm volatile("s_waitcnt vmcnt(0)" ::: "memory");
            const unsigned og = xb_add(&bar[XB_TOP], 1u);
            const unsigned tg = og / nx;
            if (og + 1u == (tg + 1u) * nx) xb_add(&bar[XB_TOPGEN], 1u);
            else XB_SPIN(xb_ld(&bar[XB_TOPGEN]) == tg, bar);
            __builtin_amdgcn_fence(__ATOMIC_ACQUIRE, "agent");
            xb_add(&bar[XB_XGEN(b.x)], 1u);
            asm volatile("s_waitcnt vmcnt(0)" ::: "memory");
        } else {
            XB_SPIN(xb_ld(&bar[XB_XGEN(b.x)]) == gen, bar);
            __builtin_amdgcn_fence(__ATOMIC_ACQUIRE, "agent");
            asm volatile("s_waitcnt vmcnt(0)" ::: "memory");
        }
    }
    __syncthreads();
}
struct Frame {
    LAS unsigned char* lds;
    volatile LAS unsigned* MISC;
    unsigned char* ws;
    int tid, lane, wave;
    int vcu, G;
    const float* in[19];
    float* out;
};
#define WSP(T, off) ((T*)(F.ws + (off)))

typedef float cv16f_t __attribute__((ext_vector_type(16)));
typedef unsigned cv6u_t __attribute__((ext_vector_type(6)));
struct Conv { const float* pu; const float* pv; unsigned char* u8; unsigned char* v8; LAS unsigned char* lbuf; int next, stride, end, pend, tick; };
__device__ __forceinline__ void conv_issue(const Conv& c, int item, int lane) {
    const float* src = ((item >> 14) ? c.pv : c.pu) + (size_t)(item & 16383) * 2048 + 4 * lane;
#pragma unroll
    for (int q = 0; q < 8; ++q) __builtin_amdgcn_global_load_lds((const unsigned*)(src + 256 * q), (LAS unsigned*)(c.lbuf + q * 1024), 16, 0, 0);
}
__device__ __forceinline__ void conv_finish(const Conv& c, int item, int lane) {
    const int isv = item >> 14, row = item & 16383; const float sc = isv ? PEER_V_SCALE : PEER_U_SCALE; unsigned w[4] = {0u, 0u, 0u, 0u};
#define CONV_Q(q) { const f32x4 x = *(const LAS f32x4*)(c.lbuf + (q) * 1024 + lane * 16) * sc; \
        w[(q) >> 1] = __builtin_amdgcn_cvt_scalef32_pk_fp4_f32(w[(q) >> 1], x[0], x[1], 1.0f, (2 * (q)) & 3); w[(q) >> 1] = __builtin_amdgcn_cvt_scalef32_pk_fp4_f32(w[(q) >> 1], x[2], x[3], 1.0f, (2 * (q) + 1) & 3); }
    CONV_Q(0) asm volatile("" : "+v"(w[0]) :: "memory"); CONV_Q(1) asm volatile("" : "+v"(w[0]) :: "memory"); CONV_Q(2) asm volatile("" : "+v"(w[1]) :: "memory"); CONV_Q(3) asm volatile("" : "+v"(w[1]) :: "memory");
    CONV_Q(4) asm volatile("" : "+v"(w[2]) :: "memory"); CONV_Q(5) asm volatile("" : "+v"(w[2]) :: "memory"); CONV_Q(6) asm volatile("" : "+v"(w[3]) :: "memory"); CONV_Q(7)
#undef CONV_Q
    unsigned char* rec = (isv ? c.v8 : c.u8) + (size_t)row * 1024;
    *(GAS u32x4*)(rec + lane * 16) = (u32x4){w[0], w[1], w[2], w[3]};
}
template <int YOUNGER>
__device__ __forceinline__ void conv_step(Conv& c, int lane) {
    if (c.pend >= 0) { if constexpr (YOUNGER == 0) asm volatile("s_waitcnt vmcnt(0)" ::: "memory"); else { static_assert(YOUNGER == 12, "wait count"); asm volatile("s_waitcnt vmcnt(12)" ::: "memory"); }
        conv_finish(c, c.pend, lane); c.pend = -1; asm volatile("s_waitcnt lgkmcnt(0)" ::: "memory"); }
    if (c.next < c.end) { conv_issue(c, c.next, lane); c.pend = c.next; c.next += c.stride; }
}
__device__ __forceinline__ void p0_transpose_item(const float* W, int K, int N, int k0, int n0, bf16_t* WT, int drow, bool rope, const float* gain, LAS float* scr, int lane) {
    { f32x4 v[8]; float gk[8];
#pragma unroll
      for (int i = 0; i < 8; ++i) { const int kk = 8 * i + (lane >> 3); v[i] = *(const GAS f32x4*)(W + (size_t)(k0 + kk) * N + n0 + 4 * (lane & 7)); gk[i] = gain ? gain[k0 + kk] : 1.f; }
#pragma unroll
      for (int i = 0; i < 8; ++i) { const int kk = 8 * i + (lane >> 3); LAS float* d = scr + kk * 33 + 4 * (lane & 7);
#pragma unroll
          for (int e = 0; e < 4; ++e) d[e] = v[i][e] * gk[i]; } }
    LDS_WAIT(); asm volatile("" ::: "memory");
    const int c = lane & 7;
#pragma unroll
    for (int j = 0; j < 4; ++j) { const int n = (lane >> 3) + 8 * j; const LAS float* s = scr + (8 * c) * 33 + n;
        u32x4 o; o.x = cvt_pk_bf16(s[0 * 33], s[1 * 33]); o.y = cvt_pk_bf16(s[2 * 33], s[3 * 33]); o.z = cvt_pk_bf16(s[4 * 33], s[5 * 33]); o.w = cvt_pk_bf16(s[6 * 33], s[7 * 33]);
        const int dr = drow + (rope ? (8 * (n >> 2) + (n & 3)) : n);
        *(GAS u32x4*)(WT + (size_t)dr * K + k0 + 8 * c) = o; }
    LDS_WAIT(); asm volatile("" ::: "memory");
}
__device__ __forceinline__ void p0_transpose_item8(const float* W, int K, int N, int k0, int n0, unsigned char* WT, int drow, bool rope, float scale, LAS float* scr, int lane, const float* gain = nullptr) {
    { f32x4 v[8]; float gk[8];
#pragma unroll
      for (int i = 0; i < 8; ++i) { const int kk = 8 * i + (lane >> 3); v[i] = *(const GAS f32x4*)(W + (size_t)(k0 + kk) * N + n0 + 4 * (lane & 7)); gk[i] = gain ? gain[k0 + kk] * scale : scale; }
#pragma unroll
      for (int i = 0; i < 8; ++i) { const int kk = 8 * i + (lane >> 3); LAS float* d = scr + kk * 33 + 4 * (lane & 7);
#pragma unroll
          for (int e = 0; e < 4; ++e) d[e] = v[i][e] * gk[i]; } }
    LDS_WAIT(); asm volatile("" ::: "memory");
#pragma unroll
    for (int j = 0; j < 2; ++j) { const int q = lane + 64 * j, n = q >> 2, c = q & 3; const LAS float* s = scr + (16 * c) * 33 + n; u32x4 o;
#pragma unroll
        for (int d = 0; d < 4; ++d) { int w = 0; w = __builtin_amdgcn_cvt_pk_fp8_f32(s[(4 * d) * 33], s[(4 * d + 1) * 33], w, false); w = __builtin_amdgcn_cvt_pk_fp8_f32(s[(4 * d + 2) * 33], s[(4 * d + 3) * 33], w, true); o[d] = (unsigned)w; }
        const int dr = drow + (rope ? (8 * (n >> 2) + (n & 3)) : n);
        *(GAS u32x4*)(WT + (size_t)dr * K + k0 + 16 * c) = o; }
    LDS_WAIT(); asm volatile("" ::: "memory");
}
__device__ __forceinline__ void rms_row_to_fp8(const float* xrow, const float* g, unsigned char* orow, int lane) {
    const GAS f32x4* xr = (const GAS f32x4*)xrow + lane; const GAS f32x4* gr = (const GAS f32x4*)g + lane;
    f32x4 v[8]; float s = 0.f;
#pragma unroll
    for (int j = 0; j < 8; ++j) { v[j] = xr[64 * j]; s += (v[j].x * v[j].x + v[j].y * v[j].y) + (v[j].z * v[j].z + v[j].w * v[j].w); }
    const float rstd = 1.0f / sqrtf(wave_sum(s) * (1.f / DM) + NORM_EPS);
    GAS unsigned* o4 = (GAS unsigned*)orow + lane;
#pragma unroll
    for (int j = 0; j < 8; ++j) { const f32x4 y = (v[j] * rstd) * gr[64 * j]; int w = 0; w = __builtin_amdgcn_cvt_pk_fp8_f32(y[0], y[1], w, false); w = __builtin_amdgcn_cvt_pk_fp8_f32(y[2], y[3], w, true); o4[64 * j] = (unsigned)w; }
}
__device__ __forceinline__ void rms_row_to_bf16(const float* xrow, const float* g, bf16_t* orow, int lane) {
    const GAS f32x4* xr = (const GAS f32x4*)xrow + lane; const GAS f32x4* gr = (const GAS f32x4*)g + lane;
    f32x4 v[8]; float s = 0.f;
#pragma unroll
    for (int j = 0; j < 8; ++j) { v[j] = xr[64 * j]; s += (v[j].x * v[j].x + v[j].y * v[j].y) + (v[j].z * v[j].z + v[j].w * v[j].w); }
    const float rstd = 1.0f / sqrtf(wave_sum(s) * (1.f / DM) + NORM_EPS);
    GAS u32x2* o8 = (GAS u32x2*)orow + lane;
#pragma unroll
    for (int j = 0; j < 8; ++j) { const f32x4 gg = gr[64 * j]; o8[64 * j] = pack4((v[j] * rstd) * gg); }
}
template <int PART>
__device__ __forceinline__ void p0_prologue(Frame& F, int rank, int nrank) {
    LAS float* scr = (LAS float*)(F.lds + F.wave * 16384);
    const int gw = rank * NWAVES + F.wave, NGW = nrank * NWAVES, lane = F.lane; const int gt = rank * 512 + F.tid, NGT = nrank * 512;
    unsigned char* WIN = WSP(unsigned char, WS_WIN); unsigned char* WVT = WSP(unsigned char, WS_WVT);
    constexpr int I_IN = 32 * 258, I_UQ = 8 * 96, I_UKV = 8 * 128, I_NA = 16 * 64, I_MLA = 32 * 64, I_OUT = 32 * 64;
    constexpr int NEARLY = I_IN + I_UQ + I_UKV, NITEMS = NEARLY + I_NA + I_MLA + I_OUT;
    for (int it = (PART == 0 ? 0 : NEARLY) + gw; it < (PART == 0 ? NEARLY : NITEMS); it += NGW) {
        int r = it;
        if (r < I_IN) { const int kb = r / 258, sb = r % 258, n0 = 32 * sb, k0 = 64 * kb; const float* W = F.in[3];
            unsigned char* dst = WIN; int drow; bool rope = false;
            if (n0 < 1024) drow = C_NAQ + n0;
            else if (n0 < 2048) drow = C_NAK + (n0 - 1024);
            else if (n0 < 3072) { dst = WVT; drow = n0 - 2048; }
            else if (n0 < 3584) drow = C_CQ + (n0 - 3072);
            else if (n0 < 4096) drow = C_CKV + (n0 - 3584);
            else if (n0 < 4160) { drow = C_KR + ((n0 - 4096) ? 4 : 0); rope = true; }
            else if (n0 < 6208) drow = C_GA + (n0 - 4160);
            else drow = C_GB + (n0 - 6208);
            p0_transpose_item8(W, 2048, 8256, k0, n0, dst, drow, rope, 64.f, scr, lane); continue; } r -= I_IN;
        if (r < I_UQ) { const int kb = r / 96, sb = r % 96, n0 = 32 * sb, k0 = 64 * kb; const int hd = n0 / 192, w = n0 % 192;
            int drow = n0; bool rope = false; if (w >= 128) { rope = true; drow = hd * 192 + 128 + ((w - 128) ? 4 : 0); }
            p0_transpose_item8(F.in[7], 512, 3072, k0, n0, WSP(unsigned char, WS_WUQ), drow, rope, 16.f, scr, lane, F.in[6]); continue; } r -= I_UQ;
        if (r < I_UKV) { const int kb = r / 128, sb = r % 128; const int n0 = 32 * sb, hd = n0 >> 8, w = n0 & 255;
            p0_transpose_item8(F.in[9], 512, 4096, 64 * kb, n0, WSP(unsigned char, WS_WUKV), (w >= 128 ? 2048 : 0) + hd * 128 + (w & 127), false, 16.f, scr, lane, F.in[8]); continue; } r -= I_UKV;
        if (r < I_NA) { const int kb = r / 64, sb = r % 64; p0_transpose_item8(F.in[10], 1024, 2048, 64 * kb, 32 * sb, WSP(unsigned char, WS_WNA), 32 * sb, false, 32.f, scr, lane); continue; } r -= I_NA;
        if (r < I_MLA) { const int kb = r / 64, sb = r % 64; p0_transpose_item8(F.in[11], 2048, 2048, 64 * kb, 32 * sb, WSP(unsigned char, WS_WMLA), 32 * sb, false, 64.f, scr, lane); continue; } r -= I_MLA;
        { const int kb = r / 64, sb = r % 64; p0_transpose_item8(F.in[12], 2048, 2048, 64 * kb, 32 * sb, WSP(unsigned char, WS_WOUT), 32 * sb, false, 64.f, scr, lane); }
    }
    if (PART == 0) { GAS u32x4* z = (GAS u32x4*)(WIN + (size_t)(C_KR + 64) * 2048); const int n16 = (NMAIN - C_KR - 64) * 2048 / 16;
      for (int i = gt; i < n16; i += NGT) z[i] = (u32x4){0u, 0u, 0u, 0u}; }
    if (PART == 0) { unsigned char* HN1 = WSP(unsigned char, WS_HN1);
#define P0_ROWSRC(m_) (((m_) < MREAL) ? F.in[0] + (size_t)(m_) * DM : F.in[1] + (size_t)((m_) - MREAL) * DM)
      { f32x4 v[8]; int m = gw;
        if (m < MREAL + NMETA) { const GAS f32x4* xr = (const GAS f32x4*)P0_ROWSRC(m) + lane;
#pragma unroll
            for (int j = 0; j < 8; ++j) v[j] = xr[64 * j]; }
        const GAS f32x4* gr = (const GAS f32x4*)F.in[2] + lane;
        while (m < MREAL + NMETA) { const int mn = m + NGW; f32x4 vn[8];
            { const int ml = mn < MREAL + NMETA ? mn : m; const GAS f32x4* xr = (const GAS f32x4*)P0_ROWSRC(ml) + lane;
#pragma unroll
              for (int j = 0; j < 8; ++j) vn[j] = xr[64 * j]; }
            float sq = 0.f;
#pragma unroll
            for (int j = 0; j < 8; ++j) sq += (v[j].x * v[j].x + v[j].y * v[j].y) + (v[j].z * v[j].z + v[j].w * v[j].w);
            const float rstd = 1.0f / sqrtf(wave_sum(sq) * (1.f / DM) + NORM_EPS);
            GAS unsigned* o4 = (GAS unsigned*)(HN1 + (size_t)m * DM) + lane;
#pragma unroll
            for (int j = 0; j < 8; ++j) { const f32x4 y = (v[j] * rstd) * gr[64 * j]; int w = 0; w = __builtin_amdgcn_cvt_pk_fp8_f32(y[0], y[1], w, false); w = __builtin_amdgcn_cvt_pk_fp8_f32(y[2], y[3], w, true); o4[64 * j] = (unsigned)w; }
#pragma unroll
            for (int j = 0; j < 8; ++j) v[j] = vn[j];
            m = mn; } }
#undef P0_ROWSRC
      GAS u32x4* z = (GAS u32x4*)(HN1 + (size_t)(MREAL + NMETA) * DM); const int n16 = (MPAD - MREAL - NMETA) * DM / 16;
      for (int i = gt; i < n16; i += NGT) z[i] = (u32x4){0u, 0u, 0u, 0u}; }
    if (PART == 0) { float* ct = WSP(float, WS_COS); float* st = WSP(float, WS_SIN);
      for (int i = gt; i < NPOS * 32; i += NGT) { const int p = i >> 5, j = i & 31;
          const float inv = __builtin_powf(10000.0f, -(float)(2 * j) / 64.0f); const float ang = (float)p * inv;
          double r = (double)ang * 0.15915494309189535; r -= __builtin_rint(r); const float rf = (float)r;
          ct[i] = __builtin_amdgcn_cosf(rf); st[i] = __builtin_amdgcn_sinf(rf); } }
    if (PART == 1) { const float* SK = F.in[15]; const float* WQ = F.in[14]; const float* g2 = F.in[13]; bf16_t* WSCp = WSP(bf16_t, WS_WSC);
      const int l15 = lane & 15, l4 = lane >> 4;
      for (int task = gw; task < 2048; task += NGW) { const int g = task >> 7, nt = (task >> 4) & 7, kc = task & 15, n0 = nt * 16;
          bf16x8 bfr[4];
#pragma unroll
          for (int kk = 0; kk < 4; ++kk) { const float* p = SK + ((size_t)g * 128 + n0 + l15) * 128 + 32 * kk + 8 * l4; const f32x4 a = *(const GAS f32x4*)p, b = *(const GAS f32x4*)(p + 4);
              const u32x4 w = pack8(a, b); bfr[kk] = __builtin_bit_cast(bf16x8, w); }
          for (int kt = 0; kt < 8; ++kt) { const int k0 = (kc * 8 + kt) * 16; f32x4 acc = (f32x4){0.f, 0.f, 0.f, 0.f};
#pragma unroll
              for (int kk = 0; kk < 4; ++kk) { const float* p = WQ + (size_t)(k0 + l15) * 2048 + g * 128 + 32 * kk + 8 * l4; const f32x4 a = *(const GAS f32x4*)p, b = *(const GAS f32x4*)(p + 4);
                  const u32x4 w = pack8(a, b); acc = __builtin_amdgcn_mfma_f32_16x16x32_bf16(__builtin_bit_cast(bf16x8, w), bfr[kk], acc, 0, 0, 0); }
              const f32x4 gg = *(const GAS f32x4*)(g2 + k0 + 4 * l4);
              *(GAS u32x2*)(WSCp + (size_t)(g * 128 + n0 + l15) * 2048 + k0 + 4 * l4) = pack4(acc * gg); } } }
}
using pg8::Unit;
struct SchedGrid {
    int G, c, nM, nN; const char* A; const char* B; size_t tstep;
    __device__ __forceinline__ bool next(int i, Unit& u) const { const int L = i * G + c; if (L >= nM * nN) return false; pg8::grid_order(L, nM, nN, u.pm, u.pn); u.kind = 0; return true; }
    __device__ __forceinline__ const char* pa(const Unit& u) const { return A + (size_t)u.pm * tstep; }
    __device__ __forceinline__ const char* pb(const Unit& u) const { return B + (size_t)u.pn * tstep; }
};
constexpr int P1_MAIN = 64 * 29, P1_VT = 4 * 65, P1_META = 7, P1_UNITS = P1_MAIN + P1_VT + P1_META;
struct SchedP1 {
    int G, c; const char* hn1; const char* win; const char* wvt; size_t tstep;
    __device__ __forceinline__ bool next(int i, Unit& u) const {
        const int L = i * G + c; if (L >= P1_UNITS) return false;
        if (L < P1_MAIN) { pg8::grid_order(L, 64, 29, u.pm, u.pn); u.kind = 0; }
        else if (L < P1_MAIN + P1_VT) { const int idx = L - P1_MAIN; u.pm = idx & 3; u.pn = idx >> 2; u.kind = 1; }
        else { const int idx = L - P1_MAIN - P1_VT; u.pm = 64; u.pn = idx < 4 ? 4 + idx : (idx < 6 ? 10 + (idx - 4) : 28); u.kind = 0; }
        return true; }
    __device__ __forceinline__ const char* pa(const Unit& u) const { return (u.kind == 1 ? wvt : hn1) + (size_t)u.pm * tstep; }
    __device__ __forceinline__ const char* pb(const Unit& u) const { return (u.kind == 1 ? hn1 : win) + (size_t)u.pn * tstep; }
};
__device__ __forceinline__ void rope4(const f32x4 x1, const f32x4 x2, const float* cosT, const float* sinT, int pos, int j0, f32x4& lo, f32x4& hi) {
    const f32x4 c = *(const GAS f32x4*)(cosT + pos * 32 + j0), s = *(const GAS f32x4*)(sinT + pos * 32 + j0);
    lo = x1 * c - x2 * s; hi = x2 * c + x1 * s;
}
struct EpiP1 {
    static constexpr bool PERM = true, HAS_PRE = false;
    unsigned char *naq, *nak, *vt; unsigned char *cq, *ckv; unsigned char *kr; unsigned char *ga, *gb; float *ssq_q, *ssq_kv; const float *cosT, *sinT;
    __device__ __forceinline__ void operator()(const f32x4 (&acc)[2][2][4][2], const Unit& u, int wr, int wc, int fr, int fq, const LAS float* rowsc) const {
        const int row0 = u.pm * 256 + wr * 64 + fr, colu = wc * 32 + 8 * fq;
        if (u.kind == 1) {
#pragma unroll
            for (int bj = 0; bj < 2; ++bj) { const int t0 = u.pn * 256 + bj * 128 + colu, pos = (t0 & ~63) + ((t0 & 63) >> 1);
#pragma unroll
                for (int ai = 0; ai < 2; ++ai)
#pragma unroll
                    for (int m = 0; m < 4; ++m) { unsigned char* rp = vt + (size_t)(row0 + ai * 128 + m * 16) * VT_PITCH + pos;
                        *(GAS unsigned*)rp = pack4_fp8(acc[ai][bj][m][0]); *(GAS unsigned*)(rp + 32) = pack4_fp8(acc[ai][bj][m][1]); } }
            return; }
        const int pn = u.pn;
        if (pn == 28) {
            if (wc < 2) { const int j0 = 4 * (4 * wc + fq);
#pragma unroll
                for (int ai = 0; ai < 2; ++ai)
#pragma unroll
                    for (int m = 0; m < 4; ++m) { const int row = row0 + ai * 128 + m * 16; const int pos = row < MREAL ? NMETA + (row & (SEQ - 1)) : row - MREAL;
                        f32x4 lo, hi; rope4(acc[ai][0][m][0], acc[ai][0][m][1], cosT, sinT, pos, j0, lo, hi);
                        *(GAS unsigned*)(kr + (size_t)row * 64 + j0) = pack4_fp8(lo); *(GAS unsigned*)(kr + (size_t)row * 64 + 32 + j0) = pack4_fp8(hi); } }
            return; }
        if (pn >= 12) {
            unsigned char* base = pn < 20 ? ga : gb; const int colt = (pn < 20 ? pn - 12 : pn - 20) * 256 + colu;
#pragma unroll
            for (int ai = 0; ai < 2; ++ai)
#pragma unroll
                for (int m = 0; m < 4; ++m) { unsigned char* rp = base + (size_t)(row0 + ai * 128 + m * 16) * 2048 + colt;
#pragma unroll
                    for (int bj = 0; bj < 2; ++bj) { f32x4 a = acc[ai][bj][m][0], b = acc[ai][bj][m][1];
#pragma unroll
                        for (int i = 0; i < 4; ++i) { a[i] = sigmoidf_(a[i]); b[i] = sigmoidf_(b[i]); }
                        *(GAS u32x2*)(rp + bj * 128) = pack8_u8(a, b); } }
            return; }
        if (pn >= 8) {
            const bool isq = pn < 10; unsigned char* base = isq ? cq : ckv; float* ssq = isq ? ssq_q : ssq_kv; const int colt = (isq ? pn - 8 : pn - 10) * 256 + colu;
#pragma unroll
            for (int ai = 0; ai < 2; ++ai)
#pragma unroll
                for (int m = 0; m < 4; ++m) { const int row = row0 + ai * 128 + m * 16; unsigned char* rp = base + (size_t)row * 512 + colt; float s = 0.f;
#pragma unroll
                    for (int bj = 0; bj < 2; ++bj) { const f32x4 a = acc[ai][bj][m][0], b = acc[ai][bj][m][1];
                        s += (a[0] * a[0] + a[1] * a[1]) + (a[2] * a[2] + a[3] * a[3]) + (b[0] * b[0] + b[1] * b[1]) + (b[2] * b[2] + b[3] * b[3]);
                        *(GAS u32x2*)(rp + bj * 128) = pack8_fp8(a, b); }
                    s += __shfl_xor(s, 16); s += __shfl_xor(s, 32);
                    if (fq == 0) ssq[(size_t)((pn & 1) * 4 + wc) * MPAD + row] = s; }
            return; }
        {
            unsigned char* base = pn < 4 ? naq : nak; const int colt = (pn & 3) * 256 + colu;
#pragma unroll
            for (int ai = 0; ai < 2; ++ai)
#pragma unroll
                for (int m = 0; m < 4; ++m) { unsigned char* rp = base + (size_t)(row0 + ai * 128 + m * 16) * 1024 + colt;
#pragma unroll
                    for (int bj = 0; bj < 2; ++bj) *(GAS u32x2*)(rp + bj * 128) = pack8_fp8(acc[ai][bj][m][0], acc[ai][bj][m][1]); }
        }
    }
};
constexpr int P3_Q = 64 * 12, P3_K = 65 * 8, P3_V = 8 * 65, P3_UNITS = P3_Q + P3_K + P3_V;
struct SchedP3 {
    int G, c; const char* ws; size_t tstep;
    __device__ __forceinline__ bool next(int i, Unit& u) const {
        const int L = i * G + c; if (L >= P3_UNITS) return false;
        if (L < P3_Q) { pg8::grid_order(L, 64, 12, u.pm, u.pn); u.kind = 0; }
        else if (L < P3_Q + P3_K) { pg8::grid_order(L - P3_Q, 65, 8, u.pm, u.pn); u.kind = 1; }
        else { const int idx = L - P3_Q - P3_K; u.pm = idx & 7; u.pn = idx >> 3; u.kind = 2; }
        return true; }
    __device__ __forceinline__ const char* pa(const Unit& u) const { const size_t o = u.kind == 0 ? WS_CQ : (u.kind == 1 ? WS_CKV : WS_WUKV + (size_t)2048 * 512); return ws + o + (size_t)u.pm * tstep; }
    __device__ __forceinline__ const char* pb(const Unit& u) const { const size_t o = u.kind == 0 ? WS_WUQ : (u.kind == 1 ? WS_WUKV : WS_CKV); return ws + o + (size_t)u.pn * tstep; }
};
template <int NS, int LD> __device__ __forceinline__ float rstd_slabs(const float* part, int row, float invn) {
    float s = 0.f;
#pragma unroll
    for (int i = 0; i < NS; ++i) s += part[(size_t)i * LD + row];
    return 1.0f / sqrtf(s * invn + NORM_EPS);
}
struct EpiP3 {
    static constexpr bool PERM = true, HAS_PRE = true;
    unsigned char *qm, *kn, *vt; const float *ssq_q, *ssq_kv; const float *cosT, *sinT;
    __device__ __forceinline__ void pre(const Unit& u, LAS float* sc, int tid) const { if (tid < 256) { const int row = (u.kind == 2 ? u.pn : u.pm) * 256 + tid; sc[tid] = u.kind ? rstd_slabs<8, MPAD>(ssq_kv, row, 1.f / 512.f) : rstd_slabs<8, MPAD>(ssq_q, row, 1.f / 512.f); } }
    __device__ __forceinline__ void operator()(const f32x4 (&acc)[2][2][4][2], const Unit& u, int wr, int wc, int fr, int fq, const LAS float* rowsc) const {
        const int row0 = u.pm * 256 + wr * 64 + fr, colu = wc * 32 + 8 * fq;
        if (u.kind == 2) {
#pragma unroll
            for (int bj = 0; bj < 2; ++bj) { const int cl = bj * 128 + colu, t0 = u.pn * 256 + cl;
                const f32x4 s0 = *(const LAS f32x4*)(rowsc + cl), s1 = *(const LAS f32x4*)(rowsc + cl + 4);
                const int g = (t0 >> 3) & 7, pos = (t0 & ~63) + 16 * (g >> 2) + 4 * (g & 3);
#pragma unroll
                for (int ai = 0; ai < 2; ++ai)
#pragma unroll
                    for (int m = 0; m < 4; ++m) { unsigned char* rp = vt + (size_t)(row0 + ai * 128 + m * 16) * MPAD + pos;
                        *(GAS unsigned*)rp = pack4_fp8(acc[ai][bj][m][0] * s0); *(GAS unsigned*)(rp + 32) = pack4_fp8(acc[ai][bj][m][1] * s1); } }
            return; }
        if (u.kind == 1) {
#pragma unroll
            for (int ai = 0; ai < 2; ++ai)
#pragma unroll
                for (int m = 0; m < 4; ++m) { const int row = row0 + ai * 128 + m * 16; const float rs = rowsc[ai * 128 + wr * 64 + m * 16 + fr];
                    unsigned char* rp = kn + (size_t)row * 2048 + u.pn * 256 + colu;
#pragma unroll
                    for (int bj = 0; bj < 2; ++bj) *(GAS u32x2*)(rp + bj * 128) = pack8_fp8(acc[ai][bj][m][0] * rs, acc[ai][bj][m][1] * rs); }
            return; }
#pragma unroll
        for (int bj = 0; bj < 2; ++bj) { const int c8 = u.pn * 256 + bj * 128 + colu; const int hd = c8 / 192, w = c8 - hd * 192;
            if (w < 128) {
#pragma unroll
                for (int ai = 0; ai < 2; ++ai)
#pragma unroll
                    for (int m = 0; m < 4; ++m) { const int row = row0 + ai * 128 + m * 16; const float rs = rowsc[ai * 128 + wr * 64 + m * 16 + fr];
                        *(GAS u32x2*)(qm + (size_t)row * 3072 + c8) = pack8_fp8(acc[ai][bj][m][0] * rs, acc[ai][bj][m][1] * rs); }
            } else { const int j0 = (w - 128) >> 1;
#pragma unroll
                for (int ai = 0; ai < 2; ++ai)
#pragma unroll
                    for (int m = 0; m < 4; ++m) { const int row = row0 + ai * 128 + m * 16; const float rs = rowsc[ai * 128 + wr * 64 + m * 16 + fr];
                        const int pos = NMETA + (row & (SEQ - 1)); f32x4 lo, hi; rope4(acc[ai][bj][m][0] * rs, acc[ai][bj][m][1] * rs, cosT, sinT, pos, j0, lo, hi);
                        unsigned char* qp = qm + (size_t)row * 3072 + hd * 192 + 128 + j0; *(GAS unsigned*)qp = pack4_fp8(lo); *(GAS unsigned*)(qp + 32) = pack4_fp8(hi); }
            } }
    }
};

__device__ __forceinline__ void unpack8(const u32x4 w, f32x4& a, f32x4& b) { a = (f32x4){bf_lo(w.x), bf_hi(w.x), bf_lo(w.y), bf_hi(w.y)}; b = (f32x4){bf_lo(w.z), bf_hi(w.z), bf_lo(w.w), bf_hi(w.w)}; }
struct EpiP5a {
    static constexpr bool PERM = true, HAS_PRE = false;
    const unsigned char* ga; unsigned char* t1;
    __device__ __forceinline__ void operator()(const f32x4 (&acc)[2][2][4][2], const Unit& u, int wr, int wc, int fr, int fq, const LAS float* rowsc) const {
        const int row0 = u.pm * 256 + wr * 64 + fr, col0 = u.pn * 256 + wc * 32 + 8 * fq;
#pragma unroll
        for (int ai = 0; ai < 2; ++ai)
#pragma unroll
            for (int m = 0; m < 4; ++m) { const size_t off = (size_t)(row0 + ai * 128 + m * 16) * 2048 + col0;
#pragma unroll
                for (int bj = 0; bj < 2; ++bj) { f32x4 g0, g1; unpack8_u8(*(const GAS u32x2*)(ga + off + bj * 128), g0, g1);
                    *(GAS u32x2*)(t1 + off + bj * 128) = pack8_fp8(acc[ai][bj][m][0] * g0 * 32.f, acc[ai][bj][m][1] * g1 * 32.f); } }
    }
};
struct EpiP5b {
    static constexpr bool PERM = true, HAS_PRE = false;
    const unsigned char* gb; const unsigned char* t1; unsigned char* merged;
    __device__ __forceinline__ void operator()(const f32x4 (&acc)[2][2][4][2], const Unit& u, int wr, int wc, int fr, int fq, const LAS float* rowsc) const {
        const int row0 = u.pm * 256 + wr * 64 + fr, col0 = u.pn * 256 + wc * 32 + 8 * fq;
#pragma unroll
        for (int ai = 0; ai < 2; ++ai)
#pragma unroll
            for (int m = 0; m < 4; ++m) { const size_t off = (size_t)(row0 + ai * 128 + m * 16) * 2048 + col0;
#pragma unroll
                for (int bj = 0; bj < 2; ++bj) { f32x4 g0, g1; unpack8_u8(*(const GAS u32x2*)(gb + off + bj * 128), g0, g1);
                    f32x4 a, b; unpack8_fp8(*(const GAS u32x2*)(t1 + off + bj * 128), a, b);
                    *(GAS u32x2*)(merged + off + bj * 128) = pack8_fp8(a + acc[ai][bj][m][0] * g0 * 32.f, b + acc[ai][bj][m][1] * g1 * 32.f); } }
    }
};
struct EpiP6 {
    static constexpr bool PERM = true, HAS_PRE = false;
    const float* x; bf16_t* h2b; float* ssq2;
    __device__ __forceinline__ void operator()(const f32x4 (&acc)[2][2][4][2], const Unit& u, int wr, int wc, int fr, int fq, const LAS float* rowsc) const {
        const int row0 = u.pm * 256 + wr * 64 + fr, col0 = u.pn * 256 + wc * 32 + 8 * fq;
#pragma unroll
        for (int ai = 0; ai < 2; ++ai)
#pragma unroll
            for (int m = 0; m < 4; ++m) { const int row = row0 + ai * 128 + m * 16; const size_t off = (size_t)row * 2048 + col0; float s = 0.f;
#pragma unroll
                for (int bj = 0; bj < 2; ++bj) { const f32x4 a = *(const GAS f32x4*)(x + off + bj * 128) + acc[ai][bj][m][0], b = *(const GAS f32x4*)(x + off + bj * 128 + 4) + acc[ai][bj][m][1];
                    s += (a[0] * a[0] + a[1] * a[1]) + (a[2] * a[2] + a[3] * a[3]) + (b[0] * b[0] + b[1] * b[1]) + (b[2] * b[2] + b[3] * b[3]);
                    *(GAS u32x4*)(h2b + off + bj * 128) = pack8(a, b); }
                s += __shfl_xor(s, 16); s += __shfl_xor(s, 32);
                if (fq == 0) ssq2[(size_t)(u.pn * 4 + wc) * MREAL + row] = s; }
    }
};
struct EpiP7 {
    static constexpr bool PERM = true, HAS_PRE = true;
    const float* ssq2; _Float16* sc;
    __device__ __forceinline__ void pre(const Unit& u, LAS float* sc, int tid) const { if (tid < 256) sc[tid] = rstd_slabs<32, MREAL>(ssq2, u.pm * 256 + tid, 1.f / 2048.f); }
    __device__ __forceinline__ void operator()(const f32x4 (&acc)[2][2][4][2], const Unit& u, int wr, int wc, int fr, int fq, const LAS float* rowsc) const {
        typedef _Float16 h4_t __attribute__((ext_vector_type(4)));
        const int row0 = u.pm * 256 + wr * 64 + fr, col0 = u.pn * 256 + wc * 32 + 8 * fq;
#pragma unroll
        for (int ai = 0; ai < 2; ++ai)
#pragma unroll
            for (int m = 0; m < 4; ++m) { const int row = row0 + ai * 128 + m * 16; const float rs = rowsc[ai * 128 + wr * 64 + m * 16 + fr]; const size_t off = (size_t)row * 2048 + col0;
#pragma unroll
                for (int bj = 0; bj < 2; ++bj) { const h4_t lo = __builtin_convertvector(acc[ai][bj][m][0] * rs, h4_t), hi = __builtin_convertvector(acc[ai][bj][m][1] * rs, h4_t);
                    const u32x2 wl = __builtin_bit_cast(u32x2, lo), wh = __builtin_bit_cast(u32x2, hi);
                    *(GAS u32x4*)(sc + off + bj * 128) = (u32x4){wl.x, wl.y, wh.x, wh.y}; } }
    }
};
namespace att {
#define KSWZ(row, colB) ((row) * 256 + ((colB) ^ (((row) & 7) << 4)))
#define KRSWZ(row, colB) ((row) * 128 + ((colB) ^ ((((row) >> 1) & 7) << 4)))
constexpr float L2E = 1.4426950408889634f;
template <int DUMMY = 0>
__device__ __forceinline__ void partialSM(f32x16& p0, f32x16& p1, float& m_reg, float& mn, float& alpha, const float C, const float THRS) {
  float pmax = p0[0];
#pragma unroll
  for (int r = 1; r < 16; ++r) pmax = fmaxf(pmax, p0[r]);
#pragma unroll
  for (int r = 0; r < 16; ++r) pmax = fmaxf(pmax, p1[r]);
  { auto rr = __builtin_amdgcn_permlane32_swap(__float_as_uint(pmax), __float_as_uint(pmax), false, false);
    pmax = fmaxf(__uint_as_float(rr[0]), __uint_as_float(rr[1])); }
  if (__builtin_expect(__all(pmax - m_reg <= THRS), 1)) { mn = m_reg; alpha = 1.f; }
  else { mn = fmaxf(m_reg, pmax); alpha = __builtin_amdgcn_exp2f((m_reg - mn) * C); m_reg = mn; }
  const float mnC = -mn * C;
#pragma unroll
  for (int r = 0; r < 16; ++r) p0[r] = fmaf(p0[r], C, mnC);
#pragma unroll
  for (int r = 0; r < 16; ++r) p1[r] = fmaf(p1[r], C, mnC);
#pragma unroll
  for (int r = 0; r < 16; ++r) p0[r] = __builtin_amdgcn_exp2f(p0[r]);
}
__device__ __forceinline__ void finishSM(f32x16& p0, f32x16& p1, float alpha, float& l_reg, bf16x8& pa0, bf16x8& pa1, bf16x8& pa2, bf16x8& pa3) {
#pragma unroll
  for (int r = 0; r < 16; ++r) p1[r] = __builtin_amdgcn_exp2f(p1[r]);
  float ps = 0;
#pragma unroll
  for (int r = 0; r < 16; ++r) ps += p0[r];
#pragma unroll
  for (int r = 0; r < 16; ++r) ps += p1[r];
  { auto rr = __builtin_amdgcn_permlane32_swap(__float_as_uint(ps), __float_as_uint(ps), false, false);
    ps = __uint_as_float(rr[0]) + __uint_as_float(rr[1]); }
  l_reg = l_reg * alpha + ps;
#define PK4(P, BASE, OUT) do { unsigned a0 = cvt_pk_bf16(P[BASE + 0], P[BASE + 1]), a1 = cvt_pk_bf16(P[BASE + 2], P[BASE + 3]);   \
    unsigned b0 = cvt_pk_bf16(P[BASE + 4], P[BASE + 5]), b1 = cvt_pk_bf16(P[BASE + 6], P[BASE + 7]);                              \
    auto r0 = __builtin_amdgcn_permlane32_swap(a0, b0, false, false); auto r1 = __builtin_amdgcn_permlane32_swap(a1, b1, false, false); \
    u32x4 w = {r0[0], r1[0], r0[1], r1[1]}; OUT = __builtin_bit_cast(bf16x8, w); } while (0)
  PK4(p0, 0, pa0); PK4(p0, 8, pa1); PK4(p1, 0, pa2); PK4(p1, 8, pa3);
#undef PK4
}
constexpr int NW = 8, QBLK = 32, KVBLK = 64;
constexpr float MLA_SCALE = 0.07216878364870322f;
constexpr float MLA_THR = 8.f;
constexpr int SHM_V = KVBLK * 128 * 2, SHM_KN = KVBLK * 128 * 2, SHM_KR = KVBLK * 64 * 2;
constexpr int OFF_V = 0, OFF_KN = 2 * SHM_V, OFF_KR = OFF_KN + 2 * SHM_KN, OFF_WS = OFF_KR + 2 * SHM_KR, OFF_QR = OFF_WS + NW * 64 * 4, MLA_LDS = OFF_QR + NW * 4096;
__device__ __forceinline__ void qkt(f32x16& p0, f32x16& p1, const LAS char* Kn, const LAS char* Kr, const bf16x8* qr, const LAS char* qrp, const int* kb, const int* krb) {
  p0 = f32x16{}; p1 = f32x16{};
#pragma unroll
  for (int d0 = 0; d0 < 8; ++d0) {
    const bf16x8 b0 = *(const LAS bf16x8*)(Kn + kb[d0 & 3] + (d0 >> 2) * 128);
    const bf16x8 b1 = *(const LAS bf16x8*)(Kn + kb[d0 & 3] + (d0 >> 2) * 128 + 8192);
    p0 = __builtin_amdgcn_mfma_f32_32x32x16_bf16(b0, qr[d0], p0, 0, 0, 0);
    p1 = __builtin_amdgcn_mfma_f32_32x32x16_bf16(b1, qr[d0], p1, 0, 0, 0); }
#pragma unroll
  for (int d0 = 0; d0 < 4; ++d0) {
    const bf16x8 b0 = *(const LAS bf16x8*)(Kr + krb[d0]);
    const bf16x8 b1 = *(const LAS bf16x8*)(Kr + krb[d0] + 4096);
    const bf16x8 qf = *(const LAS bf16x8*)(qrp + d0 * 1024);
    p0 = __builtin_amdgcn_mfma_f32_32x32x16_bf16(b0, qf, p0, 0, 0, 0);
    p1 = __builtin_amdgcn_mfma_f32_32x32x16_bf16(b1, qf, p1, 0, 0, 0); }
}
__device__ __forceinline__ int v_st(int k, int c) { const int kk = (k & ~0xC) | ((k & 4) << 1) | ((k & 8) >> 1); return ((kk >> 3) * 4 + (c >> 5)) * 512 + ((kk & 7) * 32 + (c & 31)) * 2; }
__device__ __forceinline__ int v_rd_base(int lane) { return ((lane & 3) << 3) | (((lane >> 2) & 3) << 6) | (((lane >> 4) & 1) << 5) | (((lane >> 5) & 1) << 8); }
constexpr int v_rd_off(int d0, int ks, int half) { return d0 * 512 + ks * 4096 + half * 2048; }
template <int OFF> __device__ __forceinline__ s16x4 tr_read(int vb) {
  s16x4 r; asm volatile("ds_read_b64_tr_b16 %0, %1 offset:%2" : "=&v"(r) : "v"(vb), "i"(OFF) : "memory"); return r;
}
template <int D0> __device__ __forceinline__ void pv_one(f32x16& od, int vb, bf16x8 pa0, bf16x8 pa1, bf16x8 pa2, bf16x8 pa3) {
  const s16x4 l0 = tr_read<v_rd_off(D0, 0, 0)>(vb), h0 = tr_read<v_rd_off(D0, 0, 1)>(vb), l1 = tr_read<v_rd_off(D0, 1, 0)>(vb), h1 = tr_read<v_rd_off(D0, 1, 1)>(vb);
  const s16x4 l2 = tr_read<v_rd_off(D0, 2, 0)>(vb), h2 = tr_read<v_rd_off(D0, 2, 1)>(vb), l3 = tr_read<v_rd_off(D0, 3, 0)>(vb), h3 = tr_read<v_rd_off(D0, 3, 1)>(vb);
  asm volatile("s_waitcnt lgkmcnt(0)" ::: "memory"); SBAR();
#define PK(L, H) (bf16x8){L[0], L[1], L[2], L[3], H[0], H[1], H[2], H[3]}
  od = __builtin_amdgcn_mfma_f32_32x32x16_bf16(pa0, PK(l0, h0), od, 0, 0, 0);
  od = __builtin_amdgcn_mfma_f32_32x32x16_bf16(pa1, PK(l1, h1), od, 0, 0, 0);
  od = __builtin_amdgcn_mfma_f32_32x32x16_bf16(pa2, PK(l2, h2), od, 0, 0, 0);
  od = __builtin_amdgcn_mfma_f32_32x32x16_bf16(pa3, PK(l3, h3), od, 0, 0, 0);
#undef PK
}
__device__ __forceinline__ void pv_d0(f32x16* o, int vb, bf16x8 pa0, bf16x8 pa1, bf16x8 pa2, bf16x8 pa3) {
  pv_one<0>(o[0], vb, pa0, pa1, pa2, pa3); pv_one<1>(o[1], vb, pa0, pa1, pa2, pa3); pv_one<2>(o[2], vb, pa0, pa1, pa2, pa3); pv_one<3>(o[3], vb, pa0, pa1, pa2, pa3);
}
__device__ __forceinline__ void mla_unit(int b, int h, int qb, const bf16_t* __restrict__ QM, const bf16_t* __restrict__ KN, const bf16_t* __restrict__ KR, const bf16_t* __restrict__ VV, unsigned char* __restrict__ OM, LAS char* lds) {
  const int tid = threadIdx.x, wid = tid >> 6, lane = tid & 63, r32 = lane & 31, hi = lane >> 5;
  constexpr float C = MLA_SCALE * L2E, THRS = MLA_THR / MLA_SCALE;
  constexpr int NT = 33;
  LAS char* V_lds = lds + OFF_V; LAS char* Kn_lds = lds + OFF_KN; LAS char* Kr_lds = lds + OFF_KR;
  LAS float* ws = (LAS float*)(lds + OFF_WS) + wid * 64; LAS float* li_l = ws; LAS float* al_l = ws + 32;
  float m_reg = -1e30f, l_reg = 0; f32x16 o[4] = {}; bf16x8 qr[8];
  LAS char* qrp = lds + OFF_QR + wid * 4096 + lane * 16;
  const int qrow = b * SEQ + qb * 256 + wid * QBLK + r32;
  const bf16_t* Qw = QM + (size_t)qrow * 3072 + h * 192 + hi * 8;
#pragma unroll
  for (int d0 = 0; d0 < 8; ++d0) qr[d0] = *(const GAS bf16x8*)(Qw + d0 * 16);
  __syncthreads();
#pragma unroll
  for (int d0 = 0; d0 < 4; ++d0) *(LAS bf16x8*)(qrp + d0 * 1024) = *(const GAS bf16x8*)(Qw + (8 + d0) * 16);
  const int sr = tid >> 4, sc = (tid & 15) * 8, vst0 = v_st(sr, sc), vst1 = v_st(32 + sr, sc);
  const int krr = tid >> 3, krc = (tid & 7) * 8;
  const int vb0 = (int)(uintptr_t)V_lds + v_rd_base(lane);
  bf16x8 s_v0, s_v1, s_k0, s_k1, s_kr;
  const int realbase = b * SEQ - KVBLK;
  const unsigned voff = (unsigned)(sr * 2048 + sc) * 2u, kroff = (unsigned)(krr * 64 + krc) * 2u;
  int kb[4], krb[4];
#pragma unroll
  for (int bq = 0; bq < 4; ++bq) { kb[bq] = KSWZ(r32, bq * 32 + hi * 16); krb[bq] = KRSWZ(r32, bq * 32 + hi * 16); }
#define TROW(t) ((t) == 0 ? MREAL : realbase + (t) * KVBLK)
#define SLOAD(t) do { const int k0_ = TROW(t); const size_t ro_ = ((size_t)k0_ * 2048 + h * 128) * 2; \
    const GAS char* vb_ = (const GAS char*)VV + ro_; const GAS char* nb_ = (const GAS char*)KN + ro_; const GAS char* rb_ = (const GAS char*)KR + (size_t)k0_ * 128; \
    s_v0 = *(const GAS bf16x8*)(vb_ + voff); s_v1 = *(const GAS bf16x8*)(vb_ + 32 * 4096 + voff); \
    s_k0 = *(const GAS bf16x8*)(nb_ + voff); s_k1 = *(const GAS bf16x8*)(nb_ + 32 * 4096 + voff); \
    s_kr = *(const GAS bf16x8*)(rb_ + kroff); } while (0)
#define SWRITE(bf) do { *(LAS bf16x8*)(V_lds + (bf) * SHM_V + vst0) = s_v0; *(LAS bf16x8*)(V_lds + (bf) * SHM_V + vst1) = s_v1; const int kc_ = sc * 2; \
    *(LAS bf16x8*)(Kn_lds + (bf) * SHM_KN + KSWZ(sr, kc_)) = s_k0; *(LAS bf16x8*)(Kn_lds + (bf) * SHM_KN + KSWZ(32 + sr, kc_)) = s_k1; \
    *(LAS bf16x8*)(Kr_lds + (bf) * SHM_KR + KRSWZ(krr, krc * 2)) = s_kr; } while (0)
#define SWAIT() asm volatile("s_waitcnt vmcnt(0)" ::: "memory")
#define RESC(a) do { if (__any((a) < 1.f)) { if (hi == 0) al_l[r32] = (a); asm volatile("s_waitcnt lgkmcnt(0)" ::: "memory"); \
    _Pragma("unroll") for (int d = 0; d < 4; ++d) _Pragma("unroll") for (int r = 0; r < 16; ++r) o[d][r] *= al_l[crow(r, hi)]; } } while (0)
  f32x16 pA0, pA1, pB0, pB1; float mnA, mnB, alA, alB; bf16x8 pa0, pa1, pa2, pa3;
  SLOAD(0); SWAIT(); SWRITE(0); __syncthreads();
  qkt(pA0, pA1, Kn_lds, Kr_lds, qr, qrp, kb, krb);
  { const float NEG = -INFINITY;
#pragma unroll
    for (int r = 8; r < 16; ++r) pA0[r] = NEG;
#pragma unroll
    for (int r = 0; r < 16; ++r) pA1[r] = NEG; }
  partialSM(pA0, pA1, m_reg, mnA, alA, C, THRS);
  SLOAD(1); SWAIT(); SWRITE(1); __syncthreads();
  for (int j = 1; j + 1 < NT; j += 2) {
    SBAR(); qkt(pB0, pB1, Kn_lds + SHM_KN, Kr_lds + SHM_KR, qr, qrp, kb, krb);
    finishSM(pA0, pA1, alA, l_reg, pa0, pa1, pa2, pa3); SBAR();
    SLOAD(j + 1); SBAR();
    pv_d0(o, vb0, pa0, pa1, pa2, pa3); partialSM(pB0, pB1, m_reg, mnB, alB, C, THRS);
    __syncthreads(); SWAIT(); SWRITE(0);
    RESC(alB); __syncthreads();
    SBAR(); qkt(pA0, pA1, Kn_lds, Kr_lds, qr, qrp, kb, krb);
    finishSM(pB0, pB1, alB, l_reg, pa0, pa1, pa2, pa3); SBAR();
    if (j + 2 < NT) SLOAD(j + 2); SBAR();
    pv_d0(o, vb0 + SHM_V, pa0, pa1, pa2, pa3); partialSM(pA0, pA1, m_reg, mnA, alA, C, THRS);
    __syncthreads(); if (j + 2 < NT) { SWAIT(); SWRITE(1); }
    RESC(alA); __syncthreads();
  }
  finishSM(pA0, pA1, alA, l_reg, pa0, pa1, pa2, pa3); SBAR();
  pv_d0(o, vb0, pa0, pa1, pa2, pa3);
  if (hi == 0) li_l[r32] = l_reg; asm volatile("s_waitcnt lgkmcnt(0)" ::: "memory");
  float rli[16];
#pragma unroll
  for (int r = 0; r < 16; ++r) rli[r] = __builtin_amdgcn_rcpf(li_l[crow(r, hi)]);
  unsigned char* Ow = OM + (size_t)(b * SEQ + qb * 256 + wid * QBLK) * 2048 + h * 128;
#pragma unroll
  for (int r = 0; r < 16; ++r) { const int orow = crow(r, hi);
#pragma unroll
    for (int d0 = 0; d0 < 4; ++d0) Ow[(size_t)orow * 2048 + d0 * 32 + r32] = f32_to_fp8(o[d0][r] * rli[r] * 32.f); }
#undef TROW
#undef SLOAD
#undef SWRITE
#undef SWAIT
#undef RESC
}
constexpr int K8S = 208, V8S = 80, SHM8_K = 64 * K8S, SHM8_V = 128 * V8S;
constexpr int OFF8_K = 0, OFF8_V = 2 * SHM8_K, OFF8_WS = OFF8_V + 2 * SHM8_V, MLA8_LDS = OFF8_WS + NW * 64 * 4;
constexpr float MLA8_THR = 1.9f;
typedef int a8_t __attribute__((ext_vector_type(8)));
#define MFMA8(acc_, a_, b_, sa_, sb_) asm volatile("s_nop 1\n\tv_mfma_scale_f32_32x32x64_f8f6f4 %0, %1, %2, %0, %3, %4 op_sel_hi:[0,0,0]" : "+v"(acc_) : "v"(a_), "v"(b_), "v"(sa_), "v"(sb_))
__device__ __forceinline__ a8_t ld_frag8(const LAS char* p) { const u32x4 lo = *(const LAS u32x4*)p, hi = *(const LAS u32x4*)(p + 16); return (a8_t){(int)lo.x, (int)lo.y, (int)lo.z, (int)lo.w, (int)hi.x, (int)hi.y, (int)hi.z, (int)hi.w}; }
__device__ __forceinline__ void qkt8(f32x16& p0, f32x16& p1, const LAS char* Kb, const a8_t& q0, const a8_t& q1, const a8_t& q2, int s1) {
  p0 = f32x16{}; p1 = f32x16{};
  { const a8_t a0 = ld_frag8(Kb), a1 = ld_frag8(Kb + 32 * K8S); MFMA8(p0, a0, q0, s1, s1); MFMA8(p1, a1, q0, s1, s1); }
  { const a8_t a0 = ld_frag8(Kb + 64), a1 = ld_frag8(Kb + 32 * K8S + 64); MFMA8(p0, a0, q1, s1, s1); MFMA8(p1, a1, q1, s1, s1); }
  { const a8_t a0 = ld_frag8(Kb + 128), a1 = ld_frag8(Kb + 32 * K8S + 128); MFMA8(p0, a0, q2, s1, s1); MFMA8(p1, a1, q2, s1, s1); }
  asm volatile("s_nop 15\n\ts_nop 15" : "+v"(p0), "+v"(p1));
}
__device__ __forceinline__ void partialSM8(f32x16& p0, f32x16& p1, float& m_reg, float& mn, float& alpha, const float C, const float THRS) {
  float pmax = p0[0];
#pragma unroll
  for (int r = 1; r < 16; ++r) pmax = fmaxf(pmax, p0[r]);
#pragma unroll
  for (int r = 0; r < 16; ++r) pmax = fmaxf(pmax, p1[r]);
  { auto rr = __builtin_amdgcn_permlane32_swap(__float_as_uint(pmax), __float_as_uint(pmax), false, false);
    pmax = fmaxf(__uint_as_float(rr[0]), __uint_as_float(rr[1])); }
  if (__builtin_expect(__all(pmax - m_reg <= THRS), 1)) { mn = m_reg; alpha = 1.f; }
  else { mn = fmaxf(m_reg, pmax); alpha = __builtin_amdgcn_exp2f((m_reg - mn) * C); m_reg = mn; }
  const float mnC = 6.f - mn * C;
#pragma unroll
  for (int r = 0; r < 16; ++r) p0[r] = fmaf(p0[r], C, mnC);
#pragma unroll
  for (int r = 0; r < 16; ++r) p1[r] = fmaf(p1[r], C, mnC);
#pragma unroll
  for (int r = 0; r < 16; ++r) p0[r] = __builtin_amdgcn_exp2f(p0[r]);
}
__device__ __forceinline__ void finishSM8(f32x16& p0, f32x16& p1, float alpha, float& l_reg, a8_t& pf) {
#pragma unroll
  for (int r = 0; r < 16; ++r) p1[r] = __builtin_amdgcn_exp2f(p1[r]);
  float ps = 0;
#pragma unroll
  for (int r = 0; r < 16; ++r) ps += p0[r];
#pragma unroll
  for (int r = 0; r < 16; ++r) ps += p1[r];
  { auto rr = __builtin_amdgcn_permlane32_swap(__float_as_uint(ps), __float_as_uint(ps), false, false);
    ps = __uint_as_float(rr[0]) + __uint_as_float(rr[1]); }
  l_reg = l_reg * alpha + ps;
#pragma unroll
  for (int w = 0; w < 4; ++w) { int x = 0, y = 0;
    x = __builtin_amdgcn_cvt_pk_fp8_f32(p0[4 * w], p0[4 * w + 1], x, false); x = __builtin_amdgcn_cvt_pk_fp8_f32(p0[4 * w + 2], p0[4 * w + 3], x, true);
    y = __builtin_amdgcn_cvt_pk_fp8_f32(p1[4 * w], p1[4 * w + 1], y, false); y = __builtin_amdgcn_cvt_pk_fp8_f32(p1[4 * w + 2], p1[4 * w + 3], y, true);
    pf[w] = x; pf[4 + w] = y; }
}
__device__ __forceinline__ void pv8(f32x16* o, const LAS char* Vb, const a8_t& pf, int sP, int s1) {
  const a8_t b0 = ld_frag8(Vb), b1 = ld_frag8(Vb + 32 * V8S), b2 = ld_frag8(Vb + 64 * V8S), b3 = ld_frag8(Vb + 96 * V8S);
  MFMA8(o[0], pf, b0, sP, s1); MFMA8(o[1], pf, b1, sP, s1); MFMA8(o[2], pf, b2, sP, s1); MFMA8(o[3], pf, b3, sP, s1);
  asm volatile("s_nop 15\n\ts_nop 15" : "+v"(o[0]), "+v"(o[1]), "+v"(o[2]), "+v"(o[3]));
}
__device__ __forceinline__ void mla_unit8(int b, int h, int qb, const unsigned char* __restrict__ QM8, const unsigned char* __restrict__ KN8, const unsigned char* __restrict__ KR8, const unsigned char* __restrict__ VT8,
                                          unsigned char* __restrict__ OM, LAS char* lds, Conv& cv) {
  const int tid = threadIdx.x, wid = tid >> 6, lane = tid & 63, r32 = lane & 31, hi = lane >> 5;
  constexpr float C = MLA_SCALE * L2E, THRS = MLA8_THR / MLA_SCALE;
  constexpr int NT = 33;
  LAS char* K_lds = lds + OFF8_K; LAS char* V_lds = lds + OFF8_V;
  LAS float* ws = (LAS float*)(lds + OFF8_WS) + wid * 64; LAS float* li_l = ws; LAS float* al_l = ws + 32;
  int s1 = 0x7f7f7f7f, sP = 0x79797979; asm volatile("" : "+v"(s1), "+v"(sP));
  float m_reg = -1e30f, l_reg = 0; f32x16 o[4] = {};
  const int qrow = b * SEQ + qb * 256 + wid * QBLK + r32;
  a8_t q0, q1, q2;
  { const unsigned char* Qw = QM8 + (size_t)qrow * 3072 + h * 192 + hi * 32;
    const u32x4 a = *(const GAS u32x4*)Qw, bq = *(const GAS u32x4*)(Qw + 16), c = *(const GAS u32x4*)(Qw + 64), d = *(const GAS u32x4*)(Qw + 80), e = *(const GAS u32x4*)(Qw + 128), f = *(const GAS u32x4*)(Qw + 144);
    q0 = (a8_t){(int)a.x, (int)a.y, (int)a.z, (int)a.w, (int)bq.x, (int)bq.y, (int)bq.z, (int)bq.w};
    q1 = (a8_t){(int)c.x, (int)c.y, (int)c.z, (int)c.w, (int)d.x, (int)d.y, (int)d.z, (int)d.w};
    q2 = (a8_t){(int)e.x, (int)e.y, (int)e.z, (int)e.w, (int)f.x, (int)f.y, (int)f.z, (int)f.w}; }
  __syncthreads();
  const int kkey = tid >> 3, kch = tid & 7, rkey = (tid >> 2) & 63, rch = tid & 3, vdim = tid >> 2, vch = tid & 3;
  const LAS char* Kf = K_lds + r32 * K8S + 32 * hi; const LAS char* Vf = V_lds + r32 * V8S + 32 * hi;
  u32x4 s_k, s_r, s_v;
  const int realbase = b * SEQ - KVBLK;
#define TROW(t) ((t) == 0 ? MREAL : realbase + (t) * KVBLK)
#define SLOAD(t) do { const int k0_ = TROW(t); \
    s_k = *(const GAS u32x4*)(KN8 + (size_t)(k0_ + kkey) * 2048 + h * 128 + kch * 16); \
    s_r = *(const GAS u32x4*)(KR8 + (size_t)(k0_ + rkey) * 64 + rch * 16); \
    s_v = *(const GAS u32x4*)(VT8 + (size_t)(h * 128 + vdim) * MPAD + k0_ + vch * 16); } while (0)
#define SWRITE(bf) do { *(LAS u32x4*)(K_lds + (bf) * SHM8_K + kkey * K8S + kch * 16) = s_k; if (tid < 256) *(LAS u32x4*)(K_lds + (bf) * SHM8_K + rkey * K8S + 128 + rch * 16) = s_r; \
    *(LAS u32x4*)(V_lds + (bf) * SHM8_V + vdim * V8S + vch * 16) = s_v; } while (0)
#define CONV_HOOK() do { cvi = false; if ((cv.tick++ & 3) == 0) { int lane_ = lane; asm volatile("" : "+v"(lane_));     \
      if (cv.pend >= 0) { asm volatile("s_waitcnt vmcnt(3)" ::: "memory"); conv_finish(cv, cv.pend, lane_); cv.pend = -1; asm volatile("s_waitcnt lgkmcnt(0)" ::: "memory"); } \
      if (cv.next < cv.end) { conv_issue(cv, cv.next, lane_); cv.pend = cv.next; cv.next += cv.stride; cvi = true; } } } while (0)
#define SWAIT() do { if (cvi) asm volatile("s_waitcnt vmcnt(8)" ::: "memory"); else asm volatile("s_waitcnt vmcnt(0)" ::: "memory"); } while (0)
#define RESC(a) do { if (__any((a) < 1.f)) { if (hi == 0) al_l[r32] = (a); asm volatile("s_waitcnt lgkmcnt(0)" ::: "memory"); \
    _Pragma("unroll") for (int d = 0; d < 4; ++d) _Pragma("unroll") for (int r = 0; r < 16; ++r) o[d][r] *= al_l[crow(r, hi)]; } } while (0)
  f32x16 pA0, pA1, pB0, pB1; float mnA, mnB, alA, alB; a8_t pf; bool cvi = false;
  SLOAD(0); SWAIT(); SWRITE(0); __syncthreads();
  qkt8(pA0, pA1, Kf, q0, q1, q2, s1);
  { const float NEG = -INFINITY;
#pragma unroll
    for (int r = 8; r < 16; ++r) pA0[r] = NEG;
#pragma unroll
    for (int r = 0; r < 16; ++r) pA1[r] = NEG; }
  partialSM8(pA0, pA1, m_reg, mnA, alA, C, THRS);
  SLOAD(1); SWAIT(); SWRITE(1); __syncthreads();
  for (int j = 1; j + 1 < NT; j += 2) {
    SBAR(); qkt8(pB0, pB1, Kf + SHM8_K, q0, q1, q2, s1);
    finishSM8(pA0, pA1, alA, l_reg, pf); SBAR();
    SLOAD(j + 1); CONV_HOOK(); SBAR();
    pv8(o, Vf, pf, sP, s1); partialSM8(pB0, pB1, m_reg, mnB, alB, C, THRS);
    __syncthreads(); SWAIT(); SWRITE(0);
    RESC(alB); __syncthreads();
    SBAR(); qkt8(pA0, pA1, Kf, q0, q1, q2, s1);
    finishSM8(pB0, pB1, alB, l_reg, pf); SBAR();
    if (j + 2 < NT) { SLOAD(j + 2); CONV_HOOK(); } SBAR();
    pv8(o, Vf + SHM8_V, pf, sP, s1); partialSM8(pA0, pA1, m_reg, mnA, alA, C, THRS);
    __syncthreads(); if (j + 2 < NT) { SWAIT(); SWRITE(1); }
    RESC(alA); __syncthreads();
  }
  finishSM8(pA0, pA1, alA, l_reg, pf); SBAR();
  pv8(o, Vf, pf, sP, s1);
  if (hi == 0) li_l[r32] = l_reg; asm volatile("s_waitcnt lgkmcnt(0)" ::: "memory");
  float rli[16];
#pragma unroll
  for (int r = 0; r < 16; ++r) rli[r] = __builtin_amdgcn_rcpf(li_l[crow(r, hi)]) * (64.f * 32.f);
  unsigned char* Ow = OM + (size_t)(b * SEQ + qb * 256 + wid * QBLK) * 2048 + h * 128;
#pragma unroll
  for (int r = 0; r < 16; ++r) { const int orow = crow(r, hi);
#pragma unroll
    for (int d0 = 0; d0 < 4; ++d0) Ow[(size_t)orow * 2048 + d0 * 32 + r32] = f32_to_fp8(o[d0][r] * rli[r]); }
#undef TROW
#undef SLOAD
#undef SWRITE
#undef SWAIT
#undef RESC
#undef CONV_HOOK
}
__device__ __forceinline__ void na_task(int task, const unsigned char* __restrict__ NAQ, const unsigned char* __restrict__ NAK, const unsigned char* __restrict__ VT, unsigned char* __restrict__ ONA,
                                        const LAS float* relb, const LAS float* metab, LAS float* wsf, int lane) {
  const int r32 = lane & 31, hi = lane >> 5;
  const int half = task & 1, r = (task >> 1) & 31, h = (task >> 6) & 15, b = task >> 10;
  const int qc = half * 32 + r32;
  const int cs = min(max(qc - 8, 0), 48), rs = min(max(r - 4, 0), 24);
  const int qtok = b * SEQ + r * 64 + qc;
  constexpr float C = L2E, THRS = 1.9f, SCALE = 0.125f;
  int s1 = 0x7f7f7f7f, sP = 0x79797979; asm volatile("" : "+v"(s1), "+v"(sP));
  a8_t qf; { const unsigned char* qp = NAQ + (size_t)qtok * 1024 + h * 64 + hi * 32; const u32x4 a = *(const GAS u32x4*)qp, c = *(const GAS u32x4*)(qp + 16);
    qf = (a8_t){(int)a.x, (int)a.y, (int)a.z, (int)a.w, (int)c.x, (int)c.y, (int)c.z, (int)c.w}; }
  float m_reg = -1e30f, l_reg = 0.f; f32x16 o[2] = {};
  LAS float* al_l = wsf; LAS float* li_l = wsf + 32;
  const float NEG = -INFINITY;
  const int kb0 = half * 16;
  const unsigned long long wm = 0xFFFFull << (cs - kb0);
  const unsigned mh0 = (unsigned)wm >> (4 * hi), mh1 = (unsigned)(wm >> 32) >> (4 * hi);
  const unsigned char* kq = NAK + (size_t)r32 * 1024 + h * 64 + hi * 32;
  const unsigned char* kq2 = NAK + (size_t)(32 + (r32 & 15)) * 1024 + h * 64 + hi * 32;
  const unsigned char* vq = VT + (size_t)(h * 64 + r32) * VT_PITCH + 32 * hi;
#define NA_KTOK(w) ((w) == 8 ? MREAL : b * SEQ + (rs + (w)) * 64 + kb0)
#define NA_VOFF(w) ((w) == 8 ? MREAL : b * SEQ + (rs + (w)) * 64 + (kb0 >> 1))
#define NA_LOADK(KF, w) do { const size_t ko_ = (size_t)NA_KTOK(w) * 1024; KF[0] = *(const GAS u32x4*)(kq + ko_); KF[1] = *(const GAS u32x4*)(kq + ko_ + 16); KF[2] = *(const GAS u32x4*)(kq2 + ko_); KF[3] = *(const GAS u32x4*)(kq2 + ko_ + 16); } while (0)
#define NA_A8(x_, y_) (a8_t){(int)x_.x, (int)x_.y, (int)x_.z, (int)x_.w, (int)y_.x, (int)y_.y, (int)y_.z, (int)y_.w}
#define NA_TILE(KF, wt, YN) do { \
    u32x4 va0, va1; u32x2 vb0_, vb1_; { const unsigned char* vp_ = vq + NA_VOFF(wt); va0 = *(const GAS u32x4*)vp_; vb0_ = *(const GAS u32x2*)(vp_ + 16); va1 = *(const GAS u32x4*)(vp_ + (size_t)32 * VT_PITCH); vb1_ = *(const GAS u32x2*)(vp_ + (size_t)32 * VT_PITCH + 16); } \
    f32x16 p0 = {}, p1 = {}; \
    { const a8_t k0_ = NA_A8(KF[0], KF[1]), k1_ = NA_A8(KF[2], KF[3]); MFMA8(p0, k0_, qf, s1, s1); MFMA8(p1, k1_, qf, s1, s1); asm volatile("s_nop 15\n\ts_nop 15" : "+v"(p0), "+v"(p1)); } \
    if ((wt) + 1 < 9) NA_LOADK(KF, (wt) + 1);            \
      \
    if ((wt) < 8) { const LAS float* bp_ = relb + ((h * 15 + (rs + (wt) - r + 7)) * 31 + 15 - qc + 4 * hi + kb0);     \
      float bv0[16], bv1[8];        \
      _Pragma("unroll") for (int rg = 0; rg < 16; ++rg) { const int c_ = (rg & 3) + 8 * (rg >> 2); bv0[rg] = bp_[c_]; if (rg < 8) bv1[rg] = bp_[c_ + 32]; } \
      _Pragma("unroll") for (int rg = 0; rg < 16; ++rg) { asm volatile("" : "+v"(bv0[rg])); if (rg < 8) asm volatile("" : "+v"(bv1[rg])); } \
      _Pragma("unroll") for (int rg = 0; rg < 16; ++rg) { const int c_ = (rg & 3) + 8 * (rg >> 2); \
        { const bool ok = (mh0 >> c_) & 1u; p0[rg] = ok ? fmaf(p0[rg], SCALE, bv0[rg]) : NEG; } \
        if (rg < 8) { const bool ok = (mh1 >> c_) & 1u; p1[rg] = ok ? fmaf(p1[rg], SCALE, bv1[rg]) : NEG; } } \
    } else { const LAS float* bp = metab + h * 16; \
      _Pragma("unroll") for (int rg = 0; rg < 16; ++rg) { const int kc = crow(rg, hi); p0[rg] = (rg < 8) ? fmaf(p0[rg], SCALE, bp[kc & 15]) : NEG; if (rg < 8) p1[rg] = NEG; } } \
      \
    float pmax = p0[0]; \
    _Pragma("unroll") for (int rg = 1; rg < 16; ++rg) pmax = fmaxf(pmax, p0[rg]); \
    _Pragma("unroll") for (int rg = 0; rg < 8; ++rg) pmax = fmaxf(pmax, p1[rg]); \
    { auto rr = __builtin_amdgcn_permlane32_swap(__float_as_uint(pmax), __float_as_uint(pmax), false, false); pmax = fmaxf(__uint_as_float(rr[0]), __uint_as_float(rr[1])); } \
    float mn, alpha; \
    if (__builtin_expect(__all(pmax - m_reg <= THRS), 1)) { mn = m_reg; alpha = 1.f; } \
    else { mn = fmaxf(m_reg, pmax); alpha = __builtin_amdgcn_exp2f((m_reg - mn) * C); m_reg = mn; } \
    const float mnC = 6.f - mn * C; float ps = 0.f;        \
    _Pragma("unroll") for (int rg = 0; rg < 16; ++rg) { p0[rg] = __builtin_amdgcn_exp2f(fmaf(p0[rg], C, mnC)); ps += p0[rg]; } \
    _Pragma("unroll") for (int rg = 0; rg < 8; ++rg) { p1[rg] = __builtin_amdgcn_exp2f(fmaf(p1[rg], C, mnC)); ps += p1[rg]; } \
    { auto rr = __builtin_amdgcn_permlane32_swap(__float_as_uint(ps), __float_as_uint(ps), false, false); ps = __uint_as_float(rr[0]) + __uint_as_float(rr[1]); } \
    l_reg = l_reg * alpha + ps; \
    a8_t pf;   \
    _Pragma("unroll") for (int w_ = 0; w_ < 4; ++w_) { int x = 0; x = __builtin_amdgcn_cvt_pk_fp8_f32(p0[4 * w_], p0[4 * w_ + 1], x, false); x = __builtin_amdgcn_cvt_pk_fp8_f32(p0[4 * w_ + 2], p0[4 * w_ + 3], x, true); pf[w_] = x; } \
    _Pragma("unroll") for (int w_ = 0; w_ < 2; ++w_) { int x = 0; x = __builtin_amdgcn_cvt_pk_fp8_f32(p1[4 * w_], p1[4 * w_ + 1], x, false); x = __builtin_amdgcn_cvt_pk_fp8_f32(p1[4 * w_ + 2], p1[4 * w_ + 3], x, true); pf[4 + w_] = x; } \
    pf[6] = 0; pf[7] = 0; \
    if (__any(alpha < 1.f)) { if (hi == 0) al_l[r32] = alpha; asm volatile("s_waitcnt lgkmcnt(0)" ::: "memory"); \
      _Pragma("unroll") for (int d = 0; d < 2; ++d) _Pragma("unroll") for (int rg = 0; rg < 16; ++rg) o[d][rg] *= al_l[crow(rg, hi)]; } \
    { const a8_t v0_ = (a8_t){(int)va0.x, (int)va0.y, (int)va0.z, (int)va0.w, (int)vb0_.x, (int)vb0_.y, 0, 0}, v1_ = (a8_t){(int)va1.x, (int)va1.y, (int)va1.z, (int)va1.w, (int)vb1_.x, (int)vb1_.y, 0, 0}; \
      MFMA8(o[0], pf, v0_, sP, s1); MFMA8(o[1], pf, v1_, sP, s1); asm volatile("s_nop 15\n\ts_nop 15" : "+v"(o[0]), "+v"(o[1])); } } while (0)
  { u32x4 kA[4];
    NA_LOADK(kA, 0);
#pragma unroll 1
    for (int w = 0; w < 8; ++w) { NA_TILE(kA, w, 12); }
    NA_TILE(kA, 8, 12); }
#undef NA_KTOK
#undef NA_VOFF
#undef NA_LOADK
#undef NA_A8
#undef NA_TILE
  if (hi == 0) li_l[r32] = l_reg; asm volatile("s_waitcnt lgkmcnt(0)" ::: "memory");
  unsigned char* Ow = ONA + (size_t)(b * SEQ + r * 64 + half * 32) * 1024 + h * 64;
#pragma unroll
  for (int rg = 0; rg < 16; ++rg) { const int orow = crow(rg, hi); const float rl = __builtin_amdgcn_rcpf(li_l[orow]) * (64.f * 16.f);
#pragma unroll
    for (int d0 = 0; d0 < 2; ++d0) Ow[(size_t)orow * 1024 + d0 * 32 + r32] = f32_to_fp8(o[d0][rg] * rl); }
  asm volatile("s_waitcnt lgkmcnt(0)" ::: "memory");
}
}
namespace peer {
constexpr int CH = 32;
constexpr int OFF_TV = 0, OFF_TI = OFF_TV + CH * 16 * 16 * 4, OFF_SE = OFF_TI + CH * 16 * 16 * 4, OFF_SG = OFF_SE + CH * 128 * 4, OFF_SE2 = OFF_SG + CH * 128 * 4, OFF_SG2 = OFF_SE2 + CH * 128 * 4, PEER_LDS = OFF_SG2 + CH * 128 * 4;
static_assert(PEER_LDS <= RING_BYTES, "PEER LDS");
__device__ __forceinline__ float gelu_tanh(float x) {
    const float u = 0.7978845608028654f * (x + 0.044715f * x * x * x);
    const float e = __builtin_amdgcn_exp2f(-2.f * 1.4426950408889634f * fabsf(u));
    const float t = (1.f - e) * __builtin_amdgcn_rcpf(1.f + e);
    return 0.5f * x * (1.f + (u < 0.f ? -t : t));
}
__device__ __forceinline__ void fmac1(float& acc, float a, float b) { asm("v_fmac_f32_e32 %0, %1, %2" : "+v"(acc) : "v"(a), "v"(b)); }
#define PEER_INSERT(x_, xi_) do { float x__ = (x_); int xi__ = (xi_); \
    _Pragma("unroll") for (int j_ = 0; j_ < 16; ++j_) { const bool gt_ = x__ > tv[j_]; const float tvo_ = tv[j_]; const int tio_ = ti[j_]; \
        tv[j_] = gt_ ? x__ : tvo_; ti[j_] = gt_ ? xi__ : tio_; x__ = gt_ ? tvo_ : x__; xi__ = gt_ ? tio_ : xi__; } } while (0)

#define PEER_AUX 0
typedef __amdgpu_buffer_rsrc_t rsrc_t;
__device__ __forceinline__ rsrc_t mk_rsrc(const void* p, unsigned bytes) { return __builtin_amdgcn_make_buffer_rsrc((void*)p, 0, bytes, 0x00020000); }
__device__ __forceinline__ u32x4 ldb128(rsrc_t r, unsigned off) { return __builtin_amdgcn_raw_buffer_load_b128(r, off, 0, PEER_AUX); }
typedef unsigned v6u_t __attribute__((ext_vector_type(6)));
typedef float v32f_t __attribute__((ext_vector_type(32)));
typedef float v16f_t __attribute__((ext_vector_type(16)));
__device__ __forceinline__ u32x2 ldb64(rsrc_t r, unsigned off) { return __builtin_amdgcn_raw_buffer_load_b64(r, off, 0, PEER_AUX); }
__device__ __forceinline__ f32x4 ldf128(rsrc_t r, unsigned off) { return __builtin_bit_cast(f32x4, __builtin_amdgcn_raw_buffer_load_b128(r, off, 0, PEER_AUX)); }
__device__ __forceinline__ f32x4 ldf128_nt(rsrc_t r, unsigned off) { return __builtin_bit_cast(f32x4, __builtin_amdgcn_raw_buffer_load_b128(r, off, 0, 2)); }
__device__ __forceinline__ void peer_select(int chunk, const _Float16* __restrict__ SC, LAS char* lds, int tid, LAS int* SE, LAS float* SG) {
    LAS float* TV = (LAS float*)(lds + OFF_TV); LAS int* TI = (LAS int*)(lds + OFF_TI);
    asm volatile("" : "+v"(tid));
    const int tok0 = chunk * CH;
    const rsrc_t rSC = mk_rsrc(SC, 0x4000000u);
    __syncthreads();
    { const int tl = tid >> 4, g = tid & 15; const unsigned spo = ((unsigned)(tok0 + tl) * 2048u + (unsigned)g * 128u) * 2u;
      int tk[16];
#pragma unroll
      for (int j = 0; j < 16; ++j) tk[j] = (int)0x80000000;
#define PEER_KEY(x_, lowbits_, mask_) ({ const int f_ = __float_as_int(x_); ((f_ ^ ((f_ >> 31) & 0x7fffffff)) & ~(mask_)) | (lowbits_); })
#define PEER_INS(key_) do { int x__ = (key_); _Pragma("unroll") for (int j_ = 0; j_ < 16; ++j_) { const int hi_ = max(x__, tk[j_]); x__ = min(x__, tk[j_]); tk[j_] = hi_; } } while (0)
      typedef _Float16 h8_t __attribute__((ext_vector_type(8)));
#define PEER_CX(a_, b_) do { const int hi_ = max(a_, b_), lo_ = min(a_, b_); a_ = hi_; b_ = lo_; } while (0)
      u32x4 na = __builtin_amdgcn_raw_buffer_load_b128(rSC, spo, 0, 2), nb = __builtin_amdgcn_raw_buffer_load_b128(rSC, spo + 16, 0, 2);
#pragma unroll 1
      for (int i = 0; i < 16; i += 2) { const h8_t a = __builtin_bit_cast(h8_t, na), b = __builtin_bit_cast(h8_t, nb);
          { const unsigned on = spo + (unsigned)min(i + 2, 14) * 16u; na = __builtin_amdgcn_raw_buffer_load_b128(rSC, on, 0, 2); nb = __builtin_amdgcn_raw_buffer_load_b128(rSC, on + 16, 0, 2); }
          int kk[16];
#pragma unroll
          for (int e = 0; e < 8; ++e) { kk[e] = PEER_KEY((float)a[e], 127 - (8 * i + e), 127); kk[8 + e] = PEER_KEY((float)b[e], 127 - (8 * i + 8 + e), 127); }
          PEER_CX(kk[0], kk[13]); PEER_CX(kk[1], kk[12]); PEER_CX(kk[2], kk[15]); PEER_CX(kk[3], kk[14]); PEER_CX(kk[4], kk[8]); PEER_CX(kk[5], kk[6]); PEER_CX(kk[7], kk[11]); PEER_CX(kk[9], kk[10]); PEER_CX(kk[0], kk[5]); PEER_CX(kk[1], kk[7]); PEER_CX(kk[2], kk[9]); PEER_CX(kk[3], kk[4]); PEER_CX(kk[6], kk[13]); PEER_CX(kk[8], kk[14]); PEER_CX(kk[10], kk[15]); PEER_CX(kk[11], kk[12]); PEER_CX(kk[0], kk[1]); PEER_CX(kk[2], kk[3]); PEER_CX(kk[4], kk[5]); PEER_CX(kk[6], kk[8]); PEER_CX(kk[7], kk[9]); PEER_CX(kk[10], kk[11]); PEER_CX(kk[12], kk[13]); PEER_CX(kk[14], kk[15]); PEER_CX(kk[0], kk[2]); PEER_CX(kk[1], kk[3]); PEER_CX(kk[4], kk[10]); PEER_CX(kk[5], kk[11]); PEER_CX(kk[6], kk[7]); PEER_CX(kk[8], kk[9]); PEER_CX(kk[12], kk[14]); PEER_CX(kk[13], kk[15]); PEER_CX(kk[1], kk[2]); PEER_CX(kk[3], kk[12]); PEER_CX(kk[4], kk[6]); PEER_CX(kk[5], kk[7]); PEER_CX(kk[8], kk[10]); PEER_CX(kk[9], kk[11]); PEER_CX(kk[13], kk[14]); PEER_CX(kk[1], kk[4]); PEER_CX(kk[2], kk[6]); PEER_CX(kk[5], kk[8]); PEER_CX(kk[7], kk[10]); PEER_CX(kk[9], kk[13]); PEER_CX(kk[11], kk[14]); PEER_CX(kk[2], kk[4]); PEER_CX(kk[3], kk[6]); PEER_CX(kk[9], kk[12]); PEER_CX(kk[11], kk[13]); PEER_CX(kk[3], kk[5]); PEER_CX(kk[6], kk[8]); PEER_CX(kk[7], kk[9]); PEER_CX(kk[10], kk[12]); PEER_CX(kk[3], kk[4]); PEER_CX(kk[5], kk[6]); PEER_CX(kk[7], kk[8]); PEER_CX(kk[9], kk[10]); PEER_CX(kk[11], kk[12]); PEER_CX(kk[6], kk[7]); PEER_CX(kk[8], kk[9]);
#pragma unroll
          for (int e = 0; e < 16; ++e) tk[e] = max(tk[e], kk[15 - e]);
          PEER_CX(tk[0], tk[8]); PEER_CX(tk[1], tk[9]); PEER_CX(tk[2], tk[10]); PEER_CX(tk[3], tk[11]); PEER_CX(tk[4], tk[12]); PEER_CX(tk[5], tk[13]); PEER_CX(tk[6], tk[14]); PEER_CX(tk[7], tk[15]); PEER_CX(tk[0], tk[4]); PEER_CX(tk[1], tk[5]); PEER_CX(tk[2], tk[6]); PEER_CX(tk[3], tk[7]); PEER_CX(tk[8], tk[12]); PEER_CX(tk[9], tk[13]); PEER_CX(tk[10], tk[14]); PEER_CX(tk[11], tk[15]); PEER_CX(tk[0], tk[2]); PEER_CX(tk[1], tk[3]); PEER_CX(tk[4], tk[6]); PEER_CX(tk[5], tk[7]); PEER_CX(tk[8], tk[10]); PEER_CX(tk[9], tk[11]); PEER_CX(tk[12], tk[14]); PEER_CX(tk[13], tk[15]); PEER_CX(tk[0], tk[1]); PEER_CX(tk[2], tk[3]); PEER_CX(tk[4], tk[5]); PEER_CX(tk[6], tk[7]); PEER_CX(tk[8], tk[9]); PEER_CX(tk[10], tk[11]); PEER_CX(tk[12], tk[13]); PEER_CX(tk[14], tk[15]); }
#undef PEER_CX
      LAS float* tvp = TV + (tl * 16 + g) * 16; LAS int* tip = TI + (tl * 16 + g) * 16;
#pragma unroll
      for (int j = 0; j < 16; ++j) { const int k_ = tk[j] & ~127; tvp[j] = __int_as_float(k_ ^ ((k_ >> 31) & 0x7fffffff)); tip[j] = 127 - (tk[j] & 127); } }
    __syncthreads();
    asm volatile("" : "+v"(tid));
    { const int tl = tid >> 4, hh = (tid >> 1) & 7, half = tid & 1;
      const LAS float* s1 = TV + (tl * 16 + 2 * hh) * 16; const LAS float* s2 = s1 + 16; const LAS int* i1 = TI + (tl * 16 + 2 * hh) * 16; const LAS int* i2 = i1 + 16;
      float b2[16];
#pragma unroll
      for (int j = 0; j < 16; ++j) b2[j] = s2[j];
      int tk[16];
#pragma unroll
      for (int j = 0; j < 16; ++j) tk[j] = (int)0x80000000;
#pragma unroll
      for (int ii = 0; ii < 8; ++ii) { const int i = 2 * ii + half; const float a = s1[i];
#pragma unroll
          for (int j = 0; j < 16; ++j) if ((2 * ii + 1) * (j + 1) <= 16) { if (half == 0 || (2 * ii + 2) * (j + 1) <= 16) PEER_INS(PEER_KEY(a + b2[j], 255 - (i * 16 + j), 255)); } }
      { int pk[16];
#pragma unroll
        for (int j = 0; j < 16; ++j) pk[j] = __shfl_xor(tk[j], 1);
#pragma unroll
        for (int j = 0; j < 16; ++j) PEER_INS(pk[j]); }
      if (half == 0) { float e[16], sum = 0.f; const int k0_ = tk[0] & ~255; const float v0 = __int_as_float(k0_ ^ ((k0_ >> 31) & 0x7fffffff));
#pragma unroll
        for (int j = 0; j < 16; ++j) { const int k_ = tk[j] & ~255; const float vj = __int_as_float(k_ ^ ((k_ >> 31) & 0x7fffffff)); e[j] = __builtin_amdgcn_exp2f((vj - v0) * 1.4426950408889634f); sum += e[j]; }
        const float inv = 1.0f / sum;
#pragma unroll
        for (int j = 0; j < 16; ++j) { const int ci = 255 - (tk[j] & 255); SE[tl * 128 + hh * 16 + j] = i1[ci >> 4] * 128 + i2[ci & 15]; SG[tl * 128 + hh * 16 + j] = e[j] * inv; } } }
#undef PEER_KEY
#undef PEER_INS
    __syncthreads();
}
__device__ __forceinline__ void peer_gather(int chunk, const bf16_t* __restrict__ H2, const unsigned char* __restrict__ U, const unsigned char* __restrict__ V,
                                            const float* __restrict__ g2, const float* __restrict__ gf, float* OUT, int tid, const LAS int* SE, const LAS float* SG) {
    asm volatile("" : "+v"(tid));
    const int tok0 = chunk * CH, lane = tid & 63, wave = tid >> 6;
    const rsrc_t rH2 = mk_rsrc(H2, 0x4000000u), rU = mk_rsrc(U, 0x1000000u), rV = mk_rsrc(V, 0x1000000u), rG2 = mk_rsrc(g2, 8192u), rGF = mk_rsrc(gf, 8192u);
#pragma unroll 1
    for (int tt = 0; tt < CH / NWAVES; ++tt) { const int tl = wave * (CH / NWAVES) + tt, tok = tok0 + tl;
      asm volatile("" ::: "memory");
      float hn[32]; float ss = 0.f;
#pragma unroll
      for (int j = 0; j < 2; ++j)
#pragma unroll
          for (int q = 0; q < 4; ++q) { const u32x2 w = ldb64(rH2, ((unsigned)tok * 2048u + 256u * (4 * j + q) + 4u * lane) * 2u);
              const f32x4 a = (f32x4){__uint_as_float(w.x << 16), __uint_as_float(w.x & 0xffff0000u), __uint_as_float(w.y << 16), __uint_as_float(w.y & 0xffff0000u)};
#pragma unroll
              for (int i = 0; i < 4; ++i) { hn[16 * j + 4 * q + i] = a[i]; ss += a[i] * a[i]; } }
      const float rstd = 1.0f / sqrtf(wave_sum(ss) * (1.f / 2048.f) + NORM_EPS);
#pragma unroll
      for (int j = 0; j < 2; ++j)
#pragma unroll
          for (int q = 0; q < 4; ++q) { const f32x4 a = ldf128(rG2, (256u * (4 * j + q) + 4u * lane) * 4u);
#pragma unroll
              for (int i = 0; i < 4; ++i) hn[16 * j + 4 * q + i] *= rstd * a[i]; }
      typedef _Float16 h2_t __attribute__((ext_vector_type(2)));
      h2_t hn16[16]; f32x2 accp[16];
#pragma unroll
      for (int k = 0; k < 16; ++k) { hn16[k] = (h2_t){(_Float16)hn[2 * k], (_Float16)hn[2 * k + 1]}; accp[k] = (f32x2){0.f, 0.f}; }
#define NX 4
#define PEER_LOAD(S, kb) do { _Pragma("unroll") for (int x = 0; x < NX; ++x) { const unsigned o = (unsigned)SE[tl * 128 + (kb) + x] * 1024u + (unsigned)lane * 16u; \
          S##u[x] = ldb128(rU, o); S##v[x] = ldb128(rV, o); } } while (0)
#define PEER_DU(W, k) dd = __builtin_amdgcn_fdot2(__builtin_amdgcn_cvt_scalef32_pk_f16_fp4(W[(k) >> 2], 1.0f, (k) & 3), hn16[k], dd, false);
#define PEER_DV(W, k) accp[k] = __builtin_elementwise_fma(__builtin_amdgcn_cvt_scalef32_pk_f32_fp4(W[(k) >> 2], 1.0f, (k) & 3), c2, accp[k]);
#define PEER_16(M, W) M(W, 0) M(W, 1) M(W, 2) M(W, 3) M(W, 4) M(W, 5) M(W, 6) M(W, 7) M(W, 8) M(W, 9) M(W, 10) M(W, 11) M(W, 12) M(W, 13) M(W, 14) M(W, 15)
#define PEER_COMPUTE(S, kb) do { float d[NX]; \
          _Pragma("unroll") for (int x = 0; x < NX; ++x) { const u32x4 W = S##u[x]; float dd = 0.f; PEER_16(PEER_DU, W) d[x] = dd; } \
          _Pragma("unroll") for (int o = 1; o < 64; o <<= 1) { _Pragma("unroll") for (int x = 0; x < NX; ++x) d[x] += __shfl_xor(d[x], o); } \
          float c[NX]; \
          _Pragma("unroll") for (int x = 0; x < NX; ++x) c[x] = SG[tl * 128 + (kb) + x] * gelu_tanh(d[x] * (1.f / PEER_U_SCALE)) * (1.f / PEER_V_SCALE); \
          _Pragma("unroll") for (int x = 0; x < NX; ++x) { const u32x4 W = S##v[x]; const f32x2 c2 = (f32x2){c[x], c[x]}; PEER_16(PEER_DV, W) } } while (0)
      { u32x4 Au[NX], Av[NX], Bu[NX], Bv[NX];
        PEER_LOAD(A, 0);
#pragma unroll 1
        for (int k = 0; k < 128; k += 2 * NX) {
            PEER_LOAD(B, k + NX); PEER_COMPUTE(A, k);
            { const int kn = min(k + 2 * NX, 128 - NX); PEER_LOAD(A, kn); }
            PEER_COMPUTE(B, k + NX);
        } }
#undef PEER_DU
#undef PEER_DV
#undef PEER_16
#undef NX
#undef PEER_LOAD
#undef PEER_COMPUTE
      asm volatile("" ::: "memory");
      int tok2 = tok, lane2 = lane; asm volatile("" : "+v"(tok2), "+v"(lane2));
      float s2 = 0.f;
#pragma unroll
      for (int j = 0; j < 2; ++j)
#pragma unroll
          for (int q = 0; q < 4; ++q) { const u32x2 w = ldb64(rH2, ((unsigned)tok2 * 2048u + 256u * (4 * j + q) + 4u * lane2) * 2u);
              const f32x4 a = (f32x4){__uint_as_float(w.x << 16), __uint_as_float(w.x & 0xffff0000u), __uint_as_float(w.y << 16), __uint_as_float(w.y & 0xffff0000u)};
#pragma unroll
              for (int i = 0; i < 4; ++i) { const int e_ = 16 * j + 4 * q + i; accp[e_ >> 1][e_ & 1] += a[i]; s2 += accp[e_ >> 1][e_ & 1] * accp[e_ >> 1][e_ & 1]; } }
      const float rf = 1.0f / sqrtf(wave_sum(s2) * (1.f / 2048.f) + NORM_EPS);
#pragma unroll
      for (int j = 0; j < 2; ++j)
#pragma unroll
          for (int q = 0; q < 4; ++q) { const f32x4 a = ldf128(rGF, (256u * (4 * j + q) + 4u * lane2) * 4u); f32x4 oa;
#pragma unroll
              for (int i = 0; i < 4; ++i) { const int e_ = 16 * j + 4 * q + i; oa[i] = accp[e_ >> 1][e_ & 1] * rf * a[i]; }
              float* op = OUT + (size_t)tok2 * 2048 + 256 * (4 * j + q) + 4 * lane2;
              __builtin_nontemporal_store(oa, (GAS f32x4*)op); }
    }
}
}
#ifndef MK_N_LAUNCHES
#define MK_N_LAUNCHES 1
#endif
#define MK_PROBE_PH -1
#define MK_PROBE_DIV 2
constexpr int N_PHASES = 9;
constexpr int N_LAUNCHES = MK_N_LAUNCHES;
struct Args { const float* in[19]; float* out; unsigned char* ws; int ph_lo, ph_hi; };
static_assert(sizeof(Args) == 19 * 8 + 8 + 8 + 8, "no padding");

__global__ void __launch_bounds__(NWAVES * 64, 2) hybrid_fwd(Args args) {
    extern __shared__ __attribute__((aligned(16))) unsigned char lds_raw[];
    Frame F;
    F.lds = (LAS unsigned char*)lds_raw;
    F.MISC = (volatile LAS unsigned*)(F.lds + MISC_OFF);
    F.tid = threadIdx.x; F.lane = F.tid & 63; F.wave = __builtin_amdgcn_readfirstlane(F.tid >> 6);
    F.G = gridDim.x; { const int bx = blockIdx.x; F.vcu = (F.G % 8 == 0) ? (bx % 8) * (F.G / 8) + bx / 8 : bx; }
    F.ws = args.ws; F.out = args.out;
#pragma unroll
    for (int i = 0; i < 19; ++i) F.in[i] = args.in[i];
    for (int u = F.tid; u < (LDS_BYTES - LDSCTL_OFF) / 4; u += NWAVES * 64) ((LAS unsigned*)(F.lds + LDSCTL_OFF))[u] = 0u;
    __syncthreads();
    XcdBarrier bar; bar.bar = (unsigned*)(F.ws + WS_CTL) + CW_BAR; bar.x = 0; bar.st = nullptr;
    if (N_LAUNCHES == 1) bar = xcd_barrier_post((unsigned*)(F.ws + WS_CTL) + CW_BAR, F.MISC + 8);
    const int lo = args.ph_lo, hi = args.ph_hi;
#define IN(k) (lo <= (k) && (k) < hi)
#if MK_PROBE_PH >= 0
    unsigned long long tp0 = (MK_PROBE_PH == 0 || MK_PROBE_PH == 9) ? __builtin_amdgcn_s_memrealtime() : 0ull, tp1 = 0ull;
#define SEAM(k) do { if (IN(k) && IN((k) + 1)) xcd_barrier(bar); if (MK_PROBE_PH == (k)) tp1 = __builtin_amdgcn_s_memrealtime(); if (MK_PROBE_PH == (k) + 1) tp0 = __builtin_amdgcn_s_memrealtime(); } while (0)
#else
#define SEAM(k) do { if (IN(k) && IN((k) + 1)) xcd_barrier(bar); } while (0)
#endif
    const size_t T2048 = (size_t)256 * 2048 * 2, T1024 = (size_t)256 * 1024 * 2, T512 = (size_t)256 * 512 * 2;
    float* cosT = WSP(float, WS_COS); float* sinT = WSP(float, WS_SIN);
    float* ssq_q = WSP(float, WS_SSQ_Q); float* ssq_kv = WSP(float, WS_SSQ_KV); float* ssq2 = WSP(float, WS_SSQ_2);

    if (IN(0)) { p0_prologue<0>(F, F.vcu, F.G); } SEAM(0);
    if (IN(1)) {
        SchedP1 S{F.G, (int)blockIdx.x, (const char*)(F.ws + WS_HN1), (const char*)(F.ws + WS_WIN), (const char*)(F.ws + WS_WVT), T1024};
        EpiP1 E{WSP(unsigned char, WS_NAQ), WSP(unsigned char, WS_NAK), WSP(unsigned char, WS_VT), WSP(unsigned char, WS_CQ), WSP(unsigned char, WS_CKV), WSP(unsigned char, WS_KR), WSP(unsigned char, WS_GA), WSP(unsigned char, WS_GB), ssq_q, ssq_kv, cosT, sinT};
        pg8::gemm_phase<EpiP1, SchedP1, true, -6>(F.lds, 2048, S, E);
        { const int extra = P1_UNITS % F.G, bx = (int)blockIdx.x; if (extra != 0 && bx >= extra) p0_prologue<1>(F, bx - extra, F.G - extra); else if (extra == 0) p0_prologue<1>(F, bx, F.G); }
    } SEAM(1);
    if (IN(2)) {
        LAS float* relb = (LAS float*)F.lds + 64; LAS float* metab = relb + 16 * 15 * 31 + 128; LAS float* wsf = metab + 256 + F.wave * 64;
        for (int i = F.tid; i < 16 * 15 * 31; i += NWAVES * 64) relb[i] = F.in[4][i];
        if (F.tid < 256) metab[F.tid] = F.in[5][F.tid];
        __syncthreads();
        const int gw = F.vcu * NWAVES + F.wave, NGW = F.G * NWAVES;
        for (int task = gw; task < NBATCH * 16 * 32 * 2; task += NGW)
            att::na_task(task, WSP(unsigned char, WS_NAQ), WSP(unsigned char, WS_NAK), WSP(unsigned char, WS_VT), WSP(unsigned char, WS_ONA), relb, metab, wsf, F.lane);
        __syncthreads();
    } SEAM(2);
    if (IN(3)) {
        SchedP3 S{F.G, (int)blockIdx.x, (const char*)F.ws, T512 / 2};
        EpiP3 E{WSP(unsigned char, WS_QM), WSP(unsigned char, WS_KN), WSP(unsigned char, WS_VV), ssq_q, ssq_kv, cosT, sinT};
        pg8::gemm_phase<EpiP3, SchedP3, true, -4>(F.lds, 512, S, E);
    } SEAM(3);
    if (IN(4)) {
        const int gw = F.vcu * NWAVES + F.wave, NGW = F.G * NWAVES;
        Conv cv{F.in[16], F.in[17], WSP(unsigned char, WS_U), WSP(unsigned char, WS_V), F.lds + 65536 + F.wave * 8192, gw, NGW, 2 * 16384, -1, 0};
        for (int id = F.vcu; id < NBATCH * 16 * 8; id += F.G) { const int bh = id >> 3, qb = id & 7;
            att::mla_unit8(bh >> 4, bh & 15, qb, WSP(unsigned char, WS_QM), WSP(unsigned char, WS_KN), WSP(unsigned char, WS_KR), WSP(unsigned char, WS_VV), WSP(unsigned char, WS_OMLA), (LAS char*)F.lds, cv); }
        while (cv.pend >= 0 || cv.next < cv.end) conv_step<0>(cv, F.lane);
        __syncthreads();
    } SEAM(4);
    if (IN(5)) {
        { SchedGrid S{F.G, (int)blockIdx.x, 64, 8, (const char*)(F.ws + WS_ONA), (const char*)(F.ws + WS_WNA), T512};
          EpiP5a E{WSP(unsigned char, WS_GA), WSP(unsigned char, WS_T1)};
          pg8::gemm_phase<EpiP5a, SchedGrid, true, -9>(F.lds, 1024, S, E); }
        { SchedGrid S{F.G, (int)blockIdx.x, 64, 8, (const char*)(F.ws + WS_OMLA), (const char*)(F.ws + WS_WMLA), T1024};
          EpiP5b E{WSP(unsigned char, WS_GB), WSP(unsigned char, WS_T1), WSP(unsigned char, WS_MERGED)};
          pg8::gemm_phase<EpiP5b, SchedGrid, true, -11>(F.lds, 2048, S, E); }
    } SEAM(5);
    if (IN(6)) {
        { SchedGrid S{F.G, (int)blockIdx.x, 64, 8, (const char*)(F.ws + WS_MERGED), (const char*)(F.ws + WS_WOUT), T1024};
          EpiP6 E{F.in[0], WSP(bf16_t, WS_H2B), ssq2};
          pg8::gemm_phase<EpiP6, SchedGrid, true, -11>(F.lds, 2048, S, E); }
    } SEAM(6);
    if (IN(7)) {
        SchedGrid S{F.G, (int)blockIdx.x, 64, 8, (const char*)(F.ws + WS_H2B), (const char*)(F.ws + WS_WSC), T2048};
        EpiP7 E{ssq2, WSP(_Float16, WS_SC)};
        pg8::gemm_phase<EpiP7, SchedGrid>(F.lds, 2048, S, E);
    } SEAM(7);
    if (IN(8)) {
        const int nch = (MREAL / peer::CH - F.vcu + F.G - 1) / F.G; const bool both_first = (nch == 2) && (F.vcu & 1);
        for (int op = 0; op < 2 * nch; ++op) {
            const bool sel = both_first ? (op < 2) : !(op & 1); const int ci = both_first ? (op & 1) : (op >> 1), chunk = F.vcu + ci * F.G;
            const int b2 = both_first ? ci : 0;
            LAS int* SE = (LAS int*)(F.lds + (b2 ? peer::OFF_SE2 : peer::OFF_SE)); LAS float* SG = (LAS float*)(F.lds + (b2 ? peer::OFF_SG2 : peer::OFF_SG));
            if (sel) peer::peer_select(chunk, WSP(_Float16, WS_SC), (LAS char*)F.lds, F.tid, SE, SG);
            else peer::peer_gather(chunk, WSP(bf16_t, WS_H2B), WSP(unsigned char, WS_U), WSP(unsigned char, WS_V), F.in[13], F.in[18], F.out, F.tid, SE, SG); }
    }
#if MK_PROBE_PH >= 0
    xcd_barrier(bar); tp1 = (MK_PROBE_PH >= 8) ? __builtin_amdgcn_s_memrealtime() : tp1;
    if (blockIdx.x == 0 && F.tid == 0) F.out[0] = (float)(tp1 - tp0) * (0.01f / MK_PROBE_DIV);
#endif
#undef IN
#undef SEAM
}

extern "C" void kernel_launch(void* const* d_in, const int* in_sizes, int n_in, void* d_out, int out_size, void* d_ws, size_t ws_size, hipStream_t stream) {
    static int grid = 0;
    if (grid == 0) {
        if (n_in != 19 || in_sizes[0] != MREAL * DM || out_size != MREAL * DM || ws_size < WS_END) {
            fprintf(stderr, "kernel_launch: shape/workspace mismatch: n_in %d in0 %d out %d ws %zu (need %zu); nothing launched\n", n_in, n_in > 0 ? in_sizes[0] : -1, out_size, ws_size, (size_t)WS_END); grid = -1; return; }
        int dev = 0, cus = 0, per_cu = 0;
        if (hipGetDevice(&dev) != hipSuccess || hipDeviceGetAttribute(&cus, hipDeviceAttributeMultiprocessorCount, dev) != hipSuccess) { fprintf(stderr, "kernel_launch: device query failed\n"); grid = -1; return; }
        if (hipFuncSetAttribute((const void*)hybrid_fwd, hipFuncAttributeMaxDynamicSharedMemorySize, LDS_BYTES) != hipSuccess) { fprintf(stderr, "kernel_launch: hipFuncSetAttribute failed\n"); grid = -1; return; }
        if (hipOccupancyMaxActiveBlocksPerMultiprocessor(&per_cu, (const void*)hybrid_fwd, NWAVES * 64, LDS_BYTES) != hipSuccess || per_cu < 1)
            fprintf(stderr, "kernel_launch: note: occupancy query reports %d workgroups per CU\n", per_cu);
        (void)hipGetLastError();
        grid = cus;
    }
    if (grid < 0) return;
    if (hipMemsetAsync((char*)d_ws + WS_CTL, 0, CTL_ZERO_BYTES, stream) != hipSuccess) { fprintf(stderr, "kernel_launch: hipMemsetAsync failed\n"); return; }
    Args a{};
    for (int i = 0; i < 19; ++i) a.in[i] = (const float*)d_in[i];
    a.out = (float*)d_out; a.ws = (unsigned char*)d_ws;
    for (int li = 0; li < N_LAUNCHES; ++li) {
        a.ph_lo = (N_LAUNCHES == 1) ? 0 : li; a.ph_hi = (N_LAUNCHES == 1) ? N_PHASES : li + 1;
        hipLaunchKernelGGL(hybrid_fwd, dim3(grid), dim3(NWAVES * 64), LDS_BYTES, stream, a);
        const hipError_t le = hipPeekAtLastError();
        if (le != hipSuccess) { fprintf(stderr, "kernel_launch: launch %d failed: %s\n", li, hipGetErrorName(le)); break; }
    }
}
```

```cpp
#include <hip/hip_runtime.h>
#include <cstdio>
#include <cstdint>

#define LAS __attribute__((address_space(3)))
#define GAS __attribute__((address_space(1)))
typedef unsigned short bf16_t;
typedef short bf16x8 __attribute__((ext_vector_type(8)));
typedef short s16x4 __attribute__((ext_vector_type(4)));
typedef float f32x4 __attribute__((ext_vector_type(4)));
typedef float f32x2 __attribute__((ext_vector_type(2)));
typedef float f32x16 __attribute__((ext_vector_type(16)));
typedef unsigned u32x4 __attribute__((ext_vector_type(4)));
typedef unsigned u32x2 __attribute__((ext_vector_type(2)));

constexpr int DM = 2048, NBATCH = 8, SEQ = 2048, NMETA = 16;
constexpr int MREAL = NBATCH * SEQ;
constexpr int MPAD = MREAL + 256;
constexpr int NPOS = SEQ + NMETA;
constexpr float NORM_EPS = 1e-6f;
constexpr int C_NAQ = 0, C_NAK = 1024, C_CQ = 2048, C_CKV = 2560, C_GA = 3072, C_GB = 5120, C_KR = 7168, NMAIN = 7424;
constexpr int VT_PITCH = MPAD;

constexpr size_t MiB = 1u << 20;
constexpr size_t WS_CTL = 0, CTL_ZERO_BYTES = 1 * MiB;
constexpr size_t WS_SSQ_Q = 481 * MiB, WS_SSQ_KV = 482 * MiB, WS_SSQ_2 = 486 * MiB;
constexpr size_t WS_COS = 1 * MiB, WS_SIN = 1 * MiB + 512 * 1024;
constexpr size_t WS_WUQ = 2 * MiB, WS_WUKV = 5 * MiB, WS_WNA = 9 * MiB, WS_WMLA = 13 * MiB, WS_WOUT = 21 * MiB, WS_WSC = 29 * MiB;
constexpr size_t WS_GA = 37 * MiB, WS_GB = 101 * MiB;
constexpr size_t WS_KR = 165 * MiB;
constexpr size_t WS_WIN = 167 * MiB + 256 * 1024, WS_WVT = WS_WIN + 29 * MiB;
constexpr size_t WS_ONA = 190 * MiB;
constexpr size_t WS_NAQ = 222 * MiB, WS_NAK = 254 * MiB, WS_VT = WS_NAK + 32 * MiB + 512 * 1024;
constexpr size_t WS_HN1 = 319 * MiB;
constexpr size_t WS_CQ = 448 * MiB, WS_CKV = 464 * MiB;
constexpr size_t WS_QM = 222 * MiB, WS_KN = 318 * MiB, WS_VV = 383 * MiB;
constexpr size_t WS_OMLA = 448 * MiB;
constexpr size_t WS_MERGED = 222 * MiB, WS_T1 = 286 * MiB;
constexpr size_t WS_H2 = 37 * MiB, WS_H2B = 293 * MiB;
constexpr size_t WS_U = 69 * MiB, WS_V = 133 * MiB;
constexpr size_t WS_SC = 165 * MiB;
constexpr size_t WS_END = 512 * MiB;
static_assert(WS_CKV + (size_t)MPAD * 512 * 2 <= WS_SSQ_Q && WS_SSQ_Q + (size_t)8 * MPAD * 4 <= WS_SSQ_KV && WS_SSQ_KV + (size_t)8 * MPAD * 4 <= 483 * MiB && WS_SSQ_2 + (size_t)32 * MREAL * 4 <= WS_END, "ssq slabs");
static_assert(WS_VT + (size_t)1024 * MPAD * 2 <= WS_HN1 && WS_HN1 + (size_t)MPAD * 2048 * 2 <= WS_CQ && WS_CKV + (size_t)MPAD * 512 * 2 <= WS_END, "map P1");
static_assert(WS_WVT + 4 * MiB <= WS_NAQ && WS_KR + (size_t)MPAD * 64 * 2 <= WS_WIN && WS_ONA + 32 * MiB <= WS_NAQ, "map P1b");
static_assert(WS_QM + 96 * MiB <= WS_KN && WS_KN + 65 * MiB <= WS_VV && WS_VV + 65 * MiB <= WS_OMLA && WS_OMLA + 64 * MiB <= WS_END, "map P3");
static_assert(WS_T1 + 128 * MiB <= WS_OMLA && WS_H2 + 128 * MiB <= WS_KR && WS_SC + 128 * MiB <= WS_H2B && WS_H2B + 64 * MiB <= WS_END, "map P5+");
static_assert(WS_GA + 32 * MiB <= WS_U && WS_U + 24 * MiB <= WS_GB && WS_GB + 32 * MiB <= WS_V && WS_V + 24 * MiB <= WS_KR, "expert tables between the gate codes");

constexpr int CW_BAR = 4096;
constexpr float PEER_U_SCALE = 90.50966799f, PEER_V_SCALE = 5.656854249f;

constexpr int RING_BYTES = 131072;
constexpr int LDSCTL_OFF = RING_BYTES, MISC_OFF = LDSCTL_OFF + 320;
constexpr int LDS_BYTES = 147456;
constexpr int NWAVES = 8;

#define LDS_WAIT() asm volatile("s_waitcnt lgkmcnt(0)" ::: "memory")
#define VM_WAIT() asm volatile("s_waitcnt vmcnt(0)" ::: "memory")
#define SBAR() __builtin_amdgcn_sched_barrier(0)
typedef __bf16 bf16x2_t __attribute__((ext_vector_type(2)));
__device__ __forceinline__ unsigned cvt_pk_bf16(float lo, float hi) { const f32x2 v = {lo, hi}; const bf16x2_t b = __builtin_convertvector(v, bf16x2_t); return __builtin_bit_cast(unsigned, b); }
__device__ __forceinline__ float bf_lo(unsigned w) { return __uint_as_float(w << 16); }
__device__ __forceinline__ float bf_hi(unsigned w) { return __uint_as_float(w & 0xffff0000u); }
__device__ __forceinline__ u32x4 pack8(const f32x4 a, const f32x4 b) { u32x4 w; w.x = cvt_pk_bf16(a[0], a[1]); w.y = cvt_pk_bf16(a[2], a[3]); w.z = cvt_pk_bf16(b[0], b[1]); w.w = cvt_pk_bf16(b[2], b[3]); return w; }
__device__ __forceinline__ u32x2 pack8_fp8(f32x4 a, f32x4 b) {
#pragma unroll
    for (int i = 0; i < 4; ++i) { a[i] = __builtin_fminf(__builtin_fmaxf(a[i], -448.f), 448.f); b[i] = __builtin_fminf(__builtin_fmaxf(b[i], -448.f), 448.f); }
    int w0 = 0, w1 = 0; w0 = __builtin_amdgcn_cvt_pk_fp8_f32(a[0], a[1], w0, false); w0 = __builtin_amdgcn_cvt_pk_fp8_f32(a[2], a[3], w0, true);
    w1 = __builtin_amdgcn_cvt_pk_fp8_f32(b[0], b[1], w1, false); w1 = __builtin_amdgcn_cvt_pk_fp8_f32(b[2], b[3], w1, true); return (u32x2){(unsigned)w0, (unsigned)w1}; }
__device__ __forceinline__ unsigned char f32_to_fp8(float x) { x = __builtin_fminf(__builtin_fmaxf(x, -448.f), 448.f); return (unsigned char)(__builtin_amdgcn_cvt_pk_fp8_f32(x, 0.f, 0, false) & 0xff); }
__device__ __forceinline__ u32x2 pack8_u8(const f32x4 a, const f32x4 b) { u32x2 w; unsigned x = 0u, y = 0u;
    x = __builtin_amdgcn_cvt_pk_u8_f32(a[0] * 255.f, 0u, x); x = __builtin_amdgcn_cvt_pk_u8_f32(a[1] * 255.f, 1u, x); x = __builtin_amdgcn_cvt_pk_u8_f32(a[2] * 255.f, 2u, x); x = __builtin_amdgcn_cvt_pk_u8_f32(a[3] * 255.f, 3u, x);
    y = __builtin_amdgcn_cvt_pk_u8_f32(b[0] * 255.f, 0u, y); y = __builtin_amdgcn_cvt_pk_u8_f32(b[1] * 255.f, 1u, y); y = __builtin_amdgcn_cvt_pk_u8_f32(b[2] * 255.f, 2u, y); y = __builtin_amdgcn_cvt_pk_u8_f32(b[3] * 255.f, 3u, y);
    w.x = x; w.y = y; return w; }
__device__ __forceinline__ unsigned pack4_fp8(f32x4 a) {
#pragma unroll
    for (int i = 0; i < 4; ++i) a[i] = __builtin_fminf(__builtin_fmaxf(a[i], -448.f), 448.f);
    int w0 = 0; w0 = __builtin_amdgcn_cvt_pk_fp8_f32(a[0], a[1], w0, false); w0 = __builtin_amdgcn_cvt_pk_fp8_f32(a[2], a[3], w0, true); return (unsigned)w0; }
__device__ __forceinline__ void unpack8_fp8(const u32x2 w, f32x4& a, f32x4& b) {
    const f32x2 a0 = __builtin_amdgcn_cvt_pk_f32_fp8((int)w.x, false), a1 = __builtin_amdgcn_cvt_pk_f32_fp8((int)w.x, true), b0 = __builtin_amdgcn_cvt_pk_f32_fp8((int)w.y, false), b1 = __builtin_amdgcn_cvt_pk_f32_fp8((int)w.y, true);
    a = (f32x4){a0[0], a0[1], a1[0], a1[1]}; b = (f32x4){b0[0], b0[1], b1[0], b1[1]}; }
__device__ __forceinline__ void unpack8_u8(const u32x2 w, f32x4& a, f32x4& b) { const float k = 1.f / 255.f;
    a = (f32x4){(float)(w.x & 0xffu), (float)((w.x >> 8) & 0xffu), (float)((w.x >> 16) & 0xffu), (float)(w.x >> 24)} * k;
    b = (f32x4){(float)(w.y & 0xffu), (float)((w.y >> 8) & 0xffu), (float)((w.y >> 16) & 0xffu), (float)(w.y >> 24)} * k; }
__device__ __forceinline__ u32x2 pack4(const f32x4 a) { u32x2 w; w.x = cvt_pk_bf16(a[0], a[1]); w.y = cvt_pk_bf16(a[2], a[3]); return w; }
__device__ __forceinline__ float wave_sum(float v) {
#pragma unroll
    for (int o = 1; o < 64; o <<= 1) v += __shfl_xor(v, o);
    return v;
}
__device__ __forceinline__ float sigmoidf_(float x) { return __builtin_amdgcn_rcpf(1.0f + __builtin_amdgcn_exp2f(-1.4426950408889634f * x)); }
__device__ __forceinline__ int crow(int r, int hi) { return (r & 3) + 8 * (r >> 2) + 4 * hi; }
#define PG8_AUX 0
namespace pg8 {
constexpr int BM = 256, BK = 64, HALF = 128, HTB = HALF * BK * 2  , STAGE_BYTES = 8 * HTB, NXCD = 8, WGM = 8;
__host__ __device__ __forceinline__ int lds_byte(int r, int c) { const int st = (r >> 4) * 2 + (c >> 5), rr = r & 15, cc = c & 31, ob = rr * 64 + cc * 2; return st * 1024 + (ob ^ (((ob >> 9) & 1) << 5)); }
__host__ __device__ __forceinline__ void stage_rc(int b, int& R, int& C) { const int st = b / 1024, sb = b % 1024, swz = sb ^ (((sb >> 9) & 1) << 5); R = (st >> 1) * 16 + swz / 64; C = (st & 1) * 32 + (swz % 64) / 2; }
__host__ __device__ __forceinline__ int perm32(int rho) { const int n = rho >> 4, i = rho & 15; return 8 * (i >> 2) + 4 * n + (i & 3); }

struct Unit { int pm, pn, kind; };

__device__ __forceinline__ void grid_order(int L, int nM, int nN, int& pm, int& pn) {
    const int nwg = nM * nN; int wgid = L;
    { const int q = nwg / NXCD, r = nwg % NXCD, xcd = wgid % NXCD, off = wgid / NXCD; wgid = (xcd < r ? xcd * (q + 1) : r * (q + 1) + (xcd - r) * q) + off; }
    const int nig = WGM * nN, gid = wgid / nig, fm = gid * WGM, gsz = (nM - fm) < WGM ? (nM - fm) : WGM;
    pm = fm + ((wgid % nig) % gsz); pn = (wgid % nig) / gsz;
}

typedef int v8i_t __attribute__((ext_vector_type(8)));
template <class Epi, class Sched, bool F8 = false, int F8_SCALE_EXP = 0>
__device__ __forceinline__ void gemm_phase(LAS unsigned char* lds, const int K, const Sched& S, const Epi& E) {
    const int tid = threadIdx.x, wid = __builtin_amdgcn_readfirstlane(tid >> 6), lane = tid & 63, wr = wid >> 2, wc = wid & 3, fr = lane & 15, fq = lane >> 4;
    int f8sa = 0x01010101 * (127 + F8_SCALE_EXP), f8sb = 0x7f7f7f7f; asm volatile("" : "+v"(f8sa), "+v"(f8sb));
    const int Kb = F8 ? K : 2 * K;
    const int nt = Kb / 128;
    unsigned voffA[2], voffB[2];
#pragma unroll
    for (int i = 0; i < 2; ++i) { int R, C; stage_rc(tid * 16 + i * 8192, R, C); const int Rb = Epi::PERM ? ((R & ~31) + perm32(R & 31)) : R;
        voffA[i] = (unsigned)(R * Kb + C * 2); voffB[i] = (unsigned)(Rb * Kb + C * 2); }
    const size_t kstep = (size_t)128;
    const size_t hstep = (size_t)HALF * Kb;
    const unsigned ldsw = (unsigned)wid * 1024u;
    const int aoff = lds_byte(wr * 64 + fr, F8 ? fq * 16 : fq * 8), boff = lds_byte(wc * 32 + fr, F8 ? fq * 16 : fq * 8);
#define PG8_SA(b, h) (((b) * 2 + (h)) * HTB)
#define PG8_SB(b, h) ((4 + (b) * 2 + (h)) * HTB)
#define PG8_STAGE(bufoff, gbase, voff) do { _Pragma("unroll") for (int _i = 0; _i < 2; ++_i) \
        __builtin_amdgcn_global_load_lds((const unsigned*)((const char*)(gbase) + (voff)[_i]), (LAS unsigned*)(lds + (bufoff) + ldsw + _i * 8192), 16, 0, PG8_AUX); } while (0)
#define PG8_LDA(dst, b, h) do { _Pragma("unroll") for (int m = 0; m < 4; ++m) _Pragma("unroll") for (int k = 0; k < 2; ++k) dst[m][k] = *(const LAS bf16x8*)(lds + PG8_SA(b, h) + aoff + m * 2048 + (F8 ? k * 16 : k * 1024)); } while (0)
#define PG8_LDB(dst, b, h) do { _Pragma("unroll") for (int n = 0; n < 2; ++n) _Pragma("unroll") for (int k = 0; k < 2; ++k) dst[n][k] = *(const LAS bf16x8*)(lds + PG8_SB(b, h) + boff + n * 2048 + (F8 ? k * 16 : k * 1024)); } while (0)
#define PG8_F8OP(X) __builtin_bit_cast(v8i_t, __builtin_shufflevector(X[0], X[1], 0, 1, 2, 3, 4, 5, 6, 7, 8, 9, 10, 11, 12, 13, 14, 15))
#define PG8_MMA(ai, bj, At, Bt) do { __builtin_amdgcn_s_setprio(1); \
        if constexpr (F8) { _Pragma("unroll") for (int m = 0; m < 4; ++m) _Pragma("unroll") for (int n = 0; n < 2; ++n) \
            asm volatile("v_mfma_scale_f32_16x16x128_f8f6f4 %0, %1, %2, %0, %3, %4 op_sel_hi:[0,0,0]" : "+v"(acc[ai][bj][m][n]) : "v"(PG8_F8OP(Bt[n])), "v"(PG8_F8OP(At[m])), "v"(f8sa), "v"(f8sb)); } \
        else { _Pragma("unroll") for (int m = 0; m < 4; ++m) _Pragma("unroll") for (int n = 0; n < 2; ++n) _Pragma("unroll") for (int k = 0; k < 2; ++k) \
            acc[ai][bj][m][n] = __builtin_amdgcn_mfma_f32_16x16x32_bf16(Bt[n][k], At[m][k], acc[ai][bj][m][n], 0, 0, 0); } \
        __builtin_amdgcn_s_setprio(0); } while (0)
#define PG8_WAIT_V(n) asm volatile("s_waitcnt vmcnt(" #n ")" ::: "memory")
#define PG8_WAIT_L(n) asm volatile("s_waitcnt lgkmcnt(" #n ")" ::: "memory")
#define PG8_BAR __builtin_amdgcn_s_barrier()
#define PG8_SCHED __builtin_amdgcn_sched_barrier(0)
    Unit cur, nxt; int ui = 0;
    if (!S.next(0, cur)) return;
    f32x4 acc[2][2][4][2];
#pragma unroll
    for (int a = 0; a < 2; ++a)
#pragma unroll
        for (int b = 0; b < 2; ++b)
#pragma unroll
            for (int m = 0; m < 4; ++m)
#pragma unroll
                for (int n = 0; n < 2; ++n) acc[a][b][m][n] = (f32x4){0.f, 0.f, 0.f, 0.f};
    bf16x8 At[4][2], B0[2][2], B1[2][2];
    const char* cA = S.pa(cur); const char* cB = S.pb(cur);
    PG8_STAGE(PG8_SB(0, 0), cB, voffB); PG8_STAGE(PG8_SB(0, 1), cB + hstep, voffB); PG8_STAGE(PG8_SA(0, 0), cA, voffA); PG8_STAGE(PG8_SA(0, 1), cA + hstep, voffA);
    if (wr == 1) PG8_BAR;
    PG8_WAIT_V(2); PG8_BAR;
    PG8_STAGE(PG8_SB(1, 0), cB + kstep, voffB); PG8_STAGE(PG8_SA(1, 0), cA + kstep, voffA); PG8_STAGE(PG8_SB(1, 1), cB + hstep + kstep, voffB);
    PG8_WAIT_V(6); PG8_BAR;
    for (;;) {
        const bool has_next = S.next(ui + 1, nxt);
        const char* nA = has_next ? S.pa(nxt) : cA; const char* nB = has_next ? S.pb(nxt) : cB;
        for (int t = 0; t < nt; t += 2) {
            const bool last = (t == nt - 2);
            const char* a1 = cA + (size_t)(t + 1) * kstep;
            const char* a2 = last ? nA : cA + (size_t)(t + 2) * kstep; const char* b2 = last ? nB : cB + (size_t)(t + 2) * kstep;
            const char* a3 = a2 + kstep; const char* b3 = b2 + kstep;
            PG8_LDB(B0, 0, 0); PG8_LDB(B1, 0, 1); PG8_SCHED; PG8_LDA(At, 0, 0); PG8_STAGE(PG8_SA(1, 1), a1 + hstep, voffA);
            PG8_WAIT_V(8); PG8_WAIT_L(0); PG8_BAR; PG8_MMA(0, 0, At, B0); PG8_MMA(0, 1, At, B1); PG8_BAR; PG8_SCHED;
            PG8_LDA(At, 0, 1); PG8_STAGE(PG8_SB(0, 0), b2, voffB); PG8_STAGE(PG8_SB(0, 1), b2 + hstep, voffB); PG8_STAGE(PG8_SA(0, 0), a2, voffA);
            PG8_WAIT_V(8); PG8_WAIT_L(0); PG8_BAR; PG8_MMA(1, 0, At, B0); PG8_MMA(1, 1, At, B1); PG8_BAR; PG8_SCHED;
            PG8_LDB(B0, 1, 0); PG8_LDB(B1, 1, 1); PG8_SCHED; PG8_LDA(At, 1, 0); PG8_STAGE(PG8_SA(0, 1), a2 + hstep, voffA);
            PG8_WAIT_V(8); PG8_WAIT_L(0); PG8_BAR; PG8_MMA(0, 0, At, B0); PG8_MMA(0, 1, At, B1); PG8_BAR; PG8_SCHED;
            PG8_LDA(At, 1, 1); PG8_STAGE(PG8_SB(1, 0), b3, voffB); PG8_STAGE(PG8_SB(1, 1), b3 + hstep, voffB); PG8_STAGE(PG8_SA(1, 0), a3, voffA);
            PG8_WAIT_V(8); PG8_WAIT_L(0); PG8_BAR; PG8_MMA(1, 0, At, B0); PG8_MMA(1, 1, At, B1); PG8_BAR; PG8_SCHED;
        }
        if (wr == 0) PG8_BAR;
        if constexpr (F8) asm volatile("s_nop 15\n\ts_nop 7" ::: "memory");
        if constexpr (Epi::HAS_PRE) {
            E.pre(cur, (LAS float*)(lds + STAGE_BYTES + 1024), tid); PG8_WAIT_L(0); PG8_BAR; }
        E(acc, cur, wr, wc, fr, fq, (const LAS float*)(lds + STAGE_BYTES + 1024));
        if (!has_next) break;
#pragma unroll
        for (int a = 0; a < 2; ++a)
#pragma unroll
            for (int b = 0; b < 2; ++b)
#pragma unroll
                for (int m = 0; m < 4; ++m)
#pragma unroll
                    for (int n = 0; n < 2; ++n) acc[a][b][m][n] = (f32x4){0.f, 0.f, 0.f, 0.f};
        cur = nxt; cA = nA; cB = nB; ++ui;
        if (wr == 1) PG8_BAR;
    }
    PG8_WAIT_V(0);
    PG8_BAR;
#undef PG8_SA
#undef PG8_SB
#undef PG8_STAGE
#undef PG8_LDA
#undef PG8_LDB
#undef PG8_MMA
#undef PG8_F8OP
#undef PG8_WAIT_V
#undef PG8_WAIT_L
#undef PG8_BAR
#undef PG8_SCHED
}
}
typedef GAS unsigned gu32;
#define RLX_AGENT __ATOMIC_RELAXED, __HIP_MEMORY_SCOPE_AGENT
#define XB_TMO      128
#define XB_XCNT(j)  (256  + 64 * (j))
#define XB_XSUB(j)  (1280 + 64 * (j))
#define XB_XGEN(j)  (2304 + 64 * (j))
#define XB_TOP      3328
#define XB_TOPGEN   3392
#define XCD_BAR_WORDS 3456
#define XB_SPIN_CAP (1u << 18)
__device__ __forceinline__ unsigned xb_ld(unsigned* p)              { return __hip_atomic_load(p, __ATOMIC_RELAXED, __HIP_MEMORY_SCOPE_AGENT); }
__device__ __forceinline__ unsigned xb_add(unsigned* p, unsigned v) { return __hip_atomic_fetch_add(p, v, __ATOMIC_RELAXED, __HIP_MEMORY_SCOPE_AGENT); }
__device__ __forceinline__ unsigned xb_xcc_id() { return (unsigned)__builtin_amdgcn_s_getreg((3 << 11) | 20) & 0xFu; }
#define XB_SPIN(cond, bar) do { unsigned _sp = 0; while (cond) { __builtin_amdgcn_s_sleep(1); \
    if ((++_sp & 255u) == 0u) { if (xb_ld(&(bar)[XB_TMO])) break; if (_sp > XB_SPIN_CAP) { atomicAdd(&(bar)[XB_TMO], 1u); break; } } } } while (0)
struct XcdBarrier { unsigned* bar; unsigned x; volatile LAS unsigned* st; };
__device__ __forceinline__ XcdBarrier xcd_barrier_post(unsigned* bar, volatile LAS unsigned* st) {
    XcdBarrier b; b.bar = bar; b.x = xb_xcc_id(); b.st = st;
    if (threadIdx.x == 0) (void)xb_add(&bar[XB_XCNT(b.x)], 1u);
    return b;
}
__device__ __forceinline__ void xcd_barrier_complete(unsigned* bar, unsigned x, unsigned& nloc, unsigned& nx) {
    const unsigned G = gridDim.x * gridDim.y * gridDim.z;
    unsigned sum, cnt, mine, sp = 0u;
    for (;;) {
        sum = 0u; cnt = 0u; mine = 0u;
#pragma unroll
        for (unsigned j = 0; j < 16; ++j) { const unsigned c = xb_ld(&bar[XB_XCNT(j)]); sum += c; cnt += (c > 0u) ? 1u : 0u; mine = (j == x) ? c : mine; }
        if (sum == G) break;
        __builtin_amdgcn_s_sleep(1);
        if ((++sp & 255u) == 0u) { if (xb_ld(&bar[XB_TMO])) break; if (sp > XB_SPIN_CAP) { atomicAdd(&bar[XB_TMO], 1u); break; } }
    }
    nloc = mine > 0u ? mine : 1u; nx = cnt > 0u ? cnt : 1u;
}
__device__ __forceinline__ void xcd_barrier(const XcdBarrier& b) {
    asm volatile("s_waitcnt vmcnt(0)" ::: "memory");
    __syncthreads();
    if (threadIdx.x == 0) {
        unsigned* bar = b.bar;
        __builtin_amdgcn_s_waitcnt(0);
        unsigned nloc = b.st[0], nx = b.st[1];
        if (nloc == 0u) { xcd_barrier_complete(bar, b.x, nloc, nx); b.st[0] = nloc; b.st[1] = nx; }
        const unsigned old = xb_add(&bar[XB_XSUB(b.x)], 1u);
        const unsigned gen = old / nloc;
        if (old + 1u == (gen + 1u) * nloc) {
            __builtin_amdgcn_fence(__ATOMIC_RELEASE, "agent");
            asm volatile("s_waitcnt vmcnt(0)" ::: "memory");
            const unsigned og = xb_add(&bar[XB_TOP], 1u);
            const unsigned tg = og / nx;
            if (og + 1u == (tg + 1u) * nx) xb_add(&bar[XB_TOPGEN], 1u);
            else XB_SPIN(xb_ld(&bar[XB_TOPGEN]) == tg, bar);
            __builtin_amdgcn_fence(__ATOMIC_ACQUIRE, "agent");
            xb_add(&bar[XB_XGEN(b.x)], 1u);
            asm volatile("s_waitcnt vmcnt(0)" ::: "memory");
        } else {
            XB_SPIN(xb_ld(&bar[XB_XGEN(b.x)]) == gen, bar);
            __builtin_amdgcn_fence(__ATOMIC_ACQUIRE, "agent");
            asm volatile("s_waitcnt vmcnt(0)" ::: "memory");
        }
    }
    __syncthreads();
}
struct Frame {
    LAS unsigned char* lds;
    volatile LAS unsigned* MISC;
    unsigned char* ws;
    int tid, lane, wave;
    int vcu, G;
    const float* in[19];
    float* out;
};
#define WSP(T, off) ((T*)(F.ws + (off)))

typedef float cv16f_t __attribute__((ext_vector_type(16)));
typedef unsigned cv6u_t __attribute__((ext_vector_type(6)));
struct Conv { const float* pu; const float* pv; unsigned char* u8; unsigned char* v8; LAS unsigned char* lbuf; int next, stride, end, pend, tick; };
__device__ __forceinline__ void conv_issue(const Conv& c, int item, int lane) {
    const float* src = ((item >> 14) ? c.pv : c.pu) + (size_t)(item & 16383) * 2048 + 4 * lane;
#pragma unroll
    for (int q = 0; q < 8; ++q) __builtin_amdgcn_global_load_lds((const unsigned*)(src + 256 * q), (LAS unsigned*)(c.lbuf + q * 1024), 16, 0, 0);
}
__device__ __forceinline__ void conv_finish(const Conv& c, int item, int lane) {
    const int isv = item >> 14, row = item & 16383; const float sc = isv ? PEER_V_SCALE : PEER_U_SCALE; unsigned w[4] = {0u, 0u, 0u, 0u};
#define CONV_Q(q) { const f32x4 x = *(const LAS f32x4*)(c.lbuf + (q) * 1024 + lane * 16) * sc; \
        w[(q) >> 1] = __builtin_amdgcn_cvt_scalef32_pk_fp4_f32(w[(q) >> 1], x[0], x[1], 1.0f, (2 * (q)) & 3); w[(q) >> 1] = __builtin_amdgcn_cvt_scalef32_pk_fp4_f32(w[(q) >> 1], x[2], x[3], 1.0f, (2 * (q) + 1) & 3); }
    CONV_Q(0) asm volatile("" : "+v"(w[0]) :: "memory"); CONV_Q(1) asm volatile("" : "+v"(w[0]) :: "memory"); CONV_Q(2) asm volatile("" : "+v"(w[1]) :: "memory"); CONV_Q(3) asm volatile("" : "+v"(w[1]) :: "memory");
    CONV_Q(4) asm volatile("" : "+v"(w[2]) :: "memory"); CONV_Q(5) asm volatile("" : "+v"(w[2]) :: "memory"); CONV_Q(6) asm volatile("" : "+v"(w[3]) :: "memory"); CONV_Q(7)
#undef CONV_Q
    unsigned char* rec = (isv ? c.v8 : c.u8) + (size_t)row * 1024;
    *(GAS u32x4*)(rec + lane * 16) = (u32x4){w[0], w[1], w[2], w[3]};
}
template <int YOUNGER>
__device__ __forceinline__ void conv_step(Conv& c, int lane) {
    if (c.pend >= 0) { if constexpr (YOUNGER == 0) asm volatile("s_waitcnt vmcnt(0)" ::: "memory"); else { static_assert(YOUNGER == 12, "wait count"); asm volatile("s_waitcnt vmcnt(12)" ::: "memory"); }
        conv_finish(c, c.pend, lane); c.pend = -1; asm volatile("s_waitcnt lgkmcnt(0)" ::: "memory"); }
    if (c.next < c.end) { conv_issue(c, c.next, lane); c.pend = c.next; c.next += c.stride; }
}
__device__ __forceinline__ void p0_transpose_item(const float* W, int K, int N, int k0, int n0, bf16_t* WT, int drow, bool rope, const float* gain, LAS float* scr, int lane) {
    { f32x4 v[8]; float gk[8];
#pragma unroll
      for (int i = 0; i < 8; ++i) { const int kk = 8 * i + (lane >> 3); v[i] = *(const GAS f32x4*)(W + (size_t)(k0 + kk) * N + n0 + 4 * (lane & 7)); gk[i] = gain ? gain[k0 + kk] : 1.f; }
#pragma unroll
      for (int i = 0; i < 8; ++i) { const int kk = 8 * i + (lane >> 3); LAS float* d = scr + kk * 33 + 4 * (lane & 7);
#pragma unroll
          for (int e = 0; e < 4; ++e) d[e] = v[i][e] * gk[i]; } }
    LDS_WAIT(); asm volatile("" ::: "memory");
    const int c = lane & 7;
#pragma unroll
    for (int j = 0; j < 4; ++j) { const int n = (lane >> 3) + 8 * j; const LAS float* s = scr + (8 * c) * 33 + n;
        u32x4 o; o.x = cvt_pk_bf16(s[0 * 33], s[1 * 33]); o.y = cvt_pk_bf16(s[2 * 33], s[3 * 33]); o.z = cvt_pk_bf16(s[4 * 33], s[5 * 33]); o.w = cvt_pk_bf16(s[6 * 33], s[7 * 33]);
        const int dr = drow + (rope ? (8 * (n >> 2) + (n & 3)) : n);
        *(GAS u32x4*)(WT + (size_t)dr * K + k0 + 8 * c) = o; }
    LDS_WAIT(); asm volatile("" ::: "memory");
}
__device__ __forceinline__ void p0_transpose_item8(const float* W, int K, int N, int k0, int n0, unsigned char* WT, int drow, bool rope, float scale, LAS float* scr, int lane, const float* gain = nullptr) {
    { f32x4 v[8]; float gk[8];
#pragma unroll
      for (int i = 0; i < 8; ++i) { const int kk = 8 * i + (lane >> 3); v[i] = *(const GAS f32x4*)(W + (size_t)(k0 + kk) * N + n0 + 4 * (lane & 7)); gk[i] = gain ? gain[k0 + kk] * scale : scale; }
#pragma unroll
      for (int i = 0; i < 8; ++i) { const int kk = 8 * i + (lane >> 3); LAS float* d = scr + kk * 33 + 4 * (lane & 7);
#pragma unroll
          for (int e = 0; e < 4; ++e) d[e] = v[i][e] * gk[i]; } }
    LDS_WAIT(); asm volatile("" ::: "memory");
#pragma unroll
    for (int j = 0; j < 2; ++j) { const int q = lane + 64 * j, n = q >> 2, c = q & 3; const LAS float* s = scr + (16 * c) * 33 + n; u32x4 o;
#pragma unroll
        for (int d = 0; d < 4; ++d) { int w = 0; w = __builtin_amdgcn_cvt_pk_fp8_f32(s[(4 * d) * 33], s[(4 * d + 1) * 33], w, false); w = __builtin_amdgcn_cvt_pk_fp8_f32(s[(4 * d + 2) * 33], s[(4 * d + 3) * 33], w, true); o[d] = (unsigned)w; }
        const int dr = drow + (rope ? (8 * (n >> 2) + (n & 3)) : n);
        *(GAS u32x4*)(WT + (size_t)dr * K + k0 + 16 * c) = o; }
    LDS_WAIT(); asm volatile("" ::: "memory");
}
__device__ __forceinline__ void rms_row_to_fp8(const float* xrow, const float* g, unsigned char* orow, int lane) {
    const GAS f32x4* xr = (const GAS f32x4*)xrow + lane; const GAS f32x4* gr = (const GAS f32x4*)g + lane;
    f32x4 v[8]; float s = 0.f;
#pragma unroll
    for (int j = 0; j < 8; ++j) { v[j] = xr[64 * j]; s += (v[j].x * v[j].x + v[j].y * v[j].y) + (v[j].z * v[j].z + v[j].w * v[j].w); }
    const float rstd = 1.0f / sqrtf(wave_sum(s) * (1.f / DM) + NORM_EPS);
    GAS unsigned* o4 = (GAS unsigned*)orow + lane;
#pragma unroll
    for (int j = 0; j < 8; ++j) { const f32x4 y = (v[j] * rstd) * gr[64 * j]; int w = 0; w = __builtin_amdgcn_cvt_pk_fp8_f32(y[0], y[1], w, false); w = __builtin_amdgcn_cvt_pk_fp8_f32(y[2], y[3], w, true); o4[64 * j] = (unsigned)w; }
}
__device__ __forceinline__ void rms_row_to_bf16(const float* xrow, const float* g, bf16_t* orow, int lane) {
    const GAS f32x4* xr = (const GAS f32x4*)xrow + lane; const GAS f32x4* gr = (const GAS f32x4*)g + lane;
    f32x4 v[8]; float s = 0.f;
#pragma unroll
    for (int j = 0; j < 8; ++j) { v[j] = xr[64 * j]; s += (v[j].x * v[j].x + v[j].y * v[j].y) + (v[j].z * v[j].z + v[j].w * v[j].w); }
    const float rstd = 1.0f / sqrtf(wave_sum(s) * (1.f / DM) + NORM_EPS);
    GAS u32x2* o8 = (GAS u32x2*)orow + lane;
#pragma unroll
    for (int j = 0; j < 8; ++j) { const f32x4 gg = gr[64 * j]; o8[64 * j] = pack4((v[j] * rstd) * gg); }
}
template <int PART>
__device__ __forceinline__ void p0_prologue(Frame& F, int rank, int nrank) {
    LAS float* scr = (LAS float*)(F.lds + F.wave * 16384);
    const int gw = rank * NWAVES + F.wave, NGW = nrank * NWAVES, lane = F.lane; const int gt = rank * 512 + F.tid, NGT = nrank * 512;
    unsigned char* WIN = WSP(unsigned char, WS_WIN); unsigned char* WVT = WSP(unsigned char, WS_WVT);
    constexpr int I_IN = 32 * 258, I_UQ = 8 * 96, I_UKV = 8 * 128, I_NA = 16 * 64, I_MLA = 32 * 64, I_OUT = 32 * 64;
    constexpr int NEARLY = I_IN + I_UQ + I_UKV, NITEMS = NEARLY + I_NA + I_MLA + I_OUT;
    for (int it = (PART == 0 ? 0 : NEARLY) + gw; it < (PART == 0 ? NEARLY : NITEMS); it += NGW) {
        int r = it;
        if (r < I_IN) { const int kb = r / 258, sb = r % 258, n0 = 32 * sb, k0 = 64 * kb; const float* W = F.in[3];
            unsigned char* dst = WIN; int drow; bool rope = false;
            if (n0 < 1024) drow = C_NAQ + n0;
            else if (n0 < 2048) drow = C_NAK + (n0 - 1024);
            else if (n0 < 3072) { dst = WVT; drow = n0 - 2048; }
            else if (n0 < 3584) drow = C_CQ + (n0 - 3072);
            else if (n0 < 4096) drow = C_CKV + (n0 - 3584);
            else if (n0 < 4160) { drow = C_KR + ((n0 - 4096) ? 4 : 0); rope = true; }
            else if (n0 < 6208) drow = C_GA + (n0 - 4160);
            else drow = C_GB + (n0 - 6208);
            p0_transpose_item8(W, 2048, 8256, k0, n0, dst, drow, rope, 64.f, scr, lane); continue; } r -= I_IN;
        if (r < I_UQ) { const int kb = r / 96, sb = r % 96, n0 = 32 * sb, k0 = 64 * kb; const int hd = n0 / 192, w = n0 % 192;
            int drow = n0; bool rope = false; if (w >= 128) { rope = true; drow = hd * 192 + 128 + ((w - 128) ? 4 : 0); }
            p0_transpose_item8(F.in[7], 512, 3072, k0, n0, WSP(unsigned char, WS_WUQ), drow, rope, 16.f, scr, lane, F.in[6]); continue; } r -= I_UQ;
        if (r < I_UKV) { const int kb = r / 128, sb = r % 128; const int n0 = 32 * sb, hd = n0 >> 8, w = n0 & 255;
            p0_transpose_item8(F.in[9], 512, 4096, 64 * kb, n0, WSP(unsigned char, WS_WUKV), (w >= 128 ? 2048 : 0) + hd * 128 + (w & 127), false, 16.f, scr, lane, F.in[8]); continue; } r -= I_UKV;
        if (r < I_NA) { const int kb = r / 64, sb = r % 64; p0_transpose_item8(F.in[10], 1024, 2048, 64 * kb, 32 * sb, WSP(unsigned char, WS_WNA), 32 * sb, false, 32.f, scr, lane); continue; } r -= I_NA;
        if (r < I_MLA) { const int kb = r / 64, sb = r % 64; p0_transpose_item8(F.in[11], 2048, 2048, 64 * kb, 32 * sb, WSP(unsigned char, WS_WMLA), 32 * sb, false, 64.f, scr, lane); continue; } r -= I_MLA;
        { const int kb = r / 64, sb = r % 64; p0_transpose_item8(F.in[12], 2048, 2048, 64 * kb, 32 * sb, WSP(unsigned char, WS_WOUT), 32 * sb, false, 64.f, scr, lane); }
    }
    if (PART == 0) { GAS u32x4* z = (GAS u32x4*)(WIN + (size_t)(C_KR + 64) * 2048); const int n16 = (NMAIN - C_KR - 64) * 2048 / 16;
      for (int i = gt; i < n16; i += NGT) z[i] = (u32x4){0u, 0u, 0u, 0u}; }
    if (PART == 0) { unsigned char* HN1 = WSP(unsigned char, WS_HN1);
#define P0_ROWSRC(m_) (((m_) < MREAL) ? F.in[0] + (size_t)(m_) * DM : F.in[1] + (size_t)((m_) - MREAL) * DM)
      { f32x4 v[8]; int m = gw;
        if (m < MREAL + NMETA) { const GAS f32x4* xr = (const GAS f32x4*)P0_ROWSRC(m) + lane;
#pragma unroll
            for (int j = 0; j < 8; ++j) v[j] = xr[64 * j]; }
        const GAS f32x4* gr = (const GAS f32x4*)F.in[2] + lane;
        while (m < MREAL + NMETA) { const int mn = m + NGW; f32x4 vn[8];
            { const int ml = mn < MREAL + NMETA ? mn : m; const GAS f32x4* xr = (const GAS f32x4*)P0_ROWSRC(ml) + lane;
#pragma unroll
              for (int j = 0; j < 8; ++j) vn[j] = xr[64 * j]; }
            float sq = 0.f;
#pragma unroll
            for (int j = 0; j < 8; ++j) sq += (v[j].x * v[j].x + v[j].y * v[j].y) + (v[j].z * v[j].z + v[j].w * v[j].w);
            const float rstd = 1.0f / sqrtf(wave_sum(sq) * (1.f / DM) + NORM_EPS);
            GAS unsigned* o4 = (GAS unsigned*)(HN1 + (size_t)m * DM) + lane;
#pragma unroll
            for (int j = 0; j < 8; ++j) { const f32x4 y = (v[j] * rstd) * gr[64 * j]; int w = 0; w = __builtin_amdgcn_cvt_pk_fp8_f32(y[0], y[1], w, false); w = __builtin_amdgcn_cvt_pk_fp8_f32(y[2], y[3], w, true); o4[64 * j] = (unsigned)w; }
#pragma unroll
            for (int j = 0; j < 8; ++j) v[j] = vn[j];
            m = mn; } }
#undef P0_ROWSRC
      GAS u32x4* z = (GAS u32x4*)(HN1 + (size_t)(MREAL + NMETA) * DM); const int n16 = (MPAD - MREAL - NMETA) * DM / 16;
      for (int i = gt; i < n16; i += NGT) z[i] = (u32x4){0u, 0u, 0u, 0u}; }
    if (PART == 0) { float* ct = WSP(float, WS_COS); float* st = WSP(float, WS_SIN);
      for (int i = gt; i < NPOS * 32; i += NGT) { const int p = i >> 5, j = i & 31;
          const float inv = __builtin_powf(10000.0f, -(float)(2 * j) / 64.0f); const float ang = (float)p * inv;
          double r = (double)ang * 0.15915494309189535; r -= __builtin_rint(r); const float rf = (float)r;
          ct[i] = __builtin_amdgcn_cosf(rf); st[i] = __builtin_amdgcn_sinf(rf); } }
    if (PART == 1) { const float* SK = F.in[15]; const float* WQ = F.in[14]; const float* g2 = F.in[13]; bf16_t* WSCp = WSP(bf16_t, WS_WSC);
      const int l15 = lane & 15, l4 = lane >> 4;
      for (int task = gw; task < 2048; task += NGW) { const int g = task >> 7, nt = (task >> 4) & 7, kc = task & 15, n0 = nt * 16;
          bf16x8 bfr[4];
#pragma unroll
          for (int kk = 0; kk < 4; ++kk) { const float* p = SK + ((size_t)g * 128 + n0 + l15) * 128 + 32 * kk + 8 * l4; const f32x4 a = *(const GAS f32x4*)p, b = *(const GAS f32x4*)(p + 4);
              const u32x4 w = pack8(a, b); bfr[kk] = __builtin_bit_cast(bf16x8, w); }
          for (int kt = 0; kt < 8; ++kt) { const int k0 = (kc * 8 + kt) * 16; f32x4 acc = (f32x4){0.f, 0.f, 0.f, 0.f};
#pragma unroll
              for (int kk = 0; kk < 4; ++kk) { const float* p = WQ + (size_t)(k0 + l15) * 2048 + g * 128 + 32 * kk + 8 * l4; const f32x4 a = *(const GAS f32x4*)p, b = *(const GAS f32x4*)(p + 4);
                  const u32x4 w = pack8(a, b); acc = __builtin_amdgcn_mfma_f32_16x16x32_bf16(__builtin_bit_cast(bf16x8, w), bfr[kk], acc, 0, 0, 0); }
              const f32x4 gg = *(const GAS f32x4*)(g2 + k0 + 4 * l4);
              *(GAS u32x2*)(WSCp + (size_t)(g * 128 + n0 + l15) * 2048 + k0 + 4 * l4) = pack4(acc * gg); } } }
}
using pg8::Unit;
struct SchedGrid {
    int G, c, nM, nN; const char* A; const char* B; size_t tstep;
    __device__ __forceinline__ bool next(int i, Unit& u) const { const int L = i * G + c; if (L >= nM * nN) return false; pg8::grid_order(L, nM, nN, u.pm, u.pn); u.kind = 0; return true; }
    __device__ __forceinline__ const char* pa(const Unit& u) const { return A + (size_t)u.pm * tstep; }
    __device__ __forceinline__ const char* pb(const Unit& u) const { return B + (size_t)u.pn * tstep; }
};
constexpr int P1_MAIN = 64 * 29, P1_VT = 4 * 65, P1_META = 7, P1_UNITS = P1_MAIN + P1_VT + P1_META;
struct SchedP1 {
    int G, c; const char* hn1; const char* win; const char* wvt; size_t tstep;
    __device__ __forceinline__ bool next(int i, Unit& u) const {
        const int L = i * G + c; if (L >= P1_UNITS) return false;
        if (L < P1_MAIN) { pg8::grid_order(L, 64, 29, u.pm, u.pn); u.kind = 0; }
        else if (L < P1_MAIN + P1_VT) { const int idx = L - P1_MAIN; u.pm = idx & 3; u.pn = idx >> 2; u.kind = 1; }
        else { const int idx = L - P1_MAIN - P1_VT; u.pm = 64; u.pn = idx < 4 ? 4 + idx : (idx < 6 ? 10 + (idx - 4) : 28); u.kind = 0; }
        return true; }
    __device__ __forceinline__ const char* pa(const Unit& u) const { return (u.kind == 1 ? wvt : hn1) + (size_t)u.pm * tstep; }
    __device__ __forceinline__ const char* pb(const Unit& u) const { return (u.kind == 1 ? hn1 : win) + (size_t)u.pn * tstep; }
};
__device__ __forceinline__ void rope4(const f32x4 x1, const f32x4 x2, const float* cosT, const float* sinT, int pos, int j0, f32x4& lo, f32x4& hi) {
    const f32x4 c = *(const GAS f32x4*)(cosT + pos * 32 + j0), s = *(const GAS f32x4*)(sinT + pos * 32 + j0);
    lo = x1 * c - x2 * s; hi = x2 * c + x1 * s;
}
struct EpiP1 {
    static constexpr bool PERM = true, HAS_PRE = false;
    unsigned char *naq, *nak, *vt; unsigned char *cq, *ckv; unsigned char *kr; unsigned char *ga, *gb; float *ssq_q, *ssq_kv; const float *cosT, *sinT;
    __device__ __forceinline__ void operator()(const f32x4 (&acc)[2][2][4][2], const Unit& u, int wr, int wc, int fr, int fq, const LAS float* rowsc) const {
        const int row0 = u.pm * 256 + wr * 64 + fr, colu = wc * 32 + 8 * fq;
        if (u.kind == 1) {
#pragma unroll
            for (int bj = 0; bj < 2; ++bj) { const int t0 = u.pn * 256 + bj * 128 + colu, pos = (t0 & ~63) + ((t0 & 63) >> 1);
#pragma unroll
                for (int ai = 0; ai < 2; ++ai)
#pragma unroll
                    for (int m = 0; m < 4; ++m) { unsigned char* rp = vt + (size_t)(row0 + ai * 128 + m * 16) * VT_PITCH + pos;
                        *(GAS unsigned*)rp = pack4_fp8(acc[ai][bj][m][0]); *(GAS unsigned*)(rp + 32) = pack4_fp8(acc[ai][bj][m][1]); } }
            return; }
        const int pn = u.pn;
        if (pn == 28) {
            if (wc < 2) { const int j0 = 4 * (4 * wc + fq);
#pragma unroll
                for (int ai = 0; ai < 2; ++ai)
#pragma unroll
                    for (int m = 0; m < 4; ++m) { const int row = row0 + ai * 128 + m * 16; const int pos = row < MREAL ? NMETA + (row & (SEQ - 1)) : row - MREAL;
                        f32x4 lo, hi; rope4(acc[ai][0][m][0], acc[ai][0][m][1], cosT, sinT, pos, j0, lo, hi);
                        *(GAS unsigned*)(kr + (size_t)row * 64 + j0) = pack4_fp8(lo); *(GAS unsigned*)(kr + (size_t)row * 64 + 32 + j0) = pack4_fp8(hi); } }
            return; }
        if (pn >= 12) {
            unsigned char* base = pn < 20 ? ga : gb; const int colt = (pn < 20 ? pn - 12 : pn - 20) * 256 + colu;
#pragma unroll
            for (int ai = 0; ai < 2; ++ai)
#pragma unroll
                for (int m = 0; m < 4; ++m) { unsigned char* rp = base + (size_t)(row0 + ai * 128 + m * 16) * 2048 + colt;
#pragma unroll
                    for (int bj = 0; bj < 2; ++bj) { f32x4 a = acc[ai][bj][m][0], b = acc[ai][bj][m][1];
#pragma unroll
                        for (int i = 0; i < 4; ++i) { a[i] = sigmoidf_(a[i]); b[i] = sigmoidf_(b[i]); }
                        *(GAS u32x2*)(rp + bj * 128) = pack8_u8(a, b); } }
            return; }
        if (pn >= 8) {
            const bool isq = pn < 10; unsigned char* base = isq ? cq : ckv; float* ssq = isq ? ssq_q : ssq_kv; const int colt = (isq ? pn - 8 : pn - 10) * 256 + colu;
#pragma unroll
            for (int ai = 0; ai < 2; ++ai)
#pragma unroll
                for (int m = 0; m < 4; ++m) { const int row = row0 + ai * 128 + m * 16; unsigned char* rp = base + (size_t)row * 512 + colt; float s = 0.f;
#pragma unroll
                    for (int bj = 0; bj < 2; ++bj) { const f32x4 a = acc[ai][bj][m][0], b = acc[ai][bj][m][1];
                        s += (a[0] * a[0] + a[1] * a[1]) + (a[2] * a[2] + a[3] * a[3]) + (b[0] * b[0] + b[1] * b[1]) + (b[2] * b[2] + b[3] * b[3]);
                        *(GAS u32x2*)(rp + bj * 128) = pack8_fp8(a, b); }
                    s += __shfl_xor(s, 16); s += __shfl_xor(s, 32);
                    if (fq == 0) ssq[(size_t)((pn & 1) * 4 + wc) * MPAD + row] = s; }
            return; }
        {
            unsigned char* base = pn < 4 ? naq : nak; const int colt = (pn & 3) * 256 + colu;
#pragma unroll
            for (int ai = 0; ai < 2; ++ai)
#pragma unroll
                for (int m = 0; m < 4; ++m) { unsigned char* rp = base + (size_t)(row0 + ai * 128 + m * 16) * 1024 + colt;
#pragma unroll
                    for (int bj = 0; bj < 2; ++bj) *(GAS u32x2*)(rp + bj * 128) = pack8_fp8(acc[ai][bj][m][0], acc[ai][bj][m][1]); }
        }
    }
};
constexpr int P3_Q = 64 * 12, P3_K = 65 * 8, P3_V = 8 * 65, P3_UNITS = P3_Q + P3_K + P3_V;
struct SchedP3 {
    int G, c; const char* ws; size_t tstep;
    __device__ __forceinline__ bool next(int i, Unit& u) const {
        const int L = i * G + c; if (L >= P3_UNITS) return false;
        if (L < P3_Q) { pg8::grid_order(L, 64, 12, u.pm, u.pn); u.kind = 0; }
        else if (L < P3_Q + P3_K) { pg8::grid_order(L - P3_Q, 65, 8, u.pm, u.pn); u.kind = 1; }
        else { const int idx = L - P3_Q - P3_K; u.pm = idx & 7; u.pn = idx >> 3; u.kind = 2; }
        return true; }
    __device__ __forceinline__ const char* pa(const Unit& u) const { const size_t o = u.kind == 0 ? WS_CQ : (u.kind == 1 ? WS_CKV : WS_WUKV + (size_t)2048 * 512); return ws + o + (size_t)u.pm * tstep; }
    __device__ __forceinline__ const char* pb(const Unit& u) const { const size_t o = u.kind == 0 ? WS_WUQ : (u.kind == 1 ? WS_WUKV : WS_CKV); return ws + o + (size_t)u.pn * tstep; }
};
template <int NS, int LD> __device__ __forceinline__ float rstd_slabs(const float* part, int row, float invn) {
    float s = 0.f;
#pragma unroll
    for (int i = 0; i < NS; ++i) s += part[(size_t)i * LD + row];
    return 1.0f / sqrtf(s * invn + NORM_EPS);
}
struct EpiP3 {
    static constexpr bool PERM = true, HAS_PRE = true;
    unsigned char *qm, *kn, *vt; const float *ssq_q, *ssq_kv; const float *cosT, *sinT;
    __device__ __forceinline__ void pre(const Unit& u, LAS float* sc, int tid) const { if (tid < 256) { const int row = (u.kind == 2 ? u.pn : u.pm) * 256 + tid; sc[tid] = u.kind ? rstd_slabs<8, MPAD>(ssq_kv, row, 1.f / 512.f) : rstd_slabs<8, MPAD>(ssq_q, row, 1.f / 512.f); } }
    __device__ __forceinline__ void operator()(const f32x4 (&acc)[2][2][4][2], const Unit& u, int wr, int wc, int fr, int fq, const LAS float* rowsc) const {
        const int row0 = u.pm * 256 + wr * 64 + fr, colu = wc * 32 + 8 * fq;
        if (u.kind == 2) {
#pragma unroll
            for (int bj = 0; bj < 2; ++bj) { const int cl = bj * 128 + colu, t0 = u.pn * 256 + cl;
                const f32x4 s0 = *(const LAS f32x4*)(rowsc + cl), s1 = *(const LAS f32x4*)(rowsc + cl + 4);
                const int g = (t0 >> 3) & 7, pos = (t0 & ~63) + 16 * (g >> 2) + 4 * (g & 3);
#pragma unroll
                for (int ai = 0; ai < 2; ++ai)
#pragma unroll
                    for (int m = 0; m < 4; ++m) { unsigned char* rp = vt + (size_t)(row0 + ai * 128 + m * 16) * MPAD + pos;
                        *(GAS unsigned*)rp = pack4_fp8(acc[ai][bj][m][0] * s0); *(GAS unsigned*)(rp + 32) = pack4_fp8(acc[ai][bj][m][1] * s1); } }
            return; }
        if (u.kind == 1) {
#pragma unroll
            for (int ai = 0; ai < 2; ++ai)
#pragma unroll
                for (int m = 0; m < 4; ++m) { const int row = row0 + ai * 128 + m * 16; const float rs = rowsc[ai * 128 + wr * 64 + m * 16 + fr];
                    unsigned char* rp = kn + (size_t)row * 2048 + u.pn * 256 + colu;
#pragma unroll
                    for (int bj = 0; bj < 2; ++bj) *(GAS u32x2*)(rp + bj * 128) = pack8_fp8(acc[ai][bj][m][0] * rs, acc[ai][bj][m][1] * rs); }
            return; }
#pragma unroll
        for (int bj = 0; bj < 2; ++bj) { const int c8 = u.pn * 256 + bj * 128 + colu; const int hd = c8 / 192, w = c8 - hd * 192;
            if (w < 128) {
#pragma unroll
                for (int ai = 0; ai < 2; ++ai)
#pragma unroll
                    for (int m = 0; m < 4; ++m) { const int row = row0 + ai * 128 + m * 16; const float rs = rowsc[ai * 128 + wr * 64 + m * 16 + fr];
                        *(GAS u32x2*)(qm + (size_t)row * 3072 + c8) = pack8_fp8(acc[ai][bj][m][0] * rs, acc[ai][bj][m][1] * rs); }
            } else { const int j0 = (w - 128) >> 1;
#pragma unroll
                for (int ai = 0; ai < 2; ++ai)
#pragma unroll
                    for (int m = 0; m < 4; ++m) { const int row = row0 + ai * 128 + m * 16; const float rs = rowsc[ai * 128 + wr * 64 + m * 16 + fr];
                        const int pos = NMETA + (row & (SEQ - 1)); f32x4 lo, hi; rope4(acc[ai][bj][m][0] * rs, acc[ai][bj][m][1] * rs, cosT, sinT, pos, j0, lo, hi);
                        unsigned char* qp = qm + (size_t)row * 3072 + hd * 192 + 128 + j0; *(GAS unsigned*)qp = pack4_fp8(lo); *(GAS unsigned*)(qp + 32) = pack4_fp8(hi); }
            } }
    }
};

__device__ __forceinline__ void unpack8(const u32x4 w, f32x4& a, f32x4& b) { a = (f32x4){bf_lo(w.x), bf_hi(w.x), bf_lo(w.y), bf_hi(w.y)}; b = (f32x4){bf_lo(w.z), bf_hi(w.z), bf_lo(w.w), bf_hi(w.w)}; }
struct EpiP5a {
    static constexpr bool PERM = true, HAS_PRE = false;
    const unsigned char* ga; unsigned char* t1;
    __device__ __forceinline__ void operator()(const f32x4 (&acc)[2][2][4][2], const Unit& u, int wr, int wc, int fr, int fq, const LAS float* rowsc) const {
        const int row0 = u.pm * 256 + wr * 64 + fr, col0 = u.pn * 256 + wc * 32 + 8 * fq;
#pragma unroll
        for (int ai = 0; ai < 2; ++ai)
#pragma unroll
            for (int m = 0; m < 4; ++m) { const size_t off = (size_t)(row0 + ai * 128 + m * 16) * 2048 + col0;
#pragma unroll
                for (int bj = 0; bj < 2; ++bj) { f32x4 g0, g1; unpack8_u8(*(const GAS u32x2*)(ga + off + bj * 128), g0, g1);
                    *(GAS u32x2*)(t1 + off + bj * 128) = pack8_fp8(acc[ai][bj][m][0] * g0 * 32.f, acc[ai][bj][m][1] * g1 * 32.f); } }
    }
};
struct EpiP5b {
    static constexpr bool PERM = true, HAS_PRE = false;
    const unsigned char* gb; const unsigned char* t1; unsigned char* merged;
    __device__ __forceinline__ void operator()(const f32x4 (&acc)[2][2][4][2], const Unit& u, int wr, int wc, int fr, int fq, const LAS float* rowsc) const {
        const int row0 = u.pm * 256 + wr * 64 + fr, col0 = u.pn * 256 + wc * 32 + 8 * fq;
#pragma unroll
        for (int ai = 0; ai < 2; ++ai)
#pragma unroll
            for (int m = 0; m < 4; ++m) { const size_t off = (size_t)(row0 + ai * 128 + m * 16) * 2048 + col0;
#pragma unroll
                for (int bj = 0; bj < 2; ++bj) { f32x4 g0, g1; unpack8_u8(*(const GAS u32x2*)(gb + off + bj * 128), g0, g1);
                    f32x4 a, b; unpack8_fp8(*(const GAS u32x2*)(t1 + off + bj * 128), a, b);
                    *(GAS u32x2*)(merged + off + bj * 128) = pack8_fp8(a + acc[ai][bj][m][0] * g0 * 32.f, b + acc[ai][bj][m][1] * g1 * 32.f); } }
    }
};
struct EpiP6 {
    static constexpr bool PERM = true, HAS_PRE = false;
    const float* x; bf16_t* h2b; float* ssq2;
    __device__ __forceinline__ void operator()(const f32x4 (&acc)[2][2][4][2], const Unit& u, int wr, int wc, int fr, int fq, const LAS float* rowsc) const {
        const int row0 = u.pm * 256 + wr * 64 + fr, col0 = u.pn * 256 + wc * 32 + 8 * fq;
#pragma unroll
        for (int ai = 0; ai < 2; ++ai)
#pragma unroll
            for (int m = 0; m < 4; ++m) { const int row = row0 + ai * 128 + m * 16; const size_t off = (size_t)row * 2048 + col0; float s = 0.f;
#pragma unroll
                for (int bj = 0; bj < 2; ++bj) { const f32x4 a = *(const GAS f32x4*)(x + off + bj * 128) + acc[ai][bj][m][0], b = *(const GAS f32x4*)(x + off + bj * 128 + 4) + acc[ai][bj][m][1];
                    s += (a[0] * a[0] + a[1] * a[1]) + (a[2] * a[2] + a[3] * a[3]) + (b[0] * b[0] + b[1] * b[1]) + (b[2] * b[2] + b[3] * b[3]);
                    *(GAS u32x4*)(h2b + off + bj * 128) = pack8(a, b); }
                s += __shfl_xor(s, 16); s += __shfl_xor(s, 32);
                if (fq == 0) ssq2[(size_t)(u.pn * 4 + wc) * MREAL + row] = s; }
    }
};
struct EpiP7 {
    static constexpr bool PERM = true, HAS_PRE = true;
    const float* ssq2; _Float16* sc;
    __device__ __forceinline__ void pre(const Unit& u, LAS float* sc, int tid) const { if (tid < 256) sc[tid] = rstd_slabs<32, MREAL>(ssq2, u.pm * 256 + tid, 1.f / 2048.f); }
    __device__ __forceinline__ void operator()(const f32x4 (&acc)[2][2][4][2], const Unit& u, int wr, int wc, int fr, int fq, const LAS float* rowsc) const {
        typedef _Float16 h4_t __attribute__((ext_vector_type(4)));
        const int row0 = u.pm * 256 + wr * 64 + fr, col0 = u.pn * 256 + wc * 32 + 8 * fq;
#pragma unroll
        for (int ai = 0; ai < 2; ++ai)
#pragma unroll
            for (int m = 0; m < 4; ++m) { const int row = row0 + ai * 128 + m * 16; const float rs = rowsc[ai * 128 + wr * 64 + m * 16 + fr]; const size_t off = (size_t)row * 2048 + col0;
#pragma unroll
                for (int bj = 0; bj < 2; ++bj) { const h4_t lo = __builtin_convertvector(acc[ai][bj][m][0] * rs, h4_t), hi = __builtin_convertvector(acc[ai][bj][m][1] * rs, h4_t);
                    const u32x2 wl = __builtin_bit_cast(u32x2, lo), wh = __builtin_bit_cast(u32x2, hi);
                    *(GAS u32x4*)(sc + off + bj * 128) = (u32x4){wl.x, wl.y, wh.x, wh.y}; } }
    }
};
namespace att {
#define KSWZ(row, colB) ((row) * 256 + ((colB) ^ (((row) & 7) << 4)))
#define KRSWZ(row, colB) ((row) * 128 + ((colB) ^ ((((row) >> 1) & 7) << 4)))
constexpr float L2E = 1.4426950408889634f;
template <int DUMMY = 0>
__device__ __forceinline__ void partialSM(f32x16& p0, f32x16& p1, float& m_reg, float& mn, float& alpha, const float C, const float THRS) {
  float pmax = p0[0];
#pragma unroll
  for (int r = 1; r < 16; ++r) pmax = fmaxf(pmax, p0[r]);
#pragma unroll
  for (int r = 0; r < 16; ++r) pmax = fmaxf(pmax, p1[r]);
  { auto rr = __builtin_amdgcn_permlane32_swap(__float_as_uint(pmax), __float_as_uint(pmax), false, false);
    pmax = fmaxf(__uint_as_float(rr[0]), __uint_as_float(rr[1])); }
  if (__builtin_expect(__all(pmax - m_reg <= THRS), 1)) { mn = m_reg; alpha = 1.f; }
  else { mn = fmaxf(m_reg, pmax); alpha = __builtin_amdgcn_exp2f((m_reg - mn) * C); m_reg = mn; }
  const float mnC = -mn * C;
#pragma unroll
  for (int r = 0; r < 16; ++r) p0[r] = fmaf(p0[r], C, mnC);
#pragma unroll
  for (int r = 0; r < 16; ++r) p1[r] = fmaf(p1[r], C, mnC);
#pragma unroll
  for (int r = 0; r < 16; ++r) p0[r] = __builtin_amdgcn_exp2f(p0[r]);
}
__device__ __forceinline__ void finishSM(f32x16& p0, f32x16& p1, float alpha, float& l_reg, bf16x8& pa0, bf16x8& pa1, bf16x8& pa2, bf16x8& pa3) {
#pragma unroll
  for (int r = 0; r < 16; ++r) p1[r] = __builtin_amdgcn_exp2f(p1[r]);
  float ps = 0;
#pragma unroll
  for (int r = 0; r < 16; ++r) ps += p0[r];
#pragma unroll
  for (int r = 0; r < 16; ++r) ps += p1[r];
  { auto rr = __builtin_amdgcn_permlane32_swap(__float_as_uint(ps), __float_as_uint(ps), false, false);
    ps = __uint_as_float(rr[0]) + __uint_as_float(rr[1]); }
  l_reg = l_reg * alpha + ps;
#define PK4(P, BASE, OUT) do { unsigned a0 = cvt_pk_bf16(P[BASE + 0], P[BASE + 1]), a1 = cvt_pk_bf16(P[BASE + 2], P[BASE + 3]);   \
    unsigned b0 = cvt_pk_bf16(P[BASE + 4], P[BASE + 5]), b1 = cvt_pk_bf16(P[BASE + 6], P[BASE + 7]);                              \
    auto r0 = __builtin_amdgcn_permlane32_swap(a0, b0, false, false); auto r1 = __builtin_amdgcn_permlane32_swap(a1, b1, false, false); \
    u32x4 w = {r0[0], r1[0], r0[1], r1[1]}; OUT = __builtin_bit_cast(bf16x8, w); } while (0)
  PK4(p0, 0, pa0); PK4(p0, 8, pa1); PK4(p1, 0, pa2); PK4(p1, 8, pa3);
#undef PK4
}
constexpr int NW = 8, QBLK = 32, KVBLK = 64;
constexpr float MLA_SCALE = 0.07216878364870322f;
constexpr float MLA_THR = 8.f;
constexpr int SHM_V = KVBLK * 128 * 2, SHM_KN = KVBLK * 128 * 2, SHM_KR = KVBLK * 64 * 2;
constexpr int OFF_V = 0, OFF_KN = 2 * SHM_V, OFF_KR = OFF_KN + 2 * SHM_KN, OFF_WS = OFF_KR + 2 * SHM_KR, OFF_QR = OFF_WS + NW * 64 * 4, MLA_LDS = OFF_QR + NW * 4096;
__device__ __forceinline__ void qkt(f32x16& p0, f32x16& p1, const LAS char* Kn, const LAS char* Kr, const bf16x8* qr, const LAS char* qrp, const int* kb, const int* krb) {
  p0 = f32x16{}; p1 = f32x16{};
#pragma unroll
  for (int d0 = 0; d0 < 8; ++d0) {
    const bf16x8 b0 = *(const LAS bf16x8*)(Kn + kb[d0 & 3] + (d0 >> 2) * 128);
    const bf16x8 b1 = *(const LAS bf16x8*)(Kn + kb[d0 & 3] + (d0 >> 2) * 128 + 8192);
    p0 = __builtin_amdgcn_mfma_f32_32x32x16_bf16(b0, qr[d0], p0, 0, 0, 0);
    p1 = __builtin_amdgcn_mfma_f32_32x32x16_bf16(b1, qr[d0], p1, 0, 0, 0); }
#pragma unroll
  for (int d0 = 0; d0 < 4; ++d0) {
    const bf16x8 b0 = *(const LAS bf16x8*)(Kr + krb[d0]);
    const bf16x8 b1 = *(const LAS bf16x8*)(Kr + krb[d0] + 4096);
    const bf16x8 qf = *(const LAS bf16x8*)(qrp + d0 * 1024);
    p0 = __builtin_amdgcn_mfma_f32_32x32x16_bf16(b0, qf, p0, 0, 0, 0);
    p1 = __builtin_amdgcn_mfma_f32_32x32x16_bf16(b1, qf, p1, 0, 0, 0); }
}
__device__ __forceinline__ int v_st(int k, int c) { const int kk = (k & ~0xC) | ((k & 4) << 1) | ((k & 8) >> 1); return ((kk >> 3) * 4 + (c >> 5)) * 512 + ((kk & 7) * 32 + (c & 31)) * 2; }
__device__ __forceinline__ int v_rd_base(int lane) { return ((lane & 3) << 3) | (((lane >> 2) & 3) << 6) | (((lane >> 4) & 1) << 5) | (((lane >> 5) & 1) << 8); }
constexpr int v_rd_off(int d0, int ks, int half) { return d0 * 512 + ks * 4096 + half * 2048; }
template <int OFF> __device__ __forceinline__ s16x4 tr_read(int vb) {
  s16x4 r; asm volatile("ds_read_b64_tr_b16 %0, %1 offset:%2" : "=&v"(r) : "v"(vb), "i"(OFF) : "memory"); return r;
}
template <int D0> __device__ __forceinline__ void pv_one(f32x16& od, int vb, bf16x8 pa0, bf16x8 pa1, bf16x8 pa2, bf16x8 pa3) {
  const s16x4 l0 = tr_read<v_rd_off(D0, 0, 0)>(vb), h0 = tr_read<v_rd_off(D0, 0, 1)>(vb), l1 = tr_read<v_rd_off(D0, 1, 0)>(vb), h1 = tr_read<v_rd_off(D0, 1, 1)>(vb);
  const s16x4 l2 = tr_read<v_rd_off(D0, 2, 0)>(vb), h2 = tr_read<v_rd_off(D0, 2, 1)>(vb), l3 = tr_read<v_rd_off(D0, 3, 0)>(vb), h3 = tr_read<v_rd_off(D0, 3, 1)>(vb);
  asm volatile("s_waitcnt lgkmcnt(0)" ::: "memory"); SBAR();
#define PK(L, H) (bf16x8){L[0], L[1], L[2], L[3], H[0], H[1], H[2], H[3]}
  od = __builtin_amdgcn_mfma_f32_32x32x16_bf16(pa0, PK(l0, h0), od, 0, 0, 0);
  od = __builtin_amdgcn_mfma_f32_32x32x16_bf16(pa1, PK(l1, h1), od, 0, 0, 0);
  od = __builtin_amdgcn_mfma_f32_32x32x16_bf16(pa2, PK(l2, h2), od, 0, 0, 0);
  od = __builtin_amdgcn_mfma_f32_32x32x16_bf16(pa3, PK(l3, h3), od, 0, 0, 0);
#undef PK
}
__device__ __forceinline__ void pv_d0(f32x16* o, int vb, bf16x8 pa0, bf16x8 pa1, bf16x8 pa2, bf16x8 pa3) {
  pv_one<0>(o[0], vb, pa0, pa1, pa2, pa3); pv_one<1>(o[1], vb, pa0, pa1, pa2, pa3); pv_one<2>(o[2], vb, pa0, pa1, pa2, pa3); pv_one<3>(o[3], vb, pa0, pa1, pa2, pa3);
}
__device__ __forceinline__ void mla_unit(int b, int h, int qb, const bf16_t* __restrict__ QM, const bf16_t* __restrict__ KN, const bf16_t* __restrict__ KR, const bf16_t* __restrict__ VV, unsigned char* __restrict__ OM, LAS char* lds) {
  const int tid = threadIdx.x, wid = tid >> 6, lane = tid & 63, r32 = lane & 31, hi = lane >> 5;
  constexpr float C = MLA_SCALE * L2E, THRS = MLA_THR / MLA_SCALE;
  constexpr int NT = 33;
  LAS char* V_lds = lds + OFF_V; LAS char* Kn_lds = lds + OFF_KN; LAS char* Kr_lds = lds + OFF_KR;
  LAS float* ws = (LAS float*)(lds + OFF_WS) + wid * 64; LAS float* li_l = ws; LAS float* al_l = ws + 32;
  float m_reg = -1e30f, l_reg = 0; f32x16 o[4] = {}; bf16x8 qr[8];
  LAS char* qrp = lds + OFF_QR + wid * 4096 + lane * 16;
  const int qrow = b * SEQ + qb * 256 + wid * QBLK + r32;
  const bf16_t* Qw = QM + (size_t)qrow * 3072 + h * 192 + hi * 8;
#pragma unroll
  for (int d0 = 0; d0 < 8; ++d0) qr[d0] = *(const GAS bf16x8*)(Qw + d0 * 16);
  __syncthreads();
#pragma unroll
  for (int d0 = 0; d0 < 4; ++d0) *(LAS bf16x8*)(qrp + d0 * 1024) = *(const GAS bf16x8*)(Qw + (8 + d0) * 16);
  const int sr = tid >> 4, sc = (tid & 15) * 8, vst0 = v_st(sr, sc), vst1 = v_st(32 + sr, sc);
  const int krr = tid >> 3, krc = (tid & 7) * 8;
  const int vb0 = (int)(uintptr_t)V_lds + v_rd_base(lane);
  bf16x8 s_v0, s_v1, s_k0, s_k1, s_kr;
  const int realbase = b * SEQ - KVBLK;
  const unsigned voff = (unsigned)(sr * 2048 + sc) * 2u, kroff = (unsigned)(krr * 64 + krc) * 2u;
  int kb[4], krb[4];
#pragma unroll
  for (int bq = 0; bq < 4; ++bq) { kb[bq] = KSWZ(r32, bq * 32 + hi * 16); krb[bq] = KRSWZ(r32, bq * 32 + hi * 16); }
#define TROW(t) ((t) == 0 ? MREAL : realbase + (t) * KVBLK)
#define SLOAD(t) do { const int k0_ = TROW(t); const size_t ro_ = ((size_t)k0_ * 2048 + h * 128) * 2; \
    const GAS char* vb_ = (const GAS char*)VV + ro_; const GAS char* nb_ = (const GAS char*)KN + ro_; const GAS char* rb_ = (const GAS char*)KR + (size_t)k0_ * 128; \
    s_v0 = *(const GAS bf16x8*)(vb_ + voff); s_v1 = *(const GAS bf16x8*)(vb_ + 32 * 4096 + voff); \
    s_k0 = *(const GAS bf16x8*)(nb_ + voff); s_k1 = *(const GAS bf16x8*)(nb_ + 32 * 4096 + voff); \
    s_kr = *(const GAS bf16x8*)(rb_ + kroff); } while (0)
#define SWRITE(bf) do { *(LAS bf16x8*)(V_lds + (bf) * SHM_V + vst0) = s_v0; *(LAS bf16x8*)(V_lds + (bf) * SHM_V + vst1) = s_v1; const int kc_ = sc * 2; \
    *(LAS bf16x8*)(Kn_lds + (bf) * SHM_KN + KSWZ(sr, kc_)) = s_k0; *(LAS bf16x8*)(Kn_lds + (bf) * SHM_KN + KSWZ(32 + sr, kc_)) = s_k1; \
    *(LAS bf16x8*)(Kr_lds + (bf) * SHM_KR + KRSWZ(krr, krc * 2)) = s_kr; } while (0)
#define SWAIT() asm volatile("s_waitcnt vmcnt(0)" ::: "memory")
#define RESC(a) do { if (__any((a) < 1.f)) { if (hi == 0) al_l[r32] = (a); asm volatile("s_waitcnt lgkmcnt(0)" ::: "memory"); \
    _Pragma("unroll") for (int d = 0; d < 4; ++d) _Pragma("unroll") for (int r = 0; r < 16; ++r) o[d][r] *= al_l[crow(r, hi)]; } } while (0)
  f32x16 pA0, pA1, pB0, pB1; float mnA, mnB, alA, alB; bf16x8 pa0, pa1, pa2, pa3;
  SLOAD(0); SWAIT(); SWRITE(0); __syncthreads();
  qkt(pA0, pA1, Kn_lds, Kr_lds, qr, qrp, kb, krb);
  { const float NEG = -INFINITY;
#pragma unroll
    for (int r = 8; r < 16; ++r) pA0[r] = NEG;
#pragma unroll
    for (int r = 0; r < 16; ++r) pA1[r] = NEG; }
  partialSM(pA0, pA1, m_reg, mnA, alA, C, THRS);
  SLOAD(1); SWAIT(); SWRITE(1); __syncthreads();
  for (int j = 1; j + 1 < NT; j += 2) {
    SBAR(); qkt(pB0, pB1, Kn_lds + SHM_KN, Kr_lds + SHM_KR, qr, qrp, kb, krb);
    finishSM(pA0, pA1, alA, l_reg, pa0, pa1, pa2, pa3); SBAR();
    SLOAD(j + 1); SBAR();
    pv_d0(o, vb0, pa0, pa1, pa2, pa3); partialSM(pB0, pB1, m_reg, mnB, alB, C, THRS);
    __syncthreads(); SWAIT(); SWRITE(0);
    RESC(alB); __syncthreads();
    SBAR(); qkt(pA0, pA1, Kn_lds, Kr_lds, qr, qrp, kb, krb);
    finishSM(pB0, pB1, alB, l_reg, pa0, pa1, pa2, pa3); SBAR();
    if (j + 2 < NT) SLOAD(j + 2); SBAR();
    pv_d0(o, vb0 + SHM_V, pa0, pa1, pa2, pa3); partialSM(pA0, pA1, m_reg, mnA, alA, C, THRS);
    __syncthreads(); if (j + 2 < NT) { SWAIT(); SWRITE(1); }
    RESC(alA); __syncthreads();
  }
  finishSM(pA0, pA1, alA, l_reg, pa0, pa1, pa2, pa3); SBAR();
  pv_d0(o, vb0, pa0, pa1, pa2, pa3);
  if (hi == 0) li_l[r32] = l_reg; asm volatile("s_waitcnt lgkmcnt(0)" ::: "memory");
  float rli[16];
#pragma unroll
  for (int r = 0; r < 16; ++r) rli[r] = __builtin_amdgcn_rcpf(li_l[crow(r, hi)]);
  unsigned char* Ow = OM + (size_t)(b * SEQ + qb * 256 + wid * QBLK) * 2048 + h * 128;
#pragma unroll
  for (int r = 0; r < 16; ++r) { const int orow = crow(r, hi);
#pragma unroll
    for (int d0 = 0; d0 < 4; ++d0) Ow[(size_t)orow * 2048 + d0 * 32 + r32] = f32_to_fp8(o[d0][r] * rli[r] * 32.f); }
#undef TROW
#undef SLOAD
#undef SWRITE
#undef SWAIT
#undef RESC
}
constexpr int K8S = 208, V8S = 80, SHM8_K = 64 * K8S, SHM8_V = 128 * V8S;
constexpr int OFF8_K = 0, OFF8_V = 2 * SHM8_K, OFF8_WS = OFF8_V + 2 * SHM8_V, MLA8_LDS = OFF8_WS + NW * 64 * 4;
constexpr float MLA8_THR = 1.9f;
typedef int a8_t __attribute__((ext_vector_type(8)));
#define MFMA8(acc_, a_, b_, sa_, sb_) asm volatile("s_nop 1\n\tv_mfma_scale_f32_32x32x64_f8f6f4 %0, %1, %2, %0, %3, %4 op_sel_hi:[0,0,0]" : "+v"(acc_) : "v"(a_), "v"(b_), "v"(sa_), "v"(sb_))
__device__ __forceinline__ a8_t ld_frag8(const LAS char* p) { const u32x4 lo = *(const LAS u32x4*)p, hi = *(const LAS u32x4*)(p + 16); return (a8_t){(int)lo.x, (int)lo.y, (int)lo.z, (int)lo.w, (int)hi.x, (int)hi.y, (int)hi.z, (int)hi.w}; }
__device__ __forceinline__ void qkt8(f32x16& p0, f32x16& p1, const LAS char* Kb, const a8_t& q0, const a8_t& q1, const a8_t& q2, int s1) {
  p0 = f32x16{}; p1 = f32x16{};
  { const a8_t a0 = ld_frag8(Kb), a1 = ld_frag8(Kb + 32 * K8S); MFMA8(p0, a0, q0, s1, s1); MFMA8(p1, a1, q0, s1, s1); }
  { const a8_t a0 = ld_frag8(Kb + 64), a1 = ld_frag8(Kb + 32 * K8S + 64); MFMA8(p0, a0, q1, s1, s1); MFMA8(p1, a1, q1, s1, s1); }
  { const a8_t a0 = ld_frag8(Kb + 128), a1 = ld_frag8(Kb + 32 * K8S + 128); MFMA8(p0, a0, q2, s1, s1); MFMA8(p1, a1, q2, s1, s1); }
  asm volatile("s_nop 15\n\ts_nop 15" : "+v"(p0), "+v"(p1));
}
__device__ __forceinline__ void partialSM8(f32x16& p0, f32x16& p1, float& m_reg, float& mn, float& alpha, const float C, const float THRS) {
  float pmax = p0[0];
#pragma unroll
  for (int r = 1; r < 16; ++r) pmax = fmaxf(pmax, p0[r]);
#pragma unroll
  for (int r = 0; r < 16; ++r) pmax = fmaxf(pmax, p1[r]);
  { auto rr = __builtin_amdgcn_permlane32_swap(__float_as_uint(pmax), __float_as_uint(pmax), false, false);
    pmax = fmaxf(__uint_as_float(rr[0]), __uint_as_float(rr[1])); }
  if (__builtin_expect(__all(pmax - m_reg <= THRS), 1)) { mn = m_reg; alpha = 1.f; }
  else { mn = fmaxf(m_reg, pmax); alpha = __builtin_amdgcn_exp2f((m_reg - mn) * C); m_reg = mn; }
  const float mnC = 6.f - mn * C;
#pragma unroll
  for (int r = 0; r < 16; ++r) p0[r] = fmaf(p0[r], C, mnC);
#pragma unroll
  for (int r = 0; r < 16; ++r) p1[r] = fmaf(p1[r], C, mnC);
#pragma unroll
  for (int r = 0; r < 16; ++r) p0[r] = __builtin_amdgcn_exp2f(p0[r]);
}
__device__ __forceinline__ void finishSM8(f32x16& p0, f32x16& p1, float alpha, float& l_reg, a8_t& pf) {
#pragma unroll
  for (int r = 0; r < 16; ++r) p1[r] = __builtin_amdgcn_exp2f(p1[r]);
  float ps = 0;
#pragma unroll
  for (int r = 0; r < 16; ++r) ps += p0[r];
#pragma unroll
  for (int r = 0; r < 16; ++r) ps += p1[r];
  { auto rr = __builtin_amdgcn_permlane32_swap(__float_as_uint(ps), __float_as_uint(ps), false, false);
    ps = __uint_as_float(rr[0]) + __uint_as_float(rr[1]); }
  l_reg = l_reg * alpha + ps;
#pragma unroll
  for (int w = 0; w < 4; ++w) { int x = 0, y = 0;
    x = __builtin_amdgcn_cvt_pk_fp8_f32(p0[4 * w], p0[4 * w + 1], x, false); x = __builtin_amdgcn_cvt_pk_fp8_f32(p0[4 * w + 2], p0[4 * w + 3], x, true);
    y = __builtin_amdgcn_cvt_pk_fp8_f32(p1[4 * w], p1[4 * w + 1], y, false); y = __builtin_amdgcn_cvt_pk_fp8_f32(p1[4 * w + 2], p1[4 * w + 3], y, true);
    pf[w] = x; pf[4 + w] = y; }
}
__device__ __forceinline__ void pv8(f32x16* o, const LAS char* Vb, const a8_t& pf, int sP, int s1) {
  const a8_t b0 = ld_frag8(Vb), b1 = ld_frag8(Vb + 32 * V8S), b2 = ld_frag8(Vb + 64 * V8S), b3 = ld_frag8(Vb + 96 * V8S);
  MFMA8(o[0], pf, b0, sP, s1); MFMA8(o[1], pf, b1, sP, s1); MFMA8(o[2], pf, b2, sP, s1); MFMA8(o[3], pf, b3, sP, s1);
  asm volatile("s_nop 15\n\ts_nop 15" : "+v"(o[0]), "+v"(o[1]), "+v"(o[2]), "+v"(o[3]));
}
__device__ __forceinline__ void mla_unit8(int b, int h, int qb, const unsigned char* __restrict__ QM8, const unsigned char* __restrict__ KN8, const unsigned char* __restrict__ KR8, const unsigned char* __restrict__ VT8,
                                          unsigned char* __restrict__ OM, LAS char* lds, Conv& cv) {
  const int tid = threadIdx.x, wid = tid >> 6, lane = tid & 63, r32 = lane & 31, hi = lane >> 5;
  constexpr float C = MLA_SCALE * L2E, THRS = MLA8_THR / MLA_SCALE;
  constexpr int NT = 33;
  LAS char* K_lds = lds + OFF8_K; LAS char* V_lds = lds + OFF8_V;
  LAS float* ws = (LAS float*)(lds + OFF8_WS) + wid * 64; LAS float* li_l = ws; LAS float* al_l = ws + 32;
  int s1 = 0x7f7f7f7f, sP = 0x79797979; asm volatile("" : "+v"(s1), "+v"(sP));
  float m_reg = -1e30f, l_reg = 0; f32x16 o[4] = {};
  const int qrow = b * SEQ + qb * 256 + wid * QBLK + r32;
  a8_t q0, q1, q2;
  { const unsigned char* Qw = QM8 + (size_t)qrow * 3072 + h * 192 + hi * 32;
    const u32x4 a = *(const GAS u32x4*)Qw, bq = *(const GAS u32x4*)(Qw + 16), c = *(const GAS u32x4*)(Qw + 64), d = *(const GAS u32x4*)(Qw + 80), e = *(const GAS u32x4*)(Qw + 128), f = *(const GAS u32x4*)(Qw + 144);
    q0 = (a8_t){(int)a.x, (int)a.y, (int)a.z, (int)a.w, (int)bq.x, (int)bq.y, (int)bq.z, (int)bq.w};
    q1 = (a8_t){(int)c.x, (int)c.y, (int)c.z, (int)c.w, (int)d.x, (int)d.y, (int)d.z, (int)d.w};
    q2 = (a8_t){(int)e.x, (int)e.y, (int)e.z, (int)e.w, (int)f.x, (int)f.y, (int)f.z, (int)f.w}; }
  __syncthreads();
  const int kkey = tid >> 3, kch = tid & 7, rkey = (tid >> 2) & 63, rch = tid & 3, vdim = tid >> 2, vch = tid & 3;
  const LAS char* Kf = K_lds + r32 * K8S + 32 * hi; const LAS char* Vf = V_lds + r32 * V8S + 32 * hi;
  const unsigned offk = (unsigned)(kkey * 2048 + kch * 16), offr = (unsigned)(rkey * 64 + rch * 16), offv = (unsigned)(vdim * MPAD + vch * 16);
  u32x4 kA, rA, vA, kB, rB, vB;
  const int realbase = b * SEQ - KVBLK;
#define TROW(t) ((t) == 0 ? MREAL : realbase + (t) * KVBLK)
#define SLOADX(t, K_, R_, V_) do { const int k0_ = TROW(t); \
    K_ = *(const GAS u32x4*)(KN8 + ((size_t)k0_ * 2048 + h * 128) + offk); \
    R_ = *(const GAS u32x4*)(KR8 + (size_t)k0_ * 64 + offr); \
    V_ = *(const GAS u32x4*)(VT8 + ((size_t)h * 128 * MPAD + k0_) + offv); } while (0)
#define SWRITEX(bf, K_, R_, V_) do { *(LAS u32x4*)(K_lds + (bf) * SHM8_K + kkey * K8S + kch * 16) = K_; if (tid < 256) *(LAS u32x4*)(K_lds + (bf) * SHM8_K + rkey * K8S + 128 + rch * 16) = R_; \
    *(LAS u32x4*)(V_lds + (bf) * SHM8_V + vdim * V8S + vch * 16) = V_; } while (0)
#define CONV_HOOK() do { cvi = false; if ((cv.tick++ & 3) == 0) { int lane_ = lane; asm volatile("" : "+v"(lane_));     \
      if (cv.pend >= 0) { asm volatile("s_waitcnt vmcnt(6)" ::: "memory"); conv_finish(cv, cv.pend, lane_); cv.pend = -1; asm volatile("s_waitcnt lgkmcnt(0)" ::: "memory"); } \
      if (cv.next < cv.end) { conv_issue(cv, cv.next, lane_); cv.pend = cv.next; cv.next += cv.stride; cvi = true; } } } while (0)
#define WAITX(nl) do { const int n_ = (nl) + ((cvi || cvp) ? 8 : 0); \
    if (n_ == 11) asm volatile("s_waitcnt vmcnt(11)" ::: "memory"); else if (n_ == 8) asm volatile("s_waitcnt vmcnt(8)" ::: "memory"); \
    else if (n_ == 3) asm volatile("s_waitcnt vmcnt(3)" ::: "memory"); else asm volatile("s_waitcnt vmcnt(0)" ::: "memory"); } while (0)
#define SWAIT0() asm volatile("s_waitcnt vmcnt(0)" ::: "memory")
#define RESC(a) do { if (__any((a) < 1.f)) { if (hi == 0) al_l[r32] = (a); asm volatile("s_waitcnt lgkmcnt(0)" ::: "memory"); \
    _Pragma("unroll") for (int d = 0; d < 4; ++d) _Pragma("unroll") for (int r = 0; r < 16; ++r) o[d][r] *= al_l[crow(r, hi)]; } } while (0)
  f32x16 pA0, pA1, pB0, pB1; float mnA, mnB, alA, alB; a8_t pf; bool cvi = false, cvp = false;
#define QK_FIN(N0, N1, KB, O0, O1, AL) do { N0 = f32x16{}; N1 = f32x16{}; float ps_ = 0.f; \
    a8_t fa_ = ld_frag8(KB), fb_ = ld_frag8((KB) + 32 * K8S);        \
    MFMA8(N0, fa_, q0, s1, s1); _Pragma("unroll") for (int r = 0; r < 8; ++r) O1[r] = __builtin_amdgcn_exp2f(O1[r]); SBAR(); \
    MFMA8(N1, fb_, q0, s1, s1); fa_ = ld_frag8((KB) + 64); _Pragma("unroll") for (int r = 8; r < 16; ++r) O1[r] = __builtin_amdgcn_exp2f(O1[r]); SBAR(); \
    MFMA8(N0, fa_, q1, s1, s1); fb_ = ld_frag8((KB) + 32 * K8S + 64); _Pragma("unroll") for (int r = 0; r < 16; ++r) ps_ += O0[r]; SBAR(); \
    MFMA8(N1, fb_, q1, s1, s1); fa_ = ld_frag8((KB) + 128); _Pragma("unroll") for (int r = 0; r < 16; ++r) ps_ += O1[r]; \
      { auto rr = __builtin_amdgcn_permlane32_swap(__float_as_uint(ps_), __float_as_uint(ps_), false, false); ps_ = __uint_as_float(rr[0]) + __uint_as_float(rr[1]); } l_reg = l_reg * (AL) + ps_; SBAR(); \
    MFMA8(N0, fa_, q2, s1, s1); fb_ = ld_frag8((KB) + 32 * K8S + 128); _Pragma("unroll") for (int w = 0; w < 4; ++w) { int x = 0; x = __builtin_amdgcn_cvt_pk_fp8_f32(O0[4 * w], O0[4 * w + 1], x, false); x = __builtin_amdgcn_cvt_pk_fp8_f32(O0[4 * w + 2], O0[4 * w + 3], x, true); pf[w] = x; } SBAR(); \
    MFMA8(N1, fb_, q2, s1, s1); _Pragma("unroll") for (int w = 0; w < 4; ++w) { int y = 0; y = __builtin_amdgcn_cvt_pk_fp8_f32(O1[4 * w], O1[4 * w + 1], y, false); y = __builtin_amdgcn_cvt_pk_fp8_f32(O1[4 * w + 2], O1[4 * w + 3], y, true); pf[4 + w] = y; } SBAR(); \
  } while (0)
#define PV_PART(VB, N0, N1, MN, AL) do { \
    a8_t va_ = ld_frag8(VB), vb_ = ld_frag8((VB) + 32 * V8S); \
    MFMA8(o[0], pf, va_, sP, s1); asm volatile("s_nop 15\n\ts_nop 15" : "+v"(N0), "+v"(N1));      \
      float pmax_ = N0[0]; _Pragma("unroll") for (int r = 1; r < 16; ++r) pmax_ = fmaxf(pmax_, N0[r]); SBAR(); \
    MFMA8(o[1], pf, vb_, sP, s1); va_ = ld_frag8((VB) + 64 * V8S); _Pragma("unroll") for (int r = 0; r < 16; ++r) pmax_ = fmaxf(pmax_, N1[r]); \
      { auto rr = __builtin_amdgcn_permlane32_swap(__float_as_uint(pmax_), __float_as_uint(pmax_), false, false); pmax_ = fmaxf(__uint_as_float(rr[0]), __uint_as_float(rr[1])); } \
      if (__builtin_expect(__all(pmax_ - m_reg <= THRS), 1)) { MN = m_reg; AL = 1.f; } else { MN = fmaxf(m_reg, pmax_); AL = __builtin_amdgcn_exp2f((m_reg - MN) * C); m_reg = MN; } SBAR(); \
    MFMA8(o[2], pf, va_, sP, s1); vb_ = ld_frag8((VB) + 96 * V8S); { const float mnC_ = 6.f - MN * C; _Pragma("unroll") for (int r = 0; r < 16; ++r) { N0[r] = fmaf(N0[r], C, mnC_); N1[r] = fmaf(N1[r], C, mnC_); } } SBAR(); \
    MFMA8(o[3], pf, vb_, sP, s1); _Pragma("unroll") for (int r = 0; r < 16; ++r) N0[r] = __builtin_amdgcn_exp2f(N0[r]); SBAR(); \
    asm volatile("s_nop 15\n\ts_nop 15" : "+v"(o[0]), "+v"(o[1]), "+v"(o[2]), "+v"(o[3])); } while (0)
  SLOADX(0, kA, rA, vA); SWAIT0(); SWRITEX(0, kA, rA, vA); __syncthreads();
  qkt8(pA0, pA1, Kf, q0, q1, q2, s1);
  { const float NEG = -INFINITY;
#pragma unroll
    for (int r = 8; r < 16; ++r) pA0[r] = NEG;
#pragma unroll
    for (int r = 0; r < 16; ++r) pA1[r] = NEG; }
  partialSM8(pA0, pA1, m_reg, mnA, alA, C, THRS);
  SLOADX(1, kA, rA, vA); SWAIT0(); SWRITEX(1, kA, rA, vA);
  SLOADX(2, kA, rA, vA);
  __syncthreads();
  for (int j = 1; j + 1 < NT; j += 2) {
    SBAR(); QK_FIN(pB0, pB1, Kf + SHM8_K, pA0, pA1, alA);
    const bool l1 = j + 2 < NT; if (l1) SLOADX(j + 2, kB, rB, vB); CONV_HOOK(); SBAR();
    PV_PART(Vf, pB0, pB1, mnB, alB);
    __syncthreads(); WAITX(l1 ? 3 : 0); SWRITEX(0, kA, rA, vA); cvp = cvi;
    RESC(alB); __syncthreads();
    SBAR(); QK_FIN(pA0, pA1, Kf, pB0, pB1, alB);
    const bool l2 = j + 3 < NT; if (l2) SLOADX(j + 3, kA, rA, vA); CONV_HOOK(); SBAR();
    PV_PART(Vf + SHM8_V, pA0, pA1, mnA, alA);
    __syncthreads(); if (l1) { WAITX(l2 ? 3 : 0); SWRITEX(1, kB, rB, vB); } cvp = cvi;
    RESC(alA); __syncthreads();
  }
  finishSM8(pA0, pA1, alA, l_reg, pf); SBAR();
  pv8(o, Vf, pf, sP, s1);
  if (hi == 0) li_l[r32] = l_reg; asm volatile("s_waitcnt lgkmcnt(0)" ::: "memory");
  float rli[16];
#pragma unroll
  for (int r = 0; r < 16; ++r) rli[r] = __builtin_amdgcn_rcpf(li_l[crow(r, hi)]) * (64.f * 32.f);
  unsigned char* Ow = OM + (size_t)(b * SEQ + qb * 256 + wid * QBLK) * 2048 + h * 128;
#pragma unroll
  for (int r = 0; r < 16; ++r) { const int orow = crow(r, hi);
#pragma unroll
    for (int d0 = 0; d0 < 4; ++d0) Ow[(size_t)orow * 2048 + d0 * 32 + r32] = f32_to_fp8(o[d0][r] * rli[r]); }
#undef TROW
#undef SLOADX
#undef SWRITEX
#undef WAITX
#undef SWAIT0
#undef QK_FIN
#undef PV_PART
#undef RESC
#undef CONV_HOOK
}
__device__ __forceinline__ void na_task(int task, const unsigned char* __restrict__ NAQ, const unsigned char* __restrict__ NAK, const unsigned char* __restrict__ VT, unsigned char* __restrict__ ONA,
                                        const LAS float* relb, const LAS float* metab, LAS float* wsf, int lane) {
  const int r32 = lane & 31, hi = lane >> 5;
  const int half = task & 1, r = (task >> 1) & 31, h = (task >> 6) & 15, b = task >> 10;
  const int qc = half * 32 + r32;
  const int cs = min(max(qc - 8, 0), 48), rs = min(max(r - 4, 0), 24);
  const int qtok = b * SEQ + r * 64 + qc;
  constexpr float C = L2E, THRS = 1.9f, SCALE = 0.125f;
  int s1 = 0x7f7f7f7f, sP = 0x79797979; asm volatile("" : "+v"(s1), "+v"(sP));
  a8_t qf; { const unsigned char* qp = NAQ + (size_t)qtok * 1024 + h * 64 + hi * 32; const u32x4 a = *(const GAS u32x4*)qp, c = *(const GAS u32x4*)(qp + 16);
    qf = (a8_t){(int)a.x, (int)a.y, (int)a.z, (int)a.w, (int)c.x, (int)c.y, (int)c.z, (int)c.w}; }
  float m_reg = -1e30f, l_reg = 0.f; f32x16 o[2] = {};
  LAS float* al_l = wsf; LAS float* li_l = wsf + 32;
  const float NEG = -INFINITY;
  const int kb0 = half * 16;
  const unsigned long long wm = 0xFFFFull << (cs - kb0);
  const unsigned mh0 = (unsigned)wm >> (4 * hi), mh1 = (unsigned)(wm >> 32) >> (4 * hi);
  const unsigned char* kq = NAK + (size_t)r32 * 1024 + h * 64 + hi * 32;
  const unsigned char* kq2 = NAK + (size_t)(32 + (r32 & 15)) * 1024 + h * 64 + hi * 32;
  const unsigned char* vq = VT + (size_t)(h * 64 + r32) * VT_PITCH + 32 * hi;
#define NA_KTOK(w) ((w) == 8 ? MREAL : b * SEQ + (rs + (w)) * 64 + kb0)
#define NA_VOFF(w) ((w) == 8 ? MREAL : b * SEQ + (rs + (w)) * 64 + (kb0 >> 1))
#define NA_LOADK(KF, w) do { const size_t ko_ = (size_t)NA_KTOK(w) * 1024; KF[0] = *(const GAS u32x4*)(kq + ko_); KF[1] = *(const GAS u32x4*)(kq + ko_ + 16); KF[2] = *(const GAS u32x4*)(kq2 + ko_); KF[3] = *(const GAS u32x4*)(kq2 + ko_ + 16); } while (0)
#define NA_A8(x_, y_) (a8_t){(int)x_.x, (int)x_.y, (int)x_.z, (int)x_.w, (int)y_.x, (int)y_.y, (int)y_.z, (int)y_.w}
#define NA_TILE(KF, wt, YN) do { \
    u32x4 va0, va1; u32x2 vb0_, vb1_; { const unsigned char* vp_ = vq + NA_VOFF(wt); va0 = *(const GAS u32x4*)vp_; vb0_ = *(const GAS u32x2*)(vp_ + 16); va1 = *(const GAS u32x4*)(vp_ + (size_t)32 * VT_PITCH); vb1_ = *(const GAS u32x2*)(vp_ + (size_t)32 * VT_PITCH + 16); } \
    f32x16 p0 = {}, p1 = {}; \
    { const a8_t k0_ = NA_A8(KF[0], KF[1]), k1_ = NA_A8(KF[2], KF[3]); MFMA8(p0, k0_, qf, s1, s1); MFMA8(p1, k1_, qf, s1, s1); asm volatile("s_nop 15\n\ts_nop 15" : "+v"(p0), "+v"(p1)); } \
    if ((wt) + 1 < 9) NA_LOADK(KF, (wt) + 1);            \
      \
    if ((wt) < 8) { const LAS float* bp_ = relb + ((h * 15 + (rs + (wt) - r + 7)) * 31 + 15 - qc + 4 * hi + kb0);     \
      float bv0[16], bv1[8];        \
      _Pragma("unroll") for (int rg = 0; rg < 16; ++rg) { const int c_ = (rg & 3) + 8 * (rg >> 2); bv0[rg] = bp_[c_]; if (rg < 8) bv1[rg] = bp_[c_ + 32]; } \
      _Pragma("unroll") for (int rg = 0; rg < 16; ++rg) { asm volatile("" : "+v"(bv0[rg])); if (rg < 8) asm volatile("" : "+v"(bv1[rg])); } \
      _Pragma("unroll") for (int rg = 0; rg < 16; ++rg) { const int c_ = (rg & 3) + 8 * (rg >> 2); \
        { const bool ok = (mh0 >> c_) & 1u; p0[rg] = ok ? fmaf(p0[rg], SCALE, bv0[rg]) : NEG; } \
        if (rg < 8) { const bool ok = (mh1 >> c_) & 1u; p1[rg] = ok ? fmaf(p1[rg], SCALE, bv1[rg]) : NEG; } } \
    } else { const LAS float* bp = metab + h * 16; \
      _Pragma("unroll") for (int rg = 0; rg < 16; ++rg) { const int kc = crow(rg, hi); p0[rg] = (rg < 8) ? fmaf(p0[rg], SCALE, bp[kc & 15]) : NEG; if (rg < 8) p1[rg] = NEG; } } \
      \
    float pmax = p0[0]; \
    _Pragma("unroll") for (int rg = 1; rg < 16; ++rg) pmax = fmaxf(pmax, p0[rg]); \
    _Pragma("unroll") for (int rg = 0; rg < 8; ++rg) pmax = fmaxf(pmax, p1[rg]); \
    { auto rr = __builtin_amdgcn_permlane32_swap(__float_as_uint(pmax), __float_as_uint(pmax), false, false); pmax = fmaxf(__uint_as_float(rr[0]), __uint_as_float(rr[1])); } \
    float mn, alpha; \
    if (__builtin_expect(__all(pmax - m_reg <= THRS), 1)) { mn = m_reg; alpha = 1.f; } \
    else { mn = fmaxf(m_reg, pmax); alpha = __builtin_amdgcn_exp2f((m_reg - mn) * C); m_reg = mn; } \
    const float mnC = 6.f - mn * C; float ps = 0.f;        \
    _Pragma("unroll") for (int rg = 0; rg < 16; ++rg) { p0[rg] = __builtin_amdgcn_exp2f(fmaf(p0[rg], C, mnC)); ps += p0[rg]; } \
    _Pragma("unroll") for (int rg = 0; rg < 8; ++rg) { p1[rg] = __builtin_amdgcn_exp2f(fmaf(p1[rg], C, mnC)); ps += p1[rg]; } \
    { auto rr = __builtin_amdgcn_permlane32_swap(__float_as_uint(ps), __float_as_uint(ps), false, false); ps = __uint_as_float(rr[0]) + __uint_as_float(rr[1]); } \
    l_reg = l_reg * alpha + ps; \
    a8_t pf;   \
    _Pragma("unroll") for (int w_ = 0; w_ < 4; ++w_) { int x = 0; x = __builtin_amdgcn_cvt_pk_fp8_f32(p0[4 * w_], p0[4 * w_ + 1], x, false); x = __builtin_amdgcn_cvt_pk_fp8_f32(p0[4 * w_ + 2], p0[4 * w_ + 3], x, true); pf[w_] = x; } \
    _Pragma("unroll") for (int w_ = 0; w_ < 2; ++w_) { int x = 0; x = __builtin_amdgcn_cvt_pk_fp8_f32(p1[4 * w_], p1[4 * w_ + 1], x, false); x = __builtin_amdgcn_cvt_pk_fp8_f32(p1[4 * w_ + 2], p1[4 * w_ + 3], x, true); pf[4 + w_] = x; } \
    pf[6] = 0; pf[7] = 0; \
    if (__any(alpha < 1.f)) { if (hi == 0) al_l[r32] = alpha; asm volatile("s_waitcnt lgkmcnt(0)" ::: "memory"); \
      _Pragma("unroll") for (int d = 0; d < 2; ++d) _Pragma("unroll") for (int rg = 0; rg < 16; ++rg) o[d][rg] *= al_l[crow(rg, hi)]; } \
    { const a8_t v0_ = (a8_t){(int)va0.x, (int)va0.y, (int)va0.z, (int)va0.w, (int)vb0_.x, (int)vb0_.y, 0, 0}, v1_ = (a8_t){(int)va1.x, (int)va1.y, (int)va1.z, (int)va1.w, (int)vb1_.x, (int)vb1_.y, 0, 0}; \
      MFMA8(o[0], pf, v0_, sP, s1); MFMA8(o[1], pf, v1_, sP, s1); asm volatile("s_nop 15\n\ts_nop 15" : "+v"(o[0]), "+v"(o[1])); } } while (0)
  { u32x4 kA[4];
    NA_LOADK(kA, 0);
#pragma unroll 1
    for (int w = 0; w < 8; ++w) { NA_TILE(kA, w, 12); }
    NA_TILE(kA, 8, 12); }
#undef NA_KTOK
#undef NA_VOFF
#undef NA_LOADK
#undef NA_A8
#undef NA_TILE
  if (hi == 0) li_l[r32] = l_reg; asm volatile("s_waitcnt lgkmcnt(0)" ::: "memory");
  unsigned char* Ow = ONA + (size_t)(b * SEQ + r * 64 + half * 32) * 1024 + h * 64;
#pragma unroll
  for (int rg = 0; rg < 16; ++rg) { const int orow = crow(rg, hi); const float rl = __builtin_amdgcn_rcpf(li_l[orow]) * (64.f * 16.f);
#pragma unroll
    for (int d0 = 0; d0 < 2; ++d0) Ow[(size_t)orow * 1024 + d0 * 32 + r32] = f32_to_fp8(o[d0][rg] * rl); }
  asm volatile("s_waitcnt lgkmcnt(0)" ::: "memory");
}
}
namespace peer {
constexpr int CH = 32;
constexpr int OFF_TV = 0, OFF_TI = OFF_TV + CH * 16 * 16 * 4, OFF_SE = OFF_TI + CH * 16 * 16 * 4, OFF_SG = OFF_SE + CH * 128 * 4, OFF_SE2 = OFF_SG + CH * 128 * 4, OFF_SG2 = OFF_SE2 + CH * 128 * 4, PEER_LDS = OFF_SG2 + CH * 128 * 4;
static_assert(PEER_LDS <= RING_BYTES, "PEER LDS");
__device__ __forceinline__ float gelu_tanh(float x) {
    const float u = 0.7978845608028654f * (x + 0.044715f * x * x * x);
    const float e = __builtin_amdgcn_exp2f(-2.f * 1.4426950408889634f * fabsf(u));
    const float t = (1.f - e) * __builtin_amdgcn_rcpf(1.f + e);
    return 0.5f * x * (1.f + (u < 0.f ? -t : t));
}
__device__ __forceinline__ void fmac1(float& acc, float a, float b) { asm("v_fmac_f32_e32 %0, %1, %2" : "+v"(acc) : "v"(a), "v"(b)); }
#define PEER_INSERT(x_, xi_) do { float x__ = (x_); int xi__ = (xi_); \
    _Pragma("unroll") for (int j_ = 0; j_ < 16; ++j_) { const bool gt_ = x__ > tv[j_]; const float tvo_ = tv[j_]; const int tio_ = ti[j_]; \
        tv[j_] = gt_ ? x__ : tvo_; ti[j_] = gt_ ? xi__ : tio_; x__ = gt_ ? tvo_ : x__; xi__ = gt_ ? tio_ : xi__; } } while (0)

#define PEER_AUX 0
typedef __amdgpu_buffer_rsrc_t rsrc_t;
__device__ __forceinline__ rsrc_t mk_rsrc(const void* p, unsigned bytes) { return __builtin_amdgcn_make_buffer_rsrc((void*)p, 0, bytes, 0x00020000); }
__device__ __forceinline__ u32x4 ldb128(rsrc_t r, unsigned off) { return __builtin_amdgcn_raw_buffer_load_b128(r, off, 0, PEER_AUX); }
typedef unsigned v6u_t __attribute__((ext_vector_type(6)));
typedef float v32f_t __attribute__((ext_vector_type(32)));
typedef float v16f_t __attribute__((ext_vector_type(16)));
__device__ __forceinline__ u32x2 ldb64(rsrc_t r, unsigned off) { return __builtin_amdgcn_raw_buffer_load_b64(r, off, 0, PEER_AUX); }
__device__ __forceinline__ f32x4 ldf128(rsrc_t r, unsigned off) { return __builtin_bit_cast(f32x4, __builtin_amdgcn_raw_buffer_load_b128(r, off, 0, PEER_AUX)); }
__device__ __forceinline__ f32x4 ldf128_nt(rsrc_t r, unsigned off) { return __builtin_bit_cast(f32x4, __builtin_amdgcn_raw_buffer_load_b128(r, off, 0, 2)); }
__device__ __forceinline__ void peer_select(int chunk, const _Float16* __restrict__ SC, LAS char* lds, int tid, LAS int* SE, LAS float* SG) {
    LAS float* TV = (LAS float*)(lds + OFF_TV); LAS int* TI = (LAS int*)(lds + OFF_TI);
    asm volatile("" : "+v"(tid));
    const int tok0 = chunk * CH;
    const rsrc_t rSC = mk_rsrc(SC, 0x4000000u);
    __syncthreads();
    { const int tl = tid >> 4, g = tid & 15; const unsigned spo = ((unsigned)(tok0 + tl) * 2048u + (unsigned)g * 128u) * 2u;
      int tk[16];
#pragma unroll
      for (int j = 0; j < 16; ++j) tk[j] = (int)0x80000000;
#define PEER_KEY(x_, lowbits_, mask_) ({ const int f_ = __float_as_int(x_); ((f_ ^ ((f_ >> 31) & 0x7fffffff)) & ~(mask_)) | (lowbits_); })
#define PEER_INS(key_) do { int x__ = (key_); _Pragma("unroll") for (int j_ = 0; j_ < 16; ++j_) { const int hi_ = max(x__, tk[j_]); x__ = min(x__, tk[j_]); tk[j_] = hi_; } } while (0)
      typedef _Float16 h8_t __attribute__((ext_vector_type(8)));
#define PEER_CX(a_, b_) do { const int hi_ = max(a_, b_), lo_ = min(a_, b_); a_ = hi_; b_ = lo_; } while (0)
      u32x4 na = __builtin_amdgcn_raw_buffer_load_b128(rSC, spo, 0, 2), nb = __builtin_amdgcn_raw_buffer_load_b128(rSC, spo + 16, 0, 2);
#pragma unroll 1
      for (int i = 0; i < 16; i += 2) { const h8_t a = __builtin_bit_cast(h8_t, na), b = __builtin_bit_cast(h8_t, nb);
          { const unsigned on = spo + (unsigned)min(i + 2, 14) * 16u; na = __builtin_amdgcn_raw_buffer_load_b128(rSC, on, 0, 2); nb = __builtin_amdgcn_raw_buffer_load_b128(rSC, on + 16, 0, 2); }
          int kk[16];
#pragma unroll
          for (int e = 0; e < 8; ++e) { kk[e] = PEER_KEY((float)a[e], 127 - (8 * i + e), 127); kk[8 + e] = PEER_KEY((float)b[e], 127 - (8 * i + 8 + e), 127); }
          PEER_CX(kk[0], kk[13]); PEER_CX(kk[1], kk[12]); PEER_CX(kk[2], kk[15]); PEER_CX(kk[3], kk[14]); PEER_CX(kk[4], kk[8]); PEER_CX(kk[5], kk[6]); PEER_CX(kk[7], kk[11]); PEER_CX(kk[9], kk[10]); PEER_CX(kk[0], kk[5]); PEER_CX(kk[1], kk[7]); PEER_CX(kk[2], kk[9]); PEER_CX(kk[3], kk[4]); PEER_CX(kk[6], kk[13]); PEER_CX(kk[8], kk[14]); PEER_CX(kk[10], kk[15]); PEER_CX(kk[11], kk[12]); PEER_CX(kk[0], kk[1]); PEER_CX(kk[2], kk[3]); PEER_CX(kk[4], kk[5]); PEER_CX(kk[6], kk[8]); PEER_CX(kk[7], kk[9]); PEER_CX(kk[10], kk[11]); PEER_CX(kk[12], kk[13]); PEER_CX(kk[14], kk[15]); PEER_CX(kk[0], kk[2]); PEER_CX(kk[1], kk[3]); PEER_CX(kk[4], kk[10]); PEER_CX(kk[5], kk[11]); PEER_CX(kk[6], kk[7]); PEER_CX(kk[8], kk[9]); PEER_CX(kk[12], kk[14]); PEER_CX(kk[13], kk[15]); PEER_CX(kk[1], kk[2]); PEER_CX(kk[3], kk[12]); PEER_CX(kk[4], kk[6]); PEER_CX(kk[5], kk[7]); PEER_CX(kk[8], kk[10]); PEER_CX(kk[9], kk[11]); PEER_CX(kk[13], kk[14]); PEER_CX(kk[1], kk[4]); PEER_CX(kk[2], kk[6]); PEER_CX(kk[5], kk[8]); PEER_CX(kk[7], kk[10]); PEER_CX(kk[9], kk[13]); PEER_CX(kk[11], kk[14]); PEER_CX(kk[2], kk[4]); PEER_CX(kk[3], kk[6]); PEER_CX(kk[9], kk[12]); PEER_CX(kk[11], kk[13]); PEER_CX(kk[3], kk[5]); PEER_CX(kk[6], kk[8]); PEER_CX(kk[7], kk[9]); PEER_CX(kk[10], kk[12]); PEER_CX(kk[3], kk[4]); PEER_CX(kk[5], kk[6]); PEER_CX(kk[7], kk[8]); PEER_CX(kk[9], kk[10]); PEER_CX(kk[11], kk[12]); PEER_CX(kk[6], kk[7]); PEER_CX(kk[8], kk[9]);
#pragma unroll
          for (int e = 0; e < 16; ++e) tk[e] = max(tk[e], kk[15 - e]);
          PEER_CX(tk[0], tk[8]); PEER_CX(tk[1], tk[9]); PEER_CX(tk[2], tk[10]); PEER_CX(tk[3], tk[11]); PEER_CX(tk[4], tk[12]); PEER_CX(tk[5], tk[13]); PEER_CX(tk[6], tk[14]); PEER_CX(tk[7], tk[15]); PEER_CX(tk[0], tk[4]); PEER_CX(tk[1], tk[5]); PEER_CX(tk[2], tk[6]); PEER_CX(tk[3], tk[7]); PEER_CX(tk[8], tk[12]); PEER_CX(tk[9], tk[13]); PEER_CX(tk[10], tk[14]); PEER_CX(tk[11], tk[15]); PEER_CX(tk[0], tk[2]); PEER_CX(tk[1], tk[3]); PEER_CX(tk[4], tk[6]); PEER_CX(tk[5], tk[7]); PEER_CX(tk[8], tk[10]); PEER_CX(tk[9], tk[11]); PEER_CX(tk[12], tk[14]); PEER_CX(tk[13], tk[15]); PEER_CX(tk[0], tk[1]); PEER_CX(tk[2], tk[3]); PEER_CX(tk[4], tk[5]); PEER_CX(tk[6], tk[7]); PEER_CX(tk[8], tk[9]); PEER_CX(tk[10], tk[11]); PEER_CX(tk[12], tk[13]); PEER_CX(tk[14], tk[15]); }
#undef PEER_CX
      LAS float* tvp = TV + (tl * 16 + g) * 16; LAS int* tip = TI + (tl * 16 + g) * 16;
#pragma unroll
      for (int j = 0; j < 16; ++j) { const int k_ = tk[j] & ~127; tvp[j] = __int_as_float(k_ ^ ((k_ >> 31) & 0x7fffffff)); tip[j] = 127 - (tk[j] & 127); } }
    __syncthreads();
    asm volatile("" : "+v"(tid));
    { const int tl = tid >> 4, hh = (tid >> 1) & 7, half = tid & 1;
      const LAS float* s1 = TV + (tl * 16 + 2 * hh) * 16; const LAS float* s2 = s1 + 16; const LAS int* i1 = TI + (tl * 16 + 2 * hh) * 16; const LAS int* i2 = i1 + 16;
      float b2[16];
#pragma unroll
      for (int j = 0; j < 16; ++j) b2[j] = s2[j];
      int tk[16];
#pragma unroll
      for (int j = 0; j < 16; ++j) tk[j] = (int)0x80000000;
#pragma unroll
      for (int ii = 0; ii < 8; ++ii) { const int i = 2 * ii + half; const float a = s1[i];
#pragma unroll
          for (int j = 0; j < 16; ++j) if ((2 * ii + 1) * (j + 1) <= 16) { if (half == 0 || (2 * ii + 2) * (j + 1) <= 16) PEER_INS(PEER_KEY(a + b2[j], 255 - (i * 16 + j), 255)); } }
      { int pk[16];
#pragma unroll
        for (int j = 0; j < 16; ++j) pk[j] = __shfl_xor(tk[j], 1);
#pragma unroll
        for (int j = 0; j < 16; ++j) PEER_INS(pk[j]); }
      if (half == 0) { float e[16], sum = 0.f; const int k0_ = tk[0] & ~255; const float v0 = __int_as_float(k0_ ^ ((k0_ >> 31) & 0x7fffffff));
#pragma unroll
        for (int j = 0; j < 16; ++j) { const int k_ = tk[j] & ~255; const float vj = __int_as_float(k_ ^ ((k_ >> 31) & 0x7fffffff)); e[j] = __builtin_amdgcn_exp2f((vj - v0) * 1.4426950408889634f); sum += e[j]; }
        const float inv = 1.0f / sum;
#pragma unroll
        for (int j = 0; j < 16; ++j) { const int ci = 255 - (tk[j] & 255); SE[tl * 128 + hh * 16 + j] = i1[ci >> 4] * 128 + i2[ci & 15]; SG[tl * 128 + hh * 16 + j] = e[j] * inv; } } }
#undef PEER_KEY
#undef PEER_INS
    __syncthreads();
}
__device__ __forceinline__ void peer_gather(int chunk, const bf16_t* __restrict__ H2, const unsigned char* __restrict__ U, const unsigned char* __restrict__ V,
                                            const float* __restrict__ g2, const float* __restrict__ gf, float* OUT, int tid, const LAS int* SE, const LAS float* SG) {
    asm volatile("" : "+v"(tid));
    const int tok0 = chunk * CH, lane = tid & 63, wave = tid >> 6;
    const rsrc_t rH2 = mk_rsrc(H2, 0x4000000u), rU = mk_rsrc(U, 0x1000000u), rV = mk_rsrc(V, 0x1000000u), rG2 = mk_rsrc(g2, 8192u), rGF = mk_rsrc(gf, 8192u);
#pragma unroll 1
    for (int tt = 0; tt < CH / NWAVES; ++tt) { const int tl = wave * (CH / NWAVES) + tt, tok = tok0 + tl;
      asm volatile("" ::: "memory");
      float hn[32]; float ss = 0.f;
#pragma unroll
      for (int j = 0; j < 2; ++j)
#pragma unroll
          for (int q = 0; q < 4; ++q) { const u32x2 w = ldb64(rH2, ((unsigned)tok * 2048u + 256u * (4 * j + q) + 4u * lane) * 2u);
              const f32x4 a = (f32x4){__uint_as_float(w.x << 16), __uint_as_float(w.x & 0xffff0000u), __uint_as_float(w.y << 16), __uint_as_float(w.y & 0xffff0000u)};
#pragma unroll
              for (int i = 0; i < 4; ++i) { hn[16 * j + 4 * q + i] = a[i]; ss += a[i] * a[i]; } }
      const float rstd = 1.0f / sqrtf(wave_sum(ss) * (1.f / 2048.f) + NORM_EPS);
#pragma unroll
      for (int j = 0; j < 2; ++j)
#pragma unroll
          for (int q = 0; q < 4; ++q) { const f32x4 a = ldf128(rG2, (256u * (4 * j + q) + 4u * lane) * 4u);
#pragma unroll
              for (int i = 0; i < 4; ++i) hn[16 * j + 4 * q + i] *= rstd * a[i]; }
      typedef _Float16 h2_t __attribute__((ext_vector_type(2)));
      h2_t hn16[16]; f32x2 accp[16];
#pragma unroll
      for (int k = 0; k < 16; ++k) { hn16[k] = (h2_t){(_Float16)hn[2 * k], (_Float16)hn[2 * k + 1]}; accp[k] = (f32x2){0.f, 0.f}; }
#define NX 4
#define PEER_LOAD(S, kb) do { _Pragma("unroll") for (int x = 0; x < NX; ++x) { const unsigned o = (unsigned)SE[tl * 128 + (kb) + x] * 1024u + (unsigned)lane * 16u; \
          S##u[x] = ldb128(rU, o); S##v[x] = ldb128(rV, o); } } while (0)
#define PEER_DU(W, k) dd = __builtin_amdgcn_fdot2(__builtin_amdgcn_cvt_scalef32_pk_f16_fp4(W[(k) >> 2], 1.0f, (k) & 3), hn16[k], dd, false);
#define PEER_DV(W, k) accp[k] = __builtin_elementwise_fma(__builtin_amdgcn_cvt_scalef32_pk_f32_fp4(W[(k) >> 2], 1.0f, (k) & 3), c2, accp[k]);
#define PEER_16(M, W) M(W, 0) M(W, 1) M(W, 2) M(W, 3) M(W, 4) M(W, 5) M(W, 6) M(W, 7) M(W, 8) M(W, 9) M(W, 10) M(W, 11) M(W, 12) M(W, 13) M(W, 14) M(W, 15)
#define PEER_COMPUTE(S, kb) do { float d[NX]; \
          _Pragma("unroll") for (int x = 0; x < NX; ++x) { const u32x4 W = S##u[x]; float dd = 0.f; PEER_16(PEER_DU, W) d[x] = dd; } \
          _Pragma("unroll") for (int o = 1; o < 64; o <<= 1) { _Pragma("unroll") for (int x = 0; x < NX; ++x) d[x] += __shfl_xor(d[x], o); } \
          float c[NX]; \
          _Pragma("unroll") for (int x = 0; x < NX; ++x) c[x] = SG[tl * 128 + (kb) + x] * gelu_tanh(d[x] * (1.f / PEER_U_SCALE)) * (1.f / PEER_V_SCALE); \
          _Pragma("unroll") for (int x = 0; x < NX; ++x) { const u32x4 W = S##v[x]; const f32x2 c2 = (f32x2){c[x], c[x]}; PEER_16(PEER_DV, W) } } while (0)
      { u32x4 Au[NX], Av[NX], Bu[NX], Bv[NX];
        PEER_LOAD(A, 0);
#pragma unroll 1
        for (int k = 0; k < 128; k += 2 * NX) {
            PEER_LOAD(B, k + NX); PEER_COMPUTE(A, k);
            { const int kn = min(k + 2 * NX, 128 - NX); PEER_LOAD(A, kn); }
            PEER_COMPUTE(B, k + NX);
        } }
#undef PEER_DU
#undef PEER_DV
#undef PEER_16
#undef NX
#undef PEER_LOAD
#undef PEER_COMPUTE
      asm volatile("" ::: "memory");
      int tok2 = tok, lane2 = lane; asm volatile("" : "+v"(tok2), "+v"(lane2));
      float s2 = 0.f;
#pragma unroll
      for (int j = 0; j < 2; ++j)
#pragma unroll
          for (int q = 0; q < 4; ++q) { const u32x2 w = ldb64(rH2, ((unsigned)tok2 * 2048u + 256u * (4 * j + q) + 4u * lane2) * 2u);
              const f32x4 a = (f32x4){__uint_as_float(w.x << 16), __uint_as_float(w.x & 0xffff0000u), __uint_as_float(w.y << 16), __uint_as_float(w.y & 0xffff0000u)};
#pragma unroll
              for (int i = 0; i < 4; ++i) { const int e_ = 16 * j + 4 * q + i; accp[e_ >> 1][e_ & 1] += a[i]; s2 += accp[e_ >> 1][e_ & 1] * accp[e_ >> 1][e_ & 1]; } }
      const float rf = 1.0f / sqrtf(wave_sum(s2) * (1.f / 2048.f) + NORM_EPS);
#pragma unroll
      for (int j = 0; j < 2; ++j)
#pragma unroll
          for (int q = 0; q < 4; ++q) { const f32x4 a = ldf128(rGF, (256u * (4 * j + q) + 4u * lane2) * 4u); f32x4 oa;
#pragma unroll
              for (int i = 0; i < 4; ++i) { const int e_ = 16 * j + 4 * q + i; oa[i] = accp[e_ >> 1][e_ & 1] * rf * a[i]; }
              float* op = OUT + (size_t)tok2 * 2048 + 256 * (4 * j + q) + 4 * lane2;
              __builtin_nontemporal_store(oa, (GAS f32x4*)op); }
    }
}
}
#ifndef MK_N_LAUNCHES
#define MK_N_LAUNCHES 1
#endif
#define MK_PROBE_PH -1
#define MK_PROBE_DIV 2
constexpr int N_PHASES = 9;
constexpr int N_LAUNCHES = MK_N_LAUNCHES;
struct Args { const float* in[19]; float* out; unsigned char* ws; int ph_lo, ph_hi; };
static_assert(sizeof(Args) == 19 * 8 + 8 + 8 + 8, "no padding");

__global__ void __launch_bounds__(NWAVES * 64, 2) hybrid_fwd(Args args) {
    extern __shared__ __attribute__((aligned(16))) unsigned char lds_raw[];
    Frame F;
    F.lds = (LAS unsigned char*)lds_raw;
    F.MISC = (volatile LAS unsigned*)(F.lds + MISC_OFF);
    F.tid = threadIdx.x; F.lane = F.tid & 63; F.wave = __builtin_amdgcn_readfirstlane(F.tid >> 6);
    F.G = gridDim.x; { const int bx = blockIdx.x; F.vcu = (F.G % 8 == 0) ? (bx % 8) * (F.G / 8) + bx / 8 : bx; }
    F.ws = args.ws; F.out = args.out;
#pragma unroll
    for (int i = 0; i < 19; ++i) F.in[i] = args.in[i];
    for (int u = F.tid; u < (LDS_BYTES - LDSCTL_OFF) / 4; u += NWAVES * 64) ((LAS unsigned*)(F.lds + LDSCTL_OFF))[u] = 0u;
    __syncthreads();
    XcdBarrier bar; bar.bar = (unsigned*)(F.ws + WS_CTL) + CW_BAR; bar.x = 0; bar.st = nullptr;
    if (N_LAUNCHES == 1) bar = xcd_barrier_post((unsigned*)(F.ws + WS_CTL) + CW_BAR, F.MISC + 8);
    const int lo = args.ph_lo, hi = args.ph_hi;
#define IN(k) (lo <= (k) && (k) < hi)
#if MK_PROBE_PH >= 0
    unsigned long long tp0 = (MK_PROBE_PH == 0 || MK_PROBE_PH == 9) ? __builtin_amdgcn_s_memrealtime() : 0ull, tp1 = 0ull;
#define SEAM(k) do { if (IN(k) && IN((k) + 1)) xcd_barrier(bar); if (MK_PROBE_PH == (k)) tp1 = __builtin_amdgcn_s_memrealtime(); if (MK_PROBE_PH == (k) + 1) tp0 = __builtin_amdgcn_s_memrealtime(); } while (0)
#else
#define SEAM(k) do { if (IN(k) && IN((k) + 1)) xcd_barrier(bar); } while (0)
#endif
    const size_t T2048 = (size_t)256 * 2048 * 2, T1024 = (size_t)256 * 1024 * 2, T512 = (size_t)256 * 512 * 2;
    float* cosT = WSP(float, WS_COS); float* sinT = WSP(float, WS_SIN);
    float* ssq_q = WSP(float, WS_SSQ_Q); float* ssq_kv = WSP(float, WS_SSQ_KV); float* ssq2 = WSP(float, WS_SSQ_2);

    if (IN(0)) { p0_prologue<0>(F, F.vcu, F.G); } SEAM(0);
    if (IN(1)) {
        SchedP1 S{F.G, (int)blockIdx.x, (const char*)(F.ws + WS_HN1), (const char*)(F.ws + WS_WIN), (const char*)(F.ws + WS_WVT), T1024};
        EpiP1 E{WSP(unsigned char, WS_NAQ), WSP(unsigned char, WS_NAK), WSP(unsigned char, WS_VT), WSP(unsigned char, WS_CQ), WSP(unsigned char, WS_CKV), WSP(unsigned char, WS_KR), WSP(unsigned char, WS_GA), WSP(unsigned char, WS_GB), ssq_q, ssq_kv, cosT, sinT};
        pg8::gemm_phase<EpiP1, SchedP1, true, -6>(F.lds, 2048, S, E);
        { const int extra = P1_UNITS % F.G, bx = (int)blockIdx.x; if (extra != 0 && bx >= extra) p0_prologue<1>(F, bx - extra, F.G - extra); else if (extra == 0) p0_prologue<1>(F, bx, F.G); }
    } SEAM(1);
    if (IN(2)) {
        LAS float* relb = (LAS float*)F.lds + 64; LAS float* metab = relb + 16 * 15 * 31 + 128; LAS float* wsf = metab + 256 + F.wave * 64;
        for (int i = F.tid; i < 16 * 15 * 31; i += NWAVES * 64) relb[i] = F.in[4][i];
        if (F.tid < 256) metab[F.tid] = F.in[5][F.tid];
        __syncthreads();
        const int gw = F.vcu * NWAVES + F.wave, NGW = F.G * NWAVES;
        for (int task = gw; task < NBATCH * 16 * 32 * 2; task += NGW)
            att::na_task(task, WSP(unsigned char, WS_NAQ), WSP(unsigned char, WS_NAK), WSP(unsigned char, WS_VT), WSP(unsigned char, WS_ONA), relb, metab, wsf, F.lane);
        __syncthreads();
    } SEAM(2);
    if (IN(3)) {
        SchedP3 S{F.G, (int)blockIdx.x, (const char*)F.ws, T512 / 2};
        EpiP3 E{WSP(unsigned char, WS_QM), WSP(unsigned char, WS_KN), WSP(unsigned char, WS_VV), ssq_q, ssq_kv, cosT, sinT};
        pg8::gemm_phase<EpiP3, SchedP3, true, -4>(F.lds, 512, S, E);
    } SEAM(3);
    if (IN(4)) {
        const int gw = F.vcu * NWAVES + F.wave, NGW = F.G * NWAVES;
        Conv cv{F.in[16], F.in[17], WSP(unsigned char, WS_U), WSP(unsigned char, WS_V), F.lds + 65536 + F.wave * 8192, gw, NGW, 2 * 16384, -1, 0};
        for (int id = F.vcu; id < NBATCH * 16 * 8; id += F.G) { const int bh = id >> 3, qb = id & 7;
            att::mla_unit8(bh >> 4, bh & 15, qb, WSP(unsigned char, WS_QM), WSP(unsigned char, WS_KN), WSP(unsigned char, WS_KR), WSP(unsigned char, WS_VV), WSP(unsigned char, WS_OMLA), (LAS char*)F.lds, cv); }
        while (cv.pend >= 0 || cv.next < cv.end) conv_step<0>(cv, F.lane);
        __syncthreads();
    } SEAM(4);
    if (IN(5)) {
        { SchedGrid S{F.G, (int)blockIdx.x, 64, 8, (const char*)(F.ws + WS_ONA), (const char*)(F.ws + WS_WNA), T512};
          EpiP5a E{WSP(unsigned char, WS_GA), WSP(unsigned char, WS_T1)};
          pg8::gemm_phase<EpiP5a, SchedGrid, true, -9>(F.lds, 1024, S, E); }
        { SchedGrid S{F.G, (int)blockIdx.x, 64, 8, (const char*)(F.ws + WS_OMLA), (const char*)(F.ws + WS_WMLA), T1024};
          EpiP5b E{WSP(unsigned char, WS_GB), WSP(unsigned char, WS_T1), WSP(unsigned char, WS_MERGED)};
          pg8::gemm_phase<EpiP5b, SchedGrid, true, -11>(F.lds, 2048, S, E); }
    } SEAM(5);
    if (IN(6)) {
        { SchedGrid S{F.G, (int)blockIdx.x, 64, 8, (const char*)(F.ws + WS_MERGED), (const char*)(F.ws + WS_WOUT), T1024};
          EpiP6 E{F.in[0], WSP(bf16_t, WS_H2B), ssq2};
          pg8::gemm_phase<EpiP6, SchedGrid, true, -11>(F.lds, 2048, S, E); }
    } SEAM(6);
    if (IN(7)) {
        SchedGrid S{F.G, (int)blockIdx.x, 64, 8, (const char*)(F.ws + WS_H2B), (const char*)(F.ws + WS_WSC), T2048};
        EpiP7 E{ssq2, WSP(_Float16, WS_SC)};
        pg8::gemm_phase<EpiP7, SchedGrid>(F.lds, 2048, S, E);
    } SEAM(7);
    if (IN(8)) {
        const int nch = (MREAL / peer::CH - F.vcu + F.G - 1) / F.G; const bool both_first = (nch == 2) && (F.vcu & 1);
        for (int op = 0; op < 2 * nch; ++op) {
            const bool sel = both_first ? (op < 2) : !(op & 1); const int ci = both_first ? (op & 1) : (op >> 1), chunk = F.vcu + ci * F.G;
            const int b2 = both_first ? ci : 0;
            LAS int* SE = (LAS int*)(F.lds + (b2 ? peer::OFF_SE2 : peer::OFF_SE)); LAS float* SG = (LAS float*)(F.lds + (b2 ? peer::OFF_SG2 : peer::OFF_SG));
            if (sel) peer::peer_select(chunk, WSP(_Float16, WS_SC), (LAS char*)F.lds, F.tid, SE, SG);
            else peer::peer_gather(chunk, WSP(bf16_t, WS_H2B), WSP(unsigned char, WS_U), WSP(unsigned char, WS_V), F.in[13], F.in[18], F.out, F.tid, SE, SG); }
    }
#if MK_PROBE_PH >= 0
    xcd_barrier(bar); tp1 = (MK_PROBE_PH >= 8) ? __builtin_amdgcn_s_memrealtime() : tp1;
    if (blockIdx.x == 0 && F.tid == 0) F.out[0] = (float)(tp1 - tp0) * (0.01f / MK_PROBE_DIV);
#endif
#undef IN
#undef SEAM
}

extern "C" void kernel_launch(void* const* d_in, const int* in_sizes, int n_in, void* d_out, int out_size, void* d_ws, size_t ws_size, hipStream_t stream) {
    static int grid = 0;
    if (grid == 0) {
        if (n_in != 19 || in_sizes[0] != MREAL * DM || out_size != MREAL * DM || ws_size < WS_END) {
            fprintf(stderr, "kernel_launch: shape/workspace mismatch: n_in %d in0 %d out %d ws %zu (need %zu); nothing launched\n", n_in, n_in > 0 ? in_sizes[0] : -1, out_size, ws_size, (size_t)WS_END); grid = -1; return; }
        int dev = 0, cus = 0, per_cu = 0;
        if (hipGetDevice(&dev) != hipSuccess || hipDeviceGetAttribute(&cus, hipDeviceAttributeMultiprocessorCount, dev) != hipSuccess) { fprintf(stderr, "kernel_launch: device query failed\n"); grid = -1; return; }
        if (hipFuncSetAttribute((const void*)hybrid_fwd, hipFuncAttributeMaxDynamicSharedMemorySize, LDS_BYTES) != hipSuccess) { fprintf(stderr, "kernel_launch: hipFuncSetAttribute failed\n"); grid = -1; return; }
        if (hipOccupancyMaxActiveBlocksPerMultiprocessor(&per_cu, (const void*)hybrid_fwd, NWAVES * 64, LDS_BYTES) != hipSuccess || per_cu < 1)
            fprintf(stderr, "kernel_launch: note: occupancy query reports %d workgroups per CU\n", per_cu);
        (void)hipGetLastError();
        grid = cus;
    }
    if (grid < 0) return;
    if (hipMemsetAsync((char*)d_ws + WS_CTL, 0, CTL_ZERO_BYTES, stream) != hipSuccess) { fprintf(stderr, "kernel_launch: hipMemsetAsync failed\n"); return; }
    Args a{};
    for (int i = 0; i < 19; ++i) a.in[i] = (const float*)d_in[i];
    a.out = (float*)d_out; a.ws = (unsigned char*)d_ws;
    for (int li = 0; li < N_LAUNCHES; ++li) {
        a.ph_lo = (N_LAUNCHES == 1) ? 0 : li; a.ph_hi = (N_LAUNCHES == 1) ? N_PHASES : li + 1;
        hipLaunchKernelGGL(hybrid_fwd, dim3(grid), dim3(NWAVES * 64), LDS_BYTES, stream, a);
        const hipError_t le = hipPeekAtLastError();
        if (le != hipSuccess) { fprintf(stderr, "kernel_launch: launch %d failed: %s\n", li, hipGetErrorName(le)); break; }
    }
}
```

```cpp
#include <hip/hip_runtime.h>
#include <cstdio>
#include <cstdint>

#define LAS __attribute__((address_space(3)))
#define GAS __attribute__((address_space(1)))
typedef unsigned short bf16_t;
typedef short bf16x8 __attribute__((ext_vector_type(8)));
typedef short s16x4 __attribute__((ext_vector_type(4)));
typedef float f32x4 __attribute__((ext_vector_type(4)));
typedef float f32x2 __attribute__((ext_vector_type(2)));
typedef float f32x16 __attribute__((ext_vector_type(16)));
typedef unsigned u32x4 __attribute__((ext_vector_type(4)));
typedef unsigned u32x2 __attribute__((ext_vector_type(2)));

constexpr int DM = 2048, NBATCH = 8, SEQ = 2048, NMETA = 16;
constexpr int MREAL = NBATCH * SEQ;
constexpr int MPAD = MREAL + 256;
constexpr int NPOS = SEQ + NMETA;
constexpr float NORM_EPS = 1e-6f;
constexpr int C_NAQ = 0, C_NAK = 1024, C_CQ = 2048, C_CKV = 2560, C_GA = 3072, C_GB = 5120, C_KR = 7168, NMAIN = 7424;
constexpr int VT_PITCH = MPAD;

constexpr size_t MiB = 1u << 20;
constexpr size_t WS_CTL = 0, CTL_ZERO_BYTES = 1 * MiB;
constexpr size_t WS_SSQ_Q = 481 * MiB, WS_SSQ_KV = 482 * MiB, WS_SSQ_2 = 486 * MiB;
constexpr size_t WS_COS = 1 * MiB, WS_SIN = 1 * MiB + 512 * 1024;
constexpr size_t WS_WUQ = 2 * MiB, WS_WUKV = 5 * MiB, WS_WNA = 9 * MiB, WS_WMLA = 13 * MiB, WS_WOUT = 21 * MiB, WS_WSC = 29 * MiB;
constexpr size_t WS_GA = 37 * MiB, WS_GB = 101 * MiB;
constexpr size_t WS_KR = 165 * MiB;
constexpr size_t WS_WIN = 167 * MiB + 256 * 1024, WS_WVT = WS_WIN + 29 * MiB;
constexpr size_t WS_ONA = 190 * MiB;
constexpr size_t WS_NAQ = 222 * MiB, WS_NAK = 254 * MiB, WS_VT = WS_NAK + 32 * MiB + 512 * 1024;
constexpr size_t WS_HN1 = 319 * MiB;
constexpr size_t WS_CQ = 448 * MiB, WS_CKV = 464 * MiB;
constexpr size_t WS_QM = 303 * MiB, WS_KN = 352 * MiB, WS_VV = 385 * MiB;
constexpr size_t WS_OMLA = 448 * MiB;
constexpr size_t WS_MERGED = 222 * MiB, WS_T1 = 286 * MiB;
constexpr size_t WS_H2 = 37 * MiB, WS_H2B = 293 * MiB;
constexpr size_t WS_U = 69 * MiB, WS_V = 133 * MiB;
constexpr size_t WS_SC = 165 * MiB;
constexpr size_t WS_END = 512 * MiB;
static_assert(WS_CKV + (size_t)MPAD * 512 * 2 <= WS_SSQ_Q && WS_SSQ_Q + (size_t)8 * MPAD * 4 <= WS_SSQ_KV && WS_SSQ_KV + (size_t)8 * MPAD * 4 <= 483 * MiB && WS_SSQ_2 + (size_t)32 * MREAL * 4 <= WS_END, "ssq slabs");
static_assert(WS_VT + (size_t)1024 * MPAD * 2 <= WS_HN1 && WS_HN1 + (size_t)MPAD * 2048 * 2 <= WS_CQ && WS_CKV + (size_t)MPAD * 512 * 2 <= WS_END, "map P1");
static_assert(WS_WVT + 4 * MiB <= WS_NAQ && WS_KR + (size_t)MPAD * 64 * 2 <= WS_WIN && WS_ONA + 32 * MiB <= WS_NAQ, "map P1b");
static_assert(WS_VT + (size_t)1024 * MPAD <= WS_QM && WS_QM + 48 * MiB <= WS_KN && WS_KN + 33 * MiB <= WS_VV && WS_VV + 33 * MiB <= WS_OMLA && WS_OMLA + 64 * MiB <= WS_END, "map P3");
static_assert(WS_T1 + 128 * MiB <= WS_OMLA && WS_H2 + 128 * MiB <= WS_KR && WS_SC + 128 * MiB <= WS_H2B && WS_H2B + 64 * MiB <= WS_END, "map P5+");
static_assert(WS_GA + 32 * MiB <= WS_U && WS_U + 24 * MiB <= WS_GB && WS_GB + 32 * MiB <= WS_V && WS_V + 24 * MiB <= WS_KR, "expert tables between the gate codes");

constexpr int CW_BAR = 4096;
constexpr float PEER_U_SCALE = 90.50966799f, PEER_V_SCALE = 5.656854249f;

constexpr int RING_BYTES = 131072;
constexpr int LDSCTL_OFF = RING_BYTES, MISC_OFF = LDSCTL_OFF + 320;
constexpr int LDS_BYTES = 147456;
constexpr int NWAVES = 8;

#define LDS_WAIT() asm volatile("s_waitcnt lgkmcnt(0)" ::: "memory")
#define VM_WAIT() asm volatile("s_waitcnt vmcnt(0)" ::: "memory")
#define SBAR() __builtin_amdgcn_sched_barrier(0)
typedef __bf16 bf16x2_t __attribute__((ext_vector_type(2)));
__device__ __forceinline__ unsigned cvt_pk_bf16(float lo, float hi) { const f32x2 v = {lo, hi}; const bf16x2_t b = __builtin_convertvector(v, bf16x2_t); return __builtin_bit_cast(unsigned, b); }
__device__ __forceinline__ float bf_lo(unsigned w) { return __uint_as_float(w << 16); }
__device__ __forceinline__ float bf_hi(unsigned w) { return __uint_as_float(w & 0xffff0000u); }
__device__ __forceinline__ u32x4 pack8(const f32x4 a, const f32x4 b) { u32x4 w; w.x = cvt_pk_bf16(a[0], a[1]); w.y = cvt_pk_bf16(a[2], a[3]); w.z = cvt_pk_bf16(b[0], b[1]); w.w = cvt_pk_bf16(b[2], b[3]); return w; }
__device__ __forceinline__ u32x2 pack8_fp8(f32x4 a, f32x4 b) {
#pragma unroll
    for (int i = 0; i < 4; ++i) { a[i] = __builtin_fminf(__builtin_fmaxf(a[i], -448.f), 448.f); b[i] = __builtin_fminf(__builtin_fmaxf(b[i], -448.f), 448.f); }
    int w0 = 0, w1 = 0; w0 = __builtin_amdgcn_cvt_pk_fp8_f32(a[0], a[1], w0, false); w0 = __builtin_amdgcn_cvt_pk_fp8_f32(a[2], a[3], w0, true);
    w1 = __builtin_amdgcn_cvt_pk_fp8_f32(b[0], b[1], w1, false); w1 = __builtin_amdgcn_cvt_pk_fp8_f32(b[2], b[3], w1, true); return (u32x2){(unsigned)w0, (unsigned)w1}; }
__device__ __forceinline__ unsigned char f32_to_fp8(float x) { x = __builtin_fminf(__builtin_fmaxf(x, -448.f), 448.f); return (unsigned char)(__builtin_amdgcn_cvt_pk_fp8_f32(x, 0.f, 0, false) & 0xff); }
__device__ __forceinline__ u32x2 pack8_u8(const f32x4 a, const f32x4 b) { u32x2 w; unsigned x = 0u, y = 0u;
    x = __builtin_amdgcn_cvt_pk_u8_f32(a[0] * 255.f, 0u, x); x = __builtin_amdgcn_cvt_pk_u8_f32(a[1] * 255.f, 1u, x); x = __builtin_amdgcn_cvt_pk_u8_f32(a[2] * 255.f, 2u, x); x = __builtin_amdgcn_cvt_pk_u8_f32(a[3] * 255.f, 3u, x);
    y = __builtin_amdgcn_cvt_pk_u8_f32(b[0] * 255.f, 0u, y); y = __builtin_amdgcn_cvt_pk_u8_f32(b[1] * 255.f, 1u, y); y = __builtin_amdgcn_cvt_pk_u8_f32(b[2] * 255.f, 2u, y); y = __builtin_amdgcn_cvt_pk_u8_f32(b[3] * 255.f, 3u, y);
    w.x = x; w.y = y; return w; }
__device__ __forceinline__ unsigned pack4_fp8(f32x4 a) {
#pragma unroll
    for (int i = 0; i < 4; ++i) a[i] = __builtin_fminf(__builtin_fmaxf(a[i], -448.f), 448.f);
    int w0 = 0; w0 = __builtin_amdgcn_cvt_pk_fp8_f32(a[0], a[1], w0, false); w0 = __builtin_amdgcn_cvt_pk_fp8_f32(a[2], a[3], w0, true); return (unsigned)w0; }
__device__ __forceinline__ void unpack8_fp8(const u32x2 w, f32x4& a, f32x4& b) {
    const f32x2 a0 = __builtin_amdgcn_cvt_pk_f32_fp8((int)w.x, false), a1 = __builtin_amdgcn_cvt_pk_f32_fp8((int)w.x, true), b0 = __builtin_amdgcn_cvt_pk_f32_fp8((int)w.y, false), b1 = __builtin_amdgcn_cvt_pk_f32_fp8((int)w.y, true);
    a = (f32x4){a0[0], a0[1], a1[0], a1[1]}; b = (f32x4){b0[0], b0[1], b1[0], b1[1]}; }
__device__ __forceinline__ void unpack8_u8(const u32x2 w, f32x4& a, f32x4& b) { const float k = 1.f / 255.f;
    a = (f32x4){(float)(w.x & 0xffu), (float)((w.x >> 8) & 0xffu), (float)((w.x >> 16) & 0xffu), (float)(w.x >> 24)} * k;
    b = (f32x4){(float)(w.y & 0xffu), (float)((w.y >> 8) & 0xffu), (float)((w.y >> 16) & 0xffu), (float)(w.y >> 24)} * k; }
__device__ __forceinline__ u32x2 pack4(const f32x4 a) { u32x2 w; w.x = cvt_pk_bf16(a[0], a[1]); w.y = cvt_pk_bf16(a[2], a[3]); return w; }
__device__ __forceinline__ float wave_sum(float v) {
#pragma unroll
    for (int o = 1; o < 64; o <<= 1) v += __shfl_xor(v, o);
    return v;
}
__device__ __forceinline__ float sigmoidf_(float x) { return __builtin_amdgcn_rcpf(1.0f + __builtin_amdgcn_exp2f(-1.4426950408889634f * x)); }
__device__ __forceinline__ int crow(int r, int hi) { return (r & 3) + 8 * (r >> 2) + 4 * hi; }
#define PG8_AUX 0
namespace pg8 {
constexpr int BM = 256, BK = 64, HALF = 128, HTB = HALF * BK * 2  , STAGE_BYTES = 8 * HTB, NXCD = 8, WGM = 8;
__host__ __device__ __forceinline__ int lds_byte(int r, int c) { const int st = (r >> 4) * 2 + (c >> 5), rr = r & 15, cc = c & 31, ob = rr * 64 + cc * 2; return st * 1024 + (ob ^ (((ob >> 9) & 1) << 5)); }
__host__ __device__ __forceinline__ void stage_rc(int b, int& R, int& C) { const int st = b / 1024, sb = b % 1024, swz = sb ^ (((sb >> 9) & 1) << 5); R = (st >> 1) * 16 + swz / 64; C = (st & 1) * 32 + (swz % 64) / 2; }
__host__ __device__ __forceinline__ int perm32(int rho) { const int n = rho >> 4, i = rho & 15; return 8 * (i >> 2) + 4 * n + (i & 3); }

struct Unit { int pm, pn, kind; };

__device__ __forceinline__ void grid_order(int L, int nM, int nN, int& pm, int& pn) {
    const int nwg = nM * nN; int wgid = L;
    { const int q = nwg / NXCD, r = nwg % NXCD, xcd = wgid % NXCD, off = wgid / NXCD; wgid = (xcd < r ? xcd * (q + 1) : r * (q + 1) + (xcd - r) * q) + off; }
    const int nig = WGM * nN, gid = wgid / nig, fm = gid * WGM, gsz = (nM - fm) < WGM ? (nM - fm) : WGM;
    pm = fm + ((wgid % nig) % gsz); pn = (wgid % nig) / gsz;
}

typedef int v8i_t __attribute__((ext_vector_type(8)));
template <class Epi, class Sched, bool F8 = false, int F8_SCALE_EXP = 0>
__device__ __forceinline__ void gemm_phase(LAS unsigned char* lds, const int K, const Sched& S, const Epi& E) {
    const int tid = threadIdx.x, wid = __builtin_amdgcn_readfirstlane(tid >> 6), lane = tid & 63, wr = wid >> 2, wc = wid & 3, fr = lane & 15, fq = lane >> 4;
    int f8sa = 0x01010101 * (127 + F8_SCALE_EXP), f8sb = 0x7f7f7f7f; asm volatile("" : "+v"(f8sa), "+v"(f8sb));
    const int Kb = F8 ? K : 2 * K;
    const int nt = Kb / 128;
    unsigned voffA[2], voffB[2];
#pragma unroll
    for (int i = 0; i < 2; ++i) { int R, C; stage_rc(tid * 16 + i * 8192, R, C); const int Rb = Epi::PERM ? ((R & ~31) + perm32(R & 31)) : R;
        voffA[i] = (unsigned)(R * Kb + C * 2); voffB[i] = (unsigned)(Rb * Kb + C * 2); }
    const size_t kstep = (size_t)128;
    const size_t hstep = (size_t)HALF * Kb;
    const unsigned ldsw = (unsigned)wid * 1024u;
    const int aoff = lds_byte(wr * 64 + fr, F8 ? fq * 16 : fq * 8), boff = lds_byte(wc * 32 + fr, F8 ? fq * 16 : fq * 8);
#define PG8_SA(b, h) (((b) * 2 + (h)) * HTB)
#define PG8_SB(b, h) ((4 + (b) * 2 + (h)) * HTB)
#define PG8_STAGE(bufoff, gbase, voff) do { _Pragma("unroll") for (int _i = 0; _i < 2; ++_i) \
        __builtin_amdgcn_global_load_lds((const unsigned*)((const char*)(gbase) + (voff)[_i]), (LAS unsigned*)(lds + (bufoff) + ldsw + _i * 8192), 16, 0, PG8_AUX); } while (0)
#define PG8_LDA(dst, b, h) do { _Pragma("unroll") for (int m = 0; m < 4; ++m) _Pragma("unroll") for (int k = 0; k < 2; ++k) dst[m][k] = *(const LAS bf16x8*)(lds + PG8_SA(b, h) + aoff + m * 2048 + (F8 ? k * 16 : k * 1024)); } while (0)
#define PG8_LDB(dst, b, h) do { _Pragma("unroll") for (int n = 0; n < 2; ++n) _Pragma("unroll") for (int k = 0; k < 2; ++k) dst[n][k] = *(const LAS bf16x8*)(lds + PG8_SB(b, h) + boff + n * 2048 + (F8 ? k * 16 : k * 1024)); } while (0)
#define PG8_F8OP(X) __builtin_bit_cast(v8i_t, __builtin_shufflevector(X[0], X[1], 0, 1, 2, 3, 4, 5, 6, 7, 8, 9, 10, 11, 12, 13, 14, 15))
#define PG8_MMA(ai, bj, At, Bt) do { __builtin_amdgcn_s_setprio(1); \
        if constexpr (F8) { _Pragma("unroll") for (int m = 0; m < 4; ++m) _Pragma("unroll") for (int n = 0; n < 2; ++n) \
            asm volatile("v_mfma_scale_f32_16x16x128_f8f6f4 %0, %1, %2, %0, %3, %4 op_sel_hi:[0,0,0]" : "+v"(acc[ai][bj][m][n]) : "v"(PG8_F8OP(Bt[n])), "v"(PG8_F8OP(At[m])), "v"(f8sa), "v"(f8sb)); } \
        else { _Pragma("unroll") for (int m = 0; m < 4; ++m) _Pragma("unroll") for (int n = 0; n < 2; ++n) _Pragma("unroll") for (int k = 0; k < 2; ++k) \
            acc[ai][bj][m][n] = __builtin_amdgcn_mfma_f32_16x16x32_bf16(Bt[n][k], At[m][k], acc[ai][bj][m][n], 0, 0, 0); } \
        __builtin_amdgcn_s_setprio(0); } while (0)
#define PG8_WAIT_V(n) asm volatile("s_waitcnt vmcnt(" #n ")" ::: "memory")
#define PG8_WAIT_L(n) asm volatile("s_waitcnt lgkmcnt(" #n ")" ::: "memory")
#define PG8_BAR __builtin_amdgcn_s_barrier()
#define PG8_SCHED __builtin_amdgcn_sched_barrier(0)
    Unit cur, nxt; int ui = 0;
    if (!S.next(0, cur)) return;
    f32x4 acc[2][2][4][2];
#pragma unroll
    for (int a = 0; a < 2; ++a)
#pragma unroll
        for (int b = 0; b < 2; ++b)
#pragma unroll
            for (int m = 0; m < 4; ++m)
#pragma unroll
                for (int n = 0; n < 2; ++n) acc[a][b][m][n] = (f32x4){0.f, 0.f, 0.f, 0.f};
    bf16x8 At[4][2], B0[2][2], B1[2][2];
    const char* cA = S.pa(cur); const char* cB = S.pb(cur);
    PG8_STAGE(PG8_SB(0, 0), cB, voffB); PG8_STAGE(PG8_SB(0, 1), cB + hstep, voffB); PG8_STAGE(PG8_SA(0, 0), cA, voffA); PG8_STAGE(PG8_SA(0, 1), cA + hstep, voffA);
    if (wr == 1) PG8_BAR;
    PG8_WAIT_V(2); PG8_BAR;
    PG8_STAGE(PG8_SB(1, 0), cB + kstep, voffB); PG8_STAGE(PG8_SA(1, 0), cA + kstep, voffA); PG8_STAGE(PG8_SB(1, 1), cB + hstep + kstep, voffB);
    PG8_WAIT_V(6); PG8_BAR;
    for (;;) {
        const bool has_next = S.next(ui + 1, nxt);
        const char* nA = has_next ? S.pa(nxt) : cA; const char* nB = has_next ? S.pb(nxt) : cB;
        for (int t = 0; t < nt; t += 2) {
            const bool last = (t == nt - 2);
            const char* a1 = cA + (size_t)(t + 1) * kstep;
            const char* a2 = last ? nA : cA + (size_t)(t + 2) * kstep; const char* b2 = last ? nB : cB + (size_t)(t + 2) * kstep;
            const char* a3 = a2 + kstep; const char* b3 = b2 + kstep;
            PG8_LDB(B0, 0, 0); PG8_LDB(B1, 0, 1); PG8_SCHED; PG8_LDA(At, 0, 0); PG8_STAGE(PG8_SA(1, 1), a1 + hstep, voffA);
            PG8_WAIT_V(8); PG8_WAIT_L(0); PG8_BAR; PG8_MMA(0, 0, At, B0); PG8_MMA(0, 1, At, B1); PG8_BAR; PG8_SCHED;
            PG8_LDA(At, 0, 1); PG8_STAGE(PG8_SB(0, 0), b2, voffB); PG8_STAGE(PG8_SB(0, 1), b2 + hstep, voffB); PG8_STAGE(PG8_SA(0, 0), a2, voffA);
            PG8_WAIT_V(8); PG8_WAIT_L(0); PG8_BAR; PG8_MMA(1, 0, At, B0); PG8_MMA(1, 1, At, B1); PG8_BAR; PG8_SCHED;
            PG8_LDB(B0, 1, 0); PG8_LDB(B1, 1, 1); PG8_SCHED; PG8_LDA(At, 1, 0); PG8_STAGE(PG8_SA(0, 1), a2 + hstep, voffA);
            PG8_WAIT_V(8); PG8_WAIT_L(0); PG8_BAR; PG8_MMA(0, 0, At, B0); PG8_MMA(0, 1, At, B1); PG8_BAR; PG8_SCHED;
            PG8_LDA(At, 1, 1); PG8_STAGE(PG8_SB(1, 0), b3, voffB); PG8_STAGE(PG8_SB(1, 1), b3 + hstep, voffB); PG8_STAGE(PG8_SA(1, 0), a3, voffA);
            PG8_WAIT_V(8); PG8_WAIT_L(0); PG8_BAR; PG8_MMA(1, 0, At, B0); PG8_MMA(1, 1, At, B1); PG8_BAR; PG8_SCHED;
        }
        if (wr == 0) PG8_BAR;
        if constexpr (F8) asm volatile("s_nop 15\n\ts_nop 7" ::: "memory");
        if constexpr (Epi::HAS_PRE) {
            E.pre(cur, (LAS float*)(lds + STAGE_BYTES + 1024), tid); PG8_WAIT_L(0); PG8_BAR; }
        E(acc, cur, wr, wc, fr, fq, (const LAS float*)(lds + STAGE_BYTES + 1024));
        if (!has_next) break;
#pragma unroll
        for (int a = 0; a < 2; ++a)
#pragma unroll
            for (int b = 0; b < 2; ++b)
#pragma unroll
                for (int m = 0; m < 4; ++m)
#pragma unroll
                    for (int n = 0; n < 2; ++n) acc[a][b][m][n] = (f32x4){0.f, 0.f, 0.f, 0.f};
        cur = nxt; cA = nA; cB = nB; ++ui;
        if (wr == 1) PG8_BAR;
    }
    PG8_WAIT_V(0);
    PG8_BAR;
#undef PG8_SA
#undef PG8_SB
#undef PG8_STAGE
#undef PG8_LDA
#undef PG8_LDB
#undef PG8_MMA
#undef PG8_F8OP
#undef PG8_WAIT_V
#undef PG8_WAIT_L
#undef PG8_BAR
#undef PG8_SCHED
}
}
typedef GAS unsigned gu32;
#define RLX_AGENT __ATOMIC_RELAXED, __HIP_MEMORY_SCOPE_AGENT
#define XB_TMO      128
#define XB_XCNT(j)  (256  + 64 * (j))
#define XB_XSUB(j)  (1280 + 64 * (j))
#define XB_XGEN(j)  (2304 + 64 * (j))
#define XB_TOP      3328
#define XB_TOPGEN   3392
#define XCD_BAR_WORDS 3456
#define XB_SPIN_CAP (1u << 18)
__device__ __forceinline__ unsigned xb_ld(unsigned* p)              { return __hip_atomic_load(p, __ATOMIC_RELAXED, __HIP_MEMORY_SCOPE_AGENT); }
__device__ __forceinline__ unsigned xb_add(unsigned* p, unsigned v) { return __hip_atomic_fetch_add(p, v, __ATOMIC_RELAXED, __HIP_MEMORY_SCOPE_AGENT); }
__device__ __forceinline__ unsigned xb_xcc_id() { return (unsigned)__builtin_amdgcn_s_getreg((3 << 11) | 20) & 0xFu; }
#define XB_SPIN(cond, bar) do { unsigned _sp = 0; while (cond) { __builtin_amdgcn_s_sleep(1); \
    if ((++_sp & 255u) == 0u) { if (xb_ld(&(bar)[XB_TMO])) break; if (_sp > XB_SPIN_CAP) { atomicAdd(&(bar)[XB_TMO], 1u); break; } } } } while (0)
struct XcdBarrier { unsigned* bar; unsigned x; volatile LAS unsigned* st; };
__device__ __forceinline__ XcdBarrier xcd_barrier_post(unsigned* bar, volatile LAS unsigned* st) {
    XcdBarrier b; b.bar = bar; b.x = xb_xcc_id(); b.st = st;
    if (threadIdx.x == 0) (void)xb_add(&bar[XB_XCNT(b.x)], 1u);
    return b;
}
__device__ __forceinline__ void xcd_barrier_complete(unsigned* bar, unsigned x, unsigned& nloc, unsigned& nx) {
    const unsigned G = gridDim.x * gridDim.y * gridDim.z;
    unsigned sum, cnt, mine, sp = 0u;
    for (;;) {
        sum = 0u; cnt = 0u; mine = 0u;
#pragma unroll
        for (unsigned j = 0; j < 16; ++j) { const unsigned c = xb_ld(&bar[XB_XCNT(j)]); sum += c; cnt += (c > 0u) ? 1u : 0u; mine = (j == x) ? c : mine; }
        if (sum == G) break;
        __builtin_amdgcn_s_sleep(1);
        if ((++sp & 255u) == 0u) { if (xb_ld(&bar[XB_TMO])) break; if (sp > XB_SPIN_CAP) { atomicAdd(&bar[XB_TMO], 1u); break; } }
    }
    nloc = mine > 0u ? mine : 1u; nx = cnt > 0u ? cnt : 1u;
}
__device__ __forceinline__ void xcd_barrier(const XcdBarrier& b) {
    asm volatile("s_waitcnt vmcnt(0)" ::: "memory");
    __syncthreads();
    if (threadIdx.x == 0) {
        unsigned* bar = b.bar;
        __builtin_amdgcn_s_waitcnt(0);
        unsigned nloc = b.st[0], nx = b.st[1];
        if (nloc == 0u) { xcd_barrier_complete(bar, b.x, nloc, nx); b.st[0] = nloc; b.st[1] = nx; }
        const unsigned old = xb_add(&bar[XB_XSUB(b.x)], 1u);
        const unsigned gen = old / nloc;
        if (old + 1u == (gen + 1u) * nloc) {
            __builtin_amdgcn_fence(__ATOMIC_RELEASE, "agent");
            asm volatile("s_waitcnt vmcnt(0)" ::: "memory");
            const unsigned og = xb_add(&bar[XB_TOP], 1u);
            const unsigned tg = og / nx;
            if (og + 1u == (tg + 1u) * nx) xb_add(&bar[XB_TOPGEN], 1u);
            else XB_SPIN(xb_ld(&bar[XB_TOPGEN]) == tg, bar);
            __builtin_amdgcn_fence(__ATOMIC_ACQUIRE, "agent");
            xb_add(&bar[XB_XGEN(b.x)], 1u);
            asm volatile("s_waitcnt vmcnt(0)" ::: "memory");
        } else {
            XB_SPIN(xb_ld(&bar[XB_XGEN(b.x)]) == gen, bar);
            __builtin_amdgcn_fence(__ATOMIC_ACQUIRE, "agent");
            asm volatile("s_waitcnt vmcnt(0)" ::: "memory");
        }
    }
    __syncthreads();
}
struct Frame {
    LAS unsigned char* lds;
    volatile LAS unsigned* MISC;
    unsigned char* ws;
    int tid, lane, wave;
    int vcu, G;
    const float* in[19];
    float* out;
};
#define WSP(T, off) ((T*)(F.ws + (off)))

typedef float cv16f_t __attribute__((ext_vector_type(16)));
typedef unsigned cv6u_t __attribute__((ext_vector_type(6)));
struct Conv { const float* pu; const float* pv; unsigned char* u8; unsigned char* v8; LAS unsigned char* lbuf; int next, stride, end, pend, tick; };
__device__ __forceinline__ void conv_issue(const Conv& c, int item, int lane) {
    const float* src = ((item >> 14) ? c.pv : c.pu) + (size_t)(item & 16383) * 2048 + 4 * lane;
#pragma unroll
    for (int q = 0; q < 8; ++q) __builtin_amdgcn_global_load_lds((const unsigned*)(src + 256 * q), (LAS unsigned*)(c.lbuf + q * 1024), 16, 0, 0);
}
__device__ __forceinline__ void conv_finish(const Conv& c, int item, int lane) {
    const int isv = item >> 14, row = item & 16383; const float sc = isv ? PEER_V_SCALE : PEER_U_SCALE; unsigned w[4] = {0u, 0u, 0u, 0u};
#define CONV_Q(q) { const f32x4 x = *(const LAS f32x4*)(c.lbuf + (q) * 1024 + lane * 16) * sc; \
        w[(q) >> 1] = __builtin_amdgcn_cvt_scalef32_pk_fp4_f32(w[(q) >> 1], x[0], x[1], 1.0f, (2 * (q)) & 3); w[(q) >> 1] = __builtin_amdgcn_cvt_scalef32_pk_fp4_f32(w[(q) >> 1], x[2], x[3], 1.0f, (2 * (q) + 1) & 3); }
    CONV_Q(0) asm volatile("" : "+v"(w[0]) :: "memory"); CONV_Q(1) asm volatile("" : "+v"(w[0]) :: "memory"); CONV_Q(2) asm volatile("" : "+v"(w[1]) :: "memory"); CONV_Q(3) asm volatile("" : "+v"(w[1]) :: "memory");
    CONV_Q(4) asm volatile("" : "+v"(w[2]) :: "memory"); CONV_Q(5) asm volatile("" : "+v"(w[2]) :: "memory"); CONV_Q(6) asm volatile("" : "+v"(w[3]) :: "memory"); CONV_Q(7)
#undef CONV_Q
    unsigned char* rec = (isv ? c.v8 : c.u8) + (size_t)row * 1024;
    *(GAS u32x4*)(rec + lane * 16) = (u32x4){w[0], w[1], w[2], w[3]};
}
template <int YOUNGER>
__device__ __forceinline__ void conv_step(Conv& c, int lane) {
    if (c.pend >= 0) { if constexpr (YOUNGER == 0) asm volatile("s_waitcnt vmcnt(0)" ::: "memory"); else { static_assert(YOUNGER == 12, "wait count"); asm volatile("s_waitcnt vmcnt(12)" ::: "memory"); }
        conv_finish(c, c.pend, lane); c.pend = -1; asm volatile("s_waitcnt lgkmcnt(0)" ::: "memory"); }
    if (c.next < c.end) { conv_issue(c, c.next, lane); c.pend = c.next; c.next += c.stride; }
}
__device__ __forceinline__ void p0_transpose_item(const float* W, int K, int N, int k0, int n0, bf16_t* WT, int drow, bool rope, const float* gain, LAS float* scr, int lane) {
    { f32x4 v[8]; float gk[8];
#pragma unroll
      for (int i = 0; i < 8; ++i) { const int kk = 8 * i + (lane >> 3); v[i] = *(const GAS f32x4*)(W + (size_t)(k0 + kk) * N + n0 + 4 * (lane & 7)); gk[i] = gain ? gain[k0 + kk] : 1.f; }
#pragma unroll
      for (int i = 0; i < 8; ++i) { const int kk = 8 * i + (lane >> 3); LAS float* d = scr + kk * 33 + 4 * (lane & 7);
#pragma unroll
          for (int e = 0; e < 4; ++e) d[e] = v[i][e] * gk[i]; } }
    LDS_WAIT(); asm volatile("" ::: "memory");
    const int c = lane & 7;
#pragma unroll
    for (int j = 0; j < 4; ++j) { const int n = (lane >> 3) + 8 * j; const LAS float* s = scr + (8 * c) * 33 + n;
        u32x4 o; o.x = cvt_pk_bf16(s[0 * 33], s[1 * 33]); o.y = cvt_pk_bf16(s[2 * 33], s[3 * 33]); o.z = cvt_pk_bf16(s[4 * 33], s[5 * 33]); o.w = cvt_pk_bf16(s[6 * 33], s[7 * 33]);
        const int dr = drow + (rope ? (8 * (n >> 2) + (n & 3)) : n);
        *(GAS u32x4*)(WT + (size_t)dr * K + k0 + 8 * c) = o; }
    LDS_WAIT(); asm volatile("" ::: "memory");
}
__device__ __forceinline__ void p0_transpose_item8(const float* W, int K, int N, int k0, int n0, unsigned char* WT, int drow, bool rope, float scale, LAS float* scr, int lane, const float* gain = nullptr) {
    { f32x4 v[8]; float gk[8];
#pragma unroll
      for (int i = 0; i < 8; ++i) { const int kk = 8 * i + (lane >> 3); v[i] = *(const GAS f32x4*)(W + (size_t)(k0 + kk) * N + n0 + 4 * (lane & 7)); gk[i] = gain ? gain[k0 + kk] * scale : scale; }
#pragma unroll
      for (int i = 0; i < 8; ++i) { const int kk = 8 * i + (lane >> 3); LAS float* d = scr + kk * 33 + 4 * (lane & 7);
#pragma unroll
          for (int e = 0; e < 4; ++e) d[e] = v[i][e] * gk[i]; } }
    LDS_WAIT(); asm volatile("" ::: "memory");
#pragma unroll
    for (int j = 0; j < 2; ++j) { const int q = lane + 64 * j, n = q >> 2, c = q & 3; const LAS float* s = scr + (16 * c) * 33 + n; u32x4 o;
#pragma unroll
        for (int d = 0; d < 4; ++d) { int w = 0; w = __builtin_amdgcn_cvt_pk_fp8_f32(s[(4 * d) * 33], s[(4 * d + 1) * 33], w, false); w = __builtin_amdgcn_cvt_pk_fp8_f32(s[(4 * d + 2) * 33], s[(4 * d + 3) * 33], w, true); o[d] = (unsigned)w; }
        const int dr = drow + (rope ? (8 * (n >> 2) + (n & 3)) : n);
        *(GAS u32x4*)(WT + (size_t)dr * K + k0 + 16 * c) = o; }
    LDS_WAIT(); asm volatile("" ::: "memory");
}
__device__ __forceinline__ void rms_row_to_fp8(const float* xrow, const float* g, unsigned char* orow, int lane) {
    const GAS f32x4* xr = (const GAS f32x4*)xrow + lane; const GAS f32x4* gr = (const GAS f32x4*)g + lane;
    f32x4 v[8]; float s = 0.f;
#pragma unroll
    for (int j = 0; j < 8; ++j) { v[j] = xr[64 * j]; s += (v[j].x * v[j].x + v[j].y * v[j].y) + (v[j].z * v[j].z + v[j].w * v[j].w); }
    const float rstd = 1.0f / sqrtf(wave_sum(s) * (1.f / DM) + NORM_EPS);
    GAS unsigned* o4 = (GAS unsigned*)orow + lane;
#pragma unroll
    for (int j = 0; j < 8; ++j) { const f32x4 y = (v[j] * rstd) * gr[64 * j]; int w = 0; w = __builtin_amdgcn_cvt_pk_fp8_f32(y[0], y[1], w, false); w = __builtin_amdgcn_cvt_pk_fp8_f32(y[2], y[3], w, true); o4[64 * j] = (unsigned)w; }
}
__device__ __forceinline__ void rms_row_to_bf16(const float* xrow, const float* g, bf16_t* orow, int lane) {
    const GAS f32x4* xr = (const GAS f32x4*)xrow + lane; const GAS f32x4* gr = (const GAS f32x4*)g + lane;
    f32x4 v[8]; float s = 0.f;
#pragma unroll
    for (int j = 0; j < 8; ++j) { v[j] = xr[64 * j]; s += (v[j].x * v[j].x + v[j].y * v[j].y) + (v[j].z * v[j].z + v[j].w * v[j].w); }
    const float rstd = 1.0f / sqrtf(wave_sum(s) * (1.f / DM) + NORM_EPS);
    GAS u32x2* o8 = (GAS u32x2*)orow + lane;
#pragma unroll
    for (int j = 0; j < 8; ++j) { const f32x4 gg = gr[64 * j]; o8[64 * j] = pack4((v[j] * rstd) * gg); }
}
template <int PART>
__device__ __forceinline__ void p0_prologue(Frame& F, int rank, int nrank) {
    LAS float* scr = (LAS float*)(F.lds + F.wave * 16384);
    const int gw = rank * NWAVES + F.wave, NGW = nrank * NWAVES, lane = F.lane; const int gt = rank * 512 + F.tid, NGT = nrank * 512;
    unsigned char* WIN = WSP(unsigned char, WS_WIN); unsigned char* WVT = WSP(unsigned char, WS_WVT);
    constexpr int I_IN = 32 * 258, I_UQ = 8 * 96, I_UKV = 8 * 128, I_NA = 16 * 64, I_MLA = 32 * 64, I_OUT = 32 * 64;
    constexpr int NEARLY = I_IN + I_UQ + I_UKV, NITEMS = NEARLY + I_NA + I_MLA + I_OUT;
    for (int it = (PART == 0 ? 0 : NEARLY) + gw; it < (PART == 0 ? NEARLY : NITEMS); it += NGW) {
        int r = it;
        if (r < I_IN) { const int kb = r / 258, sb = r % 258, n0 = 32 * sb, k0 = 64 * kb; const float* W = F.in[3];
            unsigned char* dst = WIN; int drow; bool rope = false;
            if (n0 < 1024) drow = C_NAQ + n0;
            else if (n0 < 2048) drow = C_NAK + (n0 - 1024);
            else if (n0 < 3072) { dst = WVT; drow = n0 - 2048; }
            else if (n0 < 3584) drow = C_CQ + (n0 - 3072);
            else if (n0 < 4096) drow = C_CKV + (n0 - 3584);
            else if (n0 < 4160) { drow = C_KR + ((n0 - 4096) ? 4 : 0); rope = true; }
            else if (n0 < 6208) drow = C_GA + (n0 - 4160);
            else drow = C_GB + (n0 - 6208);
            p0_transpose_item8(W, 2048, 8256, k0, n0, dst, drow, rope, 64.f, scr, lane); continue; } r -= I_IN;
        if (r < I_UQ) { const int kb = r / 96, sb = r % 96, n0 = 32 * sb, k0 = 64 * kb; const int hd = n0 / 192, w = n0 % 192;
            int drow = n0; bool rope = false; if (w >= 128) { rope = true; drow = hd * 192 + 128 + ((w - 128) ? 4 : 0); }
            p0_transpose_item8(F.in[7], 512, 3072, k0, n0, WSP(unsigned char, WS_WUQ), drow, rope, 16.f, scr, lane, F.in[6]); continue; } r -= I_UQ;
        if (r < I_UKV) { const int kb = r / 128, sb = r % 128; const int n0 = 32 * sb, hd = n0 >> 8, w = n0 & 255;
            p0_transpose_item8(F.in[9], 512, 4096, 64 * kb, n0, WSP(unsigned char, WS_WUKV), (w >= 128 ? 2048 : 0) + hd * 128 + (w & 127), false, 16.f, scr, lane, F.in[8]); continue; } r -= I_UKV;
        if (r < I_NA) { const int kb = r / 64, sb = r % 64; p0_transpose_item8(F.in[10], 1024, 2048, 64 * kb, 32 * sb, WSP(unsigned char, WS_WNA), 32 * sb, false, 32.f, scr, lane); continue; } r -= I_NA;
        if (r < I_MLA) { const int kb = r / 64, sb = r % 64; p0_transpose_item8(F.in[11], 2048, 2048, 64 * kb, 32 * sb, WSP(unsigned char, WS_WMLA), 32 * sb, false, 64.f, scr, lane); continue; } r -= I_MLA;
        { const int kb = r / 64, sb = r % 64; p0_transpose_item8(F.in[12], 2048, 2048, 64 * kb, 32 * sb, WSP(unsigned char, WS_WOUT), 32 * sb, false, 64.f, scr, lane); }
    }
    if (PART == 0) { GAS u32x4* z = (GAS u32x4*)(WIN + (size_t)(C_KR + 64) * 2048); const int n16 = (NMAIN - C_KR - 64) * 2048 / 16;
      for (int i = gt; i < n16; i += NGT) z[i] = (u32x4){0u, 0u, 0u, 0u}; }
    if (PART == 0) { unsigned char* HN1 = WSP(unsigned char, WS_HN1);
#define P0_ROWSRC(m_) (((m_) < MREAL) ? F.in[0] + (size_t)(m_) * DM : F.in[1] + (size_t)((m_) - MREAL) * DM)
      { f32x4 v[8]; int m = gw;
        if (m < MREAL + NMETA) { const GAS f32x4* xr = (const GAS f32x4*)P0_ROWSRC(m) + lane;
#pragma unroll
            for (int j = 0; j < 8; ++j) v[j] = xr[64 * j]; }
        const GAS f32x4* gr = (const GAS f32x4*)F.in[2] + lane;
        while (m < MREAL + NMETA) { const int mn = m + NGW; f32x4 vn[8];
            { const int ml = mn < MREAL + NMETA ? mn : m; const GAS f32x4* xr = (const GAS f32x4*)P0_ROWSRC(ml) + lane;
#pragma unroll
              for (int j = 0; j < 8; ++j) vn[j] = xr[64 * j]; }
            float sq = 0.f;
#pragma unroll
            for (int j = 0; j < 8; ++j) sq += (v[j].x * v[j].x + v[j].y * v[j].y) + (v[j].z * v[j].z + v[j].w * v[j].w);
            const float rstd = 1.0f / sqrtf(wave_sum(sq) * (1.f / DM) + NORM_EPS);
            GAS unsigned* o4 = (GAS unsigned*)(HN1 + (size_t)m * DM) + lane;
#pragma unroll
            for (int j = 0; j < 8; ++j) { const f32x4 y = (v[j] * rstd) * gr[64 * j]; int w = 0; w = __builtin_amdgcn_cvt_pk_fp8_f32(y[0], y[1], w, false); w = __builtin_amdgcn_cvt_pk_fp8_f32(y[2], y[3], w, true); o4[64 * j] = (unsigned)w; }
#pragma unroll
            for (int j = 0; j < 8; ++j) v[j] = vn[j];
            m = mn; } }
#undef P0_ROWSRC
      GAS u32x4* z = (GAS u32x4*)(HN1 + (size_t)(MREAL + NMETA) * DM); const int n16 = (MPAD - MREAL - NMETA) * DM / 16;
      for (int i = gt; i < n16; i += NGT) z[i] = (u32x4){0u, 0u, 0u, 0u}; }
    if (PART == 0) { float* ct = WSP(float, WS_COS); float* st = WSP(float, WS_SIN);
      for (int i = gt; i < NPOS * 32; i += NGT) { const int p = i >> 5, j = i & 31;
          const float inv = __builtin_powf(10000.0f, -(float)(2 * j) / 64.0f); const float ang = (float)p * inv;
          double r = (double)ang * 0.15915494309189535; r -= __builtin_rint(r); const float rf = (float)r;
          ct[i] = __builtin_amdgcn_cosf(rf); st[i] = __builtin_amdgcn_sinf(rf); } }
    if (PART == 1) { const float* SK = F.in[15]; const float* WQ = F.in[14]; const float* g2 = F.in[13]; bf16_t* WSCp = WSP(bf16_t, WS_WSC);
      const int l15 = lane & 15, l4 = lane >> 4;
      for (int task = gw; task < 2048; task += NGW) { const int g = task >> 7, nt = (task >> 4) & 7, kc = task & 15, n0 = nt * 16;
          bf16x8 bfr[4];
#pragma unroll
          for (int kk = 0; kk < 4; ++kk) { const float* p = SK + ((size_t)g * 128 + n0 + l15) * 128 + 32 * kk + 8 * l4; const f32x4 a = *(const GAS f32x4*)p, b = *(const GAS f32x4*)(p + 4);
              const u32x4 w = pack8(a, b); bfr[kk] = __builtin_bit_cast(bf16x8, w); }
          for (int kt = 0; kt < 8; ++kt) { const int k0 = (kc * 8 + kt) * 16; f32x4 acc = (f32x4){0.f, 0.f, 0.f, 0.f};
#pragma unroll
              for (int kk = 0; kk < 4; ++kk) { const float* p = WQ + (size_t)(k0 + l15) * 2048 + g * 128 + 32 * kk + 8 * l4; const f32x4 a = *(const GAS f32x4*)p, b = *(const GAS f32x4*)(p + 4);
                  const u32x4 w = pack8(a, b); acc = __builtin_amdgcn_mfma_f32_16x16x32_bf16(__builtin_bit_cast(bf16x8, w), bfr[kk], acc, 0, 0, 0); }
              const f32x4 gg = *(const GAS f32x4*)(g2 + k0 + 4 * l4);
              *(GAS u32x2*)(WSCp + (size_t)(g * 128 + n0 + l15) * 2048 + k0 + 4 * l4) = pack4(acc * gg); } } }
}
using pg8::Unit;
struct SchedGrid {
    int G, c, nM, nN; const char* A; const char* B; size_t tstep;
    __device__ __forceinline__ bool next(int i, Unit& u) const { const int L = i * G + c; if (L >= nM * nN) return false; pg8::grid_order(L, nM, nN, u.pm, u.pn); u.kind = 0; return true; }
    __device__ __forceinline__ const char* pa(const Unit& u) const { return A + (size_t)u.pm * tstep; }
    __device__ __forceinline__ const char* pb(const Unit& u) const { return B + (size_t)u.pn * tstep; }
};
constexpr int P1_MAIN = 64 * 29, P1_VT = 4 * 65, P1_META = 7, P1_UNITS = P1_MAIN + P1_VT + P1_META;
struct SchedP1 {
    int G, c; const char* hn1; const char* win; const char* wvt; size_t tstep;
    __device__ __forceinline__ bool next(int i, Unit& u) const {
        const int L = i * G + c; if (L >= P1_UNITS) return false;
        if (L < P1_MAIN) { pg8::grid_order(L, 64, 29, u.pm, u.pn); u.kind = 0; }
        else if (L < P1_MAIN + P1_VT) { const int idx = L - P1_MAIN; u.pm = idx & 3; u.pn = idx >> 2; u.kind = 1; }
        else { const int idx = L - P1_MAIN - P1_VT; u.pm = 64; u.pn = idx < 4 ? 4 + idx : (idx < 6 ? 10 + (idx - 4) : 28); u.kind = 0; }
        return true; }
    __device__ __forceinline__ const char* pa(const Unit& u) const { return (u.kind == 1 ? wvt : hn1) + (size_t)u.pm * tstep; }
    __device__ __forceinline__ const char* pb(const Unit& u) const { return (u.kind == 1 ? hn1 : win) + (size_t)u.pn * tstep; }
};
__device__ __forceinline__ void rope4(const f32x4 x1, const f32x4 x2, const float* cosT, const float* sinT, int pos, int j0, f32x4& lo, f32x4& hi) {
    const f32x4 c = *(const GAS f32x4*)(cosT + pos * 32 + j0), s = *(const GAS f32x4*)(sinT + pos * 32 + j0);
    lo = x1 * c - x2 * s; hi = x2 * c + x1 * s;
}
struct EpiP1 {
    static constexpr bool PERM = true, HAS_PRE = false;
    unsigned char *naq, *nak, *vt; unsigned char *cq, *ckv; unsigned char *kr; unsigned char *ga, *gb; float *ssq_q, *ssq_kv; const float *cosT, *sinT;
    __device__ __forceinline__ void operator()(const f32x4 (&acc)[2][2][4][2], const Unit& u, int wr, int wc, int fr, int fq, const LAS float* rowsc) const {
        const int row0 = u.pm * 256 + wr * 64 + fr, colu = wc * 32 + 8 * fq;
        if (u.kind == 1) {
#pragma unroll
            for (int bj = 0; bj < 2; ++bj) { const int t0 = u.pn * 256 + bj * 128 + colu, pos = (t0 & ~63) + ((t0 & 63) >> 1);
#pragma unroll
                for (int ai = 0; ai < 2; ++ai)
#pragma unroll
                    for (int m = 0; m < 4; ++m) { unsigned char* rp = vt + (size_t)(row0 + ai * 128 + m * 16) * VT_PITCH + pos;
                        *(GAS unsigned*)rp = pack4_fp8(acc[ai][bj][m][0]); *(GAS unsigned*)(rp + 32) = pack4_fp8(acc[ai][bj][m][1]); } }
            return; }
        const int pn = u.pn;
        if (pn == 28) {
            if (wc < 2) { const int j0 = 4 * (4 * wc + fq);
#pragma unroll
                for (int ai = 0; ai < 2; ++ai)
#pragma unroll
                    for (int m = 0; m < 4; ++m) { const int row = row0 + ai * 128 + m * 16; const int pos = row < MREAL ? NMETA + (row & (SEQ - 1)) : row - MREAL;
                        f32x4 lo, hi; rope4(acc[ai][0][m][0], acc[ai][0][m][1], cosT, sinT, pos, j0, lo, hi);
                        *(GAS unsigned*)(kr + (size_t)row * 64 + j0) = pack4_fp8(lo); *(GAS unsigned*)(kr + (size_t)row * 64 + 32 + j0) = pack4_fp8(hi); } }
            return; }
        if (pn >= 12) {
            unsigned char* base = pn < 20 ? ga : gb; const int colt = (pn < 20 ? pn - 12 : pn - 20) * 256 + colu;
#pragma unroll
            for (int ai = 0; ai < 2; ++ai)
#pragma unroll
                for (int m = 0; m < 4; ++m) { unsigned char* rp = base + (size_t)(row0 + ai * 128 + m * 16) * 2048 + colt;
#pragma unroll
                    for (int bj = 0; bj < 2; ++bj) { f32x4 a = acc[ai][bj][m][0], b = acc[ai][bj][m][1];
#pragma unroll
                        for (int i = 0; i < 4; ++i) { a[i] = sigmoidf_(a[i]); b[i] = sigmoidf_(b[i]); }
                        *(GAS u32x2*)(rp + bj * 128) = pack8_u8(a, b); } }
            return; }
        if (pn >= 8) {
            const bool isq = pn < 10; unsigned char* base = isq ? cq : ckv; float* ssq = isq ? ssq_q : ssq_kv; const int colt = (isq ? pn - 8 : pn - 10) * 256 + colu;
#pragma unroll
            for (int ai = 0; ai < 2; ++ai)
#pragma unroll
                for (int m = 0; m < 4; ++m) { const int row = row0 + ai * 128 + m * 16; unsigned char* rp = base + (size_t)row * 512 + colt; float s = 0.f;
#pragma unroll
                    for (int bj = 0; bj < 2; ++bj) { const f32x4 a = acc[ai][bj][m][0], b = acc[ai][bj][m][1];
                        s += (a[0] * a[0] + a[1] * a[1]) + (a[2] * a[2] + a[3] * a[3]) + (b[0] * b[0] + b[1] * b[1]) + (b[2] * b[2] + b[3] * b[3]);
                        *(GAS u32x2*)(rp + bj * 128) = pack8_fp8(a, b); }
                    s += __shfl_xor(s, 16); s += __shfl_xor(s, 32);
                    if (fq == 0) ssq[(size_t)((pn & 1) * 4 + wc) * MPAD + row] = s; }
            return; }
        {
            unsigned char* base = pn < 4 ? naq : nak; const int colt = (pn & 3) * 256 + colu;
#pragma unroll
            for (int ai = 0; ai < 2; ++ai)
#pragma unroll
                for (int m = 0; m < 4; ++m) { unsigned char* rp = base + (size_t)(row0 + ai * 128 + m * 16) * 1024 + colt;
#pragma unroll
                    for (int bj = 0; bj < 2; ++bj) *(GAS u32x2*)(rp + bj * 128) = pack8_fp8(acc[ai][bj][m][0], acc[ai][bj][m][1]); }
        }
    }
};
constexpr int P3_Q = 64 * 12, P3_K = 65 * 8, P3_V = 8 * 65, P3_UNITS = P3_Q + P3_K + P3_V;
struct SchedP3 {
    int G, c; const char* ws; size_t tstep;
    __device__ __forceinline__ bool next(int i, Unit& u) const {
        const int L = i * G + c; if (L >= P3_UNITS) return false;
        if (L < P3_Q) { pg8::grid_order(L, 64, 12, u.pm, u.pn); u.kind = 0; }
        else if (L < P3_Q + P3_K) { pg8::grid_order(L - P3_Q, 65, 8, u.pm, u.pn); u.kind = 1; }
        else { const int idx = L - P3_Q - P3_K; u.pm = idx & 7; u.pn = idx >> 3; u.kind = 2; }
        return true; }
    __device__ __forceinline__ const char* pa(const Unit& u) const { const size_t o = u.kind == 0 ? WS_CQ : (u.kind == 1 ? WS_CKV : WS_WUKV + (size_t)2048 * 512); return ws + o + (size_t)u.pm * tstep; }
    __device__ __forceinline__ const char* pb(const Unit& u) const { const size_t o = u.kind == 0 ? WS_WUQ : (u.kind == 1 ? WS_WUKV : WS_CKV); return ws + o + (size_t)u.pn * tstep; }
};
template <int NS, int LD> __device__ __forceinline__ float rstd_slabs(const float* part, int row, float invn) {
    float s = 0.f;
#pragma unroll
    for (int i = 0; i < NS; ++i) s += part[(size_t)i * LD + row];
    return 1.0f / sqrtf(s * invn + NORM_EPS);
}
struct EpiP3 {
    static constexpr bool PERM = true, HAS_PRE = true;
    unsigned char *qm, *kn, *vt; const float *ssq_q, *ssq_kv; const float *cosT, *sinT;
    __device__ __forceinline__ void pre(const Unit& u, LAS float* sc, int tid) const { if (tid < 256) { const int row = (u.kind == 2 ? u.pn : u.pm) * 256 + tid; sc[tid] = u.kind ? rstd_slabs<8, MPAD>(ssq_kv, row, 1.f / 512.f) : rstd_slabs<8, MPAD>(ssq_q, row, 1.f / 512.f); } }
    __device__ __forceinline__ void operator()(const f32x4 (&acc)[2][2][4][2], const Unit& u, int wr, int wc, int fr, int fq, const LAS float* rowsc) const {
        const int row0 = u.pm * 256 + wr * 64 + fr, colu = wc * 32 + 8 * fq;
        if (u.kind == 2) {
#pragma unroll
            for (int bj = 0; bj < 2; ++bj) { const int cl = bj * 128 + colu, t0 = u.pn * 256 + cl;
                const f32x4 s0 = *(const LAS f32x4*)(rowsc + cl), s1 = *(const LAS f32x4*)(rowsc + cl + 4);
                const int g = (t0 >> 3) & 7, pos = (t0 & ~63) + 16 * (g >> 2) + 4 * (g & 3);
#pragma unroll
                for (int ai = 0; ai < 2; ++ai)
#pragma unroll
                    for (int m = 0; m < 4; ++m) { unsigned char* rp = vt + (size_t)(row0 + ai * 128 + m * 16) * MPAD + pos;
                        *(GAS unsigned*)rp = pack4_fp8(acc[ai][bj][m][0] * s0); *(GAS unsigned*)(rp + 32) = pack4_fp8(acc[ai][bj][m][1] * s1); } }
            return; }
        if (u.kind == 1) {
#pragma unroll
            for (int ai = 0; ai < 2; ++ai)
#pragma unroll
                for (int m = 0; m < 4; ++m) { const int row = row0 + ai * 128 + m * 16; const float rs = rowsc[ai * 128 + wr * 64 + m * 16 + fr];
                    unsigned char* rp = kn + (size_t)row * 2048 + u.pn * 256 + colu;
#pragma unroll
                    for (int bj = 0; bj < 2; ++bj) *(GAS u32x2*)(rp + bj * 128) = pack8_fp8(acc[ai][bj][m][0] * rs, acc[ai][bj][m][1] * rs); }
            return; }
#pragma unroll
        for (int bj = 0; bj < 2; ++bj) { const int c8 = u.pn * 256 + bj * 128 + colu; const int hd = c8 / 192, w = c8 - hd * 192;
            if (w < 128) {
#pragma unroll
                for (int ai = 0; ai < 2; ++ai)
#pragma unroll
                    for (int m = 0; m < 4; ++m) { const int row = row0 + ai * 128 + m * 16; const float rs = rowsc[ai * 128 + wr * 64 + m * 16 + fr];
                        *(GAS u32x2*)(qm + (size_t)row * 3072 + c8) = pack8_fp8(acc[ai][bj][m][0] * rs, acc[ai][bj][m][1] * rs); }
            } else { const int j0 = (w - 128) >> 1;
#pragma unroll
                for (int ai = 0; ai < 2; ++ai)
#pragma unroll
                    for (int m = 0; m < 4; ++m) { const int row = row0 + ai * 128 + m * 16; const float rs = rowsc[ai * 128 + wr * 64 + m * 16 + fr];
                        const int pos = NMETA + (row & (SEQ - 1)); f32x4 lo, hi; rope4(acc[ai][bj][m][0] * rs, acc[ai][bj][m][1] * rs, cosT, sinT, pos, j0, lo, hi);
                        unsigned char* qp = qm + (size_t)row * 3072 + hd * 192 + 128 + j0; *(GAS unsigned*)qp = pack4_fp8(lo); *(GAS unsigned*)(qp + 32) = pack4_fp8(hi); }
            } }
    }
};

__device__ __forceinline__ void unpack8(const u32x4 w, f32x4& a, f32x4& b) { a = (f32x4){bf_lo(w.x), bf_hi(w.x), bf_lo(w.y), bf_hi(w.y)}; b = (f32x4){bf_lo(w.z), bf_hi(w.z), bf_lo(w.w), bf_hi(w.w)}; }
struct EpiP5a {
    static constexpr bool PERM = true, HAS_PRE = false;
    const unsigned char* ga; unsigned char* t1;
    __device__ __forceinline__ void operator()(const f32x4 (&acc)[2][2][4][2], const Unit& u, int wr, int wc, int fr, int fq, const LAS float* rowsc) const {
        const int row0 = u.pm * 256 + wr * 64 + fr, col0 = u.pn * 256 + wc * 32 + 8 * fq;
#pragma unroll
        for (int ai = 0; ai < 2; ++ai)
#pragma unroll
            for (int m = 0; m < 4; ++m) { const size_t off = (size_t)(row0 + ai * 128 + m * 16) * 2048 + col0;
#pragma unroll
                for (int bj = 0; bj < 2; ++bj) { f32x4 g0, g1; unpack8_u8(*(const GAS u32x2*)(ga + off + bj * 128), g0, g1);
                    *(GAS u32x2*)(t1 + off + bj * 128) = pack8_fp8(acc[ai][bj][m][0] * g0 * 32.f, acc[ai][bj][m][1] * g1 * 32.f); } }
    }
};
struct EpiP5b {
    static constexpr bool PERM = true, HAS_PRE = false;
    const unsigned char* gb; const unsigned char* t1; unsigned char* merged;
    __device__ __forceinline__ void operator()(const f32x4 (&acc)[2][2][4][2], const Unit& u, int wr, int wc, int fr, int fq, const LAS float* rowsc) const {
        const int row0 = u.pm * 256 + wr * 64 + fr, col0 = u.pn * 256 + wc * 32 + 8 * fq;
#pragma unroll
        for (int ai = 0; ai < 2; ++ai)
#pragma unroll
            for (int m = 0; m < 4; ++m) { const size_t off = (size_t)(row0 + ai * 128 + m * 16) * 2048 + col0;
#pragma unroll
                for (int bj = 0; bj < 2; ++bj) { f32x4 g0, g1; unpack8_u8(*(const GAS u32x2*)(gb + off + bj * 128), g0, g1);
                    f32x4 a, b; unpack8_fp8(*(const GAS u32x2*)(t1 + off + bj * 128), a, b);
                    *(GAS u32x2*)(merged + off + bj * 128) = pack8_fp8(a + acc[ai][bj][m][0] * g0 * 32.f, b + acc[ai][bj][m][1] * g1 * 32.f); } }
    }
};
struct EpiP6 {
    static constexpr bool PERM = true, HAS_PRE = false;
    const float* x; bf16_t* h2b; float* ssq2;
    __device__ __forceinline__ void operator()(const f32x4 (&acc)[2][2][4][2], const Unit& u, int wr, int wc, int fr, int fq, const LAS float* rowsc) const {
        const int row0 = u.pm * 256 + wr * 64 + fr, col0 = u.pn * 256 + wc * 32 + 8 * fq;
#pragma unroll
        for (int ai = 0; ai < 2; ++ai)
#pragma unroll
            for (int m = 0; m < 4; ++m) { const int row = row0 + ai * 128 + m * 16; const size_t off = (size_t)row * 2048 + col0; float s = 0.f;
#pragma unroll
                for (int bj = 0; bj < 2; ++bj) { const f32x4 a = *(const GAS f32x4*)(x + off + bj * 128) + acc[ai][bj][m][0], b = *(const GAS f32x4*)(x + off + bj * 128 + 4) + acc[ai][bj][m][1];
                    s += (a[0] * a[0] + a[1] * a[1]) + (a[2] * a[2] + a[3] * a[3]) + (b[0] * b[0] + b[1] * b[1]) + (b[2] * b[2] + b[3] * b[3]);
                    *(GAS u32x4*)(h2b + off + bj * 128) = pack8(a, b); }
                s += __shfl_xor(s, 16); s += __shfl_xor(s, 32);
                if (fq == 0) ssq2[(size_t)(u.pn * 4 + wc) * MREAL + row] = s; }
    }
};
struct EpiP7 {
    static constexpr bool PERM = true, HAS_PRE = true;
    const float* ssq2; _Float16* sc;
    __device__ __forceinline__ void pre(const Unit& u, LAS float* sc, int tid) const { if (tid < 256) sc[tid] = rstd_slabs<32, MREAL>(ssq2, u.pm * 256 + tid, 1.f / 2048.f); }
    __device__ __forceinline__ void operator()(const f32x4 (&acc)[2][2][4][2], const Unit& u, int wr, int wc, int fr, int fq, const LAS float* rowsc) const {
        typedef _Float16 h4_t __attribute__((ext_vector_type(4)));
        const int row0 = u.pm * 256 + wr * 64 + fr, col0 = u.pn * 256 + wc * 32 + 8 * fq;
#pragma unroll
        for (int ai = 0; ai < 2; ++ai)
#pragma unroll
            for (int m = 0; m < 4; ++m) { const int row = row0 + ai * 128 + m * 16; const float rs = rowsc[ai * 128 + wr * 64 + m * 16 + fr]; const size_t off = (size_t)row * 2048 + col0;
#pragma unroll
                for (int bj = 0; bj < 2; ++bj) { const h4_t lo = __builtin_convertvector(acc[ai][bj][m][0] * rs, h4_t), hi = __builtin_convertvector(acc[ai][bj][m][1] * rs, h4_t);
                    const u32x2 wl = __builtin_bit_cast(u32x2, lo), wh = __builtin_bit_cast(u32x2, hi);
                    *(GAS u32x4*)(sc + off + bj * 128) = (u32x4){wl.x, wl.y, wh.x, wh.y}; } }
    }
};
namespace att {
#define KSWZ(row, colB) ((row) * 256 + ((colB) ^ (((row) & 7) << 4)))
#define KRSWZ(row, colB) ((row) * 128 + ((colB) ^ ((((row) >> 1) & 7) << 4)))
constexpr float L2E = 1.4426950408889634f;
template <int DUMMY = 0>
__device__ __forceinline__ void partialSM(f32x16& p0, f32x16& p1, float& m_reg, float& mn, float& alpha, const float C, const float THRS) {
  float pmax = p0[0];
#pragma unroll
  for (int r = 1; r < 16; ++r) pmax = fmaxf(pmax, p0[r]);
#pragma unroll
  for (int r = 0; r < 16; ++r) pmax = fmaxf(pmax, p1[r]);
  { auto rr = __builtin_amdgcn_permlane32_swap(__float_as_uint(pmax), __float_as_uint(pmax), false, false);
    pmax = fmaxf(__uint_as_float(rr[0]), __uint_as_float(rr[1])); }
  if (__builtin_expect(__all(pmax - m_reg <= THRS), 1)) { mn = m_reg; alpha = 1.f; }
  else { mn = fmaxf(m_reg, pmax); alpha = __builtin_amdgcn_exp2f((m_reg - mn) * C); m_reg = mn; }
  const float mnC = -mn * C;
#pragma unroll
  for (int r = 0; r < 16; ++r) p0[r] = fmaf(p0[r], C, mnC);
#pragma unroll
  for (int r = 0; r < 16; ++r) p1[r] = fmaf(p1[r], C, mnC);
#pragma unroll
  for (int r = 0; r < 16; ++r) p0[r] = __builtin_amdgcn_exp2f(p0[r]);
}
__device__ __forceinline__ void finishSM(f32x16& p0, f32x16& p1, float alpha, float& l_reg, bf16x8& pa0, bf16x8& pa1, bf16x8& pa2, bf16x8& pa3) {
#pragma unroll
  for (int r = 0; r < 16; ++r) p1[r] = __builtin_amdgcn_exp2f(p1[r]);
  float ps = 0;
#pragma unroll
  for (int r = 0; r < 16; ++r) ps += p0[r];
#pragma unroll
  for (int r = 0; r < 16; ++r) ps += p1[r];
  { auto rr = __builtin_amdgcn_permlane32_swap(__float_as_uint(ps), __float_as_uint(ps), false, false);
    ps = __uint_as_float(rr[0]) + __uint_as_float(rr[1]); }
  l_reg = l_reg * alpha + ps;
#define PK4(P, BASE, OUT) do { unsigned a0 = cvt_pk_bf16(P[BASE + 0], P[BASE + 1]), a1 = cvt_pk_bf16(P[BASE + 2], P[BASE + 3]);   \
    unsigned b0 = cvt_pk_bf16(P[BASE + 4], P[BASE + 5]), b1 = cvt_pk_bf16(P[BASE + 6], P[BASE + 7]);                              \
    auto r0 = __builtin_amdgcn_permlane32_swap(a0, b0, false, false); auto r1 = __builtin_amdgcn_permlane32_swap(a1, b1, false, false); \
    u32x4 w = {r0[0], r1[0], r0[1], r1[1]}; OUT = __builtin_bit_cast(bf16x8, w); } while (0)
  PK4(p0, 0, pa0); PK4(p0, 8, pa1); PK4(p1, 0, pa2); PK4(p1, 8, pa3);
#undef PK4
}
constexpr int NW = 8, QBLK = 32, KVBLK = 64;
constexpr float MLA_SCALE = 0.07216878364870322f;
constexpr float MLA_THR = 8.f;
constexpr int SHM_V = KVBLK * 128 * 2, SHM_KN = KVBLK * 128 * 2, SHM_KR = KVBLK * 64 * 2;
constexpr int OFF_V = 0, OFF_KN = 2 * SHM_V, OFF_KR = OFF_KN + 2 * SHM_KN, OFF_WS = OFF_KR + 2 * SHM_KR, OFF_QR = OFF_WS + NW * 64 * 4, MLA_LDS = OFF_QR + NW * 4096;
__device__ __forceinline__ void qkt(f32x16& p0, f32x16& p1, const LAS char* Kn, const LAS char* Kr, const bf16x8* qr, const LAS char* qrp, const int* kb, const int* krb) {
  p0 = f32x16{}; p1 = f32x16{};
#pragma unroll
  for (int d0 = 0; d0 < 8; ++d0) {
    const bf16x8 b0 = *(const LAS bf16x8*)(Kn + kb[d0 & 3] + (d0 >> 2) * 128);
    const bf16x8 b1 = *(const LAS bf16x8*)(Kn + kb[d0 & 3] + (d0 >> 2) * 128 + 8192);
    p0 = __builtin_amdgcn_mfma_f32_32x32x16_bf16(b0, qr[d0], p0, 0, 0, 0);
    p1 = __builtin_amdgcn_mfma_f32_32x32x16_bf16(b1, qr[d0], p1, 0, 0, 0); }
#pragma unroll
  for (int d0 = 0; d0 < 4; ++d0) {
    const bf16x8 b0 = *(const LAS bf16x8*)(Kr + krb[d0]);
    const bf16x8 b1 = *(const LAS bf16x8*)(Kr + krb[d0] + 4096);
    const bf16x8 qf = *(const LAS bf16x8*)(qrp + d0 * 1024);
    p0 = __builtin_amdgcn_mfma_f32_32x32x16_bf16(b0, qf, p0, 0, 0, 0);
    p1 = __builtin_amdgcn_mfma_f32_32x32x16_bf16(b1, qf, p1, 0, 0, 0); }
}
__device__ __forceinline__ int v_st(int k, int c) { const int kk = (k & ~0xC) | ((k & 4) << 1) | ((k & 8) >> 1); return ((kk >> 3) * 4 + (c >> 5)) * 512 + ((kk & 7) * 32 + (c & 31)) * 2; }
__device__ __forceinline__ int v_rd_base(int lane) { return ((lane & 3) << 3) | (((lane >> 2) & 3) << 6) | (((lane >> 4) & 1) << 5) | (((lane >> 5) & 1) << 8); }
constexpr int v_rd_off(int d0, int ks, int half) { return d0 * 512 + ks * 4096 + half * 2048; }
template <int OFF> __device__ __forceinline__ s16x4 tr_read(int vb) {
  s16x4 r; asm volatile("ds_read_b64_tr_b16 %0, %1 offset:%2" : "=&v"(r) : "v"(vb), "i"(OFF) : "memory"); return r;
}
template <int D0> __device__ __forceinline__ void pv_one(f32x16& od, int vb, bf16x8 pa0, bf16x8 pa1, bf16x8 pa2, bf16x8 pa3) {
  const s16x4 l0 = tr_read<v_rd_off(D0, 0, 0)>(vb), h0 = tr_read<v_rd_off(D0, 0, 1)>(vb), l1 = tr_read<v_rd_off(D0, 1, 0)>(vb), h1 = tr_read<v_rd_off(D0, 1, 1)>(vb);
  const s16x4 l2 = tr_read<v_rd_off(D0, 2, 0)>(vb), h2 = tr_read<v_rd_off(D0, 2, 1)>(vb), l3 = tr_read<v_rd_off(D0, 3, 0)>(vb), h3 = tr_read<v_rd_off(D0, 3, 1)>(vb);
  asm volatile("s_waitcnt lgkmcnt(0)" ::: "memory"); SBAR();
#define PK(L, H) (bf16x8){L[0], L[1], L[2], L[3], H[0], H[1], H[2], H[3]}
  od = __builtin_amdgcn_mfma_f32_32x32x16_bf16(pa0, PK(l0, h0), od, 0, 0, 0);
  od = __builtin_amdgcn_mfma_f32_32x32x16_bf16(pa1, PK(l1, h1), od, 0, 0, 0);
  od = __builtin_amdgcn_mfma_f32_32x32x16_bf16(pa2, PK(l2, h2), od, 0, 0, 0);
  od = __builtin_amdgcn_mfma_f32_32x32x16_bf16(pa3, PK(l3, h3), od, 0, 0, 0);
#undef PK
}
__device__ __forceinline__ void pv_d0(f32x16* o, int vb, bf16x8 pa0, bf16x8 pa1, bf16x8 pa2, bf16x8 pa3) {
  pv_one<0>(o[0], vb, pa0, pa1, pa2, pa3); pv_one<1>(o[1], vb, pa0, pa1, pa2, pa3); pv_one<2>(o[2], vb, pa0, pa1, pa2, pa3); pv_one<3>(o[3], vb, pa0, pa1, pa2, pa3);
}
__device__ __forceinline__ void mla_unit(int b, int h, int qb, const bf16_t* __restrict__ QM, const bf16_t* __restrict__ KN, const bf16_t* __restrict__ KR, const bf16_t* __restrict__ VV, unsigned char* __restrict__ OM, LAS char* lds) {
  const int tid = threadIdx.x, wid = tid >> 6, lane = tid & 63, r32 = lane & 31, hi = lane >> 5;
  constexpr float C = MLA_SCALE * L2E, THRS = MLA_THR / MLA_SCALE;
  constexpr int NT = 33;
  LAS char* V_lds = lds + OFF_V; LAS char* Kn_lds = lds + OFF_KN; LAS char* Kr_lds = lds + OFF_KR;
  LAS float* ws = (LAS float*)(lds + OFF_WS) + wid * 64; LAS float* li_l = ws; LAS float* al_l = ws + 32;
  float m_reg = -1e30f, l_reg = 0; f32x16 o[4] = {}; bf16x8 qr[8];
  LAS char* qrp = lds + OFF_QR + wid * 4096 + lane * 16;
  const int qrow = b * SEQ + qb * 256 + wid * QBLK + r32;
  const bf16_t* Qw = QM + (size_t)qrow * 3072 + h * 192 + hi * 8;
#pragma unroll
  for (int d0 = 0; d0 < 8; ++d0) qr[d0] = *(const GAS bf16x8*)(Qw + d0 * 16);
  __syncthreads();
#pragma unroll
  for (int d0 = 0; d0 < 4; ++d0) *(LAS bf16x8*)(qrp + d0 * 1024) = *(const GAS bf16x8*)(Qw + (8 + d0) * 16);
  const int sr = tid >> 4, sc = (tid & 15) * 8, vst0 = v_st(sr, sc), vst1 = v_st(32 + sr, sc);
  const int krr = tid >> 3, krc = (tid & 7) * 8;
  const int vb0 = (int)(uintptr_t)V_lds + v_rd_base(lane);
  bf16x8 s_v0, s_v1, s_k0, s_k1, s_kr;
  const int realbase = b * SEQ - KVBLK;
  const unsigned voff = (unsigned)(sr * 2048 + sc) * 2u, kroff = (unsigned)(krr * 64 + krc) * 2u;
  int kb[4], krb[4];
#pragma unroll
  for (int bq = 0; bq < 4; ++bq) { kb[bq] = KSWZ(r32, bq * 32 + hi * 16); krb[bq] = KRSWZ(r32, bq * 32 + hi * 16); }
#define TROW(t) ((t) == 0 ? MREAL : realbase + (t) * KVBLK)
#define SLOAD(t) do { const int k0_ = TROW(t); const size_t ro_ = ((size_t)k0_ * 2048 + h * 128) * 2; \
    const GAS char* vb_ = (const GAS char*)VV + ro_; const GAS char* nb_ = (const GAS char*)KN + ro_; const GAS char* rb_ = (const GAS char*)KR + (size_t)k0_ * 128; \
    s_v0 = *(const GAS bf16x8*)(vb_ + voff); s_v1 = *(const GAS bf16x8*)(vb_ + 32 * 4096 + voff); \
    s_k0 = *(const GAS bf16x8*)(nb_ + voff); s_k1 = *(const GAS bf16x8*)(nb_ + 32 * 4096 + voff); \
    s_kr = *(const GAS bf16x8*)(rb_ + kroff); } while (0)
#define SWRITE(bf) do { *(LAS bf16x8*)(V_lds + (bf) * SHM_V + vst0) = s_v0; *(LAS bf16x8*)(V_lds + (bf) * SHM_V + vst1) = s_v1; const int kc_ = sc * 2; \
    *(LAS bf16x8*)(Kn_lds + (bf) * SHM_KN + KSWZ(sr, kc_)) = s_k0; *(LAS bf16x8*)(Kn_lds + (bf) * SHM_KN + KSWZ(32 + sr, kc_)) = s_k1; \
    *(LAS bf16x8*)(Kr_lds + (bf) * SHM_KR + KRSWZ(krr, krc * 2)) = s_kr; } while (0)
#define SWAIT() asm volatile("s_waitcnt vmcnt(0)" ::: "memory")
#define RESC(a) do { if (__any((a) < 1.f)) { if (hi == 0) al_l[r32] = (a); asm volatile("s_waitcnt lgkmcnt(0)" ::: "memory"); \
    _Pragma("unroll") for (int d = 0; d < 4; ++d) _Pragma("unroll") for (int r = 0; r < 16; ++r) o[d][r] *= al_l[crow(r, hi)]; } } while (0)
  f32x16 pA0, pA1, pB0, pB1; float mnA, mnB, alA, alB; bf16x8 pa0, pa1, pa2, pa3;
  SLOAD(0); SWAIT(); SWRITE(0); __syncthreads();
  qkt(pA0, pA1, Kn_lds, Kr_lds, qr, qrp, kb, krb);
  { const float NEG = -INFINITY;
#pragma unroll
    for (int r = 8; r < 16; ++r) pA0[r] = NEG;
#pragma unroll
    for (int r = 0; r < 16; ++r) pA1[r] = NEG; }
  partialSM(pA0, pA1, m_reg, mnA, alA, C, THRS);
  SLOAD(1); SWAIT(); SWRITE(1); __syncthreads();
  for (int j = 1; j + 1 < NT; j += 2) {
    SBAR(); qkt(pB0, pB1, Kn_lds + SHM_KN, Kr_lds + SHM_KR, qr, qrp, kb, krb);
    finishSM(pA0, pA1, alA, l_reg, pa0, pa1, pa2, pa3); SBAR();
    SLOAD(j + 1); SBAR();
    pv_d0(o, vb0, pa0, pa1, pa2, pa3); partialSM(pB0, pB1, m_reg, mnB, alB, C, THRS);
    __syncthreads(); SWAIT(); SWRITE(0);
    RESC(alB); __syncthreads();
    SBAR(); qkt(pA0, pA1, Kn_lds, Kr_lds, qr, qrp, kb, krb);
    finishSM(pB0, pB1, alB, l_reg, pa0, pa1, pa2, pa3); SBAR();
    if (j + 2 < NT) SLOAD(j + 2); SBAR();
    pv_d0(o, vb0 + SHM_V, pa0, pa1, pa2, pa3); partialSM(pA0, pA1, m_reg, mnA, alA, C, THRS);
    __syncthreads(); if (j + 2 < NT) { SWAIT(); SWRITE(1); }
    RESC(alA); __syncthreads();
  }
  finishSM(pA0, pA1, alA, l_reg, pa0, pa1, pa2, pa3); SBAR();
  pv_d0(o, vb0, pa0, pa1, pa2, pa3);
  if (hi == 0) li_l[r32] = l_reg; asm volatile("s_waitcnt lgkmcnt(0)" ::: "memory");
  float rli[16];
#pragma unroll
  for (int r = 0; r < 16; ++r) rli[r] = __builtin_amdgcn_rcpf(li_l[crow(r, hi)]);
  unsigned char* Ow = OM + (size_t)(b * SEQ + qb * 256 + wid * QBLK) * 2048 + h * 128;
#pragma unroll
  for (int r = 0; r < 16; ++r) { const int orow = crow(r, hi);
#pragma unroll
    for (int d0 = 0; d0 < 4; ++d0) Ow[(size_t)orow * 2048 + d0 * 32 + r32] = f32_to_fp8(o[d0][r] * rli[r] * 32.f); }
#undef TROW
#undef SLOAD
#undef SWRITE
#undef SWAIT
#undef RESC
}
constexpr int K8S = 208, V8S = 80, SHM8_K = 64 * K8S, SHM8_V = 128 * V8S;
constexpr int OFF8_K = 0, OFF8_V = 2 * SHM8_K, OFF8_WS = OFF8_V + 2 * SHM8_V, MLA8_LDS = OFF8_WS + NW * 64 * 4;
constexpr float MLA8_THR = 1.9f;
typedef int a8_t __attribute__((ext_vector_type(8)));
#define MFMA8(acc_, a_, b_, sa_, sb_) asm volatile("s_nop 1\n\tv_mfma_scale_f32_32x32x64_f8f6f4 %0, %1, %2, %0, %3, %4 op_sel_hi:[0,0,0]" : "+v"(acc_) : "v"(a_), "v"(b_), "v"(sa_), "v"(sb_))
__device__ __forceinline__ a8_t ld_frag8(const LAS char* p) { const u32x4 lo = *(const LAS u32x4*)p, hi = *(const LAS u32x4*)(p + 16); return (a8_t){(int)lo.x, (int)lo.y, (int)lo.z, (int)lo.w, (int)hi.x, (int)hi.y, (int)hi.z, (int)hi.w}; }
__device__ __forceinline__ void qkt8(f32x16& p0, f32x16& p1, const LAS char* Kb, const a8_t& q0, const a8_t& q1, const a8_t& q2, int s1) {
  p0 = f32x16{}; p1 = f32x16{};
  { const a8_t a0 = ld_frag8(Kb), a1 = ld_frag8(Kb + 32 * K8S); MFMA8(p0, a0, q0, s1, s1); MFMA8(p1, a1, q0, s1, s1); }
  { const a8_t a0 = ld_frag8(Kb + 64), a1 = ld_frag8(Kb + 32 * K8S + 64); MFMA8(p0, a0, q1, s1, s1); MFMA8(p1, a1, q1, s1, s1); }
  { const a8_t a0 = ld_frag8(Kb + 128), a1 = ld_frag8(Kb + 32 * K8S + 128); MFMA8(p0, a0, q2, s1, s1); MFMA8(p1, a1, q2, s1, s1); }
  asm volatile("s_nop 15\n\ts_nop 15" : "+v"(p0), "+v"(p1));
}
__device__ __forceinline__ void partialSM8(f32x16& p0, f32x16& p1, float& m_reg, float& mn, float& alpha, const float C, const float THRS) {
  float pmax = p0[0];
#pragma unroll
  for (int r = 1; r < 16; ++r) pmax = fmaxf(pmax, p0[r]);
#pragma unroll
  for (int r = 0; r < 16; ++r) pmax = fmaxf(pmax, p1[r]);
  { auto rr = __builtin_amdgcn_permlane32_swap(__float_as_uint(pmax), __float_as_uint(pmax), false, false);
    pmax = fmaxf(__uint_as_float(rr[0]), __uint_as_float(rr[1])); }
  if (__builtin_expect(__all(pmax - m_reg <= THRS), 1)) { mn = m_reg; alpha = 1.f; }
  else { mn = fmaxf(m_reg, pmax); alpha = __builtin_amdgcn_exp2f((m_reg - mn) * C); m_reg = mn; }
  const float mnC = 6.f - mn * C;
#pragma unroll
  for (int r = 0; r < 16; ++r) p0[r] = fmaf(p0[r], C, mnC);
#pragma unroll
  for (int r = 0; r < 16; ++r) p1[r] = fmaf(p1[r], C, mnC);
#pragma unroll
  for (int r = 0; r < 16; ++r) p0[r] = __builtin_amdgcn_exp2f(p0[r]);
}
__device__ __forceinline__ void finishSM8(f32x16& p0, f32x16& p1, float alpha, float& l_reg, a8_t& pf) {
#pragma unroll
  for (int r = 0; r < 16; ++r) p1[r] = __builtin_amdgcn_exp2f(p1[r]);
  float ps = 0;
#pragma unroll
  for (int r = 0; r < 16; ++r) ps += p0[r];
#pragma unroll
  for (int r = 0; r < 16; ++r) ps += p1[r];
  { auto rr = __builtin_amdgcn_permlane32_swap(__float_as_uint(ps), __float_as_uint(ps), false, false);
    ps = __uint_as_float(rr[0]) + __uint_as_float(rr[1]); }
  l_reg = l_reg * alpha + ps;
#pragma unroll
  for (int w = 0; w < 4; ++w) { int x = 0, y = 0;
    x = __builtin_amdgcn_cvt_pk_fp8_f32(p0[4 * w], p0[4 * w + 1], x, false); x = __builtin_amdgcn_cvt_pk_fp8_f32(p0[4 * w + 2], p0[4 * w + 3], x, true);
    y = __builtin_amdgcn_cvt_pk_fp8_f32(p1[4 * w], p1[4 * w + 1], y, false); y = __builtin_amdgcn_cvt_pk_fp8_f32(p1[4 * w + 2], p1[4 * w + 3], y, true);
    pf[w] = x; pf[4 + w] = y; }
}
__device__ __forceinline__ void pv8(f32x16* o, const LAS char* Vb, const a8_t& pf, int sP, int s1) {
  const a8_t b0 = ld_frag8(Vb), b1 = ld_frag8(Vb + 32 * V8S), b2 = ld_frag8(Vb + 64 * V8S), b3 = ld_frag8(Vb + 96 * V8S);
  MFMA8(o[0], pf, b0, sP, s1); MFMA8(o[1], pf, b1, sP, s1); MFMA8(o[2], pf, b2, sP, s1); MFMA8(o[3], pf, b3, sP, s1);
  asm volatile("s_nop 15\n\ts_nop 15" : "+v"(o[0]), "+v"(o[1]), "+v"(o[2]), "+v"(o[3]));
}
__device__ __forceinline__ void mla_unit8(int b, int h, int qb, const unsigned char* __restrict__ QM8, const unsigned char* __restrict__ KN8, const unsigned char* __restrict__ KR8, const unsigned char* __restrict__ VT8,
                                          unsigned char* __restrict__ OM, LAS char* lds, Conv& cv) {
  const int tid = threadIdx.x, wid = tid >> 6, lane = tid & 63, r32 = lane & 31, hi = lane >> 5;
  constexpr float C = MLA_SCALE * L2E, THRS = MLA8_THR / MLA_SCALE;
  constexpr int NT = 33;
  LAS char* K_lds = lds + OFF8_K; LAS char* V_lds = lds + OFF8_V;
  LAS float* ws = (LAS float*)(lds + OFF8_WS) + wid * 64; LAS float* li_l = ws; LAS float* al_l = ws + 32;
  int s1 = 0x7f7f7f7f, sP = 0x79797979; asm volatile("" : "+v"(s1), "+v"(sP));
  float m_reg = -1e30f, l_reg = 0; f32x16 o[4] = {};
  const int qrow = b * SEQ + qb * 256 + wid * QBLK + r32;
  a8_t q0, q1, q2;
  { const unsigned char* Qw = QM8 + (size_t)qrow * 3072 + h * 192 + hi * 32;
    const u32x4 a = *(const GAS u32x4*)Qw, bq = *(const GAS u32x4*)(Qw + 16), c = *(const GAS u32x4*)(Qw + 64), d = *(const GAS u32x4*)(Qw + 80), e = *(const GAS u32x4*)(Qw + 128), f = *(const GAS u32x4*)(Qw + 144);
    q0 = (a8_t){(int)a.x, (int)a.y, (int)a.z, (int)a.w, (int)bq.x, (int)bq.y, (int)bq.z, (int)bq.w};
    q1 = (a8_t){(int)c.x, (int)c.y, (int)c.z, (int)c.w, (int)d.x, (int)d.y, (int)d.z, (int)d.w};
    q2 = (a8_t){(int)e.x, (int)e.y, (int)e.z, (int)e.w, (int)f.x, (int)f.y, (int)f.z, (int)f.w}; }
  __syncthreads();
  const int kkey = tid >> 3, kch = tid & 7, rkey = (tid >> 2) & 63, rch = tid & 3, vdim = tid >> 2, vch = tid & 3;
  const LAS char* Kf = K_lds + r32 * K8S + 32 * hi; const LAS char* Vf = V_lds + r32 * V8S + 32 * hi;
  const unsigned offk = (unsigned)(kkey * 2048 + kch * 16), offr = (unsigned)(rkey * 64 + rch * 16), offv = (unsigned)(vdim * MPAD + vch * 16);
  u32x4 kA, rA, vA, kB, rB, vB;
  const int realbase = b * SEQ - KVBLK;
#define TROW(t) ((t) == 0 ? MREAL : realbase + (t) * KVBLK)
#define SLOADX(t, K_, R_, V_) do { const int k0_ = TROW(t); \
    K_ = *(const GAS u32x4*)(KN8 + ((size_t)k0_ * 2048 + h * 128) + offk); \
    R_ = *(const GAS u32x4*)(KR8 + (size_t)k0_ * 64 + offr); \
    V_ = *(const GAS u32x4*)(VT8 + ((size_t)h * 128 * MPAD + k0_) + offv); } while (0)
#define SWRITEX(bf, K_, R_, V_) do { *(LAS u32x4*)(K_lds + (bf) * SHM8_K + kkey * K8S + kch * 16) = K_; if (tid < 256) *(LAS u32x4*)(K_lds + (bf) * SHM8_K + rkey * K8S + 128 + rch * 16) = R_; \
    *(LAS u32x4*)(V_lds + (bf) * SHM8_V + vdim * V8S + vch * 16) = V_; } while (0)
#define CONV_HOOK() do { cvi = false; if ((cv.tick++ & 3) == 0) { int lane_ = lane; asm volatile("" : "+v"(lane_));     \
      if (cv.pend >= 0) { asm volatile("s_waitcnt vmcnt(6)" ::: "memory"); conv_finish(cv, cv.pend, lane_); cv.pend = -1; asm volatile("s_waitcnt lgkmcnt(0)" ::: "memory"); } \
      if (cv.next < cv.end) { conv_issue(cv, cv.next, lane_); cv.pend = cv.next; cv.next += cv.stride; cvi = true; } } } while (0)
#define WAITX(nl) do { const int n_ = (nl) + ((cvi || cvp) ? 8 : 0); \
    if (n_ == 11) asm volatile("s_waitcnt vmcnt(11)" ::: "memory"); else if (n_ == 8) asm volatile("s_waitcnt vmcnt(8)" ::: "memory"); \
    else if (n_ == 3) asm volatile("s_waitcnt vmcnt(3)" ::: "memory"); else asm volatile("s_waitcnt vmcnt(0)" ::: "memory"); } while (0)
#define SWAIT0() asm volatile("s_waitcnt vmcnt(0)" ::: "memory")
#define RESC(a) do { if (__any((a) < 1.f)) { if (hi == 0) al_l[r32] = (a); asm volatile("s_waitcnt lgkmcnt(0)" ::: "memory"); \
    _Pragma("unroll") for (int d = 0; d < 4; ++d) _Pragma("unroll") for (int r = 0; r < 16; ++r) o[d][r] *= al_l[crow(r, hi)]; } } while (0)
  f32x16 pA0, pA1, pB0, pB1; float mnA, mnB, alA, alB; a8_t pf; bool cvi = false, cvp = false;
#define QK_FIN(N0, N1, KB, O0, O1, AL) do { N0 = f32x16{}; N1 = f32x16{}; float ps_ = 0.f; \
    a8_t fa_ = ld_frag8(KB), fb_ = ld_frag8((KB) + 32 * K8S);        \
    MFMA8(N0, fa_, q0, s1, s1); _Pragma("unroll") for (int r = 0; r < 8; ++r) O1[r] = __builtin_amdgcn_exp2f(O1[r]); SBAR(); \
    MFMA8(N1, fb_, q0, s1, s1); fa_ = ld_frag8((KB) + 64); _Pragma("unroll") for (int r = 8; r < 16; ++r) O1[r] = __builtin_amdgcn_exp2f(O1[r]); SBAR(); \
    MFMA8(N0, fa_, q1, s1, s1); fb_ = ld_frag8((KB) + 32 * K8S + 64); _Pragma("unroll") for (int r = 0; r < 16; ++r) ps_ += O0[r]; SBAR(); \
    MFMA8(N1, fb_, q1, s1, s1); fa_ = ld_frag8((KB) + 128); _Pragma("unroll") for (int r = 0; r < 16; ++r) ps_ += O1[r]; \
      { auto rr = __builtin_amdgcn_permlane32_swap(__float_as_uint(ps_), __float_as_uint(ps_), false, false); ps_ = __uint_as_float(rr[0]) + __uint_as_float(rr[1]); } l_reg = l_reg * (AL) + ps_; SBAR(); \
    MFMA8(N0, fa_, q2, s1, s1); fb_ = ld_frag8((KB) + 32 * K8S + 128); _Pragma("unroll") for (int w = 0; w < 4; ++w) { int x = 0; x = __builtin_amdgcn_cvt_pk_fp8_f32(O0[4 * w], O0[4 * w + 1], x, false); x = __builtin_amdgcn_cvt_pk_fp8_f32(O0[4 * w + 2], O0[4 * w + 3], x, true); pf[w] = x; } SBAR(); \
    MFMA8(N1, fb_, q2, s1, s1); _Pragma("unroll") for (int w = 0; w < 4; ++w) { int y = 0; y = __builtin_amdgcn_cvt_pk_fp8_f32(O1[4 * w], O1[4 * w + 1], y, false); y = __builtin_amdgcn_cvt_pk_fp8_f32(O1[4 * w + 2], O1[4 * w + 3], y, true); pf[4 + w] = y; } SBAR(); \
  } while (0)
#define PV_PART(VB, N0, N1, MN, AL) do { \
    a8_t va_ = ld_frag8(VB), vb_ = ld_frag8((VB) + 32 * V8S); \
    MFMA8(o[0], pf, va_, sP, s1); asm volatile("s_nop 15\n\ts_nop 15" : "+v"(N0), "+v"(N1));      \
      float pmax_ = N0[0]; _Pragma("unroll") for (int r = 1; r < 16; ++r) pmax_ = fmaxf(pmax_, N0[r]); SBAR(); \
    MFMA8(o[1], pf, vb_, sP, s1); va_ = ld_frag8((VB) + 64 * V8S); _Pragma("unroll") for (int r = 0; r < 16; ++r) pmax_ = fmaxf(pmax_, N1[r]); \
      { auto rr = __builtin_amdgcn_permlane32_swap(__float_as_uint(pmax_), __float_as_uint(pmax_), false, false); pmax_ = fmaxf(__uint_as_float(rr[0]), __uint_as_float(rr[1])); } \
      if (__builtin_expect(__all(pmax_ - m_reg <= THRS), 1)) { MN = m_reg; AL = 1.f; } else { MN = fmaxf(m_reg, pmax_); AL = __builtin_amdgcn_exp2f((m_reg - MN) * C); m_reg = MN; } SBAR(); \
    MFMA8(o[2], pf, va_, sP, s1); vb_ = ld_frag8((VB) + 96 * V8S); { const float mnC_ = 6.f - MN * C; _Pragma("unroll") for (int r = 0; r < 16; ++r) { N0[r] = fmaf(N0[r], C, mnC_); N1[r] = fmaf(N1[r], C, mnC_); } } SBAR(); \
    MFMA8(o[3], pf, vb_, sP, s1); _Pragma("unroll") for (int r = 0; r < 16; ++r) N0[r] = __builtin_amdgcn_exp2f(N0[r]); SBAR(); \
    asm volatile("s_nop 15\n\ts_nop 15" : "+v"(o[0]), "+v"(o[1]), "+v"(o[2]), "+v"(o[3])); } while (0)
  SLOADX(0, kA, rA, vA); SWAIT0(); SWRITEX(0, kA, rA, vA); __syncthreads();
  qkt8(pA0, pA1, Kf, q0, q1, q2, s1);
  { const float NEG = -INFINITY;
#pragma unroll
    for (int r = 8; r < 16; ++r) pA0[r] = NEG;
#pragma unroll
    for (int r = 0; r < 16; ++r) pA1[r] = NEG; }
  partialSM8(pA0, pA1, m_reg, mnA, alA, C, THRS);
  SLOADX(1, kA, rA, vA); SWAIT0(); SWRITEX(1, kA, rA, vA);
  SLOADX(2, kA, rA, vA);
  __syncthreads();
  for (int j = 1; j + 1 < NT; j += 2) {
    SBAR(); QK_FIN(pB0, pB1, Kf + SHM8_K, pA0, pA1, alA);
    const bool l1 = j + 2 < NT; if (l1) SLOADX(j + 2, kB, rB, vB); CONV_HOOK(); SBAR();
    PV_PART(Vf, pB0, pB1, mnB, alB);
    __syncthreads(); WAITX(l1 ? 3 : 0); SWRITEX(0, kA, rA, vA); cvp = cvi;
    RESC(alB); __syncthreads();
    SBAR(); QK_FIN(pA0, pA1, Kf, pB0, pB1, alB);
    const bool l2 = j + 3 < NT; if (l2) SLOADX(j + 3, kA, rA, vA); CONV_HOOK(); SBAR();
    PV_PART(Vf + SHM8_V, pA0, pA1, mnA, alA);
    __syncthreads(); if (l1) { WAITX(l2 ? 3 : 0); SWRITEX(1, kB, rB, vB); } cvp = cvi;
    RESC(alA); __syncthreads();
  }
  finishSM8(pA0, pA1, alA, l_reg, pf); SBAR();
  pv8(o, Vf, pf, sP, s1);
  if (hi == 0) li_l[r32] = l_reg; asm volatile("s_waitcnt lgkmcnt(0)" ::: "memory");
  float rli[16];
#pragma unroll
  for (int r = 0; r < 16; ++r) rli[r] = __builtin_amdgcn_rcpf(li_l[crow(r, hi)]) * (64.f * 32.f);
  unsigned char* Ow = OM + (size_t)(b * SEQ + qb * 256 + wid * QBLK) * 2048 + h * 128;
#pragma unroll
  for (int r = 0; r < 16; ++r) { const int orow = crow(r, hi);
#pragma unroll
    for (int d0 = 0; d0 < 4; ++d0) Ow[(size_t)orow * 2048 + d0 * 32 + r32] = f32_to_fp8(o[d0][r] * rli[r]); }
#undef TROW
#undef SLOADX
#undef SWRITEX
#undef WAITX
#undef SWAIT0
#undef QK_FIN
#undef PV_PART
#undef RESC
#undef CONV_HOOK
}
__device__ __forceinline__ void na_task(int task, const unsigned char* __restrict__ NAQ, const unsigned char* __restrict__ NAK, const unsigned char* __restrict__ VT, unsigned char* __restrict__ ONA,
                                        const LAS float* relb, const LAS float* metab, LAS float* wsf, int lane) {
  const int r32 = lane & 31, hi = lane >> 5;
  const int half = task & 1, r = (task >> 1) & 31, h = (task >> 6) & 15, b = task >> 10;
  const int qc = half * 32 + r32;
  const int cs = min(max(qc - 8, 0), 48), rs = min(max(r - 4, 0), 24);
  const int qtok = b * SEQ + r * 64 + qc;
  constexpr float C = L2E, THRS = 1.9f, SCALE = 0.125f;
  int s1 = 0x7f7f7f7f, sP = 0x79797979; asm volatile("" : "+v"(s1), "+v"(sP));
  a8_t qf; { const unsigned char* qp = NAQ + (size_t)qtok * 1024 + h * 64 + hi * 32; const u32x4 a = *(const GAS u32x4*)qp, c = *(const GAS u32x4*)(qp + 16);
    qf = (a8_t){(int)a.x, (int)a.y, (int)a.z, (int)a.w, (int)c.x, (int)c.y, (int)c.z, (int)c.w}; }
  float m_reg = -1e30f, l_reg = 0.f; f32x16 o[2] = {};
  LAS float* al_l = wsf; LAS float* li_l = wsf + 32;
  const float NEG = -INFINITY;
  const int kb0 = half * 16;
  const unsigned long long wm = 0xFFFFull << (cs - kb0);
  const unsigned mh0 = (unsigned)wm >> (4 * hi), mh1 = (unsigned)(wm >> 32) >> (4 * hi);
  const unsigned char* kq = NAK + (size_t)r32 * 1024 + h * 64 + hi * 32;
  const unsigned char* kq2 = NAK + (size_t)(32 + (r32 & 15)) * 1024 + h * 64 + hi * 32;
  const unsigned char* vq = VT + (size_t)(h * 64 + r32) * VT_PITCH + 32 * hi;
#define NA_KTOK(w) ((w) == 8 ? MREAL : b * SEQ + (rs + (w)) * 64 + kb0)
#define NA_VOFF(w) ((w) == 8 ? MREAL : b * SEQ + (rs + (w)) * 64 + (kb0 >> 1))
#define NA_LOADK(KF, w) do { const size_t ko_ = (size_t)NA_KTOK(w) * 1024; KF[0] = *(const GAS u32x4*)(kq + ko_); KF[1] = *(const GAS u32x4*)(kq + ko_ + 16); KF[2] = *(const GAS u32x4*)(kq2 + ko_); KF[3] = *(const GAS u32x4*)(kq2 + ko_ + 16); } while (0)
#define NA_A8(x_, y_) (a8_t){(int)x_.x, (int)x_.y, (int)x_.z, (int)x_.w, (int)y_.x, (int)y_.y, (int)y_.z, (int)y_.w}
#define NA_TILE(KF, wt, YN) do { \
    u32x4 va0, va1; u32x2 vb0_, vb1_; { const unsigned char* vp_ = vq + NA_VOFF(wt); va0 = *(const GAS u32x4*)vp_; vb0_ = *(const GAS u32x2*)(vp_ + 16); va1 = *(const GAS u32x4*)(vp_ + (size_t)32 * VT_PITCH); vb1_ = *(const GAS u32x2*)(vp_ + (size_t)32 * VT_PITCH + 16); } \
    f32x16 p0 = {}, p1 = {}; \
    { const a8_t k0_ = NA_A8(KF[0], KF[1]), k1_ = NA_A8(KF[2], KF[3]); MFMA8(p0, k0_, qf, s1, s1); MFMA8(p1, k1_, qf, s1, s1); asm volatile("s_nop 15\n\ts_nop 15" : "+v"(p0), "+v"(p1)); } \
    if ((wt) + 1 < 9) NA_LOADK(KF, (wt) + 1);            \
      \
    if ((wt) < 8) { const LAS float* bp_ = relb + ((h * 15 + (rs + (wt) - r + 7)) * 31 + 15 - qc + 4 * hi + kb0);     \
      float bv0[16], bv1[8];        \
      _Pragma("unroll") for (int rg = 0; rg < 16; ++rg) { const int c_ = (rg & 3) + 8 * (rg >> 2); bv0[rg] = bp_[c_]; if (rg < 8) bv1[rg] = bp_[c_ + 32]; } \
      _Pragma("unroll") for (int rg = 0; rg < 16; ++rg) { asm volatile("" : "+v"(bv0[rg])); if (rg < 8) asm volatile("" : "+v"(bv1[rg])); } \
      _Pragma("unroll") for (int rg = 0; rg < 16; ++rg) { const int c_ = (rg & 3) + 8 * (rg >> 2); \
        { const bool ok = (mh0 >> c_) & 1u; p0[rg] = ok ? fmaf(p0[rg], SCALE, bv0[rg]) : NEG; } \
        if (rg < 8) { const bool ok = (mh1 >> c_) & 1u; p1[rg] = ok ? fmaf(p1[rg], SCALE, bv1[rg]) : NEG; } } \
    } else { const LAS float* bp = metab + h * 16; \
      _Pragma("unroll") for (int rg = 0; rg < 16; ++rg) { const int kc = crow(rg, hi); p0[rg] = (rg < 8) ? fmaf(p0[rg], SCALE, bp[kc & 15]) : NEG; if (rg < 8) p1[rg] = NEG; } } \
      \
    float pmax = p0[0]; \
    _Pragma("unroll") for (int rg = 1; rg < 16; ++rg) pmax = fmaxf(pmax, p0[rg]); \
    _Pragma("unroll") for (int rg = 0; rg < 8; ++rg) pmax = fmaxf(pmax, p1[rg]); \
    { auto rr = __builtin_amdgcn_permlane32_swap(__float_as_uint(pmax), __float_as_uint(pmax), false, false); pmax = fmaxf(__uint_as_float(rr[0]), __uint_as_float(rr[1])); } \
    float mn, alpha; \
    if (__builtin_expect(__all(pmax - m_reg <= THRS), 1)) { mn = m_reg; alpha = 1.f; } \
    else { mn = fmaxf(m_reg, pmax); alpha = __builtin_amdgcn_exp2f((m_reg - mn) * C); m_reg = mn; } \
    const float mnC = 6.f - mn * C; float ps = 0.f;        \
    _Pragma("unroll") for (int rg = 0; rg < 16; ++rg) { p0[rg] = __builtin_amdgcn_exp2f(fmaf(p0[rg], C, mnC)); ps += p0[rg]; } \
    _Pragma("unroll") for (int rg = 0; rg < 8; ++rg) { p1[rg] = __builtin_amdgcn_exp2f(fmaf(p1[rg], C, mnC)); ps += p1[rg]; } \
    { auto rr = __builtin_amdgcn_permlane32_swap(__float_as_uint(ps), __float_as_uint(ps), false, false); ps = __uint_as_float(rr[0]) + __uint_as_float(rr[1]); } \
    l_reg = l_reg * alpha + ps; \
    a8_t pf;   \
    _Pragma("unroll") for (int w_ = 0; w_ < 4; ++w_) { int x = 0; x = __builtin_amdgcn_cvt_pk_fp8_f32(p0[4 * w_], p0[4 * w_ + 1], x, false); x = __builtin_amdgcn_cvt_pk_fp8_f32(p0[4 * w_ + 2], p0[4 * w_ + 3], x, true); pf[w_] = x; } \
    _Pragma("unroll") for (int w_ = 0; w_ < 2; ++w_) { int x = 0; x = __builtin_amdgcn_cvt_pk_fp8_f32(p1[4 * w_], p1[4 * w_ + 1], x, false); x = __builtin_amdgcn_cvt_pk_fp8_f32(p1[4 * w_ + 2], p1[4 * w_ + 3], x, true); pf[4 + w_] = x; } \
    pf[6] = 0; pf[7] = 0; \
    if (__any(alpha < 1.f)) { if (hi == 0) al_l[r32] = alpha; asm volatile("s_waitcnt lgkmcnt(0)" ::: "memory"); \
      _Pragma("unroll") for (int d = 0; d < 2; ++d) _Pragma("unroll") for (int rg = 0; rg < 16; ++rg) o[d][rg] *= al_l[crow(rg, hi)]; } \
    { const a8_t v0_ = (a8_t){(int)va0.x, (int)va0.y, (int)va0.z, (int)va0.w, (int)vb0_.x, (int)vb0_.y, 0, 0}, v1_ = (a8_t){(int)va1.x, (int)va1.y, (int)va1.z, (int)va1.w, (int)vb1_.x, (int)vb1_.y, 0, 0}; \
      MFMA8(o[0], pf, v0_, sP, s1); MFMA8(o[1], pf, v1_, sP, s1); asm volatile("s_nop 15\n\ts_nop 15" : "+v"(o[0]), "+v"(o[1])); } } while (0)
  { u32x4 kA[4];
    NA_LOADK(kA, 0);
#pragma unroll 1
    for (int w = 0; w < 8; ++w) { NA_TILE(kA, w, 12); }
    NA_TILE(kA, 8, 12); }
#undef NA_KTOK
#undef NA_VOFF
#undef NA_LOADK
#undef NA_A8
#undef NA_TILE
  if (hi == 0) li_l[r32] = l_reg; asm volatile("s_waitcnt lgkmcnt(0)" ::: "memory");
  unsigned char* Ow = ONA + (size_t)(b * SEQ + r * 64 + half * 32) * 1024 + h * 64;
#pragma unroll
  for (int rg = 0; rg < 16; ++rg) { const int orow = crow(rg, hi); const float rl = __builtin_amdgcn_rcpf(li_l[orow]) * (64.f * 16.f);
#pragma unroll
    for (int d0 = 0; d0 < 2; ++d0) Ow[(size_t)orow * 1024 + d0 * 32 + r32] = f32_to_fp8(o[d0][rg] * rl); }
  asm volatile("s_waitcnt lgkmcnt(0)" ::: "memory");
}
}
namespace peer {
constexpr int CH = 32;
constexpr int OFF_TV = 0, OFF_TI = OFF_TV + CH * 16 * 16 * 4, OFF_SE = OFF_TI + CH * 16 * 16 * 4, OFF_SG = OFF_SE + CH * 128 * 4, OFF_SE2 = OFF_SG + CH * 128 * 4, OFF_SG2 = OFF_SE2 + CH * 128 * 4, PEER_LDS = OFF_SG2 + CH * 128 * 4;
static_assert(PEER_LDS <= RING_BYTES, "PEER LDS");
__device__ __forceinline__ float gelu_tanh(float x) {
    const float u = 0.7978845608028654f * (x + 0.044715f * x * x * x);
    const float e = __builtin_amdgcn_exp2f(-2.f * 1.4426950408889634f * fabsf(u));
    const float t = (1.f - e) * __builtin_amdgcn_rcpf(1.f + e);
    return 0.5f * x * (1.f + (u < 0.f ? -t : t));
}
__device__ __forceinline__ void fmac1(float& acc, float a, float b) { asm("v_fmac_f32_e32 %0, %1, %2" : "+v"(acc) : "v"(a), "v"(b)); }
#define PEER_INSERT(x_, xi_) do { float x__ = (x_); int xi__ = (xi_); \
    _Pragma("unroll") for (int j_ = 0; j_ < 16; ++j_) { const bool gt_ = x__ > tv[j_]; const float tvo_ = tv[j_]; const int tio_ = ti[j_]; \
        tv[j_] = gt_ ? x__ : tvo_; ti[j_] = gt_ ? xi__ : tio_; x__ = gt_ ? tvo_ : x__; xi__ = gt_ ? tio_ : xi__; } } while (0)

#define PEER_AUX 0
typedef __amdgpu_buffer_rsrc_t rsrc_t;
__device__ __forceinline__ rsrc_t mk_rsrc(const void* p, unsigned bytes) { return __builtin_amdgcn_make_buffer_rsrc((void*)p, 0, bytes, 0x00020000); }
__device__ __forceinline__ u32x4 ldb128(rsrc_t r, unsigned off) { return __builtin_amdgcn_raw_buffer_load_b128(r, off, 0, PEER_AUX); }
typedef unsigned v6u_t __attribute__((ext_vector_type(6)));
typedef float v32f_t __attribute__((ext_vector_type(32)));
typedef float v16f_t __attribute__((ext_vector_type(16)));
__device__ __forceinline__ u32x2 ldb64(rsrc_t r, unsigned off) { return __builtin_amdgcn_raw_buffer_load_b64(r, off, 0, PEER_AUX); }
__device__ __forceinline__ f32x4 ldf128(rsrc_t r, unsigned off) { return __builtin_bit_cast(f32x4, __builtin_amdgcn_raw_buffer_load_b128(r, off, 0, PEER_AUX)); }
__device__ __forceinline__ f32x4 ldf128_nt(rsrc_t r, unsigned off) { return __builtin_bit_cast(f32x4, __builtin_amdgcn_raw_buffer_load_b128(r, off, 0, 2)); }
__device__ __forceinline__ void peer_select(int chunk, const _Float16* __restrict__ SC, LAS char* lds, int tid, LAS int* SE, LAS float* SG) {
    LAS float* TV = (LAS float*)(lds + OFF_TV); LAS int* TI = (LAS int*)(lds + OFF_TI);
    asm volatile("" : "+v"(tid));
    const int tok0 = chunk * CH;
    const rsrc_t rSC = mk_rsrc(SC, 0x4000000u);
    __syncthreads();
    { const int tl = tid >> 4, g = tid & 15; const unsigned spo = ((unsigned)(tok0 + tl) * 2048u + (unsigned)g * 128u) * 2u;
      int tk[16];
#pragma unroll
      for (int j = 0; j < 16; ++j) tk[j] = (int)0x80000000;
#define PEER_KEY(x_, lowbits_, mask_) ({ const int f_ = __float_as_int(x_); ((f_ ^ ((f_ >> 31) & 0x7fffffff)) & ~(mask_)) | (lowbits_); })
#define PEER_INS(key_) do { int x__ = (key_); _Pragma("unroll") for (int j_ = 0; j_ < 16; ++j_) { const int hi_ = max(x__, tk[j_]); x__ = min(x__, tk[j_]); tk[j_] = hi_; } } while (0)
      typedef _Float16 h8_t __attribute__((ext_vector_type(8)));
#define PEER_CX(a_, b_) do { const int hi_ = max(a_, b_), lo_ = min(a_, b_); a_ = hi_; b_ = lo_; } while (0)
      u32x4 na = __builtin_amdgcn_raw_buffer_load_b128(rSC, spo, 0, 2), nb = __builtin_amdgcn_raw_buffer_load_b128(rSC, spo + 16, 0, 2);
#pragma unroll 1
      for (int i = 0; i < 16; i += 2) { const h8_t a = __builtin_bit_cast(h8_t, na), b = __builtin_bit_cast(h8_t, nb);
          { const unsigned on = spo + (unsigned)min(i + 2, 14) * 16u; na = __builtin_amdgcn_raw_buffer_load_b128(rSC, on, 0, 2); nb = __builtin_amdgcn_raw_buffer_load_b128(rSC, on + 16, 0, 2); }
          int kk[16];
#pragma unroll
          for (int e = 0; e < 8; ++e) { kk[e] = PEER_KEY((float)a[e], 127 - (8 * i + e), 127); kk[8 + e] = PEER_KEY((float)b[e], 127 - (8 * i + 8 + e), 127); }
          PEER_CX(kk[0], kk[13]); PEER_CX(kk[1], kk[12]); PEER_CX(kk[2], kk[15]); PEER_CX(kk[3], kk[14]); PEER_CX(kk[4], kk[8]); PEER_CX(kk[5], kk[6]); PEER_CX(kk[7], kk[11]); PEER_CX(kk[9], kk[10]); PEER_CX(kk[0], kk[5]); PEER_CX(kk[1], kk[7]); PEER_CX(kk[2], kk[9]); PEER_CX(kk[3], kk[4]); PEER_CX(kk[6], kk[13]); PEER_CX(kk[8], kk[14]); PEER_CX(kk[10], kk[15]); PEER_CX(kk[11], kk[12]); PEER_CX(kk[0], kk[1]); PEER_CX(kk[2], kk[3]); PEER_CX(kk[4], kk[5]); PEER_CX(kk[6], kk[8]); PEER_CX(kk[7], kk[9]); PEER_CX(kk[10], kk[11]); PEER_CX(kk[12], kk[13]); PEER_CX(kk[14], kk[15]); PEER_CX(kk[0], kk[2]); PEER_CX(kk[1], kk[3]); PEER_CX(kk[4], kk[10]); PEER_CX(kk[5], kk[11]); PEER_CX(kk[6], kk[7]); PEER_CX(kk[8], kk[9]); PEER_CX(kk[12], kk[14]); PEER_CX(kk[13], kk[15]); PEER_CX(kk[1], kk[2]); PEER_CX(kk[3], kk[12]); PEER_CX(kk[4], kk[6]); PEER_CX(kk[5], kk[7]); PEER_CX(kk[8], kk[10]); PEER_CX(kk[9], kk[11]); PEER_CX(kk[13], kk[14]); PEER_CX(kk[1], kk[4]); PEER_CX(kk[2], kk[6]); PEER_CX(kk[5], kk[8]); PEER_CX(kk[7], kk[10]); PEER_CX(kk[9], kk[13]); PEER_CX(kk[11], kk[14]); PEER_CX(kk[2], kk[4]); PEER_CX(kk[3], kk[6]); PEER_CX(kk[9], kk[12]); PEER_CX(kk[11], kk[13]); PEER_CX(kk[3], kk[5]); PEER_CX(kk[6], kk[8]); PEER_CX(kk[7], kk[9]); PEER_CX(kk[10], kk[12]); PEER_CX(kk[3], kk[4]); PEER_CX(kk[5], kk[6]); PEER_CX(kk[7], kk[8]); PEER_CX(kk[9], kk[10]); PEER_CX(kk[11], kk[12]); PEER_CX(kk[6], kk[7]); PEER_CX(kk[8], kk[9]);
#pragma unroll
          for (int e = 0; e < 16; ++e) tk[e] = max(tk[e], kk[15 - e]);
          PEER_CX(tk[0], tk[8]); PEER_CX(tk[1], tk[9]); PEER_CX(tk[2], tk[10]); PEER_CX(tk[3], tk[11]); PEER_CX(tk[4], tk[12]); PEER_CX(tk[5], tk[13]); PEER_CX(tk[6], tk[14]); PEER_CX(tk[7], tk[15]); PEER_CX(tk[0], tk[4]); PEER_CX(tk[1], tk[5]); PEER_CX(tk[2], tk[6]); PEER_CX(tk[3], tk[7]); PEER_CX(tk[8], tk[12]); PEER_CX(tk[9], tk[13]); PEER_CX(tk[10], tk[14]); PEER_CX(tk[11], tk[15]); PEER_CX(tk[0], tk[2]); PEER_CX(tk[1], tk[3]); PEER_CX(tk[4], tk[6]); PEER_CX(tk[5], tk[7]); PEER_CX(tk[8], tk[10]); PEER_CX(tk[9], tk[11]); PEER_CX(tk[12], tk[14]); PEER_CX(tk[13], tk[15]); PEER_CX(tk[0], tk[1]); PEER_CX(tk[2], tk[3]); PEER_CX(tk[4], tk[5]); PEER_CX(tk[6], tk[7]); PEER_CX(tk[8], tk[9]); PEER_CX(tk[10], tk[11]); PEER_CX(tk[12], tk[13]); PEER_CX(tk[14], tk[15]); }
#undef PEER_CX
      LAS float* tvp = TV + (tl * 16 + g) * 16; LAS int* tip = TI + (tl * 16 + g) * 16;
#pragma unroll
      for (int j = 0; j < 16; ++j) { const int k_ = tk[j] & ~127; tvp[j] = __int_as_float(k_ ^ ((k_ >> 31) & 0x7fffffff)); tip[j] = 127 - (tk[j] & 127); } }
    __syncthreads();
    asm volatile("" : "+v"(tid));
    { const int tl = tid >> 4, hh = (tid >> 1) & 7, half = tid & 1;
      const LAS float* s1 = TV + (tl * 16 + 2 * hh) * 16; const LAS float* s2 = s1 + 16; const LAS int* i1 = TI + (tl * 16 + 2 * hh) * 16; const LAS int* i2 = i1 + 16;
      float b2[16];
#pragma unroll
      for (int j = 0; j < 16; ++j) b2[j] = s2[j];
      int tk[16];
#pragma unroll
      for (int j = 0; j < 16; ++j) tk[j] = (int)0x80000000;
#pragma unroll
      for (int ii = 0; ii < 8; ++ii) { const int i = 2 * ii + half; const float a = s1[i];
#pragma unroll
          for (int j = 0; j < 16; ++j) if ((2 * ii + 1) * (j + 1) <= 16) { if (half == 0 || (2 * ii + 2) * (j + 1) <= 16) PEER_INS(PEER_KEY(a + b2[j], 255 - (i * 16 + j), 255)); } }
      { int pk[16];
#pragma unroll
        for (int j = 0; j < 16; ++j) pk[j] = __shfl_xor(tk[j], 1);
#pragma unroll
        for (int j = 0; j < 16; ++j) PEER_INS(pk[j]); }
      if (half == 0) { float e[16], sum = 0.f; const int k0_ = tk[0] & ~255; const float v0 = __int_as_float(k0_ ^ ((k0_ >> 31) & 0x7fffffff));
#pragma unroll
        for (int j = 0; j < 16; ++j) { const int k_ = tk[j] & ~255; const float vj = __int_as_float(k_ ^ ((k_ >> 31) & 0x7fffffff)); e[j] = __builtin_amdgcn_exp2f((vj - v0) * 1.4426950408889634f); sum += e[j]; }
        const float inv = 1.0f / sum;
#pragma unroll
        for (int j = 0; j < 16; ++j) { const int ci = 255 - (tk[j] & 255); SE[tl * 128 + hh * 16 + j] = i1[ci >> 4] * 128 + i2[ci & 15]; SG[tl * 128 + hh * 16 + j] = e[j] * inv; } } }
#undef PEER_KEY
#undef PEER_INS
    __syncthreads();
}
__device__ __forceinline__ void peer_gather(int chunk, const bf16_t* __restrict__ H2, const unsigned char* __restrict__ U, const unsigned char* __restrict__ V,
                                            const float* __restrict__ g2, const float* __restrict__ gf, float* OUT, int tid, const LAS int* SE, const LAS float* SG) {
    asm volatile("" : "+v"(tid));
    const int tok0 = chunk * CH, lane = tid & 63, wave = tid >> 6;
    const rsrc_t rH2 = mk_rsrc(H2, 0x4000000u), rU = mk_rsrc(U, 0x1000000u), rV = mk_rsrc(V, 0x1000000u), rG2 = mk_rsrc(g2, 8192u), rGF = mk_rsrc(gf, 8192u);
#pragma unroll 1
    for (int tt = 0; tt < CH / NWAVES; ++tt) { const int tl = wave * (CH / NWAVES) + tt, tok = tok0 + tl;
      asm volatile("" ::: "memory");
      float hn[32]; float ss = 0.f;
#pragma unroll
      for (int j = 0; j < 2; ++j)
#pragma unroll
          for (int q = 0; q < 4; ++q) { const u32x2 w = ldb64(rH2, ((unsigned)tok * 2048u + 256u * (4 * j + q) + 4u * lane) * 2u);
              const f32x4 a = (f32x4){__uint_as_float(w.x << 16), __uint_as_float(w.x & 0xffff0000u), __uint_as_float(w.y << 16), __uint_as_float(w.y & 0xffff0000u)};
#pragma unroll
              for (int i = 0; i < 4; ++i) { hn[16 * j + 4 * q + i] = a[i]; ss += a[i] * a[i]; } }
      const float rstd = 1.0f / sqrtf(wave_sum(ss) * (1.f / 2048.f) + NORM_EPS);
#pragma unroll
      for (int j = 0; j < 2; ++j)
#pragma unroll
          for (int q = 0; q < 4; ++q) { const f32x4 a = ldf128(rG2, (256u * (4 * j + q) + 4u * lane) * 4u);
#pragma unroll
              for (int i = 0; i < 4; ++i) hn[16 * j + 4 * q + i] *= rstd * a[i]; }
      typedef _Float16 h2_t __attribute__((ext_vector_type(2)));
      h2_t hn16[16]; f32x2 accp[16];
#pragma unroll
      for (int k = 0; k < 16; ++k) { hn16[k] = (h2_t){(_Float16)hn[2 * k], (_Float16)hn[2 * k + 1]}; accp[k] = (f32x2){0.f, 0.f}; }
#define NX 4
#define PEER_LOAD(S, kb) do { _Pragma("unroll") for (int x = 0; x < NX; ++x) { const unsigned o = (unsigned)SE[tl * 128 + (kb) + x] * 1024u + (unsigned)lane * 16u; \
          S##u[x] = ldb128(rU, o); S##v[x] = ldb128(rV, o); } } while (0)
#define PEER_DU(W, k) dd = __builtin_amdgcn_fdot2(__builtin_amdgcn_cvt_scalef32_pk_f16_fp4(W[(k) >> 2], 1.0f, (k) & 3), hn16[k], dd, false);
#define PEER_DV(W, k) accp[k] = __builtin_elementwise_fma(__builtin_amdgcn_cvt_scalef32_pk_f32_fp4(W[(k) >> 2], 1.0f, (k) & 3), c2, accp[k]);
#define PEER_16(M, W) M(W, 0) M(W, 1) M(W, 2) M(W, 3) M(W, 4) M(W, 5) M(W, 6) M(W, 7) M(W, 8) M(W, 9) M(W, 10) M(W, 11) M(W, 12) M(W, 13) M(W, 14) M(W, 15)
#define PEER_COMPUTE(S, kb) do { float d[NX]; \
          _Pragma("unroll") for (int x = 0; x < NX; ++x) { const u32x4 W = S##u[x]; float dd = 0.f; PEER_16(PEER_DU, W) d[x] = dd; } \
          _Pragma("unroll") for (int o = 1; o < 64; o <<= 1) { _Pragma("unroll") for (int x = 0; x < NX; ++x) d[x] += __shfl_xor(d[x], o); } \
          float c[NX]; \
          _Pragma("unroll") for (int x = 0; x < NX; ++x) c[x] = SG[tl * 128 + (kb) + x] * gelu_tanh(d[x] * (1.f / PEER_U_SCALE)) * (1.f / PEER_V_SCALE); \
          _Pragma("unroll") for (int x = 0; x < NX; ++x) { const u32x4 W = S##v[x]; const f32x2 c2 = (f32x2){c[x], c[x]}; PEER_16(PEER_DV, W) } } while (0)
      { u32x4 Au[NX], Av[NX], Bu[NX], Bv[NX];
        PEER_LOAD(A, 0);
#pragma unroll 1
        for (int k = 0; k < 128; k += 2 * NX) {
            PEER_LOAD(B, k + NX); PEER_COMPUTE(A, k);
            { const int kn = min(k + 2 * NX, 128 - NX); PEER_LOAD(A, kn); }
            PEER_COMPUTE(B, k + NX);
        } }
#undef PEER_DU
#undef PEER_DV
#undef PEER_16
#undef NX
#undef PEER_LOAD
#undef PEER_COMPUTE
      asm volatile("" ::: "memory");
      int tok2 = tok, lane2 = lane; asm volatile("" : "+v"(tok2), "+v"(lane2));
      float s2 = 0.f;
#pragma unroll
      for (int j = 0; j < 2; ++j)
#pragma unroll
          for (int q = 0; q < 4; ++q) { const u32x2 w = ldb64(rH2, ((unsigned)tok2 * 2048u + 256u * (4 * j + q) + 4u * lane2) * 2u);
              const f32x4 a = (f32x4){__uint_as_float(w.x << 16), __uint_as_float(w.x & 0xffff0000u), __uint_as_float(w.y << 16), __uint_as_float(w.y & 0xffff0000u)};
#pragma unroll
              for (int i = 0; i < 4; ++i) { const int e_ = 16 * j + 4 * q + i; accp[e_ >> 1][e_ & 1] += a[i]; s2 += accp[e_ >> 1][e_ & 1] * accp[e_ >> 1][e_ & 1]; } }
      const float rf = 1.0f / sqrtf(wave_sum(s2) * (1.f / 2048.f) + NORM_EPS);
#pragma unroll
      for (int j = 0; j < 2; ++j)
#pragma unroll
          for (int q = 0; q < 4; ++q) { const f32x4 a = ldf128(rGF, (256u * (4 * j + q) + 4u * lane2) * 4u); f32x4 oa;
#pragma unroll
              for (int i = 0; i < 4; ++i) { const int e_ = 16 * j + 4 * q + i; oa[i] = accp[e_ >> 1][e_ & 1] * rf * a[i]; }
              float* op = OUT + (size_t)tok2 * 2048 + 256 * (4 * j + q) + 4 * lane2;
              __builtin_nontemporal_store(oa, (GAS f32x4*)op); }
    }
}
}
#ifndef MK_N_LAUNCHES
#define MK_N_LAUNCHES 1
#endif
#define MK_PROBE_PH -1
#define MK_PROBE_DIV 2
constexpr int N_PHASES = 9;
constexpr int N_LAUNCHES = MK_N_LAUNCHES;
struct Args { const float* in[19]; float* out; unsigned char* ws; int ph_lo, ph_hi; };
static_assert(sizeof(Args) == 19 * 8 + 8 + 8 + 8, "no padding");

__global__ void __launch_bounds__(NWAVES * 64, 2) hybrid_fwd(Args args) {
    extern __shared__ __attribute__((aligned(16))) unsigned char lds_raw[];
    Frame F;
    F.lds = (LAS unsigned char*)lds_raw;
    F.MISC = (volatile LAS unsigned*)(F.lds + MISC_OFF);
    F.tid = threadIdx.x; F.lane = F.tid & 63; F.wave = __builtin_amdgcn_readfirstlane(F.tid >> 6);
    F.G = gridDim.x; { const int bx = blockIdx.x; F.vcu = (F.G % 8 == 0) ? (bx % 8) * (F.G / 8) + bx / 8 : bx; }
    F.ws = args.ws; F.out = args.out;
#pragma unroll
    for (int i = 0; i < 19; ++i) F.in[i] = args.in[i];
    for (int u = F.tid; u < (LDS_BYTES - LDSCTL_OFF) / 4; u += NWAVES * 64) ((LAS unsigned*)(F.lds + LDSCTL_OFF))[u] = 0u;
    __syncthreads();
    XcdBarrier bar; bar.bar = (unsigned*)(F.ws + WS_CTL) + CW_BAR; bar.x = 0; bar.st = nullptr;
    if (N_LAUNCHES == 1) bar = xcd_barrier_post((unsigned*)(F.ws + WS_CTL) + CW_BAR, F.MISC + 8);
    const int lo = args.ph_lo, hi = args.ph_hi;
#define IN(k) (lo <= (k) && (k) < hi)
#if MK_PROBE_PH >= 0
    unsigned long long tp0 = (MK_PROBE_PH == 0 || MK_PROBE_PH == 9) ? __builtin_amdgcn_s_memrealtime() : 0ull, tp1 = 0ull;
#define SEAM(k) do { if (IN(k) && IN((k) + 1)) xcd_barrier(bar); if (MK_PROBE_PH == (k)) tp1 = __builtin_amdgcn_s_memrealtime(); if (MK_PROBE_PH == (k) + 1) tp0 = __builtin_amdgcn_s_memrealtime(); } while (0)
#else
#define SEAM(k) do { if (IN(k) && IN((k) + 1)) xcd_barrier(bar); } while (0)
#endif
    const size_t T2048 = (size_t)256 * 2048 * 2, T1024 = (size_t)256 * 1024 * 2, T512 = (size_t)256 * 512 * 2;
    float* cosT = WSP(float, WS_COS); float* sinT = WSP(float, WS_SIN);
    float* ssq_q = WSP(float, WS_SSQ_Q); float* ssq_kv = WSP(float, WS_SSQ_KV); float* ssq2 = WSP(float, WS_SSQ_2);

    if (IN(0)) { p0_prologue<0>(F, F.vcu, F.G); } SEAM(0);
    if (IN(1)) {
        SchedP1 S{F.G, (int)blockIdx.x, (const char*)(F.ws + WS_HN1), (const char*)(F.ws + WS_WIN), (const char*)(F.ws + WS_WVT), T1024};
        EpiP1 E{WSP(unsigned char, WS_NAQ), WSP(unsigned char, WS_NAK), WSP(unsigned char, WS_VT), WSP(unsigned char, WS_CQ), WSP(unsigned char, WS_CKV), WSP(unsigned char, WS_KR), WSP(unsigned char, WS_GA), WSP(unsigned char, WS_GB), ssq_q, ssq_kv, cosT, sinT};
        pg8::gemm_phase<EpiP1, SchedP1, true, -6>(F.lds, 2048, S, E);
        { const int extra = P1_UNITS % F.G, bx = (int)blockIdx.x; if (extra != 0 && bx >= extra) p0_prologue<1>(F, bx - extra, F.G - extra); else if (extra == 0) p0_prologue<1>(F, bx, F.G); }
    } SEAM(1);
    if (IN(2)) {
        LAS float* relb = (LAS float*)F.lds + 64; LAS float* metab = relb + 16 * 15 * 31 + 128; LAS float* wsf = metab + 256 + F.wave * 64;
        for (int i = F.tid; i < 16 * 15 * 31; i += NWAVES * 64) relb[i] = F.in[4][i];
        if (F.tid < 256) metab[F.tid] = F.in[5][F.tid];
        __syncthreads();
        const int gw = F.vcu * NWAVES + F.wave, NGW = F.G * NWAVES;
        for (int task = gw; task < NBATCH * 16 * 32 * 2; task += NGW)
            att::na_task(task, WSP(unsigned char, WS_NAQ), WSP(unsigned char, WS_NAK), WSP(unsigned char, WS_VT), WSP(unsigned char, WS_ONA), relb, metab, wsf, F.lane);
        __syncthreads();
    }
    if (IN(3)) {
        SchedP3 S{F.G, (int)blockIdx.x, (const char*)F.ws, T512 / 2};
        EpiP3 E{WSP(unsigned char, WS_QM), WSP(unsigned char, WS_KN), WSP(unsigned char, WS_VV), ssq_q, ssq_kv, cosT, sinT};
        pg8::gemm_phase<EpiP3, SchedP3, true, -4>(F.lds, 512, S, E);
    } SEAM(3);
    if (IN(4)) {
        const int gw = F.vcu * NWAVES + F.wave, NGW = F.G * NWAVES;
        Conv cv{F.in[16], F.in[17], WSP(unsigned char, WS_U), WSP(unsigned char, WS_V), F.lds + 65536 + F.wave * 8192, gw, NGW, 2 * 16384, -1, 0};
        for (int id = F.vcu; id < NBATCH * 16 * 8; id += F.G) { const int bh = id >> 3, qb = id & 7;
            att::mla_unit8(bh >> 4, bh & 15, qb, WSP(unsigned char, WS_QM), WSP(unsigned char, WS_KN), WSP(unsigned char, WS_KR), WSP(unsigned char, WS_VV), WSP(unsigned char, WS_OMLA), (LAS char*)F.lds, cv); }
        while (cv.pend >= 0 || cv.next < cv.end) conv_step<0>(cv, F.lane);
        __syncthreads();
    } SEAM(4);
    if (IN(5)) {
        { SchedGrid S{F.G, (int)blockIdx.x, 64, 8, (const char*)(F.ws + WS_ONA), (const char*)(F.ws + WS_WNA), T512};
          EpiP5a E{WSP(unsigned char, WS_GA), WSP(unsigned char, WS_T1)};
          pg8::gemm_phase<EpiP5a, SchedGrid, true, -9>(F.lds, 1024, S, E); }
        { SchedGrid S{F.G, (int)blockIdx.x, 64, 8, (const char*)(F.ws + WS_OMLA), (const char*)(F.ws + WS_WMLA), T1024};
          EpiP5b E{WSP(unsigned char, WS_GB), WSP(unsigned char, WS_T1), WSP(unsigned char, WS_MERGED)};
          pg8::gemm_phase<EpiP5b, SchedGrid, true, -11>(F.lds, 2048, S, E); }
    } SEAM(5);
    if (IN(6)) {
        { SchedGrid S{F.G, (int)blockIdx.x, 64, 8, (const char*)(F.ws + WS_MERGED), (const char*)(F.ws + WS_WOUT), T1024};
          EpiP6 E{F.in[0], WSP(bf16_t, WS_H2B), ssq2};
          pg8::gemm_phase<EpiP6, SchedGrid, true, -11>(F.lds, 2048, S, E); }
    } SEAM(6);
    if (IN(7)) {
        SchedGrid S{F.G, (int)blockIdx.x, 64, 8, (const char*)(F.ws + WS_H2B), (const char*)(F.ws + WS_WSC), T2048};
        EpiP7 E{ssq2, WSP(_Float16, WS_SC)};
        pg8::gemm_phase<EpiP7, SchedGrid>(F.lds, 2048, S, E);
    } SEAM(7);
    if (IN(8)) {
        const int nch = (MREAL / peer::CH - F.vcu + F.G - 1) / F.G; const bool both_first = (nch == 2) && (F.vcu & 1);
        for (int op = 0; op < 2 * nch; ++op) {
            const bool sel = both_first ? (op < 2) : !(op & 1); const int ci = both_first ? (op & 1) : (op >> 1), chunk = F.vcu + ci * F.G;
            const int b2 = both_first ? ci : 0;
            LAS int* SE = (LAS int*)(F.lds + (b2 ? peer::OFF_SE2 : peer::OFF_SE)); LAS float* SG = (LAS float*)(F.lds + (b2 ? peer::OFF_SG2 : peer::OFF_SG));
            if (sel) peer::peer_select(chunk, WSP(_Float16, WS_SC), (LAS char*)F.lds, F.tid, SE, SG);
            else peer::peer_gather(chunk, WSP(bf16_t, WS_H2B), WSP(unsigned char, WS_U), WSP(unsigned char, WS_V), F.in[13], F.in[18], F.out, F.tid, SE, SG); }
    }
#if MK_PROBE_PH >= 0
    xcd_barrier(bar); tp1 = (MK_PROBE_PH >= 8) ? __builtin_amdgcn_s_memrealtime() : tp1;
    if (blockIdx.x == 0 && F.tid == 0) F.out[0] = (float)(tp1 - tp0) * (0.01f / MK_PROBE_DIV);
#endif
#undef IN
#undef SEAM
}

extern "C" void kernel_launch(void* const* d_in, const int* in_sizes, int n_in, void* d_out, int out_size, void* d_ws, size_t ws_size, hipStream_t stream) {
    static int grid = 0;
    if (grid == 0) {
        if (n_in != 19 || in_sizes[0] != MREAL * DM || out_size != MREAL * DM || ws_size < WS_END) {
            fprintf(stderr, "kernel_launch: shape/workspace mismatch: n_in %d in0 %d out %d ws %zu (need %zu); nothing launched\n", n_in, n_in > 0 ? in_sizes[0] : -1, out_size, ws_size, (size_t)WS_END); grid = -1; return; }
        int dev = 0, cus = 0, per_cu = 0;
        if (hipGetDevice(&dev) != hipSuccess || hipDeviceGetAttribute(&cus, hipDeviceAttributeMultiprocessorCount, dev) != hipSuccess) { fprintf(stderr, "kernel_launch: device query failed\n"); grid = -1; return; }
        if (hipFuncSetAttribute((const void*)hybrid_fwd, hipFuncAttributeMaxDynamicSharedMemorySize, LDS_BYTES) != hipSuccess) { fprintf(stderr, "kernel_launch: hipFuncSetAttribute failed\n"); grid = -1; return; }
        if (hipOccupancyMaxActiveBlocksPerMultiprocessor(&per_cu, (const void*)hybrid_fwd, NWAVES * 64, LDS_BYTES) != hipSuccess || per_cu < 1)
            fprintf(stderr, "kernel_launch: note: occupancy query reports %d workgroups per CU\n", per_cu);
        (void)hipGetLastError();
        grid = cus;
    }
    if (grid < 0) return;
    if (hipMemsetAsync((char*)d_ws + WS_CTL, 0, CTL_ZERO_BYTES, stream) != hipSuccess) { fprintf(stderr, "kernel_launch: hipMemsetAsync failed\n"); return; }
    Args a{};
    for (int i = 0; i < 19; ++i) a.in[i] = (const float*)d_in[i];
    a.out = (float*)d_out; a.ws = (unsigned char*)d_ws;
    for (int li = 0; li < N_LAUNCHES; ++li) {
        a.ph_lo = (N_LAUNCHES == 1) ? 0 : li; a.ph_hi = (N_LAUNCHES == 1) ? N_PHASES : li + 1;
        hipLaunchKernelGGL(hybrid_fwd, dim3(grid), dim3(NWAVES * 64), LDS_BYTES, stream, a);
        const hipError_t le = hipPeekAtLastError();
        if (le != hipSuccess) { fprintf(stderr, "kernel_launch: launch %d failed: %s\n", li, hipGetErrorName(le)); break; }
    }
}
```

```cpp
#include <hip/hip_runtime.h>
#include <cstdio>
#include <cstdint>

#define LAS __attribute__((address_space(3)))
#define GAS __attribute__((address_space(1)))
typedef unsigned short bf16_t;
typedef short bf16x8 __attribute__((ext_vector_type(8)));
typedef short s16x4 __attribute__((ext_vector_type(4)));
typedef float f32x4 __attribute__((ext_vector_type(4)));
typedef float f32x2 __attribute__((ext_vector_type(2)));
typedef float f32x16 __attribute__((ext_vector_type(16)));
typedef unsigned u32x4 __attribute__((ext_vector_type(4)));
typedef unsigned u32x2 __attribute__((ext_vector_type(2)));

constexpr int DM = 2048, NBATCH = 8, SEQ = 2048, NMETA = 16;
constexpr int MREAL = NBATCH * SEQ;
constexpr int MPAD = MREAL + 256;
constexpr int NPOS = SEQ + NMETA;
constexpr float NORM_EPS = 1e-6f;
constexpr int C_NAQ = 0, C_NAK = 1024, C_CQ = 2048, C_CKV = 2560, C_GA = 3072, C_GB = 5120, C_KR = 7168, NMAIN = 7424;
constexpr int VT_PITCH = MPAD;

constexpr size_t MiB = 1u << 20;
constexpr size_t WS_CTL = 0, CTL_ZERO_BYTES = 1 * MiB;
constexpr size_t WS_SSQ_Q = 481 * MiB, WS_SSQ_KV = 482 * MiB, WS_SSQ_2 = 486 * MiB;
constexpr size_t WS_COS = 1 * MiB, WS_SIN = 1 * MiB + 512 * 1024;
constexpr size_t WS_WUQ = 2 * MiB, WS_WUKV = 5 * MiB, WS_WNA = 9 * MiB, WS_WMLA = 13 * MiB, WS_WOUT = 21 * MiB, WS_WSC = 29 * MiB;
constexpr size_t WS_GA = 37 * MiB, WS_GB = 101 * MiB;
constexpr size_t WS_KR = 165 * MiB;
constexpr size_t WS_WIN = 167 * MiB + 256 * 1024, WS_WVT = WS_WIN + 29 * MiB;
constexpr size_t WS_ONA = 190 * MiB;
constexpr size_t WS_NAQ = 222 * MiB, WS_NAK = 254 * MiB, WS_VT = WS_NAK + 32 * MiB + 512 * 1024;
constexpr size_t WS_HN1 = 319 * MiB;
constexpr size_t WS_CQ = 448 * MiB, WS_CKV = 464 * MiB;
constexpr size_t WS_QM = 303 * MiB, WS_KN = 352 * MiB, WS_VV = 385 * MiB;
constexpr size_t WS_OMLA = 448 * MiB;
constexpr size_t WS_MERGED = 222 * MiB, WS_T1 = 286 * MiB;
constexpr size_t WS_H2 = 37 * MiB, WS_H2B = 293 * MiB;
constexpr size_t WS_U = 69 * MiB, WS_V = 133 * MiB;
constexpr size_t WS_SC = 165 * MiB;
constexpr size_t WS_END = 512 * MiB;
static_assert(WS_CKV + (size_t)MPAD * 512 * 2 <= WS_SSQ_Q && WS_SSQ_Q + (size_t)8 * MPAD * 4 <= WS_SSQ_KV && WS_SSQ_KV + (size_t)8 * MPAD * 4 <= 483 * MiB && WS_SSQ_2 + (size_t)32 * MREAL * 4 <= WS_END, "ssq slabs");
static_assert(WS_VT + (size_t)1024 * MPAD * 2 <= WS_HN1 && WS_HN1 + (size_t)MPAD * 2048 * 2 <= WS_CQ && WS_CKV + (size_t)MPAD * 512 * 2 <= WS_END, "map P1");
static_assert(WS_WVT + 4 * MiB <= WS_NAQ && WS_KR + (size_t)MPAD * 64 * 2 <= WS_WIN && WS_ONA + 32 * MiB <= WS_NAQ, "map P1b");
static_assert(WS_VT + (size_t)1024 * MPAD <= WS_QM && WS_QM + 48 * MiB <= WS_KN && WS_KN + 33 * MiB <= WS_VV && WS_VV + 33 * MiB <= WS_OMLA && WS_OMLA + 64 * MiB <= WS_END, "map P3");
static_assert(WS_T1 + 128 * MiB <= WS_OMLA && WS_H2 + 128 * MiB <= WS_KR && WS_SC + 128 * MiB <= WS_H2B && WS_H2B + 64 * MiB <= WS_END, "map P5+");
static_assert(WS_GA + 32 * MiB <= WS_U && WS_U + 24 * MiB <= WS_GB && WS_GB + 32 * MiB <= WS_V && WS_V + 24 * MiB <= WS_KR, "expert tables between the gate codes");

constexpr int CW_BAR = 4096;
constexpr float PEER_U_SCALE = 90.50966799f, PEER_V_SCALE = 5.656854249f;

constexpr int RING_BYTES = 131072;
constexpr int LDSCTL_OFF = RING_BYTES, MISC_OFF = LDSCTL_OFF + 320;
constexpr int LDS_BYTES = 147456;
constexpr int NWAVES = 8;

#define LDS_WAIT() asm volatile("s_waitcnt lgkmcnt(0)" ::: "memory")
#define VM_WAIT() asm volatile("s_waitcnt vmcnt(0)" ::: "memory")
#define SBAR() __builtin_amdgcn_sched_barrier(0)
typedef __bf16 bf16x2_t __attribute__((ext_vector_type(2)));
__device__ __forceinline__ unsigned cvt_pk_bf16(float lo, float hi) { const f32x2 v = {lo, hi}; const bf16x2_t b = __builtin_convertvector(v, bf16x2_t); return __builtin_bit_cast(unsigned, b); }
__device__ __forceinline__ float bf_lo(unsigned w) { return __uint_as_float(w << 16); }
__device__ __forceinline__ float bf_hi(unsigned w) { return __uint_as_float(w & 0xffff0000u); }
__device__ __forceinline__ u32x4 pack8(const f32x4 a, const f32x4 b) { u32x4 w; w.x = cvt_pk_bf16(a[0], a[1]); w.y = cvt_pk_bf16(a[2], a[3]); w.z = cvt_pk_bf16(b[0], b[1]); w.w = cvt_pk_bf16(b[2], b[3]); return w; }
__device__ __forceinline__ u32x2 pack8_fp8(f32x4 a, f32x4 b) {
#pragma unroll
    for (int i = 0; i < 4; ++i) { a[i] = __builtin_fminf(__builtin_fmaxf(a[i], -448.f), 448.f); b[i] = __builtin_fminf(__builtin_fmaxf(b[i], -448.f), 448.f); }
    int w0 = 0, w1 = 0; w0 = __builtin_amdgcn_cvt_pk_fp8_f32(a[0], a[1], w0, false); w0 = __builtin_amdgcn_cvt_pk_fp8_f32(a[2], a[3], w0, true);
    w1 = __builtin_amdgcn_cvt_pk_fp8_f32(b[0], b[1], w1, false); w1 = __builtin_amdgcn_cvt_pk_fp8_f32(b[2], b[3], w1, true); return (u32x2){(unsigned)w0, (unsigned)w1}; }
__device__ __forceinline__ unsigned char f32_to_fp8(float x) { x = __builtin_fminf(__builtin_fmaxf(x, -448.f), 448.f); return (unsigned char)(__builtin_amdgcn_cvt_pk_fp8_f32(x, 0.f, 0, false) & 0xff); }
__device__ __forceinline__ u32x2 pack8_u8(const f32x4 a, const f32x4 b) { u32x2 w; unsigned x = 0u, y = 0u;
    x = __builtin_amdgcn_cvt_pk_u8_f32(a[0] * 255.f, 0u, x); x = __builtin_amdgcn_cvt_pk_u8_f32(a[1] * 255.f, 1u, x); x = __builtin_amdgcn_cvt_pk_u8_f32(a[2] * 255.f, 2u, x); x = __builtin_amdgcn_cvt_pk_u8_f32(a[3] * 255.f, 3u, x);
    y = __builtin_amdgcn_cvt_pk_u8_f32(b[0] * 255.f, 0u, y); y = __builtin_amdgcn_cvt_pk_u8_f32(b[1] * 255.f, 1u, y); y = __builtin_amdgcn_cvt_pk_u8_f32(b[2] * 255.f, 2u, y); y = __builtin_amdgcn_cvt_pk_u8_f32(b[3] * 255.f, 3u, y);
    w.x = x; w.y = y; return w; }
__device__ __forceinline__ unsigned pack4_fp8(f32x4 a) {
#pragma unroll
    for (int i = 0; i < 4; ++i) a[i] = __builtin_fminf(__builtin_fmaxf(a[i], -448.f), 448.f);
    int w0 = 0; w0 = __builtin_amdgcn_cvt_pk_fp8_f32(a[0], a[1], w0, false); w0 = __builtin_amdgcn_cvt_pk_fp8_f32(a[2], a[3], w0, true); return (unsigned)w0; }
__device__ __forceinline__ void unpack8_fp8(const u32x2 w, f32x4& a, f32x4& b) {
    const f32x2 a0 = __builtin_amdgcn_cvt_pk_f32_fp8((int)w.x, false), a1 = __builtin_amdgcn_cvt_pk_f32_fp8((int)w.x, true), b0 = __builtin_amdgcn_cvt_pk_f32_fp8((int)w.y, false), b1 = __builtin_amdgcn_cvt_pk_f32_fp8((int)w.y, true);
    a = (f32x4){a0[0], a0[1], a1[0], a1[1]}; b = (f32x4){b0[0], b0[1], b1[0], b1[1]}; }
__device__ __forceinline__ void unpack8_u8(const u32x2 w, f32x4& a, f32x4& b) { const float k = 1.f / 255.f;
    a = (f32x4){(float)(w.x & 0xffu), (float)((w.x >> 8) & 0xffu), (float)((w.x >> 16) & 0xffu), (float)(w.x >> 24)} * k;
    b = (f32x4){(float)(w.y & 0xffu), (float)((w.y >> 8) & 0xffu), (float)((w.y >> 16) & 0xffu), (float)(w.y >> 24)} * k; }
__device__ __forceinline__ u32x2 pack4(const f32x4 a) { u32x2 w; w.x = cvt_pk_bf16(a[0], a[1]); w.y = cvt_pk_bf16(a[2], a[3]); return w; }
__device__ __forceinline__ float wave_sum(float v) {
#pragma unroll
    for (int o = 1; o < 64; o <<= 1) v += __shfl_xor(v, o);
    return v;
}
__device__ __forceinline__ float sigmoidf_(float x) { return __builtin_amdgcn_rcpf(1.0f + __builtin_amdgcn_exp2f(-1.4426950408889634f * x)); }
__device__ __forceinline__ int crow(int r, int hi) { return (r & 3) + 8 * (r >> 2) + 4 * hi; }
#define PG8_AUX 0
namespace pg8 {
constexpr int BM = 256, BK = 64, HALF = 128, HTB = HALF * BK * 2  , STAGE_BYTES = 8 * HTB, NXCD = 8, WGM = 8;
__host__ __device__ __forceinline__ int lds_byte(int r, int c) { const int st = (r >> 4) * 2 + (c >> 5), rr = r & 15, cc = c & 31, ob = rr * 64 + cc * 2; return st * 1024 + (ob ^ (((ob >> 9) & 1) << 5)); }
__host__ __device__ __forceinline__ void stage_rc(int b, int& R, int& C) { const int st = b / 1024, sb = b % 1024, swz = sb ^ (((sb >> 9) & 1) << 5); R = (st >> 1) * 16 + swz / 64; C = (st & 1) * 32 + (swz % 64) / 2; }
__host__ __device__ __forceinline__ int perm32(int rho) { const int n = rho >> 4, i = rho & 15; return 8 * (i >> 2) + 4 * n + (i & 3); }

struct Unit { int pm, pn, kind; };

__device__ __forceinline__ void grid_order(int L, int nM, int nN, int& pm, int& pn) {
    const int nwg = nM * nN; int wgid = L;
    { const int q = nwg / NXCD, r = nwg % NXCD, xcd = wgid % NXCD, off = wgid / NXCD; wgid = (xcd < r ? xcd * (q + 1) : r * (q + 1) + (xcd - r) * q) + off; }
    const int nig = WGM * nN, gid = wgid / nig, fm = gid * WGM, gsz = (nM - fm) < WGM ? (nM - fm) : WGM;
    pm = fm + ((wgid % nig) % gsz); pn = (wgid % nig) / gsz;
}

typedef int v8i_t __attribute__((ext_vector_type(8)));
template <class Epi, class Sched, bool F8 = false, int F8_SCALE_EXP = 0>
__device__ __forceinline__ void gemm_phase(LAS unsigned char* lds, const int K, const Sched& S, const Epi& E) {
    const int tid = threadIdx.x, wid = __builtin_amdgcn_readfirstlane(tid >> 6), lane = tid & 63, wr = wid >> 2, wc = wid & 3, fr = lane & 15, fq = lane >> 4;
    int f8sa = 0x01010101 * (127 + F8_SCALE_EXP), f8sb = 0x7f7f7f7f; asm volatile("" : "+v"(f8sa), "+v"(f8sb));
    const int Kb = F8 ? K : 2 * K;
    const int nt = Kb / 128;
    unsigned voffA[2], voffB[2];
#pragma unroll
    for (int i = 0; i < 2; ++i) { int R, C; stage_rc(tid * 16 + i * 8192, R, C); const int Rb = Epi::PERM ? ((R & ~31) + perm32(R & 31)) : R;
        voffA[i] = (unsigned)(R * Kb + C * 2); voffB[i] = (unsigned)(Rb * Kb + C * 2); }
    const size_t kstep = (size_t)128;
    const size_t hstep = (size_t)HALF * Kb;
    const unsigned ldsw = (unsigned)wid * 1024u;
    const int aoff = lds_byte(wr * 64 + fr, F8 ? fq * 16 : fq * 8), boff = lds_byte(wc * 32 + fr, F8 ? fq * 16 : fq * 8);
#define PG8_SA(b, h) (((b) * 2 + (h)) * HTB)
#define PG8_SB(b, h) ((4 + (b) * 2 + (h)) * HTB)
#define PG8_STAGE(bufoff, gbase, voff) do { _Pragma("unroll") for (int _i = 0; _i < 2; ++_i) \
        __builtin_amdgcn_global_load_lds((const unsigned*)((const char*)(gbase) + (voff)[_i]), (LAS unsigned*)(lds + (bufoff) + ldsw + _i * 8192), 16, 0, PG8_AUX); } while (0)
#define PG8_LDA(dst, b, h) do { _Pragma("unroll") for (int m = 0; m < 4; ++m) _Pragma("unroll") for (int k = 0; k < 2; ++k) dst[m][k] = *(const LAS bf16x8*)(lds + PG8_SA(b, h) + aoff + m * 2048 + (F8 ? k * 16 : k * 1024)); } while (0)
#define PG8_LDB(dst, b, h) do { _Pragma("unroll") for (int n = 0; n < 2; ++n) _Pragma("unroll") for (int k = 0; k < 2; ++k) dst[n][k] = *(const LAS bf16x8*)(lds + PG8_SB(b, h) + boff + n * 2048 + (F8 ? k * 16 : k * 1024)); } while (0)
#define PG8_F8OP(X) __builtin_bit_cast(v8i_t, __builtin_shufflevector(X[0], X[1], 0, 1, 2, 3, 4, 5, 6, 7, 8, 9, 10, 11, 12, 13, 14, 15))
#define PG8_MMA(ai, bj, At, Bt) do { __builtin_amdgcn_s_setprio(1); \
        if constexpr (F8) { _Pragma("unroll") for (int m = 0; m < 4; ++m) _Pragma("unroll") for (int n = 0; n < 2; ++n) \
            asm volatile("v_mfma_scale_f32_16x16x128_f8f6f4 %0, %1, %2, %0, %3, %4 op_sel_hi:[0,0,0]" : "+v"(acc[ai][bj][m][n]) : "v"(PG8_F8OP(Bt[n])), "v"(PG8_F8OP(At[m])), "v"(f8sa), "v"(f8sb)); } \
        else { _Pragma("unroll") for (int m = 0; m < 4; ++m) _Pragma("unroll") for (int n = 0; n < 2; ++n) _Pragma("unroll") for (int k = 0; k < 2; ++k) \
            acc[ai][bj][m][n] = __builtin_amdgcn_mfma_f32_16x16x32_bf16(Bt[n][k], At[m][k], acc[ai][bj][m][n], 0, 0, 0); } \
        __builtin_amdgcn_s_setprio(0); } while (0)
#define PG8_WAIT_V(n) asm volatile("s_waitcnt vmcnt(" #n ")" ::: "memory")
#define PG8_WAIT_L(n) asm volatile("s_waitcnt lgkmcnt(" #n ")" ::: "memory")
#define PG8_BAR __builtin_amdgcn_s_barrier()
#define PG8_SCHED __builtin_amdgcn_sched_barrier(0)
    Unit cur, nxt; int ui = 0;
    if (!S.next(0, cur)) return;
    f32x4 acc[2][2][4][2];
#pragma unroll
    for (int a = 0; a < 2; ++a)
#pragma unroll
        for (int b = 0; b < 2; ++b)
#pragma unroll
            for (int m = 0; m < 4; ++m)
#pragma unroll
                for (int n = 0; n < 2; ++n) acc[a][b][m][n] = (f32x4){0.f, 0.f, 0.f, 0.f};
    bf16x8 At[4][2], B0[2][2], B1[2][2];
    const char* cA = S.pa(cur); const char* cB = S.pb(cur);
    PG8_STAGE(PG8_SB(0, 0), cB, voffB); PG8_STAGE(PG8_SB(0, 1), cB + hstep, voffB); PG8_STAGE(PG8_SA(0, 0), cA, voffA); PG8_STAGE(PG8_SA(0, 1), cA + hstep, voffA);
    if (wr == 1) PG8_BAR;
    PG8_WAIT_V(2); PG8_BAR;
    PG8_STAGE(PG8_SB(1, 0), cB + kstep, voffB); PG8_STAGE(PG8_SA(1, 0), cA + kstep, voffA); PG8_STAGE(PG8_SB(1, 1), cB + hstep + kstep, voffB);
    PG8_WAIT_V(6); PG8_BAR;
    for (;;) {
        const bool has_next = S.next(ui + 1, nxt);
        const char* nA = has_next ? S.pa(nxt) : cA; const char* nB = has_next ? S.pb(nxt) : cB;
        for (int t = 0; t < nt; t += 2) {
            const bool last = (t == nt - 2);
            const char* a1 = cA + (size_t)(t + 1) * kstep;
            const char* a2 = last ? nA : cA + (size_t)(t + 2) * kstep; const char* b2 = last ? nB : cB + (size_t)(t + 2) * kstep;
            const char* a3 = a2 + kstep; const char* b3 = b2 + kstep;
            PG8_LDB(B0, 0, 0); PG8_LDB(B1, 0, 1); PG8_SCHED; PG8_LDA(At, 0, 0); PG8_STAGE(PG8_SA(1, 1), a1 + hstep, voffA);
            PG8_WAIT_V(8); PG8_WAIT_L(0); PG8_BAR; PG8_MMA(0, 0, At, B0); PG8_MMA(0, 1, At, B1); PG8_BAR; PG8_SCHED;
            PG8_LDA(At, 0, 1); PG8_STAGE(PG8_SB(0, 0), b2, voffB); PG8_STAGE(PG8_SB(0, 1), b2 + hstep, voffB); PG8_STAGE(PG8_SA(0, 0), a2, voffA);
            PG8_WAIT_V(8); PG8_WAIT_L(0); PG8_BAR; PG8_MMA(1, 0, At, B0); PG8_MMA(1, 1, At, B1); PG8_BAR; PG8_SCHED;
            PG8_LDB(B0, 1, 0); PG8_LDB(B1, 1, 1); PG8_SCHED; PG8_LDA(At, 1, 0); PG8_STAGE(PG8_SA(0, 1), a2 + hstep, voffA);
            PG8_WAIT_V(8); PG8_WAIT_L(0); PG8_BAR; PG8_MMA(0, 0, At, B0); PG8_MMA(0, 1, At, B1); PG8_BAR; PG8_SCHED;
            PG8_LDA(At, 1, 1); PG8_STAGE(PG8_SB(1, 0), b3, voffB); PG8_STAGE(PG8_SB(1, 1), b3 + hstep, voffB); PG8_STAGE(PG8_SA(1, 0), a3, voffA);
            PG8_WAIT_V(8); PG8_WAIT_L(0); PG8_BAR; PG8_MMA(1, 0, At, B0); PG8_MMA(1, 1, At, B1); PG8_BAR; PG8_SCHED;
        }
        if (wr == 0) PG8_BAR;
        if constexpr (F8) asm volatile("s_nop 15\n\ts_nop 7" ::: "memory");
        if constexpr (Epi::HAS_PRE) {
            E.pre(cur, (LAS float*)(lds + STAGE_BYTES + 1024), tid); PG8_WAIT_L(0); PG8_BAR; }
        E(acc, cur, wr, wc, fr, fq, (const LAS float*)(lds + STAGE_BYTES + 1024));
        if (!has_next) break;
#pragma unroll
        for (int a = 0; a < 2; ++a)
#pragma unroll
            for (int b = 0; b < 2; ++b)
#pragma unroll
                for (int m = 0; m < 4; ++m)
#pragma unroll
                    for (int n = 0; n < 2; ++n) acc[a][b][m][n] = (f32x4){0.f, 0.f, 0.f, 0.f};
        cur = nxt; cA = nA; cB = nB; ++ui;
        if (wr == 1) PG8_BAR;
    }
    PG8_WAIT_V(0);
    PG8_BAR;
#undef PG8_SA
#undef PG8_SB
#undef PG8_STAGE
#undef PG8_LDA
#undef PG8_LDB
#undef PG8_MMA
#undef PG8_F8OP
#undef PG8_WAIT_V
#undef PG8_WAIT_L
#undef PG8_BAR
#undef PG8_SCHED
}
}
typedef GAS unsigned gu32;
#define RLX_AGENT __ATOMIC_RELAXED, __HIP_MEMORY_SCOPE_AGENT
#define XB_TMO      128
#define XB_XCNT(j)  (256  + 64 * (j))
#define XB_XSUB(j)  (1280 + 64 * (j))
#define XB_XGEN(j)  (2304 + 64 * (j))
#define XB_TOP      3328
#define XB_TOPGEN   3392
#define XCD_BAR_WORDS 3456
#define XB_SPIN_CAP (1u << 18)
__device__ __forceinline__ unsigned xb_ld(unsigned* p)              { return __hip_atomic_load(p, __ATOMIC_RELAXED, __HIP_MEMORY_SCOPE_AGENT); }
__device__ __forceinline__ unsigned xb_add(unsigned* p, unsigned v) { return __hip_atomic_fetch_add(p, v, __ATOMIC_RELAXED, __HIP_MEMORY_SCOPE_AGENT); }
__device__ __forceinline__ unsigned xb_xcc_id() { return (unsigned)__builtin_amdgcn_s_getreg((3 << 11) | 20) & 0xFu; }
#define XB_SPIN(cond, bar) do { unsigned _sp = 0; while (cond) { __builtin_amdgcn_s_sleep(1); \
    if ((++_sp & 255u) == 0u) { if (xb_ld(&(bar)[XB_TMO])) break; if (_sp > XB_SPIN_CAP) { atomicAdd(&(bar)[XB_TMO], 1u); break; } } } } while (0)
struct XcdBarrier { unsigned* bar; unsigned x; volatile LAS unsigned* st; };
__device__ __forceinline__ XcdBarrier xcd_barrier_post(unsigned* bar, volatile LAS unsigned* st) {
    XcdBarrier b; b.bar = bar; b.x = xb_xcc_id(); b.st = st;
    if (threadIdx.x == 0) (void)xb_add(&bar[XB_XCNT(b.x)], 1u);
    return b;
}
__device__ __forceinline__ void xcd_barrier_complete(unsigned* bar, unsigned x, unsigned& nloc, unsigned& nx) {
    const unsigned G = gridDim.x * gridDim.y * gridDim.z;
    unsigned sum, cnt, mine, sp = 0u;
    for (;;) {
        sum = 0u; cnt = 0u; mine = 0u;
#pragma unroll
        for (unsigned j = 0; j < 16; ++j) { const unsigned c = xb_ld(&bar[XB_XCNT(j)]); sum += c; cnt += (c > 0u) ? 1u : 0u; mine = (j == x) ? c : mine; }
        if (sum == G) break;
        __builtin_amdgcn_s_sleep(1);
        if ((++sp & 255u) == 0u) { if (xb_ld(&bar[XB_TMO])) break; if (sp > XB_SPIN_CAP) { atomicAdd(&bar[XB_TMO], 1u); break; } }
    }
    nloc = mine > 0u ? mine : 1u; nx = cnt > 0u ? cnt : 1u;
}
__device__ __forceinline__ void xcd_barrier(const XcdBarrier& b) {
    asm volatile("s_waitcnt vmcnt(0)" ::: "memory");
    __syncthreads();
    if (threadIdx.x == 0) {
        unsigned* bar = b.bar;
        __builtin_amdgcn_s_waitcnt(0);
        unsigned nloc = b.st[0], nx = b.st[1];
        if (nloc == 0u) { xcd_barrier_complete(bar, b.x, nloc, nx); b.st[0] = nloc; b.st[1] = nx; }
        const unsigned old = xb_add(&bar[XB_XSUB(b.x)], 1u);
        const unsigned gen = old / nloc;
        if (old + 1u == (gen + 1u) * nloc) {
            __builtin_amdgcn_fence(__ATOMIC_RELEASE, "agent");
            asm volatile("s_waitcnt vmcnt(0)" ::: "memory");
            const unsigned og = xb_add(&bar[XB_TOP], 1u);
            const unsigned tg = og / nx;
            if (og + 1u == (tg + 1u) * nx) xb_add(&bar[XB_TOPGEN], 1u);
            else XB_SPIN(xb_ld(&bar[XB_TOPGEN]) == tg, bar);
            __builtin_amdgcn_fence(__ATOMIC_ACQUIRE, "agent");
            xb_add(&bar[XB_XGEN(b.x)], 1u);
            asm volatile("s_waitcnt vmcnt(0)" ::: "memory");
        } else {
            XB_SPIN(xb_ld(&bar[XB_XGEN(b.x)]) == gen, bar);
            __builtin_amdgcn_fence(__ATOMIC_ACQUIRE, "agent");
            asm volatile("s_waitcnt vmcnt(0)" ::: "memory");
        }
    }
    __syncthreads();
}
struct Frame {
    LAS unsigned char* lds;
    volatile LAS unsigned* MISC;
    unsigned char* ws;
    int tid, lane, wave;
    int vcu, G;
    const float* in[19];
    float* out;
};
#define WSP(T, off) ((T*)(F.ws + (off)))

typedef float cv16f_t __attribute__((ext_vector_type(16)));
typedef unsigned cv6u_t __attribute__((ext_vector_type(6)));
struct Conv { const float* pu; const float* pv; unsigned char* u8; unsigned char* v8; LAS unsigned char* lbuf; int next, stride, end, pend, tick; };
__device__ __forceinline__ void conv_issue(const Conv& c, int item, int lane) {
    const float* src = ((item >> 14) ? c.pv : c.pu) + (size_t)(item & 16383) * 2048 + 4 * lane;
#pragma unroll
    for (int q = 0; q < 8; ++q) __builtin_amdgcn_global_load_lds((const unsigned*)(src + 256 * q), (LAS unsigned*)(c.lbuf + q * 1024), 16, 0, 0);
}
__device__ __forceinline__ void conv_finish(const Conv& c, int item, int lane) {
    const int isv = item >> 14, row = item & 16383; const float sc = isv ? PEER_V_SCALE : PEER_U_SCALE; unsigned w[4] = {0u, 0u, 0u, 0u};
#define CONV_Q(q) { const f32x4 x = *(const LAS f32x4*)(c.lbuf + (q) * 1024 + lane * 16) * sc; \
        w[(q) >> 1] = __builtin_amdgcn_cvt_scalef32_pk_fp4_f32(w[(q) >> 1], x[0], x[1], 1.0f, (2 * (q)) & 3); w[(q) >> 1] = __builtin_amdgcn_cvt_scalef32_pk_fp4_f32(w[(q) >> 1], x[2], x[3], 1.0f, (2 * (q) + 1) & 3); }
    CONV_Q(0) asm volatile("" : "+v"(w[0]) :: "memory"); CONV_Q(1) asm volatile("" : "+v"(w[0]) :: "memory"); CONV_Q(2) asm volatile("" : "+v"(w[1]) :: "memory"); CONV_Q(3) asm volatile("" : "+v"(w[1]) :: "memory");
    CONV_Q(4) asm volatile("" : "+v"(w[2]) :: "memory"); CONV_Q(5) asm volatile("" : "+v"(w[2]) :: "memory"); CONV_Q(6) asm volatile("" : "+v"(w[3]) :: "memory"); CONV_Q(7)
#undef CONV_Q
    unsigned char* rec = (isv ? c.v8 : c.u8) + (size_t)row * 1024;
    *(GAS u32x4*)(rec + lane * 16) = (u32x4){w[0], w[1], w[2], w[3]};
}
template <int YOUNGER>
__device__ __forceinline__ void conv_step(Conv& c, int lane) {
    if (c.pend >= 0) { if constexpr (YOUNGER == 0) asm volatile("s_waitcnt vmcnt(0)" ::: "memory"); else { static_assert(YOUNGER == 12, "wait count"); asm volatile("s_waitcnt vmcnt(12)" ::: "memory"); }
        conv_finish(c, c.pend, lane); c.pend = -1; asm volatile("s_waitcnt lgkmcnt(0)" ::: "memory"); }
    if (c.next < c.end) { conv_issue(c, c.next, lane); c.pend = c.next; c.next += c.stride; }
}
__device__ __forceinline__ void p0_transpose_item8(const float* W, int K, int N, int k0, int n0, unsigned char* WT, int drow, bool rope, float scale, LAS float* scr, int lane, const float* gain = nullptr) {
    { f32x4 v[8]; float gk[8];
#pragma unroll
      for (int i = 0; i < 8; ++i) { const int kk = 8 * i + (lane >> 3); v[i] = *(const GAS f32x4*)(W + (size_t)(k0 + kk) * N + n0 + 4 * (lane & 7)); gk[i] = gain ? gain[k0 + kk] * scale : scale; }
#pragma unroll
      for (int i = 0; i < 8; ++i) { const int kk = 8 * i + (lane >> 3); LAS float* d = scr + kk * 33 + 4 * (lane & 7);
#pragma unroll
          for (int e = 0; e < 4; ++e) d[e] = v[i][e] * gk[i]; } }
    LDS_WAIT(); asm volatile("" ::: "memory");
#pragma unroll
    for (int j = 0; j < 2; ++j) { const int q = lane + 64 * j, n = q >> 2, c = q & 3; const LAS float* s = scr + (16 * c) * 33 + n; u32x4 o;
#pragma unroll
        for (int d = 0; d < 4; ++d) { int w = 0; w = __builtin_amdgcn_cvt_pk_fp8_f32(s[(4 * d) * 33], s[(4 * d + 1) * 33], w, false); w = __builtin_amdgcn_cvt_pk_fp8_f32(s[(4 * d + 2) * 33], s[(4 * d + 3) * 33], w, true); o[d] = (unsigned)w; }
        const int dr = drow + (rope ? (8 * (n >> 2) + (n & 3)) : n);
        *(GAS u32x4*)(WT + (size_t)dr * K + k0 + 16 * c) = o; }
    LDS_WAIT(); asm volatile("" ::: "memory");
}
template <int PART>
__device__ __forceinline__ void p0_prologue(Frame& F, int rank, int nrank) {
    LAS float* scr = (LAS float*)(F.lds + F.wave * 16384);
    const int gw = rank * NWAVES + F.wave, NGW = nrank * NWAVES, lane = F.lane; const int gt = rank * 512 + F.tid, NGT = nrank * 512;
    unsigned char* WIN = WSP(unsigned char, WS_WIN); unsigned char* WVT = WSP(unsigned char, WS_WVT);
    constexpr int I_IN = 32 * 258, I_UQ = 8 * 96, I_UKV = 8 * 128, I_NA = 16 * 64, I_MLA = 32 * 64, I_OUT = 32 * 64;
    constexpr int NEARLY = I_IN + I_UQ + I_UKV, NITEMS = NEARLY + I_NA + I_MLA + I_OUT;
    for (int it = (PART == 0 ? 0 : NEARLY) + gw; it < (PART == 0 ? NEARLY : NITEMS); it += NGW) {
        int r = it;
        if (r < I_IN) { const int kb = r / 258, sb = r % 258, n0 = 32 * sb, k0 = 64 * kb; const float* W = F.in[3];
            unsigned char* dst = WIN; int drow; bool rope = false;
            if (n0 < 1024) drow = C_NAQ + n0;
            else if (n0 < 2048) drow = C_NAK + (n0 - 1024);
            else if (n0 < 3072) { dst = WVT; drow = n0 - 2048; }
            else if (n0 < 3584) drow = C_CQ + (n0 - 3072);
            else if (n0 < 4096) drow = C_CKV + (n0 - 3584);
            else if (n0 < 4160) { drow = C_KR + ((n0 - 4096) ? 4 : 0); rope = true; }
            else if (n0 < 6208) drow = C_GA + (n0 - 4160);
            else drow = C_GB + (n0 - 6208);
            p0_transpose_item8(W, 2048, 8256, k0, n0, dst, drow, rope, 64.f, scr, lane); continue; } r -= I_IN;
        if (r < I_UQ) { const int kb = r / 96, sb = r % 96, n0 = 32 * sb, k0 = 64 * kb; const int hd = n0 / 192, w = n0 % 192;
            int drow = n0; bool rope = false; if (w >= 128) { rope = true; drow = hd * 192 + 128 + ((w - 128) ? 4 : 0); }
            p0_transpose_item8(F.in[7], 512, 3072, k0, n0, WSP(unsigned char, WS_WUQ), drow, rope, 16.f, scr, lane, F.in[6]); continue; } r -= I_UQ;
        if (r < I_UKV) { const int kb = r / 128, sb = r % 128; const int n0 = 32 * sb, hd = n0 >> 8, w = n0 & 255;
            p0_transpose_item8(F.in[9], 512, 4096, 64 * kb, n0, WSP(unsigned char, WS_WUKV), (w >= 128 ? 2048 : 0) + hd * 128 + (w & 127), false, 16.f, scr, lane, F.in[8]); continue; } r -= I_UKV;
        if (r < I_NA) { const int kb = r / 64, sb = r % 64; p0_transpose_item8(F.in[10], 1024, 2048, 64 * kb, 32 * sb, WSP(unsigned char, WS_WNA), 32 * sb, false, 32.f, scr, lane); continue; } r -= I_NA;
        if (r < I_MLA) { const int kb = r / 64, sb = r % 64; p0_transpose_item8(F.in[11], 2048, 2048, 64 * kb, 32 * sb, WSP(unsigned char, WS_WMLA), 32 * sb, false, 64.f, scr, lane); continue; } r -= I_MLA;
        { const int kb = r / 64, sb = r % 64; p0_transpose_item8(F.in[12], 2048, 2048, 64 * kb, 32 * sb, WSP(unsigned char, WS_WOUT), 32 * sb, false, 64.f, scr, lane); }
    }
    if (PART == 0) { GAS u32x4* z = (GAS u32x4*)(WIN + (size_t)(C_KR + 64) * 2048); const int n16 = (NMAIN - C_KR - 64) * 2048 / 16;
      for (int i = gt; i < n16; i += NGT) z[i] = (u32x4){0u, 0u, 0u, 0u}; }
    if (PART == 0) { unsigned char* HN1 = WSP(unsigned char, WS_HN1);
#define P0_ROWSRC(m_) (((m_) < MREAL) ? F.in[0] + (size_t)(m_) * DM : F.in[1] + (size_t)((m_) - MREAL) * DM)
      { f32x4 v[8]; int m = gw;
        if (m < MREAL + NMETA) { const GAS f32x4* xr = (const GAS f32x4*)P0_ROWSRC(m) + lane;
#pragma unroll
            for (int j = 0; j < 8; ++j) v[j] = xr[64 * j]; }
        const GAS f32x4* gr = (const GAS f32x4*)F.in[2] + lane;
        while (m < MREAL + NMETA) { const int mn = m + NGW; f32x4 vn[8];
            { const int ml = mn < MREAL + NMETA ? mn : m; const GAS f32x4* xr = (const GAS f32x4*)P0_ROWSRC(ml) + lane;
#pragma unroll
              for (int j = 0; j < 8; ++j) vn[j] = xr[64 * j]; }
            float sq = 0.f;
#pragma unroll
            for (int j = 0; j < 8; ++j) sq += (v[j].x * v[j].x + v[j].y * v[j].y) + (v[j].z * v[j].z + v[j].w * v[j].w);
            const float rstd = 1.0f / sqrtf(wave_sum(sq) * (1.f / DM) + NORM_EPS);
            GAS unsigned* o4 = (GAS unsigned*)(HN1 + (size_t)m * DM) + lane;
#pragma unroll
            for (int j = 0; j < 8; ++j) { const f32x4 y = (v[j] * rstd) * gr[64 * j]; int w = 0; w = __builtin_amdgcn_cvt_pk_fp8_f32(y[0], y[1], w, false); w = __builtin_amdgcn_cvt_pk_fp8_f32(y[2], y[3], w, true); o4[64 * j] = (unsigned)w; }
#pragma unroll
            for (int j = 0; j < 8; ++j) v[j] = vn[j];
            m = mn; } }
#undef P0_ROWSRC
      GAS u32x4* z = (GAS u32x4*)(HN1 + (size_t)(MREAL + NMETA) * DM); const int n16 = (MPAD - MREAL - NMETA) * DM / 16;
      for (int i = gt; i < n16; i += NGT) z[i] = (u32x4){0u, 0u, 0u, 0u}; }
    if (PART == 0) { float* ct = WSP(float, WS_COS); float* st = WSP(float, WS_SIN);
      for (int i = gt; i < NPOS * 32; i += NGT) { const int p = i >> 5, j = i & 31;
          const float inv = __builtin_powf(10000.0f, -(float)(2 * j) / 64.0f); const float ang = (float)p * inv;
          double r = (double)ang * 0.15915494309189535; r -= __builtin_rint(r); const float rf = (float)r;
          ct[i] = __builtin_amdgcn_cosf(rf); st[i] = __builtin_amdgcn_sinf(rf); } }
    if (PART == 1) { const float* SK = F.in[15]; const float* WQ = F.in[14]; const float* g2 = F.in[13]; bf16_t* WSCp = WSP(bf16_t, WS_WSC);
      const int l15 = lane & 15, l4 = lane >> 4;
      for (int task = gw; task < 2048; task += NGW) { const int g = task >> 7, nt = (task >> 4) & 7, kc = task & 15, n0 = nt * 16;
          bf16x8 bfr[4];
#pragma unroll
          for (int kk = 0; kk < 4; ++kk) { const float* p = SK + ((size_t)g * 128 + n0 + l15) * 128 + 32 * kk + 8 * l4; const f32x4 a = *(const GAS f32x4*)p, b = *(const GAS f32x4*)(p + 4);
              const u32x4 w = pack8(a, b); bfr[kk] = __builtin_bit_cast(bf16x8, w); }
          for (int kt = 0; kt < 8; ++kt) { const int k0 = (kc * 8 + kt) * 16; f32x4 acc = (f32x4){0.f, 0.f, 0.f, 0.f};
#pragma unroll
              for (int kk = 0; kk < 4; ++kk) { const float* p = WQ + (size_t)(k0 + l15) * 2048 + g * 128 + 32 * kk + 8 * l4; const f32x4 a = *(const GAS f32x4*)p, b = *(const GAS f32x4*)(p + 4);
                  const u32x4 w = pack8(a, b); acc = __builtin_amdgcn_mfma_f32_16x16x32_bf16(__builtin_bit_cast(bf16x8, w), bfr[kk], acc, 0, 0, 0); }
              const f32x4 gg = *(const GAS f32x4*)(g2 + k0 + 4 * l4);
              *(GAS u32x2*)(WSCp + (size_t)(g * 128 + n0 + l15) * 2048 + k0 + 4 * l4) = pack4(acc * gg); } } }
}
using pg8::Unit;
struct SchedGrid {
    int G, c, nM, nN; const char* A; const char* B; size_t tstep;
    __device__ __forceinline__ bool next(int i, Unit& u) const { const int L = i * G + c; if (L >= nM * nN) return false; pg8::grid_order(L, nM, nN, u.pm, u.pn); u.kind = 0; return true; }
    __device__ __forceinline__ const char* pa(const Unit& u) const { return A + (size_t)u.pm * tstep; }
    __device__ __forceinline__ const char* pb(const Unit& u) const { return B + (size_t)u.pn * tstep; }
};
constexpr int P1_MAIN = 64 * 29, P1_VT = 4 * 65, P1_META = 7, P1_UNITS = P1_MAIN + P1_VT + P1_META;
struct SchedP1 {
    int G, c; const char* hn1; const char* win; const char* wvt; size_t tstep;
    __device__ __forceinline__ bool next(int i, Unit& u) const {
        const int L = i * G + c; if (L >= P1_UNITS) return false;
        if (L < P1_MAIN) { pg8::grid_order(L, 64, 29, u.pm, u.pn); u.kind = 0; }
        else if (L < P1_MAIN + P1_VT) { const int idx = L - P1_MAIN; u.pm = idx & 3; u.pn = idx >> 2; u.kind = 1; }
        else { const int idx = L - P1_MAIN - P1_VT; u.pm = 64; u.pn = idx < 4 ? 4 + idx : (idx < 6 ? 10 + (idx - 4) : 28); u.kind = 0; }
        return true; }
    __device__ __forceinline__ const char* pa(const Unit& u) const { return (u.kind == 1 ? wvt : hn1) + (size_t)u.pm * tstep; }
    __device__ __forceinline__ const char* pb(const Unit& u) const { return (u.kind == 1 ? hn1 : win) + (size_t)u.pn * tstep; }
};
__device__ __forceinline__ void rope4(const f32x4 x1, const f32x4 x2, const float* cosT, const float* sinT, int pos, int j0, f32x4& lo, f32x4& hi) {
    const f32x4 c = *(const GAS f32x4*)(cosT + pos * 32 + j0), s = *(const GAS f32x4*)(sinT + pos * 32 + j0);
    lo = x1 * c - x2 * s; hi = x2 * c + x1 * s;
}
struct EpiP1 {
    static constexpr bool PERM = true, HAS_PRE = false;
    unsigned char *naq, *nak, *vt; unsigned char *cq, *ckv; unsigned char *kr; unsigned char *ga, *gb; float *ssq_q, *ssq_kv; const float *cosT, *sinT;
    __device__ __forceinline__ void operator()(const f32x4 (&acc)[2][2][4][2], const Unit& u, int wr, int wc, int fr, int fq, const LAS float* rowsc) const {
        const int row0 = u.pm * 256 + wr * 64 + fr, colu = wc * 32 + 8 * fq;
        if (u.kind == 1) {
#pragma unroll
            for (int bj = 0; bj < 2; ++bj) { const int t0 = u.pn * 256 + bj * 128 + colu, pos = (t0 & ~63) + ((t0 & 63) >> 1);
#pragma unroll
                for (int ai = 0; ai < 2; ++ai)
#pragma unroll
                    for (int m = 0; m < 4; ++m) { unsigned char* rp = vt + (size_t)(row0 + ai * 128 + m * 16) * VT_PITCH + pos;
                        *(GAS unsigned*)rp = pack4_fp8(acc[ai][bj][m][0]); *(GAS unsigned*)(rp + 32) = pack4_fp8(acc[ai][bj][m][1]); } }
            return; }
        const int pn = u.pn;
        if (pn == 28) {
            if (wc < 2) { const int j0 = 4 * (4 * wc + fq);
#pragma unroll
                for (int ai = 0; ai < 2; ++ai)
#pragma unroll
                    for (int m = 0; m < 4; ++m) { const int row = row0 + ai * 128 + m * 16; const int pos = row < MREAL ? NMETA + (row & (SEQ - 1)) : row - MREAL;
                        f32x4 lo, hi; rope4(acc[ai][0][m][0], acc[ai][0][m][1], cosT, sinT, pos, j0, lo, hi);
                        *(GAS unsigned*)(kr + (size_t)row * 64 + j0) = pack4_fp8(lo); *(GAS unsigned*)(kr + (size_t)row * 64 + 32 + j0) = pack4_fp8(hi); } }
            return; }
        if (pn >= 12) {
            unsigned char* base = pn < 20 ? ga : gb; const int colt = (pn < 20 ? pn - 12 : pn - 20) * 256 + colu;
#pragma unroll
            for (int ai = 0; ai < 2; ++ai)
#pragma unroll
                for (int m = 0; m < 4; ++m) { unsigned char* rp = base + (size_t)(row0 + ai * 128 + m * 16) * 2048 + colt;
#pragma unroll
                    for (int bj = 0; bj < 2; ++bj) { f32x4 a = acc[ai][bj][m][0], b = acc[ai][bj][m][1];
#pragma unroll
                        for (int i = 0; i < 4; ++i) { a[i] = sigmoidf_(a[i]); b[i] = sigmoidf_(b[i]); }
                        *(GAS u32x2*)(rp + bj * 128) = pack8_u8(a, b); } }
            return; }
        if (pn >= 8) {
            const bool isq = pn < 10; unsigned char* base = isq ? cq : ckv; float* ssq = isq ? ssq_q : ssq_kv; const int colt = (isq ? pn - 8 : pn - 10) * 256 + colu;
#pragma unroll
            for (int ai = 0; ai < 2; ++ai)
#pragma unroll
                for (int m = 0; m < 4; ++m) { const int row = row0 + ai * 128 + m * 16; unsigned char* rp = base + (size_t)row * 512 + colt; float s = 0.f;
#pragma unroll
                    for (int bj = 0; bj < 2; ++bj) { const f32x4 a = acc[ai][bj][m][0], b = acc[ai][bj][m][1];
                        s += (a[0] * a[0] + a[1] * a[1]) + (a[2] * a[2] + a[3] * a[3]) + (b[0] * b[0] + b[1] * b[1]) + (b[2] * b[2] + b[3] * b[3]);
                        *(GAS u32x2*)(rp + bj * 128) = pack8_fp8(a, b); }
                    s += __shfl_xor(s, 16); s += __shfl_xor(s, 32);
                    if (fq == 0) ssq[(size_t)((pn & 1) * 4 + wc) * MPAD + row] = s; }
            return; }
        {
            unsigned char* base = pn < 4 ? naq : nak; const int colt = (pn & 3) * 256 + colu;
#pragma unroll
            for (int ai = 0; ai < 2; ++ai)
#pragma unroll
                for (int m = 0; m < 4; ++m) { unsigned char* rp = base + (size_t)(row0 + ai * 128 + m * 16) * 1024 + colt;
#pragma unroll
                    for (int bj = 0; bj < 2; ++bj) *(GAS u32x2*)(rp + bj * 128) = pack8_fp8(acc[ai][bj][m][0], acc[ai][bj][m][1]); }
        }
    }
};
constexpr int P3_Q = 64 * 12, P3_K = 65 * 8, P3_V = 8 * 65, P3_UNITS = P3_Q + P3_K + P3_V;
struct SchedP3 {
    int G, c; const char* ws; size_t tstep;
    __device__ __forceinline__ bool next(int i, Unit& u) const {
        const int L = i * G + c; if (L >= P3_UNITS) return false;
        if (L < P3_Q) { pg8::grid_order(L, 64, 12, u.pm, u.pn); u.kind = 0; }
        else if (L < P3_Q + P3_K) { pg8::grid_order(L - P3_Q, 65, 8, u.pm, u.pn); u.kind = 1; }
        else { const int idx = L - P3_Q - P3_K; u.pm = idx & 7; u.pn = idx >> 3; u.kind = 2; }
        return true; }
    __device__ __forceinline__ const char* pa(const Unit& u) const { const size_t o = u.kind == 0 ? WS_CQ : (u.kind == 1 ? WS_CKV : WS_WUKV + (size_t)2048 * 512); return ws + o + (size_t)u.pm * tstep; }
    __device__ __forceinline__ const char* pb(const Unit& u) const { const size_t o = u.kind == 0 ? WS_WUQ : (u.kind == 1 ? WS_WUKV : WS_CKV); return ws + o + (size_t)u.pn * tstep; }
};
template <int NS, int LD> __device__ __forceinline__ float rstd_slabs(const float* part, int row, float invn) {
    float s = 0.f;
#pragma unroll
    for (int i = 0; i < NS; ++i) s += part[(size_t)i * LD + row];
    return 1.0f / sqrtf(s * invn + NORM_EPS);
}
struct EpiP3 {
    static constexpr bool PERM = true, HAS_PRE = true;
    unsigned char *qm, *kn, *vt; const float *ssq_q, *ssq_kv; const float *cosT, *sinT;
    __device__ __forceinline__ void pre(const Unit& u, LAS float* sc, int tid) const { if (tid < 256) { const int row = (u.kind == 2 ? u.pn : u.pm) * 256 + tid; sc[tid] = u.kind ? rstd_slabs<8, MPAD>(ssq_kv, row, 1.f / 512.f) : rstd_slabs<8, MPAD>(ssq_q, row, 1.f / 512.f); } }
    __device__ __forceinline__ void operator()(const f32x4 (&acc)[2][2][4][2], const Unit& u, int wr, int wc, int fr, int fq, const LAS float* rowsc) const {
        const int row0 = u.pm * 256 + wr * 64 + fr, colu = wc * 32 + 8 * fq;
        if (u.kind == 2) {
#pragma unroll
            for (int bj = 0; bj < 2; ++bj) { const int cl = bj * 128 + colu, t0 = u.pn * 256 + cl;
                const f32x4 s0 = *(const LAS f32x4*)(rowsc + cl), s1 = *(const LAS f32x4*)(rowsc + cl + 4);
                const int g = (t0 >> 3) & 7, pos = (t0 & ~63) + 16 * (g >> 2) + 4 * (g & 3);
#pragma unroll
                for (int ai = 0; ai < 2; ++ai)
#pragma unroll
                    for (int m = 0; m < 4; ++m) { unsigned char* rp = vt + (size_t)(row0 + ai * 128 + m * 16) * MPAD + pos;
                        *(GAS unsigned*)rp = pack4_fp8(acc[ai][bj][m][0] * s0); *(GAS unsigned*)(rp + 32) = pack4_fp8(acc[ai][bj][m][1] * s1); } }
            return; }
        if (u.kind == 1) {
#pragma unroll
            for (int ai = 0; ai < 2; ++ai)
#pragma unroll
                for (int m = 0; m < 4; ++m) { const int row = row0 + ai * 128 + m * 16; const float rs = rowsc[ai * 128 + wr * 64 + m * 16 + fr];
                    unsigned char* rp = kn + (size_t)row * 2048 + u.pn * 256 + colu;
#pragma unroll
                    for (int bj = 0; bj < 2; ++bj) *(GAS u32x2*)(rp + bj * 128) = pack8_fp8(acc[ai][bj][m][0] * rs, acc[ai][bj][m][1] * rs); }
            return; }
#pragma unroll
        for (int bj = 0; bj < 2; ++bj) { const int c8 = u.pn * 256 + bj * 128 + colu; const int hd = c8 / 192, w = c8 - hd * 192;
            if (w < 128) {
#pragma unroll
                for (int ai = 0; ai < 2; ++ai)
#pragma unroll
                    for (int m = 0; m < 4; ++m) { const int row = row0 + ai * 128 + m * 16; const float rs = rowsc[ai * 128 + wr * 64 + m * 16 + fr];
                        *(GAS u32x2*)(qm + (size_t)row * 3072 + c8) = pack8_fp8(acc[ai][bj][m][0] * rs, acc[ai][bj][m][1] * rs); }
            } else { const int j0 = (w - 128) >> 1;
#pragma unroll
                for (int ai = 0; ai < 2; ++ai)
#pragma unroll
                    for (int m = 0; m < 4; ++m) { const int row = row0 + ai * 128 + m * 16; const float rs = rowsc[ai * 128 + wr * 64 + m * 16 + fr];
                        const int pos = NMETA + (row & (SEQ - 1)); f32x4 lo, hi; rope4(acc[ai][bj][m][0] * rs, acc[ai][bj][m][1] * rs, cosT, sinT, pos, j0, lo, hi);
                        unsigned char* qp = qm + (size_t)row * 3072 + hd * 192 + 128 + j0; *(GAS unsigned*)qp = pack4_fp8(lo); *(GAS unsigned*)(qp + 32) = pack4_fp8(hi); }
            } }
    }
};

__device__ __forceinline__ void unpack8(const u32x4 w, f32x4& a, f32x4& b) { a = (f32x4){bf_lo(w.x), bf_hi(w.x), bf_lo(w.y), bf_hi(w.y)}; b = (f32x4){bf_lo(w.z), bf_hi(w.z), bf_lo(w.w), bf_hi(w.w)}; }
struct EpiP5a {
    static constexpr bool PERM = true, HAS_PRE = false;
    const unsigned char* ga; unsigned char* t1;
    __device__ __forceinline__ void operator()(const f32x4 (&acc)[2][2][4][2], const Unit& u, int wr, int wc, int fr, int fq, const LAS float* rowsc) const {
        const int row0 = u.pm * 256 + wr * 64 + fr, col0 = u.pn * 256 + wc * 32 + 8 * fq;
#pragma unroll
        for (int ai = 0; ai < 2; ++ai)
#pragma unroll
            for (int m = 0; m < 4; ++m) { const size_t off = (size_t)(row0 + ai * 128 + m * 16) * 2048 + col0;
#pragma unroll
                for (int bj = 0; bj < 2; ++bj) { f32x4 g0, g1; unpack8_u8(*(const GAS u32x2*)(ga + off + bj * 128), g0, g1);
                    *(GAS u32x2*)(t1 + off + bj * 128) = pack8_fp8(acc[ai][bj][m][0] * g0 * 32.f, acc[ai][bj][m][1] * g1 * 32.f); } }
    }
};
struct EpiP5b {
    static constexpr bool PERM = true, HAS_PRE = false;
    const unsigned char* gb; const unsigned char* t1; unsigned char* merged;
    __device__ __forceinline__ void operator()(const f32x4 (&acc)[2][2][4][2], const Unit& u, int wr, int wc, int fr, int fq, const LAS float* rowsc) const {
        const int row0 = u.pm * 256 + wr * 64 + fr, col0 = u.pn * 256 + wc * 32 + 8 * fq;
#pragma unroll
        for (int ai = 0; ai < 2; ++ai)
#pragma unroll
            for (int m = 0; m < 4; ++m) { const size_t off = (size_t)(row0 + ai * 128 + m * 16) * 2048 + col0;
#pragma unroll
                for (int bj = 0; bj < 2; ++bj) { f32x4 g0, g1; unpack8_u8(*(const GAS u32x2*)(gb + off + bj * 128), g0, g1);
                    f32x4 a, b; unpack8_fp8(*(const GAS u32x2*)(t1 + off + bj * 128), a, b);
                    *(GAS u32x2*)(merged + off + bj * 128) = pack8_fp8(a + acc[ai][bj][m][0] * g0 * 32.f, b + acc[ai][bj][m][1] * g1 * 32.f); } }
    }
};
struct EpiP6 {
    static constexpr bool PERM = true, HAS_PRE = false;
    const float* x; bf16_t* h2b; float* ssq2;
    __device__ __forceinline__ void operator()(const f32x4 (&acc)[2][2][4][2], const Unit& u, int wr, int wc, int fr, int fq, const LAS float* rowsc) const {
        const int row0 = u.pm * 256 + wr * 64 + fr, col0 = u.pn * 256 + wc * 32 + 8 * fq;
#pragma unroll
        for (int ai = 0; ai < 2; ++ai)
#pragma unroll
            for (int m = 0; m < 4; ++m) { const int row = row0 + ai * 128 + m * 16; const size_t off = (size_t)row * 2048 + col0; float s = 0.f;
#pragma unroll
                for (int bj = 0; bj < 2; ++bj) { const f32x4 a = *(const GAS f32x4*)(x + off + bj * 128) + acc[ai][bj][m][0], b = *(const GAS f32x4*)(x + off + bj * 128 + 4) + acc[ai][bj][m][1];
                    s += (a[0] * a[0] + a[1] * a[1]) + (a[2] * a[2] + a[3] * a[3]) + (b[0] * b[0] + b[1] * b[1]) + (b[2] * b[2] + b[3] * b[3]);
                    *(GAS u32x4*)(h2b + off + bj * 128) = pack8(a, b); }
                s += __shfl_xor(s, 16); s += __shfl_xor(s, 32);
                if (fq == 0) ssq2[(size_t)(u.pn * 4 + wc) * MREAL + row] = s; }
    }
};
struct EpiP7 {
    static constexpr bool PERM = true, HAS_PRE = true;
    const float* ssq2; _Float16* sc;
    __device__ __forceinline__ void pre(const Unit& u, LAS float* sc, int tid) const { if (tid < 256) sc[tid] = rstd_slabs<32, MREAL>(ssq2, u.pm * 256 + tid, 1.f / 2048.f); }
    __device__ __forceinline__ void operator()(const f32x4 (&acc)[2][2][4][2], const Unit& u, int wr, int wc, int fr, int fq, const LAS float* rowsc) const {
        typedef _Float16 h4_t __attribute__((ext_vector_type(4)));
        const int row0 = u.pm * 256 + wr * 64 + fr, col0 = u.pn * 256 + wc * 32 + 8 * fq;
#pragma unroll
        for (int ai = 0; ai < 2; ++ai)
#pragma unroll
            for (int m = 0; m < 4; ++m) { const int row = row0 + ai * 128 + m * 16; const float rs = rowsc[ai * 128 + wr * 64 + m * 16 + fr]; const size_t off = (size_t)row * 2048 + col0;
#pragma unroll
                for (int bj = 0; bj < 2; ++bj) { const h4_t lo = __builtin_convertvector(acc[ai][bj][m][0] * rs, h4_t), hi = __builtin_convertvector(acc[ai][bj][m][1] * rs, h4_t);
                    const u32x2 wl = __builtin_bit_cast(u32x2, lo), wh = __builtin_bit_cast(u32x2, hi);
                    *(GAS u32x4*)(sc + off + bj * 128) = (u32x4){wl.x, wl.y, wh.x, wh.y}; } }
    }
};
namespace att {
constexpr float L2E = 1.4426950408889634f;
constexpr int NW = 8, QBLK = 32, KVBLK = 64;
constexpr float MLA_SCALE = 0.07216878364870322f;
constexpr int K8S = 208, V8S = 80, SHM8_K = 64 * K8S, SHM8_V = 128 * V8S;
constexpr int OFF8_K = 0, OFF8_V = 2 * SHM8_K, OFF8_WS = OFF8_V + 2 * SHM8_V, MLA8_LDS = OFF8_WS + NW * 64 * 4;
constexpr float MLA8_THR = 1.9f;
typedef int a8_t __attribute__((ext_vector_type(8)));
#define MFMA8Z(acc_, a_, b_, sa_, sb_) asm volatile("s_nop 1\n\tv_mfma_scale_f32_32x32x64_f8f6f4 %0, %1, %2, 0, %3, %4 op_sel_hi:[0,0,0]" : "=&v"(acc_) : "v"(a_), "v"(b_), "v"(sa_), "v"(sb_))
#define MFMA8(acc_, a_, b_, sa_, sb_) asm volatile("s_nop 1\n\tv_mfma_scale_f32_32x32x64_f8f6f4 %0, %1, %2, %0, %3, %4 op_sel_hi:[0,0,0]" : "+v"(acc_) : "v"(a_), "v"(b_), "v"(sa_), "v"(sb_))
#define CAT8(lo_, hi_) __builtin_bit_cast(a8_t, __builtin_shufflevector(lo_, hi_, 0, 1, 2, 3, 4, 5, 6, 7))
__device__ __forceinline__ a8_t ld_frag8(const LAS char* p) { const u32x4 lo = *(const LAS u32x4*)p, hi = *(const LAS u32x4*)(p + 16); return CAT8(lo, hi); }
__device__ __forceinline__ void qkt8(f32x16& p0, f32x16& p1, const LAS char* Kb, const a8_t& q0, const a8_t& q1, const a8_t& q2, int s1) {
  { const a8_t a0 = ld_frag8(Kb), a1 = ld_frag8(Kb + 32 * K8S); MFMA8Z(p0, a0, q0, s1, s1); MFMA8Z(p1, a1, q0, s1, s1); }
  { const a8_t a0 = ld_frag8(Kb + 64), a1 = ld_frag8(Kb + 32 * K8S + 64); MFMA8(p0, a0, q1, s1, s1); MFMA8(p1, a1, q1, s1, s1); }
  { const a8_t a0 = ld_frag8(Kb + 128), a1 = ld_frag8(Kb + 32 * K8S + 128); MFMA8(p0, a0, q2, s1, s1); MFMA8(p1, a1, q2, s1, s1); }
  asm volatile("s_nop 15\n\ts_nop 15" : "+v"(p0), "+v"(p1));
}
__device__ __forceinline__ void partialSM8(f32x16& p0, f32x16& p1, float& m_reg, float& mn, float& alpha, const float C, const float THRS) {
  float pmax = p0[0];
#pragma unroll
  for (int r = 1; r < 16; ++r) pmax = fmaxf(pmax, p0[r]);
#pragma unroll
  for (int r = 0; r < 16; ++r) pmax = fmaxf(pmax, p1[r]);
  { auto rr = __builtin_amdgcn_permlane32_swap(__float_as_uint(pmax), __float_as_uint(pmax), false, false);
    pmax = fmaxf(__uint_as_float(rr[0]), __uint_as_float(rr[1])); }
  if (__builtin_expect(__all(pmax - m_reg <= THRS), 1)) { mn = m_reg; alpha = 1.f; }
  else { mn = fmaxf(m_reg, pmax); alpha = __builtin_amdgcn_exp2f((m_reg - mn) * C); m_reg = mn; }
  const float mnC = 6.f - mn * C;
#pragma unroll
  for (int r = 0; r < 16; ++r) p0[r] = fmaf(p0[r], C, mnC);
#pragma unroll
  for (int r = 0; r < 16; ++r) p1[r] = fmaf(p1[r], C, mnC);
#pragma unroll
  for (int r = 0; r < 16; ++r) p0[r] = __builtin_amdgcn_exp2f(p0[r]);
}
__device__ __forceinline__ void finishSM8(f32x16& p0, f32x16& p1, float alpha, float& l_reg, a8_t& pf) {
#pragma unroll
  for (int r = 0; r < 16; ++r) p1[r] = __builtin_amdgcn_exp2f(p1[r]);
  float ps = 0;
#pragma unroll
  for (int r = 0; r < 16; ++r) ps += p0[r];
#pragma unroll
  for (int r = 0; r < 16; ++r) ps += p1[r];
  { auto rr = __builtin_amdgcn_permlane32_swap(__float_as_uint(ps), __float_as_uint(ps), false, false);
    ps = __uint_as_float(rr[0]) + __uint_as_float(rr[1]); }
  l_reg = l_reg * alpha + ps;
#pragma unroll
  for (int w = 0; w < 4; ++w) { int x = 0, y = 0;
    x = __builtin_amdgcn_cvt_pk_fp8_f32(p0[4 * w], p0[4 * w + 1], x, false); x = __builtin_amdgcn_cvt_pk_fp8_f32(p0[4 * w + 2], p0[4 * w + 3], x, true);
    y = __builtin_amdgcn_cvt_pk_fp8_f32(p1[4 * w], p1[4 * w + 1], y, false); y = __builtin_amdgcn_cvt_pk_fp8_f32(p1[4 * w + 2], p1[4 * w + 3], y, true);
    pf[w] = x; pf[4 + w] = y; }
}
__device__ __forceinline__ void pv8(f32x16* o, const LAS char* Vb, const a8_t& pf, int sP, int s1) {
  const a8_t b0 = ld_frag8(Vb), b1 = ld_frag8(Vb + 32 * V8S), b2 = ld_frag8(Vb + 64 * V8S), b3 = ld_frag8(Vb + 96 * V8S);
  MFMA8(o[0], pf, b0, sP, s1); MFMA8(o[1], pf, b1, sP, s1); MFMA8(o[2], pf, b2, sP, s1); MFMA8(o[3], pf, b3, sP, s1);
  asm volatile("s_nop 15\n\ts_nop 15" : "+v"(o[0]), "+v"(o[1]), "+v"(o[2]), "+v"(o[3]));
}
__device__ __forceinline__ void mla_unit8(int b, int h, int qb, const unsigned char* __restrict__ QM8, const unsigned char* __restrict__ KN8, const unsigned char* __restrict__ KR8, const unsigned char* __restrict__ VT8,
                                          unsigned char* __restrict__ OM, LAS char* lds, Conv& cv) {
  const int tid = threadIdx.x, wid = tid >> 6, lane = tid & 63, r32 = lane & 31, hi = lane >> 5;
  constexpr float C = MLA_SCALE * L2E, THRS = MLA8_THR / MLA_SCALE;
  constexpr int NT = 33;
  LAS char* K_lds = lds + OFF8_K; LAS char* V_lds = lds + OFF8_V;
  LAS float* ws = (LAS float*)(lds + OFF8_WS) + wid * 64; LAS float* li_l = ws; LAS float* al_l = ws + 32;
  int s1 = 0x7f7f7f7f, sP = 0x79797979; asm volatile("" : "+v"(s1), "+v"(sP));
  float m_reg = -1e30f, l_reg = 0; f32x16 o[4] = {};
  const int qrow = b * SEQ + qb * 256 + wid * QBLK + r32;
  a8_t q0, q1, q2;
  { const unsigned char* Qw = QM8 + (size_t)qrow * 3072 + h * 192 + hi * 32;
    const u32x4 a = *(const GAS u32x4*)Qw, bq = *(const GAS u32x4*)(Qw + 16), c = *(const GAS u32x4*)(Qw + 64), d = *(const GAS u32x4*)(Qw + 80), e = *(const GAS u32x4*)(Qw + 128), f = *(const GAS u32x4*)(Qw + 144);
    q0 = CAT8(a, bq); q1 = CAT8(c, d); q2 = CAT8(e, f); }
  __syncthreads();
  const int kkey = tid >> 3, kch = tid & 7, rkey = (tid >> 2) & 63, rch = tid & 3, vdim = tid >> 2, vch = tid & 3;
  const LAS char* Kf = K_lds + r32 * K8S + 32 * hi; const LAS char* Vf = V_lds + r32 * V8S + 32 * hi;
  const unsigned offk = (unsigned)(kkey * 2048 + kch * 16), offr = (unsigned)(rkey * 64 + rch * 16), offv = (unsigned)(vdim * MPAD + vch * 16);
  u32x4 kA, rA, vA, kB, rB, vB;
  const int realbase = b * SEQ - KVBLK;
#define TROW(t) ((t) == 0 ? MREAL : realbase + (t) * KVBLK)
#define SLOADX(t, K_, R_, V_) do { const int k0_ = TROW(t); \
    K_ = *(const GAS u32x4*)(KN8 + ((size_t)k0_ * 2048 + h * 128) + offk); \
    R_ = *(const GAS u32x4*)(KR8 + (size_t)k0_ * 64 + offr); \
    V_ = *(const GAS u32x4*)(VT8 + ((size_t)h * 128 * MPAD + k0_) + offv); } while (0)
#define SWRITEX(bf, K_, R_, V_) do { *(LAS u32x4*)(K_lds + (bf) * SHM8_K + kkey * K8S + kch * 16) = K_; if (tid < 256) *(LAS u32x4*)(K_lds + (bf) * SHM8_K + rkey * K8S + 128 + rch * 16) = R_; \
    *(LAS u32x4*)(V_lds + (bf) * SHM8_V + vdim * V8S + vch * 16) = V_; } while (0)
#define CONV_HOOK() do { cvi = false; if ((cv.tick++ & 3) == 0) { int lane_ = lane; asm volatile("" : "+v"(lane_));     \
      if (cv.pend >= 0) { asm volatile("s_waitcnt vmcnt(6)" ::: "memory"); conv_finish(cv, cv.pend, lane_); cv.pend = -1; asm volatile("s_waitcnt lgkmcnt(0)" ::: "memory"); } \
      if (cv.next < cv.end) { conv_issue(cv, cv.next, lane_); cv.pend = cv.next; cv.next += cv.stride; cvi = true; } } } while (0)
#define WAITX(nl) do { const int n_ = (nl) + ((cvi || cvp) ? 8 : 0); \
    if (n_ == 11) asm volatile("s_waitcnt vmcnt(11)" ::: "memory"); else if (n_ == 8) asm volatile("s_waitcnt vmcnt(8)" ::: "memory"); \
    else if (n_ == 3) asm volatile("s_waitcnt vmcnt(3)" ::: "memory"); else asm volatile("s_waitcnt vmcnt(0)" ::: "memory"); } while (0)
#define SWAIT0() asm volatile("s_waitcnt vmcnt(0)" ::: "memory")
#define RESC(a) do { if (__any((a) < 1.f)) { if (hi == 0) al_l[r32] = (a); asm volatile("s_waitcnt lgkmcnt(0)" ::: "memory"); \
    _Pragma("unroll") for (int d = 0; d < 4; ++d) _Pragma("unroll") for (int r = 0; r < 16; ++r) o[d][r] *= al_l[crow(r, hi)]; } } while (0)
  f32x16 pA0, pA1, pB0, pB1; float mnA, mnB, alA, alB; a8_t pf = {}; bool cvi = false, cvp = false;
#define QK_FIN(N0, N1, KB, O0, O1, AL) do { float ps_ = 0.f; \
    a8_t fa_ = ld_frag8(KB), fb_ = ld_frag8((KB) + 32 * K8S);        \
    MFMA8Z(N0, fa_, q0, s1, s1); _Pragma("unroll") for (int r = 0; r < 8; ++r) O1[r] = __builtin_amdgcn_exp2f(O1[r]); SBAR(); \
    MFMA8Z(N1, fb_, q0, s1, s1); fa_ = ld_frag8((KB) + 64); _Pragma("unroll") for (int r = 8; r < 16; ++r) O1[r] = __builtin_amdgcn_exp2f(O1[r]); SBAR(); \
    MFMA8(N0, fa_, q1, s1, s1); fb_ = ld_frag8((KB) + 32 * K8S + 64); _Pragma("unroll") for (int r = 0; r < 16; ++r) ps_ += O0[r]; SBAR(); \
    MFMA8(N1, fb_, q1, s1, s1); fa_ = ld_frag8((KB) + 128); _Pragma("unroll") for (int r = 0; r < 16; ++r) ps_ += O1[r]; \
      { auto rr = __builtin_amdgcn_permlane32_swap(__float_as_uint(ps_), __float_as_uint(ps_), false, false); ps_ = __uint_as_float(rr[0]) + __uint_as_float(rr[1]); } l_reg = l_reg * (AL) + ps_; SBAR(); \
    MFMA8(N0, fa_, q2, s1, s1); fb_ = ld_frag8((KB) + 32 * K8S + 128); _Pragma("unroll") for (int w = 0; w < 4; ++w) { int x = pf[w]; x = __builtin_amdgcn_cvt_pk_fp8_f32(O0[4 * w], O0[4 * w + 1], x, false); x = __builtin_amdgcn_cvt_pk_fp8_f32(O0[4 * w + 2], O0[4 * w + 3], x, true); pf[w] = x; } SBAR();        \
    MFMA8(N1, fb_, q2, s1, s1); _Pragma("unroll") for (int w = 0; w < 4; ++w) { int y = pf[4 + w]; y = __builtin_amdgcn_cvt_pk_fp8_f32(O1[4 * w], O1[4 * w + 1], y, false); y = __builtin_amdgcn_cvt_pk_fp8_f32(O1[4 * w + 2], O1[4 * w + 3], y, true); pf[4 + w] = y; } SBAR(); \
  } while (0)
#define PV_PART(VB, N0, N1, MN, AL) do { \
    a8_t va_ = ld_frag8(VB), vb_ = ld_frag8((VB) + 32 * V8S); \
    MFMA8(o[0], pf, va_, sP, s1); asm volatile("s_nop 15\n\ts_nop 15" : "+v"(N0), "+v"(N1));      \
      float pmax_ = N0[0]; _Pragma("unroll") for (int r = 1; r < 16; ++r) pmax_ = fmaxf(pmax_, N0[r]); SBAR(); \
    MFMA8(o[1], pf, vb_, sP, s1); va_ = ld_frag8((VB) + 64 * V8S); _Pragma("unroll") for (int r = 0; r < 16; ++r) pmax_ = fmaxf(pmax_, N1[r]); \
      { auto rr = __builtin_amdgcn_permlane32_swap(__float_as_uint(pmax_), __float_as_uint(pmax_), false, false); pmax_ = fmaxf(__uint_as_float(rr[0]), __uint_as_float(rr[1])); } \
      if (__builtin_expect(__all(pmax_ - m_reg <= THRS), 1)) { MN = m_reg; AL = 1.f; } else { MN = fmaxf(m_reg, pmax_); AL = __builtin_amdgcn_exp2f((m_reg - MN) * C); m_reg = MN; } SBAR(); \
    MFMA8(o[2], pf, va_, sP, s1); vb_ = ld_frag8((VB) + 96 * V8S); { const float mnC_ = 6.f - MN * C; _Pragma("unroll") for (int r = 0; r < 16; ++r) { N0[r] = fmaf(N0[r], C, mnC_); N1[r] = fmaf(N1[r], C, mnC_); } } SBAR(); \
    MFMA8(o[3], pf, vb_, sP, s1); _Pragma("unroll") for (int r = 0; r < 16; ++r) N0[r] = __builtin_amdgcn_exp2f(N0[r]); SBAR(); \
    asm volatile("s_nop 15\n\ts_nop 15" : "+v"(o[0]), "+v"(o[1]), "+v"(o[2]), "+v"(o[3])); } while (0)
  SLOADX(0, kA, rA, vA); SWAIT0(); SWRITEX(0, kA, rA, vA); __syncthreads();
  qkt8(pA0, pA1, Kf, q0, q1, q2, s1);
  { const float NEG = -INFINITY;
#pragma unroll
    for (int r = 8; r < 16; ++r) pA0[r] = NEG;
#pragma unroll
    for (int r = 0; r < 16; ++r) pA1[r] = NEG; }
  partialSM8(pA0, pA1, m_reg, mnA, alA, C, THRS);
  SLOADX(1, kA, rA, vA); SWAIT0(); SWRITEX(1, kA, rA, vA);
  SLOADX(2, kA, rA, vA);
  __syncthreads();
  for (int j = 1; j + 1 < NT; j += 2) {
    SBAR(); QK_FIN(pB0, pB1, Kf + SHM8_K, pA0, pA1, alA);
    const bool l1 = j + 2 < NT; if (l1) SLOADX(j + 2, kB, rB, vB); CONV_HOOK(); SBAR();
    PV_PART(Vf, pB0, pB1, mnB, alB);
    __syncthreads(); WAITX(l1 ? 3 : 0); SWRITEX(0, kA, rA, vA); cvp = cvi;
    RESC(alB); __syncthreads();
    SBAR(); QK_FIN(pA0, pA1, Kf, pB0, pB1, alB);
    const bool l2 = j + 3 < NT; if (l2) SLOADX(j + 3, kA, rA, vA); CONV_HOOK(); SBAR();
    PV_PART(Vf + SHM8_V, pA0, pA1, mnA, alA);
    __syncthreads(); if (l1) { WAITX(l2 ? 3 : 0); SWRITEX(1, kB, rB, vB); } cvp = cvi;
    RESC(alA); __syncthreads();
  }
  finishSM8(pA0, pA1, alA, l_reg, pf); SBAR();
  pv8(o, Vf, pf, sP, s1);
  if (hi == 0) li_l[r32] = l_reg; asm volatile("s_waitcnt lgkmcnt(0)" ::: "memory");
  float rli[16];
#pragma unroll
  for (int r = 0; r < 16; ++r) rli[r] = __builtin_amdgcn_rcpf(li_l[crow(r, hi)]) * (64.f * 32.f);
  unsigned char* Ow = OM + (size_t)(b * SEQ + qb * 256 + wid * QBLK) * 2048 + h * 128;
#pragma unroll
  for (int r = 0; r < 16; ++r) { const int orow = crow(r, hi);
#pragma unroll
    for (int d0 = 0; d0 < 4; ++d0) Ow[(size_t)orow * 2048 + d0 * 32 + r32] = f32_to_fp8(o[d0][r] * rli[r]); }
#undef TROW
#undef SLOADX
#undef SWRITEX
#undef WAITX
#undef SWAIT0
#undef QK_FIN
#undef PV_PART
#undef RESC
#undef CONV_HOOK
}
__device__ __forceinline__ void na_task(int task, const unsigned char* __restrict__ NAQ, const unsigned char* __restrict__ NAK, const unsigned char* __restrict__ VT, unsigned char* __restrict__ ONA,
                                        const LAS float* relb, const LAS float* metab, LAS float* wsf, int lane) {
  const int r32 = lane & 31, hi = lane >> 5;
  const int half = task & 1, r = (task >> 1) & 31, h = (task >> 6) & 15, b = task >> 10;
  const int qc = half * 32 + r32;
  const int cs = min(max(qc - 8, 0), 48), rs = min(max(r - 4, 0), 24);
  const int qtok = b * SEQ + r * 64 + qc;
  constexpr float C = L2E, THRS = 1.9f, SCALE = 0.125f;
  int s1 = 0x7f7f7f7f, sP = 0x79797979; asm volatile("" : "+v"(s1), "+v"(sP));
  a8_t qf; { const unsigned char* qp = NAQ + (size_t)qtok * 1024 + h * 64 + hi * 32; const u32x4 a = *(const GAS u32x4*)qp, c = *(const GAS u32x4*)(qp + 16);
    qf = CAT8(a, c); }
  float m_reg = -1e30f, l_reg = 0.f; f32x16 o[2] = {};
  LAS float* al_l = wsf; LAS float* li_l = wsf + 32;
  const float NEG = -INFINITY;
  const int kb0 = half * 16;
  const unsigned long long wm = 0xFFFFull << (cs - kb0);
  const unsigned mh0 = (unsigned)wm >> (4 * hi), mh1 = (unsigned)(wm >> 32) >> (4 * hi);
  const unsigned char* kq = NAK + (size_t)r32 * 1024 + h * 64 + hi * 32;
  const unsigned char* kq2 = NAK + (size_t)(32 + (r32 & 15)) * 1024 + h * 64 + hi * 32;
  const unsigned char* vq = VT + (size_t)(h * 64 + r32) * VT_PITCH + 32 * hi;
#define NA_KTOK(w) ((w) == 8 ? MREAL : b * SEQ + (rs + (w)) * 64 + kb0)
#define NA_VOFF(w) ((w) == 8 ? MREAL : b * SEQ + (rs + (w)) * 64 + (kb0 >> 1))
#define NA_LOADK(KF, w) do { const size_t ko_ = (size_t)NA_KTOK(w) * 1024; KF[0] = *(const GAS u32x4*)(kq + ko_); KF[1] = *(const GAS u32x4*)(kq + ko_ + 16); KF[2] = *(const GAS u32x4*)(kq2 + ko_); KF[3] = *(const GAS u32x4*)(kq2 + ko_ + 16); } while (0)
#define NA_A8(x_, y_) CAT8(x_, y_)
#define NA_TILE(KF, wt, YN) do { \
    u32x4 va0, va1; u32x2 vb0_, vb1_; { const unsigned char* vp_ = vq + NA_VOFF(wt); va0 = *(const GAS u32x4*)vp_; vb0_ = *(const GAS u32x2*)(vp_ + 16); va1 = *(const GAS u32x4*)(vp_ + (size_t)32 * VT_PITCH); vb1_ = *(const GAS u32x2*)(vp_ + (size_t)32 * VT_PITCH + 16); } \
    f32x16 p0, p1; \
    { const a8_t k0_ = NA_A8(KF[0], KF[1]), k1_ = NA_A8(KF[2], KF[3]); MFMA8Z(p0, k0_, qf, s1, s1); MFMA8Z(p1, k1_, qf, s1, s1); asm volatile("s_nop 15\n\ts_nop 15" : "+v"(p0), "+v"(p1)); } \
    if ((wt) + 1 < 9) NA_LOADK(KF, (wt) + 1);            \
      \
    if ((wt) < 8) { const LAS float* bp_ = relb + ((h * 15 + (rs + (wt) - r + 7)) * 31 + 15 - qc + 4 * hi + kb0);     \
      float bv0[16], bv1[8];        \
      _Pragma("unroll") for (int rg = 0; rg < 16; ++rg) { const int c_ = (rg & 3) + 8 * (rg >> 2); bv0[rg] = bp_[c_]; if (rg < 8) bv1[rg] = bp_[c_ + 32]; } \
      _Pragma("unroll") for (int rg = 0; rg < 16; ++rg) { asm volatile("" : "+v"(bv0[rg])); if (rg < 8) asm volatile("" : "+v"(bv1[rg])); } \
      _Pragma("unroll") for (int rg = 0; rg < 16; ++rg) { const int c_ = (rg & 3) + 8 * (rg >> 2); \
        { const bool ok = (mh0 >> c_) & 1u; p0[rg] = ok ? fmaf(p0[rg], SCALE, bv0[rg]) : NEG; } \
        if (rg < 8) { const bool ok = (mh1 >> c_) & 1u; p1[rg] = ok ? fmaf(p1[rg], SCALE, bv1[rg]) : NEG; } } \
    } else { const LAS float* bp = metab + h * 16; \
      _Pragma("unroll") for (int rg = 0; rg < 16; ++rg) { const int kc = crow(rg, hi); p0[rg] = (rg < 8) ? fmaf(p0[rg], SCALE, bp[kc & 15]) : NEG; if (rg < 8) p1[rg] = NEG; } } \
      \
    float pmax = p0[0]; \
    _Pragma("unroll") for (int rg = 1; rg < 16; ++rg) pmax = fmaxf(pmax, p0[rg]); \
    _Pragma("unroll") for (int rg = 0; rg < 8; ++rg) pmax = fmaxf(pmax, p1[rg]); \
    { auto rr = __builtin_amdgcn_permlane32_swap(__float_as_uint(pmax), __float_as_uint(pmax), false, false); pmax = fmaxf(__uint_as_float(rr[0]), __uint_as_float(rr[1])); } \
    float mn, alpha; \
    if (__builtin_expect(__all(pmax - m_reg <= THRS), 1)) { mn = m_reg; alpha = 1.f; } \
    else { mn = fmaxf(m_reg, pmax); alpha = __builtin_amdgcn_exp2f((m_reg - mn) * C); m_reg = mn; } \
    const float mnC = 6.f - mn * C; float ps = 0.f;        \
    _Pragma("unroll") for (int rg = 0; rg < 16; ++rg) { p0[rg] = __builtin_amdgcn_exp2f(fmaf(p0[rg], C, mnC)); ps += p0[rg]; } \
    _Pragma("unroll") for (int rg = 0; rg < 8; ++rg) { p1[rg] = __builtin_amdgcn_exp2f(fmaf(p1[rg], C, mnC)); ps += p1[rg]; } \
    { auto rr = __builtin_amdgcn_permlane32_swap(__float_as_uint(ps), __float_as_uint(ps), false, false); ps = __uint_as_float(rr[0]) + __uint_as_float(rr[1]); } \
    l_reg = l_reg * alpha + ps; \
    a8_t pf;   \
    _Pragma("unroll") for (int w_ = 0; w_ < 4; ++w_) { int x = 0; x = __builtin_amdgcn_cvt_pk_fp8_f32(p0[4 * w_], p0[4 * w_ + 1], x, false); x = __builtin_amdgcn_cvt_pk_fp8_f32(p0[4 * w_ + 2], p0[4 * w_ + 3], x, true); pf[w_] = x; } \
    _Pragma("unroll") for (int w_ = 0; w_ < 2; ++w_) { int x = 0; x = __builtin_amdgcn_cvt_pk_fp8_f32(p1[4 * w_], p1[4 * w_ + 1], x, false); x = __builtin_amdgcn_cvt_pk_fp8_f32(p1[4 * w_ + 2], p1[4 * w_ + 3], x, true); pf[4 + w_] = x; } \
    pf[6] = 0; pf[7] = 0; \
    if (__any(alpha < 1.f)) { if (hi == 0) al_l[r32] = alpha; asm volatile("s_waitcnt lgkmcnt(0)" ::: "memory"); \
      _Pragma("unroll") for (int d = 0; d < 2; ++d) _Pragma("unroll") for (int rg = 0; rg < 16; ++rg) o[d][rg] *= al_l[crow(rg, hi)]; } \
    { const u32x4 z0_ = (u32x4){vb0_.x, vb0_.y, 0u, 0u}, z1_ = (u32x4){vb1_.x, vb1_.y, 0u, 0u}; const a8_t v0_ = CAT8(va0, z0_), v1_ = CAT8(va1, z1_); \
      MFMA8(o[0], pf, v0_, sP, s1); MFMA8(o[1], pf, v1_, sP, s1); asm volatile("s_nop 15\n\ts_nop 15" : "+v"(o[0]), "+v"(o[1])); } } while (0)
  { u32x4 kA[4];
    NA_LOADK(kA, 0);
#pragma unroll 1
    for (int w = 0; w < 8; ++w) { NA_TILE(kA, w, 12); }
    NA_TILE(kA, 8, 12); }
#undef NA_KTOK
#undef NA_VOFF
#undef NA_LOADK
#undef NA_A8
#undef NA_TILE
  if (hi == 0) li_l[r32] = l_reg; asm volatile("s_waitcnt lgkmcnt(0)" ::: "memory");
  unsigned char* Ow = ONA + (size_t)(b * SEQ + r * 64 + half * 32) * 1024 + h * 64;
#pragma unroll
  for (int rg = 0; rg < 16; ++rg) { const int orow = crow(rg, hi); const float rl = __builtin_amdgcn_rcpf(li_l[orow]) * (64.f * 16.f);
#pragma unroll
    for (int d0 = 0; d0 < 2; ++d0) Ow[(size_t)orow * 1024 + d0 * 32 + r32] = f32_to_fp8(o[d0][rg] * rl); }
  asm volatile("s_waitcnt lgkmcnt(0)" ::: "memory");
}
}
namespace peer {
constexpr int CH = 32;
constexpr int OFF_TV = 0, OFF_TI = OFF_TV + CH * 16 * 16 * 4, OFF_SE = OFF_TI + CH * 16 * 16 * 4, OFF_SG = OFF_SE + CH * 128 * 4, OFF_SE2 = OFF_SG + CH * 128 * 4, OFF_SG2 = OFF_SE2 + CH * 128 * 4, PEER_LDS = OFF_SG2 + CH * 128 * 4;
static_assert(PEER_LDS <= RING_BYTES, "PEER LDS");
__device__ __forceinline__ float gelu_tanh(float x) {
    const float u = 0.7978845608028654f * (x + 0.044715f * x * x * x);
    const float e = __builtin_amdgcn_exp2f(-2.f * 1.4426950408889634f * fabsf(u));
    const float t = (1.f - e) * __builtin_amdgcn_rcpf(1.f + e);
    return 0.5f * x * (1.f + (u < 0.f ? -t : t));
}
__device__ __forceinline__ void fmac1(float& acc, float a, float b) { asm("v_fmac_f32_e32 %0, %1, %2" : "+v"(acc) : "v"(a), "v"(b)); }
#define PEER_INSERT(x_, xi_) do { float x__ = (x_); int xi__ = (xi_); \
    _Pragma("unroll") for (int j_ = 0; j_ < 16; ++j_) { const bool gt_ = x__ > tv[j_]; const float tvo_ = tv[j_]; const int tio_ = ti[j_]; \
        tv[j_] = gt_ ? x__ : tvo_; ti[j_] = gt_ ? xi__ : tio_; x__ = gt_ ? tvo_ : x__; xi__ = gt_ ? tio_ : xi__; } } while (0)

#define PEER_AUX 0
typedef __amdgpu_buffer_rsrc_t rsrc_t;
__device__ __forceinline__ rsrc_t mk_rsrc(const void* p, unsigned bytes) { return __builtin_amdgcn_make_buffer_rsrc((void*)p, 0, bytes, 0x00020000); }
__device__ __forceinline__ u32x4 ldb128(rsrc_t r, unsigned off) { return __builtin_amdgcn_raw_buffer_load_b128(r, off, 0, PEER_AUX); }
typedef unsigned v6u_t __attribute__((ext_vector_type(6)));
typedef float v32f_t __attribute__((ext_vector_type(32)));
typedef float v16f_t __attribute__((ext_vector_type(16)));
__device__ __forceinline__ u32x2 ldb64(rsrc_t r, unsigned off) { return __builtin_amdgcn_raw_buffer_load_b64(r, off, 0, PEER_AUX); }
__device__ __forceinline__ f32x4 ldf128(rsrc_t r, unsigned off) { return __builtin_bit_cast(f32x4, __builtin_amdgcn_raw_buffer_load_b128(r, off, 0, PEER_AUX)); }
__device__ __forceinline__ f32x4 ldf128_nt(rsrc_t r, unsigned off) { return __builtin_bit_cast(f32x4, __builtin_amdgcn_raw_buffer_load_b128(r, off, 0, 2)); }
__device__ __forceinline__ void peer_select(int chunk, const _Float16* __restrict__ SC, LAS char* lds, int tid, LAS int* SE, LAS float* SG) {
    LAS float* TV = (LAS float*)(lds + OFF_TV); LAS int* TI = (LAS int*)(lds + OFF_TI);
    asm volatile("" : "+v"(tid));
    const int tok0 = chunk * CH;
    const rsrc_t rSC = mk_rsrc(SC, 0x4000000u);
    __syncthreads();
    { const int tl = tid >> 4, g = tid & 15; const unsigned spo = ((unsigned)(tok0 + tl) * 2048u + (unsigned)g * 128u) * 2u;
      int tk[16];
#pragma unroll
      for (int j = 0; j < 16; ++j) tk[j] = (int)0x80000000;
#define PEER_KEY(x_, lowbits_, mask_) ({ const int f_ = __float_as_int(x_); ((f_ ^ ((f_ >> 31) & 0x7fffffff)) & ~(mask_)) | (lowbits_); })
#define PEER_INS(key_) do { int x__ = (key_); _Pragma("unroll") for (int j_ = 0; j_ < 16; ++j_) { const int hi_ = max(x__, tk[j_]); x__ = min(x__, tk[j_]); tk[j_] = hi_; } } while (0)
      typedef _Float16 h8_t __attribute__((ext_vector_type(8)));
#define PEER_CX(a_, b_) do { const int hi_ = max(a_, b_), lo_ = min(a_, b_); a_ = hi_; b_ = lo_; } while (0)
      u32x4 na = __builtin_amdgcn_raw_buffer_load_b128(rSC, spo, 0, 2), nb = __builtin_amdgcn_raw_buffer_load_b128(rSC, spo + 16, 0, 2);
#pragma unroll 1
      for (int i = 0; i < 16; i += 2) { const h8_t a = __builtin_bit_cast(h8_t, na), b = __builtin_bit_cast(h8_t, nb);
          { const unsigned on = spo + (unsigned)min(i + 2, 14) * 16u; na = __builtin_amdgcn_raw_buffer_load_b128(rSC, on, 0, 2); nb = __builtin_amdgcn_raw_buffer_load_b128(rSC, on + 16, 0, 2); }
          int kk[16];
#pragma unroll
          for (int e = 0; e < 8; ++e) { kk[e] = PEER_KEY((float)a[e], 127 - (8 * i + e), 127); kk[8 + e] = PEER_KEY((float)b[e], 127 - (8 * i + 8 + e), 127); }
          PEER_CX(kk[0], kk[13]); PEER_CX(kk[1], kk[12]); PEER_CX(kk[2], kk[15]); PEER_CX(kk[3], kk[14]); PEER_CX(kk[4], kk[8]); PEER_CX(kk[5], kk[6]); PEER_CX(kk[7], kk[11]); PEER_CX(kk[9], kk[10]); PEER_CX(kk[0], kk[5]); PEER_CX(kk[1], kk[7]); PEER_CX(kk[2], kk[9]); PEER_CX(kk[3], kk[4]); PEER_CX(kk[6], kk[13]); PEER_CX(kk[8], kk[14]); PEER_CX(kk[10], kk[15]); PEER_CX(kk[11], kk[12]); PEER_CX(kk[0], kk[1]); PEER_CX(kk[2], kk[3]); PEER_CX(kk[4], kk[5]); PEER_CX(kk[6], kk[8]); PEER_CX(kk[7], kk[9]); PEER_CX(kk[10], kk[11]); PEER_CX(kk[12], kk[13]); PEER_CX(kk[14], kk[15]); PEER_CX(kk[0], kk[2]); PEER_CX(kk[1], kk[3]); PEER_CX(kk[4], kk[10]); PEER_CX(kk[5], kk[11]); PEER_CX(kk[6], kk[7]); PEER_CX(kk[8], kk[9]); PEER_CX(kk[12], kk[14]); PEER_CX(kk[13], kk[15]); PEER_CX(kk[1], kk[2]); PEER_CX(kk[3], kk[12]); PEER_CX(kk[4], kk[6]); PEER_CX(kk[5], kk[7]); PEER_CX(kk[8], kk[10]); PEER_CX(kk[9], kk[11]); PEER_CX(kk[13], kk[14]); PEER_CX(kk[1], kk[4]); PEER_CX(kk[2], kk[6]); PEER_CX(kk[5], kk[8]); PEER_CX(kk[7], kk[10]); PEER_CX(kk[9], kk[13]); PEER_CX(kk[11], kk[14]); PEER_CX(kk[2], kk[4]); PEER_CX(kk[3], kk[6]); PEER_CX(kk[9], kk[12]); PEER_CX(kk[11], kk[13]); PEER_CX(kk[3], kk[5]); PEER_CX(kk[6], kk[8]); PEER_CX(kk[7], kk[9]); PEER_CX(kk[10], kk[12]); PEER_CX(kk[3], kk[4]); PEER_CX(kk[5], kk[6]); PEER_CX(kk[7], kk[8]); PEER_CX(kk[9], kk[10]); PEER_CX(kk[11], kk[12]); PEER_CX(kk[6], kk[7]); PEER_CX(kk[8], kk[9]);
#pragma unroll
          for (int e = 0; e < 16; ++e) tk[e] = max(tk[e], kk[15 - e]);
          PEER_CX(tk[0], tk[8]); PEER_CX(tk[1], tk[9]); PEER_CX(tk[2], tk[10]); PEER_CX(tk[3], tk[11]); PEER_CX(tk[4], tk[12]); PEER_CX(tk[5], tk[13]); PEER_CX(tk[6], tk[14]); PEER_CX(tk[7], tk[15]); PEER_CX(tk[0], tk[4]); PEER_CX(tk[1], tk[5]); PEER_CX(tk[2], tk[6]); PEER_CX(tk[3], tk[7]); PEER_CX(tk[8], tk[12]); PEER_CX(tk[9], tk[13]); PEER_CX(tk[10], tk[14]); PEER_CX(tk[11], tk[15]); PEER_CX(tk[0], tk[2]); PEER_CX(tk[1], tk[3]); PEER_CX(tk[4], tk[6]); PEER_CX(tk[5], tk[7]); PEER_CX(tk[8], tk[10]); PEER_CX(tk[9], tk[11]); PEER_CX(tk[12], tk[14]); PEER_CX(tk[13], tk[15]); PEER_CX(tk[0], tk[1]); PEER_CX(tk[2], tk[3]); PEER_CX(tk[4], tk[5]); PEER_CX(tk[6], tk[7]); PEER_CX(tk[8], tk[9]); PEER_CX(tk[10], tk[11]); PEER_CX(tk[12], tk[13]); PEER_CX(tk[14], tk[15]); }
#undef PEER_CX
      LAS float* tvp = TV + (tl * 16 + g) * 16; LAS int* tip = TI + (tl * 16 + g) * 16;
#pragma unroll
      for (int j = 0; j < 16; ++j) { const int k_ = tk[j] & ~127; tvp[j] = __int_as_float(k_ ^ ((k_ >> 31) & 0x7fffffff)); tip[j] = 127 - (tk[j] & 127); } }
    __syncthreads();
    asm volatile("" : "+v"(tid));
    { const int tl = tid >> 4, hh = (tid >> 1) & 7, half = tid & 1;
      const LAS float* s1 = TV + (tl * 16 + 2 * hh) * 16; const LAS float* s2 = s1 + 16; const LAS int* i1 = TI + (tl * 16 + 2 * hh) * 16; const LAS int* i2 = i1 + 16;
      float b2[16];
#pragma unroll
      for (int j = 0; j < 16; ++j) b2[j] = s2[j];
      int tk[16];
#pragma unroll
      for (int j = 0; j < 16; ++j) tk[j] = (int)0x80000000;
#pragma unroll
      for (int ii = 0; ii < 8; ++ii) { const int i = 2 * ii + half; const float a = s1[i];
#pragma unroll
          for (int j = 0; j < 16; ++j) if ((2 * ii + 1) * (j + 1) <= 16) { if (half == 0 || (2 * ii + 2) * (j + 1) <= 16) PEER_INS(PEER_KEY(a + b2[j], 255 - (i * 16 + j), 255)); } }
      { int pk[16];
#pragma unroll
        for (int j = 0; j < 16; ++j) pk[j] = __shfl_xor(tk[j], 1);
#pragma unroll
        for (int j = 0; j < 16; ++j) PEER_INS(pk[j]); }
      if (half == 0) { float e[16], sum = 0.f; const int k0_ = tk[0] & ~255; const float v0 = __int_as_float(k0_ ^ ((k0_ >> 31) & 0x7fffffff));
#pragma unroll
        for (int j = 0; j < 16; ++j) { const int k_ = tk[j] & ~255; const float vj = __int_as_float(k_ ^ ((k_ >> 31) & 0x7fffffff)); e[j] = __builtin_amdgcn_exp2f((vj - v0) * 1.4426950408889634f); sum += e[j]; }
        const float inv = 1.0f / sum;
#pragma unroll
        for (int j = 0; j < 16; ++j) { const int ci = 255 - (tk[j] & 255); SE[tl * 128 + hh * 16 + j] = i1[ci >> 4] * 128 + i2[ci & 15]; SG[tl * 128 + hh * 16 + j] = e[j] * inv; } } }
#undef PEER_KEY
#undef PEER_INS
    __syncthreads();
}
__device__ __forceinline__ void peer_gather(int chunk, const bf16_t* __restrict__ H2, const unsigned char* __restrict__ U, const unsigned char* __restrict__ V,
                                            const float* __restrict__ g2, const float* __restrict__ gf, float* OUT, int tid, const LAS int* SE, const LAS float* SG) {
    asm volatile("" : "+v"(tid));
    const int tok0 = chunk * CH, lane = tid & 63, wave = tid >> 6;
    const rsrc_t rH2 = mk_rsrc(H2, 0x4000000u), rU = mk_rsrc(U, 0x1000000u), rV = mk_rsrc(V, 0x1000000u), rG2 = mk_rsrc(g2, 8192u), rGF = mk_rsrc(gf, 8192u);
#pragma unroll 1
    for (int tt = 0; tt < CH / NWAVES; ++tt) { const int tl = wave * (CH / NWAVES) + tt, tok = tok0 + tl;
      asm volatile("" ::: "memory");
      float hn[32]; float ss = 0.f;
#pragma unroll
      for (int j = 0; j < 2; ++j)
#pragma unroll
          for (int q = 0; q < 4; ++q) { const u32x2 w = ldb64(rH2, ((unsigned)tok * 2048u + 256u * (4 * j + q) + 4u * lane) * 2u);
              const f32x4 a = (f32x4){__uint_as_float(w.x << 16), __uint_as_float(w.x & 0xffff0000u), __uint_as_float(w.y << 16), __uint_as_float(w.y & 0xffff0000u)};
#pragma unroll
              for (int i = 0; i < 4; ++i) { hn[16 * j + 4 * q + i] = a[i]; ss += a[i] * a[i]; } }
      const float rstd = 1.0f / sqrtf(wave_sum(ss) * (1.f / 2048.f) + NORM_EPS);
#pragma unroll
      for (int j = 0; j < 2; ++j)
#pragma unroll
          for (int q = 0; q < 4; ++q) { const f32x4 a = ldf128(rG2, (256u * (4 * j + q) + 4u * lane) * 4u);
#pragma unroll
              for (int i = 0; i < 4; ++i) hn[16 * j + 4 * q + i] *= rstd * a[i]; }
      typedef _Float16 h2_t __attribute__((ext_vector_type(2)));
      h2_t hn16[16]; f32x2 accp[16];
#pragma unroll
      for (int k = 0; k < 16; ++k) { hn16[k] = (h2_t){(_Float16)hn[2 * k], (_Float16)hn[2 * k + 1]}; accp[k] = (f32x2){0.f, 0.f}; }
#define NX 4
#define PEER_LOAD(S, kb) do { _Pragma("unroll") for (int x = 0; x < NX; ++x) { const unsigned o = (unsigned)SE[tl * 128 + (kb) + x] * 1024u + (unsigned)lane * 16u; \
          S##u[x] = ldb128(rU, o); S##v[x] = ldb128(rV, o); } } while (0)
#define PEER_DU(W, k) dd = __builtin_amdgcn_fdot2(__builtin_amdgcn_cvt_scalef32_pk_f16_fp4(W[(k) >> 2], 1.0f, (k) & 3), hn16[k], dd, false);
#define PEER_DV(W, k) accp[k] = __builtin_elementwise_fma(__builtin_amdgcn_cvt_scalef32_pk_f32_fp4(W[(k) >> 2], 1.0f, (k) & 3), c2, accp[k]);
#define PEER_16(M, W) M(W, 0) M(W, 1) M(W, 2) M(W, 3) M(W, 4) M(W, 5) M(W, 6) M(W, 7) M(W, 8) M(W, 9) M(W, 10) M(W, 11) M(W, 12) M(W, 13) M(W, 14) M(W, 15)
#define PEER_COMPUTE(S, kb) do { float d[NX]; \
          _Pragma("unroll") for (int x = 0; x < NX; ++x) { const u32x4 W = S##u[x]; float dd = 0.f; PEER_16(PEER_DU, W) d[x] = dd; } \
          _Pragma("unroll") for (int o = 1; o < 64; o <<= 1) { _Pragma("unroll") for (int x = 0; x < NX; ++x) d[x] += __shfl_xor(d[x], o); } \
          float c[NX]; \
          _Pragma("unroll") for (int x = 0; x < NX; ++x) c[x] = SG[tl * 128 + (kb) + x] * gelu_tanh(d[x] * (1.f / PEER_U_SCALE)) * (1.f / PEER_V_SCALE); \
          _Pragma("unroll") for (int x = 0; x < NX; ++x) { const u32x4 W = S##v[x]; const f32x2 c2 = (f32x2){c[x], c[x]}; PEER_16(PEER_DV, W) } } while (0)
      { u32x4 Au[NX], Av[NX], Bu[NX], Bv[NX];
        PEER_LOAD(A, 0);
#pragma unroll 1
        for (int k = 0; k < 128; k += 2 * NX) {
            PEER_LOAD(B, k + NX); PEER_COMPUTE(A, k);
            { const int kn = min(k + 2 * NX, 128 - NX); PEER_LOAD(A, kn); }
            PEER_COMPUTE(B, k + NX);
        } }
#undef PEER_DU
#undef PEER_DV
#undef PEER_16
#undef NX
#undef PEER_LOAD
#undef PEER_COMPUTE
      asm volatile("" ::: "memory");
      int tok2 = tok, lane2 = lane; asm volatile("" : "+v"(tok2), "+v"(lane2));
      float s2 = 0.f;
#pragma unroll
      for (int j = 0; j < 2; ++j)
#pragma unroll
          for (int q = 0; q < 4; ++q) { const u32x2 w = ldb64(rH2, ((unsigned)tok2 * 2048u + 256u * (4 * j + q) + 4u * lane2) * 2u);
              const f32x4 a = (f32x4){__uint_as_float(w.x << 16), __uint_as_float(w.x & 0xffff0000u), __uint_as_float(w.y << 16), __uint_as_float(w.y & 0xffff0000u)};
#pragma unroll
              for (int i = 0; i < 4; ++i) { const int e_ = 16 * j + 4 * q + i; accp[e_ >> 1][e_ & 1] += a[i]; s2 += accp[e_ >> 1][e_ & 1] * accp[e_ >> 1][e_ & 1]; } }
      const float rf = 1.0f / sqrtf(wave_sum(s2) * (1.f / 2048.f) + NORM_EPS);
#pragma unroll
      for (int j = 0; j < 2; ++j)
#pragma unroll
          for (int q = 0; q < 4; ++q) { const f32x4 a = ldf128(rGF, (256u * (4 * j + q) + 4u * lane2) * 4u); f32x4 oa;
#pragma unroll
              for (int i = 0; i < 4; ++i) { const int e_ = 16 * j + 4 * q + i; oa[i] = accp[e_ >> 1][e_ & 1] * rf * a[i]; }
              float* op = OUT + (size_t)tok2 * 2048 + 256 * (4 * j + q) + 4 * lane2;
              __builtin_nontemporal_store(oa, (GAS f32x4*)op); }
    }
}
}
#ifndef MK_N_LAUNCHES
#define MK_N_LAUNCHES 1
#endif
#define MK_PROBE_PH -1
#define MK_PROBE_DIV 2
constexpr int N_PHASES = 9;
constexpr int N_LAUNCHES = MK_N_LAUNCHES;
struct Args { const float* in[19]; float* out; unsigned char* ws; int ph_lo, ph_hi; };
static_assert(sizeof(Args) == 19 * 8 + 8 + 8 + 8, "no padding");

__global__ void __launch_bounds__(NWAVES * 64, 2) hybrid_fwd(Args args) {
    extern __shared__ __attribute__((aligned(16))) unsigned char lds_raw[];
    Frame F;
    F.lds = (LAS unsigned char*)lds_raw;
    F.MISC = (volatile LAS unsigned*)(F.lds + MISC_OFF);
    F.tid = threadIdx.x; F.lane = F.tid & 63; F.wave = __builtin_amdgcn_readfirstlane(F.tid >> 6);
    F.G = gridDim.x; { const int bx = blockIdx.x; F.vcu = (F.G % 8 == 0) ? (bx % 8) * (F.G / 8) + bx / 8 : bx; }
    F.ws = args.ws; F.out = args.out;
#pragma unroll
    for (int i = 0; i < 19; ++i) F.in[i] = args.in[i];
    for (int u = F.tid; u < (LDS_BYTES - LDSCTL_OFF) / 4; u += NWAVES * 64) ((LAS unsigned*)(F.lds + LDSCTL_OFF))[u] = 0u;
    __syncthreads();
    XcdBarrier bar; bar.bar = (unsigned*)(F.ws + WS_CTL) + CW_BAR; bar.x = 0; bar.st = nullptr;
    if (N_LAUNCHES == 1) bar = xcd_barrier_post((unsigned*)(F.ws + WS_CTL) + CW_BAR, F.MISC + 8);
    const int lo = args.ph_lo, hi = args.ph_hi;
#define IN(k) (lo <= (k) && (k) < hi)
#if MK_PROBE_PH >= 0
    unsigned long long tp0 = (MK_PROBE_PH == 0 || MK_PROBE_PH == 9) ? __builtin_amdgcn_s_memrealtime() : 0ull, tp1 = 0ull;
#define SEAM(k) do { if (IN(k) && IN((k) + 1)) xcd_barrier(bar); if (MK_PROBE_PH == (k)) tp1 = __builtin_amdgcn_s_memrealtime(); if (MK_PROBE_PH == (k) + 1) tp0 = __builtin_amdgcn_s_memrealtime(); } while (0)
#else
#define SEAM(k) do { if (IN(k) && IN((k) + 1)) xcd_barrier(bar); } while (0)
#endif
    const size_t T2048 = (size_t)256 * 2048 * 2, T1024 = (size_t)256 * 1024 * 2, T512 = (size_t)256 * 512 * 2;
    float* cosT = WSP(float, WS_COS); float* sinT = WSP(float, WS_SIN);
    float* ssq_q = WSP(float, WS_SSQ_Q); float* ssq_kv = WSP(float, WS_SSQ_KV); float* ssq2 = WSP(float, WS_SSQ_2);

    if (IN(0)) { p0_prologue<0>(F, F.vcu, F.G); } SEAM(0);
    if (IN(1)) {
        SchedP1 S{F.G, (int)blockIdx.x, (const char*)(F.ws + WS_HN1), (const char*)(F.ws + WS_WIN), (const char*)(F.ws + WS_WVT), T1024};
        EpiP1 E{WSP(unsigned char, WS_NAQ), WSP(unsigned char, WS_NAK), WSP(unsigned char, WS_VT), WSP(unsigned char, WS_CQ), WSP(unsigned char, WS_CKV), WSP(unsigned char, WS_KR), WSP(unsigned char, WS_GA), WSP(unsigned char, WS_GB), ssq_q, ssq_kv, cosT, sinT};
        pg8::gemm_phase<EpiP1, SchedP1, true, -6>(F.lds, 2048, S, E);
        { const int extra = P1_UNITS % F.G, bx = (int)blockIdx.x; if (extra != 0 && bx >= extra) p0_prologue<1>(F, bx - extra, F.G - extra); else if (extra == 0) p0_prologue<1>(F, bx, F.G); }
    } SEAM(1);
    if (IN(2)) {
        LAS float* relb = (LAS float*)F.lds + 64; LAS float* metab = relb + 16 * 15 * 31 + 128; LAS float* wsf = metab + 256 + F.wave * 64;
        for (int i = F.tid; i < 16 * 15 * 31; i += NWAVES * 64) relb[i] = F.in[4][i];
        if (F.tid < 256) metab[F.tid] = F.in[5][F.tid];
        __syncthreads();
        const int gw = F.vcu * NWAVES + F.wave, NGW = F.G * NWAVES;
        for (int task = gw; task < NBATCH * 16 * 32 * 2; task += NGW)
            att::na_task(task, WSP(unsigned char, WS_NAQ), WSP(unsigned char, WS_NAK), WSP(unsigned char, WS_VT), WSP(unsigned char, WS_ONA), relb, metab, wsf, F.lane);
        __syncthreads();
    }
    if (IN(3)) {
        SchedP3 S{F.G, (int)blockIdx.x, (const char*)F.ws, T512 / 2};
        EpiP3 E{WSP(unsigned char, WS_QM), WSP(unsigned char, WS_KN), WSP(unsigned char, WS_VV), ssq_q, ssq_kv, cosT, sinT};
        pg8::gemm_phase<EpiP3, SchedP3, true, -4>(F.lds, 512, S, E);
    } SEAM(3);
    if (IN(4)) {
        const int gw = F.vcu * NWAVES + F.wave, NGW = F.G * NWAVES;
        Conv cv{F.in[16], F.in[17], WSP(unsigned char, WS_U), WSP(unsigned char, WS_V), F.lds + 65536 + F.wave * 8192, gw, NGW, 2 * 16384, -1, 0};
        for (int id = F.vcu; id < NBATCH * 16 * 8; id += F.G) { const int bh = id >> 3, qb = id & 7;
            att::mla_unit8(bh >> 4, bh & 15, qb, WSP(unsigned char, WS_QM), WSP(unsigned char, WS_KN), WSP(unsigned char, WS_KR), WSP(unsigned char, WS_VV), WSP(unsigned char, WS_OMLA), (LAS char*)F.lds, cv); }
        while (cv.pend >= 0 || cv.next < cv.end) conv_step<0>(cv, F.lane);
        __syncthreads();
    } SEAM(4);
    if (IN(5)) {
        { SchedGrid S{F.G, (int)blockIdx.x, 64, 8, (const char*)(F.ws + WS_ONA), (const char*)(F.ws + WS_WNA), T512};
          EpiP5a E{WSP(unsigned char, WS_GA), WSP(unsigned char, WS_T1)};
          pg8::gemm_phase<EpiP5a, SchedGrid, true, -9>(F.lds, 1024, S, E); }
        { SchedGrid S{F.G, (int)blockIdx.x, 64, 8, (const char*)(F.ws + WS_OMLA), (const char*)(F.ws + WS_WMLA), T1024};
          EpiP5b E{WSP(unsigned char, WS_GB), WSP(unsigned char, WS_T1), WSP(unsigned char, WS_MERGED)};
          pg8::gemm_phase<EpiP5b, SchedGrid, true, -11>(F.lds, 2048, S, E); }
    } SEAM(5);
    if (IN(6)) {
        { SchedGrid S{F.G, (int)blockIdx.x, 64, 8, (const char*)(F.ws + WS_MERGED), (const char*)(F.ws + WS_WOUT), T1024};
          EpiP6 E{F.in[0], WSP(bf16_t, WS_H2B), ssq2};
          pg8::gemm_phase<EpiP6, SchedGrid, true, -11>(F.lds, 2048, S, E); }
    } SEAM(6);
    if (IN(7)) {
        SchedGrid S{F.G, (int)blockIdx.x, 64, 8, (const char*)(F.ws + WS_H2B), (const char*)(F.ws + WS_WSC), T2048};
        EpiP7 E{ssq2, WSP(_Float16, WS_SC)};
        pg8::gemm_phase<EpiP7, SchedGrid>(F.lds, 2048, S, E);
    } SEAM(7);
    if (IN(8)) {
        const int nch = (MREAL / peer::CH - F.vcu + F.G - 1) / F.G; const bool both_first = (nch == 2) && (F.vcu & 1);
        for (int op = 0; op < 2 * nch; ++op) {
            const bool sel = both_first ? (op < 2) : !(op & 1); const int ci = both_first ? (op & 1) : (op >> 1), chunk = F.vcu + ci * F.G;
            const int b2 = both_first ? ci : 0;
            LAS int* SE = (LAS int*)(F.lds + (b2 ? peer::OFF_SE2 : peer::OFF_SE)); LAS float* SG = (LAS float*)(F.lds + (b2 ? peer::OFF_SG2 : peer::OFF_SG));
            if (sel) peer::peer_select(chunk, WSP(_Float16, WS_SC), (LAS char*)F.lds, F.tid, SE, SG);
            else peer::peer_gather(chunk, WSP(bf16_t, WS_H2B), WSP(unsigned char, WS_U), WSP(unsigned char, WS_V), F.in[13], F.in[18], F.out, F.tid, SE, SG); }
    }
#if MK_PROBE_PH >= 0
    xcd_barrier(bar); tp1 = (MK_PROBE_PH >= 8) ? __builtin_amdgcn_s_memrealtime() : tp1;
    if (blockIdx.x == 0 && F.tid == 0) F.out[0] = (float)(tp1 - tp0) * (0.01f / MK_PROBE_DIV);
#endif
#undef IN
#undef SEAM
}

extern "C" void kernel_launch(void* const* d_in, const int* in_sizes, int n_in, void* d_out, int out_size, void* d_ws, size_t ws_size, hipStream_t stream) {
    static int grid = 0;
    if (grid == 0) {
        if (n_in != 19 || in_sizes[0] != MREAL * DM || out_size != MREAL * DM || ws_size < WS_END) {
            fprintf(stderr, "kernel_launch: shape/workspace mismatch: n_in %d in0 %d out %d ws %zu (need %zu); nothing launched\n", n_in, n_in > 0 ? in_sizes[0] : -1, out_size, ws_size, (size_t)WS_END); grid = -1; return; }
        int dev = 0, cus = 0, per_cu = 0;
        if (hipGetDevice(&dev) != hipSuccess || hipDeviceGetAttribute(&cus, hipDeviceAttributeMultiprocessorCount, dev) != hipSuccess) { fprintf(stderr, "kernel_launch: device query failed\n"); grid = -1; return; }
        if (hipFuncSetAttribute((const void*)hybrid_fwd, hipFuncAttributeMaxDynamicSharedMemorySize, LDS_BYTES) != hipSuccess) { fprintf(stderr, "kernel_launch: hipFuncSetAttribute failed\n"); grid = -1; return; }
        if (hipOccupancyMaxActiveBlocksPerMultiprocessor(&per_cu, (const void*)hybrid_fwd, NWAVES * 64, LDS_BYTES) != hipSuccess || per_cu < 1)
            fprintf(stderr, "kernel_launch: note: occupancy query reports %d workgroups per CU\n", per_cu);
        (void)hipGetLastError();
        grid = cus;
    }
    if (grid < 0) return;
    if (hipMemsetAsync((char*)d_ws + WS_CTL, 0, CTL_ZERO_BYTES, stream) != hipSuccess) { fprintf(stderr, "kernel_launch: hipMemsetAsync failed\n"); return; }
    Args a{};
    for (int i = 0; i < 19; ++i) a.in[i] = (const float*)d_in[i];
    a.out = (float*)d_out; a.ws = (unsigned char*)d_ws;
    for (int li = 0; li < N_LAUNCHES; ++li) {
        a.ph_lo = (N_LAUNCHES == 1) ? 0 : li; a.ph_hi = (N_LAUNCHES == 1) ? N_PHASES : li + 1;
        hipLaunchKernelGGL(hybrid_fwd, dim3(grid), dim3(NWAVES * 64), LDS_BYTES, stream, a);
        const hipError_t le = hipPeekAtLastError();
        if (le != hipSuccess) { fprintf(stderr, "kernel_launch: launch %d failed: %s\n", li, hipGetErrorName(le)); break; }
    }
}
```

```cpp
#include <hip/hip_runtime.h>
#include <cstdio>
#include <cstdint>

#define LAS __attribute__((address_space(3)))
#define GAS __attribute__((address_space(1)))
typedef unsigned short bf16_t;
typedef short bf16x8 __attribute__((ext_vector_type(8)));
typedef short s16x4 __attribute__((ext_vector_type(4)));
typedef float f32x4 __attribute__((ext_vector_type(4)));
typedef float f32x2 __attribute__((ext_vector_type(2)));
typedef float f32x16 __attribute__((ext_vector_type(16)));
typedef unsigned u32x4 __attribute__((ext_vector_type(4)));
typedef unsigned u32x2 __attribute__((ext_vector_type(2)));

constexpr int DM = 2048, NBATCH = 8, SEQ = 2048, NMETA = 16;
constexpr int MREAL = NBATCH * SEQ;
constexpr int MPAD = MREAL + 256;
constexpr int NPOS = SEQ + NMETA;
constexpr float NORM_EPS = 1e-6f;
constexpr int C_NAQ = 0, C_NAK = 1024, C_CQ = 2048, C_CKV = 2560, C_GA = 3072, C_GB = 5120, C_KR = 7168, NMAIN = 7424;
constexpr int VT_PITCH = MPAD;

constexpr size_t MiB = 1u << 20;
constexpr size_t WS_CTL = 0, CTL_ZERO_BYTES = 1 * MiB;
constexpr size_t WS_SSQ_Q = 481 * MiB, WS_SSQ_KV = 482 * MiB, WS_SSQ_2 = 486 * MiB;
constexpr size_t WS_COS = 1 * MiB, WS_SIN = 1 * MiB + 512 * 1024;
constexpr size_t WS_WUQ = 2 * MiB, WS_WUKV = 5 * MiB, WS_WNA = 9 * MiB, WS_WMLA = 13 * MiB, WS_WOUT = 21 * MiB, WS_WSC = 29 * MiB;
constexpr size_t WS_GA = 37 * MiB, WS_GB = 101 * MiB;
constexpr size_t WS_KR = 165 * MiB;
constexpr size_t WS_WIN = 167 * MiB + 256 * 1024, WS_WVT = WS_WIN + 29 * MiB;
constexpr size_t WS_ONA = 190 * MiB;
constexpr size_t WS_NAQ = 222 * MiB, WS_NAK = 254 * MiB, WS_VT = WS_NAK + 32 * MiB + 512 * 1024;
constexpr size_t WS_HN1 = 319 * MiB;
constexpr size_t WS_CQ = 448 * MiB, WS_CKV = 464 * MiB;
constexpr size_t WS_QM = 303 * MiB, WS_KN = 352 * MiB, WS_VV = 385 * MiB;
constexpr size_t WS_OMLA = 448 * MiB;
constexpr size_t WS_MERGED = 222 * MiB, WS_T1 = 286 * MiB;
constexpr size_t WS_H2 = 37 * MiB, WS_H2B = 293 * MiB;
constexpr size_t WS_U = 69 * MiB, WS_V = 133 * MiB;
constexpr size_t WS_SC = 165 * MiB;
constexpr size_t WS_END = 512 * MiB;
static_assert(WS_CKV + (size_t)MPAD * 512 * 2 <= WS_SSQ_Q && WS_SSQ_Q + (size_t)8 * MPAD * 4 <= WS_SSQ_KV && WS_SSQ_KV + (size_t)8 * MPAD * 4 <= 483 * MiB && WS_SSQ_2 + (size_t)32 * MREAL * 4 <= WS_END, "ssq slabs");
static_assert(WS_VT + (size_t)1024 * MPAD * 2 <= WS_HN1 && WS_HN1 + (size_t)MPAD * 2048 * 2 <= WS_CQ && WS_CKV + (size_t)MPAD * 512 * 2 <= WS_END, "map P1");
static_assert(WS_WVT + 4 * MiB <= WS_NAQ && WS_KR + (size_t)MPAD * 64 * 2 <= WS_WIN && WS_ONA + 32 * MiB <= WS_NAQ, "map P1b");
static_assert(WS_VT + (size_t)1024 * MPAD <= WS_QM && WS_QM + 48 * MiB <= WS_KN && WS_KN + 33 * MiB <= WS_VV && WS_VV + 33 * MiB <= WS_OMLA && WS_OMLA + 64 * MiB <= WS_END, "map P3");
static_assert(WS_T1 + 128 * MiB <= WS_OMLA && WS_H2 + 128 * MiB <= WS_KR && WS_SC + 128 * MiB <= WS_H2B && WS_H2B + 64 * MiB <= WS_END, "map P5+");
static_assert(WS_GA + 32 * MiB <= WS_U && WS_U + 24 * MiB <= WS_GB && WS_GB + 32 * MiB <= WS_V && WS_V + 24 * MiB <= WS_KR, "expert tables between the gate codes");

constexpr int CW_BAR = 4096;
constexpr float PEER_U_SCALE = 90.50966799f, PEER_V_SCALE = 5.656854249f;

constexpr int RING_BYTES = 131072;
constexpr int LDSCTL_OFF = RING_BYTES, MISC_OFF = LDSCTL_OFF + 320;
constexpr int LDS_BYTES = 147456;
constexpr int NWAVES = 8;

#define LDS_WAIT() asm volatile("s_waitcnt lgkmcnt(0)" ::: "memory")
#define VM_WAIT() asm volatile("s_waitcnt vmcnt(0)" ::: "memory")
#define SBAR() __builtin_amdgcn_sched_barrier(0)
typedef __bf16 bf16x2_t __attribute__((ext_vector_type(2)));
__device__ __forceinline__ unsigned cvt_pk_bf16(float lo, float hi) { const f32x2 v = {lo, hi}; const bf16x2_t b = __builtin_convertvector(v, bf16x2_t); return __builtin_bit_cast(unsigned, b); }
__device__ __forceinline__ float bf_lo(unsigned w) { return __uint_as_float(w << 16); }
__device__ __forceinline__ float bf_hi(unsigned w) { return __uint_as_float(w & 0xffff0000u); }
__device__ __forceinline__ u32x4 pack8(const f32x4 a, const f32x4 b) { u32x4 w; w.x = cvt_pk_bf16(a[0], a[1]); w.y = cvt_pk_bf16(a[2], a[3]); w.z = cvt_pk_bf16(b[0], b[1]); w.w = cvt_pk_bf16(b[2], b[3]); return w; }
__device__ __forceinline__ u32x2 pack8_fp8(f32x4 a, f32x4 b) {
#pragma unroll
    for (int i = 0; i < 4; ++i) { a[i] = __builtin_fminf(__builtin_fmaxf(a[i], -448.f), 448.f); b[i] = __builtin_fminf(__builtin_fmaxf(b[i], -448.f), 448.f); }
    int w0 = 0, w1 = 0; w0 = __builtin_amdgcn_cvt_pk_fp8_f32(a[0], a[1], w0, false); w0 = __builtin_amdgcn_cvt_pk_fp8_f32(a[2], a[3], w0, true);
    w1 = __builtin_amdgcn_cvt_pk_fp8_f32(b[0], b[1], w1, false); w1 = __builtin_amdgcn_cvt_pk_fp8_f32(b[2], b[3], w1, true); return (u32x2){(unsigned)w0, (unsigned)w1}; }
__device__ __forceinline__ unsigned char f32_to_fp8(float x) { x = __builtin_fminf(__builtin_fmaxf(x, -448.f), 448.f); return (unsigned char)(__builtin_amdgcn_cvt_pk_fp8_f32(x, 0.f, 0, false) & 0xff); }
__device__ __forceinline__ u32x2 pack8_u8(const f32x4 a, const f32x4 b) { u32x2 w; unsigned x = 0u, y = 0u;
    x = __builtin_amdgcn_cvt_pk_u8_f32(a[0] * 255.f, 0u, x); x = __builtin_amdgcn_cvt_pk_u8_f32(a[1] * 255.f, 1u, x); x = __builtin_amdgcn_cvt_pk_u8_f32(a[2] * 255.f, 2u, x); x = __builtin_amdgcn_cvt_pk_u8_f32(a[3] * 255.f, 3u, x);
    y = __builtin_amdgcn_cvt_pk_u8_f32(b[0] * 255.f, 0u, y); y = __builtin_amdgcn_cvt_pk_u8_f32(b[1] * 255.f, 1u, y); y = __builtin_amdgcn_cvt_pk_u8_f32(b[2] * 255.f, 2u, y); y = __builtin_amdgcn_cvt_pk_u8_f32(b[3] * 255.f, 3u, y);
    w.x = x; w.y = y; return w; }
__device__ __forceinline__ unsigned pack4_fp8(f32x4 a) {
#pragma unroll
    for (int i = 0; i < 4; ++i) a[i] = __builtin_fminf(__builtin_fmaxf(a[i], -448.f), 448.f);
    int w0 = 0; w0 = __builtin_amdgcn_cvt_pk_fp8_f32(a[0], a[1], w0, false); w0 = __builtin_amdgcn_cvt_pk_fp8_f32(a[2], a[3], w0, true); return (unsigned)w0; }
__device__ __forceinline__ void unpack8_fp8(const u32x2 w, f32x4& a, f32x4& b) {
    const f32x2 a0 = __builtin_amdgcn_cvt_pk_f32_fp8((int)w.x, false), a1 = __builtin_amdgcn_cvt_pk_f32_fp8((int)w.x, true), b0 = __builtin_amdgcn_cvt_pk_f32_fp8((int)w.y, false), b1 = __builtin_amdgcn_cvt_pk_f32_fp8((int)w.y, true);
    a = (f32x4){a0[0], a0[1], a1[0], a1[1]}; b = (f32x4){b0[0], b0[1], b1[0], b1[1]}; }
__device__ __forceinline__ void unpack8_u8(const u32x2 w, f32x4& a, f32x4& b) { const float k = 1.f / 255.f;
    a = (f32x4){(float)(w.x & 0xffu), (float)((w.x >> 8) & 0xffu), (float)((w.x >> 16) & 0xffu), (float)(w.x >> 24)} * k;
    b = (f32x4){(float)(w.y & 0xffu), (float)((w.y >> 8) & 0xffu), (float)((w.y >> 16) & 0xffu), (float)(w.y >> 24)} * k; }
__device__ __forceinline__ u32x2 pack4(const f32x4 a) { u32x2 w; w.x = cvt_pk_bf16(a[0], a[1]); w.y = cvt_pk_bf16(a[2], a[3]); return w; }
__device__ __forceinline__ float wave_sum(float v) {
#pragma unroll
    for (int o = 1; o < 64; o <<= 1) v += __shfl_xor(v, o);
    return v;
}
__device__ __forceinline__ float sigmoidf_(float x) { return __builtin_amdgcn_rcpf(1.0f + __builtin_amdgcn_exp2f(-1.4426950408889634f * x)); }
__device__ __forceinline__ int crow(int r, int hi) { return (r & 3) + 8 * (r >> 2) + 4 * hi; }
#define PG8_AUX 0
namespace pg8 {
constexpr int BM = 256, BK = 64, HALF = 128, HTB = HALF * BK * 2  , STAGE_BYTES = 8 * HTB, NXCD = 8, WGM = 8;
__host__ __device__ __forceinline__ int lds_byte(int r, int c) { const int st = (r >> 4) * 2 + (c >> 5), rr = r & 15, cc = c & 31, ob = rr * 64 + cc * 2; return st * 1024 + (ob ^ (((ob >> 9) & 1) << 5)); }
__host__ __device__ __forceinline__ void stage_rc(int b, int& R, int& C) { const int st = b / 1024, sb = b % 1024, swz = sb ^ (((sb >> 9) & 1) << 5); R = (st >> 1) * 16 + swz / 64; C = (st & 1) * 32 + (swz % 64) / 2; }
__host__ __device__ __forceinline__ int perm32(int rho) { const int n = rho >> 4, i = rho & 15; return 8 * (i >> 2) + 4 * n + (i & 3); }

struct Unit { int pm, pn, kind; };

__device__ __forceinline__ void grid_order(int L, int nM, int nN, int& pm, int& pn) {
    const int nwg = nM * nN; int wgid = L;
    { const int q = nwg / NXCD, r = nwg % NXCD, xcd = wgid % NXCD, off = wgid / NXCD; wgid = (xcd < r ? xcd * (q + 1) : r * (q + 1) + (xcd - r) * q) + off; }
    const int nig = WGM * nN, gid = wgid / nig, fm = gid * WGM, gsz = (nM - fm) < WGM ? (nM - fm) : WGM;
    pm = fm + ((wgid % nig) % gsz); pn = (wgid % nig) / gsz;
}

typedef int v8i_t __attribute__((ext_vector_type(8)));
template <class Epi, class Sched, bool F8 = false, int F8_SCALE_EXP = 0>
__device__ __forceinline__ void gemm_phase(LAS unsigned char* lds, const int K, const Sched& S, const Epi& E) {
    const int tid = threadIdx.x, wid = __builtin_amdgcn_readfirstlane(tid >> 6), lane = tid & 63, wr = wid >> 2, wc = wid & 3, fr = lane & 15, fq = lane >> 4;
    int f8sa = 0x01010101 * (127 + F8_SCALE_EXP), f8sb = 0x7f7f7f7f; asm volatile("" : "+v"(f8sa), "+v"(f8sb));
    const int Kb = F8 ? K : 2 * K;
    const int nt = Kb / 128;
    unsigned voffA[2], voffB[2];
#pragma unroll
    for (int i = 0; i < 2; ++i) { int R, C; stage_rc(tid * 16 + i * 8192, R, C); const int Rb = Epi::PERM ? ((R & ~31) + perm32(R & 31)) : R;
        voffA[i] = (unsigned)(R * Kb + C * 2); voffB[i] = (unsigned)(Rb * Kb + C * 2); }
    const size_t kstep = (size_t)128;
    const size_t hstep = (size_t)HALF * Kb;
    const unsigned ldsw = (unsigned)wid * 1024u;
    const int aoff = lds_byte(wr * 64 + fr, F8 ? fq * 16 : fq * 8), boff = lds_byte(wc * 32 + fr, F8 ? fq * 16 : fq * 8);
#define PG8_SA(b, h) (((b) * 2 + (h)) * HTB)
#define PG8_SB(b, h) ((4 + (b) * 2 + (h)) * HTB)
#define PG8_STAGE(bufoff, gbase, voff) do { _Pragma("unroll") for (int _i = 0; _i < 2; ++_i) \
        __builtin_amdgcn_global_load_lds((const unsigned*)((const char*)(gbase) + (voff)[_i]), (LAS unsigned*)(lds + (bufoff) + ldsw + _i * 8192), 16, 0, PG8_AUX); } while (0)
#define PG8_LDA(dst, b, h) do { _Pragma("unroll") for (int m = 0; m < 4; ++m) _Pragma("unroll") for (int k = 0; k < 2; ++k) dst[m][k] = *(const LAS bf16x8*)(lds + PG8_SA(b, h) + aoff + m * 2048 + (F8 ? k * 16 : k * 1024)); } while (0)
#define PG8_LDB(dst, b, h) do { _Pragma("unroll") for (int n = 0; n < 2; ++n) _Pragma("unroll") for (int k = 0; k < 2; ++k) dst[n][k] = *(const LAS bf16x8*)(lds + PG8_SB(b, h) + boff + n * 2048 + (F8 ? k * 16 : k * 1024)); } while (0)
#define PG8_F8OP(X) __builtin_bit_cast(v8i_t, __builtin_shufflevector(X[0], X[1], 0, 1, 2, 3, 4, 5, 6, 7, 8, 9, 10, 11, 12, 13, 14, 15))
#define PG8_MMA(ai, bj, At, Bt) do { __builtin_amdgcn_s_setprio(1); \
        if constexpr (F8) { _Pragma("unroll") for (int m = 0; m < 4; ++m) _Pragma("unroll") for (int n = 0; n < 2; ++n) \
            asm volatile("v_mfma_scale_f32_16x16x128_f8f6f4 %0, %1, %2, %0, %3, %4 op_sel_hi:[0,0,0]" : "+v"(acc[ai][bj][m][n]) : "v"(PG8_F8OP(Bt[n])), "v"(PG8_F8OP(At[m])), "v"(f8sa), "v"(f8sb)); } \
        else { _Pragma("unroll") for (int m = 0; m < 4; ++m) _Pragma("unroll") for (int n = 0; n < 2; ++n) _Pragma("unroll") for (int k = 0; k < 2; ++k) \
            acc[ai][bj][m][n] = __builtin_amdgcn_mfma_f32_16x16x32_bf16(Bt[n][k], At[m][k], acc[ai][bj][m][n], 0, 0, 0); } \
        __builtin_amdgcn_s_setprio(0); } while (0)
#define PG8_WAIT_V(n) asm volatile("s_waitcnt vmcnt(" #n ")" ::: "memory")
#define PG8_WAIT_L(n) asm volatile("s_waitcnt lgkmcnt(" #n ")" ::: "memory")
#define PG8_BAR __builtin_amdgcn_s_barrier()
#define PG8_SCHED __builtin_amdgcn_sched_barrier(0)
    Unit cur, nxt; int ui = 0;
    if (!S.next(0, cur)) return;
    f32x4 acc[2][2][4][2];
#pragma unroll
    for (int a = 0; a < 2; ++a)
#pragma unroll
        for (int b = 0; b < 2; ++b)
#pragma unroll
            for (int m = 0; m < 4; ++m)
#pragma unroll
                for (int n = 0; n < 2; ++n) acc[a][b][m][n] = (f32x4){0.f, 0.f, 0.f, 0.f};
    bf16x8 At[4][2], B0[2][2], B1[2][2];
    const char* cA = S.pa(cur); const char* cB = S.pb(cur);
    PG8_STAGE(PG8_SB(0, 0), cB, voffB); PG8_STAGE(PG8_SB(0, 1), cB + hstep, voffB); PG8_STAGE(PG8_SA(0, 0), cA, voffA); PG8_STAGE(PG8_SA(0, 1), cA + hstep, voffA);
    if (wr == 1) PG8_BAR;
    PG8_WAIT_V(2); PG8_BAR;
    PG8_STAGE(PG8_SB(1, 0), cB + kstep, voffB); PG8_STAGE(PG8_SA(1, 0), cA + kstep, voffA); PG8_STAGE(PG8_SB(1, 1), cB + hstep + kstep, voffB);
    PG8_WAIT_V(6); PG8_BAR;
    for (;;) {
        const bool has_next = S.next(ui + 1, nxt);
        const char* nA = has_next ? S.pa(nxt) : cA; const char* nB = has_next ? S.pb(nxt) : cB;
        for (int t = 0; t < nt; t += 2) {
            const bool last = (t == nt - 2);
            const char* a1 = cA + (size_t)(t + 1) * kstep;
            const char* a2 = last ? nA : cA + (size_t)(t + 2) * kstep; const char* b2 = last ? nB : cB + (size_t)(t + 2) * kstep;
            const char* a3 = a2 + kstep; const char* b3 = b2 + kstep;
            PG8_LDB(B0, 0, 0); PG8_LDB(B1, 0, 1); PG8_SCHED; PG8_LDA(At, 0, 0); PG8_STAGE(PG8_SA(1, 1), a1 + hstep, voffA);
            PG8_WAIT_V(8); PG8_WAIT_L(0); PG8_BAR; PG8_MMA(0, 0, At, B0); PG8_MMA(0, 1, At, B1); PG8_BAR; PG8_SCHED;
            PG8_LDA(At, 0, 1); PG8_STAGE(PG8_SB(0, 0), b2, voffB); PG8_STAGE(PG8_SB(0, 1), b2 + hstep, voffB); PG8_STAGE(PG8_SA(0, 0), a2, voffA);
            PG8_WAIT_V(8); PG8_WAIT_L(0); PG8_BAR; PG8_MMA(1, 0, At, B0); PG8_MMA(1, 1, At, B1); PG8_BAR; PG8_SCHED;
            PG8_LDB(B0, 1, 0); PG8_LDB(B1, 1, 1); PG8_SCHED; PG8_LDA(At, 1, 0); PG8_STAGE(PG8_SA(0, 1), a2 + hstep, voffA);
            PG8_WAIT_V(8); PG8_WAIT_L(0); PG8_BAR; PG8_MMA(0, 0, At, B0); PG8_MMA(0, 1, At, B1); PG8_BAR; PG8_SCHED;
            PG8_LDA(At, 1, 1); PG8_STAGE(PG8_SB(1, 0), b3, voffB); PG8_STAGE(PG8_SB(1, 1), b3 + hstep, voffB); PG8_STAGE(PG8_SA(1, 0), a3, voffA);
            PG8_WAIT_V(8); PG8_WAIT_L(0); PG8_BAR; PG8_MMA(1, 0, At, B0); PG8_MMA(1, 1, At, B1); PG8_BAR; PG8_SCHED;
        }
        if (wr == 0) PG8_BAR;
        if constexpr (F8) asm volatile("s_nop 15\n\ts_nop 7" ::: "memory");
        if constexpr (Epi::HAS_PRE) {
            E.pre(cur, (LAS float*)(lds + STAGE_BYTES + 1024), tid); PG8_WAIT_L(0); PG8_BAR; }
        E(acc, cur, wr, wc, fr, fq, (const LAS float*)(lds + STAGE_BYTES + 1024));
        if (!has_next) break;
#pragma unroll
        for (int a = 0; a < 2; ++a)
#pragma unroll
            for (int b = 0; b < 2; ++b)
#pragma unroll
                for (int m = 0; m < 4; ++m)
#pragma unroll
                    for (int n = 0; n < 2; ++n) acc[a][b][m][n] = (f32x4){0.f, 0.f, 0.f, 0.f};
        cur = nxt; cA = nA; cB = nB; ++ui;
        if (wr == 1) PG8_BAR;
    }
    PG8_WAIT_V(0);
    PG8_BAR;
#undef PG8_SA
#undef PG8_SB
#undef PG8_STAGE
#undef PG8_LDA
#undef PG8_LDB
#undef PG8_MMA
#undef PG8_F8OP
#undef PG8_WAIT_V
#undef PG8_WAIT_L
#undef PG8_BAR
#undef PG8_SCHED
}
}
typedef GAS unsigned gu32;
#define RLX_AGENT __ATOMIC_RELAXED, __HIP_MEMORY_SCOPE_AGENT
#define XB_TMO      128
#define XB_XCNT(j)  (256  + 64 * (j))
#define XB_XSUB(j)  (1280 + 64 * (j))
#define XB_XGEN(j)  (2304 + 64 * (j))
#define XB_TOP      3328
#define XB_TOPGEN   3392
#define XCD_BAR_WORDS 3456
#define XB_SPIN_CAP (1u << 18)
__device__ __forceinline__ unsigned xb_ld(unsigned* p)              { return __hip_atomic_load(p, __ATOMIC_RELAXED, __HIP_MEMORY_SCOPE_AGENT); }
__device__ __forceinline__ unsigned xb_add(unsigned* p, unsigned v) { return __hip_atomic_fetch_add(p, v, __ATOMIC_RELAXED, __HIP_MEMORY_SCOPE_AGENT); }
__device__ __forceinline__ unsigned xb_xcc_id() { return (unsigned)__builtin_amdgcn_s_getreg((3 << 11) | 20) & 0xFu; }
#define XB_SPIN(cond, bar) do { unsigned _sp = 0; while (cond) { __builtin_amdgcn_s_sleep(1); \
    if ((++_sp & 255u) == 0u) { if (xb_ld(&(bar)[XB_TMO])) break; if (_sp > XB_SPIN_CAP) { atomicAdd(&(bar)[XB_TMO], 1u); break; } } } } while (0)
struct XcdBarrier { unsigned* bar; unsigned x; volatile LAS unsigned* st; };
__device__ __forceinline__ XcdBarrier xcd_barrier_post(unsigned* bar, volatile LAS unsigned* st) {
    XcdBarrier b; b.bar = bar; b.x = xb_xcc_id(); b.st = st;
    if (threadIdx.x == 0) (void)xb_add(&bar[XB_XCNT(b.x)], 1u);
    return b;
}
__device__ __forceinline__ void xcd_barrier_complete(unsigned* bar, unsigned x, unsigned& nloc, unsigned& nx) {
    const unsigned G = gridDim.x * gridDim.y * gridDim.z;
    unsigned sum, cnt, mine, sp = 0u;
    for (;;) {
        sum = 0u; cnt = 0u; mine = 0u;
#pragma unroll
        for (unsigned j = 0; j < 16; ++j) { const unsigned c = xb_ld(&bar[XB_XCNT(j)]); sum += c; cnt += (c > 0u) ? 1u : 0u; mine = (j == x) ? c : mine; }
        if (sum == G) break;
        __builtin_amdgcn_s_sleep(1);
        if ((++sp & 255u) == 0u) { if (xb_ld(&bar[XB_TMO])) break; if (sp > XB_SPIN_CAP) { atomicAdd(&bar[XB_TMO], 1u); break; } }
    }
    nloc = mine > 0u ? mine : 1u; nx = cnt > 0u ? cnt : 1u;
}
__device__ __forceinline__ void xcd_barrier(const XcdBarrier& b) {
    asm volatile("s_waitcnt vmcnt(0)" ::: "memory");
    __syncthreads();
    if (threadIdx.x == 0) {
        unsigned* bar = b.bar;
        __builtin_amdgcn_s_waitcnt(0);
        unsigned nloc = b.st[0], nx = b.st[1];
        if (nloc == 0u) { xcd_barrier_complete(bar, b.x, nloc, nx); b.st[0] = nloc; b.st[1] = nx; }
        const unsigned old = xb_add(&bar[XB_XSUB(b.x)], 1u);
        const unsigned gen = old / nloc;
        if (old + 1u == (gen + 1u) * nloc) {
            __builtin_amdgcn_fence(__ATOMIC_RELEASE, "agent");
            asm volatile("s_waitcnt vmcnt(0)" ::: "memory");
            const unsigned og = xb_add(&bar[XB_TOP], 1u);
            const unsigned tg = og / nx;
            if (og + 1u == (tg + 1u) * nx) xb_add(&bar[XB_TOPGEN], 1u);
            else XB_SPIN(xb_ld(&bar[XB_TOPGEN]) == tg, bar);
            __builtin_amdgcn_fence(__ATOMIC_ACQUIRE, "agent");
            xb_add(&bar[XB_XGEN(b.x)], 1u);
            asm volatile("s_waitcnt vmcnt(0)" ::: "memory");
        } else {
            XB_SPIN(xb_ld(&bar[XB_XGEN(b.x)]) == gen, bar);
            __builtin_amdgcn_fence(__ATOMIC_ACQUIRE, "agent");
            asm volatile("s_waitcnt vmcnt(0)" ::: "memory");
        }
    }
    __syncthreads();
}
struct Frame {
    LAS unsigned char* lds;
    volatile LAS unsigned* MISC;
    unsigned char* ws;
    int tid, lane, wave;
    int vcu, G;
    const float* in[19];
    float* out;
};
#define WSP(T, off) ((T*)(F.ws + (off)))

typedef float cv16f_t __attribute__((ext_vector_type(16)));
typedef unsigned cv6u_t __attribute__((ext_vector_type(6)));
struct Conv { const float* pu; const float* pv; unsigned char* u8; unsigned char* v8; LAS unsigned char* lbuf; int next, stride, end, pend, tick; };
__device__ __forceinline__ void conv_issue(const Conv& c, int item, int lane) {
    const float* src = ((item >> 14) ? c.pv : c.pu) + (size_t)(item & 16383) * 2048 + 4 * lane;
#pragma unroll
    for (int q = 0; q < 8; ++q) __builtin_amdgcn_global_load_lds((const unsigned*)(src + 256 * q), (LAS unsigned*)(c.lbuf + q * 1024), 16, 0, 0);
}
__device__ __forceinline__ void conv_finish(const Conv& c, int item, int lane) {
    const int isv = item >> 14, row = item & 16383; const float sc = isv ? PEER_V_SCALE : PEER_U_SCALE; unsigned w[4] = {0u, 0u, 0u, 0u};
#define CONV_LD(q) const f32x4 x##q = *(const LAS f32x4*)(c.lbuf + (q) * 1024 + lane * 16) * sc;
#define CONV_PK(q) { w[(q) >> 1] = __builtin_amdgcn_cvt_scalef32_pk_fp4_f32(w[(q) >> 1], x##q[0], x##q[1], 1.0f, (2 * (q)) & 3); w[(q) >> 1] = __builtin_amdgcn_cvt_scalef32_pk_fp4_f32(w[(q) >> 1], x##q[2], x##q[3], 1.0f, (2 * (q) + 1) & 3); }
    { CONV_LD(0) CONV_LD(1) CONV_PK(0) CONV_PK(1) } asm volatile("" : "+v"(w[0]) :: "memory");
    { CONV_LD(2) CONV_LD(3) CONV_PK(2) CONV_PK(3) } asm volatile("" : "+v"(w[1]) :: "memory");
    { CONV_LD(4) CONV_LD(5) CONV_PK(4) CONV_PK(5) } asm volatile("" : "+v"(w[2]) :: "memory");
    { CONV_LD(6) CONV_LD(7) CONV_PK(6) CONV_PK(7) }
#undef CONV_LD
#undef CONV_PK
    unsigned char* rec = (isv ? c.v8 : c.u8) + (size_t)row * 1024;
    *(GAS u32x4*)(rec + lane * 16) = (u32x4){w[0], w[1], w[2], w[3]};
}
template <int YOUNGER>
__device__ __forceinline__ void conv_step(Conv& c, int lane) {
    if (c.pend >= 0) { if constexpr (YOUNGER == 0) asm volatile("s_waitcnt vmcnt(0)" ::: "memory"); else { static_assert(YOUNGER == 12, "wait count"); asm volatile("s_waitcnt vmcnt(12)" ::: "memory"); }
        conv_finish(c, c.pend, lane); c.pend = -1; asm volatile("s_waitcnt lgkmcnt(0)" ::: "memory"); }
    if (c.next < c.end) { conv_issue(c, c.next, lane); c.pend = c.next; c.next += c.stride; }
}
__device__ __forceinline__ void p0_transpose_item8(const float* W, int K, int N, int k0, int n0, unsigned char* WT, int drow, bool rope, float scale, LAS float* scr, int lane, const float* gain = nullptr) {
    { f32x4 v[8]; float gk[8];
#pragma unroll
      for (int i = 0; i < 8; ++i) { const int kk = 8 * i + (lane >> 3); v[i] = *(const GAS f32x4*)(W + (size_t)(k0 + kk) * N + n0 + 4 * (lane & 7)); gk[i] = gain ? gain[k0 + kk] * scale : scale; }
#pragma unroll
      for (int i = 0; i < 8; ++i) { const int kk = 8 * i + (lane >> 3); LAS float* d = scr + kk * 33 + 4 * (lane & 7);
#pragma unroll
          for (int e = 0; e < 4; ++e) d[e] = v[i][e] * gk[i]; } }
    LDS_WAIT(); asm volatile("" ::: "memory");
#pragma unroll
    for (int j = 0; j < 2; ++j) { const int q = lane + 64 * j, n = q >> 2, c = q & 3; const LAS float* s = scr + (16 * c) * 33 + n; u32x4 o;
#pragma unroll
        for (int d = 0; d < 4; ++d) { int w = 0; w = __builtin_amdgcn_cvt_pk_fp8_f32(s[(4 * d) * 33], s[(4 * d + 1) * 33], w, false); w = __builtin_amdgcn_cvt_pk_fp8_f32(s[(4 * d + 2) * 33], s[(4 * d + 3) * 33], w, true); o[d] = (unsigned)w; }
        const int dr = drow + (rope ? (8 * (n >> 2) + (n & 3)) : n);
        *(GAS u32x4*)(WT + (size_t)dr * K + k0 + 16 * c) = o; }
    LDS_WAIT(); asm volatile("" ::: "memory");
}
template <int PART>
__device__ __forceinline__ void p0_prologue(Frame& F, int rank, int nrank) {
    LAS float* scr = (LAS float*)(F.lds + F.wave * 16384);
    const int gw = rank * NWAVES + F.wave, NGW = nrank * NWAVES, lane = F.lane; const int gt = rank * 512 + F.tid, NGT = nrank * 512;
    unsigned char* WIN = WSP(unsigned char, WS_WIN); unsigned char* WVT = WSP(unsigned char, WS_WVT);
    constexpr int I_IN = 32 * 258, I_UQ = 8 * 96, I_UKV = 8 * 128, I_NA = 16 * 64, I_MLA = 32 * 64, I_OUT = 32 * 64;
    constexpr int NEARLY = I_IN + I_UQ + I_UKV, NITEMS = NEARLY + I_NA + I_MLA + I_OUT;
    for (int it = (PART == 0 ? 0 : NEARLY) + gw; it < (PART == 0 ? NEARLY : NITEMS); it += NGW) {
        int r = it;
        if (r < I_IN) { const int kb = r / 258, sb = r % 258, n0 = 32 * sb, k0 = 64 * kb; const float* W = F.in[3];
            unsigned char* dst = WIN; int drow; bool rope = false;
            if (n0 < 1024) drow = C_NAQ + n0;
            else if (n0 < 2048) drow = C_NAK + (n0 - 1024);
            else if (n0 < 3072) { dst = WVT; drow = n0 - 2048; }
            else if (n0 < 3584) drow = C_CQ + (n0 - 3072);
            else if (n0 < 4096) drow = C_CKV + (n0 - 3584);
            else if (n0 < 4160) { drow = C_KR + ((n0 - 4096) ? 4 : 0); rope = true; }
            else if (n0 < 6208) drow = C_GA + (n0 - 4160);
            else drow = C_GB + (n0 - 6208);
            p0_transpose_item8(W, 2048, 8256, k0, n0, dst, drow, rope, 64.f, scr, lane); continue; } r -= I_IN;
        if (r < I_UQ) { const int kb = r / 96, sb = r % 96, n0 = 32 * sb, k0 = 64 * kb; const int hd = n0 / 192, w = n0 % 192;
            int drow = n0; bool rope = false; if (w >= 128) { rope = true; drow = hd * 192 + 128 + ((w - 128) ? 4 : 0); }
            p0_transpose_item8(F.in[7], 512, 3072, k0, n0, WSP(unsigned char, WS_WUQ), drow, rope, 16.f, scr, lane, F.in[6]); continue; } r -= I_UQ;
        if (r < I_UKV) { const int kb = r / 128, sb = r % 128; const int n0 = 32 * sb, hd = n0 >> 8, w = n0 & 255;
            p0_transpose_item8(F.in[9], 512, 4096, 64 * kb, n0, WSP(unsigned char, WS_WUKV), (w >= 128 ? 2048 : 0) + hd * 128 + (w & 127), false, 16.f, scr, lane, F.in[8]); continue; } r -= I_UKV;
        if (r < I_NA) { const int kb = r / 64, sb = r % 64; p0_transpose_item8(F.in[10], 1024, 2048, 64 * kb, 32 * sb, WSP(unsigned char, WS_WNA), 32 * sb, false, 32.f, scr, lane); continue; } r -= I_NA;
        if (r < I_MLA) { const int kb = r / 64, sb = r % 64; p0_transpose_item8(F.in[11], 2048, 2048, 64 * kb, 32 * sb, WSP(unsigned char, WS_WMLA), 32 * sb, false, 64.f, scr, lane); continue; } r -= I_MLA;
        { const int kb = r / 64, sb = r % 64; p0_transpose_item8(F.in[12], 2048, 2048, 64 * kb, 32 * sb, WSP(unsigned char, WS_WOUT), 32 * sb, false, 64.f, scr, lane); }
    }
    if (PART == 0) { GAS u32x4* z = (GAS u32x4*)(WIN + (size_t)(C_KR + 64) * 2048); const int n16 = (NMAIN - C_KR - 64) * 2048 / 16;
      for (int i = gt; i < n16; i += NGT) z[i] = (u32x4){0u, 0u, 0u, 0u}; }
    if (PART == 0) { unsigned char* HN1 = WSP(unsigned char, WS_HN1);
#define P0_ROWSRC(m_) (((m_) < MREAL) ? F.in[0] + (size_t)(m_) * DM : F.in[1] + (size_t)((m_) - MREAL) * DM)
      { f32x4 v[8]; int m = gw;
        if (m < MREAL + NMETA) { const GAS f32x4* xr = (const GAS f32x4*)P0_ROWSRC(m) + lane;
#pragma unroll
            for (int j = 0; j < 8; ++j) v[j] = xr[64 * j]; }
        const GAS f32x4* gr = (const GAS f32x4*)F.in[2] + lane;
        while (m < MREAL + NMETA) { const int mn = m + NGW; f32x4 vn[8];
            { const int ml = mn < MREAL + NMETA ? mn : m; const GAS f32x4* xr = (const GAS f32x4*)P0_ROWSRC(ml) + lane;
#pragma unroll
              for (int j = 0; j < 8; ++j) vn[j] = xr[64 * j]; }
            float sq = 0.f;
#pragma unroll
            for (int j = 0; j < 8; ++j) sq += (v[j].x * v[j].x + v[j].y * v[j].y) + (v[j].z * v[j].z + v[j].w * v[j].w);
            const float rstd = 1.0f / sqrtf(wave_sum(sq) * (1.f / DM) + NORM_EPS);
            GAS unsigned* o4 = (GAS unsigned*)(HN1 + (size_t)m * DM) + lane;
#pragma unroll
            for (int j = 0; j < 8; ++j) { const f32x4 y = (v[j] * rstd) * gr[64 * j]; int w = 0; w = __builtin_amdgcn_cvt_pk_fp8_f32(y[0], y[1], w, false); w = __builtin_amdgcn_cvt_pk_fp8_f32(y[2], y[3], w, true); o4[64 * j] = (unsigned)w; }
#pragma unroll
            for (int j = 0; j < 8; ++j) v[j] = vn[j];
            m = mn; } }
#undef P0_ROWSRC
      GAS u32x4* z = (GAS u32x4*)(HN1 + (size_t)(MREAL + NMETA) * DM); const int n16 = (MPAD - MREAL - NMETA) * DM / 16;
      for (int i = gt; i < n16; i += NGT) z[i] = (u32x4){0u, 0u, 0u, 0u}; }
    if (PART == 0) { float* ct = WSP(float, WS_COS); float* st = WSP(float, WS_SIN);
      for (int i = gt; i < NPOS * 32; i += NGT) { const int p = i >> 5, j = i & 31;
          const float inv = __builtin_powf(10000.0f, -(float)(2 * j) / 64.0f); const float ang = (float)p * inv;
          double r = (double)ang * 0.15915494309189535; r -= __builtin_rint(r); const float rf = (float)r;
          ct[i] = __builtin_amdgcn_cosf(rf); st[i] = __builtin_amdgcn_sinf(rf); } }
    if (PART == 1) { const float* SK = F.in[15]; const float* WQ = F.in[14]; const float* g2 = F.in[13]; bf16_t* WSCp = WSP(bf16_t, WS_WSC);
      const int l15 = lane & 15, l4 = lane >> 4;
      for (int task = gw; task < 2048; task += NGW) { const int g = task >> 7, nt = (task >> 4) & 7, kc = task & 15, n0 = nt * 16;
          bf16x8 bfr[4];
#pragma unroll
          for (int kk = 0; kk < 4; ++kk) { const float* p = SK + ((size_t)g * 128 + n0 + l15) * 128 + 32 * kk + 8 * l4; const f32x4 a = *(const GAS f32x4*)p, b = *(const GAS f32x4*)(p + 4);
              const u32x4 w = pack8(a, b); bfr[kk] = __builtin_bit_cast(bf16x8, w); }
          for (int kt = 0; kt < 8; ++kt) { const int k0 = (kc * 8 + kt) * 16; f32x4 acc = (f32x4){0.f, 0.f, 0.f, 0.f};
#pragma unroll
              for (int kk = 0; kk < 4; ++kk) { const float* p = WQ + (size_t)(k0 + l15) * 2048 + g * 128 + 32 * kk + 8 * l4; const f32x4 a = *(const GAS f32x4*)p, b = *(const GAS f32x4*)(p + 4);
                  const u32x4 w = pack8(a, b); acc = __builtin_amdgcn_mfma_f32_16x16x32_bf16(__builtin_bit_cast(bf16x8, w), bfr[kk], acc, 0, 0, 0); }
              const f32x4 gg = *(const GAS f32x4*)(g2 + k0 + 4 * l4);
              *(GAS u32x2*)(WSCp + (size_t)(g * 128 + n0 + l15) * 2048 + k0 + 4 * l4) = pack4(acc * gg); } } }
}
using pg8::Unit;
struct SchedGrid {
    int G, c, nM, nN; const char* A; const char* B; size_t tstep;
    __device__ __forceinline__ bool next(int i, Unit& u) const { const int L = i * G + c; if (L >= nM * nN) return false; pg8::grid_order(L, nM, nN, u.pm, u.pn); u.kind = 0; return true; }
    __device__ __forceinline__ const char* pa(const Unit& u) const { return A + (size_t)u.pm * tstep; }
    __device__ __forceinline__ const char* pb(const Unit& u) const { return B + (size_t)u.pn * tstep; }
};
constexpr int P1_MAIN = 64 * 29, P1_VT = 4 * 65, P1_META = 7, P1_UNITS = P1_MAIN + P1_VT + P1_META;
struct SchedP1 {
    int G, c; const char* hn1; const char* win; const char* wvt; size_t tstep;
    __device__ __forceinline__ bool next(int i, Unit& u) const {
        const int L = i * G + c; if (L >= P1_UNITS) return false;
        if (L < P1_MAIN) { pg8::grid_order(L, 64, 29, u.pm, u.pn); u.kind = 0; }
        else if (L < P1_MAIN + P1_VT) { const int idx = L - P1_MAIN; u.pm = idx & 3; u.pn = idx >> 2; u.kind = 1; }
        else { const int idx = L - P1_MAIN - P1_VT; u.pm = 64; u.pn = idx < 4 ? 4 + idx : (idx < 6 ? 10 + (idx - 4) : 28); u.kind = 0; }
        return true; }
    __device__ __forceinline__ const char* pa(const Unit& u) const { return (u.kind == 1 ? wvt : hn1) + (size_t)u.pm * tstep; }
    __device__ __forceinline__ const char* pb(const Unit& u) const { return (u.kind == 1 ? hn1 : win) + (size_t)u.pn * tstep; }
};
__device__ __forceinline__ void rope4(const f32x4 x1, const f32x4 x2, const float* cosT, const float* sinT, int pos, int j0, f32x4& lo, f32x4& hi) {
    const f32x4 c = *(const GAS f32x4*)(cosT + pos * 32 + j0), s = *(const GAS f32x4*)(sinT + pos * 32 + j0);
    lo = x1 * c - x2 * s; hi = x2 * c + x1 * s;
}
struct EpiP1 {
    static constexpr bool PERM = true, HAS_PRE = false;
    unsigned char *naq, *nak, *vt; unsigned char *cq, *ckv; unsigned char *kr; unsigned char *ga, *gb; float *ssq_q, *ssq_kv; const float *cosT, *sinT;
    __device__ __forceinline__ void operator()(const f32x4 (&acc)[2][2][4][2], const Unit& u, int wr, int wc, int fr, int fq, const LAS float* rowsc) const {
        const int row0 = u.pm * 256 + wr * 64 + fr, colu = wc * 32 + 8 * fq;
        if (u.kind == 1) {
#pragma unroll
            for (int bj = 0; bj < 2; ++bj) { const int t0 = u.pn * 256 + bj * 128 + colu, pos = (t0 & ~63) + ((t0 & 63) >> 1);
#pragma unroll
                for (int ai = 0; ai < 2; ++ai)
#pragma unroll
                    for (int m = 0; m < 4; ++m) { unsigned char* rp = vt + (size_t)(row0 + ai * 128 + m * 16) * VT_PITCH + pos;
                        *(GAS unsigned*)rp = pack4_fp8(acc[ai][bj][m][0]); *(GAS unsigned*)(rp + 32) = pack4_fp8(acc[ai][bj][m][1]); } }
            return; }
        const int pn = u.pn;
        if (pn == 28) {
            if (wc < 2) { const int j0 = 4 * (4 * wc + fq);
#pragma unroll
                for (int ai = 0; ai < 2; ++ai)
#pragma unroll
                    for (int m = 0; m < 4; ++m) { const int row = row0 + ai * 128 + m * 16; const int pos = row < MREAL ? NMETA + (row & (SEQ - 1)) : row - MREAL;
                        f32x4 lo, hi; rope4(acc[ai][0][m][0], acc[ai][0][m][1], cosT, sinT, pos, j0, lo, hi);
                        *(GAS unsigned*)(kr + (size_t)row * 64 + j0) = pack4_fp8(lo); *(GAS unsigned*)(kr + (size_t)row * 64 + 32 + j0) = pack4_fp8(hi); } }
            return; }
        if (pn >= 12) {
            unsigned char* base = pn < 20 ? ga : gb; const int colt = (pn < 20 ? pn - 12 : pn - 20) * 256 + colu;
#pragma unroll
            for (int ai = 0; ai < 2; ++ai)
#pragma unroll
                for (int m = 0; m < 4; ++m) { unsigned char* rp = base + (size_t)(row0 + ai * 128 + m * 16) * 2048 + colt;
#pragma unroll
                    for (int bj = 0; bj < 2; ++bj) { f32x4 a = acc[ai][bj][m][0], b = acc[ai][bj][m][1];
#pragma unroll
                        for (int i = 0; i < 4; ++i) { a[i] = sigmoidf_(a[i]); b[i] = sigmoidf_(b[i]); }
                        *(GAS u32x2*)(rp + bj * 128) = pack8_u8(a, b); } }
            return; }
        if (pn >= 8) {
            const bool isq = pn < 10; unsigned char* base = isq ? cq : ckv; float* ssq = isq ? ssq_q : ssq_kv; const int colt = (isq ? pn - 8 : pn - 10) * 256 + colu;
#pragma unroll
            for (int ai = 0; ai < 2; ++ai)
#pragma unroll
                for (int m = 0; m < 4; ++m) { const int row = row0 + ai * 128 + m * 16; unsigned char* rp = base + (size_t)row * 512 + colt; float s = 0.f;
#pragma unroll
                    for (int bj = 0; bj < 2; ++bj) { const f32x4 a = acc[ai][bj][m][0], b = acc[ai][bj][m][1];
                        s += (a[0] * a[0] + a[1] * a[1]) + (a[2] * a[2] + a[3] * a[3]) + (b[0] * b[0] + b[1] * b[1]) + (b[2] * b[2] + b[3] * b[3]);
                        *(GAS u32x2*)(rp + bj * 128) = pack8_fp8(a, b); }
                    s += __shfl_xor(s, 16); s += __shfl_xor(s, 32);
                    if (fq == 0) ssq[(size_t)((pn & 1) * 4 + wc) * MPAD + row] = s; }
            return; }
        {
            unsigned char* base = pn < 4 ? naq : nak; const int colt = (pn & 3) * 256 + colu;
#pragma unroll
            for (int ai = 0; ai < 2; ++ai)
#pragma unroll
                for (int m = 0; m < 4; ++m) { unsigned char* rp = base + (size_t)(row0 + ai * 128 + m * 16) * 1024 + colt;
#pragma unroll
                    for (int bj = 0; bj < 2; ++bj) *(GAS u32x2*)(rp + bj * 128) = pack8_fp8(acc[ai][bj][m][0], acc[ai][bj][m][1]); }
        }
    }
};
constexpr int P3_Q = 64 * 12, P3_K = 65 * 8, P3_V = 8 * 65, P3_UNITS = P3_Q + P3_K + P3_V;
struct SchedP3 {
    int G, c; const char* ws; size_t tstep;
    __device__ __forceinline__ bool next(int i, Unit& u) const {
        const int L = i * G + c; if (L >= P3_UNITS) return false;
        if (L < P3_Q) { pg8::grid_order(L, 64, 12, u.pm, u.pn); u.kind = 0; }
        else if (L < P3_Q + P3_K) { pg8::grid_order(L - P3_Q, 65, 8, u.pm, u.pn); u.kind = 1; }
        else { const int idx = L - P3_Q - P3_K; u.pm = idx & 7; u.pn = idx >> 3; u.kind = 2; }
        return true; }
    __device__ __forceinline__ const char* pa(const Unit& u) const { const size_t o = u.kind == 0 ? WS_CQ : (u.kind == 1 ? WS_CKV : WS_WUKV + (size_t)2048 * 512); return ws + o + (size_t)u.pm * tstep; }
    __device__ __forceinline__ const char* pb(const Unit& u) const { const size_t o = u.kind == 0 ? WS_WUQ : (u.kind == 1 ? WS_WUKV : WS_CKV); return ws + o + (size_t)u.pn * tstep; }
};
template <int NS, int LD> __device__ __forceinline__ float rstd_slabs(const float* part, int row, float invn) {
    float s = 0.f;
#pragma unroll
    for (int i = 0; i < NS; ++i) s += part[(size_t)i * LD + row];
    return 1.0f / sqrtf(s * invn + NORM_EPS);
}
struct EpiP3 {
    static constexpr bool PERM = true, HAS_PRE = true;
    unsigned char *qm, *kn, *vt; const float *ssq_q, *ssq_kv; const float *cosT, *sinT;
    __device__ __forceinline__ void pre(const Unit& u, LAS float* sc, int tid) const { if (tid < 256) { const int row = (u.kind == 2 ? u.pn : u.pm) * 256 + tid; sc[tid] = u.kind ? rstd_slabs<8, MPAD>(ssq_kv, row, 1.f / 512.f) : rstd_slabs<8, MPAD>(ssq_q, row, 1.f / 512.f); } }
    __device__ __forceinline__ void operator()(const f32x4 (&acc)[2][2][4][2], const Unit& u, int wr, int wc, int fr, int fq, const LAS float* rowsc) const {
        const int row0 = u.pm * 256 + wr * 64 + fr, colu = wc * 32 + 8 * fq;
        if (u.kind == 2) {
#pragma unroll
            for (int bj = 0; bj < 2; ++bj) { const int cl = bj * 128 + colu, t0 = u.pn * 256 + cl;
                const f32x4 s0 = *(const LAS f32x4*)(rowsc + cl), s1 = *(const LAS f32x4*)(rowsc + cl + 4);
                const int g = (t0 >> 3) & 7, pos = (t0 & ~63) + 16 * (g >> 2) + 4 * (g & 3);
#pragma unroll
                for (int ai = 0; ai < 2; ++ai)
#pragma unroll
                    for (int m = 0; m < 4; ++m) { unsigned char* rp = vt + (size_t)(row0 + ai * 128 + m * 16) * MPAD + pos;
                        *(GAS unsigned*)rp = pack4_fp8(acc[ai][bj][m][0] * s0); *(GAS unsigned*)(rp + 32) = pack4_fp8(acc[ai][bj][m][1] * s1); } }
            return; }
        if (u.kind == 1) {
#pragma unroll
            for (int ai = 0; ai < 2; ++ai)
#pragma unroll
                for (int m = 0; m < 4; ++m) { const int row = row0 + ai * 128 + m * 16; const float rs = rowsc[ai * 128 + wr * 64 + m * 16 + fr];
                    unsigned char* rp = kn + (size_t)row * 2048 + u.pn * 256 + colu;
#pragma unroll
                    for (int bj = 0; bj < 2; ++bj) *(GAS u32x2*)(rp + bj * 128) = pack8_fp8(acc[ai][bj][m][0] * rs, acc[ai][bj][m][1] * rs); }
            return; }
#pragma unroll
        for (int bj = 0; bj < 2; ++bj) { const int c8 = u.pn * 256 + bj * 128 + colu; const int hd = c8 / 192, w = c8 - hd * 192;
            if (w < 128) {
#pragma unroll
                for (int ai = 0; ai < 2; ++ai)
#pragma unroll
                    for (int m = 0; m < 4; ++m) { const int row = row0 + ai * 128 + m * 16; const float rs = rowsc[ai * 128 + wr * 64 + m * 16 + fr];
                        *(GAS u32x2*)(qm + (size_t)row * 3072 + c8) = pack8_fp8(acc[ai][bj][m][0] * rs, acc[ai][bj][m][1] * rs); }
            } else { const int j0 = (w - 128) >> 1;
#pragma unroll
                for (int ai = 0; ai < 2; ++ai)
#pragma unroll
                    for (int m = 0; m < 4; ++m) { const int row = row0 + ai * 128 + m * 16; const float rs = rowsc[ai * 128 + wr * 64 + m * 16 + fr];
                        const int pos = NMETA + (row & (SEQ - 1)); f32x4 lo, hi; rope4(acc[ai][bj][m][0] * rs, acc[ai][bj][m][1] * rs, cosT, sinT, pos, j0, lo, hi);
                        unsigned char* qp = qm + (size_t)row * 3072 + hd * 192 + 128 + j0; *(GAS unsigned*)qp = pack4_fp8(lo); *(GAS unsigned*)(qp + 32) = pack4_fp8(hi); }
            } }
    }
};

__device__ __forceinline__ void unpack8(const u32x4 w, f32x4& a, f32x4& b) { a = (f32x4){bf_lo(w.x), bf_hi(w.x), bf_lo(w.y), bf_hi(w.y)}; b = (f32x4){bf_lo(w.z), bf_hi(w.z), bf_lo(w.w), bf_hi(w.w)}; }
struct EpiP5a {
    static constexpr bool PERM = true, HAS_PRE = false;
    const unsigned char* ga; unsigned char* t1;
    __device__ __forceinline__ void operator()(const f32x4 (&acc)[2][2][4][2], const Unit& u, int wr, int wc, int fr, int fq, const LAS float* rowsc) const {
        const int row0 = u.pm * 256 + wr * 64 + fr, col0 = u.pn * 256 + wc * 32 + 8 * fq;
#pragma unroll
        for (int ai = 0; ai < 2; ++ai)
#pragma unroll
            for (int m = 0; m < 4; ++m) { const size_t off = (size_t)(row0 + ai * 128 + m * 16) * 2048 + col0;
#pragma unroll
                for (int bj = 0; bj < 2; ++bj) { f32x4 g0, g1; unpack8_u8(*(const GAS u32x2*)(ga + off + bj * 128), g0, g1);
                    *(GAS u32x2*)(t1 + off + bj * 128) = pack8_fp8(acc[ai][bj][m][0] * g0 * 32.f, acc[ai][bj][m][1] * g1 * 32.f); } }
    }
};
struct EpiP5b {
    static constexpr bool PERM = true, HAS_PRE = false;
    const unsigned char* gb; const unsigned char* t1; unsigned char* merged;
    __device__ __forceinline__ void operator()(const f32x4 (&acc)[2][2][4][2], const Unit& u, int wr, int wc, int fr, int fq, const LAS float* rowsc) const {
        const int row0 = u.pm * 256 + wr * 64 + fr, col0 = u.pn * 256 + wc * 32 + 8 * fq;
#pragma unroll
        for (int ai = 0; ai < 2; ++ai)
#pragma unroll
            for (int m = 0; m < 4; ++m) { const size_t off = (size_t)(row0 + ai * 128 + m * 16) * 2048 + col0;
#pragma unroll
                for (int bj = 0; bj < 2; ++bj) { f32x4 g0, g1; unpack8_u8(*(const GAS u32x2*)(gb + off + bj * 128), g0, g1);
                    f32x4 a, b; unpack8_fp8(*(const GAS u32x2*)(t1 + off + bj * 128), a, b);
                    *(GAS u32x2*)(merged + off + bj * 128) = pack8_fp8(a + acc[ai][bj][m][0] * g0 * 32.f, b + acc[ai][bj][m][1] * g1 * 32.f); } }
    }
};
struct EpiP6 {
    static constexpr bool PERM = true, HAS_PRE = false;
    const float* x; bf16_t* h2b; float* ssq2;
    __device__ __forceinline__ void operator()(const f32x4 (&acc)[2][2][4][2], const Unit& u, int wr, int wc, int fr, int fq, const LAS float* rowsc) const {
        const int row0 = u.pm * 256 + wr * 64 + fr, col0 = u.pn * 256 + wc * 32 + 8 * fq;
#pragma unroll
        for (int ai = 0; ai < 2; ++ai)
#pragma unroll
            for (int m = 0; m < 4; ++m) { const int row = row0 + ai * 128 + m * 16; const size_t off = (size_t)row * 2048 + col0; float s = 0.f;
#pragma unroll
                for (int bj = 0; bj < 2; ++bj) { const f32x4 a = *(const GAS f32x4*)(x + off + bj * 128) + acc[ai][bj][m][0], b = *(const GAS f32x4*)(x + off + bj * 128 + 4) + acc[ai][bj][m][1];
                    s += (a[0] * a[0] + a[1] * a[1]) + (a[2] * a[2] + a[3] * a[3]) + (b[0] * b[0] + b[1] * b[1]) + (b[2] * b[2] + b[3] * b[3]);
                    *(GAS u32x4*)(h2b + off + bj * 128) = pack8(a, b); }
                s += __shfl_xor(s, 16); s += __shfl_xor(s, 32);
                if (fq == 0) ssq2[(size_t)(u.pn * 4 + wc) * MREAL + row] = s; }
    }
};
struct EpiP7 {
    static constexpr bool PERM = true, HAS_PRE = true;
    const float* ssq2; _Float16* sc;
    __device__ __forceinline__ void pre(const Unit& u, LAS float* sc, int tid) const { if (tid < 256) sc[tid] = rstd_slabs<32, MREAL>(ssq2, u.pm * 256 + tid, 1.f / 2048.f); }
    __device__ __forceinline__ void operator()(const f32x4 (&acc)[2][2][4][2], const Unit& u, int wr, int wc, int fr, int fq, const LAS float* rowsc) const {
        typedef _Float16 h4_t __attribute__((ext_vector_type(4)));
        const int row0 = u.pm * 256 + wr * 64 + fr, col0 = u.pn * 256 + wc * 32 + 8 * fq;
#pragma unroll
        for (int ai = 0; ai < 2; ++ai)
#pragma unroll
            for (int m = 0; m < 4; ++m) { const int row = row0 + ai * 128 + m * 16; const float rs = rowsc[ai * 128 + wr * 64 + m * 16 + fr]; const size_t off = (size_t)row * 2048 + col0;
#pragma unroll
                for (int bj = 0; bj < 2; ++bj) { const h4_t lo = __builtin_convertvector(acc[ai][bj][m][0] * rs, h4_t), hi = __builtin_convertvector(acc[ai][bj][m][1] * rs, h4_t);
                    const u32x2 wl = __builtin_bit_cast(u32x2, lo), wh = __builtin_bit_cast(u32x2, hi);
                    *(GAS u32x4*)(sc + off + bj * 128) = (u32x4){wl.x, wl.y, wh.x, wh.y}; } }
    }
};
namespace att {
constexpr float L2E = 1.4426950408889634f;
constexpr int NW = 8, QBLK = 32, KVBLK = 64;
constexpr float MLA_SCALE = 0.07216878364870322f;
constexpr int K8S = 208, V8S = 80, SHM8_K = 64 * K8S, SHM8_V = 128 * V8S;
constexpr int OFF8_K = 0, OFF8_V = 2 * SHM8_K, OFF8_WS = OFF8_V + 2 * SHM8_V, MLA8_LDS = OFF8_WS + NW * 64 * 4;
constexpr float MLA8_THR = 1.9f;
typedef int a8_t __attribute__((ext_vector_type(8)));
#define MFMA8Z(acc_, a_, b_, sa_, sb_) asm volatile("s_nop 1\n\tv_mfma_scale_f32_32x32x64_f8f6f4 %0, %1, %2, 0, %3, %4 op_sel_hi:[0,0,0]" : "=&v"(acc_) : "v"(a_), "v"(b_), "v"(sa_), "v"(sb_))
#define MFMA8(acc_, a_, b_, sa_, sb_) asm volatile("s_nop 1\n\tv_mfma_scale_f32_32x32x64_f8f6f4 %0, %1, %2, %0, %3, %4 op_sel_hi:[0,0,0]" : "+v"(acc_) : "v"(a_), "v"(b_), "v"(sa_), "v"(sb_))
#define CAT8(lo_, hi_) __builtin_bit_cast(a8_t, __builtin_shufflevector(lo_, hi_, 0, 1, 2, 3, 4, 5, 6, 7))
__device__ __forceinline__ a8_t ld_frag8(const LAS char* p) { const u32x4 lo = *(const LAS u32x4*)p, hi = *(const LAS u32x4*)(p + 16); return CAT8(lo, hi); }
__device__ __forceinline__ void qkt8(f32x16& p0, f32x16& p1, const LAS char* Kb, const a8_t& q0, const a8_t& q1, const a8_t& q2, int s1) {
  { const a8_t a0 = ld_frag8(Kb), a1 = ld_frag8(Kb + 32 * K8S); MFMA8Z(p0, a0, q0, s1, s1); MFMA8Z(p1, a1, q0, s1, s1); }
  { const a8_t a0 = ld_frag8(Kb + 64), a1 = ld_frag8(Kb + 32 * K8S + 64); MFMA8(p0, a0, q1, s1, s1); MFMA8(p1, a1, q1, s1, s1); }
  { const a8_t a0 = ld_frag8(Kb + 128), a1 = ld_frag8(Kb + 32 * K8S + 128); MFMA8(p0, a0, q2, s1, s1); MFMA8(p1, a1, q2, s1, s1); }
  asm volatile("s_nop 15\n\ts_nop 15" : "+v"(p0), "+v"(p1));
}
__device__ __forceinline__ void partialSM8(f32x16& p0, f32x16& p1, float& m_reg, float& mn, float& alpha, const float C, const float THRS) {
  float pmax = p0[0];
#pragma unroll
  for (int r = 1; r < 16; ++r) pmax = fmaxf(pmax, p0[r]);
#pragma unroll
  for (int r = 0; r < 16; ++r) pmax = fmaxf(pmax, p1[r]);
  { auto rr = __builtin_amdgcn_permlane32_swap(__float_as_uint(pmax), __float_as_uint(pmax), false, false);
    pmax = fmaxf(__uint_as_float(rr[0]), __uint_as_float(rr[1])); }
  if (__builtin_expect(__all(pmax - m_reg <= THRS), 1)) { mn = m_reg; alpha = 1.f; }
  else { mn = fmaxf(m_reg, pmax); alpha = __builtin_amdgcn_exp2f((m_reg - mn) * C); m_reg = mn; }
  const float mnC = 6.f - mn * C;
#pragma unroll
  for (int r = 0; r < 16; ++r) p0[r] = fmaf(p0[r], C, mnC);
#pragma unroll
  for (int r = 0; r < 16; ++r) p1[r] = fmaf(p1[r], C, mnC);
#pragma unroll
  for (int r = 0; r < 16; ++r) p0[r] = __builtin_amdgcn_exp2f(p0[r]);
}
__device__ __forceinline__ void finishSM8(f32x16& p0, f32x16& p1, float alpha, float& l_reg, a8_t& pf) {
#pragma unroll
  for (int r = 0; r < 16; ++r) p1[r] = __builtin_amdgcn_exp2f(p1[r]);
  float ps = 0;
#pragma unroll
  for (int r = 0; r < 16; ++r) ps += p0[r];
#pragma unroll
  for (int r = 0; r < 16; ++r) ps += p1[r];
  { auto rr = __builtin_amdgcn_permlane32_swap(__float_as_uint(ps), __float_as_uint(ps), false, false);
    ps = __uint_as_float(rr[0]) + __uint_as_float(rr[1]); }
  l_reg = l_reg * alpha + ps;
#pragma unroll
  for (int w = 0; w < 4; ++w) { int x = 0, y = 0;
    x = __builtin_amdgcn_cvt_pk_fp8_f32(p0[4 * w], p0[4 * w + 1], x, false); x = __builtin_amdgcn_cvt_pk_fp8_f32(p0[4 * w + 2], p0[4 * w + 3], x, true);
    y = __builtin_amdgcn_cvt_pk_fp8_f32(p1[4 * w], p1[4 * w + 1], y, false); y = __builtin_amdgcn_cvt_pk_fp8_f32(p1[4 * w + 2], p1[4 * w + 3], y, true);
    pf[w] = x; pf[4 + w] = y; }
}
__device__ __forceinline__ void pv8(f32x16* o, const LAS char* Vb, const a8_t& pf, int sP, int s1) {
  const a8_t b0 = ld_frag8(Vb), b1 = ld_frag8(Vb + 32 * V8S), b2 = ld_frag8(Vb + 64 * V8S), b3 = ld_frag8(Vb + 96 * V8S);
  MFMA8(o[0], pf, b0, sP, s1); MFMA8(o[1], pf, b1, sP, s1); MFMA8(o[2], pf, b2, sP, s1); MFMA8(o[3], pf, b3, sP, s1);
  asm volatile("s_nop 15\n\ts_nop 15" : "+v"(o[0]), "+v"(o[1]), "+v"(o[2]), "+v"(o[3]));
}
__device__ __forceinline__ void mla_unit8(int b, int h, int qb, const unsigned char* __restrict__ QM8, const unsigned char* __restrict__ KN8, const unsigned char* __restrict__ KR8, const unsigned char* __restrict__ VT8,
                                          unsigned char* __restrict__ OM, LAS char* lds, Conv& cv) {
  const int tid = threadIdx.x, wid = tid >> 6, lane = tid & 63, r32 = lane & 31, hi = lane >> 5;
  constexpr float C = MLA_SCALE * L2E, THRS = MLA8_THR / MLA_SCALE;
  constexpr int NT = 33;
  LAS char* K_lds = lds + OFF8_K; LAS char* V_lds = lds + OFF8_V;
  LAS float* ws = (LAS float*)(lds + OFF8_WS) + wid * 64; LAS float* li_l = ws; LAS float* al_l = ws + 32;
  int s1 = 0x7f7f7f7f, sP = 0x79797979; asm volatile("" : "+v"(s1), "+v"(sP));
  float m_reg = -1e30f, l_reg = 0; f32x16 o[4] = {};
  const int qrow = b * SEQ + qb * 256 + wid * QBLK + r32;
  a8_t q0, q1, q2;
  { const unsigned char* Qw = QM8 + (size_t)qrow * 3072 + h * 192 + hi * 32;
    const u32x4 a = *(const GAS u32x4*)Qw, bq = *(const GAS u32x4*)(Qw + 16), c = *(const GAS u32x4*)(Qw + 64), d = *(const GAS u32x4*)(Qw + 80), e = *(const GAS u32x4*)(Qw + 128), f = *(const GAS u32x4*)(Qw + 144);
    q0 = CAT8(a, bq); q1 = CAT8(c, d); q2 = CAT8(e, f); }
  __syncthreads();
  const int kkey = tid >> 3, kch = tid & 7, rkey = (tid >> 2) & 63, rch = tid & 3, vdim = tid >> 2, vch = tid & 3;
  const LAS char* Kf = K_lds + r32 * K8S + 32 * hi; const LAS char* Vf = V_lds + r32 * V8S + 32 * hi;
  const unsigned offk = (unsigned)(kkey * 2048 + kch * 16), offr = (unsigned)(rkey * 64 + rch * 16), offv = (unsigned)(vdim * MPAD + vch * 16);
  u32x4 kA, rA, vA, kB, rB, vB;
  const int realbase = b * SEQ - KVBLK;
#define TROW(t) ((t) == 0 ? MREAL : realbase + (t) * KVBLK)
#define SLOADX(t, K_, R_, V_) do { const int k0_ = TROW(t); \
    K_ = *(const GAS u32x4*)(KN8 + ((size_t)k0_ * 2048 + h * 128) + offk); \
    R_ = *(const GAS u32x4*)(KR8 + (size_t)k0_ * 64 + offr); \
    V_ = *(const GAS u32x4*)(VT8 + ((size_t)h * 128 * MPAD + k0_) + offv); } while (0)
#define SWRITEX(bf, K_, R_, V_) do { *(LAS u32x4*)(K_lds + (bf) * SHM8_K + kkey * K8S + kch * 16) = K_; if (tid < 256) *(LAS u32x4*)(K_lds + (bf) * SHM8_K + rkey * K8S + 128 + rch * 16) = R_; \
    *(LAS u32x4*)(V_lds + (bf) * SHM8_V + vdim * V8S + vch * 16) = V_; } while (0)
#define CONV_HOOK() do { cvi = false; if ((cv.tick++ & 3) == 0) { int lane_ = lane; asm volatile("" : "+v"(lane_));     \
      if (cv.pend >= 0) { asm volatile("s_waitcnt vmcnt(6)" ::: "memory"); conv_finish(cv, cv.pend, lane_); cv.pend = -1; asm volatile("s_waitcnt lgkmcnt(0)" ::: "memory"); } \
      if (cv.next < cv.end) { conv_issue(cv, cv.next, lane_); cv.pend = cv.next; cv.next += cv.stride; cvi = true; } } } while (0)
#define WAITX(nl) do { const int n_ = (nl) + ((cvi || cvp) ? 8 : 0); \
    if (n_ == 11) asm volatile("s_waitcnt vmcnt(11)" ::: "memory"); else if (n_ == 8) asm volatile("s_waitcnt vmcnt(8)" ::: "memory"); \
    else if (n_ == 3) asm volatile("s_waitcnt vmcnt(3)" ::: "memory"); else asm volatile("s_waitcnt vmcnt(0)" ::: "memory"); } while (0)
#define SWAIT0() asm volatile("s_waitcnt vmcnt(0)" ::: "memory")
#define RESC(a) do { if (__any((a) < 1.f)) { if (hi == 0) al_l[r32] = (a); asm volatile("s_waitcnt lgkmcnt(0)" ::: "memory"); \
    _Pragma("unroll") for (int d = 0; d < 4; ++d) _Pragma("unroll") for (int r = 0; r < 16; ++r) o[d][r] *= al_l[crow(r, hi)]; } } while (0)
  f32x16 pA0, pA1, pB0, pB1; float mnA, mnB, alA, alB; a8_t pf = {}; bool cvi = false, cvp = false;
#define QK_FIN(N0, N1, KB, O0, O1, AL) do { float ps_ = 0.f; \
    a8_t fa_ = ld_frag8(KB), fb_ = ld_frag8((KB) + 32 * K8S);        \
    MFMA8Z(N0, fa_, q0, s1, s1); _Pragma("unroll") for (int r = 0; r < 8; ++r) O1[r] = __builtin_amdgcn_exp2f(O1[r]); SBAR(); \
    MFMA8Z(N1, fb_, q0, s1, s1); fa_ = ld_frag8((KB) + 64); _Pragma("unroll") for (int r = 8; r < 16; ++r) O1[r] = __builtin_amdgcn_exp2f(O1[r]); SBAR(); \
    MFMA8(N0, fa_, q1, s1, s1); fb_ = ld_frag8((KB) + 32 * K8S + 64); _Pragma("unroll") for (int r = 0; r < 16; ++r) ps_ += O0[r]; SBAR(); \
    MFMA8(N1, fb_, q1, s1, s1); fa_ = ld_frag8((KB) + 128); _Pragma("unroll") for (int r = 0; r < 16; ++r) ps_ += O1[r]; \
      { auto rr = __builtin_amdgcn_permlane32_swap(__float_as_uint(ps_), __float_as_uint(ps_), false, false); ps_ = __uint_as_float(rr[0]) + __uint_as_float(rr[1]); } l_reg = l_reg * (AL) + ps_; SBAR(); \
    MFMA8(N0, fa_, q2, s1, s1); fb_ = ld_frag8((KB) + 32 * K8S + 128); _Pragma("unroll") for (int w = 0; w < 4; ++w) { int x = pf[w]; x = __builtin_amdgcn_cvt_pk_fp8_f32(O0[4 * w], O0[4 * w + 1], x, false); x = __builtin_amdgcn_cvt_pk_fp8_f32(O0[4 * w + 2], O0[4 * w + 3], x, true); pf[w] = x; } SBAR();        \
    MFMA8(N1, fb_, q2, s1, s1); _Pragma("unroll") for (int w = 0; w < 4; ++w) { int y = pf[4 + w]; y = __builtin_amdgcn_cvt_pk_fp8_f32(O1[4 * w], O1[4 * w + 1], y, false); y = __builtin_amdgcn_cvt_pk_fp8_f32(O1[4 * w + 2], O1[4 * w + 3], y, true); pf[4 + w] = y; } SBAR(); \
  } while (0)
#define PV_PART(VB, N0, N1, MN, AL) do { \
    a8_t va_ = ld_frag8(VB), vb_ = ld_frag8((VB) + 32 * V8S); \
    MFMA8(o[0], pf, va_, sP, s1); asm volatile("s_nop 15\n\ts_nop 15" : "+v"(N0), "+v"(N1));      \
      float pmax_ = N0[0]; _Pragma("unroll") for (int r = 1; r < 16; ++r) pmax_ = fmaxf(pmax_, N0[r]); SBAR(); \
    MFMA8(o[1], pf, vb_, sP, s1); va_ = ld_frag8((VB) + 64 * V8S); _Pragma("unroll") for (int r = 0; r < 16; ++r) pmax_ = fmaxf(pmax_, N1[r]); \
      { auto rr = __builtin_amdgcn_permlane32_swap(__float_as_uint(pmax_), __float_as_uint(pmax_), false, false); pmax_ = fmaxf(__uint_as_float(rr[0]), __uint_as_float(rr[1])); } \
      if (__builtin_expect(__all(pmax_ - m_reg <= THRS), 1)) { MN = m_reg; AL = 1.f; } else { MN = fmaxf(m_reg, pmax_); AL = __builtin_amdgcn_exp2f((m_reg - MN) * C); m_reg = MN; } SBAR(); \
    MFMA8(o[2], pf, va_, sP, s1); vb_ = ld_frag8((VB) + 96 * V8S); { const float mnC_ = 6.f - MN * C; _Pragma("unroll") for (int r = 0; r < 16; ++r) { N0[r] = fmaf(N0[r], C, mnC_); N1[r] = fmaf(N1[r], C, mnC_); } } SBAR(); \
    MFMA8(o[3], pf, vb_, sP, s1); _Pragma("unroll") for (int r = 0; r < 16; ++r) N0[r] = __builtin_amdgcn_exp2f(N0[r]); SBAR(); \
    asm volatile("s_nop 15\n\ts_nop 15" : "+v"(o[0]), "+v"(o[1]), "+v"(o[2]), "+v"(o[3])); } while (0)
  SLOADX(0, kA, rA, vA); SWAIT0(); SWRITEX(0, kA, rA, vA); __syncthreads();
  qkt8(pA0, pA1, Kf, q0, q1, q2, s1);
  { const float NEG = -INFINITY;
#pragma unroll
    for (int r = 8; r < 16; ++r) pA0[r] = NEG;
#pragma unroll
    for (int r = 0; r < 16; ++r) pA1[r] = NEG; }
  partialSM8(pA0, pA1, m_reg, mnA, alA, C, THRS);
  SLOADX(1, kA, rA, vA); SWAIT0(); SWRITEX(1, kA, rA, vA);
  SLOADX(2, kA, rA, vA);
  __syncthreads();
  for (int j = 1; j + 1 < NT; j += 2) {
    SBAR(); QK_FIN(pB0, pB1, Kf + SHM8_K, pA0, pA1, alA);
    const bool l1 = j + 2 < NT; if (l1) SLOADX(j + 2, kB, rB, vB); CONV_HOOK(); SBAR();
    PV_PART(Vf, pB0, pB1, mnB, alB);
    __syncthreads(); WAITX(l1 ? 3 : 0); SWRITEX(0, kA, rA, vA); cvp = cvi;
    RESC(alB); __syncthreads();
    SBAR(); QK_FIN(pA0, pA1, Kf, pB0, pB1, alB);
    const bool l2 = j + 3 < NT; if (l2) SLOADX(j + 3, kA, rA, vA); CONV_HOOK(); SBAR();
    PV_PART(Vf + SHM8_V, pA0, pA1, mnA, alA);
    __syncthreads(); if (l1) { WAITX(l2 ? 3 : 0); SWRITEX(1, kB, rB, vB); } cvp = cvi;
    RESC(alA); __syncthreads();
  }
  finishSM8(pA0, pA1, alA, l_reg, pf); SBAR();
  pv8(o, Vf, pf, sP, s1);
  if (hi == 0) li_l[r32] = l_reg; asm volatile("s_waitcnt lgkmcnt(0)" ::: "memory");
  float rli[16];
#pragma unroll
  for (int r = 0; r < 16; ++r) rli[r] = __builtin_amdgcn_rcpf(li_l[crow(r, hi)]) * (64.f * 32.f);
  unsigned char* Ow = OM + (size_t)(b * SEQ + qb * 256 + wid * QBLK) * 2048 + h * 128;
#pragma unroll
  for (int r = 0; r < 16; ++r) { const int orow = crow(r, hi);
#pragma unroll
    for (int d0 = 0; d0 < 4; ++d0) Ow[(size_t)orow * 2048 + d0 * 32 + r32] = f32_to_fp8(o[d0][r] * rli[r]); }
#undef TROW
#undef SLOADX
#undef SWRITEX
#undef WAITX
#undef SWAIT0
#undef QK_FIN
#undef PV_PART
#undef RESC
#undef CONV_HOOK
}
__device__ __forceinline__ void na_task(int task, const unsigned char* __restrict__ NAQ, const unsigned char* __restrict__ NAK, const unsigned char* __restrict__ VT, unsigned char* __restrict__ ONA,
                                        const LAS float* relb, const LAS float* metab, LAS float* wsf, int lane) {
  const int r32 = lane & 31, hi = lane >> 5;
  const int half = task & 1, r = (task >> 1) & 31, h = (task >> 6) & 15, b = task >> 10;
  const int qc = half * 32 + r32;
  const int cs = min(max(qc - 8, 0), 48), rs = min(max(r - 4, 0), 24);
  const int qtok = b * SEQ + r * 64 + qc;
  constexpr float C = L2E, THRS = 1.9f, SCALE = 0.125f;
  int s1 = 0x7f7f7f7f, sP = 0x79797979; asm volatile("" : "+v"(s1), "+v"(sP));
  a8_t qf; { const unsigned char* qp = NAQ + (size_t)qtok * 1024 + h * 64 + hi * 32; const u32x4 a = *(const GAS u32x4*)qp, c = *(const GAS u32x4*)(qp + 16);
    qf = CAT8(a, c); }
  float m_reg = -1e30f, l_reg = 0.f; f32x16 o[2] = {};
  LAS float* al_l = wsf; LAS float* li_l = wsf + 32;
  const float NEG = -INFINITY;
  const int kb0 = half * 16;
  const unsigned long long wm = 0xFFFFull << (cs - kb0);
  const unsigned mh0 = (unsigned)wm >> (4 * hi), mh1 = (unsigned)(wm >> 32) >> (4 * hi);
  const unsigned char* kq = NAK + (size_t)r32 * 1024 + h * 64 + hi * 32;
  const unsigned char* kq2 = NAK + (size_t)(32 + (r32 & 15)) * 1024 + h * 64 + hi * 32;
  const unsigned char* vq = VT + (size_t)(h * 64 + r32) * VT_PITCH + 32 * hi;
#define NA_KTOK(w) ((w) == 8 ? MREAL : b * SEQ + (rs + (w)) * 64 + kb0)
#define NA_VOFF(w) ((w) == 8 ? MREAL : b * SEQ + (rs + (w)) * 64 + (kb0 >> 1))
#define NA_LOADK(KF, w) do { const size_t ko_ = (size_t)NA_KTOK(w) * 1024; KF[0] = *(const GAS u32x4*)(kq + ko_); KF[1] = *(const GAS u32x4*)(kq + ko_ + 16); KF[2] = *(const GAS u32x4*)(kq2 + ko_); KF[3] = *(const GAS u32x4*)(kq2 + ko_ + 16); } while (0)
#define NA_A8(x_, y_) CAT8(x_, y_)
#define NA_TILE(KF, wt, YN) do { \
    u32x4 va0, va1; u32x2 vb0_, vb1_; { const unsigned char* vp_ = vq + NA_VOFF(wt); va0 = *(const GAS u32x4*)vp_; vb0_ = *(const GAS u32x2*)(vp_ + 16); va1 = *(const GAS u32x4*)(vp_ + (size_t)32 * VT_PITCH); vb1_ = *(const GAS u32x2*)(vp_ + (size_t)32 * VT_PITCH + 16); } \
    f32x16 p0, p1; \
    { const a8_t k0_ = NA_A8(KF[0], KF[1]), k1_ = NA_A8(KF[2], KF[3]); MFMA8Z(p0, k0_, qf, s1, s1); MFMA8Z(p1, k1_, qf, s1, s1); asm volatile("s_nop 15\n\ts_nop 15" : "+v"(p0), "+v"(p1)); } \
    if ((wt) + 1 < 9) NA_LOADK(KF, (wt) + 1);            \
      \
    if ((wt) < 8) { const LAS float* bp_ = relb + ((h * 15 + (rs + (wt) - r + 7)) * 31 + 15 - qc + 4 * hi + kb0);     \
      float bv0[16], bv1[8];        \
      _Pragma("unroll") for (int rg = 0; rg < 16; ++rg) { const int c_ = (rg & 3) + 8 * (rg >> 2); bv0[rg] = bp_[c_]; if (rg < 8) bv1[rg] = bp_[c_ + 32]; } \
      _Pragma("unroll") for (int rg = 0; rg < 16; ++rg) { asm volatile("" : "+v"(bv0[rg])); if (rg < 8) asm volatile("" : "+v"(bv1[rg])); } \
      _Pragma("unroll") for (int rg = 0; rg < 16; ++rg) { const int c_ = (rg & 3) + 8 * (rg >> 2); \
        { const bool ok = (mh0 >> c_) & 1u; p0[rg] = ok ? fmaf(p0[rg], SCALE, bv0[rg]) : NEG; } \
        if (rg < 8) { const bool ok = (mh1 >> c_) & 1u; p1[rg] = ok ? fmaf(p1[rg], SCALE, bv1[rg]) : NEG; } } \
    } else { const LAS float* bp = metab + h * 16; \
      _Pragma("unroll") for (int rg = 0; rg < 16; ++rg) { const int kc = crow(rg, hi); p0[rg] = (rg < 8) ? fmaf(p0[rg], SCALE, bp[kc & 15]) : NEG; if (rg < 8) p1[rg] = NEG; } } \
      \
    float pmax = p0[0]; \
    _Pragma("unroll") for (int rg = 1; rg < 16; ++rg) pmax = fmaxf(pmax, p0[rg]); \
    _Pragma("unroll") for (int rg = 0; rg < 8; ++rg) pmax = fmaxf(pmax, p1[rg]); \
    { auto rr = __builtin_amdgcn_permlane32_swap(__float_as_uint(pmax), __float_as_uint(pmax), false, false); pmax = fmaxf(__uint_as_float(rr[0]), __uint_as_float(rr[1])); } \
    float mn, alpha; \
    if (__builtin_expect(__all(pmax - m_reg <= THRS), 1)) { mn = m_reg; alpha = 1.f; } \
    else { mn = fmaxf(m_reg, pmax); alpha = __builtin_amdgcn_exp2f((m_reg - mn) * C); m_reg = mn; } \
    const float mnC = 6.f - mn * C; float ps = 0.f;        \
    _Pragma("unroll") for (int rg = 0; rg < 16; ++rg) { p0[rg] = __builtin_amdgcn_exp2f(fmaf(p0[rg], C, mnC)); ps += p0[rg]; } \
    _Pragma("unroll") for (int rg = 0; rg < 8; ++rg) { p1[rg] = __builtin_amdgcn_exp2f(fmaf(p1[rg], C, mnC)); ps += p1[rg]; } \
    { auto rr = __builtin_amdgcn_permlane32_swap(__float_as_uint(ps), __float_as_uint(ps), false, false); ps = __uint_as_float(rr[0]) + __uint_as_float(rr[1]); } \
    l_reg = l_reg * alpha + ps; \
    a8_t pf;   \
    _Pragma("unroll") for (int w_ = 0; w_ < 4; ++w_) { int x = 0; x = __builtin_amdgcn_cvt_pk_fp8_f32(p0[4 * w_], p0[4 * w_ + 1], x, false); x = __builtin_amdgcn_cvt_pk_fp8_f32(p0[4 * w_ + 2], p0[4 * w_ + 3], x, true); pf[w_] = x; } \
    _Pragma("unroll") for (int w_ = 0; w_ < 2; ++w_) { int x = 0; x = __builtin_amdgcn_cvt_pk_fp8_f32(p1[4 * w_], p1[4 * w_ + 1], x, false); x = __builtin_amdgcn_cvt_pk_fp8_f32(p1[4 * w_ + 2], p1[4 * w_ + 3], x, true); pf[4 + w_] = x; } \
    pf[6] = 0; pf[7] = 0; \
    if (__any(alpha < 1.f)) { if (hi == 0) al_l[r32] = alpha; asm volatile("s_waitcnt lgkmcnt(0)" ::: "memory"); \
      _Pragma("unroll") for (int d = 0; d < 2; ++d) _Pragma("unroll") for (int rg = 0; rg < 16; ++rg) o[d][rg] *= al_l[crow(rg, hi)]; } \
    { const u32x4 z0_ = (u32x4){vb0_.x, vb0_.y, 0u, 0u}, z1_ = (u32x4){vb1_.x, vb1_.y, 0u, 0u}; const a8_t v0_ = CAT8(va0, z0_), v1_ = CAT8(va1, z1_); \
      MFMA8(o[0], pf, v0_, sP, s1); MFMA8(o[1], pf, v1_, sP, s1); asm volatile("s_nop 15\n\ts_nop 15" : "+v"(o[0]), "+v"(o[1])); } } while (0)
  { u32x4 kA[4];
    NA_LOADK(kA, 0);
#pragma unroll 1
    for (int w = 0; w < 8; ++w) { NA_TILE(kA, w, 12); }
    NA_TILE(kA, 8, 12); }
#undef NA_KTOK
#undef NA_VOFF
#undef NA_LOADK
#undef NA_A8
#undef NA_TILE
  if (hi == 0) li_l[r32] = l_reg; asm volatile("s_waitcnt lgkmcnt(0)" ::: "memory");
  unsigned char* Ow = ONA + (size_t)(b * SEQ + r * 64 + half * 32) * 1024 + h * 64;
#pragma unroll
  for (int rg = 0; rg < 16; ++rg) { const int orow = crow(rg, hi); const float rl = __builtin_amdgcn_rcpf(li_l[orow]) * (64.f * 16.f);
#pragma unroll
    for (int d0 = 0; d0 < 2; ++d0) Ow[(size_t)orow * 1024 + d0 * 32 + r32] = f32_to_fp8(o[d0][rg] * rl); }
  asm volatile("s_waitcnt lgkmcnt(0)" ::: "memory");
}
}
namespace peer {
constexpr int CH = 32;
constexpr int OFF_TV = 0, OFF_TI = OFF_TV + CH * 16 * 16 * 4, OFF_SE = OFF_TI + CH * 16 * 16 * 4, OFF_SG = OFF_SE + CH * 128 * 4, OFF_SE2 = OFF_SG + CH * 128 * 4, OFF_SG2 = OFF_SE2 + CH * 128 * 4, PEER_LDS = OFF_SG2 + CH * 128 * 4;
static_assert(PEER_LDS <= RING_BYTES, "PEER LDS");
__device__ __forceinline__ float gelu_tanh(float x) {
    const float u = 0.7978845608028654f * (x + 0.044715f * x * x * x);
    const float e = __builtin_amdgcn_exp2f(-2.f * 1.4426950408889634f * fabsf(u));
    const float t = (1.f - e) * __builtin_amdgcn_rcpf(1.f + e);
    return 0.5f * x * (1.f + (u < 0.f ? -t : t));
}
__device__ __forceinline__ void fmac1(float& acc, float a, float b) { asm("v_fmac_f32_e32 %0, %1, %2" : "+v"(acc) : "v"(a), "v"(b)); }
#define PEER_INSERT(x_, xi_) do { float x__ = (x_); int xi__ = (xi_); \
    _Pragma("unroll") for (int j_ = 0; j_ < 16; ++j_) { const bool gt_ = x__ > tv[j_]; const float tvo_ = tv[j_]; const int tio_ = ti[j_]; \
        tv[j_] = gt_ ? x__ : tvo_; ti[j_] = gt_ ? xi__ : tio_; x__ = gt_ ? tvo_ : x__; xi__ = gt_ ? tio_ : xi__; } } while (0)

#define PEER_AUX 0
typedef __amdgpu_buffer_rsrc_t rsrc_t;
__device__ __forceinline__ rsrc_t mk_rsrc(const void* p, unsigned bytes) { return __builtin_amdgcn_make_buffer_rsrc((void*)p, 0, bytes, 0x00020000); }
__device__ __forceinline__ u32x4 ldb128(rsrc_t r, unsigned off) { return __builtin_amdgcn_raw_buffer_load_b128(r, off, 0, PEER_AUX); }
typedef unsigned v6u_t __attribute__((ext_vector_type(6)));
typedef float v32f_t __attribute__((ext_vector_type(32)));
typedef float v16f_t __attribute__((ext_vector_type(16)));
__device__ __forceinline__ u32x2 ldb64(rsrc_t r, unsigned off) { return __builtin_amdgcn_raw_buffer_load_b64(r, off, 0, PEER_AUX); }
__device__ __forceinline__ f32x4 ldf128(rsrc_t r, unsigned off) { return __builtin_bit_cast(f32x4, __builtin_amdgcn_raw_buffer_load_b128(r, off, 0, PEER_AUX)); }
__device__ __forceinline__ f32x4 ldf128_nt(rsrc_t r, unsigned off) { return __builtin_bit_cast(f32x4, __builtin_amdgcn_raw_buffer_load_b128(r, off, 0, 2)); }
__device__ __forceinline__ void peer_select(int chunk, const _Float16* __restrict__ SC, LAS char* lds, int tid, LAS int* SE, LAS float* SG) {
    LAS float* TV = (LAS float*)(lds + OFF_TV); LAS int* TI = (LAS int*)(lds + OFF_TI);
    asm volatile("" : "+v"(tid));
    const int tok0 = chunk * CH;
    const rsrc_t rSC = mk_rsrc(SC, 0x4000000u);
    __syncthreads();
    { const int tl = tid >> 4, g = tid & 15; const unsigned spo = ((unsigned)(tok0 + tl) * 2048u + (unsigned)g * 128u) * 2u;
      int tk[16];
#pragma unroll
      for (int j = 0; j < 16; ++j) tk[j] = (int)0x80000000;
#define PEER_KEY(x_, lowbits_, mask_) ({ const int f_ = __float_as_int(x_); ((f_ ^ ((f_ >> 31) & 0x7fffffff)) & ~(mask_)) | (lowbits_); })
#define PEER_INS(key_) do { int x__ = (key_); _Pragma("unroll") for (int j_ = 0; j_ < 16; ++j_) { const int hi_ = max(x__, tk[j_]); x__ = min(x__, tk[j_]); tk[j_] = hi_; } } while (0)
      typedef _Float16 h8_t __attribute__((ext_vector_type(8)));
#define PEER_CX(a_, b_) do { const int hi_ = max(a_, b_), lo_ = min(a_, b_); a_ = hi_; b_ = lo_; } while (0)
      u32x4 na = __builtin_amdgcn_raw_buffer_load_b128(rSC, spo, 0, 2), nb = __builtin_amdgcn_raw_buffer_load_b128(rSC, spo + 16, 0, 2);
#pragma unroll 1
      for (int i = 0; i < 16; i += 2) { const h8_t a = __builtin_bit_cast(h8_t, na), b = __builtin_bit_cast(h8_t, nb);
          { const unsigned on = spo + (unsigned)min(i + 2, 14) * 16u; na = __builtin_amdgcn_raw_buffer_load_b128(rSC, on, 0, 2); nb = __builtin_amdgcn_raw_buffer_load_b128(rSC, on + 16, 0, 2); }
          int kk[16];
#pragma unroll
          for (int e = 0; e < 8; ++e) { kk[e] = PEER_KEY((float)a[e], 127 - (8 * i + e), 127); kk[8 + e] = PEER_KEY((float)b[e], 127 - (8 * i + 8 + e), 127); }
          PEER_CX(kk[0], kk[13]); PEER_CX(kk[1], kk[12]); PEER_CX(kk[2], kk[15]); PEER_CX(kk[3], kk[14]); PEER_CX(kk[4], kk[8]); PEER_CX(kk[5], kk[6]); PEER_CX(kk[7], kk[11]); PEER_CX(kk[9], kk[10]); PEER_CX(kk[0], kk[5]); PEER_CX(kk[1], kk[7]); PEER_CX(kk[2], kk[9]); PEER_CX(kk[3], kk[4]); PEER_CX(kk[6], kk[13]); PEER_CX(kk[8], kk[14]); PEER_CX(kk[10], kk[15]); PEER_CX(kk[11], kk[12]); PEER_CX(kk[0], kk[1]); PEER_CX(kk[2], kk[3]); PEER_CX(kk[4], kk[5]); PEER_CX(kk[6], kk[8]); PEER_CX(kk[7], kk[9]); PEER_CX(kk[10], kk[11]); PEER_CX(kk[12], kk[13]); PEER_CX(kk[14], kk[15]); PEER_CX(kk[0], kk[2]); PEER_CX(kk[1], kk[3]); PEER_CX(kk[4], kk[10]); PEER_CX(kk[5], kk[11]); PEER_CX(kk[6], kk[7]); PEER_CX(kk[8], kk[9]); PEER_CX(kk[12], kk[14]); PEER_CX(kk[13], kk[15]); PEER_CX(kk[1], kk[2]); PEER_CX(kk[3], kk[12]); PEER_CX(kk[4], kk[6]); PEER_CX(kk[5], kk[7]); PEER_CX(kk[8], kk[10]); PEER_CX(kk[9], kk[11]); PEER_CX(kk[13], kk[14]); PEER_CX(kk[1], kk[4]); PEER_CX(kk[2], kk[6]); PEER_CX(kk[5], kk[8]); PEER_CX(kk[7], kk[10]); PEER_CX(kk[9], kk[13]); PEER_CX(kk[11], kk[14]); PEER_CX(kk[2], kk[4]); PEER_CX(kk[3], kk[6]); PEER_CX(kk[9], kk[12]); PEER_CX(kk[11], kk[13]); PEER_CX(kk[3], kk[5]); PEER_CX(kk[6], kk[8]); PEER_CX(kk[7], kk[9]); PEER_CX(kk[10], kk[12]); PEER_CX(kk[3], kk[4]); PEER_CX(kk[5], kk[6]); PEER_CX(kk[7], kk[8]); PEER_CX(kk[9], kk[10]); PEER_CX(kk[11], kk[12]); PEER_CX(kk[6], kk[7]); PEER_CX(kk[8], kk[9]);
#pragma unroll
          for (int e = 0; e < 16; ++e) tk[e] = max(tk[e], kk[15 - e]);
          PEER_CX(tk[0], tk[8]); PEER_CX(tk[1], tk[9]); PEER_CX(tk[2], tk[10]); PEER_CX(tk[3], tk[11]); PEER_CX(tk[4], tk[12]); PEER_CX(tk[5], tk[13]); PEER_CX(tk[6], tk[14]); PEER_CX(tk[7], tk[15]); PEER_CX(tk[0], tk[4]); PEER_CX(tk[1], tk[5]); PEER_CX(tk[2], tk[6]); PEER_CX(tk[3], tk[7]); PEER_CX(tk[8], tk[12]); PEER_CX(tk[9], tk[13]); PEER_CX(tk[10], tk[14]); PEER_CX(tk[11], tk[15]); PEER_CX(tk[0], tk[2]); PEER_CX(tk[1], tk[3]); PEER_CX(tk[4], tk[6]); PEER_CX(tk[5], tk[7]); PEER_CX(tk[8], tk[10]); PEER_CX(tk[9], tk[11]); PEER_CX(tk[12], tk[14]); PEER_CX(tk[13], tk[15]); PEER_CX(tk[0], tk[1]); PEER_CX(tk[2], tk[3]); PEER_CX(tk[4], tk[5]); PEER_CX(tk[6], tk[7]); PEER_CX(tk[8], tk[9]); PEER_CX(tk[10], tk[11]); PEER_CX(tk[12], tk[13]); PEER_CX(tk[14], tk[15]); }
#undef PEER_CX
      LAS float* tvp = TV + (tl * 16 + g) * 16; LAS int* tip = TI + (tl * 16 + g) * 16;
#pragma unroll
      for (int j = 0; j < 16; ++j) { const int k_ = tk[j] & ~127; tvp[j] = __int_as_float(k_ ^ ((k_ >> 31) & 0x7fffffff)); tip[j] = 127 - (tk[j] & 127); } }
    __syncthreads();
    asm volatile("" : "+v"(tid));
    { const int tl = tid >> 4, hh = (tid >> 1) & 7, half = tid & 1;
      const LAS float* s1 = TV + (tl * 16 + 2 * hh) * 16; const LAS float* s2 = s1 + 16; const LAS int* i1 = TI + (tl * 16 + 2 * hh) * 16; const LAS int* i2 = i1 + 16;
      float b2[16];
#pragma unroll
      for (int j = 0; j < 16; ++j) b2[j] = s2[j];
      int tk[16];
#pragma unroll
      for (int j = 0; j < 16; ++j) tk[j] = (int)0x80000000;
#pragma unroll
      for (int ii = 0; ii < 8; ++ii) { const int i = 2 * ii + half; const float a = s1[i];
#pragma unroll
          for (int j = 0; j < 16; ++j) if ((2 * ii + 1) * (j + 1) <= 16) { if (half == 0 || (2 * ii + 2) * (j + 1) <= 16) PEER_INS(PEER_KEY(a + b2[j], 255 - (i * 16 + j), 255)); } }
      { int pk[16];
#pragma unroll
        for (int j = 0; j < 16; ++j) pk[j] = __shfl_xor(tk[j], 1);
#pragma unroll
        for (int j = 0; j < 16; ++j) PEER_INS(pk[j]); }
      if (half == 0) { float e[16], sum = 0.f; const int k0_ = tk[0] & ~255; const float v0 = __int_as_float(k0_ ^ ((k0_ >> 31) & 0x7fffffff));
#pragma unroll
        for (int j = 0; j < 16; ++j) { const int k_ = tk[j] & ~255; const float vj = __int_as_float(k_ ^ ((k_ >> 31) & 0x7fffffff)); e[j] = __builtin_amdgcn_exp2f((vj - v0) * 1.4426950408889634f); sum += e[j]; }
        const float inv = 1.0f / sum;
#pragma unroll
        for (int j = 0; j < 16; ++j) { const int ci = 255 - (tk[j] & 255); SE[tl * 128 + hh * 16 + j] = i1[ci >> 4] * 128 + i2[ci & 15]; SG[tl * 128 + hh * 16 + j] = e[j] * inv; } } }
#undef PEER_KEY
#undef PEER_INS
    __syncthreads();
}
__device__ __forceinline__ void peer_gather(int chunk, const bf16_t* __restrict__ H2, const unsigned char* __restrict__ U, const unsigned char* __restrict__ V,
                                            const float* __restrict__ g2, const float* __restrict__ gf, float* OUT, int tid, const LAS int* SE, const LAS float* SG) {
    asm volatile("" : "+v"(tid));
    const int tok0 = chunk * CH, lane = tid & 63, wave = tid >> 6;
    const rsrc_t rH2 = mk_rsrc(H2, 0x4000000u), rU = mk_rsrc(U, 0x1000000u), rV = mk_rsrc(V, 0x1000000u), rG2 = mk_rsrc(g2, 8192u), rGF = mk_rsrc(gf, 8192u);
#pragma unroll 1
    for (int tt = 0; tt < CH / NWAVES; ++tt) { const int tl = wave * (CH / NWAVES) + tt, tok = tok0 + tl;
      asm volatile("" ::: "memory");
      float hn[32]; float ss = 0.f;
#pragma unroll
      for (int j = 0; j < 2; ++j)
#pragma unroll
          for (int q = 0; q < 4; ++q) { const u32x2 w = ldb64(rH2, ((unsigned)tok * 2048u + 256u * (4 * j + q) + 4u * lane) * 2u);
              const f32x4 a = (f32x4){__uint_as_float(w.x << 16), __uint_as_float(w.x & 0xffff0000u), __uint_as_float(w.y << 16), __uint_as_float(w.y & 0xffff0000u)};
#pragma unroll
              for (int i = 0; i < 4; ++i) { hn[16 * j + 4 * q + i] = a[i]; ss += a[i] * a[i]; } }
      const float rstd = 1.0f / sqrtf(wave_sum(ss) * (1.f / 2048.f) + NORM_EPS);
#pragma unroll
      for (int j = 0; j < 2; ++j)
#pragma unroll
          for (int q = 0; q < 4; ++q) { const f32x4 a = ldf128(rG2, (256u * (4 * j + q) + 4u * lane) * 4u);
#pragma unroll
              for (int i = 0; i < 4; ++i) hn[16 * j + 4 * q + i] *= rstd * a[i]; }
      typedef _Float16 h2_t __attribute__((ext_vector_type(2)));
      h2_t hn16[16]; f32x2 accp[16];
#pragma unroll
      for (int k = 0; k < 16; ++k) { hn16[k] = (h2_t){(_Float16)hn[2 * k], (_Float16)hn[2 * k + 1]}; accp[k] = (f32x2){0.f, 0.f}; }
#define NX 4
#define PEER_LOAD(S, kb) do { _Pragma("unroll") for (int x = 0; x < NX; ++x) { const unsigned o = (unsigned)SE[tl * 128 + (kb) + x] * 1024u + (unsigned)lane * 16u; \
          S##u[x] = ldb128(rU, o); S##v[x] = ldb128(rV, o); } } while (0)
#define PEER_DU(W, k) dd = __builtin_amdgcn_fdot2(__builtin_amdgcn_cvt_scalef32_pk_f16_fp4(W[(k) >> 2], 1.0f, (k) & 3), hn16[k], dd, false);
#define PEER_DV(W, k) accp[k] = __builtin_elementwise_fma(__builtin_amdgcn_cvt_scalef32_pk_f32_fp4(W[(k) >> 2], 1.0f, (k) & 3), c2, accp[k]);
#define PEER_16(M, W) M(W, 0) M(W, 1) M(W, 2) M(W, 3) M(W, 4) M(W, 5) M(W, 6) M(W, 7) M(W, 8) M(W, 9) M(W, 10) M(W, 11) M(W, 12) M(W, 13) M(W, 14) M(W, 15)
#define PEER_COMPUTE(S, kb) do { float d[NX]; \
          _Pragma("unroll") for (int x = 0; x < NX; ++x) { const u32x4 W = S##u[x]; float dd = 0.f; PEER_16(PEER_DU, W) d[x] = dd; } \
          _Pragma("unroll") for (int o = 1; o < 64; o <<= 1) { _Pragma("unroll") for (int x = 0; x < NX; ++x) d[x] += __shfl_xor(d[x], o); } \
          float c[NX]; \
          _Pragma("unroll") for (int x = 0; x < NX; ++x) c[x] = SG[tl * 128 + (kb) + x] * gelu_tanh(d[x] * (1.f / PEER_U_SCALE)) * (1.f / PEER_V_SCALE); \
          _Pragma("unroll") for (int x = 0; x < NX; ++x) { const u32x4 W = S##v[x]; const f32x2 c2 = (f32x2){c[x], c[x]}; PEER_16(PEER_DV, W) } } while (0)
      { u32x4 Au[NX], Av[NX], Bu[NX], Bv[NX];
        PEER_LOAD(A, 0);
#pragma unroll 1
        for (int k = 0; k < 128; k += 2 * NX) {
            PEER_LOAD(B, k + NX); PEER_COMPUTE(A, k);
            { const int kn = min(k + 2 * NX, 128 - NX); PEER_LOAD(A, kn); }
            PEER_COMPUTE(B, k + NX);
        } }
#undef PEER_DU
#undef PEER_DV
#undef PEER_16
#undef NX
#undef PEER_LOAD
#undef PEER_COMPUTE
      asm volatile("" ::: "memory");
      int tok2 = tok, lane2 = lane; asm volatile("" : "+v"(tok2), "+v"(lane2));
      float s2 = 0.f;
#pragma unroll
      for (int j = 0; j < 2; ++j)
#pragma unroll
          for (int q = 0; q < 4; ++q) { const u32x2 w = ldb64(rH2, ((unsigned)tok2 * 2048u + 256u * (4 * j + q) + 4u * lane2) * 2u);
              const f32x4 a = (f32x4){__uint_as_float(w.x << 16), __uint_as_float(w.x & 0xffff0000u), __uint_as_float(w.y << 16), __uint_as_float(w.y & 0xffff0000u)};
#pragma unroll
              for (int i = 0; i < 4; ++i) { const int e_ = 16 * j + 4 * q + i; accp[e_ >> 1][e_ & 1] += a[i]; s2 += accp[e_ >> 1][e_ & 1] * accp[e_ >> 1][e_ & 1]; } }
      const float rf = 1.0f / sqrtf(wave_sum(s2) * (1.f / 2048.f) + NORM_EPS);
#pragma unroll
      for (int j = 0; j < 2; ++j)
#pragma unroll
          for (int q = 0; q < 4; ++q) { const f32x4 a = ldf128(rGF, (256u * (4 * j + q) + 4u * lane2) * 4u); f32x4 oa;
#pragma unroll
              for (int i = 0; i < 4; ++i) { const int e_ = 16 * j + 4 * q + i; oa[i] = accp[e_ >> 1][e_ & 1] * rf * a[i]; }
              float* op = OUT + (size_t)tok2 * 2048 + 256 * (4 * j + q) + 4 * lane2;
              __builtin_nontemporal_store(oa, (GAS f32x4*)op); }
    }
}
}
#ifndef MK_N_LAUNCHES
#define MK_N_LAUNCHES 1
#endif
#define MK_PROBE_PH -1
#define MK_PROBE_DIV 2
constexpr int N_PHASES = 9;
constexpr int N_LAUNCHES = MK_N_LAUNCHES;
struct Args { const float* in[19]; float* out; unsigned char* ws; int ph_lo, ph_hi; };
static_assert(sizeof(Args) == 19 * 8 + 8 + 8 + 8, "no padding");

__global__ void __launch_bounds__(NWAVES * 64, 2) hybrid_fwd(Args args) {
    extern __shared__ __attribute__((aligned(16))) unsigned char lds_raw[];
    Frame F;
    F.lds = (LAS unsigned char*)lds_raw;
    F.MISC = (volatile LAS unsigned*)(F.lds + MISC_OFF);
    F.tid = threadIdx.x; F.lane = F.tid & 63; F.wave = __builtin_amdgcn_readfirstlane(F.tid >> 6);
    F.G = gridDim.x; { const int bx = blockIdx.x; F.vcu = (F.G % 8 == 0) ? (bx % 8) * (F.G / 8) + bx / 8 : bx; }
    F.ws = args.ws; F.out = args.out;
#pragma unroll
    for (int i = 0; i < 19; ++i) F.in[i] = args.in[i];
    for (int u = F.tid; u < (LDS_BYTES - LDSCTL_OFF) / 4; u += NWAVES * 64) ((LAS unsigned*)(F.lds + LDSCTL_OFF))[u] = 0u;
    __syncthreads();
    XcdBarrier bar; bar.bar = (unsigned*)(F.ws + WS_CTL) + CW_BAR; bar.x = 0; bar.st = nullptr;
    if (N_LAUNCHES == 1) bar = xcd_barrier_post((unsigned*)(F.ws + WS_CTL) + CW_BAR, F.MISC + 8);
    const int lo = args.ph_lo, hi = args.ph_hi;
#define IN(k) (lo <= (k) && (k) < hi)
#if MK_PROBE_PH >= 0
    unsigned long long tp0 = (MK_PROBE_PH == 0 || MK_PROBE_PH == 9) ? __builtin_amdgcn_s_memrealtime() : 0ull, tp1 = 0ull;
#define SEAM(k) do { if (IN(k) && IN((k) + 1)) xcd_barrier(bar); if (MK_PROBE_PH == (k)) tp1 = __builtin_amdgcn_s_memrealtime(); if (MK_PROBE_PH == (k) + 1) tp0 = __builtin_amdgcn_s_memrealtime(); } while (0)
#else
#define SEAM(k) do { if (IN(k) && IN((k) + 1)) xcd_barrier(bar); } while (0)
#endif
    const size_t T2048 = (size_t)256 * 2048 * 2, T1024 = (size_t)256 * 1024 * 2, T512 = (size_t)256 * 512 * 2;
    float* cosT = WSP(float, WS_COS); float* sinT = WSP(float, WS_SIN);
    float* ssq_q = WSP(float, WS_SSQ_Q); float* ssq_kv = WSP(float, WS_SSQ_KV); float* ssq2 = WSP(float, WS_SSQ_2);

    if (IN(0)) { p0_prologue<0>(F, F.vcu, F.G); } SEAM(0);
    if (IN(1)) {
        SchedP1 S{F.G, (int)blockIdx.x, (const char*)(F.ws + WS_HN1), (const char*)(F.ws + WS_WIN), (const char*)(F.ws + WS_WVT), T1024};
        EpiP1 E{WSP(unsigned char, WS_NAQ), WSP(unsigned char, WS_NAK), WSP(unsigned char, WS_VT), WSP(unsigned char, WS_CQ), WSP(unsigned char, WS_CKV), WSP(unsigned char, WS_KR), WSP(unsigned char, WS_GA), WSP(unsigned char, WS_GB), ssq_q, ssq_kv, cosT, sinT};
        pg8::gemm_phase<EpiP1, SchedP1, true, -6>(F.lds, 2048, S, E);
        { const int extra = P1_UNITS % F.G, bx = (int)blockIdx.x; if (extra != 0 && bx >= extra) p0_prologue<1>(F, bx - extra, F.G - extra); else if (extra == 0) p0_prologue<1>(F, bx, F.G); }
    } SEAM(1);
    if (IN(2)) {
        LAS float* relb = (LAS float*)F.lds + 64; LAS float* metab = relb + 16 * 15 * 31 + 128; LAS float* wsf = metab + 256 + F.wave * 64;
        for (int i = F.tid; i < 16 * 15 * 31; i += NWAVES * 64) relb[i] = F.in[4][i];
        if (F.tid < 256) metab[F.tid] = F.in[5][F.tid];
        __syncthreads();
        const int gw = F.vcu * NWAVES + F.wave, NGW = F.G * NWAVES;
        for (int task = gw; task < NBATCH * 16 * 32 * 2; task += NGW)
            att::na_task(task, WSP(unsigned char, WS_NAQ), WSP(unsigned char, WS_NAK), WSP(unsigned char, WS_VT), WSP(unsigned char, WS_ONA), relb, metab, wsf, F.lane);
        __syncthreads();
    }
    if (IN(3)) {
        SchedP3 S{F.G, (int)blockIdx.x, (const char*)F.ws, T512 / 2};
        EpiP3 E{WSP(unsigned char, WS_QM), WSP(unsigned char, WS_KN), WSP(unsigned char, WS_VV), ssq_q, ssq_kv, cosT, sinT};
        pg8::gemm_phase<EpiP3, SchedP3, true, -4>(F.lds, 512, S, E);
    } SEAM(3);
    if (IN(4)) {
        const int gw = F.vcu * NWAVES + F.wave, NGW = F.G * NWAVES;
        Conv cv{F.in[16], F.in[17], WSP(unsigned char, WS_U), WSP(unsigned char, WS_V), F.lds + 65536 + F.wave * 8192, gw, NGW, 2 * 16384, -1, 0};
        for (int id = F.vcu; id < NBATCH * 16 * 8; id += F.G) { const int bh = id >> 3, qb = id & 7;
            att::mla_unit8(bh >> 4, bh & 15, qb, WSP(unsigned char, WS_QM), WSP(unsigned char, WS_KN), WSP(unsigned char, WS_KR), WSP(unsigned char, WS_VV), WSP(unsigned char, WS_OMLA), (LAS char*)F.lds, cv); }
        while (cv.pend >= 0 || cv.next < cv.end) conv_step<0>(cv, F.lane);
        __syncthreads();
    } SEAM(4);
    if (IN(5)) {
        { SchedGrid S{F.G, (int)blockIdx.x, 64, 8, (const char*)(F.ws + WS_ONA), (const char*)(F.ws + WS_WNA), T512};
          EpiP5a E{WSP(unsigned char, WS_GA), WSP(unsigned char, WS_T1)};
          pg8::gemm_phase<EpiP5a, SchedGrid, true, -9>(F.lds, 1024, S, E); }
        { SchedGrid S{F.G, (int)blockIdx.x, 64, 8, (const char*)(F.ws + WS_OMLA), (const char*)(F.ws + WS_WMLA), T1024};
          EpiP5b E{WSP(unsigned char, WS_GB), WSP(unsigned char, WS_T1), WSP(unsigned char, WS_MERGED)};
          pg8::gemm_phase<EpiP5b, SchedGrid, true, -11>(F.lds, 2048, S, E); }
    } SEAM(5);
    if (IN(6)) {
        { SchedGrid S{F.G, (int)blockIdx.x, 64, 8, (const char*)(F.ws + WS_MERGED), (const char*)(F.ws + WS_WOUT), T1024};
          EpiP6 E{F.in[0], WSP(bf16_t, WS_H2B), ssq2};
          pg8::gemm_phase<EpiP6, SchedGrid, true, -11>(F.lds, 2048, S, E); }
    } SEAM(6);
    if (IN(7)) {
        SchedGrid S{F.G, (int)blockIdx.x, 64, 8, (const char*)(F.ws + WS_H2B), (const char*)(F.ws + WS_WSC), T2048};
        EpiP7 E{ssq2, WSP(_Float16, WS_SC)};
        pg8::gemm_phase<EpiP7, SchedGrid>(F.lds, 2048, S, E);
    } SEAM(7);
    if (IN(8)) {
        const int nch = (MREAL / peer::CH - F.vcu + F.G - 1) / F.G; const bool both_first = (nch == 2) && (F.vcu & 1);
        for (int op = 0; op < 2 * nch; ++op) {
            const bool sel = both_first ? (op < 2) : !(op & 1); const int ci = both_first ? (op & 1) : (op >> 1), chunk = F.vcu + ci * F.G;
            const int b2 = both_first ? ci : 0;
            LAS int* SE = (LAS int*)(F.lds + (b2 ? peer::OFF_SE2 : peer::OFF_SE)); LAS float* SG = (LAS float*)(F.lds + (b2 ? peer::OFF_SG2 : peer::OFF_SG));
            if (sel) peer::peer_select(chunk, WSP(_Float16, WS_SC), (LAS char*)F.lds, F.tid, SE, SG);
            else peer::peer_gather(chunk, WSP(bf16_t, WS_H2B), WSP(unsigned char, WS_U), WSP(unsigned char, WS_V), F.in[13], F.in[18], F.out, F.tid, SE, SG); }
    }
#if MK_PROBE_PH >= 0
    xcd_barrier(bar); tp1 = (MK_PROBE_PH >= 8) ? __builtin_amdgcn_s_memrealtime() : tp1;
    if (blockIdx.x == 0 && F.tid == 0) F.out[0] = (float)(tp1 - tp0) * (0.01f / MK_PROBE_DIV);
#endif
#undef IN
#undef SEAM
}

extern "C" void kernel_launch(void* const* d_in, const int* in_sizes, int n_in, void* d_out, int out_size, void* d_ws, size_t ws_size, hipStream_t stream) {
    static int grid = 0;
    if (grid == 0) {
        if (n_in != 19 || in_sizes[0] != MREAL * DM || out_size != MREAL * DM || ws_size < WS_END) {
            fprintf(stderr, "kernel_launch: shape/workspace mismatch: n_in %d in0 %d out %d ws %zu (need %zu); nothing launched\n", n_in, n_in > 0 ? in_sizes[0] : -1, out_size, ws_size, (size_t)WS_END); grid = -1; return; }
        int dev = 0, cus = 0, per_cu = 0;
        if (hipGetDevice(&dev) != hipSuccess || hipDeviceGetAttribute(&cus, hipDeviceAttributeMultiprocessorCount, dev) != hipSuccess) { fprintf(stderr, "kernel_launch: device query failed\n"); grid = -1; return; }
        if (hipFuncSetAttribute((const void*)hybrid_fwd, hipFuncAttributeMaxDynamicSharedMemorySize, LDS_BYTES) != hipSuccess) { fprintf(stderr, "kernel_launch: hipFuncSetAttribute failed\n"); grid = -1; return; }
        if (hipOccupancyMaxActiveBlocksPerMultiprocessor(&per_cu, (const void*)hybrid_fwd, NWAVES * 64, LDS_BYTES) != hipSuccess || per_cu < 1)
            fprintf(stderr, "kernel_launch: note: occupancy query reports %d workgroups per CU\n", per_cu);
        (void)hipGetLastError();
        grid = cus;
    }
    if (grid < 0) return;
    if (hipMemsetAsync((char*)d_ws + WS_CTL, 0, CTL_ZERO_BYTES, stream) != hipSuccess) { fprintf(stderr, "kernel_launch: hipMemsetAsync failed\n"); return; }
    Args a{};
    for (int i = 0; i < 19; ++i) a.in[i] = (const float*)d_in[i];
    a.out = (float*)d_out; a.ws = (unsigned char*)d_ws;
    for (int li = 0; li < N_LAUNCHES; ++li) {
        a.ph_lo = (N_LAUNCHES == 1) ? 0 : li; a.ph_hi = (N_LAUNCHES == 1) ? N_PHASES : li + 1;
        hipLaunchKernelGGL(hybrid_fwd, dim3(grid), dim3(NWAVES * 64), LDS_BYTES, stream, a);
        const hipError_t le = hipPeekAtLastError();
        if (le != hipSuccess) { fprintf(stderr, "kernel_launch: launch %d failed: %s\n", li, hipGetErrorName(le)); break; }
    }
}
```

```cpp
#include <hip/hip_runtime.h>
#include <cstdio>
#include <cstdint>

#define LAS __attribute__((address_space(3)))
#define GAS __attribute__((address_space(1)))
typedef unsigned short bf16_t;
typedef short bf16x8 __attribute__((ext_vector_type(8)));
typedef short s16x4 __attribute__((ext_vector_type(4)));
typedef float f32x4 __attribute__((ext_vector_type(4)));
typedef float f32x2 __attribute__((ext_vector_type(2)));
typedef float f32x16 __attribute__((ext_vector_type(16)));
typedef unsigned u32x4 __attribute__((ext_vector_type(4)));
typedef unsigned u32x2 __attribute__((ext_vector_type(2)));

constexpr int DM = 2048, NBATCH = 8, SEQ = 2048, NMETA = 16;
constexpr int MREAL = NBATCH * SEQ;
constexpr int MPAD = MREAL + 256;
constexpr int NPOS = SEQ + NMETA;
constexpr float NORM_EPS = 1e-6f;
constexpr int C_NAQ = 0, C_NAK = 1024, C_CQ = 2048, C_CKV = 2560, C_GA = 3072, C_GB = 5120, C_KR = 7168, NMAIN = 7424;
constexpr int VT_PITCH = MPAD;

constexpr size_t MiB = 1u << 20;
constexpr size_t WS_CTL = 0, CTL_ZERO_BYTES = 1 * MiB;
constexpr size_t WS_SSQ_Q = 481 * MiB, WS_SSQ_KV = 482 * MiB, WS_SSQ_2 = 486 * MiB;
constexpr size_t WS_COS = 1 * MiB, WS_SIN = 1 * MiB + 512 * 1024;
constexpr size_t WS_WUQ = 2 * MiB, WS_WUKV = 5 * MiB, WS_WNA = 9 * MiB, WS_WMLA = 13 * MiB, WS_WOUT = 21 * MiB, WS_WSC = 29 * MiB;
constexpr size_t WS_GA = 37 * MiB, WS_GB = 101 * MiB;
constexpr size_t WS_KR = 165 * MiB;
constexpr size_t WS_WIN = 167 * MiB + 256 * 1024, WS_WVT = WS_WIN + 29 * MiB;
constexpr size_t WS_ONA = 190 * MiB;
constexpr size_t WS_NAQ = 222 * MiB, WS_NAK = 254 * MiB, WS_VT = WS_NAK + 32 * MiB + 512 * 1024;
constexpr size_t WS_HN1 = 319 * MiB;
constexpr size_t WS_CQ = 448 * MiB, WS_CKV = 464 * MiB;
constexpr size_t WS_QM = 303 * MiB, WS_KN = 352 * MiB, WS_VV = 385 * MiB;
constexpr size_t WS_OMLA = 448 * MiB;
constexpr size_t WS_MERGED = 222 * MiB, WS_T1 = 286 * MiB;
constexpr size_t WS_H2 = 37 * MiB, WS_H2B = 293 * MiB;
constexpr size_t WS_U = 69 * MiB, WS_V = 133 * MiB;
constexpr size_t WS_SC = 165 * MiB;
constexpr size_t WS_END = 512 * MiB;
static_assert(WS_CKV + (size_t)MPAD * 512 * 2 <= WS_SSQ_Q && WS_SSQ_Q + (size_t)8 * MPAD * 4 <= WS_SSQ_KV && WS_SSQ_KV + (size_t)8 * MPAD * 4 <= 483 * MiB && WS_SSQ_2 + (size_t)32 * MREAL * 4 <= WS_END, "ssq slabs");
static_assert(WS_VT + (size_t)1024 * MPAD * 2 <= WS_HN1 && WS_HN1 + (size_t)MPAD * 2048 * 2 <= WS_CQ && WS_CKV + (size_t)MPAD * 512 * 2 <= WS_END, "map P1");
static_assert(WS_WVT + 4 * MiB <= WS_NAQ && WS_KR + (size_t)MPAD * 64 * 2 <= WS_WIN && WS_ONA + 32 * MiB <= WS_NAQ, "map P1b");
static_assert(WS_VT + (size_t)1024 * MPAD <= WS_QM && WS_QM + 48 * MiB <= WS_KN && WS_KN + 33 * MiB <= WS_VV && WS_VV + 33 * MiB <= WS_OMLA && WS_OMLA + 64 * MiB <= WS_END, "map P3");
static_assert(WS_T1 + 128 * MiB <= WS_OMLA && WS_H2 + 128 * MiB <= WS_KR && WS_SC + 128 * MiB <= WS_H2B && WS_H2B + 64 * MiB <= WS_END, "map P5+");
static_assert(WS_GA + 32 * MiB <= WS_U && WS_U + 24 * MiB <= WS_GB && WS_GB + 32 * MiB <= WS_V && WS_V + 24 * MiB <= WS_KR, "expert tables between the gate codes");

constexpr int CW_BAR = 4096;
constexpr float PEER_U_SCALE = 90.50966799f, PEER_V_SCALE = 5.656854249f;

constexpr int RING_BYTES = 131072;
constexpr int LDSCTL_OFF = RING_BYTES, MISC_OFF = LDSCTL_OFF + 320;
constexpr int LDS_BYTES = 147456;
constexpr int NWAVES = 8;

#define LDS_WAIT() asm volatile("s_waitcnt lgkmcnt(0)" ::: "memory")
#define VM_WAIT() asm volatile("s_waitcnt vmcnt(0)" ::: "memory")
#define SBAR() __builtin_amdgcn_sched_barrier(0)
typedef __bf16 bf16x2_t __attribute__((ext_vector_type(2)));
__device__ __forceinline__ unsigned cvt_pk_bf16(float lo, float hi) { const f32x2 v = {lo, hi}; const bf16x2_t b = __builtin_convertvector(v, bf16x2_t); return __builtin_bit_cast(unsigned, b); }
__device__ __forceinline__ float bf_lo(unsigned w) { return __uint_as_float(w << 16); }
__device__ __forceinline__ float bf_hi(unsigned w) { return __uint_as_float(w & 0xffff0000u); }
__device__ __forceinline__ u32x4 pack8(const f32x4 a, const f32x4 b) { u32x4 w; w.x = cvt_pk_bf16(a[0], a[1]); w.y = cvt_pk_bf16(a[2], a[3]); w.z = cvt_pk_bf16(b[0], b[1]); w.w = cvt_pk_bf16(b[2], b[3]); return w; }
__device__ __forceinline__ u32x2 pack8_fp8(f32x4 a, f32x4 b) {
#pragma unroll
    for (int i = 0; i < 4; ++i) { a[i] = __builtin_fminf(__builtin_fmaxf(a[i], -448.f), 448.f); b[i] = __builtin_fminf(__builtin_fmaxf(b[i], -448.f), 448.f); }
    int w0 = 0, w1 = 0; w0 = __builtin_amdgcn_cvt_pk_fp8_f32(a[0], a[1], w0, false); w0 = __builtin_amdgcn_cvt_pk_fp8_f32(a[2], a[3], w0, true);
    w1 = __builtin_amdgcn_cvt_pk_fp8_f32(b[0], b[1], w1, false); w1 = __builtin_amdgcn_cvt_pk_fp8_f32(b[2], b[3], w1, true); return (u32x2){(unsigned)w0, (unsigned)w1}; }
__device__ __forceinline__ unsigned char f32_to_fp8(float x) { x = __builtin_fminf(__builtin_fmaxf(x, -448.f), 448.f); return (unsigned char)(__builtin_amdgcn_cvt_pk_fp8_f32(x, 0.f, 0, false) & 0xff); }
__device__ __forceinline__ u32x2 pack8_u8(const f32x4 a, const f32x4 b) { u32x2 w; unsigned x = 0u, y = 0u;
    x = __builtin_amdgcn_cvt_pk_u8_f32(a[0] * 255.f, 0u, x); x = __builtin_amdgcn_cvt_pk_u8_f32(a[1] * 255.f, 1u, x); x = __builtin_amdgcn_cvt_pk_u8_f32(a[2] * 255.f, 2u, x); x = __builtin_amdgcn_cvt_pk_u8_f32(a[3] * 255.f, 3u, x);
    y = __builtin_amdgcn_cvt_pk_u8_f32(b[0] * 255.f, 0u, y); y = __builtin_amdgcn_cvt_pk_u8_f32(b[1] * 255.f, 1u, y); y = __builtin_amdgcn_cvt_pk_u8_f32(b[2] * 255.f, 2u, y); y = __builtin_amdgcn_cvt_pk_u8_f32(b[3] * 255.f, 3u, y);
    w.x = x; w.y = y; return w; }
__device__ __forceinline__ unsigned pack4_fp8(f32x4 a) {
#pragma unroll
    for (int i = 0; i < 4; ++i) a[i] = __builtin_fminf(__builtin_fmaxf(a[i], -448.f), 448.f);
    int w0 = 0; w0 = __builtin_amdgcn_cvt_pk_fp8_f32(a[0], a[1], w0, false); w0 = __builtin_amdgcn_cvt_pk_fp8_f32(a[2], a[3], w0, true); return (unsigned)w0; }
__device__ __forceinline__ void unpack8_fp8(const u32x2 w, f32x4& a, f32x4& b) {
    const f32x2 a0 = __builtin_amdgcn_cvt_pk_f32_fp8((int)w.x, false), a1 = __builtin_amdgcn_cvt_pk_f32_fp8((int)w.x, true), b0 = __builtin_amdgcn_cvt_pk_f32_fp8((int)w.y, false), b1 = __builtin_amdgcn_cvt_pk_f32_fp8((int)w.y, true);
    a = (f32x4){a0[0], a0[1], a1[0], a1[1]}; b = (f32x4){b0[0], b0[1], b1[0], b1[1]}; }
__device__ __forceinline__ void unpack8_u8(const u32x2 w, f32x4& a, f32x4& b) { const float k = 1.f / 255.f;
    a = (f32x4){(float)(w.x & 0xffu), (float)((w.x >> 8) & 0xffu), (float)((w.x >> 16) & 0xffu), (float)(w.x >> 24)} * k;
    b = (f32x4){(float)(w.y & 0xffu), (float)((w.y >> 8) & 0xffu), (float)((w.y >> 16) & 0xffu), (float)(w.y >> 24)} * k; }
__device__ __forceinline__ u32x2 pack4(const f32x4 a) { u32x2 w; w.x = cvt_pk_bf16(a[0], a[1]); w.y = cvt_pk_bf16(a[2], a[3]); return w; }
__device__ __forceinline__ float wave_sum_dpp(float v) {
#define DPP_ADD(ctrl_, rmask_) v += __builtin_bit_cast(float, __builtin_amdgcn_update_dpp(0, __builtin_bit_cast(int, v), ctrl_, rmask_, 0xF, false))
    DPP_ADD(0xB1, 0xF); DPP_ADD(0x4E, 0xF); DPP_ADD(0x141, 0xF); DPP_ADD(0x140, 0xF); DPP_ADD(0x142, 0xA); DPP_ADD(0x143, 0xC);
#undef DPP_ADD
    return __builtin_bit_cast(float, __builtin_amdgcn_readlane(__builtin_bit_cast(int, v), 63));
}
__device__ __forceinline__ float wave_sum(float v) {
#pragma unroll
    for (int o = 1; o < 64; o <<= 1) v += __shfl_xor(v, o);
    return v;
}
__device__ __forceinline__ float sigmoidf_(float x) { return __builtin_amdgcn_rcpf(1.0f + __builtin_amdgcn_exp2f(-1.4426950408889634f * x)); }
__device__ __forceinline__ int crow(int r, int hi) { return (r & 3) + 8 * (r >> 2) + 4 * hi; }
#define PG8_AUX 0
namespace pg8 {
constexpr int BM = 256, BK = 64, HALF = 128, HTB = HALF * BK * 2  , STAGE_BYTES = 8 * HTB, NXCD = 8, WGM = 4;
__host__ __device__ __forceinline__ int lds_byte(int r, int c) { const int st = (r >> 4) * 2 + (c >> 5), rr = r & 15, cc = c & 31, ob = rr * 64 + cc * 2; return st * 1024 + (ob ^ (((ob >> 9) & 1) << 5)); }
__host__ __device__ __forceinline__ void stage_rc(int b, int& R, int& C) { const int st = b / 1024, sb = b % 1024, swz = sb ^ (((sb >> 9) & 1) << 5); R = (st >> 1) * 16 + swz / 64; C = (st & 1) * 32 + (swz % 64) / 2; }
__host__ __device__ __forceinline__ int perm32(int rho) { const int n = rho >> 4, i = rho & 15; return 8 * (i >> 2) + 4 * n + (i & 3); }

struct Unit { int pm, pn, kind; };

__device__ __forceinline__ void grid_order(int L, int nM, int nN, int& pm, int& pn) {
    const int nwg = nM * nN; int wgid = L;
    { const int q = nwg / NXCD, r = nwg % NXCD, xcd = wgid % NXCD, off = wgid / NXCD; wgid = (xcd < r ? xcd * (q + 1) : r * (q + 1) + (xcd - r) * q) + off; }
    const int nig = WGM * nN, gid = wgid / nig, fm = gid * WGM, gsz = (nM - fm) < WGM ? (nM - fm) : WGM;
    pm = fm + ((wgid % nig) % gsz); pn = (wgid % nig) / gsz;
}

typedef int v8i_t __attribute__((ext_vector_type(8)));
template <class Epi, class Sched, bool F8 = false, int F8_SCALE_EXP = 0>
__device__ __forceinline__ void gemm_phase(LAS unsigned char* lds, const int K, const Sched& S, const Epi& E) {
    const int tid = threadIdx.x, wid = __builtin_amdgcn_readfirstlane(tid >> 6), lane = tid & 63, wr = wid >> 2, wc = wid & 3, fr = lane & 15, fq = lane >> 4;
    int f8sa = 0x01010101 * (127 + F8_SCALE_EXP), f8sb = 0x7f7f7f7f; asm volatile("" : "+v"(f8sa), "+v"(f8sb));
    const int Kb = F8 ? K : 2 * K;
    const int nt = Kb / 128;
    unsigned voffA[2], voffB[2];
#pragma unroll
    for (int i = 0; i < 2; ++i) { int R, C; stage_rc(tid * 16 + i * 8192, R, C); const int Rb = Epi::PERM ? ((R & ~31) + perm32(R & 31)) : R;
        voffA[i] = (unsigned)(R * Kb + C * 2); voffB[i] = (unsigned)(Rb * Kb + C * 2); }
    const size_t kstep = (size_t)128;
    const size_t hstep = (size_t)HALF * Kb;
    const unsigned ldsw = (unsigned)wid * 1024u;
    const int aoff = lds_byte(wr * 64 + fr, F8 ? fq * 16 : fq * 8), boff = lds_byte(wc * 32 + fr, F8 ? fq * 16 : fq * 8);
#define PG8_SA(b, h) (((b) * 2 + (h)) * HTB)
#define PG8_SB(b, h) ((4 + (b) * 2 + (h)) * HTB)
#define PG8_STAGE(bufoff, gbase, voff) do { _Pragma("unroll") for (int _i = 0; _i < 2; ++_i) \
        __builtin_amdgcn_global_load_lds((const unsigned*)((const char*)(gbase) + (voff)[_i]), (LAS unsigned*)(lds + (bufoff) + ldsw + _i * 8192), 16, 0, PG8_AUX); } while (0)
#define PG8_LDA(dst, b, h) do { _Pragma("unroll") for (int m = 0; m < 4; ++m) _Pragma("unroll") for (int k = 0; k < 2; ++k) dst[m][k] = *(const LAS bf16x8*)(lds + PG8_SA(b, h) + aoff + m * 2048 + (F8 ? k * 16 : k * 1024)); } while (0)
#define PG8_LDB(dst, b, h) do { _Pragma("unroll") for (int n = 0; n < 2; ++n) _Pragma("unroll") for (int k = 0; k < 2; ++k) dst[n][k] = *(const LAS bf16x8*)(lds + PG8_SB(b, h) + boff + n * 2048 + (F8 ? k * 16 : k * 1024)); } while (0)
#define PG8_F8OP(X) __builtin_bit_cast(v8i_t, __builtin_shufflevector(X[0], X[1], 0, 1, 2, 3, 4, 5, 6, 7, 8, 9, 10, 11, 12, 13, 14, 15))
#define PG8_MMA(ai, bj, At, Bt) do { __builtin_amdgcn_s_setprio(1); \
        if constexpr (F8) { _Pragma("unroll") for (int m = 0; m < 4; ++m) _Pragma("unroll") for (int n = 0; n < 2; ++n) \
            asm volatile("v_mfma_scale_f32_16x16x128_f8f6f4 %0, %1, %2, %0, %3, %4 op_sel_hi:[0,0,0]" : "+v"(acc[ai][bj][m][n]) : "v"(PG8_F8OP(Bt[n])), "v"(PG8_F8OP(At[m])), "v"(f8sa), "v"(f8sb)); } \
        else { _Pragma("unroll") for (int m = 0; m < 4; ++m) _Pragma("unroll") for (int n = 0; n < 2; ++n) _Pragma("unroll") for (int k = 0; k < 2; ++k) \
            acc[ai][bj][m][n] = __builtin_amdgcn_mfma_f32_16x16x32_bf16(Bt[n][k], At[m][k], acc[ai][bj][m][n], 0, 0, 0); } \
        __builtin_amdgcn_s_setprio(0); } while (0)
#define PG8_WAIT_V(n) asm volatile("s_waitcnt vmcnt(" #n ")" ::: "memory")
#define PG8_WAIT_L(n) asm volatile("s_waitcnt lgkmcnt(" #n ")" ::: "memory")
#define PG8_BAR __builtin_amdgcn_s_barrier()
#define PG8_SCHED __builtin_amdgcn_sched_barrier(0)
    Unit cur, nxt; int ui = 0;
    if (!S.next(0, cur)) return;
    f32x4 acc[2][2][4][2];
#pragma unroll
    for (int a = 0; a < 2; ++a)
#pragma unroll
        for (int b = 0; b < 2; ++b)
#pragma unroll
            for (int m = 0; m < 4; ++m)
#pragma unroll
                for (int n = 0; n < 2; ++n) acc[a][b][m][n] = (f32x4){0.f, 0.f, 0.f, 0.f};
    bf16x8 At[4][2], B0[2][2], B1[2][2];
    const char* cA = S.pa(cur); const char* cB = S.pb(cur);
    PG8_STAGE(PG8_SB(0, 0), cB, voffB); PG8_STAGE(PG8_SB(0, 1), cB + hstep, voffB); PG8_STAGE(PG8_SA(0, 0), cA, voffA); PG8_STAGE(PG8_SA(0, 1), cA + hstep, voffA);
    if (wr == 1) PG8_BAR;
    PG8_WAIT_V(2); PG8_BAR;
    PG8_STAGE(PG8_SB(1, 0), cB + kstep, voffB); PG8_STAGE(PG8_SA(1, 0), cA + kstep, voffA); PG8_STAGE(PG8_SB(1, 1), cB + hstep + kstep, voffB);
    PG8_WAIT_V(6); PG8_BAR;
    for (;;) {
        const bool has_next = S.next(ui + 1, nxt);
        const char* nA = has_next ? S.pa(nxt) : cA; const char* nB = has_next ? S.pb(nxt) : cB;
        for (int t = 0; t < nt; t += 2) {
            const bool last = (t == nt - 2);
            const char* a1 = cA + (size_t)(t + 1) * kstep;
            const char* a2 = last ? nA : cA + (size_t)(t + 2) * kstep; const char* b2 = last ? nB : cB + (size_t)(t + 2) * kstep;
            const char* a3 = a2 + kstep; const char* b3 = b2 + kstep;
            PG8_LDB(B0, 0, 0); PG8_LDB(B1, 0, 1); PG8_SCHED; PG8_LDA(At, 0, 0); PG8_STAGE(PG8_SA(1, 1), a1 + hstep, voffA);
            PG8_WAIT_V(8); PG8_WAIT_L(0); PG8_BAR; PG8_MMA(0, 0, At, B0); PG8_MMA(0, 1, At, B1); PG8_BAR; PG8_SCHED;
            PG8_LDA(At, 0, 1); PG8_STAGE(PG8_SB(0, 0), b2, voffB); PG8_STAGE(PG8_SB(0, 1), b2 + hstep, voffB); PG8_STAGE(PG8_SA(0, 0), a2, voffA);
            PG8_WAIT_V(8); PG8_WAIT_L(0); PG8_BAR; PG8_MMA(1, 0, At, B0); PG8_MMA(1, 1, At, B1); PG8_BAR; PG8_SCHED;
            PG8_LDB(B0, 1, 0); PG8_LDB(B1, 1, 1); PG8_SCHED; PG8_LDA(At, 1, 0); PG8_STAGE(PG8_SA(0, 1), a2 + hstep, voffA);
            PG8_WAIT_V(8); PG8_WAIT_L(0); PG8_BAR; PG8_MMA(0, 0, At, B0); PG8_MMA(0, 1, At, B1); PG8_BAR; PG8_SCHED;
            PG8_LDA(At, 1, 1); PG8_STAGE(PG8_SB(1, 0), b3, voffB); PG8_STAGE(PG8_SB(1, 1), b3 + hstep, voffB); PG8_STAGE(PG8_SA(1, 0), a3, voffA);
            PG8_WAIT_V(8); PG8_WAIT_L(0); PG8_BAR; PG8_MMA(1, 0, At, B0); PG8_MMA(1, 1, At, B1); PG8_BAR; PG8_SCHED;
        }
        if (wr == 0) PG8_BAR;
        if constexpr (F8) asm volatile("s_nop 15\n\ts_nop 7" ::: "memory");
        if constexpr (Epi::HAS_PRE) {
            E.pre(cur, (LAS float*)(lds + STAGE_BYTES + 1024), tid); PG8_WAIT_L(0); PG8_BAR; }
        E(acc, cur, wr, wc, fr, fq, (const LAS float*)(lds + STAGE_BYTES + 1024));
        if (!has_next) break;
#pragma unroll
        for (int a = 0; a < 2; ++a)
#pragma unroll
            for (int b = 0; b < 2; ++b)
#pragma unroll
                for (int m = 0; m < 4; ++m)
#pragma unroll
                    for (int n = 0; n < 2; ++n) acc[a][b][m][n] = (f32x4){0.f, 0.f, 0.f, 0.f};
        cur = nxt; cA = nA; cB = nB; ++ui;
        if (wr == 1) PG8_BAR;
    }
    PG8_WAIT_V(0);
    PG8_BAR;
#undef PG8_SA
#undef PG8_SB
#undef PG8_STAGE
#undef PG8_LDA
#undef PG8_LDB
#undef PG8_MMA
#undef PG8_F8OP
#undef PG8_WAIT_V
#undef PG8_WAIT_L
#undef PG8_BAR
#undef PG8_SCHED
}
}
typedef GAS unsigned gu32;
#define RLX_AGENT __ATOMIC_RELAXED, __HIP_MEMORY_SCOPE_AGENT
#define XB_TMO      128
#define XB_XCNT(j)  (256  + 64 * (j))
#define XB_XSUB(j)  (1280 + 64 * (j))
#define XB_XGEN(j)  (2304 + 64 * (j))
#define XB_TOP      3328
#define XB_TOPGEN   3392
#define XCD_BAR_WORDS 3456
#define XB_SPIN_CAP (1u << 18)
__device__ __forceinline__ unsigned xb_ld(unsigned* p)              { return __hip_atomic_load(p, __ATOMIC_RELAXED, __HIP_MEMORY_SCOPE_AGENT); }
__device__ __forceinline__ unsigned xb_add(unsigned* p, unsigned v) { return __hip_atomic_fetch_add(p, v, __ATOMIC_RELAXED, __HIP_MEMORY_SCOPE_AGENT); }
__device__ __forceinline__ unsigned xb_xcc_id() { return (unsigned)__builtin_amdgcn_s_getreg((3 << 11) | 20) & 0xFu; }
#define XB_SPIN(cond, bar) do { unsigned _sp = 0; while (cond) { __builtin_amdgcn_s_sleep(1); \
    if ((++_sp & 255u) == 0u) { if (xb_ld(&(bar)[XB_TMO])) break; if (_sp > XB_SPIN_CAP) { atomicAdd(&(bar)[XB_TMO], 1u); break; } } } } while (0)
struct XcdBarrier { unsigned* bar; unsigned x; volatile LAS unsigned* st; };
__device__ __forceinline__ XcdBarrier xcd_barrier_post(unsigned* bar, volatile LAS unsigned* st) {
    XcdBarrier b; b.bar = bar; b.x = xb_xcc_id(); b.st = st;
    if (threadIdx.x == 0) (void)xb_add(&bar[XB_XCNT(b.x)], 1u);
    return b;
}
__device__ __forceinline__ void xcd_barrier_complete(unsigned* bar, unsigned x, unsigned& nloc, unsigned& nx) {
    const unsigned G = gridDim.x * gridDim.y * gridDim.z;
    unsigned sum, cnt, mine, sp = 0u;
    for (;;) {
        sum = 0u; cnt = 0u; mine = 0u;
#pragma unroll
        for (unsigned j = 0; j < 16; ++j) { const unsigned c = xb_ld(&bar[XB_XCNT(j)]); sum += c; cnt += (c > 0u) ? 1u : 0u; mine = (j == x) ? c : mine; }
        if (sum == G) break;
        __builtin_amdgcn_s_sleep(1);
        if ((++sp & 255u) == 0u) { if (xb_ld(&bar[XB_TMO])) break; if (sp > XB_SPIN_CAP) { atomicAdd(&bar[XB_TMO], 1u); break; } }
    }
    nloc = mine > 0u ? mine : 1u; nx = cnt > 0u ? cnt : 1u;
}
__device__ __forceinline__ void xcd_barrier(const XcdBarrier& b) {
    asm volatile("s_waitcnt vmcnt(0)" ::: "memory");
    __syncthreads();
    if (threadIdx.x == 0) {
        unsigned* bar = b.bar;
        __builtin_amdgcn_s_waitcnt(0);
        unsigned nloc = b.st[0], nx = b.st[1];
        if (nloc == 0u) { xcd_barrier_complete(bar, b.x, nloc, nx); b.st[0] = nloc; b.st[1] = nx; }
        const unsigned old = xb_add(&bar[XB_XSUB(b.x)], 1u);
        const unsigned gen = old / nloc;
        if (old + 1u == (gen + 1u) * nloc) {
            __builtin_amdgcn_fence(__ATOMIC_RELEASE, "agent");
            asm volatile("s_waitcnt vmcnt(0)" ::: "memory");
            const unsigned og = xb_add(&bar[XB_TOP], 1u);
            const unsigned tg = og / nx;
            if (og + 1u == (tg + 1u) * nx) xb_add(&bar[XB_TOPGEN], 1u);
            else XB_SPIN(xb_ld(&bar[XB_TOPGEN]) == tg, bar);
            __builtin_amdgcn_fence(__ATOMIC_ACQUIRE, "agent");
            xb_add(&bar[XB_XGEN(b.x)], 1u);
            asm volatile("s_waitcnt vmcnt(0)" ::: "memory");
        } else {
            XB_SPIN(xb_ld(&bar[XB_XGEN(b.x)]) == gen, bar);
            __builtin_amdgcn_fence(__ATOMIC_ACQUIRE, "agent");
            asm volatile("s_waitcnt vmcnt(0)" ::: "memory");
        }
    }
    __syncthreads();
}
struct Frame {
    LAS unsigned char* lds;
    volatile LAS unsigned* MISC;
    unsigned char* ws;
    int tid, lane, wave;
    int vcu, G;
    const float* in[19];
    float* out;
};
#define WSP(T, off) ((T*)(F.ws + (off)))

typedef float cv16f_t __attribute__((ext_vector_type(16)));
typedef unsigned cv6u_t __attribute__((ext_vector_type(6)));
struct Conv { const float* pu; const float* pv; unsigned char* u8; unsigned char* v8; LAS unsigned char* lbuf; int next, stride, end, pend, tick; };
__device__ __forceinline__ void conv_issue(const Conv& c, int item, int lane) {
    const float* src = ((item >> 14) ? c.pv : c.pu) + (size_t)(item & 16383) * 2048 + 4 * lane;
#pragma unroll
    for (int q = 0; q < 8; ++q) __builtin_amdgcn_global_load_lds((const unsigned*)(src + 256 * q), (LAS unsigned*)(c.lbuf + q * 1024), 16, 0, 2);
}
__device__ __forceinline__ void conv_finish(const Conv& c, int item, int lane) {
    const int isv = item >> 14, row = item & 16383; const float sc = isv ? PEER_V_SCALE : PEER_U_SCALE; unsigned w[4] = {0u, 0u, 0u, 0u};
#define CONV_LD(q) const f32x4 x##q = *(const LAS f32x4*)(c.lbuf + (q) * 1024 + lane * 16) * sc;
#define CONV_PK(q) { w[(q) >> 1] = __builtin_amdgcn_cvt_scalef32_pk_fp4_f32(w[(q) >> 1], x##q[0], x##q[1], 1.0f, (2 * (q)) & 3); w[(q) >> 1] = __builtin_amdgcn_cvt_scalef32_pk_fp4_f32(w[(q) >> 1], x##q[2], x##q[3], 1.0f, (2 * (q) + 1) & 3); }
    { CONV_LD(0) CONV_LD(1) CONV_PK(0) CONV_PK(1) } asm volatile("" : "+v"(w[0]) :: "memory");
    { CONV_LD(2) CONV_LD(3) CONV_PK(2) CONV_PK(3) } asm volatile("" : "+v"(w[1]) :: "memory");
    { CONV_LD(4) CONV_LD(5) CONV_PK(4) CONV_PK(5) } asm volatile("" : "+v"(w[2]) :: "memory");
    { CONV_LD(6) CONV_LD(7) CONV_PK(6) CONV_PK(7) }
#undef CONV_LD
#undef CONV_PK
    unsigned char* rec = (isv ? c.v8 : c.u8) + (size_t)row * 1024;
    *(GAS u32x4*)(rec + lane * 16) = (u32x4){w[0], w[1], w[2], w[3]};
}
template <int YOUNGER>
__device__ __forceinline__ void conv_step(Conv& c, int lane) {
    if (c.pend >= 0) { if constexpr (YOUNGER == 0) asm volatile("s_waitcnt vmcnt(0)" ::: "memory"); else { static_assert(YOUNGER == 12, "wait count"); asm volatile("s_waitcnt vmcnt(12)" ::: "memory"); }
        conv_finish(c, c.pend, lane); c.pend = -1; asm volatile("s_waitcnt lgkmcnt(0)" ::: "memory"); }
    if (c.next < c.end) { conv_issue(c, c.next, lane); c.pend = c.next; c.next += c.stride; }
}
__device__ __forceinline__ void p0_transpose_item8(const float* W, int K, int N, int k0, int n0, unsigned char* WT, int drow, bool rope, float scale, LAS float* scr, int lane, const float* gain = nullptr) {
    { f32x4 v[8]; float gk[8];
#pragma unroll
      for (int i = 0; i < 8; ++i) { const int kk = 8 * i + (lane >> 3); v[i] = __builtin_nontemporal_load((const GAS f32x4*)(W + (size_t)(k0 + kk) * N + n0 + 4 * (lane & 7))); gk[i] = gain ? gain[k0 + kk] * scale : scale; }
#pragma unroll
      for (int i = 0; i < 8; ++i) { const int kk = 8 * i + (lane >> 3); LAS float* d = scr + kk * 33 + 4 * (lane & 7);
#pragma unroll
          for (int e = 0; e < 4; ++e) d[e] = v[i][e] * gk[i]; } }
    LDS_WAIT(); asm volatile("" ::: "memory");
#pragma unroll
    for (int j = 0; j < 2; ++j) { const int q = lane + 64 * j, n = q >> 2, c = q & 3; const LAS float* s = scr + (16 * c) * 33 + n; u32x4 o;
#pragma unroll
        for (int d = 0; d < 4; ++d) { int w = 0; w = __builtin_amdgcn_cvt_pk_fp8_f32(s[(4 * d) * 33], s[(4 * d + 1) * 33], w, false); w = __builtin_amdgcn_cvt_pk_fp8_f32(s[(4 * d + 2) * 33], s[(4 * d + 3) * 33], w, true); o[d] = (unsigned)w; }
        const int dr = drow + (rope ? (8 * (n >> 2) + (n & 3)) : n);
        *(GAS u32x4*)(WT + (size_t)dr * K + k0 + 16 * c) = o; }
    LDS_WAIT(); asm volatile("" ::: "memory");
}
template <int PART>
__device__ __forceinline__ void p0_prologue(Frame& F, int rank, int nrank) {
    LAS float* scr = (LAS float*)(F.lds + F.wave * 16384);
    const int gw = rank * NWAVES + F.wave, NGW = nrank * NWAVES, lane = F.lane; const int gt = rank * 512 + F.tid, NGT = nrank * 512;
    unsigned char* WIN = WSP(unsigned char, WS_WIN); unsigned char* WVT = WSP(unsigned char, WS_WVT);
    constexpr int I_IN = 32 * 258, I_UQ = 8 * 96, I_UKV = 8 * 128, I_NA = 16 * 64, I_MLA = 32 * 64, I_OUT = 32 * 64;
    constexpr int NEARLY = I_IN + I_UQ + I_UKV, NITEMS = NEARLY + I_NA + I_MLA + I_OUT;
    for (int it = (PART == 0 ? 0 : NEARLY) + gw; it < (PART == 0 ? NEARLY : NITEMS); it += NGW) {
        int r = it;
        if (r < I_IN) { const int kb = r / 258, sb = r % 258, n0 = 32 * sb, k0 = 64 * kb; const float* W = F.in[3];
            unsigned char* dst = WIN; int drow; bool rope = false;
            if (n0 < 1024) drow = C_NAQ + n0;
            else if (n0 < 2048) drow = C_NAK + (n0 - 1024);
            else if (n0 < 3072) { dst = WVT; drow = n0 - 2048; }
            else if (n0 < 3584) drow = C_CQ + (n0 - 3072);
            else if (n0 < 4096) drow = C_CKV + (n0 - 3584);
            else if (n0 < 4160) { drow = C_KR + ((n0 - 4096) ? 4 : 0); rope = true; }
            else if (n0 < 6208) drow = C_GA + (n0 - 4160);
            else drow = C_GB + (n0 - 6208);
            p0_transpose_item8(W, 2048, 8256, k0, n0, dst, drow, rope, 64.f, scr, lane); continue; } r -= I_IN;
        if (r < I_UQ) { const int kb = r / 96, sb = r % 96, n0 = 32 * sb, k0 = 64 * kb; const int hd = n0 / 192, w = n0 % 192;
            int drow = n0; bool rope = false; if (w >= 128) { rope = true; drow = hd * 192 + 128 + ((w - 128) ? 4 : 0); }
            p0_transpose_item8(F.in[7], 512, 3072, k0, n0, WSP(unsigned char, WS_WUQ), drow, rope, 16.f, scr, lane, F.in[6]); continue; } r -= I_UQ;
        if (r < I_UKV) { const int kb = r / 128, sb = r % 128; const int n0 = 32 * sb, hd = n0 >> 8, w = n0 & 255;
            p0_transpose_item8(F.in[9], 512, 4096, 64 * kb, n0, WSP(unsigned char, WS_WUKV), (w >= 128 ? 2048 : 0) + hd * 128 + (w & 127), false, 16.f, scr, lane, F.in[8]); continue; } r -= I_UKV;
        if (r < I_NA) { const int kb = r / 64, sb = r % 64; p0_transpose_item8(F.in[10], 1024, 2048, 64 * kb, 32 * sb, WSP(unsigned char, WS_WNA), 32 * sb, false, 32.f, scr, lane); continue; } r -= I_NA;
        if (r < I_MLA) { const int kb = r / 64, sb = r % 64; p0_transpose_item8(F.in[11], 2048, 2048, 64 * kb, 32 * sb, WSP(unsigned char, WS_WMLA), 32 * sb, false, 64.f, scr, lane); continue; } r -= I_MLA;
        { const int kb = r / 64, sb = r % 64; p0_transpose_item8(F.in[12], 2048, 2048, 64 * kb, 32 * sb, WSP(unsigned char, WS_WOUT), 32 * sb, false, 64.f, scr, lane); }
    }
    if (PART == 0) { GAS u32x4* z = (GAS u32x4*)(WIN + (size_t)(C_KR + 64) * 2048); const int n16 = (NMAIN - C_KR - 64) * 2048 / 16;
      for (int i = gt; i < n16; i += NGT) z[i] = (u32x4){0u, 0u, 0u, 0u}; }
    if (PART == 0) { unsigned char* HN1 = WSP(unsigned char, WS_HN1);
#define P0_ROWSRC(m_) (((m_) < MREAL) ? F.in[0] + (size_t)(m_) * DM : F.in[1] + (size_t)((m_) - MREAL) * DM)
      { f32x4 v[8]; int m = gw;
        if (m < MREAL + NMETA) { const GAS f32x4* xr = (const GAS f32x4*)P0_ROWSRC(m) + lane;
#pragma unroll
            for (int j = 0; j < 8; ++j) v[j] = __builtin_nontemporal_load(xr + 64 * j); }
        const GAS f32x4* gr = (const GAS f32x4*)F.in[2] + lane;
        while (m < MREAL + NMETA) { const int mn = m + NGW; f32x4 vn[8];
            { const int ml = mn < MREAL + NMETA ? mn : m; const GAS f32x4* xr = (const GAS f32x4*)P0_ROWSRC(ml) + lane;
#pragma unroll
              for (int j = 0; j < 8; ++j) vn[j] = __builtin_nontemporal_load(xr + 64 * j); }
            float sq = 0.f;
#pragma unroll
            for (int j = 0; j < 8; ++j) sq += (v[j].x * v[j].x + v[j].y * v[j].y) + (v[j].z * v[j].z + v[j].w * v[j].w);
            const float rstd = 1.0f / sqrtf(wave_sum(sq) * (1.f / DM) + NORM_EPS);
            GAS unsigned* o4 = (GAS unsigned*)(HN1 + (size_t)m * DM) + lane;
#pragma unroll
            for (int j = 0; j < 8; ++j) { const f32x4 y = (v[j] * rstd) * gr[64 * j]; int w = 0; w = __builtin_amdgcn_cvt_pk_fp8_f32(y[0], y[1], w, false); w = __builtin_amdgcn_cvt_pk_fp8_f32(y[2], y[3], w, true); o4[64 * j] = (unsigned)w; }
#pragma unroll
            for (int j = 0; j < 8; ++j) v[j] = vn[j];
            m = mn; } }
#undef P0_ROWSRC
      GAS u32x4* z = (GAS u32x4*)(HN1 + (size_t)(MREAL + NMETA) * DM); const int n16 = (MPAD - MREAL - NMETA) * DM / 16;
      for (int i = gt; i < n16; i += NGT) z[i] = (u32x4){0u, 0u, 0u, 0u}; }
    if (PART == 0) { float* ct = WSP(float, WS_COS); float* st = WSP(float, WS_SIN);
      for (int i = gt; i < NPOS * 32; i += NGT) { const int p = i >> 5, j = i & 31;
          const float inv = __builtin_powf(10000.0f, -(float)(2 * j) / 64.0f); const float ang = (float)p * inv;
          double r = (double)ang * 0.15915494309189535; r -= __builtin_rint(r); const float rf = (float)r;
          ct[i] = __builtin_amdgcn_cosf(rf); st[i] = __builtin_amdgcn_sinf(rf); } }
    if (PART == 1) { const float* SK = F.in[15]; const float* WQ = F.in[14]; const float* g2 = F.in[13]; bf16_t* WSCp = WSP(bf16_t, WS_WSC);
      const int l15 = lane & 15, l4 = lane >> 4;
      for (int task = gw; task < 2048; task += NGW) { const int g = task >> 7, nt = (task >> 4) & 7, kc = task & 15, n0 = nt * 16;
          bf16x8 bfr[4];
#pragma unroll
          for (int kk = 0; kk < 4; ++kk) { const float* p = SK + ((size_t)g * 128 + n0 + l15) * 128 + 32 * kk + 8 * l4; const f32x4 a = *(const GAS f32x4*)p, b = *(const GAS f32x4*)(p + 4);
              const u32x4 w = pack8(a, b); bfr[kk] = __builtin_bit_cast(bf16x8, w); }
          for (int kt = 0; kt < 8; ++kt) { const int k0 = (kc * 8 + kt) * 16; f32x4 acc = (f32x4){0.f, 0.f, 0.f, 0.f};
#pragma unroll
              for (int kk = 0; kk < 4; ++kk) { const float* p = WQ + (size_t)(k0 + l15) * 2048 + g * 128 + 32 * kk + 8 * l4; const f32x4 a = *(const GAS f32x4*)p, b = *(const GAS f32x4*)(p + 4);
                  const u32x4 w = pack8(a, b); acc = __builtin_amdgcn_mfma_f32_16x16x32_bf16(__builtin_bit_cast(bf16x8, w), bfr[kk], acc, 0, 0, 0); }
              const f32x4 gg = *(const GAS f32x4*)(g2 + k0 + 4 * l4);
              *(GAS u32x2*)(WSCp + (size_t)(g * 128 + n0 + l15) * 2048 + k0 + 4 * l4) = pack4(acc * gg); } } }
}
using pg8::Unit;
struct SchedGrid {
    int G, c, nM, nN; const char* A; const char* B; size_t tstep;
    __device__ __forceinline__ bool next(int i, Unit& u) const { const int L = i * G + c; if (L >= nM * nN) return false; pg8::grid_order(L, nM, nN, u.pm, u.pn); u.kind = 0; return true; }
    __device__ __forceinline__ const char* pa(const Unit& u) const { return A + (size_t)u.pm * tstep; }
    __device__ __forceinline__ const char* pb(const Unit& u) const { return B + (size_t)u.pn * tstep; }
};
constexpr int P1_MAIN = 64 * 29, P1_VT = 4 * 65, P1_META = 7, P1_UNITS = P1_MAIN + P1_VT + P1_META;
struct SchedP1 {
    int G, c; const char* hn1; const char* win; const char* wvt; size_t tstep;
    __device__ __forceinline__ bool next(int i, Unit& u) const {
        const int L = i * G + c; if (L >= P1_UNITS) return false;
        if (L < P1_MAIN) { pg8::grid_order(L, 64, 29, u.pm, u.pn); u.kind = 0; }
        else if (L < P1_MAIN + P1_VT) { const int idx = L - P1_MAIN; u.pm = idx & 3; u.pn = idx >> 2; u.kind = 1; }
        else { const int idx = L - P1_MAIN - P1_VT; u.pm = 64; u.pn = idx < 4 ? 4 + idx : (idx < 6 ? 10 + (idx - 4) : 28); u.kind = 0; }
        return true; }
    __device__ __forceinline__ const char* pa(const Unit& u) const { return (u.kind == 1 ? wvt : hn1) + (size_t)u.pm * tstep; }
    __device__ __forceinline__ const char* pb(const Unit& u) const { return (u.kind == 1 ? hn1 : win) + (size_t)u.pn * tstep; }
};
__device__ __forceinline__ void rope4(const f32x4 x1, const f32x4 x2, const float* cosT, const float* sinT, int pos, int j0, f32x4& lo, f32x4& hi) {
    const f32x4 c = *(const GAS f32x4*)(cosT + pos * 32 + j0), s = *(const GAS f32x4*)(sinT + pos * 32 + j0);
    lo = x1 * c - x2 * s; hi = x2 * c + x1 * s;
}
struct EpiP1 {
    static constexpr bool PERM = true, HAS_PRE = false;
    unsigned char *naq, *nak, *vt; unsigned char *cq, *ckv; unsigned char *kr; unsigned char *ga, *gb; float *ssq_q, *ssq_kv; const float *cosT, *sinT;
    __device__ __forceinline__ void operator()(const f32x4 (&acc)[2][2][4][2], const Unit& u, int wr, int wc, int fr, int fq, const LAS float* rowsc) const {
        const int row0 = u.pm * 256 + wr * 64 + fr, colu = wc * 32 + 8 * fq;
        if (u.kind == 1) {
#pragma unroll
            for (int bj = 0; bj < 2; ++bj) { const int t0 = u.pn * 256 + bj * 128 + colu, pos = (t0 & ~63) + ((t0 & 63) >> 1);
#pragma unroll
                for (int ai = 0; ai < 2; ++ai)
#pragma unroll
                    for (int m = 0; m < 4; ++m) { unsigned char* rp = vt + (size_t)(row0 + ai * 128 + m * 16) * VT_PITCH + pos;
                        *(GAS unsigned*)rp = pack4_fp8(acc[ai][bj][m][0]); *(GAS unsigned*)(rp + 32) = pack4_fp8(acc[ai][bj][m][1]); } }
            return; }
        const int pn = u.pn;
        if (pn == 28) {
            if (wc < 2) { const int j0 = 4 * (4 * wc + fq);
#pragma unroll
                for (int ai = 0; ai < 2; ++ai)
#pragma unroll
                    for (int m = 0; m < 4; ++m) { const int row = row0 + ai * 128 + m * 16; const int pos = row < MREAL ? NMETA + (row & (SEQ - 1)) : row - MREAL;
                        f32x4 lo, hi; rope4(acc[ai][0][m][0], acc[ai][0][m][1], cosT, sinT, pos, j0, lo, hi);
                        *(GAS unsigned*)(kr + (size_t)row * 64 + j0) = pack4_fp8(lo); *(GAS unsigned*)(kr + (size_t)row * 64 + 32 + j0) = pack4_fp8(hi); } }
            return; }
        if (pn >= 12) {
            unsigned char* base = pn < 20 ? ga : gb; const int colt = (pn < 20 ? pn - 12 : pn - 20) * 256 + colu;
#pragma unroll
            for (int ai = 0; ai < 2; ++ai)
#pragma unroll
                for (int m = 0; m < 4; ++m) { unsigned char* rp = base + (size_t)(row0 + ai * 128 + m * 16) * 2048 + colt;
#pragma unroll
                    for (int bj = 0; bj < 2; ++bj) { f32x4 a = acc[ai][bj][m][0], b = acc[ai][bj][m][1];
#pragma unroll
                        for (int i = 0; i < 4; ++i) { a[i] = sigmoidf_(a[i]); b[i] = sigmoidf_(b[i]); }
                        *(GAS u32x2*)(rp + bj * 128) = pack8_u8(a, b); } }
            return; }
        if (pn >= 8) {
            const bool isq = pn < 10; unsigned char* base = isq ? cq : ckv; float* ssq = isq ? ssq_q : ssq_kv; const int colt = (isq ? pn - 8 : pn - 10) * 256 + colu;
#pragma unroll
            for (int ai = 0; ai < 2; ++ai)
#pragma unroll
                for (int m = 0; m < 4; ++m) { const int row = row0 + ai * 128 + m * 16; unsigned char* rp = base + (size_t)row * 512 + colt; float s = 0.f;
#pragma unroll
                    for (int bj = 0; bj < 2; ++bj) { const f32x4 a = acc[ai][bj][m][0], b = acc[ai][bj][m][1];
                        s += (a[0] * a[0] + a[1] * a[1]) + (a[2] * a[2] + a[3] * a[3]) + (b[0] * b[0] + b[1] * b[1]) + (b[2] * b[2] + b[3] * b[3]);
                        *(GAS u32x2*)(rp + bj * 128) = pack8_fp8(a, b); }
                    s += __shfl_xor(s, 16); s += __shfl_xor(s, 32);
                    if (fq == 0) ssq[(size_t)((pn & 1) * 4 + wc) * MPAD + row] = s; }
            return; }
        {
            unsigned char* base = pn < 4 ? naq : nak; const int colt = (pn & 3) * 256 + colu;
#pragma unroll
            for (int ai = 0; ai < 2; ++ai)
#pragma unroll
                for (int m = 0; m < 4; ++m) { unsigned char* rp = base + (size_t)(row0 + ai * 128 + m * 16) * 1024 + colt;
#pragma unroll
                    for (int bj = 0; bj < 2; ++bj) *(GAS u32x2*)(rp + bj * 128) = pack8_fp8(acc[ai][bj][m][0], acc[ai][bj][m][1]); }
        }
    }
};
constexpr int P3_Q = 64 * 12, P3_K = 65 * 8, P3_V = 8 * 65, P3_UNITS = P3_Q + P3_K + P3_V;
struct SchedP3 {
    int G, c; const char* ws; size_t tstep;
    __device__ __forceinline__ bool next(int i, Unit& u) const {
        const int L = i * G + c; if (L >= P3_UNITS) return false;
        if (L < P3_Q) { pg8::grid_order(L, 64, 12, u.pm, u.pn); u.kind = 0; }
        else if (L < P3_Q + P3_K) { pg8::grid_order(L - P3_Q, 65, 8, u.pm, u.pn); u.kind = 1; }
        else { const int idx = L - P3_Q - P3_K; u.pm = idx & 7; u.pn = idx >> 3; u.kind = 2; }
        return true; }
    __device__ __forceinline__ const char* pa(const Unit& u) const { const size_t o = u.kind == 0 ? WS_CQ : (u.kind == 1 ? WS_CKV : WS_WUKV + (size_t)2048 * 512); return ws + o + (size_t)u.pm * tstep; }
    __device__ __forceinline__ const char* pb(const Unit& u) const { const size_t o = u.kind == 0 ? WS_WUQ : (u.kind == 1 ? WS_WUKV : WS_CKV); return ws + o + (size_t)u.pn * tstep; }
};
template <int NS, int LD> __device__ __forceinline__ float rstd_slabs(const float* part, int row, float invn) {
    float s = 0.f;
#pragma unroll
    for (int i = 0; i < NS; ++i) s += part[(size_t)i * LD + row];
    return 1.0f / sqrtf(s * invn + NORM_EPS);
}
struct EpiP3 {
    static constexpr bool PERM = true, HAS_PRE = true;
    unsigned char *qm, *kn, *vt; const float *ssq_q, *ssq_kv; const float *cosT, *sinT;
    __device__ __forceinline__ void pre(const Unit& u, LAS float* sc, int tid) const { if (tid < 256) { const int row = (u.kind == 2 ? u.pn : u.pm) * 256 + tid; sc[tid] = u.kind ? rstd_slabs<8, MPAD>(ssq_kv, row, 1.f / 512.f) : rstd_slabs<8, MPAD>(ssq_q, row, 1.f / 512.f); } }
    __device__ __forceinline__ void operator()(const f32x4 (&acc)[2][2][4][2], const Unit& u, int wr, int wc, int fr, int fq, const LAS float* rowsc) const {
        const int row0 = u.pm * 256 + wr * 64 + fr, colu = wc * 32 + 8 * fq;
        if (u.kind == 2) {
#pragma unroll
            for (int bj = 0; bj < 2; ++bj) { const int cl = bj * 128 + colu, t0 = u.pn * 256 + cl;
                const f32x4 s0 = *(const LAS f32x4*)(rowsc + cl), s1 = *(const LAS f32x4*)(rowsc + cl + 4);
                const int g = (t0 >> 3) & 7, pos = (t0 & ~63) + 16 * (g >> 2) + 4 * (g & 3);
#pragma unroll
                for (int ai = 0; ai < 2; ++ai)
#pragma unroll
                    for (int m = 0; m < 4; ++m) { unsigned char* rp = vt + (size_t)(row0 + ai * 128 + m * 16) * MPAD + pos;
                        *(GAS unsigned*)rp = pack4_fp8(acc[ai][bj][m][0] * s0); *(GAS unsigned*)(rp + 32) = pack4_fp8(acc[ai][bj][m][1] * s1); } }
            return; }
        if (u.kind == 1) {
#pragma unroll
            for (int ai = 0; ai < 2; ++ai)
#pragma unroll
                for (int m = 0; m < 4; ++m) { const int row = row0 + ai * 128 + m * 16; const float rs = rowsc[ai * 128 + wr * 64 + m * 16 + fr];
                    unsigned char* rp = kn + (size_t)row * 2048 + u.pn * 256 + colu;
#pragma unroll
                    for (int bj = 0; bj < 2; ++bj) *(GAS u32x2*)(rp + bj * 128) = pack8_fp8(acc[ai][bj][m][0] * rs, acc[ai][bj][m][1] * rs); }
            return; }
#pragma unroll
        for (int bj = 0; bj < 2; ++bj) { const int c8 = u.pn * 256 + bj * 128 + colu; const int hd = c8 / 192, w = c8 - hd * 192;
            if (w < 128) {
#pragma unroll
                for (int ai = 0; ai < 2; ++ai)
#pragma unroll
                    for (int m = 0; m < 4; ++m) { const int row = row0 + ai * 128 + m * 16; const float rs = rowsc[ai * 128 + wr * 64 + m * 16 + fr];
                        *(GAS u32x2*)(qm + (size_t)row * 3072 + c8) = pack8_fp8(acc[ai][bj][m][0] * rs, acc[ai][bj][m][1] * rs); }
            } else { const int j0 = (w - 128) >> 1;
#pragma unroll
                for (int ai = 0; ai < 2; ++ai)
#pragma unroll
                    for (int m = 0; m < 4; ++m) { const int row = row0 + ai * 128 + m * 16; const float rs = rowsc[ai * 128 + wr * 64 + m * 16 + fr];
                        const int pos = NMETA + (row & (SEQ - 1)); f32x4 lo, hi; rope4(acc[ai][bj][m][0] * rs, acc[ai][bj][m][1] * rs, cosT, sinT, pos, j0, lo, hi);
                        unsigned char* qp = qm + (size_t)row * 3072 + hd * 192 + 128 + j0; *(GAS unsigned*)qp = pack4_fp8(lo); *(GAS unsigned*)(qp + 32) = pack4_fp8(hi); }
            } }
    }
};

__device__ __forceinline__ void unpack8(const u32x4 w, f32x4& a, f32x4& b) { a = (f32x4){bf_lo(w.x), bf_hi(w.x), bf_lo(w.y), bf_hi(w.y)}; b = (f32x4){bf_lo(w.z), bf_hi(w.z), bf_lo(w.w), bf_hi(w.w)}; }
struct EpiP5a {
    static constexpr bool PERM = true, HAS_PRE = false;
    const unsigned char* ga; unsigned char* t1;
    __device__ __forceinline__ void operator()(const f32x4 (&acc)[2][2][4][2], const Unit& u, int wr, int wc, int fr, int fq, const LAS float* rowsc) const {
        const int row0 = u.pm * 256 + wr * 64 + fr, col0 = u.pn * 256 + wc * 32 + 8 * fq;
#pragma unroll
        for (int ai = 0; ai < 2; ++ai)
#pragma unroll
            for (int m = 0; m < 4; ++m) { const size_t off = (size_t)(row0 + ai * 128 + m * 16) * 2048 + col0;
#pragma unroll
                for (int bj = 0; bj < 2; ++bj) { f32x4 g0, g1; unpack8_u8(*(const GAS u32x2*)(ga + off + bj * 128), g0, g1);
                    *(GAS u32x2*)(t1 + off + bj * 128) = pack8_fp8(acc[ai][bj][m][0] * g0 * 32.f, acc[ai][bj][m][1] * g1 * 32.f); } }
    }
};
struct EpiP5b {
    static constexpr bool PERM = true, HAS_PRE = false;
    const unsigned char* gb; const unsigned char* t1; unsigned char* merged;
    __device__ __forceinline__ void operator()(const f32x4 (&acc)[2][2][4][2], const Unit& u, int wr, int wc, int fr, int fq, const LAS float* rowsc) const {
        const int row0 = u.pm * 256 + wr * 64 + fr, col0 = u.pn * 256 + wc * 32 + 8 * fq;
#pragma unroll
        for (int ai = 0; ai < 2; ++ai)
#pragma unroll
            for (int m = 0; m < 4; ++m) { const size_t off = (size_t)(row0 + ai * 128 + m * 16) * 2048 + col0;
#pragma unroll
                for (int bj = 0; bj < 2; ++bj) { f32x4 g0, g1; unpack8_u8(*(const GAS u32x2*)(gb + off + bj * 128), g0, g1);
                    f32x4 a, b; unpack8_fp8(*(const GAS u32x2*)(t1 + off + bj * 128), a, b);
                    *(GAS u32x2*)(merged + off + bj * 128) = pack8_fp8(a + acc[ai][bj][m][0] * g0 * 32.f, b + acc[ai][bj][m][1] * g1 * 32.f); } }
    }
};
struct EpiP6 {
    static constexpr bool PERM = true, HAS_PRE = false;
    const float* x; bf16_t* h2b; float* ssq2;
    __device__ __forceinline__ void operator()(const f32x4 (&acc)[2][2][4][2], const Unit& u, int wr, int wc, int fr, int fq, const LAS float* rowsc) const {
        const int row0 = u.pm * 256 + wr * 64 + fr, col0 = u.pn * 256 + wc * 32 + 8 * fq;
#pragma unroll
        for (int ai = 0; ai < 2; ++ai)
#pragma unroll
            for (int m = 0; m < 4; ++m) { const int row = row0 + ai * 128 + m * 16; const size_t off = (size_t)row * 2048 + col0; float s = 0.f;
#pragma unroll
                for (int bj = 0; bj < 2; ++bj) { const f32x4 a = __builtin_nontemporal_load((const GAS f32x4*)(x + off + bj * 128)) + acc[ai][bj][m][0], b = __builtin_nontemporal_load((const GAS f32x4*)(x + off + bj * 128 + 4)) + acc[ai][bj][m][1];
                    s += (a[0] * a[0] + a[1] * a[1]) + (a[2] * a[2] + a[3] * a[3]) + (b[0] * b[0] + b[1] * b[1]) + (b[2] * b[2] + b[3] * b[3]);
                    *(GAS u32x4*)(h2b + off + bj * 128) = pack8(a, b); }
                s += __shfl_xor(s, 16); s += __shfl_xor(s, 32);
                if (fq == 0) ssq2[(size_t)(u.pn * 4 + wc) * MREAL + row] = s; }
    }
};
struct EpiP7 {
    static constexpr bool PERM = true, HAS_PRE = true;
    const float* ssq2; _Float16* sc;
    __device__ __forceinline__ void pre(const Unit& u, LAS float* sc, int tid) const { if (tid < 256) sc[tid] = rstd_slabs<32, MREAL>(ssq2, u.pm * 256 + tid, 1.f / 2048.f); }
    __device__ __forceinline__ void operator()(const f32x4 (&acc)[2][2][4][2], const Unit& u, int wr, int wc, int fr, int fq, const LAS float* rowsc) const {
        typedef _Float16 h4_t __attribute__((ext_vector_type(4)));
        const int row0 = u.pm * 256 + wr * 64 + fr, col0 = u.pn * 256 + wc * 32 + 8 * fq;
#pragma unroll
        for (int ai = 0; ai < 2; ++ai)
#pragma unroll
            for (int m = 0; m < 4; ++m) { const int row = row0 + ai * 128 + m * 16; const float rs = rowsc[ai * 128 + wr * 64 + m * 16 + fr]; const size_t off = (size_t)row * 2048 + col0;
#pragma unroll
                for (int bj = 0; bj < 2; ++bj) { const h4_t lo = __builtin_convertvector(acc[ai][bj][m][0] * rs, h4_t), hi = __builtin_convertvector(acc[ai][bj][m][1] * rs, h4_t);
                    const u32x2 wl = __builtin_bit_cast(u32x2, lo), wh = __builtin_bit_cast(u32x2, hi);
                    *(GAS u32x4*)(sc + off + bj * 128) = (u32x4){wl.x, wl.y, wh.x, wh.y}; } }
    }
};
namespace att {
constexpr float L2E = 1.4426950408889634f;
constexpr int NW = 8, QBLK = 32, KVBLK = 64;
constexpr float MLA_SCALE = 0.07216878364870322f;
constexpr int K8S = 208, V8S = 80, SHM8_K = 64 * K8S, SHM8_V = 128 * V8S;
constexpr int OFF8_K = 0, OFF8_V = 2 * SHM8_K, OFF8_WS = OFF8_V + 3 * SHM8_V, MLA8_LDS = OFF8_WS + NW * 64 * 4;
static_assert(MLA8_LDS <= 65536, "MLA LDS below the conversion landing buffers");
constexpr float MLA8_THR = 1.9f;
typedef int a8_t __attribute__((ext_vector_type(8)));
#define MFMA8Z(acc_, a_, b_, sa_, sb_) asm volatile("s_nop 1\n\tv_mfma_scale_f32_32x32x64_f8f6f4 %0, %1, %2, 0, %3, %4 op_sel_hi:[0,0,0]" : "=&v"(acc_) : "v"(a_), "v"(b_), "v"(sa_), "v"(sb_))
#define MFMA8(acc_, a_, b_, sa_, sb_) asm volatile("s_nop 1\n\tv_mfma_scale_f32_32x32x64_f8f6f4 %0, %1, %2, %0, %3, %4 op_sel_hi:[0,0,0]" : "+v"(acc_) : "v"(a_), "v"(b_), "v"(sa_), "v"(sb_))
#define CAT8(lo_, hi_) __builtin_bit_cast(a8_t, __builtin_shufflevector(lo_, hi_, 0, 1, 2, 3, 4, 5, 6, 7))
__device__ __forceinline__ a8_t ld_frag8(const LAS char* p) { const u32x4 lo = *(const LAS u32x4*)p, hi = *(const LAS u32x4*)(p + 16); return CAT8(lo, hi); }
__device__ __forceinline__ void qkt8(f32x16& p0, f32x16& p1, const LAS char* Kb, const a8_t& q0, const a8_t& q1, const a8_t& q2, int s1) {
  { const a8_t a0 = ld_frag8(Kb), a1 = ld_frag8(Kb + 32 * K8S); MFMA8Z(p0, a0, q0, s1, s1); MFMA8Z(p1, a1, q0, s1, s1); }
  { const a8_t a0 = ld_frag8(Kb + 64), a1 = ld_frag8(Kb + 32 * K8S + 64); MFMA8(p0, a0, q1, s1, s1); MFMA8(p1, a1, q1, s1, s1); }
  { const a8_t a0 = ld_frag8(Kb + 128), a1 = ld_frag8(Kb + 32 * K8S + 128); MFMA8(p0, a0, q2, s1, s1); MFMA8(p1, a1, q2, s1, s1); }
  asm volatile("s_nop 15\n\ts_nop 15" : "+v"(p0), "+v"(p1));
}
__device__ __forceinline__ void partialSM8(f32x16& p0, f32x16& p1, float& m_reg, float& mn, float& alpha, const float C, const float THRS) {
  float pmax = p0[0];
#pragma unroll
  for (int r = 1; r < 16; ++r) pmax = fmaxf(pmax, p0[r]);
#pragma unroll
  for (int r = 0; r < 16; ++r) pmax = fmaxf(pmax, p1[r]);
  { auto rr = __builtin_amdgcn_permlane32_swap(__float_as_uint(pmax), __float_as_uint(pmax), false, false);
    pmax = fmaxf(__uint_as_float(rr[0]), __uint_as_float(rr[1])); }
  if (__builtin_expect(__all(pmax - m_reg <= THRS), 1)) { mn = m_reg; alpha = 1.f; }
  else { mn = fmaxf(m_reg, pmax); alpha = __builtin_amdgcn_exp2f((m_reg - mn) * C); m_reg = mn; }
  const float mnC = 6.f - mn * C;
#pragma unroll
  for (int r = 0; r < 16; ++r) p0[r] = fmaf(p0[r], C, mnC);
#pragma unroll
  for (int r = 0; r < 16; ++r) p1[r] = fmaf(p1[r], C, mnC);
#pragma unroll
  for (int r = 0; r < 16; ++r) p0[r] = __builtin_amdgcn_exp2f(p0[r]);
}
__device__ __forceinline__ void finishSM8(f32x16& p0, f32x16& p1, float alpha, float& l_reg, a8_t& pf) {
#pragma unroll
  for (int r = 0; r < 16; ++r) p1[r] = __builtin_amdgcn_exp2f(p1[r]);
  float ps = 0;
#pragma unroll
  for (int r = 0; r < 16; ++r) ps += p0[r];
#pragma unroll
  for (int r = 0; r < 16; ++r) ps += p1[r];
  { auto rr = __builtin_amdgcn_permlane32_swap(__float_as_uint(ps), __float_as_uint(ps), false, false);
    ps = __uint_as_float(rr[0]) + __uint_as_float(rr[1]); }
  l_reg = l_reg * alpha + ps;
#pragma unroll
  for (int w = 0; w < 4; ++w) { int x = 0, y = 0;
    x = __builtin_amdgcn_cvt_pk_fp8_f32(p0[4 * w], p0[4 * w + 1], x, false); x = __builtin_amdgcn_cvt_pk_fp8_f32(p0[4 * w + 2], p0[4 * w + 3], x, true);
    y = __builtin_amdgcn_cvt_pk_fp8_f32(p1[4 * w], p1[4 * w + 1], y, false); y = __builtin_amdgcn_cvt_pk_fp8_f32(p1[4 * w + 2], p1[4 * w + 3], y, true);
    pf[w] = x; pf[4 + w] = y; }
}
__device__ __forceinline__ void pv8(f32x16* o, const LAS char* Vb, const a8_t& pf, int sP, int s1) {
  const a8_t b0 = ld_frag8(Vb), b1 = ld_frag8(Vb + 32 * V8S), b2 = ld_frag8(Vb + 64 * V8S), b3 = ld_frag8(Vb + 96 * V8S);
  MFMA8(o[0], pf, b0, sP, s1); MFMA8(o[1], pf, b1, sP, s1); MFMA8(o[2], pf, b2, sP, s1); MFMA8(o[3], pf, b3, sP, s1);
  asm volatile("s_nop 15\n\ts_nop 15" : "+v"(o[0]), "+v"(o[1]), "+v"(o[2]), "+v"(o[3]));
}
__device__ __forceinline__ void mla_unit8(int b, int h, int qb, const unsigned char* __restrict__ QM8, const unsigned char* __restrict__ KN8, const unsigned char* __restrict__ KR8, const unsigned char* __restrict__ VT8,
                                          unsigned char* __restrict__ OM, LAS char* lds, Conv& cv) {
  const int tid = threadIdx.x, wid = tid >> 6, lane = tid & 63, r32 = lane & 31, hi = lane >> 5;
  constexpr float C = MLA_SCALE * L2E, THRS = MLA8_THR / MLA_SCALE;
  constexpr int NT = 33;
  LAS char* K_lds = lds + OFF8_K; LAS char* V_lds = lds + OFF8_V;
  LAS float* ws = (LAS float*)(lds + OFF8_WS) + wid * 64; LAS float* li_l = ws; LAS float* al_l = ws + 32;
  int s1 = 0x7f7f7f7f, sP = 0x79797979; asm volatile("" : "+v"(s1), "+v"(sP));
  float m_reg = -1e30f, l_reg = 0; f32x16 o[4] = {};
  const int qrow = b * SEQ + qb * 256 + wid * QBLK + r32;
  a8_t q0, q1, q2;
  { const unsigned char* Qw = QM8 + (size_t)qrow * 3072 + h * 192 + hi * 32;
    const u32x4 a = *(const GAS u32x4*)Qw, bq = *(const GAS u32x4*)(Qw + 16), c = *(const GAS u32x4*)(Qw + 64), d = *(const GAS u32x4*)(Qw + 80), e = *(const GAS u32x4*)(Qw + 128), f = *(const GAS u32x4*)(Qw + 144);
    q0 = CAT8(a, bq); q1 = CAT8(c, d); q2 = CAT8(e, f); }
  __syncthreads();
  const int kkey = tid >> 3, kch = tid & 7, rkey = (tid >> 2) & 63, rch = tid & 3, vdim = tid >> 2, vch = tid & 3;
  const LAS char* Kf = K_lds + r32 * K8S + 32 * hi; const LAS char* Vf = V_lds + r32 * V8S + 32 * hi;
  const unsigned offk = (unsigned)(kkey * 2048 + kch * 16), offr = (unsigned)(rkey * 64 + rch * 16), offv = (unsigned)(vdim * MPAD + vch * 16);
  u32x4 kA, rA, vA, kB, rB, vB;
  const int realbase = b * SEQ - KVBLK;
#define TROW(t) ((t) == 0 ? MREAL : realbase + (t) * KVBLK)
#define SLOADX(t, K_, R_, V_) do { const int k0_ = TROW(t); \
    K_ = *(const GAS u32x4*)(KN8 + ((size_t)k0_ * 2048 + h * 128) + offk); \
    R_ = *(const GAS u32x4*)(KR8 + (size_t)k0_ * 64 + offr); \
    V_ = *(const GAS u32x4*)(VT8 + ((size_t)h * 128 * MPAD + k0_) + offv); } while (0)
#define SWRITEXV(bf, voff, K_, R_, V_) do { *(LAS u32x4*)(K_lds + (bf) * SHM8_K + kkey * K8S + kch * 16) = K_; if (tid < 256) *(LAS u32x4*)(K_lds + (bf) * SHM8_K + rkey * K8S + 128 + rch * 16) = R_; \
    *(LAS u32x4*)(V_lds + (voff) + vdim * V8S + vch * 16) = V_; } while (0)
#define SWRITEX(bf, K_, R_, V_) SWRITEXV(bf, (bf) * SHM8_V, K_, R_, V_)
#define CONV_HOOK() do { cvi = false; if ((cv.tick++ & 3) == 0) { int lane_ = lane; asm volatile("" : "+v"(lane_));     \
      if (cv.pend >= 0) { asm volatile("s_waitcnt vmcnt(6)" ::: "memory"); conv_finish(cv, cv.pend, lane_); cv.pend = -1; asm volatile("s_waitcnt lgkmcnt(0)" ::: "memory"); } \
      if (cv.next < cv.end) { conv_issue(cv, cv.next, lane_); cv.pend = cv.next; cv.next += cv.stride; cvi = true; } } } while (0)
#define WAITX(nl) do { const int n_ = (nl) + ((cvi || cvp) ? 8 : 0); \
    if (n_ == 11) asm volatile("s_waitcnt vmcnt(11)" ::: "memory"); else if (n_ == 8) asm volatile("s_waitcnt vmcnt(8)" ::: "memory"); \
    else if (n_ == 3) asm volatile("s_waitcnt vmcnt(3)" ::: "memory"); else asm volatile("s_waitcnt vmcnt(0)" ::: "memory"); } while (0)
#define SWAIT0() asm volatile("s_waitcnt vmcnt(0)" ::: "memory")
#define RESC(a) do { if (__any((a) < 1.f)) { if (hi == 0) al_l[r32] = (a); asm volatile("s_waitcnt lgkmcnt(0)" ::: "memory"); \
    _Pragma("unroll") for (int d = 0; d < 4; ++d) _Pragma("unroll") for (int r = 0; r < 16; ++r) o[d][r] *= al_l[crow(r, hi)]; } } while (0)
  f32x16 pA0, pA1, pB0, pB1; float mnA, mnB, alA, alB; a8_t pf = {}; bool cvi = false, cvp = false;
#define QK_FIN(N0, N1, KB, O0, O1, AL) do { float ps_ = 0.f; \
    a8_t fa_ = ld_frag8(KB), fb_ = ld_frag8((KB) + 32 * K8S);        \
    MFMA8Z(N0, fa_, q0, s1, s1); _Pragma("unroll") for (int r = 0; r < 8; ++r) O1[r] = __builtin_amdgcn_exp2f(O1[r]); SBAR(); \
    MFMA8Z(N1, fb_, q0, s1, s1); fa_ = ld_frag8((KB) + 64); _Pragma("unroll") for (int r = 8; r < 16; ++r) O1[r] = __builtin_amdgcn_exp2f(O1[r]); SBAR(); \
    MFMA8(N0, fa_, q1, s1, s1); fb_ = ld_frag8((KB) + 32 * K8S + 64); _Pragma("unroll") for (int r = 0; r < 16; ++r) ps_ += O0[r]; SBAR(); \
    MFMA8(N1, fb_, q1, s1, s1); fa_ = ld_frag8((KB) + 128); _Pragma("unroll") for (int r = 0; r < 16; ++r) ps_ += O1[r]; \
      { auto rr = __builtin_amdgcn_permlane32_swap(__float_as_uint(ps_), __float_as_uint(ps_), false, false); ps_ = __uint_as_float(rr[0]) + __uint_as_float(rr[1]); } l_reg = l_reg * (AL) + ps_; SBAR(); \
    MFMA8(N0, fa_, q2, s1, s1); fb_ = ld_frag8((KB) + 32 * K8S + 128); _Pragma("unroll") for (int w = 0; w < 4; ++w) { int x = pf[w]; x = __builtin_amdgcn_cvt_pk_fp8_f32(O0[4 * w], O0[4 * w + 1], x, false); x = __builtin_amdgcn_cvt_pk_fp8_f32(O0[4 * w + 2], O0[4 * w + 3], x, true); pf[w] = x; } SBAR();        \
    MFMA8(N1, fb_, q2, s1, s1); _Pragma("unroll") for (int w = 0; w < 4; ++w) { int y = pf[4 + w]; y = __builtin_amdgcn_cvt_pk_fp8_f32(O1[4 * w], O1[4 * w + 1], y, false); y = __builtin_amdgcn_cvt_pk_fp8_f32(O1[4 * w + 2], O1[4 * w + 3], y, true); pf[4 + w] = y; } SBAR(); \
  } while (0)
#define PV_PART(VB, N0, N1, MN, AL) do { \
    a8_t va_ = ld_frag8(VB), vb_ = ld_frag8((VB) + 32 * V8S); \
    MFMA8(o[0], pf, va_, sP, s1); asm volatile("s_nop 15\n\ts_nop 15" : "+v"(N0), "+v"(N1));      \
      float pmax_ = N0[0]; _Pragma("unroll") for (int r = 1; r < 16; ++r) pmax_ = fmaxf(pmax_, N0[r]); SBAR(); \
    MFMA8(o[1], pf, vb_, sP, s1); va_ = ld_frag8((VB) + 64 * V8S); _Pragma("unroll") for (int r = 0; r < 16; ++r) pmax_ = fmaxf(pmax_, N1[r]); \
      { auto rr = __builtin_amdgcn_permlane32_swap(__float_as_uint(pmax_), __float_as_uint(pmax_), false, false); pmax_ = fmaxf(__uint_as_float(rr[0]), __uint_as_float(rr[1])); } \
      if (__builtin_expect(__all(pmax_ - m_reg <= THRS), 1)) { MN = m_reg; AL = 1.f; } else { MN = fmaxf(m_reg, pmax_); AL = __builtin_amdgcn_exp2f((m_reg - MN) * C); m_reg = MN; } SBAR(); \
    MFMA8(o[2], pf, va_, sP, s1); vb_ = ld_frag8((VB) + 96 * V8S); { const float mnC_ = 6.f - MN * C; _Pragma("unroll") for (int r = 0; r < 16; ++r) { N0[r] = fmaf(N0[r], C, mnC_); N1[r] = fmaf(N1[r], C, mnC_); } } SBAR(); \
    MFMA8(o[3], pf, vb_, sP, s1); _Pragma("unroll") for (int r = 0; r < 16; ++r) N0[r] = __builtin_amdgcn_exp2f(N0[r]); SBAR(); \
    asm volatile("s_nop 15\n\ts_nop 15" : "+v"(o[0]), "+v"(o[1]), "+v"(o[2]), "+v"(o[3])); } while (0)
  SLOADX(0, kA, rA, vA); SWAIT0(); SWRITEX(0, kA, rA, vA); __syncthreads();
  qkt8(pA0, pA1, Kf, q0, q1, q2, s1);
  { const float NEG = -INFINITY;
#pragma unroll
    for (int r = 8; r < 16; ++r) pA0[r] = NEG;
#pragma unroll
    for (int r = 0; r < 16; ++r) pA1[r] = NEG; }
  partialSM8(pA0, pA1, m_reg, mnA, alA, C, THRS);
  SLOADX(1, kA, rA, vA); SWAIT0(); SWRITEX(1, kA, rA, vA);
  SLOADX(2, kA, rA, vA);
  __syncthreads();
  int vrd = 0, vwr = 2 * SHM8_V;
#define VNEXT(v_) ((v_) == 2 * SHM8_V ? 0 : (v_) + SHM8_V)
  for (int j = 1; j + 1 < NT; j += 2) {
    SBAR(); QK_FIN(pB0, pB1, Kf + SHM8_K, pA0, pA1, alA);
    const bool l1 = j + 2 < NT; if (l1) SLOADX(j + 2, kB, rB, vB); CONV_HOOK(); SBAR();
    PV_PART(Vf + vrd, pB0, pB1, mnB, alB);
    WAITX(l1 ? 3 : 0); SWRITEXV(0, vwr, kA, rA, vA); cvp = cvi; vrd = VNEXT(vrd); vwr = VNEXT(vwr);
    RESC(alB); __syncthreads();
    SBAR(); QK_FIN(pA0, pA1, Kf, pB0, pB1, alB);
    const bool l2 = j + 3 < NT; if (l2) SLOADX(j + 3, kA, rA, vA); CONV_HOOK(); SBAR();
    PV_PART(Vf + vrd, pA0, pA1, mnA, alA);
    if (l1) { WAITX(l2 ? 3 : 0); SWRITEXV(1, vwr, kB, rB, vB); } cvp = cvi; vrd = VNEXT(vrd); vwr = VNEXT(vwr);
    RESC(alA); __syncthreads();
  }
#undef VNEXT
  finishSM8(pA0, pA1, alA, l_reg, pf); SBAR();
  pv8(o, Vf + ((NT - 1) % 3) * SHM8_V, pf, sP, s1);
  if (hi == 0) li_l[r32] = l_reg; asm volatile("s_waitcnt lgkmcnt(0)" ::: "memory");
  float rli[16];
#pragma unroll
  for (int r = 0; r < 16; ++r) rli[r] = __builtin_amdgcn_rcpf(li_l[crow(r, hi)]) * (64.f * 32.f);
  unsigned char* Ow = OM + (size_t)(b * SEQ + qb * 256 + wid * QBLK) * 2048 + h * 128;
#pragma unroll
  for (int r = 0; r < 16; ++r) { const int orow = crow(r, hi);
#pragma unroll
    for (int d0 = 0; d0 < 4; ++d0) Ow[(size_t)orow * 2048 + d0 * 32 + r32] = f32_to_fp8(o[d0][r] * rli[r]); }
#undef TROW
#undef SLOADX
#undef SWRITEX
#undef SWRITEXV
#undef WAITX
#undef SWAIT0
#undef QK_FIN
#undef PV_PART
#undef RESC
#undef CONV_HOOK
}
__device__ __forceinline__ void na_task(int task, const unsigned char* __restrict__ NAQ, const unsigned char* __restrict__ NAK, const unsigned char* __restrict__ VT, unsigned char* __restrict__ ONA,
                                        const LAS float* relb, const LAS float* metab, LAS float* wsf, int lane) {
  const int r32 = lane & 31, hi = lane >> 5;
  const int half = task & 1, r = (task >> 1) & 31, h = (task >> 6) & 15, b = task >> 10;
  const int qc = half * 32 + r32;
  const int cs = min(max(qc - 8, 0), 48), rs = min(max(r - 4, 0), 24);
  const int qtok = b * SEQ + r * 64 + qc;
  constexpr float C = L2E, THRS = 1.9f, SCALE = 0.125f;
  int s1 = 0x7f7f7f7f, sP = 0x79797979; asm volatile("" : "+v"(s1), "+v"(sP));
  a8_t qf; { const unsigned char* qp = NAQ + (size_t)qtok * 1024 + h * 64 + hi * 32; const u32x4 a = *(const GAS u32x4*)qp, c = *(const GAS u32x4*)(qp + 16);
    qf = CAT8(a, c); }
  float m_reg = -1e30f, l_reg = 0.f; f32x16 o[2] = {};
  LAS float* al_l = wsf; LAS float* li_l = wsf + 32;
  const float NEG = -INFINITY;
  const int kb0 = half * 16;
  const unsigned long long wm = 0xFFFFull << (cs - kb0);
  const unsigned mh0 = (unsigned)wm >> (4 * hi), mh1 = (unsigned)(wm >> 32) >> (4 * hi);
  const unsigned char* kq = NAK + (size_t)r32 * 1024 + h * 64 + hi * 32;
  const unsigned char* kq2 = NAK + (size_t)(32 + (r32 & 15)) * 1024 + h * 64 + hi * 32;
  const unsigned char* vq = VT + (size_t)(h * 64 + r32) * VT_PITCH + 32 * hi;
#define NA_KTOK(w) ((w) == 8 ? MREAL : b * SEQ + (rs + (w)) * 64 + kb0)
#define NA_VOFF(w) ((w) == 8 ? MREAL : b * SEQ + (rs + (w)) * 64 + (kb0 >> 1))
#define NA_LOADK(KF, w) do { const size_t ko_ = (size_t)NA_KTOK(w) * 1024; KF[0] = *(const GAS u32x4*)(kq + ko_); KF[1] = *(const GAS u32x4*)(kq + ko_ + 16); KF[2] = *(const GAS u32x4*)(kq2 + ko_); KF[3] = *(const GAS u32x4*)(kq2 + ko_ + 16); } while (0)
#define NA_A8(x_, y_) CAT8(x_, y_)
#define NA_TILE(KF, wt, YN) do { \
    u32x4 va0, va1; u32x2 vb0_, vb1_; { const unsigned char* vp_ = vq + NA_VOFF(wt); va0 = *(const GAS u32x4*)vp_; vb0_ = *(const GAS u32x2*)(vp_ + 16); va1 = *(const GAS u32x4*)(vp_ + (size_t)32 * VT_PITCH); vb1_ = *(const GAS u32x2*)(vp_ + (size_t)32 * VT_PITCH + 16); } \
    f32x16 p0, p1; \
    { const a8_t k0_ = NA_A8(KF[0], KF[1]), k1_ = NA_A8(KF[2], KF[3]); MFMA8Z(p0, k0_, qf, s1, s1); MFMA8Z(p1, k1_, qf, s1, s1); asm volatile("s_nop 15\n\ts_nop 15" : "+v"(p0), "+v"(p1)); } \
    if ((wt) + 1 < 9) NA_LOADK(KF, (wt) + 1);            \
      \
    if ((wt) < 8) { const LAS float* bp_ = relb + ((h * 15 + (rs + (wt) - r + 7)) * 31 + 15 - qc + 4 * hi + kb0);     \
      float bv0[16], bv1[8];        \
      _Pragma("unroll") for (int rg = 0; rg < 16; ++rg) { const int c_ = (rg & 3) + 8 * (rg >> 2); bv0[rg] = bp_[c_]; if (rg < 8) bv1[rg] = bp_[c_ + 32]; } \
      _Pragma("unroll") for (int rg = 0; rg < 16; ++rg) { asm volatile("" : "+v"(bv0[rg])); if (rg < 8) asm volatile("" : "+v"(bv1[rg])); } \
      _Pragma("unroll") for (int rg = 0; rg < 16; ++rg) { const int c_ = (rg & 3) + 8 * (rg >> 2); \
        { const bool ok = (mh0 >> c_) & 1u; p0[rg] = ok ? fmaf(p0[rg], SCALE, bv0[rg]) : NEG; } \
        if (rg < 8) { const bool ok = (mh1 >> c_) & 1u; p1[rg] = ok ? fmaf(p1[rg], SCALE, bv1[rg]) : NEG; } } \
    } else { const LAS float* bp = metab + h * 16; \
      _Pragma("unroll") for (int rg = 0; rg < 16; ++rg) { const int kc = crow(rg, hi); p0[rg] = (rg < 8) ? fmaf(p0[rg], SCALE, bp[kc & 15]) : NEG; if (rg < 8) p1[rg] = NEG; } } \
      \
    float pmax = p0[0]; \
    _Pragma("unroll") for (int rg = 1; rg < 16; ++rg) pmax = fmaxf(pmax, p0[rg]); \
    _Pragma("unroll") for (int rg = 0; rg < 8; ++rg) pmax = fmaxf(pmax, p1[rg]); \
    { auto rr = __builtin_amdgcn_permlane32_swap(__float_as_uint(pmax), __float_as_uint(pmax), false, false); pmax = fmaxf(__uint_as_float(rr[0]), __uint_as_float(rr[1])); } \
    float mn, alpha; \
    if (__builtin_expect(__all(pmax - m_reg <= THRS), 1)) { mn = m_reg; alpha = 1.f; } \
    else { mn = fmaxf(m_reg, pmax); alpha = __builtin_amdgcn_exp2f((m_reg - mn) * C); m_reg = mn; } \
    const float mnC = 6.f - mn * C; float ps = 0.f;        \
    _Pragma("unroll") for (int rg = 0; rg < 16; ++rg) { p0[rg] = __builtin_amdgcn_exp2f(fmaf(p0[rg], C, mnC)); ps += p0[rg]; } \
    _Pragma("unroll") for (int rg = 0; rg < 8; ++rg) { p1[rg] = __builtin_amdgcn_exp2f(fmaf(p1[rg], C, mnC)); ps += p1[rg]; } \
    { auto rr = __builtin_amdgcn_permlane32_swap(__float_as_uint(ps), __float_as_uint(ps), false, false); ps = __uint_as_float(rr[0]) + __uint_as_float(rr[1]); } \
    l_reg = l_reg * alpha + ps; \
    a8_t pf;   \
    _Pragma("unroll") for (int w_ = 0; w_ < 4; ++w_) { int x = 0; x = __builtin_amdgcn_cvt_pk_fp8_f32(p0[4 * w_], p0[4 * w_ + 1], x, false); x = __builtin_amdgcn_cvt_pk_fp8_f32(p0[4 * w_ + 2], p0[4 * w_ + 3], x, true); pf[w_] = x; } \
    _Pragma("unroll") for (int w_ = 0; w_ < 2; ++w_) { int x = 0; x = __builtin_amdgcn_cvt_pk_fp8_f32(p1[4 * w_], p1[4 * w_ + 1], x, false); x = __builtin_amdgcn_cvt_pk_fp8_f32(p1[4 * w_ + 2], p1[4 * w_ + 3], x, true); pf[4 + w_] = x; } \
    pf[6] = 0; pf[7] = 0; \
    if (__any(alpha < 1.f)) { if (hi == 0) al_l[r32] = alpha; asm volatile("s_waitcnt lgkmcnt(0)" ::: "memory"); \
      _Pragma("unroll") for (int d = 0; d < 2; ++d) _Pragma("unroll") for (int rg = 0; rg < 16; ++rg) o[d][rg] *= al_l[crow(rg, hi)]; } \
    { const u32x4 z0_ = (u32x4){vb0_.x, vb0_.y, 0u, 0u}, z1_ = (u32x4){vb1_.x, vb1_.y, 0u, 0u}; const a8_t v0_ = CAT8(va0, z0_), v1_ = CAT8(va1, z1_); \
      MFMA8(o[0], pf, v0_, sP, s1); MFMA8(o[1], pf, v1_, sP, s1); asm volatile("s_nop 15\n\ts_nop 15" : "+v"(o[0]), "+v"(o[1])); } } while (0)
  { u32x4 kA[4];
    NA_LOADK(kA, 0);
#pragma unroll 1
    for (int w = 0; w < 8; ++w) { NA_TILE(kA, w, 12); }
    NA_TILE(kA, 8, 12); }
#undef NA_KTOK
#undef NA_VOFF
#undef NA_LOADK
#undef NA_A8
#undef NA_TILE
  if (hi == 0) li_l[r32] = l_reg; asm volatile("s_waitcnt lgkmcnt(0)" ::: "memory");
  unsigned char* Ow = ONA + (size_t)(b * SEQ + r * 64 + half * 32) * 1024 + h * 64;
#pragma unroll
  for (int rg = 0; rg < 16; ++rg) { const int orow = crow(rg, hi); const float rl = __builtin_amdgcn_rcpf(li_l[orow]) * (64.f * 16.f);
#pragma unroll
    for (int d0 = 0; d0 < 2; ++d0) Ow[(size_t)orow * 1024 + d0 * 32 + r32] = f32_to_fp8(o[d0][rg] * rl); }
  asm volatile("s_waitcnt lgkmcnt(0)" ::: "memory");
}
}
namespace peer {
constexpr int CH = 32;
constexpr int OFF_TV = 0, OFF_TI = OFF_TV + CH * 16 * 16 * 4, OFF_SE = OFF_TI + CH * 16 * 16 * 4, OFF_SG = OFF_SE + CH * 128 * 4, OFF_SE2 = OFF_SG + CH * 128 * 4, OFF_SG2 = OFF_SE2 + CH * 128 * 4, PEER_LDS = OFF_SG2 + CH * 128 * 4;
static_assert(PEER_LDS <= RING_BYTES, "PEER LDS");
__device__ __forceinline__ float gelu_tanh(float x) {
    const float u = 0.7978845608028654f * (x + 0.044715f * x * x * x);
    const float e = __builtin_amdgcn_exp2f(-2.f * 1.4426950408889634f * fabsf(u));
    const float t = (1.f - e) * __builtin_amdgcn_rcpf(1.f + e);
    return 0.5f * x * (1.f + (u < 0.f ? -t : t));
}
__device__ __forceinline__ void fmac1(float& acc, float a, float b) { asm("v_fmac_f32_e32 %0, %1, %2" : "+v"(acc) : "v"(a), "v"(b)); }
#define PEER_INSERT(x_, xi_) do { float x__ = (x_); int xi__ = (xi_); \
    _Pragma("unroll") for (int j_ = 0; j_ < 16; ++j_) { const bool gt_ = x__ > tv[j_]; const float tvo_ = tv[j_]; const int tio_ = ti[j_]; \
        tv[j_] = gt_ ? x__ : tvo_; ti[j_] = gt_ ? xi__ : tio_; x__ = gt_ ? tvo_ : x__; xi__ = gt_ ? tio_ : xi__; } } while (0)

#define PEER_AUX 0
typedef __amdgpu_buffer_rsrc_t rsrc_t;
__device__ __forceinline__ rsrc_t mk_rsrc(const void* p, unsigned bytes) { return __builtin_amdgcn_make_buffer_rsrc((void*)p, 0, bytes, 0x00020000); }
__device__ __forceinline__ u32x4 ldb128(rsrc_t r, unsigned off) { return __builtin_amdgcn_raw_buffer_load_b128(r, off, 0, PEER_AUX); }
typedef unsigned v6u_t __attribute__((ext_vector_type(6)));
typedef float v32f_t __attribute__((ext_vector_type(32)));
typedef float v16f_t __attribute__((ext_vector_type(16)));
__device__ __forceinline__ u32x2 ldb64(rsrc_t r, unsigned off) { return __builtin_amdgcn_raw_buffer_load_b64(r, off, 0, PEER_AUX); }
__device__ __forceinline__ u32x2 ldb64_nt(rsrc_t r, unsigned off) { return __builtin_amdgcn_raw_buffer_load_b64(r, off, 0, 2); }
__device__ __forceinline__ f32x4 ldf128(rsrc_t r, unsigned off) { return __builtin_bit_cast(f32x4, __builtin_amdgcn_raw_buffer_load_b128(r, off, 0, PEER_AUX)); }
__device__ __forceinline__ f32x4 ldf128_nt(rsrc_t r, unsigned off) { return __builtin_bit_cast(f32x4, __builtin_amdgcn_raw_buffer_load_b128(r, off, 0, 2)); }
__device__ __forceinline__ void peer_select(int chunk, const _Float16* __restrict__ SC, LAS char* lds, int tid, LAS int* SE, LAS float* SG) {
    LAS float* TV = (LAS float*)(lds + OFF_TV); LAS int* TI = (LAS int*)(lds + OFF_TI);
    asm volatile("" : "+v"(tid));
    const int tok0 = chunk * CH;
    const rsrc_t rSC = mk_rsrc(SC, 0x4000000u);
    __syncthreads();
    { const int tl = tid >> 4, g = tid & 15; const unsigned spo = ((unsigned)(tok0 + tl) * 2048u + (unsigned)g * 128u) * 2u;
      int tk[16];
#pragma unroll
      for (int j = 0; j < 16; ++j) tk[j] = (int)0x80000000;
#define PEER_KEY(x_, lowbits_, mask_) ({ const int f_ = __float_as_int(x_); ((f_ ^ ((f_ >> 31) & 0x7fffffff)) & ~(mask_)) | (lowbits_); })
#define PEER_INS(key_) do { int x__ = (key_); _Pragma("unroll") for (int j_ = 0; j_ < 16; ++j_) { const int hi_ = max(x__, tk[j_]); x__ = min(x__, tk[j_]); tk[j_] = hi_; } } while (0)
      typedef _Float16 h8_t __attribute__((ext_vector_type(8)));
#define PEER_CX(a_, b_) do { const int hi_ = max(a_, b_), lo_ = min(a_, b_); a_ = hi_; b_ = lo_; } while (0)
      u32x4 na = __builtin_amdgcn_raw_buffer_load_b128(rSC, spo, 0, 2), nb = __builtin_amdgcn_raw_buffer_load_b128(rSC, spo + 16, 0, 2);
#pragma unroll 1
      for (int i = 0; i < 16; i += 2) { const h8_t a = __builtin_bit_cast(h8_t, na), b = __builtin_bit_cast(h8_t, nb);
          { const unsigned on = spo + (unsigned)min(i + 2, 14) * 16u; na = __builtin_amdgcn_raw_buffer_load_b128(rSC, on, 0, 2); nb = __builtin_amdgcn_raw_buffer_load_b128(rSC, on + 16, 0, 2); }
          int kk[16];
#pragma unroll
          for (int e = 0; e < 8; ++e) { kk[e] = PEER_KEY((float)a[e], 127 - (8 * i + e), 127); kk[8 + e] = PEER_KEY((float)b[e], 127 - (8 * i + 8 + e), 127); }
          PEER_CX(kk[0], kk[13]); PEER_CX(kk[1], kk[12]); PEER_CX(kk[2], kk[15]); PEER_CX(kk[3], kk[14]); PEER_CX(kk[4], kk[8]); PEER_CX(kk[5], kk[6]); PEER_CX(kk[7], kk[11]); PEER_CX(kk[9], kk[10]); PEER_CX(kk[0], kk[5]); PEER_CX(kk[1], kk[7]); PEER_CX(kk[2], kk[9]); PEER_CX(kk[3], kk[4]); PEER_CX(kk[6], kk[13]); PEER_CX(kk[8], kk[14]); PEER_CX(kk[10], kk[15]); PEER_CX(kk[11], kk[12]); PEER_CX(kk[0], kk[1]); PEER_CX(kk[2], kk[3]); PEER_CX(kk[4], kk[5]); PEER_CX(kk[6], kk[8]); PEER_CX(kk[7], kk[9]); PEER_CX(kk[10], kk[11]); PEER_CX(kk[12], kk[13]); PEER_CX(kk[14], kk[15]); PEER_CX(kk[0], kk[2]); PEER_CX(kk[1], kk[3]); PEER_CX(kk[4], kk[10]); PEER_CX(kk[5], kk[11]); PEER_CX(kk[6], kk[7]); PEER_CX(kk[8], kk[9]); PEER_CX(kk[12], kk[14]); PEER_CX(kk[13], kk[15]); PEER_CX(kk[1], kk[2]); PEER_CX(kk[3], kk[12]); PEER_CX(kk[4], kk[6]); PEER_CX(kk[5], kk[7]); PEER_CX(kk[8], kk[10]); PEER_CX(kk[9], kk[11]); PEER_CX(kk[13], kk[14]); PEER_CX(kk[1], kk[4]); PEER_CX(kk[2], kk[6]); PEER_CX(kk[5], kk[8]); PEER_CX(kk[7], kk[10]); PEER_CX(kk[9], kk[13]); PEER_CX(kk[11], kk[14]); PEER_CX(kk[2], kk[4]); PEER_CX(kk[3], kk[6]); PEER_CX(kk[9], kk[12]); PEER_CX(kk[11], kk[13]); PEER_CX(kk[3], kk[5]); PEER_CX(kk[6], kk[8]); PEER_CX(kk[7], kk[9]); PEER_CX(kk[10], kk[12]); PEER_CX(kk[3], kk[4]); PEER_CX(kk[5], kk[6]); PEER_CX(kk[7], kk[8]); PEER_CX(kk[9], kk[10]); PEER_CX(kk[11], kk[12]); PEER_CX(kk[6], kk[7]); PEER_CX(kk[8], kk[9]);
#pragma unroll
          for (int e = 0; e < 16; ++e) tk[e] = max(tk[e], kk[15 - e]);
          PEER_CX(tk[0], tk[8]); PEER_CX(tk[1], tk[9]); PEER_CX(tk[2], tk[10]); PEER_CX(tk[3], tk[11]); PEER_CX(tk[4], tk[12]); PEER_CX(tk[5], tk[13]); PEER_CX(tk[6], tk[14]); PEER_CX(tk[7], tk[15]); PEER_CX(tk[0], tk[4]); PEER_CX(tk[1], tk[5]); PEER_CX(tk[2], tk[6]); PEER_CX(tk[3], tk[7]); PEER_CX(tk[8], tk[12]); PEER_CX(tk[9], tk[13]); PEER_CX(tk[10], tk[14]); PEER_CX(tk[11], tk[15]); PEER_CX(tk[0], tk[2]); PEER_CX(tk[1], tk[3]); PEER_CX(tk[4], tk[6]); PEER_CX(tk[5], tk[7]); PEER_CX(tk[8], tk[10]); PEER_CX(tk[9], tk[11]); PEER_CX(tk[12], tk[14]); PEER_CX(tk[13], tk[15]); PEER_CX(tk[0], tk[1]); PEER_CX(tk[2], tk[3]); PEER_CX(tk[4], tk[5]); PEER_CX(tk[6], tk[7]); PEER_CX(tk[8], tk[9]); PEER_CX(tk[10], tk[11]); PEER_CX(tk[12], tk[13]); PEER_CX(tk[14], tk[15]); }
#undef PEER_CX
      LAS float* tvp = TV + (tl * 16 + g) * 16; LAS int* tip = TI + (tl * 16 + g) * 16;
#pragma unroll
      for (int j = 0; j < 16; ++j) { const int k_ = tk[j] & ~127; tvp[j] = __int_as_float(k_ ^ ((k_ >> 31) & 0x7fffffff)); tip[j] = 127 - (tk[j] & 127); } }
    asm volatile("s_waitcnt lgkmcnt(0)" ::: "memory");
    asm volatile("" : "+v"(tid));
    { const int tl = tid >> 4, hh = (tid >> 1) & 7, half = tid & 1;
      const LAS float* s1 = TV + (tl * 16 + 2 * hh) * 16; const LAS float* s2 = s1 + 16; const LAS int* i1 = TI + (tl * 16 + 2 * hh) * 16; const LAS int* i2 = i1 + 16;
      float b2[16];
#pragma unroll
      for (int j = 0; j < 16; ++j) b2[j] = s2[j];
      int tk[16];
#pragma unroll
      for (int j = 0; j < 16; ++j) tk[j] = (int)0x80000000;
#pragma unroll
      for (int ii = 0; ii < 8; ++ii) { const int i = 2 * ii + half; const float a = s1[i];
#pragma unroll
          for (int j = 0; j < 16; ++j) if ((2 * ii + 1) * (j + 1) <= 16) { if (half == 0 || (2 * ii + 2) * (j + 1) <= 16) PEER_INS(PEER_KEY(a + b2[j], 255 - (i * 16 + j), 255)); } }
      { int pk[16];
#pragma unroll
        for (int j = 0; j < 16; ++j) pk[j] = __shfl_xor(tk[j], 1);
#pragma unroll
        for (int j = 0; j < 16; ++j) PEER_INS(pk[j]); }
      if (half == 0) { float e[16], sum = 0.f; const int k0_ = tk[0] & ~255; const float v0 = __int_as_float(k0_ ^ ((k0_ >> 31) & 0x7fffffff));
#pragma unroll
        for (int j = 0; j < 16; ++j) { const int k_ = tk[j] & ~255; const float vj = __int_as_float(k_ ^ ((k_ >> 31) & 0x7fffffff)); e[j] = __builtin_amdgcn_exp2f((vj - v0) * 1.4426950408889634f); sum += e[j]; }
        const float inv = 1.0f / sum;
#pragma unroll
        for (int j = 0; j < 16; ++j) { const int ci = 255 - (tk[j] & 255); SE[tl * 128 + hh * 16 + j] = i1[ci >> 4] * 128 + i2[ci & 15]; SG[tl * 128 + hh * 16 + j] = e[j] * inv; } } }
#undef PEER_KEY
#undef PEER_INS
    asm volatile("s_waitcnt lgkmcnt(0)" ::: "memory");
}
__device__ __forceinline__ void peer_gather(int chunk, const bf16_t* __restrict__ H2, const unsigned char* __restrict__ U, const unsigned char* __restrict__ V,
                                            const float* __restrict__ g2, const float* __restrict__ gf, float* OUT, int tid, const LAS int* SE, const LAS float* SG) {
    asm volatile("" : "+v"(tid));
    const int tok0 = chunk * CH, lane = tid & 63, wave = tid >> 6;
    const rsrc_t rH2 = mk_rsrc(H2, 0x4000000u), rU = mk_rsrc(U, 0x1000000u), rV = mk_rsrc(V, 0x1000000u), rG2 = mk_rsrc(g2, 8192u), rGF = mk_rsrc(gf, 8192u);
#pragma unroll 1
    for (int tt = 0; tt < CH / NWAVES; ++tt) { const int tl = wave * (CH / NWAVES) + tt, tok = tok0 + tl;
      asm volatile("" ::: "memory");
      float hn[32]; float ss = 0.f;
#pragma unroll
      for (int j = 0; j < 2; ++j)
#pragma unroll
          for (int q = 0; q < 4; ++q) { const u32x2 w = ldb64_nt(rH2, ((unsigned)tok * 2048u + 256u * (4 * j + q) + 4u * lane) * 2u);
              const f32x4 a = (f32x4){__uint_as_float(w.x << 16), __uint_as_float(w.x & 0xffff0000u), __uint_as_float(w.y << 16), __uint_as_float(w.y & 0xffff0000u)};
#pragma unroll
              for (int i = 0; i < 4; ++i) { hn[16 * j + 4 * q + i] = a[i]; ss += a[i] * a[i]; } }
      const float rstd = 1.0f / sqrtf(wave_sum(ss) * (1.f / 2048.f) + NORM_EPS);
#pragma unroll
      for (int j = 0; j < 2; ++j)
#pragma unroll
          for (int q = 0; q < 4; ++q) { const f32x4 a = ldf128(rG2, (256u * (4 * j + q) + 4u * lane) * 4u);
#pragma unroll
              for (int i = 0; i < 4; ++i) hn[16 * j + 4 * q + i] *= rstd * a[i]; }
      typedef _Float16 h2_t __attribute__((ext_vector_type(2)));
      h2_t hn16[16]; f32x2 accp[16];
#pragma unroll
      for (int k = 0; k < 16; ++k) { hn16[k] = (h2_t){(_Float16)hn[2 * k], (_Float16)hn[2 * k + 1]}; accp[k] = (f32x2){0.f, 0.f}; }
#define NX 4
#define PEER_LOAD(S, kb) do { _Pragma("unroll") for (int x = 0; x < NX; ++x) { const unsigned o = (unsigned)SE[tl * 128 + (kb) + x] * 1024u + (unsigned)lane * 16u; \
          S##u[x] = ldb128(rU, o); S##v[x] = ldb128(rV, o); } } while (0)
#define PEER_DU(W, k) dd = __builtin_amdgcn_fdot2(__builtin_amdgcn_cvt_scalef32_pk_f16_fp4(W[(k) >> 2], 1.0f, (k) & 3), hn16[k], dd, false);
#define PEER_DV(W, k) accp[k] = __builtin_elementwise_fma(__builtin_amdgcn_cvt_scalef32_pk_f32_fp4(W[(k) >> 2], 1.0f, (k) & 3), c2, accp[k]);
#define PEER_16(M, W) M(W, 0) M(W, 1) M(W, 2) M(W, 3) M(W, 4) M(W, 5) M(W, 6) M(W, 7) M(W, 8) M(W, 9) M(W, 10) M(W, 11) M(W, 12) M(W, 13) M(W, 14) M(W, 15)
#define PEER_COMPUTE(S, kb) do { float d[NX]; \
          _Pragma("unroll") for (int x = 0; x < NX; ++x) { const u32x4 W = S##u[x]; float dd = 0.f; PEER_16(PEER_DU, W) d[x] = dd; } \
          _Pragma("unroll") for (int x = 0; x < NX; ++x) d[x] = wave_sum_dpp(d[x]); \
          float c[NX];        \
          { float dv_ = d[0]; _Pragma("unroll") for (int x = 1; x < NX; ++x) dv_ = ((lane & (NX - 1)) == x) ? d[x] : dv_; \
            const float g_ = SG[tl * 128 + (kb) + (lane & (NX - 1))] * gelu_tanh(dv_ * (1.f / PEER_U_SCALE)) * (1.f / PEER_V_SCALE); \
            _Pragma("unroll") for (int x = 0; x < NX; ++x) c[x] = __builtin_bit_cast(float, __builtin_amdgcn_readlane(__builtin_bit_cast(int, g_), x)); } \
          _Pragma("unroll") for (int x = 0; x < NX; ++x) { const u32x4 W = S##v[x]; const f32x2 c2 = (f32x2){c[x], c[x]}; PEER_16(PEER_DV, W) } } while (0)
      { u32x4 Au[NX], Av[NX], Bu[NX], Bv[NX];
        PEER_LOAD(A, 0);
#pragma unroll 1
        for (int k = 0; k < 128; k += 2 * NX) {
            PEER_LOAD(B, k + NX); PEER_COMPUTE(A, k);
            { const int kn = min(k + 2 * NX, 128 - NX); PEER_LOAD(A, kn); }
            PEER_COMPUTE(B, k + NX);
        } }
#undef PEER_DU
#undef PEER_DV
#undef PEER_16
#undef NX
#undef PEER_LOAD
#undef PEER_COMPUTE
      asm volatile("" ::: "memory");
      int tok2 = tok, lane2 = lane; asm volatile("" : "+v"(tok2), "+v"(lane2));
      float s2 = 0.f;
#pragma unroll
      for (int j = 0; j < 2; ++j)
#pragma unroll
          for (int q = 0; q < 4; ++q) { const u32x2 w = ldb64_nt(rH2, ((unsigned)tok2 * 2048u + 256u * (4 * j + q) + 4u * lane2) * 2u);
              const f32x4 a = (f32x4){__uint_as_float(w.x << 16), __uint_as_float(w.x & 0xffff0000u), __uint_as_float(w.y << 16), __uint_as_float(w.y & 0xffff0000u)};
#pragma unroll
              for (int i = 0; i < 4; ++i) { const int e_ = 16 * j + 4 * q + i; accp[e_ >> 1][e_ & 1] += a[i]; s2 += accp[e_ >> 1][e_ & 1] * accp[e_ >> 1][e_ & 1]; } }
      const float rf = 1.0f / sqrtf(wave_sum(s2) * (1.f / 2048.f) + NORM_EPS);
#pragma unroll
      for (int j = 0; j < 2; ++j)
#pragma unroll
          for (int q = 0; q < 4; ++q) { const f32x4 a = ldf128(rGF, (256u * (4 * j + q) + 4u * lane2) * 4u); f32x4 oa;
#pragma unroll
              for (int i = 0; i < 4; ++i) { const int e_ = 16 * j + 4 * q + i; oa[i] = accp[e_ >> 1][e_ & 1] * rf * a[i]; }
              float* op = OUT + (size_t)tok2 * 2048 + 256 * (4 * j + q) + 4 * lane2;
              __builtin_nontemporal_store(oa, (GAS f32x4*)op); }
    }
}
}
#ifndef MK_N_LAUNCHES
#define MK_N_LAUNCHES 1
#endif
constexpr int N_PHASES = 9;
constexpr int N_LAUNCHES = MK_N_LAUNCHES;
struct Args { const float* in[19]; float* out; unsigned char* ws; int ph_lo, ph_hi; };
static_assert(sizeof(Args) == 19 * 8 + 8 + 8 + 8, "no padding");

__global__ void __launch_bounds__(NWAVES * 64, 2) hybrid_fwd(Args args) {
    extern __shared__ __attribute__((aligned(16))) unsigned char lds_raw[];
    Frame F;
    F.lds = (LAS unsigned char*)lds_raw;
    F.MISC = (volatile LAS unsigned*)(F.lds + MISC_OFF);
    F.tid = threadIdx.x; F.lane = F.tid & 63; F.wave = __builtin_amdgcn_readfirstlane(F.tid >> 6);
    F.G = gridDim.x; { const int bx = blockIdx.x; F.vcu = (F.G % 8 == 0) ? (bx % 8) * (F.G / 8) + bx / 8 : bx; }
    F.ws = args.ws; F.out = args.out;
#pragma unroll
    for (int i = 0; i < 19; ++i) F.in[i] = args.in[i];
    for (int u = F.tid; u < (LDS_BYTES - LDSCTL_OFF) / 4; u += NWAVES * 64) ((LAS unsigned*)(F.lds + LDSCTL_OFF))[u] = 0u;
    __syncthreads();
    XcdBarrier bar; bar.bar = (unsigned*)(F.ws + WS_CTL) + CW_BAR; bar.x = 0; bar.st = nullptr;
    if (N_LAUNCHES == 1) bar = xcd_barrier_post((unsigned*)(F.ws + WS_CTL) + CW_BAR, F.MISC + 8);
    const int lo = args.ph_lo, hi = args.ph_hi;
#define IN(k) (lo <= (k) && (k) < hi)
#define SEAM(k) do { if (IN(k) && IN((k) + 1)) xcd_barrier(bar); } while (0)
    const size_t T2048 = (size_t)256 * 2048 * 2, T1024 = (size_t)256 * 1024 * 2, T512 = (size_t)256 * 512 * 2;
    float* cosT = WSP(float, WS_COS); float* sinT = WSP(float, WS_SIN);
    float* ssq_q = WSP(float, WS_SSQ_Q); float* ssq_kv = WSP(float, WS_SSQ_KV); float* ssq2 = WSP(float, WS_SSQ_2);

    if (IN(0)) { p0_prologue<0>(F, F.vcu, F.G); } SEAM(0);
    if (IN(1)) {
        SchedP1 S{F.G, (int)blockIdx.x, (const char*)(F.ws + WS_HN1), (const char*)(F.ws + WS_WIN), (const char*)(F.ws + WS_WVT), T1024};
        EpiP1 E{WSP(unsigned char, WS_NAQ), WSP(unsigned char, WS_NAK), WSP(unsigned char, WS_VT), WSP(unsigned char, WS_CQ), WSP(unsigned char, WS_CKV), WSP(unsigned char, WS_KR), WSP(unsigned char, WS_GA), WSP(unsigned char, WS_GB), ssq_q, ssq_kv, cosT, sinT};
        pg8::gemm_phase<EpiP1, SchedP1, true, -6>(F.lds, 2048, S, E);
        { const int extra = P1_UNITS % F.G, bx = (int)blockIdx.x; if (extra != 0 && bx >= extra) p0_prologue<1>(F, bx - extra, F.G - extra); else if (extra == 0) p0_prologue<1>(F, bx, F.G); }
    } SEAM(1);
    if (IN(2)) {
        LAS float* relb = (LAS float*)F.lds + 64; LAS float* metab = relb + 16 * 15 * 31 + 128; LAS float* wsf = metab + 256 + F.wave * 64;
        for (int i = F.tid; i < 16 * 15 * 31; i += NWAVES * 64) relb[i] = F.in[4][i];
        if (F.tid < 256) metab[F.tid] = F.in[5][F.tid];
        __syncthreads();
        const int gw = F.vcu * NWAVES + F.wave, NGW = F.G * NWAVES;
        for (int task = gw; task < NBATCH * 16 * 32 * 2; task += NGW)
            att::na_task(task, WSP(unsigned char, WS_NAQ), WSP(unsigned char, WS_NAK), WSP(unsigned char, WS_VT), WSP(unsigned char, WS_ONA), relb, metab, wsf, F.lane);
        __syncthreads();
    }
    if (IN(3)) {
        SchedP3 S{F.G, (int)blockIdx.x, (const char*)F.ws, T512 / 2};
        EpiP3 E{WSP(unsigned char, WS_QM), WSP(unsigned char, WS_KN), WSP(unsigned char, WS_VV), ssq_q, ssq_kv, cosT, sinT};
        pg8::gemm_phase<EpiP3, SchedP3, true, -4>(F.lds, 512, S, E);
    } SEAM(3);
    if (IN(4)) {
        const int gw = F.vcu * NWAVES + F.wave, NGW = F.G * NWAVES;
        Conv cv{F.in[16], F.in[17], WSP(unsigned char, WS_U), WSP(unsigned char, WS_V), F.lds + 65536 + F.wave * 8192, gw, NGW, 2 * 16384, -1, 0};
        for (int id = F.vcu; id < NBATCH * 16 * 8; id += F.G) { const int bh = id >> 3, qb = id & 7;
            att::mla_unit8(bh >> 4, bh & 15, qb, WSP(unsigned char, WS_QM), WSP(unsigned char, WS_KN), WSP(unsigned char, WS_KR), WSP(unsigned char, WS_VV), WSP(unsigned char, WS_OMLA), (LAS char*)F.lds, cv); }
        while (cv.pend >= 0 || cv.next < cv.end) conv_step<0>(cv, F.lane);
        __syncthreads();
    } SEAM(4);
    if (IN(5)) {
        { SchedGrid S{F.G, (int)blockIdx.x, 64, 8, (const char*)(F.ws + WS_ONA), (const char*)(F.ws + WS_WNA), T512};
          EpiP5a E{WSP(unsigned char, WS_GA), WSP(unsigned char, WS_T1)};
          pg8::gemm_phase<EpiP5a, SchedGrid, true, -9>(F.lds, 1024, S, E); }
        { SchedGrid S{F.G, (int)blockIdx.x, 64, 8, (const char*)(F.ws + WS_OMLA), (const char*)(F.ws + WS_WMLA), T1024};
          EpiP5b E{WSP(unsigned char, WS_GB), WSP(unsigned char, WS_T1), WSP(unsigned char, WS_MERGED)};
          pg8::gemm_phase<EpiP5b, SchedGrid, true, -11>(F.lds, 2048, S, E); }
    } SEAM(5);
    if (IN(6)) {
        { SchedGrid S{F.G, (int)blockIdx.x, 64, 8, (const char*)(F.ws + WS_MERGED), (const char*)(F.ws + WS_WOUT), T1024};
          EpiP6 E{F.in[0], WSP(bf16_t, WS_H2B), ssq2};
          pg8::gemm_phase<EpiP6, SchedGrid, true, -11>(F.lds, 2048, S, E); }
    } SEAM(6);
    if (IN(7)) {
        SchedGrid S{F.G, (int)blockIdx.x, 64, 8, (const char*)(F.ws + WS_H2B), (const char*)(F.ws + WS_WSC), T2048};
        EpiP7 E{ssq2, WSP(_Float16, WS_SC)};
        pg8::gemm_phase<EpiP7, SchedGrid>(F.lds, 2048, S, E);
    } SEAM(7);
    if (IN(8)) {
        const int nch = (MREAL / peer::CH - F.vcu + F.G - 1) / F.G; const bool both_first = (nch == 2) && (F.vcu & 1);
        for (int op = 0; op < 2 * nch; ++op) {
            const bool sel = both_first ? (op < 2) : !(op & 1); const int ci = both_first ? (op & 1) : (op >> 1), chunk = F.vcu + ci * F.G;
            const int b2 = both_first ? ci : 0;
            LAS int* SE = (LAS int*)(F.lds + (b2 ? peer::OFF_SE2 : peer::OFF_SE)); LAS float* SG = (LAS float*)(F.lds + (b2 ? peer::OFF_SG2 : peer::OFF_SG));
            if (sel) peer::peer_select(chunk, WSP(_Float16, WS_SC), (LAS char*)F.lds, F.tid, SE, SG);
            else peer::peer_gather(chunk, WSP(bf16_t, WS_H2B), WSP(unsigned char, WS_U), WSP(unsigned char, WS_V), F.in[13], F.in[18], F.out, F.tid, SE, SG); }
    }
#undef IN
#undef SEAM
}

extern "C" void kernel_launch(void* const* d_in, const int* in_sizes, int n_in, void* d_out, int out_size, void* d_ws, size_t ws_size, hipStream_t stream) {
    static int grid = 0;
    if (grid == 0) {
        if (n_in != 19 || in_sizes[0] != MREAL * DM || out_size != MREAL * DM || ws_size < WS_END) {
            fprintf(stderr, "kernel_launch: shape/workspace mismatch: n_in %d in0 %d out %d ws %zu (need %zu); nothing launched\n", n_in, n_in > 0 ? in_sizes[0] : -1, out_size, ws_size, (size_t)WS_END); grid = -1; return; }
        int dev = 0, cus = 0, per_cu = 0;
        if (hipGetDevice(&dev) != hipSuccess || hipDeviceGetAttribute(&cus, hipDeviceAttributeMultiprocessorCount, dev) != hipSuccess) { fprintf(stderr, "kernel_launch: device query failed\n"); grid = -1; return; }
        if (hipFuncSetAttribute((const void*)hybrid_fwd, hipFuncAttributeMaxDynamicSharedMemorySize, LDS_BYTES) != hipSuccess) { fprintf(stderr, "kernel_launch: hipFuncSetAttribute failed\n"); grid = -1; return; }
        if (hipOccupancyMaxActiveBlocksPerMultiprocessor(&per_cu, (const void*)hybrid_fwd, NWAVES * 64, LDS_BYTES) != hipSuccess || per_cu < 1)
            fprintf(stderr, "kernel_launch: note: occupancy query reports %d workgroups per CU\n", per_cu);
        (void)hipGetLastError();
        grid = cus;
    }
    if (grid < 0) return;
    if (hipMemsetAsync((char*)d_ws + WS_CTL, 0, CTL_ZERO_BYTES, stream) != hipSuccess) { fprintf(stderr, "kernel_launch: hipMemsetAsync failed\n"); return; }
    Args a{};
    for (int i = 0; i < 19; ++i) a.in[i] = (const float*)d_in[i];
    a.out = (float*)d_out; a.ws = (unsigned char*)d_ws;
    for (int li = 0; li < N_LAUNCHES; ++li) {
        a.ph_lo = (N_LAUNCHES == 1) ? 0 : li; a.ph_hi = (N_LAUNCHES == 1) ? N_PHASES : li + 1;
        hipLaunchKernelGGL(hybrid_fwd, dim3(grid), dim3(NWAVES * 64), LDS_BYTES, stream, a);
        const hipError_t le = hipPeekAtLastError();
        if (le != hipSuccess) { fprintf(stderr, "kernel_launch: launch %d failed: %s\n", li, hipGetErrorName(le)); break; }
    }
}
```
